# Optimizing an MI355X kernel written in HIP

```python
import math
import jax, jax.numpy as jnp
from jax import lax
import numpy as np

D_MODEL = 2048
BATCH = 1
SEQ = 16384
DEPTH = 4
DEC_BATCH = 8
DEC_SEQ = 64
PAST_LEN = 2048

CHUNK = 64
N_MIXERS = 3
ROPE_THETA = 10000.0
EPS = 1e-6

A_HD = 64
A_VD = 2 * A_HD
A_HEADS = D_MODEL // A_VD
A_W = A_HEADS * A_VD
Q_BLOCK = 128

R_DK = 256
R_HEADS = D_MODEL // R_DK
R_DV = 2 * R_DK
R_QK = R_HEADS * R_DK
R_V = R_HEADS * R_DV

M_CHUNK = 128
M_GROUPS = 8
M_W = 2 * D_MODEL
M_GD = M_W // M_GROUPS

N_A = (DEPTH + 2) // 3
N_B = (DEPTH + 1) // 3
N_C = DEPTH // 3

kernel_name = "hybrid_streaming_encoder_step"


def rms_norm(x, w):
    xf = x.astype(jnp.float32)
    y = xf * lax.rsqrt(jnp.mean(xf * xf, axis=-1, keepdims=True) + EPS)
    return (y * w.astype(jnp.float32)).astype(x.dtype)


def rms_norm_plain(x):
    xf = x.astype(jnp.float32)
    return xf * lax.rsqrt(jnp.mean(xf * xf, axis=-1, keepdims=True) + EPS)


def split_heads(x, heads):
    return x.reshape(x.shape[:-1] + (heads, x.shape[-1] // heads))


def rope(x, pos):
    d = x.shape[-1]
    inv = ROPE_THETA ** (-jnp.arange(0, d, 2, dtype=jnp.float32) / d)
    ang = pos.astype(jnp.float32)[:, None] * inv[None, :]
    cos = jnp.cos(ang)[None, :, None, :]
    sin = jnp.sin(ang)[None, :, None, :]
    xf = x.astype(jnp.float32)
    x1, x2 = xf[..., : d // 2], xf[..., d // 2:]
    return jnp.concatenate([x1 * cos - x2 * sin, x2 * cos + x1 * sin], axis=-1).astype(x.dtype)


def diff_lambda(lq1, lk1, lq2, lk2, lam_init):
    f = lambda a: a.astype(jnp.float32)
    return jnp.exp(jnp.sum(f(lq1) * f(lk1))) - jnp.exp(jnp.sum(f(lq2) * f(lk2))) + lam_init


def diff_project(h, pos, w_in, q_gain, k_gain):
    z = h @ w_in
    q, k, v, g = jnp.split(z, 4, axis=-1)
    q = rope(rms_norm(split_heads(q, 2 * A_HEADS), q_gain), pos)
    k = rope(rms_norm(split_heads(k, 2 * A_HEADS), k_gain), pos)
    v = split_heads(v, A_HEADS)
    return q, k, v, g


def diff_attend(q, k, v, q_pos, k_pos, lam):
    b, t = q.shape[:2]
    s_len = k.shape[1]
    sc = jnp.einsum('bthd,bshd->bhts', q.astype(jnp.float32), k.astype(jnp.float32)) * (A_HD ** -0.5)
    visible = k_pos[None, :] < ((q_pos // CHUNK + 1) * CHUNK)[:, None]
    sc = jnp.where(visible[None, None], sc, -jnp.inf)
    p = jax.nn.softmax(sc, axis=-1).reshape(b, A_HEADS, 2, t, s_len)
    a = p[:, :, 0] - lam * p[:, :, 1]
    return jnp.einsum('bhts,bshe->bthe', a, v.astype(jnp.float32))


def diff_output(o, g, sub_gain, lam_init, w_out):
    o = rms_norm(o, sub_gain) * (1.0 - lam_init)
    o = o.reshape(o.shape[:2] + (A_W,)).astype(g.dtype) * jax.nn.silu(g)
    return o @ w_out


def diff_attn_prompt(h, pos, w_in, w_out, q_gain, k_gain, lam, lam_init, sub_gain):
    q, k, v, g = diff_project(h, pos, w_in, q_gain, k_gain)
    b, s = h.shape[:2]
    nb = s // Q_BLOCK
    qb = jnp.moveaxis(q.reshape(b, nb, Q_BLOCK, 2 * A_HEADS, A_HD), 1, 0)
    pb = pos.reshape(nb, Q_BLOCK)
    o = lax.map(lambda blk: diff_attend(blk[0], k, v, blk[1], pos, lam), (qb, pb))
    o = jnp.moveaxis(o, 0, 1).reshape(b, s, A_HEADS, A_VD)
    return diff_output(o, g, sub_gain, lam_init, w_out), k, v


def diff_attn_sample(h, pos, k_past, v_past, w_in, w_out, q_gain, k_gain, lam, lam_init, sub_gain):
    q, k, v, g = diff_project(h, pos, w_in, q_gain, k_gain)
    k_all = jnp.concatenate([k_past.astype(k.dtype), k], axis=1)
    v_all = jnp.concatenate([v_past.astype(v.dtype), v], axis=1)
    k_pos = jnp.arange(k_all.shape[1], dtype=jnp.int32)
    o = diff_attend(q, k_all, v_all, pos, k_pos, lam)
    return diff_output(o, g, sub_gain, lam_init, w_out), k, v


def ret_log_gamma():
    return jnp.log1p(-(2.0 ** (-5.0 - jnp.arange(R_HEADS, dtype=jnp.float32))))


def ret_project(h, pos, w_in):
    z = h @ w_in
    q, k, v, g = jnp.split(z, [R_QK, 2 * R_QK, 2 * R_QK + R_V], axis=-1)
    q = rope(split_heads(q, R_HEADS), pos)
    k = rope(split_heads(k, R_HEADS), pos) * (R_DK ** -0.5)
    v = split_heads(v, R_HEADS)
    return q, k, v, g


def retention_chunk(state, q, k, v):
    L = q.shape[1]
    lg = ret_log_gamma()
    idx = jnp.arange(L, dtype=jnp.float32)
    diff = idx[:, None] - idx[None, :]
    decay = jnp.where(diff >= 0, jnp.exp(lg[:, None, None] * jnp.maximum(diff, 0.0)), 0.0)
    qf, kf, vf = q.astype(jnp.float32), k.astype(jnp.float32), v.astype(jnp.float32)
    inner = jnp.einsum('bihd,bjhd->bhij', qf, kf) * decay[None]
    o = jnp.einsum('bhij,bjhe->bihe', inner, vf)
    cross_decay = jnp.exp(lg[None, :] * (idx[:, None] + 1.0))
    o = o + jnp.einsum('bihd,bhde->bihe', qf, state) * cross_decay[None, :, :, None]
    k_decay = jnp.exp(lg[:, None] * (L - 1.0 - idx[None, :]))
    new_state = state * jnp.exp(lg * L)[None, :, None, None] + jnp.einsum('bjhd,bjhe,hj->bhde', kf, vf, k_decay)
    return new_state, o


def ret_output(o, g, w_out):
    o = rms_norm_plain(o)
    o = o.reshape(o.shape[:2] + (R_V,)).astype(g.dtype) * jax.nn.silu(g)
    return o @ w_out


def retention_prompt(h, pos, w_in, w_out):
    q, k, v, g = ret_project(h, pos, w_in)
    b, s = h.shape[:2]
    nc = s // CHUNK
    to_chunks = lambda a: jnp.moveaxis(a.reshape((b, nc, CHUNK) + a.shape[2:]), 1, 0)
    s0 = jnp.zeros((b, R_HEADS, R_DK, R_DV), jnp.float32)
    s_fin, o = lax.scan(lambda st, xs: retention_chunk(st, xs[0], xs[1], xs[2]), s0,
                        (to_chunks(q), to_chunks(k), to_chunks(v)))
    o = jnp.moveaxis(o, 0, 1).reshape(b, s, R_HEADS, R_DV)
    return ret_output(o, g, w_out), s_fin


def retention_sample(h, pos, state, w_in, w_out):
    q, k, v, g = ret_project(h, pos, w_in)
    s_new, o = retention_chunk(state.astype(jnp.float32), q, k, v)
    return ret_output(o, g, w_out), s_new


def cmlp_branch(h, w_in, w_out, v_gain, w_s, b_s, chunk_len):
    z = h @ w_in
    u, v, g = jnp.split(z, 3, axis=-1)
    v = rms_norm(jax.nn.gelu(v), v_gain)
    b, s = h.shape[:2]
    nc = s // chunk_len
    vc = v.reshape(b, nc, chunk_len, M_GROUPS, M_GD)
    w = jnp.tril(w_s[:, :chunk_len, :chunk_len])
    mix = jnp.einsum('gij,bcjgd->bcigd', w, vc) + b_s[:, :chunk_len].T[None, None, :, :, None]
    y = jax.nn.gelu(u) * mix.reshape(b, s, M_W).astype(u.dtype) * jax.nn.silu(g)
    return y @ w_out, v


def setup_inputs(seed: int = 0) -> dict:
    key = jax.random.key(seed)
    ks = jax.random.split(key, 24)
    nrm = lambda k, shape, scale: jax.random.normal(k, shape, jnp.float32) * scale
    gain = lambda k, shape: 1.0 + 0.01 * jax.random.normal(k, shape, jnp.float32)
    return {
        "x_prompt": nrm(ks[0], (BATCH, SEQ, D_MODEL), 1.0),
        "x_sample": nrm(ks[1], (DEC_BATCH, DEC_SEQ, D_MODEL), 1.0),
        "cache_k_attn": nrm(ks[2], (N_A, DEC_BATCH, PAST_LEN, 2 * A_HEADS, A_HD), 1.0),
        "cache_v_attn": nrm(ks[3], (N_A, DEC_BATCH, PAST_LEN, A_HEADS, A_VD), 1.0),
        "state_ret": nrm(ks[4], (N_B, DEC_BATCH, R_HEADS, R_DK, R_DV), 0.1),
        "norm_w": gain(ks[5], (DEPTH, D_MODEL)),
        "a_w_in": nrm(ks[6], (N_A, D_MODEL, 4 * A_W), D_MODEL ** -0.5),
        "a_w_out": nrm(ks[7], (N_A, A_W, D_MODEL), A_W ** -0.5),
        "a_q_gain": gain(ks[8], (N_A, A_HD)),
        "a_k_gain": gain(ks[9], (N_A, A_HD)),
        "a_lam_q1": nrm(ks[10], (N_A, A_HD), 0.1),
        "a_lam_k1": nrm(ks[11], (N_A, A_HD), 0.1),
        "a_lam_q2": nrm(ks[12], (N_A, A_HD), 0.1),
        "a_lam_k2": nrm(ks[13], (N_A, A_HD), 0.1),
        "a_sub_gain": gain(ks[14], (N_A, A_VD)),
        "r_w_in": nrm(ks[15], (N_B, D_MODEL, 2 * R_QK + 2 * R_V), D_MODEL ** -0.5),
        "r_w_out": nrm(ks[16], (N_B, R_V, D_MODEL), R_V ** -0.5),
        "c_w_in": nrm(ks[17], (N_C, D_MODEL, 3 * M_W), D_MODEL ** -0.5),
        "c_w_out": nrm(ks[18], (N_C, M_W, D_MODEL), M_W ** -0.5),
        "c_v_gain": gain(ks[19], (N_C, M_W)),
        "c_w_s": nrm(ks[20], (N_C, M_GROUPS, M_CHUNK, M_CHUNK), M_CHUNK ** -0.5),
        "c_b_s": 1.0 + nrm(ks[21], (N_C, M_GROUPS, M_CHUNK), 0.1),
    }


def reference(x_prompt, x_sample, cache_k_attn, cache_v_attn, state_ret, norm_w,
              a_w_in, a_w_out, a_q_gain, a_k_gain, a_lam_q1, a_lam_k1, a_lam_q2, a_lam_k2, a_sub_gain,
              r_w_in, r_w_out, c_w_in, c_w_out, c_v_gain, c_w_s, c_b_s):
    hp, hs = x_prompt, x_sample
    s_len = x_prompt.shape[1]
    dec_len = x_sample.shape[1]
    past = cache_k_attn.shape[2]
    pos_p = jnp.arange(s_len, dtype=jnp.int32)
    pos_s = past + jnp.arange(dec_len, dtype=jnp.int32)

    kp_l, vp_l, ks_l, vs_l = [], [], [], []
    sp_l, ss_l, vm_l = [], [], []
    for i in range(DEPTH):
        kind = i % N_MIXERS
        j = i // N_MIXERS
        np_in = rms_norm(hp, norm_w[i])
        ns_in = rms_norm(hs, norm_w[i])
        if kind == 0:
            lam_init = 0.8 - 0.6 * math.exp(-0.3 * i)
            lam = diff_lambda(a_lam_q1[j], a_lam_k1[j], a_lam_q2[j], a_lam_k2[j], lam_init)
            yp, kp, vp = diff_attn_prompt(np_in, pos_p, a_w_in[j], a_w_out[j], a_q_gain[j], a_k_gain[j],
                                          lam, lam_init, a_sub_gain[j])
            ys, kn, vn = diff_attn_sample(ns_in, pos_s, cache_k_attn[j], cache_v_attn[j], a_w_in[j], a_w_out[j],
                                          a_q_gain[j], a_k_gain[j], lam, lam_init, a_sub_gain[j])
            kp_l.append(kp); vp_l.append(vp); ks_l.append(kn); vs_l.append(vn)
        elif kind == 1:
            yp, st_p = retention_prompt(np_in, pos_p, r_w_in[j], r_w_out[j])
            ys, st_s = retention_sample(ns_in, pos_s, state_ret[j], r_w_in[j], r_w_out[j])
            sp_l.append(st_p); ss_l.append(st_s)
        else:
            yp, _ = cmlp_branch(np_in, c_w_in[j], c_w_out[j], c_v_gain[j], c_w_s[j], c_b_s[j], M_CHUNK)
            ys, v_s = cmlp_branch(ns_in, c_w_in[j], c_w_out[j], c_v_gain[j], c_w_s[j], c_b_s[j], dec_len)
            vm_l.append(v_s)
        hp = hp + yp.astype(hp.dtype)
        hs = hs + ys.astype(hs.dtype)

    return (hp, hs, jnp.stack(kp_l), jnp.stack(vp_l), jnp.stack(ks_l), jnp.stack(vs_l),
            jnp.stack(sp_l), jnp.stack(ss_l), jnp.stack(vm_l))
```

```cpp
#include <hip/hip_runtime.h>
#include <cstdio>
#include <cstdint>

namespace pg8 {
#define PG8_LAS __attribute__((address_space(3)))
typedef unsigned short bf16_t;
typedef short bf16x8 __attribute__((ext_vector_type(8)));
typedef float f32x4 __attribute__((ext_vector_type(4)));
typedef unsigned u32x4 __attribute__((ext_vector_type(4)));
constexpr int BM = 256, BK = 64, HALF = 128, HTB = HALF * BK * 2, STAGE_BYTES = 8 * HTB, NXCD = 8, WGM = 8;

__host__ __device__ __forceinline__ int lds_byte(int r, int c) { const int st = (r >> 4) * 2 + (c >> 5), rr = r & 15, cc = c & 31, ob = rr * 64 + cc * 2; return st * 1024 + (ob ^ (((ob >> 9) & 1) << 5)); }
__host__ __device__ __forceinline__ void stage_rc(int b, int& R, int& C) { const int st = b / 1024, sb = b % 1024, swz = sb ^ (((sb >> 9) & 1) << 5); R = (st >> 1) * 16 + swz / 64; C = (st & 1) * 32 + (swz % 64) / 2; }
__host__ __device__ __forceinline__ int perm32(int rho) { const int n = rho >> 4, i = rho & 15; return 8 * (i >> 2) + 4 * n + (i & 3); }

struct Unit { int pm, pn; const char* a; const char* b; };
struct GemmP { int lda, ldb, nt; };

struct StaticOrder {
    int nM, nN, nwg, G, c; const char* A; const char* B; size_t ta, tb;
    __host__ __device__ void init(int nM_, int nN_, int G_, int c_, const void* A_, const void* B_, int lda, int ldb) { nM = nM_; nN = nN_; nwg = nM * nN; G = G_; c = c_; A = (const char*)A_; B = (const char*)B_; ta = (size_t)BM * lda * 2; tb = (size_t)BM * ldb * 2; }
    __host__ __device__ bool next(int i, Unit& u) const {
        const long L = (long)i * G + c; if (L >= nwg) return false;
        int wgid = (int)L; { const int q = nwg / NXCD, r = nwg % NXCD, xcd = wgid % NXCD, off = wgid / NXCD; wgid = (xcd < r ? xcd * (q + 1) : r * (q + 1) + (xcd - r) * q) + off; }
        const int nig = WGM * nN, gid = wgid / nig, fm = gid * WGM, gsz = (nM - fm) < WGM ? (nM - fm) : WGM;
        u.pm = fm + ((wgid % nig) % gsz); u.pn = (wgid % nig) / gsz; u.a = A + (size_t)u.pm * ta; u.b = B + (size_t)u.pn * tb; return true;
    }
    __device__ __forceinline__ void a_ready(const Unit&) const {}
    __device__ __forceinline__ void done(const Unit&) const {}
};

__device__ __forceinline__ unsigned cvt_pk_bf16(float lo, float hi) { unsigned r; asm volatile("v_cvt_pk_bf16_f32 %0, %1, %2" : "=v"(r) : "v"(lo), "v"(hi)); return r; }

struct EpiStoreBf16 {
    static constexpr bool PERM = true;
    bf16_t* O; int ldc;
    __device__ __forceinline__ void operator()(const f32x4 (&acc)[2][2][4][2], const Unit& u, int wr, int wc, int fr, int fq) const {
        const int row0 = u.pm * BM + wr * 64 + fr; const int col0 = u.pn * BM + wc * 32 + 8 * fq;
#pragma unroll
        for (int ai = 0; ai < 2; ++ai)
#pragma unroll
            for (int m = 0; m < 4; ++m) { bf16_t* rowp = O + (size_t)(row0 + ai * HALF + m * 16) * ldc + col0;
#pragma unroll
                for (int bj = 0; bj < 2; ++bj) { const f32x4 v0 = acc[ai][bj][m][0], v1 = acc[ai][bj][m][1];
                    u32x4 w; w.x = cvt_pk_bf16(v0[0], v0[1]); w.y = cvt_pk_bf16(v0[2], v0[3]); w.z = cvt_pk_bf16(v1[0], v1[1]); w.w = cvt_pk_bf16(v1[2], v1[3]);
                    *(u32x4*)(rowp + bj * HALF) = w; } }
    }
};
struct EpiResid {
    static constexpr bool PERM = false;
    const float* base_p; const float* base_s; float* out; int split;
    __device__ __forceinline__ void operator()(const f32x4 (&acc)[2][2][4][2], const Unit& u, int wr, int wc, int fr, int fq) const {
        const int col0 = u.pn * BM + wc * 32 + 4 * fq;
#pragma unroll
        for (int ai = 0; ai < 2; ++ai)
#pragma unroll
            for (int m = 0; m < 4; ++m) { const int r = u.pm * BM + ai * HALF + wr * 64 + m * 16 + fr;
                const float* bp = (r < split) ? base_p + (size_t)r * 2048 : base_s + (size_t)(r - split) * 2048; float* op = out + (size_t)r * 2048;
#pragma unroll
                for (int bj = 0; bj < 2; ++bj)
#pragma unroll
                    for (int n = 0; n < 2; ++n) { const int c = col0 + bj * HALF + n * 16; const f32x4 bs = *(const f32x4*)(bp + c); *(f32x4*)(op + c) = bs + acc[ai][bj][m][n]; }
                if (m & 1) asm volatile("" ::: "memory"); }
    }
};

template <class Epi, class Sched, bool ALIGN_EPI = true>
__device__ __forceinline__ void gemm_phase(PG8_LAS unsigned char* lds, const GemmP g, const Sched& S, const Epi& E) {
    const int tid = threadIdx.x, wid = __builtin_amdgcn_readfirstlane(tid >> 6), lane = tid & 63, wr = wid >> 2, wc = wid & 3, fr = lane & 15, fq = lane >> 4;
    const int nt = g.nt;
    unsigned voffA[2], voffB[2];
#pragma unroll
    for (int i = 0; i < 2; ++i) { int R, C; stage_rc(tid * 16 + i * 8192, R, C); const int Rb = Epi::PERM ? ((R & ~31) + perm32(R & 31)) : R;
        voffA[i] = (unsigned)(R * g.lda + C) * 2u; voffB[i] = (unsigned)(Rb * g.ldb + C) * 2u; }
    const size_t kstep = (size_t)(BK * 2);
    const size_t hstepA = (size_t)HALF * g.lda * 2, hstepB = (size_t)HALF * g.ldb * 2;
    const unsigned ldsw = (unsigned)wid * 1024u;
    const int aoff = lds_byte(wr * 64 + fr, fq * 8), boff = lds_byte(wc * 32 + fr, fq * 8);
#define PG8_SA(b, h) (((b) * 2 + (h)) * HTB)
#define PG8_SB(b, h) ((4 + (b) * 2 + (h)) * HTB)
#define PG8_STAGE(bufoff, gbase, voff) do { _Pragma("unroll") for (int _i = 0; _i < 2; ++_i) \
        __builtin_amdgcn_global_load_lds((const unsigned*)((const char*)(gbase) + (voff)[_i]), (PG8_LAS unsigned*)(lds + (bufoff) + ldsw + _i * 8192), 16, 0, 0); } while (0)
#define PG8_LDA(dst, b, h) do { _Pragma("unroll") for (int m = 0; m < 4; ++m) _Pragma("unroll") for (int k = 0; k < 2; ++k) dst[m][k] = *(const PG8_LAS bf16x8*)(lds + PG8_SA(b, h) + aoff + m * 2048 + k * 1024); } while (0)
#define PG8_LDB(dst, b, h) do { _Pragma("unroll") for (int n = 0; n < 2; ++n) _Pragma("unroll") for (int k = 0; k < 2; ++k) dst[n][k] = *(const PG8_LAS bf16x8*)(lds + PG8_SB(b, h) + boff + n * 2048 + k * 1024); } while (0)
#define PG8_MMA(ai, bj, At, Bt) do { __builtin_amdgcn_s_setprio(1); _Pragma("unroll") for (int m = 0; m < 4; ++m) _Pragma("unroll") for (int n = 0; n < 2; ++n) _Pragma("unroll") for (int k = 0; k < 2; ++k) \
        acc[ai][bj][m][n] = __builtin_amdgcn_mfma_f32_16x16x32_bf16(Bt[n][k], At[m][k], acc[ai][bj][m][n], 0, 0, 0); __builtin_amdgcn_s_setprio(0); } while (0)
#define PG8_WAIT_V(n) asm volatile("s_waitcnt vmcnt(" #n ")" ::: "memory")
#define PG8_WAIT_L(n) asm volatile("s_waitcnt lgkmcnt(" #n ")" ::: "memory")
#define PG8_BAR __builtin_amdgcn_s_barrier()
#define PG8_SCHED __builtin_amdgcn_sched_barrier(0)
    Unit cur, nxt; int ui = 0;
    if (!S.next(0, cur)) return;
    f32x4 acc[2][2][4][2];
#pragma unroll
    for (int a = 0; a < 2; ++a)
#pragma unroll
        for (int b = 0; b < 2; ++b)
#pragma unroll
            for (int m = 0; m < 4; ++m)
#pragma unroll
                for (int n = 0; n < 2; ++n) acc[a][b][m][n] = (f32x4){0.f, 0.f, 0.f, 0.f};
    bf16x8 At[4][2], B0[2][2], B1[2][2];
    const char* cA = cur.a; const char* cB = cur.b;
    S.a_ready(cur);
    PG8_STAGE(PG8_SB(0, 0), cB, voffB); PG8_STAGE(PG8_SB(0, 1), cB + hstepB, voffB); PG8_STAGE(PG8_SA(0, 0), cA, voffA); PG8_STAGE(PG8_SA(0, 1), cA + hstepA, voffA);
    if (wr == 1) PG8_BAR;
    PG8_WAIT_V(2); PG8_BAR;
    PG8_STAGE(PG8_SB(1, 0), cB + kstep, voffB); PG8_STAGE(PG8_SA(1, 0), cA + kstep, voffA); PG8_STAGE(PG8_SB(1, 1), cB + hstepB + kstep, voffB);
    PG8_WAIT_V(6); PG8_BAR;
    for (;;) {
        const bool has_next = S.next(ui + 1, nxt);
        const char* nA = has_next ? nxt.a : cA; const char* nB = has_next ? nxt.b : cB;
        for (int t = 0; t < nt; t += 2) {
            const bool last = (t == nt - 2);
            const char* a1 = cA + (size_t)(t + 1) * kstep;
            const char* a2 = last ? nA : cA + (size_t)(t + 2) * kstep; const char* b2 = last ? nB : cB + (size_t)(t + 2) * kstep;
            const char* a3 = a2 + kstep; const char* b3 = b2 + kstep;
            if (last && has_next) S.a_ready(nxt);
            PG8_LDB(B0, 0, 0); PG8_LDB(B1, 0, 1); PG8_SCHED; PG8_LDA(At, 0, 0); PG8_STAGE(PG8_SA(1, 1), a1 + hstepA, voffA);
            PG8_WAIT_V(8); PG8_WAIT_L(0); PG8_BAR; PG8_MMA(0, 0, At, B0); PG8_MMA(0, 1, At, B1); PG8_BAR; PG8_SCHED;
            PG8_LDA(At, 0, 1); PG8_STAGE(PG8_SB(0, 0), b2, voffB); PG8_STAGE(PG8_SB(0, 1), b2 + hstepB, voffB); PG8_STAGE(PG8_SA(0, 0), a2, voffA);
            PG8_WAIT_V(8); PG8_WAIT_L(0); PG8_BAR; PG8_MMA(1, 0, At, B0); PG8_MMA(1, 1, At, B1); PG8_BAR; PG8_SCHED;
            PG8_LDB(B0, 1, 0); PG8_LDB(B1, 1, 1); PG8_SCHED; PG8_LDA(At, 1, 0); PG8_STAGE(PG8_SA(0, 1), a2 + hstepA, voffA);
            PG8_WAIT_V(8); PG8_WAIT_L(0); PG8_BAR; PG8_MMA(0, 0, At, B0); PG8_MMA(0, 1, At, B1); PG8_BAR; PG8_SCHED;
            PG8_LDA(At, 1, 1); PG8_STAGE(PG8_SB(1, 0), b3, voffB); PG8_STAGE(PG8_SB(1, 1), b3 + hstepB, voffB); PG8_STAGE(PG8_SA(1, 0), a3, voffA);
            PG8_WAIT_V(8); PG8_WAIT_L(0); PG8_BAR; PG8_MMA(1, 0, At, B0); PG8_MMA(1, 1, At, B1); PG8_BAR; PG8_SCHED;
        }
        if constexpr (ALIGN_EPI) { if (wr == 0) PG8_BAR; }
        E(acc, cur, wr, wc, fr, fq); S.done(cur);
        if (!has_next) break;
#pragma unroll
        for (int a = 0; a < 2; ++a)
#pragma unroll
            for (int b = 0; b < 2; ++b)
#pragma unroll
                for (int m = 0; m < 4; ++m)
#pragma unroll
                    for (int n = 0; n < 2; ++n) acc[a][b][m][n] = (f32x4){0.f, 0.f, 0.f, 0.f};
        cur = nxt; cA = nA; cB = nB; ++ui;
        if constexpr (ALIGN_EPI) { if (wr == 1) PG8_BAR; }
    }
    PG8_WAIT_V(0);
    if constexpr (!ALIGN_EPI) { if (wr == 0) PG8_BAR; }
    PG8_BAR;
#undef PG8_SA
#undef PG8_SB
#undef PG8_STAGE
#undef PG8_LDA
#undef PG8_LDB
#undef PG8_MMA
#undef PG8_WAIT_V
#undef PG8_WAIT_L
#undef PG8_BAR
#undef PG8_SCHED
}
}

constexpr int NWAVES = 8, NTHR = 512;
constexpr int DM = 2048, MP = 16384, MS = 512, MT = MP + MS, PAST = 2048, DECL = 64, NB = 8;
constexpr int KCROWS = PAST + DECL;
constexpr float EPS = 1e-6f;
constexpr float LOG2E = 1.4426950408889634f;
constexpr float C2 = 0.125f * LOG2E;

enum { I_XP = 0, I_XS, I_CK, I_CV, I_SR, I_NW, I_AWIN, I_AWOUT, I_AQG, I_AKG, I_LQ1, I_LK1, I_LQ2, I_LK2, I_ASG, I_RWIN, I_RWOUT, I_CWIN, I_CWOUT, I_CVG, I_CWS, I_CBS, N_IN };
constexpr size_t O_YP = 0, O_YS = O_YP + (size_t)MP * DM, O_KP = O_YS + (size_t)MS * DM, O_VP = O_KP + 2 * (size_t)MP * DM, O_KS = O_VP + 2 * (size_t)MP * DM, O_VS = O_KS + 2 * (size_t)MS * DM,
                 O_SP = O_VS + 2 * (size_t)MS * DM, O_SS = O_SP + (size_t)8 * 256 * 512, O_VM = O_SS + (size_t)NB * 8 * 256 * 512, O_END = O_VM + (size_t)MS * 4096;

constexpr size_t MiB = 1u << 20;
constexpr size_t WS_CTL = 0, CTL_ZERO_BYTES = 1 * MiB;
constexpr size_t WS_WAIN0 = 8 * MiB, WS_WAIN1 = 40 * MiB, WS_WAOUT0 = 72 * MiB, WS_WAOUT1 = 80 * MiB, WS_WRIN = 88 * MiB, WS_WROUT = 136 * MiB, WS_WCIN = 152 * MiB, WS_WCOUT = 200 * MiB;
constexpr size_t WS_XN = 216 * MiB, WS_Z = 282 * MiB, WS_B1 = 678 * MiB, WS_B2 = 744 * MiB, WS_B3 = 810 * MiB, WS_B4 = 876 * MiB, WS_B5 = 942 * MiB, WS_B6 = 1008 * MiB, WS_END = 1074 * MiB;

#define GAS __attribute__((address_space(1)))
#define LAS __attribute__((address_space(3)))
typedef unsigned short bf16;
typedef unsigned v4u __attribute__((ext_vector_type(4)));
typedef unsigned v2u __attribute__((ext_vector_type(2)));
typedef float f32x4 __attribute__((ext_vector_type(4)));
typedef GAS unsigned gu32;
#define RLX_AGENT __ATOMIC_RELAXED, __HIP_MEMORY_SCOPE_AGENT
#define LDS_WAIT() asm volatile("s_waitcnt lgkmcnt(0)" ::: "memory")
#define VM_WAIT() asm volatile("s_waitcnt vmcnt(0)" ::: "memory")
__device__ __forceinline__ unsigned f2bf(float f) { unsigned u = __builtin_bit_cast(unsigned, f); return (u + 0x7fffu + ((u >> 16) & 1u)) >> 16; }
__device__ __forceinline__ unsigned pk2(float lo, float hi) { return f2bf(lo) | (f2bf(hi) << 16); }
__device__ __forceinline__ float bf2f(unsigned short b) { return __builtin_bit_cast(float, (unsigned)b << 16); }
__device__ __forceinline__ float bflo(unsigned w) { return __builtin_bit_cast(float, w << 16); }
__device__ __forceinline__ float bfhi(unsigned w) { return __builtin_bit_cast(float, w & 0xffff0000u); }
__device__ __forceinline__ float silu_f(float x) { return x / (1.f + __expf(-x)); }
__device__ __forceinline__ float gelu_tanh_f(float x) { const float u = 0.7978845608028654f * (x + 0.044715f * x * x * x); return x / (1.f + __expf(-2.f * u)); }
__device__ __forceinline__ float wave_sum(float v) {
#pragma unroll
    for (int o = 1; o < 64; o <<= 1) v += __shfl_xor(v, o);
    return v;
}
__device__ __forceinline__ void rope_cs(int pos, int i, int nf, float& c, float& s) {
    const float inv = exp2f(-(float)i / (float)nf * 13.287712379549449f);
    const double a = (double)pos * (double)inv * 0.15915494309189535;
    const float r = (float)(a - floor(a));
    c = __builtin_amdgcn_cosf(r); s = __builtin_amdgcn_sinf(r);
}

#define XB_TMO      128
#define XB_XCNT(j)  (256  + 64 * (j))
#define XB_XSUB(j)  (1280 + 64 * (j))
#define XB_XGEN(j)  (2304 + 64 * (j))
#define XB_TOP      3328
#define XB_TOPGEN   3392
#define XCD_BAR_WORDS 3456
#define XB_SPIN_CAP (1u << 22)
__device__ __forceinline__ unsigned xb_ld(unsigned* p)              { return __hip_atomic_load(p, __ATOMIC_RELAXED, __HIP_MEMORY_SCOPE_AGENT); }
__device__ __forceinline__ unsigned xb_add(unsigned* p, unsigned v) { return __hip_atomic_fetch_add(p, v, __ATOMIC_RELAXED, __HIP_MEMORY_SCOPE_AGENT); }
__device__ __forceinline__ unsigned xb_xcc_id() { return (unsigned)__builtin_amdgcn_s_getreg((3 << 11) | 20) & 0xFu; }
#define XB_SPIN(cond, bar) do { unsigned _sp = 0; while (cond) { __builtin_amdgcn_s_sleep(1); \
    if ((++_sp & 255u) == 0u) { if (xb_ld(&(bar)[XB_TMO])) break; if (_sp > XB_SPIN_CAP) { atomicAdd(&(bar)[XB_TMO], 1u); break; } } } } while (0)
struct XcdBarrier { unsigned* bar; unsigned x; volatile LAS unsigned* st; };
__device__ __forceinline__ XcdBarrier xcd_barrier_post(unsigned* bar, volatile LAS unsigned* st) {
    XcdBarrier b; b.bar = bar; b.x = xb_xcc_id(); b.st = st;
    if (threadIdx.x == 0) (void)xb_add(&bar[XB_XCNT(b.x)], 1u);
    return b;
}
__device__ __forceinline__ void xcd_barrier_complete(unsigned* bar, unsigned x, unsigned& nloc, unsigned& nx) {
    const unsigned G = gridDim.x * gridDim.y * gridDim.z;
    unsigned sum, cnt, mine, sp = 0u;
    for (;;) {
        sum = 0u; cnt = 0u; mine = 0u;
#pragma unroll
        for (unsigned j = 0; j < 16; ++j) { const unsigned c = xb_ld(&bar[XB_XCNT(j)]); sum += c; cnt += (c > 0u) ? 1u : 0u; mine = (j == x) ? c : mine; }
        if (sum == G) break;
        __builtin_amdgcn_s_sleep(1);
        if ((++sp & 255u) == 0u) { if (xb_ld(&bar[XB_TMO])) break; if (sp > XB_SPIN_CAP) { atomicAdd(&bar[XB_TMO], 1u); break; } }
    }
    nloc = mine > 0u ? mine : 1u; nx = cnt > 0u ? cnt : 1u;
}
__device__ __forceinline__ void xcd_barrier(const XcdBarrier& b) {
    asm volatile("s_waitcnt vmcnt(0)" ::: "memory");
    __syncthreads();
    if (threadIdx.x == 0) {
        unsigned* bar = b.bar;
        __builtin_amdgcn_s_waitcnt(0);
        unsigned nloc = b.st[0], nx = b.st[1];
        if (nloc == 0u) { xcd_barrier_complete(bar, b.x, nloc, nx); b.st[0] = nloc; b.st[1] = nx; }
        const unsigned old = xb_add(&bar[XB_XSUB(b.x)], 1u);
        const unsigned gen = old / nloc;
        if (old + 1u == (gen + 1u) * nloc) {
            __builtin_amdgcn_fence(__ATOMIC_RELEASE, "agent");
            asm volatile("s_waitcnt vmcnt(0)" ::: "memory");
            const unsigned og = xb_add(&bar[XB_TOP], 1u);
            const unsigned tg = og / nx;
            if (og + 1u == (tg + 1u) * nx) xb_add(&bar[XB_TOPGEN], 1u);
            else XB_SPIN(xb_ld(&bar[XB_TOPGEN]) == tg, bar);
            __builtin_amdgcn_fence(__ATOMIC_ACQUIRE, "agent");
            xb_add(&bar[XB_XGEN(b.x)], 1u);
            asm volatile("s_waitcnt vmcnt(0)" ::: "memory");
        } else {
            XB_SPIN(xb_ld(&bar[XB_XGEN(b.x)]) == gen, bar);
            __builtin_amdgcn_fence(__ATOMIC_ACQUIRE, "agent");
            asm volatile("s_waitcnt vmcnt(0)" ::: "memory");
        }
    }
    __syncthreads();
}

constexpr int RING_OFF = 0, RING_BYTES = 139264;
constexpr int MISC_OFF = RING_BYTES;
constexpr int LDS_BYTES = 147456;
struct Args { const float* in[N_IN]; float* out; unsigned char* ws; int ph_lo, ph_hi; };
struct Frame {
    LAS unsigned char* lds; int tid, lane, wave, G, bid;
    const float* const* in; float* out; unsigned char* ws;
};

__device__ __forceinline__ void p0_transpose_item(const float* W, int K, int N, bf16* WT, LAS float* scr, int item, int lane) {
    const int nblk = N / 32, kb = item / nblk, nb = item % nblk, k0 = 64 * kb, n0 = 32 * nb;
#pragma unroll 8
    for (int i = 0; i < 32; ++i) { const int kk = 2 * i + (lane >> 5); scr[kk * 33 + (lane & 31)] = W[(size_t)(k0 + kk) * N + n0 + (lane & 31)]; }
    LDS_WAIT(); asm volatile("" ::: "memory");
    const int c = lane & 7;
#pragma unroll
    for (int j = 0; j < 4; ++j) { const int n = (lane >> 3) + 8 * j; const LAS float* s = scr + (8 * c) * 33 + n;
        v4u o; o.x = pk2(s[0 * 33], s[1 * 33]); o.y = pk2(s[2 * 33], s[3 * 33]); o.z = pk2(s[4 * 33], s[5 * 33]); o.w = pk2(s[6 * 33], s[7 * 33]);
        *(GAS v4u*)(WT + (size_t)(n0 + n) * K + k0 + 8 * c) = o; }
    LDS_WAIT(); asm volatile("" ::: "memory");
}
__device__ __forceinline__ void transpose_weight(Frame& F, const float* W, int K, int N, bf16* WT) {
    LAS float* scr = (LAS float*)(F.lds + RING_OFF + F.wave * 16384);
    const int gw = F.bid * NWAVES + F.wave, NGW = F.G * NWAVES, nitems = (K / 64) * (N / 32);
    for (int it = gw; it < nitems; it += NGW) p0_transpose_item(W, K, N, WT, scr, it, F.lane);
}
__device__ __forceinline__ void norm_rows(Frame& F, const float* src_p, const float* src_s, const float* w, bf16* XN) {
    const int gw = F.bid * NWAVES + F.wave, NGW = F.G * NWAVES;
    for (int m = gw; m < MT; m += NGW) {
        const float* xrow = (m < MP) ? src_p + (size_t)m * DM : src_s + (size_t)(m - MP) * DM;
        const GAS f32x4* xr = (const GAS f32x4*)xrow + F.lane; const GAS f32x4* wr = (const GAS f32x4*)w + F.lane;
        f32x4 v[8]; float s = 0.f;
#pragma unroll
        for (int j = 0; j < 8; ++j) { v[j] = xr[64 * j]; s += (v[j].x * v[j].x + v[j].y * v[j].y) + (v[j].z * v[j].z + v[j].w * v[j].w); }
        const float rstd = 1.f / sqrtf(wave_sum(s) * (1.f / DM) + EPS);
        GAS v2u* o8 = (GAS v2u*)(XN + (size_t)m * DM) + F.lane;
#pragma unroll
        for (int j = 0; j < 8; ++j) { const f32x4 g = wr[64 * j]; v2u o; o.x = pk2(v[j].x * rstd * g.x, v[j].y * rstd * g.y); o.y = pk2(v[j].z * rstd * g.z, v[j].w * rstd * g.w); o8[64 * j] = o; }
    }
}
__device__ __forceinline__ void cache_cvt(Frame& F, const float* ck, const float* cv, bf16* KC, bf16* VC) {
    const size_t nvec = (size_t)NB * PAST * DM / 4;
    const size_t gt = (size_t)F.bid * NTHR + F.tid, NG = (size_t)F.G * NTHR;
    for (size_t i = gt; i < 2 * nvec; i += NG) {
        const bool isv = i >= nvec; const size_t e = (isv ? i - nvec : i) * 4;
        const size_t brow = e / DM, col = e % DM, b = brow / PAST, t = brow % PAST;
        const f32x4 x = *(const GAS f32x4*)((isv ? cv : ck) + e);
        v2u o; o.x = pk2(x.x, x.y); o.y = pk2(x.z, x.w);
        *(GAS v2u*)((isv ? VC : KC) + ((b * KCROWS + t) * DM + col)) = o;
    }
}
__device__ __forceinline__ int row_pos(int row) { return row < MP ? row : PAST + ((row - MP) & 63); }

__device__ __forceinline__ void a_post(Frame& F, const bf16* Z  , const float* qg, const float* kg, bf16* Qs, bf16* KP, bf16* VP, bf16* KC, bf16* VC, float* okp, float* ovp, float* oks, float* ovs) {
    const int gw = F.bid * NWAVES + F.wave, NGW = F.G * NWAVES, lane = F.lane;
    const float gq = qg[lane], gk = kg[lane];
    for (int it = gw; it < MT * 96; it += NGW) {
        const int row = it / 96, blk = it % 96;
        const float x = bf2f(Z[(size_t)row * 8192 + blk * 64 + lane]);
        if (blk < 64) {
            const float ss = wave_sum(x * x);
            const float y = x * (1.f / sqrtf(ss * (1.f / 64.f) + EPS)) * (blk < 32 ? gq : gk);
            const float p = __shfl_xor(y, 32);
            float c, s; rope_cs(row_pos(row), lane & 31, 32, c, s);
            const float o = (lane < 32) ? y * c - p * s : y * c + p * s;
            if (blk < 32) Qs[(size_t)row * DM + blk * 64 + lane] = (bf16)f2bf(o * C2);
            else { const int col = (blk - 32) * 64 + lane;
                if (row < MP) { KP[(size_t)row * DM + col] = (bf16)f2bf(o); okp[(size_t)row * DM + col] = o; }
                else { const int s_ = row - MP, b = s_ >> 6, t = s_ & 63; KC[((size_t)b * KCROWS + PAST + t) * DM + col] = (bf16)f2bf(o); oks[(size_t)s_ * DM + col] = o; } }
        } else { const int col = (blk - 64) * 64 + lane;
            if (row < MP) { VP[(size_t)row * DM + col] = (bf16)f2bf(x); ovp[(size_t)row * DM + col] = x; }
            else { const int s_ = row - MP, b = s_ >> 6, t = s_ & 63; VC[((size_t)b * KCROWS + PAST + t) * DM + col] = (bf16)f2bf(x); ovs[(size_t)s_ * DM + col] = x; } }
    }
}

constexpr int QP_ = 132;
__device__ __forceinline__ void attn_naive(Frame& F, const bf16* Qs, const bf16* KP, const bf16* VP, const bf16* KC, const bf16* VC, const bf16* Z  , bf16* AO,
                                           float lam, float one_m_li, const float* sub_gain) {
    LAS float* q12 = (LAS float*)(F.lds + RING_OFF);
    LAS float* p12 = q12 + 64 * QP_;
    LAS float* k12 = p12 + 64 * QP_;
    LAS float* vv = k12 + 64 * 128;
    LAS float* red = vv + 64 * 128;
    const int tid = F.tid;
    const int NIT = 16 * 256 + 16 * NB;
    for (int it = F.bid; it < NIT; it += F.G) {
        int h, qrow0, ntile; const bf16* Kb; const bf16* Vb;
        if (it < 4096) { const int c = 255 - (it >> 4); h = it & 15; qrow0 = 64 * c; ntile = c + 1; Kb = KP; Vb = VP; }
        else { const int j = it - 4096, b = j >> 4; h = j & 15; qrow0 = MP + 64 * b; ntile = KCROWS / 64; Kb = KC + (size_t)b * KCROWS * DM; Vb = VC + (size_t)b * KCROWS * DM; }
        __syncthreads();
        {
            const int r = tid >> 3, part = tid & 7; const v4u* src = (const v4u*)(Qs + (size_t)(qrow0 + r) * DM + h * 128 + part * 16);
            const v4u a = src[0], b = src[1]; LAS float* d = q12 + r * QP_ + part * 16;
            d[0] = bflo(a.x); d[1] = bfhi(a.x); d[2] = bflo(a.y); d[3] = bfhi(a.y); d[4] = bflo(a.z); d[5] = bfhi(a.z); d[6] = bflo(a.w); d[7] = bfhi(a.w);
            d[8] = bflo(b.x); d[9] = bfhi(b.x); d[10] = bflo(b.y); d[11] = bfhi(b.y); d[12] = bflo(b.z); d[13] = bfhi(b.z); d[14] = bflo(b.w); d[15] = bfhi(b.w);
        }
        float O1[16], O2[16], l1 = 0.f, l2 = 0.f;
#pragma unroll
        for (int d = 0; d < 16; ++d) { O1[d] = 0.f; O2[d] = 0.f; }
        const int r = tid & 63, grp = tid >> 6;
        for (int t = 0; t < ntile; ++t) {
            __syncthreads();
            { const int kr = tid >> 3, part = tid & 7; const size_t go = (size_t)(t * 64 + kr) * DM + h * 128 + part * 16;
                const v4u* ks = (const v4u*)(Kb + go); const v4u* vs = (const v4u*)(Vb + go);
                const v4u a = ks[0], b = ks[1], c = vs[0], e = vs[1]; LAS float* d = k12 + kr * 128 + part * 16; LAS float* w = vv + kr * 128 + part * 16;
                d[0] = bflo(a.x); d[1] = bfhi(a.x); d[2] = bflo(a.y); d[3] = bfhi(a.y); d[4] = bflo(a.z); d[5] = bfhi(a.z); d[6] = bflo(a.w); d[7] = bfhi(a.w);
                d[8] = bflo(b.x); d[9] = bfhi(b.x); d[10] = bflo(b.y); d[11] = bfhi(b.y); d[12] = bflo(b.z); d[13] = bfhi(b.z); d[14] = bflo(b.w); d[15] = bfhi(b.w);
                w[0] = bflo(c.x); w[1] = bfhi(c.x); w[2] = bflo(c.y); w[3] = bfhi(c.y); w[4] = bflo(c.z); w[5] = bfhi(c.z); w[6] = bflo(c.w); w[7] = bfhi(c.w);
                w[8] = bflo(e.x); w[9] = bfhi(e.x); w[10] = bflo(e.y); w[11] = bfhi(e.y); w[12] = bflo(e.z); w[13] = bfhi(e.z); w[14] = bflo(e.w); w[15] = bfhi(e.w);
            }
            __syncthreads();
            {
                float s1[8], s2[8];
#pragma unroll
                for (int k = 0; k < 8; ++k) { s1[k] = 0.f; s2[k] = 0.f; }
                for (int d = 0; d < 64; d += 4) {
                    const f32x4 qa = *(const LAS f32x4*)(q12 + r * QP_ + d), qb = *(const LAS f32x4*)(q12 + r * QP_ + 64 + d);
#pragma unroll
                    for (int k = 0; k < 8; ++k) { const f32x4 ka = *(const LAS f32x4*)(k12 + (grp * 8 + k) * 128 + d), kb = *(const LAS f32x4*)(k12 + (grp * 8 + k) * 128 + 64 + d);
                        s1[k] += qa.x * ka.x + qa.y * ka.y + qa.z * ka.z + qa.w * ka.w; s2[k] += qb.x * kb.x + qb.y * kb.y + qb.z * kb.z + qb.w * kb.w; }
                }
#pragma unroll
                for (int k = 0; k < 8; ++k) { p12[r * QP_ + grp * 8 + k] = exp2f(s1[k]); p12[r * QP_ + 64 + grp * 8 + k] = exp2f(s2[k]); }
            }
            __syncthreads();
            {
                for (int k = 0; k < 64; k += 4) {
                    const f32x4 pa = *(const LAS f32x4*)(p12 + r * QP_ + k), pb = *(const LAS f32x4*)(p12 + r * QP_ + 64 + k);
                    l1 += (pa.x + pa.y) + (pa.z + pa.w); l2 += (pb.x + pb.y) + (pb.z + pb.w);
#pragma unroll
                    for (int kk = 0; kk < 4; ++kk) { const float a = pa[kk], b = pb[kk];
#pragma unroll
                        for (int d4 = 0; d4 < 4; ++d4) { const f32x4 v = *(const LAS f32x4*)(vv + (k + kk) * 128 + grp * 16 + d4 * 4);
                            O1[d4 * 4 + 0] += a * v.x; O1[d4 * 4 + 1] += a * v.y; O1[d4 * 4 + 2] += a * v.z; O1[d4 * 4 + 3] += a * v.w;
                            O2[d4 * 4 + 0] += b * v.x; O2[d4 * 4 + 1] += b * v.y; O2[d4 * 4 + 2] += b * v.z; O2[d4 * 4 + 3] += b * v.w; } }
                }
            }
        }
        const float i1 = 1.f / l1, i2 = lam / l2; float ss = 0.f;
#pragma unroll
        for (int d = 0; d < 16; ++d) { O1[d] = O1[d] * i1 - O2[d] * i2; ss += O1[d] * O1[d]; }
        red[r * 8 + grp] = ss;
        __syncthreads();
        float tot = 0.f;
#pragma unroll
        for (int g = 0; g < 8; ++g) tot += red[r * 8 + g];
        const float rstd = 1.f / sqrtf(tot * (1.f / 128.f) + EPS);
        const size_t row = (size_t)(qrow0 + r);
#pragma unroll
        for (int d = 0; d < 16; ++d) { const int col = h * 128 + grp * 16 + d; const float g = bf2f(Z[row * 8192 + 6144 + col]);
            AO[row * DM + col] = (bf16)f2bf(O1[d] * rstd * sub_gain[grp * 16 + d] * one_m_li * silu_f(g)); }
    }
}

__device__ __forceinline__ void r_post(Frame& F, const bf16* Z  , bf16* RQ, bf16* RK) {
    const int gw = F.bid * NWAVES + F.wave, NGW = F.G * NWAVES, lane = F.lane;
    for (int it = gw; it < MT * 16; it += NGW) {
        const int row = it >> 4, hh = it & 15; const bf16* z = Z + (size_t)row * 12288 + hh * 256; bf16* o = (hh < 8 ? RQ + (size_t)row * DM + hh * 256 : RK + (size_t)row * DM + (hh - 8) * 256);
        const float sc = hh < 8 ? 1.f : 0.0625f; const int pos = row_pos(row);
#pragma unroll
        for (int k = 0; k < 2; ++k) { const int i = lane + 64 * k; const float x1 = bf2f(z[i]), x2 = bf2f(z[128 + i]); float c, s; rope_cs(pos, i, 128, c, s);
            o[i] = (bf16)f2bf((x1 * c - x2 * s) * sc); o[128 + i] = (bf16)f2bf((x2 * c + x1 * s) * sc); }
    }
}
__device__ __forceinline__ void ret_naive(Frame& F, const bf16* RQ, const bf16* RK, const bf16* Z  , const float* state_in, bf16* ORET  , float* osp, float* oss) {
    LAS float* red = (LAS float*)(F.lds + RING_OFF);
    const int tid = F.tid, c = tid & 63, rg = __builtin_amdgcn_readfirstlane(tid >> 6);
    const int NIT = 64 + 64 * NB;
    for (int it = F.bid; it < NIT; it += F.G) {
        int h, sl, row0, ntok; float* so; const float* si;
        if (it < 64) { h = it >> 3; sl = it & 7; row0 = 0; ntok = MP; so = osp + (size_t)h * 256 * 512; si = nullptr; }
        else { const int j = it - 64, b = j >> 6; h = (j >> 3) & 7; sl = j & 7; row0 = MP + 64 * b; ntok = 64; so = oss + ((size_t)b * 8 + h) * 256 * 512; si = state_in + ((size_t)b * 8 + h) * 256 * 512; }
        const float gamma = 1.f - exp2f(-5.f - (float)h);
        float S[32];
#pragma unroll
        for (int j = 0; j < 32; ++j) S[j] = si ? si[(size_t)(rg * 32 + j) * 512 + sl * 64 + c] : 0.f;
        const bf16* qp = RQ + (size_t)row0 * DM + h * 256 + rg * 32 + (c & 31);
        const bf16* kp = RK + (size_t)row0 * DM + h * 256 + rg * 32 + (c & 31);
        const bf16* vp = Z + (size_t)row0 * 12288 + 4096 + h * 512 + sl * 64 + c;
        float qn = bf2f(qp[0]), kn = bf2f(kp[0]), vn = bf2f(vp[0]);
        __syncthreads();
        for (int t = 0; t < ntok; ++t) {
            const float qv = qn, kv = kn, vv = vn;
            if (t + 1 < ntok) { qn = bf2f(qp[(size_t)(t + 1) * DM]); kn = bf2f(kp[(size_t)(t + 1) * DM]); vn = bf2f(vp[(size_t)(t + 1) * 12288]); }
            float po = 0.f;
#pragma unroll
            for (int j = 0; j < 32; ++j) { const float kj = __builtin_bit_cast(float, __builtin_amdgcn_readlane(__builtin_bit_cast(int, kv), j)), qj = __builtin_bit_cast(float, __builtin_amdgcn_readlane(__builtin_bit_cast(int, qv), j));
                S[j] = gamma * S[j] + kj * vv; po += qj * S[j]; }
            LAS float* rb = red + (t & 1) * 512;
            rb[rg * 64 + c] = po;
            __syncthreads();
            if (rg == 0) { float o = 0.f;
#pragma unroll
                for (int g = 0; g < 8; ++g) o += rb[g * 64 + c];
                ORET[(size_t)(row0 + t) * 4096 + h * 512 + sl * 64 + c] = (bf16)f2bf(o); }
        }
#pragma unroll
        for (int j = 0; j < 32; ++j) so[(size_t)(rg * 32 + j) * 512 + sl * 64 + c] = S[j];
        __syncthreads();
    }
}
__device__ __forceinline__ void r_out(Frame& F, const bf16* ORET, const bf16* Z  , bf16* AO) {
    const int gw = F.bid * NWAVES + F.wave, NGW = F.G * NWAVES, lane = F.lane;
    for (int it = gw; it < MT * 8; it += NGW) {
        const int row = it >> 3, h = it & 7; const size_t off = (size_t)row * 4096 + h * 512 + lane * 8;
        const v4u o4 = *(const v4u*)(ORET + off), g4 = *(const v4u*)(Z + (size_t)row * 12288 + 8192 + h * 512 + lane * 8);
        float o[8] = {bflo(o4.x), bfhi(o4.x), bflo(o4.y), bfhi(o4.y), bflo(o4.z), bfhi(o4.z), bflo(o4.w), bfhi(o4.w)};
        const float g[8] = {bflo(g4.x), bfhi(g4.x), bflo(g4.y), bfhi(g4.y), bflo(g4.z), bfhi(g4.z), bflo(g4.w), bfhi(g4.w)};
        float ss = 0.f;
#pragma unroll
        for (int k = 0; k < 8; ++k) ss += o[k] * o[k];
        const float rstd = 1.f / sqrtf(wave_sum(ss) * (1.f / 512.f) + EPS);
#pragma unroll
        for (int k = 0; k < 8; ++k) o[k] = o[k] * rstd * silu_f(g[k]);
        v4u w; w.x = pk2(o[0], o[1]); w.y = pk2(o[2], o[3]); w.z = pk2(o[4], o[5]); w.w = pk2(o[6], o[7]);
        *(v4u*)(AO + off) = w;
    }
}
__device__ __forceinline__ void c_stats(Frame& F, const bf16* Z  , const float* vgain, bf16* VN, float* ovm) {
    const int gw = F.bid * NWAVES + F.wave, NGW = F.G * NWAVES, lane = F.lane;
    for (int row = gw; row < MT; row += NGW) {
        float x[64]; float ss = 0.f;
#pragma unroll
        for (int j = 0; j < 8; ++j) { const v4u v4 = *(const v4u*)(Z + (size_t)row * 12288 + 4096 + j * 512 + lane * 8);
            const float t[8] = {bflo(v4.x), bfhi(v4.x), bflo(v4.y), bfhi(v4.y), bflo(v4.z), bfhi(v4.z), bflo(v4.w), bfhi(v4.w)};
#pragma unroll
            for (int k = 0; k < 8; ++k) { const float g = gelu_tanh_f(t[k]); x[j * 8 + k] = g; ss += g * g; } }
        const float rstd = 1.f / sqrtf(wave_sum(ss) * (1.f / 4096.f) + EPS);
#pragma unroll
        for (int j = 0; j < 8; ++j) { const int col = j * 512 + lane * 8; float y[8];
#pragma unroll
            for (int k = 0; k < 8; ++k) y[k] = x[j * 8 + k] * rstd * vgain[col + k];
            v4u w; w.x = pk2(y[0], y[1]); w.y = pk2(y[2], y[3]); w.z = pk2(y[4], y[5]); w.w = pk2(y[6], y[7]);
            *(v4u*)(VN + (size_t)row * 4096 + col) = w;
            if (row >= MP) { float* o = ovm + (size_t)(row - MP) * 4096 + col; *(f32x4*)o = (f32x4){y[0], y[1], y[2], y[3]}; *(f32x4*)(o + 4) = (f32x4){y[4], y[5], y[6], y[7]}; } }
    }
}
__device__ __forceinline__ void c_mix(Frame& F, const bf16* Z  , const bf16* VN, const float* ws_, const float* bs_, bf16* AO) {
    LAS float* vl = (LAS float*)(F.lds + RING_OFF);
    const int tid = F.tid, d = tid & 255, ih = tid >> 8;
    const int NIT = (128 + NB) * 16;
    for (int it = F.bid; it < NIT; it += F.G) {
        const int ch = it >> 4, gh = it & 15, g = gh >> 1, c0 = gh * 256;
        const int L = ch < 128 ? 128 : 64, row0 = ch < 128 ? ch * 128 : MP + (ch - 128) * 64;
        __syncthreads();
        for (int e = tid; e < L * 256; e += NTHR) { const int j = e >> 8, dd = e & 255; vl[j * 256 + dd] = bf2f(VN[(size_t)(row0 + j) * 4096 + c0 + dd]); }
        __syncthreads();
        for (int i = ih; i < L; i += 2) {
            const float* wrow = ws_ + ((size_t)g * 128 + i) * 128; float acc = bs_[g * 128 + i];
            for (int j = 0; j <= i; ++j) acc += wrow[j] * vl[j * 256 + d];
            const size_t row = (size_t)(row0 + i); const float u = bf2f(Z[row * 12288 + c0 + d]), gg = bf2f(Z[row * 12288 + 8192 + c0 + d]);
            AO[row * 4096 + c0 + d] = (bf16)f2bf(gelu_tanh_f(u) * acc * silu_f(gg));
        }
    }
}
__device__ __forceinline__ float diff_lambda(const float* q1, const float* k1, const float* q2, const float* k2, float lam_init) {
    float a = 0.f, b = 0.f;
    for (int i = 0; i < 64; ++i) { a += q1[i] * k1[i]; b += q2[i] * k2[i]; }
    return expf(a) - expf(b) + lam_init;
}

constexpr int N_PHASES = 21;
__global__ void __launch_bounds__(NTHR, 2) mega(Args args) {
    extern __shared__ __attribute__((aligned(16))) unsigned char lds[];
    Frame F;
    F.lds = (LAS unsigned char*)lds; F.tid = threadIdx.x; F.lane = F.tid & 63; F.wave = __builtin_amdgcn_readfirstlane(F.tid >> 6); F.G = gridDim.x; F.bid = blockIdx.x;
    F.in = args.in; F.out = args.out; F.ws = args.ws;
    unsigned char* ws = args.ws; float* out = args.out;
    bf16* W_AIN[2] = {(bf16*)(ws + WS_WAIN0), (bf16*)(ws + WS_WAIN1)}; bf16* W_AOUT[2] = {(bf16*)(ws + WS_WAOUT0), (bf16*)(ws + WS_WAOUT1)};
    bf16* W_RIN = (bf16*)(ws + WS_WRIN); bf16* W_ROUT = (bf16*)(ws + WS_WROUT); bf16* W_CIN = (bf16*)(ws + WS_WCIN); bf16* W_COUT = (bf16*)(ws + WS_WCOUT);
    bf16* XN = (bf16*)(ws + WS_XN); bf16* Z = (bf16*)(ws + WS_Z);
    bf16* Qs = (bf16*)(ws + WS_B1); bf16* KP = (bf16*)(ws + WS_B2); bf16* VP = (bf16*)(ws + WS_B3); bf16* KC = (bf16*)(ws + WS_B4); bf16* VC = (bf16*)(ws + WS_B5); bf16* AO_A = (bf16*)(ws + WS_B6);
    bf16* RQ = (bf16*)(ws + WS_B1); bf16* RK = (bf16*)(ws + WS_B2); bf16* AO_BC = (bf16*)(ws + WS_B3); bf16* ORET = (bf16*)(ws + WS_B5); bf16* VN = (bf16*)(ws + WS_B5);
    const int lo = args.ph_lo, hi = args.ph_hi;
    volatile LAS unsigned* MISC = (volatile LAS unsigned*)(F.lds + MISC_OFF);
    for (int u = F.tid; u < (LDS_BYTES - MISC_OFF) / 4; u += NTHR) ((LAS unsigned*)(F.lds + MISC_OFF))[u] = 0u;
    __syncthreads();
    XcdBarrier bar = xcd_barrier_post((unsigned*)(ws + WS_CTL) + 4096, MISC + 8);
#define IN(k) (lo <= (k) && (k) < hi)
#define SEAM(k) do { if (IN(k) && IN((k) + 1)) xcd_barrier(bar); } while (0)

#define GEMM_STORE(Aptr, Wptr, NN, KK, Optr) do { pg8::GemmP g{KK, KK, (KK) / 64}; pg8::StaticOrder S; S.init(MT / 256, (NN) / 256, F.G, F.bid, Aptr, Wptr, KK, KK); pg8::EpiStoreBf16 E{(pg8::bf16_t*)(Optr), NN}; \
        pg8::gemm_phase<pg8::EpiStoreBf16, pg8::StaticOrder>(F.lds + RING_OFF, g, S, E); } while (0)
#define GEMM_RESID(Aptr, Wptr, KK, BP, BS) do { pg8::GemmP g{KK, KK, (KK) / 64}; pg8::StaticOrder S; S.init(MT / 256, DM / 256, F.G, F.bid, Aptr, Wptr, KK, KK); pg8::EpiResid E{BP, BS, out, MP}; \
        pg8::gemm_phase<pg8::EpiResid, pg8::StaticOrder>(F.lds + RING_OFF, g, S, E); } while (0)

    if (IN(0)) {
        transpose_weight(F, args.in[I_AWIN], 2048, 8192, W_AIN[0]); transpose_weight(F, args.in[I_AWIN] + (size_t)2048 * 8192, 2048, 8192, W_AIN[1]);
        transpose_weight(F, args.in[I_AWOUT], 2048, 2048, W_AOUT[0]); transpose_weight(F, args.in[I_AWOUT] + (size_t)2048 * 2048, 2048, 2048, W_AOUT[1]);
        transpose_weight(F, args.in[I_RWIN], 2048, 12288, W_RIN); transpose_weight(F, args.in[I_RWOUT], 4096, 2048, W_ROUT);
        transpose_weight(F, args.in[I_CWIN], 2048, 12288, W_CIN); transpose_weight(F, args.in[I_CWOUT], 4096, 2048, W_COUT);
        norm_rows(F, args.in[I_XP], args.in[I_XS], args.in[I_NW], XN);
        cache_cvt(F, args.in[I_CK], args.in[I_CV], KC, VC);
    }
    SEAM(0);
    if (IN(1)) GEMM_STORE(XN, W_AIN[0], 8192, 2048, Z);
    SEAM(1);
    if (IN(2)) a_post(F, Z, args.in[I_AQG], args.in[I_AKG], Qs, KP, VP, KC, VC, out + O_KP, out + O_VP, out + O_KS, out + O_VS);
    SEAM(2);
    if (IN(3)) { const float li = 0.8f - 0.6f * expf(-0.3f * 0.f); const float lam = diff_lambda(args.in[I_LQ1], args.in[I_LK1], args.in[I_LQ2], args.in[I_LK2], li);
        attn_naive(F, Qs, KP, VP, KC, VC, Z, AO_A, lam, 1.f - li, args.in[I_ASG]); }
    SEAM(3);
    if (IN(4)) GEMM_RESID(AO_A, W_AOUT[0], 2048, args.in[I_XP], args.in[I_XS]);
    SEAM(4);
    if (IN(5)) norm_rows(F, out + O_YP, out + O_YS, args.in[I_NW] + DM, XN);
    SEAM(5);
    if (IN(6)) GEMM_STORE(XN, W_RIN, 12288, 2048, Z);
    SEAM(6);
    if (IN(7)) r_post(F, Z, RQ, RK);
    SEAM(7);
    if (IN(8)) ret_naive(F, RQ, RK, Z, args.in[I_SR], ORET, out + O_SP, out + O_SS);
    SEAM(8);
    if (IN(9)) r_out(F, ORET, Z, AO_BC);
    SEAM(9);
    if (IN(10)) GEMM_RESID(AO_BC, W_ROUT, 4096, out + O_YP, out + O_YS);
    SEAM(10);
    if (IN(11)) norm_rows(F, out + O_YP, out + O_YS, args.in[I_NW] + 2 * DM, XN);
    SEAM(11);
    if (IN(12)) GEMM_STORE(XN, W_CIN, 12288, 2048, Z);
    SEAM(12);
    if (IN(13)) c_stats(F, Z, args.in[I_CVG], VN, out + O_VM);
    SEAM(13);
    if (IN(14)) c_mix(F, Z, VN, args.in[I_CWS], args.in[I_CBS], AO_BC);
    SEAM(14);
    if (IN(15)) GEMM_RESID(AO_BC, W_COUT, 4096, out + O_YP, out + O_YS);
    SEAM(15);
    if (IN(16)) { norm_rows(F, out + O_YP, out + O_YS, args.in[I_NW] + 3 * DM, XN);
        cache_cvt(F, args.in[I_CK] + (size_t)NB * PAST * DM, args.in[I_CV] + (size_t)NB * PAST * DM, KC, VC); }
    SEAM(16);
    if (IN(17)) GEMM_STORE(XN, W_AIN[1], 8192, 2048, Z);
    SEAM(17);
    if (IN(18)) a_post(F, Z, args.in[I_AQG] + 64, args.in[I_AKG] + 64, Qs, KP, VP, KC, VC, out + O_KP + (size_t)MP * DM, out + O_VP + (size_t)MP * DM, out + O_KS + (size_t)MS * DM, out + O_VS + (size_t)MS * DM);
    SEAM(18);
    if (IN(19)) { const float li = 0.8f - 0.6f * expf(-0.3f * 3.f); const float lam = diff_lambda(args.in[I_LQ1] + 64, args.in[I_LK1] + 64, args.in[I_LQ2] + 64, args.in[I_LK2] + 64, li);
        attn_naive(F, Qs, KP, VP, KC, VC, Z, AO_A, lam, 1.f - li, args.in[I_ASG] + 128); }
    SEAM(19);
    if (IN(20)) GEMM_RESID(AO_A, W_AOUT[1], 2048, out + O_YP, out + O_YS);
#undef IN
#undef SEAM
}

extern "C" void kernel_launch(void* const* d_in, const int* in_sizes, int n_in, void* d_out, int out_size, void* d_ws, size_t ws_size, hipStream_t stream) {
    static int grid = 0;
    if (grid == 0) {
        if (n_in != N_IN || (size_t)out_size != O_END || ws_size < WS_END) { fprintf(stderr, "kernel_launch: unexpected shapes: n_in %d out %d ws %zu (need %zu)\n", n_in, out_size, ws_size, (size_t)WS_END); grid = -1; return; }
        int dev = 0, cus = 0;
        if (hipGetDevice(&dev) != hipSuccess || hipDeviceGetAttribute(&cus, hipDeviceAttributeMultiprocessorCount, dev) != hipSuccess) { grid = -1; return; }
        if (hipFuncSetAttribute((const void*)mega, hipFuncAttributeMaxDynamicSharedMemorySize, LDS_BYTES) != hipSuccess) { fprintf(stderr, "kernel_launch: hipFuncSetAttribute failed\n"); grid = -1; return; }
        (void)hipGetLastError();
        grid = cus;
    }
    if (grid < 0) return;
    Args a{};
    for (int i = 0; i < N_IN; ++i) a.in[i] = (const float*)d_in[i];
    a.out = (float*)d_out; a.ws = (unsigned char*)d_ws;
    (void)hipMemsetAsync((char*)d_ws + WS_CTL, 0, CTL_ZERO_BYTES, stream);
    a.ph_lo = 0; a.ph_hi = N_PHASES;
    hipLaunchKernelGGL(mega, dim3(grid), dim3(NTHR), LDS_BYTES, stream, a);
}
```

```cpp
#include <hip/hip_runtime.h>
#include <cstdio>
#include <cstdint>

namespace pg8 {
#define PG8_LAS __attribute__((address_space(3)))
typedef unsigned short bf16_t;
typedef short bf16x8 __attribute__((ext_vector_type(8)));
typedef float f32x4 __attribute__((ext_vector_type(4)));
typedef unsigned u32x4 __attribute__((ext_vector_type(4)));
constexpr int BM = 256, BK = 64, HALF = 128, HTB = HALF * BK * 2, STAGE_BYTES = 8 * HTB, NXCD = 8, WGM = 8;

__host__ __device__ __forceinline__ int lds_byte(int r, int c) { const int st = (r >> 4) * 2 + (c >> 5), rr = r & 15, cc = c & 31, ob = rr * 64 + cc * 2; return st * 1024 + (ob ^ (((ob >> 9) & 1) << 5)); }
__host__ __device__ __forceinline__ void stage_rc(int b, int& R, int& C) { const int st = b / 1024, sb = b % 1024, swz = sb ^ (((sb >> 9) & 1) << 5); R = (st >> 1) * 16 + swz / 64; C = (st & 1) * 32 + (swz % 64) / 2; }
__host__ __device__ __forceinline__ int perm32(int rho) { const int n = rho >> 4, i = rho & 15; return 8 * (i >> 2) + 4 * n + (i & 3); }

struct Unit { int pm, pn; const char* a; const char* b; };
struct GemmP { int lda, ldb, nt; };

struct StaticOrder {
    int nM, nN, nwg, G, c; const char* A; const char* B; size_t ta, tb;
    __host__ __device__ void init(int nM_, int nN_, int G_, int c_, const void* A_, const void* B_, int lda, int ldb) { nM = nM_; nN = nN_; nwg = nM * nN; G = G_; c = c_; A = (const char*)A_; B = (const char*)B_; ta = (size_t)BM * lda * 2; tb = (size_t)BM * ldb * 2; }
    __host__ __device__ bool next(int i, Unit& u) const {
        const long L = (long)i * G + c; if (L >= nwg) return false;
        int wgid = (int)L; { const int q = nwg / NXCD, r = nwg % NXCD, xcd = wgid % NXCD, off = wgid / NXCD; wgid = (xcd < r ? xcd * (q + 1) : r * (q + 1) + (xcd - r) * q) + off; }
        const int nig = WGM * nN, gid = wgid / nig, fm = gid * WGM, gsz = (nM - fm) < WGM ? (nM - fm) : WGM;
        u.pm = fm + ((wgid % nig) % gsz); u.pn = (wgid % nig) / gsz; u.a = A + (size_t)u.pm * ta; u.b = B + (size_t)u.pn * tb; return true;
    }
    __device__ __forceinline__ void a_ready(const Unit&) const {}
    __device__ __forceinline__ void done(const Unit&) const {}
};

__device__ __forceinline__ unsigned cvt_pk_bf16(float lo, float hi) { unsigned r; asm volatile("v_cvt_pk_bf16_f32 %0, %1, %2" : "=v"(r) : "v"(lo), "v"(hi)); return r; }

struct EpiStoreBf16 {
    static constexpr bool PERM = true;
    bf16_t* O; int ldc;
    __device__ __forceinline__ void operator()(const f32x4 (&acc)[2][2][4][2], const Unit& u, int wr, int wc, int fr, int fq) const {
        const int row0 = u.pm * BM + wr * 64 + fr; const int col0 = u.pn * BM + wc * 32 + 8 * fq;
#pragma unroll
        for (int ai = 0; ai < 2; ++ai)
#pragma unroll
            for (int m = 0; m < 4; ++m) { bf16_t* rowp = O + (size_t)(row0 + ai * HALF + m * 16) * ldc + col0;
#pragma unroll
                for (int bj = 0; bj < 2; ++bj) { const f32x4 v0 = acc[ai][bj][m][0], v1 = acc[ai][bj][m][1];
                    u32x4 w; w.x = cvt_pk_bf16(v0[0], v0[1]); w.y = cvt_pk_bf16(v0[2], v0[3]); w.z = cvt_pk_bf16(v1[0], v1[1]); w.w = cvt_pk_bf16(v1[2], v1[3]);
                    *(u32x4*)(rowp + bj * HALF) = w; } }
    }
};
struct EpiResid {
    static constexpr bool PERM = false;
    const float* base_p; const float* base_s; float* out; int split;
    __device__ __forceinline__ void operator()(const f32x4 (&acc)[2][2][4][2], const Unit& u, int wr, int wc, int fr, int fq) const {
        const int col0 = u.pn * BM + wc * 32 + 4 * fq;
#pragma unroll
        for (int ai = 0; ai < 2; ++ai)
#pragma unroll
            for (int m = 0; m < 4; ++m) { const int r = u.pm * BM + ai * HALF + wr * 64 + m * 16 + fr;
                const float* bp = (r < split) ? base_p + (size_t)r * 2048 : base_s + (size_t)(r - split) * 2048; float* op = out + (size_t)r * 2048;
#pragma unroll
                for (int bj = 0; bj < 2; ++bj)
#pragma unroll
                    for (int n = 0; n < 2; ++n) { const int c = col0 + bj * HALF + n * 16; const f32x4 bs = *(const f32x4*)(bp + c); *(f32x4*)(op + c) = bs + acc[ai][bj][m][n]; }
                if (m & 1) asm volatile("" ::: "memory"); }
    }
};

template <class Epi, class Sched, bool ALIGN_EPI = true>
__device__ __forceinline__ void gemm_phase(PG8_LAS unsigned char* lds, const GemmP g, const Sched& S, const Epi& E) {
    const int tid = threadIdx.x, wid = __builtin_amdgcn_readfirstlane(tid >> 6), lane = tid & 63, wr = wid >> 2, wc = wid & 3, fr = lane & 15, fq = lane >> 4;
    const int nt = g.nt;
    unsigned voffA[2], voffB[2];
#pragma unroll
    for (int i = 0; i < 2; ++i) { int R, C; stage_rc(tid * 16 + i * 8192, R, C); const int Rb = Epi::PERM ? ((R & ~31) + perm32(R & 31)) : R;
        voffA[i] = (unsigned)(R * g.lda + C) * 2u; voffB[i] = (unsigned)(Rb * g.ldb + C) * 2u; }
    const size_t kstep = (size_t)(BK * 2);
    const size_t hstepA = (size_t)HALF * g.lda * 2, hstepB = (size_t)HALF * g.ldb * 2;
    const unsigned ldsw = (unsigned)wid * 1024u;
    const int aoff = lds_byte(wr * 64 + fr, fq * 8), boff = lds_byte(wc * 32 + fr, fq * 8);
#define PG8_SA(b, h) (((b) * 2 + (h)) * HTB)
#define PG8_SB(b, h) ((4 + (b) * 2 + (h)) * HTB)
#define PG8_STAGE(bufoff, gbase, voff) do { _Pragma("unroll") for (int _i = 0; _i < 2; ++_i) \
        __builtin_amdgcn_global_load_lds((const unsigned*)((const char*)(gbase) + (voff)[_i]), (PG8_LAS unsigned*)(lds + (bufoff) + ldsw + _i * 8192), 16, 0, 0); } while (0)
#define PG8_LDA(dst, b, h) do { _Pragma("unroll") for (int m = 0; m < 4; ++m) _Pragma("unroll") for (int k = 0; k < 2; ++k) dst[m][k] = *(const PG8_LAS bf16x8*)(lds + PG8_SA(b, h) + aoff + m * 2048 + k * 1024); } while (0)
#define PG8_LDB(dst, b, h) do { _Pragma("unroll") for (int n = 0; n < 2; ++n) _Pragma("unroll") for (int k = 0; k < 2; ++k) dst[n][k] = *(const PG8_LAS bf16x8*)(lds + PG8_SB(b, h) + boff + n * 2048 + k * 1024); } while (0)
#define PG8_MMA(ai, bj, At, Bt) do { __builtin_amdgcn_s_setprio(1); _Pragma("unroll") for (int m = 0; m < 4; ++m) _Pragma("unroll") for (int n = 0; n < 2; ++n) _Pragma("unroll") for (int k = 0; k < 2; ++k) \
        acc[ai][bj][m][n] = __builtin_amdgcn_mfma_f32_16x16x32_bf16(Bt[n][k], At[m][k], acc[ai][bj][m][n], 0, 0, 0); __builtin_amdgcn_s_setprio(0); } while (0)
#define PG8_WAIT_V(n) asm volatile("s_waitcnt vmcnt(" #n ")" ::: "memory")
#define PG8_WAIT_L(n) asm volatile("s_waitcnt lgkmcnt(" #n ")" ::: "memory")
#define PG8_BAR __builtin_amdgcn_s_barrier()
#define PG8_SCHED __builtin_amdgcn_sched_barrier(0)
    Unit cur, nxt; int ui = 0;
    if (!S.next(0, cur)) return;
    f32x4 acc[2][2][4][2];
#pragma unroll
    for (int a = 0; a < 2; ++a)
#pragma unroll
        for (int b = 0; b < 2; ++b)
#pragma unroll
            for (int m = 0; m < 4; ++m)
#pragma unroll
                for (int n = 0; n < 2; ++n) acc[a][b][m][n] = (f32x4){0.f, 0.f, 0.f, 0.f};
    bf16x8 At[4][2], B0[2][2], B1[2][2];
    const char* cA = cur.a; const char* cB = cur.b;
    S.a_ready(cur);
    PG8_STAGE(PG8_SB(0, 0), cB, voffB); PG8_STAGE(PG8_SB(0, 1), cB + hstepB, voffB); PG8_STAGE(PG8_SA(0, 0), cA, voffA); PG8_STAGE(PG8_SA(0, 1), cA + hstepA, voffA);
    if (wr == 1) PG8_BAR;
    PG8_WAIT_V(2); PG8_BAR;
    PG8_STAGE(PG8_SB(1, 0), cB + kstep, voffB); PG8_STAGE(PG8_SA(1, 0), cA + kstep, voffA); PG8_STAGE(PG8_SB(1, 1), cB + hstepB + kstep, voffB);
    PG8_WAIT_V(6); PG8_BAR;
    for (;;) {
        const bool has_next = S.next(ui + 1, nxt);
        const char* nA = has_next ? nxt.a : cA; const char* nB = has_next ? nxt.b : cB;
        for (int t = 0; t < nt; t += 2) {
            const bool last = (t == nt - 2);
            const char* a1 = cA + (size_t)(t + 1) * kstep;
            const char* a2 = last ? nA : cA + (size_t)(t + 2) * kstep; const char* b2 = last ? nB : cB + (size_t)(t + 2) * kstep;
            const char* a3 = a2 + kstep; const char* b3 = b2 + kstep;
            if (last && has_next) S.a_ready(nxt);
            PG8_LDB(B0, 0, 0); PG8_LDB(B1, 0, 1); PG8_SCHED; PG8_LDA(At, 0, 0); PG8_STAGE(PG8_SA(1, 1), a1 + hstepA, voffA);
            PG8_WAIT_V(8); PG8_WAIT_L(0); PG8_BAR; PG8_MMA(0, 0, At, B0); PG8_MMA(0, 1, At, B1); PG8_BAR; PG8_SCHED;
            PG8_LDA(At, 0, 1); PG8_STAGE(PG8_SB(0, 0), b2, voffB); PG8_STAGE(PG8_SB(0, 1), b2 + hstepB, voffB); PG8_STAGE(PG8_SA(0, 0), a2, voffA);
            PG8_WAIT_V(8); PG8_WAIT_L(0); PG8_BAR; PG8_MMA(1, 0, At, B0); PG8_MMA(1, 1, At, B1); PG8_BAR; PG8_SCHED;
            PG8_LDB(B0, 1, 0); PG8_LDB(B1, 1, 1); PG8_SCHED; PG8_LDA(At, 1, 0); PG8_STAGE(PG8_SA(0, 1), a2 + hstepA, voffA);
            PG8_WAIT_V(8); PG8_WAIT_L(0); PG8_BAR; PG8_MMA(0, 0, At, B0); PG8_MMA(0, 1, At, B1); PG8_BAR; PG8_SCHED;
            PG8_LDA(At, 1, 1); PG8_STAGE(PG8_SB(1, 0), b3, voffB); PG8_STAGE(PG8_SB(1, 1), b3 + hstepB, voffB); PG8_STAGE(PG8_SA(1, 0), a3, voffA);
            PG8_WAIT_V(8); PG8_WAIT_L(0); PG8_BAR; PG8_MMA(1, 0, At, B0); PG8_MMA(1, 1, At, B1); PG8_BAR; PG8_SCHED;
        }
        if constexpr (ALIGN_EPI) { if (wr == 0) PG8_BAR; }
        E(acc, cur, wr, wc, fr, fq); S.done(cur);
        if (!has_next) break;
#pragma unroll
        for (int a = 0; a < 2; ++a)
#pragma unroll
            for (int b = 0; b < 2; ++b)
#pragma unroll
                for (int m = 0; m < 4; ++m)
#pragma unroll
                    for (int n = 0; n < 2; ++n) acc[a][b][m][n] = (f32x4){0.f, 0.f, 0.f, 0.f};
        cur = nxt; cA = nA; cB = nB; ++ui;
        if constexpr (ALIGN_EPI) { if (wr == 1) PG8_BAR; }
    }
    PG8_WAIT_V(0);
    if constexpr (!ALIGN_EPI) { if (wr == 0) PG8_BAR; }
    PG8_BAR;
#undef PG8_SA
#undef PG8_SB
#undef PG8_STAGE
#undef PG8_LDA
#undef PG8_LDB
#undef PG8_MMA
#undef PG8_WAIT_V
#undef PG8_WAIT_L
#undef PG8_BAR
#undef PG8_SCHED
}
}

constexpr int NWAVES = 8, NTHR = 512;
constexpr int DM = 2048, MP = 16384, MS = 512, MT = MP + MS, PAST = 2048, DECL = 64, NB = 8;
constexpr int KCROWS = PAST + DECL;
constexpr float EPS = 1e-6f;
constexpr float LOG2E = 1.4426950408889634f;
constexpr float C2 = 0.125f * LOG2E;

enum { I_XP = 0, I_XS, I_CK, I_CV, I_SR, I_NW, I_AWIN, I_AWOUT, I_AQG, I_AKG, I_LQ1, I_LK1, I_LQ2, I_LK2, I_ASG, I_RWIN, I_RWOUT, I_CWIN, I_CWOUT, I_CVG, I_CWS, I_CBS, N_IN };
constexpr size_t O_YP = 0, O_YS = O_YP + (size_t)MP * DM, O_KP = O_YS + (size_t)MS * DM, O_VP = O_KP + 2 * (size_t)MP * DM, O_KS = O_VP + 2 * (size_t)MP * DM, O_VS = O_KS + 2 * (size_t)MS * DM,
                 O_SP = O_VS + 2 * (size_t)MS * DM, O_SS = O_SP + (size_t)8 * 256 * 512, O_VM = O_SS + (size_t)NB * 8 * 256 * 512, O_END = O_VM + (size_t)MS * 4096;

constexpr size_t MiB = 1u << 20;
constexpr size_t WS_CTL = 0, CTL_ZERO_BYTES = 1 * MiB;
constexpr size_t WS_WAIN0 = 8 * MiB, WS_WAIN1 = 40 * MiB, WS_WAOUT0 = 72 * MiB, WS_WAOUT1 = 80 * MiB, WS_WRIN = 88 * MiB, WS_WROUT = 136 * MiB, WS_WCIN = 152 * MiB, WS_WCOUT = 200 * MiB;
constexpr size_t WS_XN = 216 * MiB, WS_Z = 282 * MiB, WS_B1 = 678 * MiB, WS_B2 = 744 * MiB, WS_B3 = 810 * MiB, WS_B4 = 876 * MiB, WS_B5 = 942 * MiB, WS_B6 = 1008 * MiB, WS_END = 1074 * MiB;

#define GAS __attribute__((address_space(1)))
#define LAS __attribute__((address_space(3)))
typedef unsigned short bf16;
typedef unsigned v4u __attribute__((ext_vector_type(4)));
typedef unsigned v2u __attribute__((ext_vector_type(2)));
typedef float f32x4 __attribute__((ext_vector_type(4)));
typedef GAS unsigned gu32;
#define RLX_AGENT __ATOMIC_RELAXED, __HIP_MEMORY_SCOPE_AGENT
#define LDS_WAIT() asm volatile("s_waitcnt lgkmcnt(0)" ::: "memory")
#define VM_WAIT() asm volatile("s_waitcnt vmcnt(0)" ::: "memory")
__device__ __forceinline__ unsigned f2bf(float f) { unsigned u = __builtin_bit_cast(unsigned, f); return (u + 0x7fffu + ((u >> 16) & 1u)) >> 16; }
__device__ __forceinline__ unsigned pk2(float lo, float hi) { return f2bf(lo) | (f2bf(hi) << 16); }
__device__ __forceinline__ float bf2f(unsigned short b) { return __builtin_bit_cast(float, (unsigned)b << 16); }
__device__ __forceinline__ float bflo(unsigned w) { return __builtin_bit_cast(float, w << 16); }
__device__ __forceinline__ float bfhi(unsigned w) { return __builtin_bit_cast(float, w & 0xffff0000u); }
__device__ __forceinline__ float silu_f(float x) { return x / (1.f + __expf(-x)); }
__device__ __forceinline__ float gelu_tanh_f(float x) { const float u = 0.7978845608028654f * (x + 0.044715f * x * x * x); return x / (1.f + __expf(-2.f * u)); }
__device__ __forceinline__ float wave_sum(float v) {
#pragma unroll
    for (int o = 1; o < 64; o <<= 1) v += __shfl_xor(v, o);
    return v;
}
__device__ __forceinline__ void rope_cs(int pos, int i, int nf, float& c, float& s) {
    const float inv = exp2f(-(float)i / (float)nf * 13.287712379549449f);
    const double a = (double)pos * (double)inv * 0.15915494309189535;
    const float r = (float)(a - floor(a));
    c = __builtin_amdgcn_cosf(r); s = __builtin_amdgcn_sinf(r);
}

#define XB_TMO      128
#define XB_XCNT(j)  (256  + 64 * (j))
#define XB_XSUB(j)  (1280 + 64 * (j))
#define XB_XGEN(j)  (2304 + 64 * (j))
#define XB_TOP      3328
#define XB_TOPGEN   3392
#define XCD_BAR_WORDS 3456
#define XB_SPIN_CAP (1u << 22)
__device__ __forceinline__ unsigned xb_ld(unsigned* p)              { return __hip_atomic_load(p, __ATOMIC_RELAXED, __HIP_MEMORY_SCOPE_AGENT); }
__device__ __forceinline__ unsigned xb_add(unsigned* p, unsigned v) { return __hip_atomic_fetch_add(p, v, __ATOMIC_RELAXED, __HIP_MEMORY_SCOPE_AGENT); }
__device__ __forceinline__ unsigned xb_xcc_id() { return (unsigned)__builtin_amdgcn_s_getreg((3 << 11) | 20) & 0xFu; }
#define XB_SPIN(cond, bar) do { unsigned _sp = 0; while (cond) { __builtin_amdgcn_s_sleep(1); \
    if ((++_sp & 255u) == 0u) { if (xb_ld(&(bar)[XB_TMO])) break; if (_sp > XB_SPIN_CAP) { atomicAdd(&(bar)[XB_TMO], 1u); break; } } } } while (0)
struct XcdBarrier { unsigned* bar; unsigned x; volatile LAS unsigned* st; };
__device__ __forceinline__ XcdBarrier xcd_barrier_post(unsigned* bar, volatile LAS unsigned* st) {
    XcdBarrier b; b.bar = bar; b.x = xb_xcc_id(); b.st = st;
    if (threadIdx.x == 0) (void)xb_add(&bar[XB_XCNT(b.x)], 1u);
    return b;
}
__device__ __forceinline__ void xcd_barrier_complete(unsigned* bar, unsigned x, unsigned& nloc, unsigned& nx) {
    const unsigned G = gridDim.x * gridDim.y * gridDim.z;
    unsigned sum, cnt, mine, sp = 0u;
    for (;;) {
        sum = 0u; cnt = 0u; mine = 0u;
#pragma unroll
        for (unsigned j = 0; j < 16; ++j) { const unsigned c = xb_ld(&bar[XB_XCNT(j)]); sum += c; cnt += (c > 0u) ? 1u : 0u; mine = (j == x) ? c : mine; }
        if (sum == G) break;
        __builtin_amdgcn_s_sleep(1);
        if ((++sp & 255u) == 0u) { if (xb_ld(&bar[XB_TMO])) break; if (sp > XB_SPIN_CAP) { atomicAdd(&bar[XB_TMO], 1u); break; } }
    }
    nloc = mine > 0u ? mine : 1u; nx = cnt > 0u ? cnt : 1u;
}
__device__ __forceinline__ void xcd_barrier(const XcdBarrier& b) {
    asm volatile("s_waitcnt vmcnt(0)" ::: "memory");
    __syncthreads();
    if (threadIdx.x == 0) {
        unsigned* bar = b.bar;
        __builtin_amdgcn_s_waitcnt(0);
        unsigned nloc = b.st[0], nx = b.st[1];
        if (nloc == 0u) { xcd_barrier_complete(bar, b.x, nloc, nx); b.st[0] = nloc; b.st[1] = nx; }
        const unsigned old = xb_add(&bar[XB_XSUB(b.x)], 1u);
        const unsigned gen = old / nloc;
        if (old + 1u == (gen + 1u) * nloc) {
            __builtin_amdgcn_fence(__ATOMIC_RELEASE, "agent");
            asm volatile("s_waitcnt vmcnt(0)" ::: "memory");
            const unsigned og = xb_add(&bar[XB_TOP], 1u);
            const unsigned tg = og / nx;
            if (og + 1u == (tg + 1u) * nx) xb_add(&bar[XB_TOPGEN], 1u);
            else XB_SPIN(xb_ld(&bar[XB_TOPGEN]) == tg, bar);
            __builtin_amdgcn_fence(__ATOMIC_ACQUIRE, "agent");
            xb_add(&bar[XB_XGEN(b.x)], 1u);
            asm volatile("s_waitcnt vmcnt(0)" ::: "memory");
        } else {
            XB_SPIN(xb_ld(&bar[XB_XGEN(b.x)]) == gen, bar);
            __builtin_amdgcn_fence(__ATOMIC_ACQUIRE, "agent");
            asm volatile("s_waitcnt vmcnt(0)" ::: "memory");
        }
    }
    __syncthreads();
}

constexpr int RING_OFF = 0, RING_BYTES = 139264;
constexpr int MISC_OFF = RING_BYTES;
constexpr int LDS_BYTES = 147456;
struct Args { const float* in[N_IN]; float* out; unsigned char* ws; int ph_lo, ph_hi; };
struct Frame {
    LAS unsigned char* lds; int tid, lane, wave, G, bid;
    const float* const* in; float* out; unsigned char* ws;
};

__device__ __forceinline__ void p0_transpose_item(const float* W, int K, int N, bf16* WT, LAS float* scr, int item, int lane) {
    const int nblk = N / 32, kb = item / nblk, nb = item % nblk, k0 = 64 * kb, n0 = 32 * nb;
#pragma unroll 8
    for (int i = 0; i < 32; ++i) { const int kk = 2 * i + (lane >> 5); scr[kk * 33 + (lane & 31)] = W[(size_t)(k0 + kk) * N + n0 + (lane & 31)]; }
    LDS_WAIT(); asm volatile("" ::: "memory");
    const int c = lane & 7;
#pragma unroll
    for (int j = 0; j < 4; ++j) { const int n = (lane >> 3) + 8 * j; const LAS float* s = scr + (8 * c) * 33 + n;
        v4u o; o.x = pk2(s[0 * 33], s[1 * 33]); o.y = pk2(s[2 * 33], s[3 * 33]); o.z = pk2(s[4 * 33], s[5 * 33]); o.w = pk2(s[6 * 33], s[7 * 33]);
        *(GAS v4u*)(WT + (size_t)(n0 + n) * K + k0 + 8 * c) = o; }
    LDS_WAIT(); asm volatile("" ::: "memory");
}
__device__ __forceinline__ void transpose_weight(Frame& F, const float* W, int K, int N, bf16* WT) {
    LAS float* scr = (LAS float*)(F.lds + RING_OFF + F.wave * 16384);
    const int gw = F.bid * NWAVES + F.wave, NGW = F.G * NWAVES, nitems = (K / 64) * (N / 32);
    for (int it = gw; it < nitems; it += NGW) p0_transpose_item(W, K, N, WT, scr, it, F.lane);
}
__device__ __forceinline__ void norm_rows(Frame& F, const float* src_p, const float* src_s, const float* w, bf16* XN) {
    const int gw = F.bid * NWAVES + F.wave, NGW = F.G * NWAVES;
    for (int m = gw; m < MT; m += NGW) {
        const float* xrow = (m < MP) ? src_p + (size_t)m * DM : src_s + (size_t)(m - MP) * DM;
        const GAS f32x4* xr = (const GAS f32x4*)xrow + F.lane; const GAS f32x4* wr = (const GAS f32x4*)w + F.lane;
        f32x4 v[8]; float s = 0.f;
#pragma unroll
        for (int j = 0; j < 8; ++j) { v[j] = xr[64 * j]; s += (v[j].x * v[j].x + v[j].y * v[j].y) + (v[j].z * v[j].z + v[j].w * v[j].w); }
        const float rstd = 1.f / sqrtf(wave_sum(s) * (1.f / DM) + EPS);
        GAS v2u* o8 = (GAS v2u*)(XN + (size_t)m * DM) + F.lane;
#pragma unroll
        for (int j = 0; j < 8; ++j) { const f32x4 g = wr[64 * j]; v2u o; o.x = pk2(v[j].x * rstd * g.x, v[j].y * rstd * g.y); o.y = pk2(v[j].z * rstd * g.z, v[j].w * rstd * g.w); o8[64 * j] = o; }
    }
}
__device__ __forceinline__ void cache_cvt(Frame& F, const float* ck, const float* cv, bf16* KC, bf16* VC) {
    const size_t nvec = (size_t)NB * PAST * DM / 4;
    const size_t gt = (size_t)F.bid * NTHR + F.tid, NG = (size_t)F.G * NTHR;
    for (size_t i = gt; i < 2 * nvec; i += NG) {
        const bool isv = i >= nvec; const size_t e = (isv ? i - nvec : i) * 4;
        const size_t brow = e / DM, col = e % DM, b = brow / PAST, t = brow % PAST;
        const f32x4 x = *(const GAS f32x4*)((isv ? cv : ck) + e);
        v2u o; o.x = pk2(x.x, x.y); o.y = pk2(x.z, x.w);
        *(GAS v2u*)((isv ? VC : KC) + ((b * KCROWS + t) * DM + col)) = o;
    }
}
__device__ __forceinline__ int row_pos(int row) { return row < MP ? row : PAST + ((row - MP) & 63); }

__device__ __forceinline__ void a_post(Frame& F, const bf16* Z  , const float* qg, const float* kg, bf16* Qs, bf16* KP, bf16* VP, bf16* KC, bf16* VC, float* okp, float* ovp, float* oks, float* ovs) {
    const int gw = F.bid * NWAVES + F.wave, NGW = F.G * NWAVES, lane = F.lane;
    const float gq = qg[lane], gk = kg[lane];
    for (int it = gw; it < MT * 96; it += NGW) {
        const int row = it / 96, blk = it % 96;
        const float x = bf2f(Z[(size_t)row * 8192 + blk * 64 + lane]);
        if (blk < 64) {
            const float ss = wave_sum(x * x);
            const float y = x * (1.f / sqrtf(ss * (1.f / 64.f) + EPS)) * (blk < 32 ? gq : gk);
            const float p = __shfl_xor(y, 32);
            float c, s; rope_cs(row_pos(row), lane & 31, 32, c, s);
            const float o = (lane < 32) ? y * c - p * s : y * c + p * s;
            if (blk < 32) Qs[(size_t)row * DM + blk * 64 + lane] = (bf16)f2bf(o * C2);
            else { const int col = (blk - 32) * 64 + lane;
                if (row < MP) { KP[(size_t)row * DM + col] = (bf16)f2bf(o); okp[(size_t)row * DM + col] = o; }
                else { const int s_ = row - MP, b = s_ >> 6, t = s_ & 63; KC[((size_t)b * KCROWS + PAST + t) * DM + col] = (bf16)f2bf(o); oks[(size_t)s_ * DM + col] = o; } }
        } else { const int col = (blk - 64) * 64 + lane;
            if (row < MP) { VP[(size_t)row * DM + col] = (bf16)f2bf(x); ovp[(size_t)row * DM + col] = x; }
            else { const int s_ = row - MP, b = s_ >> 6, t = s_ & 63; VC[((size_t)b * KCROWS + PAST + t) * DM + col] = (bf16)f2bf(x); ovs[(size_t)s_ * DM + col] = x; } }
    }
}

namespace dattn {
typedef short bf16x8 __attribute__((ext_vector_type(8)));
typedef short s16x4 __attribute__((ext_vector_type(4)));
typedef short v4i16_t __attribute__((ext_vector_type(4)));
typedef float f32x16 __attribute__((ext_vector_type(16)));
typedef unsigned u32x4 __attribute__((ext_vector_type(4)));
typedef __attribute__((address_space(3))) const char* lds_cptr;
constexpr int SLOTB = 32768, NSLOT = 3, RINGB = SLOTB * NSLOT, WSF_OFF = RINGB, XCHB = 18432, STP = 144;
__device__ __forceinline__ int crow(int r, int hi) { return (r & 3) + 8 * (r >> 2) + 4 * hi; }
__device__ __forceinline__ void glds16(const void* gsrc, unsigned lds_dst) { unsigned keep;
    asm volatile("s_mov_b32 %0, m0\n\ts_mov_b32 m0, %2\n\ts_nop 0\n\tglobal_load_lds_dwordx4 %1, off\n\ts_mov_b32 m0, %0" : "=&s"(keep) : "v"(gsrc), "s"(lds_dst) : "memory"); }
typedef float f32x2_t __attribute__((ext_vector_type(2))); typedef __bf16 bf16x2_t __attribute__((ext_vector_type(2)));
__device__ __forceinline__ unsigned cvtpk_s(float lo, float hi) { f32x2_t v = {lo, hi}; bf16x2_t b = __builtin_convertvector(v, bf16x2_t); return __builtin_bit_cast(unsigned, b); }
#define DA_WAIT_BAR(N) asm volatile("s_waitcnt vmcnt(" #N ") lgkmcnt(0)\n\ts_barrier" ::: "memory")
__device__ __forceinline__ s16x4 vtr(lds_cptr p) { return __builtin_bit_cast(s16x4, __builtin_amdgcn_ds_read_tr16_b64_v4i16((__attribute__((address_space(3))) v4i16_t*)p)); }
struct Unit { const bf16* Q; const bf16* K; const bf16* V; const bf16* G; bf16* AO; int NT; int full; };

__device__ __forceinline__ void attn_unit(const Unit& u, char* shm, float lam, float one_m_li, const float* sub_gain) {
    const int tid = threadIdx.x, lane = tid & 63, r32 = lane & 31, hi = lane >> 5; const int wid = __builtin_amdgcn_readfirstlane(tid >> 6), s = wid >> 2, g = wid & 3;
    const int NT = u.NT; const int wt = u.full ? (g < 2 ? NT - 1 : NT) : (g < 2 ? NT : 0);
    const unsigned lds0 = (unsigned)(uintptr_t)shm;
    float* wsf = (float*)(shm + WSF_OFF) + wid * 64;
    const bf16* ksrc = u.K + (long)lane * DM + wid * 8;
    const bf16* vsrc = u.V + (long)(16 * (wid & 3) + (lane >> 2)) * DM + (wid >> 2) * 32 + (lane & 3) * 8;
    const unsigned kdst = lds0 + wid * 1024, vdst = lds0 + 16384 + wid * 1024;
#define DA_DMA(t, slot) do { const int tt_ = (t) < NT ? (t) : NT - 1; const bf16* kp_ = ksrc + (long)tt_ * 64 * DM; const bf16* vp_ = vsrc + (long)tt_ * 64 * DM; \
        glds16(kp_, (unsigned)__builtin_amdgcn_readfirstlane(kdst + (slot))); glds16(kp_ + 64, (unsigned)__builtin_amdgcn_readfirstlane(kdst + 8192 + (slot))); \
        glds16(vp_, (unsigned)__builtin_amdgcn_readfirstlane(vdst + (slot))); glds16(vp_ + 64, (unsigned)__builtin_amdgcn_readfirstlane(vdst + 8192 + (slot))); } while (0)
    const lds_cptr shm3 = (lds_cptr)shm;
    const lds_cptr kp0 = shm3 + s * 8192 + hi * 1024 + r32 * 16;
    const lds_cptr vp0 = shm3 + 16384 + ((lane >> 4) & 1) * 32 + (lane & 3) * 8 + (4 * hi + ((lane & 15) >> 2)) * 64;
    DA_DMA(0, 0); DA_DMA(1, SLOTB);
    bf16x8 qr[4];
    { const bf16* Qw = u.Q + (long)(32 * g + r32) * DM + s * 64;
#pragma unroll
      for (int d0 = 0; d0 < 4; ++d0) qr[d0] = (wt > 0) ? *reinterpret_cast<const bf16x8*>(Qw + d0 * 16 + hi * 8) : (bf16x8){0, 0, 0, 0, 0, 0, 0, 0}; }
    f32x16 o[4]; o[0] = f32x16{}; o[1] = f32x16{}; o[2] = f32x16{}; o[3] = f32x16{};
    float l_reg = 0.f;
    int sl = 0, sl2 = 2 * SLOTB;
    for (int t = 0; t < NT; ++t) {
        DA_WAIT_BAR(4);
        DA_DMA(t + 2, sl2);
        if (t < wt) {
            const lds_cptr kp = kp0 + sl; const lds_cptr vp = vp0 + sl;
            f32x16 C0, C1;
            { bf16x8 kf[8];
#pragma unroll
              for (int j = 0; j < 4; ++j) { kf[2 * j] = *(const __attribute__((address_space(3))) bf16x8*)(kp + j * 2048); kf[2 * j + 1] = *(const __attribute__((address_space(3))) bf16x8*)(kp + j * 2048 + 512); }
              const f32x16 z = f32x16{};
              C0 = __builtin_amdgcn_mfma_f32_32x32x16_bf16(kf[0], qr[0], z, 0, 0, 0); C1 = __builtin_amdgcn_mfma_f32_32x32x16_bf16(kf[1], qr[0], z, 0, 0, 0);
#pragma unroll
              for (int j = 1; j < 4; ++j) { C0 = __builtin_amdgcn_mfma_f32_32x32x16_bf16(kf[2 * j], qr[j], C0, 0, 0, 0); C1 = __builtin_amdgcn_mfma_f32_32x32x16_bf16(kf[2 * j + 1], qr[j], C1, 0, 0, 0); } }
            float sa = 0.f, sb = 0.f;
#pragma unroll
            for (int r = 0; r < 16; ++r) { C0[r] = __builtin_amdgcn_exp2f(C0[r]); C1[r] = __builtin_amdgcn_exp2f(C1[r]); sa += C0[r]; sb += C1[r]; }
            l_reg += sa + sb;
            u32x4 pw[4];
#pragma unroll
            for (int k = 0; k < 4; ++k) { pw[0][k] = cvtpk_s(C0[2 * k], C0[2 * k + 1]); pw[1][k] = cvtpk_s(C0[8 + 2 * k], C0[8 + 2 * k + 1]); pw[2][k] = cvtpk_s(C1[2 * k], C1[2 * k + 1]); pw[3][k] = cvtpk_s(C1[8 + 2 * k], C1[8 + 2 * k + 1]); }
#pragma unroll
            for (int db = 0; db < 4; ++db)
#pragma unroll
                for (int ks = 0; ks < 4; ++ks) { const s16x4 lo = vtr(vp + db * 4096 + ks * 1024), hh = vtr(vp + db * 4096 + ks * 1024 + 512);
                    const bf16x8 vf = (bf16x8){lo[0], lo[1], lo[2], lo[3], hh[0], hh[1], hh[2], hh[3]};
                    o[db] = __builtin_amdgcn_mfma_f32_32x32x16_bf16(__builtin_bit_cast(bf16x8, pw[ks]), vf, o[db], 0, 0, 0); }
        }
        sl = (sl == (NSLOT - 1) * SLOTB) ? 0 : sl + SLOTB; sl2 = (sl2 == (NSLOT - 1) * SLOTB) ? 0 : sl2 + SLOTB;
    }
    { auto rr = __builtin_amdgcn_permlane32_swap(__float_as_uint(l_reg), __float_as_uint(l_reg), false, false); l_reg = __uint_as_float(rr[0]) + __uint_as_float(rr[1]); }
    if (hi == 0) wsf[r32] = l_reg;
    DA_WAIT_BAR(0);
    float rli[16];
#pragma unroll
    for (int r = 0; r < 16; ++r) { const float lq = wsf[crow(r, hi)]; rli[r] = (s == 0 ? 1.f : -lam) / lq; }
    float* xch = (float*)(shm + g * XCHB);
    if (s == 1 && wt > 0) {
#pragma unroll
        for (int db = 0; db < 4; ++db)
#pragma unroll
            for (int r = 0; r < 16; ++r) xch[(db * 16 + r) * 64 + lane] = o[db][r] * rli[r];
    }
    DA_WAIT_BAR(0);
    if (s == 0 && wt > 0) {
#pragma unroll
        for (int db = 0; db < 4; ++db)
#pragma unroll
            for (int r = 0; r < 16; ++r) o[db][r] = o[db][r] * rli[r] + xch[(db * 16 + r) * 64 + lane];
        asm volatile("s_waitcnt lgkmcnt(0)" ::: "memory");
#pragma unroll
        for (int db = 0; db < 4; ++db)
#pragma unroll
            for (int r = 0; r < 16; ++r) xch[crow(r, hi) * STP + 32 * db + r32] = o[db][r];
        asm volatile("s_waitcnt lgkmcnt(0)" ::: "memory");
        const int row = lane >> 1, half = lane & 1;
        float v[64]; float ss = 0.f;
#pragma unroll
        for (int k = 0; k < 16; ++k) { const f32x4 x = *(const f32x4*)(xch + row * STP + half * 64 + 4 * k); v[4 * k] = x.x; v[4 * k + 1] = x.y; v[4 * k + 2] = x.z; v[4 * k + 3] = x.w; ss += (x.x * x.x + x.y * x.y) + (x.z * x.z + x.w * x.w); }
        ss += __shfl_xor(ss, 1);
        const float sc = one_m_li / sqrtf(ss * (1.f / 128.f) + EPS);
        const bf16* gp = u.G + (long)(32 * g + row) * 8192 + half * 64; bf16* op = u.AO + (long)(32 * g + row) * DM + half * 64; const float* sg = sub_gain + half * 64;
#pragma unroll
        for (int k = 0; k < 8; ++k) { const v4u g4 = *(const v4u*)(gp + 8 * k); const f32x4 ga = *(const f32x4*)(sg + 8 * k), gb = *(const f32x4*)(sg + 8 * k + 4);
            const float gg[8] = {bflo(g4.x), bfhi(g4.x), bflo(g4.y), bfhi(g4.y), bflo(g4.z), bfhi(g4.z), bflo(g4.w), bfhi(g4.w)};
            const float gn[8] = {ga.x, ga.y, ga.z, ga.w, gb.x, gb.y, gb.z, gb.w}; float y[8];
#pragma unroll
            for (int e = 0; e < 8; ++e) y[e] = v[8 * k + e] * sc * gn[e] * silu_f(gg[e]);
            v4u w; w.x = pk2(y[0], y[1]); w.y = pk2(y[2], y[3]); w.z = pk2(y[4], y[5]); w.w = pk2(y[6], y[7]);
            *(v4u*)(op + 8 * k) = w; }
    }
    DA_WAIT_BAR(0);
#undef DA_DMA
}
}
__device__ __forceinline__ void attn_fast(Frame& F, const bf16* Qs, const bf16* KP, const bf16* VP, const bf16* KC, const bf16* VC, const bf16* Z  , bf16* AO,
                                          float lam, float one_m_li, const float* sub_gain) {
    const int NU = 2048 + 16 * NB;
    for (int i = 0;; ++i) {
        const int idx = i * F.G + ((i & 1) ? F.G - 1 - F.bid : F.bid); if (idx >= NU) break;
        dattn::Unit u;
        if (idx < 2048) { const int qb = 127 - (idx >> 4), h = idx & 15; const long row0 = 128L * qb;
            u.Q = Qs + row0 * DM + h * 128; u.K = KP + h * 128; u.V = VP + h * 128; u.G = Z + row0 * 8192 + 6144 + h * 128; u.AO = AO + row0 * DM + h * 128; u.NT = 2 * qb + 2; u.full = 1; }
        else { const int j = idx - 2048, b = j >> 4, h = j & 15; const long row0 = MP + 64L * b;
            u.Q = Qs + row0 * DM + h * 128; u.K = KC + (long)b * KCROWS * DM + h * 128; u.V = VC + (long)b * KCROWS * DM + h * 128; u.G = Z + row0 * 8192 + 6144 + h * 128; u.AO = AO + row0 * DM + h * 128; u.NT = KCROWS / 64; u.full = 0; }
        dattn::attn_unit(u, (char*)F.lds + RING_OFF, lam, one_m_li, sub_gain);
    }
}
__device__ __forceinline__ void r_post(Frame& F, const bf16* Z  , bf16* RQ, bf16* RK) {
    const int gw = F.bid * NWAVES + F.wave, NGW = F.G * NWAVES, lane = F.lane;
    for (int it = gw; it < MT * 16; it += NGW) {
        const int row = it >> 4, hh = it & 15; const bf16* z = Z + (size_t)row * 12288 + hh * 256; bf16* o = (hh < 8 ? RQ + (size_t)row * DM + hh * 256 : RK + (size_t)row * DM + (hh - 8) * 256);
        const float sc = hh < 8 ? 1.f : 0.0625f; const int pos = row_pos(row);
#pragma unroll
        for (int k = 0; k < 2; ++k) { const int i = lane + 64 * k; const float x1 = bf2f(z[i]), x2 = bf2f(z[128 + i]); float c, s; rope_cs(pos, i, 128, c, s);
            o[i] = (bf16)f2bf((x1 * c - x2 * s) * sc); o[128 + i] = (bf16)f2bf((x2 * c + x1 * s) * sc); }
    }
}
__device__ __forceinline__ void ret_naive(Frame& F, const bf16* RQ, const bf16* RK, const bf16* Z  , const float* state_in, bf16* ORET  , float* osp, float* oss) {
    LAS float* red = (LAS float*)(F.lds + RING_OFF);
    const int tid = F.tid, c = tid & 63, rg = __builtin_amdgcn_readfirstlane(tid >> 6);
    const int NIT = 64 + 64 * NB;
    for (int it = F.bid; it < NIT; it += F.G) {
        int h, sl, row0, ntok; float* so; const float* si;
        if (it < 64) { h = it >> 3; sl = it & 7; row0 = 0; ntok = MP; so = osp + (size_t)h * 256 * 512; si = nullptr; }
        else { const int j = it - 64, b = j >> 6; h = (j >> 3) & 7; sl = j & 7; row0 = MP + 64 * b; ntok = 64; so = oss + ((size_t)b * 8 + h) * 256 * 512; si = state_in + ((size_t)b * 8 + h) * 256 * 512; }
        const float gamma = 1.f - exp2f(-5.f - (float)h);
        float S[32];
#pragma unroll
        for (int j = 0; j < 32; ++j) S[j] = si ? si[(size_t)(rg * 32 + j) * 512 + sl * 64 + c] : 0.f;
        const bf16* qp = RQ + (size_t)row0 * DM + h * 256 + rg * 32 + (c & 31);
        const bf16* kp = RK + (size_t)row0 * DM + h * 256 + rg * 32 + (c & 31);
        const bf16* vp = Z + (size_t)row0 * 12288 + 4096 + h * 512 + sl * 64 + c;
        float qn = bf2f(qp[0]), kn = bf2f(kp[0]), vn = bf2f(vp[0]);
        __syncthreads();
        for (int t = 0; t < ntok; ++t) {
            const float qv = qn, kv = kn, vv = vn;
            if (t + 1 < ntok) { qn = bf2f(qp[(size_t)(t + 1) * DM]); kn = bf2f(kp[(size_t)(t + 1) * DM]); vn = bf2f(vp[(size_t)(t + 1) * 12288]); }
            float po = 0.f;
#pragma unroll
            for (int j = 0; j < 32; ++j) { const float kj = __builtin_bit_cast(float, __builtin_amdgcn_readlane(__builtin_bit_cast(int, kv), j)), qj = __builtin_bit_cast(float, __builtin_amdgcn_readlane(__builtin_bit_cast(int, qv), j));
                S[j] = gamma * S[j] + kj * vv; po += qj * S[j]; }
            LAS float* rb = red + (t & 1) * 512;
            rb[rg * 64 + c] = po;
            __syncthreads();
            if (rg == 0) { float o = 0.f;
#pragma unroll
                for (int g = 0; g < 8; ++g) o += rb[g * 64 + c];
                ORET[(size_t)(row0 + t) * 4096 + h * 512 + sl * 64 + c] = (bf16)f2bf(o); }
        }
#pragma unroll
        for (int j = 0; j < 32; ++j) so[(size_t)(rg * 32 + j) * 512 + sl * 64 + c] = S[j];
        __syncthreads();
    }
}
__device__ __forceinline__ void r_out(Frame& F, const bf16* ORET, const bf16* Z  , bf16* AO) {
    const int gw = F.bid * NWAVES + F.wave, NGW = F.G * NWAVES, lane = F.lane;
    for (int it = gw; it < MT * 8; it += NGW) {
        const int row = it >> 3, h = it & 7; const size_t off = (size_t)row * 4096 + h * 512 + lane * 8;
        const v4u o4 = *(const v4u*)(ORET + off), g4 = *(const v4u*)(Z + (size_t)row * 12288 + 8192 + h * 512 + lane * 8);
        float o[8] = {bflo(o4.x), bfhi(o4.x), bflo(o4.y), bfhi(o4.y), bflo(o4.z), bfhi(o4.z), bflo(o4.w), bfhi(o4.w)};
        const float g[8] = {bflo(g4.x), bfhi(g4.x), bflo(g4.y), bfhi(g4.y), bflo(g4.z), bfhi(g4.z), bflo(g4.w), bfhi(g4.w)};
        float ss = 0.f;
#pragma unroll
        for (int k = 0; k < 8; ++k) ss += o[k] * o[k];
        const float rstd = 1.f / sqrtf(wave_sum(ss) * (1.f / 512.f) + EPS);
#pragma unroll
        for (int k = 0; k < 8; ++k) o[k] = o[k] * rstd * silu_f(g[k]);
        v4u w; w.x = pk2(o[0], o[1]); w.y = pk2(o[2], o[3]); w.z = pk2(o[4], o[5]); w.w = pk2(o[6], o[7]);
        *(v4u*)(AO + off) = w;
    }
}
__device__ __forceinline__ void c_stats(Frame& F, const bf16* Z  , const float* vgain, bf16* VN, float* ovm) {
    const int gw = F.bid * NWAVES + F.wave, NGW = F.G * NWAVES, lane = F.lane;
    for (int row = gw; row < MT; row += NGW) {
        float x[64]; float ss = 0.f;
#pragma unroll
        for (int j = 0; j < 8; ++j) { const v4u v4 = *(const v4u*)(Z + (size_t)row * 12288 + 4096 + j * 512 + lane * 8);
            const float t[8] = {bflo(v4.x), bfhi(v4.x), bflo(v4.y), bfhi(v4.y), bflo(v4.z), bfhi(v4.z), bflo(v4.w), bfhi(v4.w)};
#pragma unroll
            for (int k = 0; k < 8; ++k) { const float g = gelu_tanh_f(t[k]); x[j * 8 + k] = g; ss += g * g; } }
        const float rstd = 1.f / sqrtf(wave_sum(ss) * (1.f / 4096.f) + EPS);
#pragma unroll
        for (int j = 0; j < 8; ++j) { const int col = j * 512 + lane * 8; float y[8];
#pragma unroll
            for (int k = 0; k < 8; ++k) y[k] = x[j * 8 + k] * rstd * vgain[col + k];
            v4u w; w.x = pk2(y[0], y[1]); w.y = pk2(y[2], y[3]); w.z = pk2(y[4], y[5]); w.w = pk2(y[6], y[7]);
            *(v4u*)(VN + (size_t)row * 4096 + col) = w;
            if (row >= MP) { float* o = ovm + (size_t)(row - MP) * 4096 + col; *(f32x4*)o = (f32x4){y[0], y[1], y[2], y[3]}; *(f32x4*)(o + 4) = (f32x4){y[4], y[5], y[6], y[7]}; } }
    }
}
__device__ __forceinline__ void c_mix(Frame& F, const bf16* Z  , const bf16* VN, const float* ws_, const float* bs_, bf16* AO) {
    LAS float* vl = (LAS float*)(F.lds + RING_OFF);
    const int tid = F.tid, d = tid & 255, ih = tid >> 8;
    const int NIT = (128 + NB) * 16;
    for (int it = F.bid; it < NIT; it += F.G) {
        const int ch = it >> 4, gh = it & 15, g = gh >> 1, c0 = gh * 256;
        const int L = ch < 128 ? 128 : 64, row0 = ch < 128 ? ch * 128 : MP + (ch - 128) * 64;
        __syncthreads();
        for (int e = tid; e < L * 256; e += NTHR) { const int j = e >> 8, dd = e & 255; vl[j * 256 + dd] = bf2f(VN[(size_t)(row0 + j) * 4096 + c0 + dd]); }
        __syncthreads();
        for (int i = ih; i < L; i += 2) {
            const float* wrow = ws_ + ((size_t)g * 128 + i) * 128; float acc = bs_[g * 128 + i];
            for (int j = 0; j <= i; ++j) acc += wrow[j] * vl[j * 256 + d];
            const size_t row = (size_t)(row0 + i); const float u = bf2f(Z[row * 12288 + c0 + d]), gg = bf2f(Z[row * 12288 + 8192 + c0 + d]);
            AO[row * 4096 + c0 + d] = (bf16)f2bf(gelu_tanh_f(u) * acc * silu_f(gg));
        }
    }
}
__device__ __forceinline__ float diff_lambda(const float* q1, const float* k1, const float* q2, const float* k2, float lam_init) {
    float a = 0.f, b = 0.f;
    for (int i = 0; i < 64; ++i) { a += q1[i] * k1[i]; b += q2[i] * k2[i]; }
    return expf(a) - expf(b) + lam_init;
}

constexpr int N_PHASES = 21;
__global__ void __launch_bounds__(NTHR, 2) mega(Args args) {
    extern __shared__ __attribute__((aligned(16))) unsigned char lds[];
    Frame F;
    F.lds = (LAS unsigned char*)lds; F.tid = threadIdx.x; F.lane = F.tid & 63; F.wave = __builtin_amdgcn_readfirstlane(F.tid >> 6); F.G = gridDim.x; F.bid = blockIdx.x;
    F.in = args.in; F.out = args.out; F.ws = args.ws;
    unsigned char* ws = args.ws; float* out = args.out;
    bf16* W_AIN[2] = {(bf16*)(ws + WS_WAIN0), (bf16*)(ws + WS_WAIN1)}; bf16* W_AOUT[2] = {(bf16*)(ws + WS_WAOUT0), (bf16*)(ws + WS_WAOUT1)};
    bf16* W_RIN = (bf16*)(ws + WS_WRIN); bf16* W_ROUT = (bf16*)(ws + WS_WROUT); bf16* W_CIN = (bf16*)(ws + WS_WCIN); bf16* W_COUT = (bf16*)(ws + WS_WCOUT);
    bf16* XN = (bf16*)(ws + WS_XN); bf16* Z = (bf16*)(ws + WS_Z);
    bf16* Qs = (bf16*)(ws + WS_B1); bf16* KP = (bf16*)(ws + WS_B2); bf16* VP = (bf16*)(ws + WS_B3); bf16* KC = (bf16*)(ws + WS_B4); bf16* VC = (bf16*)(ws + WS_B5); bf16* AO_A = (bf16*)(ws + WS_B6);
    bf16* RQ = (bf16*)(ws + WS_B1); bf16* RK = (bf16*)(ws + WS_B2); bf16* AO_BC = (bf16*)(ws + WS_B3); bf16* ORET = (bf16*)(ws + WS_B5); bf16* VN = (bf16*)(ws + WS_B5);
    const int lo = args.ph_lo, hi = args.ph_hi;
    volatile LAS unsigned* MISC = (volatile LAS unsigned*)(F.lds + MISC_OFF);
    for (int u = F.tid; u < (LDS_BYTES - MISC_OFF) / 4; u += NTHR) ((LAS unsigned*)(F.lds + MISC_OFF))[u] = 0u;
    __syncthreads();
    XcdBarrier bar = xcd_barrier_post((unsigned*)(ws + WS_CTL) + 4096, MISC + 8);
#define IN(k) (lo <= (k) && (k) < hi)
#define SEAM(k) do { if (IN(k) && IN((k) + 1)) xcd_barrier(bar); } while (0)

#define GEMM_STORE(Aptr, Wptr, NN, KK, Optr) do { pg8::GemmP g{KK, KK, (KK) / 64}; pg8::StaticOrder S; S.init(MT / 256, (NN) / 256, F.G, F.bid, Aptr, Wptr, KK, KK); pg8::EpiStoreBf16 E{(pg8::bf16_t*)(Optr), NN}; \
        pg8::gemm_phase<pg8::EpiStoreBf16, pg8::StaticOrder>(F.lds + RING_OFF, g, S, E); } while (0)
#define GEMM_RESID(Aptr, Wptr, KK, BP, BS) do { pg8::GemmP g{KK, KK, (KK) / 64}; pg8::StaticOrder S; S.init(MT / 256, DM / 256, F.G, F.bid, Aptr, Wptr, KK, KK); pg8::EpiResid E{BP, BS, out, MP}; \
        pg8::gemm_phase<pg8::EpiResid, pg8::StaticOrder>(F.lds + RING_OFF, g, S, E); } while (0)

    if (IN(0)) {
        transpose_weight(F, args.in[I_AWIN], 2048, 8192, W_AIN[0]); transpose_weight(F, args.in[I_AWIN] + (size_t)2048 * 8192, 2048, 8192, W_AIN[1]);
        transpose_weight(F, args.in[I_AWOUT], 2048, 2048, W_AOUT[0]); transpose_weight(F, args.in[I_AWOUT] + (size_t)2048 * 2048, 2048, 2048, W_AOUT[1]);
        transpose_weight(F, args.in[I_RWIN], 2048, 12288, W_RIN); transpose_weight(F, args.in[I_RWOUT], 4096, 2048, W_ROUT);
        transpose_weight(F, args.in[I_CWIN], 2048, 12288, W_CIN); transpose_weight(F, args.in[I_CWOUT], 4096, 2048, W_COUT);
        norm_rows(F, args.in[I_XP], args.in[I_XS], args.in[I_NW], XN);
        cache_cvt(F, args.in[I_CK], args.in[I_CV], KC, VC);
    }
    SEAM(0);
    if (IN(1)) GEMM_STORE(XN, W_AIN[0], 8192, 2048, Z);
    SEAM(1);
    if (IN(2)) a_post(F, Z, args.in[I_AQG], args.in[I_AKG], Qs, KP, VP, KC, VC, out + O_KP, out + O_VP, out + O_KS, out + O_VS);
    SEAM(2);
    if (IN(3)) { const float li = 0.8f - 0.6f * expf(-0.3f * 0.f); const float lam = diff_lambda(args.in[I_LQ1], args.in[I_LK1], args.in[I_LQ2], args.in[I_LK2], li);
        attn_fast(F, Qs, KP, VP, KC, VC, Z, AO_A, lam, 1.f - li, args.in[I_ASG]); }
    SEAM(3);
    if (IN(4)) GEMM_RESID(AO_A, W_AOUT[0], 2048, args.in[I_XP], args.in[I_XS]);
    SEAM(4);
    if (IN(5)) norm_rows(F, out + O_YP, out + O_YS, args.in[I_NW] + DM, XN);
    SEAM(5);
    if (IN(6)) GEMM_STORE(XN, W_RIN, 12288, 2048, Z);
    SEAM(6);
    if (IN(7)) r_post(F, Z, RQ, RK);
    SEAM(7);
    if (IN(8)) ret_naive(F, RQ, RK, Z, args.in[I_SR], ORET, out + O_SP, out + O_SS);
    SEAM(8);
    if (IN(9)) r_out(F, ORET, Z, AO_BC);
    SEAM(9);
    if (IN(10)) GEMM_RESID(AO_BC, W_ROUT, 4096, out + O_YP, out + O_YS);
    SEAM(10);
    if (IN(11)) norm_rows(F, out + O_YP, out + O_YS, args.in[I_NW] + 2 * DM, XN);
    SEAM(11);
    if (IN(12)) GEMM_STORE(XN, W_CIN, 12288, 2048, Z);
    SEAM(12);
    if (IN(13)) c_stats(F, Z, args.in[I_CVG], VN, out + O_VM);
    SEAM(13);
    if (IN(14)) c_mix(F, Z, VN, args.in[I_CWS], args.in[I_CBS], AO_BC);
    SEAM(14);
    if (IN(15)) GEMM_RESID(AO_BC, W_COUT, 4096, out + O_YP, out + O_YS);
    SEAM(15);
    if (IN(16)) { norm_rows(F, out + O_YP, out + O_YS, args.in[I_NW] + 3 * DM, XN);
        cache_cvt(F, args.in[I_CK] + (size_t)NB * PAST * DM, args.in[I_CV] + (size_t)NB * PAST * DM, KC, VC); }
    SEAM(16);
    if (IN(17)) GEMM_STORE(XN, W_AIN[1], 8192, 2048, Z);
    SEAM(17);
    if (IN(18)) a_post(F, Z, args.in[I_AQG] + 64, args.in[I_AKG] + 64, Qs, KP, VP, KC, VC, out + O_KP + (size_t)MP * DM, out + O_VP + (size_t)MP * DM, out + O_KS + (size_t)MS * DM, out + O_VS + (size_t)MS * DM);
    SEAM(18);
    if (IN(19)) { const float li = 0.8f - 0.6f * expf(-0.3f * 3.f); const float lam = diff_lambda(args.in[I_LQ1] + 64, args.in[I_LK1] + 64, args.in[I_LQ2] + 64, args.in[I_LK2] + 64, li);
        attn_fast(F, Qs, KP, VP, KC, VC, Z, AO_A, lam, 1.f - li, args.in[I_ASG] + 128); }
    SEAM(19);
    if (IN(20)) GEMM_RESID(AO_A, W_AOUT[1], 2048, out + O_YP, out + O_YS);
#undef IN
#undef SEAM
}

extern "C" void kernel_launch(void* const* d_in, const int* in_sizes, int n_in, void* d_out, int out_size, void* d_ws, size_t ws_size, hipStream_t stream) {
    static int grid = 0;
    if (grid == 0) {
        if (n_in != N_IN || (size_t)out_size != O_END || ws_size < WS_END) { fprintf(stderr, "kernel_launch: unexpected shapes: n_in %d out %d ws %zu (need %zu)\n", n_in, out_size, ws_size, (size_t)WS_END); grid = -1; return; }
        int dev = 0, cus = 0;
        if (hipGetDevice(&dev) != hipSuccess || hipDeviceGetAttribute(&cus, hipDeviceAttributeMultiprocessorCount, dev) != hipSuccess) { grid = -1; return; }
        if (hipFuncSetAttribute((const void*)mega, hipFuncAttributeMaxDynamicSharedMemorySize, LDS_BYTES) != hipSuccess) { fprintf(stderr, "kernel_launch: hipFuncSetAttribute failed\n"); grid = -1; return; }
        (void)hipGetLastError();
        grid = cus;
    }
    if (grid < 0) return;
    Args a{};
    for (int i = 0; i < N_IN; ++i) a.in[i] = (const float*)d_in[i];
    a.out = (float*)d_out; a.ws = (unsigned char*)d_ws;
    (void)hipMemsetAsync((char*)d_ws + WS_CTL, 0, CTL_ZERO_BYTES, stream);
    a.ph_lo = 0; a.ph_hi = N_PHASES;
    hipLaunchKernelGGL(mega, dim3(grid), dim3(NTHR), LDS_BYTES, stream, a);
}
```

```cpp
#include <hip/hip_runtime.h>
#include <cstdio>
#include <cstdint>

namespace pg8 {
#define PG8_LAS __attribute__((address_space(3)))
typedef unsigned short bf16_t;
typedef short bf16x8 __attribute__((ext_vector_type(8)));
typedef float f32x4 __attribute__((ext_vector_type(4)));
typedef unsigned u32x4 __attribute__((ext_vector_type(4)));
constexpr int BM = 256, BK = 64, HALF = 128, HTB = HALF * BK * 2, STAGE_BYTES = 8 * HTB, NXCD = 8, WGM = 8;

__host__ __device__ __forceinline__ int lds_byte(int r, int c) { const int st = (r >> 4) * 2 + (c >> 5), rr = r & 15, cc = c & 31, ob = rr * 64 + cc * 2; return st * 1024 + (ob ^ (((ob >> 9) & 1) << 5)); }
__host__ __device__ __forceinline__ void stage_rc(int b, int& R, int& C) { const int st = b / 1024, sb = b % 1024, swz = sb ^ (((sb >> 9) & 1) << 5); R = (st >> 1) * 16 + swz / 64; C = (st & 1) * 32 + (swz % 64) / 2; }
__host__ __device__ __forceinline__ int perm32(int rho) { const int n = rho >> 4, i = rho & 15; return 8 * (i >> 2) + 4 * n + (i & 3); }

struct Unit { int pm, pn; const char* a; const char* b; };
struct GemmP { int lda, ldb, nt; };

struct StaticOrder {
    int nM, nN, nwg, G, c; const char* A; const char* B; size_t ta, tb;
    __host__ __device__ void init(int nM_, int nN_, int G_, int c_, const void* A_, const void* B_, int lda, int ldb) { nM = nM_; nN = nN_; nwg = nM * nN; G = G_; c = c_; A = (const char*)A_; B = (const char*)B_; ta = (size_t)BM * lda * 2; tb = (size_t)BM * ldb * 2; }
    __host__ __device__ bool next(int i, Unit& u) const {
        const long L = (long)i * G + c; if (L >= nwg) return false;
        int wgid = (int)L; { const int q = nwg / NXCD, r = nwg % NXCD, xcd = wgid % NXCD, off = wgid / NXCD; wgid = (xcd < r ? xcd * (q + 1) : r * (q + 1) + (xcd - r) * q) + off; }
        const int nig = WGM * nN, gid = wgid / nig, fm = gid * WGM, gsz = (nM - fm) < WGM ? (nM - fm) : WGM;
        u.pm = fm + ((wgid % nig) % gsz); u.pn = (wgid % nig) / gsz; u.a = A + (size_t)u.pm * ta; u.b = B + (size_t)u.pn * tb; return true;
    }
    __device__ __forceinline__ void a_ready(const Unit&) const {}
    __device__ __forceinline__ void done(const Unit&) const {}
};

__device__ __forceinline__ unsigned cvt_pk_bf16(float lo, float hi) { unsigned r; asm volatile("v_cvt_pk_bf16_f32 %0, %1, %2" : "=v"(r) : "v"(lo), "v"(hi)); return r; }

struct EpiStoreBf16 {
    static constexpr int BMODE = 1;
    bf16_t* O; int ldc;
    __device__ __forceinline__ void operator()(const f32x4 (&acc)[2][2][4][2], const Unit& u, int wr, int wc, int fr, int fq) const {
        const int row0 = u.pm * BM + wr * 64 + fr; const int col0 = u.pn * BM + wc * 32 + 8 * fq;
#pragma unroll
        for (int ai = 0; ai < 2; ++ai)
#pragma unroll
            for (int m = 0; m < 4; ++m) { bf16_t* rowp = O + (size_t)(row0 + ai * HALF + m * 16) * ldc + col0;
#pragma unroll
                for (int bj = 0; bj < 2; ++bj) { const f32x4 v0 = acc[ai][bj][m][0], v1 = acc[ai][bj][m][1];
                    u32x4 w; w.x = cvt_pk_bf16(v0[0], v0[1]); w.y = cvt_pk_bf16(v0[2], v0[3]); w.z = cvt_pk_bf16(v1[0], v1[1]); w.w = cvt_pk_bf16(v1[2], v1[3]);
                    *(u32x4*)(rowp + bj * HALF) = w; } }
    }
};
struct EpiResid {
    static constexpr int BMODE = 0;
    const float* base_p; const float* base_s; float* out; int split;
    __device__ __forceinline__ void operator()(const f32x4 (&acc)[2][2][4][2], const Unit& u, int wr, int wc, int fr, int fq) const {
        const int col0 = u.pn * BM + wc * 32 + 4 * fq;
#pragma unroll
        for (int ai = 0; ai < 2; ++ai)
#pragma unroll
            for (int m = 0; m < 4; ++m) { const int r = u.pm * BM + ai * HALF + wr * 64 + m * 16 + fr;
                const float* bp = (r < split) ? base_p + (size_t)r * 2048 : base_s + (size_t)(r - split) * 2048; float* op = out + (size_t)r * 2048;
#pragma unroll
                for (int bj = 0; bj < 2; ++bj)
#pragma unroll
                    for (int n = 0; n < 2; ++n) { const int c = col0 + bj * HALF + n * 16; const f32x4 bs = *(const f32x4*)(bp + c); *(f32x4*)(op + c) = bs + acc[ai][bj][m][n]; }
                if (m & 1) asm volatile("" ::: "memory"); }
    }
};

template <class Epi, class Sched, bool ALIGN_EPI = true>
__device__ __forceinline__ void gemm_phase(PG8_LAS unsigned char* lds, const GemmP g, const Sched& S, const Epi& E) {
    const int tid = threadIdx.x, wid = __builtin_amdgcn_readfirstlane(tid >> 6), lane = tid & 63, wr = wid >> 2, wc = wid & 3, fr = lane & 15, fq = lane >> 4;
    const int nt = g.nt;
    unsigned voffA[2], voffB[2];
#pragma unroll
    for (int i = 0; i < 2; ++i) { int R, C; stage_rc(tid * 16 + i * 8192, R, C); const int Rb = Epi::BMODE == 2 ? (64 * (R >> 5) + perm32(R & 31)) : Epi::BMODE == 1 ? ((R & ~31) + perm32(R & 31)) : R;
        voffA[i] = (unsigned)(R * g.lda + C) * 2u; voffB[i] = (unsigned)(Rb * g.ldb + C) * 2u; }
    const size_t kstep = (size_t)(BK * 2);
    const size_t hstepA = (size_t)HALF * g.lda * 2, hstepB = (size_t)(Epi::BMODE == 2 ? 32 : HALF) * g.ldb * 2;
    const unsigned ldsw = (unsigned)wid * 1024u;
    const int aoff = lds_byte(wr * 64 + fr, fq * 8), boff = lds_byte(wc * 32 + fr, fq * 8);
#define PG8_SA(b, h) (((b) * 2 + (h)) * HTB)
#define PG8_SB(b, h) ((4 + (b) * 2 + (h)) * HTB)
#define PG8_STAGE(bufoff, gbase, voff) do { _Pragma("unroll") for (int _i = 0; _i < 2; ++_i) \
        __builtin_amdgcn_global_load_lds((const unsigned*)((const char*)(gbase) + (voff)[_i]), (PG8_LAS unsigned*)(lds + (bufoff) + ldsw + _i * 8192), 16, 0, 0); } while (0)
#define PG8_LDA(dst, b, h) do { _Pragma("unroll") for (int m = 0; m < 4; ++m) _Pragma("unroll") for (int k = 0; k < 2; ++k) dst[m][k] = *(const PG8_LAS bf16x8*)(lds + PG8_SA(b, h) + aoff + m * 2048 + k * 1024); } while (0)
#define PG8_LDB(dst, b, h) do { _Pragma("unroll") for (int n = 0; n < 2; ++n) _Pragma("unroll") for (int k = 0; k < 2; ++k) dst[n][k] = *(const PG8_LAS bf16x8*)(lds + PG8_SB(b, h) + boff + n * 2048 + k * 1024); } while (0)
#define PG8_MMA(ai, bj, At, Bt) do { __builtin_amdgcn_s_setprio(1); _Pragma("unroll") for (int m = 0; m < 4; ++m) _Pragma("unroll") for (int n = 0; n < 2; ++n) _Pragma("unroll") for (int k = 0; k < 2; ++k) \
        acc[ai][bj][m][n] = __builtin_amdgcn_mfma_f32_16x16x32_bf16(Bt[n][k], At[m][k], acc[ai][bj][m][n], 0, 0, 0); __builtin_amdgcn_s_setprio(0); } while (0)
#define PG8_WAIT_V(n) asm volatile("s_waitcnt vmcnt(" #n ")" ::: "memory")
#define PG8_WAIT_L(n) asm volatile("s_waitcnt lgkmcnt(" #n ")" ::: "memory")
#define PG8_BAR __builtin_amdgcn_s_barrier()
#define PG8_SCHED __builtin_amdgcn_sched_barrier(0)
    Unit cur, nxt; int ui = 0;
    if (!S.next(0, cur)) return;
    f32x4 acc[2][2][4][2];
#pragma unroll
    for (int a = 0; a < 2; ++a)
#pragma unroll
        for (int b = 0; b < 2; ++b)
#pragma unroll
            for (int m = 0; m < 4; ++m)
#pragma unroll
                for (int n = 0; n < 2; ++n) acc[a][b][m][n] = (f32x4){0.f, 0.f, 0.f, 0.f};
    bf16x8 At[4][2], B0[2][2], B1[2][2];
    const char* cA = cur.a; const char* cB = cur.b;
    S.a_ready(cur);
    PG8_STAGE(PG8_SB(0, 0), cB, voffB); PG8_STAGE(PG8_SB(0, 1), cB + hstepB, voffB); PG8_STAGE(PG8_SA(0, 0), cA, voffA); PG8_STAGE(PG8_SA(0, 1), cA + hstepA, voffA);
    if (wr == 1) PG8_BAR;
    PG8_WAIT_V(2); PG8_BAR;
    PG8_STAGE(PG8_SB(1, 0), cB + kstep, voffB); PG8_STAGE(PG8_SA(1, 0), cA + kstep, voffA); PG8_STAGE(PG8_SB(1, 1), cB + hstepB + kstep, voffB);
    PG8_WAIT_V(6); PG8_BAR;
    for (;;) {
        const bool has_next = S.next(ui + 1, nxt);
        const char* nA = has_next ? nxt.a : cA; const char* nB = has_next ? nxt.b : cB;
        for (int t = 0; t < nt; t += 2) {
            const bool last = (t == nt - 2);
            const char* a1 = cA + (size_t)(t + 1) * kstep;
            const char* a2 = last ? nA : cA + (size_t)(t + 2) * kstep; const char* b2 = last ? nB : cB + (size_t)(t + 2) * kstep;
            const char* a3 = a2 + kstep; const char* b3 = b2 + kstep;
            if (last && has_next) S.a_ready(nxt);
            PG8_LDB(B0, 0, 0); PG8_LDB(B1, 0, 1); PG8_SCHED; PG8_LDA(At, 0, 0); PG8_STAGE(PG8_SA(1, 1), a1 + hstepA, voffA);
            PG8_WAIT_V(8); PG8_WAIT_L(0); PG8_BAR; PG8_MMA(0, 0, At, B0); PG8_MMA(0, 1, At, B1); PG8_BAR; PG8_SCHED;
            PG8_LDA(At, 0, 1); PG8_STAGE(PG8_SB(0, 0), b2, voffB); PG8_STAGE(PG8_SB(0, 1), b2 + hstepB, voffB); PG8_STAGE(PG8_SA(0, 0), a2, voffA);
            PG8_WAIT_V(8); PG8_WAIT_L(0); PG8_BAR; PG8_MMA(1, 0, At, B0); PG8_MMA(1, 1, At, B1); PG8_BAR; PG8_SCHED;
            PG8_LDB(B0, 1, 0); PG8_LDB(B1, 1, 1); PG8_SCHED; PG8_LDA(At, 1, 0); PG8_STAGE(PG8_SA(0, 1), a2 + hstepA, voffA);
            PG8_WAIT_V(8); PG8_WAIT_L(0); PG8_BAR; PG8_MMA(0, 0, At, B0); PG8_MMA(0, 1, At, B1); PG8_BAR; PG8_SCHED;
            PG8_LDA(At, 1, 1); PG8_STAGE(PG8_SB(1, 0), b3, voffB); PG8_STAGE(PG8_SB(1, 1), b3 + hstepB, voffB); PG8_STAGE(PG8_SA(1, 0), a3, voffA);
            PG8_WAIT_V(8); PG8_WAIT_L(0); PG8_BAR; PG8_MMA(1, 0, At, B0); PG8_MMA(1, 1, At, B1); PG8_BAR; PG8_SCHED;
        }
        if constexpr (ALIGN_EPI) { if (wr == 0) PG8_BAR; }
        E(acc, cur, wr, wc, fr, fq); S.done(cur);
        if (!has_next) break;
#pragma unroll
        for (int a = 0; a < 2; ++a)
#pragma unroll
            for (int b = 0; b < 2; ++b)
#pragma unroll
                for (int m = 0; m < 4; ++m)
#pragma unroll
                    for (int n = 0; n < 2; ++n) acc[a][b][m][n] = (f32x4){0.f, 0.f, 0.f, 0.f};
        cur = nxt; cA = nA; cB = nB; ++ui;
        if constexpr (ALIGN_EPI) { if (wr == 1) PG8_BAR; }
    }
    PG8_WAIT_V(0);
    if constexpr (!ALIGN_EPI) { if (wr == 0) PG8_BAR; }
    PG8_BAR;
#undef PG8_SA
#undef PG8_SB
#undef PG8_STAGE
#undef PG8_LDA
#undef PG8_LDB
#undef PG8_MMA
#undef PG8_WAIT_V
#undef PG8_WAIT_L
#undef PG8_BAR
#undef PG8_SCHED
}
}

constexpr int NWAVES = 8, NTHR = 512;
constexpr int DM = 2048, MP = 16384, MS = 512, MT = MP + MS, PAST = 2048, DECL = 64, NB = 8;
constexpr int KCROWS = PAST + DECL;
constexpr float EPS = 1e-6f;
constexpr float LOG2E = 1.4426950408889634f;
constexpr float C2 = 0.125f * LOG2E;

enum { I_XP = 0, I_XS, I_CK, I_CV, I_SR, I_NW, I_AWIN, I_AWOUT, I_AQG, I_AKG, I_LQ1, I_LK1, I_LQ2, I_LK2, I_ASG, I_RWIN, I_RWOUT, I_CWIN, I_CWOUT, I_CVG, I_CWS, I_CBS, N_IN };
constexpr size_t O_YP = 0, O_YS = O_YP + (size_t)MP * DM, O_KP = O_YS + (size_t)MS * DM, O_VP = O_KP + 2 * (size_t)MP * DM, O_KS = O_VP + 2 * (size_t)MP * DM, O_VS = O_KS + 2 * (size_t)MS * DM,
                 O_SP = O_VS + 2 * (size_t)MS * DM, O_SS = O_SP + (size_t)8 * 256 * 512, O_VM = O_SS + (size_t)NB * 8 * 256 * 512, O_END = O_VM + (size_t)MS * 4096;

constexpr size_t MiB = 1u << 20;
constexpr size_t WS_CTL = 0, CTL_ZERO_BYTES = 1 * MiB;
constexpr size_t WS_WAIN0 = 8 * MiB, WS_WAOUT0 = 40 * MiB, WS_WRIN = 48 * MiB, WS_WROUT = 96 * MiB, WS_WCIN = 112 * MiB, WS_WCOUT = 160 * MiB, WS_WAIN1 = 176 * MiB, WS_WAOUT1 = 208 * MiB;
constexpr size_t WS_XN = 216 * MiB, WS_Z = 282 * MiB;
constexpr size_t WS_QS = 546 * MiB, WS_KP = 612 * MiB, WS_VP = 676 * MiB, WS_KC = 740 * MiB, WS_VC = 806 * MiB, WS_AOA = 872 * MiB;
constexpr size_t WS_KT = 112 * MiB, WS_RG = 282 * MiB, WS_QP = 414 * MiB, WS_KN = 546 * MiB, WS_VS = 612 * MiB, WS_ORET = 900 * MiB;
constexpr size_t WS_GU = 282 * MiB, WS_SG = 414 * MiB, WS_GVT = 546 * MiB, WS_WM = 678 * MiB, WS_SSQ = 744 * MiB, WS_GVS = 752 * MiB;
constexpr size_t WS_GA = 282 * MiB;
constexpr size_t WS_TABR = 1040 * MiB, WS_TABA = 1056 * MiB, WS_END = 1060 * MiB;

#define GAS __attribute__((address_space(1)))
#define LAS __attribute__((address_space(3)))
typedef unsigned short bf16;
typedef unsigned v4u __attribute__((ext_vector_type(4)));
typedef unsigned v2u __attribute__((ext_vector_type(2)));
typedef float f32x4 __attribute__((ext_vector_type(4)));
typedef GAS unsigned gu32;
#define RLX_AGENT __ATOMIC_RELAXED, __HIP_MEMORY_SCOPE_AGENT
#define LDS_WAIT() asm volatile("s_waitcnt lgkmcnt(0)" ::: "memory")
#define VM_WAIT() asm volatile("s_waitcnt vmcnt(0)" ::: "memory")
__device__ __forceinline__ unsigned f2bf(float f) { unsigned u = __builtin_bit_cast(unsigned, f); return (u + 0x7fffu + ((u >> 16) & 1u)) >> 16; }
__device__ __forceinline__ unsigned pk2(float lo, float hi) { return f2bf(lo) | (f2bf(hi) << 16); }
__device__ __forceinline__ float bf2f(unsigned short b) { return __builtin_bit_cast(float, (unsigned)b << 16); }
__device__ __forceinline__ float bflo(unsigned w) { return __builtin_bit_cast(float, w << 16); }
__device__ __forceinline__ float bfhi(unsigned w) { return __builtin_bit_cast(float, w & 0xffff0000u); }
__device__ __forceinline__ float silu_f(float x) { return x / (1.f + __expf(-x)); }
__device__ __forceinline__ float gelu_tanh_f(float x) { const float u = 0.7978845608028654f * (x + 0.044715f * x * x * x); return x / (1.f + __expf(-2.f * u)); }
__device__ __forceinline__ float wave_sum(float v) {
#pragma unroll
    for (int o = 1; o < 64; o <<= 1) v += __shfl_xor(v, o);
    return v;
}
__device__ __forceinline__ void rope_cs(int pos, int i, int nf, float& c, float& s) {
    const float inv = exp2f(-(float)i / (float)nf * 13.287712379549449f);
    const double a = (double)pos * (double)inv * 0.15915494309189535;
    const float r = (float)(a - floor(a));
    c = __builtin_amdgcn_cosf(r); s = __builtin_amdgcn_sinf(r);
}

#define XB_TMO      128
#define XB_XCNT(j)  (256  + 64 * (j))
#define XB_XSUB(j)  (1280 + 64 * (j))
#define XB_XGEN(j)  (2304 + 64 * (j))
#define XB_TOP      3328
#define XB_TOPGEN   3392
#define XCD_BAR_WORDS 3456
#define XB_SPIN_CAP (1u << 22)
__device__ __forceinline__ unsigned xb_ld(unsigned* p)              { return __hip_atomic_load(p, __ATOMIC_RELAXED, __HIP_MEMORY_SCOPE_AGENT); }
__device__ __forceinline__ unsigned xb_add(unsigned* p, unsigned v) { return __hip_atomic_fetch_add(p, v, __ATOMIC_RELAXED, __HIP_MEMORY_SCOPE_AGENT); }
__device__ __forceinline__ unsigned xb_xcc_id() { return (unsigned)__builtin_amdgcn_s_getreg((3 << 11) | 20) & 0xFu; }
#define XB_SPIN(cond, bar) do { unsigned _sp = 0; while (cond) { __builtin_amdgcn_s_sleep(1); \
    if ((++_sp & 255u) == 0u) { if (xb_ld(&(bar)[XB_TMO])) break; if (_sp > XB_SPIN_CAP) { atomicAdd(&(bar)[XB_TMO], 1u); break; } } } } while (0)
struct XcdBarrier { unsigned* bar; unsigned x; volatile LAS unsigned* st; };
__device__ __forceinline__ XcdBarrier xcd_barrier_post(unsigned* bar, volatile LAS unsigned* st) {
    XcdBarrier b; b.bar = bar; b.x = xb_xcc_id(); b.st = st;
    if (threadIdx.x == 0) (void)xb_add(&bar[XB_XCNT(b.x)], 1u);
    return b;
}
__device__ __forceinline__ void xcd_barrier_complete(unsigned* bar, unsigned x, unsigned& nloc, unsigned& nx) {
    const unsigned G = gridDim.x * gridDim.y * gridDim.z;
    unsigned sum, cnt, mine, sp = 0u;
    for (;;) {
        sum = 0u; cnt = 0u; mine = 0u;
#pragma unroll
        for (unsigned j = 0; j < 16; ++j) { const unsigned c = xb_ld(&bar[XB_XCNT(j)]); sum += c; cnt += (c > 0u) ? 1u : 0u; mine = (j == x) ? c : mine; }
        if (sum == G) break;
        __builtin_amdgcn_s_sleep(1);
        if ((++sp & 255u) == 0u) { if (xb_ld(&bar[XB_TMO])) break; if (sp > XB_SPIN_CAP) { atomicAdd(&bar[XB_TMO], 1u); break; } }
    }
    nloc = mine > 0u ? mine : 1u; nx = cnt > 0u ? cnt : 1u;
}
__device__ __forceinline__ void xcd_barrier(const XcdBarrier& b) {
    asm volatile("s_waitcnt vmcnt(0)" ::: "memory");
    __syncthreads();
    if (threadIdx.x == 0) {
        unsigned* bar = b.bar;
        __builtin_amdgcn_s_waitcnt(0);
        unsigned nloc = b.st[0], nx = b.st[1];
        if (nloc == 0u) { xcd_barrier_complete(bar, b.x, nloc, nx); b.st[0] = nloc; b.st[1] = nx; }
        const unsigned old = xb_add(&bar[XB_XSUB(b.x)], 1u);
        const unsigned gen = old / nloc;
        if (old + 1u == (gen + 1u) * nloc) {
            __builtin_amdgcn_fence(__ATOMIC_RELEASE, "agent");
            asm volatile("s_waitcnt vmcnt(0)" ::: "memory");
            const unsigned og = xb_add(&bar[XB_TOP], 1u);
            const unsigned tg = og / nx;
            if (og + 1u == (tg + 1u) * nx) xb_add(&bar[XB_TOPGEN], 1u);
            else XB_SPIN(xb_ld(&bar[XB_TOPGEN]) == tg, bar);
            __builtin_amdgcn_fence(__ATOMIC_ACQUIRE, "agent");
            xb_add(&bar[XB_XGEN(b.x)], 1u);
            asm volatile("s_waitcnt vmcnt(0)" ::: "memory");
        } else {
            XB_SPIN(xb_ld(&bar[XB_XGEN(b.x)]) == gen, bar);
            __builtin_amdgcn_fence(__ATOMIC_ACQUIRE, "agent");
            asm volatile("s_waitcnt vmcnt(0)" ::: "memory");
        }
    }
    __syncthreads();
}

constexpr int RING_OFF = 0, RING_BYTES = 139264;
constexpr int MISC_OFF = RING_BYTES;
constexpr int LDS_BYTES = 147456;
struct Args { const float* in[N_IN]; float* out; unsigned char* ws; int ph_lo, ph_hi; };
struct Frame {
    LAS unsigned char* lds; int tid, lane, wave, G, bid;
    const float* const* in; float* out; unsigned char* ws;
};

__device__ __forceinline__ void p0_transpose_item(const float* W, int K, int N, bf16* WT, LAS float* scr, int item, int lane) {
    const int nblk = N / 32, kb = item / nblk, nb = item % nblk, k0 = 64 * kb, n0 = 32 * nb;
#pragma unroll 8
    for (int i = 0; i < 32; ++i) { const int kk = 2 * i + (lane >> 5); scr[kk * 33 + (lane & 31)] = W[(size_t)(k0 + kk) * N + n0 + (lane & 31)]; }
    LDS_WAIT(); asm volatile("" ::: "memory");
    const int c = lane & 7;
#pragma unroll
    for (int j = 0; j < 4; ++j) { const int n = (lane >> 3) + 8 * j; const LAS float* s = scr + (8 * c) * 33 + n;
        v4u o; o.x = pk2(s[0 * 33], s[1 * 33]); o.y = pk2(s[2 * 33], s[3 * 33]); o.z = pk2(s[4 * 33], s[5 * 33]); o.w = pk2(s[6 * 33], s[7 * 33]);
        *(GAS v4u*)(WT + (size_t)(n0 + n) * K + k0 + 8 * c) = o; }
    LDS_WAIT(); asm volatile("" ::: "memory");
}
__device__ __forceinline__ void transpose_weight(Frame& F, const float* W, int K, int N, bf16* WT) {
    LAS float* scr = (LAS float*)(F.lds + RING_OFF + F.wave * 16384);
    const int gw = F.bid * NWAVES + F.wave, NGW = F.G * NWAVES, nitems = (K / 64) * (N / 32);
    for (int it = gw; it < nitems; it += NGW) p0_transpose_item(W, K, N, WT, scr, it, F.lane);
}
__device__ __forceinline__ void norm_rows(Frame& F, const float* src_p, const float* src_s, const float* w, bf16* XN) {
    const int gw = F.bid * NWAVES + F.wave, NGW = F.G * NWAVES;
    for (int m = gw; m < MT; m += NGW) {
        const float* xrow = (m < MP) ? src_p + (size_t)m * DM : src_s + (size_t)(m - MP) * DM;
        const GAS f32x4* xr = (const GAS f32x4*)xrow + F.lane; const GAS f32x4* wr = (const GAS f32x4*)w + F.lane;
        f32x4 v[8]; float s = 0.f;
#pragma unroll
        for (int j = 0; j < 8; ++j) { v[j] = xr[64 * j]; s += (v[j].x * v[j].x + v[j].y * v[j].y) + (v[j].z * v[j].z + v[j].w * v[j].w); }
        const float rstd = 1.f / sqrtf(wave_sum(s) * (1.f / DM) + EPS);
        GAS v2u* o8 = (GAS v2u*)(XN + (size_t)m * DM) + F.lane;
#pragma unroll
        for (int j = 0; j < 8; ++j) { const f32x4 g = wr[64 * j]; v2u o; o.x = pk2(v[j].x * rstd * g.x, v[j].y * rstd * g.y); o.y = pk2(v[j].z * rstd * g.z, v[j].w * rstd * g.w); o8[64 * j] = o; }
    }
}
__device__ __forceinline__ void cache_cvt(Frame& F, const float* ck, const float* cv, bf16* KC, bf16* VC) {
    const size_t nvec = (size_t)NB * PAST * DM / 4;
    const size_t gt = (size_t)F.bid * NTHR + F.tid, NG = (size_t)F.G * NTHR;
    for (size_t i = gt; i < 2 * nvec; i += NG) {
        const bool isv = i >= nvec; const size_t e = (isv ? i - nvec : i) * 4;
        const size_t brow = e / DM, col = e % DM, b = brow / PAST, t = brow % PAST;
        const f32x4 x = *(const GAS f32x4*)((isv ? cv : ck) + e);
        v2u o; o.x = pk2(x.x, x.y); o.y = pk2(x.z, x.w);
        *(GAS v2u*)((isv ? VC : KC) + ((b * KCROWS + t) * DM + col)) = o;
    }
}
__device__ __forceinline__ int row_pos(int row) { return row < MP ? row : PAST + ((row - MP) & 63); }

struct EpiAIn {
    static constexpr int BMODE = 2;
    pg8::bf16_t *Qs, *KP, *VP, *KC, *VC, *GA; float *okp, *ovp, *oks, *ovs; const float* tab; const float* qg; const float* kg;
    __device__ __forceinline__ void operator()(const pg8::f32x4 (&acc)[2][2][4][2], const pg8::Unit& u, int wr, int wc, int fr, int fq) const {
        asm volatile("" : "+v"(fr), "+v"(fq));
        const int pn = u.pn, pm = u.pm, typ = pn >> 3, cl = ((pn & 7) * 4 + wc) * 64 + 8 * fq;
        float g1[8], g2[8];
        if (typ < 2) { const float* gp = (typ == 0 ? qg : kg) + 8 * fq; const pg8::f32x4 a = *(const pg8::f32x4*)gp, b = *(const pg8::f32x4*)(gp + 4), c = *(const pg8::f32x4*)(gp + 32), d = *(const pg8::f32x4*)(gp + 36);
#pragma unroll
            for (int e = 0; e < 4; ++e) { g1[e] = a[e]; g1[4 + e] = b[e]; g2[e] = c[e]; g2[4 + e] = d[e]; } }
#pragma unroll
        for (int ai = 0; ai < 2; ++ai)
#pragma unroll
            for (int m = 0; m < 4; ++m) {
                const int i = ai * 128 + wr * 64 + m * 16 + fr; const size_t row = (size_t)pm * 256 + i;
                float x1[8], x2[8];
#pragma unroll
                for (int e = 0; e < 4; ++e) { x1[e] = acc[ai][0][m][0][e]; x1[4 + e] = acc[ai][0][m][1][e]; x2[e] = acc[ai][1][m][0][e]; x2[4 + e] = acc[ai][1][m][1][e]; }
                size_t drow; pg8::bf16_t* dk; pg8::bf16_t* dv; float* fk; float* fv;
                if (pm < 64) { drow = row; dk = KP; dv = VP; fk = okp + row * DM; fv = ovp + row * DM; }
                else { const int s_ = (int)(row - MP); drow = (size_t)(s_ >> 6) * KCROWS + PAST + (s_ & 63); dk = KC; dv = VC; fk = oks + (size_t)s_ * DM; fv = ovs + (size_t)s_ * DM; }
                if (typ < 2) {
                    float ss = 0.f;
#pragma unroll
                    for (int k = 0; k < 8; ++k) ss += x1[k] * x1[k] + x2[k] * x2[k];
                    ss += __shfl_xor(ss, 16); ss += __shfl_xor(ss, 32);
                    const float rstd = 1.f / sqrtf(ss * (1.f / 64.f) + EPS);
                    const int pos = pm < 64 ? (int)row : PAST + (i & 63);
                    const float* tp = tab + ((size_t)pos * 32 + 8 * fq) * 2; float o1[8], o2[8];
#pragma unroll
                    for (int q4 = 0; q4 < 4; ++q4) { const pg8::f32x4 t = *(const pg8::f32x4*)(tp + 4 * q4);
#pragma unroll
                        for (int z = 0; z < 2; ++z) { const int k = 2 * q4 + z; const float c = t[2 * z], s = t[2 * z + 1], y1 = x1[k] * rstd * g1[k], y2 = x2[k] * rstd * g2[k]; o1[k] = y1 * c - y2 * s; o2[k] = y2 * c + y1 * s; } }
                    if (typ == 0) { v4u w1, w2;
                        w1.x = pk2(o1[0] * C2, o1[1] * C2); w1.y = pk2(o1[2] * C2, o1[3] * C2); w1.z = pk2(o1[4] * C2, o1[5] * C2); w1.w = pk2(o1[6] * C2, o1[7] * C2);
                        w2.x = pk2(o2[0] * C2, o2[1] * C2); w2.y = pk2(o2[2] * C2, o2[3] * C2); w2.z = pk2(o2[4] * C2, o2[5] * C2); w2.w = pk2(o2[6] * C2, o2[7] * C2);
                        *(v4u*)(Qs + row * DM + cl) = w1; *(v4u*)(Qs + row * DM + cl + 32) = w2;
                    } else { v4u w1, w2;
                        w1.x = pk2(o1[0], o1[1]); w1.y = pk2(o1[2], o1[3]); w1.z = pk2(o1[4], o1[5]); w1.w = pk2(o1[6], o1[7]);
                        w2.x = pk2(o2[0], o2[1]); w2.y = pk2(o2[2], o2[3]); w2.z = pk2(o2[4], o2[5]); w2.w = pk2(o2[6], o2[7]);
                        *(v4u*)(dk + drow * DM + cl) = w1; *(v4u*)(dk + drow * DM + cl + 32) = w2;
                        *(pg8::f32x4*)(fk + cl) = (pg8::f32x4){o1[0], o1[1], o1[2], o1[3]}; *(pg8::f32x4*)(fk + cl + 4) = (pg8::f32x4){o1[4], o1[5], o1[6], o1[7]};
                        *(pg8::f32x4*)(fk + cl + 32) = (pg8::f32x4){o2[0], o2[1], o2[2], o2[3]}; *(pg8::f32x4*)(fk + cl + 36) = (pg8::f32x4){o2[4], o2[5], o2[6], o2[7]}; }
                } else { v4u w1, w2;
                    w1.x = pk2(x1[0], x1[1]); w1.y = pk2(x1[2], x1[3]); w1.z = pk2(x1[4], x1[5]); w1.w = pk2(x1[6], x1[7]);
                    w2.x = pk2(x2[0], x2[1]); w2.y = pk2(x2[2], x2[3]); w2.z = pk2(x2[4], x2[5]); w2.w = pk2(x2[6], x2[7]);
                    if (typ == 2) { *(v4u*)(dv + drow * DM + cl) = w1; *(v4u*)(dv + drow * DM + cl + 32) = w2;
                        *(pg8::f32x4*)(fv + cl) = (pg8::f32x4){x1[0], x1[1], x1[2], x1[3]}; *(pg8::f32x4*)(fv + cl + 4) = (pg8::f32x4){x1[4], x1[5], x1[6], x1[7]};
                        *(pg8::f32x4*)(fv + cl + 32) = (pg8::f32x4){x2[0], x2[1], x2[2], x2[3]}; *(pg8::f32x4*)(fv + cl + 36) = (pg8::f32x4){x2[4], x2[5], x2[6], x2[7]}; }
                    else { *(v4u*)(GA + row * DM + cl) = w1; *(v4u*)(GA + row * DM + cl + 32) = w2; }
                }
                if (m & 1) asm volatile("" ::: "memory");
            }
    }
};
__device__ __forceinline__ void attn_table(Frame& F, float* tab) {
    const size_t gt = (size_t)F.bid * NTHR + F.tid, NG = (size_t)F.G * NTHR;
    for (size_t e = gt; e < (size_t)MP * 32; e += NG) { float c, s; rope_cs((int)(e >> 5), (int)(e & 31), 32, c, s); tab[2 * e] = c; tab[2 * e + 1] = s; }
}
namespace dattn {
typedef short bf16x8 __attribute__((ext_vector_type(8)));
typedef short s16x4 __attribute__((ext_vector_type(4)));
typedef short v4i16_t __attribute__((ext_vector_type(4)));
typedef float f32x16 __attribute__((ext_vector_type(16)));
typedef unsigned u32x4 __attribute__((ext_vector_type(4)));
typedef __attribute__((address_space(3))) const char* lds_cptr;
constexpr int SLOTB = 32768, NSLOT = 3, RINGB = SLOTB * NSLOT, WSF_OFF = RINGB, XCHB = 18432, STP = 144;
__device__ __forceinline__ int crow(int r, int hi) { return (r & 3) + 8 * (r >> 2) + 4 * hi; }
__device__ __forceinline__ void glds16(const void* gsrc, unsigned lds_dst) { unsigned keep;
    asm volatile("s_mov_b32 %0, m0\n\ts_mov_b32 m0, %2\n\ts_nop 0\n\tglobal_load_lds_dwordx4 %1, off\n\ts_mov_b32 m0, %0" : "=&s"(keep) : "v"(gsrc), "s"(lds_dst) : "memory"); }
typedef float f32x2_t __attribute__((ext_vector_type(2))); typedef __bf16 bf16x2_t __attribute__((ext_vector_type(2)));
__device__ __forceinline__ unsigned cvtpk_s(float lo, float hi) { f32x2_t v = {lo, hi}; bf16x2_t b = __builtin_convertvector(v, bf16x2_t); return __builtin_bit_cast(unsigned, b); }
#define DA_WAIT_BAR(N) asm volatile("s_waitcnt vmcnt(" #N ") lgkmcnt(0)\n\ts_barrier" ::: "memory")
__device__ __forceinline__ s16x4 vtr(lds_cptr p) { return __builtin_bit_cast(s16x4, __builtin_amdgcn_ds_read_tr16_b64_v4i16((__attribute__((address_space(3))) v4i16_t*)p)); }
struct Unit { const bf16* Q; const bf16* K; const bf16* V; const bf16* G; bf16* AO; int NT; int full; };

__device__ __forceinline__ void attn_unit(const Unit& u, char* shm, float lam, float one_m_li, const float* sub_gain) {
    const int tid = threadIdx.x, lane = tid & 63, r32 = lane & 31, hi = lane >> 5; const int wid = __builtin_amdgcn_readfirstlane(tid >> 6), s = wid >> 2, g = wid & 3;
    const int NT = u.NT; const int wt = u.full ? (g < 2 ? NT - 1 : NT) : (g < 2 ? NT : 0);
    const unsigned lds0 = (unsigned)(uintptr_t)shm;
    float* wsf = (float*)(shm + WSF_OFF) + wid * 64;
    const bf16* ksrc = u.K + (long)lane * DM + wid * 8;
    const bf16* vsrc = u.V + (long)(16 * (wid & 3) + (lane >> 2)) * DM + (wid >> 2) * 32 + (lane & 3) * 8;
    const unsigned kdst = lds0 + wid * 1024, vdst = lds0 + 16384 + wid * 1024;
#define DA_DMA(t, slot) do { const int tt_ = (t) < NT ? (t) : NT - 1; const bf16* kp_ = ksrc + (long)tt_ * 64 * DM; const bf16* vp_ = vsrc + (long)tt_ * 64 * DM; \
        glds16(kp_, (unsigned)__builtin_amdgcn_readfirstlane(kdst + (slot))); glds16(kp_ + 64, (unsigned)__builtin_amdgcn_readfirstlane(kdst + 8192 + (slot))); \
        glds16(vp_, (unsigned)__builtin_amdgcn_readfirstlane(vdst + (slot))); glds16(vp_ + 64, (unsigned)__builtin_amdgcn_readfirstlane(vdst + 8192 + (slot))); } while (0)
    const lds_cptr shm3 = (lds_cptr)shm;
    const lds_cptr kp0 = shm3 + s * 8192 + hi * 1024 + r32 * 16;
    const lds_cptr vp0 = shm3 + 16384 + ((lane >> 4) & 1) * 32 + (lane & 3) * 8 + (4 * hi + ((lane & 15) >> 2)) * 64;
    DA_DMA(0, 0); DA_DMA(1, SLOTB);
    bf16x8 qr[4];
    { const bf16* Qw = u.Q + (long)(32 * g + r32) * DM + s * 64;
#pragma unroll
      for (int d0 = 0; d0 < 4; ++d0) qr[d0] = (wt > 0) ? *reinterpret_cast<const bf16x8*>(Qw + d0 * 16 + hi * 8) : (bf16x8){0, 0, 0, 0, 0, 0, 0, 0}; }
    f32x16 o[4]; o[0] = f32x16{}; o[1] = f32x16{}; o[2] = f32x16{}; o[3] = f32x16{};
    float l_reg = 0.f;
    int sl = 0, sl2 = 2 * SLOTB;
    for (int t = 0; t < NT; ++t) {
        DA_WAIT_BAR(4);
        DA_DMA(t + 2, sl2);
        if (t < wt) {
            const lds_cptr kp = kp0 + sl; const lds_cptr vp = vp0 + sl;
            f32x16 C0, C1;
            { bf16x8 kf[8];
#pragma unroll
              for (int j = 0; j < 4; ++j) { kf[2 * j] = *(const __attribute__((address_space(3))) bf16x8*)(kp + j * 2048); kf[2 * j + 1] = *(const __attribute__((address_space(3))) bf16x8*)(kp + j * 2048 + 512); }
              const f32x16 z = f32x16{};
              C0 = __builtin_amdgcn_mfma_f32_32x32x16_bf16(kf[0], qr[0], z, 0, 0, 0); C1 = __builtin_amdgcn_mfma_f32_32x32x16_bf16(kf[1], qr[0], z, 0, 0, 0);
#pragma unroll
              for (int j = 1; j < 4; ++j) { C0 = __builtin_amdgcn_mfma_f32_32x32x16_bf16(kf[2 * j], qr[j], C0, 0, 0, 0); C1 = __builtin_amdgcn_mfma_f32_32x32x16_bf16(kf[2 * j + 1], qr[j], C1, 0, 0, 0); } }
            float sa = 0.f, sb = 0.f;
#pragma unroll
            for (int r = 0; r < 16; ++r) { C0[r] = __builtin_amdgcn_exp2f(C0[r]); C1[r] = __builtin_amdgcn_exp2f(C1[r]); sa += C0[r]; sb += C1[r]; }
            l_reg += sa + sb;
            u32x4 pw[4];
#pragma unroll
            for (int k = 0; k < 4; ++k) { pw[0][k] = cvtpk_s(C0[2 * k], C0[2 * k + 1]); pw[1][k] = cvtpk_s(C0[8 + 2 * k], C0[8 + 2 * k + 1]); pw[2][k] = cvtpk_s(C1[2 * k], C1[2 * k + 1]); pw[3][k] = cvtpk_s(C1[8 + 2 * k], C1[8 + 2 * k + 1]); }
#pragma unroll
            for (int db = 0; db < 4; ++db)
#pragma unroll
                for (int ks = 0; ks < 4; ++ks) { const s16x4 lo = vtr(vp + db * 4096 + ks * 1024), hh = vtr(vp + db * 4096 + ks * 1024 + 512);
                    const bf16x8 vf = (bf16x8){lo[0], lo[1], lo[2], lo[3], hh[0], hh[1], hh[2], hh[3]};
                    o[db] = __builtin_amdgcn_mfma_f32_32x32x16_bf16(__builtin_bit_cast(bf16x8, pw[ks]), vf, o[db], 0, 0, 0); }
        }
        sl = (sl == (NSLOT - 1) * SLOTB) ? 0 : sl + SLOTB; sl2 = (sl2 == (NSLOT - 1) * SLOTB) ? 0 : sl2 + SLOTB;
    }
    { auto rr = __builtin_amdgcn_permlane32_swap(__float_as_uint(l_reg), __float_as_uint(l_reg), false, false); l_reg = __uint_as_float(rr[0]) + __uint_as_float(rr[1]); }
    if (hi == 0) wsf[r32] = l_reg;
    DA_WAIT_BAR(0);
    float rli[16];
#pragma unroll
    for (int r = 0; r < 16; ++r) { const float lq = wsf[crow(r, hi)]; rli[r] = (s == 0 ? 1.f : -lam) / lq; }
    float* xch = (float*)(shm + g * XCHB);
    if (s == 1 && wt > 0) {
#pragma unroll
        for (int db = 0; db < 4; ++db)
#pragma unroll
            for (int r = 0; r < 16; ++r) xch[(db * 16 + r) * 64 + lane] = o[db][r] * rli[r];
    }
    DA_WAIT_BAR(0);
    if (s == 0 && wt > 0) {
#pragma unroll
        for (int db = 0; db < 4; ++db)
#pragma unroll
            for (int r = 0; r < 16; ++r) o[db][r] = o[db][r] * rli[r] + xch[(db * 16 + r) * 64 + lane];
        asm volatile("s_waitcnt lgkmcnt(0)" ::: "memory");
#pragma unroll
        for (int db = 0; db < 4; ++db)
#pragma unroll
            for (int r = 0; r < 16; ++r) xch[crow(r, hi) * STP + 32 * db + r32] = o[db][r];
        asm volatile("s_waitcnt lgkmcnt(0)" ::: "memory");
        const int row = lane >> 1, half = lane & 1;
        float v[64]; float ss = 0.f;
#pragma unroll
        for (int k = 0; k < 16; ++k) { const f32x4 x = *(const f32x4*)(xch + row * STP + half * 64 + 4 * k); v[4 * k] = x.x; v[4 * k + 1] = x.y; v[4 * k + 2] = x.z; v[4 * k + 3] = x.w; ss += (x.x * x.x + x.y * x.y) + (x.z * x.z + x.w * x.w); }
        ss += __shfl_xor(ss, 1);
        const float sc = one_m_li / sqrtf(ss * (1.f / 128.f) + EPS);
        const bf16* gp = u.G + (long)(32 * g + row) * DM + half * 64; bf16* op = u.AO + (long)(32 * g + row) * DM + half * 64; const float* sg = sub_gain + half * 64;
#pragma unroll
        for (int k = 0; k < 8; ++k) { const v4u g4 = *(const v4u*)(gp + 8 * k); const f32x4 ga = *(const f32x4*)(sg + 8 * k), gb = *(const f32x4*)(sg + 8 * k + 4);
            const float gg[8] = {bflo(g4.x), bfhi(g4.x), bflo(g4.y), bfhi(g4.y), bflo(g4.z), bfhi(g4.z), bflo(g4.w), bfhi(g4.w)};
            const float gn[8] = {ga.x, ga.y, ga.z, ga.w, gb.x, gb.y, gb.z, gb.w}; float y[8];
#pragma unroll
            for (int e = 0; e < 8; ++e) y[e] = v[8 * k + e] * sc * gn[e] * silu_f(gg[e]);
            v4u w; w.x = pk2(y[0], y[1]); w.y = pk2(y[2], y[3]); w.z = pk2(y[4], y[5]); w.w = pk2(y[6], y[7]);
            *(v4u*)(op + 8 * k) = w; }
    }
    DA_WAIT_BAR(0);
#undef DA_DMA
}
}
__device__ __forceinline__ void attn_fast(Frame& F, const bf16* Qs, const bf16* KP, const bf16* VP, const bf16* KC, const bf16* VC, const bf16* GA  , bf16* AO,
                                          float lam, float one_m_li, const float* sub_gain) {
    const int NU = 2048 + 16 * NB;
    for (int i = 0;; ++i) {
        const int idx = i * F.G + ((i & 1) ? F.G - 1 - F.bid : F.bid); if (idx >= NU) break;
        dattn::Unit u;
        if (idx < 2048) { const int qb = 127 - (idx >> 4), h = idx & 15; const long row0 = 128L * qb;
            u.Q = Qs + row0 * DM + h * 128; u.K = KP + h * 128; u.V = VP + h * 128; u.G = GA + row0 * DM + h * 128; u.AO = AO + row0 * DM + h * 128; u.NT = 2 * qb + 2; u.full = 1; }
        else { const int j = idx - 2048, b = j >> 4, h = j & 15; const long row0 = MP + 64L * b;
            u.Q = Qs + row0 * DM + h * 128; u.K = KC + (long)b * KCROWS * DM + h * 128; u.V = VC + (long)b * KCROWS * DM + h * 128; u.G = GA + row0 * DM + h * 128; u.AO = AO + row0 * DM + h * 128; u.NT = KCROWS / 64; u.full = 0; }
        dattn::attn_unit(u, (char*)F.lds + RING_OFF, lam, one_m_li, sub_gain);
    }
}
constexpr int RBLK = 72;
__device__ __forceinline__ float ret_lg2(int h) { return log2f(1.f - exp2f(-5.f - (float)h)); }
struct EpiRet {
    static constexpr int BMODE = 0;
    pg8::bf16_t* QP; pg8::bf16_t* KN; pg8::bf16_t* KT; pg8::bf16_t* VS; pg8::bf16_t* RG; const float* tab;
    __device__ __forceinline__ void operator()(const pg8::f32x4 (&acc)[2][2][4][2], const pg8::Unit& u, int wr, int wc, int fr, int fq) const {
        asm volatile("" : "+v"(fr), "+v"(fq));
        const int pn = u.pn, pm = u.pm;
#pragma unroll
        for (int ai = 0; ai < 2; ++ai)
#pragma unroll
            for (int m = 0; m < 4; ++m) {
                const int i = ai * 128 + wr * 64 + m * 16 + fr; const size_t row = (size_t)pm * 256 + i;
                const int J = pm < 64 ? pm : 64 + 4 * (pm - 64) + (i >> 6), jj = pm < 64 ? i : (i & 63), pos = pm < 64 ? (int)row : PAST + (i & 63);
                if (pn < 16) {
                    const int h = pn & 7; const bool isk = pn >= 8; const float sc = isk ? 0.0625f : 1.f;
#pragma unroll
                    for (int n = 0; n < 2; ++n) { const int c1 = wc * 32 + n * 16 + 4 * fq;
                        const pg8::f32x4 t0 = *(const pg8::f32x4*)(tab + ((size_t)pos * 128 + c1) * 2), t1 = *(const pg8::f32x4*)(tab + ((size_t)pos * 128 + c1) * 2 + 4);
                        const pg8::f32x4 x1 = acc[ai][0][m][n], x2 = acc[ai][1][m][n];
                        const float cs[4] = {t0[0], t0[2], t1[0], t1[2]}, sn[4] = {t0[1], t0[3], t1[1], t1[3]}; float o1[4], o2[4];
#pragma unroll
                        for (int e = 0; e < 4; ++e) { o1[e] = (x1[e] * cs[e] - x2[e] * sn[e]) * sc; o2[e] = (x2[e] * cs[e] + x1[e] * sn[e]) * sc; }
                        v2u w1, w2; w1.x = pk2(o1[0], o1[1]); w1.y = pk2(o1[2], o1[3]); w2.x = pk2(o2[0], o2[1]); w2.y = pk2(o2[2], o2[3]);
                        if (!isk) { pg8::bf16_t* p = QP + row * 4096 + h * 512 + 256 + c1; *(v2u*)p = w1; *(v2u*)(p + 128) = w2; }
                        else { pg8::bf16_t* p = KN + row * 2048 + h * 256 + c1; *(v2u*)p = w1; *(v2u*)(p + 128) = w2;
                            pg8::bf16_t* t = KT + ((size_t)(J * 8 + h) * 256 + c1) * 256 + jj;
#pragma unroll
                            for (int e = 0; e < 4; ++e) { t[(size_t)e * 256] = (pg8::bf16_t)f2bf(o1[e]); t[(size_t)(128 + e) * 256] = (pg8::bf16_t)f2bf(o2[e]); } } }
                } else if (pn < 32) {
                    const int h = (pn - 16) >> 1, half = (pn - 16) & 1; const float f = exp2f(-(float)(1 + jj) * ret_lg2(h));
#pragma unroll
                    for (int bj = 0; bj < 2; ++bj)
#pragma unroll
                        for (int n = 0; n < 2; ++n) { const int dv = half * 256 + bj * 128 + wc * 32 + n * 16 + 4 * fq; pg8::bf16_t* t = VS + ((size_t)(J * 8 + h) * 512 + dv) * 512 + jj;
#pragma unroll
                            for (int e = 0; e < 4; ++e) t[(size_t)e * 512] = (pg8::bf16_t)f2bf(acc[ai][bj][m][n][e] * f); }
                } else {
#pragma unroll
                    for (int bj = 0; bj < 2; ++bj)
#pragma unroll
                        for (int n = 0; n < 2; ++n) { const int c = (pn - 32) * 256 + bj * 128 + wc * 32 + n * 16 + 4 * fq; const pg8::f32x4 x = acc[ai][bj][m][n];
                            v2u w; w.x = pk2(x[0], x[1]); w.y = pk2(x[2], x[3]); *(v2u*)(RG + row * 4096 + c) = w; }
                }
            }
    }
};
__device__ __forceinline__ size_t ret_row0(int J) { return J < 64 ? (size_t)256 * J : (size_t)MP + 64 * (J - 64); }
struct RetQKOrder {
    int G, c; const char* QP; const char* KN;
    __device__ __forceinline__ bool next(int i, pg8::Unit& u) const { const int L = i * G + c; if (L >= RBLK * 8) return false; const int J = L >> 3, h = L & 7; const size_t r0 = ret_row0(J);
        u.pm = J; u.pn = h; u.a = QP + (r0 * 4096 + h * 512 + 256) * 2; u.b = KN + (r0 * 2048 + h * 256) * 2; return true; }
    __device__ __forceinline__ void a_ready(const pg8::Unit&) const {}
    __device__ __forceinline__ void done(const pg8::Unit&) const {}
};
struct EpiRetQK {
    static constexpr int BMODE = 1;
    pg8::bf16_t* QP;
    __device__ __forceinline__ void operator()(const pg8::f32x4 (&acc)[2][2][4][2], const pg8::Unit& u, int wr, int wc, int fr, int fq) const {
        asm volatile("" : "+v"(fr), "+v"(fq));
        const int J = u.pm, h = u.pn, nv = J < 64 ? 256 : 64; const size_t r0 = ret_row0(J);
#pragma unroll
        for (int ai = 0; ai < 2; ++ai)
#pragma unroll
            for (int m = 0; m < 4; ++m) { const int i = ai * 128 + wr * 64 + m * 16 + fr;
                if (i < nv) {
#pragma unroll
                    for (int bj = 0; bj < 2; ++bj) { const int j0 = bj * 128 + wc * 32 + 8 * fq; const pg8::f32x4 v0 = acc[ai][bj][m][0], v1 = acc[ai][bj][m][1]; float x[8] = {v0[0], v0[1], v0[2], v0[3], v1[0], v1[1], v1[2], v1[3]};
#pragma unroll
                        for (int k = 0; k < 8; ++k) x[k] = (j0 + k <= i) ? x[k] : 0.f;
                        v4u w; w.x = pk2(x[0], x[1]); w.y = pk2(x[2], x[3]); w.z = pk2(x[4], x[5]); w.w = pk2(x[6], x[7]);
                        *(v4u*)(QP + (r0 + i) * 4096 + h * 512 + j0) = w; } } }
    }
};
struct RetOOrder {
    int G, c; const char* QP; const char* VS;
    __device__ __forceinline__ bool next(int i, pg8::Unit& u) const { const int L = i * G + c; if (L >= RBLK * 16) return false; const int J = L >> 4, r = L & 15, h = r >> 1, half = r & 1; const size_t r0 = ret_row0(J);
        u.pm = J; u.pn = r; u.a = QP + (r0 * 4096 + h * 512) * 2; u.b = VS + (((size_t)(J * 8 + h) * 512 + half * 256) * 512) * 2; return true; }
    __device__ __forceinline__ void a_ready(const pg8::Unit&) const {}
    __device__ __forceinline__ void done(const pg8::Unit&) const {}
};
struct EpiRetO {
    static constexpr int BMODE = 1;
    pg8::bf16_t* O;
    __device__ __forceinline__ void operator()(const pg8::f32x4 (&acc)[2][2][4][2], const pg8::Unit& u, int wr, int wc, int fr, int fq) const {
        asm volatile("" : "+v"(fr), "+v"(fq));
        const int J = u.pm, h = u.pn >> 1, half = u.pn & 1, nv = J < 64 ? 256 : 64; const size_t r0 = ret_row0(J); const float lg = ret_lg2(h);
#pragma unroll
        for (int ai = 0; ai < 2; ++ai)
#pragma unroll
            for (int m = 0; m < 4; ++m) { const int i = ai * 128 + wr * 64 + m * 16 + fr;
                if (i < nv) { const float f = exp2f((float)(i + 1) * lg);
#pragma unroll
                    for (int bj = 0; bj < 2; ++bj) { const int j0 = bj * 128 + wc * 32 + 8 * fq; const pg8::f32x4 v0 = acc[ai][bj][m][0] * f, v1 = acc[ai][bj][m][1] * f;
                        v4u w; w.x = pk2(v0[0], v0[1]); w.y = pk2(v0[2], v0[3]); w.z = pk2(v1[0], v1[1]); w.w = pk2(v1[2], v1[3]);
                        *(v4u*)(O + (r0 + i) * 4096 + h * 512 + half * 256 + j0) = w; } } }
    }
};
__device__ __forceinline__ void ret_scan(Frame& F, const bf16* KT, bf16* VS, const float* state_in, float* osp, float* oss) {
    typedef short bf16x8 __attribute__((ext_vector_type(8)));
    const int lane = F.lane, j = lane & 15, kg = lane >> 4, w = F.wave;
    for (int it = F.bid; it < 256; it += F.G) {
        const int h = it >> 5, dv0 = (it & 31) * 16, dk0 = w * 32; const float lg = ret_lg2(h), g256 = exp2f(256.f * lg), g64 = exp2f(64.f * lg);
        f32x4 acc[2]; acc[0] = (f32x4){0.f, 0.f, 0.f, 0.f}; acc[1] = acc[0];
        for (int J = 0; J < RBLK; ++J) {
            const size_t bh = (size_t)(J * 8 + h);
            if (J >= 64) { const float* si = state_in + ((size_t)(J - 64) * 8 + h) * 256 * 512;
#pragma unroll
                for (int nt = 0; nt < 2; ++nt)
#pragma unroll
                    for (int e = 0; e < 4; ++e) acc[nt][e] = si[(size_t)(dk0 + 16 * nt + j) * 512 + dv0 + 4 * kg + e]; }
#pragma unroll
            for (int nt = 0; nt < 2; ++nt)
#pragma unroll
                for (int e = 0; e < 4; ++e) VS[(bh * 512 + dv0 + 4 * kg + e) * 512 + 256 + dk0 + 16 * nt + j] = (bf16)f2bf(acc[nt][e]);
            const int nks = J < 64 ? 8 : 2;
            const bf16* xp = VS + (bh * 512 + dv0 + j) * 512 + 8 * kg; const bf16* yp = KT + (bh * 256 + dk0 + j) * 256 + 8 * kg;
            if (J < 64) {
                bf16x8 x[8], y0[8], y1[8];
#pragma unroll
                for (int ks = 0; ks < 8; ++ks) { x[ks] = *(const bf16x8*)(xp + ks * 32); y0[ks] = *(const bf16x8*)(yp + ks * 32); y1[ks] = *(const bf16x8*)(yp + 16 * 256 + ks * 32); }
#pragma unroll
                for (int ks = 0; ks < 8; ++ks) { acc[0] = __builtin_amdgcn_mfma_f32_16x16x32_bf16(x[ks], y0[ks], acc[0], 0, 0, 0); acc[1] = __builtin_amdgcn_mfma_f32_16x16x32_bf16(x[ks], y1[ks], acc[1], 0, 0, 0); }
                acc[0] = acc[0] * g256; acc[1] = acc[1] * g256;
                if (J == 63) {
#pragma unroll
                    for (int nt = 0; nt < 2; ++nt)
#pragma unroll
                        for (int e = 0; e < 4; ++e) osp[((size_t)h * 256 + dk0 + 16 * nt + j) * 512 + dv0 + 4 * kg + e] = acc[nt][e]; }
            } else {
                (void)nks;
#pragma unroll
                for (int ks = 0; ks < 2; ++ks) { const bf16x8 x = *(const bf16x8*)(xp + ks * 32), y0 = *(const bf16x8*)(yp + ks * 32), y1 = *(const bf16x8*)(yp + 16 * 256 + ks * 32);
                    acc[0] = __builtin_amdgcn_mfma_f32_16x16x32_bf16(x, y0, acc[0], 0, 0, 0); acc[1] = __builtin_amdgcn_mfma_f32_16x16x32_bf16(x, y1, acc[1], 0, 0, 0); }
                float* so = oss + ((size_t)(J - 64) * 8 + h) * 256 * 512;
#pragma unroll
                for (int nt = 0; nt < 2; ++nt)
#pragma unroll
                    for (int e = 0; e < 4; ++e) so[(size_t)(dk0 + 16 * nt + j) * 512 + dv0 + 4 * kg + e] = acc[nt][e] * g64;
            }
        }
    }
}
__device__ __forceinline__ void ret_zero_pad(Frame& F, bf16* VS) {
    const size_t gt = (size_t)F.bid * NTHR + F.tid, NG = (size_t)F.G * NTHR, n = (size_t)NB * 8 * 512 * 24;
    for (size_t i = gt; i < n; i += NG) { const size_t rowi = i / 24, c = i % 24; *(v4u*)(VS + ((size_t)64 * 8 * 512 + rowi) * 512 + 64 + c * 8) = (v4u){0u, 0u, 0u, 0u}; }
}
__device__ __forceinline__ void ret_table(Frame& F, float* tab) {
    const size_t gt = (size_t)F.bid * NTHR + F.tid, NG = (size_t)F.G * NTHR;
    for (size_t e = gt; e < (size_t)MP * 128; e += NG) { float c, s; rope_cs((int)(e >> 7), (int)(e & 127), 128, c, s); tab[2 * e] = c; tab[2 * e + 1] = s; }
}
__device__ __forceinline__ void r_out(Frame& F, bf16* O, const bf16* RG) {
    const int gw = F.bid * NWAVES + F.wave, NGW = F.G * NWAVES, lane = F.lane;
    for (int it = gw; it < MT * 8; it += NGW) {
        const int row = it >> 3, h = it & 7; const size_t off = (size_t)row * 4096 + h * 512 + lane * 8;
        const v4u o4 = *(const v4u*)(O + off), g4 = *(const v4u*)(RG + off);
        float o[8] = {bflo(o4.x), bfhi(o4.x), bflo(o4.y), bfhi(o4.y), bflo(o4.z), bfhi(o4.z), bflo(o4.w), bfhi(o4.w)};
        const float g[8] = {bflo(g4.x), bfhi(g4.x), bflo(g4.y), bfhi(g4.y), bflo(g4.z), bfhi(g4.z), bflo(g4.w), bfhi(g4.w)};
        float ss = 0.f;
#pragma unroll
        for (int k = 0; k < 8; ++k) ss += o[k] * o[k];
        const float rstd = 1.f / sqrtf(wave_sum(ss) * (1.f / 512.f) + EPS);
#pragma unroll
        for (int k = 0; k < 8; ++k) o[k] = o[k] * rstd * silu_f(g[k]);
        v4u w; w.x = pk2(o[0], o[1]); w.y = pk2(o[2], o[3]); w.z = pk2(o[4], o[5]); w.w = pk2(o[6], o[7]);
        *(v4u*)(O + off) = w;
    }
}
struct EpiCIn {
    static constexpr int BMODE = 0;
    pg8::bf16_t* GU; pg8::bf16_t* GVT; pg8::bf16_t* SG; pg8::bf16_t* GVS; float* SSQ;
    __device__ __forceinline__ void operator()(const pg8::f32x4 (&acc)[2][2][4][2], const pg8::Unit& u, int wr, int wc, int fr, int fq) const {
        asm volatile("" : "+v"(fr), "+v"(fq));
        const int pn = u.pn, pm = u.pm, typ = pn >> 4, pt = pn & 15;
#pragma unroll
        for (int ai = 0; ai < 2; ++ai)
#pragma unroll
            for (int m = 0; m < 4; ++m) {
                const int i = ai * 128 + wr * 64 + m * 16 + fr; const size_t row = (size_t)pm * 256 + i; float ss = 0.f;
#pragma unroll
                for (int bj = 0; bj < 2; ++bj)
#pragma unroll
                    for (int n = 0; n < 2; ++n) { const int c = pt * 256 + bj * 128 + wc * 32 + n * 16 + 4 * fq; const pg8::f32x4 x = acc[ai][bj][m][n]; float y[4];
                        if (typ == 2) {
#pragma unroll
                            for (int e = 0; e < 4; ++e) y[e] = silu_f(x[e]);
                            v2u w; w.x = pk2(y[0], y[1]); w.y = pk2(y[2], y[3]); *(v2u*)(SG + row * 4096 + c) = w;
                        } else {
#pragma unroll
                            for (int e = 0; e < 4; ++e) y[e] = gelu_tanh_f(x[e]);
                            v2u w; w.x = pk2(y[0], y[1]); w.y = pk2(y[2], y[3]);
                            if (typ == 0) *(v2u*)(GU + row * 4096 + c) = w;
                            else { ss += (y[0] * y[0] + y[1] * y[1]) + (y[2] * y[2] + y[3] * y[3]);
                                pg8::bf16_t* t = GVT + ((size_t)pm * 4096 + c) * 256 + i;
                                t[0] = (pg8::bf16_t)(w.x & 0xffffu); t[256] = (pg8::bf16_t)(w.x >> 16); t[512] = (pg8::bf16_t)(w.y & 0xffffu); t[768] = (pg8::bf16_t)(w.y >> 16);
                                if (pm >= 64) *(v2u*)(GVS + (row - MP) * 4096 + c) = w; } } }
                if (typ == 1) { ss += __shfl_xor(ss, 16); ss += __shfl_xor(ss, 32); if (fq == 0) SSQ[row * 64 + pt * 4 + wc] = ss; }
                if (m & 1) asm volatile("" ::: "memory");
            }
    }
};
__device__ __forceinline__ void c_prep(Frame& F, const float* SSQ, const float* wsin, const float* vgain, const bf16* GVS, bf16* Wm, float* ovm) {
    LAS float* rs = (LAS float*)(F.lds + RING_OFF);
    const int tid = F.tid;
    for (int it = F.bid; it < 66 * 8; it += F.G) {
        const int J = it >> 3, g = it & 7; const int cl = J < 64 ? 128 : 64;
        __syncthreads();
        if (tid < 256) { const float* p = SSQ + ((size_t)J * 256 + tid) * 64; float s = 0.f;
#pragma unroll
            for (int k = 0; k < 16; ++k) { const f32x4 x = *(const f32x4*)(p + 4 * k); s += (x.x + x.y) + (x.z + x.w); }
            rs[tid] = 1.f / sqrtf(s * (1.f / 4096.f) + EPS); }
        __syncthreads();
        bf16* wm = Wm + (size_t)(J * 8 + g) * 65536;
        for (int e8 = tid; e8 < 8192; e8 += NTHR) { const int i = e8 >> 5, j0 = (e8 & 31) * 8; float y[8];
#pragma unroll
            for (int k = 0; k < 8; ++k) { const int j = j0 + k; const bool on = (i / cl == j / cl) && (j % cl <= i % cl);
                y[k] = on ? wsin[((size_t)g * 128 + (i % cl)) * 128 + (j % cl)] * rs[j] : 0.f; }
            v4u w; w.x = pk2(y[0], y[1]); w.y = pk2(y[2], y[3]); w.z = pk2(y[4], y[5]); w.w = pk2(y[6], y[7]);
            *(v4u*)(wm + i * 256 + j0) = w; }
    }
    const int gw = F.bid * NWAVES + F.wave, NGW = F.G * NWAVES, lane = F.lane;
    for (int r = gw; r < MS; r += NGW) {
        const float rstd = 1.f / sqrtf(wave_sum(SSQ[((size_t)MP + r) * 64 + lane]) * (1.f / 4096.f) + EPS);
#pragma unroll
        for (int k = 0; k < 8; ++k) { const int col = k * 512 + lane * 8; const v4u v4 = *(const v4u*)(GVS + (size_t)r * 4096 + col);
            const f32x4 ga = *(const f32x4*)(vgain + col), gb = *(const f32x4*)(vgain + col + 4);
            float* o = ovm + (size_t)r * 4096 + col;
            *(f32x4*)o = (f32x4){bflo(v4.x) * rstd * ga.x, bfhi(v4.x) * rstd * ga.y, bflo(v4.y) * rstd * ga.z, bfhi(v4.y) * rstd * ga.w};
            *(f32x4*)(o + 4) = (f32x4){bflo(v4.z) * rstd * gb.x, bfhi(v4.z) * rstd * gb.y, bflo(v4.w) * rstd * gb.z, bfhi(v4.w) * rstd * gb.w}; }
    }
}
struct CMixOrder {
    int G, c; const char* Wm; const char* GVT;
    __device__ __forceinline__ bool next(int i, pg8::Unit& u) const { const int L = i * G + c; if (L >= 66 * 16) return false; const int J = L >> 4, nt = L & 15;
        u.pm = J; u.pn = nt; u.a = Wm + ((size_t)(J * 8 + (nt >> 1)) * 65536) * 2; u.b = GVT + (((size_t)J * 4096 + nt * 256) * 256) * 2; return true; }
    __device__ __forceinline__ void a_ready(const pg8::Unit&) const {}
    __device__ __forceinline__ void done(const pg8::Unit&) const {}
};
struct EpiCMix {
    static constexpr int BMODE = 1;
    pg8::bf16_t* GU; const pg8::bf16_t* SG; const float* vgain; const float* bs;
    __device__ __forceinline__ void operator()(const pg8::f32x4 (&acc)[2][2][4][2], const pg8::Unit& u, int wr, int wc, int fr, int fq) const {
        asm volatile("" : "+v"(fr), "+v"(fq));
        const int J = u.pm, nt = u.pn, g = nt >> 1, cm = J < 64 ? 127 : 63;
#pragma unroll
        for (int bj = 0; bj < 2; ++bj) { const int c0 = nt * 256 + bj * 128 + wc * 32 + 8 * fq; const f32x4 ga = *(const f32x4*)(vgain + c0), gb = *(const f32x4*)(vgain + c0 + 4);
            const float gn[8] = {ga.x, ga.y, ga.z, ga.w, gb.x, gb.y, gb.z, gb.w};
#pragma unroll
            for (int ai = 0; ai < 2; ++ai)
#pragma unroll
                for (int m = 0; m < 4; ++m) { const int i = ai * 128 + wr * 64 + m * 16 + fr; const size_t off = ((size_t)J * 256 + i) * 4096 + c0; const float b = bs[g * 128 + (i & cm)];
                    const v4u u4 = *(const v4u*)(GU + off), s4 = *(const v4u*)(SG + off); const pg8::f32x4 v0 = acc[ai][bj][m][0], v1 = acc[ai][bj][m][1];
                    const float mx[8] = {v0[0], v0[1], v0[2], v0[3], v1[0], v1[1], v1[2], v1[3]};
                    const float uu[8] = {bflo(u4.x), bfhi(u4.x), bflo(u4.y), bfhi(u4.y), bflo(u4.z), bfhi(u4.z), bflo(u4.w), bfhi(u4.w)};
                    const float sg[8] = {bflo(s4.x), bfhi(s4.x), bflo(s4.y), bfhi(s4.y), bflo(s4.z), bfhi(s4.z), bflo(s4.w), bfhi(s4.w)}; float y[8];
#pragma unroll
                    for (int k = 0; k < 8; ++k) y[k] = uu[k] * (mx[k] * gn[k] + b) * sg[k];
                    v4u w; w.x = pk2(y[0], y[1]); w.y = pk2(y[2], y[3]); w.z = pk2(y[4], y[5]); w.w = pk2(y[6], y[7]);
                    *(v4u*)(GU + off) = w; } }
    }
};
__device__ __forceinline__ float diff_lambda(const float* q1, const float* k1, const float* q2, const float* k2, float lam_init) {
    float a = 0.f, b = 0.f;
    for (int i = 0; i < 64; ++i) { a += q1[i] * k1[i]; b += q2[i] * k2[i]; }
    return expf(a) - expf(b) + lam_init;
}

constexpr int N_PHASES = 21;
__global__ void __launch_bounds__(NTHR, 2) mega(Args args) {
    extern __shared__ __attribute__((aligned(16))) unsigned char lds[];
    Frame F;
    F.lds = (LAS unsigned char*)lds; F.tid = threadIdx.x; F.lane = F.tid & 63; F.wave = __builtin_amdgcn_readfirstlane(F.tid >> 6); F.G = gridDim.x; F.bid = blockIdx.x;
    F.in = args.in; F.out = args.out; F.ws = args.ws;
    unsigned char* ws = args.ws; float* out = args.out;
    bf16* W_AIN[2] = {(bf16*)(ws + WS_WAIN0), (bf16*)(ws + WS_WAIN1)}; bf16* W_AOUT[2] = {(bf16*)(ws + WS_WAOUT0), (bf16*)(ws + WS_WAOUT1)};
    bf16* W_RIN = (bf16*)(ws + WS_WRIN); bf16* W_ROUT = (bf16*)(ws + WS_WROUT); bf16* W_CIN = (bf16*)(ws + WS_WCIN); bf16* W_COUT = (bf16*)(ws + WS_WCOUT);
    bf16* XN = (bf16*)(ws + WS_XN); bf16* Z = (bf16*)(ws + WS_Z);
    bf16* Qs = (bf16*)(ws + WS_QS); bf16* KP = (bf16*)(ws + WS_KP); bf16* VP = (bf16*)(ws + WS_VP); bf16* KC = (bf16*)(ws + WS_KC); bf16* VC = (bf16*)(ws + WS_VC); bf16* AO_A = (bf16*)(ws + WS_AOA);
    bf16* KT = (bf16*)(ws + WS_KT); bf16* RG = (bf16*)(ws + WS_RG); bf16* QP = (bf16*)(ws + WS_QP); bf16* KN = (bf16*)(ws + WS_KN); bf16* VS = (bf16*)(ws + WS_VS); bf16* ORET = (bf16*)(ws + WS_ORET);
    bf16* GU = (bf16*)(ws + WS_GU); bf16* SG = (bf16*)(ws + WS_SG); bf16* GVT = (bf16*)(ws + WS_GVT); bf16* WM = (bf16*)(ws + WS_WM); float* SSQ = (float*)(ws + WS_SSQ); bf16* GVS = (bf16*)(ws + WS_GVS); float* TABR = (float*)(ws + WS_TABR); float* TABA = (float*)(ws + WS_TABA); bf16* GA = (bf16*)(ws + WS_GA);
    const int lo = args.ph_lo, hi = args.ph_hi;
    volatile LAS unsigned* MISC = (volatile LAS unsigned*)(F.lds + MISC_OFF);
    for (int u = F.tid; u < (LDS_BYTES - MISC_OFF) / 4; u += NTHR) ((LAS unsigned*)(F.lds + MISC_OFF))[u] = 0u;
    __syncthreads();
    XcdBarrier bar = xcd_barrier_post((unsigned*)(ws + WS_CTL) + 4096, MISC + 8);
#define IN(k) (lo <= (k) && (k) < hi)
#define SEAM(k) do { if (IN(k) && IN((k) + 1)) xcd_barrier(bar); } while (0)

#define GEMM_STORE(Aptr, Wptr, NN, KK, Optr) do { pg8::GemmP g{KK, KK, (KK) / 64}; pg8::StaticOrder S; S.init(MT / 256, (NN) / 256, F.G, F.bid, Aptr, Wptr, KK, KK); pg8::EpiStoreBf16 E{(pg8::bf16_t*)(Optr), NN}; \
        pg8::gemm_phase<pg8::EpiStoreBf16, pg8::StaticOrder>(F.lds + RING_OFF, g, S, E); } while (0)
#define GEMM_RESID(Aptr, Wptr, KK, BP, BS) do { pg8::GemmP g{KK, KK, (KK) / 64}; pg8::StaticOrder S; S.init(MT / 256, DM / 256, F.G, F.bid, Aptr, Wptr, KK, KK); pg8::EpiResid E{BP, BS, out, MP}; \
        pg8::gemm_phase<pg8::EpiResid, pg8::StaticOrder>(F.lds + RING_OFF, g, S, E); } while (0)

    if (IN(0)) {
        transpose_weight(F, args.in[I_AWIN], 2048, 8192, W_AIN[0]); transpose_weight(F, args.in[I_AWOUT], 2048, 2048, W_AOUT[0]);
        transpose_weight(F, args.in[I_RWIN], 2048, 12288, W_RIN); transpose_weight(F, args.in[I_RWOUT], 4096, 2048, W_ROUT);
        ret_table(F, TABR); attn_table(F, TABA);
        norm_rows(F, args.in[I_XP], args.in[I_XS], args.in[I_NW], XN);
        cache_cvt(F, args.in[I_CK], args.in[I_CV], KC, VC);
    }
    SEAM(0);
#define GEMM_AIN(Wptr, J_) do { pg8::GemmP g{2048, 2048, 32}; pg8::StaticOrder S; S.init(MT / 256, 32, F.G, F.bid, XN, Wptr, 2048, 2048); \
        EpiAIn E{Qs, KP, VP, KC, VC, GA, out + O_KP + (size_t)(J_) * MP * DM, out + O_VP + (size_t)(J_) * MP * DM, out + O_KS + (size_t)(J_) * MS * DM, out + O_VS + (size_t)(J_) * MS * DM, TABA, args.in[I_AQG] + 64 * (J_), args.in[I_AKG] + 64 * (J_)}; \
        pg8::gemm_phase<EpiAIn, pg8::StaticOrder>(F.lds + RING_OFF, g, S, E); } while (0)
    if (IN(1)) GEMM_AIN(W_AIN[0], 0);
    SEAM(1);
    if (IN(3)) { const float li = 0.8f - 0.6f * expf(-0.3f * 0.f); const float lam = diff_lambda(args.in[I_LQ1], args.in[I_LK1], args.in[I_LQ2], args.in[I_LK2], li);
        attn_fast(F, Qs, KP, VP, KC, VC, GA, AO_A, lam, 1.f - li, args.in[I_ASG]); }
    SEAM(3);
    if (IN(4)) GEMM_RESID(AO_A, W_AOUT[0], 2048, args.in[I_XP], args.in[I_XS]);
    SEAM(4);
    if (IN(5)) { norm_rows(F, out + O_YP, out + O_YS, args.in[I_NW] + DM, XN); ret_zero_pad(F, VS); }
    SEAM(5);
    if (IN(6)) { pg8::GemmP g{2048, 2048, 32}; pg8::StaticOrder S; S.init(MT / 256, 48, F.G, F.bid, XN, W_RIN, 2048, 2048); EpiRet E{QP, KN, KT, VS, RG, TABR};
        pg8::gemm_phase<EpiRet, pg8::StaticOrder>(F.lds + RING_OFF, g, S, E); }
    SEAM(6);
    if (IN(7)) { { pg8::GemmP g{4096, 2048, 4}; RetQKOrder S{F.G, F.bid, (const char*)QP, (const char*)KN}; EpiRetQK E{QP}; pg8::gemm_phase<EpiRetQK, RetQKOrder>(F.lds + RING_OFF, g, S, E); }
        ret_scan(F, KT, VS, args.in[I_SR], out + O_SP, out + O_SS); }
    SEAM(7);
    if (IN(8)) { pg8::GemmP g{4096, 512, 8}; RetOOrder S{F.G, F.bid, (const char*)QP, (const char*)VS}; EpiRetO E{ORET}; pg8::gemm_phase<EpiRetO, RetOOrder>(F.lds + RING_OFF, g, S, E); }
    SEAM(8);
    if (IN(9)) r_out(F, ORET, RG);
    SEAM(9);
    if (IN(10)) GEMM_RESID(ORET, W_ROUT, 4096, out + O_YP, out + O_YS);
    SEAM(10);
    if (IN(11)) { norm_rows(F, out + O_YP, out + O_YS, args.in[I_NW] + 2 * DM, XN);
        transpose_weight(F, args.in[I_CWIN], 2048, 12288, W_CIN); transpose_weight(F, args.in[I_CWOUT], 4096, 2048, W_COUT);
        transpose_weight(F, args.in[I_AWIN] + (size_t)2048 * 8192, 2048, 8192, W_AIN[1]); transpose_weight(F, args.in[I_AWOUT] + (size_t)2048 * 2048, 2048, 2048, W_AOUT[1]); }
    SEAM(11);
    if (IN(12)) { pg8::GemmP g{2048, 2048, 32}; pg8::StaticOrder S; S.init(MT / 256, 48, F.G, F.bid, XN, W_CIN, 2048, 2048); EpiCIn E{GU, GVT, SG, GVS, SSQ};
        pg8::gemm_phase<EpiCIn, pg8::StaticOrder>(F.lds + RING_OFF, g, S, E); }
    SEAM(12);
    if (IN(13)) c_prep(F, SSQ, args.in[I_CWS], args.in[I_CVG], GVS, WM, out + O_VM);
    SEAM(13);
    if (IN(14)) { pg8::GemmP g{256, 256, 4}; CMixOrder S{F.G, F.bid, (const char*)WM, (const char*)GVT}; EpiCMix E{GU, SG, args.in[I_CVG], args.in[I_CBS]}; pg8::gemm_phase<EpiCMix, CMixOrder>(F.lds + RING_OFF, g, S, E); }
    SEAM(14);
    if (IN(15)) GEMM_RESID(GU, W_COUT, 4096, out + O_YP, out + O_YS);
    SEAM(15);
    if (IN(16)) { norm_rows(F, out + O_YP, out + O_YS, args.in[I_NW] + 3 * DM, XN);
        cache_cvt(F, args.in[I_CK] + (size_t)NB * PAST * DM, args.in[I_CV] + (size_t)NB * PAST * DM, KC, VC); }
    SEAM(16);
    if (IN(17)) GEMM_AIN(W_AIN[1], 1);
    SEAM(17);
    if (IN(19)) { const float li = 0.8f - 0.6f * expf(-0.3f * 3.f); const float lam = diff_lambda(args.in[I_LQ1] + 64, args.in[I_LK1] + 64, args.in[I_LQ2] + 64, args.in[I_LK2] + 64, li);
        attn_fast(F, Qs, KP, VP, KC, VC, GA, AO_A, lam, 1.f - li, args.in[I_ASG] + 128); }
    SEAM(19);
    if (IN(20)) GEMM_RESID(AO_A, W_AOUT[1], 2048, out + O_YP, out + O_YS);
#undef IN
#undef SEAM
}

extern "C" void kernel_launch(void* const* d_in, const int* in_sizes, int n_in, void* d_out, int out_size, void* d_ws, size_t ws_size, hipStream_t stream) {
    static int grid = 0;
    if (grid == 0) {
        if (n_in != N_IN || (size_t)out_size != O_END || ws_size < WS_END) { fprintf(stderr, "kernel_launch: unexpected shapes: n_in %d out %d ws %zu (need %zu)\n", n_in, out_size, ws_size, (size_t)WS_END); grid = -1; return; }
        int dev = 0, cus = 0;
        if (hipGetDevice(&dev) != hipSuccess || hipDeviceGetAttribute(&cus, hipDeviceAttributeMultiprocessorCount, dev) != hipSuccess) { grid = -1; return; }
        if (hipFuncSetAttribute((const void*)mega, hipFuncAttributeMaxDynamicSharedMemorySize, LDS_BYTES) != hipSuccess) { fprintf(stderr, "kernel_launch: hipFuncSetAttribute failed\n"); grid = -1; return; }
        (void)hipGetLastError();
        grid = cus;
    }
    if (grid < 0) return;
    Args a{};
    for (int i = 0; i < N_IN; ++i) a.in[i] = (const float*)d_in[i];
    a.out = (float*)d_out; a.ws = (unsigned char*)d_ws;
    (void)hipMemsetAsync((char*)d_ws + WS_CTL, 0, CTL_ZERO_BYTES, stream);
    a.ph_lo = 0; a.ph_hi = N_PHASES;
    hipLaunchKernelGGL(mega, dim3(grid), dim3(NTHR), LDS_BYTES, stream, a);
}
```

```cpp
#include <hip/hip_runtime.h>
#include <cstdio>
#include <cstdint>

namespace pg8 {
#define PG8_LAS __attribute__((address_space(3)))
typedef unsigned short bf16_t;
typedef short bf16x8 __attribute__((ext_vector_type(8)));
typedef float f32x4 __attribute__((ext_vector_type(4)));
typedef unsigned u32x4 __attribute__((ext_vector_type(4)));
constexpr int BM = 256, BK = 64, HALF = 128, HTB = HALF * BK * 2, STAGE_BYTES = 8 * HTB, NXCD = 8, WGM = 8;

__host__ __device__ __forceinline__ int lds_byte(int r, int c) { const int st = (r >> 4) * 2 + (c >> 5), rr = r & 15, cc = c & 31, ob = rr * 64 + cc * 2; return st * 1024 + (ob ^ (((ob >> 9) & 1) << 5)); }
__host__ __device__ __forceinline__ void stage_rc(int b, int& R, int& C) { const int st = b / 1024, sb = b % 1024, swz = sb ^ (((sb >> 9) & 1) << 5); R = (st >> 1) * 16 + swz / 64; C = (st & 1) * 32 + (swz % 64) / 2; }
__host__ __device__ __forceinline__ int perm32(int rho) { const int n = rho >> 4, i = rho & 15; return 8 * (i >> 2) + 4 * n + (i & 3); }

struct Unit { int pm, pn; const char* a; const char* b; };
struct GemmP { int lda, ldb, nt; };

struct StaticOrder {
    int nM, nN, nwg, G, c; const char* A; const char* B; size_t ta, tb;
    __host__ __device__ void init(int nM_, int nN_, int G_, int c_, const void* A_, const void* B_, int lda, int ldb) { nM = nM_; nN = nN_; nwg = nM * nN; G = G_; c = c_; A = (const char*)A_; B = (const char*)B_; ta = (size_t)BM * lda * 2; tb = (size_t)BM * ldb * 2; }
    __host__ __device__ bool next(int i, Unit& u) const {
        const long L = (long)i * G + c; if (L >= nwg) return false;
        int wgid = (int)L; { const int q = nwg / NXCD, r = nwg % NXCD, xcd = wgid % NXCD, off = wgid / NXCD; wgid = (xcd < r ? xcd * (q + 1) : r * (q + 1) + (xcd - r) * q) + off; }
        const int nig = WGM * nN, gid = wgid / nig, fm = gid * WGM, gsz = (nM - fm) < WGM ? (nM - fm) : WGM;
        u.pm = fm + ((wgid % nig) % gsz); u.pn = (wgid % nig) / gsz; u.a = A + (size_t)u.pm * ta; u.b = B + (size_t)u.pn * tb; return true;
    }
    __device__ __forceinline__ void a_ready(const Unit&) const {}
    __device__ __forceinline__ void done(const Unit&) const {}
};

__device__ __forceinline__ unsigned cvt_pk_bf16(float lo, float hi) { unsigned r; asm volatile("v_cvt_pk_bf16_f32 %0, %1, %2" : "=v"(r) : "v"(lo), "v"(hi)); return r; }

struct EpiStoreBf16 {
    static constexpr int BMODE = 1;
    bf16_t* O; int ldc;
    __device__ __forceinline__ void operator()(const f32x4 (&acc)[2][2][4][2], const Unit& u, int wr, int wc, int fr, int fq) const {
        const int row0 = u.pm * BM + wr * 64 + fr; const int col0 = u.pn * BM + wc * 32 + 8 * fq;
#pragma unroll
        for (int ai = 0; ai < 2; ++ai)
#pragma unroll
            for (int m = 0; m < 4; ++m) { bf16_t* rowp = O + (size_t)(row0 + ai * HALF + m * 16) * ldc + col0;
#pragma unroll
                for (int bj = 0; bj < 2; ++bj) { const f32x4 v0 = acc[ai][bj][m][0], v1 = acc[ai][bj][m][1];
                    u32x4 w; w.x = cvt_pk_bf16(v0[0], v0[1]); w.y = cvt_pk_bf16(v0[2], v0[3]); w.z = cvt_pk_bf16(v1[0], v1[1]); w.w = cvt_pk_bf16(v1[2], v1[3]);
                    *(u32x4*)(rowp + bj * HALF) = w; } }
    }
};
struct EpiResid {
    static constexpr int BMODE = 0;
    const float* base_p; const float* base_s; float* out; int split;
    __device__ __forceinline__ void operator()(const f32x4 (&acc)[2][2][4][2], const Unit& u, int wr, int wc, int fr, int fq) const {
        const int col0 = u.pn * BM + wc * 32 + 4 * fq;
#pragma unroll
        for (int ai = 0; ai < 2; ++ai)
#pragma unroll
            for (int m = 0; m < 4; ++m) { const int r = u.pm * BM + ai * HALF + wr * 64 + m * 16 + fr;
                const float* bp = (r < split) ? base_p + (size_t)r * 2048 : base_s + (size_t)(r - split) * 2048; float* op = out + (size_t)r * 2048;
#pragma unroll
                for (int bj = 0; bj < 2; ++bj)
#pragma unroll
                    for (int n = 0; n < 2; ++n) { const int c = col0 + bj * HALF + n * 16; const f32x4 bs = *(const f32x4*)(bp + c); *(f32x4*)(op + c) = bs + acc[ai][bj][m][n]; }
                if (m & 1) asm volatile("" ::: "memory"); }
    }
};

template <class Epi, class Sched, bool ALIGN_EPI = true>
__device__ __forceinline__ void gemm_phase(PG8_LAS unsigned char* lds, const GemmP g, const Sched& S, const Epi& E) {
    int tid = threadIdx.x; asm volatile("" : "+v"(tid));
    const int wid = __builtin_amdgcn_readfirstlane(tid >> 6), lane = tid & 63, wr = wid >> 2, wc = wid & 3, fr = lane & 15, fq = lane >> 4;
    const int nt = g.nt;
    unsigned voffA[2], voffB[2];
#pragma unroll
    for (int i = 0; i < 2; ++i) { int R, C; stage_rc(tid * 16 + i * 8192, R, C); const int Rb = Epi::BMODE == 2 ? (64 * (R >> 5) + perm32(R & 31)) : Epi::BMODE == 1 ? ((R & ~31) + perm32(R & 31)) : R;
        voffA[i] = (unsigned)(R * g.lda + C) * 2u; voffB[i] = (unsigned)(Rb * g.ldb + C) * 2u; }
    const size_t kstep = (size_t)(BK * 2);
    const size_t hstepA = (size_t)HALF * g.lda * 2, hstepB = (size_t)(Epi::BMODE == 2 ? 32 : HALF) * g.ldb * 2;
    const unsigned ldsw = (unsigned)wid * 1024u;
    const int aoff = lds_byte(wr * 64 + fr, fq * 8), boff = lds_byte(wc * 32 + fr, fq * 8);
#define PG8_SA(b, h) (((b) * 2 + (h)) * HTB)
#define PG8_SB(b, h) ((4 + (b) * 2 + (h)) * HTB)
#define PG8_STAGE(bufoff, gbase, voff) do { _Pragma("unroll") for (int _i = 0; _i < 2; ++_i) \
        __builtin_amdgcn_global_load_lds((const unsigned*)((const char*)(gbase) + (voff)[_i]), (PG8_LAS unsigned*)(lds + (bufoff) + ldsw + _i * 8192), 16, 0, 0); } while (0)
#define PG8_LDA(dst, b, h) do { _Pragma("unroll") for (int m = 0; m < 4; ++m) _Pragma("unroll") for (int k = 0; k < 2; ++k) dst[m][k] = *(const PG8_LAS bf16x8*)(lds + PG8_SA(b, h) + aoff + m * 2048 + k * 1024); } while (0)
#define PG8_LDB(dst, b, h) do { _Pragma("unroll") for (int n = 0; n < 2; ++n) _Pragma("unroll") for (int k = 0; k < 2; ++k) dst[n][k] = *(const PG8_LAS bf16x8*)(lds + PG8_SB(b, h) + boff + n * 2048 + k * 1024); } while (0)
#define PG8_MMA(ai, bj, At, Bt) do { __builtin_amdgcn_s_setprio(1); _Pragma("unroll") for (int m = 0; m < 4; ++m) _Pragma("unroll") for (int n = 0; n < 2; ++n) _Pragma("unroll") for (int k = 0; k < 2; ++k) \
        acc[ai][bj][m][n] = __builtin_amdgcn_mfma_f32_16x16x32_bf16(Bt[n][k], At[m][k], acc[ai][bj][m][n], 0, 0, 0); __builtin_amdgcn_s_setprio(0); } while (0)
#define PG8_WAIT_V(n) asm volatile("s_waitcnt vmcnt(" #n ")" ::: "memory")
#define PG8_WAIT_L(n) asm volatile("s_waitcnt lgkmcnt(" #n ")" ::: "memory")
#define PG8_BAR __builtin_amdgcn_s_barrier()
#define PG8_SCHED __builtin_amdgcn_sched_barrier(0)
    Unit cur, nxt; int ui = 0;
    if (!S.next(0, cur)) return;
    f32x4 acc[2][2][4][2];
#pragma unroll
    for (int a = 0; a < 2; ++a)
#pragma unroll
        for (int b = 0; b < 2; ++b)
#pragma unroll
            for (int m = 0; m < 4; ++m)
#pragma unroll
                for (int n = 0; n < 2; ++n) acc[a][b][m][n] = (f32x4){0.f, 0.f, 0.f, 0.f};
    bf16x8 At[4][2], B0[2][2], B1[2][2];
    const char* cA = cur.a; const char* cB = cur.b;
    S.a_ready(cur);
    PG8_STAGE(PG8_SB(0, 0), cB, voffB); PG8_STAGE(PG8_SB(0, 1), cB + hstepB, voffB); PG8_STAGE(PG8_SA(0, 0), cA, voffA); PG8_STAGE(PG8_SA(0, 1), cA + hstepA, voffA);
    if (wr == 1) PG8_BAR;
    PG8_WAIT_V(2); PG8_BAR;
    PG8_STAGE(PG8_SB(1, 0), cB + kstep, voffB); PG8_STAGE(PG8_SA(1, 0), cA + kstep, voffA); PG8_STAGE(PG8_SB(1, 1), cB + hstepB + kstep, voffB);
    PG8_WAIT_V(6); PG8_BAR;
    for (;;) {
        const bool has_next = S.next(ui + 1, nxt);
        const char* nA = has_next ? nxt.a : cA; const char* nB = has_next ? nxt.b : cB;
        for (int t = 0; t < nt; t += 2) {
            const bool last = (t == nt - 2);
            const char* a1 = cA + (size_t)(t + 1) * kstep;
            const char* a2 = last ? nA : cA + (size_t)(t + 2) * kstep; const char* b2 = last ? nB : cB + (size_t)(t + 2) * kstep;
            const char* a3 = a2 + kstep; const char* b3 = b2 + kstep;
            if (last && has_next) S.a_ready(nxt);
            PG8_LDB(B0, 0, 0); PG8_LDB(B1, 0, 1); PG8_SCHED; PG8_LDA(At, 0, 0); PG8_STAGE(PG8_SA(1, 1), a1 + hstepA, voffA);
            PG8_WAIT_V(8); PG8_WAIT_L(0); PG8_BAR; PG8_MMA(0, 0, At, B0); PG8_MMA(0, 1, At, B1); PG8_BAR; PG8_SCHED;
            PG8_LDA(At, 0, 1); PG8_STAGE(PG8_SB(0, 0), b2, voffB); PG8_STAGE(PG8_SB(0, 1), b2 + hstepB, voffB); PG8_STAGE(PG8_SA(0, 0), a2, voffA);
            PG8_WAIT_V(8); PG8_WAIT_L(0); PG8_BAR; PG8_MMA(1, 0, At, B0); PG8_MMA(1, 1, At, B1); PG8_BAR; PG8_SCHED;
            PG8_LDB(B0, 1, 0); PG8_LDB(B1, 1, 1); PG8_SCHED; PG8_LDA(At, 1, 0); PG8_STAGE(PG8_SA(0, 1), a2 + hstepA, voffA);
            PG8_WAIT_V(8); PG8_WAIT_L(0); PG8_BAR; PG8_MMA(0, 0, At, B0); PG8_MMA(0, 1, At, B1); PG8_BAR; PG8_SCHED;
            PG8_LDA(At, 1, 1); PG8_STAGE(PG8_SB(1, 0), b3, voffB); PG8_STAGE(PG8_SB(1, 1), b3 + hstepB, voffB); PG8_STAGE(PG8_SA(1, 0), a3, voffA);
            PG8_WAIT_V(8); PG8_WAIT_L(0); PG8_BAR; PG8_MMA(1, 0, At, B0); PG8_MMA(1, 1, At, B1); PG8_BAR; PG8_SCHED;
        }
        if constexpr (ALIGN_EPI) { if (wr == 0) PG8_BAR; }
        E(acc, cur, wr, wc, fr, fq); S.done(cur);
        if (!has_next) break;
#pragma unroll
        for (int a = 0; a < 2; ++a)
#pragma unroll
            for (int b = 0; b < 2; ++b)
#pragma unroll
                for (int m = 0; m < 4; ++m)
#pragma unroll
                    for (int n = 0; n < 2; ++n) acc[a][b][m][n] = (f32x4){0.f, 0.f, 0.f, 0.f};
        cur = nxt; cA = nA; cB = nB; ++ui;
        if constexpr (ALIGN_EPI) { if (wr == 1) PG8_BAR; }
    }
    PG8_WAIT_V(0);
    if constexpr (!ALIGN_EPI) { if (wr == 0) PG8_BAR; }
    PG8_BAR;
#undef PG8_SA
#undef PG8_SB
#undef PG8_STAGE
#undef PG8_LDA
#undef PG8_LDB
#undef PG8_MMA
#undef PG8_WAIT_V
#undef PG8_WAIT_L
#undef PG8_BAR
#undef PG8_SCHED
}
}

constexpr int NWAVES = 8, NTHR = 512;
constexpr int DM = 2048, MP = 16384, MS = 512, MT = MP + MS, PAST = 2048, DECL = 64, NB = 8;
constexpr int KCROWS = PAST + DECL;
constexpr float EPS = 1e-6f;
constexpr float LOG2E = 1.4426950408889634f;
constexpr float C2 = 0.125f * LOG2E;

enum { I_XP = 0, I_XS, I_CK, I_CV, I_SR, I_NW, I_AWIN, I_AWOUT, I_AQG, I_AKG, I_LQ1, I_LK1, I_LQ2, I_LK2, I_ASG, I_RWIN, I_RWOUT, I_CWIN, I_CWOUT, I_CVG, I_CWS, I_CBS, N_IN };
constexpr size_t O_YP = 0, O_YS = O_YP + (size_t)MP * DM, O_KP = O_YS + (size_t)MS * DM, O_VP = O_KP + 2 * (size_t)MP * DM, O_KS = O_VP + 2 * (size_t)MP * DM, O_VS = O_KS + 2 * (size_t)MS * DM,
                 O_SP = O_VS + 2 * (size_t)MS * DM, O_SS = O_SP + (size_t)8 * 256 * 512, O_VM = O_SS + (size_t)NB * 8 * 256 * 512, O_END = O_VM + (size_t)MS * 4096;

constexpr size_t MiB = 1u << 20;
constexpr size_t WS_CTL = 0, CTL_ZERO_BYTES = 1 * MiB;
constexpr size_t WS_WAIN0 = 8 * MiB, WS_WAOUT0 = 40 * MiB, WS_WRIN = 48 * MiB, WS_WROUT = 96 * MiB, WS_WCIN = 112 * MiB, WS_WCOUT = 160 * MiB, WS_WAIN1 = 176 * MiB, WS_WAOUT1 = 208 * MiB;
constexpr size_t WS_XN = 216 * MiB, WS_Z = 282 * MiB;
constexpr size_t WS_QS = 546 * MiB, WS_KP = 612 * MiB, WS_VP = 676 * MiB, WS_KC = 740 * MiB, WS_VC = 806 * MiB, WS_AOA = 872 * MiB;
constexpr size_t WS_KT = 112 * MiB, WS_RG = 282 * MiB, WS_QP = 414 * MiB, WS_KN = 546 * MiB, WS_VS = 612 * MiB, WS_ORET = 900 * MiB;
constexpr size_t WS_GU = 282 * MiB, WS_SG = 414 * MiB, WS_GVT = 546 * MiB, WS_WM = 678 * MiB, WS_SSQ = 744 * MiB, WS_GVS = 752 * MiB;
constexpr size_t WS_GA = 282 * MiB;
constexpr size_t WS_TABR = 1040 * MiB, WS_TABA = 1056 * MiB, WS_END = 1060 * MiB;

#define GAS __attribute__((address_space(1)))
#define LAS __attribute__((address_space(3)))
typedef unsigned short bf16;
typedef unsigned v4u __attribute__((ext_vector_type(4)));
typedef unsigned v2u __attribute__((ext_vector_type(2)));
typedef float f32x4 __attribute__((ext_vector_type(4)));
typedef GAS unsigned gu32;
#define RLX_AGENT __ATOMIC_RELAXED, __HIP_MEMORY_SCOPE_AGENT
#define LDS_WAIT() asm volatile("s_waitcnt lgkmcnt(0)" ::: "memory")
#define VM_WAIT() asm volatile("s_waitcnt vmcnt(0)" ::: "memory")
__device__ __forceinline__ unsigned f2bf(float f) { unsigned u = __builtin_bit_cast(unsigned, f); return (u + 0x7fffu + ((u >> 16) & 1u)) >> 16; }
__device__ __forceinline__ unsigned pk2(float lo, float hi) { return f2bf(lo) | (f2bf(hi) << 16); }
__device__ __forceinline__ float bf2f(unsigned short b) { return __builtin_bit_cast(float, (unsigned)b << 16); }
__device__ __forceinline__ float bflo(unsigned w) { return __builtin_bit_cast(float, w << 16); }
__device__ __forceinline__ float bfhi(unsigned w) { return __builtin_bit_cast(float, w & 0xffff0000u); }
__device__ __forceinline__ float silu_f(float x) { return x / (1.f + __expf(-x)); }
__device__ __forceinline__ float gelu_tanh_f(float x) { const float u = 0.7978845608028654f * (x + 0.044715f * x * x * x); return x / (1.f + __expf(-2.f * u)); }
__device__ __forceinline__ float wave_sum(float v) {
#pragma unroll
    for (int o = 1; o < 64; o <<= 1) v += __shfl_xor(v, o);
    return v;
}
__device__ __forceinline__ void rope_cs(int pos, int i, int nf, float& c, float& s) {
    const float inv = exp2f(-(float)i / (float)nf * 13.287712379549449f);
    const double a = (double)pos * (double)inv * 0.15915494309189535;
    const float r = (float)(a - floor(a));
    c = __builtin_amdgcn_cosf(r); s = __builtin_amdgcn_sinf(r);
}

#define XB_TMO      128
#define XB_XCNT(j)  (256  + 64 * (j))
#define XB_XSUB(j)  (1280 + 64 * (j))
#define XB_XGEN(j)  (2304 + 64 * (j))
#define XB_TOP      3328
#define XB_TOPGEN   3392
#define XCD_BAR_WORDS 3456
#define XB_SPIN_CAP (1u << 22)
__device__ __forceinline__ unsigned xb_ld(unsigned* p)              { return __hip_atomic_load(p, __ATOMIC_RELAXED, __HIP_MEMORY_SCOPE_AGENT); }
__device__ __forceinline__ unsigned xb_add(unsigned* p, unsigned v) { return __hip_atomic_fetch_add(p, v, __ATOMIC_RELAXED, __HIP_MEMORY_SCOPE_AGENT); }
__device__ __forceinline__ unsigned xb_xcc_id() { return (unsigned)__builtin_amdgcn_s_getreg((3 << 11) | 20) & 0xFu; }
#define XB_SPIN(cond, bar) do { unsigned _sp = 0; while (cond) { __builtin_amdgcn_s_sleep(1); \
    if ((++_sp & 255u) == 0u) { if (xb_ld(&(bar)[XB_TMO])) break; if (_sp > XB_SPIN_CAP) { atomicAdd(&(bar)[XB_TMO], 1u); break; } } } } while (0)
struct XcdBarrier { unsigned* bar; unsigned x; volatile LAS unsigned* st; };
__device__ __forceinline__ XcdBarrier xcd_barrier_post(unsigned* bar, volatile LAS unsigned* st) {
    XcdBarrier b; b.bar = bar; b.x = xb_xcc_id(); b.st = st;
    if (threadIdx.x == 0) (void)xb_add(&bar[XB_XCNT(b.x)], 1u);
    return b;
}
__device__ __forceinline__ void xcd_barrier_complete(unsigned* bar, unsigned x, unsigned& nloc, unsigned& nx) {
    const unsigned G = gridDim.x * gridDim.y * gridDim.z;
    unsigned sum, cnt, mine, sp = 0u;
    for (;;) {
        sum = 0u; cnt = 0u; mine = 0u;
#pragma unroll
        for (unsigned j = 0; j < 16; ++j) { const unsigned c = xb_ld(&bar[XB_XCNT(j)]); sum += c; cnt += (c > 0u) ? 1u : 0u; mine = (j == x) ? c : mine; }
        if (sum == G) break;
        __builtin_amdgcn_s_sleep(1);
        if ((++sp & 255u) == 0u) { if (xb_ld(&bar[XB_TMO])) break; if (sp > XB_SPIN_CAP) { atomicAdd(&bar[XB_TMO], 1u); break; } }
    }
    nloc = mine > 0u ? mine : 1u; nx = cnt > 0u ? cnt : 1u;
}
__device__ __forceinline__ void xcd_barrier(const XcdBarrier& b) {
    asm volatile("s_waitcnt vmcnt(0)" ::: "memory");
    __syncthreads();
    if (threadIdx.x == 0) {
        unsigned* bar = b.bar;
        __builtin_amdgcn_s_waitcnt(0);
        unsigned nloc = b.st[0], nx = b.st[1];
        if (nloc == 0u) { xcd_barrier_complete(bar, b.x, nloc, nx); b.st[0] = nloc; b.st[1] = nx; }
        const unsigned old = xb_add(&bar[XB_XSUB(b.x)], 1u);
        const unsigned gen = old / nloc;
        if (old + 1u == (gen + 1u) * nloc) {
            __builtin_amdgcn_fence(__ATOMIC_RELEASE, "agent");
            asm volatile("s_waitcnt vmcnt(0)" ::: "memory");
            const unsigned og = xb_add(&bar[XB_TOP], 1u);
            const unsigned tg = og / nx;
            if (og + 1u == (tg + 1u) * nx) xb_add(&bar[XB_TOPGEN], 1u);
            else XB_SPIN(xb_ld(&bar[XB_TOPGEN]) == tg, bar);
            __builtin_amdgcn_fence(__ATOMIC_ACQUIRE, "agent");
            xb_add(&bar[XB_XGEN(b.x)], 1u);
            asm volatile("s_waitcnt vmcnt(0)" ::: "memory");
        } else {
            XB_SPIN(xb_ld(&bar[XB_XGEN(b.x)]) == gen, bar);
            __builtin_amdgcn_fence(__ATOMIC_ACQUIRE, "agent");
            asm volatile("s_waitcnt vmcnt(0)" ::: "memory");
        }
    }
    __syncthreads();
}

constexpr int RING_OFF = 0, RING_BYTES = 139264;
constexpr int MISC_OFF = RING_BYTES;
constexpr int LDS_BYTES = 147456;
struct Args { const float* in[N_IN]; float* out; unsigned char* ws; int ph_lo, ph_hi; };
struct Frame {
    LAS unsigned char* lds; int tid, lane, wave, G, bid;
    const float* const* in; float* out; unsigned char* ws;
};

__device__ __forceinline__ void p0_transpose_item(const float* W, int K, int N, bf16* WT, LAS float* scr, int item, int lane) {
    const int nblk = N / 32, kb = item / nblk, nb = item % nblk, k0 = 64 * kb, n0 = 32 * nb;
#pragma unroll 8
    for (int i = 0; i < 32; ++i) { const int kk = 2 * i + (lane >> 5); scr[kk * 33 + (lane & 31)] = W[(size_t)(k0 + kk) * N + n0 + (lane & 31)]; }
    LDS_WAIT(); asm volatile("" ::: "memory");
    const int c = lane & 7;
#pragma unroll
    for (int j = 0; j < 4; ++j) { const int n = (lane >> 3) + 8 * j; const LAS float* s = scr + (8 * c) * 33 + n;
        v4u o; o.x = pk2(s[0 * 33], s[1 * 33]); o.y = pk2(s[2 * 33], s[3 * 33]); o.z = pk2(s[4 * 33], s[5 * 33]); o.w = pk2(s[6 * 33], s[7 * 33]);
        *(GAS v4u*)(WT + (size_t)(n0 + n) * K + k0 + 8 * c) = o; }
    LDS_WAIT(); asm volatile("" ::: "memory");
}
__device__ __forceinline__ void transpose_weight(Frame& F, const float* W, int K, int N, bf16* WT) {
    LAS float* scr = (LAS float*)(F.lds + RING_OFF + F.wave * 16384);
    const int gw = F.bid * NWAVES + F.wave, NGW = F.G * NWAVES, nitems = (K / 64) * (N / 32);
    for (int it = gw; it < nitems; it += NGW) p0_transpose_item(W, K, N, WT, scr, it, F.lane);
}
__device__ __forceinline__ void norm_rows(Frame& F, const float* src_p, const float* src_s, const float* w, bf16* XN) {
    const int gw = F.bid * NWAVES + F.wave, NGW = F.G * NWAVES;
    for (int m = gw; m < MT; m += NGW) {
        const float* xrow = (m < MP) ? src_p + (size_t)m * DM : src_s + (size_t)(m - MP) * DM;
        const GAS f32x4* xr = (const GAS f32x4*)xrow + F.lane; const GAS f32x4* wr = (const GAS f32x4*)w + F.lane;
        f32x4 v[8]; float s = 0.f;
#pragma unroll
        for (int j = 0; j < 8; ++j) { v[j] = xr[64 * j]; s += (v[j].x * v[j].x + v[j].y * v[j].y) + (v[j].z * v[j].z + v[j].w * v[j].w); }
        const float rstd = 1.f / sqrtf(wave_sum(s) * (1.f / DM) + EPS);
        GAS v2u* o8 = (GAS v2u*)(XN + (size_t)m * DM) + F.lane;
#pragma unroll
        for (int j = 0; j < 8; ++j) { const f32x4 g = wr[64 * j]; v2u o; o.x = pk2(v[j].x * rstd * g.x, v[j].y * rstd * g.y); o.y = pk2(v[j].z * rstd * g.z, v[j].w * rstd * g.w); o8[64 * j] = o; }
    }
}
__device__ __forceinline__ void cache_cvt(Frame& F, const float* ck, const float* cv, bf16* KC, bf16* VC) {
    const size_t nvec = (size_t)NB * PAST * DM / 4;
    const size_t gt = (size_t)F.bid * NTHR + F.tid, NG = (size_t)F.G * NTHR;
    for (size_t i = gt; i < 2 * nvec; i += NG) {
        const bool isv = i >= nvec; const size_t e = (isv ? i - nvec : i) * 4;
        const size_t brow = e / DM, col = e % DM, b = brow / PAST, t = brow % PAST;
        const f32x4 x = *(const GAS f32x4*)((isv ? cv : ck) + e);
        v2u o; o.x = pk2(x.x, x.y); o.y = pk2(x.z, x.w);
        *(GAS v2u*)((isv ? VC : KC) + ((b * KCROWS + t) * DM + col)) = o;
    }
}
__device__ __forceinline__ int tw_chunks(int K, int N) { return (K / 64) * (N / 32) / 64; }
__device__ __forceinline__ void tw_run(Frame& F, const float* W, int K, int N, bf16* WT, int c) {
    LAS float* scr = (LAS float*)(F.lds + RING_OFF + F.wave * 16384);
#pragma unroll 1
    for (int i = 0; i < 8; ++i) p0_transpose_item(W, K, N, WT, scr, c * 64 + F.wave * 8 + i, F.lane);
}
constexpr int CC_CHUNKS = 2 * (NB * PAST * DM / 4) / 8192;
__device__ __forceinline__ void cc_run(Frame& F, const float* ck, const float* cv, bf16* KC, bf16* VC, int c) {
    const size_t nvec = (size_t)NB * PAST * DM / 4;
#pragma unroll 4
    for (int k = 0; k < 16; ++k) { const size_t i = (size_t)c * 8192 + k * NTHR + F.tid;
        const bool isv = i >= nvec; const size_t e = (isv ? i - nvec : i) * 4; const size_t brow = e / DM, col = e % DM, b = brow / PAST, t = brow % PAST;
        const f32x4 x = *(const GAS f32x4*)((isv ? cv : ck) + e); v2u o; o.x = pk2(x.x, x.y); o.y = pk2(x.z, x.w);
        *(GAS v2u*)((isv ? VC : KC) + ((b * KCROWS + t) * DM + col)) = o; }
}
constexpr int TR_CHUNKS = MP * 128 / 8192;
__device__ __forceinline__ void tr_run(Frame& F, float* tab, int c) {
#pragma unroll 1
    for (int k = 0; k < 16; ++k) { const size_t e = (size_t)c * 8192 + k * NTHR + F.tid; float cs, sn; rope_cs((int)(e >> 7), (int)(e & 127), 128, cs, sn); tab[2 * e] = cs; tab[2 * e + 1] = sn; }
}
__device__ __forceinline__ int row_pos(int row) { return row < MP ? row : PAST + ((row - MP) & 63); }

struct EpiAIn {
    static constexpr int BMODE = 2;
    pg8::bf16_t *Qs, *KP, *VP, *KC, *VC, *GA; float *okp, *ovp, *oks, *ovs; const float* tab; const float* qg; const float* kg;
    __device__ __forceinline__ void operator()(const pg8::f32x4 (&acc)[2][2][4][2], const pg8::Unit& u, int wr, int wc, int fr, int fq) const {
        asm volatile("" : "+v"(fr), "+v"(fq));
        const int pn = u.pn, pm = u.pm, typ = pn >> 3, cl = ((pn & 7) * 4 + wc) * 64 + 8 * fq;
        float g1[8], g2[8];
        if (typ < 2) { const float* gp = (typ == 0 ? qg : kg) + 8 * fq; const pg8::f32x4 a = *(const pg8::f32x4*)gp, b = *(const pg8::f32x4*)(gp + 4), c = *(const pg8::f32x4*)(gp + 32), d = *(const pg8::f32x4*)(gp + 36);
#pragma unroll
            for (int e = 0; e < 4; ++e) { g1[e] = a[e]; g1[4 + e] = b[e]; g2[e] = c[e]; g2[4 + e] = d[e]; } }
#pragma unroll
        for (int ai = 0; ai < 2; ++ai)
#pragma unroll
            for (int m = 0; m < 4; ++m) {
                const int i = ai * 128 + wr * 64 + m * 16 + fr; const size_t row = (size_t)pm * 256 + i;
                float x1[8], x2[8];
#pragma unroll
                for (int e = 0; e < 4; ++e) { x1[e] = acc[ai][0][m][0][e]; x1[4 + e] = acc[ai][0][m][1][e]; x2[e] = acc[ai][1][m][0][e]; x2[4 + e] = acc[ai][1][m][1][e]; }
                size_t drow; pg8::bf16_t* dk; pg8::bf16_t* dv; float* fk; float* fv;
                if (pm < 64) { drow = row; dk = KP; dv = VP; fk = okp + row * DM; fv = ovp + row * DM; }
                else { const int s_ = (int)(row - MP); drow = (size_t)(s_ >> 6) * KCROWS + PAST + (s_ & 63); dk = KC; dv = VC; fk = oks + (size_t)s_ * DM; fv = ovs + (size_t)s_ * DM; }
                if (typ < 2) {
                    float ss = 0.f;
#pragma unroll
                    for (int k = 0; k < 8; ++k) ss += x1[k] * x1[k] + x2[k] * x2[k];
                    ss += __shfl_xor(ss, 16); ss += __shfl_xor(ss, 32);
                    const float rstd = 1.f / sqrtf(ss * (1.f / 64.f) + EPS);
                    const int pos = pm < 64 ? (int)row : PAST + (i & 63);
                    const float* tp = tab + ((size_t)pos * 32 + 8 * fq) * 2; float o1[8], o2[8];
#pragma unroll
                    for (int q4 = 0; q4 < 4; ++q4) { const pg8::f32x4 t = *(const pg8::f32x4*)(tp + 4 * q4);
#pragma unroll
                        for (int z = 0; z < 2; ++z) { const int k = 2 * q4 + z; const float c = t[2 * z], s = t[2 * z + 1], y1 = x1[k] * rstd * g1[k], y2 = x2[k] * rstd * g2[k]; o1[k] = y1 * c - y2 * s; o2[k] = y2 * c + y1 * s; } }
                    if (typ == 0) { v4u w1, w2;
                        w1.x = pk2(o1[0] * C2, o1[1] * C2); w1.y = pk2(o1[2] * C2, o1[3] * C2); w1.z = pk2(o1[4] * C2, o1[5] * C2); w1.w = pk2(o1[6] * C2, o1[7] * C2);
                        w2.x = pk2(o2[0] * C2, o2[1] * C2); w2.y = pk2(o2[2] * C2, o2[3] * C2); w2.z = pk2(o2[4] * C2, o2[5] * C2); w2.w = pk2(o2[6] * C2, o2[7] * C2);
                        *(v4u*)(Qs + row * DM + cl) = w1; *(v4u*)(Qs + row * DM + cl + 32) = w2;
                    } else { v4u w1, w2;
                        w1.x = pk2(o1[0], o1[1]); w1.y = pk2(o1[2], o1[3]); w1.z = pk2(o1[4], o1[5]); w1.w = pk2(o1[6], o1[7]);
                        w2.x = pk2(o2[0], o2[1]); w2.y = pk2(o2[2], o2[3]); w2.z = pk2(o2[4], o2[5]); w2.w = pk2(o2[6], o2[7]);
                        *(v4u*)(dk + drow * DM + cl) = w1; *(v4u*)(dk + drow * DM + cl + 32) = w2;
                        *(pg8::f32x4*)(fk + cl) = (pg8::f32x4){o1[0], o1[1], o1[2], o1[3]}; *(pg8::f32x4*)(fk + cl + 4) = (pg8::f32x4){o1[4], o1[5], o1[6], o1[7]};
                        *(pg8::f32x4*)(fk + cl + 32) = (pg8::f32x4){o2[0], o2[1], o2[2], o2[3]}; *(pg8::f32x4*)(fk + cl + 36) = (pg8::f32x4){o2[4], o2[5], o2[6], o2[7]}; }
                } else { v4u w1, w2;
                    w1.x = pk2(x1[0], x1[1]); w1.y = pk2(x1[2], x1[3]); w1.z = pk2(x1[4], x1[5]); w1.w = pk2(x1[6], x1[7]);
                    w2.x = pk2(x2[0], x2[1]); w2.y = pk2(x2[2], x2[3]); w2.z = pk2(x2[4], x2[5]); w2.w = pk2(x2[6], x2[7]);
                    if (typ == 2) { *(v4u*)(dv + drow * DM + cl) = w1; *(v4u*)(dv + drow * DM + cl + 32) = w2;
                        *(pg8::f32x4*)(fv + cl) = (pg8::f32x4){x1[0], x1[1], x1[2], x1[3]}; *(pg8::f32x4*)(fv + cl + 4) = (pg8::f32x4){x1[4], x1[5], x1[6], x1[7]};
                        *(pg8::f32x4*)(fv + cl + 32) = (pg8::f32x4){x2[0], x2[1], x2[2], x2[3]}; *(pg8::f32x4*)(fv + cl + 36) = (pg8::f32x4){x2[4], x2[5], x2[6], x2[7]}; }
                    else { *(v4u*)(GA + row * DM + cl) = w1; *(v4u*)(GA + row * DM + cl + 32) = w2; }
                }
                if (m & 1) asm volatile("" ::: "memory");
            }
    }
};
__device__ __forceinline__ void attn_table(Frame& F, float* tab) {
    const size_t gt = (size_t)F.bid * NTHR + F.tid, NG = (size_t)F.G * NTHR;
    for (size_t e = gt; e < (size_t)MP * 32; e += NG) { float c, s; rope_cs((int)(e >> 5), (int)(e & 31), 32, c, s); tab[2 * e] = c; tab[2 * e + 1] = s; }
}
namespace dattn {
typedef short bf16x8 __attribute__((ext_vector_type(8)));
typedef short s16x4 __attribute__((ext_vector_type(4)));
typedef short v4i16_t __attribute__((ext_vector_type(4)));
typedef float f32x16 __attribute__((ext_vector_type(16)));
typedef unsigned u32x4 __attribute__((ext_vector_type(4)));
typedef __attribute__((address_space(3))) const char* lds_cptr;
constexpr int RINGB = 98304, WSF_OFF = RINGB, XCHB = 18432, STP = 144;
__device__ __forceinline__ int crow(int r, int hi) { return (r & 3) + 8 * (r >> 2) + 4 * hi; }
__device__ __forceinline__ void glds16(const void* gsrc, unsigned lds_dst) { unsigned keep;
    asm volatile("s_mov_b32 %0, m0\n\ts_mov_b32 m0, %2\n\ts_nop 0\n\tglobal_load_lds_dwordx4 %1, off\n\ts_mov_b32 m0, %0" : "=&s"(keep) : "v"(gsrc), "s"(lds_dst) : "memory"); }
typedef float f32x2_t __attribute__((ext_vector_type(2))); typedef __bf16 bf16x2_t __attribute__((ext_vector_type(2)));
__device__ __forceinline__ unsigned cvtpk_s(float lo, float hi) { f32x2_t v = {lo, hi}; bf16x2_t b = __builtin_convertvector(v, bf16x2_t); return __builtin_bit_cast(unsigned, b); }
#define DA_WAIT_BAR(N) asm volatile("s_waitcnt vmcnt(" #N ") lgkmcnt(0)\n\ts_barrier" ::: "memory")
__device__ __forceinline__ s16x4 vtr(lds_cptr p) { return __builtin_bit_cast(s16x4, __builtin_amdgcn_ds_read_tr16_b64_v4i16((__attribute__((address_space(3))) v4i16_t*)p)); }
struct Unit { const bf16* Q; const bf16* K; const bf16* V; const bf16* G; bf16* AO; int NT; int full; int dma0; };

constexpr int KSLOT = 16384, VSLOT = 16384, VRING = 3 * KSLOT;
#define DA_SBAR() __builtin_amdgcn_sched_barrier(0)
#define DA_PIN(x) asm volatile("" : "+v"(x))
#define DA_MFMA(a, b, c) __builtin_amdgcn_mfma_f32_32x32x16_bf16(a, b, c, 0, 0, 0)
template <bool QK, bool PV, int VAR>
__device__ __forceinline__ void step(lds_cptr kpn, lds_cptr vp, const bf16x8 (&qr)[4], bf16x8 (&kf)[8], f32x16 (&o)[4], u32x4 (&pw)[4], float& l_reg) {
    f32x16 C0 = f32x16{}, C1 = f32x16{};
    s16x4 vlo[4], vhi[4];
#define DA_FOFF(f) ((((f) & 3) * 4096) + (((f) >> 2) * 1024))
#pragma unroll
    for (int a = 0; a < 8; ++a) {
        if constexpr (PV) { if (a >= 4) { vlo[a - 4] = vtr(vp + DA_FOFF(a - 4)); vhi[a - 4] = vtr(vp + DA_FOFF(a - 4) + 512); DA_SBAR(); } }
        if constexpr (QK) {
            if (a & 1) C1 = (a < 2) ? DA_MFMA(kf[a], qr[a >> 1], f32x16{}) : DA_MFMA(kf[a], qr[a >> 1], C1);
            else       C0 = (a < 2) ? DA_MFMA(kf[a], qr[a >> 1], f32x16{}) : DA_MFMA(kf[a], qr[a >> 1], C0);
            DA_SBAR();
        }
    }
    u32x4 pwn[4]; pwn[0] = u32x4{}; pwn[1] = u32x4{}; pwn[2] = u32x4{}; pwn[3] = u32x4{};
    float s0 = 0.f, s1 = 0.f;
#pragma unroll
    for (int p = 0; p < 16; ++p) {
        if constexpr (PV) {
            const bf16x8 vf = (bf16x8){vlo[p & 3][0], vlo[p & 3][1], vlo[p & 3][2], vlo[p & 3][3], vhi[p & 3][0], vhi[p & 3][1], vhi[p & 3][2], vhi[p & 3][3]};
            if (VAR != 3) o[p & 3] = DA_MFMA(__builtin_bit_cast(bf16x8, pw[p >> 2]), vf, o[p & 3]); else { o[p & 3][0] += __builtin_bit_cast(float, (int)vf[0] | ((int)vf[4] << 16)); }
            if (p < 12) { vlo[p & 3] = vtr(vp + DA_FOFF(p + 4)); vhi[p & 3] = vtr(vp + DA_FOFF(p + 4) + 512); }
        }
        if constexpr (QK) {
            float e0, e1;
            if (VAR == 2) { if (p < 8) { e0 = C0[2 * p]; e1 = C0[2 * p + 1]; } else { e0 = C1[2 * p - 16]; e1 = C1[2 * p - 15]; } }
            else if (p < 8) { e0 = __builtin_amdgcn_exp2f(C0[2 * p]); e1 = __builtin_amdgcn_exp2f(C0[2 * p + 1]); }
            else       { e0 = __builtin_amdgcn_exp2f(C1[2 * p - 16]); e1 = __builtin_amdgcn_exp2f(C1[2 * p - 15]); }
            s0 += e0; s1 += e1; pwn[p >> 2][p & 3] = cvtpk_s(e0, e1);
            DA_PIN(s0); DA_PIN(s1); DA_PIN(pwn[p >> 2]);
            if (p >= 8) { const int j = p - 8; kf[j] = *(const __attribute__((address_space(3))) bf16x8*)(kpn + (j >> 1) * 2048 + (j & 1) * 512); }
        }
        DA_SBAR();
    }
    if constexpr (QK) { l_reg += s0 + s1; pw[0] = pwn[0]; pw[1] = pwn[1]; pw[2] = pwn[2]; pw[3] = pwn[3]; }
#undef DA_FOFF
}

template <int VAR>
__device__ __forceinline__ void attn_unit(const Unit& u, char* shm, float lam, float one_m_li, const float* sub_gain) {
    int tid = threadIdx.x; asm volatile("" : "+v"(tid));
    const int lane = tid & 63, r32 = lane & 31, hi = lane >> 5; const int wid = __builtin_amdgcn_readfirstlane(tid >> 6), s = wid >> 2, g = wid & 3;
    const int NT = u.NT; const int wt = u.full ? (g < 2 ? NT - 1 : NT) : (g < 2 ? NT : 0);
    const unsigned lds0 = (unsigned)(uintptr_t)shm;
    float* wsf = (float*)(shm + WSF_OFF) + wid * 64;
    const bf16* ksrc = u.K + (long)lane * DM + wid * 8;
    const bf16* vsrc = u.V + (long)(16 * (wid & 3) + (lane >> 2)) * DM + (wid >> 2) * 32 + (lane & 3) * 8;
    const unsigned kdst = lds0 + wid * 1024, vdst = lds0 + VRING + wid * 1024;
#define DA_DMA_K(t, slot) do { const int tt_ = u.dma0 ? 0 : (t) < NT ? (t) : NT - 1; const bf16* kp_ = ksrc + (long)tt_ * 64 * DM; \
        glds16(kp_, (unsigned)__builtin_amdgcn_readfirstlane(kdst + (slot) * KSLOT)); glds16(kp_ + 64, (unsigned)__builtin_amdgcn_readfirstlane(kdst + 8192 + (slot) * KSLOT)); } while (0)
#define DA_DMA_V(t, slot) do { const int tt_ = u.dma0 ? 0 : (t) < NT ? (t) : NT - 1; const bf16* vp_ = vsrc + (long)tt_ * 64 * DM; \
        glds16(vp_, (unsigned)__builtin_amdgcn_readfirstlane(vdst + (slot) * VSLOT)); glds16(vp_ + 64, (unsigned)__builtin_amdgcn_readfirstlane(vdst + 8192 + (slot) * VSLOT)); } while (0)
    const lds_cptr shm3 = (lds_cptr)shm;
    const lds_cptr kp0 = shm3 + s * 8192 + hi * 1024 + r32 * 16;
    const lds_cptr vp0 = shm3 + VRING + ((lane >> 4) & 1) * 32 + (lane & 3) * 8 + (4 * hi + ((lane & 15) >> 2)) * 64;
    DA_DMA_K(0, 0); DA_DMA_K(1, 1); DA_DMA_K(2, 2); DA_DMA_V(0, 0);
    bf16x8 qr[4];
    { const bf16* Qw = u.Q + (long)(32 * g + r32) * DM + s * 64;
#pragma unroll
      for (int d0 = 0; d0 < 4; ++d0) qr[d0] = (wt > 0) ? *reinterpret_cast<const bf16x8*>(Qw + d0 * 16 + hi * 8) : (bf16x8){0, 0, 0, 0, 0, 0, 0, 0}; }
    asm volatile("" : "+v"(qr[0]), "+v"(qr[1]), "+v"(qr[2]), "+v"(qr[3]));
    f32x16 o[4]; o[0] = f32x16{}; o[1] = f32x16{}; o[2] = f32x16{}; o[3] = f32x16{};
    float l_reg = 0.f;
    u32x4 pw[4]; pw[0] = u32x4{}; pw[1] = u32x4{}; pw[2] = u32x4{}; pw[3] = u32x4{};
    DA_WAIT_BAR(0);
    bf16x8 kf[8];
#pragma unroll
    for (int j = 0; j < 8; ++j) kf[j] = *(const __attribute__((address_space(3))) bf16x8*)(kp0 + (j >> 1) * 2048 + (j & 1) * 512);
    int ks_cur = 0  , vs_prev = 2  ;
    for (int t = 0; t <= NT; ++t) {
        DA_WAIT_BAR(4);
        const int ks_next = (ks_cur == 2) ? 0 : ks_cur + 1, vs_cur = (vs_prev == 2) ? 0 : vs_prev + 1, vs_next = (vs_cur == 2) ? 0 : vs_cur + 1;
        DA_DMA_K(t + 3, ks_cur); DA_DMA_V(t + 1, vs_next);
        const lds_cptr kpn = kp0 + ks_next * KSLOT; const lds_cptr vp = vp0 + vs_prev * VSLOT;
        if (t < wt) { if (t > 0) step<true, true, VAR>(kpn, vp, qr, kf, o, pw, l_reg); else step<true, false, VAR>(kpn, vp, qr, kf, o, pw, l_reg); }
        else if (t == wt && t > 0) step<false, true, VAR>(kpn, vp, qr, kf, o, pw, l_reg);
        ks_cur = ks_next; vs_prev = vs_cur;
    }
    { auto rr = __builtin_amdgcn_permlane32_swap(__float_as_uint(l_reg), __float_as_uint(l_reg), false, false); l_reg = __uint_as_float(rr[0]) + __uint_as_float(rr[1]); }
    if (hi == 0) wsf[r32] = l_reg;
    DA_WAIT_BAR(0);
    float rli[16];
#pragma unroll
    for (int r = 0; r < 16; ++r) { const float lq = wsf[crow(r, hi)]; rli[r] = (s == 0 ? 1.f : -lam) / lq; }
    int le = lane; asm volatile("" : "+v"(le));
    const int r32e = le & 31, hie = le >> 5;
    float* xch = (float*)(shm + g * XCHB);
    if (s == 1 && wt > 0) {
#pragma unroll
        for (int db = 0; db < 4; ++db)
#pragma unroll
            for (int r = 0; r < 16; ++r) xch[(db * 16 + r) * 64 + le] = o[db][r] * rli[r];
    }
    DA_WAIT_BAR(0);
    if (s == 0 && wt > 0) {
#pragma unroll
        for (int db = 0; db < 4; ++db)
#pragma unroll
            for (int r = 0; r < 16; ++r) o[db][r] = o[db][r] * rli[r] + xch[(db * 16 + r) * 64 + le];
        asm volatile("s_waitcnt lgkmcnt(0)" ::: "memory");
#pragma unroll
        for (int db = 0; db < 4; ++db)
#pragma unroll
            for (int r = 0; r < 16; ++r) xch[crow(r, hie) * STP + 32 * db + r32e] = o[db][r];
        asm volatile("s_waitcnt lgkmcnt(0)" ::: "memory");
        const int row = le >> 1, half = le & 1;
        float v[64]; float ss = 0.f;
#pragma unroll
        for (int k = 0; k < 16; ++k) { const f32x4 x = *(const f32x4*)(xch + row * STP + half * 64 + 4 * k); v[4 * k] = x.x; v[4 * k + 1] = x.y; v[4 * k + 2] = x.z; v[4 * k + 3] = x.w; ss += (x.x * x.x + x.y * x.y) + (x.z * x.z + x.w * x.w); }
        ss += __shfl_xor(ss, 1);
        const float sc = one_m_li / sqrtf(ss * (1.f / 128.f) + EPS);
        const bf16* gp = u.G + (long)(32 * g + row) * DM + half * 64; bf16* op = u.AO + (long)(32 * g + row) * DM + half * 64; const float* sg = sub_gain + half * 64;
#pragma unroll
        for (int k = 0; k < 8; ++k) { const v4u g4 = *(const v4u*)(gp + 8 * k); const f32x4 ga = *(const f32x4*)(sg + 8 * k), gb = *(const f32x4*)(sg + 8 * k + 4);
            const float gg[8] = {bflo(g4.x), bfhi(g4.x), bflo(g4.y), bfhi(g4.y), bflo(g4.z), bfhi(g4.z), bflo(g4.w), bfhi(g4.w)};
            const float gn[8] = {ga.x, ga.y, ga.z, ga.w, gb.x, gb.y, gb.z, gb.w}; float y[8];
#pragma unroll
            for (int e = 0; e < 8; ++e) y[e] = v[8 * k + e] * sc * gn[e] * silu_f(gg[e]);
            v4u w; w.x = pk2(y[0], y[1]); w.y = pk2(y[2], y[3]); w.z = pk2(y[4], y[5]); w.w = pk2(y[6], y[7]);
            *(v4u*)(op + 8 * k) = w; }
    }
    DA_WAIT_BAR(0);
#undef DA_DMA_K
#undef DA_DMA_V
}
}
template <int VAR = 0>
__device__ __forceinline__ void attn_fast(Frame& F, const bf16* Qs, const bf16* KP, const bf16* VP, const bf16* KC, const bf16* VC, const bf16* GA  , bf16* AO,
                                          float lam, float one_m_li, const float* sub_gain, int dma0 = 0) {
    const int NU = 2048 + 16 * NB;
    const bool xcd = (F.G == 256);
    for (int i = 0;; ++i) {
        int qb, h, b = -1;
        if (xcd) { const int x = F.bid & 7, r = F.bid >> 3;
            if (i < 8) { h = x + 8 * (i >> 2); qb = 127 - ((i & 3) * 32 + ((i & 1) ? 31 - r : r)); }
            else if (i == 8 && r < 16) { h = x + 8 * (r >> 3); b = r & 7; qb = 0; }
            else break;
        } else { const int idx = i * F.G + ((i & 1) ? F.G - 1 - F.bid : F.bid); if (idx >= NU) break;
            if (idx < 2048) { qb = 127 - (idx >> 4); h = idx & 15; } else { const int j = idx - 2048; b = j >> 4; h = j & 15; qb = 0; } }
        dattn::Unit u; u.dma0 = dma0;
        if (b < 0) { const long row0 = 128L * qb;
            u.Q = Qs + row0 * DM + h * 128; u.K = KP + h * 128; u.V = VP + h * 128; u.G = GA + row0 * DM + h * 128; u.AO = AO + row0 * DM + h * 128; u.NT = 2 * qb + 2; u.full = 1; }
        else { const long row0 = MP + 64L * b;
            u.Q = Qs + row0 * DM + h * 128; u.K = KC + (long)b * KCROWS * DM + h * 128; u.V = VC + (long)b * KCROWS * DM + h * 128; u.G = GA + row0 * DM + h * 128; u.AO = AO + row0 * DM + h * 128; u.NT = KCROWS / 64; u.full = 0; }
        dattn::attn_unit<VAR>(u, (char*)F.lds + RING_OFF, lam, one_m_li, sub_gain);
    }
}
constexpr int RBLK = 72;
__device__ __forceinline__ float ret_lg2(int h) { return log2f(1.f - exp2f(-5.f - (float)h)); }
struct EpiRet {
    static constexpr int BMODE = 0;
    pg8::bf16_t* QP; pg8::bf16_t* KN; pg8::bf16_t* KT; pg8::bf16_t* VS; pg8::bf16_t* RG; const float* tab;
    __device__ __forceinline__ void operator()(const pg8::f32x4 (&acc)[2][2][4][2], const pg8::Unit& u, int wr, int wc, int fr, int fq) const {
        asm volatile("" : "+v"(fr), "+v"(fq));
        const int pn = u.pn, pm = u.pm;
#pragma unroll
        for (int ai = 0; ai < 2; ++ai)
#pragma unroll
            for (int m = 0; m < 4; ++m) {
                const int i = ai * 128 + wr * 64 + m * 16 + fr; const size_t row = (size_t)pm * 256 + i;
                const int J = pm < 64 ? pm : 64 + 4 * (pm - 64) + (i >> 6), jj = pm < 64 ? i : (i & 63), pos = pm < 64 ? (int)row : PAST + (i & 63);
                if (pn < 16) {
                    const int h = pn & 7; const bool isk = pn >= 8; const float sc = isk ? 0.0625f : 1.f;
#pragma unroll
                    for (int n = 0; n < 2; ++n) { const int c1 = wc * 32 + n * 16 + 4 * fq;
                        const pg8::f32x4 t0 = *(const pg8::f32x4*)(tab + ((size_t)pos * 128 + c1) * 2), t1 = *(const pg8::f32x4*)(tab + ((size_t)pos * 128 + c1) * 2 + 4);
                        const pg8::f32x4 x1 = acc[ai][0][m][n], x2 = acc[ai][1][m][n];
                        const float cs[4] = {t0[0], t0[2], t1[0], t1[2]}, sn[4] = {t0[1], t0[3], t1[1], t1[3]}; float o1[4], o2[4];
#pragma unroll
                        for (int e = 0; e < 4; ++e) { o1[e] = (x1[e] * cs[e] - x2[e] * sn[e]) * sc; o2[e] = (x2[e] * cs[e] + x1[e] * sn[e]) * sc; }
                        v2u w1, w2; w1.x = pk2(o1[0], o1[1]); w1.y = pk2(o1[2], o1[3]); w2.x = pk2(o2[0], o2[1]); w2.y = pk2(o2[2], o2[3]);
                        if (!isk) { pg8::bf16_t* p = QP + row * 4096 + h * 512 + 256 + c1; *(v2u*)p = w1; *(v2u*)(p + 128) = w2; }
                        else { pg8::bf16_t* p = KN + row * 2048 + h * 256 + c1; *(v2u*)p = w1; *(v2u*)(p + 128) = w2;
                            pg8::bf16_t* t = KT + ((size_t)(J * 8 + h) * 256 + c1) * 256 + jj;
#pragma unroll
                            for (int e = 0; e < 4; ++e) { t[(size_t)e * 256] = (pg8::bf16_t)f2bf(o1[e]); t[(size_t)(128 + e) * 256] = (pg8::bf16_t)f2bf(o2[e]); } } }
                } else if (pn < 32) {
                    const int h = (pn - 16) >> 1, half = (pn - 16) & 1; const float f = exp2f(-(float)(1 + jj) * ret_lg2(h));
#pragma unroll
                    for (int bj = 0; bj < 2; ++bj)
#pragma unroll
                        for (int n = 0; n < 2; ++n) { const int dv = half * 256 + bj * 128 + wc * 32 + n * 16 + 4 * fq; pg8::bf16_t* t = VS + ((size_t)(J * 8 + h) * 512 + dv) * 512 + jj;
#pragma unroll
                            for (int e = 0; e < 4; ++e) t[(size_t)e * 512] = (pg8::bf16_t)f2bf(acc[ai][bj][m][n][e] * f); }
                } else {
#pragma unroll
                    for (int bj = 0; bj < 2; ++bj)
#pragma unroll
                        for (int n = 0; n < 2; ++n) { const int c = (pn - 32) * 256 + bj * 128 + wc * 32 + n * 16 + 4 * fq; const pg8::f32x4 x = acc[ai][bj][m][n];
                            v2u w; w.x = pk2(x[0], x[1]); w.y = pk2(x[2], x[3]); *(v2u*)(RG + row * 4096 + c) = w; }
                }
            }
    }
};
__device__ __forceinline__ size_t ret_row0(int J) { return J < 64 ? (size_t)256 * J : (size_t)MP + 64 * (J - 64); }
struct RetQKOrder {
    int G, c; const char* QP; const char* KN;
    __device__ __forceinline__ bool next(int i, pg8::Unit& u) const { const int L = i * G + c; if (L >= RBLK * 8) return false; const int J = L >> 3, h = L & 7; const size_t r0 = ret_row0(J);
        u.pm = J; u.pn = h; u.a = QP + (r0 * 4096 + h * 512 + 256) * 2; u.b = KN + (r0 * 2048 + h * 256) * 2; return true; }
    __device__ __forceinline__ void a_ready(const pg8::Unit&) const {}
    __device__ __forceinline__ void done(const pg8::Unit&) const {}
};
struct EpiRetQK {
    static constexpr int BMODE = 1;
    pg8::bf16_t* QP;
    __device__ __forceinline__ void operator()(const pg8::f32x4 (&acc)[2][2][4][2], const pg8::Unit& u, int wr, int wc, int fr, int fq) const {
        asm volatile("" : "+v"(fr), "+v"(fq));
        const int J = u.pm, h = u.pn, nv = J < 64 ? 256 : 64; const size_t r0 = ret_row0(J);
#pragma unroll
        for (int ai = 0; ai < 2; ++ai)
#pragma unroll
            for (int m = 0; m < 4; ++m) { const int i = ai * 128 + wr * 64 + m * 16 + fr;
                if (i < nv) {
#pragma unroll
                    for (int bj = 0; bj < 2; ++bj) { const int j0 = bj * 128 + wc * 32 + 8 * fq; const pg8::f32x4 v0 = acc[ai][bj][m][0], v1 = acc[ai][bj][m][1]; float x[8] = {v0[0], v0[1], v0[2], v0[3], v1[0], v1[1], v1[2], v1[3]};
#pragma unroll
                        for (int k = 0; k < 8; ++k) x[k] = (j0 + k <= i) ? x[k] : 0.f;
                        v4u w; w.x = pk2(x[0], x[1]); w.y = pk2(x[2], x[3]); w.z = pk2(x[4], x[5]); w.w = pk2(x[6], x[7]);
                        *(v4u*)(QP + (r0 + i) * 4096 + h * 512 + j0) = w; } } }
    }
};
struct RetOOrder {
    int G, c; const char* QP; const char* VS;
    __device__ __forceinline__ bool next(int i, pg8::Unit& u) const { const int L = i * G + c; if (L >= RBLK * 16) return false; const int J = L >> 4, r = L & 15, h = r >> 1, half = r & 1; const size_t r0 = ret_row0(J);
        u.pm = J; u.pn = r; u.a = QP + (r0 * 4096 + h * 512) * 2; u.b = VS + (((size_t)(J * 8 + h) * 512 + half * 256) * 512) * 2; return true; }
    __device__ __forceinline__ void a_ready(const pg8::Unit&) const {}
    __device__ __forceinline__ void done(const pg8::Unit&) const {}
};
struct EpiRetO {
    static constexpr int BMODE = 1;
    pg8::bf16_t* O;
    __device__ __forceinline__ void operator()(const pg8::f32x4 (&acc)[2][2][4][2], const pg8::Unit& u, int wr, int wc, int fr, int fq) const {
        asm volatile("" : "+v"(fr), "+v"(fq));
        const int J = u.pm, h = u.pn >> 1, half = u.pn & 1, nv = J < 64 ? 256 : 64; const size_t r0 = ret_row0(J); const float lg = ret_lg2(h);
#pragma unroll
        for (int ai = 0; ai < 2; ++ai)
#pragma unroll
            for (int m = 0; m < 4; ++m) { const int i = ai * 128 + wr * 64 + m * 16 + fr;
                if (i < nv) { const float f = exp2f((float)(i + 1) * lg);
#pragma unroll
                    for (int bj = 0; bj < 2; ++bj) { const int j0 = bj * 128 + wc * 32 + 8 * fq; const pg8::f32x4 v0 = acc[ai][bj][m][0] * f, v1 = acc[ai][bj][m][1] * f;
                        v4u w; w.x = pk2(v0[0], v0[1]); w.y = pk2(v0[2], v0[3]); w.z = pk2(v1[0], v1[1]); w.w = pk2(v1[2], v1[3]);
                        *(v4u*)(O + (r0 + i) * 4096 + h * 512 + half * 256 + j0) = w; } } }
    }
};
__device__ __forceinline__ void ret_scan(Frame& F, const bf16* KT, bf16* VS, const float* state_in, float* osp, float* oss) {
    typedef short bf16x8 __attribute__((ext_vector_type(8)));
    const int lane = F.lane, j = lane & 15, kg = lane >> 4, w = F.wave;
    for (int it = F.bid; it < 256; it += F.G) {
        const int h = it >> 5, dv0 = (it & 31) * 16, dk0 = w * 32; const float lg = ret_lg2(h), g256 = exp2f(256.f * lg), g64 = exp2f(64.f * lg);
        f32x4 acc[2]; acc[0] = (f32x4){0.f, 0.f, 0.f, 0.f}; acc[1] = acc[0];
        for (int J = 0; J < RBLK; ++J) {
            const size_t bh = (size_t)(J * 8 + h);
            if (J >= 64) { const float* si = state_in + ((size_t)(J - 64) * 8 + h) * 256 * 512;
#pragma unroll
                for (int nt = 0; nt < 2; ++nt)
#pragma unroll
                    for (int e = 0; e < 4; ++e) acc[nt][e] = si[(size_t)(dk0 + 16 * nt + j) * 512 + dv0 + 4 * kg + e]; }
#pragma unroll
            for (int nt = 0; nt < 2; ++nt)
#pragma unroll
                for (int e = 0; e < 4; ++e) VS[(bh * 512 + dv0 + 4 * kg + e) * 512 + 256 + dk0 + 16 * nt + j] = (bf16)f2bf(acc[nt][e]);
            const int nks = J < 64 ? 8 : 2;
            const bf16* xp = VS + (bh * 512 + dv0 + j) * 512 + 8 * kg; const bf16* yp = KT + (bh * 256 + dk0 + j) * 256 + 8 * kg;
            if (J < 64) {
                bf16x8 x[8], y0[8], y1[8];
#pragma unroll
                for (int ks = 0; ks < 8; ++ks) { x[ks] = *(const bf16x8*)(xp + ks * 32); y0[ks] = *(const bf16x8*)(yp + ks * 32); y1[ks] = *(const bf16x8*)(yp + 16 * 256 + ks * 32); }
#pragma unroll
                for (int ks = 0; ks < 8; ++ks) { acc[0] = __builtin_amdgcn_mfma_f32_16x16x32_bf16(x[ks], y0[ks], acc[0], 0, 0, 0); acc[1] = __builtin_amdgcn_mfma_f32_16x16x32_bf16(x[ks], y1[ks], acc[1], 0, 0, 0); }
                acc[0] = acc[0] * g256; acc[1] = acc[1] * g256;
                if (J == 63) {
#pragma unroll
                    for (int nt = 0; nt < 2; ++nt)
#pragma unroll
                        for (int e = 0; e < 4; ++e) osp[((size_t)h * 256 + dk0 + 16 * nt + j) * 512 + dv0 + 4 * kg + e] = acc[nt][e]; }
            } else {
                (void)nks;
#pragma unroll
                for (int ks = 0; ks < 2; ++ks) { const bf16x8 x = *(const bf16x8*)(xp + ks * 32), y0 = *(const bf16x8*)(yp + ks * 32), y1 = *(const bf16x8*)(yp + 16 * 256 + ks * 32);
                    acc[0] = __builtin_amdgcn_mfma_f32_16x16x32_bf16(x, y0, acc[0], 0, 0, 0); acc[1] = __builtin_amdgcn_mfma_f32_16x16x32_bf16(x, y1, acc[1], 0, 0, 0); }
                float* so = oss + ((size_t)(J - 64) * 8 + h) * 256 * 512;
#pragma unroll
                for (int nt = 0; nt < 2; ++nt)
#pragma unroll
                    for (int e = 0; e < 4; ++e) so[(size_t)(dk0 + 16 * nt + j) * 512 + dv0 + 4 * kg + e] = acc[nt][e] * g64;
            }
        }
    }
}
__device__ __forceinline__ void ret_zero_pad(Frame& F, bf16* VS) {
    const size_t gt = (size_t)F.bid * NTHR + F.tid, NG = (size_t)F.G * NTHR, n = (size_t)NB * 8 * 512 * 24;
    for (size_t i = gt; i < n; i += NG) { const size_t rowi = i / 24, c = i % 24; *(v4u*)(VS + ((size_t)64 * 8 * 512 + rowi) * 512 + 64 + c * 8) = (v4u){0u, 0u, 0u, 0u}; }
}
__device__ __forceinline__ void ret_table(Frame& F, float* tab) {
    const size_t gt = (size_t)F.bid * NTHR + F.tid, NG = (size_t)F.G * NTHR;
    for (size_t e = gt; e < (size_t)MP * 128; e += NG) { float c, s; rope_cs((int)(e >> 7), (int)(e & 127), 128, c, s); tab[2 * e] = c; tab[2 * e + 1] = s; }
}
__device__ __forceinline__ void r_out(Frame& F, bf16* O, const bf16* RG) {
    const int gw = F.bid * NWAVES + F.wave, NGW = F.G * NWAVES, lane = F.lane;
    for (int it = gw; it < MT * 8; it += NGW) {
        const int row = it >> 3, h = it & 7; const size_t off = (size_t)row * 4096 + h * 512 + lane * 8;
        const v4u o4 = *(const v4u*)(O + off), g4 = *(const v4u*)(RG + off);
        float o[8] = {bflo(o4.x), bfhi(o4.x), bflo(o4.y), bfhi(o4.y), bflo(o4.z), bfhi(o4.z), bflo(o4.w), bfhi(o4.w)};
        const float g[8] = {bflo(g4.x), bfhi(g4.x), bflo(g4.y), bfhi(g4.y), bflo(g4.z), bfhi(g4.z), bflo(g4.w), bfhi(g4.w)};
        float ss = 0.f;
#pragma unroll
        for (int k = 0; k < 8; ++k) ss += o[k] * o[k];
        const float rstd = 1.f / sqrtf(wave_sum(ss) * (1.f / 512.f) + EPS);
#pragma unroll
        for (int k = 0; k < 8; ++k) o[k] = o[k] * rstd * silu_f(g[k]);
        v4u w; w.x = pk2(o[0], o[1]); w.y = pk2(o[2], o[3]); w.z = pk2(o[4], o[5]); w.w = pk2(o[6], o[7]);
        *(v4u*)(O + off) = w;
    }
}
struct EpiCIn {
    static constexpr int BMODE = 0;
    pg8::bf16_t* GU; pg8::bf16_t* GVT; pg8::bf16_t* SG; pg8::bf16_t* GVS; float* SSQ;
    __device__ __forceinline__ void operator()(const pg8::f32x4 (&acc)[2][2][4][2], const pg8::Unit& u, int wr, int wc, int fr, int fq) const {
        asm volatile("" : "+v"(fr), "+v"(fq));
        const int pn = u.pn, pm = u.pm, typ = pn >> 4, pt = pn & 15;
#pragma unroll
        for (int ai = 0; ai < 2; ++ai)
#pragma unroll
            for (int m = 0; m < 4; ++m) {
                const int i = ai * 128 + wr * 64 + m * 16 + fr; const size_t row = (size_t)pm * 256 + i; float ss = 0.f;
#pragma unroll
                for (int bj = 0; bj < 2; ++bj)
#pragma unroll
                    for (int n = 0; n < 2; ++n) { const int c = pt * 256 + bj * 128 + wc * 32 + n * 16 + 4 * fq; const pg8::f32x4 x = acc[ai][bj][m][n]; float y[4];
                        if (typ == 2) {
#pragma unroll
                            for (int e = 0; e < 4; ++e) y[e] = silu_f(x[e]);
                            v2u w; w.x = pk2(y[0], y[1]); w.y = pk2(y[2], y[3]); *(v2u*)(SG + row * 4096 + c) = w;
                        } else {
#pragma unroll
                            for (int e = 0; e < 4; ++e) y[e] = gelu_tanh_f(x[e]);
                            v2u w; w.x = pk2(y[0], y[1]); w.y = pk2(y[2], y[3]);
                            if (typ == 0) *(v2u*)(GU + row * 4096 + c) = w;
                            else { ss += (y[0] * y[0] + y[1] * y[1]) + (y[2] * y[2] + y[3] * y[3]);
                                pg8::bf16_t* t = GVT + ((size_t)pm * 4096 + c) * 256 + i;
                                t[0] = (pg8::bf16_t)(w.x & 0xffffu); t[256] = (pg8::bf16_t)(w.x >> 16); t[512] = (pg8::bf16_t)(w.y & 0xffffu); t[768] = (pg8::bf16_t)(w.y >> 16);
                                if (pm >= 64) *(v2u*)(GVS + (row - MP) * 4096 + c) = w; } } }
                if (typ == 1) { ss += __shfl_xor(ss, 16); ss += __shfl_xor(ss, 32); if (fq == 0) SSQ[row * 64 + pt * 4 + wc] = ss; }
                if (m & 1) asm volatile("" ::: "memory");
            }
    }
};
__device__ __forceinline__ void c_prep(Frame& F, const float* SSQ, const float* wsin, const float* vgain, const bf16* GVS, bf16* Wm, float* ovm) {
    LAS float* rs = (LAS float*)(F.lds + RING_OFF);
    const int tid = F.tid;
    for (int it = F.bid; it < 66 * 8; it += F.G) {
        const int J = it >> 3, g = it & 7; const int cl = J < 64 ? 128 : 64;
        __syncthreads();
        if (tid < 256) { const float* p = SSQ + ((size_t)J * 256 + tid) * 64; float s = 0.f;
#pragma unroll
            for (int k = 0; k < 16; ++k) { const f32x4 x = *(const f32x4*)(p + 4 * k); s += (x.x + x.y) + (x.z + x.w); }
            rs[tid] = 1.f / sqrtf(s * (1.f / 4096.f) + EPS); }
        __syncthreads();
        bf16* wm = Wm + (size_t)(J * 8 + g) * 65536;
        for (int e8 = tid; e8 < 8192; e8 += NTHR) { const int i = e8 >> 5, j0 = (e8 & 31) * 8; float y[8];
#pragma unroll
            for (int k = 0; k < 8; ++k) { const int j = j0 + k; const bool on = (i / cl == j / cl) && (j % cl <= i % cl);
                y[k] = on ? wsin[((size_t)g * 128 + (i % cl)) * 128 + (j % cl)] * rs[j] : 0.f; }
            v4u w; w.x = pk2(y[0], y[1]); w.y = pk2(y[2], y[3]); w.z = pk2(y[4], y[5]); w.w = pk2(y[6], y[7]);
            *(v4u*)(wm + i * 256 + j0) = w; }
    }
    const int gw = F.bid * NWAVES + F.wave, NGW = F.G * NWAVES, lane = F.lane;
    for (int r = gw; r < MS; r += NGW) {
        const float rstd = 1.f / sqrtf(wave_sum(SSQ[((size_t)MP + r) * 64 + lane]) * (1.f / 4096.f) + EPS);
#pragma unroll
        for (int k = 0; k < 8; ++k) { const int col = k * 512 + lane * 8; const v4u v4 = *(const v4u*)(GVS + (size_t)r * 4096 + col);
            const f32x4 ga = *(const f32x4*)(vgain + col), gb = *(const f32x4*)(vgain + col + 4);
            float* o = ovm + (size_t)r * 4096 + col;
            *(f32x4*)o = (f32x4){bflo(v4.x) * rstd * ga.x, bfhi(v4.x) * rstd * ga.y, bflo(v4.y) * rstd * ga.z, bfhi(v4.y) * rstd * ga.w};
            *(f32x4*)(o + 4) = (f32x4){bflo(v4.z) * rstd * gb.x, bfhi(v4.z) * rstd * gb.y, bflo(v4.w) * rstd * gb.z, bfhi(v4.w) * rstd * gb.w}; }
    }
}
struct CMixOrder {
    int G, c; const char* Wm; const char* GVT;
    __device__ __forceinline__ bool next(int i, pg8::Unit& u) const { const int L = i * G + c; if (L >= 66 * 16) return false; const int J = L >> 4, nt = L & 15;
        u.pm = J; u.pn = nt; u.a = Wm + ((size_t)(J * 8 + (nt >> 1)) * 65536) * 2; u.b = GVT + (((size_t)J * 4096 + nt * 256) * 256) * 2; return true; }
    __device__ __forceinline__ void a_ready(const pg8::Unit&) const {}
    __device__ __forceinline__ void done(const pg8::Unit&) const {}
};
struct EpiCMix {
    static constexpr int BMODE = 1;
    pg8::bf16_t* GU; const pg8::bf16_t* SG; const float* vgain; const float* bs;
    __device__ __forceinline__ void operator()(const pg8::f32x4 (&acc)[2][2][4][2], const pg8::Unit& u, int wr, int wc, int fr, int fq) const {
        asm volatile("" : "+v"(fr), "+v"(fq));
        const int J = u.pm, nt = u.pn, g = nt >> 1, cm = J < 64 ? 127 : 63;
#pragma unroll
        for (int bj = 0; bj < 2; ++bj) { const int c0 = nt * 256 + bj * 128 + wc * 32 + 8 * fq; const f32x4 ga = *(const f32x4*)(vgain + c0), gb = *(const f32x4*)(vgain + c0 + 4);
            const float gn[8] = {ga.x, ga.y, ga.z, ga.w, gb.x, gb.y, gb.z, gb.w};
#pragma unroll
            for (int ai = 0; ai < 2; ++ai)
#pragma unroll
                for (int m = 0; m < 4; ++m) { const int i = ai * 128 + wr * 64 + m * 16 + fr; const size_t off = ((size_t)J * 256 + i) * 4096 + c0; const float b = bs[g * 128 + (i & cm)];
                    const v4u u4 = *(const v4u*)(GU + off), s4 = *(const v4u*)(SG + off); const pg8::f32x4 v0 = acc[ai][bj][m][0], v1 = acc[ai][bj][m][1];
                    const float mx[8] = {v0[0], v0[1], v0[2], v0[3], v1[0], v1[1], v1[2], v1[3]};
                    const float uu[8] = {bflo(u4.x), bfhi(u4.x), bflo(u4.y), bfhi(u4.y), bflo(u4.z), bfhi(u4.z), bflo(u4.w), bfhi(u4.w)};
                    const float sg[8] = {bflo(s4.x), bfhi(s4.x), bflo(s4.y), bfhi(s4.y), bflo(s4.z), bfhi(s4.z), bflo(s4.w), bfhi(s4.w)}; float y[8];
#pragma unroll
                    for (int k = 0; k < 8; ++k) y[k] = uu[k] * (mx[k] * gn[k] + b) * sg[k];
                    v4u w; w.x = pk2(y[0], y[1]); w.y = pk2(y[2], y[3]); w.z = pk2(y[4], y[5]); w.w = pk2(y[6], y[7]);
                    *(v4u*)(GU + off) = w; } }
    }
};
__device__ __forceinline__ float diff_lambda(const float* q1, const float* k1, const float* q2, const float* k2, float lam_init) {
    float a = 0.f, b = 0.f;
    for (int i = 0; i < 64; ++i) { a += q1[i] * k1[i]; b += q2[i] * k2[i]; }
    return expf(a) - expf(b) + lam_init;
}

constexpr int N_PHASES = 21;
__global__ void __launch_bounds__(NTHR, 2) mega(Args args) {
    extern __shared__ __attribute__((aligned(16))) unsigned char lds[];
    Frame F;
    F.lds = (LAS unsigned char*)lds; F.tid = threadIdx.x; F.lane = F.tid & 63; F.wave = __builtin_amdgcn_readfirstlane(F.tid >> 6); F.G = gridDim.x; F.bid = blockIdx.x;
    F.in = args.in; F.out = args.out; F.ws = args.ws;
    unsigned char* ws = args.ws; float* out = args.out;
    bf16* W_AIN[2] = {(bf16*)(ws + WS_WAIN0), (bf16*)(ws + WS_WAIN1)}; bf16* W_AOUT[2] = {(bf16*)(ws + WS_WAOUT0), (bf16*)(ws + WS_WAOUT1)};
    bf16* W_RIN = (bf16*)(ws + WS_WRIN); bf16* W_ROUT = (bf16*)(ws + WS_WROUT); bf16* W_CIN = (bf16*)(ws + WS_WCIN); bf16* W_COUT = (bf16*)(ws + WS_WCOUT);
    bf16* XN = (bf16*)(ws + WS_XN); bf16* Z = (bf16*)(ws + WS_Z);
    bf16* Qs = (bf16*)(ws + WS_QS); bf16* KP = (bf16*)(ws + WS_KP); bf16* VP = (bf16*)(ws + WS_VP); bf16* KC = (bf16*)(ws + WS_KC); bf16* VC = (bf16*)(ws + WS_VC); bf16* AO_A = (bf16*)(ws + WS_AOA);
    bf16* KT = (bf16*)(ws + WS_KT); bf16* RG = (bf16*)(ws + WS_RG); bf16* QP = (bf16*)(ws + WS_QP); bf16* KN = (bf16*)(ws + WS_KN); bf16* VS = (bf16*)(ws + WS_VS); bf16* ORET = (bf16*)(ws + WS_ORET);
    bf16* GU = (bf16*)(ws + WS_GU); bf16* SG = (bf16*)(ws + WS_SG); bf16* GVT = (bf16*)(ws + WS_GVT); bf16* WM = (bf16*)(ws + WS_WM); float* SSQ = (float*)(ws + WS_SSQ); bf16* GVS = (bf16*)(ws + WS_GVS); float* TABR = (float*)(ws + WS_TABR); float* TABA = (float*)(ws + WS_TABA); bf16* GA = (bf16*)(ws + WS_GA);
    const int lo = args.ph_lo, hi = args.ph_hi;
    volatile LAS unsigned* MISC = (volatile LAS unsigned*)(F.lds + MISC_OFF);
    for (int u = F.tid; u < (LDS_BYTES - MISC_OFF) / 4; u += NTHR) ((LAS unsigned*)(F.lds + MISC_OFF))[u] = 0u;
    __syncthreads();
    XcdBarrier bar = xcd_barrier_post((unsigned*)(ws + WS_CTL) + 4096, MISC + 8);
#define IN(k) (lo <= (k) && (k) < hi)
#define PH_ENTER() do { int t_ = threadIdx.x; asm volatile("" : "+v"(t_)); F.tid = t_; F.lane = t_ & 63; } while (0)
    volatile LAS int* DRW = (volatile LAS int*)(F.lds + MISC_OFF + 64);
    unsigned* DCTR = (unsigned*)(ws + WS_CTL) + 8192;
#define DRAIN(ph, total, BODY) do { for (;;) { __syncthreads(); if (F.tid == 0) DRW[0] = (int)atomicAdd(DCTR + 64 * (ph), 1u); __syncthreads(); const int c_ = DRW[0]; if (c_ >= (total)) break; BODY } } while (0)
#define SEAM(k) do { if (IN(k) && IN((k) + 1)) xcd_barrier(bar); } while (0)

#define GEMM_STORE(Aptr, Wptr, NN, KK, Optr) do { pg8::GemmP g{KK, KK, (KK) / 64}; pg8::StaticOrder S; S.init(MT / 256, (NN) / 256, F.G, F.bid, Aptr, Wptr, KK, KK); pg8::EpiStoreBf16 E{(pg8::bf16_t*)(Optr), NN}; \
        pg8::gemm_phase<pg8::EpiStoreBf16, pg8::StaticOrder>(F.lds + RING_OFF, g, S, E); } while (0)
#define GEMM_RESID(Aptr, Wptr, KK, BP, BS) do { pg8::GemmP g{KK, KK, (KK) / 64}; pg8::StaticOrder S; S.init(MT / 256, DM / 256, F.G, F.bid, Aptr, Wptr, KK, KK); pg8::EpiResid E{BP, BS, out, MP}; \
        pg8::gemm_phase<pg8::EpiResid, pg8::StaticOrder>(F.lds + RING_OFF, g, S, E); } while (0)

    PH_ENTER(); if (IN(0)) {
        transpose_weight(F, args.in[I_AWIN], 2048, 8192, W_AIN[0]); attn_table(F, TABA);
        norm_rows(F, args.in[I_XP], args.in[I_XS], args.in[I_NW], XN);
    }
    SEAM(0);
#define GEMM_AIN(Wptr, J_) do { pg8::GemmP g{2048, 2048, 32}; pg8::StaticOrder S; S.init(MT / 256, 32, F.G, F.bid, XN, Wptr, 2048, 2048); \
        EpiAIn E{Qs, KP, VP, KC, VC, GA, out + O_KP + (size_t)(J_) * MP * DM, out + O_VP + (size_t)(J_) * MP * DM, out + O_KS + (size_t)(J_) * MS * DM, out + O_VS + (size_t)(J_) * MS * DM, TABA, args.in[I_AQG] + 64 * (J_), args.in[I_AKG] + 64 * (J_)}; \
        pg8::gemm_phase<EpiAIn, pg8::StaticOrder>(F.lds + RING_OFF, g, S, E); } while (0)
    PH_ENTER(); if (IN(1)) { GEMM_AIN(W_AIN[0], 0);
        const int n0 = CC_CHUNKS, n1 = n0 + tw_chunks(2048, 2048), n2 = n1 + TR_CHUNKS;
        DRAIN(1, n2, if (c_ < n0) cc_run(F, args.in[I_CK], args.in[I_CV], KC, VC, c_); else if (c_ < n1) tw_run(F, args.in[I_AWOUT], 2048, 2048, W_AOUT[0], c_ - n0); else tr_run(F, TABR, c_ - n1);); }
    SEAM(1);
    PH_ENTER(); if (IN(3)) { const float li = 0.8f - 0.6f * expf(-0.3f * 0.f); const float lam = diff_lambda(args.in[I_LQ1], args.in[I_LK1], args.in[I_LQ2], args.in[I_LK2], li);
        attn_fast(F, Qs, KP, VP, KC, VC, GA, AO_A, lam, 1.f - li, args.in[I_ASG]); }
    SEAM(3);
    PH_ENTER(); if (IN(4)) { GEMM_RESID(AO_A, W_AOUT[0], 2048, args.in[I_XP], args.in[I_XS]);
        const int n0 = tw_chunks(2048, 12288), n1 = n0 + tw_chunks(4096, 2048);
        DRAIN(4, n1, if (c_ < n0) tw_run(F, args.in[I_RWIN], 2048, 12288, W_RIN, c_); else tw_run(F, args.in[I_RWOUT], 4096, 2048, W_ROUT, c_ - n0);); }
    SEAM(4);
    PH_ENTER(); if (IN(5)) { norm_rows(F, out + O_YP, out + O_YS, args.in[I_NW] + DM, XN); ret_zero_pad(F, VS); }
    SEAM(5);
    PH_ENTER(); if (IN(6)) { pg8::GemmP g{2048, 2048, 32}; pg8::StaticOrder S; S.init(MT / 256, 48, F.G, F.bid, XN, W_RIN, 2048, 2048); EpiRet E{QP, KN, KT, VS, RG, TABR};
        pg8::gemm_phase<EpiRet, pg8::StaticOrder>(F.lds + RING_OFF, g, S, E); }
    SEAM(6);
    PH_ENTER(); if (IN(7)) { { pg8::GemmP g{4096, 2048, 4}; RetQKOrder S{F.G, F.bid, (const char*)QP, (const char*)KN}; EpiRetQK E{QP}; pg8::gemm_phase<EpiRetQK, RetQKOrder>(F.lds + RING_OFF, g, S, E); }
        ret_scan(F, KT, VS, args.in[I_SR], out + O_SP, out + O_SS); }
    SEAM(7);
    PH_ENTER(); if (IN(8)) { pg8::GemmP g{4096, 512, 8}; RetOOrder S{F.G, F.bid, (const char*)QP, (const char*)VS}; EpiRetO E{ORET}; pg8::gemm_phase<EpiRetO, RetOOrder>(F.lds + RING_OFF, g, S, E); }
    SEAM(8);
    PH_ENTER(); if (IN(9)) r_out(F, ORET, RG);
    SEAM(9);
    PH_ENTER(); if (IN(10)) { GEMM_RESID(ORET, W_ROUT, 4096, out + O_YP, out + O_YS);
        const int n0 = tw_chunks(2048, 12288), n1 = n0 + tw_chunks(4096, 2048), n2 = n1 + tw_chunks(2048, 8192), n3 = n2 + tw_chunks(2048, 2048);
        DRAIN(10, n3, if (c_ < n0) tw_run(F, args.in[I_CWIN], 2048, 12288, W_CIN, c_); else if (c_ < n1) tw_run(F, args.in[I_CWOUT], 4096, 2048, W_COUT, c_ - n0);
                      else if (c_ < n2) tw_run(F, args.in[I_AWIN] + (size_t)2048 * 8192, 2048, 8192, W_AIN[1], c_ - n1); else tw_run(F, args.in[I_AWOUT] + (size_t)2048 * 2048, 2048, 2048, W_AOUT[1], c_ - n2);); }
    SEAM(10);
    PH_ENTER(); if (IN(11)) norm_rows(F, out + O_YP, out + O_YS, args.in[I_NW] + 2 * DM, XN);
    SEAM(11);
    PH_ENTER(); if (IN(12)) { pg8::GemmP g{2048, 2048, 32}; pg8::StaticOrder S; S.init(MT / 256, 48, F.G, F.bid, XN, W_CIN, 2048, 2048); EpiCIn E{GU, GVT, SG, GVS, SSQ};
        pg8::gemm_phase<EpiCIn, pg8::StaticOrder>(F.lds + RING_OFF, g, S, E); }
    SEAM(12);
    PH_ENTER(); if (IN(13)) c_prep(F, SSQ, args.in[I_CWS], args.in[I_CVG], GVS, WM, out + O_VM);
    SEAM(13);
    PH_ENTER(); if (IN(14)) { pg8::GemmP g{256, 256, 4}; CMixOrder S{F.G, F.bid, (const char*)WM, (const char*)GVT}; EpiCMix E{GU, SG, args.in[I_CVG], args.in[I_CBS]}; pg8::gemm_phase<EpiCMix, CMixOrder>(F.lds + RING_OFF, g, S, E); }
    SEAM(14);
    PH_ENTER(); if (IN(15)) { GEMM_RESID(GU, W_COUT, 4096, out + O_YP, out + O_YS);
        DRAIN(15, CC_CHUNKS, cc_run(F, args.in[I_CK] + (size_t)NB * PAST * DM, args.in[I_CV] + (size_t)NB * PAST * DM, KC, VC, c_);); }
    SEAM(15);
    PH_ENTER(); if (IN(16)) norm_rows(F, out + O_YP, out + O_YS, args.in[I_NW] + 3 * DM, XN);
    SEAM(16);
    PH_ENTER(); if (IN(17)) GEMM_AIN(W_AIN[1], 1);
    SEAM(17);
    PH_ENTER(); if (IN(19)) { const float li = 0.8f - 0.6f * expf(-0.3f * 3.f); const float lam = diff_lambda(args.in[I_LQ1] + 64, args.in[I_LK1] + 64, args.in[I_LQ2] + 64, args.in[I_LK2] + 64, li);
        attn_fast(F, Qs, KP, VP, KC, VC, GA, AO_A, lam, 1.f - li, args.in[I_ASG] + 128); }
    SEAM(19);
    PH_ENTER(); if (IN(20)) GEMM_RESID(AO_A, W_AOUT[1], 2048, out + O_YP, out + O_YS);
#undef IN
#undef SEAM
}

extern "C" void kernel_launch(void* const* d_in, const int* in_sizes, int n_in, void* d_out, int out_size, void* d_ws, size_t ws_size, hipStream_t stream) {
    static int grid = 0;
    if (grid == 0) {
        if (n_in != N_IN || (size_t)out_size != O_END || ws_size < WS_END) { fprintf(stderr, "kernel_launch: unexpected shapes: n_in %d out %d ws %zu (need %zu)\n", n_in, out_size, ws_size, (size_t)WS_END); grid = -1; return; }
        int dev = 0, cus = 0;
        if (hipGetDevice(&dev) != hipSuccess || hipDeviceGetAttribute(&cus, hipDeviceAttributeMultiprocessorCount, dev) != hipSuccess) { grid = -1; return; }
        if (hipFuncSetAttribute((const void*)mega, hipFuncAttributeMaxDynamicSharedMemorySize, LDS_BYTES) != hipSuccess) { fprintf(stderr, "kernel_launch: hipFuncSetAttribute failed\n"); grid = -1; return; }
        (void)hipGetLastError();
        grid = cus;
    }
    if (grid < 0) return;
    Args a{};
    for (int i = 0; i < N_IN; ++i) a.in[i] = (const float*)d_in[i];
    a.out = (float*)d_out; a.ws = (unsigned char*)d_ws;
    (void)hipMemsetAsync((char*)d_ws + WS_CTL, 0, CTL_ZERO_BYTES, stream);
    a.ph_lo = 0; a.ph_hi = N_PHASES;
    hipLaunchKernelGGL(mega, dim3(grid), dim3(NTHR), LDS_BYTES, stream, a);
}
```

```cpp
#include <hip/hip_runtime.h>
#include <cstdio>
#include <cstdint>

__device__ __forceinline__ int lane_now() { int l; asm volatile("v_mbcnt_lo_u32_b32 %0, -1, 0\n\tv_mbcnt_hi_u32_b32 %0, -1, %0" : "=v"(l)); return l; }
namespace pg8 {
#define PG8_LAS __attribute__((address_space(3)))
typedef unsigned short bf16_t;
typedef short bf16x8 __attribute__((ext_vector_type(8)));
typedef float f32x4 __attribute__((ext_vector_type(4)));
typedef unsigned u32x4 __attribute__((ext_vector_type(4)));
constexpr int BM = 256, BK = 64, HALF = 128, HTB = HALF * BK * 2, STAGE_BYTES = 8 * HTB, NXCD = 8, WGM = 8;

__host__ __device__ __forceinline__ int lds_byte(int r, int c) { const int st = (r >> 4) * 2 + (c >> 5), rr = r & 15, cc = c & 31, ob = rr * 64 + cc * 2; return st * 1024 + (ob ^ (((ob >> 9) & 1) << 5)); }
__host__ __device__ __forceinline__ void stage_rc(int b, int& R, int& C) { const int st = b / 1024, sb = b % 1024, swz = sb ^ (((sb >> 9) & 1) << 5); R = (st >> 1) * 16 + swz / 64; C = (st & 1) * 32 + (swz % 64) / 2; }
__host__ __device__ __forceinline__ int perm32(int rho) { const int n = rho >> 4, i = rho & 15; return 8 * (i >> 2) + 4 * n + (i & 3); }

struct Unit { int pm, pn; const char* a; const char* b; };
struct GemmP { int lda, ldb, nt; };

struct StaticOrder {
    int nM, nN, nwg, G, c; const char* A; const char* B; size_t ta, tb;
    __host__ __device__ void init(int nM_, int nN_, int G_, int c_, const void* A_, const void* B_, int lda, int ldb) { nM = nM_; nN = nN_; nwg = nM * nN; G = G_; c = c_; A = (const char*)A_; B = (const char*)B_; ta = (size_t)BM * lda * 2; tb = (size_t)BM * ldb * 2; }
    __host__ __device__ bool next(int i, Unit& u) const {
        const long L = (long)i * G + c; if (L >= nwg) return false;
        int wgid = (int)L; { const int q = nwg / NXCD, r = nwg % NXCD, xcd = wgid % NXCD, off = wgid / NXCD; wgid = (xcd < r ? xcd * (q + 1) : r * (q + 1) + (xcd - r) * q) + off; }
        const int nig = WGM * nN, gid = wgid / nig, fm = gid * WGM, gsz = (nM - fm) < WGM ? (nM - fm) : WGM;
        u.pm = fm + ((wgid % nig) % gsz); u.pn = (wgid % nig) / gsz; u.a = A + (size_t)u.pm * ta; u.b = B + (size_t)u.pn * tb; return true;
    }
    __device__ __forceinline__ void a_ready(const Unit&) const {}
    __device__ __forceinline__ void done(const Unit&) const {}
};

__device__ __forceinline__ unsigned cvt_pk_bf16(float lo, float hi) { unsigned r; asm volatile("v_cvt_pk_bf16_f32 %0, %1, %2" : "=v"(r) : "v"(lo), "v"(hi)); return r; }

struct EpiStoreBf16 {
    static constexpr int BMODE = 1;
    bf16_t* O; int ldc;
    __device__ __forceinline__ void operator()(const f32x4 (&acc)[2][2][4][2], const Unit& u, int wr, int wc, int fr, int fq) const {
        const int row0 = u.pm * BM + wr * 64 + fr; const int col0 = u.pn * BM + wc * 32 + 8 * fq;
#pragma unroll
        for (int ai = 0; ai < 2; ++ai)
#pragma unroll
            for (int m = 0; m < 4; ++m) { bf16_t* rowp = O + (size_t)(row0 + ai * HALF + m * 16) * ldc + col0;
#pragma unroll
                for (int bj = 0; bj < 2; ++bj) { const f32x4 v0 = acc[ai][bj][m][0], v1 = acc[ai][bj][m][1];
                    u32x4 w; w.x = cvt_pk_bf16(v0[0], v0[1]); w.y = cvt_pk_bf16(v0[2], v0[3]); w.z = cvt_pk_bf16(v1[0], v1[1]); w.w = cvt_pk_bf16(v1[2], v1[3]);
                    *(u32x4*)(rowp + bj * HALF) = w; } }
    }
};
struct EpiResid {
    static constexpr int BMODE = 0;
    const float* base_p; const float* base_s; float* out; int split;
    __device__ __forceinline__ void operator()(const f32x4 (&acc)[2][2][4][2], const Unit& u, int wr, int wc, int fr, int fq) const {
        const int col0 = u.pn * BM + wc * 32 + 4 * fq;
#pragma unroll
        for (int ai = 0; ai < 2; ++ai)
#pragma unroll
            for (int m = 0; m < 4; ++m) { const int r = u.pm * BM + ai * HALF + wr * 64 + m * 16 + fr;
                const float* bp = (r < split) ? base_p + (size_t)r * 2048 : base_s + (size_t)(r - split) * 2048; float* op = out + (size_t)r * 2048;
#pragma unroll
                for (int bj = 0; bj < 2; ++bj)
#pragma unroll
                    for (int n = 0; n < 2; ++n) { const int c = col0 + bj * HALF + n * 16; const f32x4 bs = *(const f32x4*)(bp + c); *(f32x4*)(op + c) = bs + acc[ai][bj][m][n]; }
                if (m & 1) asm volatile("" ::: "memory"); }
    }
};

template <class Epi, class Sched, bool ALIGN_EPI = true>
__device__ __forceinline__ void gemm_phase(PG8_LAS unsigned char* lds, const GemmP g, const Sched& S, const Epi& E, int tid) {
    asm volatile("" : "+v"(tid));
    const int wid = __builtin_amdgcn_readfirstlane(tid >> 6), lane = tid & 63, wr = wid >> 2, wc = wid & 3, fr = lane & 15, fq = lane >> 4;
    const int nt = g.nt;
    unsigned voffA[2], voffB[2];
#pragma unroll
    for (int i = 0; i < 2; ++i) { int R, C; stage_rc(tid * 16 + i * 8192, R, C); const int Rb = Epi::BMODE == 2 ? (64 * (R >> 5) + perm32(R & 31)) : Epi::BMODE == 1 ? ((R & ~31) + perm32(R & 31)) : R;
        voffA[i] = (unsigned)(R * g.lda + C) * 2u; voffB[i] = (unsigned)(Rb * g.ldb + C) * 2u; }
    const size_t kstep = (size_t)(BK * 2);
    const size_t hstepA = (size_t)HALF * g.lda * 2, hstepB = (size_t)(Epi::BMODE == 2 ? 32 : HALF) * g.ldb * 2;
    const unsigned ldsw = (unsigned)wid * 1024u;
    const int aoff = lds_byte(wr * 64 + fr, fq * 8), boff = lds_byte(wc * 32 + fr, fq * 8);
#define PG8_SA(b, h) (((b) * 2 + (h)) * HTB)
#define PG8_SB(b, h) ((4 + (b) * 2 + (h)) * HTB)
#define PG8_STAGE(bufoff, gbase, voff) do { _Pragma("unroll") for (int _i = 0; _i < 2; ++_i) \
        __builtin_amdgcn_global_load_lds((const unsigned*)((const char*)(gbase) + (voff)[_i]), (PG8_LAS unsigned*)(lds + (bufoff) + ldsw + _i * 8192), 16, 0, 0); } while (0)
#define PG8_LDA(dst, b, h) do { _Pragma("unroll") for (int m = 0; m < 4; ++m) _Pragma("unroll") for (int k = 0; k < 2; ++k) dst[m][k] = *(const PG8_LAS bf16x8*)(lds + PG8_SA(b, h) + aoff + m * 2048 + k * 1024); } while (0)
#define PG8_LDB(dst, b, h) do { _Pragma("unroll") for (int n = 0; n < 2; ++n) _Pragma("unroll") for (int k = 0; k < 2; ++k) dst[n][k] = *(const PG8_LAS bf16x8*)(lds + PG8_SB(b, h) + boff + n * 2048 + k * 1024); } while (0)
#define PG8_MMA(ai, bj, At, Bt) do { __builtin_amdgcn_s_setprio(1); _Pragma("unroll") for (int m = 0; m < 4; ++m) _Pragma("unroll") for (int n = 0; n < 2; ++n) _Pragma("unroll") for (int k = 0; k < 2; ++k) \
        acc[ai][bj][m][n] = __builtin_amdgcn_mfma_f32_16x16x32_bf16(Bt[n][k], At[m][k], acc[ai][bj][m][n], 0, 0, 0); __builtin_amdgcn_s_setprio(0); } while (0)
#define PG8_WAIT_V(n) asm volatile("s_waitcnt vmcnt(" #n ")" ::: "memory")
#define PG8_WAIT_L(n) asm volatile("s_waitcnt lgkmcnt(" #n ")" ::: "memory")
#define PG8_BAR __builtin_amdgcn_s_barrier()
#define PG8_SCHED __builtin_amdgcn_sched_barrier(0)
    Unit cur, nxt; int ui = 0;
    if (!S.next(0, cur)) return;
    f32x4 acc[2][2][4][2];
#pragma unroll
    for (int a = 0; a < 2; ++a)
#pragma unroll
        for (int b = 0; b < 2; ++b)
#pragma unroll
            for (int m = 0; m < 4; ++m)
#pragma unroll
                for (int n = 0; n < 2; ++n) acc[a][b][m][n] = (f32x4){0.f, 0.f, 0.f, 0.f};
    bf16x8 At[4][2], B0[2][2], B1[2][2];
    const char* cA = cur.a; const char* cB = cur.b;
    S.a_ready(cur);
    PG8_STAGE(PG8_SB(0, 0), cB, voffB); PG8_STAGE(PG8_SB(0, 1), cB + hstepB, voffB); PG8_STAGE(PG8_SA(0, 0), cA, voffA); PG8_STAGE(PG8_SA(0, 1), cA + hstepA, voffA);
    if (wr == 1) PG8_BAR;
    PG8_WAIT_V(2); PG8_BAR;
    PG8_STAGE(PG8_SB(1, 0), cB + kstep, voffB); PG8_STAGE(PG8_SA(1, 0), cA + kstep, voffA); PG8_STAGE(PG8_SB(1, 1), cB + hstepB + kstep, voffB);
    PG8_WAIT_V(6); PG8_BAR;
    for (;;) {
        const bool has_next = S.next(ui + 1, nxt);
        const char* nA = has_next ? nxt.a : cA; const char* nB = has_next ? nxt.b : cB;
        for (int t = 0; t < nt; t += 2) {
            const bool last = (t == nt - 2);
            const char* a1 = cA + (size_t)(t + 1) * kstep;
            const char* a2 = last ? nA : cA + (size_t)(t + 2) * kstep; const char* b2 = last ? nB : cB + (size_t)(t + 2) * kstep;
            const char* a3 = a2 + kstep; const char* b3 = b2 + kstep;
            if (last && has_next) S.a_ready(nxt);
            PG8_LDB(B0, 0, 0); PG8_LDB(B1, 0, 1); PG8_SCHED; PG8_LDA(At, 0, 0); PG8_STAGE(PG8_SA(1, 1), a1 + hstepA, voffA);
            PG8_WAIT_V(8); PG8_WAIT_L(0); PG8_BAR; PG8_MMA(0, 0, At, B0); PG8_MMA(0, 1, At, B1); PG8_BAR; PG8_SCHED;
            PG8_LDA(At, 0, 1); PG8_STAGE(PG8_SB(0, 0), b2, voffB); PG8_STAGE(PG8_SB(0, 1), b2 + hstepB, voffB); PG8_STAGE(PG8_SA(0, 0), a2, voffA);
            PG8_WAIT_V(8); PG8_WAIT_L(0); PG8_BAR; PG8_MMA(1, 0, At, B0); PG8_MMA(1, 1, At, B1); PG8_BAR; PG8_SCHED;
            PG8_LDB(B0, 1, 0); PG8_LDB(B1, 1, 1); PG8_SCHED; PG8_LDA(At, 1, 0); PG8_STAGE(PG8_SA(0, 1), a2 + hstepA, voffA);
            PG8_WAIT_V(8); PG8_WAIT_L(0); PG8_BAR; PG8_MMA(0, 0, At, B0); PG8_MMA(0, 1, At, B1); PG8_BAR; PG8_SCHED;
            PG8_LDA(At, 1, 1); PG8_STAGE(PG8_SB(1, 0), b3, voffB); PG8_STAGE(PG8_SB(1, 1), b3 + hstepB, voffB); PG8_STAGE(PG8_SA(1, 0), a3, voffA);
            PG8_WAIT_V(8); PG8_WAIT_L(0); PG8_BAR; PG8_MMA(1, 0, At, B0); PG8_MMA(1, 1, At, B1); PG8_BAR; PG8_SCHED;
        }
        if constexpr (ALIGN_EPI) { if (wr == 0) PG8_BAR; }
        E(acc, cur, wr, wc, fr, fq); S.done(cur);
        if (!has_next) break;
#pragma unroll
        for (int a = 0; a < 2; ++a)
#pragma unroll
            for (int b = 0; b < 2; ++b)
#pragma unroll
                for (int m = 0; m < 4; ++m)
#pragma unroll
                    for (int n = 0; n < 2; ++n) acc[a][b][m][n] = (f32x4){0.f, 0.f, 0.f, 0.f};
        cur = nxt; cA = nA; cB = nB; ++ui;
        if constexpr (ALIGN_EPI) { if (wr == 1) PG8_BAR; }
    }
    PG8_WAIT_V(0);
    if constexpr (!ALIGN_EPI) { if (wr == 0) PG8_BAR; }
    PG8_BAR;
#undef PG8_SA
#undef PG8_SB
#undef PG8_STAGE
#undef PG8_LDA
#undef PG8_LDB
#undef PG8_MMA
#undef PG8_WAIT_V
#undef PG8_WAIT_L
#undef PG8_BAR
#undef PG8_SCHED
}
}

constexpr int NWAVES = 8, NTHR = 512;
constexpr int DM = 2048, MP = 16384, MS = 512, MT = MP + MS, PAST = 2048, DECL = 64, NB = 8;
constexpr int KCROWS = PAST + DECL;
constexpr float EPS = 1e-6f;
constexpr float LOG2E = 1.4426950408889634f;
constexpr float C2 = 0.125f * LOG2E;

enum { I_XP = 0, I_XS, I_CK, I_CV, I_SR, I_NW, I_AWIN, I_AWOUT, I_AQG, I_AKG, I_LQ1, I_LK1, I_LQ2, I_LK2, I_ASG, I_RWIN, I_RWOUT, I_CWIN, I_CWOUT, I_CVG, I_CWS, I_CBS, N_IN };
constexpr size_t O_YP = 0, O_YS = O_YP + (size_t)MP * DM, O_KP = O_YS + (size_t)MS * DM, O_VP = O_KP + 2 * (size_t)MP * DM, O_KS = O_VP + 2 * (size_t)MP * DM, O_VS = O_KS + 2 * (size_t)MS * DM,
                 O_SP = O_VS + 2 * (size_t)MS * DM, O_SS = O_SP + (size_t)8 * 256 * 512, O_VM = O_SS + (size_t)NB * 8 * 256 * 512, O_END = O_VM + (size_t)MS * 4096;

constexpr size_t MiB = 1u << 20;
constexpr size_t WS_CTL = 0, CTL_ZERO_BYTES = 1 * MiB;
constexpr size_t WS_WAIN0 = 8 * MiB, WS_WAOUT0 = 40 * MiB, WS_WRIN = 48 * MiB, WS_WROUT = 96 * MiB, WS_WCIN = 112 * MiB, WS_WCOUT = 160 * MiB, WS_WAIN1 = 176 * MiB, WS_WAOUT1 = 208 * MiB;
constexpr size_t WS_XN = 216 * MiB, WS_Z = 282 * MiB;
constexpr size_t WS_QS = 546 * MiB, WS_KP = 612 * MiB, WS_VP = 676 * MiB, WS_KC = 740 * MiB, WS_VC = 806 * MiB, WS_AOA = 872 * MiB;
constexpr size_t WS_KT = 112 * MiB, WS_RG = 282 * MiB, WS_QP = 414 * MiB, WS_KN = 546 * MiB, WS_VS = 612 * MiB, WS_ORET = 900 * MiB;
constexpr size_t WS_GU = 282 * MiB, WS_SG = 414 * MiB, WS_GVT = 546 * MiB, WS_WM = 678 * MiB, WS_SSQ = 744 * MiB, WS_GVS = 752 * MiB;
constexpr size_t WS_GA = 282 * MiB;
constexpr size_t WS_KVX = 184 * MiB;
constexpr size_t WS_TABR = 1040 * MiB, WS_TABA = 1056 * MiB, WS_END = 1060 * MiB;

#define GAS __attribute__((address_space(1)))
#define LAS __attribute__((address_space(3)))
typedef unsigned short bf16;
typedef unsigned v4u __attribute__((ext_vector_type(4)));
typedef unsigned v2u __attribute__((ext_vector_type(2)));
typedef float f32x4 __attribute__((ext_vector_type(4)));
typedef GAS unsigned gu32;
#define RLX_AGENT __ATOMIC_RELAXED, __HIP_MEMORY_SCOPE_AGENT
#define LDS_WAIT() asm volatile("s_waitcnt lgkmcnt(0)" ::: "memory")
#define VM_WAIT() asm volatile("s_waitcnt vmcnt(0)" ::: "memory")
__device__ __forceinline__ unsigned f2bf(float f) { unsigned u = __builtin_bit_cast(unsigned, f); return (u + 0x7fffu + ((u >> 16) & 1u)) >> 16; }
__device__ __forceinline__ unsigned pk2(float lo, float hi) { return f2bf(lo) | (f2bf(hi) << 16); }
__device__ __forceinline__ float bf2f(unsigned short b) { return __builtin_bit_cast(float, (unsigned)b << 16); }
__device__ __forceinline__ float bflo(unsigned w) { return __builtin_bit_cast(float, w << 16); }
__device__ __forceinline__ float bfhi(unsigned w) { return __builtin_bit_cast(float, w & 0xffff0000u); }
__device__ __forceinline__ float silu_f(float x) { return x / (1.f + __expf(-x)); }
__device__ __forceinline__ float gelu_tanh_f(float x) { const float u = 0.7978845608028654f * (x + 0.044715f * x * x * x); return x / (1.f + __expf(-2.f * u)); }
__device__ __forceinline__ float wave_sum(float v) {
#pragma unroll
    for (int o = 1; o < 64; o <<= 1) v += __shfl_xor(v, o);
    return v;
}
__device__ __forceinline__ void rope_cs(int pos, int i, int nf, float& c, float& s) {
    const float inv = exp2f(-(float)i / (float)nf * 13.287712379549449f);
    const double a = (double)pos * (double)inv * 0.15915494309189535;
    const float r = (float)(a - floor(a));
    c = __builtin_amdgcn_cosf(r); s = __builtin_amdgcn_sinf(r);
}

#define XB_TMO      128
#define XB_XCNT(j)  (256  + 64 * (j))
#define XB_XSUB(j)  (1280 + 64 * (j))
#define XB_XGEN(j)  (2304 + 64 * (j))
#define XB_TOP      3328
#define XB_TOPGEN   3392
#define XCD_BAR_WORDS 3456
#define XB_SPIN_CAP (1u << 22)
__device__ __forceinline__ unsigned xb_ld(unsigned* p)              { return __hip_atomic_load(p, __ATOMIC_RELAXED, __HIP_MEMORY_SCOPE_AGENT); }
__device__ __forceinline__ unsigned xb_add(unsigned* p, unsigned v) { return __hip_atomic_fetch_add(p, v, __ATOMIC_RELAXED, __HIP_MEMORY_SCOPE_AGENT); }
__device__ __forceinline__ unsigned xb_xcc_id() { return (unsigned)__builtin_amdgcn_s_getreg((3 << 11) | 20) & 0xFu; }
#define XB_SPIN(cond, bar) do { unsigned _sp = 0; while (cond) { __builtin_amdgcn_s_sleep(1); \
    if ((++_sp & 255u) == 0u) { if (xb_ld(&(bar)[XB_TMO])) break; if (_sp > XB_SPIN_CAP) { atomicAdd(&(bar)[XB_TMO], 1u); break; } } } } while (0)
struct XcdBarrier { unsigned* bar; unsigned x; volatile LAS unsigned* st; };
__device__ __forceinline__ XcdBarrier xcd_barrier_post(unsigned* bar, volatile LAS unsigned* st) {
    XcdBarrier b; b.bar = bar; b.x = xb_xcc_id(); b.st = st;
    if (threadIdx.x == 0) (void)xb_add(&bar[XB_XCNT(b.x)], 1u);
    return b;
}
__device__ __forceinline__ void xcd_barrier_complete(unsigned* bar, unsigned x, unsigned& nloc, unsigned& nx) {
    const unsigned G = gridDim.x * gridDim.y * gridDim.z;
    unsigned sum, cnt, mine, sp = 0u;
    for (;;) {
        sum = 0u; cnt = 0u; mine = 0u;
#pragma unroll
        for (unsigned j = 0; j < 16; ++j) { const unsigned c = xb_ld(&bar[XB_XCNT(j)]); sum += c; cnt += (c > 0u) ? 1u : 0u; mine = (j == x) ? c : mine; }
        if (sum == G) break;
        __builtin_amdgcn_s_sleep(1);
        if ((++sp & 255u) == 0u) { if (xb_ld(&bar[XB_TMO])) break; if (sp > XB_SPIN_CAP) { atomicAdd(&bar[XB_TMO], 1u); break; } }
    }
    nloc = mine > 0u ? mine : 1u; nx = cnt > 0u ? cnt : 1u;
}
__device__ __forceinline__ void xcd_barrier(const XcdBarrier& b, bool leader) {
    asm volatile("s_waitcnt vmcnt(0)" ::: "memory");
    __syncthreads();
    if (leader) {
        unsigned* bar = b.bar;
        __builtin_amdgcn_s_waitcnt(0);
        unsigned nloc = b.st[0], nx = b.st[1];
        if (nloc == 0u) { xcd_barrier_complete(bar, b.x, nloc, nx); b.st[0] = nloc; b.st[1] = nx; }
        const unsigned old = xb_add(&bar[XB_XSUB(b.x)], 1u);
        const unsigned gen = old / nloc;
        if (old + 1u == (gen + 1u) * nloc) {
            __builtin_amdgcn_fence(__ATOMIC_RELEASE, "agent");
            asm volatile("s_waitcnt vmcnt(0)" ::: "memory");
            const unsigned og = xb_add(&bar[XB_TOP], 1u);
            const unsigned tg = og / nx;
            if (og + 1u == (tg + 1u) * nx) xb_add(&bar[XB_TOPGEN], 1u);
            else XB_SPIN(xb_ld(&bar[XB_TOPGEN]) == tg, bar);
            __builtin_amdgcn_fence(__ATOMIC_ACQUIRE, "agent");
            xb_add(&bar[XB_XGEN(b.x)], 1u);
            asm volatile("s_waitcnt vmcnt(0)" ::: "memory");
        } else {
            XB_SPIN(xb_ld(&bar[XB_XGEN(b.x)]) == gen, bar);
            __builtin_amdgcn_fence(__ATOMIC_ACQUIRE, "agent");
            asm volatile("s_waitcnt vmcnt(0)" ::: "memory");
        }
    }
    __syncthreads();
}

constexpr int RING_OFF = 0, RING_BYTES = 139264;
constexpr int MISC_OFF = RING_BYTES;
constexpr int LDS_BYTES = 147456;
struct Args { const float* in[N_IN]; float* out; unsigned char* ws; int ph_lo, ph_hi; };
struct Frame {
    LAS unsigned char* lds; int tid, lane, wave, G, bid;
    const float* const* in; float* out; unsigned char* ws;
};

__device__ __forceinline__ void p0_transpose_item(const float* W, int K, int N, bf16* WT, LAS float* scr, int item, int lane) {
    const int nblk = N / 32, kb = item / nblk, nb = item % nblk, k0 = 64 * kb, n0 = 32 * nb;
#pragma unroll 8
    for (int i = 0; i < 32; ++i) { const int kk = 2 * i + (lane >> 5); scr[kk * 33 + (lane & 31)] = W[(size_t)(k0 + kk) * N + n0 + (lane & 31)]; }
    LDS_WAIT(); asm volatile("" ::: "memory");
    const int c = lane & 7;
#pragma unroll
    for (int j = 0; j < 4; ++j) { const int n = (lane >> 3) + 8 * j; const LAS float* s = scr + (8 * c) * 33 + n;
        v4u o; o.x = pk2(s[0 * 33], s[1 * 33]); o.y = pk2(s[2 * 33], s[3 * 33]); o.z = pk2(s[4 * 33], s[5 * 33]); o.w = pk2(s[6 * 33], s[7 * 33]);
        *(GAS v4u*)(WT + (size_t)(n0 + n) * K + k0 + 8 * c) = o; }
    LDS_WAIT(); asm volatile("" ::: "memory");
}
__device__ __forceinline__ void transpose_weight(Frame& F, const float* W, int K, int N, bf16* WT) {
    LAS float* scr = (LAS float*)(F.lds + RING_OFF + F.wave * 16384);
    const int gw = F.bid * NWAVES + F.wave, NGW = F.G * NWAVES, nitems = (K / 64) * (N / 32);
    for (int it = gw; it < nitems; it += NGW) p0_transpose_item(W, K, N, WT, scr, it, F.lane);
}
__device__ __forceinline__ void norm_rows(Frame& F, const float* src_p, const float* src_s, const float* w, bf16* XN) {
    const int gw = F.bid * NWAVES + F.wave, NGW = F.G * NWAVES;
    for (int m = gw; m < MT; m += NGW) {
        const float* xrow = (m < MP) ? src_p + (size_t)m * DM : src_s + (size_t)(m - MP) * DM;
        const GAS f32x4* xr = (const GAS f32x4*)xrow + F.lane; const GAS f32x4* wr = (const GAS f32x4*)w + F.lane;
        f32x4 v[8]; float s = 0.f;
#pragma unroll
        for (int j = 0; j < 8; ++j) { v[j] = xr[64 * j]; s += (v[j].x * v[j].x + v[j].y * v[j].y) + (v[j].z * v[j].z + v[j].w * v[j].w); }
        const float rstd = 1.f / sqrtf(wave_sum(s) * (1.f / DM) + EPS);
        GAS v2u* o8 = (GAS v2u*)(XN + (size_t)m * DM) + F.lane;
#pragma unroll
        for (int j = 0; j < 8; ++j) { const f32x4 g = wr[64 * j]; v2u o; o.x = pk2(v[j].x * rstd * g.x, v[j].y * rstd * g.y); o.y = pk2(v[j].z * rstd * g.z, v[j].w * rstd * g.w); o8[64 * j] = o; }
    }
}
__device__ __forceinline__ void cache_cvt(Frame& F, const float* ck, const float* cv, bf16* KC, bf16* VC) {
    const size_t nvec = (size_t)NB * PAST * DM / 4;
    const size_t gt = (size_t)F.bid * NTHR + F.tid, NG = (size_t)F.G * NTHR;
    for (size_t i = gt; i < 2 * nvec; i += NG) {
        const bool isv = i >= nvec; const size_t e = (isv ? i - nvec : i) * 4;
        const size_t brow = e / DM, col = e % DM, b = brow / PAST, t = brow % PAST;
        const f32x4 x = *(const GAS f32x4*)((isv ? cv : ck) + e);
        v2u o; o.x = pk2(x.x, x.y); o.y = pk2(x.z, x.w);
        *(GAS v2u*)((isv ? VC : KC) + ((b * KCROWS + t) * DM + col)) = o;
    }
}
__device__ __forceinline__ int tw_chunks(int K, int N) { return (K / 64) * (N / 32) / 64; }
__device__ __forceinline__ void tw_run(Frame& F, const float* W, int K, int N, bf16* WT, int c) {
    LAS float* scr = (LAS float*)(F.lds + RING_OFF + F.wave * 16384);
#pragma unroll 1
    for (int i = 0; i < 8; ++i) p0_transpose_item(W, K, N, WT, scr, c * 64 + F.wave * 8 + i, F.lane);
}
constexpr int CC_CHUNKS = 2 * (NB * PAST * DM / 4) / 8192;
__device__ __forceinline__ void cc_run(Frame& F, const float* ck, const float* cv, bf16* KC, bf16* VC, int c) {
    const size_t nvec = (size_t)NB * PAST * DM / 4;
#pragma unroll 4
    for (int k = 0; k < 16; ++k) { const size_t i = (size_t)c * 8192 + k * NTHR + F.tid;
        const bool isv = i >= nvec; const size_t e = (isv ? i - nvec : i) * 4; const size_t brow = e / DM, col = e % DM, b = brow / PAST, t = brow % PAST;
        const f32x4 x = *(const GAS f32x4*)((isv ? cv : ck) + e); v2u o; o.x = pk2(x.x, x.y); o.y = pk2(x.z, x.w);
        *(GAS v2u*)((isv ? VC : KC) + ((b * KCROWS + t) * DM + col)) = o; }
}
constexpr int TR_CHUNKS = MP * 128 / 8192;
__device__ __forceinline__ void tr_run(Frame& F, float* tab, int c) {
#pragma unroll 1
    for (int k = 0; k < 16; ++k) { const size_t e = (size_t)c * 8192 + k * NTHR + F.tid; float cs, sn; rope_cs((int)(e >> 7), (int)(e & 127), 128, cs, sn); tab[2 * e] = cs; tab[2 * e + 1] = sn; }
}
__device__ __forceinline__ int row_pos(int row) { return row < MP ? row : PAST + ((row - MP) & 63); }

struct EpiAIn {
    static constexpr int BMODE = 2;
    pg8::bf16_t *Qs, *KP, *VP, *KC, *VC, *GA; float *okp, *ovp, *oks, *ovs; const float* tab; const float* qg; const float* kg;
    __device__ __forceinline__ void operator()(const pg8::f32x4 (&acc)[2][2][4][2], const pg8::Unit& u, int wr, int wc, int fr, int fq) const {
        { const int l_ = lane_now(); fr = l_ & 15; fq = l_ >> 4; }
        const int pn = u.pn, pm = u.pm, typ = pn >> 3, cl = ((pn & 7) * 4 + wc) * 64 + 8 * fq;
        float g1[8], g2[8];
        if (typ < 2) { const float* gp = (typ == 0 ? qg : kg) + 8 * fq; const pg8::f32x4 a = *(const pg8::f32x4*)gp, b = *(const pg8::f32x4*)(gp + 4), c = *(const pg8::f32x4*)(gp + 32), d = *(const pg8::f32x4*)(gp + 36);
#pragma unroll
            for (int e = 0; e < 4; ++e) { g1[e] = a[e]; g1[4 + e] = b[e]; g2[e] = c[e]; g2[4 + e] = d[e]; } }
#pragma unroll
        for (int ai = 0; ai < 2; ++ai)
#pragma unroll
            for (int m = 0; m < 4; ++m) {
                const int i = ai * 128 + wr * 64 + m * 16 + fr; const size_t row = (size_t)pm * 256 + i;
                float x1[8], x2[8];
#pragma unroll
                for (int e = 0; e < 4; ++e) { x1[e] = acc[ai][0][m][0][e]; x1[4 + e] = acc[ai][0][m][1][e]; x2[e] = acc[ai][1][m][0][e]; x2[4 + e] = acc[ai][1][m][1][e]; }
                size_t drow; pg8::bf16_t* dk; pg8::bf16_t* dv; float* fk; float* fv;
                if (pm < 64) { drow = row; dk = KP; dv = VP; fk = okp + row * DM; fv = ovp + row * DM; }
                else { const int s_ = (int)(row - MP); drow = (size_t)(s_ >> 6) * KCROWS + PAST + (s_ & 63); dk = KC; dv = VC; fk = oks + (size_t)s_ * DM; fv = ovs + (size_t)s_ * DM; }
                if (typ < 2) {
                    float ss = 0.f;
#pragma unroll
                    for (int k = 0; k < 8; ++k) ss += x1[k] * x1[k] + x2[k] * x2[k];
                    ss += __shfl_xor(ss, 16); ss += __shfl_xor(ss, 32);
                    const float rstd = 1.f / sqrtf(ss * (1.f / 64.f) + EPS);
                    const int pos = pm < 64 ? (int)row : PAST + (i & 63);
                    const float* tp = tab + ((size_t)pos * 32 + 8 * fq) * 2; float o1[8], o2[8];
#pragma unroll
                    for (int q4 = 0; q4 < 4; ++q4) { const pg8::f32x4 t = *(const pg8::f32x4*)(tp + 4 * q4);
#pragma unroll
                        for (int z = 0; z < 2; ++z) { const int k = 2 * q4 + z; const float c = t[2 * z], s = t[2 * z + 1], y1 = x1[k] * rstd * g1[k], y2 = x2[k] * rstd * g2[k]; o1[k] = y1 * c - y2 * s; o2[k] = y2 * c + y1 * s; } }
                    if (typ == 0) { v4u w1, w2;
                        w1.x = pk2(o1[0] * C2, o1[1] * C2); w1.y = pk2(o1[2] * C2, o1[3] * C2); w1.z = pk2(o1[4] * C2, o1[5] * C2); w1.w = pk2(o1[6] * C2, o1[7] * C2);
                        w2.x = pk2(o2[0] * C2, o2[1] * C2); w2.y = pk2(o2[2] * C2, o2[3] * C2); w2.z = pk2(o2[4] * C2, o2[5] * C2); w2.w = pk2(o2[6] * C2, o2[7] * C2);
                        *(v4u*)(Qs + row * DM + cl) = w1; *(v4u*)(Qs + row * DM + cl + 32) = w2;
                    } else { v4u w1, w2;
                        w1.x = pk2(o1[0], o1[1]); w1.y = pk2(o1[2], o1[3]); w1.z = pk2(o1[4], o1[5]); w1.w = pk2(o1[6], o1[7]);
                        w2.x = pk2(o2[0], o2[1]); w2.y = pk2(o2[2], o2[3]); w2.z = pk2(o2[4], o2[5]); w2.w = pk2(o2[6], o2[7]);
                        *(v4u*)(dk + drow * DM + cl) = w1; *(v4u*)(dk + drow * DM + cl + 32) = w2;
                        *(pg8::f32x4*)(fk + cl) = (pg8::f32x4){o1[0], o1[1], o1[2], o1[3]}; *(pg8::f32x4*)(fk + cl + 4) = (pg8::f32x4){o1[4], o1[5], o1[6], o1[7]};
                        *(pg8::f32x4*)(fk + cl + 32) = (pg8::f32x4){o2[0], o2[1], o2[2], o2[3]}; *(pg8::f32x4*)(fk + cl + 36) = (pg8::f32x4){o2[4], o2[5], o2[6], o2[7]}; }
                } else { v4u w1, w2;
                    w1.x = pk2(x1[0], x1[1]); w1.y = pk2(x1[2], x1[3]); w1.z = pk2(x1[4], x1[5]); w1.w = pk2(x1[6], x1[7]);
                    w2.x = pk2(x2[0], x2[1]); w2.y = pk2(x2[2], x2[3]); w2.z = pk2(x2[4], x2[5]); w2.w = pk2(x2[6], x2[7]);
                    if (typ == 2) { *(v4u*)(dv + drow * DM + cl) = w1; *(v4u*)(dv + drow * DM + cl + 32) = w2;
                        *(pg8::f32x4*)(fv + cl) = (pg8::f32x4){x1[0], x1[1], x1[2], x1[3]}; *(pg8::f32x4*)(fv + cl + 4) = (pg8::f32x4){x1[4], x1[5], x1[6], x1[7]};
                        *(pg8::f32x4*)(fv + cl + 32) = (pg8::f32x4){x2[0], x2[1], x2[2], x2[3]}; *(pg8::f32x4*)(fv + cl + 36) = (pg8::f32x4){x2[4], x2[5], x2[6], x2[7]}; }
                    else { *(v4u*)(GA + row * DM + cl) = w1; *(v4u*)(GA + row * DM + cl + 32) = w2; }
                }
                if (m & 1) asm volatile("" ::: "memory");
            }
    }
};
__device__ __forceinline__ void attn_table(Frame& F, float* tab) {
    const size_t gt = (size_t)F.bid * NTHR + F.tid, NG = (size_t)F.G * NTHR;
    for (size_t e = gt; e < (size_t)MP * 32; e += NG) { float c, s; rope_cs((int)(e >> 5), (int)(e & 31), 32, c, s); tab[2 * e] = c; tab[2 * e + 1] = s; }
}
namespace dattn {
typedef short bf16x8 __attribute__((ext_vector_type(8)));
typedef short s16x4 __attribute__((ext_vector_type(4)));
typedef short v4i16_t __attribute__((ext_vector_type(4)));
typedef float f32x16 __attribute__((ext_vector_type(16)));
typedef unsigned u32x4 __attribute__((ext_vector_type(4)));
typedef __attribute__((address_space(3))) const char* lds_cptr;
constexpr int RINGB = 98304, WSF_OFF = RINGB, XCHB = 18432, STP = 144;
__device__ __forceinline__ int crow(int r, int hi) { return (r & 3) + 8 * (r >> 2) + 4 * hi; }
__device__ __forceinline__ void glds16(const void* gsrc, unsigned lds_dst) { unsigned keep;
    asm volatile("s_mov_b32 %0, m0\n\ts_mov_b32 m0, %2\n\ts_nop 0\n\tglobal_load_lds_dwordx4 %1, off\n\ts_mov_b32 m0, %0" : "=&s"(keep) : "v"(gsrc), "s"(lds_dst) : "memory"); }
typedef float f32x2_t __attribute__((ext_vector_type(2))); typedef __bf16 bf16x2_t __attribute__((ext_vector_type(2)));
__device__ __forceinline__ unsigned cvtpk_s(float lo, float hi) { f32x2_t v = {lo, hi}; bf16x2_t b = __builtin_convertvector(v, bf16x2_t); return __builtin_bit_cast(unsigned, b); }
#define DA_WAIT_BAR(N) asm volatile("s_waitcnt vmcnt(" #N ") lgkmcnt(0)\n\ts_barrier" ::: "memory")
__device__ __forceinline__ s16x4 vtr(lds_cptr p) { return __builtin_bit_cast(s16x4, __builtin_amdgcn_ds_read_tr16_b64_v4i16((__attribute__((address_space(3))) v4i16_t*)p)); }
struct Unit { const bf16* Q; const bf16* K; const bf16* V; const bf16* G; bf16* AO; int NT; int full; int dma0; };

constexpr int KSLOT = 16384, VSLOT = 16384, VRING = 3 * KSLOT;
#define DA_SBAR() __builtin_amdgcn_sched_barrier(0)
#define DA_PIN(x) asm volatile("" : "+v"(x))
#define DA_MFMA(a, b, c) __builtin_amdgcn_mfma_f32_32x32x16_bf16(a, b, c, 0, 0, 0)
template <bool QK, bool PV, int VAR>
__device__ __forceinline__ void step(lds_cptr kpn, lds_cptr vp, const bf16x8 (&qr)[4], bf16x8 (&kf)[8], f32x16 (&o)[4], u32x4 (&pw)[4], float& l_reg) {
    f32x16 C0 = f32x16{}, C1 = f32x16{};
    s16x4 vlo[4], vhi[4];
#define DA_FOFF(f) ((((f) & 3) * 4096) + (((f) >> 2) * 1024))
#pragma unroll
    for (int a = 0; a < 8; ++a) {
        if constexpr (PV) { if (a >= 4) { if (VAR != 4) { vlo[a - 4] = vtr(vp + DA_FOFF(a - 4)); vhi[a - 4] = vtr(vp + DA_FOFF(a - 4) + 512); } else { vlo[a - 4] = s16x4{1, 2, 3, 4}; vhi[a - 4] = s16x4{5, 6, 7, 8}; } DA_SBAR(); } }
        if constexpr (QK) {
            if (a & 1) C1 = (a < 2) ? DA_MFMA(kf[a], qr[a >> 1], f32x16{}) : DA_MFMA(kf[a], qr[a >> 1], C1);
            else       C0 = (a < 2) ? DA_MFMA(kf[a], qr[a >> 1], f32x16{}) : DA_MFMA(kf[a], qr[a >> 1], C0);
            DA_SBAR();
        }
    }
    u32x4 pwn[4]; pwn[0] = u32x4{}; pwn[1] = u32x4{}; pwn[2] = u32x4{}; pwn[3] = u32x4{};
    float s0 = 0.f, s1 = 0.f;
#pragma unroll
    for (int p = 0; p < 16; ++p) {
        if constexpr (PV) {
            const bf16x8 vf = (bf16x8){vlo[p & 3][0], vlo[p & 3][1], vlo[p & 3][2], vlo[p & 3][3], vhi[p & 3][0], vhi[p & 3][1], vhi[p & 3][2], vhi[p & 3][3]};
            if (VAR != 3) o[p & 3] = DA_MFMA(__builtin_bit_cast(bf16x8, pw[p >> 2]), vf, o[p & 3]); else { o[p & 3][0] += __builtin_bit_cast(float, (int)vf[0] | ((int)vf[4] << 16)); }
            if (p < 12 && VAR != 4) { vlo[p & 3] = vtr(vp + DA_FOFF(p + 4)); vhi[p & 3] = vtr(vp + DA_FOFF(p + 4) + 512); }
        }
        if constexpr (QK) {
            float e0, e1;
            if (VAR == 2) { if (p < 8) { e0 = C0[2 * p]; e1 = C0[2 * p + 1]; } else { e0 = C1[2 * p - 16]; e1 = C1[2 * p - 15]; } }
            else if (p < 8) { e0 = __builtin_amdgcn_exp2f(C0[2 * p]); e1 = __builtin_amdgcn_exp2f(C0[2 * p + 1]); }
            else       { e0 = __builtin_amdgcn_exp2f(C1[2 * p - 16]); e1 = __builtin_amdgcn_exp2f(C1[2 * p - 15]); }
            s0 += e0; s1 += e1; pwn[p >> 2][p & 3] = cvtpk_s(e0, e1);
            DA_PIN(s0); DA_PIN(s1); DA_PIN(pwn[p >> 2]);
            if (p >= 8 && VAR != 6) { const int j = p - 8; kf[j] = *(const __attribute__((address_space(3))) bf16x8*)(kpn + (j >> 1) * 2048 + (j & 1) * 512); }
        }
        DA_SBAR();
    }
    if constexpr (QK) { l_reg += s0 + s1; pw[0] = pwn[0]; pw[1] = pwn[1]; pw[2] = pwn[2]; pw[3] = pwn[3]; }
#undef DA_FOFF
}

template <int VAR>
__device__ __forceinline__ void attn_unit(const Unit& u, char* shm, float lam, float one_m_li, const float* sub_gain, int tid) {
    asm volatile("" : "+v"(tid));
    const int lane = tid & 63, r32 = lane & 31, hi = lane >> 5; const int wid = __builtin_amdgcn_readfirstlane(tid >> 6), s = wid >> 2, g = wid & 3;
    const int NT = u.NT; const int wt = u.full ? (g < 2 ? NT - 1 : NT) : (g < 2 ? NT : 0);
    const unsigned lds0 = (unsigned)(uintptr_t)shm;
    float* wsf = (float*)(shm + WSF_OFF) + wid * 64;
    const bf16* ksrc = u.K + (long)lane * DM + wid * 8;
    const bf16* vsrc = u.V + (long)(16 * (wid & 3) + (lane >> 2)) * DM + (wid >> 2) * 32 + (lane & 3) * 8;
    const unsigned kdst = lds0 + wid * 1024, vdst = lds0 + VRING + wid * 1024;
#define DA_DMA_K(t, slot) do { const int tt_ = u.dma0 ? 0 : (t) < NT ? (t) : NT - 1; const bf16* kp_ = ksrc + (long)tt_ * 64 * DM; \
        glds16(kp_, (unsigned)__builtin_amdgcn_readfirstlane(kdst + (slot) * KSLOT)); glds16(kp_ + 64, (unsigned)__builtin_amdgcn_readfirstlane(kdst + 8192 + (slot) * KSLOT)); } while (0)
#define DA_DMA_V(t, slot) do { const int tt_ = u.dma0 ? 0 : (t) < NT ? (t) : NT - 1; const bf16* vp_ = vsrc + (long)tt_ * 64 * DM; \
        glds16(vp_, (unsigned)__builtin_amdgcn_readfirstlane(vdst + (slot) * VSLOT)); glds16(vp_ + 64, (unsigned)__builtin_amdgcn_readfirstlane(vdst + 8192 + (slot) * VSLOT)); } while (0)
    const lds_cptr shm3 = (lds_cptr)shm;
    const lds_cptr kp0 = shm3 + s * 8192 + hi * 1024 + r32 * 16;
    const lds_cptr vp0 = shm3 + VRING + ((lane >> 4) & 1) * 32 + (lane & 3) * 8 + (4 * hi + ((lane & 15) >> 2)) * 64;
    DA_DMA_K(0, 0); DA_DMA_K(1, 1); DA_DMA_K(2, 2); DA_DMA_V(0, 0);
    bf16x8 qr[4];
    { const bf16* Qw = u.Q + (long)(32 * g + r32) * DM + s * 64;
#pragma unroll
      for (int d0 = 0; d0 < 4; ++d0) qr[d0] = (wt > 0) ? *reinterpret_cast<const bf16x8*>(Qw + d0 * 16 + hi * 8) : (bf16x8){0, 0, 0, 0, 0, 0, 0, 0}; }
    asm volatile("" : "+v"(qr[0]), "+v"(qr[1]), "+v"(qr[2]), "+v"(qr[3]));
    f32x16 o[4]; o[0] = f32x16{}; o[1] = f32x16{}; o[2] = f32x16{}; o[3] = f32x16{};
    float l_reg = 0.f;
    u32x4 pw[4]; pw[0] = u32x4{}; pw[1] = u32x4{}; pw[2] = u32x4{}; pw[3] = u32x4{};
    DA_WAIT_BAR(0);
    bf16x8 kf[8];
#pragma unroll
    for (int j = 0; j < 8; ++j) kf[j] = *(const __attribute__((address_space(3))) bf16x8*)(kp0 + (j >> 1) * 2048 + (j & 1) * 512);
    int ks_cur = 0  , vs_prev = 2  ;
#define DA_TOP(t) \
        DA_WAIT_BAR(4);                                          \
        const int ks_next = (ks_cur == 2) ? 0 : ks_cur + 1, vs_cur = (vs_prev == 2) ? 0 : vs_prev + 1, vs_next = (vs_cur == 2) ? 0 : vs_cur + 1; \
        if (VAR != 7) { DA_DMA_K((t) + 3, ks_cur); DA_DMA_V((t) + 1, vs_next); }       \
        const lds_cptr kpn = kp0 + ks_next * KSLOT; const lds_cptr vp = vp0 + vs_prev * VSLOT; (void)kpn; (void)vp
#define DA_ROT() do { ks_cur = ks_next; vs_prev = vs_cur; } while (0)
    int t = 0;
    { DA_TOP(0); if (wt > 0) step<true, false, VAR>(kpn, vp, qr, kf, o, pw, l_reg); DA_ROT(); t = 1; }
    for (; t < wt; ++t) { DA_TOP(t); step<true, true, VAR>(kpn, vp, qr, kf, o, pw, l_reg); DA_ROT(); }
    if (wt > 0) { DA_TOP(t); step<false, true, VAR>(kpn, vp, qr, kf, o, pw, l_reg); DA_ROT(); ++t; }
    for (; t <= NT; ++t) { DA_TOP(t); DA_ROT(); }
#undef DA_TOP
#undef DA_ROT
    { auto rr = __builtin_amdgcn_permlane32_swap(__float_as_uint(l_reg), __float_as_uint(l_reg), false, false); l_reg = __uint_as_float(rr[0]) + __uint_as_float(rr[1]); }
    if (hi == 0) wsf[r32] = l_reg;
    DA_WAIT_BAR(0);
    float rli[16];
#pragma unroll
    for (int r = 0; r < 16; ++r) { const float lq = wsf[crow(r, hi)]; rli[r] = (s == 0 ? 1.f : -lam) / lq; }
    int le = lane; asm volatile("" : "+v"(le));
    const int r32e = le & 31, hie = le >> 5;
    float* xch = (float*)(shm + g * XCHB);
    if (s == 1 && wt > 0) {
#pragma unroll
        for (int db = 0; db < 4; ++db)
#pragma unroll
            for (int r = 0; r < 16; ++r) xch[(db * 16 + r) * 64 + le] = o[db][r] * rli[r];
    }
    DA_WAIT_BAR(0);
    if (s == 0 && wt > 0) {
#pragma unroll
        for (int db = 0; db < 4; ++db)
#pragma unroll
            for (int r = 0; r < 16; ++r) o[db][r] = o[db][r] * rli[r] + xch[(db * 16 + r) * 64 + le];
        asm volatile("s_waitcnt lgkmcnt(0)" ::: "memory");
#pragma unroll
        for (int db = 0; db < 4; ++db)
#pragma unroll
            for (int r = 0; r < 16; ++r) xch[crow(r, hie) * STP + 32 * db + r32e] = o[db][r];
        asm volatile("s_waitcnt lgkmcnt(0)" ::: "memory");
        const int row = le >> 1, half = le & 1;
        float v[64]; float ss = 0.f;
#pragma unroll
        for (int k = 0; k < 16; ++k) { const f32x4 x = *(const f32x4*)(xch + row * STP + half * 64 + 4 * k); v[4 * k] = x.x; v[4 * k + 1] = x.y; v[4 * k + 2] = x.z; v[4 * k + 3] = x.w; ss += (x.x * x.x + x.y * x.y) + (x.z * x.z + x.w * x.w); }
        ss += __shfl_xor(ss, 1);
        const float sc = one_m_li / sqrtf(ss * (1.f / 128.f) + EPS);
        const bf16* gp = u.G + (long)(32 * g + row) * DM + half * 64; bf16* op = u.AO + (long)(32 * g + row) * DM + half * 64; const float* sg = sub_gain + half * 64;
#pragma unroll
        for (int k = 0; k < 8; ++k) { const v4u g4 = *(const v4u*)(gp + 8 * k); const f32x4 ga = *(const f32x4*)(sg + 8 * k), gb = *(const f32x4*)(sg + 8 * k + 4);
            const float gg[8] = {bflo(g4.x), bfhi(g4.x), bflo(g4.y), bfhi(g4.y), bflo(g4.z), bfhi(g4.z), bflo(g4.w), bfhi(g4.w)};
            const float gn[8] = {ga.x, ga.y, ga.z, ga.w, gb.x, gb.y, gb.z, gb.w}; float y[8];
#pragma unroll
            for (int e = 0; e < 8; ++e) y[e] = v[8 * k + e] * sc * gn[e] * silu_f(gg[e]);
            v4u w; w.x = pk2(y[0], y[1]); w.y = pk2(y[2], y[3]); w.z = pk2(y[4], y[5]); w.w = pk2(y[6], y[7]);
            *(v4u*)(op + 8 * k) = w; }
    }
    DA_WAIT_BAR(0);
#undef DA_DMA_K
#undef DA_DMA_V
}
}
template <int VAR = 0>
__device__ __forceinline__ void attn_fast(Frame& F, const bf16* Qs, const bf16* KP, const bf16* VP, const bf16* KC, const bf16* VC, const bf16* GA  , bf16* AO,
                                          float lam, float one_m_li, const float* sub_gain, int dma0 = 0) {
    const int NU = 2048 + 16 * NB;
    const bool xcd = (F.G == 256);
    for (int i = 0;; ++i) {
        int qb, h, b = -1;
        if (xcd) { const int x = F.bid & 7, r = F.bid >> 3;
            if (i < 8) { h = x + 8 * (i >> 2); qb = 127 - ((i & 3) * 32 + ((i & 1) ? 31 - r : r)); }
            else if (i == 8 && r < 16) { h = x + 8 * (r >> 3); b = r & 7; qb = 0; }
            else break;
        } else { const int idx = i * F.G + ((i & 1) ? F.G - 1 - F.bid : F.bid); if (idx >= NU) break;
            if (idx < 2048) { qb = 127 - (idx >> 4); h = idx & 15; } else { const int j = idx - 2048; b = j >> 4; h = j & 15; qb = 0; } }
        dattn::Unit u; u.dma0 = dma0;
        if (b < 0) { const long row0 = 128L * qb;
            u.Q = Qs + row0 * DM + h * 128; u.K = KP + h * 128; u.V = VP + h * 128; u.G = GA + row0 * DM + h * 128; u.AO = AO + row0 * DM + h * 128; u.NT = 2 * qb + 2; u.full = 1; }
        else { const long row0 = MP + 64L * b;
            u.Q = Qs + row0 * DM + h * 128; u.K = KC + (long)b * KCROWS * DM + h * 128; u.V = VC + (long)b * KCROWS * DM + h * 128; u.G = GA + row0 * DM + h * 128; u.AO = AO + row0 * DM + h * 128; u.NT = KCROWS / 64; u.full = 0; }
        dattn::attn_unit<VAR>(u, (char*)F.lds + RING_OFF, lam, one_m_li, sub_gain, F.tid);
    }
}
constexpr int RBLK = 72;
__device__ __forceinline__ float ret_lg2(int h) { return log2f(1.f - exp2f(-5.f - (float)h)); }
struct EpiRet {
    static constexpr int BMODE = 0;
    pg8::bf16_t* QP; pg8::bf16_t* KN; pg8::bf16_t* KT; pg8::bf16_t* VS; pg8::bf16_t* RG; const float* tab;
    __device__ __forceinline__ void operator()(const pg8::f32x4 (&acc)[2][2][4][2], const pg8::Unit& u, int wr, int wc, int fr, int fq) const {
        { const int l_ = lane_now(); fr = l_ & 15; fq = l_ >> 4; }
        const int pn = u.pn, pm = u.pm;
#pragma unroll
        for (int ai = 0; ai < 2; ++ai)
#pragma unroll
            for (int m = 0; m < 4; ++m) {
                const int i = ai * 128 + wr * 64 + m * 16 + fr; const size_t row = (size_t)pm * 256 + i;
                const int J = pm < 64 ? pm : 64 + 4 * (pm - 64) + (i >> 6), jj = pm < 64 ? i : (i & 63), pos = pm < 64 ? (int)row : PAST + (i & 63);
                if (pn < 16) {
                    const int h = pn & 7; const bool isk = pn >= 8; const float sc = isk ? 0.0625f : 1.f;
#pragma unroll
                    for (int n = 0; n < 2; ++n) { const int c1 = wc * 32 + n * 16 + 4 * fq;
                        const pg8::f32x4 t0 = *(const pg8::f32x4*)(tab + ((size_t)pos * 128 + c1) * 2), t1 = *(const pg8::f32x4*)(tab + ((size_t)pos * 128 + c1) * 2 + 4);
                        const pg8::f32x4 x1 = acc[ai][0][m][n], x2 = acc[ai][1][m][n];
                        const float cs[4] = {t0[0], t0[2], t1[0], t1[2]}, sn[4] = {t0[1], t0[3], t1[1], t1[3]}; float o1[4], o2[4];
#pragma unroll
                        for (int e = 0; e < 4; ++e) { o1[e] = (x1[e] * cs[e] - x2[e] * sn[e]) * sc; o2[e] = (x2[e] * cs[e] + x1[e] * sn[e]) * sc; }
                        v2u w1, w2; w1.x = pk2(o1[0], o1[1]); w1.y = pk2(o1[2], o1[3]); w2.x = pk2(o2[0], o2[1]); w2.y = pk2(o2[2], o2[3]);
                        if (!isk) { pg8::bf16_t* p = QP + row * 4096 + h * 512 + 256 + c1; *(v2u*)p = w1; *(v2u*)(p + 128) = w2; }
                        else { pg8::bf16_t* p = KN + row * 2048 + h * 256 + c1; *(v2u*)p = w1; *(v2u*)(p + 128) = w2;
                            pg8::bf16_t* t = KT + ((size_t)(J * 8 + h) * 256 + c1) * 256 + jj;
#pragma unroll
                            for (int e = 0; e < 4; ++e) { t[(size_t)e * 256] = (pg8::bf16_t)f2bf(o1[e]); t[(size_t)(128 + e) * 256] = (pg8::bf16_t)f2bf(o2[e]); } } }
                } else if (pn < 32) {
                    const int h = (pn - 16) >> 1, half = (pn - 16) & 1; const float f = exp2f(-(float)(1 + jj) * ret_lg2(h));
#pragma unroll
                    for (int bj = 0; bj < 2; ++bj)
#pragma unroll
                        for (int n = 0; n < 2; ++n) { const int dv = half * 256 + bj * 128 + wc * 32 + n * 16 + 4 * fq; pg8::bf16_t* t = VS + ((size_t)(J * 8 + h) * 512 + dv) * 512 + jj;
#pragma unroll
                            for (int e = 0; e < 4; ++e) t[(size_t)e * 512] = (pg8::bf16_t)f2bf(acc[ai][bj][m][n][e] * f); }
                } else {
#pragma unroll
                    for (int bj = 0; bj < 2; ++bj)
#pragma unroll
                        for (int n = 0; n < 2; ++n) { const int c = (pn - 32) * 256 + bj * 128 + wc * 32 + n * 16 + 4 * fq; const pg8::f32x4 x = acc[ai][bj][m][n];
                            v2u w; w.x = pk2(x[0], x[1]); w.y = pk2(x[2], x[3]); *(v2u*)(RG + row * 4096 + c) = w; }
                }
            }
    }
};
__device__ __forceinline__ size_t ret_row0(int J) { return J < 64 ? (size_t)256 * J : (size_t)MP + 64 * (J - 64); }
struct RetQKOrder {
    int G, c; const char* QP; const char* KN;
    __device__ __forceinline__ bool next(int i, pg8::Unit& u) const { const int L = i * G + c; if (L >= RBLK * 8) return false; const int J = L >> 3, h = L & 7; const size_t r0 = ret_row0(J);
        u.pm = J; u.pn = h; u.a = QP + (r0 * 4096 + h * 512 + 256) * 2; u.b = KN + (r0 * 2048 + h * 256) * 2; return true; }
    __device__ __forceinline__ void a_ready(const pg8::Unit&) const {}
    __device__ __forceinline__ void done(const pg8::Unit&) const {}
};
struct EpiRetQK {
    static constexpr int BMODE = 1;
    pg8::bf16_t* QP;
    __device__ __forceinline__ void operator()(const pg8::f32x4 (&acc)[2][2][4][2], const pg8::Unit& u, int wr, int wc, int fr, int fq) const {
        { const int l_ = lane_now(); fr = l_ & 15; fq = l_ >> 4; }
        const int J = u.pm, h = u.pn, nv = J < 64 ? 256 : 64; const size_t r0 = ret_row0(J);
#pragma unroll
        for (int ai = 0; ai < 2; ++ai)
#pragma unroll
            for (int m = 0; m < 4; ++m) { const int i = ai * 128 + wr * 64 + m * 16 + fr;
                if (i < nv) {
#pragma unroll
                    for (int bj = 0; bj < 2; ++bj) { const int j0 = bj * 128 + wc * 32 + 8 * fq; const pg8::f32x4 v0 = acc[ai][bj][m][0], v1 = acc[ai][bj][m][1]; float x[8] = {v0[0], v0[1], v0[2], v0[3], v1[0], v1[1], v1[2], v1[3]};
#pragma unroll
                        for (int k = 0; k < 8; ++k) x[k] = (j0 + k <= i) ? x[k] : 0.f;
                        v4u w; w.x = pk2(x[0], x[1]); w.y = pk2(x[2], x[3]); w.z = pk2(x[4], x[5]); w.w = pk2(x[6], x[7]);
                        *(v4u*)(QP + (r0 + i) * 4096 + h * 512 + j0) = w; } } }
    }
};
struct RetOOrder {
    int G, c; const char* QP; const char* VS;
    __device__ __forceinline__ bool next(int i, pg8::Unit& u) const { const int L = i * G + c; if (L >= RBLK * 16) return false; const int J = L >> 4, r = L & 15, h = r >> 1, half = r & 1; const size_t r0 = ret_row0(J);
        u.pm = J; u.pn = r; u.a = QP + (r0 * 4096 + h * 512) * 2; u.b = VS + (((size_t)(J * 8 + h) * 512 + half * 256) * 512) * 2; return true; }
    __device__ __forceinline__ void a_ready(const pg8::Unit&) const {}
    __device__ __forceinline__ void done(const pg8::Unit&) const {}
};
struct EpiRetO {
    static constexpr int BMODE = 1;
    pg8::bf16_t* O;
    __device__ __forceinline__ void operator()(const pg8::f32x4 (&acc)[2][2][4][2], const pg8::Unit& u, int wr, int wc, int fr, int fq) const {
        { const int l_ = lane_now(); fr = l_ & 15; fq = l_ >> 4; }
        const int J = u.pm, h = u.pn >> 1, half = u.pn & 1, nv = J < 64 ? 256 : 64; const size_t r0 = ret_row0(J); const float lg = ret_lg2(h);
#pragma unroll
        for (int ai = 0; ai < 2; ++ai)
#pragma unroll
            for (int m = 0; m < 4; ++m) { const int i = ai * 128 + wr * 64 + m * 16 + fr;
                if (i < nv) { const float f = exp2f((float)(i + 1) * lg);
#pragma unroll
                    for (int bj = 0; bj < 2; ++bj) { const int j0 = bj * 128 + wc * 32 + 8 * fq; const pg8::f32x4 v0 = acc[ai][bj][m][0] * f, v1 = acc[ai][bj][m][1] * f;
                        v4u w; w.x = pk2(v0[0], v0[1]); w.y = pk2(v0[2], v0[3]); w.z = pk2(v1[0], v1[1]); w.w = pk2(v1[2], v1[3]);
                        *(v4u*)(O + (r0 + i) * 4096 + h * 512 + half * 256 + j0) = w; } } }
    }
};
struct RetKVOrder {
    int G, c; const char* VS; const char* KT;
    __device__ __forceinline__ bool next(int i, pg8::Unit& u) const { const int L = i * G + c; if (L >= RBLK * 16) return false; const int J = L >> 4, r = L & 15, h = r >> 1, half = r & 1;
        u.pm = J; u.pn = r; u.a = VS + (((size_t)(J * 8 + h) * 512 + half * 256) * 512) * 2; u.b = KT + ((size_t)(J * 8 + h) * 256 * 256) * 2; return true; }
    __device__ __forceinline__ void a_ready(const pg8::Unit&) const {}
    __device__ __forceinline__ void done(const pg8::Unit&) const {}
};
struct EpiRetKV {
    static constexpr int BMODE = 1;
    pg8::bf16_t* VS; pg8::bf16_t* KVX;
    __device__ __forceinline__ void operator()(const pg8::f32x4 (&acc)[2][2][4][2], const pg8::Unit& u, int wr, int wc, int fr, int fq) const {
        { const int l_ = lane_now(); fr = l_ & 15; fq = l_ >> 4; }
        const int J = u.pm, h = u.pn >> 1, half = u.pn & 1;
        pg8::bf16_t* base; int pitch;
        if (J < 63) { base = VS + ((size_t)((J + 1) * 8 + h) * 512 + half * 256) * 512 + 256; pitch = 512; }
        else { base = KVX + ((size_t)((J - 63) * 8 + h) * 512 + half * 256) * 256; pitch = 256; }
#pragma unroll
        for (int ai = 0; ai < 2; ++ai)
#pragma unroll
            for (int m = 0; m < 4; ++m) { pg8::bf16_t* rowp = base + (size_t)(ai * 128 + wr * 64 + m * 16 + fr) * pitch + wc * 32 + 8 * fq;
#pragma unroll
                for (int bj = 0; bj < 2; ++bj) { const pg8::f32x4 v0 = acc[ai][bj][m][0], v1 = acc[ai][bj][m][1];
                    v4u w; w.x = pk2(v0[0], v0[1]); w.y = pk2(v0[2], v0[3]); w.z = pk2(v1[0], v1[1]); w.w = pk2(v1[2], v1[3]);
                    *(v4u*)(rowp + bj * 128) = w; } }
    }
};
__device__ __forceinline__ void ret_scan(Frame& F, bf16* VS, const bf16* KVX, const float* state_in, float* osp, float* oss) {
    const int gt = F.bid * NTHR + F.tid;
    for (int c = gt; c < 8 * 512 * 32; c += F.G * NTHR) {
        const int h = c >> 14, dv = (c >> 5) & 511, dk0 = (c & 31) * 8; const float lg = ret_lg2(h), g256 = exp2f(256.f * lg), g64 = exp2f(64.f * lg);
        float S[8];
#pragma unroll
        for (int k = 0; k < 8; ++k) S[k] = 0.f;
        bf16* slot = VS + ((size_t)h * 512 + dv) * 512 + 256 + dk0;
        *(v4u*)slot = (v4u){0u, 0u, 0u, 0u};
        v4u nx = *(const v4u*)(slot + (size_t)8 * 512 * 512);
        for (int J = 1; J < 64; ++J) {
            const v4u kv = nx; bf16* sj = slot + (size_t)J * 8 * 512 * 512;
            if (J < 63) nx = *(const v4u*)(sj + (size_t)8 * 512 * 512);
            const float x[8] = {bflo(kv.x), bfhi(kv.x), bflo(kv.y), bfhi(kv.y), bflo(kv.z), bfhi(kv.z), bflo(kv.w), bfhi(kv.w)};
#pragma unroll
            for (int k = 0; k < 8; ++k) S[k] = (S[k] + x[k]) * g256;
            v4u w; w.x = pk2(S[0], S[1]); w.y = pk2(S[2], S[3]); w.z = pk2(S[4], S[5]); w.w = pk2(S[6], S[7]);
            *(v4u*)sj = w;
        }
        { const v4u kv = *(const v4u*)(KVX + ((size_t)h * 512 + dv) * 256 + dk0);
          const float x[8] = {bflo(kv.x), bfhi(kv.x), bflo(kv.y), bfhi(kv.y), bflo(kv.z), bfhi(kv.z), bflo(kv.w), bfhi(kv.w)};
#pragma unroll
          for (int k = 0; k < 8; ++k) osp[((size_t)h * 256 + dk0 + k) * 512 + dv] = (S[k] + x[k]) * g256; }
    }
    for (int c = gt; c < NB * 8 * 512 * 32; c += F.G * NTHR) {
        const int dv = c & 511, dk0 = ((c >> 9) & 31) * 8, h = (c >> 14) & 7, b = c >> 17; const float g64 = exp2f(64.f * ret_lg2(h));
        const float* si = state_in + (((size_t)b * 8 + h) * 256 + dk0) * 512 + dv; float* so = oss + (((size_t)b * 8 + h) * 256 + dk0) * 512 + dv;
        const v4u kv = *(const v4u*)(KVX + ((size_t)((1 + b) * 8 + h) * 512 + dv) * 256 + dk0);
        const float x[8] = {bflo(kv.x), bfhi(kv.x), bflo(kv.y), bfhi(kv.y), bflo(kv.z), bfhi(kv.z), bflo(kv.w), bfhi(kv.w)}; float s0[8];
#pragma unroll
        for (int k = 0; k < 8; ++k) s0[k] = si[(size_t)k * 512];
        v4u w; w.x = pk2(s0[0], s0[1]); w.y = pk2(s0[2], s0[3]); w.z = pk2(s0[4], s0[5]); w.w = pk2(s0[6], s0[7]);
        *(v4u*)(VS + ((size_t)((64 + b) * 8 + h) * 512 + dv) * 512 + 256 + dk0) = w;
#pragma unroll
        for (int k = 0; k < 8; ++k) so[(size_t)k * 512] = (s0[k] + x[k]) * g64;
    }
}
__device__ __forceinline__ void ret_zero_pad(Frame& F, bf16* VS) {
    const size_t gt = (size_t)F.bid * NTHR + F.tid, NG = (size_t)F.G * NTHR, n = (size_t)NB * 8 * 512 * 24;
    for (size_t i = gt; i < n; i += NG) { const size_t rowi = i / 24, c = i % 24; *(v4u*)(VS + ((size_t)64 * 8 * 512 + rowi) * 512 + 64 + c * 8) = (v4u){0u, 0u, 0u, 0u}; }
}
__device__ __forceinline__ void ret_table(Frame& F, float* tab) {
    const size_t gt = (size_t)F.bid * NTHR + F.tid, NG = (size_t)F.G * NTHR;
    for (size_t e = gt; e < (size_t)MP * 128; e += NG) { float c, s; rope_cs((int)(e >> 7), (int)(e & 127), 128, c, s); tab[2 * e] = c; tab[2 * e + 1] = s; }
}
__device__ __forceinline__ void r_out(Frame& F, bf16* O, const bf16* RG) {
    const int gw = F.bid * NWAVES + F.wave, NGW = F.G * NWAVES, lane = F.lane;
    for (int it = gw; it < MT * 8; it += NGW) {
        const int row = it >> 3, h = it & 7; const size_t off = (size_t)row * 4096 + h * 512 + lane * 8;
        const v4u o4 = *(const v4u*)(O + off), g4 = *(const v4u*)(RG + off);
        float o[8] = {bflo(o4.x), bfhi(o4.x), bflo(o4.y), bfhi(o4.y), bflo(o4.z), bfhi(o4.z), bflo(o4.w), bfhi(o4.w)};
        const float g[8] = {bflo(g4.x), bfhi(g4.x), bflo(g4.y), bfhi(g4.y), bflo(g4.z), bfhi(g4.z), bflo(g4.w), bfhi(g4.w)};
        float ss = 0.f;
#pragma unroll
        for (int k = 0; k < 8; ++k) ss += o[k] * o[k];
        const float rstd = 1.f / sqrtf(wave_sum(ss) * (1.f / 512.f) + EPS);
#pragma unroll
        for (int k = 0; k < 8; ++k) o[k] = o[k] * rstd * silu_f(g[k]);
        v4u w; w.x = pk2(o[0], o[1]); w.y = pk2(o[2], o[3]); w.z = pk2(o[4], o[5]); w.w = pk2(o[6], o[7]);
        *(v4u*)(O + off) = w;
    }
}
struct EpiCIn {
    static constexpr int BMODE = 0;
    pg8::bf16_t* GU; pg8::bf16_t* GVT; pg8::bf16_t* SG; pg8::bf16_t* GVS; float* SSQ;
    __device__ __forceinline__ void operator()(const pg8::f32x4 (&acc)[2][2][4][2], const pg8::Unit& u, int wr, int wc, int fr, int fq) const {
        { const int l_ = lane_now(); fr = l_ & 15; fq = l_ >> 4; }
        const int pn = u.pn, pm = u.pm, typ = pn >> 4, pt = pn & 15;
#pragma unroll
        for (int ai = 0; ai < 2; ++ai)
#pragma unroll
            for (int m = 0; m < 4; ++m) {
                const int i = ai * 128 + wr * 64 + m * 16 + fr; const size_t row = (size_t)pm * 256 + i; float ss = 0.f;
#pragma unroll
                for (int bj = 0; bj < 2; ++bj)
#pragma unroll
                    for (int n = 0; n < 2; ++n) { const int c = pt * 256 + bj * 128 + wc * 32 + n * 16 + 4 * fq; const pg8::f32x4 x = acc[ai][bj][m][n]; float y[4];
                        if (typ == 2) {
#pragma unroll
                            for (int e = 0; e < 4; ++e) y[e] = silu_f(x[e]);
                            v2u w; w.x = pk2(y[0], y[1]); w.y = pk2(y[2], y[3]); *(v2u*)(SG + row * 4096 + c) = w;
                        } else {
#pragma unroll
                            for (int e = 0; e < 4; ++e) y[e] = gelu_tanh_f(x[e]);
                            v2u w; w.x = pk2(y[0], y[1]); w.y = pk2(y[2], y[3]);
                            if (typ == 0) *(v2u*)(GU + row * 4096 + c) = w;
                            else { ss += (y[0] * y[0] + y[1] * y[1]) + (y[2] * y[2] + y[3] * y[3]);
                                pg8::bf16_t* t = GVT + ((size_t)pm * 4096 + c) * 256 + i;
                                t[0] = (pg8::bf16_t)(w.x & 0xffffu); t[256] = (pg8::bf16_t)(w.x >> 16); t[512] = (pg8::bf16_t)(w.y & 0xffffu); t[768] = (pg8::bf16_t)(w.y >> 16);
                                if (pm >= 64) *(v2u*)(GVS + (row - MP) * 4096 + c) = w; } } }
                if (typ == 1) { ss += __shfl_xor(ss, 16); ss += __shfl_xor(ss, 32); if (fq == 0) SSQ[row * 64 + pt * 4 + wc] = ss; }
                if (m & 1) asm volatile("" ::: "memory");
            }
    }
};
__device__ __forceinline__ void c_prep(Frame& F, const float* SSQ, const float* wsin, const float* vgain, const bf16* GVS, bf16* Wm, float* ovm) {
    LAS float* rs = (LAS float*)(F.lds + RING_OFF);
    const int tid = F.tid;
    for (int it = F.bid; it < 66 * 8; it += F.G) {
        const int J = it >> 3, g = it & 7; const int cl = J < 64 ? 128 : 64;
        __syncthreads();
        if (tid < 256) { const float* p = SSQ + ((size_t)J * 256 + tid) * 64; float s = 0.f;
#pragma unroll
            for (int k = 0; k < 16; ++k) { const f32x4 x = *(const f32x4*)(p + 4 * k); s += (x.x + x.y) + (x.z + x.w); }
            rs[tid] = 1.f / sqrtf(s * (1.f / 4096.f) + EPS); }
        __syncthreads();
        bf16* wm = Wm + (size_t)(J * 8 + g) * 65536;
        for (int e8 = tid; e8 < 8192; e8 += NTHR) { const int i = e8 >> 5, j0 = (e8 & 31) * 8; float y[8];
#pragma unroll
            for (int k = 0; k < 8; ++k) { const int j = j0 + k; const bool on = (i / cl == j / cl) && (j % cl <= i % cl);
                y[k] = on ? wsin[((size_t)g * 128 + (i % cl)) * 128 + (j % cl)] * rs[j] : 0.f; }
            v4u w; w.x = pk2(y[0], y[1]); w.y = pk2(y[2], y[3]); w.z = pk2(y[4], y[5]); w.w = pk2(y[6], y[7]);
            *(v4u*)(wm + i * 256 + j0) = w; }
    }
    const int gw = F.bid * NWAVES + F.wave, NGW = F.G * NWAVES, lane = F.lane;
    for (int r = gw; r < MS; r += NGW) {
        const float rstd = 1.f / sqrtf(wave_sum(SSQ[((size_t)MP + r) * 64 + lane]) * (1.f / 4096.f) + EPS);
#pragma unroll
        for (int k = 0; k < 8; ++k) { const int col = k * 512 + lane * 8; const v4u v4 = *(const v4u*)(GVS + (size_t)r * 4096 + col);
            const f32x4 ga = *(const f32x4*)(vgain + col), gb = *(const f32x4*)(vgain + col + 4);
            float* o = ovm + (size_t)r * 4096 + col;
            *(f32x4*)o = (f32x4){bflo(v4.x) * rstd * ga.x, bfhi(v4.x) * rstd * ga.y, bflo(v4.y) * rstd * ga.z, bfhi(v4.y) * rstd * ga.w};
            *(f32x4*)(o + 4) = (f32x4){bflo(v4.z) * rstd * gb.x, bfhi(v4.z) * rstd * gb.y, bflo(v4.w) * rstd * gb.z, bfhi(v4.w) * rstd * gb.w}; }
    }
}
struct CMixOrder {
    int G, c; const char* Wm; const char* GVT;
    __device__ __forceinline__ bool next(int i, pg8::Unit& u) const { const int L = i * G + c; if (L >= 66 * 16) return false; const int J = L >> 4, nt = L & 15;
        u.pm = J; u.pn = nt; u.a = Wm + ((size_t)(J * 8 + (nt >> 1)) * 65536) * 2; u.b = GVT + (((size_t)J * 4096 + nt * 256) * 256) * 2; return true; }
    __device__ __forceinline__ void a_ready(const pg8::Unit&) const {}
    __device__ __forceinline__ void done(const pg8::Unit&) const {}
};
struct EpiCMix {
    static constexpr int BMODE = 1;
    pg8::bf16_t* GU; const pg8::bf16_t* SG; const float* vgain; const float* bs;
    __device__ __forceinline__ void operator()(const pg8::f32x4 (&acc)[2][2][4][2], const pg8::Unit& u, int wr, int wc, int fr, int fq) const {
        { const int l_ = lane_now(); fr = l_ & 15; fq = l_ >> 4; }
        const int J = u.pm, nt = u.pn, g = nt >> 1, cm = J < 64 ? 127 : 63;
#pragma unroll
        for (int bj = 0; bj < 2; ++bj) { const int c0 = nt * 256 + bj * 128 + wc * 32 + 8 * fq; const f32x4 ga = *(const f32x4*)(vgain + c0), gb = *(const f32x4*)(vgain + c0 + 4);
            const float gn[8] = {ga.x, ga.y, ga.z, ga.w, gb.x, gb.y, gb.z, gb.w};
#pragma unroll
            for (int ai = 0; ai < 2; ++ai)
#pragma unroll
                for (int m = 0; m < 4; ++m) { const int i = ai * 128 + wr * 64 + m * 16 + fr; const size_t off = ((size_t)J * 256 + i) * 4096 + c0; const float b = bs[g * 128 + (i & cm)];
                    const v4u u4 = *(const v4u*)(GU + off), s4 = *(const v4u*)(SG + off); const pg8::f32x4 v0 = acc[ai][bj][m][0], v1 = acc[ai][bj][m][1];
                    const float mx[8] = {v0[0], v0[1], v0[2], v0[3], v1[0], v1[1], v1[2], v1[3]};
                    const float uu[8] = {bflo(u4.x), bfhi(u4.x), bflo(u4.y), bfhi(u4.y), bflo(u4.z), bfhi(u4.z), bflo(u4.w), bfhi(u4.w)};
                    const float sg[8] = {bflo(s4.x), bfhi(s4.x), bflo(s4.y), bfhi(s4.y), bflo(s4.z), bfhi(s4.z), bflo(s4.w), bfhi(s4.w)}; float y[8];
#pragma unroll
                    for (int k = 0; k < 8; ++k) y[k] = uu[k] * (mx[k] * gn[k] + b) * sg[k];
                    v4u w; w.x = pk2(y[0], y[1]); w.y = pk2(y[2], y[3]); w.z = pk2(y[4], y[5]); w.w = pk2(y[6], y[7]);
                    *(v4u*)(GU + off) = w; } }
    }
};
__device__ __forceinline__ float diff_lambda(const float* q1, const float* k1, const float* q2, const float* k2, float lam_init) {
    float a = 0.f, b = 0.f;
    for (int i = 0; i < 64; ++i) { a += q1[i] * k1[i]; b += q2[i] * k2[i]; }
    return expf(a) - expf(b) + lam_init;
}

constexpr int N_PHASES = 21;
__global__ void __launch_bounds__(NTHR, 2) mega(Args args) {
    extern __shared__ __attribute__((aligned(16))) unsigned char lds[];
    Frame F;
    F.lds = (LAS unsigned char*)lds; F.tid = threadIdx.x; F.lane = F.tid & 63; F.wave = __builtin_amdgcn_readfirstlane(F.tid >> 6); F.G = gridDim.x; F.bid = blockIdx.x;
    F.in = args.in; F.out = args.out; F.ws = args.ws;
    unsigned char* ws = args.ws; float* out = args.out;
    bf16* W_AIN[2] = {(bf16*)(ws + WS_WAIN0), (bf16*)(ws + WS_WAIN1)}; bf16* W_AOUT[2] = {(bf16*)(ws + WS_WAOUT0), (bf16*)(ws + WS_WAOUT1)};
    bf16* W_RIN = (bf16*)(ws + WS_WRIN); bf16* W_ROUT = (bf16*)(ws + WS_WROUT); bf16* W_CIN = (bf16*)(ws + WS_WCIN); bf16* W_COUT = (bf16*)(ws + WS_WCOUT);
    bf16* XN = (bf16*)(ws + WS_XN); bf16* Z = (bf16*)(ws + WS_Z);
    bf16* Qs = (bf16*)(ws + WS_QS); bf16* KP = (bf16*)(ws + WS_KP); bf16* VP = (bf16*)(ws + WS_VP); bf16* KC = (bf16*)(ws + WS_KC); bf16* VC = (bf16*)(ws + WS_VC); bf16* AO_A = (bf16*)(ws + WS_AOA);
    bf16* KT = (bf16*)(ws + WS_KT); bf16* RG = (bf16*)(ws + WS_RG); bf16* QP = (bf16*)(ws + WS_QP); bf16* KN = (bf16*)(ws + WS_KN); bf16* VS = (bf16*)(ws + WS_VS); bf16* ORET = (bf16*)(ws + WS_ORET);
    bf16* GU = (bf16*)(ws + WS_GU); bf16* SG = (bf16*)(ws + WS_SG); bf16* GVT = (bf16*)(ws + WS_GVT); bf16* WM = (bf16*)(ws + WS_WM); float* SSQ = (float*)(ws + WS_SSQ); bf16* GVS = (bf16*)(ws + WS_GVS); float* TABR = (float*)(ws + WS_TABR); bf16* KVX = (bf16*)(ws + WS_KVX); float* TABA = (float*)(ws + WS_TABA); bf16* GA = (bf16*)(ws + WS_GA);
    const int lo = args.ph_lo, hi = args.ph_hi;
    volatile LAS unsigned* MISC = (volatile LAS unsigned*)(F.lds + MISC_OFF);
    for (int u = F.tid; u < (LDS_BYTES - MISC_OFF) / 4; u += NTHR) ((LAS unsigned*)(F.lds + MISC_OFF))[u] = 0u;
    __syncthreads();
    XcdBarrier bar = xcd_barrier_post((unsigned*)(ws + WS_CTL) + 4096, MISC + 8);
#define IN(k) (lo <= (k) && (k) < hi)
#define PH_ENTER() do { int t_ = F.wave * 64 + lane_now(); F.tid = t_; F.lane = t_ & 63; } while (0)
    volatile LAS int* DRW = (volatile LAS int*)(F.lds + MISC_OFF + 64);
    unsigned* DCTR = (unsigned*)(ws + WS_CTL) + 8192;
#define DRAIN(ph, total, BODY) do { PH_ENTER(); for (;;) { __syncthreads(); if (F.tid == 0) DRW[0] = (int)atomicAdd(DCTR + 64 * (ph), 1u); __syncthreads(); const int c_ = DRW[0]; if (c_ >= (total)) break; BODY } } while (0)
#define SEAM(k) do { if (IN(k) && IN((k) + 1)) xcd_barrier(bar, F.wave == 0 && lane_now() == 0); } while (0)

#define GEMM_STORE(Aptr, Wptr, NN, KK, Optr) do { pg8::GemmP g{KK, KK, (KK) / 64}; pg8::StaticOrder S; S.init(MT / 256, (NN) / 256, F.G, F.bid, Aptr, Wptr, KK, KK); pg8::EpiStoreBf16 E{(pg8::bf16_t*)(Optr), NN}; \
        pg8::gemm_phase<pg8::EpiStoreBf16, pg8::StaticOrder>(F.lds + RING_OFF, g, S, E, F.tid); } while (0)
#define GEMM_RESID(Aptr, Wptr, KK, BP, BS) do { pg8::GemmP g{KK, KK, (KK) / 64}; pg8::StaticOrder S; S.init(MT / 256, DM / 256, F.G, F.bid, Aptr, Wptr, KK, KK); pg8::EpiResid E{BP, BS, out, MP}; \
        pg8::gemm_phase<pg8::EpiResid, pg8::StaticOrder>(F.lds + RING_OFF, g, S, E, F.tid); } while (0)

    PH_ENTER(); if (IN(0)) {
        transpose_weight(F, args.in[I_AWIN], 2048, 8192, W_AIN[0]); attn_table(F, TABA);
        norm_rows(F, args.in[I_XP], args.in[I_XS], args.in[I_NW], XN);
    }
    SEAM(0);
#define GEMM_AIN(Wptr, J_) do { pg8::GemmP g{2048, 2048, 32}; pg8::StaticOrder S; S.init(MT / 256, 32, F.G, F.bid, XN, Wptr, 2048, 2048); \
        EpiAIn E{Qs, KP, VP, KC, VC, GA, out + O_KP + (size_t)(J_) * MP * DM, out + O_VP + (size_t)(J_) * MP * DM, out + O_KS + (size_t)(J_) * MS * DM, out + O_VS + (size_t)(J_) * MS * DM, TABA, args.in[I_AQG] + 64 * (J_), args.in[I_AKG] + 64 * (J_)}; \
        pg8::gemm_phase<EpiAIn, pg8::StaticOrder>(F.lds + RING_OFF, g, S, E, F.tid); } while (0)
    PH_ENTER(); if (IN(1)) { GEMM_AIN(W_AIN[0], 0);
        const int n0 = CC_CHUNKS, n1 = n0 + tw_chunks(2048, 2048), n2 = n1 + TR_CHUNKS;
        DRAIN(1, n2, if (c_ < n0) cc_run(F, args.in[I_CK], args.in[I_CV], KC, VC, c_); else if (c_ < n1) tw_run(F, args.in[I_AWOUT], 2048, 2048, W_AOUT[0], c_ - n0); else tr_run(F, TABR, c_ - n1);); }
    SEAM(1);
    PH_ENTER(); if (IN(3)) { const float li = 0.8f - 0.6f * expf(-0.3f * 0.f); const float lam = diff_lambda(args.in[I_LQ1], args.in[I_LK1], args.in[I_LQ2], args.in[I_LK2], li);
        attn_fast(F, Qs, KP, VP, KC, VC, GA, AO_A, lam, 1.f - li, args.in[I_ASG]); }
    SEAM(3);
    PH_ENTER(); if (IN(4)) { GEMM_RESID(AO_A, W_AOUT[0], 2048, args.in[I_XP], args.in[I_XS]);
        const int n0 = tw_chunks(2048, 12288), n1 = n0 + tw_chunks(4096, 2048);
        DRAIN(4, n1, if (c_ < n0) tw_run(F, args.in[I_RWIN], 2048, 12288, W_RIN, c_); else tw_run(F, args.in[I_RWOUT], 4096, 2048, W_ROUT, c_ - n0);); }
    SEAM(4);
    PH_ENTER(); if (IN(5)) { norm_rows(F, out + O_YP, out + O_YS, args.in[I_NW] + DM, XN); ret_zero_pad(F, VS); }
    SEAM(5);
    PH_ENTER(); if (IN(6)) { pg8::GemmP g{2048, 2048, 32}; pg8::StaticOrder S; S.init(MT / 256, 48, F.G, F.bid, XN, W_RIN, 2048, 2048); EpiRet E{QP, KN, KT, VS, RG, TABR};
        pg8::gemm_phase<EpiRet, pg8::StaticOrder>(F.lds + RING_OFF, g, S, E, F.tid); }
    SEAM(6);
    PH_ENTER(); if (IN(7)) { { pg8::GemmP g{4096, 2048, 4}; RetQKOrder S{F.G, F.bid, (const char*)QP, (const char*)KN}; EpiRetQK E{QP}; pg8::gemm_phase<EpiRetQK, RetQKOrder>(F.lds + RING_OFF, g, S, E, F.tid); }
        PH_ENTER(); { pg8::GemmP g{512, 256, 4}; RetKVOrder S{F.G, F.bid, (const char*)VS, (const char*)KT}; EpiRetKV E{VS, KVX}; pg8::gemm_phase<EpiRetKV, RetKVOrder>(F.lds + RING_OFF, g, S, E, F.tid); }
        xcd_barrier(bar, F.wave == 0 && lane_now() == 0);
        PH_ENTER(); ret_scan(F, VS, KVX, args.in[I_SR], out + O_SP, out + O_SS); }
    SEAM(7);
    PH_ENTER(); if (IN(8)) { pg8::GemmP g{4096, 512, 8}; RetOOrder S{F.G, F.bid, (const char*)QP, (const char*)VS}; EpiRetO E{ORET}; pg8::gemm_phase<EpiRetO, RetOOrder>(F.lds + RING_OFF, g, S, E, F.tid); }
    SEAM(8);
    PH_ENTER(); if (IN(9)) r_out(F, ORET, RG);
    SEAM(9);
    PH_ENTER(); if (IN(10)) { GEMM_RESID(ORET, W_ROUT, 4096, out + O_YP, out + O_YS);
        const int n0 = tw_chunks(2048, 12288), n1 = n0 + tw_chunks(4096, 2048), n2 = n1 + tw_chunks(2048, 8192), n3 = n2 + tw_chunks(2048, 2048);
        DRAIN(10, n3, if (c_ < n0) tw_run(F, args.in[I_CWIN], 2048, 12288, W_CIN, c_); else if (c_ < n1) tw_run(F, args.in[I_CWOUT], 4096, 2048, W_COUT, c_ - n0);
                      else if (c_ < n2) tw_run(F, args.in[I_AWIN] + (size_t)2048 * 8192, 2048, 8192, W_AIN[1], c_ - n1); else tw_run(F, args.in[I_AWOUT] + (size_t)2048 * 2048, 2048, 2048, W_AOUT[1], c_ - n2);); }
    SEAM(10);
    PH_ENTER(); if (IN(11)) norm_rows(F, out + O_YP, out + O_YS, args.in[I_NW] + 2 * DM, XN);
    SEAM(11);
    PH_ENTER(); if (IN(12)) { pg8::GemmP g{2048, 2048, 32}; pg8::StaticOrder S; S.init(MT / 256, 48, F.G, F.bid, XN, W_CIN, 2048, 2048); EpiCIn E{GU, GVT, SG, GVS, SSQ};
        pg8::gemm_phase<EpiCIn, pg8::StaticOrder>(F.lds + RING_OFF, g, S, E, F.tid); }
    SEAM(12);
    PH_ENTER(); if (IN(13)) c_prep(F, SSQ, args.in[I_CWS], args.in[I_CVG], GVS, WM, out + O_VM);
    SEAM(13);
    PH_ENTER(); if (IN(14)) { pg8::GemmP g{256, 256, 4}; CMixOrder S{F.G, F.bid, (const char*)WM, (const char*)GVT}; EpiCMix E{GU, SG, args.in[I_CVG], args.in[I_CBS]}; pg8::gemm_phase<EpiCMix, CMixOrder>(F.lds + RING_OFF, g, S, E, F.tid); }
    SEAM(14);
    PH_ENTER(); if (IN(15)) { GEMM_RESID(GU, W_COUT, 4096, out + O_YP, out + O_YS);
        DRAIN(15, CC_CHUNKS, cc_run(F, args.in[I_CK] + (size_t)NB * PAST * DM, args.in[I_CV] + (size_t)NB * PAST * DM, KC, VC, c_);); }
    SEAM(15);
    PH_ENTER(); if (IN(16)) norm_rows(F, out + O_YP, out + O_YS, args.in[I_NW] + 3 * DM, XN);
    SEAM(16);
    PH_ENTER(); if (IN(17)) GEMM_AIN(W_AIN[1], 1);
    SEAM(17);
    PH_ENTER(); if (IN(19)) { const float li = 0.8f - 0.6f * expf(-0.3f * 3.f); const float lam = diff_lambda(args.in[I_LQ1] + 64, args.in[I_LK1] + 64, args.in[I_LQ2] + 64, args.in[I_LK2] + 64, li);
        attn_fast(F, Qs, KP, VP, KC, VC, GA, AO_A, lam, 1.f - li, args.in[I_ASG] + 128); }
    SEAM(19);
    PH_ENTER(); if (IN(20)) GEMM_RESID(AO_A, W_AOUT[1], 2048, out + O_YP, out + O_YS);
#undef IN
#undef SEAM
}

extern "C" void kernel_launch(void* const* d_in, const int* in_sizes, int n_in, void* d_out, int out_size, void* d_ws, size_t ws_size, hipStream_t stream) {
    static int grid = 0;
    if (grid == 0) {
        if (n_in != N_IN || (size_t)out_size != O_END || ws_size < WS_END) { fprintf(stderr, "kernel_launch: unexpected shapes: n_in %d out %d ws %zu (need %zu)\n", n_in, out_size, ws_size, (size_t)WS_END); grid = -1; return; }
        int dev = 0, cus = 0;
        if (hipGetDevice(&dev) != hipSuccess || hipDeviceGetAttribute(&cus, hipDeviceAttributeMultiprocessorCount, dev) != hipSuccess) { grid = -1; return; }
        if (hipFuncSetAttribute((const void*)mega, hipFuncAttributeMaxDynamicSharedMemorySize, LDS_BYTES) != hipSuccess) { fprintf(stderr, "kernel_launch: hipFuncSetAttribute failed\n"); grid = -1; return; }
        (void)hipGetLastError();
        grid = cus;
    }
    if (grid < 0) return;
    Args a{};
    for (int i = 0; i < N_IN; ++i) a.in[i] = (const float*)d_in[i];
    a.out = (float*)d_out; a.ws = (unsigned char*)d_ws;
    (void)hipMemsetAsync((char*)d_ws + WS_CTL, 0, CTL_ZERO_BYTES, stream);
    a.ph_lo = 0; a.ph_hi = N_PHASES;
    hipLaunchKernelGGL(mega, dim3(grid), dim3(NTHR), LDS_BYTES, stream, a);
}
```

```cpp
#include <hip/hip_runtime.h>
#include <cstdio>
#include <cstdint>

__device__ __forceinline__ int lane_now() { int l; asm volatile("v_mbcnt_lo_u32_b32 %0, -1, 0\n\tv_mbcnt_hi_u32_b32 %0, -1, %0" : "=v"(l)); return l; }
namespace pg8 {
#define PG8_LAS __attribute__((address_space(3)))
typedef unsigned short bf16_t;
typedef short bf16x8 __attribute__((ext_vector_type(8)));
typedef float f32x4 __attribute__((ext_vector_type(4)));
typedef unsigned u32x4 __attribute__((ext_vector_type(4)));
constexpr int BM = 256, BK = 64, HALF = 128, HTB = HALF * BK * 2, STAGE_BYTES = 8 * HTB, NXCD = 8, WGM = 8;

__host__ __device__ __forceinline__ int lds_byte(int r, int c) { const int st = (r >> 4) * 2 + (c >> 5), rr = r & 15, cc = c & 31, ob = rr * 64 + cc * 2; return st * 1024 + (ob ^ (((ob >> 9) & 1) << 5)); }
__host__ __device__ __forceinline__ void stage_rc(int b, int& R, int& C) { const int st = b / 1024, sb = b % 1024, swz = sb ^ (((sb >> 9) & 1) << 5); R = (st >> 1) * 16 + swz / 64; C = (st & 1) * 32 + (swz % 64) / 2; }
__host__ __device__ __forceinline__ int perm32(int rho) { const int n = rho >> 4, i = rho & 15; return 8 * (i >> 2) + 4 * n + (i & 3); }

struct Unit { int pm, pn; const char* a; const char* b; };
struct GemmP { int lda, ldb, nt; };

struct StaticOrder {
    int nM, nN, nwg, G, c; const char* A; const char* B; size_t ta, tb;
    __host__ __device__ void init(int nM_, int nN_, int G_, int c_, const void* A_, const void* B_, int lda, int ldb) { nM = nM_; nN = nN_; nwg = nM * nN; G = G_; c = c_; A = (const char*)A_; B = (const char*)B_; ta = (size_t)BM * lda * 2; tb = (size_t)BM * ldb * 2; }
    __host__ __device__ bool next(int i, Unit& u) const {
        const long L = (long)i * G + c; if (L >= nwg) return false;
        int wgid = (int)L; { const int q = nwg / NXCD, r = nwg % NXCD, xcd = wgid % NXCD, off = wgid / NXCD; wgid = (xcd < r ? xcd * (q + 1) : r * (q + 1) + (xcd - r) * q) + off; }
        const int nig = WGM * nN, gid = wgid / nig, fm = gid * WGM, gsz = (nM - fm) < WGM ? (nM - fm) : WGM;
        u.pm = fm + ((wgid % nig) % gsz); u.pn = (wgid % nig) / gsz; u.a = A + (size_t)u.pm * ta; u.b = B + (size_t)u.pn * tb; return true;
    }
    __device__ __forceinline__ void a_ready(const Unit&) const {}
    __device__ __forceinline__ void done(const Unit&) const {}
};

__device__ __forceinline__ unsigned cvt_pk_bf16(float lo, float hi) { unsigned r; asm volatile("v_cvt_pk_bf16_f32 %0, %1, %2" : "=v"(r) : "v"(lo), "v"(hi)); return r; }

struct EpiStoreBf16 {
    static constexpr int BMODE = 1;
    bf16_t* O; int ldc;
    __device__ __forceinline__ void operator()(const f32x4 (&acc)[2][2][4][2], const Unit& u, int wr, int wc, int fr, int fq) const {
        const int row0 = u.pm * BM + wr * 64 + fr; const int col0 = u.pn * BM + wc * 32 + 8 * fq;
#pragma unroll
        for (int ai = 0; ai < 2; ++ai)
#pragma unroll
            for (int m = 0; m < 4; ++m) { bf16_t* rowp = O + (size_t)(row0 + ai * HALF + m * 16) * ldc + col0;
#pragma unroll
                for (int bj = 0; bj < 2; ++bj) { const f32x4 v0 = acc[ai][bj][m][0], v1 = acc[ai][bj][m][1];
                    u32x4 w; w.x = cvt_pk_bf16(v0[0], v0[1]); w.y = cvt_pk_bf16(v0[2], v0[3]); w.z = cvt_pk_bf16(v1[0], v1[1]); w.w = cvt_pk_bf16(v1[2], v1[3]);
                    *(u32x4*)(rowp + bj * HALF) = w; } }
    }
};
struct EpiResid {
    static constexpr int BMODE = 0;
    const float* base_p; const float* base_s; float* out; int split;
    __device__ __forceinline__ void operator()(const f32x4 (&acc)[2][2][4][2], const Unit& u, int wr, int wc, int fr, int fq) const {
        { const int l_ = lane_now(); fr = l_ & 15; fq = l_ >> 4; }
        const int col0 = u.pn * BM + wc * 32 + 4 * fq;
#pragma unroll
        for (int ai = 0; ai < 2; ++ai) {
            f32x4 bs[4][2][2];
#pragma unroll
            for (int m = 0; m < 4; ++m) { const int r = u.pm * BM + ai * HALF + wr * 64 + m * 16 + fr; const float* bp = (r < split) ? base_p + (size_t)r * 2048 : base_s + (size_t)(r - split) * 2048;
#pragma unroll
                for (int bj = 0; bj < 2; ++bj)
#pragma unroll
                    for (int n = 0; n < 2; ++n) bs[m][bj][n] = *(const f32x4*)(bp + col0 + bj * HALF + n * 16); }
#pragma unroll
            for (int m = 0; m < 4; ++m) { const int r = u.pm * BM + ai * HALF + wr * 64 + m * 16 + fr; float* op = out + (size_t)r * 2048;
#pragma unroll
                for (int bj = 0; bj < 2; ++bj)
#pragma unroll
                    for (int n = 0; n < 2; ++n) *(f32x4*)(op + col0 + bj * HALF + n * 16) = bs[m][bj][n] + acc[ai][bj][m][n]; }
            asm volatile("" ::: "memory");
        }
    }
};

template <int MODE> struct EpiResidB {
    static constexpr int BMODE = 1;
    const float* base_p; const float* base_s; bf16_t* HB; float* out; float* SSQ2;
    __device__ __forceinline__ void operator()(const f32x4 (&acc)[2][2][4][2], const Unit& u, int wr, int wc, int fr, int fq) const {
        { const int l_ = lane_now(); fr = l_ & 15; fq = l_ >> 4; }
        const int col0 = u.pn * BM + wc * 32 + 8 * fq;
#pragma unroll
        for (int ai = 0; ai < 2; ++ai) {
            f32x4 b0[4][2], b1[4][2]; u32x4 hb[4][2];
#pragma unroll
            for (int m = 0; m < 4; ++m) { const int r = u.pm * BM + ai * HALF + wr * 64 + m * 16 + fr;
#pragma unroll
                for (int bj = 0; bj < 2; ++bj) {
                    if (MODE == 0) { const float* bp = ((r < 16384) ? base_p + (size_t)r * 2048 : base_s + (size_t)(r - 16384) * 2048) + col0 + bj * HALF; b0[m][bj] = *(const f32x4*)bp; b1[m][bj] = *(const f32x4*)(bp + 4); }
                    else hb[m][bj] = *(const u32x4*)(HB + (size_t)r * 2048 + col0 + bj * HALF); } }
#pragma unroll
            for (int m = 0; m < 4; ++m) { const int r = u.pm * BM + ai * HALF + wr * 64 + m * 16 + fr; float ss = 0.f;
#pragma unroll
                for (int bj = 0; bj < 2; ++bj) { f32x4 h0, h1;
                    if (MODE == 0) { h0 = b0[m][bj] + acc[ai][bj][m][0]; h1 = b1[m][bj] + acc[ai][bj][m][1]; }
                    else { const u32x4 w = hb[m][bj];
                        h0 = (f32x4){__builtin_bit_cast(float, w.x << 16), __builtin_bit_cast(float, w.x & 0xffff0000u), __builtin_bit_cast(float, w.y << 16), __builtin_bit_cast(float, w.y & 0xffff0000u)} + acc[ai][bj][m][0];
                        h1 = (f32x4){__builtin_bit_cast(float, w.z << 16), __builtin_bit_cast(float, w.z & 0xffff0000u), __builtin_bit_cast(float, w.w << 16), __builtin_bit_cast(float, w.w & 0xffff0000u)} + acc[ai][bj][m][1]; }
                    if (MODE == 2) { float* op = out + (size_t)r * 2048 + col0 + bj * HALF; *(f32x4*)op = h0; *(f32x4*)(op + 4) = h1; }
                    else { u32x4 w; w.x = cvt_pk_bf16(h0[0], h0[1]); w.y = cvt_pk_bf16(h0[2], h0[3]); w.z = cvt_pk_bf16(h1[0], h1[1]); w.w = cvt_pk_bf16(h1[2], h1[3]);
                        *(u32x4*)(HB + (size_t)r * 2048 + col0 + bj * HALF) = w;
                        ss += (h0[0] * h0[0] + h0[1] * h0[1]) + (h0[2] * h0[2] + h0[3] * h0[3]) + (h1[0] * h1[0] + h1[1] * h1[1]) + (h1[2] * h1[2] + h1[3] * h1[3]); } }
                if (MODE != 2) { ss += __shfl_xor(ss, 16); ss += __shfl_xor(ss, 32); if (fq == 0) SSQ2[(size_t)r * 32 + u.pn * 4 + wc] = ss; } }
            asm volatile("" ::: "memory");
        }
    }
};

template <class Epi, class Sched, bool ALIGN_EPI = true>
__device__ __forceinline__ void gemm_phase(PG8_LAS unsigned char* lds, const GemmP g, const Sched& S, const Epi& E, int tid) {
    asm volatile("" : "+v"(tid));
    const int wid = __builtin_amdgcn_readfirstlane(tid >> 6), lane = tid & 63, wr = wid >> 2, wc = wid & 3, fr = lane & 15, fq = lane >> 4;
    const int nt = g.nt;
    unsigned voffA[2], voffB[2];
#pragma unroll
    for (int i = 0; i < 2; ++i) { int R, C; stage_rc(tid * 16 + i * 8192, R, C); const int Rb = Epi::BMODE == 2 ? (64 * (R >> 5) + perm32(R & 31)) : Epi::BMODE == 1 ? ((R & ~31) + perm32(R & 31)) : R;
        voffA[i] = (unsigned)(R * g.lda + C) * 2u; voffB[i] = (unsigned)(Rb * g.ldb + C) * 2u; }
    const size_t kstep = (size_t)(BK * 2);
    const size_t hstepA = (size_t)HALF * g.lda * 2, hstepB = (size_t)(Epi::BMODE == 2 ? 32 : HALF) * g.ldb * 2;
    const unsigned ldsw = (unsigned)wid * 1024u;
    const int aoff = lds_byte(wr * 64 + fr, fq * 8), boff = lds_byte(wc * 32 + fr, fq * 8);
#define PG8_SA(b, h) (((b) * 2 + (h)) * HTB)
#define PG8_SB(b, h) ((4 + (b) * 2 + (h)) * HTB)
#define PG8_STAGE(bufoff, gbase, voff) do { _Pragma("unroll") for (int _i = 0; _i < 2; ++_i) \
        __builtin_amdgcn_global_load_lds((const unsigned*)((const char*)(gbase) + (voff)[_i]), (PG8_LAS unsigned*)(lds + (bufoff) + ldsw + _i * 8192), 16, 0, 0); } while (0)
#define PG8_LDA(dst, b, h) do { _Pragma("unroll") for (int m = 0; m < 4; ++m) _Pragma("unroll") for (int k = 0; k < 2; ++k) dst[m][k] = *(const PG8_LAS bf16x8*)(lds + PG8_SA(b, h) + aoff + m * 2048 + k * 1024); } while (0)
#define PG8_LDB(dst, b, h) do { _Pragma("unroll") for (int n = 0; n < 2; ++n) _Pragma("unroll") for (int k = 0; k < 2; ++k) dst[n][k] = *(const PG8_LAS bf16x8*)(lds + PG8_SB(b, h) + boff + n * 2048 + k * 1024); } while (0)
#define PG8_MMA(ai, bj, At, Bt) do { __builtin_amdgcn_s_setprio(1); _Pragma("unroll") for (int m = 0; m < 4; ++m) _Pragma("unroll") for (int n = 0; n < 2; ++n) _Pragma("unroll") for (int k = 0; k < 2; ++k) \
        acc[ai][bj][m][n] = __builtin_amdgcn_mfma_f32_16x16x32_bf16(Bt[n][k], At[m][k], acc[ai][bj][m][n], 0, 0, 0); __builtin_amdgcn_s_setprio(0); } while (0)
#define PG8_WAIT_V(n) asm volatile("s_waitcnt vmcnt(" #n ")" ::: "memory")
#define PG8_WAIT_L(n) asm volatile("s_waitcnt lgkmcnt(" #n ")" ::: "memory")
#define PG8_BAR __builtin_amdgcn_s_barrier()
#define PG8_SCHED __builtin_amdgcn_sched_barrier(0)
    Unit cur, nxt; int ui = 0;
    if (!S.next(0, cur)) return;
    f32x4 acc[2][2][4][2];
#pragma unroll
    for (int a = 0; a < 2; ++a)
#pragma unroll
        for (int b = 0; b < 2; ++b)
#pragma unroll
            for (int m = 0; m < 4; ++m)
#pragma unroll
                for (int n = 0; n < 2; ++n) acc[a][b][m][n] = (f32x4){0.f, 0.f, 0.f, 0.f};
    bf16x8 At[4][2], B0[2][2], B1[2][2];
    const char* cA = cur.a; const char* cB = cur.b;
    S.a_ready(cur);
    PG8_STAGE(PG8_SB(0, 0), cB, voffB); PG8_STAGE(PG8_SB(0, 1), cB + hstepB, voffB); PG8_STAGE(PG8_SA(0, 0), cA, voffA); PG8_STAGE(PG8_SA(0, 1), cA + hstepA, voffA);
    if (wr == 1) PG8_BAR;
    PG8_WAIT_V(2); PG8_BAR;
    PG8_STAGE(PG8_SB(1, 0), cB + kstep, voffB); PG8_STAGE(PG8_SA(1, 0), cA + kstep, voffA); PG8_STAGE(PG8_SB(1, 1), cB + hstepB + kstep, voffB);
    PG8_WAIT_V(6); PG8_BAR;
    for (;;) {
        const bool has_next = S.next(ui + 1, nxt);
        const char* nA = has_next ? nxt.a : cA; const char* nB = has_next ? nxt.b : cB;
        for (int t = 0; t < nt; t += 2) {
            const bool last = (t == nt - 2);
            const char* a1 = cA + (size_t)(t + 1) * kstep;
            const char* a2 = last ? nA : cA + (size_t)(t + 2) * kstep; const char* b2 = last ? nB : cB + (size_t)(t + 2) * kstep;
            const char* a3 = a2 + kstep; const char* b3 = b2 + kstep;
            if (last && has_next) S.a_ready(nxt);
            PG8_LDB(B0, 0, 0); PG8_LDB(B1, 0, 1); PG8_SCHED; PG8_LDA(At, 0, 0); PG8_STAGE(PG8_SA(1, 1), a1 + hstepA, voffA);
            PG8_WAIT_V(8); PG8_WAIT_L(0); PG8_BAR; PG8_MMA(0, 0, At, B0); PG8_MMA(0, 1, At, B1); PG8_BAR; PG8_SCHED;
            PG8_LDA(At, 0, 1); PG8_STAGE(PG8_SB(0, 0), b2, voffB); PG8_STAGE(PG8_SB(0, 1), b2 + hstepB, voffB); PG8_STAGE(PG8_SA(0, 0), a2, voffA);
            PG8_WAIT_V(8); PG8_WAIT_L(0); PG8_BAR; PG8_MMA(1, 0, At, B0); PG8_MMA(1, 1, At, B1); PG8_BAR; PG8_SCHED;
            PG8_LDB(B0, 1, 0); PG8_LDB(B1, 1, 1); PG8_SCHED; PG8_LDA(At, 1, 0); PG8_STAGE(PG8_SA(0, 1), a2 + hstepA, voffA);
            PG8_WAIT_V(8); PG8_WAIT_L(0); PG8_BAR; PG8_MMA(0, 0, At, B0); PG8_MMA(0, 1, At, B1); PG8_BAR; PG8_SCHED;
            PG8_LDA(At, 1, 1); PG8_STAGE(PG8_SB(1, 0), b3, voffB); PG8_STAGE(PG8_SB(1, 1), b3 + hstepB, voffB); PG8_STAGE(PG8_SA(1, 0), a3, voffA);
            PG8_WAIT_V(8); PG8_WAIT_L(0); PG8_BAR; PG8_MMA(1, 0, At, B0); PG8_MMA(1, 1, At, B1); PG8_BAR; PG8_SCHED;
        }
        if constexpr (ALIGN_EPI) { if (wr == 0) PG8_BAR; }
        E(acc, cur, wr, wc, fr, fq); S.done(cur);
        if (!has_next) break;
#pragma unroll
        for (int a = 0; a < 2; ++a)
#pragma unroll
            for (int b = 0; b < 2; ++b)
#pragma unroll
                for (int m = 0; m < 4; ++m)
#pragma unroll
                    for (int n = 0; n < 2; ++n) acc[a][b][m][n] = (f32x4){0.f, 0.f, 0.f, 0.f};
        cur = nxt; cA = nA; cB = nB; ++ui;
        if constexpr (ALIGN_EPI) { if (wr == 1) PG8_BAR; }
    }
    PG8_WAIT_V(0);
    if constexpr (!ALIGN_EPI) { if (wr == 0) PG8_BAR; }
    PG8_BAR;
#undef PG8_SA
#undef PG8_SB
#undef PG8_STAGE
#undef PG8_LDA
#undef PG8_LDB
#undef PG8_MMA
#undef PG8_WAIT_V
#undef PG8_WAIT_L
#undef PG8_BAR
#undef PG8_SCHED
}
}

constexpr int NWAVES = 8, NTHR = 512;
constexpr int DM = 2048, MP = 16384, MS = 512, MT = MP + MS, PAST = 2048, DECL = 64, NB = 8;
constexpr int KCROWS = PAST + DECL;
constexpr float EPS = 1e-6f;
constexpr float LOG2E = 1.4426950408889634f;
constexpr float C2 = 0.125f * LOG2E;

enum { I_XP = 0, I_XS, I_CK, I_CV, I_SR, I_NW, I_AWIN, I_AWOUT, I_AQG, I_AKG, I_LQ1, I_LK1, I_LQ2, I_LK2, I_ASG, I_RWIN, I_RWOUT, I_CWIN, I_CWOUT, I_CVG, I_CWS, I_CBS, N_IN };
constexpr size_t O_YP = 0, O_YS = O_YP + (size_t)MP * DM, O_KP = O_YS + (size_t)MS * DM, O_VP = O_KP + 2 * (size_t)MP * DM, O_KS = O_VP + 2 * (size_t)MP * DM, O_VS = O_KS + 2 * (size_t)MS * DM,
                 O_SP = O_VS + 2 * (size_t)MS * DM, O_SS = O_SP + (size_t)8 * 256 * 512, O_VM = O_SS + (size_t)NB * 8 * 256 * 512, O_END = O_VM + (size_t)MS * 4096;

constexpr size_t MiB = 1u << 20;
constexpr size_t WS_CTL = 0, CTL_ZERO_BYTES = 1 * MiB;
constexpr size_t WS_WAIN0 = 8 * MiB, WS_WAOUT0 = 40 * MiB, WS_WRIN = 48 * MiB, WS_WROUT = 96 * MiB, WS_WCIN = 112 * MiB, WS_WCOUT = 160 * MiB, WS_WAIN1 = 176 * MiB, WS_WAOUT1 = 208 * MiB;
constexpr size_t WS_SSQ2 = 2 * MiB;
constexpr size_t WS_HB = 216 * MiB, WS_Z = 282 * MiB;
constexpr size_t WS_XN0 = 348 * MiB;
constexpr size_t WS_QS = 546 * MiB, WS_KP = 612 * MiB, WS_VP = 676 * MiB, WS_KC = 740 * MiB, WS_VC = 806 * MiB, WS_AOA = 872 * MiB;
constexpr size_t WS_KT = 112 * MiB, WS_RG = 282 * MiB, WS_QP = 414 * MiB, WS_KN = 546 * MiB, WS_VS = 612 * MiB, WS_ORET = 900 * MiB;
constexpr size_t WS_GU = 282 * MiB, WS_SG = 414 * MiB, WS_GVT = 546 * MiB, WS_WM = 678 * MiB, WS_SSQ = 744 * MiB, WS_GVS = 752 * MiB;
constexpr size_t WS_GA = 282 * MiB;
constexpr size_t WS_KVX = 184 * MiB;
constexpr size_t WS_TABR = 1040 * MiB, WS_TABA = 1056 * MiB, WS_END = 1060 * MiB;

#define GAS __attribute__((address_space(1)))
#define LAS __attribute__((address_space(3)))
typedef unsigned short bf16;
typedef unsigned v4u __attribute__((ext_vector_type(4)));
typedef unsigned v2u __attribute__((ext_vector_type(2)));
typedef float f32x4 __attribute__((ext_vector_type(4)));
typedef GAS unsigned gu32;
#define RLX_AGENT __ATOMIC_RELAXED, __HIP_MEMORY_SCOPE_AGENT
#define LDS_WAIT() asm volatile("s_waitcnt lgkmcnt(0)" ::: "memory")
#define VM_WAIT() asm volatile("s_waitcnt vmcnt(0)" ::: "memory")
__device__ __forceinline__ unsigned f2bf(float f) { unsigned u = __builtin_bit_cast(unsigned, f); return (u + 0x7fffu + ((u >> 16) & 1u)) >> 16; }
__device__ __forceinline__ unsigned pk2(float lo, float hi) { return f2bf(lo) | (f2bf(hi) << 16); }
__device__ __forceinline__ float bf2f(unsigned short b) { return __builtin_bit_cast(float, (unsigned)b << 16); }
__device__ __forceinline__ float bflo(unsigned w) { return __builtin_bit_cast(float, w << 16); }
__device__ __forceinline__ float bfhi(unsigned w) { return __builtin_bit_cast(float, w & 0xffff0000u); }
__device__ __forceinline__ float silu_f(float x) { return x / (1.f + __expf(-x)); }
__device__ __forceinline__ float gelu_tanh_f(float x) { const float u = 0.7978845608028654f * (x + 0.044715f * x * x * x); return x / (1.f + __expf(-2.f * u)); }
__device__ __forceinline__ float wave_sum(float v) {
#pragma unroll
    for (int o = 1; o < 64; o <<= 1) v += __shfl_xor(v, o);
    return v;
}
__device__ __forceinline__ void row_rstd(const float* ssq, int pm, int wr, int fr, int fq, float (&rs)[2][4]) {
#pragma unroll
    for (int ai = 0; ai < 2; ++ai)
#pragma unroll
        for (int m = 0; m < 4; ++m) {
            if (ssq) { const float* p = ssq + ((size_t)pm * 256 + ai * 128 + wr * 64 + m * 16 + fr) * 32 + 8 * fq; const f32x4 a = *(const f32x4*)p, b = *(const f32x4*)(p + 4);
                float t = ((a.x + a.y) + (a.z + a.w)) + ((b.x + b.y) + (b.z + b.w)); t += __shfl_xor(t, 16); t += __shfl_xor(t, 32); rs[ai][m] = 1.f / sqrtf(t * (1.f / 2048.f) + EPS); }
            else rs[ai][m] = 1.f; }
}
__device__ __forceinline__ void rope_cs(int pos, int i, int nf, float& c, float& s) {
    const float inv = exp2f(-(float)i / (float)nf * 13.287712379549449f);
    const double a = (double)pos * (double)inv * 0.15915494309189535;
    const float r = (float)(a - floor(a));
    c = __builtin_amdgcn_cosf(r); s = __builtin_amdgcn_sinf(r);
}

#define XB_TMO      128
#define XB_XCNT(j)  (256  + 64 * (j))
#define XB_XSUB(j)  (1280 + 64 * (j))
#define XB_XGEN(j)  (2304 + 64 * (j))
#define XB_TOP      3328
#define XB_TOPGEN   3392
#define XCD_BAR_WORDS 3456
#define XB_SPIN_CAP (1u << 22)
__device__ __forceinline__ unsigned xb_ld(unsigned* p)              { return __hip_atomic_load(p, __ATOMIC_RELAXED, __HIP_MEMORY_SCOPE_AGENT); }
__device__ __forceinline__ unsigned xb_add(unsigned* p, unsigned v) { return __hip_atomic_fetch_add(p, v, __ATOMIC_RELAXED, __HIP_MEMORY_SCOPE_AGENT); }
__device__ __forceinline__ unsigned xb_xcc_id() { return (unsigned)__builtin_amdgcn_s_getreg((3 << 11) | 20) & 0xFu; }
#define XB_SPIN(cond, bar) do { unsigned _sp = 0; while (cond) { __builtin_amdgcn_s_sleep(1); \
    if ((++_sp & 255u) == 0u) { if (xb_ld(&(bar)[XB_TMO])) break; if (_sp > XB_SPIN_CAP) { atomicAdd(&(bar)[XB_TMO], 1u); break; } } } } while (0)
struct XcdBarrier { unsigned* bar; unsigned x; volatile LAS unsigned* st; };
__device__ __forceinline__ XcdBarrier xcd_barrier_post(unsigned* bar, volatile LAS unsigned* st) {
    XcdBarrier b; b.bar = bar; b.x = xb_xcc_id(); b.st = st;
    if (threadIdx.x == 0) (void)xb_add(&bar[XB_XCNT(b.x)], 1u);
    return b;
}
__device__ __forceinline__ void xcd_barrier_complete(unsigned* bar, unsigned x, unsigned& nloc, unsigned& nx) {
    const unsigned G = gridDim.x * gridDim.y * gridDim.z;
    unsigned sum, cnt, mine, sp = 0u;
    for (;;) {
        sum = 0u; cnt = 0u; mine = 0u;
#pragma unroll
        for (unsigned j = 0; j < 16; ++j) { const unsigned c = xb_ld(&bar[XB_XCNT(j)]); sum += c; cnt += (c > 0u) ? 1u : 0u; mine = (j == x) ? c : mine; }
        if (sum == G) break;
        __builtin_amdgcn_s_sleep(1);
        if ((++sp & 255u) == 0u) { if (xb_ld(&bar[XB_TMO])) break; if (sp > XB_SPIN_CAP) { atomicAdd(&bar[XB_TMO], 1u); break; } }
    }
    nloc = mine > 0u ? mine : 1u; nx = cnt > 0u ? cnt : 1u;
}
__device__ __forceinline__ void xcd_barrier(const XcdBarrier& b, bool leader) {
    asm volatile("s_waitcnt vmcnt(0)" ::: "memory");
    __syncthreads();
    if (leader) {
        unsigned* bar = b.bar;
        __builtin_amdgcn_s_waitcnt(0);
        unsigned nloc = b.st[0], nx = b.st[1];
        if (nloc == 0u) { xcd_barrier_complete(bar, b.x, nloc, nx); b.st[0] = nloc; b.st[1] = nx; }
        const unsigned old = xb_add(&bar[XB_XSUB(b.x)], 1u);
        const unsigned gen = old / nloc;
        if (old + 1u == (gen + 1u) * nloc) {
            __builtin_amdgcn_fence(__ATOMIC_RELEASE, "agent");
            asm volatile("s_waitcnt vmcnt(0)" ::: "memory");
            const unsigned og = xb_add(&bar[XB_TOP], 1u);
            const unsigned tg = og / nx;
            if (og + 1u == (tg + 1u) * nx) xb_add(&bar[XB_TOPGEN], 1u);
            else XB_SPIN(xb_ld(&bar[XB_TOPGEN]) == tg, bar);
            __builtin_amdgcn_fence(__ATOMIC_ACQUIRE, "agent");
            xb_add(&bar[XB_XGEN(b.x)], 1u);
            asm volatile("s_waitcnt vmcnt(0)" ::: "memory");
        } else {
            XB_SPIN(xb_ld(&bar[XB_XGEN(b.x)]) == gen, bar);
            __builtin_amdgcn_fence(__ATOMIC_ACQUIRE, "agent");
            asm volatile("s_waitcnt vmcnt(0)" ::: "memory");
        }
    }
    __syncthreads();
}

constexpr int RING_OFF = 0, RING_BYTES = 139264;
constexpr int MISC_OFF = RING_BYTES;
constexpr int LDS_BYTES = 147456;
struct Args { const float* in[N_IN]; float* out; unsigned char* ws; int ph_lo, ph_hi; };
struct Frame {
    LAS unsigned char* lds; int tid, lane, wave, G, bid;
    const float* const* in; float* out; unsigned char* ws;
};

__device__ __forceinline__ void p0_transpose_item(const float* W, int K, int N, bf16* WT, LAS float* scr, int item, int lane, const float* ksc = nullptr) {
    const int nblk = N / 32, kb = item / nblk, nb = item % nblk, k0 = 64 * kb, n0 = 32 * nb;
#pragma unroll 8
    for (int i = 0; i < 32; ++i) { const int kk = 2 * i + (lane >> 5); const float w_ = W[(size_t)(k0 + kk) * N + n0 + (lane & 31)]; scr[kk * 33 + (lane & 31)] = ksc ? w_ * ksc[k0 + kk] : w_; }
    LDS_WAIT(); asm volatile("" ::: "memory");
    const int c = lane & 7;
#pragma unroll
    for (int j = 0; j < 4; ++j) { const int n = (lane >> 3) + 8 * j; const LAS float* s = scr + (8 * c) * 33 + n;
        v4u o; o.x = pk2(s[0 * 33], s[1 * 33]); o.y = pk2(s[2 * 33], s[3 * 33]); o.z = pk2(s[4 * 33], s[5 * 33]); o.w = pk2(s[6 * 33], s[7 * 33]);
        *(GAS v4u*)(WT + (size_t)(n0 + n) * K + k0 + 8 * c) = o; }
    LDS_WAIT(); asm volatile("" ::: "memory");
}
__device__ __forceinline__ void transpose_weight(Frame& F, const float* W, int K, int N, bf16* WT) {
    LAS float* scr = (LAS float*)(F.lds + RING_OFF + F.wave * 16384);
    const int gw = F.bid * NWAVES + F.wave, NGW = F.G * NWAVES, nitems = (K / 64) * (N / 32);
    for (int it = gw; it < nitems; it += NGW) p0_transpose_item(W, K, N, WT, scr, it, F.lane);
}
__device__ __forceinline__ void norm_rows(Frame& F, const float* src_p, const float* src_s, const float* w, bf16* XN) {
    const int gw = F.bid * NWAVES + F.wave, NGW = F.G * NWAVES;
    for (int m = gw; m < MT; m += NGW) {
        const float* xrow = (m < MP) ? src_p + (size_t)m * DM : src_s + (size_t)(m - MP) * DM;
        const GAS f32x4* xr = (const GAS f32x4*)xrow + F.lane; const GAS f32x4* wr = (const GAS f32x4*)w + F.lane;
        f32x4 v[8]; float s = 0.f;
#pragma unroll
        for (int j = 0; j < 8; ++j) { v[j] = xr[64 * j]; s += (v[j].x * v[j].x + v[j].y * v[j].y) + (v[j].z * v[j].z + v[j].w * v[j].w); }
        const float rstd = 1.f / sqrtf(wave_sum(s) * (1.f / DM) + EPS);
        GAS v2u* o8 = (GAS v2u*)(XN + (size_t)m * DM) + F.lane;
#pragma unroll
        for (int j = 0; j < 8; ++j) { const f32x4 g = wr[64 * j]; v2u o; o.x = pk2(v[j].x * rstd * g.x, v[j].y * rstd * g.y); o.y = pk2(v[j].z * rstd * g.z, v[j].w * rstd * g.w); o8[64 * j] = o; }
    }
}
__device__ __forceinline__ void cache_cvt(Frame& F, const float* ck, const float* cv, bf16* KC, bf16* VC) {
    const size_t nvec = (size_t)NB * PAST * DM / 4;
    const size_t gt = (size_t)F.bid * NTHR + F.tid, NG = (size_t)F.G * NTHR;
    for (size_t i = gt; i < 2 * nvec; i += NG) {
        const bool isv = i >= nvec; const size_t e = (isv ? i - nvec : i) * 4;
        const size_t brow = e / DM, col = e % DM, b = brow / PAST, t = brow % PAST;
        const f32x4 x = *(const GAS f32x4*)((isv ? cv : ck) + e);
        v2u o; o.x = pk2(x.x, x.y); o.y = pk2(x.z, x.w);
        *(GAS v2u*)((isv ? VC : KC) + ((b * KCROWS + t) * DM + col)) = o;
    }
}
__device__ __forceinline__ int tw_chunks(int K, int N) { return (K / 64) * (N / 32) / 64; }
__device__ __forceinline__ void tw_run(Frame& F, const float* W, int K, int N, bf16* WT, int c, const float* ksc = nullptr) {
    LAS float* scr = (LAS float*)(F.lds + RING_OFF + F.wave * 16384);
#pragma unroll 1
    for (int i = 0; i < 8; ++i) p0_transpose_item(W, K, N, WT, scr, c * 64 + F.wave * 8 + i, F.lane, ksc);
}
constexpr int CC_CHUNKS = 2 * (NB * PAST * DM / 4) / 8192;
__device__ __forceinline__ void cc_run(Frame& F, const float* ck, const float* cv, bf16* KC, bf16* VC, int c) {
    const size_t nvec = (size_t)NB * PAST * DM / 4;
#pragma unroll 4
    for (int k = 0; k < 16; ++k) { const size_t i = (size_t)c * 8192 + k * NTHR + F.tid;
        const bool isv = i >= nvec; const size_t e = (isv ? i - nvec : i) * 4; const size_t brow = e / DM, col = e % DM, b = brow / PAST, t = brow % PAST;
        const f32x4 x = *(const GAS f32x4*)((isv ? cv : ck) + e); v2u o; o.x = pk2(x.x, x.y); o.y = pk2(x.z, x.w);
        *(GAS v2u*)((isv ? VC : KC) + ((b * KCROWS + t) * DM + col)) = o; }
}
constexpr int TR_CHUNKS = MP * 128 / 8192;
__device__ __forceinline__ void tr_run(Frame& F, float* tab, int c) {
#pragma unroll 1
    for (int k = 0; k < 16; ++k) { const size_t e = (size_t)c * 8192 + k * NTHR + F.tid; float cs, sn; rope_cs((int)(e >> 7), (int)(e & 127), 128, cs, sn); tab[2 * e] = cs; tab[2 * e + 1] = sn; }
}
__device__ __forceinline__ int row_pos(int row) { return row < MP ? row : PAST + ((row - MP) & 63); }

struct EpiAIn {
    static constexpr int BMODE = 2;
    pg8::bf16_t *Qs, *KP, *VP, *KC, *VC, *GA; float *okp, *ovp, *oks, *ovs; const float* tab; const float* qg; const float* kg; const float* ssq;
    __device__ __forceinline__ void operator()(const pg8::f32x4 (&acc)[2][2][4][2], const pg8::Unit& u, int wr, int wc, int fr, int fq) const {
        { const int l_ = lane_now(); fr = l_ & 15; fq = l_ >> 4; }
        const int pn = u.pn, pm = u.pm, typ = pn >> 3, cl = ((pn & 7) * 4 + wc) * 64 + 8 * fq; float rs[2][4]; row_rstd(ssq, pm, wr, fr, fq, rs);
        float g1[8], g2[8];
        if (typ < 2) { const float* gp = (typ == 0 ? qg : kg) + 8 * fq; const pg8::f32x4 a = *(const pg8::f32x4*)gp, b = *(const pg8::f32x4*)(gp + 4), c = *(const pg8::f32x4*)(gp + 32), d = *(const pg8::f32x4*)(gp + 36);
#pragma unroll
            for (int e = 0; e < 4; ++e) { g1[e] = a[e]; g1[4 + e] = b[e]; g2[e] = c[e]; g2[4 + e] = d[e]; } }
#pragma unroll
        for (int ai = 0; ai < 2; ++ai)
#pragma unroll
          for (int mp = 0; mp < 2; ++mp) {
            pg8::f32x4 tq[4][4];
            if (typ < 2) {
#pragma unroll
                for (int m = 2 * mp; m < 2 * mp + 2; ++m) { const int i_ = ai * 128 + wr * 64 + m * 16 + fr; const int pos_ = pm < 64 ? pm * 256 + i_ : PAST + (i_ & 63); const float* tp_ = tab + ((size_t)pos_ * 32 + 8 * fq) * 2;
#pragma unroll
                    for (int q4 = 0; q4 < 4; ++q4) tq[m][q4] = *(const pg8::f32x4*)(tp_ + 4 * q4); } }
#pragma unroll
            for (int m = 2 * mp; m < 2 * mp + 2; ++m) {
                const int i = ai * 128 + wr * 64 + m * 16 + fr; const size_t row = (size_t)pm * 256 + i;
                float x1[8], x2[8];
#pragma unroll
                for (int e = 0; e < 4; ++e) { x1[e] = acc[ai][0][m][0][e] * rs[ai][m]; x1[4 + e] = acc[ai][0][m][1][e] * rs[ai][m]; x2[e] = acc[ai][1][m][0][e] * rs[ai][m]; x2[4 + e] = acc[ai][1][m][1][e] * rs[ai][m]; }
                size_t drow; pg8::bf16_t* dk; pg8::bf16_t* dv; float* fk; float* fv;
                if (pm < 64) { drow = row; dk = KP; dv = VP; fk = okp + row * DM; fv = ovp + row * DM; }
                else { const int s_ = (int)(row - MP); drow = (size_t)(s_ >> 6) * KCROWS + PAST + (s_ & 63); dk = KC; dv = VC; fk = oks + (size_t)s_ * DM; fv = ovs + (size_t)s_ * DM; }
                if (typ < 2) {
                    float ss = 0.f;
#pragma unroll
                    for (int k = 0; k < 8; ++k) ss += x1[k] * x1[k] + x2[k] * x2[k];
                    ss += __shfl_xor(ss, 16); ss += __shfl_xor(ss, 32);
                    const float rstd = 1.f / sqrtf(ss * (1.f / 64.f) + EPS);
                    float o1[8], o2[8];
#pragma unroll
                    for (int q4 = 0; q4 < 4; ++q4) { const pg8::f32x4 t = tq[m][q4];
#pragma unroll
                        for (int z = 0; z < 2; ++z) { const int k = 2 * q4 + z; const float c = t[2 * z], s = t[2 * z + 1], y1 = x1[k] * rstd * g1[k], y2 = x2[k] * rstd * g2[k]; o1[k] = y1 * c - y2 * s; o2[k] = y2 * c + y1 * s; } }
                    if (typ == 0) { v4u w1, w2;
                        w1.x = pk2(o1[0] * C2, o1[1] * C2); w1.y = pk2(o1[2] * C2, o1[3] * C2); w1.z = pk2(o1[4] * C2, o1[5] * C2); w1.w = pk2(o1[6] * C2, o1[7] * C2);
                        w2.x = pk2(o2[0] * C2, o2[1] * C2); w2.y = pk2(o2[2] * C2, o2[3] * C2); w2.z = pk2(o2[4] * C2, o2[5] * C2); w2.w = pk2(o2[6] * C2, o2[7] * C2);
                        *(v4u*)(Qs + row * DM + cl) = w1; *(v4u*)(Qs + row * DM + cl + 32) = w2;
                    } else { v4u w1, w2;
                        w1.x = pk2(o1[0], o1[1]); w1.y = pk2(o1[2], o1[3]); w1.z = pk2(o1[4], o1[5]); w1.w = pk2(o1[6], o1[7]);
                        w2.x = pk2(o2[0], o2[1]); w2.y = pk2(o2[2], o2[3]); w2.z = pk2(o2[4], o2[5]); w2.w = pk2(o2[6], o2[7]);
                        *(v4u*)(dk + drow * DM + cl) = w1; *(v4u*)(dk + drow * DM + cl + 32) = w2;
                        *(pg8::f32x4*)(fk + cl) = (pg8::f32x4){o1[0], o1[1], o1[2], o1[3]}; *(pg8::f32x4*)(fk + cl + 4) = (pg8::f32x4){o1[4], o1[5], o1[6], o1[7]};
                        *(pg8::f32x4*)(fk + cl + 32) = (pg8::f32x4){o2[0], o2[1], o2[2], o2[3]}; *(pg8::f32x4*)(fk + cl + 36) = (pg8::f32x4){o2[4], o2[5], o2[6], o2[7]}; }
                } else { v4u w1, w2;
                    w1.x = pk2(x1[0], x1[1]); w1.y = pk2(x1[2], x1[3]); w1.z = pk2(x1[4], x1[5]); w1.w = pk2(x1[6], x1[7]);
                    w2.x = pk2(x2[0], x2[1]); w2.y = pk2(x2[2], x2[3]); w2.z = pk2(x2[4], x2[5]); w2.w = pk2(x2[6], x2[7]);
                    if (typ == 2) { *(v4u*)(dv + drow * DM + cl) = w1; *(v4u*)(dv + drow * DM + cl + 32) = w2;
                        *(pg8::f32x4*)(fv + cl) = (pg8::f32x4){x1[0], x1[1], x1[2], x1[3]}; *(pg8::f32x4*)(fv + cl + 4) = (pg8::f32x4){x1[4], x1[5], x1[6], x1[7]};
                        *(pg8::f32x4*)(fv + cl + 32) = (pg8::f32x4){x2[0], x2[1], x2[2], x2[3]}; *(pg8::f32x4*)(fv + cl + 36) = (pg8::f32x4){x2[4], x2[5], x2[6], x2[7]}; }
                    else { *(v4u*)(GA + row * DM + cl) = w1; *(v4u*)(GA + row * DM + cl + 32) = w2; }
                }
                if (m & 1) asm volatile("" ::: "memory");
            }
        }
    }
};
__device__ __forceinline__ void attn_table(Frame& F, float* tab) {
    const size_t gt = (size_t)F.bid * NTHR + F.tid, NG = (size_t)F.G * NTHR;
    for (size_t e = gt; e < (size_t)MP * 32; e += NG) { float c, s; rope_cs((int)(e >> 5), (int)(e & 31), 32, c, s); tab[2 * e] = c; tab[2 * e + 1] = s; }
}
namespace dattn {
typedef short bf16x8 __attribute__((ext_vector_type(8)));
typedef short s16x4 __attribute__((ext_vector_type(4)));
typedef short v4i16_t __attribute__((ext_vector_type(4)));
typedef float f32x16 __attribute__((ext_vector_type(16)));
typedef unsigned u32x4 __attribute__((ext_vector_type(4)));
typedef __attribute__((address_space(3))) const char* lds_cptr;
constexpr int RINGB = 98304, WSF_OFF = RINGB, XCHB = 18432, STP = 144;
__device__ __forceinline__ int crow(int r, int hi) { return (r & 3) + 8 * (r >> 2) + 4 * hi; }
__device__ __forceinline__ void glds16(const void* gsrc, unsigned lds_dst) { unsigned keep;
    asm volatile("s_mov_b32 %0, m0\n\ts_mov_b32 m0, %2\n\ts_nop 0\n\tglobal_load_lds_dwordx4 %1, off\n\ts_mov_b32 m0, %0" : "=&s"(keep) : "v"(gsrc), "s"(lds_dst) : "memory"); }
typedef float f32x2_t __attribute__((ext_vector_type(2))); typedef __bf16 bf16x2_t __attribute__((ext_vector_type(2)));
__device__ __forceinline__ unsigned cvtpk_s(float lo, float hi) { f32x2_t v = {lo, hi}; bf16x2_t b = __builtin_convertvector(v, bf16x2_t); return __builtin_bit_cast(unsigned, b); }
#define DA_WAIT_BAR(N) asm volatile("s_waitcnt vmcnt(" #N ") lgkmcnt(0)\n\ts_barrier" ::: "memory")
__device__ __forceinline__ s16x4 vtr(lds_cptr p) { return __builtin_bit_cast(s16x4, __builtin_amdgcn_ds_read_tr16_b64_v4i16((__attribute__((address_space(3))) v4i16_t*)p)); }
struct Unit { const bf16* Q; const bf16* K; const bf16* V; const bf16* G; bf16* AO; int NT; int full; int dma0; };

constexpr int KSLOT = 16384, VSLOT = 16384, VRING = 3 * KSLOT;
#define DA_SBAR() __builtin_amdgcn_sched_barrier(0)
#define DA_PIN(x) asm volatile("" : "+v"(x))
#define DA_MFMA(a, b, c) __builtin_amdgcn_mfma_f32_32x32x16_bf16(a, b, c, 0, 0, 0)
template <bool QK, bool PV, int VAR>
__device__ __forceinline__ void step(lds_cptr kpn, lds_cptr vp, const bf16x8 (&qr)[4], bf16x8 (&kf)[8], f32x16 (&o)[4], u32x4 (&pw)[4], float& l_reg) {
    f32x16 C0 = f32x16{}, C1 = f32x16{};
    s16x4 vlo[4], vhi[4];
#define DA_FOFF(f) ((((f) & 3) * 4096) + (((f) >> 2) * 1024))
#pragma unroll
    for (int a = 0; a < 8; ++a) {
        if constexpr (PV) { if (a >= 4) { if (VAR != 4) { vlo[a - 4] = vtr(vp + DA_FOFF(a - 4)); vhi[a - 4] = vtr(vp + DA_FOFF(a - 4) + 512); } else { vlo[a - 4] = s16x4{1, 2, 3, 4}; vhi[a - 4] = s16x4{5, 6, 7, 8}; } DA_SBAR(); } }
        if constexpr (QK) {
            if (a & 1) C1 = (a < 2) ? DA_MFMA(kf[a], qr[a >> 1], f32x16{}) : DA_MFMA(kf[a], qr[a >> 1], C1);
            else       C0 = (a < 2) ? DA_MFMA(kf[a], qr[a >> 1], f32x16{}) : DA_MFMA(kf[a], qr[a >> 1], C0);
            DA_SBAR();
        }
    }
    u32x4 pwn[4]; pwn[0] = u32x4{}; pwn[1] = u32x4{}; pwn[2] = u32x4{}; pwn[3] = u32x4{};
    float s0 = 0.f, s1 = 0.f;
#pragma unroll
    for (int p = 0; p < 16; ++p) {
        if constexpr (PV) {
            const bf16x8 vf = (bf16x8){vlo[p & 3][0], vlo[p & 3][1], vlo[p & 3][2], vlo[p & 3][3], vhi[p & 3][0], vhi[p & 3][1], vhi[p & 3][2], vhi[p & 3][3]};
            if (VAR != 3) o[p & 3] = DA_MFMA(__builtin_bit_cast(bf16x8, pw[p >> 2]), vf, o[p & 3]); else { o[p & 3][0] += __builtin_bit_cast(float, (int)vf[0] | ((int)vf[4] << 16)); }
            if (p < 12 && VAR != 4) { vlo[p & 3] = vtr(vp + DA_FOFF(p + 4)); vhi[p & 3] = vtr(vp + DA_FOFF(p + 4) + 512); }
        }
        if constexpr (QK) {
            float e0, e1;
            if (VAR == 2) { if (p < 8) { e0 = C0[2 * p]; e1 = C0[2 * p + 1]; } else { e0 = C1[2 * p - 16]; e1 = C1[2 * p - 15]; } }
            else if (p < 8) { e0 = __builtin_amdgcn_exp2f(C0[2 * p]); e1 = __builtin_amdgcn_exp2f(C0[2 * p + 1]); }
            else       { e0 = __builtin_amdgcn_exp2f(C1[2 * p - 16]); e1 = __builtin_amdgcn_exp2f(C1[2 * p - 15]); }
            s0 += e0; s1 += e1; pwn[p >> 2][p & 3] = cvtpk_s(e0, e1);
            DA_PIN(s0); DA_PIN(s1); DA_PIN(pwn[p >> 2]);
            if (p >= 8 && VAR != 6) { const int j = p - 8; kf[j] = *(const __attribute__((address_space(3))) bf16x8*)(kpn + (j >> 1) * 2048 + (j & 1) * 512); }
        }
        DA_SBAR();
    }
    if constexpr (QK) { l_reg += s0 + s1; pw[0] = pwn[0]; pw[1] = pwn[1]; pw[2] = pwn[2]; pw[3] = pwn[3]; }
#undef DA_FOFF
}

template <int VAR>
__device__ __forceinline__ void attn_unit(const Unit& u, char* shm, float lam, float one_m_li, const float* sub_gain, int tid) {
    asm volatile("" : "+v"(tid));
    const int lane = tid & 63, r32 = lane & 31, hi = lane >> 5; const int wid = __builtin_amdgcn_readfirstlane(tid >> 6), s = wid >> 2, g = wid & 3;
    const int NT = u.NT; const int wt = u.full ? (g < 2 ? NT - 1 : NT) : (g < 2 ? NT : 0);
    const unsigned lds0 = (unsigned)(uintptr_t)shm;
    float* wsf = (float*)(shm + WSF_OFF) + wid * 64;
    const bf16* ksrc = u.K + (long)lane * DM + wid * 8;
    const bf16* vsrc = u.V + (long)(16 * (wid & 3) + (lane >> 2)) * DM + (wid >> 2) * 32 + (lane & 3) * 8;
    const unsigned kdst = lds0 + wid * 1024, vdst = lds0 + VRING + wid * 1024;
#define DA_DMA_K(t, slot) do { const int tt_ = u.dma0 ? 0 : (t) < NT ? (t) : NT - 1; const bf16* kp_ = ksrc + (long)tt_ * 64 * DM; \
        glds16(kp_, (unsigned)__builtin_amdgcn_readfirstlane(kdst + (slot) * KSLOT)); glds16(kp_ + 64, (unsigned)__builtin_amdgcn_readfirstlane(kdst + 8192 + (slot) * KSLOT)); } while (0)
#define DA_DMA_V(t, slot) do { const int tt_ = u.dma0 ? 0 : (t) < NT ? (t) : NT - 1; const bf16* vp_ = vsrc + (long)tt_ * 64 * DM; \
        glds16(vp_, (unsigned)__builtin_amdgcn_readfirstlane(vdst + (slot) * VSLOT)); glds16(vp_ + 64, (unsigned)__builtin_amdgcn_readfirstlane(vdst + 8192 + (slot) * VSLOT)); } while (0)
    const lds_cptr shm3 = (lds_cptr)shm;
    const lds_cptr kp0 = shm3 + s * 8192 + hi * 1024 + r32 * 16;
    const lds_cptr vp0 = shm3 + VRING + ((lane >> 4) & 1) * 32 + (lane & 3) * 8 + (4 * hi + ((lane & 15) >> 2)) * 64;
    DA_DMA_K(0, 0); DA_DMA_K(1, 1); DA_DMA_K(2, 2); DA_DMA_V(0, 0);
    bf16x8 qr[4];
    { const bf16* Qw = u.Q + (long)(32 * g + r32) * DM + s * 64;
#pragma unroll
      for (int d0 = 0; d0 < 4; ++d0) qr[d0] = (wt > 0) ? *reinterpret_cast<const bf16x8*>(Qw + d0 * 16 + hi * 8) : (bf16x8){0, 0, 0, 0, 0, 0, 0, 0}; }
    asm volatile("" : "+v"(qr[0]), "+v"(qr[1]), "+v"(qr[2]), "+v"(qr[3]));
    f32x16 o[4]; o[0] = f32x16{}; o[1] = f32x16{}; o[2] = f32x16{}; o[3] = f32x16{};
    float l_reg = 0.f;
    u32x4 pw[4]; pw[0] = u32x4{}; pw[1] = u32x4{}; pw[2] = u32x4{}; pw[3] = u32x4{};
    DA_WAIT_BAR(0);
    bf16x8 kf[8];
#pragma unroll
    for (int j = 0; j < 8; ++j) kf[j] = *(const __attribute__((address_space(3))) bf16x8*)(kp0 + (j >> 1) * 2048 + (j & 1) * 512);
    int ks_cur = 0  , vs_prev = 2  ;
#define DA_TOP(t) \
        DA_WAIT_BAR(4);                                          \
        const int ks_next = (ks_cur == 2) ? 0 : ks_cur + 1, vs_cur = (vs_prev == 2) ? 0 : vs_prev + 1, vs_next = (vs_cur == 2) ? 0 : vs_cur + 1; \
        if (VAR != 7) { DA_DMA_K((t) + 3, ks_cur); DA_DMA_V((t) + 1, vs_next); }       \
        const lds_cptr kpn = kp0 + ks_next * KSLOT; const lds_cptr vp = vp0 + vs_prev * VSLOT; (void)kpn; (void)vp
#define DA_ROT() do { ks_cur = ks_next; vs_prev = vs_cur; } while (0)
    int t = 0;
    { DA_TOP(0); if (wt > 0) step<true, false, VAR>(kpn, vp, qr, kf, o, pw, l_reg); DA_ROT(); t = 1; }
    for (; t < wt; ++t) { DA_TOP(t); step<true, true, VAR>(kpn, vp, qr, kf, o, pw, l_reg); DA_ROT(); }
    if (wt > 0) { DA_TOP(t); step<false, true, VAR>(kpn, vp, qr, kf, o, pw, l_reg); DA_ROT(); ++t; }
    for (; t <= NT; ++t) { DA_TOP(t); DA_ROT(); }
#undef DA_TOP
#undef DA_ROT
    { auto rr = __builtin_amdgcn_permlane32_swap(__float_as_uint(l_reg), __float_as_uint(l_reg), false, false); l_reg = __uint_as_float(rr[0]) + __uint_as_float(rr[1]); }
    if (hi == 0) wsf[r32] = l_reg;
    DA_WAIT_BAR(0);
    float rli[16];
#pragma unroll
    for (int r = 0; r < 16; ++r) { const float lq = wsf[crow(r, hi)]; rli[r] = (s == 0 ? 1.f : -lam) / lq; }
    int le = lane; asm volatile("" : "+v"(le));
    const int r32e = le & 31, hie = le >> 5;
    float* xch = (float*)(shm + g * XCHB);
    if (s == 1 && wt > 0) {
#pragma unroll
        for (int db = 0; db < 4; ++db)
#pragma unroll
            for (int r = 0; r < 16; ++r) xch[(db * 16 + r) * 64 + le] = o[db][r] * rli[r];
    }
    DA_WAIT_BAR(0);
    if (s == 0 && wt > 0) {
#pragma unroll
        for (int db = 0; db < 4; ++db)
#pragma unroll
            for (int r = 0; r < 16; ++r) o[db][r] = o[db][r] * rli[r] + xch[(db * 16 + r) * 64 + le];
        asm volatile("s_waitcnt lgkmcnt(0)" ::: "memory");
#pragma unroll
        for (int db = 0; db < 4; ++db)
#pragma unroll
            for (int r = 0; r < 16; ++r) xch[crow(r, hie) * STP + 32 * db + r32e] = o[db][r];
        asm volatile("s_waitcnt lgkmcnt(0)" ::: "memory");
        const int row = le >> 1, half = le & 1;
        float v[64]; float ss = 0.f;
#pragma unroll
        for (int k = 0; k < 16; ++k) { const f32x4 x = *(const f32x4*)(xch + row * STP + half * 64 + 4 * k); v[4 * k] = x.x; v[4 * k + 1] = x.y; v[4 * k + 2] = x.z; v[4 * k + 3] = x.w; ss += (x.x * x.x + x.y * x.y) + (x.z * x.z + x.w * x.w); }
        ss += __shfl_xor(ss, 1);
        const float sc = one_m_li / sqrtf(ss * (1.f / 128.f) + EPS);
        const bf16* gp = u.G + (long)(32 * g + row) * DM + half * 64; bf16* op = u.AO + (long)(32 * g + row) * DM + half * 64; const float* sg = sub_gain + half * 64;
#pragma unroll
        for (int k = 0; k < 8; ++k) { const v4u g4 = *(const v4u*)(gp + 8 * k); const f32x4 ga = *(const f32x4*)(sg + 8 * k), gb = *(const f32x4*)(sg + 8 * k + 4);
            const float gg[8] = {bflo(g4.x), bfhi(g4.x), bflo(g4.y), bfhi(g4.y), bflo(g4.z), bfhi(g4.z), bflo(g4.w), bfhi(g4.w)};
            const float gn[8] = {ga.x, ga.y, ga.z, ga.w, gb.x, gb.y, gb.z, gb.w}; float y[8];
#pragma unroll
            for (int e = 0; e < 8; ++e) y[e] = v[8 * k + e] * sc * gn[e] * silu_f(gg[e]);
            v4u w; w.x = pk2(y[0], y[1]); w.y = pk2(y[2], y[3]); w.z = pk2(y[4], y[5]); w.w = pk2(y[6], y[7]);
            *(v4u*)(op + 8 * k) = w; }
    }
    DA_WAIT_BAR(0);
#undef DA_DMA_K
#undef DA_DMA_V
}
}
template <int VAR = 0>
__device__ __forceinline__ void attn_fast(Frame& F, const bf16* Qs, const bf16* KP, const bf16* VP, const bf16* KC, const bf16* VC, const bf16* GA  , bf16* AO,
                                          float lam, float one_m_li, const float* sub_gain, int dma0 = 0) {
    const int NU = 2048 + 16 * NB;
    const bool xcd = (F.G == 256);
    for (int i = 0;; ++i) {
        int qb, h, b = -1;
        if (xcd) { const int x = F.bid & 7, r = F.bid >> 3;
            if (i < 8) { h = x + 8 * (i >> 2); const int rr = (i == 0) ? (r ^ 8) : r; qb = 127 - ((i & 3) * 32 + ((i & 1) ? 31 - rr : rr)); }
            else if (i == 8 && (r & 8) == 0) { const int sb = (r & 7) + ((r >> 4) << 3); h = x + 8 * (sb >> 3); b = sb & 7; qb = 0; }
            else break;
        } else { const int idx = i * F.G + ((i & 1) ? F.G - 1 - F.bid : F.bid); if (idx >= NU) break;
            if (idx < 2048) { qb = 127 - (idx >> 4); h = idx & 15; } else { const int j = idx - 2048; b = j >> 4; h = j & 15; qb = 0; } }
        dattn::Unit u; u.dma0 = dma0;
        if (b < 0) { const long row0 = 128L * qb;
            u.Q = Qs + row0 * DM + h * 128; u.K = KP + h * 128; u.V = VP + h * 128; u.G = GA + row0 * DM + h * 128; u.AO = AO + row0 * DM + h * 128; u.NT = 2 * qb + 2; u.full = 1; }
        else { const long row0 = MP + 64L * b;
            u.Q = Qs + row0 * DM + h * 128; u.K = KC + (long)b * KCROWS * DM + h * 128; u.V = VC + (long)b * KCROWS * DM + h * 128; u.G = GA + row0 * DM + h * 128; u.AO = AO + row0 * DM + h * 128; u.NT = KCROWS / 64; u.full = 0; }
        dattn::attn_unit<VAR>(u, (char*)F.lds + RING_OFF, lam, one_m_li, sub_gain, F.tid);
    }
}
constexpr int RBLK = 72;
__device__ __forceinline__ float ret_lg2(int h) { return log2f(1.f - exp2f(-5.f - (float)h)); }
struct EpiRet {
    static constexpr int BMODE = 0;
    pg8::bf16_t* QP; pg8::bf16_t* KN; pg8::bf16_t* KT; pg8::bf16_t* VS; pg8::bf16_t* RG; const float* tab; const float* ssq;
    __device__ __forceinline__ void operator()(const pg8::f32x4 (&acc)[2][2][4][2], const pg8::Unit& u, int wr, int wc, int fr, int fq) const {
        { const int l_ = lane_now(); fr = l_ & 15; fq = l_ >> 4; }
        const int pn = u.pn, pm = u.pm; float rs[2][4]; row_rstd(ssq, pm, wr, fr, fq, rs);
#pragma unroll
        for (int ai = 0; ai < 2; ++ai)
#pragma unroll
            for (int m = 0; m < 4; ++m) {
                const int i = ai * 128 + wr * 64 + m * 16 + fr; const size_t row = (size_t)pm * 256 + i;
                const int J = pm < 64 ? pm : 64 + 4 * (pm - 64) + (i >> 6), jj = pm < 64 ? i : (i & 63), pos = pm < 64 ? (int)row : PAST + (i & 63);
                if (pn < 16) {
                    const int h = pn & 7; const bool isk = pn >= 8; const float sc = isk ? 0.0625f : 1.f;
#pragma unroll
                    for (int n = 0; n < 2; ++n) { const int c1 = wc * 32 + n * 16 + 4 * fq;
                        const pg8::f32x4 t0 = *(const pg8::f32x4*)(tab + ((size_t)pos * 128 + c1) * 2), t1 = *(const pg8::f32x4*)(tab + ((size_t)pos * 128 + c1) * 2 + 4);
                        const pg8::f32x4 x1 = acc[ai][0][m][n] * rs[ai][m], x2 = acc[ai][1][m][n] * rs[ai][m];
                        const float cs[4] = {t0[0], t0[2], t1[0], t1[2]}, sn[4] = {t0[1], t0[3], t1[1], t1[3]}; float o1[4], o2[4];
#pragma unroll
                        for (int e = 0; e < 4; ++e) { o1[e] = (x1[e] * cs[e] - x2[e] * sn[e]) * sc; o2[e] = (x2[e] * cs[e] + x1[e] * sn[e]) * sc; }
                        v2u w1, w2; w1.x = pk2(o1[0], o1[1]); w1.y = pk2(o1[2], o1[3]); w2.x = pk2(o2[0], o2[1]); w2.y = pk2(o2[2], o2[3]);
                        if (!isk) { pg8::bf16_t* p = QP + row * 4096 + h * 512 + 256 + c1; *(v2u*)p = w1; *(v2u*)(p + 128) = w2; }
                        else { pg8::bf16_t* p = KN + row * 2048 + h * 256 + c1; *(v2u*)p = w1; *(v2u*)(p + 128) = w2;
                            pg8::bf16_t* t = KT + ((size_t)(J * 8 + h) * 256 + c1) * 256 + jj;
#pragma unroll
                            for (int e = 0; e < 4; ++e) { t[(size_t)e * 256] = (pg8::bf16_t)f2bf(o1[e]); t[(size_t)(128 + e) * 256] = (pg8::bf16_t)f2bf(o2[e]); } } }
                } else if (pn < 32) {
                    const int h = (pn - 16) >> 1, half = (pn - 16) & 1; const float f = exp2f(-(float)(1 + jj) * ret_lg2(h)) * rs[ai][m];
#pragma unroll
                    for (int bj = 0; bj < 2; ++bj)
#pragma unroll
                        for (int n = 0; n < 2; ++n) { const int dv = half * 256 + bj * 128 + wc * 32 + n * 16 + 4 * fq; pg8::bf16_t* t = VS + ((size_t)(J * 8 + h) * 512 + dv) * 512 + jj;
#pragma unroll
                            for (int e = 0; e < 4; ++e) t[(size_t)e * 512] = (pg8::bf16_t)f2bf(acc[ai][bj][m][n][e] * f); }
                } else {
#pragma unroll
                    for (int bj = 0; bj < 2; ++bj)
#pragma unroll
                        for (int n = 0; n < 2; ++n) { const int c = (pn - 32) * 256 + bj * 128 + wc * 32 + n * 16 + 4 * fq; const pg8::f32x4 x = acc[ai][bj][m][n] * rs[ai][m];
                            v2u w; w.x = pk2(x[0], x[1]); w.y = pk2(x[2], x[3]); *(v2u*)(RG + row * 4096 + c) = w; }
                }
            }
    }
};
__device__ __forceinline__ size_t ret_row0(int J) { return J < 64 ? (size_t)256 * J : (size_t)MP + 64 * (J - 64); }
struct RetQKOrder {
    int G, c; const char* QP; const char* KN;
    __device__ __forceinline__ bool next(int i, pg8::Unit& u) const { const int L = i * G + c; if (L >= RBLK * 8) return false; const int J = L >> 3, h = L & 7; const size_t r0 = ret_row0(J);
        u.pm = J; u.pn = h; u.a = QP + (r0 * 4096 + h * 512 + 256) * 2; u.b = KN + (r0 * 2048 + h * 256) * 2; return true; }
    __device__ __forceinline__ void a_ready(const pg8::Unit&) const {}
    __device__ __forceinline__ void done(const pg8::Unit&) const {}
};
struct EpiRetQK {
    static constexpr int BMODE = 1;
    pg8::bf16_t* QP;
    __device__ __forceinline__ void operator()(const pg8::f32x4 (&acc)[2][2][4][2], const pg8::Unit& u, int wr, int wc, int fr, int fq) const {
        { const int l_ = lane_now(); fr = l_ & 15; fq = l_ >> 4; }
        const int J = u.pm, h = u.pn, nv = J < 64 ? 256 : 64; const size_t r0 = ret_row0(J);
#pragma unroll
        for (int ai = 0; ai < 2; ++ai)
#pragma unroll
            for (int m = 0; m < 4; ++m) { const int i = ai * 128 + wr * 64 + m * 16 + fr;
                if (i < nv) {
#pragma unroll
                    for (int bj = 0; bj < 2; ++bj) { const int j0 = bj * 128 + wc * 32 + 8 * fq; const pg8::f32x4 v0 = acc[ai][bj][m][0], v1 = acc[ai][bj][m][1]; float x[8] = {v0[0], v0[1], v0[2], v0[3], v1[0], v1[1], v1[2], v1[3]};
#pragma unroll
                        for (int k = 0; k < 8; ++k) x[k] = (j0 + k <= i) ? x[k] : 0.f;
                        v4u w; w.x = pk2(x[0], x[1]); w.y = pk2(x[2], x[3]); w.z = pk2(x[4], x[5]); w.w = pk2(x[6], x[7]);
                        *(v4u*)(QP + (r0 + i) * 4096 + h * 512 + j0) = w; } } }
    }
};
struct RetOOrder {
    int G, c; const char* QP; const char* VS;
    __device__ __forceinline__ bool next(int i, pg8::Unit& u) const { const int L = i * G + c; if (L >= RBLK * 16) return false; const int J = L >> 4, r = L & 15, h = r >> 1, half = r & 1; const size_t r0 = ret_row0(J);
        u.pm = J; u.pn = r; u.a = QP + (r0 * 4096 + h * 512) * 2; u.b = VS + (((size_t)(J * 8 + h) * 512 + half * 256) * 512) * 2; return true; }
    __device__ __forceinline__ void a_ready(const pg8::Unit&) const {}
    __device__ __forceinline__ void done(const pg8::Unit&) const {}
};
struct EpiRetO {
    static constexpr int BMODE = 1;
    pg8::bf16_t* O;
    __device__ __forceinline__ void operator()(const pg8::f32x4 (&acc)[2][2][4][2], const pg8::Unit& u, int wr, int wc, int fr, int fq) const {
        { const int l_ = lane_now(); fr = l_ & 15; fq = l_ >> 4; }
        const int J = u.pm, h = u.pn >> 1, half = u.pn & 1, nv = J < 64 ? 256 : 64; const size_t r0 = ret_row0(J); const float lg = ret_lg2(h);
#pragma unroll
        for (int ai = 0; ai < 2; ++ai)
#pragma unroll
            for (int m = 0; m < 4; ++m) { const int i = ai * 128 + wr * 64 + m * 16 + fr;
                if (i < nv) { const float f = exp2f((float)(i + 1) * lg);
#pragma unroll
                    for (int bj = 0; bj < 2; ++bj) { const int j0 = bj * 128 + wc * 32 + 8 * fq; const pg8::f32x4 v0 = acc[ai][bj][m][0] * f, v1 = acc[ai][bj][m][1] * f;
                        v4u w; w.x = pk2(v0[0], v0[1]); w.y = pk2(v0[2], v0[3]); w.z = pk2(v1[0], v1[1]); w.w = pk2(v1[2], v1[3]);
                        *(v4u*)(O + (r0 + i) * 4096 + h * 512 + half * 256 + j0) = w; } } }
    }
};
struct RetKVOrder {
    int G, c; const char* VS; const char* KT;
    __device__ __forceinline__ bool next(int i, pg8::Unit& u) const { const int L = i * G + c; if (L >= RBLK * 16) return false; const int J = L >> 4, r = L & 15, h = r >> 1, half = r & 1;
        u.pm = J; u.pn = r; u.a = VS + (((size_t)(J * 8 + h) * 512 + half * 256) * 512) * 2; u.b = KT + ((size_t)(J * 8 + h) * 256 * 256) * 2; return true; }
    __device__ __forceinline__ void a_ready(const pg8::Unit&) const {}
    __device__ __forceinline__ void done(const pg8::Unit&) const {}
};
struct EpiRetKV {
    static constexpr int BMODE = 1;
    pg8::bf16_t* VS; pg8::bf16_t* KVX;
    __device__ __forceinline__ void operator()(const pg8::f32x4 (&acc)[2][2][4][2], const pg8::Unit& u, int wr, int wc, int fr, int fq) const {
        { const int l_ = lane_now(); fr = l_ & 15; fq = l_ >> 4; }
        const int J = u.pm, h = u.pn >> 1, half = u.pn & 1;
        pg8::bf16_t* base; int pitch;
        if (J < 63) { base = VS + ((size_t)((J + 1) * 8 + h) * 512 + half * 256) * 512 + 256; pitch = 512; }
        else { base = KVX + ((size_t)((J - 63) * 8 + h) * 512 + half * 256) * 256; pitch = 256; }
#pragma unroll
        for (int ai = 0; ai < 2; ++ai)
#pragma unroll
            for (int m = 0; m < 4; ++m) { pg8::bf16_t* rowp = base + (size_t)(ai * 128 + wr * 64 + m * 16 + fr) * pitch + wc * 32 + 8 * fq;
#pragma unroll
                for (int bj = 0; bj < 2; ++bj) { const pg8::f32x4 v0 = acc[ai][bj][m][0], v1 = acc[ai][bj][m][1];
                    v4u w; w.x = pk2(v0[0], v0[1]); w.y = pk2(v0[2], v0[3]); w.z = pk2(v1[0], v1[1]); w.w = pk2(v1[2], v1[3]);
                    *(v4u*)(rowp + bj * 128) = w; } }
    }
};
__device__ __forceinline__ void ret_scan(Frame& F, bf16* VS, const bf16* KVX, const float* state_in, float* osp, float* oss) {
    const int gt = F.bid * NTHR + F.tid;
    for (int c = gt; c < 8 * 512 * 32; c += F.G * NTHR) {
        const int h = c >> 14, dv = (c >> 5) & 511, dk0 = (c & 31) * 8; const float lg = ret_lg2(h), g256 = exp2f(256.f * lg), g64 = exp2f(64.f * lg);
        float S[8];
#pragma unroll
        for (int k = 0; k < 8; ++k) S[k] = 0.f;
        bf16* slot = VS + ((size_t)h * 512 + dv) * 512 + 256 + dk0;
        *(v4u*)slot = (v4u){0u, 0u, 0u, 0u};
        v4u nx = *(const v4u*)(slot + (size_t)8 * 512 * 512);
        for (int J = 1; J < 64; ++J) {
            const v4u kv = nx; bf16* sj = slot + (size_t)J * 8 * 512 * 512;
            if (J < 63) nx = *(const v4u*)(sj + (size_t)8 * 512 * 512);
            const float x[8] = {bflo(kv.x), bfhi(kv.x), bflo(kv.y), bfhi(kv.y), bflo(kv.z), bfhi(kv.z), bflo(kv.w), bfhi(kv.w)};
#pragma unroll
            for (int k = 0; k < 8; ++k) S[k] = (S[k] + x[k]) * g256;
            v4u w; w.x = pk2(S[0], S[1]); w.y = pk2(S[2], S[3]); w.z = pk2(S[4], S[5]); w.w = pk2(S[6], S[7]);
            *(v4u*)sj = w;
        }
        { const v4u kv = *(const v4u*)(KVX + ((size_t)h * 512 + dv) * 256 + dk0);
          const float x[8] = {bflo(kv.x), bfhi(kv.x), bflo(kv.y), bfhi(kv.y), bflo(kv.z), bfhi(kv.z), bflo(kv.w), bfhi(kv.w)};
#pragma unroll
          for (int k = 0; k < 8; ++k) osp[((size_t)h * 256 + dk0 + k) * 512 + dv] = (S[k] + x[k]) * g256; }
    }
    for (int c = gt; c < NB * 8 * 512 * 32; c += F.G * NTHR) {
        const int dv = c & 511, dk0 = ((c >> 9) & 31) * 8, h = (c >> 14) & 7, b = c >> 17; const float g64 = exp2f(64.f * ret_lg2(h));
        const float* si = state_in + (((size_t)b * 8 + h) * 256 + dk0) * 512 + dv; float* so = oss + (((size_t)b * 8 + h) * 256 + dk0) * 512 + dv;
        const v4u kv = *(const v4u*)(KVX + ((size_t)((1 + b) * 8 + h) * 512 + dv) * 256 + dk0);
        const float x[8] = {bflo(kv.x), bfhi(kv.x), bflo(kv.y), bfhi(kv.y), bflo(kv.z), bfhi(kv.z), bflo(kv.w), bfhi(kv.w)}; float s0[8];
#pragma unroll
        for (int k = 0; k < 8; ++k) s0[k] = si[(size_t)k * 512];
        v4u w; w.x = pk2(s0[0], s0[1]); w.y = pk2(s0[2], s0[3]); w.z = pk2(s0[4], s0[5]); w.w = pk2(s0[6], s0[7]);
        *(v4u*)(VS + ((size_t)((64 + b) * 8 + h) * 512 + dv) * 512 + 256 + dk0) = w;
#pragma unroll
        for (int k = 0; k < 8; ++k) so[(size_t)k * 512] = (s0[k] + x[k]) * g64;
    }
}
__device__ __forceinline__ void ret_zero_pad(Frame& F, bf16* VS, bf16* KT) {
    const size_t gt = (size_t)F.bid * NTHR + F.tid, NG = (size_t)F.G * NTHR, n = (size_t)NB * 8 * 512 * 24, n2 = (size_t)NB * 8 * 256 * 24;
    for (size_t i = gt; i < n; i += NG) { const size_t rowi = i / 24, c = i % 24; *(v4u*)(VS + ((size_t)64 * 8 * 512 + rowi) * 512 + 64 + c * 8) = (v4u){0u, 0u, 0u, 0u}; }
    for (size_t i = gt; i < n2; i += NG) { const size_t rowi = i / 24, c = i % 24; *(v4u*)(KT + ((size_t)64 * 8 * 256 + rowi) * 256 + 64 + c * 8) = (v4u){0u, 0u, 0u, 0u}; }
}
__device__ __forceinline__ void ret_table(Frame& F, float* tab) {
    const size_t gt = (size_t)F.bid * NTHR + F.tid, NG = (size_t)F.G * NTHR;
    for (size_t e = gt; e < (size_t)MP * 128; e += NG) { float c, s; rope_cs((int)(e >> 7), (int)(e & 127), 128, c, s); tab[2 * e] = c; tab[2 * e + 1] = s; }
}
__device__ __forceinline__ void r_out(Frame& F, bf16* O, const bf16* RG) {
    const int gw = F.bid * NWAVES + F.wave, NGW = F.G * NWAVES, lane = F.lane;
    for (int it = gw; it < MT * 8; it += NGW) {
        const int row = it >> 3, h = it & 7; const size_t off = (size_t)row * 4096 + h * 512 + lane * 8;
        const v4u o4 = *(const v4u*)(O + off), g4 = *(const v4u*)(RG + off);
        float o[8] = {bflo(o4.x), bfhi(o4.x), bflo(o4.y), bfhi(o4.y), bflo(o4.z), bfhi(o4.z), bflo(o4.w), bfhi(o4.w)};
        const float g[8] = {bflo(g4.x), bfhi(g4.x), bflo(g4.y), bfhi(g4.y), bflo(g4.z), bfhi(g4.z), bflo(g4.w), bfhi(g4.w)};
        float ss = 0.f;
#pragma unroll
        for (int k = 0; k < 8; ++k) ss += o[k] * o[k];
        const float rstd = 1.f / sqrtf(wave_sum(ss) * (1.f / 512.f) + EPS);
#pragma unroll
        for (int k = 0; k < 8; ++k) o[k] = o[k] * rstd * silu_f(g[k]);
        v4u w; w.x = pk2(o[0], o[1]); w.y = pk2(o[2], o[3]); w.z = pk2(o[4], o[5]); w.w = pk2(o[6], o[7]);
        *(v4u*)(O + off) = w;
    }
}
struct EpiCIn {
    static constexpr int BMODE = 0;
    pg8::bf16_t* GU; pg8::bf16_t* GVT; pg8::bf16_t* SG; pg8::bf16_t* GVS; float* SSQ; const float* ssq;
    __device__ __forceinline__ void operator()(const pg8::f32x4 (&acc)[2][2][4][2], const pg8::Unit& u, int wr, int wc, int fr, int fq) const {
        { const int l_ = lane_now(); fr = l_ & 15; fq = l_ >> 4; }
        const int pn = u.pn, pm = u.pm, typ = pn >> 4, pt = pn & 15; float rs[2][4]; row_rstd(ssq, pm, wr, fr, fq, rs);
#pragma unroll
        for (int ai = 0; ai < 2; ++ai)
#pragma unroll
            for (int m = 0; m < 4; ++m) {
                const int i = ai * 128 + wr * 64 + m * 16 + fr; const size_t row = (size_t)pm * 256 + i; float ss = 0.f;
#pragma unroll
                for (int bj = 0; bj < 2; ++bj)
#pragma unroll
                    for (int n = 0; n < 2; ++n) { const int c = pt * 256 + bj * 128 + wc * 32 + n * 16 + 4 * fq; const pg8::f32x4 x = acc[ai][bj][m][n] * rs[ai][m]; float y[4];
                        if (typ == 2) {
#pragma unroll
                            for (int e = 0; e < 4; ++e) y[e] = silu_f(x[e]);
                            v2u w; w.x = pk2(y[0], y[1]); w.y = pk2(y[2], y[3]); *(v2u*)(SG + row * 4096 + c) = w;
                        } else {
#pragma unroll
                            for (int e = 0; e < 4; ++e) y[e] = gelu_tanh_f(x[e]);
                            v2u w; w.x = pk2(y[0], y[1]); w.y = pk2(y[2], y[3]);
                            if (typ == 0) *(v2u*)(GU + row * 4096 + c) = w;
                            else { ss += (y[0] * y[0] + y[1] * y[1]) + (y[2] * y[2] + y[3] * y[3]);
                                pg8::bf16_t* t = GVT + ((size_t)pm * 4096 + c) * 256 + i;
                                t[0] = (pg8::bf16_t)(w.x & 0xffffu); t[256] = (pg8::bf16_t)(w.x >> 16); t[512] = (pg8::bf16_t)(w.y & 0xffffu); t[768] = (pg8::bf16_t)(w.y >> 16);
                                if (pm >= 64) *(v2u*)(GVS + (row - MP) * 4096 + c) = w; } } }
                if (typ == 1) { ss += __shfl_xor(ss, 16); ss += __shfl_xor(ss, 32); if (fq == 0) SSQ[row * 64 + pt * 4 + wc] = ss; }
                if (m & 1) asm volatile("" ::: "memory");
            }
    }
};
__device__ __forceinline__ void c_prep(Frame& F, const float* SSQ, const float* wsin, const float* vgain, const bf16* GVS, bf16* Wm, float* ovm) {
    LAS float* rs = (LAS float*)(F.lds + RING_OFF);
    const int tid = F.tid;
    for (int it = F.bid; it < 66 * 8; it += F.G) {
        const int J = it >> 3, g = it & 7;
        __syncthreads();
        if (tid < 256) { const float* p = SSQ + ((size_t)J * 256 + tid) * 64; float s = 0.f;
#pragma unroll
            for (int k = 0; k < 16; ++k) { const f32x4 x = *(const f32x4*)(p + 4 * k); s += (x.x + x.y) + (x.z + x.w); }
            rs[tid] = 1.f / sqrtf(s * (1.f / 4096.f) + EPS); }
        __syncthreads();
        bf16* wm = Wm + (size_t)(J * 8 + g) * 65536; const int sh = J < 64 ? 7 : 6, cm = (1 << sh) - 1;
        for (int e8 = tid; e8 < 8192; e8 += NTHR) { const int i = e8 >> 5, j0 = (e8 & 31) * 8, il = i & cm, jl0 = j0 & cm; float y[8];
            if ((i >> sh) == (j0 >> sh) && jl0 <= il) { const float* wr_ = wsin + ((size_t)g * 128 + il) * 128 + jl0; const f32x4 a = *(const f32x4*)wr_, b = *(const f32x4*)(wr_ + 4);
                const float wv[8] = {a.x, a.y, a.z, a.w, b.x, b.y, b.z, b.w};
#pragma unroll
                for (int k = 0; k < 8; ++k) y[k] = (jl0 + k <= il) ? wv[k] * rs[j0 + k] : 0.f;
            } else {
#pragma unroll
                for (int k = 0; k < 8; ++k) y[k] = 0.f; }
            v4u w; w.x = pk2(y[0], y[1]); w.y = pk2(y[2], y[3]); w.z = pk2(y[4], y[5]); w.w = pk2(y[6], y[7]);
            *(v4u*)(wm + i * 256 + j0) = w; }
    }
    const int gw = F.bid * NWAVES + F.wave, NGW = F.G * NWAVES, lane = F.lane;
    for (int r = gw; r < MS; r += NGW) {
        const float rstd = 1.f / sqrtf(wave_sum(SSQ[((size_t)MP + r) * 64 + lane]) * (1.f / 4096.f) + EPS);
#pragma unroll
        for (int k = 0; k < 8; ++k) { const int col = k * 512 + lane * 8; const v4u v4 = *(const v4u*)(GVS + (size_t)r * 4096 + col);
            const f32x4 ga = *(const f32x4*)(vgain + col), gb = *(const f32x4*)(vgain + col + 4);
            float* o = ovm + (size_t)r * 4096 + col;
            *(f32x4*)o = (f32x4){bflo(v4.x) * rstd * ga.x, bfhi(v4.x) * rstd * ga.y, bflo(v4.y) * rstd * ga.z, bfhi(v4.y) * rstd * ga.w};
            *(f32x4*)(o + 4) = (f32x4){bflo(v4.z) * rstd * gb.x, bfhi(v4.z) * rstd * gb.y, bflo(v4.w) * rstd * gb.z, bfhi(v4.w) * rstd * gb.w}; }
    }
}
struct CMixOrder {
    int G, c; const char* Wm; const char* GVT;
    __device__ __forceinline__ bool next(int i, pg8::Unit& u) const { const int L = i * G + c; if (L >= 66 * 16) return false; const int J = L >> 4, nt = L & 15;
        u.pm = J; u.pn = nt; u.a = Wm + ((size_t)(J * 8 + (nt >> 1)) * 65536) * 2; u.b = GVT + (((size_t)J * 4096 + nt * 256) * 256) * 2; return true; }
    __device__ __forceinline__ void a_ready(const pg8::Unit&) const {}
    __device__ __forceinline__ void done(const pg8::Unit&) const {}
};
struct EpiCMix {
    static constexpr int BMODE = 1;
    pg8::bf16_t* GU; const pg8::bf16_t* SG; const float* vgain; const float* bs;
    __device__ __forceinline__ void operator()(const pg8::f32x4 (&acc)[2][2][4][2], const pg8::Unit& u, int wr, int wc, int fr, int fq) const {
        { const int l_ = lane_now(); fr = l_ & 15; fq = l_ >> 4; }
        const int J = u.pm, nt = u.pn, g = nt >> 1, cm = J < 64 ? 127 : 63;
#pragma unroll
        for (int bj = 0; bj < 2; ++bj) { const int c0 = nt * 256 + bj * 128 + wc * 32 + 8 * fq; const f32x4 ga = *(const f32x4*)(vgain + c0), gb = *(const f32x4*)(vgain + c0 + 4);
            const float gn[8] = {ga.x, ga.y, ga.z, ga.w, gb.x, gb.y, gb.z, gb.w};
#pragma unroll
            for (int ai = 0; ai < 2; ++ai)
#pragma unroll
                for (int m = 0; m < 4; ++m) { const int i = ai * 128 + wr * 64 + m * 16 + fr; const size_t off = ((size_t)J * 256 + i) * 4096 + c0; const float b = bs[g * 128 + (i & cm)];
                    const v4u u4 = *(const v4u*)(GU + off), s4 = *(const v4u*)(SG + off); const pg8::f32x4 v0 = acc[ai][bj][m][0], v1 = acc[ai][bj][m][1];
                    const float mx[8] = {v0[0], v0[1], v0[2], v0[3], v1[0], v1[1], v1[2], v1[3]};
                    const float uu[8] = {bflo(u4.x), bfhi(u4.x), bflo(u4.y), bfhi(u4.y), bflo(u4.z), bfhi(u4.z), bflo(u4.w), bfhi(u4.w)};
                    const float sg[8] = {bflo(s4.x), bfhi(s4.x), bflo(s4.y), bfhi(s4.y), bflo(s4.z), bfhi(s4.z), bflo(s4.w), bfhi(s4.w)}; float y[8];
#pragma unroll
                    for (int k = 0; k < 8; ++k) y[k] = uu[k] * (mx[k] * gn[k] + b) * sg[k];
                    v4u w; w.x = pk2(y[0], y[1]); w.y = pk2(y[2], y[3]); w.z = pk2(y[4], y[5]); w.w = pk2(y[6], y[7]);
                    *(v4u*)(GU + off) = w; } }
    }
};
__device__ __forceinline__ float diff_lambda(const float* q1, const float* k1, const float* q2, const float* k2, float lam_init) {
    float a = 0.f, b = 0.f;
    for (int i = 0; i < 64; ++i) { a += q1[i] * k1[i]; b += q2[i] * k2[i]; }
    return expf(a) - expf(b) + lam_init;
}

constexpr int N_PHASES = 21;
__global__ void __launch_bounds__(NTHR, 2) mega(Args args) {
    extern __shared__ __attribute__((aligned(16))) unsigned char lds[];
    Frame F;
    F.lds = (LAS unsigned char*)lds; F.tid = threadIdx.x; F.lane = F.tid & 63; F.wave = __builtin_amdgcn_readfirstlane(F.tid >> 6); F.G = gridDim.x; F.bid = blockIdx.x;
    F.in = args.in; F.out = args.out; F.ws = args.ws;
    unsigned char* ws = args.ws; float* out = args.out;
    bf16* W_AIN[2] = {(bf16*)(ws + WS_WAIN0), (bf16*)(ws + WS_WAIN1)}; bf16* W_AOUT[2] = {(bf16*)(ws + WS_WAOUT0), (bf16*)(ws + WS_WAOUT1)};
    bf16* W_RIN = (bf16*)(ws + WS_WRIN); bf16* W_ROUT = (bf16*)(ws + WS_WROUT); bf16* W_CIN = (bf16*)(ws + WS_WCIN); bf16* W_COUT = (bf16*)(ws + WS_WCOUT);
    bf16* XN0 = (bf16*)(ws + WS_XN0); bf16* HB = (bf16*)(ws + WS_HB); float* SSQ2 = (float*)(ws + WS_SSQ2);
    bf16* Qs = (bf16*)(ws + WS_QS); bf16* KP = (bf16*)(ws + WS_KP); bf16* VP = (bf16*)(ws + WS_VP); bf16* KC = (bf16*)(ws + WS_KC); bf16* VC = (bf16*)(ws + WS_VC); bf16* AO_A = (bf16*)(ws + WS_AOA);
    bf16* KT = (bf16*)(ws + WS_KT); bf16* RG = (bf16*)(ws + WS_RG); bf16* QP = (bf16*)(ws + WS_QP); bf16* KN = (bf16*)(ws + WS_KN); bf16* VS = (bf16*)(ws + WS_VS); bf16* ORET = (bf16*)(ws + WS_ORET);
    bf16* GU = (bf16*)(ws + WS_GU); bf16* SG = (bf16*)(ws + WS_SG); bf16* GVT = (bf16*)(ws + WS_GVT); bf16* WM = (bf16*)(ws + WS_WM); float* SSQ = (float*)(ws + WS_SSQ); bf16* GVS = (bf16*)(ws + WS_GVS); float* TABR = (float*)(ws + WS_TABR); bf16* KVX = (bf16*)(ws + WS_KVX); float* TABA = (float*)(ws + WS_TABA); bf16* GA = (bf16*)(ws + WS_GA);
    const int lo = args.ph_lo, hi = args.ph_hi;
    volatile LAS unsigned* MISC = (volatile LAS unsigned*)(F.lds + MISC_OFF);
    for (int u = F.tid; u < (LDS_BYTES - MISC_OFF) / 4; u += NTHR) ((LAS unsigned*)(F.lds + MISC_OFF))[u] = 0u;
    __syncthreads();
    XcdBarrier bar = xcd_barrier_post((unsigned*)(ws + WS_CTL) + 4096, MISC + 8);
#define IN(k) (lo <= (k) && (k) < hi)
#define PH_ENTER() do { int t_ = F.wave * 64 + lane_now(); F.tid = t_; F.lane = t_ & 63; } while (0)
    volatile LAS int* DRW = (volatile LAS int*)(F.lds + MISC_OFF + 64);
    unsigned* DCTR = (unsigned*)(ws + WS_CTL) + 8192;
#define DRAIN(ph, total, BODY) do { PH_ENTER(); for (;;) { __syncthreads(); if (F.tid == 0) DRW[0] = (int)atomicAdd(DCTR + 64 * (ph), 1u); __syncthreads(); const int c_ = DRW[0]; if (c_ >= (total)) break; BODY } } while (0)
#define SEAM(k) do { if (IN(k) && IN((k) + 1)) xcd_barrier(bar, F.wave == 0 && lane_now() == 0); } while (0)

#define GEMM_STORE(Aptr, Wptr, NN, KK, Optr) do { pg8::GemmP g{KK, KK, (KK) / 64}; pg8::StaticOrder S; S.init(MT / 256, (NN) / 256, F.G, F.bid, Aptr, Wptr, KK, KK); pg8::EpiStoreBf16 E{(pg8::bf16_t*)(Optr), NN}; \
        pg8::gemm_phase<pg8::EpiStoreBf16, pg8::StaticOrder>(F.lds + RING_OFF, g, S, E, F.tid); } while (0)
#define GEMM_RESIDB(MODE_, Aptr, Wptr, KK) do { pg8::GemmP g{KK, KK, (KK) / 64}; pg8::StaticOrder S; S.init(MT / 256, DM / 256, F.G, F.bid, Aptr, Wptr, KK, KK); \
        pg8::EpiResidB<MODE_> E{args.in[I_XP], args.in[I_XS], (pg8::bf16_t*)HB, out, SSQ2}; pg8::gemm_phase<pg8::EpiResidB<MODE_>, pg8::StaticOrder>(F.lds + RING_OFF, g, S, E, F.tid); } while (0)

    PH_ENTER(); if (IN(0)) {
        transpose_weight(F, args.in[I_AWIN], 2048, 8192, W_AIN[0]); attn_table(F, TABA);
        norm_rows(F, args.in[I_XP], args.in[I_XS], args.in[I_NW], XN0);
    }
    SEAM(0);
#define GEMM_AIN(Aptr, Wptr, J_, SSQP) do { pg8::GemmP g{2048, 2048, 32}; pg8::StaticOrder S; S.init(MT / 256, 32, F.G, F.bid, Aptr, Wptr, 2048, 2048); \
        EpiAIn E{Qs, KP, VP, KC, VC, GA, out + O_KP + (size_t)(J_) * MP * DM, out + O_VP + (size_t)(J_) * MP * DM, out + O_KS + (size_t)(J_) * MS * DM, out + O_VS + (size_t)(J_) * MS * DM, TABA, args.in[I_AQG] + 64 * (J_), args.in[I_AKG] + 64 * (J_), SSQP}; \
        pg8::gemm_phase<EpiAIn, pg8::StaticOrder>(F.lds + RING_OFF, g, S, E, F.tid); } while (0)
    PH_ENTER(); if (IN(1)) { GEMM_AIN(XN0, W_AIN[0], 0, (const float*)nullptr);
        const int n0 = CC_CHUNKS, n1 = n0 + tw_chunks(2048, 2048), n2 = n1 + TR_CHUNKS;
        DRAIN(1, n2, if (c_ < n0) cc_run(F, args.in[I_CK], args.in[I_CV], KC, VC, c_); else if (c_ < n1) tw_run(F, args.in[I_AWOUT], 2048, 2048, W_AOUT[0], c_ - n0); else tr_run(F, TABR, c_ - n1);); }
    SEAM(1);
    PH_ENTER(); if (IN(3)) { const float li = 0.8f - 0.6f * expf(-0.3f * 0.f); const float lam = diff_lambda(args.in[I_LQ1], args.in[I_LK1], args.in[I_LQ2], args.in[I_LK2], li);
        attn_fast(F, Qs, KP, VP, KC, VC, GA, AO_A, lam, 1.f - li, args.in[I_ASG]); }
    SEAM(3);
    PH_ENTER(); if (IN(4)) { GEMM_RESIDB(0, AO_A, W_AOUT[0], 2048);
        const int n0 = tw_chunks(2048, 12288), n1 = n0 + tw_chunks(4096, 2048);
        DRAIN(4, n1, if (c_ < n0) tw_run(F, args.in[I_RWIN], 2048, 12288, W_RIN, c_, args.in[I_NW] + DM); else tw_run(F, args.in[I_RWOUT], 4096, 2048, W_ROUT, c_ - n0);); }
    if (IN(4) && IN(6)) xcd_barrier(bar, F.wave == 0 && lane_now() == 0);
    PH_ENTER(); if (IN(6)) { ret_zero_pad(F, VS, KT);
        PH_ENTER(); pg8::GemmP g{2048, 2048, 32}; pg8::StaticOrder S; S.init(MT / 256, 48, F.G, F.bid, HB, W_RIN, 2048, 2048); EpiRet E{QP, KN, KT, VS, RG, TABR, SSQ2};
        pg8::gemm_phase<EpiRet, pg8::StaticOrder>(F.lds + RING_OFF, g, S, E, F.tid); }
    SEAM(6);
    PH_ENTER(); if (IN(7)) { { pg8::GemmP g{4096, 2048, 4}; RetQKOrder S{F.G, F.bid, (const char*)QP, (const char*)KN}; EpiRetQK E{QP}; pg8::gemm_phase<EpiRetQK, RetQKOrder>(F.lds + RING_OFF, g, S, E, F.tid); }
        PH_ENTER(); { pg8::GemmP g{512, 256, 4}; RetKVOrder S{F.G, F.bid, (const char*)VS, (const char*)KT}; EpiRetKV E{VS, KVX}; pg8::gemm_phase<EpiRetKV, RetKVOrder>(F.lds + RING_OFF, g, S, E, F.tid); }
        xcd_barrier(bar, F.wave == 0 && lane_now() == 0);
        PH_ENTER(); ret_scan(F, VS, KVX, args.in[I_SR], out + O_SP, out + O_SS); }
    SEAM(7);
    PH_ENTER(); if (IN(8)) { pg8::GemmP g{4096, 512, 8}; RetOOrder S{F.G, F.bid, (const char*)QP, (const char*)VS}; EpiRetO E{ORET}; pg8::gemm_phase<EpiRetO, RetOOrder>(F.lds + RING_OFF, g, S, E, F.tid); }
    SEAM(8);
    PH_ENTER(); if (IN(9)) r_out(F, ORET, RG);
    SEAM(9);
    PH_ENTER(); if (IN(10)) { GEMM_RESIDB(1, ORET, W_ROUT, 4096);
        const int n0 = tw_chunks(2048, 12288), n1 = n0 + tw_chunks(4096, 2048), n2 = n1 + tw_chunks(2048, 8192), n3 = n2 + tw_chunks(2048, 2048);
        DRAIN(10, n3, if (c_ < n0) tw_run(F, args.in[I_CWIN], 2048, 12288, W_CIN, c_, args.in[I_NW] + 2 * DM); else if (c_ < n1) tw_run(F, args.in[I_CWOUT], 4096, 2048, W_COUT, c_ - n0);
                      else if (c_ < n2) tw_run(F, args.in[I_AWIN] + (size_t)2048 * 8192, 2048, 8192, W_AIN[1], c_ - n1, args.in[I_NW] + 3 * DM); else tw_run(F, args.in[I_AWOUT] + (size_t)2048 * 2048, 2048, 2048, W_AOUT[1], c_ - n2);); }
    if (IN(10) && IN(12)) xcd_barrier(bar, F.wave == 0 && lane_now() == 0);
    PH_ENTER(); if (IN(12)) { pg8::GemmP g{2048, 2048, 32}; pg8::StaticOrder S; S.init(MT / 256, 48, F.G, F.bid, HB, W_CIN, 2048, 2048); EpiCIn E{GU, GVT, SG, GVS, SSQ, SSQ2};
        pg8::gemm_phase<EpiCIn, pg8::StaticOrder>(F.lds + RING_OFF, g, S, E, F.tid); }
    SEAM(12);
    PH_ENTER(); if (IN(13)) c_prep(F, SSQ, args.in[I_CWS], args.in[I_CVG], GVS, WM, out + O_VM);
    SEAM(13);
    PH_ENTER(); if (IN(14)) { pg8::GemmP g{256, 256, 4}; CMixOrder S{F.G, F.bid, (const char*)WM, (const char*)GVT}; EpiCMix E{GU, SG, args.in[I_CVG], args.in[I_CBS]}; pg8::gemm_phase<EpiCMix, CMixOrder>(F.lds + RING_OFF, g, S, E, F.tid); }
    SEAM(14);
    PH_ENTER(); if (IN(15)) { GEMM_RESIDB(1, GU, W_COUT, 4096);
        DRAIN(15, CC_CHUNKS, cc_run(F, args.in[I_CK] + (size_t)NB * PAST * DM, args.in[I_CV] + (size_t)NB * PAST * DM, KC, VC, c_);); }
    if (IN(15) && IN(17)) xcd_barrier(bar, F.wave == 0 && lane_now() == 0);
    PH_ENTER(); if (IN(17)) GEMM_AIN(HB, W_AIN[1], 1, (const float*)SSQ2);
    SEAM(17);
    PH_ENTER(); if (IN(19)) { const float li = 0.8f - 0.6f * expf(-0.3f * 3.f); const float lam = diff_lambda(args.in[I_LQ1] + 64, args.in[I_LK1] + 64, args.in[I_LQ2] + 64, args.in[I_LK2] + 64, li);
        attn_fast(F, Qs, KP, VP, KC, VC, GA, AO_A, lam, 1.f - li, args.in[I_ASG] + 128); }
    SEAM(19);
    PH_ENTER(); if (IN(20)) GEMM_RESIDB(2, AO_A, W_AOUT[1], 2048);
#undef IN
#undef SEAM
}

extern "C" void kernel_launch(void* const* d_in, const int* in_sizes, int n_in, void* d_out, int out_size, void* d_ws, size_t ws_size, hipStream_t stream) {
    static int grid = 0;
    if (grid == 0) {
        if (n_in != N_IN || (size_t)out_size != O_END || ws_size < WS_END) { fprintf(stderr, "kernel_launch: unexpected shapes: n_in %d out %d ws %zu (need %zu)\n", n_in, out_size, ws_size, (size_t)WS_END); grid = -1; return; }
        int dev = 0, cus = 0;
        if (hipGetDevice(&dev) != hipSuccess || hipDeviceGetAttribute(&cus, hipDeviceAttributeMultiprocessorCount, dev) != hipSuccess) { grid = -1; return; }
        if (hipFuncSetAttribute((const void*)mega, hipFuncAttributeMaxDynamicSharedMemorySize, LDS_BYTES) != hipSuccess) { fprintf(stderr, "kernel_launch: hipFuncSetAttribute failed\n"); grid = -1; return; }
        (void)hipGetLastError();
        grid = cus;
    }
    if (grid < 0) return;
    Args a{};
    for (int i = 0; i < N_IN; ++i) a.in[i] = (const float*)d_in[i];
    a.out = (float*)d_out; a.ws = (unsigned char*)d_ws;
    (void)hipMemsetAsync((char*)d_ws + WS_CTL, 0, CTL_ZERO_BYTES, stream);
    a.ph_lo = 0; a.ph_hi = N_PHASES;
    hipLaunchKernelGGL(mega, dim3(grid), dim3(NTHR), LDS_BYTES, stream, a);
}
```

```cpp
#include <hip/hip_runtime.h>
#include <cstdio>
#include <cstdint>

__device__ __forceinline__ int lane_now() { int l; asm volatile("v_mbcnt_lo_u32_b32 %0, -1, 0\n\tv_mbcnt_hi_u32_b32 %0, -1, %0" : "=v"(l)); return l; }
namespace pg8 {
#define PG8_LAS __attribute__((address_space(3)))
typedef unsigned short bf16_t;
typedef short bf16x8 __attribute__((ext_vector_type(8)));
typedef float f32x4 __attribute__((ext_vector_type(4)));
typedef unsigned u32x4 __attribute__((ext_vector_type(4)));
constexpr int BM = 256, BK = 64, HALF = 128, HTB = HALF * BK * 2, STAGE_BYTES = 8 * HTB, NXCD = 8, WGM = 8;

__host__ __device__ __forceinline__ int lds_byte(int r, int c) { const int st = (r >> 4) * 2 + (c >> 5), rr = r & 15, cc = c & 31, ob = rr * 64 + cc * 2; return st * 1024 + (ob ^ (((ob >> 9) & 1) << 5)); }
__host__ __device__ __forceinline__ void stage_rc(int b, int& R, int& C) { const int st = b / 1024, sb = b % 1024, swz = sb ^ (((sb >> 9) & 1) << 5); R = (st >> 1) * 16 + swz / 64; C = (st & 1) * 32 + (swz % 64) / 2; }
__host__ __device__ __forceinline__ int perm32(int rho) { const int n = rho >> 4, i = rho & 15; return 8 * (i >> 2) + 4 * n + (i & 3); }

struct Unit { int pm, pn; const char* a; const char* b; };
struct GemmP { int lda, ldb, nt; };

struct StaticOrder {
    int nM, nN, nwg, G, c; const char* A; const char* B; size_t ta, tb;
    __host__ __device__ void init(int nM_, int nN_, int G_, int c_, const void* A_, const void* B_, int lda, int ldb) { nM = nM_; nN = nN_; nwg = nM * nN; G = G_; c = c_; A = (const char*)A_; B = (const char*)B_; ta = (size_t)BM * lda * 2; tb = (size_t)BM * ldb * 2; }
    __host__ __device__ bool next(int i, Unit& u) const {
        const long L = (long)i * G + c; if (L >= nwg) return false;
        int wgid = (int)L; { const int q = nwg / NXCD, r = nwg % NXCD, xcd = wgid % NXCD, off = wgid / NXCD; wgid = (xcd < r ? xcd * (q + 1) : r * (q + 1) + (xcd - r) * q) + off; }
        const int nig = WGM * nN, gid = wgid / nig, fm = gid * WGM, gsz = (nM - fm) < WGM ? (nM - fm) : WGM;
        u.pm = fm + ((wgid % nig) % gsz); u.pn = (wgid % nig) / gsz; u.a = A + (size_t)u.pm * ta; u.b = B + (size_t)u.pn * tb; return true;
    }
    __device__ __forceinline__ void a_ready(const Unit&) const {}
    __device__ __forceinline__ void done(const Unit&) const {}
};

__device__ __forceinline__ unsigned cvt_pk_bf16(float lo, float hi) { unsigned r; asm volatile("v_cvt_pk_bf16_f32 %0, %1, %2" : "=v"(r) : "v"(lo), "v"(hi)); return r; }

struct EpiStoreBf16 {
    static constexpr int BMODE = 1;
    bf16_t* O; int ldc;
    __device__ __forceinline__ void operator()(const f32x4 (&acc)[2][2][4][2], const Unit& u, int wr, int wc, int fr, int fq) const {
        const int row0 = u.pm * BM + wr * 64 + fr; const int col0 = u.pn * BM + wc * 32 + 8 * fq;
#pragma unroll
        for (int ai = 0; ai < 2; ++ai)
#pragma unroll
            for (int m = 0; m < 4; ++m) { bf16_t* rowp = O + (size_t)(row0 + ai * HALF + m * 16) * ldc + col0;
#pragma unroll
                for (int bj = 0; bj < 2; ++bj) { const f32x4 v0 = acc[ai][bj][m][0], v1 = acc[ai][bj][m][1];
                    u32x4 w; w.x = cvt_pk_bf16(v0[0], v0[1]); w.y = cvt_pk_bf16(v0[2], v0[3]); w.z = cvt_pk_bf16(v1[0], v1[1]); w.w = cvt_pk_bf16(v1[2], v1[3]);
                    *(u32x4*)(rowp + bj * HALF) = w; } }
    }
};
struct EpiResid {
    static constexpr int BMODE = 0;
    const float* base_p; const float* base_s; float* out; int split;
    __device__ __forceinline__ void operator()(const f32x4 (&acc)[2][2][4][2], const Unit& u, int wr, int wc, int fr, int fq) const {
        { const int l_ = lane_now(); fr = l_ & 15; fq = l_ >> 4; }
        const int col0 = u.pn * BM + wc * 32 + 4 * fq;
#pragma unroll
        for (int ai = 0; ai < 2; ++ai) {
            f32x4 bs[4][2][2];
#pragma unroll
            for (int m = 0; m < 4; ++m) { const int r = u.pm * BM + ai * HALF + wr * 64 + m * 16 + fr; const float* bp = (r < split) ? base_p + (size_t)r * 2048 : base_s + (size_t)(r - split) * 2048;
#pragma unroll
                for (int bj = 0; bj < 2; ++bj)
#pragma unroll
                    for (int n = 0; n < 2; ++n) bs[m][bj][n] = *(const f32x4*)(bp + col0 + bj * HALF + n * 16); }
#pragma unroll
            for (int m = 0; m < 4; ++m) { const int r = u.pm * BM + ai * HALF + wr * 64 + m * 16 + fr; float* op = out + (size_t)r * 2048;
#pragma unroll
                for (int bj = 0; bj < 2; ++bj)
#pragma unroll
                    for (int n = 0; n < 2; ++n) *(f32x4*)(op + col0 + bj * HALF + n * 16) = bs[m][bj][n] + acc[ai][bj][m][n]; }
            asm volatile("" ::: "memory");
        }
    }
};

template <int MODE> struct EpiResidB {
    static constexpr int BMODE = 1;
    const float* base_p; const float* base_s; bf16_t* HB; float* out; float* SSQ2;
    __device__ __forceinline__ void operator()(const f32x4 (&acc)[2][2][4][2], const Unit& u, int wr, int wc, int fr, int fq) const {
        { const int l_ = lane_now(); fr = l_ & 15; fq = l_ >> 4; }
        const int col0 = u.pn * BM + wc * 32 + 8 * fq;
#pragma unroll
        for (int ai = 0; ai < 2; ++ai) {
            f32x4 b0[4][2], b1[4][2]; u32x4 hb[4][2];
#pragma unroll
            for (int m = 0; m < 4; ++m) { const int r = u.pm * BM + ai * HALF + wr * 64 + m * 16 + fr;
#pragma unroll
                for (int bj = 0; bj < 2; ++bj) {
                    if (MODE == 0) { const float* bp = ((r < 16384) ? base_p + (size_t)r * 2048 : base_s + (size_t)(r - 16384) * 2048) + col0 + bj * HALF; b0[m][bj] = *(const f32x4*)bp; b1[m][bj] = *(const f32x4*)(bp + 4); }
                    else hb[m][bj] = *(const u32x4*)(HB + (size_t)r * 2048 + col0 + bj * HALF); } }
#pragma unroll
            for (int m = 0; m < 4; ++m) { const int r = u.pm * BM + ai * HALF + wr * 64 + m * 16 + fr; float ss = 0.f;
#pragma unroll
                for (int bj = 0; bj < 2; ++bj) { f32x4 h0, h1;
                    if (MODE == 0) { h0 = b0[m][bj] + acc[ai][bj][m][0]; h1 = b1[m][bj] + acc[ai][bj][m][1]; }
                    else { const u32x4 w = hb[m][bj];
                        h0 = (f32x4){__builtin_bit_cast(float, w.x << 16), __builtin_bit_cast(float, w.x & 0xffff0000u), __builtin_bit_cast(float, w.y << 16), __builtin_bit_cast(float, w.y & 0xffff0000u)} + acc[ai][bj][m][0];
                        h1 = (f32x4){__builtin_bit_cast(float, w.z << 16), __builtin_bit_cast(float, w.z & 0xffff0000u), __builtin_bit_cast(float, w.w << 16), __builtin_bit_cast(float, w.w & 0xffff0000u)} + acc[ai][bj][m][1]; }
                    if (MODE == 2) { float* op = out + (size_t)r * 2048 + col0 + bj * HALF; *(f32x4*)op = h0; *(f32x4*)(op + 4) = h1; }
                    else { u32x4 w; w.x = cvt_pk_bf16(h0[0], h0[1]); w.y = cvt_pk_bf16(h0[2], h0[3]); w.z = cvt_pk_bf16(h1[0], h1[1]); w.w = cvt_pk_bf16(h1[2], h1[3]);
                        *(u32x4*)(HB + (size_t)r * 2048 + col0 + bj * HALF) = w;
                        ss += (h0[0] * h0[0] + h0[1] * h0[1]) + (h0[2] * h0[2] + h0[3] * h0[3]) + (h1[0] * h1[0] + h1[1] * h1[1]) + (h1[2] * h1[2] + h1[3] * h1[3]); } }
                if (MODE != 2) { ss += __shfl_xor(ss, 16); ss += __shfl_xor(ss, 32); if (fq == 0) SSQ2[(size_t)r * 32 + u.pn * 4 + wc] = ss; } }
            asm volatile("" ::: "memory");
        }
    }
};

template <class Epi, class Sched, bool ALIGN_EPI = true>
__device__ __forceinline__ void gemm_phase(PG8_LAS unsigned char* lds, const GemmP g, const Sched& S, const Epi& E, int tid) {
    asm volatile("" : "+v"(tid));
    const int wid = __builtin_amdgcn_readfirstlane(tid >> 6), lane = tid & 63, wr = wid >> 2, wc = wid & 3, fr = lane & 15, fq = lane >> 4;
    const int nt = g.nt;
    unsigned voffA[2], voffB[2];
#pragma unroll
    for (int i = 0; i < 2; ++i) { int R, C; stage_rc(tid * 16 + i * 8192, R, C); const int Rb = Epi::BMODE == 2 ? (64 * (R >> 5) + perm32(R & 31)) : Epi::BMODE == 1 ? ((R & ~31) + perm32(R & 31)) : R;
        voffA[i] = (unsigned)(R * g.lda + C) * 2u; voffB[i] = (unsigned)(Rb * g.ldb + C) * 2u; }
    const size_t kstep = (size_t)(BK * 2);
    const size_t hstepA = (size_t)HALF * g.lda * 2, hstepB = (size_t)(Epi::BMODE == 2 ? 32 : HALF) * g.ldb * 2;
    const unsigned ldsw = (unsigned)wid * 1024u;
    const int aoff = lds_byte(wr * 64 + fr, fq * 8), boff = lds_byte(wc * 32 + fr, fq * 8);
#define PG8_SA(b, h) (((b) * 2 + (h)) * HTB)
#define PG8_SB(b, h) ((4 + (b) * 2 + (h)) * HTB)
#define PG8_STAGE(bufoff, gbase, voff) do { _Pragma("unroll") for (int _i = 0; _i < 2; ++_i) \
        __builtin_amdgcn_global_load_lds((const unsigned*)((const char*)(gbase) + (voff)[_i]), (PG8_LAS unsigned*)(lds + (bufoff) + ldsw + _i * 8192), 16, 0, 0); } while (0)
#define PG8_LDA(dst, b, h) do { _Pragma("unroll") for (int m = 0; m < 4; ++m) _Pragma("unroll") for (int k = 0; k < 2; ++k) dst[m][k] = *(const PG8_LAS bf16x8*)(lds + PG8_SA(b, h) + aoff + m * 2048 + k * 1024); } while (0)
#define PG8_LDB(dst, b, h) do { _Pragma("unroll") for (int n = 0; n < 2; ++n) _Pragma("unroll") for (int k = 0; k < 2; ++k) dst[n][k] = *(const PG8_LAS bf16x8*)(lds + PG8_SB(b, h) + boff + n * 2048 + k * 1024); } while (0)
#define PG8_MMA(ai, bj, At, Bt) do { __builtin_amdgcn_s_setprio(1); _Pragma("unroll") for (int m = 0; m < 4; ++m) _Pragma("unroll") for (int n = 0; n < 2; ++n) _Pragma("unroll") for (int k = 0; k < 2; ++k) \
        acc[ai][bj][m][n] = __builtin_amdgcn_mfma_f32_16x16x32_bf16(Bt[n][k], At[m][k], acc[ai][bj][m][n], 0, 0, 0); __builtin_amdgcn_s_setprio(0); } while (0)
#define PG8_WAIT_V(n) asm volatile("s_waitcnt vmcnt(" #n ")" ::: "memory")
#define PG8_WAIT_L(n) asm volatile("s_waitcnt lgkmcnt(" #n ")" ::: "memory")
#define PG8_BAR __builtin_amdgcn_s_barrier()
#define PG8_SCHED __builtin_amdgcn_sched_barrier(0)
    Unit cur, nxt; int ui = 0;
    if (!S.next(0, cur)) return;
    f32x4 acc[2][2][4][2];
#pragma unroll
    for (int a = 0; a < 2; ++a)
#pragma unroll
        for (int b = 0; b < 2; ++b)
#pragma unroll
            for (int m = 0; m < 4; ++m)
#pragma unroll
                for (int n = 0; n < 2; ++n) acc[a][b][m][n] = (f32x4){0.f, 0.f, 0.f, 0.f};
    bf16x8 At[4][2], B0[2][2], B1[2][2];
    const char* cA = cur.a; const char* cB = cur.b;
    S.a_ready(cur);
    PG8_STAGE(PG8_SB(0, 0), cB, voffB); PG8_STAGE(PG8_SB(0, 1), cB + hstepB, voffB); PG8_STAGE(PG8_SA(0, 0), cA, voffA); PG8_STAGE(PG8_SA(0, 1), cA + hstepA, voffA);
    if (wr == 1) PG8_BAR;
    PG8_WAIT_V(2); PG8_BAR;
    PG8_STAGE(PG8_SB(1, 0), cB + kstep, voffB); PG8_STAGE(PG8_SA(1, 0), cA + kstep, voffA); PG8_STAGE(PG8_SB(1, 1), cB + hstepB + kstep, voffB);
    PG8_WAIT_V(6); PG8_BAR;
    for (;;) {
        const bool has_next = S.next(ui + 1, nxt);
        const char* nA = has_next ? nxt.a : cA; const char* nB = has_next ? nxt.b : cB;
        for (int t = 0; t < nt; t += 2) {
            const bool last = (t == nt - 2);
            const char* a1 = cA + (size_t)(t + 1) * kstep;
            const char* a2 = last ? nA : cA + (size_t)(t + 2) * kstep; const char* b2 = last ? nB : cB + (size_t)(t + 2) * kstep;
            const char* a3 = a2 + kstep; const char* b3 = b2 + kstep;
            if (last && has_next) S.a_ready(nxt);
            PG8_LDB(B0, 0, 0); PG8_LDB(B1, 0, 1); PG8_SCHED; PG8_LDA(At, 0, 0); PG8_STAGE(PG8_SA(1, 1), a1 + hstepA, voffA);
            PG8_WAIT_V(8); PG8_WAIT_L(0); PG8_BAR; PG8_MMA(0, 0, At, B0); PG8_MMA(0, 1, At, B1); PG8_BAR; PG8_SCHED;
            PG8_LDA(At, 0, 1); PG8_STAGE(PG8_SB(0, 0), b2, voffB); PG8_STAGE(PG8_SB(0, 1), b2 + hstepB, voffB); PG8_STAGE(PG8_SA(0, 0), a2, voffA);
            PG8_WAIT_V(8); PG8_WAIT_L(0); PG8_BAR; PG8_MMA(1, 0, At, B0); PG8_MMA(1, 1, At, B1); PG8_BAR; PG8_SCHED;
            PG8_LDB(B0, 1, 0); PG8_LDB(B1, 1, 1); PG8_SCHED; PG8_LDA(At, 1, 0); PG8_STAGE(PG8_SA(0, 1), a2 + hstepA, voffA);
            PG8_WAIT_V(8); PG8_WAIT_L(0); PG8_BAR; PG8_MMA(0, 0, At, B0); PG8_MMA(0, 1, At, B1); PG8_BAR; PG8_SCHED;
            PG8_LDA(At, 1, 1); PG8_STAGE(PG8_SB(1, 0), b3, voffB); PG8_STAGE(PG8_SB(1, 1), b3 + hstepB, voffB); PG8_STAGE(PG8_SA(1, 0), a3, voffA);
            PG8_WAIT_V(8); PG8_WAIT_L(0); PG8_BAR; PG8_MMA(1, 0, At, B0); PG8_MMA(1, 1, At, B1); PG8_BAR; PG8_SCHED;
        }
        if constexpr (ALIGN_EPI) { if (wr == 0) PG8_BAR; }
        E(acc, cur, wr, wc, fr, fq); S.done(cur);
        if (!has_next) break;
#pragma unroll
        for (int a = 0; a < 2; ++a)
#pragma unroll
            for (int b = 0; b < 2; ++b)
#pragma unroll
                for (int m = 0; m < 4; ++m)
#pragma unroll
                    for (int n = 0; n < 2; ++n) acc[a][b][m][n] = (f32x4){0.f, 0.f, 0.f, 0.f};
        cur = nxt; cA = nA; cB = nB; ++ui;
        if constexpr (ALIGN_EPI) { if (wr == 1) PG8_BAR; }
    }
    PG8_WAIT_V(0);
    if constexpr (!ALIGN_EPI) { if (wr == 0) PG8_BAR; }
    PG8_BAR;
#undef PG8_SA
#undef PG8_SB
#undef PG8_STAGE
#undef PG8_LDA
#undef PG8_LDB
#undef PG8_MMA
#undef PG8_WAIT_V
#undef PG8_WAIT_L
#undef PG8_BAR
#undef PG8_SCHED
}
}

constexpr int NWAVES = 8, NTHR = 512;
constexpr int DM = 2048, MP = 16384, MS = 512, MT = MP + MS, PAST = 2048, DECL = 64, NB = 8;
constexpr int KCROWS = PAST + DECL;
constexpr float EPS = 1e-6f;
constexpr float LOG2E = 1.4426950408889634f;
constexpr float C2 = 0.125f * LOG2E;

enum { I_XP = 0, I_XS, I_CK, I_CV, I_SR, I_NW, I_AWIN, I_AWOUT, I_AQG, I_AKG, I_LQ1, I_LK1, I_LQ2, I_LK2, I_ASG, I_RWIN, I_RWOUT, I_CWIN, I_CWOUT, I_CVG, I_CWS, I_CBS, N_IN };
constexpr size_t O_YP = 0, O_YS = O_YP + (size_t)MP * DM, O_KP = O_YS + (size_t)MS * DM, O_VP = O_KP + 2 * (size_t)MP * DM, O_KS = O_VP + 2 * (size_t)MP * DM, O_VS = O_KS + 2 * (size_t)MS * DM,
                 O_SP = O_VS + 2 * (size_t)MS * DM, O_SS = O_SP + (size_t)8 * 256 * 512, O_VM = O_SS + (size_t)NB * 8 * 256 * 512, O_END = O_VM + (size_t)MS * 4096;

constexpr size_t MiB = 1u << 20;
constexpr size_t WS_CTL = 0, CTL_ZERO_BYTES = 1 * MiB;
constexpr size_t WS_WAIN0 = 8 * MiB, WS_WAOUT0 = 40 * MiB, WS_WRIN = 48 * MiB, WS_WROUT = 96 * MiB, WS_WCIN = 112 * MiB, WS_WCOUT = 160 * MiB, WS_WAIN1 = 176 * MiB, WS_WAOUT1 = 208 * MiB;
constexpr size_t WS_SSQ2 = 2 * MiB;
constexpr size_t WS_HB = 216 * MiB, WS_Z = 282 * MiB;
constexpr size_t WS_XN0 = 348 * MiB;
constexpr size_t WS_QS = 546 * MiB, WS_KP = 612 * MiB, WS_VP = 676 * MiB, WS_KC = 740 * MiB, WS_VC = 806 * MiB, WS_AOA = 872 * MiB;
constexpr size_t WS_KT = 112 * MiB, WS_RG = 282 * MiB, WS_QP = 414 * MiB, WS_KN = 546 * MiB, WS_VS = 612 * MiB, WS_ORET = 900 * MiB;
constexpr size_t WS_GU = 282 * MiB, WS_SG = 414 * MiB, WS_GVT = 546 * MiB, WS_WM = 678 * MiB, WS_SSQ = 744 * MiB, WS_GVS = 752 * MiB;
constexpr size_t WS_GA = 282 * MiB;
constexpr size_t WS_KVX = 184 * MiB;
constexpr size_t WS_TABR = 1040 * MiB, WS_TABA = 1056 * MiB, WS_END = 1060 * MiB;

#define GAS __attribute__((address_space(1)))
#define LAS __attribute__((address_space(3)))
typedef unsigned short bf16;
typedef unsigned v4u __attribute__((ext_vector_type(4)));
typedef unsigned v2u __attribute__((ext_vector_type(2)));
typedef float f32x4 __attribute__((ext_vector_type(4)));
typedef GAS unsigned gu32;
#define RLX_AGENT __ATOMIC_RELAXED, __HIP_MEMORY_SCOPE_AGENT
#define LDS_WAIT() asm volatile("s_waitcnt lgkmcnt(0)" ::: "memory")
#define VM_WAIT() asm volatile("s_waitcnt vmcnt(0)" ::: "memory")
__device__ __forceinline__ unsigned f2bf(float f) { unsigned u = __builtin_bit_cast(unsigned, f); return (u + 0x7fffu + ((u >> 16) & 1u)) >> 16; }
__device__ __forceinline__ unsigned pk2(float lo, float hi) { return f2bf(lo) | (f2bf(hi) << 16); }
__device__ __forceinline__ float bf2f(unsigned short b) { return __builtin_bit_cast(float, (unsigned)b << 16); }
__device__ __forceinline__ float bflo(unsigned w) { return __builtin_bit_cast(float, w << 16); }
__device__ __forceinline__ float bfhi(unsigned w) { return __builtin_bit_cast(float, w & 0xffff0000u); }
__device__ __forceinline__ float silu_f(float x) { return x / (1.f + __expf(-x)); }
__device__ __forceinline__ float gelu_tanh_f(float x) { const float u = 0.7978845608028654f * (x + 0.044715f * x * x * x); return x / (1.f + __expf(-2.f * u)); }
__device__ __forceinline__ float wave_sum(float v) {
#pragma unroll
    for (int o = 1; o < 64; o <<= 1) v += __shfl_xor(v, o);
    return v;
}
__device__ __forceinline__ void row_rstd(const float* ssq, int pm, int wr, int fr, int fq, float (&rs)[2][4]) {
#pragma unroll
    for (int ai = 0; ai < 2; ++ai)
#pragma unroll
        for (int m = 0; m < 4; ++m) {
            if (ssq) { const float* p = ssq + ((size_t)pm * 256 + ai * 128 + wr * 64 + m * 16 + fr) * 32 + 8 * fq; const f32x4 a = *(const f32x4*)p, b = *(const f32x4*)(p + 4);
                float t = ((a.x + a.y) + (a.z + a.w)) + ((b.x + b.y) + (b.z + b.w)); t += __shfl_xor(t, 16); t += __shfl_xor(t, 32); rs[ai][m] = 1.f / sqrtf(t * (1.f / 2048.f) + EPS); }
            else rs[ai][m] = 1.f; }
}
__device__ __forceinline__ void rope_cs(int pos, int i, int nf, float& c, float& s) {
    const float inv = exp2f(-(float)i / (float)nf * 13.287712379549449f);
    const double a = (double)pos * (double)inv * 0.15915494309189535;
    const float r = (float)(a - floor(a));
    c = __builtin_amdgcn_cosf(r); s = __builtin_amdgcn_sinf(r);
}

#define XB_TMO      128
#define XB_XCNT(j)  (256  + 64 * (j))
#define XB_XSUB(j)  (1280 + 64 * (j))
#define XB_XGEN(j)  (2304 + 64 * (j))
#define XB_TOP      3328
#define XB_TOPGEN   3392
#define XCD_BAR_WORDS 3456
#define XB_SPIN_CAP (1u << 22)
__device__ __forceinline__ unsigned xb_ld(unsigned* p)              { return __hip_atomic_load(p, __ATOMIC_RELAXED, __HIP_MEMORY_SCOPE_AGENT); }
__device__ __forceinline__ unsigned xb_add(unsigned* p, unsigned v) { return __hip_atomic_fetch_add(p, v, __ATOMIC_RELAXED, __HIP_MEMORY_SCOPE_AGENT); }
__device__ __forceinline__ unsigned xb_xcc_id() { return (unsigned)__builtin_amdgcn_s_getreg((3 << 11) | 20) & 0xFu; }
#define XB_SPIN(cond, bar) do { unsigned _sp = 0; while (cond) { __builtin_amdgcn_s_sleep(1); \
    if ((++_sp & 255u) == 0u) { if (xb_ld(&(bar)[XB_TMO])) break; if (_sp > XB_SPIN_CAP) { atomicAdd(&(bar)[XB_TMO], 1u); break; } } } } while (0)
struct XcdBarrier { unsigned* bar; unsigned x; volatile LAS unsigned* st; };
__device__ __forceinline__ XcdBarrier xcd_barrier_post(unsigned* bar, volatile LAS unsigned* st) {
    XcdBarrier b; b.bar = bar; b.x = xb_xcc_id(); b.st = st;
    if (threadIdx.x == 0) (void)xb_add(&bar[XB_XCNT(b.x)], 1u);
    return b;
}
__device__ __forceinline__ void xcd_barrier_complete(unsigned* bar, unsigned x, unsigned& nloc, unsigned& nx) {
    const unsigned G = gridDim.x * gridDim.y * gridDim.z;
    unsigned sum, cnt, mine, sp = 0u;
    for (;;) {
        sum = 0u; cnt = 0u; mine = 0u;
#pragma unroll
        for (unsigned j = 0; j < 16; ++j) { const unsigned c = xb_ld(&bar[XB_XCNT(j)]); sum += c; cnt += (c > 0u) ? 1u : 0u; mine = (j == x) ? c : mine; }
        if (sum == G) break;
        __builtin_amdgcn_s_sleep(1);
        if ((++sp & 255u) == 0u) { if (xb_ld(&bar[XB_TMO])) break; if (sp > XB_SPIN_CAP) { atomicAdd(&bar[XB_TMO], 1u); break; } }
    }
    nloc = mine > 0u ? mine : 1u; nx = cnt > 0u ? cnt : 1u;
}
__device__ __forceinline__ void xcd_barrier(const XcdBarrier& b, bool leader) {
    asm volatile("s_waitcnt vmcnt(0)" ::: "memory");
    __syncthreads();
    if (leader) {
        unsigned* bar = b.bar;
        __builtin_amdgcn_s_waitcnt(0);
        unsigned nloc = b.st[0], nx = b.st[1];
        if (nloc == 0u) { xcd_barrier_complete(bar, b.x, nloc, nx); b.st[0] = nloc; b.st[1] = nx; }
        const unsigned old = xb_add(&bar[XB_XSUB(b.x)], 1u);
        const unsigned gen = old / nloc;
        if (old + 1u == (gen + 1u) * nloc) {
            __builtin_amdgcn_fence(__ATOMIC_RELEASE, "agent");
            asm volatile("s_waitcnt vmcnt(0)" ::: "memory");
            const unsigned og = xb_add(&bar[XB_TOP], 1u);
            const unsigned tg = og / nx;
            if (og + 1u == (tg + 1u) * nx) xb_add(&bar[XB_TOPGEN], 1u);
            else XB_SPIN(xb_ld(&bar[XB_TOPGEN]) == tg, bar);
            __builtin_amdgcn_fence(__ATOMIC_ACQUIRE, "agent");
            xb_add(&bar[XB_XGEN(b.x)], 1u);
            asm volatile("s_waitcnt vmcnt(0)" ::: "memory");
        } else {
            XB_SPIN(xb_ld(&bar[XB_XGEN(b.x)]) == gen, bar);
            __builtin_amdgcn_fence(__ATOMIC_ACQUIRE, "agent");
            asm volatile("s_waitcnt vmcnt(0)" ::: "memory");
        }
    }
    __syncthreads();
}

constexpr int RING_OFF = 0, RING_BYTES = 139264;
constexpr int MISC_OFF = RING_BYTES;
constexpr int LDS_BYTES = 147456;
struct Args { const float* in[N_IN]; float* out; unsigned char* ws; int ph_lo, ph_hi; };
struct Frame {
    LAS unsigned char* lds; int tid, lane, wave, G, bid;
    const float* const* in; float* out; unsigned char* ws;
};

__device__ __forceinline__ void p0_transpose_item(const float* W, int K, int N, bf16* WT, LAS float* scr, int item, int lane, const float* ksc = nullptr) {
    const int nblk = N / 32, kb = item / nblk, nb = item % nblk, k0 = 64 * kb, n0 = 32 * nb;
#pragma unroll 8
    for (int i = 0; i < 32; ++i) { const int kk = 2 * i + (lane >> 5); const float w_ = W[(size_t)(k0 + kk) * N + n0 + (lane & 31)]; scr[kk * 33 + (lane & 31)] = ksc ? w_ * ksc[k0 + kk] : w_; }
    LDS_WAIT(); asm volatile("" ::: "memory");
    const int c = lane & 7;
#pragma unroll
    for (int j = 0; j < 4; ++j) { const int n = (lane >> 3) + 8 * j; const LAS float* s = scr + (8 * c) * 33 + n;
        v4u o; o.x = pk2(s[0 * 33], s[1 * 33]); o.y = pk2(s[2 * 33], s[3 * 33]); o.z = pk2(s[4 * 33], s[5 * 33]); o.w = pk2(s[6 * 33], s[7 * 33]);
        *(GAS v4u*)(WT + (size_t)(n0 + n) * K + k0 + 8 * c) = o; }
    LDS_WAIT(); asm volatile("" ::: "memory");
}
__device__ __forceinline__ void transpose_weight(Frame& F, const float* W, int K, int N, bf16* WT) {
    LAS float* scr = (LAS float*)(F.lds + RING_OFF + F.wave * 16384);
    const int gw = F.bid * NWAVES + F.wave, NGW = F.G * NWAVES, nitems = (K / 64) * (N / 32);
    for (int it = gw; it < nitems; it += NGW) p0_transpose_item(W, K, N, WT, scr, it, F.lane);
}
__device__ __forceinline__ void norm_rows(Frame& F, const float* src_p, const float* src_s, const float* w, bf16* XN) {
    const int gw = F.bid * NWAVES + F.wave, NGW = F.G * NWAVES;
    for (int m = gw; m < MT; m += NGW) {
        const float* xrow = (m < MP) ? src_p + (size_t)m * DM : src_s + (size_t)(m - MP) * DM;
        const GAS f32x4* xr = (const GAS f32x4*)xrow + F.lane; const GAS f32x4* wr = (const GAS f32x4*)w + F.lane;
        f32x4 v[8]; float s = 0.f;
#pragma unroll
        for (int j = 0; j < 8; ++j) { v[j] = xr[64 * j]; s += (v[j].x * v[j].x + v[j].y * v[j].y) + (v[j].z * v[j].z + v[j].w * v[j].w); }
        const float rstd = 1.f / sqrtf(wave_sum(s) * (1.f / DM) + EPS);
        GAS v2u* o8 = (GAS v2u*)(XN + (size_t)m * DM) + F.lane;
#pragma unroll
        for (int j = 0; j < 8; ++j) { const f32x4 g = wr[64 * j]; v2u o; o.x = pk2(v[j].x * rstd * g.x, v[j].y * rstd * g.y); o.y = pk2(v[j].z * rstd * g.z, v[j].w * rstd * g.w); o8[64 * j] = o; }
    }
}
__device__ __forceinline__ void cache_cvt(Frame& F, const float* ck, const float* cv, bf16* KC, bf16* VC) {
    const size_t nvec = (size_t)NB * PAST * DM / 4;
    const size_t gt = (size_t)F.bid * NTHR + F.tid, NG = (size_t)F.G * NTHR;
    for (size_t i = gt; i < 2 * nvec; i += NG) {
        const bool isv = i >= nvec; const size_t e = (isv ? i - nvec : i) * 4;
        const size_t brow = e / DM, col = e % DM, b = brow / PAST, t = brow % PAST;
        const f32x4 x = *(const GAS f32x4*)((isv ? cv : ck) + e);
        v2u o; o.x = pk2(x.x, x.y); o.y = pk2(x.z, x.w);
        *(GAS v2u*)((isv ? VC : KC) + ((b * KCROWS + t) * DM + col)) = o;
    }
}
__device__ __forceinline__ int tw_chunks(int K, int N) { return (K / 64) * (N / 32) / 64; }
__device__ __forceinline__ void tw_run(Frame& F, const float* W, int K, int N, bf16* WT, int c, const float* ksc = nullptr) {
    LAS float* scr = (LAS float*)(F.lds + RING_OFF + F.wave * 16384);
#pragma unroll 1
    for (int i = 0; i < 8; ++i) p0_transpose_item(W, K, N, WT, scr, c * 64 + F.wave * 8 + i, F.lane, ksc);
}
constexpr int CC_CHUNKS = 2 * (NB * PAST * DM / 4) / 8192;
__device__ __forceinline__ void cc_run(Frame& F, const float* ck, const float* cv, bf16* KC, bf16* VC, int c) {
    const size_t nvec = (size_t)NB * PAST * DM / 4;
#pragma unroll 4
    for (int k = 0; k < 16; ++k) { const size_t i = (size_t)c * 8192 + k * NTHR + F.tid;
        const bool isv = i >= nvec; const size_t e = (isv ? i - nvec : i) * 4; const size_t brow = e / DM, col = e % DM, b = brow / PAST, t = brow % PAST;
        const f32x4 x = *(const GAS f32x4*)((isv ? cv : ck) + e); v2u o; o.x = pk2(x.x, x.y); o.y = pk2(x.z, x.w);
        *(GAS v2u*)((isv ? VC : KC) + ((b * KCROWS + t) * DM + col)) = o; }
}
constexpr int TR_CHUNKS = MP * 128 / 8192;
__device__ __forceinline__ void tr_run(Frame& F, float* tab, int c) {
#pragma unroll 1
    for (int k = 0; k < 16; ++k) { const size_t e = (size_t)c * 8192 + k * NTHR + F.tid; float cs, sn; rope_cs((int)(e >> 7), (int)(e & 127), 128, cs, sn); tab[2 * e] = cs; tab[2 * e + 1] = sn; }
}
__device__ __forceinline__ int row_pos(int row) { return row < MP ? row : PAST + ((row - MP) & 63); }

struct EpiAIn {
    static constexpr int BMODE = 2;
    pg8::bf16_t *Qs, *KP, *VP, *KC, *VC, *GA; float *okp, *ovp, *oks, *ovs; const float* tab; const float* qg; const float* kg; const float* ssq;
    __device__ __forceinline__ void operator()(const pg8::f32x4 (&acc)[2][2][4][2], const pg8::Unit& u, int wr, int wc, int fr, int fq) const {
        { const int l_ = lane_now(); fr = l_ & 15; fq = l_ >> 4; }
        const int pn = u.pn, pm = u.pm, typ = pn >> 3, cl = ((pn & 7) * 4 + wc) * 64 + 8 * fq; float rs[2][4]; row_rstd(ssq, pm, wr, fr, fq, rs);
        float g1[8], g2[8];
        if (typ < 2) { const float* gp = (typ == 0 ? qg : kg) + 8 * fq; const pg8::f32x4 a = *(const pg8::f32x4*)gp, b = *(const pg8::f32x4*)(gp + 4), c = *(const pg8::f32x4*)(gp + 32), d = *(const pg8::f32x4*)(gp + 36);
#pragma unroll
            for (int e = 0; e < 4; ++e) { g1[e] = a[e]; g1[4 + e] = b[e]; g2[e] = c[e]; g2[4 + e] = d[e]; } }
#pragma unroll
        for (int ai = 0; ai < 2; ++ai)
#pragma unroll
          for (int mp = 0; mp < 2; ++mp) {
            pg8::f32x4 tq[4][4];
            if (typ < 2) {
#pragma unroll
                for (int m = 2 * mp; m < 2 * mp + 2; ++m) { const int i_ = ai * 128 + wr * 64 + m * 16 + fr; const int pos_ = pm < 64 ? pm * 256 + i_ : PAST + (i_ & 63); const float* tp_ = tab + ((size_t)pos_ * 32 + 8 * fq) * 2;
#pragma unroll
                    for (int q4 = 0; q4 < 4; ++q4) tq[m][q4] = *(const pg8::f32x4*)(tp_ + 4 * q4); } }
#pragma unroll
            for (int m = 2 * mp; m < 2 * mp + 2; ++m) {
                const int i = ai * 128 + wr * 64 + m * 16 + fr; const size_t row = (size_t)pm * 256 + i;
                float x1[8], x2[8];
#pragma unroll
                for (int e = 0; e < 4; ++e) { x1[e] = acc[ai][0][m][0][e] * rs[ai][m]; x1[4 + e] = acc[ai][0][m][1][e] * rs[ai][m]; x2[e] = acc[ai][1][m][0][e] * rs[ai][m]; x2[4 + e] = acc[ai][1][m][1][e] * rs[ai][m]; }
                size_t drow; pg8::bf16_t* dk; pg8::bf16_t* dv; float* fk; float* fv;
                if (pm < 64) { drow = row; dk = KP; dv = VP; fk = okp + row * DM; fv = ovp + row * DM; }
                else { const int s_ = (int)(row - MP); drow = (size_t)(s_ >> 6) * KCROWS + PAST + (s_ & 63); dk = KC; dv = VC; fk = oks + (size_t)s_ * DM; fv = ovs + (size_t)s_ * DM; }
                if (typ < 2) {
                    float ss = 0.f;
#pragma unroll
                    for (int k = 0; k < 8; ++k) ss += x1[k] * x1[k] + x2[k] * x2[k];
                    ss += __shfl_xor(ss, 16); ss += __shfl_xor(ss, 32);
                    const float rstd = 1.f / sqrtf(ss * (1.f / 64.f) + EPS);
                    float o1[8], o2[8];
#pragma unroll
                    for (int q4 = 0; q4 < 4; ++q4) { const pg8::f32x4 t = tq[m][q4];
#pragma unroll
                        for (int z = 0; z < 2; ++z) { const int k = 2 * q4 + z; const float c = t[2 * z], s = t[2 * z + 1], y1 = x1[k] * rstd * g1[k], y2 = x2[k] * rstd * g2[k]; o1[k] = y1 * c - y2 * s; o2[k] = y2 * c + y1 * s; } }
                    if (typ == 0) { v4u w1, w2;
                        w1.x = pk2(o1[0] * C2, o1[1] * C2); w1.y = pk2(o1[2] * C2, o1[3] * C2); w1.z = pk2(o1[4] * C2, o1[5] * C2); w1.w = pk2(o1[6] * C2, o1[7] * C2);
                        w2.x = pk2(o2[0] * C2, o2[1] * C2); w2.y = pk2(o2[2] * C2, o2[3] * C2); w2.z = pk2(o2[4] * C2, o2[5] * C2); w2.w = pk2(o2[6] * C2, o2[7] * C2);
                        *(v4u*)(Qs + row * DM + cl) = w1; *(v4u*)(Qs + row * DM + cl + 32) = w2;
                    } else { v4u w1, w2;
                        w1.x = pk2(o1[0], o1[1]); w1.y = pk2(o1[2], o1[3]); w1.z = pk2(o1[4], o1[5]); w1.w = pk2(o1[6], o1[7]);
                        w2.x = pk2(o2[0], o2[1]); w2.y = pk2(o2[2], o2[3]); w2.z = pk2(o2[4], o2[5]); w2.w = pk2(o2[6], o2[7]);
                        *(v4u*)(dk + drow * DM + cl) = w1; *(v4u*)(dk + drow * DM + cl + 32) = w2;
                        *(pg8::f32x4*)(fk + cl) = (pg8::f32x4){o1[0], o1[1], o1[2], o1[3]}; *(pg8::f32x4*)(fk + cl + 4) = (pg8::f32x4){o1[4], o1[5], o1[6], o1[7]};
                        *(pg8::f32x4*)(fk + cl + 32) = (pg8::f32x4){o2[0], o2[1], o2[2], o2[3]}; *(pg8::f32x4*)(fk + cl + 36) = (pg8::f32x4){o2[4], o2[5], o2[6], o2[7]}; }
                } else { v4u w1, w2;
                    w1.x = pk2(x1[0], x1[1]); w1.y = pk2(x1[2], x1[3]); w1.z = pk2(x1[4], x1[5]); w1.w = pk2(x1[6], x1[7]);
                    w2.x = pk2(x2[0], x2[1]); w2.y = pk2(x2[2], x2[3]); w2.z = pk2(x2[4], x2[5]); w2.w = pk2(x2[6], x2[7]);
                    if (typ == 2) { *(v4u*)(dv + drow * DM + cl) = w1; *(v4u*)(dv + drow * DM + cl + 32) = w2;
                        *(pg8::f32x4*)(fv + cl) = (pg8::f32x4){x1[0], x1[1], x1[2], x1[3]}; *(pg8::f32x4*)(fv + cl + 4) = (pg8::f32x4){x1[4], x1[5], x1[6], x1[7]};
                        *(pg8::f32x4*)(fv + cl + 32) = (pg8::f32x4){x2[0], x2[1], x2[2], x2[3]}; *(pg8::f32x4*)(fv + cl + 36) = (pg8::f32x4){x2[4], x2[5], x2[6], x2[7]}; }
                    else { *(v4u*)(GA + row * DM + cl) = w1; *(v4u*)(GA + row * DM + cl + 32) = w2; }
                }
                if (m & 1) asm volatile("" ::: "memory");
            }
        }
    }
};
__device__ __forceinline__ void attn_table(Frame& F, float* tab) {
    const size_t gt = (size_t)F.bid * NTHR + F.tid, NG = (size_t)F.G * NTHR;
    for (size_t e = gt; e < (size_t)MP * 32; e += NG) { float c, s; rope_cs((int)(e >> 5), (int)(e & 31), 32, c, s); tab[2 * e] = c; tab[2 * e + 1] = s; }
}
namespace dattn {
typedef short bf16x8 __attribute__((ext_vector_type(8)));
typedef short s16x4 __attribute__((ext_vector_type(4)));
typedef short v4i16_t __attribute__((ext_vector_type(4)));
typedef float f32x16 __attribute__((ext_vector_type(16)));
typedef unsigned u32x4 __attribute__((ext_vector_type(4)));
typedef __attribute__((address_space(3))) const char* lds_cptr;
constexpr int RINGB = 98304, WSF_OFF = RINGB, XCHB = 18432, STP = 144;
__device__ __forceinline__ int crow(int r, int hi) { return (r & 3) + 8 * (r >> 2) + 4 * hi; }
__device__ __forceinline__ void glds16(const void* gsrc, unsigned lds_dst) { unsigned keep;
    asm volatile("s_mov_b32 %0, m0\n\ts_mov_b32 m0, %2\n\ts_nop 0\n\tglobal_load_lds_dwordx4 %1, off\n\ts_mov_b32 m0, %0" : "=&s"(keep) : "v"(gsrc), "s"(lds_dst) : "memory"); }
typedef float f32x2_t __attribute__((ext_vector_type(2))); typedef __bf16 bf16x2_t __attribute__((ext_vector_type(2)));
__device__ __forceinline__ unsigned cvtpk_s(float lo, float hi) { f32x2_t v = {lo, hi}; bf16x2_t b = __builtin_convertvector(v, bf16x2_t); return __builtin_bit_cast(unsigned, b); }
#define DA_WAIT_BAR(N) asm volatile("s_waitcnt vmcnt(" #N ") lgkmcnt(0)\n\ts_barrier" ::: "memory")
__device__ __forceinline__ s16x4 vtr(lds_cptr p) { return __builtin_bit_cast(s16x4, __builtin_amdgcn_ds_read_tr16_b64_v4i16((__attribute__((address_space(3))) v4i16_t*)p)); }
struct Unit { const bf16* Q; const bf16* K; const bf16* V; const bf16* G; bf16* AO; int NT; int full; int dma0; };

constexpr int KSLOT = 16384, VSLOT = 16384, VRING = 3 * KSLOT;
#define DA_SBAR() __builtin_amdgcn_sched_barrier(0)
#define DA_PIN(x) asm volatile("" : "+v"(x))
#define DA_MFMA(a, b, c) __builtin_amdgcn_mfma_f32_32x32x16_bf16(a, b, c, 0, 0, 0)
struct DmaJob { const bf16* kp; const bf16* vp; unsigned kd0, kd1, vd0, vd1; };
__device__ __forceinline__ void dma_piece(const DmaJob& j, int i) { if (i == 0) glds16(j.kp, j.kd0); else if (i == 1) glds16(j.kp + 64, j.kd1); else if (i == 2) glds16(j.vp, j.vd0); else glds16(j.vp + 64, j.vd1); }
template <bool QK, bool PV, int VAR>
__device__ __forceinline__ void step(lds_cptr kpn, lds_cptr vp, const bf16x8 (&qr)[4], bf16x8 (&kf)[8], f32x16 (&o)[4], u32x4 (&pw)[4], float& l_reg, const DmaJob& dj) {
    f32x16 C0 = f32x16{}, C1 = f32x16{};
    s16x4 vlo[4], vhi[4];
    if constexpr (!QK) { dma_piece(dj, 0); dma_piece(dj, 1); dma_piece(dj, 2); dma_piece(dj, 3); }
#define DA_FOFF(f) ((((f) & 3) * 4096) + (((f) >> 2) * 1024))
#pragma unroll
    for (int a = 0; a < 8; ++a) {
        if constexpr (PV) { if (a >= 4) { if (VAR != 4) { vlo[a - 4] = vtr(vp + DA_FOFF(a - 4)); vhi[a - 4] = vtr(vp + DA_FOFF(a - 4) + 512); } else { vlo[a - 4] = s16x4{1, 2, 3, 4}; vhi[a - 4] = s16x4{5, 6, 7, 8}; } DA_SBAR(); } }
        if constexpr (QK) {
            if (a & 1) C1 = (a < 2) ? DA_MFMA(kf[a], qr[a >> 1], f32x16{}) : DA_MFMA(kf[a], qr[a >> 1], C1);
            else       C0 = (a < 2) ? DA_MFMA(kf[a], qr[a >> 1], f32x16{}) : DA_MFMA(kf[a], qr[a >> 1], C0);
            if (a < 4) dma_piece(dj, a);
            DA_SBAR();
        }
    }
    u32x4 pwn[4]; pwn[0] = u32x4{}; pwn[1] = u32x4{}; pwn[2] = u32x4{}; pwn[3] = u32x4{};
    float s0 = 0.f, s1 = 0.f;
#pragma unroll
    for (int p = 0; p < 16; ++p) {
        if constexpr (PV) {
            const bf16x8 vf = (bf16x8){vlo[p & 3][0], vlo[p & 3][1], vlo[p & 3][2], vlo[p & 3][3], vhi[p & 3][0], vhi[p & 3][1], vhi[p & 3][2], vhi[p & 3][3]};
            if (VAR != 3) o[p & 3] = DA_MFMA(__builtin_bit_cast(bf16x8, pw[p >> 2]), vf, o[p & 3]); else { o[p & 3][0] += __builtin_bit_cast(float, (int)vf[0] | ((int)vf[4] << 16)); }
            if (p < 12 && VAR != 4) { vlo[p & 3] = vtr(vp + DA_FOFF(p + 4)); vhi[p & 3] = vtr(vp + DA_FOFF(p + 4) + 512); }
        }
        if constexpr (QK) {
            float e0, e1;
            if (VAR == 2) { if (p < 8) { e0 = C0[2 * p]; e1 = C0[2 * p + 1]; } else { e0 = C1[2 * p - 16]; e1 = C1[2 * p - 15]; } }
            else if (p < 8) { e0 = __builtin_amdgcn_exp2f(C0[2 * p]); e1 = __builtin_amdgcn_exp2f(C0[2 * p + 1]); }
            else       { e0 = __builtin_amdgcn_exp2f(C1[2 * p - 16]); e1 = __builtin_amdgcn_exp2f(C1[2 * p - 15]); }
            s0 += e0; s1 += e1; pwn[p >> 2][p & 3] = cvtpk_s(e0, e1);
            DA_PIN(s0); DA_PIN(s1); DA_PIN(pwn[p >> 2]);
            if (p >= 8 && VAR != 6) { const int j = p - 8; kf[j] = *(const __attribute__((address_space(3))) bf16x8*)(kpn + (j >> 1) * 2048 + (j & 1) * 512); }
        }
        DA_SBAR();
    }
    if constexpr (QK) { l_reg += s0 + s1; pw[0] = pwn[0]; pw[1] = pwn[1]; pw[2] = pwn[2]; pw[3] = pwn[3]; }
#undef DA_FOFF
}

template <int VAR>
__device__ __forceinline__ void attn_unit(const Unit& u, char* shm, float lam, float one_m_li, const float* sub_gain, int tid) {
    asm volatile("" : "+v"(tid));
    const int lane = tid & 63, r32 = lane & 31, hi = lane >> 5; const int wid = __builtin_amdgcn_readfirstlane(tid >> 6), s = wid >> 2, g = wid & 3;
    const int NT = u.NT; const int wt = u.full ? (g < 2 ? NT - 1 : NT) : (g < 2 ? NT : 0);
    const unsigned lds0 = (unsigned)(uintptr_t)shm;
    float* wsf = (float*)(shm + WSF_OFF) + wid * 64;
    const bf16* ksrc = u.K + (long)lane * DM + wid * 8;
    const bf16* vsrc = u.V + (long)(16 * (wid & 3) + (lane >> 2)) * DM + (wid >> 2) * 32 + (lane & 3) * 8;
    const unsigned kdst = lds0 + wid * 1024, vdst = lds0 + VRING + wid * 1024;
#define DA_DMA_K(t, slot) do { const int tt_ = u.dma0 ? 0 : (t) < NT ? (t) : NT - 1; const bf16* kp_ = ksrc + (long)tt_ * 64 * DM; \
        glds16(kp_, (unsigned)__builtin_amdgcn_readfirstlane(kdst + (slot) * KSLOT)); glds16(kp_ + 64, (unsigned)__builtin_amdgcn_readfirstlane(kdst + 8192 + (slot) * KSLOT)); } while (0)
#define DA_DMA_V(t, slot) do { const int tt_ = u.dma0 ? 0 : (t) < NT ? (t) : NT - 1; const bf16* vp_ = vsrc + (long)tt_ * 64 * DM; \
        glds16(vp_, (unsigned)__builtin_amdgcn_readfirstlane(vdst + (slot) * VSLOT)); glds16(vp_ + 64, (unsigned)__builtin_amdgcn_readfirstlane(vdst + 8192 + (slot) * VSLOT)); } while (0)
    const lds_cptr shm3 = (lds_cptr)shm;
    const lds_cptr kp0 = shm3 + s * 8192 + hi * 1024 + r32 * 16;
    const lds_cptr vp0 = shm3 + VRING + ((lane >> 4) & 1) * 32 + (lane & 3) * 8 + (4 * hi + ((lane & 15) >> 2)) * 64;
    DA_DMA_K(0, 0); DA_DMA_K(1, 1); DA_DMA_K(2, 2); DA_DMA_V(0, 0);
    bf16x8 qr[4];
    { const bf16* Qw = u.Q + (long)(32 * g + r32) * DM + s * 64;
#pragma unroll
      for (int d0 = 0; d0 < 4; ++d0) qr[d0] = (wt > 0) ? *reinterpret_cast<const bf16x8*>(Qw + d0 * 16 + hi * 8) : (bf16x8){0, 0, 0, 0, 0, 0, 0, 0}; }
    asm volatile("" : "+v"(qr[0]), "+v"(qr[1]), "+v"(qr[2]), "+v"(qr[3]));
    f32x16 o[4]; o[0] = f32x16{}; o[1] = f32x16{}; o[2] = f32x16{}; o[3] = f32x16{};
    float l_reg = 0.f;
    u32x4 pw[4]; pw[0] = u32x4{}; pw[1] = u32x4{}; pw[2] = u32x4{}; pw[3] = u32x4{};
    DA_WAIT_BAR(0);
    bf16x8 kf[8];
#pragma unroll
    for (int j = 0; j < 8; ++j) kf[j] = *(const __attribute__((address_space(3))) bf16x8*)(kp0 + (j >> 1) * 2048 + (j & 1) * 512);
    int ks_cur = 0  , vs_prev = 2  ;
#define DA_TOP(t) \
        DA_WAIT_BAR(4);                                          \
        const int ks_next = (ks_cur == 2) ? 0 : ks_cur + 1, vs_cur = (vs_prev == 2) ? 0 : vs_prev + 1, vs_next = (vs_cur == 2) ? 0 : vs_cur + 1; \
        DmaJob dj; { const int tk_ = ((t) + 3) < NT ? ((t) + 3) : NT - 1, tv_ = ((t) + 1) < NT ? ((t) + 1) : NT - 1; dj.kp = ksrc + (long)tk_ * 64 * DM; dj.vp = vsrc + (long)tv_ * 64 * DM; \
          dj.kd0 = (unsigned)__builtin_amdgcn_readfirstlane(kdst + ks_cur * KSLOT); dj.kd1 = dj.kd0 + 8192u; dj.vd0 = (unsigned)__builtin_amdgcn_readfirstlane(vdst + vs_next * VSLOT); dj.vd1 = dj.vd0 + 8192u; }     \
        const lds_cptr kpn = kp0 + ks_next * KSLOT; const lds_cptr vp = vp0 + vs_prev * VSLOT; (void)kpn; (void)vp
#define DA_ROT() do { ks_cur = ks_next; vs_prev = vs_cur; } while (0)
    int t = 0;
    { DA_TOP(0); if (wt > 0) step<true, false, VAR>(kpn, vp, qr, kf, o, pw, l_reg, dj); else { dma_piece(dj, 0); dma_piece(dj, 1); dma_piece(dj, 2); dma_piece(dj, 3); } DA_ROT(); t = 1; }
    for (; t < wt; ++t) { DA_TOP(t); step<true, true, VAR>(kpn, vp, qr, kf, o, pw, l_reg, dj); DA_ROT(); }
    if (wt > 0) { DA_TOP(t); step<false, true, VAR>(kpn, vp, qr, kf, o, pw, l_reg, dj); DA_ROT(); ++t; }
    for (; t <= NT; ++t) { DA_TOP(t); dma_piece(dj, 0); dma_piece(dj, 1); dma_piece(dj, 2); dma_piece(dj, 3); DA_ROT(); }
#undef DA_TOP
#undef DA_ROT
    { auto rr = __builtin_amdgcn_permlane32_swap(__float_as_uint(l_reg), __float_as_uint(l_reg), false, false); l_reg = __uint_as_float(rr[0]) + __uint_as_float(rr[1]); }
    if (hi == 0) wsf[r32] = l_reg;
    DA_WAIT_BAR(0);
    float rli[16];
#pragma unroll
    for (int r = 0; r < 16; ++r) { const float lq = wsf[crow(r, hi)]; rli[r] = (s == 0 ? 1.f : -lam) / lq; }
    int le = lane; asm volatile("" : "+v"(le));
    const int r32e = le & 31, hie = le >> 5;
    float* xch = (float*)(shm + g * XCHB);
    if (s == 1 && wt > 0) {
#pragma unroll
        for (int db = 0; db < 4; ++db)
#pragma unroll
            for (int r = 0; r < 16; ++r) xch[(db * 16 + r) * 64 + le] = o[db][r] * rli[r];
    }
    DA_WAIT_BAR(0);
    if (s == 0 && wt > 0) {
#pragma unroll
        for (int db = 0; db < 4; ++db)
#pragma unroll
            for (int r = 0; r < 16; ++r) o[db][r] = o[db][r] * rli[r] + xch[(db * 16 + r) * 64 + le];
        asm volatile("s_waitcnt lgkmcnt(0)" ::: "memory");
#pragma unroll
        for (int db = 0; db < 4; ++db)
#pragma unroll
            for (int r = 0; r < 16; ++r) xch[crow(r, hie) * STP + 32 * db + r32e] = o[db][r];
        asm volatile("s_waitcnt lgkmcnt(0)" ::: "memory");
        const int row = le >> 1, half = le & 1;
        float v[64]; float ss = 0.f;
#pragma unroll
        for (int k = 0; k < 16; ++k) { const f32x4 x = *(const f32x4*)(xch + row * STP + half * 64 + 4 * k); v[4 * k] = x.x; v[4 * k + 1] = x.y; v[4 * k + 2] = x.z; v[4 * k + 3] = x.w; ss += (x.x * x.x + x.y * x.y) + (x.z * x.z + x.w * x.w); }
        ss += __shfl_xor(ss, 1);
        const float sc = one_m_li / sqrtf(ss * (1.f / 128.f) + EPS);
        const bf16* gp = u.G + (long)(32 * g + row) * DM + half * 64; bf16* op = u.AO + (long)(32 * g + row) * DM + half * 64; const float* sg = sub_gain + half * 64;
#pragma unroll
        for (int k = 0; k < 8; ++k) { const v4u g4 = *(const v4u*)(gp + 8 * k); const f32x4 ga = *(const f32x4*)(sg + 8 * k), gb = *(const f32x4*)(sg + 8 * k + 4);
            const float gg[8] = {bflo(g4.x), bfhi(g4.x), bflo(g4.y), bfhi(g4.y), bflo(g4.z), bfhi(g4.z), bflo(g4.w), bfhi(g4.w)};
            const float gn[8] = {ga.x, ga.y, ga.z, ga.w, gb.x, gb.y, gb.z, gb.w}; float y[8];
#pragma unroll
            for (int e = 0; e < 8; ++e) y[e] = v[8 * k + e] * sc * gn[e] * silu_f(gg[e]);
            v4u w; w.x = pk2(y[0], y[1]); w.y = pk2(y[2], y[3]); w.z = pk2(y[4], y[5]); w.w = pk2(y[6], y[7]);
            *(v4u*)(op + 8 * k) = w; }
    }
    DA_WAIT_BAR(0);
#undef DA_DMA_K
#undef DA_DMA_V
}
}
template <int VAR = 0>
__device__ __forceinline__ void attn_fast(Frame& F, const bf16* Qs, const bf16* KP, const bf16* VP, const bf16* KC, const bf16* VC, const bf16* GA  , bf16* AO,
                                          float lam, float one_m_li, const float* sub_gain, int dma0 = 0) {
    const int NU = 2048 + 16 * NB;
    const bool xcd = (F.G == 256);
    for (int i = 0;; ++i) {
        int qb, h, b = -1;
        if (xcd) { const int x = F.bid & 7, r = F.bid >> 3;
            if (i < 8) { h = x + 8 * (i >> 2); const int rr = (i == 0) ? (r ^ 8) : r; qb = 127 - ((i & 3) * 32 + ((i & 1) ? 31 - rr : rr)); }
            else if (i == 8 && (r & 8) == 0) { const int sb = (r & 7) + ((r >> 4) << 3); h = x + 8 * (sb >> 3); b = sb & 7; qb = 0; }
            else break;
        } else { const int idx = i * F.G + ((i & 1) ? F.G - 1 - F.bid : F.bid); if (idx >= NU) break;
            if (idx < 2048) { qb = 127 - (idx >> 4); h = idx & 15; } else { const int j = idx - 2048; b = j >> 4; h = j & 15; qb = 0; } }
        dattn::Unit u; u.dma0 = dma0;
        if (b < 0) { const long row0 = 128L * qb;
            u.Q = Qs + row0 * DM + h * 128; u.K = KP + h * 128; u.V = VP + h * 128; u.G = GA + row0 * DM + h * 128; u.AO = AO + row0 * DM + h * 128; u.NT = 2 * qb + 2; u.full = 1; }
        else { const long row0 = MP + 64L * b;
            u.Q = Qs + row0 * DM + h * 128; u.K = KC + (long)b * KCROWS * DM + h * 128; u.V = VC + (long)b * KCROWS * DM + h * 128; u.G = GA + row0 * DM + h * 128; u.AO = AO + row0 * DM + h * 128; u.NT = KCROWS / 64; u.full = 0; }
        dattn::attn_unit<VAR>(u, (char*)F.lds + RING_OFF, lam, one_m_li, sub_gain, F.tid);
    }
}
constexpr int RBLK = 72;
__device__ __forceinline__ float ret_lg2(int h) { return log2f(1.f - exp2f(-5.f - (float)h)); }
struct EpiRet {
    static constexpr int BMODE = 0;
    pg8::bf16_t* QP; pg8::bf16_t* KN; pg8::bf16_t* KT; pg8::bf16_t* VS; pg8::bf16_t* RG; const float* tab; const float* ssq;
    __device__ __forceinline__ void operator()(const pg8::f32x4 (&acc)[2][2][4][2], const pg8::Unit& u, int wr, int wc, int fr, int fq) const {
        { const int l_ = lane_now(); fr = l_ & 15; fq = l_ >> 4; }
        const int pn = u.pn, pm = u.pm; float rs[2][4]; row_rstd(ssq, pm, wr, fr, fq, rs);
#pragma unroll
        for (int ai = 0; ai < 2; ++ai)
#pragma unroll
            for (int m = 0; m < 4; ++m) {
                const int i = ai * 128 + wr * 64 + m * 16 + fr; const size_t row = (size_t)pm * 256 + i;
                const int J = pm < 64 ? pm : 64 + 4 * (pm - 64) + (i >> 6), jj = pm < 64 ? i : (i & 63), pos = pm < 64 ? (int)row : PAST + (i & 63);
                if (pn < 16) {
                    const int h = pn & 7; const bool isk = pn >= 8; const float sc = isk ? 0.0625f : 1.f;
#pragma unroll
                    for (int n = 0; n < 2; ++n) { const int c1 = wc * 32 + n * 16 + 4 * fq;
                        const pg8::f32x4 t0 = *(const pg8::f32x4*)(tab + ((size_t)pos * 128 + c1) * 2), t1 = *(const pg8::f32x4*)(tab + ((size_t)pos * 128 + c1) * 2 + 4);
                        const pg8::f32x4 x1 = acc[ai][0][m][n] * rs[ai][m], x2 = acc[ai][1][m][n] * rs[ai][m];
                        const float cs[4] = {t0[0], t0[2], t1[0], t1[2]}, sn[4] = {t0[1], t0[3], t1[1], t1[3]}; float o1[4], o2[4];
#pragma unroll
                        for (int e = 0; e < 4; ++e) { o1[e] = (x1[e] * cs[e] - x2[e] * sn[e]) * sc; o2[e] = (x2[e] * cs[e] + x1[e] * sn[e]) * sc; }
                        v2u w1, w2; w1.x = pk2(o1[0], o1[1]); w1.y = pk2(o1[2], o1[3]); w2.x = pk2(o2[0], o2[1]); w2.y = pk2(o2[2], o2[3]);
                        if (!isk) { pg8::bf16_t* p = QP + row * 4096 + h * 512 + 256 + c1; *(v2u*)p = w1; *(v2u*)(p + 128) = w2; }
                        else { pg8::bf16_t* p = KN + row * 2048 + h * 256 + c1; *(v2u*)p = w1; *(v2u*)(p + 128) = w2;
                            pg8::bf16_t* t = KT + ((size_t)(J * 8 + h) * 256 + c1) * 256 + jj;
#pragma unroll
                            for (int e = 0; e < 4; ++e) { t[(size_t)e * 256] = (pg8::bf16_t)f2bf(o1[e]); t[(size_t)(128 + e) * 256] = (pg8::bf16_t)f2bf(o2[e]); } } }
                } else if (pn < 32) {
                    const int h = (pn - 16) >> 1, half = (pn - 16) & 1; const float f = exp2f(-(float)(1 + jj) * ret_lg2(h)) * rs[ai][m];
#pragma unroll
                    for (int bj = 0; bj < 2; ++bj)
#pragma unroll
                        for (int n = 0; n < 2; ++n) { const int dv = half * 256 + bj * 128 + wc * 32 + n * 16 + 4 * fq; pg8::bf16_t* t = VS + ((size_t)(J * 8 + h) * 512 + dv) * 512 + jj;
#pragma unroll
                            for (int e = 0; e < 4; ++e) t[(size_t)e * 512] = (pg8::bf16_t)f2bf(acc[ai][bj][m][n][e] * f); }
                } else {
#pragma unroll
                    for (int bj = 0; bj < 2; ++bj)
#pragma unroll
                        for (int n = 0; n < 2; ++n) { const int c = (pn - 32) * 256 + bj * 128 + wc * 32 + n * 16 + 4 * fq; const pg8::f32x4 x = acc[ai][bj][m][n] * rs[ai][m];
                            v2u w; w.x = pk2(x[0], x[1]); w.y = pk2(x[2], x[3]); *(v2u*)(RG + row * 4096 + c) = w; }
                }
            }
    }
};
__device__ __forceinline__ size_t ret_row0(int J) { return J < 64 ? (size_t)256 * J : (size_t)MP + 64 * (J - 64); }
struct RetQKOrder {
    int G, c; const char* QP; const char* KN;
    __device__ __forceinline__ bool next(int i, pg8::Unit& u) const { const int L = i * G + c; if (L >= RBLK * 8) return false; const int J = L >> 3, h = L & 7; const size_t r0 = ret_row0(J);
        u.pm = J; u.pn = h; u.a = QP + (r0 * 4096 + h * 512 + 256) * 2; u.b = KN + (r0 * 2048 + h * 256) * 2; return true; }
    __device__ __forceinline__ void a_ready(const pg8::Unit&) const {}
    __device__ __forceinline__ void done(const pg8::Unit&) const {}
};
struct EpiRetQK {
    static constexpr int BMODE = 1;
    pg8::bf16_t* QP;
    __device__ __forceinline__ void operator()(const pg8::f32x4 (&acc)[2][2][4][2], const pg8::Unit& u, int wr, int wc, int fr, int fq) const {
        { const int l_ = lane_now(); fr = l_ & 15; fq = l_ >> 4; }
        const int J = u.pm, h = u.pn, nv = J < 64 ? 256 : 64; const size_t r0 = ret_row0(J);
#pragma unroll
        for (int ai = 0; ai < 2; ++ai)
#pragma unroll
            for (int m = 0; m < 4; ++m) { const int i = ai * 128 + wr * 64 + m * 16 + fr;
                if (i < nv) {
#pragma unroll
                    for (int bj = 0; bj < 2; ++bj) { const int j0 = bj * 128 + wc * 32 + 8 * fq; const pg8::f32x4 v0 = acc[ai][bj][m][0], v1 = acc[ai][bj][m][1]; float x[8] = {v0[0], v0[1], v0[2], v0[3], v1[0], v1[1], v1[2], v1[3]};
#pragma unroll
                        for (int k = 0; k < 8; ++k) x[k] = (j0 + k <= i) ? x[k] : 0.f;
                        v4u w; w.x = pk2(x[0], x[1]); w.y = pk2(x[2], x[3]); w.z = pk2(x[4], x[5]); w.w = pk2(x[6], x[7]);
                        *(v4u*)(QP + (r0 + i) * 4096 + h * 512 + j0) = w; } } }
    }
};
struct RetOOrder {
    int G, c; const char* QP; const char* VS;
    __device__ __forceinline__ bool next(int i, pg8::Unit& u) const { const int L = i * G + c; if (L >= RBLK * 16) return false; const int J = L >> 4, r = L & 15, h = r >> 1, half = r & 1; const size_t r0 = ret_row0(J);
        u.pm = J; u.pn = r; u.a = QP + (r0 * 4096 + h * 512) * 2; u.b = VS + (((size_t)(J * 8 + h) * 512 + half * 256) * 512) * 2; return true; }
    __device__ __forceinline__ void a_ready(const pg8::Unit&) const {}
    __device__ __forceinline__ void done(const pg8::Unit&) const {}
};
struct EpiRetO {
    static constexpr int BMODE = 1;
    pg8::bf16_t* O;
    __device__ __forceinline__ void operator()(const pg8::f32x4 (&acc)[2][2][4][2], const pg8::Unit& u, int wr, int wc, int fr, int fq) const {
        { const int l_ = lane_now(); fr = l_ & 15; fq = l_ >> 4; }
        const int J = u.pm, h = u.pn >> 1, half = u.pn & 1, nv = J < 64 ? 256 : 64; const size_t r0 = ret_row0(J); const float lg = ret_lg2(h);
#pragma unroll
        for (int ai = 0; ai < 2; ++ai)
#pragma unroll
            for (int m = 0; m < 4; ++m) { const int i = ai * 128 + wr * 64 + m * 16 + fr;
                if (i < nv) { const float f = exp2f((float)(i + 1) * lg);
#pragma unroll
                    for (int bj = 0; bj < 2; ++bj) { const int j0 = bj * 128 + wc * 32 + 8 * fq; const pg8::f32x4 v0 = acc[ai][bj][m][0] * f, v1 = acc[ai][bj][m][1] * f;
                        v4u w; w.x = pk2(v0[0], v0[1]); w.y = pk2(v0[2], v0[3]); w.z = pk2(v1[0], v1[1]); w.w = pk2(v1[2], v1[3]);
                        *(v4u*)(O + (r0 + i) * 4096 + h * 512 + half * 256 + j0) = w; } } }
    }
};
struct RetKVOrder {
    int G, c; const char* VS; const char* KT;
    __device__ __forceinline__ bool next(int i, pg8::Unit& u) const { const int L = i * G + c; if (L >= RBLK * 16) return false; const int J = L >> 4, r = L & 15, h = r >> 1, half = r & 1;
        u.pm = J; u.pn = r; u.a = VS + (((size_t)(J * 8 + h) * 512 + half * 256) * 512) * 2; u.b = KT + ((size_t)(J * 8 + h) * 256 * 256) * 2; return true; }
    __device__ __forceinline__ void a_ready(const pg8::Unit&) const {}
    __device__ __forceinline__ void done(const pg8::Unit&) const {}
};
struct EpiRetKV {
    static constexpr int BMODE = 1;
    pg8::bf16_t* VS; pg8::bf16_t* KVX;
    __device__ __forceinline__ void operator()(const pg8::f32x4 (&acc)[2][2][4][2], const pg8::Unit& u, int wr, int wc, int fr, int fq) const {
        { const int l_ = lane_now(); fr = l_ & 15; fq = l_ >> 4; }
        const int J = u.pm, h = u.pn >> 1, half = u.pn & 1;
        pg8::bf16_t* base; int pitch;
        if (J < 63) { base = VS + ((size_t)((J + 1) * 8 + h) * 512 + half * 256) * 512 + 256; pitch = 512; }
        else { base = KVX + ((size_t)((J - 63) * 8 + h) * 512 + half * 256) * 256; pitch = 256; }
#pragma unroll
        for (int ai = 0; ai < 2; ++ai)
#pragma unroll
            for (int m = 0; m < 4; ++m) { pg8::bf16_t* rowp = base + (size_t)(ai * 128 + wr * 64 + m * 16 + fr) * pitch + wc * 32 + 8 * fq;
#pragma unroll
                for (int bj = 0; bj < 2; ++bj) { const pg8::f32x4 v0 = acc[ai][bj][m][0], v1 = acc[ai][bj][m][1];
                    v4u w; w.x = pk2(v0[0], v0[1]); w.y = pk2(v0[2], v0[3]); w.z = pk2(v1[0], v1[1]); w.w = pk2(v1[2], v1[3]);
                    *(v4u*)(rowp + bj * 128) = w; } }
    }
};
__device__ __forceinline__ void ret_scan(Frame& F, bf16* VS, const bf16* KVX, const float* state_in, float* osp, float* oss) {
    const int gt = F.bid * NTHR + F.tid;
    for (int c = gt; c < 8 * 512 * 32; c += F.G * NTHR) {
        const int h = c >> 14, dv = (c >> 5) & 511, dk0 = (c & 31) * 8; const float lg = ret_lg2(h), g256 = exp2f(256.f * lg), g64 = exp2f(64.f * lg);
        float S[8];
#pragma unroll
        for (int k = 0; k < 8; ++k) S[k] = 0.f;
        bf16* slot = VS + ((size_t)h * 512 + dv) * 512 + 256 + dk0;
        *(v4u*)slot = (v4u){0u, 0u, 0u, 0u};
        v4u nx = *(const v4u*)(slot + (size_t)8 * 512 * 512);
        for (int J = 1; J < 64; ++J) {
            const v4u kv = nx; bf16* sj = slot + (size_t)J * 8 * 512 * 512;
            if (J < 63) nx = *(const v4u*)(sj + (size_t)8 * 512 * 512);
            const float x[8] = {bflo(kv.x), bfhi(kv.x), bflo(kv.y), bfhi(kv.y), bflo(kv.z), bfhi(kv.z), bflo(kv.w), bfhi(kv.w)};
#pragma unroll
            for (int k = 0; k < 8; ++k) S[k] = (S[k] + x[k]) * g256;
            v4u w; w.x = pk2(S[0], S[1]); w.y = pk2(S[2], S[3]); w.z = pk2(S[4], S[5]); w.w = pk2(S[6], S[7]);
            *(v4u*)sj = w;
        }
        { const v4u kv = *(const v4u*)(KVX + ((size_t)h * 512 + dv) * 256 + dk0);
          const float x[8] = {bflo(kv.x), bfhi(kv.x), bflo(kv.y), bfhi(kv.y), bflo(kv.z), bfhi(kv.z), bflo(kv.w), bfhi(kv.w)};
#pragma unroll
          for (int k = 0; k < 8; ++k) osp[((size_t)h * 256 + dk0 + k) * 512 + dv] = (S[k] + x[k]) * g256; }
    }
    for (int c = gt; c < NB * 8 * 512 * 32; c += F.G * NTHR) {
        const int dv = c & 511, dk0 = ((c >> 9) & 31) * 8, h = (c >> 14) & 7, b = c >> 17; const float g64 = exp2f(64.f * ret_lg2(h));
        const float* si = state_in + (((size_t)b * 8 + h) * 256 + dk0) * 512 + dv; float* so = oss + (((size_t)b * 8 + h) * 256 + dk0) * 512 + dv;
        const v4u kv = *(const v4u*)(KVX + ((size_t)((1 + b) * 8 + h) * 512 + dv) * 256 + dk0);
        const float x[8] = {bflo(kv.x), bfhi(kv.x), bflo(kv.y), bfhi(kv.y), bflo(kv.z), bfhi(kv.z), bflo(kv.w), bfhi(kv.w)}; float s0[8];
#pragma unroll
        for (int k = 0; k < 8; ++k) s0[k] = si[(size_t)k * 512];
        v4u w; w.x = pk2(s0[0], s0[1]); w.y = pk2(s0[2], s0[3]); w.z = pk2(s0[4], s0[5]); w.w = pk2(s0[6], s0[7]);
        *(v4u*)(VS + ((size_t)((64 + b) * 8 + h) * 512 + dv) * 512 + 256 + dk0) = w;
#pragma unroll
        for (int k = 0; k < 8; ++k) so[(size_t)k * 512] = (s0[k] + x[k]) * g64;
    }
}
__device__ __forceinline__ void ret_zero_pad(Frame& F, bf16* VS, bf16* KT) {
    const size_t gt = (size_t)F.bid * NTHR + F.tid, NG = (size_t)F.G * NTHR, n = (size_t)NB * 8 * 512 * 24, n2 = (size_t)NB * 8 * 256 * 24;
    for (size_t i = gt; i < n; i += NG) { const size_t rowi = i / 24, c = i % 24; *(v4u*)(VS + ((size_t)64 * 8 * 512 + rowi) * 512 + 64 + c * 8) = (v4u){0u, 0u, 0u, 0u}; }
    for (size_t i = gt; i < n2; i += NG) { const size_t rowi = i / 24, c = i % 24; *(v4u*)(KT + ((size_t)64 * 8 * 256 + rowi) * 256 + 64 + c * 8) = (v4u){0u, 0u, 0u, 0u}; }
}
__device__ __forceinline__ void ret_table(Frame& F, float* tab) {
    const size_t gt = (size_t)F.bid * NTHR + F.tid, NG = (size_t)F.G * NTHR;
    for (size_t e = gt; e < (size_t)MP * 128; e += NG) { float c, s; rope_cs((int)(e >> 7), (int)(e & 127), 128, c, s); tab[2 * e] = c; tab[2 * e + 1] = s; }
}
__device__ __forceinline__ void r_out(Frame& F, bf16* O, const bf16* RG) {
    const int gw = F.bid * NWAVES + F.wave, NGW = F.G * NWAVES, lane = F.lane;
    for (int it = gw; it < MT * 8; it += NGW) {
        const int row = it >> 3, h = it & 7; const size_t off = (size_t)row * 4096 + h * 512 + lane * 8;
        const v4u o4 = *(const v4u*)(O + off), g4 = *(const v4u*)(RG + off);
        float o[8] = {bflo(o4.x), bfhi(o4.x), bflo(o4.y), bfhi(o4.y), bflo(o4.z), bfhi(o4.z), bflo(o4.w), bfhi(o4.w)};
        const float g[8] = {bflo(g4.x), bfhi(g4.x), bflo(g4.y), bfhi(g4.y), bflo(g4.z), bfhi(g4.z), bflo(g4.w), bfhi(g4.w)};
        float ss = 0.f;
#pragma unroll
        for (int k = 0; k < 8; ++k) ss += o[k] * o[k];
        const float rstd = 1.f / sqrtf(wave_sum(ss) * (1.f / 512.f) + EPS);
#pragma unroll
        for (int k = 0; k < 8; ++k) o[k] = o[k] * rstd * silu_f(g[k]);
        v4u w; w.x = pk2(o[0], o[1]); w.y = pk2(o[2], o[3]); w.z = pk2(o[4], o[5]); w.w = pk2(o[6], o[7]);
        *(v4u*)(O + off) = w;
    }
}
struct EpiCIn {
    static constexpr int BMODE = 0;
    pg8::bf16_t* GU; pg8::bf16_t* GVT; pg8::bf16_t* SG; pg8::bf16_t* GVS; float* SSQ; const float* ssq;
    __device__ __forceinline__ void operator()(const pg8::f32x4 (&acc)[2][2][4][2], const pg8::Unit& u, int wr, int wc, int fr, int fq) const {
        { const int l_ = lane_now(); fr = l_ & 15; fq = l_ >> 4; }
        const int pn = u.pn, pm = u.pm, typ = pn >> 4, pt = pn & 15; float rs[2][4]; row_rstd(ssq, pm, wr, fr, fq, rs);
#pragma unroll
        for (int ai = 0; ai < 2; ++ai)
#pragma unroll
            for (int m = 0; m < 4; ++m) {
                const int i = ai * 128 + wr * 64 + m * 16 + fr; const size_t row = (size_t)pm * 256 + i; float ss = 0.f;
#pragma unroll
                for (int bj = 0; bj < 2; ++bj)
#pragma unroll
                    for (int n = 0; n < 2; ++n) { const int c = pt * 256 + bj * 128 + wc * 32 + n * 16 + 4 * fq; const pg8::f32x4 x = acc[ai][bj][m][n] * rs[ai][m]; float y[4];
                        if (typ == 2) {
#pragma unroll
                            for (int e = 0; e < 4; ++e) y[e] = silu_f(x[e]);
                            v2u w; w.x = pk2(y[0], y[1]); w.y = pk2(y[2], y[3]); *(v2u*)(SG + row * 4096 + c) = w;
                        } else {
#pragma unroll
                            for (int e = 0; e < 4; ++e) y[e] = gelu_tanh_f(x[e]);
                            v2u w; w.x = pk2(y[0], y[1]); w.y = pk2(y[2], y[3]);
                            if (typ == 0) *(v2u*)(GU + row * 4096 + c) = w;
                            else { ss += (y[0] * y[0] + y[1] * y[1]) + (y[2] * y[2] + y[3] * y[3]);
                                pg8::bf16_t* t = GVT + ((size_t)pm * 4096 + c) * 256 + i;
                                t[0] = (pg8::bf16_t)(w.x & 0xffffu); t[256] = (pg8::bf16_t)(w.x >> 16); t[512] = (pg8::bf16_t)(w.y & 0xffffu); t[768] = (pg8::bf16_t)(w.y >> 16);
                                if (pm >= 64) *(v2u*)(GVS + (row - MP) * 4096 + c) = w; } } }
                if (typ == 1) { ss += __shfl_xor(ss, 16); ss += __shfl_xor(ss, 32); if (fq == 0) SSQ[row * 64 + pt * 4 + wc] = ss; }
                if (m & 1) asm volatile("" ::: "memory");
            }
    }
};
__device__ __forceinline__ void c_prep(Frame& F, const float* SSQ, const float* wsin, const float* vgain, const bf16* GVS, bf16* Wm, float* ovm) {
    LAS float* rs = (LAS float*)(F.lds + RING_OFF);
    const int tid = F.tid;
    for (int it = F.bid; it < 66 * 8; it += F.G) {
        const int J = it >> 3, g = it & 7;
        __syncthreads();
        if (tid < 256) { const float* p = SSQ + ((size_t)J * 256 + tid) * 64; float s = 0.f;
#pragma unroll
            for (int k = 0; k < 16; ++k) { const f32x4 x = *(const f32x4*)(p + 4 * k); s += (x.x + x.y) + (x.z + x.w); }
            rs[tid] = 1.f / sqrtf(s * (1.f / 4096.f) + EPS); }
        __syncthreads();
        bf16* wm = Wm + (size_t)(J * 8 + g) * 65536; const int sh = J < 64 ? 7 : 6, cm = (1 << sh) - 1;
        for (int e8 = tid; e8 < 8192; e8 += NTHR) { const int i = e8 >> 5, j0 = (e8 & 31) * 8, il = i & cm, jl0 = j0 & cm; float y[8];
            if ((i >> sh) == (j0 >> sh) && jl0 <= il) { const float* wr_ = wsin + ((size_t)g * 128 + il) * 128 + jl0; const f32x4 a = *(const f32x4*)wr_, b = *(const f32x4*)(wr_ + 4);
                const float wv[8] = {a.x, a.y, a.z, a.w, b.x, b.y, b.z, b.w};
#pragma unroll
                for (int k = 0; k < 8; ++k) y[k] = (jl0 + k <= il) ? wv[k] * rs[j0 + k] : 0.f;
            } else {
#pragma unroll
                for (int k = 0; k < 8; ++k) y[k] = 0.f; }
            v4u w; w.x = pk2(y[0], y[1]); w.y = pk2(y[2], y[3]); w.z = pk2(y[4], y[5]); w.w = pk2(y[6], y[7]);
            *(v4u*)(wm + i * 256 + j0) = w; }
    }
    const int gw = F.bid * NWAVES + F.wave, NGW = F.G * NWAVES, lane = F.lane;
    for (int r = gw; r < MS; r += NGW) {
        const float rstd = 1.f / sqrtf(wave_sum(SSQ[((size_t)MP + r) * 64 + lane]) * (1.f / 4096.f) + EPS);
#pragma unroll
        for (int k = 0; k < 8; ++k) { const int col = k * 512 + lane * 8; const v4u v4 = *(const v4u*)(GVS + (size_t)r * 4096 + col);
            const f32x4 ga = *(const f32x4*)(vgain + col), gb = *(const f32x4*)(vgain + col + 4);
            float* o = ovm + (size_t)r * 4096 + col;
            *(f32x4*)o = (f32x4){bflo(v4.x) * rstd * ga.x, bfhi(v4.x) * rstd * ga.y, bflo(v4.y) * rstd * ga.z, bfhi(v4.y) * rstd * ga.w};
            *(f32x4*)(o + 4) = (f32x4){bflo(v4.z) * rstd * gb.x, bfhi(v4.z) * rstd * gb.y, bflo(v4.w) * rstd * gb.z, bfhi(v4.w) * rstd * gb.w}; }
    }
}
struct CMixOrder {
    int G, c; const char* Wm; const char* GVT;
    __device__ __forceinline__ bool next(int i, pg8::Unit& u) const { const int L = i * G + c; if (L >= 66 * 16) return false; const int J = L >> 4, nt = L & 15;
        u.pm = J; u.pn = nt; u.a = Wm + ((size_t)(J * 8 + (nt >> 1)) * 65536) * 2; u.b = GVT + (((size_t)J * 4096 + nt * 256) * 256) * 2; return true; }
    __device__ __forceinline__ void a_ready(const pg8::Unit&) const {}
    __device__ __forceinline__ void done(const pg8::Unit&) const {}
};
struct EpiCMix {
    static constexpr int BMODE = 1;
    pg8::bf16_t* GU; const pg8::bf16_t* SG; const float* vgain; const float* bs;
    __device__ __forceinline__ void operator()(const pg8::f32x4 (&acc)[2][2][4][2], const pg8::Unit& u, int wr, int wc, int fr, int fq) const {
        { const int l_ = lane_now(); fr = l_ & 15; fq = l_ >> 4; }
        const int J = u.pm, nt = u.pn, g = nt >> 1, cm = J < 64 ? 127 : 63;
#pragma unroll
        for (int bj = 0; bj < 2; ++bj) { const int c0 = nt * 256 + bj * 128 + wc * 32 + 8 * fq; const f32x4 ga = *(const f32x4*)(vgain + c0), gb = *(const f32x4*)(vgain + c0 + 4);
            const float gn[8] = {ga.x, ga.y, ga.z, ga.w, gb.x, gb.y, gb.z, gb.w};
#pragma unroll
            for (int ai = 0; ai < 2; ++ai)
#pragma unroll
                for (int m = 0; m < 4; ++m) { const int i = ai * 128 + wr * 64 + m * 16 + fr; const size_t off = ((size_t)J * 256 + i) * 4096 + c0; const float b = bs[g * 128 + (i & cm)];
                    const v4u u4 = *(const v4u*)(GU + off), s4 = *(const v4u*)(SG + off); const pg8::f32x4 v0 = acc[ai][bj][m][0], v1 = acc[ai][bj][m][1];
                    const float mx[8] = {v0[0], v0[1], v0[2], v0[3], v1[0], v1[1], v1[2], v1[3]};
                    const float uu[8] = {bflo(u4.x), bfhi(u4.x), bflo(u4.y), bfhi(u4.y), bflo(u4.z), bfhi(u4.z), bflo(u4.w), bfhi(u4.w)};
                    const float sg[8] = {bflo(s4.x), bfhi(s4.x), bflo(s4.y), bfhi(s4.y), bflo(s4.z), bfhi(s4.z), bflo(s4.w), bfhi(s4.w)}; float y[8];
#pragma unroll
                    for (int k = 0; k < 8; ++k) y[k] = uu[k] * (mx[k] * gn[k] + b) * sg[k];
                    v4u w; w.x = pk2(y[0], y[1]); w.y = pk2(y[2], y[3]); w.z = pk2(y[4], y[5]); w.w = pk2(y[6], y[7]);
                    *(v4u*)(GU + off) = w; } }
    }
};
__device__ __forceinline__ float diff_lambda(const float* q1, const float* k1, const float* q2, const float* k2, float lam_init) {
    float a = 0.f, b = 0.f;
    for (int i = 0; i < 64; ++i) { a += q1[i] * k1[i]; b += q2[i] * k2[i]; }
    return expf(a) - expf(b) + lam_init;
}

constexpr int N_PHASES = 21;
__global__ void __launch_bounds__(NTHR, 2) mega(Args args) {
    extern __shared__ __attribute__((aligned(16))) unsigned char lds[];
    Frame F;
    F.lds = (LAS unsigned char*)lds; F.tid = threadIdx.x; F.lane = F.tid & 63; F.wave = __builtin_amdgcn_readfirstlane(F.tid >> 6); F.G = gridDim.x; F.bid = blockIdx.x;
    F.in = args.in; F.out = args.out; F.ws = args.ws;
    unsigned char* ws = args.ws; float* out = args.out;
    bf16* W_AIN[2] = {(bf16*)(ws + WS_WAIN0), (bf16*)(ws + WS_WAIN1)}; bf16* W_AOUT[2] = {(bf16*)(ws + WS_WAOUT0), (bf16*)(ws + WS_WAOUT1)};
    bf16* W_RIN = (bf16*)(ws + WS_WRIN); bf16* W_ROUT = (bf16*)(ws + WS_WROUT); bf16* W_CIN = (bf16*)(ws + WS_WCIN); bf16* W_COUT = (bf16*)(ws + WS_WCOUT);
    bf16* XN0 = (bf16*)(ws + WS_XN0); bf16* HB = (bf16*)(ws + WS_HB); float* SSQ2 = (float*)(ws + WS_SSQ2);
    bf16* Qs = (bf16*)(ws + WS_QS); bf16* KP = (bf16*)(ws + WS_KP); bf16* VP = (bf16*)(ws + WS_VP); bf16* KC = (bf16*)(ws + WS_KC); bf16* VC = (bf16*)(ws + WS_VC); bf16* AO_A = (bf16*)(ws + WS_AOA);
    bf16* KT = (bf16*)(ws + WS_KT); bf16* RG = (bf16*)(ws + WS_RG); bf16* QP = (bf16*)(ws + WS_QP); bf16* KN = (bf16*)(ws + WS_KN); bf16* VS = (bf16*)(ws + WS_VS); bf16* ORET = (bf16*)(ws + WS_ORET);
    bf16* GU = (bf16*)(ws + WS_GU); bf16* SG = (bf16*)(ws + WS_SG); bf16* GVT = (bf16*)(ws + WS_GVT); bf16* WM = (bf16*)(ws + WS_WM); float* SSQ = (float*)(ws + WS_SSQ); bf16* GVS = (bf16*)(ws + WS_GVS); float* TABR = (float*)(ws + WS_TABR); bf16* KVX = (bf16*)(ws + WS_KVX); float* TABA = (float*)(ws + WS_TABA); bf16* GA = (bf16*)(ws + WS_GA);
    const int lo = args.ph_lo, hi = args.ph_hi;
    volatile LAS unsigned* MISC = (volatile LAS unsigned*)(F.lds + MISC_OFF);
    for (int u = F.tid; u < (LDS_BYTES - MISC_OFF) / 4; u += NTHR) ((LAS unsigned*)(F.lds + MISC_OFF))[u] = 0u;
    __syncthreads();
    XcdBarrier bar = xcd_barrier_post((unsigned*)(ws + WS_CTL) + 4096, MISC + 8);
#define IN(k) (lo <= (k) && (k) < hi)
#define PH_ENTER() do { int t_ = F.wave * 64 + lane_now(); F.tid = t_; F.lane = t_ & 63; } while (0)
    volatile LAS int* DRW = (volatile LAS int*)(F.lds + MISC_OFF + 64);
    unsigned* DCTR = (unsigned*)(ws + WS_CTL) + 8192;
#define DRAIN(ph, total, BODY) do { PH_ENTER(); for (;;) { __syncthreads(); if (F.tid == 0) DRW[0] = (int)atomicAdd(DCTR + 64 * (ph), 1u); __syncthreads(); const int c_ = DRW[0]; if (c_ >= (total)) break; BODY } } while (0)
#define SEAM(k) do { if (IN(k) && IN((k) + 1)) xcd_barrier(bar, F.wave == 0 && lane_now() == 0); } while (0)

#define GEMM_STORE(Aptr, Wptr, NN, KK, Optr) do { pg8::GemmP g{KK, KK, (KK) / 64}; pg8::StaticOrder S; S.init(MT / 256, (NN) / 256, F.G, F.bid, Aptr, Wptr, KK, KK); pg8::EpiStoreBf16 E{(pg8::bf16_t*)(Optr), NN}; \
        pg8::gemm_phase<pg8::EpiStoreBf16, pg8::StaticOrder>(F.lds + RING_OFF, g, S, E, F.tid); } while (0)
#define GEMM_RESIDB(MODE_, Aptr, Wptr, KK) do { pg8::GemmP g{KK, KK, (KK) / 64}; pg8::StaticOrder S; S.init(MT / 256, DM / 256, F.G, F.bid, Aptr, Wptr, KK, KK); \
        pg8::EpiResidB<MODE_> E{args.in[I_XP], args.in[I_XS], (pg8::bf16_t*)HB, out, SSQ2}; pg8::gemm_phase<pg8::EpiResidB<MODE_>, pg8::StaticOrder>(F.lds + RING_OFF, g, S, E, F.tid); } while (0)

    PH_ENTER(); if (IN(0)) {
        transpose_weight(F, args.in[I_AWIN], 2048, 8192, W_AIN[0]); attn_table(F, TABA);
        norm_rows(F, args.in[I_XP], args.in[I_XS], args.in[I_NW], XN0);
    }
    SEAM(0);
#define GEMM_AIN(Aptr, Wptr, J_, SSQP) do { pg8::GemmP g{2048, 2048, 32}; pg8::StaticOrder S; S.init(MT / 256, 32, F.G, F.bid, Aptr, Wptr, 2048, 2048); \
        EpiAIn E{Qs, KP, VP, KC, VC, GA, out + O_KP + (size_t)(J_) * MP * DM, out + O_VP + (size_t)(J_) * MP * DM, out + O_KS + (size_t)(J_) * MS * DM, out + O_VS + (size_t)(J_) * MS * DM, TABA, args.in[I_AQG] + 64 * (J_), args.in[I_AKG] + 64 * (J_), SSQP}; \
        pg8::gemm_phase<EpiAIn, pg8::StaticOrder>(F.lds + RING_OFF, g, S, E, F.tid); } while (0)
    PH_ENTER(); if (IN(1)) { GEMM_AIN(XN0, W_AIN[0], 0, (const float*)nullptr);
        const int n0 = CC_CHUNKS, n1 = n0 + tw_chunks(2048, 2048), n2 = n1 + TR_CHUNKS;
        DRAIN(1, n2, if (c_ < n0) cc_run(F, args.in[I_CK], args.in[I_CV], KC, VC, c_); else if (c_ < n1) tw_run(F, args.in[I_AWOUT], 2048, 2048, W_AOUT[0], c_ - n0); else tr_run(F, TABR, c_ - n1);); }
    SEAM(1);
    PH_ENTER(); if (IN(3)) { const float li = 0.8f - 0.6f * expf(-0.3f * 0.f); const float lam = diff_lambda(args.in[I_LQ1], args.in[I_LK1], args.in[I_LQ2], args.in[I_LK2], li);
        attn_fast(F, Qs, KP, VP, KC, VC, GA, AO_A, lam, 1.f - li, args.in[I_ASG]); }
    SEAM(3);
    PH_ENTER(); if (IN(4)) { GEMM_RESIDB(0, AO_A, W_AOUT[0], 2048);
        const int n0 = tw_chunks(2048, 12288), n1 = n0 + tw_chunks(4096, 2048);
        DRAIN(4, n1, if (c_ < n0) tw_run(F, args.in[I_RWIN], 2048, 12288, W_RIN, c_, args.in[I_NW] + DM); else tw_run(F, args.in[I_RWOUT], 4096, 2048, W_ROUT, c_ - n0);); }
    if (IN(4) && IN(6)) xcd_barrier(bar, F.wave == 0 && lane_now() == 0);
    PH_ENTER(); if (IN(6)) { ret_zero_pad(F, VS, KT);
        PH_ENTER(); pg8::GemmP g{2048, 2048, 32}; pg8::StaticOrder S; S.init(MT / 256, 48, F.G, F.bid, HB, W_RIN, 2048, 2048); EpiRet E{QP, KN, KT, VS, RG, TABR, SSQ2};
        pg8::gemm_phase<EpiRet, pg8::StaticOrder>(F.lds + RING_OFF, g, S, E, F.tid); }
    SEAM(6);
    PH_ENTER(); if (IN(7)) { { pg8::GemmP g{4096, 2048, 4}; RetQKOrder S{F.G, F.bid, (const char*)QP, (const char*)KN}; EpiRetQK E{QP}; pg8::gemm_phase<EpiRetQK, RetQKOrder>(F.lds + RING_OFF, g, S, E, F.tid); }
        PH_ENTER(); { pg8::GemmP g{512, 256, 4}; RetKVOrder S{F.G, F.bid, (const char*)VS, (const char*)KT}; EpiRetKV E{VS, KVX}; pg8::gemm_phase<EpiRetKV, RetKVOrder>(F.lds + RING_OFF, g, S, E, F.tid); }
        xcd_barrier(bar, F.wave == 0 && lane_now() == 0);
        PH_ENTER(); ret_scan(F, VS, KVX, args.in[I_SR], out + O_SP, out + O_SS); }
    SEAM(7);
    PH_ENTER(); if (IN(8)) { pg8::GemmP g{4096, 512, 8}; RetOOrder S{F.G, F.bid, (const char*)QP, (const char*)VS}; EpiRetO E{ORET}; pg8::gemm_phase<EpiRetO, RetOOrder>(F.lds + RING_OFF, g, S, E, F.tid); }
    SEAM(8);
    PH_ENTER(); if (IN(9)) r_out(F, ORET, RG);
    SEAM(9);
    PH_ENTER(); if (IN(10)) { GEMM_RESIDB(1, ORET, W_ROUT, 4096);
        const int n0 = tw_chunks(2048, 12288), n1 = n0 + tw_chunks(4096, 2048), n2 = n1 + tw_chunks(2048, 8192), n3 = n2 + tw_chunks(2048, 2048);
        DRAIN(10, n3, if (c_ < n0) tw_run(F, args.in[I_CWIN], 2048, 12288, W_CIN, c_, args.in[I_NW] + 2 * DM); else if (c_ < n1) tw_run(F, args.in[I_CWOUT], 4096, 2048, W_COUT, c_ - n0);
                      else if (c_ < n2) tw_run(F, args.in[I_AWIN] + (size_t)2048 * 8192, 2048, 8192, W_AIN[1], c_ - n1, args.in[I_NW] + 3 * DM); else tw_run(F, args.in[I_AWOUT] + (size_t)2048 * 2048, 2048, 2048, W_AOUT[1], c_ - n2);); }
    if (IN(10) && IN(12)) xcd_barrier(bar, F.wave == 0 && lane_now() == 0);
    PH_ENTER(); if (IN(12)) { pg8::GemmP g{2048, 2048, 32}; pg8::StaticOrder S; S.init(MT / 256, 48, F.G, F.bid, HB, W_CIN, 2048, 2048); EpiCIn E{GU, GVT, SG, GVS, SSQ, SSQ2};
        pg8::gemm_phase<EpiCIn, pg8::StaticOrder>(F.lds + RING_OFF, g, S, E, F.tid); }
    SEAM(12);
    PH_ENTER(); if (IN(13)) c_prep(F, SSQ, args.in[I_CWS], args.in[I_CVG], GVS, WM, out + O_VM);
    SEAM(13);
    PH_ENTER(); if (IN(14)) { pg8::GemmP g{256, 256, 4}; CMixOrder S{F.G, F.bid, (const char*)WM, (const char*)GVT}; EpiCMix E{GU, SG, args.in[I_CVG], args.in[I_CBS]}; pg8::gemm_phase<EpiCMix, CMixOrder>(F.lds + RING_OFF, g, S, E, F.tid); }
    SEAM(14);
    PH_ENTER(); if (IN(15)) { GEMM_RESIDB(1, GU, W_COUT, 4096);
        DRAIN(15, CC_CHUNKS, cc_run(F, args.in[I_CK] + (size_t)NB * PAST * DM, args.in[I_CV] + (size_t)NB * PAST * DM, KC, VC, c_);); }
    if (IN(15) && IN(17)) xcd_barrier(bar, F.wave == 0 && lane_now() == 0);
    PH_ENTER(); if (IN(17)) GEMM_AIN(HB, W_AIN[1], 1, (const float*)SSQ2);
    SEAM(17);
    PH_ENTER(); if (IN(19)) { const float li = 0.8f - 0.6f * expf(-0.3f * 3.f); const float lam = diff_lambda(args.in[I_LQ1] + 64, args.in[I_LK1] + 64, args.in[I_LQ2] + 64, args.in[I_LK2] + 64, li);
        attn_fast(F, Qs, KP, VP, KC, VC, GA, AO_A, lam, 1.f - li, args.in[I_ASG] + 128); }
    SEAM(19);
    PH_ENTER(); if (IN(20)) GEMM_RESIDB(2, AO_A, W_AOUT[1], 2048);
#undef IN
#undef SEAM
}

extern "C" void kernel_launch(void* const* d_in, const int* in_sizes, int n_in, void* d_out, int out_size, void* d_ws, size_t ws_size, hipStream_t stream) {
    static int grid = 0;
    if (grid == 0) {
        if (n_in != N_IN || (size_t)out_size != O_END || ws_size < WS_END) { fprintf(stderr, "kernel_launch: unexpected shapes: n_in %d out %d ws %zu (need %zu)\n", n_in, out_size, ws_size, (size_t)WS_END); grid = -1; return; }
        int dev = 0, cus = 0;
        if (hipGetDevice(&dev) != hipSuccess || hipDeviceGetAttribute(&cus, hipDeviceAttributeMultiprocessorCount, dev) != hipSuccess) { grid = -1; return; }
        if (hipFuncSetAttribute((const void*)mega, hipFuncAttributeMaxDynamicSharedMemorySize, LDS_BYTES) != hipSuccess) { fprintf(stderr, "kernel_launch: hipFuncSetAttribute failed\n"); grid = -1; return; }
        (void)hipGetLastError();
        grid = cus;
    }
    if (grid < 0) return;
    Args a{};
    for (int i = 0; i < N_IN; ++i) a.in[i] = (const float*)d_in[i];
    a.out = (float*)d_out; a.ws = (unsigned char*)d_ws;
    (void)hipMemsetAsync((char*)d_ws + WS_CTL, 0, CTL_ZERO_BYTES, stream);
    a.ph_lo = 0; a.ph_hi = N_PHASES;
    hipLaunchKernelGGL(mega, dim3(grid), dim3(NTHR), LDS_BYTES, stream, a);
}
```

```cpp
#include <hip/hip_runtime.h>
#include <cstdio>
#include <cstdint>

__device__ __forceinline__ int lane_now() { int l; asm volatile("v_mbcnt_lo_u32_b32 %0, -1, 0\n\tv_mbcnt_hi_u32_b32 %0, -1, %0" : "=v"(l)); return l; }
namespace pg8 {
#define PG8_LAS __attribute__((address_space(3)))
typedef unsigned short bf16_t;
typedef short bf16x8 __attribute__((ext_vector_type(8)));
typedef float f32x4 __attribute__((ext_vector_type(4)));
typedef unsigned u32x4 __attribute__((ext_vector_type(4)));
constexpr int BM = 256, BK = 64, HALF = 128, HTB = HALF * BK * 2, STAGE_BYTES = 8 * HTB, NXCD = 8, WGM = 8;

__host__ __device__ __forceinline__ int lds_byte(int r, int c) { const int st = (r >> 4) * 2 + (c >> 5), rr = r & 15, cc = c & 31, ob = rr * 64 + cc * 2; return st * 1024 + (ob ^ (((ob >> 9) & 1) << 5)); }
__host__ __device__ __forceinline__ void stage_rc(int b, int& R, int& C) { const int st = b / 1024, sb = b % 1024, swz = sb ^ (((sb >> 9) & 1) << 5); R = (st >> 1) * 16 + swz / 64; C = (st & 1) * 32 + (swz % 64) / 2; }
__host__ __device__ __forceinline__ int perm32(int rho) { const int n = rho >> 4, i = rho & 15; return 8 * (i >> 2) + 4 * n + (i & 3); }

struct Unit { int pm, pn; const char* a; const char* b; };
struct GemmP { int lda, ldb, nt; };

struct StaticOrder {
    int nM, nN, nwg, G, c; const char* A; const char* B; size_t ta, tb;
    __host__ __device__ void init(int nM_, int nN_, int G_, int c_, const void* A_, const void* B_, int lda, int ldb) { nM = nM_; nN = nN_; nwg = nM * nN; G = G_; c = c_; A = (const char*)A_; B = (const char*)B_; ta = (size_t)BM * lda * 2; tb = (size_t)BM * ldb * 2; }
    __host__ __device__ bool next(int i, Unit& u) const {
        const long L = (long)i * G + c; if (L >= nwg) return false;
        int wgid = (int)L; { const int q = nwg / NXCD, r = nwg % NXCD, xcd = wgid % NXCD, off = wgid / NXCD; wgid = (xcd < r ? xcd * (q + 1) : r * (q + 1) + (xcd - r) * q) + off; }
        const int nig = WGM * nN, gid = wgid / nig, fm = gid * WGM, gsz = (nM - fm) < WGM ? (nM - fm) : WGM;
        u.pm = fm + ((wgid % nig) % gsz); u.pn = (wgid % nig) / gsz; u.a = A + (size_t)u.pm * ta; u.b = B + (size_t)u.pn * tb; return true;
    }
    __device__ __forceinline__ void a_ready(const Unit&) const {}
    __device__ __forceinline__ void done(const Unit&) const {}
};

__device__ __forceinline__ unsigned cvt_pk_bf16(float lo, float hi) { unsigned r; asm volatile("v_cvt_pk_bf16_f32 %0, %1, %2" : "=v"(r) : "v"(lo), "v"(hi)); return r; }

struct EpiStoreBf16 {
    static constexpr int BMODE = 1;
    bf16_t* O; int ldc;
    __device__ __forceinline__ void operator()(const f32x4 (&acc)[2][2][4][2], const Unit& u, int wr, int wc, int fr, int fq) const {
        const int row0 = u.pm * BM + wr * 64 + fr; const int col0 = u.pn * BM + wc * 32 + 8 * fq;
#pragma unroll
        for (int ai = 0; ai < 2; ++ai)
#pragma unroll
            for (int m = 0; m < 4; ++m) { bf16_t* rowp = O + (size_t)(row0 + ai * HALF + m * 16) * ldc + col0;
#pragma unroll
                for (int bj = 0; bj < 2; ++bj) { const f32x4 v0 = acc[ai][bj][m][0], v1 = acc[ai][bj][m][1];
                    u32x4 w; w.x = cvt_pk_bf16(v0[0], v0[1]); w.y = cvt_pk_bf16(v0[2], v0[3]); w.z = cvt_pk_bf16(v1[0], v1[1]); w.w = cvt_pk_bf16(v1[2], v1[3]);
                    *(u32x4*)(rowp + bj * HALF) = w; } }
    }
};
struct EpiResid {
    static constexpr int BMODE = 0;
    const float* base_p; const float* base_s; float* out; int split;
    __device__ __forceinline__ void operator()(const f32x4 (&acc)[2][2][4][2], const Unit& u, int wr, int wc, int fr, int fq) const {
        { const int l_ = lane_now(); fr = l_ & 15; fq = l_ >> 4; }
        const int col0 = u.pn * BM + wc * 32 + 4 * fq;
#pragma unroll
        for (int ai = 0; ai < 2; ++ai) {
            f32x4 bs[4][2][2];
#pragma unroll
            for (int m = 0; m < 4; ++m) { const int r = u.pm * BM + ai * HALF + wr * 64 + m * 16 + fr; const float* bp = (r < split) ? base_p + (size_t)r * 2048 : base_s + (size_t)(r - split) * 2048;
#pragma unroll
                for (int bj = 0; bj < 2; ++bj)
#pragma unroll
                    for (int n = 0; n < 2; ++n) bs[m][bj][n] = *(const f32x4*)(bp + col0 + bj * HALF + n * 16); }
#pragma unroll
            for (int m = 0; m < 4; ++m) { const int r = u.pm * BM + ai * HALF + wr * 64 + m * 16 + fr; float* op = out + (size_t)r * 2048;
#pragma unroll
                for (int bj = 0; bj < 2; ++bj)
#pragma unroll
                    for (int n = 0; n < 2; ++n) *(f32x4*)(op + col0 + bj * HALF + n * 16) = bs[m][bj][n] + acc[ai][bj][m][n]; }
            asm volatile("" ::: "memory");
        }
    }
};

template <int MODE> struct EpiResidB {
    static constexpr int BMODE = 1;
    const float* base_p; const float* base_s; bf16_t* HB; float* out; float* SSQ2;
    __device__ __forceinline__ void operator()(const f32x4 (&acc)[2][2][4][2], const Unit& u, int wr, int wc, int fr, int fq) const {
        { const int l_ = lane_now(); fr = l_ & 15; fq = l_ >> 4; }
        const int col0 = u.pn * BM + wc * 32 + 8 * fq;
#pragma unroll
        for (int ai = 0; ai < 2; ++ai) {
            f32x4 b0[4][2], b1[4][2]; u32x4 hb[4][2];
#pragma unroll
            for (int m = 0; m < 4; ++m) { const int r = u.pm * BM + ai * HALF + wr * 64 + m * 16 + fr;
#pragma unroll
                for (int bj = 0; bj < 2; ++bj) {
                    if (MODE == 0) { const float* bp = ((r < 16384) ? base_p + (size_t)r * 2048 : base_s + (size_t)(r - 16384) * 2048) + col0 + bj * HALF; b0[m][bj] = *(const f32x4*)bp; b1[m][bj] = *(const f32x4*)(bp + 4); }
                    else hb[m][bj] = *(const u32x4*)(HB + (size_t)r * 2048 + col0 + bj * HALF); } }
#pragma unroll
            for (int m = 0; m < 4; ++m) { const int r = u.pm * BM + ai * HALF + wr * 64 + m * 16 + fr; float ss = 0.f;
#pragma unroll
                for (int bj = 0; bj < 2; ++bj) { f32x4 h0, h1;
                    if (MODE == 0) { h0 = b0[m][bj] + acc[ai][bj][m][0]; h1 = b1[m][bj] + acc[ai][bj][m][1]; }
                    else { const u32x4 w = hb[m][bj];
                        h0 = (f32x4){__builtin_bit_cast(float, w.x << 16), __builtin_bit_cast(float, w.x & 0xffff0000u), __builtin_bit_cast(float, w.y << 16), __builtin_bit_cast(float, w.y & 0xffff0000u)} + acc[ai][bj][m][0];
                        h1 = (f32x4){__builtin_bit_cast(float, w.z << 16), __builtin_bit_cast(float, w.z & 0xffff0000u), __builtin_bit_cast(float, w.w << 16), __builtin_bit_cast(float, w.w & 0xffff0000u)} + acc[ai][bj][m][1]; }
                    if (MODE == 2) { float* op = out + (size_t)r * 2048 + col0 + bj * HALF; *(f32x4*)op = h0; *(f32x4*)(op + 4) = h1; }
                    else { u32x4 w; w.x = cvt_pk_bf16(h0[0], h0[1]); w.y = cvt_pk_bf16(h0[2], h0[3]); w.z = cvt_pk_bf16(h1[0], h1[1]); w.w = cvt_pk_bf16(h1[2], h1[3]);
                        *(u32x4*)(HB + (size_t)r * 2048 + col0 + bj * HALF) = w;
                        ss += (h0[0] * h0[0] + h0[1] * h0[1]) + (h0[2] * h0[2] + h0[3] * h0[3]) + (h1[0] * h1[0] + h1[1] * h1[1]) + (h1[2] * h1[2] + h1[3] * h1[3]); } }
                if (MODE != 2) { ss += __shfl_xor(ss, 16); ss += __shfl_xor(ss, 32); if (fq == 0) SSQ2[(size_t)r * 32 + u.pn * 4 + wc] = ss; } }
            asm volatile("" ::: "memory");
        }
    }
};

template <class Epi, class Sched, bool ALIGN_EPI = true>
__device__ __forceinline__ void gemm_phase(PG8_LAS unsigned char* lds, const GemmP g, const Sched& S, const Epi& E, int tid) {
    asm volatile("" : "+v"(tid));
    const int wid = __builtin_amdgcn_readfirstlane(tid >> 6), lane = tid & 63, wr = wid >> 2, wc = wid & 3, fr = lane & 15, fq = lane >> 4;
    const int nt = g.nt;
    unsigned voffA[2], voffB[2];
#pragma unroll
    for (int i = 0; i < 2; ++i) { int R, C; stage_rc(tid * 16 + i * 8192, R, C); const int Rb = Epi::BMODE == 2 ? (64 * (R >> 5) + perm32(R & 31)) : Epi::BMODE == 1 ? ((R & ~31) + perm32(R & 31)) : R;
        voffA[i] = (unsigned)(R * g.lda + C) * 2u; voffB[i] = (unsigned)(Rb * g.ldb + C) * 2u; }
    const size_t kstep = (size_t)(BK * 2);
    const size_t hstepA = (size_t)HALF * g.lda * 2, hstepB = (size_t)(Epi::BMODE == 2 ? 32 : HALF) * g.ldb * 2;
    const unsigned ldsw = (unsigned)wid * 1024u;
    const int aoff = lds_byte(wr * 64 + fr, fq * 8), boff = lds_byte(wc * 32 + fr, fq * 8);
#define PG8_SA(b, h) (((b) * 2 + (h)) * HTB)
#define PG8_SB(b, h) ((4 + (b) * 2 + (h)) * HTB)
#define PG8_STAGE(bufoff, gbase, voff) do { _Pragma("unroll") for (int _i = 0; _i < 2; ++_i) \
        __builtin_amdgcn_global_load_lds((const unsigned*)((const char*)(gbase) + (voff)[_i]), (PG8_LAS unsigned*)(lds + (bufoff) + ldsw + _i * 8192), 16, 0, 0); } while (0)
#define PG8_LDA(dst, b, h) do { _Pragma("unroll") for (int m = 0; m < 4; ++m) _Pragma("unroll") for (int k = 0; k < 2; ++k) dst[m][k] = *(const PG8_LAS bf16x8*)(lds + PG8_SA(b, h) + aoff + m * 2048 + k * 1024); } while (0)
#define PG8_LDB(dst, b, h) do { _Pragma("unroll") for (int n = 0; n < 2; ++n) _Pragma("unroll") for (int k = 0; k < 2; ++k) dst[n][k] = *(const PG8_LAS bf16x8*)(lds + PG8_SB(b, h) + boff + n * 2048 + k * 1024); } while (0)
#define PG8_MMA(ai, bj, At, Bt) do { __builtin_amdgcn_s_setprio(1); _Pragma("unroll") for (int m = 0; m < 4; ++m) _Pragma("unroll") for (int n = 0; n < 2; ++n) _Pragma("unroll") for (int k = 0; k < 2; ++k) \
        acc[ai][bj][m][n] = __builtin_amdgcn_mfma_f32_16x16x32_bf16(Bt[n][k], At[m][k], acc[ai][bj][m][n], 0, 0, 0); __builtin_amdgcn_s_setprio(0); } while (0)
#define PG8_WAIT_V(n) asm volatile("s_waitcnt vmcnt(" #n ")" ::: "memory")
#define PG8_WAIT_L(n) asm volatile("s_waitcnt lgkmcnt(" #n ")" ::: "memory")
#define PG8_BAR __builtin_amdgcn_s_barrier()
#define PG8_SCHED __builtin_amdgcn_sched_barrier(0)
    Unit cur, nxt; int ui = 0;
    if (!S.next(0, cur)) return;
    f32x4 acc[2][2][4][2];
#pragma unroll
    for (int a = 0; a < 2; ++a)
#pragma unroll
        for (int b = 0; b < 2; ++b)
#pragma unroll
            for (int m = 0; m < 4; ++m)
#pragma unroll
                for (int n = 0; n < 2; ++n) acc[a][b][m][n] = (f32x4){0.f, 0.f, 0.f, 0.f};
    bf16x8 At[4][2], B0[2][2], B1[2][2];
    const char* cA = cur.a; const char* cB = cur.b;
    S.a_ready(cur);
    PG8_STAGE(PG8_SB(0, 0), cB, voffB); PG8_STAGE(PG8_SB(0, 1), cB + hstepB, voffB); PG8_STAGE(PG8_SA(0, 0), cA, voffA); PG8_STAGE(PG8_SA(0, 1), cA + hstepA, voffA);
    if (wr == 1) PG8_BAR;
    PG8_WAIT_V(2); PG8_BAR;
    PG8_STAGE(PG8_SB(1, 0), cB + kstep, voffB); PG8_STAGE(PG8_SA(1, 0), cA + kstep, voffA); PG8_STAGE(PG8_SB(1, 1), cB + hstepB + kstep, voffB);
    PG8_WAIT_V(6); PG8_BAR;
    for (;;) {
        const bool has_next = S.next(ui + 1, nxt);
        const char* nA = has_next ? nxt.a : cA; const char* nB = has_next ? nxt.b : cB;
        for (int t = 0; t < nt; t += 2) {
            const bool last = (t == nt - 2);
            const char* a1 = cA + (size_t)(t + 1) * kstep;
            const char* a2 = last ? nA : cA + (size_t)(t + 2) * kstep; const char* b2 = last ? nB : cB + (size_t)(t + 2) * kstep;
            const char* a3 = a2 + kstep; const char* b3 = b2 + kstep;
            if (last && has_next) S.a_ready(nxt);
            PG8_LDB(B0, 0, 0); PG8_LDB(B1, 0, 1); PG8_SCHED; PG8_LDA(At, 0, 0); PG8_STAGE(PG8_SA(1, 1), a1 + hstepA, voffA);
            PG8_WAIT_V(8); PG8_WAIT_L(0); PG8_BAR; PG8_MMA(0, 0, At, B0); PG8_MMA(0, 1, At, B1); PG8_BAR; PG8_SCHED;
            PG8_LDA(At, 0, 1); PG8_STAGE(PG8_SB(0, 0), b2, voffB); PG8_STAGE(PG8_SB(0, 1), b2 + hstepB, voffB); PG8_STAGE(PG8_SA(0, 0), a2, voffA);
            PG8_WAIT_V(8); PG8_WAIT_L(0); PG8_BAR; PG8_MMA(1, 0, At, B0); PG8_MMA(1, 1, At, B1); PG8_BAR; PG8_SCHED;
            PG8_LDB(B0, 1, 0); PG8_LDB(B1, 1, 1); PG8_SCHED; PG8_LDA(At, 1, 0); PG8_STAGE(PG8_SA(0, 1), a2 + hstepA, voffA);
            PG8_WAIT_V(8); PG8_WAIT_L(0); PG8_BAR; PG8_MMA(0, 0, At, B0); PG8_MMA(0, 1, At, B1); PG8_BAR; PG8_SCHED;
            PG8_LDA(At, 1, 1); PG8_STAGE(PG8_SB(1, 0), b3, voffB); PG8_STAGE(PG8_SB(1, 1), b3 + hstepB, voffB); PG8_STAGE(PG8_SA(1, 0), a3, voffA);
            PG8_WAIT_V(8); PG8_WAIT_L(0); PG8_BAR; PG8_MMA(1, 0, At, B0); PG8_MMA(1, 1, At, B1); PG8_BAR; PG8_SCHED;
        }
        if constexpr (ALIGN_EPI) { if (wr == 0) PG8_BAR; }
        E(acc, cur, wr, wc, fr, fq); S.done(cur);
        if (!has_next) break;
#pragma unroll
        for (int a = 0; a < 2; ++a)
#pragma unroll
            for (int b = 0; b < 2; ++b)
#pragma unroll
                for (int m = 0; m < 4; ++m)
#pragma unroll
                    for (int n = 0; n < 2; ++n) acc[a][b][m][n] = (f32x4){0.f, 0.f, 0.f, 0.f};
        cur = nxt; cA = nA; cB = nB; ++ui;
        if constexpr (ALIGN_EPI) { if (wr == 1) PG8_BAR; }
    }
    PG8_WAIT_V(0);
    if constexpr (!ALIGN_EPI) { if (wr == 0) PG8_BAR; }
    PG8_BAR;
#undef PG8_SA
#undef PG8_SB
#undef PG8_STAGE
#undef PG8_LDA
#undef PG8_LDB
#undef PG8_MMA
#undef PG8_WAIT_V
#undef PG8_WAIT_L
#undef PG8_BAR
#undef PG8_SCHED
}
}

constexpr int NWAVES = 8, NTHR = 512;
constexpr int DM = 2048, MP = 16384, MS = 512, MT = MP + MS, PAST = 2048, DECL = 64, NB = 8;
constexpr int KCROWS = PAST + DECL;
constexpr float EPS = 1e-6f;
constexpr float LOG2E = 1.4426950408889634f;
constexpr float C2 = 0.125f * LOG2E;

enum { I_XP = 0, I_XS, I_CK, I_CV, I_SR, I_NW, I_AWIN, I_AWOUT, I_AQG, I_AKG, I_LQ1, I_LK1, I_LQ2, I_LK2, I_ASG, I_RWIN, I_RWOUT, I_CWIN, I_CWOUT, I_CVG, I_CWS, I_CBS, N_IN };
constexpr size_t O_YP = 0, O_YS = O_YP + (size_t)MP * DM, O_KP = O_YS + (size_t)MS * DM, O_VP = O_KP + 2 * (size_t)MP * DM, O_KS = O_VP + 2 * (size_t)MP * DM, O_VS = O_KS + 2 * (size_t)MS * DM,
                 O_SP = O_VS + 2 * (size_t)MS * DM, O_SS = O_SP + (size_t)8 * 256 * 512, O_VM = O_SS + (size_t)NB * 8 * 256 * 512, O_END = O_VM + (size_t)MS * 4096;

constexpr size_t MiB = 1u << 20;
constexpr size_t WS_CTL = 0, CTL_ZERO_BYTES = 1 * MiB;
constexpr size_t WS_WAIN0 = 8 * MiB, WS_WAOUT0 = 40 * MiB, WS_WRIN = 48 * MiB, WS_WROUT = 96 * MiB, WS_WCIN = 112 * MiB, WS_WCOUT = 160 * MiB, WS_WAIN1 = 176 * MiB, WS_WAOUT1 = 208 * MiB;
constexpr size_t WS_SSQ2 = 2 * MiB;
constexpr size_t WS_HB = 216 * MiB, WS_Z = 282 * MiB;
constexpr size_t WS_XN0 = 348 * MiB;
constexpr size_t WS_QS = 546 * MiB, WS_KP = 612 * MiB, WS_VP = 676 * MiB, WS_KC = 740 * MiB, WS_VC = 806 * MiB, WS_AOA = 872 * MiB;
constexpr size_t WS_KT = 112 * MiB, WS_RG = 282 * MiB, WS_QP = 414 * MiB, WS_KN = 546 * MiB, WS_VS = 612 * MiB, WS_ORET = 900 * MiB;
constexpr size_t WS_GU = 282 * MiB, WS_SG = 414 * MiB, WS_GVT = 546 * MiB, WS_WM = 678 * MiB, WS_SSQ = 744 * MiB, WS_GVS = 752 * MiB;
constexpr size_t WS_GA = 282 * MiB;
constexpr size_t WS_KVX = 184 * MiB;
constexpr size_t WS_TABR = 1040 * MiB, WS_TABA = 1056 * MiB, WS_END = 1060 * MiB;

#define GAS __attribute__((address_space(1)))
#define LAS __attribute__((address_space(3)))
typedef unsigned short bf16;
typedef unsigned v4u __attribute__((ext_vector_type(4)));
typedef unsigned v2u __attribute__((ext_vector_type(2)));
typedef float f32x4 __attribute__((ext_vector_type(4)));
typedef GAS unsigned gu32;
#define RLX_AGENT __ATOMIC_RELAXED, __HIP_MEMORY_SCOPE_AGENT
#define LDS_WAIT() asm volatile("s_waitcnt lgkmcnt(0)" ::: "memory")
#define VM_WAIT() asm volatile("s_waitcnt vmcnt(0)" ::: "memory")
__device__ __forceinline__ unsigned f2bf(float f) { unsigned u = __builtin_bit_cast(unsigned, f); return (u + 0x7fffu + ((u >> 16) & 1u)) >> 16; }
__device__ __forceinline__ unsigned pk2(float lo, float hi) { return f2bf(lo) | (f2bf(hi) << 16); }
__device__ __forceinline__ float bf2f(unsigned short b) { return __builtin_bit_cast(float, (unsigned)b << 16); }
__device__ __forceinline__ float bflo(unsigned w) { return __builtin_bit_cast(float, w << 16); }
__device__ __forceinline__ float bfhi(unsigned w) { return __builtin_bit_cast(float, w & 0xffff0000u); }
__device__ __forceinline__ float silu_f(float x) { return x / (1.f + __expf(-x)); }
__device__ __forceinline__ float gelu_tanh_f(float x) { const float u = 0.7978845608028654f * (x + 0.044715f * x * x * x); return x / (1.f + __expf(-2.f * u)); }
__device__ __forceinline__ float wave_sum(float v) {
#pragma unroll
    for (int o = 1; o < 64; o <<= 1) v += __shfl_xor(v, o);
    return v;
}
__device__ __forceinline__ void row_rstd(const float* ssq, int pm, int wr, int fr, int fq, float (&rs)[2][4]) {
#pragma unroll
    for (int ai = 0; ai < 2; ++ai)
#pragma unroll
        for (int m = 0; m < 4; ++m) {
            if (ssq) { const float* p = ssq + ((size_t)pm * 256 + ai * 128 + wr * 64 + m * 16 + fr) * 32 + 8 * fq; const f32x4 a = *(const f32x4*)p, b = *(const f32x4*)(p + 4);
                float t = ((a.x + a.y) + (a.z + a.w)) + ((b.x + b.y) + (b.z + b.w)); t += __shfl_xor(t, 16); t += __shfl_xor(t, 32); rs[ai][m] = 1.f / sqrtf(t * (1.f / 2048.f) + EPS); }
            else rs[ai][m] = 1.f; }
}
__device__ __forceinline__ void rope_cs(int pos, int i, int nf, float& c, float& s) {
    const float inv = exp2f(-(float)i / (float)nf * 13.287712379549449f);
    const double a = (double)pos * (double)inv * 0.15915494309189535;
    const float r = (float)(a - floor(a));
    c = __builtin_amdgcn_cosf(r); s = __builtin_amdgcn_sinf(r);
}

#define XB_TMO      128
#define XB_XCNT(j)  (256  + 64 * (j))
#define XB_XSUB(j)  (1280 + 64 * (j))
#define XB_XGEN(j)  (2304 + 64 * (j))
#define XB_TOP      3328
#define XB_TOPGEN   3392
#define XCD_BAR_WORDS 3456
#define XB_SPIN_CAP (1u << 22)
__device__ __forceinline__ unsigned xb_ld(unsigned* p)              { return __hip_atomic_load(p, __ATOMIC_RELAXED, __HIP_MEMORY_SCOPE_AGENT); }
__device__ __forceinline__ unsigned xb_add(unsigned* p, unsigned v) { return __hip_atomic_fetch_add(p, v, __ATOMIC_RELAXED, __HIP_MEMORY_SCOPE_AGENT); }
__device__ __forceinline__ unsigned xb_xcc_id() { return (unsigned)__builtin_amdgcn_s_getreg((3 << 11) | 20) & 0xFu; }
#define XB_SPIN(cond, bar) do { unsigned _sp = 0; while (cond) { __builtin_amdgcn_s_sleep(1); \
    if ((++_sp & 255u) == 0u) { if (xb_ld(&(bar)[XB_TMO])) break; if (_sp > XB_SPIN_CAP) { atomicAdd(&(bar)[XB_TMO], 1u); break; } } } } while (0)
struct XcdBarrier { unsigned* bar; unsigned x; volatile LAS unsigned* st; };
__device__ __forceinline__ XcdBarrier xcd_barrier_post(unsigned* bar, volatile LAS unsigned* st) {
    XcdBarrier b; b.bar = bar; b.x = xb_xcc_id(); b.st = st;
    if (threadIdx.x == 0) (void)xb_add(&bar[XB_XCNT(b.x)], 1u);
    return b;
}
__device__ __forceinline__ void xcd_barrier_complete(unsigned* bar, unsigned x, unsigned& nloc, unsigned& nx) {
    const unsigned G = gridDim.x * gridDim.y * gridDim.z;
    unsigned sum, cnt, mine, sp = 0u;
    for (;;) {
        sum = 0u; cnt = 0u; mine = 0u;
#pragma unroll
        for (unsigned j = 0; j < 16; ++j) { const unsigned c = xb_ld(&bar[XB_XCNT(j)]); sum += c; cnt += (c > 0u) ? 1u : 0u; mine = (j == x) ? c : mine; }
        if (sum == G) break;
        __builtin_amdgcn_s_sleep(1);
        if ((++sp & 255u) == 0u) { if (xb_ld(&bar[XB_TMO])) break; if (sp > XB_SPIN_CAP) { atomicAdd(&bar[XB_TMO], 1u); break; } }
    }
    nloc = mine > 0u ? mine : 1u; nx = cnt > 0u ? cnt : 1u;
}
__device__ __forceinline__ void xcd_barrier(const XcdBarrier& b, bool leader) {
    asm volatile("s_waitcnt vmcnt(0)" ::: "memory");
    __syncthreads();
    if (leader) {
        unsigned* bar = b.bar;
        __builtin_amdgcn_s_waitcnt(0);
        unsigned nloc = b.st[0], nx = b.st[1];
        if (nloc == 0u) { xcd_barrier_complete(bar, b.x, nloc, nx); b.st[0] = nloc; b.st[1] = nx; }
        const unsigned old = xb_add(&bar[XB_XSUB(b.x)], 1u);
        const unsigned gen = old / nloc;
        if (old + 1u == (gen + 1u) * nloc) {
            __builtin_amdgcn_fence(__ATOMIC_RELEASE, "agent");
            asm volatile("s_waitcnt vmcnt(0)" ::: "memory");
            const unsigned og = xb_add(&bar[XB_TOP], 1u);
            const unsigned tg = og / nx;
            if (og + 1u == (tg + 1u) * nx) xb_add(&bar[XB_TOPGEN], 1u);
            else XB_SPIN(xb_ld(&bar[XB_TOPGEN]) == tg, bar);
            __builtin_amdgcn_fence(__ATOMIC_ACQUIRE, "agent");
            xb_add(&bar[XB_XGEN(b.x)], 1u);
            asm volatile("s_waitcnt vmcnt(0)" ::: "memory");
        } else {
            XB_SPIN(xb_ld(&bar[XB_XGEN(b.x)]) == gen, bar);
            __builtin_amdgcn_fence(__ATOMIC_ACQUIRE, "agent");
            asm volatile("s_waitcnt vmcnt(0)" ::: "memory");
        }
    }
    __syncthreads();
}

constexpr int RING_OFF = 0, RING_BYTES = 139264;
constexpr int MISC_OFF = RING_BYTES;
constexpr int LDS_BYTES = 147456;
struct Args { const float* in[N_IN]; float* out; unsigned char* ws; int ph_lo, ph_hi; };
struct Frame {
    LAS unsigned char* lds; int tid, lane, wave, G, bid;
    const float* const* in; float* out; unsigned char* ws;
};

__device__ __forceinline__ void p0_transpose_item(const float* W, int K, int N, bf16* WT, LAS float* scr, int item, int lane, const float* ksc = nullptr) {
    const int nblk = N / 32, kb = item / nblk, nb = item % nblk, k0 = 64 * kb, n0 = 32 * nb;
#pragma unroll 8
    for (int i = 0; i < 32; ++i) { const int kk = 2 * i + (lane >> 5); const float w_ = W[(size_t)(k0 + kk) * N + n0 + (lane & 31)]; scr[kk * 33 + (lane & 31)] = ksc ? w_ * ksc[k0 + kk] : w_; }
    LDS_WAIT(); asm volatile("" ::: "memory");
    const int c = lane & 7;
#pragma unroll
    for (int j = 0; j < 4; ++j) { const int n = (lane >> 3) + 8 * j; const LAS float* s = scr + (8 * c) * 33 + n;
        v4u o; o.x = pk2(s[0 * 33], s[1 * 33]); o.y = pk2(s[2 * 33], s[3 * 33]); o.z = pk2(s[4 * 33], s[5 * 33]); o.w = pk2(s[6 * 33], s[7 * 33]);
        *(GAS v4u*)(WT + (size_t)(n0 + n) * K + k0 + 8 * c) = o; }
    LDS_WAIT(); asm volatile("" ::: "memory");
}
__device__ __forceinline__ void transpose_weight(Frame& F, const float* W, int K, int N, bf16* WT) {
    LAS float* scr = (LAS float*)(F.lds + RING_OFF + F.wave * 16384);
    const int gw = F.bid * NWAVES + F.wave, NGW = F.G * NWAVES, nitems = (K / 64) * (N / 32);
    for (int it = gw; it < nitems; it += NGW) p0_transpose_item(W, K, N, WT, scr, it, F.lane);
}
__device__ __forceinline__ void norm_rows(Frame& F, const float* src_p, const float* src_s, const float* w, bf16* XN) {
    const int gw = F.bid * NWAVES + F.wave, NGW = F.G * NWAVES;
    for (int m = gw; m < MT; m += NGW) {
        const float* xrow = (m < MP) ? src_p + (size_t)m * DM : src_s + (size_t)(m - MP) * DM;
        const GAS f32x4* xr = (const GAS f32x4*)xrow + F.lane; const GAS f32x4* wr = (const GAS f32x4*)w + F.lane;
        f32x4 v[8]; float s = 0.f;
#pragma unroll
        for (int j = 0; j < 8; ++j) { v[j] = xr[64 * j]; s += (v[j].x * v[j].x + v[j].y * v[j].y) + (v[j].z * v[j].z + v[j].w * v[j].w); }
        const float rstd = 1.f / sqrtf(wave_sum(s) * (1.f / DM) + EPS);
        GAS v2u* o8 = (GAS v2u*)(XN + (size_t)m * DM) + F.lane;
#pragma unroll
        for (int j = 0; j < 8; ++j) { const f32x4 g = wr[64 * j]; v2u o; o.x = pk2(v[j].x * rstd * g.x, v[j].y * rstd * g.y); o.y = pk2(v[j].z * rstd * g.z, v[j].w * rstd * g.w); o8[64 * j] = o; }
    }
}
__device__ __forceinline__ void cache_cvt(Frame& F, const float* ck, const float* cv, bf16* KC, bf16* VC) {
    const size_t nvec = (size_t)NB * PAST * DM / 4;
    const size_t gt = (size_t)F.bid * NTHR + F.tid, NG = (size_t)F.G * NTHR;
    for (size_t i = gt; i < 2 * nvec; i += NG) {
        const bool isv = i >= nvec; const size_t e = (isv ? i - nvec : i) * 4;
        const size_t brow = e / DM, col = e % DM, b = brow / PAST, t = brow % PAST;
        const f32x4 x = *(const GAS f32x4*)((isv ? cv : ck) + e);
        v2u o; o.x = pk2(x.x, x.y); o.y = pk2(x.z, x.w);
        *(GAS v2u*)((isv ? VC : KC) + ((b * KCROWS + t) * DM + col)) = o;
    }
}
__device__ __forceinline__ int tw_chunks(int K, int N) { return (K / 64) * (N / 32) / 64; }
__device__ __forceinline__ void tw_run(Frame& F, const float* W, int K, int N, bf16* WT, int c, const float* ksc = nullptr) {
    LAS float* scr = (LAS float*)(F.lds + RING_OFF + F.wave * 16384);
#pragma unroll 1
    for (int i = 0; i < 8; ++i) p0_transpose_item(W, K, N, WT, scr, c * 64 + F.wave * 8 + i, F.lane, ksc);
}
constexpr int CC_CHUNKS = 2 * (NB * PAST * DM / 4) / 8192;
__device__ __forceinline__ void cc_run(Frame& F, const float* ck, const float* cv, bf16* KC, bf16* VC, int c) {
    const size_t nvec = (size_t)NB * PAST * DM / 4;
#pragma unroll 4
    for (int k = 0; k < 16; ++k) { const size_t i = (size_t)c * 8192 + k * NTHR + F.tid;
        const bool isv = i >= nvec; const size_t e = (isv ? i - nvec : i) * 4; const size_t brow = e / DM, col = e % DM, b = brow / PAST, t = brow % PAST;
        const f32x4 x = *(const GAS f32x4*)((isv ? cv : ck) + e); v2u o; o.x = pk2(x.x, x.y); o.y = pk2(x.z, x.w);
        *(GAS v2u*)((isv ? VC : KC) + ((b * KCROWS + t) * DM + col)) = o; }
}
constexpr int TR_CHUNKS = MP * 128 / 8192;
__device__ __forceinline__ void tr_run(Frame& F, float* tab, int c) {
#pragma unroll 1
    for (int k = 0; k < 16; ++k) { const size_t e = (size_t)c * 8192 + k * NTHR + F.tid; float cs, sn; rope_cs((int)(e >> 7), (int)(e & 127), 128, cs, sn); tab[2 * e] = cs; tab[2 * e + 1] = sn; }
}
__device__ __forceinline__ int row_pos(int row) { return row < MP ? row : PAST + ((row - MP) & 63); }

struct EpiAIn {
    static constexpr int BMODE = 2;
    pg8::bf16_t *Qs, *KP, *VP, *KC, *VC, *GA; float *okp, *ovp, *oks, *ovs; const float* tab; const float* qg; const float* kg; const float* ssq;
    __device__ __forceinline__ void operator()(const pg8::f32x4 (&acc)[2][2][4][2], const pg8::Unit& u, int wr, int wc, int fr, int fq) const {
        { const int l_ = lane_now(); fr = l_ & 15; fq = l_ >> 4; }
        const int pn = u.pn, pm = u.pm, typ = pn >> 3, cl = ((pn & 7) * 4 + wc) * 64 + 8 * fq; float rs[2][4]; row_rstd(ssq, pm, wr, fr, fq, rs);
        float g1[8], g2[8];
        if (typ < 2) { const float* gp = (typ == 0 ? qg : kg) + 8 * fq; const pg8::f32x4 a = *(const pg8::f32x4*)gp, b = *(const pg8::f32x4*)(gp + 4), c = *(const pg8::f32x4*)(gp + 32), d = *(const pg8::f32x4*)(gp + 36);
#pragma unroll
            for (int e = 0; e < 4; ++e) { g1[e] = a[e]; g1[4 + e] = b[e]; g2[e] = c[e]; g2[4 + e] = d[e]; } }
#pragma unroll
        for (int ai = 0; ai < 2; ++ai)
#pragma unroll
          for (int mp = 0; mp < 2; ++mp) {
            pg8::f32x4 tq[4][4];
            if (typ < 2) {
#pragma unroll
                for (int m = 2 * mp; m < 2 * mp + 2; ++m) { const int i_ = ai * 128 + wr * 64 + m * 16 + fr; const int pos_ = pm < 64 ? pm * 256 + i_ : PAST + (i_ & 63); const float* tp_ = tab + ((size_t)pos_ * 32 + 8 * fq) * 2;
#pragma unroll
                    for (int q4 = 0; q4 < 4; ++q4) tq[m][q4] = *(const pg8::f32x4*)(tp_ + 4 * q4); } }
#pragma unroll
            for (int m = 2 * mp; m < 2 * mp + 2; ++m) {
                const int i = ai * 128 + wr * 64 + m * 16 + fr; const size_t row = (size_t)pm * 256 + i;
                float x1[8], x2[8];
#pragma unroll
                for (int e = 0; e < 4; ++e) { x1[e] = acc[ai][0][m][0][e] * rs[ai][m]; x1[4 + e] = acc[ai][0][m][1][e] * rs[ai][m]; x2[e] = acc[ai][1][m][0][e] * rs[ai][m]; x2[4 + e] = acc[ai][1][m][1][e] * rs[ai][m]; }
                size_t drow; pg8::bf16_t* dk; pg8::bf16_t* dv; float* fk; float* fv;
                if (pm < 64) { drow = row; dk = KP; dv = VP; fk = okp + row * DM; fv = ovp + row * DM; }
                else { const int s_ = (int)(row - MP); drow = (size_t)(s_ >> 6) * KCROWS + PAST + (s_ & 63); dk = KC; dv = VC; fk = oks + (size_t)s_ * DM; fv = ovs + (size_t)s_ * DM; }
                if (typ < 2) {
                    float ss = 0.f;
#pragma unroll
                    for (int k = 0; k < 8; ++k) ss += x1[k] * x1[k] + x2[k] * x2[k];
                    ss += __shfl_xor(ss, 16); ss += __shfl_xor(ss, 32);
                    const float rstd = 1.f / sqrtf(ss * (1.f / 64.f) + EPS);
                    float o1[8], o2[8];
#pragma unroll
                    for (int q4 = 0; q4 < 4; ++q4) { const pg8::f32x4 t = tq[m][q4];
#pragma unroll
                        for (int z = 0; z < 2; ++z) { const int k = 2 * q4 + z; const float c = t[2 * z], s = t[2 * z + 1], y1 = x1[k] * rstd * g1[k], y2 = x2[k] * rstd * g2[k]; o1[k] = y1 * c - y2 * s; o2[k] = y2 * c + y1 * s; } }
                    if (typ == 0) { v4u w1, w2;
                        w1.x = pk2(o1[0] * C2, o1[1] * C2); w1.y = pk2(o1[2] * C2, o1[3] * C2); w1.z = pk2(o1[4] * C2, o1[5] * C2); w1.w = pk2(o1[6] * C2, o1[7] * C2);
                        w2.x = pk2(o2[0] * C2, o2[1] * C2); w2.y = pk2(o2[2] * C2, o2[3] * C2); w2.z = pk2(o2[4] * C2, o2[5] * C2); w2.w = pk2(o2[6] * C2, o2[7] * C2);
                        *(v4u*)(Qs + row * DM + cl) = w1; *(v4u*)(Qs + row * DM + cl + 32) = w2;
                    } else { v4u w1, w2;
                        w1.x = pk2(o1[0], o1[1]); w1.y = pk2(o1[2], o1[3]); w1.z = pk2(o1[4], o1[5]); w1.w = pk2(o1[6], o1[7]);
                        w2.x = pk2(o2[0], o2[1]); w2.y = pk2(o2[2], o2[3]); w2.z = pk2(o2[4], o2[5]); w2.w = pk2(o2[6], o2[7]);
                        *(v4u*)(dk + drow * DM + cl) = w1; *(v4u*)(dk + drow * DM + cl + 32) = w2;
                        *(pg8::f32x4*)(fk + cl) = (pg8::f32x4){o1[0], o1[1], o1[2], o1[3]}; *(pg8::f32x4*)(fk + cl + 4) = (pg8::f32x4){o1[4], o1[5], o1[6], o1[7]};
                        *(pg8::f32x4*)(fk + cl + 32) = (pg8::f32x4){o2[0], o2[1], o2[2], o2[3]}; *(pg8::f32x4*)(fk + cl + 36) = (pg8::f32x4){o2[4], o2[5], o2[6], o2[7]}; }
                } else { v4u w1, w2;
                    w1.x = pk2(x1[0], x1[1]); w1.y = pk2(x1[2], x1[3]); w1.z = pk2(x1[4], x1[5]); w1.w = pk2(x1[6], x1[7]);
                    w2.x = pk2(x2[0], x2[1]); w2.y = pk2(x2[2], x2[3]); w2.z = pk2(x2[4], x2[5]); w2.w = pk2(x2[6], x2[7]);
                    if (typ == 2) { *(v4u*)(dv + drow * DM + cl) = w1; *(v4u*)(dv + drow * DM + cl + 32) = w2;
                        *(pg8::f32x4*)(fv + cl) = (pg8::f32x4){x1[0], x1[1], x1[2], x1[3]}; *(pg8::f32x4*)(fv + cl + 4) = (pg8::f32x4){x1[4], x1[5], x1[6], x1[7]};
                        *(pg8::f32x4*)(fv + cl + 32) = (pg8::f32x4){x2[0], x2[1], x2[2], x2[3]}; *(pg8::f32x4*)(fv + cl + 36) = (pg8::f32x4){x2[4], x2[5], x2[6], x2[7]}; }
                    else { *(v4u*)(GA + row * DM + cl) = w1; *(v4u*)(GA + row * DM + cl + 32) = w2; }
                }
                if (m & 1) asm volatile("" ::: "memory");
            }
        }
    }
};
__device__ __forceinline__ void attn_table(Frame& F, float* tab) {
    const size_t gt = (size_t)F.bid * NTHR + F.tid, NG = (size_t)F.G * NTHR;
    for (size_t e = gt; e < (size_t)MP * 32; e += NG) { float c, s; rope_cs((int)(e >> 5), (int)(e & 31), 32, c, s); tab[2 * e] = c; tab[2 * e + 1] = s; }
}
namespace dattn {
typedef short bf16x8 __attribute__((ext_vector_type(8)));
typedef short s16x4 __attribute__((ext_vector_type(4)));
typedef short v4i16_t __attribute__((ext_vector_type(4)));
typedef float f32x16 __attribute__((ext_vector_type(16)));
typedef unsigned u32x4 __attribute__((ext_vector_type(4)));
typedef __attribute__((address_space(3))) const char* lds_cptr;
constexpr int RINGB = 98304, WSF_OFF = RINGB, XCHB = 18432, STP = 144;
__device__ __forceinline__ int crow(int r, int hi) { return (r & 3) + 8 * (r >> 2) + 4 * hi; }
__device__ __forceinline__ void glds16(const void* gsrc, unsigned lds_dst) { unsigned keep;
    asm volatile("s_mov_b32 %0, m0\n\ts_mov_b32 m0, %2\n\ts_nop 0\n\tglobal_load_lds_dwordx4 %1, off\n\ts_mov_b32 m0, %0" : "=&s"(keep) : "v"(gsrc), "s"(lds_dst) : "memory"); }
typedef float f32x2_t __attribute__((ext_vector_type(2))); typedef __bf16 bf16x2_t __attribute__((ext_vector_type(2)));
__device__ __forceinline__ unsigned cvtpk_s(float lo, float hi) { f32x2_t v = {lo, hi}; bf16x2_t b = __builtin_convertvector(v, bf16x2_t); return __builtin_bit_cast(unsigned, b); }
#define DA_WAIT_BAR(N) asm volatile("s_waitcnt vmcnt(" #N ") lgkmcnt(0)\n\ts_barrier" ::: "memory")
__device__ __forceinline__ s16x4 vtr(lds_cptr p) { return __builtin_bit_cast(s16x4, __builtin_amdgcn_ds_read_tr16_b64_v4i16((__attribute__((address_space(3))) v4i16_t*)p)); }
struct Unit { const bf16* Q; const bf16* K; const bf16* V; const bf16* G; bf16* AO; int NT; int full; int dma0; };

constexpr int KSLOT = 16384, VSLOT = 16384, VRING = 3 * KSLOT;
#define DA_SBAR() __builtin_amdgcn_sched_barrier(0)
#define DA_PIN(x) asm volatile("" : "+v"(x))
#define DA_MFMA(a, b, c) __builtin_amdgcn_mfma_f32_32x32x16_bf16(a, b, c, 0, 0, 0)
struct DmaJob { const bf16* kp; const bf16* vp; unsigned kd0, kd1, vd0, vd1; };
__device__ __forceinline__ void dma_piece(const DmaJob& j, int i) { if (i == 0) glds16(j.kp, j.kd0); else if (i == 1) glds16(j.kp + 64, j.kd1); else if (i == 2) glds16(j.vp, j.vd0); else glds16(j.vp + 64, j.vd1); }
template <bool QK, bool PV, int VAR>
__device__ __forceinline__ void step(lds_cptr kpn, lds_cptr vp, const bf16x8 (&qr)[4], bf16x8 (&kf)[8], f32x16 (&o)[4], u32x4 (&pw)[4], float& l_reg, const DmaJob& dj) {
    f32x16 C0 = f32x16{}, C1 = f32x16{};
    s16x4 vlo[4], vhi[4];
    if constexpr (!QK) { dma_piece(dj, 0); dma_piece(dj, 1); dma_piece(dj, 2); dma_piece(dj, 3); }
#define DA_FOFF(f) ((((f) & 3) * 4096) + (((f) >> 2) * 1024))
#pragma unroll
    for (int a = 0; a < 8; ++a) {
        if constexpr (PV) { if (a >= 4) { if (VAR != 4) { vlo[a - 4] = vtr(vp + DA_FOFF(a - 4)); vhi[a - 4] = vtr(vp + DA_FOFF(a - 4) + 512); } else { vlo[a - 4] = s16x4{1, 2, 3, 4}; vhi[a - 4] = s16x4{5, 6, 7, 8}; } DA_SBAR(); } }
        if constexpr (QK) {
            if (a & 1) C1 = (a < 2) ? DA_MFMA(kf[a], qr[a >> 1], f32x16{}) : DA_MFMA(kf[a], qr[a >> 1], C1);
            else       C0 = (a < 2) ? DA_MFMA(kf[a], qr[a >> 1], f32x16{}) : DA_MFMA(kf[a], qr[a >> 1], C0);
            if (a < 4) dma_piece(dj, a);
            DA_SBAR();
        }
    }
    u32x4 pwn[4]; pwn[0] = u32x4{}; pwn[1] = u32x4{}; pwn[2] = u32x4{}; pwn[3] = u32x4{};
    float s0 = 0.f, s1 = 0.f;
#pragma unroll
    for (int p = 0; p < 16; ++p) {
        if constexpr (PV) {
            const bf16x8 vf = (bf16x8){vlo[p & 3][0], vlo[p & 3][1], vlo[p & 3][2], vlo[p & 3][3], vhi[p & 3][0], vhi[p & 3][1], vhi[p & 3][2], vhi[p & 3][3]};
            if (VAR != 3) o[p & 3] = DA_MFMA(__builtin_bit_cast(bf16x8, pw[p >> 2]), vf, o[p & 3]); else { o[p & 3][0] += __builtin_bit_cast(float, (int)vf[0] | ((int)vf[4] << 16)); }
            if (p < 12 && VAR != 4) { vlo[p & 3] = vtr(vp + DA_FOFF(p + 4)); vhi[p & 3] = vtr(vp + DA_FOFF(p + 4) + 512); }
        }
        if constexpr (QK) {
            float e0, e1;
            if (VAR == 2) { if (p < 8) { e0 = C0[2 * p]; e1 = C0[2 * p + 1]; } else { e0 = C1[2 * p - 16]; e1 = C1[2 * p - 15]; } }
            else if (p < 8) { e0 = __builtin_amdgcn_exp2f(C0[2 * p]); e1 = __builtin_amdgcn_exp2f(C0[2 * p + 1]); }
            else       { e0 = __builtin_amdgcn_exp2f(C1[2 * p - 16]); e1 = __builtin_amdgcn_exp2f(C1[2 * p - 15]); }
            s0 += e0; s1 += e1; pwn[p >> 2][p & 3] = cvtpk_s(e0, e1);
            DA_PIN(s0); DA_PIN(s1); DA_PIN(pwn[p >> 2]);
            if (p >= 8 && VAR != 6) { const int j = p - 8; kf[j] = *(const __attribute__((address_space(3))) bf16x8*)(kpn + (j >> 1) * 2048 + (j & 1) * 512); }
        }
        DA_SBAR();
    }
    if constexpr (QK) { l_reg += s0 + s1; pw[0] = pwn[0]; pw[1] = pwn[1]; pw[2] = pwn[2]; pw[3] = pwn[3]; }
#undef DA_FOFF
}

template <bool QK, bool PV>
__device__ __forceinline__ void step2(lds_cptr kpn, lds_cptr vp, const bf16x8 (&qr)[4], bf16x8 (&kf)[8], f32x16 (&o)[4], u32x4 (&pw)[4], float& l_reg, const DmaJob& dj,
                                      f32x16& Cn0, f32x16& Cn1, const f32x16& Pp0, const f32x16& Pp1) {
    s16x4 vlo[4], vhi[4];
#define DA_FOFF(f) ((((f) & 3) * 4096) + (((f) >> 2) * 1024))
    if constexpr (!QK) { dma_piece(dj, 0); dma_piece(dj, 1); dma_piece(dj, 2); dma_piece(dj, 3); }
    float s0 = 0.f, s1 = 0.f;
#pragma unroll
    for (int a = 0; a < 8; ++a) {
        if constexpr (PV) { if (a >= 4) { vlo[a - 4] = vtr(vp + DA_FOFF(a - 4)); vhi[a - 4] = vtr(vp + DA_FOFF(a - 4) + 512); DA_SBAR(); } }
        if constexpr (QK) {
            if (a & 1) Cn1 = (a < 2) ? DA_MFMA(kf[a], qr[a >> 1], f32x16{}) : DA_MFMA(kf[a], qr[a >> 1], Cn1);
            else       Cn0 = (a < 2) ? DA_MFMA(kf[a], qr[a >> 1], f32x16{}) : DA_MFMA(kf[a], qr[a >> 1], Cn0);
            if (a < 4) dma_piece(dj, a);
        }
        if constexpr (PV) {
            float x0, x1, x2, x3;
            if (a < 4) { x0 = Pp0[4 * a]; x1 = Pp0[4 * a + 1]; x2 = Pp0[4 * a + 2]; x3 = Pp0[4 * a + 3]; }
            else       { x0 = Pp1[4 * a - 16]; x1 = Pp1[4 * a - 15]; x2 = Pp1[4 * a - 14]; x3 = Pp1[4 * a - 13]; }
            s0 += x0; s1 += x1; s0 += x2; s1 += x3;
            pw[(2 * a) >> 2][(2 * a) & 3] = cvtpk_s(x0, x1); pw[(2 * a + 1) >> 2][(2 * a + 1) & 3] = cvtpk_s(x2, x3);
            DA_PIN(s0); DA_PIN(s1); DA_PIN(pw[(2 * a) >> 2]);
        }
        if constexpr (QK || PV) DA_SBAR();
    }
    if constexpr (PV) l_reg += s0 + s1;
#pragma unroll
    for (int p = 0; p < 16; ++p) {
        if constexpr (PV) {
            const bf16x8 vf = (bf16x8){vlo[p & 3][0], vlo[p & 3][1], vlo[p & 3][2], vlo[p & 3][3], vhi[p & 3][0], vhi[p & 3][1], vhi[p & 3][2], vhi[p & 3][3]};
            o[p & 3] = DA_MFMA(__builtin_bit_cast(bf16x8, pw[p >> 2]), vf, o[p & 3]);
            if (p < 12) { vlo[p & 3] = vtr(vp + DA_FOFF(p + 4)); vhi[p & 3] = vtr(vp + DA_FOFF(p + 4) + 512); }
        }
        if constexpr (QK) {
            if (p < 8) { Cn0[2 * p] = __builtin_amdgcn_exp2f(Cn0[2 * p]); Cn0[2 * p + 1] = __builtin_amdgcn_exp2f(Cn0[2 * p + 1]); DA_PIN(Cn0); }
            else       { Cn1[2 * p - 16] = __builtin_amdgcn_exp2f(Cn1[2 * p - 16]); Cn1[2 * p - 15] = __builtin_amdgcn_exp2f(Cn1[2 * p - 15]); DA_PIN(Cn1); }
            if (p >= 8) { const int j = p - 8; kf[j] = *(const __attribute__((address_space(3))) bf16x8*)(kpn + (j >> 1) * 2048 + (j & 1) * 512); }
        }
        if constexpr (QK || PV) DA_SBAR();
    }
#undef DA_FOFF
}

template <int VAR>
__device__ __forceinline__ void attn_unit(const Unit& u, char* shm, float lam, float one_m_li, const float* sub_gain, int tid) {
    asm volatile("" : "+v"(tid));
    const int lane = tid & 63, r32 = lane & 31, hi = lane >> 5; const int wid = __builtin_amdgcn_readfirstlane(tid >> 6), s = wid >> 2, g = wid & 3;
    const int NT = u.NT; const int wt = u.full ? (g < 2 ? NT - 1 : NT) : (g < 2 ? NT : 0);
    const unsigned lds0 = (unsigned)(uintptr_t)shm;
    float* wsf = (float*)(shm + WSF_OFF) + wid * 64;
    const bf16* ksrc = u.K + (long)lane * DM + wid * 8;
    const bf16* vsrc = u.V + (long)(16 * (wid & 3) + (lane >> 2)) * DM + (wid >> 2) * 32 + (lane & 3) * 8;
    const unsigned kdst = lds0 + wid * 1024, vdst = lds0 + VRING + wid * 1024;
#define DA_DMA_K(t, slot) do { const int tt_ = u.dma0 ? 0 : (t) < NT ? (t) : NT - 1; const bf16* kp_ = ksrc + (long)tt_ * 64 * DM; \
        glds16(kp_, (unsigned)__builtin_amdgcn_readfirstlane(kdst + (slot) * KSLOT)); glds16(kp_ + 64, (unsigned)__builtin_amdgcn_readfirstlane(kdst + 8192 + (slot) * KSLOT)); } while (0)
#define DA_DMA_V(t, slot) do { const int tt_ = u.dma0 ? 0 : (t) < NT ? (t) : NT - 1; const bf16* vp_ = vsrc + (long)tt_ * 64 * DM; \
        glds16(vp_, (unsigned)__builtin_amdgcn_readfirstlane(vdst + (slot) * VSLOT)); glds16(vp_ + 64, (unsigned)__builtin_amdgcn_readfirstlane(vdst + 8192 + (slot) * VSLOT)); } while (0)
    const lds_cptr shm3 = (lds_cptr)shm;
    const lds_cptr kp0 = shm3 + s * 8192 + hi * 1024 + r32 * 16;
    const lds_cptr vp0 = shm3 + VRING + ((lane >> 4) & 1) * 32 + (lane & 3) * 8 + (4 * hi + ((lane & 15) >> 2)) * 64;
    DA_DMA_K(0, 0); DA_DMA_K(1, 1); DA_DMA_K(2, 2); DA_DMA_V(0, 0);
    bf16x8 qr[4];
    { const bf16* Qw = u.Q + (long)(32 * g + r32) * DM + s * 64;
#pragma unroll
      for (int d0 = 0; d0 < 4; ++d0) qr[d0] = (wt > 0) ? *reinterpret_cast<const bf16x8*>(Qw + d0 * 16 + hi * 8) : (bf16x8){0, 0, 0, 0, 0, 0, 0, 0}; }
    asm volatile("" : "+v"(qr[0]), "+v"(qr[1]), "+v"(qr[2]), "+v"(qr[3]));
    f32x16 o[4]; o[0] = f32x16{}; o[1] = f32x16{}; o[2] = f32x16{}; o[3] = f32x16{};
    float l_reg = 0.f;
    u32x4 pw[4]; pw[0] = u32x4{}; pw[1] = u32x4{}; pw[2] = u32x4{}; pw[3] = u32x4{};
    DA_WAIT_BAR(0);
    bf16x8 kf[8];
#pragma unroll
    for (int j = 0; j < 8; ++j) kf[j] = *(const __attribute__((address_space(3))) bf16x8*)(kp0 + (j >> 1) * 2048 + (j & 1) * 512);
    int ks_cur = 0  , vs_prev = 2  ;
#define DA_TOP(t) \
        DA_WAIT_BAR(4);                                          \
        const int ks_next = (ks_cur == 2) ? 0 : ks_cur + 1, vs_cur = (vs_prev == 2) ? 0 : vs_prev + 1, vs_next = (vs_cur == 2) ? 0 : vs_cur + 1; \
        DmaJob dj; { const int tk_ = ((t) + 3) < NT ? ((t) + 3) : NT - 1, tv_ = ((t) + 1) < NT ? ((t) + 1) : NT - 1; dj.kp = ksrc + (long)tk_ * 64 * DM; dj.vp = vsrc + (long)tv_ * 64 * DM; \
          dj.kd0 = (unsigned)__builtin_amdgcn_readfirstlane(kdst + ks_cur * KSLOT); dj.kd1 = dj.kd0 + 8192u; dj.vd0 = (unsigned)__builtin_amdgcn_readfirstlane(vdst + vs_next * VSLOT); dj.vd1 = dj.vd0 + 8192u; }     \
        const lds_cptr kpn = kp0 + ks_next * KSLOT; const lds_cptr vp = vp0 + vs_prev * VSLOT; (void)kpn; (void)vp
#define DA_ROT() do { ks_cur = ks_next; vs_prev = vs_cur; } while (0)
    f32x16 pA0 = f32x16{}, pA1 = f32x16{}, pB0 = f32x16{}, pB1 = f32x16{};
#define DA_IDLE() do { dma_piece(dj, 0); dma_piece(dj, 1); dma_piece(dj, 2); dma_piece(dj, 3); } while (0)
    int t = 0;
    const bool odd = ((wt - 1) & 1) != 0;
    { DA_TOP(0); if (wt > 0) { if (odd) step2<true, false>(kpn, vp, qr, kf, o, pw, l_reg, dj, pB0, pB1, pA0, pA1); else step2<true, false>(kpn, vp, qr, kf, o, pw, l_reg, dj, pA0, pA1, pB0, pB1); } else DA_IDLE(); DA_ROT(); }
    t = 1;
    if (wt > 0 && odd) { DA_TOP(t); step2<true, true>(kpn, vp, qr, kf, o, pw, l_reg, dj, pA0, pA1, pB0, pB1); DA_ROT(); ++t; }
    for (; t + 1 < wt; t += 2) {
        { DA_TOP(t);     step2<true, true>(kpn, vp, qr, kf, o, pw, l_reg, dj, pB0, pB1, pA0, pA1); DA_ROT(); }
        { DA_TOP(t + 1); step2<true, true>(kpn, vp, qr, kf, o, pw, l_reg, dj, pA0, pA1, pB0, pB1); DA_ROT(); }
    }
    if (wt > 0) { DA_TOP(t); step2<false, true>(kpn, vp, qr, kf, o, pw, l_reg, dj, pB0, pB1, pA0, pA1); DA_ROT(); ++t; }
    for (; t <= NT; ++t) { DA_TOP(t); DA_IDLE(); DA_ROT(); }
#undef DA_IDLE
#undef DA_TOP
#undef DA_ROT
    { auto rr = __builtin_amdgcn_permlane32_swap(__float_as_uint(l_reg), __float_as_uint(l_reg), false, false); l_reg = __uint_as_float(rr[0]) + __uint_as_float(rr[1]); }
    if (hi == 0) wsf[r32] = l_reg;
    DA_WAIT_BAR(0);
    float rli[16];
#pragma unroll
    for (int r = 0; r < 16; ++r) { const float lq = wsf[crow(r, hi)]; rli[r] = (s == 0 ? 1.f : -lam) / lq; }
    int le = lane; asm volatile("" : "+v"(le));
    const int r32e = le & 31, hie = le >> 5;
    float* xch = (float*)(shm + g * XCHB);
    if (s == 1 && wt > 0) {
#pragma unroll
        for (int db = 0; db < 4; ++db)
#pragma unroll
            for (int r = 0; r < 16; ++r) xch[(db * 16 + r) * 64 + le] = o[db][r] * rli[r];
    }
    DA_WAIT_BAR(0);
    if (s == 0 && wt > 0) {
#pragma unroll
        for (int db = 0; db < 4; ++db)
#pragma unroll
            for (int r = 0; r < 16; ++r) o[db][r] = o[db][r] * rli[r] + xch[(db * 16 + r) * 64 + le];
        asm volatile("s_waitcnt lgkmcnt(0)" ::: "memory");
#pragma unroll
        for (int db = 0; db < 4; ++db)
#pragma unroll
            for (int r = 0; r < 16; ++r) xch[crow(r, hie) * STP + 32 * db + r32e] = o[db][r];
        asm volatile("s_waitcnt lgkmcnt(0)" ::: "memory");
        const int row = le >> 1, half = le & 1;
        float v[64]; float ss = 0.f;
#pragma unroll
        for (int k = 0; k < 16; ++k) { const f32x4 x = *(const f32x4*)(xch + row * STP + half * 64 + 4 * k); v[4 * k] = x.x; v[4 * k + 1] = x.y; v[4 * k + 2] = x.z; v[4 * k + 3] = x.w; ss += (x.x * x.x + x.y * x.y) + (x.z * x.z + x.w * x.w); }
        ss += __shfl_xor(ss, 1);
        const float sc = one_m_li / sqrtf(ss * (1.f / 128.f) + EPS);
        const bf16* gp = u.G + (long)(32 * g + row) * DM + half * 64; bf16* op = u.AO + (long)(32 * g + row) * DM + half * 64; const float* sg = sub_gain + half * 64;
#pragma unroll
        for (int k = 0; k < 8; ++k) { const v4u g4 = *(const v4u*)(gp + 8 * k); const f32x4 ga = *(const f32x4*)(sg + 8 * k), gb = *(const f32x4*)(sg + 8 * k + 4);
            const float gg[8] = {bflo(g4.x), bfhi(g4.x), bflo(g4.y), bfhi(g4.y), bflo(g4.z), bfhi(g4.z), bflo(g4.w), bfhi(g4.w)};
            const float gn[8] = {ga.x, ga.y, ga.z, ga.w, gb.x, gb.y, gb.z, gb.w}; float y[8];
#pragma unroll
            for (int e = 0; e < 8; ++e) y[e] = v[8 * k + e] * sc * gn[e] * silu_f(gg[e]);
            v4u w; w.x = pk2(y[0], y[1]); w.y = pk2(y[2], y[3]); w.z = pk2(y[4], y[5]); w.w = pk2(y[6], y[7]);
            *(v4u*)(op + 8 * k) = w; }
    }
    DA_WAIT_BAR(0);
#undef DA_DMA_K
#undef DA_DMA_V
}
}
template <int VAR = 0>
__device__ __forceinline__ void attn_fast(Frame& F, const bf16* Qs, const bf16* KP, const bf16* VP, const bf16* KC, const bf16* VC, const bf16* GA  , bf16* AO,
                                          float lam, float one_m_li, const float* sub_gain, int dma0 = 0) {
    const int NU = 2048 + 16 * NB;
    const bool xcd = (F.G == 256);
    for (int i = 0;; ++i) {
        int qb, h, b = -1;
        if (xcd) { const int x = F.bid & 7, r = F.bid >> 3;
            if (i < 8) { h = x + 8 * (i >> 2); const int rr = (i == 0) ? (r ^ 8) : r; qb = 127 - ((i & 3) * 32 + ((i & 1) ? 31 - rr : rr)); }
            else if (i == 8 && (r & 8) == 0) { const int sb = (r & 7) + ((r >> 4) << 3); h = x + 8 * (sb >> 3); b = sb & 7; qb = 0; }
            else break;
        } else { const int idx = i * F.G + ((i & 1) ? F.G - 1 - F.bid : F.bid); if (idx >= NU) break;
            if (idx < 2048) { qb = 127 - (idx >> 4); h = idx & 15; } else { const int j = idx - 2048; b = j >> 4; h = j & 15; qb = 0; } }
        dattn::Unit u; u.dma0 = dma0;
        if (b < 0) { const long row0 = 128L * qb;
            u.Q = Qs + row0 * DM + h * 128; u.K = KP + h * 128; u.V = VP + h * 128; u.G = GA + row0 * DM + h * 128; u.AO = AO + row0 * DM + h * 128; u.NT = 2 * qb + 2; u.full = 1; }
        else { const long row0 = MP + 64L * b;
            u.Q = Qs + row0 * DM + h * 128; u.K = KC + (long)b * KCROWS * DM + h * 128; u.V = VC + (long)b * KCROWS * DM + h * 128; u.G = GA + row0 * DM + h * 128; u.AO = AO + row0 * DM + h * 128; u.NT = KCROWS / 64; u.full = 0; }
        dattn::attn_unit<VAR>(u, (char*)F.lds + RING_OFF, lam, one_m_li, sub_gain, F.tid);
    }
}
constexpr int RBLK = 72;
__device__ __forceinline__ float ret_lg2(int h) { return log2f(1.f - exp2f(-5.f - (float)h)); }
struct EpiRet {
    static constexpr int BMODE = 0;
    pg8::bf16_t* QP; pg8::bf16_t* KN; pg8::bf16_t* KT; pg8::bf16_t* VS; pg8::bf16_t* RG; const float* tab; const float* ssq;
    __device__ __forceinline__ void operator()(const pg8::f32x4 (&acc)[2][2][4][2], const pg8::Unit& u, int wr, int wc, int fr, int fq) const {
        { const int l_ = lane_now(); fr = l_ & 15; fq = l_ >> 4; }
        const int pn = u.pn, pm = u.pm; float rs[2][4]; row_rstd(ssq, pm, wr, fr, fq, rs);
#pragma unroll
        for (int ai = 0; ai < 2; ++ai)
#pragma unroll
            for (int m = 0; m < 4; ++m) {
                const int i = ai * 128 + wr * 64 + m * 16 + fr; const size_t row = (size_t)pm * 256 + i;
                const int J = pm < 64 ? pm : 64 + 4 * (pm - 64) + (i >> 6), jj = pm < 64 ? i : (i & 63), pos = pm < 64 ? (int)row : PAST + (i & 63);
                if (pn < 16) {
                    const int h = pn & 7; const bool isk = pn >= 8; const float sc = isk ? 0.0625f : 1.f;
#pragma unroll
                    for (int n = 0; n < 2; ++n) { const int c1 = wc * 32 + n * 16 + 4 * fq;
                        const pg8::f32x4 t0 = *(const pg8::f32x4*)(tab + ((size_t)pos * 128 + c1) * 2), t1 = *(const pg8::f32x4*)(tab + ((size_t)pos * 128 + c1) * 2 + 4);
                        const pg8::f32x4 x1 = acc[ai][0][m][n] * rs[ai][m], x2 = acc[ai][1][m][n] * rs[ai][m];
                        const float cs[4] = {t0[0], t0[2], t1[0], t1[2]}, sn[4] = {t0[1], t0[3], t1[1], t1[3]}; float o1[4], o2[4];
#pragma unroll
                        for (int e = 0; e < 4; ++e) { o1[e] = (x1[e] * cs[e] - x2[e] * sn[e]) * sc; o2[e] = (x2[e] * cs[e] + x1[e] * sn[e]) * sc; }
                        v2u w1, w2; w1.x = pk2(o1[0], o1[1]); w1.y = pk2(o1[2], o1[3]); w2.x = pk2(o2[0], o2[1]); w2.y = pk2(o2[2], o2[3]);
                        if (!isk) { pg8::bf16_t* p = QP + row * 4096 + h * 512 + 256 + c1; *(v2u*)p = w1; *(v2u*)(p + 128) = w2; }
                        else { pg8::bf16_t* p = KN + row * 2048 + h * 256 + c1; *(v2u*)p = w1; *(v2u*)(p + 128) = w2;
                            pg8::bf16_t* t = KT + ((size_t)(J * 8 + h) * 256 + c1) * 256 + jj;
#pragma unroll
                            for (int e = 0; e < 4; ++e) { t[(size_t)e * 256] = (pg8::bf16_t)f2bf(o1[e]); t[(size_t)(128 + e) * 256] = (pg8::bf16_t)f2bf(o2[e]); } } }
                } else if (pn < 32) {
                    const int h = (pn - 16) >> 1, half = (pn - 16) & 1; const float f = exp2f(-(float)(1 + jj) * ret_lg2(h)) * rs[ai][m];
#pragma unroll
                    for (int bj = 0; bj < 2; ++bj)
#pragma unroll
                        for (int n = 0; n < 2; ++n) { const int dv = half * 256 + bj * 128 + wc * 32 + n * 16 + 4 * fq; pg8::bf16_t* t = VS + ((size_t)(J * 8 + h) * 512 + dv) * 512 + jj;
#pragma unroll
                            for (int e = 0; e < 4; ++e) t[(size_t)e * 512] = (pg8::bf16_t)f2bf(acc[ai][bj][m][n][e] * f); }
                } else {
#pragma unroll
                    for (int bj = 0; bj < 2; ++bj)
#pragma unroll
                        for (int n = 0; n < 2; ++n) { const int c = (pn - 32) * 256 + bj * 128 + wc * 32 + n * 16 + 4 * fq; const pg8::f32x4 x = acc[ai][bj][m][n] * rs[ai][m];
                            v2u w; w.x = pk2(x[0], x[1]); w.y = pk2(x[2], x[3]); *(v2u*)(RG + row * 4096 + c) = w; }
                }
            }
    }
};
__device__ __forceinline__ size_t ret_row0(int J) { return J < 64 ? (size_t)256 * J : (size_t)MP + 64 * (J - 64); }
struct RetQKOrder {
    int G, c; const char* QP; const char* KN;
    __device__ __forceinline__ bool next(int i, pg8::Unit& u) const { const int L = i * G + c; if (L >= RBLK * 8) return false; const int J = L >> 3, h = L & 7; const size_t r0 = ret_row0(J);
        u.pm = J; u.pn = h; u.a = QP + (r0 * 4096 + h * 512 + 256) * 2; u.b = KN + (r0 * 2048 + h * 256) * 2; return true; }
    __device__ __forceinline__ void a_ready(const pg8::Unit&) const {}
    __device__ __forceinline__ void done(const pg8::Unit&) const {}
};
struct EpiRetQK {
    static constexpr int BMODE = 1;
    pg8::bf16_t* QP;
    __device__ __forceinline__ void operator()(const pg8::f32x4 (&acc)[2][2][4][2], const pg8::Unit& u, int wr, int wc, int fr, int fq) const {
        { const int l_ = lane_now(); fr = l_ & 15; fq = l_ >> 4; }
        const int J = u.pm, h = u.pn, nv = J < 64 ? 256 : 64; const size_t r0 = ret_row0(J);
#pragma unroll
        for (int ai = 0; ai < 2; ++ai)
#pragma unroll
            for (int m = 0; m < 4; ++m) { const int i = ai * 128 + wr * 64 + m * 16 + fr;
                if (i < nv) {
#pragma unroll
                    for (int bj = 0; bj < 2; ++bj) { const int j0 = bj * 128 + wc * 32 + 8 * fq; const pg8::f32x4 v0 = acc[ai][bj][m][0], v1 = acc[ai][bj][m][1]; float x[8] = {v0[0], v0[1], v0[2], v0[3], v1[0], v1[1], v1[2], v1[3]};
#pragma unroll
                        for (int k = 0; k < 8; ++k) x[k] = (j0 + k <= i) ? x[k] : 0.f;
                        v4u w; w.x = pk2(x[0], x[1]); w.y = pk2(x[2], x[3]); w.z = pk2(x[4], x[5]); w.w = pk2(x[6], x[7]);
                        *(v4u*)(QP + (r0 + i) * 4096 + h * 512 + j0) = w; } } }
    }
};
struct RetOOrder {
    int G, c; const char* QP; const char* VS;
    __device__ __forceinline__ bool next(int i, pg8::Unit& u) const { const int L = i * G + c; if (L >= RBLK * 16) return false; const int J = L >> 4, r = L & 15, h = r >> 1, half = r & 1; const size_t r0 = ret_row0(J);
        u.pm = J; u.pn = r; u.a = QP + (r0 * 4096 + h * 512) * 2; u.b = VS + (((size_t)(J * 8 + h) * 512 + half * 256) * 512) * 2; return true; }
    __device__ __forceinline__ void a_ready(const pg8::Unit&) const {}
    __device__ __forceinline__ void done(const pg8::Unit&) const {}
};
struct EpiRetO {
    static constexpr int BMODE = 1;
    pg8::bf16_t* O;
    __device__ __forceinline__ void operator()(const pg8::f32x4 (&acc)[2][2][4][2], const pg8::Unit& u, int wr, int wc, int fr, int fq) const {
        { const int l_ = lane_now(); fr = l_ & 15; fq = l_ >> 4; }
        const int J = u.pm, h = u.pn >> 1, half = u.pn & 1, nv = J < 64 ? 256 : 64; const size_t r0 = ret_row0(J); const float lg = ret_lg2(h);
#pragma unroll
        for (int ai = 0; ai < 2; ++ai)
#pragma unroll
            for (int m = 0; m < 4; ++m) { const int i = ai * 128 + wr * 64 + m * 16 + fr;
                if (i < nv) { const float f = exp2f((float)(i + 1) * lg);
#pragma unroll
                    for (int bj = 0; bj < 2; ++bj) { const int j0 = bj * 128 + wc * 32 + 8 * fq; const pg8::f32x4 v0 = acc[ai][bj][m][0] * f, v1 = acc[ai][bj][m][1] * f;
                        v4u w; w.x = pk2(v0[0], v0[1]); w.y = pk2(v0[2], v0[3]); w.z = pk2(v1[0], v1[1]); w.w = pk2(v1[2], v1[3]);
                        *(v4u*)(O + (r0 + i) * 4096 + h * 512 + half * 256 + j0) = w; } } }
    }
};
struct RetKVOrder {
    int G, c; const char* VS; const char* KT;
    __device__ __forceinline__ bool next(int i, pg8::Unit& u) const { const int L = i * G + c; if (L >= RBLK * 16) return false; const int J = L >> 4, r = L & 15, h = r >> 1, half = r & 1;
        u.pm = J; u.pn = r; u.a = VS + (((size_t)(J * 8 + h) * 512 + half * 256) * 512) * 2; u.b = KT + ((size_t)(J * 8 + h) * 256 * 256) * 2; return true; }
    __device__ __forceinline__ void a_ready(const pg8::Unit&) const {}
    __device__ __forceinline__ void done(const pg8::Unit&) const {}
};
struct EpiRetKV {
    static constexpr int BMODE = 1;
    pg8::bf16_t* VS; pg8::bf16_t* KVX;
    __device__ __forceinline__ void operator()(const pg8::f32x4 (&acc)[2][2][4][2], const pg8::Unit& u, int wr, int wc, int fr, int fq) const {
        { const int l_ = lane_now(); fr = l_ & 15; fq = l_ >> 4; }
        const int J = u.pm, h = u.pn >> 1, half = u.pn & 1;
        pg8::bf16_t* base; int pitch;
        if (J < 63) { base = VS + ((size_t)((J + 1) * 8 + h) * 512 + half * 256) * 512 + 256; pitch = 512; }
        else { base = KVX + ((size_t)((J - 63) * 8 + h) * 512 + half * 256) * 256; pitch = 256; }
#pragma unroll
        for (int ai = 0; ai < 2; ++ai)
#pragma unroll
            for (int m = 0; m < 4; ++m) { pg8::bf16_t* rowp = base + (size_t)(ai * 128 + wr * 64 + m * 16 + fr) * pitch + wc * 32 + 8 * fq;
#pragma unroll
                for (int bj = 0; bj < 2; ++bj) { const pg8::f32x4 v0 = acc[ai][bj][m][0], v1 = acc[ai][bj][m][1];
                    v4u w; w.x = pk2(v0[0], v0[1]); w.y = pk2(v0[2], v0[3]); w.z = pk2(v1[0], v1[1]); w.w = pk2(v1[2], v1[3]);
                    *(v4u*)(rowp + bj * 128) = w; } }
    }
};
__device__ __forceinline__ void ret_scan(Frame& F, bf16* VS, const bf16* KVX, const float* state_in, float* osp, float* oss) {
    const int gt = F.bid * NTHR + F.tid;
    for (int c = gt; c < 8 * 512 * 32; c += F.G * NTHR) {
        const int h = c >> 14, dv = (c >> 5) & 511, dk0 = (c & 31) * 8; const float lg = ret_lg2(h), g256 = exp2f(256.f * lg), g64 = exp2f(64.f * lg);
        float S[8];
#pragma unroll
        for (int k = 0; k < 8; ++k) S[k] = 0.f;
        bf16* slot = VS + ((size_t)h * 512 + dv) * 512 + 256 + dk0;
        *(v4u*)slot = (v4u){0u, 0u, 0u, 0u};
        v4u nx = *(const v4u*)(slot + (size_t)8 * 512 * 512);
        for (int J = 1; J < 64; ++J) {
            const v4u kv = nx; bf16* sj = slot + (size_t)J * 8 * 512 * 512;
            if (J < 63) nx = *(const v4u*)(sj + (size_t)8 * 512 * 512);
            const float x[8] = {bflo(kv.x), bfhi(kv.x), bflo(kv.y), bfhi(kv.y), bflo(kv.z), bfhi(kv.z), bflo(kv.w), bfhi(kv.w)};
#pragma unroll
            for (int k = 0; k < 8; ++k) S[k] = (S[k] + x[k]) * g256;
            v4u w; w.x = pk2(S[0], S[1]); w.y = pk2(S[2], S[3]); w.z = pk2(S[4], S[5]); w.w = pk2(S[6], S[7]);
            *(v4u*)sj = w;
        }
        { const v4u kv = *(const v4u*)(KVX + ((size_t)h * 512 + dv) * 256 + dk0);
          const float x[8] = {bflo(kv.x), bfhi(kv.x), bflo(kv.y), bfhi(kv.y), bflo(kv.z), bfhi(kv.z), bflo(kv.w), bfhi(kv.w)};
#pragma unroll
          for (int k = 0; k < 8; ++k) osp[((size_t)h * 256 + dk0 + k) * 512 + dv] = (S[k] + x[k]) * g256; }
    }
    for (int c = gt; c < NB * 8 * 512 * 32; c += F.G * NTHR) {
        const int dv = c & 511, dk0 = ((c >> 9) & 31) * 8, h = (c >> 14) & 7, b = c >> 17; const float g64 = exp2f(64.f * ret_lg2(h));
        const float* si = state_in + (((size_t)b * 8 + h) * 256 + dk0) * 512 + dv; float* so = oss + (((size_t)b * 8 + h) * 256 + dk0) * 512 + dv;
        const v4u kv = *(const v4u*)(KVX + ((size_t)((1 + b) * 8 + h) * 512 + dv) * 256 + dk0);
        const float x[8] = {bflo(kv.x), bfhi(kv.x), bflo(kv.y), bfhi(kv.y), bflo(kv.z), bfhi(kv.z), bflo(kv.w), bfhi(kv.w)}; float s0[8];
#pragma unroll
        for (int k = 0; k < 8; ++k) s0[k] = si[(size_t)k * 512];
        v4u w; w.x = pk2(s0[0], s0[1]); w.y = pk2(s0[2], s0[3]); w.z = pk2(s0[4], s0[5]); w.w = pk2(s0[6], s0[7]);
        *(v4u*)(VS + ((size_t)((64 + b) * 8 + h) * 512 + dv) * 512 + 256 + dk0) = w;
#pragma unroll
        for (int k = 0; k < 8; ++k) so[(size_t)k * 512] = (s0[k] + x[k]) * g64;
    }
}
__device__ __forceinline__ void ret_zero_pad(Frame& F, bf16* VS, bf16* KT) {
    const size_t gt = (size_t)F.bid * NTHR + F.tid, NG = (size_t)F.G * NTHR, n = (size_t)NB * 8 * 512 * 24, n2 = (size_t)NB * 8 * 256 * 24;
    for (size_t i = gt; i < n; i += NG) { const size_t rowi = i / 24, c = i % 24; *(v4u*)(VS + ((size_t)64 * 8 * 512 + rowi) * 512 + 64 + c * 8) = (v4u){0u, 0u, 0u, 0u}; }
    for (size_t i = gt; i < n2; i += NG) { const size_t rowi = i / 24, c = i % 24; *(v4u*)(KT + ((size_t)64 * 8 * 256 + rowi) * 256 + 64 + c * 8) = (v4u){0u, 0u, 0u, 0u}; }
}
__device__ __forceinline__ void ret_table(Frame& F, float* tab) {
    const size_t gt = (size_t)F.bid * NTHR + F.tid, NG = (size_t)F.G * NTHR;
    for (size_t e = gt; e < (size_t)MP * 128; e += NG) { float c, s; rope_cs((int)(e >> 7), (int)(e & 127), 128, c, s); tab[2 * e] = c; tab[2 * e + 1] = s; }
}
__device__ __forceinline__ void r_out(Frame& F, bf16* O, const bf16* RG) {
    const int gw = F.bid * NWAVES + F.wave, NGW = F.G * NWAVES, lane = F.lane;
    for (int it = gw; it < MT * 8; it += NGW) {
        const int row = it >> 3, h = it & 7; const size_t off = (size_t)row * 4096 + h * 512 + lane * 8;
        const v4u o4 = *(const v4u*)(O + off), g4 = *(const v4u*)(RG + off);
        float o[8] = {bflo(o4.x), bfhi(o4.x), bflo(o4.y), bfhi(o4.y), bflo(o4.z), bfhi(o4.z), bflo(o4.w), bfhi(o4.w)};
        const float g[8] = {bflo(g4.x), bfhi(g4.x), bflo(g4.y), bfhi(g4.y), bflo(g4.z), bfhi(g4.z), bflo(g4.w), bfhi(g4.w)};
        float ss = 0.f;
#pragma unroll
        for (int k = 0; k < 8; ++k) ss += o[k] * o[k];
        const float rstd = 1.f / sqrtf(wave_sum(ss) * (1.f / 512.f) + EPS);
#pragma unroll
        for (int k = 0; k < 8; ++k) o[k] = o[k] * rstd * silu_f(g[k]);
        v4u w; w.x = pk2(o[0], o[1]); w.y = pk2(o[2], o[3]); w.z = pk2(o[4], o[5]); w.w = pk2(o[6], o[7]);
        *(v4u*)(O + off) = w;
    }
}
struct EpiCIn {
    static constexpr int BMODE = 0;
    pg8::bf16_t* GU; pg8::bf16_t* GVT; pg8::bf16_t* SG; pg8::bf16_t* GVS; float* SSQ; const float* ssq;
    __device__ __forceinline__ void operator()(const pg8::f32x4 (&acc)[2][2][4][2], const pg8::Unit& u, int wr, int wc, int fr, int fq) const {
        { const int l_ = lane_now(); fr = l_ & 15; fq = l_ >> 4; }
        const int pn = u.pn, pm = u.pm, typ = pn >> 4, pt = pn & 15; float rs[2][4]; row_rstd(ssq, pm, wr, fr, fq, rs);
#pragma unroll
        for (int ai = 0; ai < 2; ++ai)
#pragma unroll
            for (int m = 0; m < 4; ++m) {
                const int i = ai * 128 + wr * 64 + m * 16 + fr; const size_t row = (size_t)pm * 256 + i; float ss = 0.f;
#pragma unroll
                for (int bj = 0; bj < 2; ++bj)
#pragma unroll
                    for (int n = 0; n < 2; ++n) { const int c = pt * 256 + bj * 128 + wc * 32 + n * 16 + 4 * fq; const pg8::f32x4 x = acc[ai][bj][m][n] * rs[ai][m]; float y[4];
                        if (typ == 2) {
#pragma unroll
                            for (int e = 0; e < 4; ++e) y[e] = silu_f(x[e]);
                            v2u w; w.x = pk2(y[0], y[1]); w.y = pk2(y[2], y[3]); *(v2u*)(SG + row * 4096 + c) = w;
                        } else {
#pragma unroll
                            for (int e = 0; e < 4; ++e) y[e] = gelu_tanh_f(x[e]);
                            v2u w; w.x = pk2(y[0], y[1]); w.y = pk2(y[2], y[3]);
                            if (typ == 0) *(v2u*)(GU + row * 4096 + c) = w;
                            else { ss += (y[0] * y[0] + y[1] * y[1]) + (y[2] * y[2] + y[3] * y[3]);
                                pg8::bf16_t* t = GVT + ((size_t)pm * 4096 + c) * 256 + i;
                                t[0] = (pg8::bf16_t)(w.x & 0xffffu); t[256] = (pg8::bf16_t)(w.x >> 16); t[512] = (pg8::bf16_t)(w.y & 0xffffu); t[768] = (pg8::bf16_t)(w.y >> 16);
                                if (pm >= 64) *(v2u*)(GVS + (row - MP) * 4096 + c) = w; } } }
                if (typ == 1) { ss += __shfl_xor(ss, 16); ss += __shfl_xor(ss, 32); if (fq == 0) SSQ[row * 64 + pt * 4 + wc] = ss; }
                if (m & 1) asm volatile("" ::: "memory");
            }
    }
};
__device__ __forceinline__ void c_prep(Frame& F, const float* SSQ, const float* wsin, const float* vgain, const bf16* GVS, bf16* Wm, float* ovm) {
    LAS float* rs = (LAS float*)(F.lds + RING_OFF);
    const int tid = F.tid;
    for (int it = F.bid; it < 66 * 8; it += F.G) {
        const int J = it >> 3, g = it & 7;
        __syncthreads();
        if (tid < 256) { const float* p = SSQ + ((size_t)J * 256 + tid) * 64; float s = 0.f;
#pragma unroll
            for (int k = 0; k < 16; ++k) { const f32x4 x = *(const f32x4*)(p + 4 * k); s += (x.x + x.y) + (x.z + x.w); }
            rs[tid] = 1.f / sqrtf(s * (1.f / 4096.f) + EPS); }
        __syncthreads();
        bf16* wm = Wm + (size_t)(J * 8 + g) * 65536; const int sh = J < 64 ? 7 : 6, cm = (1 << sh) - 1;
        for (int e8 = tid; e8 < 8192; e8 += NTHR) { const int i = e8 >> 5, j0 = (e8 & 31) * 8, il = i & cm, jl0 = j0 & cm; float y[8];
            if ((i >> sh) == (j0 >> sh) && jl0 <= il) { const float* wr_ = wsin + ((size_t)g * 128 + il) * 128 + jl0; const f32x4 a = *(const f32x4*)wr_, b = *(const f32x4*)(wr_ + 4);
                const float wv[8] = {a.x, a.y, a.z, a.w, b.x, b.y, b.z, b.w};
#pragma unroll
                for (int k = 0; k < 8; ++k) y[k] = (jl0 + k <= il) ? wv[k] * rs[j0 + k] : 0.f;
            } else {
#pragma unroll
                for (int k = 0; k < 8; ++k) y[k] = 0.f; }
            v4u w; w.x = pk2(y[0], y[1]); w.y = pk2(y[2], y[3]); w.z = pk2(y[4], y[5]); w.w = pk2(y[6], y[7]);
            *(v4u*)(wm + i * 256 + j0) = w; }
    }
    const int gw = F.bid * NWAVES + F.wave, NGW = F.G * NWAVES, lane = F.lane;
    for (int r = gw; r < MS; r += NGW) {
        const float rstd = 1.f / sqrtf(wave_sum(SSQ[((size_t)MP + r) * 64 + lane]) * (1.f / 4096.f) + EPS);
#pragma unroll
        for (int k = 0; k < 8; ++k) { const int col = k * 512 + lane * 8; const v4u v4 = *(const v4u*)(GVS + (size_t)r * 4096 + col);
            const f32x4 ga = *(const f32x4*)(vgain + col), gb = *(const f32x4*)(vgain + col + 4);
            float* o = ovm + (size_t)r * 4096 + col;
            *(f32x4*)o = (f32x4){bflo(v4.x) * rstd * ga.x, bfhi(v4.x) * rstd * ga.y, bflo(v4.y) * rstd * ga.z, bfhi(v4.y) * rstd * ga.w};
            *(f32x4*)(o + 4) = (f32x4){bflo(v4.z) * rstd * gb.x, bfhi(v4.z) * rstd * gb.y, bflo(v4.w) * rstd * gb.z, bfhi(v4.w) * rstd * gb.w}; }
    }
}
struct CMixOrder {
    int G, c; const char* Wm; const char* GVT;
    __device__ __forceinline__ bool next(int i, pg8::Unit& u) const { const int L = i * G + c; if (L >= 66 * 16) return false; const int J = L >> 4, nt = L & 15;
        u.pm = J; u.pn = nt; u.a = Wm + ((size_t)(J * 8 + (nt >> 1)) * 65536) * 2; u.b = GVT + (((size_t)J * 4096 + nt * 256) * 256) * 2; return true; }
    __device__ __forceinline__ void a_ready(const pg8::Unit&) const {}
    __device__ __forceinline__ void done(const pg8::Unit&) const {}
};
struct EpiCMix {
    static constexpr int BMODE = 1;
    pg8::bf16_t* GU; const pg8::bf16_t* SG; const float* vgain; const float* bs;
    __device__ __forceinline__ void operator()(const pg8::f32x4 (&acc)[2][2][4][2], const pg8::Unit& u, int wr, int wc, int fr, int fq) const {
        { const int l_ = lane_now(); fr = l_ & 15; fq = l_ >> 4; }
        const int J = u.pm, nt = u.pn, g = nt >> 1, cm = J < 64 ? 127 : 63;
#pragma unroll
        for (int bj = 0; bj < 2; ++bj) { const int c0 = nt * 256 + bj * 128 + wc * 32 + 8 * fq; const f32x4 ga = *(const f32x4*)(vgain + c0), gb = *(const f32x4*)(vgain + c0 + 4);
            const float gn[8] = {ga.x, ga.y, ga.z, ga.w, gb.x, gb.y, gb.z, gb.w};
#pragma unroll
            for (int ai = 0; ai < 2; ++ai)
#pragma unroll
                for (int m = 0; m < 4; ++m) { const int i = ai * 128 + wr * 64 + m * 16 + fr; const size_t off = ((size_t)J * 256 + i) * 4096 + c0; const float b = bs[g * 128 + (i & cm)];
                    const v4u u4 = *(const v4u*)(GU + off), s4 = *(const v4u*)(SG + off); const pg8::f32x4 v0 = acc[ai][bj][m][0], v1 = acc[ai][bj][m][1];
                    const float mx[8] = {v0[0], v0[1], v0[2], v0[3], v1[0], v1[1], v1[2], v1[3]};
                    const float uu[8] = {bflo(u4.x), bfhi(u4.x), bflo(u4.y), bfhi(u4.y), bflo(u4.z), bfhi(u4.z), bflo(u4.w), bfhi(u4.w)};
                    const float sg[8] = {bflo(s4.x), bfhi(s4.x), bflo(s4.y), bfhi(s4.y), bflo(s4.z), bfhi(s4.z), bflo(s4.w), bfhi(s4.w)}; float y[8];
#pragma unroll
                    for (int k = 0; k < 8; ++k) y[k] = uu[k] * (mx[k] * gn[k] + b) * sg[k];
                    v4u w; w.x = pk2(y[0], y[1]); w.y = pk2(y[2], y[3]); w.z = pk2(y[4], y[5]); w.w = pk2(y[6], y[7]);
                    *(v4u*)(GU + off) = w; } }
    }
};
__device__ __forceinline__ float diff_lambda(const float* q1, const float* k1, const float* q2, const float* k2, float lam_init) {
    float a = 0.f, b = 0.f;
    for (int i = 0; i < 64; ++i) { a += q1[i] * k1[i]; b += q2[i] * k2[i]; }
    return expf(a) - expf(b) + lam_init;
}

constexpr int N_PHASES = 21;
__global__ void __launch_bounds__(NTHR, 2) mega(Args args) {
    extern __shared__ __attribute__((aligned(16))) unsigned char lds[];
    Frame F;
    F.lds = (LAS unsigned char*)lds; F.tid = threadIdx.x; F.lane = F.tid & 63; F.wave = __builtin_amdgcn_readfirstlane(F.tid >> 6); F.G = gridDim.x; F.bid = blockIdx.x;
    F.in = args.in; F.out = args.out; F.ws = args.ws;
    unsigned char* ws = args.ws; float* out = args.out;
    bf16* W_AIN[2] = {(bf16*)(ws + WS_WAIN0), (bf16*)(ws + WS_WAIN1)}; bf16* W_AOUT[2] = {(bf16*)(ws + WS_WAOUT0), (bf16*)(ws + WS_WAOUT1)};
    bf16* W_RIN = (bf16*)(ws + WS_WRIN); bf16* W_ROUT = (bf16*)(ws + WS_WROUT); bf16* W_CIN = (bf16*)(ws + WS_WCIN); bf16* W_COUT = (bf16*)(ws + WS_WCOUT);
    bf16* XN0 = (bf16*)(ws + WS_XN0); bf16* HB = (bf16*)(ws + WS_HB); float* SSQ2 = (float*)(ws + WS_SSQ2);
    bf16* Qs = (bf16*)(ws + WS_QS); bf16* KP = (bf16*)(ws + WS_KP); bf16* VP = (bf16*)(ws + WS_VP); bf16* KC = (bf16*)(ws + WS_KC); bf16* VC = (bf16*)(ws + WS_VC); bf16* AO_A = (bf16*)(ws + WS_AOA);
    bf16* KT = (bf16*)(ws + WS_KT); bf16* RG = (bf16*)(ws + WS_RG); bf16* QP = (bf16*)(ws + WS_QP); bf16* KN = (bf16*)(ws + WS_KN); bf16* VS = (bf16*)(ws + WS_VS); bf16* ORET = (bf16*)(ws + WS_ORET);
    bf16* GU = (bf16*)(ws + WS_GU); bf16* SG = (bf16*)(ws + WS_SG); bf16* GVT = (bf16*)(ws + WS_GVT); bf16* WM = (bf16*)(ws + WS_WM); float* SSQ = (float*)(ws + WS_SSQ); bf16* GVS = (bf16*)(ws + WS_GVS); float* TABR = (float*)(ws + WS_TABR); bf16* KVX = (bf16*)(ws + WS_KVX); float* TABA = (float*)(ws + WS_TABA); bf16* GA = (bf16*)(ws + WS_GA);
    const int lo = args.ph_lo, hi = args.ph_hi;
    volatile LAS unsigned* MISC = (volatile LAS unsigned*)(F.lds + MISC_OFF);
    for (int u = F.tid; u < (LDS_BYTES - MISC_OFF) / 4; u += NTHR) ((LAS unsigned*)(F.lds + MISC_OFF))[u] = 0u;
    __syncthreads();
    XcdBarrier bar = xcd_barrier_post((unsigned*)(ws + WS_CTL) + 4096, MISC + 8);
#define IN(k) (lo <= (k) && (k) < hi)
#define PH_ENTER() do { int t_ = F.wave * 64 + lane_now(); F.tid = t_; F.lane = t_ & 63; } while (0)
    volatile LAS int* DRW = (volatile LAS int*)(F.lds + MISC_OFF + 64);
    unsigned* DCTR = (unsigned*)(ws + WS_CTL) + 8192;
#define DRAIN(ph, total, BODY) do { PH_ENTER(); for (;;) { __syncthreads(); if (F.tid == 0) DRW[0] = (int)atomicAdd(DCTR + 64 * (ph), 1u); __syncthreads(); const int c_ = DRW[0]; if (c_ >= (total)) break; BODY } } while (0)
#define SEAM(k) do { if (IN(k) && IN((k) + 1)) xcd_barrier(bar, F.wave == 0 && lane_now() == 0); } while (0)

#define GEMM_STORE(Aptr, Wptr, NN, KK, Optr) do { pg8::GemmP g{KK, KK, (KK) / 64}; pg8::StaticOrder S; S.init(MT / 256, (NN) / 256, F.G, F.bid, Aptr, Wptr, KK, KK); pg8::EpiStoreBf16 E{(pg8::bf16_t*)(Optr), NN}; \
        pg8::gemm_phase<pg8::EpiStoreBf16, pg8::StaticOrder>(F.lds + RING_OFF, g, S, E, F.tid); } while (0)
#define GEMM_RESIDB(MODE_, Aptr, Wptr, KK) do { pg8::GemmP g{KK, KK, (KK) / 64}; pg8::StaticOrder S; S.init(MT / 256, DM / 256, F.G, F.bid, Aptr, Wptr, KK, KK); \
        pg8::EpiResidB<MODE_> E{args.in[I_XP], args.in[I_XS], (pg8::bf16_t*)HB, out, SSQ2}; pg8::gemm_phase<pg8::EpiResidB<MODE_>, pg8::StaticOrder>(F.lds + RING_OFF, g, S, E, F.tid); } while (0)

    PH_ENTER(); if (IN(0)) {
        transpose_weight(F, args.in[I_AWIN], 2048, 8192, W_AIN[0]); attn_table(F, TABA);
        norm_rows(F, args.in[I_XP], args.in[I_XS], args.in[I_NW], XN0);
    }
    SEAM(0);
#define GEMM_AIN(Aptr, Wptr, J_, SSQP) do { pg8::GemmP g{2048, 2048, 32}; pg8::StaticOrder S; S.init(MT / 256, 32, F.G, F.bid, Aptr, Wptr, 2048, 2048); \
        EpiAIn E{Qs, KP, VP, KC, VC, GA, out + O_KP + (size_t)(J_) * MP * DM, out + O_VP + (size_t)(J_) * MP * DM, out + O_KS + (size_t)(J_) * MS * DM, out + O_VS + (size_t)(J_) * MS * DM, TABA, args.in[I_AQG] + 64 * (J_), args.in[I_AKG] + 64 * (J_), SSQP}; \
        pg8::gemm_phase<EpiAIn, pg8::StaticOrder>(F.lds + RING_OFF, g, S, E, F.tid); } while (0)
    PH_ENTER(); if (IN(1)) { GEMM_AIN(XN0, W_AIN[0], 0, (const float*)nullptr);
        const int n0 = CC_CHUNKS, n1 = n0 + tw_chunks(2048, 2048), n2 = n1 + TR_CHUNKS;
        DRAIN(1, n2, if (c_ < n0) cc_run(F, args.in[I_CK], args.in[I_CV], KC, VC, c_); else if (c_ < n1) tw_run(F, args.in[I_AWOUT], 2048, 2048, W_AOUT[0], c_ - n0); else tr_run(F, TABR, c_ - n1);); }
    SEAM(1);
    PH_ENTER(); if (IN(3)) { const float li = 0.8f - 0.6f * expf(-0.3f * 0.f); const float lam = diff_lambda(args.in[I_LQ1], args.in[I_LK1], args.in[I_LQ2], args.in[I_LK2], li);
        attn_fast(F, Qs, KP, VP, KC, VC, GA, AO_A, lam, 1.f - li, args.in[I_ASG]); }
    SEAM(3);
    PH_ENTER(); if (IN(4)) { GEMM_RESIDB(0, AO_A, W_AOUT[0], 2048);
        const int n0 = tw_chunks(2048, 12288), n1 = n0 + tw_chunks(4096, 2048);
        DRAIN(4, n1, if (c_ < n0) tw_run(F, args.in[I_RWIN], 2048, 12288, W_RIN, c_, args.in[I_NW] + DM); else tw_run(F, args.in[I_RWOUT], 4096, 2048, W_ROUT, c_ - n0);); }
    if (IN(4) && IN(6)) xcd_barrier(bar, F.wave == 0 && lane_now() == 0);
    PH_ENTER(); if (IN(6)) { ret_zero_pad(F, VS, KT);
        PH_ENTER(); pg8::GemmP g{2048, 2048, 32}; pg8::StaticOrder S; S.init(MT / 256, 48, F.G, F.bid, HB, W_RIN, 2048, 2048); EpiRet E{QP, KN, KT, VS, RG, TABR, SSQ2};
        pg8::gemm_phase<EpiRet, pg8::StaticOrder>(F.lds + RING_OFF, g, S, E, F.tid); }
    SEAM(6);
    PH_ENTER(); if (IN(7)) { { pg8::GemmP g{4096, 2048, 4}; RetQKOrder S{F.G, F.bid, (const char*)QP, (const char*)KN}; EpiRetQK E{QP}; pg8::gemm_phase<EpiRetQK, RetQKOrder>(F.lds + RING_OFF, g, S, E, F.tid); }
        PH_ENTER(); { pg8::GemmP g{512, 256, 4}; RetKVOrder S{F.G, F.bid, (const char*)VS, (const char*)KT}; EpiRetKV E{VS, KVX}; pg8::gemm_phase<EpiRetKV, RetKVOrder>(F.lds + RING_OFF, g, S, E, F.tid); }
        xcd_barrier(bar, F.wave == 0 && lane_now() == 0);
        PH_ENTER(); ret_scan(F, VS, KVX, args.in[I_SR], out + O_SP, out + O_SS); }
    SEAM(7);
    PH_ENTER(); if (IN(8)) { pg8::GemmP g{4096, 512, 8}; RetOOrder S{F.G, F.bid, (const char*)QP, (const char*)VS}; EpiRetO E{ORET}; pg8::gemm_phase<EpiRetO, RetOOrder>(F.lds + RING_OFF, g, S, E, F.tid); }
    SEAM(8);
    PH_ENTER(); if (IN(9)) r_out(F, ORET, RG);
    SEAM(9);
    PH_ENTER(); if (IN(10)) { GEMM_RESIDB(1, ORET, W_ROUT, 4096);
        const int n0 = tw_chunks(2048, 12288), n1 = n0 + tw_chunks(4096, 2048), n2 = n1 + tw_chunks(2048, 8192), n3 = n2 + tw_chunks(2048, 2048);
        DRAIN(10, n3, if (c_ < n0) tw_run(F, args.in[I_CWIN], 2048, 12288, W_CIN, c_, args.in[I_NW] + 2 * DM); else if (c_ < n1) tw_run(F, args.in[I_CWOUT], 4096, 2048, W_COUT, c_ - n0);
                      else if (c_ < n2) tw_run(F, args.in[I_AWIN] + (size_t)2048 * 8192, 2048, 8192, W_AIN[1], c_ - n1, args.in[I_NW] + 3 * DM); else tw_run(F, args.in[I_AWOUT] + (size_t)2048 * 2048, 2048, 2048, W_AOUT[1], c_ - n2);); }
    if (IN(10) && IN(12)) xcd_barrier(bar, F.wave == 0 && lane_now() == 0);
    PH_ENTER(); if (IN(12)) { pg8::GemmP g{2048, 2048, 32}; pg8::StaticOrder S; S.init(MT / 256, 48, F.G, F.bid, HB, W_CIN, 2048, 2048); EpiCIn E{GU, GVT, SG, GVS, SSQ, SSQ2};
        pg8::gemm_phase<EpiCIn, pg8::StaticOrder>(F.lds + RING_OFF, g, S, E, F.tid); }
    SEAM(12);
    PH_ENTER(); if (IN(13)) c_prep(F, SSQ, args.in[I_CWS], args.in[I_CVG], GVS, WM, out + O_VM);
    SEAM(13);
    PH_ENTER(); if (IN(14)) { pg8::GemmP g{256, 256, 4}; CMixOrder S{F.G, F.bid, (const char*)WM, (const char*)GVT}; EpiCMix E{GU, SG, args.in[I_CVG], args.in[I_CBS]}; pg8::gemm_phase<EpiCMix, CMixOrder>(F.lds + RING_OFF, g, S, E, F.tid); }
    SEAM(14);
    PH_ENTER(); if (IN(15)) { GEMM_RESIDB(1, GU, W_COUT, 4096);
        DRAIN(15, CC_CHUNKS, cc_run(F, args.in[I_CK] + (size_t)NB * PAST * DM, args.in[I_CV] + (size_t)NB * PAST * DM, KC, VC, c_);); }
    if (IN(15) && IN(17)) xcd_barrier(bar, F.wave == 0 && lane_now() == 0);
    PH_ENTER(); if (IN(17)) GEMM_AIN(HB, W_AIN[1], 1, (const float*)SSQ2);
    SEAM(17);
    PH_ENTER(); if (IN(19)) { const float li = 0.8f - 0.6f * expf(-0.3f * 3.f); const float lam = diff_lambda(args.in[I_LQ1] + 64, args.in[I_LK1] + 64, args.in[I_LQ2] + 64, args.in[I_LK2] + 64, li);
        attn_fast(F, Qs, KP, VP, KC, VC, GA, AO_A, lam, 1.f - li, args.in[I_ASG] + 128); }
    SEAM(19);
    PH_ENTER(); if (IN(20)) GEMM_RESIDB(2, AO_A, W_AOUT[1], 2048);
#undef IN
#undef SEAM
}

extern "C" void kernel_launch(void* const* d_in, const int* in_sizes, int n_in, void* d_out, int out_size, void* d_ws, size_t ws_size, hipStream_t stream) {
    static int grid = 0;
    if (grid == 0) {
        if (n_in != N_IN || (size_t)out_size != O_END || ws_size < WS_END) { fprintf(stderr, "kernel_launch: unexpected shapes: n_in %d out %d ws %zu (need %zu)\n", n_in, out_size, ws_size, (size_t)WS_END); grid = -1; return; }
        int dev = 0, cus = 0;
        if (hipGetDevice(&dev) != hipSuccess || hipDeviceGetAttribute(&cus, hipDeviceAttributeMultiprocessorCount, dev) != hipSuccess) { grid = -1; return; }
        if (hipFuncSetAttribute((const void*)mega, hipFuncAttributeMaxDynamicSharedMemorySize, LDS_BYTES) != hipSuccess) { fprintf(stderr, "kernel_launch: hipFuncSetAttribute failed\n"); grid = -1; return; }
        (void)hipGetLastError();
        grid = cus;
    }
    if (grid < 0) return;
    Args a{};
    for (int i = 0; i < N_IN; ++i) a.in[i] = (const float*)d_in[i];
    a.out = (float*)d_out; a.ws = (unsigned char*)d_ws;
    (void)hipMemsetAsync((char*)d_ws + WS_CTL, 0, CTL_ZERO_BYTES, stream);
    a.ph_lo = 0; a.ph_hi = N_PHASES;
    hipLaunchKernelGGL(mega, dim3(grid), dim3(NTHR), LDS_BYTES, stream, a);
}
```

```cpp
#include <hip/hip_runtime.h>
#include <cstdio>
#include <cstdint>

__device__ __forceinline__ int lane_now() { int l; asm volatile("v_mbcnt_lo_u32_b32 %0, -1, 0\n\tv_mbcnt_hi_u32_b32 %0, -1, %0" : "=v"(l)); return l; }
namespace pg8 {
#define PG8_LAS __attribute__((address_space(3)))
typedef unsigned short bf16_t;
typedef short bf16x8 __attribute__((ext_vector_type(8)));
typedef float f32x4 __attribute__((ext_vector_type(4)));
typedef unsigned u32x4 __attribute__((ext_vector_type(4)));
constexpr int BM = 256, BK = 64, HALF = 128, HTB = HALF * BK * 2, STAGE_BYTES = 8 * HTB, NXCD = 8, WGM = 8;

__host__ __device__ __forceinline__ int lds_byte(int r, int c) { const int st = (r >> 4) * 2 + (c >> 5), rr = r & 15, cc = c & 31, ob = rr * 64 + cc * 2; return st * 1024 + (ob ^ (((ob >> 9) & 1) << 5)); }
__host__ __device__ __forceinline__ void stage_rc(int b, int& R, int& C) { const int st = b / 1024, sb = b % 1024, swz = sb ^ (((sb >> 9) & 1) << 5); R = (st >> 1) * 16 + swz / 64; C = (st & 1) * 32 + (swz % 64) / 2; }
__host__ __device__ __forceinline__ int perm32(int rho) { const int n = rho >> 4, i = rho & 15; return 8 * (i >> 2) + 4 * n + (i & 3); }

struct Unit { int pm, pn; const char* a; const char* b; };
struct GemmP { int lda, ldb, nt; };

struct StaticOrder {
    int nM, nN, nwg, G, c; const char* A; const char* B; size_t ta, tb;
    __host__ __device__ void init(int nM_, int nN_, int G_, int c_, const void* A_, const void* B_, int lda, int ldb) { nM = nM_; nN = nN_; nwg = nM * nN; G = G_; c = c_; A = (const char*)A_; B = (const char*)B_; ta = (size_t)BM * lda * 2; tb = (size_t)BM * ldb * 2; }
    __host__ __device__ bool next(int i, Unit& u) const {
        const long L = (long)i * G + c; if (L >= nwg) return false;
        int wgid = (int)L; { const int q = nwg / NXCD, r = nwg % NXCD, xcd = wgid % NXCD, off = wgid / NXCD; wgid = (xcd < r ? xcd * (q + 1) : r * (q + 1) + (xcd - r) * q) + off; }
        const int nig = WGM * nN, gid = wgid / nig, fm = gid * WGM, gsz = (nM - fm) < WGM ? (nM - fm) : WGM;
        u.pm = fm + ((wgid % nig) % gsz); u.pn = (wgid % nig) / gsz; u.a = A + (size_t)u.pm * ta; u.b = B + (size_t)u.pn * tb; return true;
    }
    __device__ __forceinline__ void a_ready(const Unit&) const {}
    __device__ __forceinline__ void done(const Unit&) const {}
};

__device__ __forceinline__ unsigned cvt_pk_bf16(float lo, float hi) { unsigned r; asm volatile("v_cvt_pk_bf16_f32 %0, %1, %2" : "=v"(r) : "v"(lo), "v"(hi)); return r; }

struct EpiStoreBf16 {
    static constexpr int BMODE = 1;
    bf16_t* O; int ldc;
    __device__ __forceinline__ void operator()(const f32x4 (&acc)[2][2][4][2], const Unit& u, int wr, int wc, int fr, int fq) const {
        const int row0 = u.pm * BM + wr * 64 + fr; const int col0 = u.pn * BM + wc * 32 + 8 * fq;
#pragma unroll
        for (int ai = 0; ai < 2; ++ai)
#pragma unroll
            for (int m = 0; m < 4; ++m) { bf16_t* rowp = O + (size_t)(row0 + ai * HALF + m * 16) * ldc + col0;
#pragma unroll
                for (int bj = 0; bj < 2; ++bj) { const f32x4 v0 = acc[ai][bj][m][0], v1 = acc[ai][bj][m][1];
                    u32x4 w; w.x = cvt_pk_bf16(v0[0], v0[1]); w.y = cvt_pk_bf16(v0[2], v0[3]); w.z = cvt_pk_bf16(v1[0], v1[1]); w.w = cvt_pk_bf16(v1[2], v1[3]);
                    *(u32x4*)(rowp + bj * HALF) = w; } }
    }
};
struct EpiResid {
    static constexpr int BMODE = 0;
    const float* base_p; const float* base_s; float* out; int split;
    __device__ __forceinline__ void operator()(const f32x4 (&acc)[2][2][4][2], const Unit& u, int wr, int wc, int fr, int fq) const {
        { const int l_ = lane_now(); fr = l_ & 15; fq = l_ >> 4; }
        const int col0 = u.pn * BM + wc * 32 + 4 * fq;
#pragma unroll
        for (int ai = 0; ai < 2; ++ai) {
            f32x4 bs[4][2][2];
#pragma unroll
            for (int m = 0; m < 4; ++m) { const int r = u.pm * BM + ai * HALF + wr * 64 + m * 16 + fr; const float* bp = (r < split) ? base_p + (size_t)r * 2048 : base_s + (size_t)(r - split) * 2048;
#pragma unroll
                for (int bj = 0; bj < 2; ++bj)
#pragma unroll
                    for (int n = 0; n < 2; ++n) bs[m][bj][n] = *(const f32x4*)(bp + col0 + bj * HALF + n * 16); }
#pragma unroll
            for (int m = 0; m < 4; ++m) { const int r = u.pm * BM + ai * HALF + wr * 64 + m * 16 + fr; float* op = out + (size_t)r * 2048;
#pragma unroll
                for (int bj = 0; bj < 2; ++bj)
#pragma unroll
                    for (int n = 0; n < 2; ++n) *(f32x4*)(op + col0 + bj * HALF + n * 16) = bs[m][bj][n] + acc[ai][bj][m][n]; }
            asm volatile("" ::: "memory");
        }
    }
};

template <int MODE> struct EpiResidB {
    static constexpr int BMODE = 1;
    const float* base_p; const float* base_s; bf16_t* HB; float* out; float* SSQ2;
    __device__ __forceinline__ void operator()(const f32x4 (&acc)[2][2][4][2], const Unit& u, int wr, int wc, int fr, int fq) const {
        { const int l_ = lane_now(); fr = l_ & 15; fq = l_ >> 4; }
        const int col0 = u.pn * BM + wc * 32 + 8 * fq;
#pragma unroll
        for (int ai = 0; ai < 2; ++ai) {
            f32x4 b0[4][2], b1[4][2]; u32x4 hb[4][2];
#pragma unroll
            for (int m = 0; m < 4; ++m) { const int r = u.pm * BM + ai * HALF + wr * 64 + m * 16 + fr;
#pragma unroll
                for (int bj = 0; bj < 2; ++bj) {
                    if (MODE == 0) { const float* bp = ((r < 16384) ? base_p + (size_t)r * 2048 : base_s + (size_t)(r - 16384) * 2048) + col0 + bj * HALF; b0[m][bj] = *(const f32x4*)bp; b1[m][bj] = *(const f32x4*)(bp + 4); }
                    else hb[m][bj] = *(const u32x4*)(HB + (size_t)r * 2048 + col0 + bj * HALF); } }
#pragma unroll
            for (int m = 0; m < 4; ++m) { const int r = u.pm * BM + ai * HALF + wr * 64 + m * 16 + fr; float ss = 0.f;
#pragma unroll
                for (int bj = 0; bj < 2; ++bj) { f32x4 h0, h1;
                    if (MODE == 0) { h0 = b0[m][bj] + acc[ai][bj][m][0]; h1 = b1[m][bj] + acc[ai][bj][m][1]; }
                    else { const u32x4 w = hb[m][bj];
                        h0 = (f32x4){__builtin_bit_cast(float, w.x << 16), __builtin_bit_cast(float, w.x & 0xffff0000u), __builtin_bit_cast(float, w.y << 16), __builtin_bit_cast(float, w.y & 0xffff0000u)} + acc[ai][bj][m][0];
                        h1 = (f32x4){__builtin_bit_cast(float, w.z << 16), __builtin_bit_cast(float, w.z & 0xffff0000u), __builtin_bit_cast(float, w.w << 16), __builtin_bit_cast(float, w.w & 0xffff0000u)} + acc[ai][bj][m][1]; }
                    if (MODE == 2) { float* op = out + (size_t)r * 2048 + col0 + bj * HALF; *(f32x4*)op = h0; *(f32x4*)(op + 4) = h1; }
                    else { u32x4 w; w.x = cvt_pk_bf16(h0[0], h0[1]); w.y = cvt_pk_bf16(h0[2], h0[3]); w.z = cvt_pk_bf16(h1[0], h1[1]); w.w = cvt_pk_bf16(h1[2], h1[3]);
                        *(u32x4*)(HB + (size_t)r * 2048 + col0 + bj * HALF) = w;
                        ss += (h0[0] * h0[0] + h0[1] * h0[1]) + (h0[2] * h0[2] + h0[3] * h0[3]) + (h1[0] * h1[0] + h1[1] * h1[1]) + (h1[2] * h1[2] + h1[3] * h1[3]); } }
                if (MODE != 2) { ss += __shfl_xor(ss, 16); ss += __shfl_xor(ss, 32); if (fq == 0) SSQ2[(size_t)r * 32 + u.pn * 4 + wc] = ss; } }
            asm volatile("" ::: "memory");
        }
    }
};

template <class Epi, class Sched, bool ALIGN_EPI = true>
__device__ __forceinline__ void gemm_phase(PG8_LAS unsigned char* lds, const GemmP g, const Sched& S, const Epi& E, int tid) {
    asm volatile("" : "+v"(tid));
    const int wid = __builtin_amdgcn_readfirstlane(tid >> 6), lane = tid & 63, wr = wid >> 2, wc = wid & 3, fr = lane & 15, fq = lane >> 4;
    int nt = g.nt; asm volatile("" : "+s"(nt));
    unsigned voffA[2], voffB[2];
#pragma unroll
    for (int i = 0; i < 2; ++i) { int R, C; stage_rc(tid * 16 + i * 8192, R, C); const int Rb = Epi::BMODE == 2 ? (64 * (R >> 5) + perm32(R & 31)) : Epi::BMODE == 1 ? ((R & ~31) + perm32(R & 31)) : R;
        voffA[i] = (unsigned)(R * g.lda + C) * 2u; voffB[i] = (unsigned)(Rb * g.ldb + C) * 2u; }
    const size_t kstep = (size_t)(BK * 2);
    const size_t hstepA = (size_t)HALF * g.lda * 2, hstepB = (size_t)(Epi::BMODE == 2 ? 32 : HALF) * g.ldb * 2;
    const unsigned ldsw = (unsigned)wid * 1024u;
    const int aoff = lds_byte(wr * 64 + fr, fq * 8), boff = lds_byte(wc * 32 + fr, fq * 8);
#define PG8_SA(b, h) (((b) * 2 + (h)) * HTB)
#define PG8_SB(b, h) ((4 + (b) * 2 + (h)) * HTB)
#define PG8_STAGE(bufoff, gbase, voff) do { _Pragma("unroll") for (int _i = 0; _i < 2; ++_i) \
        __builtin_amdgcn_global_load_lds((const unsigned*)((const char*)(gbase) + (voff)[_i]), (PG8_LAS unsigned*)(lds + (bufoff) + ldsw + _i * 8192), 16, 0, 0); } while (0)
#define PG8_LDA(dst, b, h) do { _Pragma("unroll") for (int m = 0; m < 4; ++m) _Pragma("unroll") for (int k = 0; k < 2; ++k) dst[m][k] = *(const PG8_LAS bf16x8*)(lds + PG8_SA(b, h) + aoff + m * 2048 + k * 1024); } while (0)
#define PG8_LDB(dst, b, h) do { _Pragma("unroll") for (int n = 0; n < 2; ++n) _Pragma("unroll") for (int k = 0; k < 2; ++k) dst[n][k] = *(const PG8_LAS bf16x8*)(lds + PG8_SB(b, h) + boff + n * 2048 + k * 1024); } while (0)
#define PG8_MMA(ai, bj, At, Bt) do { __builtin_amdgcn_s_setprio(1); _Pragma("unroll") for (int m = 0; m < 4; ++m) _Pragma("unroll") for (int n = 0; n < 2; ++n) _Pragma("unroll") for (int k = 0; k < 2; ++k) \
        acc[ai][bj][m][n] = __builtin_amdgcn_mfma_f32_16x16x32_bf16(Bt[n][k], At[m][k], acc[ai][bj][m][n], 0, 0, 0); __builtin_amdgcn_s_setprio(0); } while (0)
#define PG8_WAIT_V(n) asm volatile("s_waitcnt vmcnt(" #n ")" ::: "memory")
#define PG8_WAIT_L(n) asm volatile("s_waitcnt lgkmcnt(" #n ")" ::: "memory")
#define PG8_BAR __builtin_amdgcn_s_barrier()
#define PG8_SCHED __builtin_amdgcn_sched_barrier(0)
    Unit cur, nxt; int ui = 0;
    if (!S.next(0, cur)) return;
    f32x4 acc[2][2][4][2];
#pragma unroll
    for (int a = 0; a < 2; ++a)
#pragma unroll
        for (int b = 0; b < 2; ++b)
#pragma unroll
            for (int m = 0; m < 4; ++m)
#pragma unroll
                for (int n = 0; n < 2; ++n) acc[a][b][m][n] = (f32x4){0.f, 0.f, 0.f, 0.f};
    bf16x8 At[4][2], B0[2][2], B1[2][2];
    const char* cA = cur.a; const char* cB = cur.b;
    S.a_ready(cur);
    PG8_STAGE(PG8_SB(0, 0), cB, voffB); PG8_STAGE(PG8_SB(0, 1), cB + hstepB, voffB); PG8_STAGE(PG8_SA(0, 0), cA, voffA); PG8_STAGE(PG8_SA(0, 1), cA + hstepA, voffA);
    if (wr == 1) PG8_BAR;
    PG8_WAIT_V(2); PG8_BAR;
    PG8_STAGE(PG8_SB(1, 0), cB + kstep, voffB); PG8_STAGE(PG8_SA(1, 0), cA + kstep, voffA); PG8_STAGE(PG8_SB(1, 1), cB + hstepB + kstep, voffB);
    PG8_WAIT_V(6); PG8_BAR;
    for (;;) {
        const bool has_next = S.next(ui + 1, nxt);
        const char* nA = has_next ? nxt.a : cA; const char* nB = has_next ? nxt.b : cB;
        for (int t = 0; t < nt; t += 2) {
            const bool last = (t == nt - 2);
            const char* a1 = cA + (size_t)(t + 1) * kstep;
            const char* a2 = last ? nA : cA + (size_t)(t + 2) * kstep; const char* b2 = last ? nB : cB + (size_t)(t + 2) * kstep;
            const char* a3 = a2 + kstep; const char* b3 = b2 + kstep;
            if (last && has_next) S.a_ready(nxt);
            PG8_LDB(B0, 0, 0); PG8_LDB(B1, 0, 1); PG8_SCHED; PG8_LDA(At, 0, 0); PG8_STAGE(PG8_SA(1, 1), a1 + hstepA, voffA);
            PG8_WAIT_V(8); PG8_WAIT_L(0); PG8_BAR; PG8_MMA(0, 0, At, B0); PG8_MMA(0, 1, At, B1); PG8_BAR; PG8_SCHED;
            PG8_LDA(At, 0, 1); PG8_STAGE(PG8_SB(0, 0), b2, voffB); PG8_STAGE(PG8_SB(0, 1), b2 + hstepB, voffB); PG8_STAGE(PG8_SA(0, 0), a2, voffA);
            PG8_WAIT_V(8); PG8_WAIT_L(0); PG8_BAR; PG8_MMA(1, 0, At, B0); PG8_MMA(1, 1, At, B1); PG8_BAR; PG8_SCHED;
            PG8_LDB(B0, 1, 0); PG8_LDB(B1, 1, 1); PG8_SCHED; PG8_LDA(At, 1, 0); PG8_STAGE(PG8_SA(0, 1), a2 + hstepA, voffA);
            PG8_WAIT_V(8); PG8_WAIT_L(0); PG8_BAR; PG8_MMA(0, 0, At, B0); PG8_MMA(0, 1, At, B1); PG8_BAR; PG8_SCHED;
            PG8_LDA(At, 1, 1); PG8_STAGE(PG8_SB(1, 0), b3, voffB); PG8_STAGE(PG8_SB(1, 1), b3 + hstepB, voffB); PG8_STAGE(PG8_SA(1, 0), a3, voffA);
            PG8_WAIT_V(8); PG8_WAIT_L(0); PG8_BAR; PG8_MMA(1, 0, At, B0); PG8_MMA(1, 1, At, B1); PG8_BAR; PG8_SCHED;
        }
        if constexpr (ALIGN_EPI) { if (wr == 0) PG8_BAR; }
        E(acc, cur, wr, wc, fr, fq); S.done(cur);
        if (!has_next) break;
#pragma unroll
        for (int a = 0; a < 2; ++a)
#pragma unroll
            for (int b = 0; b < 2; ++b)
#pragma unroll
                for (int m = 0; m < 4; ++m)
#pragma unroll
                    for (int n = 0; n < 2; ++n) acc[a][b][m][n] = (f32x4){0.f, 0.f, 0.f, 0.f};
        cur = nxt; cA = nA; cB = nB; ++ui;
        if constexpr (ALIGN_EPI) { if (wr == 1) PG8_BAR; }
    }
    PG8_WAIT_V(0);
    if constexpr (!ALIGN_EPI) { if (wr == 0) PG8_BAR; }
    PG8_BAR;
#undef PG8_SA
#undef PG8_SB
#undef PG8_STAGE
#undef PG8_LDA
#undef PG8_LDB
#undef PG8_MMA
#undef PG8_WAIT_V
#undef PG8_WAIT_L
#undef PG8_BAR
#undef PG8_SCHED
}
}

constexpr int NWAVES = 8, NTHR = 512;
constexpr int DM = 2048, MP = 16384, MS = 512, MT = MP + MS, PAST = 2048, DECL = 64, NB = 8;
constexpr int KCROWS = PAST + DECL;
constexpr float EPS = 1e-6f;
constexpr float LOG2E = 1.4426950408889634f;
constexpr float C2 = 0.125f * LOG2E;

enum { I_XP = 0, I_XS, I_CK, I_CV, I_SR, I_NW, I_AWIN, I_AWOUT, I_AQG, I_AKG, I_LQ1, I_LK1, I_LQ2, I_LK2, I_ASG, I_RWIN, I_RWOUT, I_CWIN, I_CWOUT, I_CVG, I_CWS, I_CBS, N_IN };
constexpr size_t O_YP = 0, O_YS = O_YP + (size_t)MP * DM, O_KP = O_YS + (size_t)MS * DM, O_VP = O_KP + 2 * (size_t)MP * DM, O_KS = O_VP + 2 * (size_t)MP * DM, O_VS = O_KS + 2 * (size_t)MS * DM,
                 O_SP = O_VS + 2 * (size_t)MS * DM, O_SS = O_SP + (size_t)8 * 256 * 512, O_VM = O_SS + (size_t)NB * 8 * 256 * 512, O_END = O_VM + (size_t)MS * 4096;

constexpr size_t MiB = 1u << 20;
constexpr size_t WS_CTL = 0, CTL_ZERO_BYTES = 1 * MiB;
constexpr size_t WS_WAIN0 = 8 * MiB, WS_WAOUT0 = 40 * MiB, WS_WRIN = 48 * MiB, WS_WROUT = 96 * MiB, WS_WCIN = 112 * MiB, WS_WCOUT = 160 * MiB, WS_WAIN1 = 176 * MiB, WS_WAOUT1 = 208 * MiB;
constexpr size_t WS_SSQ2 = 2 * MiB;
constexpr size_t WS_HB = 216 * MiB, WS_Z = 282 * MiB;
constexpr size_t WS_XN0 = 348 * MiB;
constexpr size_t WS_QS = 546 * MiB, WS_KP = 612 * MiB, WS_VP = 676 * MiB, WS_KC = 740 * MiB, WS_VC = 806 * MiB, WS_AOA = 872 * MiB;
constexpr size_t WS_KT = 112 * MiB, WS_RG = 282 * MiB, WS_QP = 414 * MiB, WS_KN = 546 * MiB, WS_VS = 612 * MiB, WS_ORET = 900 * MiB;
constexpr size_t WS_GU = 282 * MiB, WS_SG = 414 * MiB, WS_GVT = 546 * MiB, WS_WM = 678 * MiB, WS_SSQ = 744 * MiB, WS_GVS = 752 * MiB;
constexpr size_t WS_GA = 282 * MiB;
constexpr size_t WS_KVX = 184 * MiB;
constexpr size_t WS_TABR = 1040 * MiB, WS_TABA = 1056 * MiB, WS_END = 1060 * MiB;

#define GAS __attribute__((address_space(1)))
#define LAS __attribute__((address_space(3)))
typedef unsigned short bf16;
typedef unsigned v4u __attribute__((ext_vector_type(4)));
typedef unsigned v2u __attribute__((ext_vector_type(2)));
typedef float f32x4 __attribute__((ext_vector_type(4)));
typedef GAS unsigned gu32;
#define RLX_AGENT __ATOMIC_RELAXED, __HIP_MEMORY_SCOPE_AGENT
#define LDS_WAIT() asm volatile("s_waitcnt lgkmcnt(0)" ::: "memory")
#define VM_WAIT() asm volatile("s_waitcnt vmcnt(0)" ::: "memory")
typedef float g_f32x2 __attribute__((ext_vector_type(2))); typedef __bf16 g_bf16x2 __attribute__((ext_vector_type(2)));
__device__ __forceinline__ unsigned pk2(float lo, float hi) { const g_f32x2 v = {lo, hi}; const g_bf16x2 b = __builtin_convertvector(v, g_bf16x2); return __builtin_bit_cast(unsigned, b); }
__device__ __forceinline__ unsigned f2bf(float f) { return pk2(f, 0.f) & 0xffffu; }
__device__ __forceinline__ float bf2f(unsigned short b) { return __builtin_bit_cast(float, (unsigned)b << 16); }
__device__ __forceinline__ float bflo(unsigned w) { return __builtin_bit_cast(float, w << 16); }
__device__ __forceinline__ float bfhi(unsigned w) { return __builtin_bit_cast(float, w & 0xffff0000u); }
__device__ __forceinline__ float silu_f(float x) { return x * __builtin_amdgcn_rcpf(1.f + __builtin_amdgcn_exp2f(-LOG2E * x)); }
__device__ __forceinline__ float gelu_tanh_f(float x) { const float u = (0.7978845608028654f * 2.f * LOG2E) * (x + 0.044715f * x * x * x); return x * __builtin_amdgcn_rcpf(1.f + __builtin_amdgcn_exp2f(-u)); }
__device__ __forceinline__ float wave_sum(float v) {
#pragma unroll
    for (int o = 1; o < 64; o <<= 1) v += __shfl_xor(v, o);
    return v;
}
__device__ __forceinline__ void row_rstd(const float* ssq, int pm, int wr, int fr, int fq, float (&rs)[2][4]) {
#pragma unroll
    for (int ai = 0; ai < 2; ++ai)
#pragma unroll
        for (int m = 0; m < 4; ++m) {
            if (ssq) { const float* p = ssq + ((size_t)pm * 256 + ai * 128 + wr * 64 + m * 16 + fr) * 32 + 8 * fq; const f32x4 a = *(const f32x4*)p, b = *(const f32x4*)(p + 4);
                float t = ((a.x + a.y) + (a.z + a.w)) + ((b.x + b.y) + (b.z + b.w)); t += __shfl_xor(t, 16); t += __shfl_xor(t, 32); rs[ai][m] = 1.f / sqrtf(t * (1.f / 2048.f) + EPS); }
            else rs[ai][m] = 1.f; }
}
__device__ __forceinline__ void rope_cs(int pos, int i, int nf, float& c, float& s) {
    const float inv = exp2f(-(float)i / (float)nf * 13.287712379549449f);
    const double a = (double)pos * (double)inv * 0.15915494309189535;
    const float r = (float)(a - floor(a));
    c = __builtin_amdgcn_cosf(r); s = __builtin_amdgcn_sinf(r);
}

#define XB_TMO      128
#define XB_XCNT(j)  (256  + 64 * (j))
#define XB_XSUB(j)  (1280 + 64 * (j))
#define XB_XGEN(j)  (2304 + 64 * (j))
#define XB_TOP      3328
#define XB_TOPGEN   3392
#define XCD_BAR_WORDS 3456
#define XB_SPIN_CAP (1u << 22)
__device__ __forceinline__ unsigned xb_ld(unsigned* p)              { return __hip_atomic_load(p, __ATOMIC_RELAXED, __HIP_MEMORY_SCOPE_AGENT); }
__device__ __forceinline__ unsigned xb_add(unsigned* p, unsigned v) { return __hip_atomic_fetch_add(p, v, __ATOMIC_RELAXED, __HIP_MEMORY_SCOPE_AGENT); }
__device__ __forceinline__ unsigned xb_xcc_id() { return (unsigned)__builtin_amdgcn_s_getreg((3 << 11) | 20) & 0xFu; }
#define XB_SPIN(cond, bar) do { unsigned _sp = 0; while (cond) { __builtin_amdgcn_s_sleep(1); \
    if ((++_sp & 255u) == 0u) { if (xb_ld(&(bar)[XB_TMO])) break; if (_sp > XB_SPIN_CAP) { atomicAdd(&(bar)[XB_TMO], 1u); break; } } } } while (0)
struct XcdBarrier { unsigned* bar; unsigned x; volatile LAS unsigned* st; };
__device__ __forceinline__ XcdBarrier xcd_barrier_post(unsigned* bar, volatile LAS unsigned* st) {
    XcdBarrier b; b.bar = bar; b.x = xb_xcc_id(); b.st = st;
    if (threadIdx.x == 0) (void)xb_add(&bar[XB_XCNT(b.x)], 1u);
    return b;
}
__device__ __forceinline__ void xcd_barrier_complete(unsigned* bar, unsigned x, unsigned& nloc, unsigned& nx) {
    const unsigned G = gridDim.x * gridDim.y * gridDim.z;
    unsigned sum, cnt, mine, sp = 0u;
    for (;;) {
        sum = 0u; cnt = 0u; mine = 0u;
#pragma unroll
        for (unsigned j = 0; j < 16; ++j) { const unsigned c = xb_ld(&bar[XB_XCNT(j)]); sum += c; cnt += (c > 0u) ? 1u : 0u; mine = (j == x) ? c : mine; }
        if (sum == G) break;
        __builtin_amdgcn_s_sleep(1);
        if ((++sp & 255u) == 0u) { if (xb_ld(&bar[XB_TMO])) break; if (sp > XB_SPIN_CAP) { atomicAdd(&bar[XB_TMO], 1u); break; } }
    }
    nloc = mine > 0u ? mine : 1u; nx = cnt > 0u ? cnt : 1u;
}
__device__ __forceinline__ void xcd_barrier(const XcdBarrier& b, bool leader) {
    asm volatile("s_waitcnt vmcnt(0)" ::: "memory");
    __syncthreads();
    if (leader) {
        unsigned* bar = b.bar;
        __builtin_amdgcn_s_waitcnt(0);
        unsigned nloc = b.st[0], nx = b.st[1];
        if (nloc == 0u) { xcd_barrier_complete(bar, b.x, nloc, nx); b.st[0] = nloc; b.st[1] = nx; }
        const unsigned old = xb_add(&bar[XB_XSUB(b.x)], 1u);
        const unsigned gen = old / nloc;
        if (old + 1u == (gen + 1u) * nloc) {
            __builtin_amdgcn_fence(__ATOMIC_RELEASE, "agent");
            asm volatile("s_waitcnt vmcnt(0)" ::: "memory");
            const unsigned og = xb_add(&bar[XB_TOP], 1u);
            const unsigned tg = og / nx;
            if (og + 1u == (tg + 1u) * nx) xb_add(&bar[XB_TOPGEN], 1u);
            else XB_SPIN(xb_ld(&bar[XB_TOPGEN]) == tg, bar);
            __builtin_amdgcn_fence(__ATOMIC_ACQUIRE, "agent");
            xb_add(&bar[XB_XGEN(b.x)], 1u);
            asm volatile("s_waitcnt vmcnt(0)" ::: "memory");
        } else {
            XB_SPIN(xb_ld(&bar[XB_XGEN(b.x)]) == gen, bar);
            __builtin_amdgcn_fence(__ATOMIC_ACQUIRE, "agent");
            asm volatile("s_waitcnt vmcnt(0)" ::: "memory");
        }
    }
    __syncthreads();
}

constexpr int RING_OFF = 0, RING_BYTES = 139264;
constexpr int MISC_OFF = RING_BYTES;
constexpr int LDS_BYTES = 147456;
struct Args { const float* in[N_IN]; float* out; unsigned char* ws; int ph_lo, ph_hi; };
struct Frame {
    LAS unsigned char* lds; int tid, lane, wave, G, bid;
    const float* const* in; float* out; unsigned char* ws;
};

__device__ __forceinline__ void p0_transpose_item(const float* W, int K, int N, bf16* WT, LAS float* scr, int item, int lane, const float* ksc = nullptr) {
    const int nblk = N / 32, kb = item / nblk, nb = item % nblk, k0 = 64 * kb, n0 = 32 * nb;
#pragma unroll 8
    for (int i = 0; i < 32; ++i) { const int kk = 2 * i + (lane >> 5); const float w_ = W[(size_t)(k0 + kk) * N + n0 + (lane & 31)]; scr[kk * 33 + (lane & 31)] = ksc ? w_ * ksc[k0 + kk] : w_; }
    LDS_WAIT(); asm volatile("" ::: "memory");
    const int c = lane & 7;
#pragma unroll
    for (int j = 0; j < 4; ++j) { const int n = (lane >> 3) + 8 * j; const LAS float* s = scr + (8 * c) * 33 + n;
        v4u o; o.x = pk2(s[0 * 33], s[1 * 33]); o.y = pk2(s[2 * 33], s[3 * 33]); o.z = pk2(s[4 * 33], s[5 * 33]); o.w = pk2(s[6 * 33], s[7 * 33]);
        *(GAS v4u*)(WT + (size_t)(n0 + n) * K + k0 + 8 * c) = o; }
    LDS_WAIT(); asm volatile("" ::: "memory");
}
__device__ __forceinline__ void transpose_weight(Frame& F, const float* W, int K, int N, bf16* WT) {
    LAS float* scr = (LAS float*)(F.lds + RING_OFF + F.wave * 16384);
    const int gw = F.bid * NWAVES + F.wave, NGW = F.G * NWAVES, nitems = (K / 64) * (N / 32);
    for (int it = gw; it < nitems; it += NGW) p0_transpose_item(W, K, N, WT, scr, it, F.lane);
}
__device__ __forceinline__ void norm_rows(Frame& F, const float* src_p, const float* src_s, const float* w, bf16* XN) {
    const int gw = F.bid * NWAVES + F.wave, NGW = F.G * NWAVES;
    for (int m = gw; m < MT; m += NGW) {
        const float* xrow = (m < MP) ? src_p + (size_t)m * DM : src_s + (size_t)(m - MP) * DM;
        const GAS f32x4* xr = (const GAS f32x4*)xrow + F.lane; const GAS f32x4* wr = (const GAS f32x4*)w + F.lane;
        f32x4 v[8]; float s = 0.f;
#pragma unroll
        for (int j = 0; j < 8; ++j) { v[j] = xr[64 * j]; s += (v[j].x * v[j].x + v[j].y * v[j].y) + (v[j].z * v[j].z + v[j].w * v[j].w); }
        const float rstd = 1.f / sqrtf(wave_sum(s) * (1.f / DM) + EPS);
        GAS v2u* o8 = (GAS v2u*)(XN + (size_t)m * DM) + F.lane;
#pragma unroll
        for (int j = 0; j < 8; ++j) { const f32x4 g = wr[64 * j]; v2u o; o.x = pk2(v[j].x * rstd * g.x, v[j].y * rstd * g.y); o.y = pk2(v[j].z * rstd * g.z, v[j].w * rstd * g.w); o8[64 * j] = o; }
    }
}
__device__ __forceinline__ void cache_cvt(Frame& F, const float* ck, const float* cv, bf16* KC, bf16* VC) {
    const size_t nvec = (size_t)NB * PAST * DM / 4;
    const size_t gt = (size_t)F.bid * NTHR + F.tid, NG = (size_t)F.G * NTHR;
    for (size_t i = gt; i < 2 * nvec; i += NG) {
        const bool isv = i >= nvec; const size_t e = (isv ? i - nvec : i) * 4;
        const size_t brow = e / DM, col = e % DM, b = brow / PAST, t = brow % PAST;
        const f32x4 x = *(const GAS f32x4*)((isv ? cv : ck) + e);
        v2u o; o.x = pk2(x.x, x.y); o.y = pk2(x.z, x.w);
        *(GAS v2u*)((isv ? VC : KC) + ((b * KCROWS + t) * DM + col)) = o;
    }
}
__device__ __forceinline__ int tw_chunks(int K, int N) { return (K / 64) * (N / 32) / 64; }
__device__ __forceinline__ void tw_run(Frame& F, const float* W, int K, int N, bf16* WT, int c, const float* ksc = nullptr) {
    LAS float* scr = (LAS float*)(F.lds + RING_OFF + F.wave * 16384);
#pragma unroll 1
    for (int i = 0; i < 8; ++i) p0_transpose_item(W, K, N, WT, scr, c * 64 + F.wave * 8 + i, F.lane, ksc);
}
constexpr int CC_CHUNKS = 2 * (NB * PAST * DM / 4) / 8192;
__device__ __forceinline__ void cc_run(Frame& F, const float* ck, const float* cv, bf16* KC, bf16* VC, int c) {
    const size_t nvec = (size_t)NB * PAST * DM / 4;
#pragma unroll 4
    for (int k = 0; k < 16; ++k) { const size_t i = (size_t)c * 8192 + k * NTHR + F.tid;
        const bool isv = i >= nvec; const size_t e = (isv ? i - nvec : i) * 4; const size_t brow = e / DM, col = e % DM, b = brow / PAST, t = brow % PAST;
        const f32x4 x = *(const GAS f32x4*)((isv ? cv : ck) + e); v2u o; o.x = pk2(x.x, x.y); o.y = pk2(x.z, x.w);
        *(GAS v2u*)((isv ? VC : KC) + ((b * KCROWS + t) * DM + col)) = o; }
}
constexpr int TR_CHUNKS = MP * 128 / 8192;
__device__ __forceinline__ void tr_run(Frame& F, float* tab, int c) {
#pragma unroll 1
    for (int k = 0; k < 16; ++k) { const size_t e = (size_t)c * 8192 + k * NTHR + F.tid; float cs, sn; rope_cs((int)(e >> 7), (int)(e & 127), 128, cs, sn); tab[2 * e] = cs; tab[2 * e + 1] = sn; }
}
__device__ __forceinline__ int row_pos(int row) { return row < MP ? row : PAST + ((row - MP) & 63); }

struct EpiAIn {
    static constexpr int BMODE = 2;
    pg8::bf16_t *Qs, *KP, *VP, *KC, *VC, *GA; float *okp, *ovp, *oks, *ovs; const float* tab; const float* qg; const float* kg; const float* ssq;
    __device__ __forceinline__ void operator()(const pg8::f32x4 (&acc)[2][2][4][2], const pg8::Unit& u, int wr, int wc, int fr, int fq) const {
        { const int l_ = lane_now(); fr = l_ & 15; fq = l_ >> 4; }
        const int pn = u.pn, pm = u.pm, typ = pn >> 3, cl = ((pn & 7) * 4 + wc) * 64 + 8 * fq; float rs[2][4]; row_rstd(ssq, pm, wr, fr, fq, rs);
        float g1[8], g2[8];
        if (typ < 2) { const float* gp = (typ == 0 ? qg : kg) + 8 * fq; const pg8::f32x4 a = *(const pg8::f32x4*)gp, b = *(const pg8::f32x4*)(gp + 4), c = *(const pg8::f32x4*)(gp + 32), d = *(const pg8::f32x4*)(gp + 36);
#pragma unroll
            for (int e = 0; e < 4; ++e) { g1[e] = a[e]; g1[4 + e] = b[e]; g2[e] = c[e]; g2[4 + e] = d[e]; } }
#pragma unroll
        for (int ai = 0; ai < 2; ++ai)
#pragma unroll
          for (int mp = 0; mp < 2; ++mp) {
            pg8::f32x4 tq[4][4];
            if (typ < 2) {
#pragma unroll
                for (int m = 2 * mp; m < 2 * mp + 2; ++m) { const int i_ = ai * 128 + wr * 64 + m * 16 + fr; const int pos_ = pm < 64 ? pm * 256 + i_ : PAST + (i_ & 63); const float* tp_ = tab + ((size_t)pos_ * 32 + 8 * fq) * 2;
#pragma unroll
                    for (int q4 = 0; q4 < 4; ++q4) tq[m][q4] = *(const pg8::f32x4*)(tp_ + 4 * q4); } }
#pragma unroll
            for (int m = 2 * mp; m < 2 * mp + 2; ++m) {
                const int i = ai * 128 + wr * 64 + m * 16 + fr; const size_t row = (size_t)pm * 256 + i;
                float x1[8], x2[8];
#pragma unroll
                for (int e = 0; e < 4; ++e) { x1[e] = acc[ai][0][m][0][e] * rs[ai][m]; x1[4 + e] = acc[ai][0][m][1][e] * rs[ai][m]; x2[e] = acc[ai][1][m][0][e] * rs[ai][m]; x2[4 + e] = acc[ai][1][m][1][e] * rs[ai][m]; }
                size_t drow; pg8::bf16_t* dk; pg8::bf16_t* dv; float* fk; float* fv;
                if (pm < 64) { drow = row; dk = KP; dv = VP; fk = okp + row * DM; fv = ovp + row * DM; }
                else { const int s_ = (int)(row - MP); drow = (size_t)(s_ >> 6) * KCROWS + PAST + (s_ & 63); dk = KC; dv = VC; fk = oks + (size_t)s_ * DM; fv = ovs + (size_t)s_ * DM; }
                if (typ < 2) {
                    float ss = 0.f;
#pragma unroll
                    for (int k = 0; k < 8; ++k) ss += x1[k] * x1[k] + x2[k] * x2[k];
                    ss += __shfl_xor(ss, 16); ss += __shfl_xor(ss, 32);
                    const float rstd = 1.f / sqrtf(ss * (1.f / 64.f) + EPS);
                    float o1[8], o2[8];
#pragma unroll
                    for (int q4 = 0; q4 < 4; ++q4) { const pg8::f32x4 t = tq[m][q4];
#pragma unroll
                        for (int z = 0; z < 2; ++z) { const int k = 2 * q4 + z; const float c = t[2 * z], s = t[2 * z + 1], y1 = x1[k] * rstd * g1[k], y2 = x2[k] * rstd * g2[k]; o1[k] = y1 * c - y2 * s; o2[k] = y2 * c + y1 * s; } }
                    if (typ == 0) { v4u w1, w2;
                        w1.x = pk2(o1[0] * C2, o1[1] * C2); w1.y = pk2(o1[2] * C2, o1[3] * C2); w1.z = pk2(o1[4] * C2, o1[5] * C2); w1.w = pk2(o1[6] * C2, o1[7] * C2);
                        w2.x = pk2(o2[0] * C2, o2[1] * C2); w2.y = pk2(o2[2] * C2, o2[3] * C2); w2.z = pk2(o2[4] * C2, o2[5] * C2); w2.w = pk2(o2[6] * C2, o2[7] * C2);
                        *(v4u*)(Qs + row * DM + cl) = w1; *(v4u*)(Qs + row * DM + cl + 32) = w2;
                    } else { v4u w1, w2;
                        w1.x = pk2(o1[0], o1[1]); w1.y = pk2(o1[2], o1[3]); w1.z = pk2(o1[4], o1[5]); w1.w = pk2(o1[6], o1[7]);
                        w2.x = pk2(o2[0], o2[1]); w2.y = pk2(o2[2], o2[3]); w2.z = pk2(o2[4], o2[5]); w2.w = pk2(o2[6], o2[7]);
                        *(v4u*)(dk + drow * DM + cl) = w1; *(v4u*)(dk + drow * DM + cl + 32) = w2;
                        *(pg8::f32x4*)(fk + cl) = (pg8::f32x4){o1[0], o1[1], o1[2], o1[3]}; *(pg8::f32x4*)(fk + cl + 4) = (pg8::f32x4){o1[4], o1[5], o1[6], o1[7]};
                        *(pg8::f32x4*)(fk + cl + 32) = (pg8::f32x4){o2[0], o2[1], o2[2], o2[3]}; *(pg8::f32x4*)(fk + cl + 36) = (pg8::f32x4){o2[4], o2[5], o2[6], o2[7]}; }
                } else { v4u w1, w2;
                    w1.x = pk2(x1[0], x1[1]); w1.y = pk2(x1[2], x1[3]); w1.z = pk2(x1[4], x1[5]); w1.w = pk2(x1[6], x1[7]);
                    w2.x = pk2(x2[0], x2[1]); w2.y = pk2(x2[2], x2[3]); w2.z = pk2(x2[4], x2[5]); w2.w = pk2(x2[6], x2[7]);
                    if (typ == 2) { *(v4u*)(dv + drow * DM + cl) = w1; *(v4u*)(dv + drow * DM + cl + 32) = w2;
                        *(pg8::f32x4*)(fv + cl) = (pg8::f32x4){x1[0], x1[1], x1[2], x1[3]}; *(pg8::f32x4*)(fv + cl + 4) = (pg8::f32x4){x1[4], x1[5], x1[6], x1[7]};
                        *(pg8::f32x4*)(fv + cl + 32) = (pg8::f32x4){x2[0], x2[1], x2[2], x2[3]}; *(pg8::f32x4*)(fv + cl + 36) = (pg8::f32x4){x2[4], x2[5], x2[6], x2[7]}; }
                    else { *(v4u*)(GA + row * DM + cl) = w1; *(v4u*)(GA + row * DM + cl + 32) = w2; }
                }
                if (m & 1) asm volatile("" ::: "memory");
            }
        }
    }
};
__device__ __forceinline__ void attn_table(Frame& F, float* tab) {
    const size_t gt = (size_t)F.bid * NTHR + F.tid, NG = (size_t)F.G * NTHR;
    for (size_t e = gt; e < (size_t)MP * 32; e += NG) { float c, s; rope_cs((int)(e >> 5), (int)(e & 31), 32, c, s); tab[2 * e] = c; tab[2 * e + 1] = s; }
}
namespace dattn {
typedef short bf16x8 __attribute__((ext_vector_type(8)));
typedef short s16x4 __attribute__((ext_vector_type(4)));
typedef short v4i16_t __attribute__((ext_vector_type(4)));
typedef float f32x16 __attribute__((ext_vector_type(16)));
typedef unsigned u32x4 __attribute__((ext_vector_type(4)));
typedef __attribute__((address_space(3))) const char* lds_cptr;
constexpr int RINGB = 98304, WSF_OFF = RINGB, XCHB = 18432, STP = 144;
__device__ __forceinline__ int crow(int r, int hi) { return (r & 3) + 8 * (r >> 2) + 4 * hi; }
__device__ __forceinline__ void glds16(const void* gsrc, unsigned lds_dst) { unsigned keep;
    asm volatile("s_mov_b32 %0, m0\n\ts_mov_b32 m0, %2\n\ts_nop 0\n\tglobal_load_lds_dwordx4 %1, off\n\ts_mov_b32 m0, %0" : "=&s"(keep) : "v"(gsrc), "s"(lds_dst) : "memory"); }
typedef float f32x2_t __attribute__((ext_vector_type(2))); typedef __bf16 bf16x2_t __attribute__((ext_vector_type(2)));
__device__ __forceinline__ unsigned cvtpk_s(float lo, float hi) { f32x2_t v = {lo, hi}; bf16x2_t b = __builtin_convertvector(v, bf16x2_t); return __builtin_bit_cast(unsigned, b); }
#define DA_WAIT_BAR(N) asm volatile("s_waitcnt vmcnt(" #N ") lgkmcnt(0)\n\ts_barrier" ::: "memory")
__device__ __forceinline__ s16x4 vtr(lds_cptr p) { return __builtin_bit_cast(s16x4, __builtin_amdgcn_ds_read_tr16_b64_v4i16((__attribute__((address_space(3))) v4i16_t*)p)); }
struct Unit { const bf16* Q; const bf16* K; const bf16* V; const bf16* G; bf16* AO; int NT; int full; int dma0; };

constexpr int KSLOT = 16384, VSLOT = 16384, VRING = 3 * KSLOT;
#define DA_SBAR() __builtin_amdgcn_sched_barrier(0)
#define DA_PIN(x) asm volatile("" : "+v"(x))
#define DA_MFMA(a, b, c) __builtin_amdgcn_mfma_f32_32x32x16_bf16(a, b, c, 0, 0, 0)
struct DmaJob { const bf16* kp; const bf16* vp; unsigned kd0, kd1, vd0, vd1; };
__device__ __forceinline__ void dma_piece(const DmaJob& j, int i) { if (i == 0) glds16(j.kp, j.kd0); else if (i == 1) glds16(j.kp + 64, j.kd1); else if (i == 2) glds16(j.vp, j.vd0); else glds16(j.vp + 64, j.vd1); }
template <bool QK, bool PV, int VAR>
__device__ __forceinline__ void step(lds_cptr kpn, lds_cptr vp, const bf16x8 (&qr)[4], bf16x8 (&kf)[8], f32x16 (&o)[4], u32x4 (&pw)[4], float& l_reg, const DmaJob& dj) {
    f32x16 C0 = f32x16{}, C1 = f32x16{};
    s16x4 vlo[4], vhi[4];
    if constexpr (!QK) { dma_piece(dj, 0); dma_piece(dj, 1); dma_piece(dj, 2); dma_piece(dj, 3); }
#define DA_FOFF(f) ((((f) & 3) * 4096) + (((f) >> 2) * 1024))
#pragma unroll
    for (int a = 0; a < 8; ++a) {
        if constexpr (PV) { if (a >= 4) { if (VAR != 4) { vlo[a - 4] = vtr(vp + DA_FOFF(a - 4)); vhi[a - 4] = vtr(vp + DA_FOFF(a - 4) + 512); } else { vlo[a - 4] = s16x4{1, 2, 3, 4}; vhi[a - 4] = s16x4{5, 6, 7, 8}; } DA_SBAR(); } }
        if constexpr (QK) {
            if (a & 1) C1 = (a < 2) ? DA_MFMA(kf[a], qr[a >> 1], f32x16{}) : DA_MFMA(kf[a], qr[a >> 1], C1);
            else       C0 = (a < 2) ? DA_MFMA(kf[a], qr[a >> 1], f32x16{}) : DA_MFMA(kf[a], qr[a >> 1], C0);
            if (a < 4) dma_piece(dj, a);
            DA_SBAR();
        }
    }
    u32x4 pwn[4]; pwn[0] = u32x4{}; pwn[1] = u32x4{}; pwn[2] = u32x4{}; pwn[3] = u32x4{};
    float s0 = 0.f, s1 = 0.f;
#pragma unroll
    for (int p = 0; p < 16; ++p) {
        if constexpr (PV) {
            const bf16x8 vf = (bf16x8){vlo[p & 3][0], vlo[p & 3][1], vlo[p & 3][2], vlo[p & 3][3], vhi[p & 3][0], vhi[p & 3][1], vhi[p & 3][2], vhi[p & 3][3]};
            if (VAR != 3) o[p & 3] = DA_MFMA(__builtin_bit_cast(bf16x8, pw[p >> 2]), vf, o[p & 3]); else { o[p & 3][0] += __builtin_bit_cast(float, (int)vf[0] | ((int)vf[4] << 16)); }
            if (p < 12 && VAR != 4) { vlo[p & 3] = vtr(vp + DA_FOFF(p + 4)); vhi[p & 3] = vtr(vp + DA_FOFF(p + 4) + 512); }
        }
        if constexpr (QK) {
            float e0, e1;
            if (VAR == 2) { if (p < 8) { e0 = C0[2 * p]; e1 = C0[2 * p + 1]; } else { e0 = C1[2 * p - 16]; e1 = C1[2 * p - 15]; } }
            else if (p < 8) { e0 = __builtin_amdgcn_exp2f(C0[2 * p]); e1 = __builtin_amdgcn_exp2f(C0[2 * p + 1]); }
            else       { e0 = __builtin_amdgcn_exp2f(C1[2 * p - 16]); e1 = __builtin_amdgcn_exp2f(C1[2 * p - 15]); }
            s0 += e0; s1 += e1; pwn[p >> 2][p & 3] = cvtpk_s(e0, e1);
            DA_PIN(s0); DA_PIN(s1); DA_PIN(pwn[p >> 2]);
            if (p >= 8 && VAR != 6) { const int j = p - 8; kf[j] = *(const __attribute__((address_space(3))) bf16x8*)(kpn + (j >> 1) * 2048 + (j & 1) * 512); }
        }
        DA_SBAR();
    }
    if constexpr (QK) { l_reg += s0 + s1; pw[0] = pwn[0]; pw[1] = pwn[1]; pw[2] = pwn[2]; pw[3] = pwn[3]; }
#undef DA_FOFF
}

template <bool QK, bool PV>
__device__ __forceinline__ void step2(lds_cptr kpn, lds_cptr vp, const bf16x8 (&qr)[4], bf16x8 (&kf)[8], f32x16 (&o)[4], u32x4 (&pw)[4], float& l_reg, const DmaJob& dj,
                                      f32x16& Cn0, f32x16& Cn1, const f32x16& Pp0, const f32x16& Pp1) {
    s16x4 vlo[4], vhi[4];
#define DA_FOFF(f) ((((f) & 3) * 4096) + (((f) >> 2) * 1024))
    if constexpr (!QK) { dma_piece(dj, 0); dma_piece(dj, 1); dma_piece(dj, 2); dma_piece(dj, 3); }
    float s0 = 0.f, s1 = 0.f;
#pragma unroll
    for (int a = 0; a < 8; ++a) {
        if constexpr (PV) { if (a >= 4) { vlo[a - 4] = vtr(vp + DA_FOFF(a - 4)); vhi[a - 4] = vtr(vp + DA_FOFF(a - 4) + 512); DA_SBAR(); } }
        if constexpr (QK) {
            if (a & 1) Cn1 = (a < 2) ? DA_MFMA(kf[a], qr[a >> 1], f32x16{}) : DA_MFMA(kf[a], qr[a >> 1], Cn1);
            else       Cn0 = (a < 2) ? DA_MFMA(kf[a], qr[a >> 1], f32x16{}) : DA_MFMA(kf[a], qr[a >> 1], Cn0);
            if (a < 4) dma_piece(dj, a);
        }
        if constexpr (PV) {
            float x0, x1, x2, x3;
            if (a < 4) { x0 = Pp0[4 * a]; x1 = Pp0[4 * a + 1]; x2 = Pp0[4 * a + 2]; x3 = Pp0[4 * a + 3]; }
            else       { x0 = Pp1[4 * a - 16]; x1 = Pp1[4 * a - 15]; x2 = Pp1[4 * a - 14]; x3 = Pp1[4 * a - 13]; }
            s0 += x0; s1 += x1; s0 += x2; s1 += x3;
            pw[(2 * a) >> 2][(2 * a) & 3] = cvtpk_s(x0, x1); pw[(2 * a + 1) >> 2][(2 * a + 1) & 3] = cvtpk_s(x2, x3);
            DA_PIN(s0); DA_PIN(s1); DA_PIN(pw[(2 * a) >> 2]);
        }
        if constexpr (QK || PV) DA_SBAR();
    }
    if constexpr (PV) l_reg += s0 + s1;
#pragma unroll
    for (int p = 0; p < 16; ++p) {
        if constexpr (PV) {
            const bf16x8 vf = (bf16x8){vlo[p & 3][0], vlo[p & 3][1], vlo[p & 3][2], vlo[p & 3][3], vhi[p & 3][0], vhi[p & 3][1], vhi[p & 3][2], vhi[p & 3][3]};
            o[p & 3] = DA_MFMA(__builtin_bit_cast(bf16x8, pw[p >> 2]), vf, o[p & 3]);
            if (p < 12) { vlo[p & 3] = vtr(vp + DA_FOFF(p + 4)); vhi[p & 3] = vtr(vp + DA_FOFF(p + 4) + 512); }
        }
        if constexpr (QK) {
            if (p < 8) { Cn0[2 * p] = __builtin_amdgcn_exp2f(Cn0[2 * p]); Cn0[2 * p + 1] = __builtin_amdgcn_exp2f(Cn0[2 * p + 1]); DA_PIN(Cn0); }
            else       { Cn1[2 * p - 16] = __builtin_amdgcn_exp2f(Cn1[2 * p - 16]); Cn1[2 * p - 15] = __builtin_amdgcn_exp2f(Cn1[2 * p - 15]); DA_PIN(Cn1); }
            if (p >= 8) { const int j = p - 8; kf[j] = *(const __attribute__((address_space(3))) bf16x8*)(kpn + (j >> 1) * 2048 + (j & 1) * 512); }
        }
        if constexpr (QK || PV) DA_SBAR();
    }
#undef DA_FOFF
}

__device__ __forceinline__ void unit_prologue(const Unit& u, unsigned lds0, int lane, int wid, bf16x8 (&qr)[4]) {
    const int r32 = lane & 31, hi = lane >> 5, s = wid >> 2, g = wid & 3; const int NT = u.NT; const int wt = u.full ? (g < 2 ? NT - 1 : NT) : (g < 2 ? NT : 0);
    const bf16* ksrc = u.K + (long)lane * DM + wid * 8;
    const bf16* vsrc = u.V + (long)(16 * (wid & 3) + (lane >> 2)) * DM + (wid >> 2) * 32 + (lane & 3) * 8;
    const unsigned kdst = lds0 + wid * 1024, vdst = lds0 + VRING + wid * 1024;
#pragma unroll
    for (int t = 0; t < 3; ++t) { const int tt_ = t < NT ? t : NT - 1; const bf16* kp_ = ksrc + (long)tt_ * 64 * DM;
        glds16(kp_, (unsigned)__builtin_amdgcn_readfirstlane(kdst + t * KSLOT)); glds16(kp_ + 64, (unsigned)__builtin_amdgcn_readfirstlane(kdst + 8192 + t * KSLOT)); }
    glds16(vsrc, (unsigned)__builtin_amdgcn_readfirstlane(vdst)); glds16(vsrc + 64, (unsigned)__builtin_amdgcn_readfirstlane(vdst + 8192));
    const bf16* Qw = u.Q + (long)(32 * g + r32) * DM + s * 64;
#pragma unroll
    for (int d0 = 0; d0 < 4; ++d0) qr[d0] = (wt > 0) ? *reinterpret_cast<const bf16x8*>(Qw + d0 * 16 + hi * 8) : (bf16x8){0, 0, 0, 0, 0, 0, 0, 0};
}
template <int VAR>
__device__ __forceinline__ void attn_unit(const Unit& u, bool has_next, const Unit& nxt, bool prefetched, bf16x8 (&qr)[4], char* shm, float* wsf_base, float lam, float one_m_li, const float* sub_gain, int tid) {
    asm volatile("" : "+v"(tid));
    const int lane = tid & 63, r32 = lane & 31, hi = lane >> 5; const int wid = __builtin_amdgcn_readfirstlane(tid >> 6), s = wid >> 2, g = wid & 3;
    const int NT = u.NT; const int wt = u.full ? (g < 2 ? NT - 1 : NT) : (g < 2 ? NT : 0);
    const unsigned lds0 = (unsigned)(uintptr_t)shm;
    float* wsf = wsf_base + wid * 64;
    const bf16* ksrc = u.K + (long)lane * DM + wid * 8;
    const bf16* vsrc = u.V + (long)(16 * (wid & 3) + (lane >> 2)) * DM + (wid >> 2) * 32 + (lane & 3) * 8;
    const unsigned kdst = lds0 + wid * 1024, vdst = lds0 + VRING + wid * 1024;
#define DA_DMA_K(t, slot) do { const int tt_ = u.dma0 ? 0 : (t) < NT ? (t) : NT - 1; const bf16* kp_ = ksrc + (long)tt_ * 64 * DM; \
        glds16(kp_, (unsigned)__builtin_amdgcn_readfirstlane(kdst + (slot) * KSLOT)); glds16(kp_ + 64, (unsigned)__builtin_amdgcn_readfirstlane(kdst + 8192 + (slot) * KSLOT)); } while (0)
#define DA_DMA_V(t, slot) do { const int tt_ = u.dma0 ? 0 : (t) < NT ? (t) : NT - 1; const bf16* vp_ = vsrc + (long)tt_ * 64 * DM; \
        glds16(vp_, (unsigned)__builtin_amdgcn_readfirstlane(vdst + (slot) * VSLOT)); glds16(vp_ + 64, (unsigned)__builtin_amdgcn_readfirstlane(vdst + 8192 + (slot) * VSLOT)); } while (0)
    const lds_cptr shm3 = (lds_cptr)shm;
    const lds_cptr kp0 = shm3 + s * 8192 + hi * 1024 + r32 * 16;
    const lds_cptr vp0 = shm3 + VRING + ((lane >> 4) & 1) * 32 + (lane & 3) * 8 + (4 * hi + ((lane & 15) >> 2)) * 64;
    if (!prefetched) unit_prologue(u, lds0, lane, wid, qr);
    asm volatile("" : "+v"(qr[0]), "+v"(qr[1]), "+v"(qr[2]), "+v"(qr[3]));
    f32x16 o[4]; o[0] = f32x16{}; o[1] = f32x16{}; o[2] = f32x16{}; o[3] = f32x16{};
    float l_reg = 0.f;
    u32x4 pw[4]; pw[0] = u32x4{}; pw[1] = u32x4{}; pw[2] = u32x4{}; pw[3] = u32x4{};
    DA_WAIT_BAR(0);
    bf16x8 kf[8];
#pragma unroll
    for (int j = 0; j < 8; ++j) kf[j] = *(const __attribute__((address_space(3))) bf16x8*)(kp0 + (j >> 1) * 2048 + (j & 1) * 512);
    int ks_cur = 0  , vs_prev = 2  ;
#define DA_TOP(t) \
        DA_WAIT_BAR(4);                                          \
        const int ks_next = (ks_cur == 2) ? 0 : ks_cur + 1, vs_cur = (vs_prev == 2) ? 0 : vs_prev + 1, vs_next = (vs_cur == 2) ? 0 : vs_cur + 1; \
        DmaJob dj; { const int tk_ = ((t) + 3) < NT ? ((t) + 3) : NT - 1, tv_ = ((t) + 1) < NT ? ((t) + 1) : NT - 1; dj.kp = ksrc + (long)tk_ * 64 * DM; dj.vp = vsrc + (long)tv_ * 64 * DM; \
          dj.kd0 = (unsigned)__builtin_amdgcn_readfirstlane(kdst + ks_cur * KSLOT); dj.kd1 = dj.kd0 + 8192u; dj.vd0 = (unsigned)__builtin_amdgcn_readfirstlane(vdst + vs_next * VSLOT); dj.vd1 = dj.vd0 + 8192u; }     \
        const lds_cptr kpn = kp0 + ks_next * KSLOT; const lds_cptr vp = vp0 + vs_prev * VSLOT; (void)kpn; (void)vp
#define DA_ROT() do { ks_cur = ks_next; vs_prev = vs_cur; } while (0)
    f32x16 pA0 = f32x16{}, pA1 = f32x16{}, pB0 = f32x16{}, pB1 = f32x16{};
#define DA_IDLE() do { dma_piece(dj, 0); dma_piece(dj, 1); dma_piece(dj, 2); dma_piece(dj, 3); } while (0)
    if (wid >= 4) __builtin_amdgcn_s_setprio(1);
    int t = 0;
    const bool odd = ((wt - 1) & 1) != 0;
    { DA_TOP(0); if (wt > 0) { if (odd) step2<true, false>(kpn, vp, qr, kf, o, pw, l_reg, dj, pB0, pB1, pA0, pA1); else step2<true, false>(kpn, vp, qr, kf, o, pw, l_reg, dj, pA0, pA1, pB0, pB1); } else DA_IDLE(); DA_ROT(); }
    t = 1;
    if (wt > 0 && odd) { DA_TOP(t); step2<true, true>(kpn, vp, qr, kf, o, pw, l_reg, dj, pA0, pA1, pB0, pB1); DA_ROT(); ++t; }
    for (; t + 1 < wt; t += 2) {
        { DA_TOP(t);     step2<true, true>(kpn, vp, qr, kf, o, pw, l_reg, dj, pB0, pB1, pA0, pA1); DA_ROT(); }
        { DA_TOP(t + 1); step2<true, true>(kpn, vp, qr, kf, o, pw, l_reg, dj, pA0, pA1, pB0, pB1); DA_ROT(); }
    }
    if (wt > 0) { DA_TOP(t); step2<false, true>(kpn, vp, qr, kf, o, pw, l_reg, dj, pB0, pB1, pA0, pA1); DA_ROT(); ++t; }
    for (; t <= NT; ++t) { DA_TOP(t); DA_IDLE(); DA_ROT(); }
#undef DA_IDLE
#undef DA_TOP
#undef DA_ROT
    __builtin_amdgcn_s_setprio(0);
    { auto rr = __builtin_amdgcn_permlane32_swap(__float_as_uint(l_reg), __float_as_uint(l_reg), false, false); l_reg = __uint_as_float(rr[0]) + __uint_as_float(rr[1]); }
    if (hi == 0) wsf[r32] = l_reg;
    DA_WAIT_BAR(0);
    if (has_next) unit_prologue(nxt, lds0, lane, wid, qr);
    float rli[16];
#pragma unroll
    for (int r = 0; r < 16; ++r) { const float lq = wsf[crow(r, hi)]; rli[r] = (s == 0 ? 1.f : -lam) / lq; }
    int le = lane; asm volatile("" : "+v"(le));
    const int r32e = le & 31, hie = le >> 5;
    float* xch = (float*)(shm + 65536 + g * XCHB);
    if (s == 1 && wt > 0) {
#pragma unroll
        for (int db = 0; db < 4; ++db)
#pragma unroll
            for (int r = 0; r < 16; ++r) xch[(db * 16 + r) * 64 + le] = o[db][r] * rli[r];
    }
    asm volatile("s_waitcnt lgkmcnt(0)\n\ts_barrier" ::: "memory");
    if (s == 0 && wt > 0) {
#pragma unroll
        for (int db = 0; db < 4; ++db)
#pragma unroll
            for (int r = 0; r < 16; ++r) o[db][r] = o[db][r] * rli[r] + xch[(db * 16 + r) * 64 + le];
        asm volatile("s_waitcnt lgkmcnt(0)" ::: "memory");
#pragma unroll
        for (int db = 0; db < 4; ++db)
#pragma unroll
            for (int r = 0; r < 16; ++r) xch[crow(r, hie) * STP + 32 * db + r32e] = o[db][r];
        asm volatile("s_waitcnt lgkmcnt(0)" ::: "memory");
        const int row = le >> 1, half = le & 1;
        float v[64]; float ss = 0.f;
#pragma unroll
        for (int k = 0; k < 16; ++k) { const f32x4 x = *(const f32x4*)(xch + row * STP + half * 64 + 4 * k); v[4 * k] = x.x; v[4 * k + 1] = x.y; v[4 * k + 2] = x.z; v[4 * k + 3] = x.w; ss += (x.x * x.x + x.y * x.y) + (x.z * x.z + x.w * x.w); }
        ss += __shfl_xor(ss, 1);
        const float sc = one_m_li / sqrtf(ss * (1.f / 128.f) + EPS);
        const bf16* gp = u.G + (long)(32 * g + row) * DM + half * 64; bf16* op = u.AO + (long)(32 * g + row) * DM + half * 64; const float* sg = sub_gain + half * 64;
#pragma unroll
        for (int k = 0; k < 8; ++k) { const v4u g4 = *(const v4u*)(gp + 8 * k); const f32x4 ga = *(const f32x4*)(sg + 8 * k), gb = *(const f32x4*)(sg + 8 * k + 4);
            const float gg[8] = {bflo(g4.x), bfhi(g4.x), bflo(g4.y), bfhi(g4.y), bflo(g4.z), bfhi(g4.z), bflo(g4.w), bfhi(g4.w)};
            const float gn[8] = {ga.x, ga.y, ga.z, ga.w, gb.x, gb.y, gb.z, gb.w}; float y[8];
#pragma unroll
            for (int e = 0; e < 8; ++e) y[e] = v[8 * k + e] * sc * gn[e] * silu_f(gg[e]);
            v4u w; w.x = pk2(y[0], y[1]); w.y = pk2(y[2], y[3]); w.z = pk2(y[4], y[5]); w.w = pk2(y[6], y[7]);
            *(v4u*)(op + 8 * k) = w; }
    }
#undef DA_DMA_K
#undef DA_DMA_V
}
}
template <int VAR = 0>
__device__ __forceinline__ void attn_fast(Frame& F, const bf16* Qs, const bf16* KP, const bf16* VP, const bf16* KC, const bf16* VC, const bf16* GA  , bf16* AO,
                                          float lam, float one_m_li, const float* sub_gain, int dma0 = 0) {
    const int NU = 2048 + 16 * NB;
    const bool xcd = (F.G == 256);
#define ATTN_GET(i_, u_, ok_) do { int qb = 0, h = 0, b = -1; ok_ = true; \
        if (xcd) { const int x = F.bid & 7, r = F.bid >> 3; \
            if ((i_) < 8) { h = x + 8 * ((i_) >> 2); const int rr = ((i_) == 0) ? (r ^ 8) : r; qb = 127 - (((i_) & 3) * 32 + (((i_) & 1) ? 31 - rr : rr)); } \
            else if ((i_) == 8 && (r & 8) == 0) { const int sb = (r & 7) + ((r >> 4) << 3); h = x + 8 * (sb >> 3); b = sb & 7; } \
            else ok_ = false; \
        } else { const int idx = (i_) * F.G + (((i_) & 1) ? F.G - 1 - F.bid : F.bid); if (idx >= NU) ok_ = false; \
            else if (idx < 2048) { qb = 127 - (idx >> 4); h = idx & 15; } else { const int j = idx - 2048; b = j >> 4; h = j & 15; } } \
        u_.dma0 = 0; \
        if (ok_) { if (b < 0) { const long row0 = 128L * qb; \
            u_.Q = Qs + row0 * DM + h * 128; u_.K = KP + h * 128; u_.V = VP + h * 128; u_.G = GA + row0 * DM + h * 128; u_.AO = AO + row0 * DM + h * 128; u_.NT = 2 * qb + 2; u_.full = 1; } \
          else { const long row0 = MP + 64L * b; \
            u_.Q = Qs + row0 * DM + h * 128; u_.K = KC + (long)b * KCROWS * DM + h * 128; u_.V = VC + (long)b * KCROWS * DM + h * 128; u_.G = GA + row0 * DM + h * 128; u_.AO = AO + row0 * DM + h * 128; u_.NT = KCROWS / 64; u_.full = 0; } } } while (0)
    dattn::Unit u, nx; bool have; ATTN_GET(0, u, have);
    dattn::bf16x8 qr[4]; bool pre = false;
    float* wsf_base = (float*)((char*)F.lds + MISC_OFF + 1024);
    for (int i = 0; have; ++i) {
        bool hn; ATTN_GET(i + 1, nx, hn);
        dattn::attn_unit<VAR>(u, hn, nx, pre, qr, (char*)F.lds + RING_OFF, wsf_base, lam, one_m_li, sub_gain, F.tid);
        u = nx; have = hn; pre = true;
    }
    __syncthreads();
#undef ATTN_GET
}
constexpr int RBLK = 72;
__device__ __forceinline__ float ret_lg2(int h) { return log2f(1.f - exp2f(-5.f - (float)h)); }
struct EpiRet {
    static constexpr int BMODE = 0;
    pg8::bf16_t* QP; pg8::bf16_t* KN; pg8::bf16_t* KT; pg8::bf16_t* VS; pg8::bf16_t* RG; const float* tab; const float* ssq;
    __device__ __forceinline__ void operator()(const pg8::f32x4 (&acc)[2][2][4][2], const pg8::Unit& u, int wr, int wc, int fr, int fq) const {
        { const int l_ = lane_now(); fr = l_ & 15; fq = l_ >> 4; }
        const int pn = u.pn, pm = u.pm; float rs[2][4]; row_rstd(ssq, pm, wr, fr, fq, rs);
#pragma unroll
        for (int ai = 0; ai < 2; ++ai)
#pragma unroll
            for (int m = 0; m < 4; ++m) {
                const int i = ai * 128 + wr * 64 + m * 16 + fr; const size_t row = (size_t)pm * 256 + i;
                const int J = pm < 64 ? pm : 64 + 4 * (pm - 64) + (i >> 6), jj = pm < 64 ? i : (i & 63), pos = pm < 64 ? (int)row : PAST + (i & 63);
                if (pn < 16) {
                    const int h = pn & 7; const bool isk = pn >= 8; const float sc = isk ? 0.0625f : 1.f;
#pragma unroll
                    for (int n = 0; n < 2; ++n) { const int c1 = wc * 32 + n * 16 + 4 * fq;
                        const pg8::f32x4 t0 = *(const pg8::f32x4*)(tab + ((size_t)pos * 128 + c1) * 2), t1 = *(const pg8::f32x4*)(tab + ((size_t)pos * 128 + c1) * 2 + 4);
                        const pg8::f32x4 x1 = acc[ai][0][m][n] * rs[ai][m], x2 = acc[ai][1][m][n] * rs[ai][m];
                        const float cs[4] = {t0[0], t0[2], t1[0], t1[2]}, sn[4] = {t0[1], t0[3], t1[1], t1[3]}; float o1[4], o2[4];
#pragma unroll
                        for (int e = 0; e < 4; ++e) { o1[e] = (x1[e] * cs[e] - x2[e] * sn[e]) * sc; o2[e] = (x2[e] * cs[e] + x1[e] * sn[e]) * sc; }
                        v2u w1, w2; w1.x = pk2(o1[0], o1[1]); w1.y = pk2(o1[2], o1[3]); w2.x = pk2(o2[0], o2[1]); w2.y = pk2(o2[2], o2[3]);
                        if (!isk) { pg8::bf16_t* p = QP + row * 4096 + h * 512 + 256 + c1; *(v2u*)p = w1; *(v2u*)(p + 128) = w2; }
                        else { pg8::bf16_t* p = KN + row * 2048 + h * 256 + c1; *(v2u*)p = w1; *(v2u*)(p + 128) = w2;
                            pg8::bf16_t* t = KT + ((size_t)(J * 8 + h) * 256 + c1) * 256 + jj;
#pragma unroll
                            for (int e = 0; e < 4; ++e) { t[(size_t)e * 256] = (pg8::bf16_t)f2bf(o1[e]); t[(size_t)(128 + e) * 256] = (pg8::bf16_t)f2bf(o2[e]); } } }
                } else if (pn < 32) {
                    const int h = (pn - 16) >> 1, half = (pn - 16) & 1; const float f = exp2f(-(float)(1 + jj) * ret_lg2(h)) * rs[ai][m];
#pragma unroll
                    for (int bj = 0; bj < 2; ++bj)
#pragma unroll
                        for (int n = 0; n < 2; ++n) { const int dv = half * 256 + bj * 128 + wc * 32 + n * 16 + 4 * fq; pg8::bf16_t* t = VS + ((size_t)(J * 8 + h) * 512 + dv) * 512 + jj;
#pragma unroll
                            for (int e = 0; e < 4; ++e) t[(size_t)e * 512] = (pg8::bf16_t)f2bf(acc[ai][bj][m][n][e] * f); }
                } else {
#pragma unroll
                    for (int bj = 0; bj < 2; ++bj)
#pragma unroll
                        for (int n = 0; n < 2; ++n) { const int c = (pn - 32) * 256 + bj * 128 + wc * 32 + n * 16 + 4 * fq; const pg8::f32x4 x = acc[ai][bj][m][n] * rs[ai][m];
                            v2u w; w.x = pk2(x[0], x[1]); w.y = pk2(x[2], x[3]); *(v2u*)(RG + row * 4096 + c) = w; }
                }
            }
    }
};
__device__ __forceinline__ size_t ret_row0(int J) { return J < 64 ? (size_t)256 * J : (size_t)MP + 64 * (J - 64); }
struct RetQKOrder {
    int G, c; const char* QP; const char* KN;
    __device__ __forceinline__ bool next(int i, pg8::Unit& u) const { const int L = i * G + c; if (L >= RBLK * 8) return false; const int J = L >> 3, h = L & 7; const size_t r0 = ret_row0(J);
        u.pm = J; u.pn = h; u.a = QP + (r0 * 4096 + h * 512 + 256) * 2; u.b = KN + (r0 * 2048 + h * 256) * 2; return true; }
    __device__ __forceinline__ void a_ready(const pg8::Unit&) const {}
    __device__ __forceinline__ void done(const pg8::Unit&) const {}
};
struct EpiRetQK {
    static constexpr int BMODE = 1;
    pg8::bf16_t* QP;
    __device__ __forceinline__ void operator()(const pg8::f32x4 (&acc)[2][2][4][2], const pg8::Unit& u, int wr, int wc, int fr, int fq) const {
        { const int l_ = lane_now(); fr = l_ & 15; fq = l_ >> 4; }
        const int J = u.pm, h = u.pn, nv = J < 64 ? 256 : 64; const size_t r0 = ret_row0(J);
#pragma unroll
        for (int ai = 0; ai < 2; ++ai)
#pragma unroll
            for (int m = 0; m < 4; ++m) { const int i = ai * 128 + wr * 64 + m * 16 + fr;
                if (i < nv) {
#pragma unroll
                    for (int bj = 0; bj < 2; ++bj) { const int j0 = bj * 128 + wc * 32 + 8 * fq; const pg8::f32x4 v0 = acc[ai][bj][m][0], v1 = acc[ai][bj][m][1]; float x[8] = {v0[0], v0[1], v0[2], v0[3], v1[0], v1[1], v1[2], v1[3]};
#pragma unroll
                        for (int k = 0; k < 8; ++k) x[k] = (j0 + k <= i) ? x[k] : 0.f;
                        v4u w; w.x = pk2(x[0], x[1]); w.y = pk2(x[2], x[3]); w.z = pk2(x[4], x[5]); w.w = pk2(x[6], x[7]);
                        *(v4u*)(QP + (r0 + i) * 4096 + h * 512 + j0) = w; } } }
    }
};
struct RetOOrder {
    int G, c; const char* QP; const char* VS;
    __device__ __forceinline__ bool next(int i, pg8::Unit& u) const { const int L = i * G + c; if (L >= RBLK * 16) return false; const int J = L >> 4, r = L & 15, h = r >> 1, half = r & 1; const size_t r0 = ret_row0(J);
        u.pm = J; u.pn = r; u.a = QP + (r0 * 4096 + h * 512) * 2; u.b = VS + (((size_t)(J * 8 + h) * 512 + half * 256) * 512) * 2; return true; }
    __device__ __forceinline__ void a_ready(const pg8::Unit&) const {}
    __device__ __forceinline__ void done(const pg8::Unit&) const {}
};
struct EpiRetO {
    static constexpr int BMODE = 1;
    pg8::bf16_t* O;
    __device__ __forceinline__ void operator()(const pg8::f32x4 (&acc)[2][2][4][2], const pg8::Unit& u, int wr, int wc, int fr, int fq) const {
        { const int l_ = lane_now(); fr = l_ & 15; fq = l_ >> 4; }
        const int J = u.pm, h = u.pn >> 1, half = u.pn & 1, nv = J < 64 ? 256 : 64; const size_t r0 = ret_row0(J); const float lg = ret_lg2(h);
#pragma unroll
        for (int ai = 0; ai < 2; ++ai)
#pragma unroll
            for (int m = 0; m < 4; ++m) { const int i = ai * 128 + wr * 64 + m * 16 + fr;
                if (i < nv) { const float f = exp2f((float)(i + 1) * lg);
#pragma unroll
                    for (int bj = 0; bj < 2; ++bj) { const int j0 = bj * 128 + wc * 32 + 8 * fq; const pg8::f32x4 v0 = acc[ai][bj][m][0] * f, v1 = acc[ai][bj][m][1] * f;
                        v4u w; w.x = pk2(v0[0], v0[1]); w.y = pk2(v0[2], v0[3]); w.z = pk2(v1[0], v1[1]); w.w = pk2(v1[2], v1[3]);
                        *(v4u*)(O + (r0 + i) * 4096 + h * 512 + half * 256 + j0) = w; } } }
    }
};
struct RetKVOrder {
    int G, c; const char* VS; const char* KT;
    __device__ __forceinline__ bool next(int i, pg8::Unit& u) const { const int L = i * G + c; if (L >= RBLK * 16) return false; const int J = L >> 4, r = L & 15, h = r >> 1, half = r & 1;
        u.pm = J; u.pn = r; u.a = VS + (((size_t)(J * 8 + h) * 512 + half * 256) * 512) * 2; u.b = KT + ((size_t)(J * 8 + h) * 256 * 256) * 2; return true; }
    __device__ __forceinline__ void a_ready(const pg8::Unit&) const {}
    __device__ __forceinline__ void done(const pg8::Unit&) const {}
};
struct EpiRetKV {
    static constexpr int BMODE = 1;
    pg8::bf16_t* VS; pg8::bf16_t* KVX;
    __device__ __forceinline__ void operator()(const pg8::f32x4 (&acc)[2][2][4][2], const pg8::Unit& u, int wr, int wc, int fr, int fq) const {
        { const int l_ = lane_now(); fr = l_ & 15; fq = l_ >> 4; }
        const int J = u.pm, h = u.pn >> 1, half = u.pn & 1;
        pg8::bf16_t* base; int pitch;
        if (J < 63) { base = VS + ((size_t)((J + 1) * 8 + h) * 512 + half * 256) * 512 + 256; pitch = 512; }
        else { base = KVX + ((size_t)((J - 63) * 8 + h) * 512 + half * 256) * 256; pitch = 256; }
#pragma unroll
        for (int ai = 0; ai < 2; ++ai)
#pragma unroll
            for (int m = 0; m < 4; ++m) { pg8::bf16_t* rowp = base + (size_t)(ai * 128 + wr * 64 + m * 16 + fr) * pitch + wc * 32 + 8 * fq;
#pragma unroll
                for (int bj = 0; bj < 2; ++bj) { const pg8::f32x4 v0 = acc[ai][bj][m][0], v1 = acc[ai][bj][m][1];
                    v4u w; w.x = pk2(v0[0], v0[1]); w.y = pk2(v0[2], v0[3]); w.z = pk2(v1[0], v1[1]); w.w = pk2(v1[2], v1[3]);
                    *(v4u*)(rowp + bj * 128) = w; } }
    }
};
__device__ __forceinline__ void ret_scan(Frame& F, bf16* VS, const bf16* KVX, const float* state_in, float* osp, float* oss) {
    const int gt = F.bid * NTHR + F.tid;
    for (int c = gt; c < 8 * 512 * 32; c += F.G * NTHR) {
        const int h = c >> 14, dv = (c >> 5) & 511, dk0 = (c & 31) * 8; const float lg = ret_lg2(h), g256 = exp2f(256.f * lg), g64 = exp2f(64.f * lg);
        float S[8];
#pragma unroll
        for (int k = 0; k < 8; ++k) S[k] = 0.f;
        bf16* slot = VS + ((size_t)h * 512 + dv) * 512 + 256 + dk0;
        *(v4u*)slot = (v4u){0u, 0u, 0u, 0u};
        v4u nx = *(const v4u*)(slot + (size_t)8 * 512 * 512);
        for (int J = 1; J < 64; ++J) {
            const v4u kv = nx; bf16* sj = slot + (size_t)J * 8 * 512 * 512;
            if (J < 63) nx = *(const v4u*)(sj + (size_t)8 * 512 * 512);
            const float x[8] = {bflo(kv.x), bfhi(kv.x), bflo(kv.y), bfhi(kv.y), bflo(kv.z), bfhi(kv.z), bflo(kv.w), bfhi(kv.w)};
#pragma unroll
            for (int k = 0; k < 8; ++k) S[k] = (S[k] + x[k]) * g256;
            v4u w; w.x = pk2(S[0], S[1]); w.y = pk2(S[2], S[3]); w.z = pk2(S[4], S[5]); w.w = pk2(S[6], S[7]);
            *(v4u*)sj = w;
        }
        { const v4u kv = *(const v4u*)(KVX + ((size_t)h * 512 + dv) * 256 + dk0);
          const float x[8] = {bflo(kv.x), bfhi(kv.x), bflo(kv.y), bfhi(kv.y), bflo(kv.z), bfhi(kv.z), bflo(kv.w), bfhi(kv.w)};
#pragma unroll
          for (int k = 0; k < 8; ++k) osp[((size_t)h * 256 + dk0 + k) * 512 + dv] = (S[k] + x[k]) * g256; }
    }
    for (int c = gt; c < NB * 8 * 512 * 32; c += F.G * NTHR) {
        const int dv = c & 511, dk0 = ((c >> 9) & 31) * 8, h = (c >> 14) & 7, b = c >> 17; const float g64 = exp2f(64.f * ret_lg2(h));
        const float* si = state_in + (((size_t)b * 8 + h) * 256 + dk0) * 512 + dv; float* so = oss + (((size_t)b * 8 + h) * 256 + dk0) * 512 + dv;
        const v4u kv = *(const v4u*)(KVX + ((size_t)((1 + b) * 8 + h) * 512 + dv) * 256 + dk0);
        const float x[8] = {bflo(kv.x), bfhi(kv.x), bflo(kv.y), bfhi(kv.y), bflo(kv.z), bfhi(kv.z), bflo(kv.w), bfhi(kv.w)}; float s0[8];
#pragma unroll
        for (int k = 0; k < 8; ++k) s0[k] = si[(size_t)k * 512];
        v4u w; w.x = pk2(s0[0], s0[1]); w.y = pk2(s0[2], s0[3]); w.z = pk2(s0[4], s0[5]); w.w = pk2(s0[6], s0[7]);
        *(v4u*)(VS + ((size_t)((64 + b) * 8 + h) * 512 + dv) * 512 + 256 + dk0) = w;
#pragma unroll
        for (int k = 0; k < 8; ++k) so[(size_t)k * 512] = (s0[k] + x[k]) * g64;
    }
}
__device__ __forceinline__ void ret_zero_pad(Frame& F, bf16* VS, bf16* KT) {
    const size_t gt = (size_t)F.bid * NTHR + F.tid, NG = (size_t)F.G * NTHR, n = (size_t)NB * 8 * 512 * 24, n2 = (size_t)NB * 8 * 256 * 24;
    for (size_t i = gt; i < n; i += NG) { const size_t rowi = i / 24, c = i % 24; *(v4u*)(VS + ((size_t)64 * 8 * 512 + rowi) * 512 + 64 + c * 8) = (v4u){0u, 0u, 0u, 0u}; }
    for (size_t i = gt; i < n2; i += NG) { const size_t rowi = i / 24, c = i % 24; *(v4u*)(KT + ((size_t)64 * 8 * 256 + rowi) * 256 + 64 + c * 8) = (v4u){0u, 0u, 0u, 0u}; }
}
__device__ __forceinline__ void ret_table(Frame& F, float* tab) {
    const size_t gt = (size_t)F.bid * NTHR + F.tid, NG = (size_t)F.G * NTHR;
    for (size_t e = gt; e < (size_t)MP * 128; e += NG) { float c, s; rope_cs((int)(e >> 7), (int)(e & 127), 128, c, s); tab[2 * e] = c; tab[2 * e + 1] = s; }
}
__device__ __forceinline__ void r_out(Frame& F, bf16* O, const bf16* RG) {
    const int gw = F.bid * NWAVES + F.wave, NGW = F.G * NWAVES, lane = F.lane;
    for (int it = gw; it < MT * 8; it += NGW) {
        const int row = it >> 3, h = it & 7; const size_t off = (size_t)row * 4096 + h * 512 + lane * 8;
        const v4u o4 = *(const v4u*)(O + off), g4 = *(const v4u*)(RG + off);
        float o[8] = {bflo(o4.x), bfhi(o4.x), bflo(o4.y), bfhi(o4.y), bflo(o4.z), bfhi(o4.z), bflo(o4.w), bfhi(o4.w)};
        const float g[8] = {bflo(g4.x), bfhi(g4.x), bflo(g4.y), bfhi(g4.y), bflo(g4.z), bfhi(g4.z), bflo(g4.w), bfhi(g4.w)};
        float ss = 0.f;
#pragma unroll
        for (int k = 0; k < 8; ++k) ss += o[k] * o[k];
        const float rstd = 1.f / sqrtf(wave_sum(ss) * (1.f / 512.f) + EPS);
#pragma unroll
        for (int k = 0; k < 8; ++k) o[k] = o[k] * rstd * silu_f(g[k]);
        v4u w; w.x = pk2(o[0], o[1]); w.y = pk2(o[2], o[3]); w.z = pk2(o[4], o[5]); w.w = pk2(o[6], o[7]);
        *(v4u*)(O + off) = w;
    }
}
struct EpiCIn {
    static constexpr int BMODE = 0;
    pg8::bf16_t* GU; pg8::bf16_t* GVT; pg8::bf16_t* SG; pg8::bf16_t* GVS; float* SSQ; const float* ssq;
    __device__ __forceinline__ void operator()(const pg8::f32x4 (&acc)[2][2][4][2], const pg8::Unit& u, int wr, int wc, int fr, int fq) const {
        { const int l_ = lane_now(); fr = l_ & 15; fq = l_ >> 4; }
        const int pn = u.pn, pm = u.pm, typ = pn >> 4, pt = pn & 15; float rs[2][4]; row_rstd(ssq, pm, wr, fr, fq, rs);
#pragma unroll
        for (int ai = 0; ai < 2; ++ai)
#pragma unroll
            for (int m = 0; m < 4; ++m) {
                const int i = ai * 128 + wr * 64 + m * 16 + fr; const size_t row = (size_t)pm * 256 + i; float ss = 0.f;
#pragma unroll
                for (int bj = 0; bj < 2; ++bj)
#pragma unroll
                    for (int n = 0; n < 2; ++n) { const int c = pt * 256 + bj * 128 + wc * 32 + n * 16 + 4 * fq; const pg8::f32x4 x = acc[ai][bj][m][n] * rs[ai][m]; float y[4];
                        if (typ == 2) {
#pragma unroll
                            for (int e = 0; e < 4; ++e) y[e] = silu_f(x[e]);
                            v2u w; w.x = pk2(y[0], y[1]); w.y = pk2(y[2], y[3]); *(v2u*)(SG + row * 4096 + c) = w;
                        } else {
#pragma unroll
                            for (int e = 0; e < 4; ++e) y[e] = gelu_tanh_f(x[e]);
                            v2u w; w.x = pk2(y[0], y[1]); w.y = pk2(y[2], y[3]);
                            if (typ == 0) *(v2u*)(GU + row * 4096 + c) = w;
                            else { ss += (y[0] * y[0] + y[1] * y[1]) + (y[2] * y[2] + y[3] * y[3]);
                                pg8::bf16_t* t = GVT + ((size_t)pm * 4096 + c) * 256 + i;
                                t[0] = (pg8::bf16_t)(w.x & 0xffffu); t[256] = (pg8::bf16_t)(w.x >> 16); t[512] = (pg8::bf16_t)(w.y & 0xffffu); t[768] = (pg8::bf16_t)(w.y >> 16);
                                if (pm >= 64) *(v2u*)(GVS + (row - MP) * 4096 + c) = w; } } }
                if (typ == 1) { ss += __shfl_xor(ss, 16); ss += __shfl_xor(ss, 32); if (fq == 0) SSQ[row * 64 + pt * 4 + wc] = ss; }
                if (m & 1) asm volatile("" ::: "memory");
            }
    }
};
__device__ __forceinline__ void c_prep(Frame& F, const float* SSQ, const float* wsin, const float* vgain, const bf16* GVS, bf16* Wm, float* ovm) {
    LAS float* rs = (LAS float*)(F.lds + RING_OFF);
    const int tid = F.tid;
    for (int it = F.bid; it < 66 * 8; it += F.G) {
        const int J = it >> 3, g = it & 7;
        __syncthreads();
        if (tid < 256) { const float* p = SSQ + ((size_t)J * 256 + tid) * 64; float s = 0.f;
#pragma unroll
            for (int k = 0; k < 16; ++k) { const f32x4 x = *(const f32x4*)(p + 4 * k); s += (x.x + x.y) + (x.z + x.w); }
            rs[tid] = 1.f / sqrtf(s * (1.f / 4096.f) + EPS); }
        __syncthreads();
        bf16* wm = Wm + (size_t)(J * 8 + g) * 65536; const int sh = J < 64 ? 7 : 6, cm = (1 << sh) - 1;
        for (int e8 = tid; e8 < 8192; e8 += NTHR) { const int i = e8 >> 5, j0 = (e8 & 31) * 8, il = i & cm, jl0 = j0 & cm; float y[8];
            if ((i >> sh) == (j0 >> sh) && jl0 <= il) { const float* wr_ = wsin + ((size_t)g * 128 + il) * 128 + jl0; const f32x4 a = *(const f32x4*)wr_, b = *(const f32x4*)(wr_ + 4);
                const float wv[8] = {a.x, a.y, a.z, a.w, b.x, b.y, b.z, b.w};
#pragma unroll
                for (int k = 0; k < 8; ++k) y[k] = (jl0 + k <= il) ? wv[k] * rs[j0 + k] : 0.f;
            } else {
#pragma unroll
                for (int k = 0; k < 8; ++k) y[k] = 0.f; }
            v4u w; w.x = pk2(y[0], y[1]); w.y = pk2(y[2], y[3]); w.z = pk2(y[4], y[5]); w.w = pk2(y[6], y[7]);
            *(v4u*)(wm + i * 256 + j0) = w; }
    }
    const int gw = F.bid * NWAVES + F.wave, NGW = F.G * NWAVES, lane = F.lane;
    for (int r = gw; r < MS; r += NGW) {
        const float rstd = 1.f / sqrtf(wave_sum(SSQ[((size_t)MP + r) * 64 + lane]) * (1.f / 4096.f) + EPS);
#pragma unroll
        for (int k = 0; k < 8; ++k) { const int col = k * 512 + lane * 8; const v4u v4 = *(const v4u*)(GVS + (size_t)r * 4096 + col);
            const f32x4 ga = *(const f32x4*)(vgain + col), gb = *(const f32x4*)(vgain + col + 4);
            float* o = ovm + (size_t)r * 4096 + col;
            *(f32x4*)o = (f32x4){bflo(v4.x) * rstd * ga.x, bfhi(v4.x) * rstd * ga.y, bflo(v4.y) * rstd * ga.z, bfhi(v4.y) * rstd * ga.w};
            *(f32x4*)(o + 4) = (f32x4){bflo(v4.z) * rstd * gb.x, bfhi(v4.z) * rstd * gb.y, bflo(v4.w) * rstd * gb.z, bfhi(v4.w) * rstd * gb.w}; }
    }
}
struct CMixOrder {
    int G, c; const char* Wm; const char* GVT;
    __device__ __forceinline__ bool next(int i, pg8::Unit& u) const { const int L = i * G + c; if (L >= 66 * 16) return false; const int J = L >> 4, nt = L & 15;
        u.pm = J; u.pn = nt; u.a = Wm + ((size_t)(J * 8 + (nt >> 1)) * 65536) * 2; u.b = GVT + (((size_t)J * 4096 + nt * 256) * 256) * 2; return true; }
    __device__ __forceinline__ void a_ready(const pg8::Unit&) const {}
    __device__ __forceinline__ void done(const pg8::Unit&) const {}
};
struct EpiCMix {
    static constexpr int BMODE = 1;
    pg8::bf16_t* GU; const pg8::bf16_t* SG; const float* vgain; const float* bs;
    __device__ __forceinline__ void operator()(const pg8::f32x4 (&acc)[2][2][4][2], const pg8::Unit& u, int wr, int wc, int fr, int fq) const {
        { const int l_ = lane_now(); fr = l_ & 15; fq = l_ >> 4; }
        const int J = u.pm, nt = u.pn, g = nt >> 1, cm = J < 64 ? 127 : 63;
#pragma unroll
        for (int bj = 0; bj < 2; ++bj) { const int c0 = nt * 256 + bj * 128 + wc * 32 + 8 * fq; const f32x4 ga = *(const f32x4*)(vgain + c0), gb = *(const f32x4*)(vgain + c0 + 4);
            const float gn[8] = {ga.x, ga.y, ga.z, ga.w, gb.x, gb.y, gb.z, gb.w};
#pragma unroll
            for (int ai = 0; ai < 2; ++ai)
#pragma unroll
                for (int m = 0; m < 4; ++m) { const int i = ai * 128 + wr * 64 + m * 16 + fr; const size_t off = ((size_t)J * 256 + i) * 4096 + c0; const float b = bs[g * 128 + (i & cm)];
                    const v4u u4 = *(const v4u*)(GU + off), s4 = *(const v4u*)(SG + off); const pg8::f32x4 v0 = acc[ai][bj][m][0], v1 = acc[ai][bj][m][1];
                    const float mx[8] = {v0[0], v0[1], v0[2], v0[3], v1[0], v1[1], v1[2], v1[3]};
                    const float uu[8] = {bflo(u4.x), bfhi(u4.x), bflo(u4.y), bfhi(u4.y), bflo(u4.z), bfhi(u4.z), bflo(u4.w), bfhi(u4.w)};
                    const float sg[8] = {bflo(s4.x), bfhi(s4.x), bflo(s4.y), bfhi(s4.y), bflo(s4.z), bfhi(s4.z), bflo(s4.w), bfhi(s4.w)}; float y[8];
#pragma unroll
                    for (int k = 0; k < 8; ++k) y[k] = uu[k] * (mx[k] * gn[k] + b) * sg[k];
                    v4u w; w.x = pk2(y[0], y[1]); w.y = pk2(y[2], y[3]); w.z = pk2(y[4], y[5]); w.w = pk2(y[6], y[7]);
                    *(v4u*)(GU + off) = w; } }
    }
};
__device__ __forceinline__ float diff_lambda(const float* q1, const float* k1, const float* q2, const float* k2, float lam_init) {
    float a = 0.f, b = 0.f;
    for (int i = 0; i < 64; ++i) { a += q1[i] * k1[i]; b += q2[i] * k2[i]; }
    return expf(a) - expf(b) + lam_init;
}

constexpr int N_PHASES = 21;
__global__ void __launch_bounds__(NTHR, 2) mega(Args args) {
    extern __shared__ __attribute__((aligned(16))) unsigned char lds[];
    Frame F;
    F.lds = (LAS unsigned char*)lds; F.tid = threadIdx.x; F.lane = F.tid & 63; F.wave = __builtin_amdgcn_readfirstlane(F.tid >> 6); F.G = gridDim.x; F.bid = blockIdx.x;
    F.in = args.in; F.out = args.out; F.ws = args.ws;
    unsigned char* ws = args.ws; float* out = args.out;
    bf16* W_AIN[2] = {(bf16*)(ws + WS_WAIN0), (bf16*)(ws + WS_WAIN1)}; bf16* W_AOUT[2] = {(bf16*)(ws + WS_WAOUT0), (bf16*)(ws + WS_WAOUT1)};
    bf16* W_RIN = (bf16*)(ws + WS_WRIN); bf16* W_ROUT = (bf16*)(ws + WS_WROUT); bf16* W_CIN = (bf16*)(ws + WS_WCIN); bf16* W_COUT = (bf16*)(ws + WS_WCOUT);
    bf16* XN0 = (bf16*)(ws + WS_XN0); bf16* HB = (bf16*)(ws + WS_HB); float* SSQ2 = (float*)(ws + WS_SSQ2);
    bf16* Qs = (bf16*)(ws + WS_QS); bf16* KP = (bf16*)(ws + WS_KP); bf16* VP = (bf16*)(ws + WS_VP); bf16* KC = (bf16*)(ws + WS_KC); bf16* VC = (bf16*)(ws + WS_VC); bf16* AO_A = (bf16*)(ws + WS_AOA);
    bf16* KT = (bf16*)(ws + WS_KT); bf16* RG = (bf16*)(ws + WS_RG); bf16* QP = (bf16*)(ws + WS_QP); bf16* KN = (bf16*)(ws + WS_KN); bf16* VS = (bf16*)(ws + WS_VS); bf16* ORET = (bf16*)(ws + WS_ORET);
    bf16* GU = (bf16*)(ws + WS_GU); bf16* SG = (bf16*)(ws + WS_SG); bf16* GVT = (bf16*)(ws + WS_GVT); bf16* WM = (bf16*)(ws + WS_WM); float* SSQ = (float*)(ws + WS_SSQ); bf16* GVS = (bf16*)(ws + WS_GVS); float* TABR = (float*)(ws + WS_TABR); bf16* KVX = (bf16*)(ws + WS_KVX); float* TABA = (float*)(ws + WS_TABA); bf16* GA = (bf16*)(ws + WS_GA);
    const int lo = args.ph_lo, hi = args.ph_hi;
    volatile LAS unsigned* MISC = (volatile LAS unsigned*)(F.lds + MISC_OFF);
    for (int u = F.tid; u < (LDS_BYTES - MISC_OFF) / 4; u += NTHR) ((LAS unsigned*)(F.lds + MISC_OFF))[u] = 0u;
    __syncthreads();
    XcdBarrier bar = xcd_barrier_post((unsigned*)(ws + WS_CTL) + 4096, MISC + 8);
#define IN(k) (lo <= (k) && (k) < hi)
#define PH_ENTER() do { int t_ = F.wave * 64 + lane_now(); F.tid = t_; F.lane = t_ & 63; } while (0)
    volatile LAS int* DRW = (volatile LAS int*)(F.lds + MISC_OFF + 64);
    unsigned* DCTR = (unsigned*)(ws + WS_CTL) + 8192;
#define DRAIN(ph, total, BODY) do { PH_ENTER(); for (;;) { __syncthreads(); if (F.tid == 0) DRW[0] = (int)atomicAdd(DCTR + 64 * (ph), 1u); __syncthreads(); const int c_ = DRW[0]; if (c_ >= (total)) break; BODY } } while (0)
#define SEAM(k) do { if (IN(k) && IN((k) + 1)) xcd_barrier(bar, F.wave == 0 && lane_now() == 0); } while (0)

#define GEMM_STORE(Aptr, Wptr, NN, KK, Optr) do { pg8::GemmP g{KK, KK, (KK) / 64}; pg8::StaticOrder S; S.init(MT / 256, (NN) / 256, F.G, F.bid, Aptr, Wptr, KK, KK); pg8::EpiStoreBf16 E{(pg8::bf16_t*)(Optr), NN}; \
        pg8::gemm_phase<pg8::EpiStoreBf16, pg8::StaticOrder>(F.lds + RING_OFF, g, S, E, F.tid); } while (0)
#define GEMM_RESIDB(MODE_, Aptr, Wptr, KK) do { pg8::GemmP g{KK, KK, (KK) / 64}; pg8::StaticOrder S; S.init(MT / 256, DM / 256, F.G, F.bid, Aptr, Wptr, KK, KK); \
        pg8::EpiResidB<MODE_> E{args.in[I_XP], args.in[I_XS], (pg8::bf16_t*)HB, out, SSQ2}; pg8::gemm_phase<pg8::EpiResidB<MODE_>, pg8::StaticOrder>(F.lds + RING_OFF, g, S, E, F.tid); } while (0)

    PH_ENTER(); if (IN(0)) {
        transpose_weight(F, args.in[I_AWIN], 2048, 8192, W_AIN[0]); attn_table(F, TABA);
        norm_rows(F, args.in[I_XP], args.in[I_XS], args.in[I_NW], XN0);
    }
    SEAM(0);
#define GEMM_AIN(Aptr, Wptr, J_, SSQP) do { pg8::GemmP g{2048, 2048, 32}; pg8::StaticOrder S; S.init(MT / 256, 32, F.G, F.bid, Aptr, Wptr, 2048, 2048); \
        EpiAIn E{Qs, KP, VP, KC, VC, GA, out + O_KP + (size_t)(J_) * MP * DM, out + O_VP + (size_t)(J_) * MP * DM, out + O_KS + (size_t)(J_) * MS * DM, out + O_VS + (size_t)(J_) * MS * DM, TABA, args.in[I_AQG] + 64 * (J_), args.in[I_AKG] + 64 * (J_), SSQP}; \
        pg8::gemm_phase<EpiAIn, pg8::StaticOrder>(F.lds + RING_OFF, g, S, E, F.tid); } while (0)
    PH_ENTER(); if (IN(1)) { GEMM_AIN(XN0, W_AIN[0], 0, (const float*)nullptr);
        const int n0 = CC_CHUNKS, n1 = n0 + tw_chunks(2048, 2048), n2 = n1 + TR_CHUNKS;
        DRAIN(1, n2, if (c_ < n0) cc_run(F, args.in[I_CK], args.in[I_CV], KC, VC, c_); else if (c_ < n1) tw_run(F, args.in[I_AWOUT], 2048, 2048, W_AOUT[0], c_ - n0); else tr_run(F, TABR, c_ - n1);); }
    SEAM(1);
    PH_ENTER(); if (IN(3)) { const float li = 0.8f - 0.6f * expf(-0.3f * 0.f); const float lam = diff_lambda(args.in[I_LQ1], args.in[I_LK1], args.in[I_LQ2], args.in[I_LK2], li);
        attn_fast(F, Qs, KP, VP, KC, VC, GA, AO_A, lam, 1.f - li, args.in[I_ASG]); }
    SEAM(3);
    PH_ENTER(); if (IN(4)) { GEMM_RESIDB(0, AO_A, W_AOUT[0], 2048);
        const int n0 = tw_chunks(2048, 12288), n1 = n0 + tw_chunks(4096, 2048);
        DRAIN(4, n1, if (c_ < n0) tw_run(F, args.in[I_RWIN], 2048, 12288, W_RIN, c_, args.in[I_NW] + DM); else tw_run(F, args.in[I_RWOUT], 4096, 2048, W_ROUT, c_ - n0);); }
    if (IN(4) && IN(6)) xcd_barrier(bar, F.wave == 0 && lane_now() == 0);
    PH_ENTER(); if (IN(6)) { ret_zero_pad(F, VS, KT);
        PH_ENTER(); pg8::GemmP g{2048, 2048, 32}; pg8::StaticOrder S; S.init(MT / 256, 48, F.G, F.bid, HB, W_RIN, 2048, 2048); EpiRet E{QP, KN, KT, VS, RG, TABR, SSQ2};
        pg8::gemm_phase<EpiRet, pg8::StaticOrder>(F.lds + RING_OFF, g, S, E, F.tid); }
    SEAM(6);
    PH_ENTER(); if (IN(7)) { { pg8::GemmP g{4096, 2048, 4}; RetQKOrder S{F.G, F.bid, (const char*)QP, (const char*)KN}; EpiRetQK E{QP}; pg8::gemm_phase<EpiRetQK, RetQKOrder>(F.lds + RING_OFF, g, S, E, F.tid); }
        PH_ENTER(); { pg8::GemmP g{512, 256, 4}; RetKVOrder S{F.G, F.bid, (const char*)VS, (const char*)KT}; EpiRetKV E{VS, KVX}; pg8::gemm_phase<EpiRetKV, RetKVOrder>(F.lds + RING_OFF, g, S, E, F.tid); }
        xcd_barrier(bar, F.wave == 0 && lane_now() == 0);
        PH_ENTER(); ret_scan(F, VS, KVX, args.in[I_SR], out + O_SP, out + O_SS); }
    SEAM(7);
    PH_ENTER(); if (IN(8)) { pg8::GemmP g{4096, 512, 8}; RetOOrder S{F.G, F.bid, (const char*)QP, (const char*)VS}; EpiRetO E{ORET}; pg8::gemm_phase<EpiRetO, RetOOrder>(F.lds + RING_OFF, g, S, E, F.tid); }
    SEAM(8);
    PH_ENTER(); if (IN(9)) r_out(F, ORET, RG);
    SEAM(9);
    PH_ENTER(); if (IN(10)) { GEMM_RESIDB(1, ORET, W_ROUT, 4096);
        const int n0 = tw_chunks(2048, 12288), n1 = n0 + tw_chunks(4096, 2048), n2 = n1 + tw_chunks(2048, 8192), n3 = n2 + tw_chunks(2048, 2048);
        DRAIN(10, n3, if (c_ < n0) tw_run(F, args.in[I_CWIN], 2048, 12288, W_CIN, c_, args.in[I_NW] + 2 * DM); else if (c_ < n1) tw_run(F, args.in[I_CWOUT], 4096, 2048, W_COUT, c_ - n0);
                      else if (c_ < n2) tw_run(F, args.in[I_AWIN] + (size_t)2048 * 8192, 2048, 8192, W_AIN[1], c_ - n1, args.in[I_NW] + 3 * DM); else tw_run(F, args.in[I_AWOUT] + (size_t)2048 * 2048, 2048, 2048, W_AOUT[1], c_ - n2);); }
    if (IN(10) && IN(12)) xcd_barrier(bar, F.wave == 0 && lane_now() == 0);
    PH_ENTER(); if (IN(12)) { pg8::GemmP g{2048, 2048, 32}; pg8::StaticOrder S; S.init(MT / 256, 48, F.G, F.bid, HB, W_CIN, 2048, 2048); EpiCIn E{GU, GVT, SG, GVS, SSQ, SSQ2};
        pg8::gemm_phase<EpiCIn, pg8::StaticOrder>(F.lds + RING_OFF, g, S, E, F.tid); }
    SEAM(12);
    PH_ENTER(); if (IN(13)) c_prep(F, SSQ, args.in[I_CWS], args.in[I_CVG], GVS, WM, out + O_VM);
    SEAM(13);
    PH_ENTER(); if (IN(14)) { pg8::GemmP g{256, 256, 4}; CMixOrder S{F.G, F.bid, (const char*)WM, (const char*)GVT}; EpiCMix E{GU, SG, args.in[I_CVG], args.in[I_CBS]}; pg8::gemm_phase<EpiCMix, CMixOrder>(F.lds + RING_OFF, g, S, E, F.tid); }
    SEAM(14);
    PH_ENTER(); if (IN(15)) { GEMM_RESIDB(1, GU, W_COUT, 4096);
        DRAIN(15, CC_CHUNKS, cc_run(F, args.in[I_CK] + (size_t)NB * PAST * DM, args.in[I_CV] + (size_t)NB * PAST * DM, KC, VC, c_);); }
    if (IN(15) && IN(17)) xcd_barrier(bar, F.wave == 0 && lane_now() == 0);
    PH_ENTER(); if (IN(17)) GEMM_AIN(HB, W_AIN[1], 1, (const float*)SSQ2);
    SEAM(17);
    PH_ENTER(); if (IN(19)) { const float li = 0.8f - 0.6f * expf(-0.3f * 3.f); const float lam = diff_lambda(args.in[I_LQ1] + 64, args.in[I_LK1] + 64, args.in[I_LQ2] + 64, args.in[I_LK2] + 64, li);
        attn_fast(F, Qs, KP, VP, KC, VC, GA, AO_A, lam, 1.f - li, args.in[I_ASG] + 128); }
    SEAM(19);
    PH_ENTER(); if (IN(20)) GEMM_RESIDB(2, AO_A, W_AOUT[1], 2048);
#undef IN
#undef SEAM
}

extern "C" void kernel_launch(void* const* d_in, const int* in_sizes, int n_in, void* d_out, int out_size, void* d_ws, size_t ws_size, hipStream_t stream) {
    static int grid = 0;
    if (grid == 0) {
        if (n_in != N_IN || (size_t)out_size != O_END || ws_size < WS_END) { fprintf(stderr, "kernel_launch: unexpected shapes: n_in %d out %d ws %zu (need %zu)\n", n_in, out_size, ws_size, (size_t)WS_END); grid = -1; return; }
        int dev = 0, cus = 0;
        if (hipGetDevice(&dev) != hipSuccess || hipDeviceGetAttribute(&cus, hipDeviceAttributeMultiprocessorCount, dev) != hipSuccess) { grid = -1; return; }
        if (hipFuncSetAttribute((const void*)mega, hipFuncAttributeMaxDynamicSharedMemorySize, LDS_BYTES) != hipSuccess) { fprintf(stderr, "kernel_launch: hipFuncSetAttribute failed\n"); grid = -1; return; }
        (void)hipGetLastError();
        grid = cus;
    }
    if (grid < 0) return;
    Args a{};
    for (int i = 0; i < N_IN; ++i) a.in[i] = (const float*)d_in[i];
    a.out = (float*)d_out; a.ws = (unsigned char*)d_ws;
    (void)hipMemsetAsync((char*)d_ws + WS_CTL, 0, CTL_ZERO_BYTES, stream);
    a.ph_lo = 0; a.ph_hi = N_PHASES;
    hipLaunchKernelGGL(mega, dim3(grid), dim3(NTHR), LDS_BYTES, stream, a);
}
```

```cpp
#include <hip/hip_runtime.h>
#include <cstdio>
#include <cstdint>

__device__ __forceinline__ int lane_now() { int l; asm volatile("v_mbcnt_lo_u32_b32 %0, -1, 0\n\tv_mbcnt_hi_u32_b32 %0, -1, %0" : "=v"(l)); return l; }
namespace pg8 {
#define PG8_LAS __attribute__((address_space(3)))
typedef unsigned short bf16_t;
typedef short bf16x8 __attribute__((ext_vector_type(8)));
typedef float f32x4 __attribute__((ext_vector_type(4)));
typedef unsigned u32x4 __attribute__((ext_vector_type(4)));
constexpr int BM = 256, BK = 64, HALF = 128, HTB = HALF * BK * 2, STAGE_BYTES = 8 * HTB, NXCD = 8, WGM = 4;

__host__ __device__ __forceinline__ int lds_byte(int r, int c) { const int st = (r >> 4) * 2 + (c >> 5), rr = r & 15, cc = c & 31, ob = rr * 64 + cc * 2; return st * 1024 + (ob ^ (((ob >> 9) & 1) << 5)); }
__host__ __device__ __forceinline__ void stage_rc(int b, int& R, int& C) { const int st = b / 1024, sb = b % 1024, swz = sb ^ (((sb >> 9) & 1) << 5); R = (st >> 1) * 16 + swz / 64; C = (st & 1) * 32 + (swz % 64) / 2; }
__host__ __device__ __forceinline__ int perm32(int rho) { const int n = rho >> 4, i = rho & 15; return 8 * (i >> 2) + 4 * n + (i & 3); }

struct Unit { int pm, pn; const char* a; const char* b; };
struct GemmP { int lda, ldb, nt; };

struct StaticOrder {
    int nM, nN, nwg, G, c; const char* A; const char* B; size_t ta, tb;
    __host__ __device__ void init(int nM_, int nN_, int G_, int c_, const void* A_, const void* B_, int lda, int ldb) { nM = nM_; nN = nN_; nwg = nM * nN; G = G_; c = c_; A = (const char*)A_; B = (const char*)B_; ta = (size_t)BM * lda * 2; tb = (size_t)BM * ldb * 2; }
    __host__ __device__ bool next(int i, Unit& u) const {
        const long L = (long)i * G + c; if (L >= nwg) return false;
        int wgid = (int)L; { const int q = nwg / NXCD, r = nwg % NXCD, xcd = wgid % NXCD, off = wgid / NXCD; wgid = (xcd < r ? xcd * (q + 1) : r * (q + 1) + (xcd - r) * q) + off; }
        const int nig = WGM * nN, gid = wgid / nig, fm = gid * WGM, gsz = (nM - fm) < WGM ? (nM - fm) : WGM;
        u.pm = fm + ((wgid % nig) % gsz); u.pn = (wgid % nig) / gsz; u.a = A + (size_t)u.pm * ta; u.b = B + (size_t)u.pn * tb; return true;
    }
    __device__ __forceinline__ void a_ready(const Unit&) const {}
    __device__ __forceinline__ void done(const Unit&) const {}
};

__device__ __forceinline__ unsigned cvt_pk_bf16(float lo, float hi) { unsigned r; asm volatile("v_cvt_pk_bf16_f32 %0, %1, %2" : "=v"(r) : "v"(lo), "v"(hi)); return r; }

struct EpiStoreBf16 {
    static constexpr int BMODE = 1;
    bf16_t* O; int ldc;
    __device__ __forceinline__ void operator()(const f32x4 (&acc)[2][2][4][2], const Unit& u, int wr, int wc, int fr, int fq) const {
        const int row0 = u.pm * BM + wr * 64 + fr; const int col0 = u.pn * BM + wc * 32 + 8 * fq;
#pragma unroll
        for (int ai = 0; ai < 2; ++ai)
#pragma unroll
            for (int m = 0; m < 4; ++m) { bf16_t* rowp = O + (size_t)(row0 + ai * HALF + m * 16) * ldc + col0;
#pragma unroll
                for (int bj = 0; bj < 2; ++bj) { const f32x4 v0 = acc[ai][bj][m][0], v1 = acc[ai][bj][m][1];
                    u32x4 w; w.x = cvt_pk_bf16(v0[0], v0[1]); w.y = cvt_pk_bf16(v0[2], v0[3]); w.z = cvt_pk_bf16(v1[0], v1[1]); w.w = cvt_pk_bf16(v1[2], v1[3]);
                    *(u32x4*)(rowp + bj * HALF) = w; } }
    }
};
struct EpiResid {
    static constexpr int BMODE = 0;
    const float* base_p; const float* base_s; float* out; int split;
    __device__ __forceinline__ void operator()(const f32x4 (&acc)[2][2][4][2], const Unit& u, int wr, int wc, int fr, int fq) const {
        { const int l_ = lane_now(); fr = l_ & 15; fq = l_ >> 4; }
        const int col0 = u.pn * BM + wc * 32 + 4 * fq;
#pragma unroll
        for (int ai = 0; ai < 2; ++ai) {
            f32x4 bs[4][2][2];
#pragma unroll
            for (int m = 0; m < 4; ++m) { const int r = u.pm * BM + ai * HALF + wr * 64 + m * 16 + fr; const float* bp = (r < split) ? base_p + (size_t)r * 2048 : base_s + (size_t)(r - split) * 2048;
#pragma unroll
                for (int bj = 0; bj < 2; ++bj)
#pragma unroll
                    for (int n = 0; n < 2; ++n) bs[m][bj][n] = *(const f32x4*)(bp + col0 + bj * HALF + n * 16); }
#pragma unroll
            for (int m = 0; m < 4; ++m) { const int r = u.pm * BM + ai * HALF + wr * 64 + m * 16 + fr; float* op = out + (size_t)r * 2048;
#pragma unroll
                for (int bj = 0; bj < 2; ++bj)
#pragma unroll
                    for (int n = 0; n < 2; ++n) *(f32x4*)(op + col0 + bj * HALF + n * 16) = bs[m][bj][n] + acc[ai][bj][m][n]; }
            asm volatile("" ::: "memory");
        }
    }
};

template <int MODE> struct EpiResidB {
    static constexpr int BMODE = 1;
    const float* base_p; const float* base_s; bf16_t* HB; float* out; float* SSQ2;
    __device__ __forceinline__ void operator()(const f32x4 (&acc)[2][2][4][2], const Unit& u, int wr, int wc, int fr, int fq) const {
        { const int l_ = lane_now(); fr = l_ & 15; fq = l_ >> 4; }
        const int col0 = u.pn * BM + wc * 32 + 8 * fq;
#pragma unroll
        for (int ai = 0; ai < 2; ++ai) {
            f32x4 b0[4][2], b1[4][2]; u32x4 hb[4][2];
#pragma unroll
            for (int m = 0; m < 4; ++m) { const int r = u.pm * BM + ai * HALF + wr * 64 + m * 16 + fr;
#pragma unroll
                for (int bj = 0; bj < 2; ++bj) {
                    if (MODE == 0) { const float* bp = ((r < 16384) ? base_p + (size_t)r * 2048 : base_s + (size_t)(r - 16384) * 2048) + col0 + bj * HALF; b0[m][bj] = *(const f32x4*)bp; b1[m][bj] = *(const f32x4*)(bp + 4); }
                    else hb[m][bj] = *(const u32x4*)(HB + (size_t)r * 2048 + col0 + bj * HALF); } }
#pragma unroll
            for (int m = 0; m < 4; ++m) { const int r = u.pm * BM + ai * HALF + wr * 64 + m * 16 + fr; float ss = 0.f;
#pragma unroll
                for (int bj = 0; bj < 2; ++bj) { f32x4 h0, h1;
                    if (MODE == 0) { h0 = b0[m][bj] + acc[ai][bj][m][0]; h1 = b1[m][bj] + acc[ai][bj][m][1]; }
                    else { const u32x4 w = hb[m][bj];
                        h0 = (f32x4){__builtin_bit_cast(float, w.x << 16), __builtin_bit_cast(float, w.x & 0xffff0000u), __builtin_bit_cast(float, w.y << 16), __builtin_bit_cast(float, w.y & 0xffff0000u)} + acc[ai][bj][m][0];
                        h1 = (f32x4){__builtin_bit_cast(float, w.z << 16), __builtin_bit_cast(float, w.z & 0xffff0000u), __builtin_bit_cast(float, w.w << 16), __builtin_bit_cast(float, w.w & 0xffff0000u)} + acc[ai][bj][m][1]; }
                    if (MODE == 2) { float* op = out + (size_t)r * 2048 + col0 + bj * HALF; *(f32x4*)op = h0; *(f32x4*)(op + 4) = h1; }
                    else { u32x4 w; w.x = cvt_pk_bf16(h0[0], h0[1]); w.y = cvt_pk_bf16(h0[2], h0[3]); w.z = cvt_pk_bf16(h1[0], h1[1]); w.w = cvt_pk_bf16(h1[2], h1[3]);
                        *(u32x4*)(HB + (size_t)r * 2048 + col0 + bj * HALF) = w;
                        ss += (h0[0] * h0[0] + h0[1] * h0[1]) + (h0[2] * h0[2] + h0[3] * h0[3]) + (h1[0] * h1[0] + h1[1] * h1[1]) + (h1[2] * h1[2] + h1[3] * h1[3]); } }
                if (MODE != 2) { ss += __shfl_xor(ss, 16); ss += __shfl_xor(ss, 32); if (fq == 0) SSQ2[(size_t)r * 32 + u.pn * 4 + wc] = ss; } }
            asm volatile("" ::: "memory");
        }
    }
};

template <class Epi, class Sched, bool ALIGN_EPI = true>
__device__ __forceinline__ void gemm_phase(PG8_LAS unsigned char* lds, const GemmP g, const Sched& S, const Epi& E, int tid) {
    asm volatile("" : "+v"(tid));
    const int wid = __builtin_amdgcn_readfirstlane(tid >> 6), lane = tid & 63, wr = wid >> 2, wc = wid & 3, fr = lane & 15, fq = lane >> 4;
    int nt = g.nt; asm volatile("" : "+s"(nt));
    unsigned voffA[2], voffB[2];
#pragma unroll
    for (int i = 0; i < 2; ++i) { int R, C; stage_rc(tid * 16 + i * 8192, R, C); const int Rb = Epi::BMODE == 2 ? (64 * (R >> 5) + perm32(R & 31)) : Epi::BMODE == 1 ? ((R & ~31) + perm32(R & 31)) : R;
        voffA[i] = (unsigned)(R * g.lda + C) * 2u; voffB[i] = (unsigned)(Rb * g.ldb + C) * 2u; }
    const size_t kstep = (size_t)(BK * 2);
    const size_t hstepA = (size_t)HALF * g.lda * 2, hstepB = (size_t)(Epi::BMODE == 2 ? 32 : HALF) * g.ldb * 2;
    const unsigned ldsw = (unsigned)wid * 1024u;
    const int aoff = lds_byte(wr * 64 + fr, fq * 8), boff = lds_byte(wc * 32 + fr, fq * 8);
#define PG8_SA(b, h) (((b) * 2 + (h)) * HTB)
#define PG8_SB(b, h) ((4 + (b) * 2 + (h)) * HTB)
#define PG8_STAGE(bufoff, gbase, voff) do { _Pragma("unroll") for (int _i = 0; _i < 2; ++_i) \
        __builtin_amdgcn_global_load_lds((const unsigned*)((const char*)(gbase) + (voff)[_i]), (PG8_LAS unsigned*)(lds + (bufoff) + ldsw + _i * 8192), 16, 0, 0); } while (0)
#define PG8_LDA(dst, b, h) do { _Pragma("unroll") for (int m = 0; m < 4; ++m) _Pragma("unroll") for (int k = 0; k < 2; ++k) dst[m][k] = *(const PG8_LAS bf16x8*)(lds + PG8_SA(b, h) + aoff + m * 2048 + k * 1024); } while (0)
#define PG8_LDB(dst, b, h) do { _Pragma("unroll") for (int n = 0; n < 2; ++n) _Pragma("unroll") for (int k = 0; k < 2; ++k) dst[n][k] = *(const PG8_LAS bf16x8*)(lds + PG8_SB(b, h) + boff + n * 2048 + k * 1024); } while (0)
#define PG8_MMA(ai, bj, At, Bt) do { __builtin_amdgcn_s_setprio(1); _Pragma("unroll") for (int m = 0; m < 4; ++m) _Pragma("unroll") for (int n = 0; n < 2; ++n) _Pragma("unroll") for (int k = 0; k < 2; ++k) \
        acc[ai][bj][m][n] = __builtin_amdgcn_mfma_f32_16x16x32_bf16(Bt[n][k], At[m][k], acc[ai][bj][m][n], 0, 0, 0); __builtin_amdgcn_s_setprio(0); } while (0)
#define PG8_WAIT_V(n) asm volatile("s_waitcnt vmcnt(" #n ")" ::: "memory")
#define PG8_WAIT_L(n) asm volatile("s_waitcnt lgkmcnt(" #n ")" ::: "memory")
#define PG8_BAR __builtin_amdgcn_s_barrier()
#define PG8_SCHED __builtin_amdgcn_sched_barrier(0)
    Unit cur, nxt; int ui = 0;
    if (!S.next(0, cur)) return;
    f32x4 acc[2][2][4][2];
#pragma unroll
    for (int a = 0; a < 2; ++a)
#pragma unroll
        for (int b = 0; b < 2; ++b)
#pragma unroll
            for (int m = 0; m < 4; ++m)
#pragma unroll
                for (int n = 0; n < 2; ++n) acc[a][b][m][n] = (f32x4){0.f, 0.f, 0.f, 0.f};
    bf16x8 At[4][2], B0[2][2], B1[2][2];
    const char* cA = cur.a; const char* cB = cur.b;
    S.a_ready(cur);
    PG8_STAGE(PG8_SB(0, 0), cB, voffB); PG8_STAGE(PG8_SB(0, 1), cB + hstepB, voffB); PG8_STAGE(PG8_SA(0, 0), cA, voffA); PG8_STAGE(PG8_SA(0, 1), cA + hstepA, voffA);
    if (wr == 1) PG8_BAR;
    PG8_WAIT_V(2); PG8_BAR;
    PG8_STAGE(PG8_SB(1, 0), cB + kstep, voffB); PG8_STAGE(PG8_SA(1, 0), cA + kstep, voffA); PG8_STAGE(PG8_SB(1, 1), cB + hstepB + kstep, voffB);
    PG8_WAIT_V(6); PG8_BAR;
    for (;;) {
        const bool has_next = S.next(ui + 1, nxt);
        const char* nA = has_next ? nxt.a : cA; const char* nB = has_next ? nxt.b : cB;
        for (int t = 0; t < nt; t += 2) {
            const bool last = (t == nt - 2);
            const char* a1 = cA + (size_t)(t + 1) * kstep;
            const char* a2 = last ? nA : cA + (size_t)(t + 2) * kstep; const char* b2 = last ? nB : cB + (size_t)(t + 2) * kstep;
            const char* a3 = a2 + kstep; const char* b3 = b2 + kstep;
            if (last && has_next) S.a_ready(nxt);
            PG8_LDB(B0, 0, 0); PG8_LDB(B1, 0, 1); PG8_SCHED; PG8_LDA(At, 0, 0); PG8_STAGE(PG8_SA(1, 1), a1 + hstepA, voffA);
            PG8_WAIT_V(8); PG8_WAIT_L(0); PG8_BAR; PG8_MMA(0, 0, At, B0); PG8_MMA(0, 1, At, B1); PG8_BAR; PG8_SCHED;
            PG8_LDA(At, 0, 1); PG8_STAGE(PG8_SB(0, 0), b2, voffB); PG8_STAGE(PG8_SB(0, 1), b2 + hstepB, voffB); PG8_STAGE(PG8_SA(0, 0), a2, voffA);
            PG8_WAIT_V(8); PG8_WAIT_L(0); PG8_BAR; PG8_MMA(1, 0, At, B0); PG8_MMA(1, 1, At, B1); PG8_BAR; PG8_SCHED;
            PG8_LDB(B0, 1, 0); PG8_LDB(B1, 1, 1); PG8_SCHED; PG8_LDA(At, 1, 0); PG8_STAGE(PG8_SA(0, 1), a2 + hstepA, voffA);
            PG8_WAIT_V(8); PG8_WAIT_L(0); PG8_BAR; PG8_MMA(0, 0, At, B0); PG8_MMA(0, 1, At, B1); PG8_BAR; PG8_SCHED;
            PG8_LDA(At, 1, 1); PG8_STAGE(PG8_SB(1, 0), b3, voffB); PG8_STAGE(PG8_SB(1, 1), b3 + hstepB, voffB); PG8_STAGE(PG8_SA(1, 0), a3, voffA);
            PG8_WAIT_V(8); PG8_WAIT_L(0); PG8_BAR; PG8_MMA(1, 0, At, B0); PG8_MMA(1, 1, At, B1); PG8_BAR; PG8_SCHED;
        }
        if constexpr (ALIGN_EPI) { if (wr == 0) PG8_BAR; }
        E(acc, cur, wr, wc, fr, fq); S.done(cur);
        if (!has_next) break;
#pragma unroll
        for (int a = 0; a < 2; ++a)
#pragma unroll
            for (int b = 0; b < 2; ++b)
#pragma unroll
                for (int m = 0; m < 4; ++m)
#pragma unroll
                    for (int n = 0; n < 2; ++n) acc[a][b][m][n] = (f32x4){0.f, 0.f, 0.f, 0.f};
        cur = nxt; cA = nA; cB = nB; ++ui;
        if constexpr (ALIGN_EPI) { if (wr == 1) PG8_BAR; }
    }
    PG8_WAIT_V(0);
    if constexpr (!ALIGN_EPI) { if (wr == 0) PG8_BAR; }
    PG8_BAR;
#undef PG8_SA
#undef PG8_SB
#undef PG8_STAGE
#undef PG8_LDA
#undef PG8_LDB
#undef PG8_MMA
#undef PG8_WAIT_V
#undef PG8_WAIT_L
#undef PG8_BAR
#undef PG8_SCHED
}
}

constexpr int NWAVES = 8, NTHR = 512;
constexpr int DM = 2048, MP = 16384, MS = 512, MT = MP + MS, PAST = 2048, DECL = 64, NB = 8;
constexpr int KCROWS = PAST + DECL;
constexpr float EPS = 1e-6f;
constexpr float LOG2E = 1.4426950408889634f;
constexpr float C2 = 0.125f * LOG2E;

enum { I_XP = 0, I_XS, I_CK, I_CV, I_SR, I_NW, I_AWIN, I_AWOUT, I_AQG, I_AKG, I_LQ1, I_LK1, I_LQ2, I_LK2, I_ASG, I_RWIN, I_RWOUT, I_CWIN, I_CWOUT, I_CVG, I_CWS, I_CBS, N_IN };
constexpr size_t O_YP = 0, O_YS = O_YP + (size_t)MP * DM, O_KP = O_YS + (size_t)MS * DM, O_VP = O_KP + 2 * (size_t)MP * DM, O_KS = O_VP + 2 * (size_t)MP * DM, O_VS = O_KS + 2 * (size_t)MS * DM,
                 O_SP = O_VS + 2 * (size_t)MS * DM, O_SS = O_SP + (size_t)8 * 256 * 512, O_VM = O_SS + (size_t)NB * 8 * 256 * 512, O_END = O_VM + (size_t)MS * 4096;

constexpr size_t MiB = 1u << 20;
constexpr size_t WS_CTL = 0, CTL_ZERO_BYTES = 1 * MiB;
constexpr size_t WS_WAIN0 = 8 * MiB, WS_WAOUT0 = 40 * MiB, WS_WRIN = 48 * MiB, WS_WROUT = 96 * MiB, WS_WCIN = 112 * MiB, WS_WCOUT = 160 * MiB, WS_WAIN1 = 176 * MiB, WS_WAOUT1 = 208 * MiB;
constexpr size_t WS_SSQ2 = 2 * MiB;
constexpr size_t WS_HB = 216 * MiB, WS_Z = 282 * MiB;
constexpr size_t WS_XN0 = 348 * MiB;
constexpr size_t WS_QS = 546 * MiB, WS_KP = 612 * MiB, WS_VP = 676 * MiB, WS_KC = 740 * MiB, WS_VC = 806 * MiB, WS_AOA = 872 * MiB;
constexpr size_t WS_KT = 112 * MiB, WS_RG = 282 * MiB, WS_QP = 414 * MiB, WS_KN = 546 * MiB, WS_VS = 612 * MiB, WS_ORET = 900 * MiB;
constexpr size_t WS_GU = 282 * MiB, WS_SG = 414 * MiB, WS_GVT = 546 * MiB, WS_WM = 678 * MiB, WS_SSQ = 744 * MiB, WS_GVS = 752 * MiB;
constexpr size_t WS_GA = 282 * MiB;
constexpr size_t WS_KVX = 184 * MiB;
constexpr size_t WS_TABR = 1040 * MiB, WS_TABA = 1056 * MiB, WS_END = 1060 * MiB;

#define GAS __attribute__((address_space(1)))
#define LAS __attribute__((address_space(3)))
typedef unsigned short bf16;
typedef unsigned v4u __attribute__((ext_vector_type(4)));
typedef unsigned v2u __attribute__((ext_vector_type(2)));
typedef float f32x4 __attribute__((ext_vector_type(4)));
typedef GAS unsigned gu32;
#define RLX_AGENT __ATOMIC_RELAXED, __HIP_MEMORY_SCOPE_AGENT
#define LDS_WAIT() asm volatile("s_waitcnt lgkmcnt(0)" ::: "memory")
#define VM_WAIT() asm volatile("s_waitcnt vmcnt(0)" ::: "memory")
typedef float g_f32x2 __attribute__((ext_vector_type(2))); typedef __bf16 g_bf16x2 __attribute__((ext_vector_type(2)));
__device__ __forceinline__ unsigned pk2(float lo, float hi) { const g_f32x2 v = {lo, hi}; const g_bf16x2 b = __builtin_convertvector(v, g_bf16x2); return __builtin_bit_cast(unsigned, b); }
__device__ __forceinline__ unsigned f2bf(float f) { return pk2(f, 0.f) & 0xffffu; }
__device__ __forceinline__ float bf2f(unsigned short b) { return __builtin_bit_cast(float, (unsigned)b << 16); }
__device__ __forceinline__ float bflo(unsigned w) { return __builtin_bit_cast(float, w << 16); }
__device__ __forceinline__ float bfhi(unsigned w) { return __builtin_bit_cast(float, w & 0xffff0000u); }
__device__ __forceinline__ float silu_f(float x) { return x * __builtin_amdgcn_rcpf(1.f + __builtin_amdgcn_exp2f(-LOG2E * x)); }
__device__ __forceinline__ float gelu_tanh_f(float x) { const float u = (0.7978845608028654f * 2.f * LOG2E) * (x + 0.044715f * x * x * x); return x * __builtin_amdgcn_rcpf(1.f + __builtin_amdgcn_exp2f(-u)); }
__device__ __forceinline__ float wave_sum(float v) {
#pragma unroll
    for (int o = 1; o < 64; o <<= 1) v += __shfl_xor(v, o);
    return v;
}
__device__ __forceinline__ void row_rstd(const float* ssq, int pm, int wr, int fr, int fq, float (&rs)[2][4]) {
#pragma unroll
    for (int ai = 0; ai < 2; ++ai)
#pragma unroll
        for (int m = 0; m < 4; ++m) {
            if (ssq) { const float* p = ssq + ((size_t)pm * 256 + ai * 128 + wr * 64 + m * 16 + fr) * 32 + 8 * fq; const f32x4 a = *(const f32x4*)p, b = *(const f32x4*)(p + 4);
                float t = ((a.x + a.y) + (a.z + a.w)) + ((b.x + b.y) + (b.z + b.w)); t += __shfl_xor(t, 16); t += __shfl_xor(t, 32); rs[ai][m] = 1.f / sqrtf(t * (1.f / 2048.f) + EPS); }
            else rs[ai][m] = 1.f; }
}
__device__ __forceinline__ void rope_cs(int pos, int i, int nf, float& c, float& s) {
    const float inv = exp2f(-(float)i / (float)nf * 13.287712379549449f);
    const double a = (double)pos * (double)inv * 0.15915494309189535;
    const float r = (float)(a - floor(a));
    c = __builtin_amdgcn_cosf(r); s = __builtin_amdgcn_sinf(r);
}

#define XB_TMO      128
#define XB_XCNT(j)  (256  + 64 * (j))
#define XB_XSUB(j)  (1280 + 64 * (j))
#define XB_XGEN(j)  (2304 + 64 * (j))
#define XB_TOP      3328
#define XB_TOPGEN   3392
#define XCD_BAR_WORDS 3456
#define XB_SPIN_CAP (1u << 22)
__device__ __forceinline__ unsigned xb_ld(unsigned* p)              { return __hip_atomic_load(p, __ATOMIC_RELAXED, __HIP_MEMORY_SCOPE_AGENT); }
__device__ __forceinline__ unsigned xb_add(unsigned* p, unsigned v) { return __hip_atomic_fetch_add(p, v, __ATOMIC_RELAXED, __HIP_MEMORY_SCOPE_AGENT); }
__device__ __forceinline__ unsigned xb_xcc_id() { return (unsigned)__builtin_amdgcn_s_getreg((3 << 11) | 20) & 0xFu; }
#define XB_SPIN(cond, bar) do { unsigned _sp = 0; while (cond) { __builtin_amdgcn_s_sleep(1); \
    if ((++_sp & 255u) == 0u) { if (xb_ld(&(bar)[XB_TMO])) break; if (_sp > XB_SPIN_CAP) { atomicAdd(&(bar)[XB_TMO], 1u); break; } } } } while (0)
struct XcdBarrier { unsigned* bar; unsigned x; volatile LAS unsigned* st; };
__device__ __forceinline__ XcdBarrier xcd_barrier_post(unsigned* bar, volatile LAS unsigned* st) {
    XcdBarrier b; b.bar = bar; b.x = xb_xcc_id(); b.st = st;
    if (threadIdx.x == 0) (void)xb_add(&bar[XB_XCNT(b.x)], 1u);
    return b;
}
__device__ __forceinline__ void xcd_barrier_complete(unsigned* bar, unsigned x, unsigned& nloc, unsigned& nx) {
    const unsigned G = gridDim.x * gridDim.y * gridDim.z;
    unsigned sum, cnt, mine, sp = 0u;
    for (;;) {
        sum = 0u; cnt = 0u; mine = 0u;
#pragma unroll
        for (unsigned j = 0; j < 16; ++j) { const unsigned c = xb_ld(&bar[XB_XCNT(j)]); sum += c; cnt += (c > 0u) ? 1u : 0u; mine = (j == x) ? c : mine; }
        if (sum == G) break;
        __builtin_amdgcn_s_sleep(1);
        if ((++sp & 255u) == 0u) { if (xb_ld(&bar[XB_TMO])) break; if (sp > XB_SPIN_CAP) { atomicAdd(&bar[XB_TMO], 1u); break; } }
    }
    nloc = mine > 0u ? mine : 1u; nx = cnt > 0u ? cnt : 1u;
}
__device__ __forceinline__ void xcd_barrier(const XcdBarrier& b, bool leader) {
    asm volatile("s_waitcnt vmcnt(0)" ::: "memory");
    __syncthreads();
    if (leader) {
        unsigned* bar = b.bar;
        __builtin_amdgcn_s_waitcnt(0);
        unsigned nloc = b.st[0], nx = b.st[1];
        if (nloc == 0u) { xcd_barrier_complete(bar, b.x, nloc, nx); b.st[0] = nloc; b.st[1] = nx; }
        const unsigned old = xb_add(&bar[XB_XSUB(b.x)], 1u);
        const unsigned gen = old / nloc;
        if (old + 1u == (gen + 1u) * nloc) {
            __builtin_amdgcn_fence(__ATOMIC_RELEASE, "agent");
            asm volatile("s_waitcnt vmcnt(0)" ::: "memory");
            const unsigned og = xb_add(&bar[XB_TOP], 1u);
            const unsigned tg = og / nx;
            if (og + 1u == (tg + 1u) * nx) xb_add(&bar[XB_TOPGEN], 1u);
            else XB_SPIN(xb_ld(&bar[XB_TOPGEN]) == tg, bar);
            __builtin_amdgcn_fence(__ATOMIC_ACQUIRE, "agent");
            xb_add(&bar[XB_XGEN(b.x)], 1u);
            asm volatile("s_waitcnt vmcnt(0)" ::: "memory");
        } else {
            XB_SPIN(xb_ld(&bar[XB_XGEN(b.x)]) == gen, bar);
            __builtin_amdgcn_fence(__ATOMIC_ACQUIRE, "agent");
            asm volatile("s_waitcnt vmcnt(0)" ::: "memory");
        }
    }
    __syncthreads();
}

constexpr int RING_OFF = 0, RING_BYTES = 139264;
constexpr int MISC_OFF = RING_BYTES;
constexpr int LDS_BYTES = 147456;
struct Args { const float* in[N_IN]; float* out; unsigned char* ws; int ph_lo, ph_hi; };
struct Frame {
    LAS unsigned char* lds; int tid, lane, wave, G, bid;
    const float* const* in; float* out; unsigned char* ws;
};

__device__ __forceinline__ void p0_transpose_item(const float* W, int K, int N, bf16* WT, LAS float* scr, int item, int lane, const float* ksc = nullptr) {
    const int nblk = N / 32, kb = item / nblk, nb = item % nblk, k0 = 64 * kb, n0 = 32 * nb;
#pragma unroll 8
    for (int i = 0; i < 32; ++i) { const int kk = 2 * i + (lane >> 5); const float w_ = W[(size_t)(k0 + kk) * N + n0 + (lane & 31)]; scr[kk * 33 + (lane & 31)] = ksc ? w_ * ksc[k0 + kk] : w_; }
    LDS_WAIT(); asm volatile("" ::: "memory");
    const int c = lane & 7;
#pragma unroll
    for (int j = 0; j < 4; ++j) { const int n = (lane >> 3) + 8 * j; const LAS float* s = scr + (8 * c) * 33 + n;
        v4u o; o.x = pk2(s[0 * 33], s[1 * 33]); o.y = pk2(s[2 * 33], s[3 * 33]); o.z = pk2(s[4 * 33], s[5 * 33]); o.w = pk2(s[6 * 33], s[7 * 33]);
        *(GAS v4u*)(WT + (size_t)(n0 + n) * K + k0 + 8 * c) = o; }
    LDS_WAIT(); asm volatile("" ::: "memory");
}
__device__ __forceinline__ void transpose_weight(Frame& F, const float* W, int K, int N, bf16* WT) {
    LAS float* scr = (LAS float*)(F.lds + RING_OFF + F.wave * 16384);
    const int gw = F.bid * NWAVES + F.wave, NGW = F.G * NWAVES, nitems = (K / 64) * (N / 32);
    for (int it = gw; it < nitems; it += NGW) p0_transpose_item(W, K, N, WT, scr, it, F.lane);
}
__device__ __forceinline__ void norm_rows(Frame& F, const float* src_p, const float* src_s, const float* w, bf16* XN) {
    const int gw = F.bid * NWAVES + F.wave, NGW = F.G * NWAVES;
    for (int m = gw; m < MT; m += NGW) {
        const float* xrow = (m < MP) ? src_p + (size_t)m * DM : src_s + (size_t)(m - MP) * DM;
        const GAS f32x4* xr = (const GAS f32x4*)xrow + F.lane; const GAS f32x4* wr = (const GAS f32x4*)w + F.lane;
        f32x4 v[8]; float s = 0.f;
#pragma unroll
        for (int j = 0; j < 8; ++j) { v[j] = xr[64 * j]; s += (v[j].x * v[j].x + v[j].y * v[j].y) + (v[j].z * v[j].z + v[j].w * v[j].w); }
        const float rstd = 1.f / sqrtf(wave_sum(s) * (1.f / DM) + EPS);
        GAS v2u* o8 = (GAS v2u*)(XN + (size_t)m * DM) + F.lane;
#pragma unroll
        for (int j = 0; j < 8; ++j) { const f32x4 g = wr[64 * j]; v2u o; o.x = pk2(v[j].x * rstd * g.x, v[j].y * rstd * g.y); o.y = pk2(v[j].z * rstd * g.z, v[j].w * rstd * g.w); o8[64 * j] = o; }
    }
}
__device__ __forceinline__ void cache_cvt(Frame& F, const float* ck, const float* cv, bf16* KC, bf16* VC) {
    const size_t nvec = (size_t)NB * PAST * DM / 4;
    const size_t gt = (size_t)F.bid * NTHR + F.tid, NG = (size_t)F.G * NTHR;
    for (size_t i = gt; i < 2 * nvec; i += NG) {
        const bool isv = i >= nvec; const size_t e = (isv ? i - nvec : i) * 4;
        const size_t brow = e / DM, col = e % DM, b = brow / PAST, t = brow % PAST;
        const f32x4 x = *(const GAS f32x4*)((isv ? cv : ck) + e);
        v2u o; o.x = pk2(x.x, x.y); o.y = pk2(x.z, x.w);
        *(GAS v2u*)((isv ? VC : KC) + ((b * KCROWS + t) * DM + col)) = o;
    }
}
__device__ __forceinline__ int tw_chunks(int K, int N) { return (K / 64) * (N / 32) / 64; }
__device__ __forceinline__ void tw_run(Frame& F, const float* W, int K, int N, bf16* WT, int c, const float* ksc = nullptr) {
    LAS float* scr = (LAS float*)(F.lds + RING_OFF + F.wave * 16384);
#pragma unroll 1
    for (int i = 0; i < 8; ++i) p0_transpose_item(W, K, N, WT, scr, c * 64 + F.wave * 8 + i, F.lane, ksc);
}
constexpr int CC_CHUNKS = 2 * (NB * PAST * DM / 4) / 8192;
__device__ __forceinline__ void cc_run(Frame& F, const float* ck, const float* cv, bf16* KC, bf16* VC, int c) {
    const size_t nvec = (size_t)NB * PAST * DM / 4;
#pragma unroll 4
    for (int k = 0; k < 16; ++k) { const size_t i = (size_t)c * 8192 + k * NTHR + F.tid;
        const bool isv = i >= nvec; const size_t e = (isv ? i - nvec : i) * 4; const size_t brow = e / DM, col = e % DM, b = brow / PAST, t = brow % PAST;
        const f32x4 x = *(const GAS f32x4*)((isv ? cv : ck) + e); v2u o; o.x = pk2(x.x, x.y); o.y = pk2(x.z, x.w);
        *(GAS v2u*)((isv ? VC : KC) + ((b * KCROWS + t) * DM + col)) = o; }
}
constexpr int TR_CHUNKS = MP * 128 / 8192;
__device__ __forceinline__ void tr_run(Frame& F, float* tab, int c) {
#pragma unroll 1
    for (int k = 0; k < 16; ++k) { const size_t e = (size_t)c * 8192 + k * NTHR + F.tid; float cs, sn; rope_cs((int)(e >> 7), (int)(e & 127), 128, cs, sn); tab[2 * e] = cs; tab[2 * e + 1] = sn; }
}
__device__ __forceinline__ int row_pos(int row) { return row < MP ? row : PAST + ((row - MP) & 63); }

struct EpiAIn {
    static constexpr int BMODE = 2;
    pg8::bf16_t *Qs, *KP, *VP, *KC, *VC, *GA; float *okp, *ovp, *oks, *ovs; const float* tab; const float* qg; const float* kg; const float* ssq;
    __device__ __forceinline__ void operator()(const pg8::f32x4 (&acc)[2][2][4][2], const pg8::Unit& u, int wr, int wc, int fr, int fq) const {
        { const int l_ = lane_now(); fr = l_ & 15; fq = l_ >> 4; }
        const int pn = u.pn, pm = u.pm, typ = pn >> 3, cl = ((pn & 7) * 4 + wc) * 64 + 8 * fq; float rs[2][4]; row_rstd(ssq, pm, wr, fr, fq, rs);
        float g1[8], g2[8];
        if (typ < 2) { const float* gp = (typ == 0 ? qg : kg) + 8 * fq; const pg8::f32x4 a = *(const pg8::f32x4*)gp, b = *(const pg8::f32x4*)(gp + 4), c = *(const pg8::f32x4*)(gp + 32), d = *(const pg8::f32x4*)(gp + 36);
#pragma unroll
            for (int e = 0; e < 4; ++e) { g1[e] = a[e]; g1[4 + e] = b[e]; g2[e] = c[e]; g2[4 + e] = d[e]; } }
#pragma unroll
        for (int ai = 0; ai < 2; ++ai)
#pragma unroll
          for (int mp = 0; mp < 2; ++mp) {
            pg8::f32x4 tq[4][4];
            if (typ < 2) {
#pragma unroll
                for (int m = 2 * mp; m < 2 * mp + 2; ++m) { const int i_ = ai * 128 + wr * 64 + m * 16 + fr; const int pos_ = pm < 64 ? pm * 256 + i_ : PAST + (i_ & 63); const float* tp_ = tab + ((size_t)pos_ * 32 + 8 * fq) * 2;
#pragma unroll
                    for (int q4 = 0; q4 < 4; ++q4) tq[m][q4] = *(const pg8::f32x4*)(tp_ + 4 * q4); } }
#pragma unroll
            for (int m = 2 * mp; m < 2 * mp + 2; ++m) {
                const int i = ai * 128 + wr * 64 + m * 16 + fr; const size_t row = (size_t)pm * 256 + i;
                float x1[8], x2[8];
#pragma unroll
                for (int e = 0; e < 4; ++e) { x1[e] = acc[ai][0][m][0][e] * rs[ai][m]; x1[4 + e] = acc[ai][0][m][1][e] * rs[ai][m]; x2[e] = acc[ai][1][m][0][e] * rs[ai][m]; x2[4 + e] = acc[ai][1][m][1][e] * rs[ai][m]; }
                size_t drow; pg8::bf16_t* dk; pg8::bf16_t* dv; float* fk; float* fv;
                if (pm < 64) { drow = row; dk = KP; dv = VP; fk = okp + row * DM; fv = ovp + row * DM; }
                else { const int s_ = (int)(row - MP); drow = (size_t)(s_ >> 6) * KCROWS + PAST + (s_ & 63); dk = KC; dv = VC; fk = oks + (size_t)s_ * DM; fv = ovs + (size_t)s_ * DM; }
                if (typ < 2) {
                    float ss = 0.f;
#pragma unroll
                    for (int k = 0; k < 8; ++k) ss += x1[k] * x1[k] + x2[k] * x2[k];
                    ss += __shfl_xor(ss, 16); ss += __shfl_xor(ss, 32);
                    const float rstd = 1.f / sqrtf(ss * (1.f / 64.f) + EPS);
                    float o1[8], o2[8];
#pragma unroll
                    for (int q4 = 0; q4 < 4; ++q4) { const pg8::f32x4 t = tq[m][q4];
#pragma unroll
                        for (int z = 0; z < 2; ++z) { const int k = 2 * q4 + z; const float c = t[2 * z], s = t[2 * z + 1], y1 = x1[k] * rstd * g1[k], y2 = x2[k] * rstd * g2[k]; o1[k] = y1 * c - y2 * s; o2[k] = y2 * c + y1 * s; } }
                    if (typ == 0) { v4u w1, w2;
                        w1.x = pk2(o1[0] * C2, o1[1] * C2); w1.y = pk2(o1[2] * C2, o1[3] * C2); w1.z = pk2(o1[4] * C2, o1[5] * C2); w1.w = pk2(o1[6] * C2, o1[7] * C2);
                        w2.x = pk2(o2[0] * C2, o2[1] * C2); w2.y = pk2(o2[2] * C2, o2[3] * C2); w2.z = pk2(o2[4] * C2, o2[5] * C2); w2.w = pk2(o2[6] * C2, o2[7] * C2);
                        *(v4u*)(Qs + row * DM + cl) = w1; *(v4u*)(Qs + row * DM + cl + 32) = w2;
                    } else { v4u w1, w2;
                        w1.x = pk2(o1[0], o1[1]); w1.y = pk2(o1[2], o1[3]); w1.z = pk2(o1[4], o1[5]); w1.w = pk2(o1[6], o1[7]);
                        w2.x = pk2(o2[0], o2[1]); w2.y = pk2(o2[2], o2[3]); w2.z = pk2(o2[4], o2[5]); w2.w = pk2(o2[6], o2[7]);
                        *(v4u*)(dk + drow * DM + cl) = w1; *(v4u*)(dk + drow * DM + cl + 32) = w2;
                        *(pg8::f32x4*)(fk + cl) = (pg8::f32x4){o1[0], o1[1], o1[2], o1[3]}; *(pg8::f32x4*)(fk + cl + 4) = (pg8::f32x4){o1[4], o1[5], o1[6], o1[7]};
                        *(pg8::f32x4*)(fk + cl + 32) = (pg8::f32x4){o2[0], o2[1], o2[2], o2[3]}; *(pg8::f32x4*)(fk + cl + 36) = (pg8::f32x4){o2[4], o2[5], o2[6], o2[7]}; }
                } else { v4u w1, w2;
                    w1.x = pk2(x1[0], x1[1]); w1.y = pk2(x1[2], x1[3]); w1.z = pk2(x1[4], x1[5]); w1.w = pk2(x1[6], x1[7]);
                    w2.x = pk2(x2[0], x2[1]); w2.y = pk2(x2[2], x2[3]); w2.z = pk2(x2[4], x2[5]); w2.w = pk2(x2[6], x2[7]);
                    if (typ == 2) { *(v4u*)(dv + drow * DM + cl) = w1; *(v4u*)(dv + drow * DM + cl + 32) = w2;
                        *(pg8::f32x4*)(fv + cl) = (pg8::f32x4){x1[0], x1[1], x1[2], x1[3]}; *(pg8::f32x4*)(fv + cl + 4) = (pg8::f32x4){x1[4], x1[5], x1[6], x1[7]};
                        *(pg8::f32x4*)(fv + cl + 32) = (pg8::f32x4){x2[0], x2[1], x2[2], x2[3]}; *(pg8::f32x4*)(fv + cl + 36) = (pg8::f32x4){x2[4], x2[5], x2[6], x2[7]}; }
                    else { *(v4u*)(GA + row * DM + cl) = w1; *(v4u*)(GA + row * DM + cl + 32) = w2; }
                }
                if (m & 1) asm volatile("" ::: "memory");
            }
        }
    }
};
__device__ __forceinline__ void attn_table(Frame& F, float* tab) {
    const size_t gt = (size_t)F.bid * NTHR + F.tid, NG = (size_t)F.G * NTHR;
    for (size_t e = gt; e < (size_t)MP * 32; e += NG) { float c, s; rope_cs((int)(e >> 5), (int)(e & 31), 32, c, s); tab[2 * e] = c; tab[2 * e + 1] = s; }
}
namespace dattn {
typedef short bf16x8 __attribute__((ext_vector_type(8)));
typedef short s16x4 __attribute__((ext_vector_type(4)));
typedef short v4i16_t __attribute__((ext_vector_type(4)));
typedef float f32x16 __attribute__((ext_vector_type(16)));
typedef unsigned u32x4 __attribute__((ext_vector_type(4)));
typedef __attribute__((address_space(3))) const char* lds_cptr;
constexpr int RINGB = 98304, WSF_OFF = RINGB, XCHB = 18432, STP = 144;
__device__ __forceinline__ int crow(int r, int hi) { return (r & 3) + 8 * (r >> 2) + 4 * hi; }
__device__ __forceinline__ void glds16(const void* gsrc, unsigned lds_dst) { unsigned keep;
    asm volatile("s_mov_b32 %0, m0\n\ts_mov_b32 m0, %2\n\ts_nop 0\n\tglobal_load_lds_dwordx4 %1, off\n\ts_mov_b32 m0, %0" : "=&s"(keep) : "v"(gsrc), "s"(lds_dst) : "memory"); }
typedef float f32x2_t __attribute__((ext_vector_type(2))); typedef __bf16 bf16x2_t __attribute__((ext_vector_type(2)));
__device__ __forceinline__ unsigned cvtpk_s(float lo, float hi) { f32x2_t v = {lo, hi}; bf16x2_t b = __builtin_convertvector(v, bf16x2_t); return __builtin_bit_cast(unsigned, b); }
#define DA_WAIT_BAR(N) asm volatile("s_waitcnt vmcnt(" #N ") lgkmcnt(0)\n\ts_barrier" ::: "memory")
__device__ __forceinline__ s16x4 vtr(lds_cptr p) { return __builtin_bit_cast(s16x4, __builtin_amdgcn_ds_read_tr16_b64_v4i16((__attribute__((address_space(3))) v4i16_t*)p)); }
struct Unit { const bf16* Q; const bf16* K; const bf16* V; const bf16* G; bf16* AO; int NT; int full; int dma0; };

constexpr int KSLOT = 16384, VSLOT = 16384, VRING = 3 * KSLOT;
#define DA_SBAR() __builtin_amdgcn_sched_barrier(0)
#define DA_PIN(x) asm volatile("" : "+v"(x))
#define DA_MFMA(a, b, c) __builtin_amdgcn_mfma_f32_32x32x16_bf16(a, b, c, 0, 0, 0)
struct DmaJob { const bf16* kp; const bf16* vp; unsigned kd0, kd1, vd0, vd1; };
__device__ __forceinline__ void dma_piece(const DmaJob& j, int i) { if (i == 0) glds16(j.kp, j.kd0); else if (i == 1) glds16(j.kp + 64, j.kd1); else if (i == 2) glds16(j.vp, j.vd0); else glds16(j.vp + 64, j.vd1); }
template <bool QK, bool PV, int VAR>
__device__ __forceinline__ void step(lds_cptr kpn, lds_cptr vp, const bf16x8 (&qr)[4], bf16x8 (&kf)[8], f32x16 (&o)[4], u32x4 (&pw)[4], float& l_reg, const DmaJob& dj) {
    f32x16 C0 = f32x16{}, C1 = f32x16{};
    s16x4 vlo[4], vhi[4];
    if constexpr (!QK) { dma_piece(dj, 0); dma_piece(dj, 1); dma_piece(dj, 2); dma_piece(dj, 3); }
#define DA_FOFF(f) ((((f) & 3) * 4096) + (((f) >> 2) * 1024))
#pragma unroll
    for (int a = 0; a < 8; ++a) {
        if constexpr (PV) { if (a >= 4) { if (VAR != 4) { vlo[a - 4] = vtr(vp + DA_FOFF(a - 4)); vhi[a - 4] = vtr(vp + DA_FOFF(a - 4) + 512); } else { vlo[a - 4] = s16x4{1, 2, 3, 4}; vhi[a - 4] = s16x4{5, 6, 7, 8}; } DA_SBAR(); } }
        if constexpr (QK) {
            if (a & 1) C1 = (a < 2) ? DA_MFMA(kf[a], qr[a >> 1], f32x16{}) : DA_MFMA(kf[a], qr[a >> 1], C1);
            else       C0 = (a < 2) ? DA_MFMA(kf[a], qr[a >> 1], f32x16{}) : DA_MFMA(kf[a], qr[a >> 1], C0);
            if (a < 4) dma_piece(dj, a);
            DA_SBAR();
        }
    }
    u32x4 pwn[4]; pwn[0] = u32x4{}; pwn[1] = u32x4{}; pwn[2] = u32x4{}; pwn[3] = u32x4{};
    float s0 = 0.f, s1 = 0.f;
#pragma unroll
    for (int p = 0; p < 16; ++p) {
        if constexpr (PV) {
            const bf16x8 vf = (bf16x8){vlo[p & 3][0], vlo[p & 3][1], vlo[p & 3][2], vlo[p & 3][3], vhi[p & 3][0], vhi[p & 3][1], vhi[p & 3][2], vhi[p & 3][3]};
            if (VAR != 3) o[p & 3] = DA_MFMA(__builtin_bit_cast(bf16x8, pw[p >> 2]), vf, o[p & 3]); else { o[p & 3][0] += __builtin_bit_cast(float, (int)vf[0] | ((int)vf[4] << 16)); }
            if (p < 12 && VAR != 4) { vlo[p & 3] = vtr(vp + DA_FOFF(p + 4)); vhi[p & 3] = vtr(vp + DA_FOFF(p + 4) + 512); }
        }
        if constexpr (QK) {
            float e0, e1;
            if (VAR == 2) { if (p < 8) { e0 = C0[2 * p]; e1 = C0[2 * p + 1]; } else { e0 = C1[2 * p - 16]; e1 = C1[2 * p - 15]; } }
            else if (p < 8) { e0 = __builtin_amdgcn_exp2f(C0[2 * p]); e1 = __builtin_amdgcn_exp2f(C0[2 * p + 1]); }
            else       { e0 = __builtin_amdgcn_exp2f(C1[2 * p - 16]); e1 = __builtin_amdgcn_exp2f(C1[2 * p - 15]); }
            s0 += e0; s1 += e1; pwn[p >> 2][p & 3] = cvtpk_s(e0, e1);
            DA_PIN(s0); DA_PIN(s1); DA_PIN(pwn[p >> 2]);
            if (p >= 8 && VAR != 6) { const int j = p - 8; kf[j] = *(const __attribute__((address_space(3))) bf16x8*)(kpn + (j >> 1) * 2048 + (j & 1) * 512); }
        }
        DA_SBAR();
    }
    if constexpr (QK) { l_reg += s0 + s1; pw[0] = pwn[0]; pw[1] = pwn[1]; pw[2] = pwn[2]; pw[3] = pwn[3]; }
#undef DA_FOFF
}

template <bool QK, bool PV>
__device__ __forceinline__ void step2(lds_cptr kpn, lds_cptr vp, const bf16x8 (&qr)[4], bf16x8 (&kf)[8], f32x16 (&o)[4], u32x4 (&pw)[4], float& l_reg, const DmaJob& dj,
                                      f32x16& Cn0, f32x16& Cn1, const f32x16& Pp0, const f32x16& Pp1) {
    s16x4 vlo[4], vhi[4];
#define DA_FOFF(f) ((((f) & 3) * 4096) + (((f) >> 2) * 1024))
    if constexpr (!QK) { dma_piece(dj, 0); dma_piece(dj, 1); dma_piece(dj, 2); dma_piece(dj, 3); }
    float s0 = 0.f, s1 = 0.f;
#pragma unroll
    for (int a = 0; a < 8; ++a) {
        if constexpr (PV) { if (a >= 4) { vlo[a - 4] = vtr(vp + DA_FOFF(a - 4)); vhi[a - 4] = vtr(vp + DA_FOFF(a - 4) + 512); DA_SBAR(); } }
        if constexpr (QK) {
            if (a & 1) Cn1 = (a < 2) ? DA_MFMA(kf[a], qr[a >> 1], f32x16{}) : DA_MFMA(kf[a], qr[a >> 1], Cn1);
            else       Cn0 = (a < 2) ? DA_MFMA(kf[a], qr[a >> 1], f32x16{}) : DA_MFMA(kf[a], qr[a >> 1], Cn0);
            if (a < 4) dma_piece(dj, a);
        }
        if constexpr (PV) {
            float x0, x1, x2, x3;
            if (a < 4) { x0 = Pp0[4 * a]; x1 = Pp0[4 * a + 1]; x2 = Pp0[4 * a + 2]; x3 = Pp0[4 * a + 3]; }
            else       { x0 = Pp1[4 * a - 16]; x1 = Pp1[4 * a - 15]; x2 = Pp1[4 * a - 14]; x3 = Pp1[4 * a - 13]; }
            s0 += x0; s1 += x1; s0 += x2; s1 += x3;
            pw[(2 * a) >> 2][(2 * a) & 3] = cvtpk_s(x0, x1); pw[(2 * a + 1) >> 2][(2 * a + 1) & 3] = cvtpk_s(x2, x3);
            DA_PIN(s0); DA_PIN(s1); DA_PIN(pw[(2 * a) >> 2]);
        }
        if constexpr (QK || PV) DA_SBAR();
    }
    if constexpr (PV) l_reg += s0 + s1;
#pragma unroll
    for (int p = 0; p < 16; ++p) {
        if constexpr (PV) {
            const bf16x8 vf = (bf16x8){vlo[p & 3][0], vlo[p & 3][1], vlo[p & 3][2], vlo[p & 3][3], vhi[p & 3][0], vhi[p & 3][1], vhi[p & 3][2], vhi[p & 3][3]};
            o[p & 3] = DA_MFMA(__builtin_bit_cast(bf16x8, pw[p >> 2]), vf, o[p & 3]);
            if (p < 12) { vlo[p & 3] = vtr(vp + DA_FOFF(p + 4)); vhi[p & 3] = vtr(vp + DA_FOFF(p + 4) + 512); }
        }
        if constexpr (QK) {
            if (p < 8) { Cn0[2 * p] = __builtin_amdgcn_exp2f(Cn0[2 * p]); Cn0[2 * p + 1] = __builtin_amdgcn_exp2f(Cn0[2 * p + 1]); DA_PIN(Cn0); }
            else       { Cn1[2 * p - 16] = __builtin_amdgcn_exp2f(Cn1[2 * p - 16]); Cn1[2 * p - 15] = __builtin_amdgcn_exp2f(Cn1[2 * p - 15]); DA_PIN(Cn1); }
            if (p >= 8) { const int j = p - 8; kf[j] = *(const __attribute__((address_space(3))) bf16x8*)(kpn + (j >> 1) * 2048 + (j & 1) * 512); }
        }
        if constexpr (QK || PV) DA_SBAR();
    }
#undef DA_FOFF
}

__device__ __forceinline__ void unit_prologue(const Unit& u, unsigned lds0, int lane, int wid, bf16x8 (&qr)[4]) {
    const int r32 = lane & 31, hi = lane >> 5, s = wid >> 2, g = wid & 3; const int NT = u.NT; const int wt = u.full ? (g < 2 ? NT - 1 : NT) : (g < 2 ? NT : 0);
    const bf16* ksrc = u.K + (long)lane * DM + wid * 8;
    const bf16* vsrc = u.V + (long)(16 * (wid & 3) + (lane >> 2)) * DM + (wid >> 2) * 32 + (lane & 3) * 8;
    const unsigned kdst = lds0 + wid * 1024, vdst = lds0 + VRING + wid * 1024;
#pragma unroll
    for (int t = 0; t < 3; ++t) { const int tt_ = t < NT ? t : NT - 1; const bf16* kp_ = ksrc + (long)tt_ * 64 * DM;
        glds16(kp_, (unsigned)__builtin_amdgcn_readfirstlane(kdst + t * KSLOT)); glds16(kp_ + 64, (unsigned)__builtin_amdgcn_readfirstlane(kdst + 8192 + t * KSLOT)); }
    glds16(vsrc, (unsigned)__builtin_amdgcn_readfirstlane(vdst)); glds16(vsrc + 64, (unsigned)__builtin_amdgcn_readfirstlane(vdst + 8192));
    const bf16* Qw = u.Q + (long)(32 * g + r32) * DM + s * 64;
#pragma unroll
    for (int d0 = 0; d0 < 4; ++d0) qr[d0] = (wt > 0) ? *reinterpret_cast<const bf16x8*>(Qw + d0 * 16 + hi * 8) : (bf16x8){0, 0, 0, 0, 0, 0, 0, 0};
}
template <int VAR>
__device__ __forceinline__ void attn_unit(const Unit& u, bool has_next, const Unit& nxt, bool prefetched, bf16x8 (&qr)[4], char* shm, float* wsf_base, float lam, float one_m_li, const float* sub_gain, int tid) {
    asm volatile("" : "+v"(tid));
    const int lane = tid & 63, r32 = lane & 31, hi = lane >> 5; const int wid = __builtin_amdgcn_readfirstlane(tid >> 6), s = wid >> 2, g = wid & 3;
    const int NT = u.NT; const int wt = u.full ? (g < 2 ? NT - 1 : NT) : (g < 2 ? NT : 0);
    const unsigned lds0 = (unsigned)(uintptr_t)shm;
    float* wsf = wsf_base + wid * 64;
    const bf16* ksrc = u.K + (long)lane * DM + wid * 8;
    const bf16* vsrc = u.V + (long)(16 * (wid & 3) + (lane >> 2)) * DM + (wid >> 2) * 32 + (lane & 3) * 8;
    const unsigned kdst = lds0 + wid * 1024, vdst = lds0 + VRING + wid * 1024;
#define DA_DMA_K(t, slot) do { const int tt_ = u.dma0 ? 0 : (t) < NT ? (t) : NT - 1; const bf16* kp_ = ksrc + (long)tt_ * 64 * DM; \
        glds16(kp_, (unsigned)__builtin_amdgcn_readfirstlane(kdst + (slot) * KSLOT)); glds16(kp_ + 64, (unsigned)__builtin_amdgcn_readfirstlane(kdst + 8192 + (slot) * KSLOT)); } while (0)
#define DA_DMA_V(t, slot) do { const int tt_ = u.dma0 ? 0 : (t) < NT ? (t) : NT - 1; const bf16* vp_ = vsrc + (long)tt_ * 64 * DM; \
        glds16(vp_, (unsigned)__builtin_amdgcn_readfirstlane(vdst + (slot) * VSLOT)); glds16(vp_ + 64, (unsigned)__builtin_amdgcn_readfirstlane(vdst + 8192 + (slot) * VSLOT)); } while (0)
    const lds_cptr shm3 = (lds_cptr)shm;
    const lds_cptr kp0 = shm3 + s * 8192 + hi * 1024 + r32 * 16;
    const lds_cptr vp0 = shm3 + VRING + ((lane >> 4) & 1) * 32 + (lane & 3) * 8 + (4 * hi + ((lane & 15) >> 2)) * 64;
    if (!prefetched) unit_prologue(u, lds0, lane, wid, qr);
    asm volatile("" : "+v"(qr[0]), "+v"(qr[1]), "+v"(qr[2]), "+v"(qr[3]));
    f32x16 o[4]; o[0] = f32x16{}; o[1] = f32x16{}; o[2] = f32x16{}; o[3] = f32x16{};
    float l_reg = 0.f;
    u32x4 pw[4]; pw[0] = u32x4{}; pw[1] = u32x4{}; pw[2] = u32x4{}; pw[3] = u32x4{};
    DA_WAIT_BAR(0);
    bf16x8 kf[8];
#pragma unroll
    for (int j = 0; j < 8; ++j) kf[j] = *(const __attribute__((address_space(3))) bf16x8*)(kp0 + (j >> 1) * 2048 + (j & 1) * 512);
    int ks_cur = 0  , vs_prev = 2  ;
#define DA_TOP(t) \
        DA_WAIT_BAR(4);                                          \
        const int ks_next = (ks_cur == 2) ? 0 : ks_cur + 1, vs_cur = (vs_prev == 2) ? 0 : vs_prev + 1, vs_next = (vs_cur == 2) ? 0 : vs_cur + 1; \
        DmaJob dj; { const int tk_ = ((t) + 3) < NT ? ((t) + 3) : NT - 1, tv_ = ((t) + 1) < NT ? ((t) + 1) : NT - 1; dj.kp = ksrc + (long)tk_ * 64 * DM; dj.vp = vsrc + (long)tv_ * 64 * DM; \
          dj.kd0 = (unsigned)__builtin_amdgcn_readfirstlane(kdst + ks_cur * KSLOT); dj.kd1 = dj.kd0 + 8192u; dj.vd0 = (unsigned)__builtin_amdgcn_readfirstlane(vdst + vs_next * VSLOT); dj.vd1 = dj.vd0 + 8192u; }     \
        const lds_cptr kpn = kp0 + ks_next * KSLOT; const lds_cptr vp = vp0 + vs_prev * VSLOT; (void)kpn; (void)vp
#define DA_ROT() do { ks_cur = ks_next; vs_prev = vs_cur; } while (0)
    f32x16 pA0 = f32x16{}, pA1 = f32x16{}, pB0 = f32x16{}, pB1 = f32x16{};
#define DA_IDLE() do { dma_piece(dj, 0); dma_piece(dj, 1); dma_piece(dj, 2); dma_piece(dj, 3); } while (0)
    if (wid >= 4) __builtin_amdgcn_s_setprio(1);
    int t = 0;
    const bool odd = ((wt - 1) & 1) != 0;
    { DA_TOP(0); if (wt > 0) { if (odd) step2<true, false>(kpn, vp, qr, kf, o, pw, l_reg, dj, pB0, pB1, pA0, pA1); else step2<true, false>(kpn, vp, qr, kf, o, pw, l_reg, dj, pA0, pA1, pB0, pB1); } else DA_IDLE(); DA_ROT(); }
    t = 1;
    if (wt > 0 && odd) { DA_TOP(t); step2<true, true>(kpn, vp, qr, kf, o, pw, l_reg, dj, pA0, pA1, pB0, pB1); DA_ROT(); ++t; }
    for (; t + 1 < wt; t += 2) {
        { DA_TOP(t);     step2<true, true>(kpn, vp, qr, kf, o, pw, l_reg, dj, pB0, pB1, pA0, pA1); DA_ROT(); }
        { DA_TOP(t + 1); step2<true, true>(kpn, vp, qr, kf, o, pw, l_reg, dj, pA0, pA1, pB0, pB1); DA_ROT(); }
    }
    if (wt > 0) { DA_TOP(t); step2<false, true>(kpn, vp, qr, kf, o, pw, l_reg, dj, pB0, pB1, pA0, pA1); DA_ROT(); ++t; }
    for (; t <= NT; ++t) { DA_TOP(t); DA_IDLE(); DA_ROT(); }
#undef DA_IDLE
#undef DA_TOP
#undef DA_ROT
    __builtin_amdgcn_s_setprio(0);
    { auto rr = __builtin_amdgcn_permlane32_swap(__float_as_uint(l_reg), __float_as_uint(l_reg), false, false); l_reg = __uint_as_float(rr[0]) + __uint_as_float(rr[1]); }
    if (hi == 0) wsf[r32] = l_reg;
    DA_WAIT_BAR(0);
    if (has_next) unit_prologue(nxt, lds0, lane, wid, qr);
    float rli[16];
#pragma unroll
    for (int r = 0; r < 16; ++r) { const float lq = wsf[crow(r, hi)]; rli[r] = (s == 0 ? 1.f : -lam) / lq; }
    int le = lane; asm volatile("" : "+v"(le));
    const int r32e = le & 31, hie = le >> 5;
    float* xch = (float*)(shm + 65536 + g * XCHB);
    if (s == 1 && wt > 0) {
#pragma unroll
        for (int db = 0; db < 4; ++db)
#pragma unroll
            for (int r = 0; r < 16; ++r) xch[(db * 16 + r) * 64 + le] = o[db][r] * rli[r];
    }
    asm volatile("s_waitcnt lgkmcnt(0)\n\ts_barrier" ::: "memory");
    if (s == 0 && wt > 0) {
#pragma unroll
        for (int db = 0; db < 4; ++db)
#pragma unroll
            for (int r = 0; r < 16; ++r) o[db][r] = o[db][r] * rli[r] + xch[(db * 16 + r) * 64 + le];
        asm volatile("s_waitcnt lgkmcnt(0)" ::: "memory");
#pragma unroll
        for (int db = 0; db < 4; ++db)
#pragma unroll
            for (int r = 0; r < 16; ++r) xch[crow(r, hie) * STP + 32 * db + r32e] = o[db][r];
        asm volatile("s_waitcnt lgkmcnt(0)" ::: "memory");
        const int row = le >> 1, half = le & 1;
        float v[64]; float ss = 0.f;
#pragma unroll
        for (int k = 0; k < 16; ++k) { const f32x4 x = *(const f32x4*)(xch + row * STP + half * 64 + 4 * k); v[4 * k] = x.x; v[4 * k + 1] = x.y; v[4 * k + 2] = x.z; v[4 * k + 3] = x.w; ss += (x.x * x.x + x.y * x.y) + (x.z * x.z + x.w * x.w); }
        ss += __shfl_xor(ss, 1);
        const float sc = one_m_li / sqrtf(ss * (1.f / 128.f) + EPS);
        const bf16* gp = u.G + (long)(32 * g + row) * DM + half * 64; bf16* op = u.AO + (long)(32 * g + row) * DM + half * 64; const float* sg = sub_gain + half * 64;
#pragma unroll
        for (int k = 0; k < 8; ++k) { const v4u g4 = *(const v4u*)(gp + 8 * k); const f32x4 ga = *(const f32x4*)(sg + 8 * k), gb = *(const f32x4*)(sg + 8 * k + 4);
            const float gg[8] = {bflo(g4.x), bfhi(g4.x), bflo(g4.y), bfhi(g4.y), bflo(g4.z), bfhi(g4.z), bflo(g4.w), bfhi(g4.w)};
            const float gn[8] = {ga.x, ga.y, ga.z, ga.w, gb.x, gb.y, gb.z, gb.w}; float y[8];
#pragma unroll
            for (int e = 0; e < 8; ++e) y[e] = v[8 * k + e] * sc * gn[e] * silu_f(gg[e]);
            v4u w; w.x = pk2(y[0], y[1]); w.y = pk2(y[2], y[3]); w.z = pk2(y[4], y[5]); w.w = pk2(y[6], y[7]);
            *(v4u*)(op + 8 * k) = w; }
    }
#undef DA_DMA_K
#undef DA_DMA_V
}
}
template <int VAR = 0>
__device__ __forceinline__ void attn_fast(Frame& F, const bf16* Qs, const bf16* KP, const bf16* VP, const bf16* KC, const bf16* VC, const bf16* GA  , bf16* AO,
                                          float lam, float one_m_li, const float* sub_gain, int dma0 = 0) {
    const int NU = 2048 + 16 * NB;
    const bool xcd = (F.G == 256);
#define ATTN_GET(i_, u_, ok_) do { int qb = 0, h = 0, b = -1; ok_ = true; \
        if (xcd) { const int x = F.bid & 7, r = F.bid >> 3; \
            if ((i_) < 8) { h = x + 8 * ((i_) >> 2); const int rr = ((i_) == 0) ? (r ^ 8) : r; qb = 127 - (((i_) & 3) * 32 + (((i_) & 1) ? 31 - rr : rr)); } \
            else if ((i_) == 8 && (r & 8) == 0) { const int sb = (r & 7) + ((r >> 4) << 3); h = x + 8 * (sb >> 3); b = sb & 7; } \
            else ok_ = false; \
        } else { const int idx = (i_) * F.G + (((i_) & 1) ? F.G - 1 - F.bid : F.bid); if (idx >= NU) ok_ = false; \
            else if (idx < 2048) { qb = 127 - (idx >> 4); h = idx & 15; } else { const int j = idx - 2048; b = j >> 4; h = j & 15; } } \
        u_.dma0 = 0; \
        if (ok_) { if (b < 0) { const long row0 = 128L * qb; \
            u_.Q = Qs + row0 * DM + h * 128; u_.K = KP + h * 128; u_.V = VP + h * 128; u_.G = GA + row0 * DM + h * 128; u_.AO = AO + row0 * DM + h * 128; u_.NT = 2 * qb + 2; u_.full = 1; } \
          else { const long row0 = MP + 64L * b; \
            u_.Q = Qs + row0 * DM + h * 128; u_.K = KC + (long)b * KCROWS * DM + h * 128; u_.V = VC + (long)b * KCROWS * DM + h * 128; u_.G = GA + row0 * DM + h * 128; u_.AO = AO + row0 * DM + h * 128; u_.NT = KCROWS / 64; u_.full = 0; } } } while (0)
    dattn::Unit u, nx; bool have; ATTN_GET(0, u, have);
    dattn::bf16x8 qr[4]; bool pre = false;
    float* wsf_base = (float*)((char*)F.lds + MISC_OFF + 1024);
    for (int i = 0; have; ++i) {
        bool hn; ATTN_GET(i + 1, nx, hn);
        dattn::attn_unit<VAR>(u, hn, nx, pre, qr, (char*)F.lds + RING_OFF, wsf_base, lam, one_m_li, sub_gain, F.tid);
        u = nx; have = hn; pre = true;
    }
    __syncthreads();
#undef ATTN_GET
}
constexpr int RBLK = 72;
__device__ __forceinline__ float ret_lg2(int h) { return log2f(1.f - exp2f(-5.f - (float)h)); }
struct EpiRet {
    static constexpr int BMODE = 0;
    pg8::bf16_t* QP; pg8::bf16_t* KN; pg8::bf16_t* KT; pg8::bf16_t* VS; pg8::bf16_t* RG; const float* tab; const float* ssq;
    __device__ __forceinline__ void operator()(const pg8::f32x4 (&acc)[2][2][4][2], const pg8::Unit& u, int wr, int wc, int fr, int fq) const {
        { const int l_ = lane_now(); fr = l_ & 15; fq = l_ >> 4; }
        const int pn = u.pn, pm = u.pm; float rs[2][4]; row_rstd(ssq, pm, wr, fr, fq, rs);
#pragma unroll
        for (int ai = 0; ai < 2; ++ai)
#pragma unroll
            for (int m = 0; m < 4; ++m) {
                const int i = ai * 128 + wr * 64 + m * 16 + fr; const size_t row = (size_t)pm * 256 + i;
                const int J = pm < 64 ? pm : 64 + 4 * (pm - 64) + (i >> 6), jj = pm < 64 ? i : (i & 63), pos = pm < 64 ? (int)row : PAST + (i & 63);
                if (pn < 16) {
                    const int h = pn & 7; const bool isk = pn >= 8; const float sc = isk ? 0.0625f : 1.f;
#pragma unroll
                    for (int n = 0; n < 2; ++n) { const int c1 = wc * 32 + n * 16 + 4 * fq;
                        const pg8::f32x4 t0 = *(const pg8::f32x4*)(tab + ((size_t)pos * 128 + c1) * 2), t1 = *(const pg8::f32x4*)(tab + ((size_t)pos * 128 + c1) * 2 + 4);
                        const pg8::f32x4 x1 = acc[ai][0][m][n] * rs[ai][m], x2 = acc[ai][1][m][n] * rs[ai][m];
                        const float cs[4] = {t0[0], t0[2], t1[0], t1[2]}, sn[4] = {t0[1], t0[3], t1[1], t1[3]}; float o1[4], o2[4];
#pragma unroll
                        for (int e = 0; e < 4; ++e) { o1[e] = (x1[e] * cs[e] - x2[e] * sn[e]) * sc; o2[e] = (x2[e] * cs[e] + x1[e] * sn[e]) * sc; }
                        v2u w1, w2; w1.x = pk2(o1[0], o1[1]); w1.y = pk2(o1[2], o1[3]); w2.x = pk2(o2[0], o2[1]); w2.y = pk2(o2[2], o2[3]);
                        if (!isk) { pg8::bf16_t* p = QP + row * 4096 + h * 512 + 256 + c1; *(v2u*)p = w1; *(v2u*)(p + 128) = w2; }
                        else { pg8::bf16_t* p = KN + row * 2048 + h * 256 + c1; *(v2u*)p = w1; *(v2u*)(p + 128) = w2;
                            pg8::bf16_t* t = KT + ((size_t)(J * 8 + h) * 256 + c1) * 256 + jj;
#pragma unroll
                            for (int e = 0; e < 4; ++e) { t[(size_t)e * 256] = (pg8::bf16_t)f2bf(o1[e]); t[(size_t)(128 + e) * 256] = (pg8::bf16_t)f2bf(o2[e]); } } }
                } else if (pn < 32) {
                    const int h = (pn - 16) >> 1, half = (pn - 16) & 1; const float f = exp2f(-(float)(1 + jj) * ret_lg2(h)) * rs[ai][m];
#pragma unroll
                    for (int bj = 0; bj < 2; ++bj)
#pragma unroll
                        for (int n = 0; n < 2; ++n) { const int dv = half * 256 + bj * 128 + wc * 32 + n * 16 + 4 * fq; pg8::bf16_t* t = VS + ((size_t)(J * 8 + h) * 512 + dv) * 512 + jj;
#pragma unroll
                            for (int e = 0; e < 4; ++e) t[(size_t)e * 512] = (pg8::bf16_t)f2bf(acc[ai][bj][m][n][e] * f); }
                } else {
#pragma unroll
                    for (int bj = 0; bj < 2; ++bj)
#pragma unroll
                        for (int n = 0; n < 2; ++n) { const int c = (pn - 32) * 256 + bj * 128 + wc * 32 + n * 16 + 4 * fq; const pg8::f32x4 x = acc[ai][bj][m][n] * rs[ai][m];
                            v2u w; w.x = pk2(x[0], x[1]); w.y = pk2(x[2], x[3]); *(v2u*)(RG + row * 4096 + c) = w; }
                }
            }
    }
};
__device__ __forceinline__ size_t ret_row0(int J) { return J < 64 ? (size_t)256 * J : (size_t)MP + 64 * (J - 64); }
struct RetQKOrder {
    int G, c; const char* QP; const char* KN;
    __device__ __forceinline__ bool next(int i, pg8::Unit& u) const { const int L = i * G + c; if (L >= RBLK * 8) return false; const int J = L >> 3, h = L & 7; const size_t r0 = ret_row0(J);
        u.pm = J; u.pn = h; u.a = QP + (r0 * 4096 + h * 512 + 256) * 2; u.b = KN + (r0 * 2048 + h * 256) * 2; return true; }
    __device__ __forceinline__ void a_ready(const pg8::Unit&) const {}
    __device__ __forceinline__ void done(const pg8::Unit&) const {}
};
struct EpiRetQK {
    static constexpr int BMODE = 1;
    pg8::bf16_t* QP;
    __device__ __forceinline__ void operator()(const pg8::f32x4 (&acc)[2][2][4][2], const pg8::Unit& u, int wr, int wc, int fr, int fq) const {
        { const int l_ = lane_now(); fr = l_ & 15; fq = l_ >> 4; }
        const int J = u.pm, h = u.pn, nv = J < 64 ? 256 : 64; const size_t r0 = ret_row0(J);
#pragma unroll
        for (int ai = 0; ai < 2; ++ai)
#pragma unroll
            for (int m = 0; m < 4; ++m) { const int i = ai * 128 + wr * 64 + m * 16 + fr;
                if (i < nv) {
#pragma unroll
                    for (int bj = 0; bj < 2; ++bj) { const int j0 = bj * 128 + wc * 32 + 8 * fq; const pg8::f32x4 v0 = acc[ai][bj][m][0], v1 = acc[ai][bj][m][1]; float x[8] = {v0[0], v0[1], v0[2], v0[3], v1[0], v1[1], v1[2], v1[3]};
#pragma unroll
                        for (int k = 0; k < 8; ++k) x[k] = (j0 + k <= i) ? x[k] : 0.f;
                        v4u w; w.x = pk2(x[0], x[1]); w.y = pk2(x[2], x[3]); w.z = pk2(x[4], x[5]); w.w = pk2(x[6], x[7]);
                        *(v4u*)(QP + (r0 + i) * 4096 + h * 512 + j0) = w; } } }
    }
};
struct RetOOrder {
    int G, c; const char* QP; const char* VS;
    __device__ __forceinline__ bool next(int i, pg8::Unit& u) const { const int L = i * G + c; if (L >= RBLK * 16) return false; const int J = L >> 4, r = L & 15, h = r >> 1, half = r & 1; const size_t r0 = ret_row0(J);
        u.pm = J; u.pn = r; u.a = QP + (r0 * 4096 + h * 512) * 2; u.b = VS + (((size_t)(J * 8 + h) * 512 + half * 256) * 512) * 2; return true; }
    __device__ __forceinline__ void a_ready(const pg8::Unit&) const {}
    __device__ __forceinline__ void done(const pg8::Unit&) const {}
};
struct EpiRetO {
    static constexpr int BMODE = 1;
    pg8::bf16_t* O;
    __device__ __forceinline__ void operator()(const pg8::f32x4 (&acc)[2][2][4][2], const pg8::Unit& u, int wr, int wc, int fr, int fq) const {
        { const int l_ = lane_now(); fr = l_ & 15; fq = l_ >> 4; }
        const int J = u.pm, h = u.pn >> 1, half = u.pn & 1, nv = J < 64 ? 256 : 64; const size_t r0 = ret_row0(J); const float lg = ret_lg2(h);
#pragma unroll
        for (int ai = 0; ai < 2; ++ai)
#pragma unroll
            for (int m = 0; m < 4; ++m) { const int i = ai * 128 + wr * 64 + m * 16 + fr;
                if (i < nv) { const float f = exp2f((float)(i + 1) * lg);
#pragma unroll
                    for (int bj = 0; bj < 2; ++bj) { const int j0 = bj * 128 + wc * 32 + 8 * fq; const pg8::f32x4 v0 = acc[ai][bj][m][0] * f, v1 = acc[ai][bj][m][1] * f;
                        v4u w; w.x = pk2(v0[0], v0[1]); w.y = pk2(v0[2], v0[3]); w.z = pk2(v1[0], v1[1]); w.w = pk2(v1[2], v1[3]);
                        *(v4u*)(O + (r0 + i) * 4096 + h * 512 + half * 256 + j0) = w; } } }
    }
};
struct RetKVOrder {
    int G, c; const char* VS; const char* KT;
    __device__ __forceinline__ bool next(int i, pg8::Unit& u) const { const int L = i * G + c; if (L >= RBLK * 16) return false; const int J = L >> 4, r = L & 15, h = r >> 1, half = r & 1;
        u.pm = J; u.pn = r; u.a = VS + (((size_t)(J * 8 + h) * 512 + half * 256) * 512) * 2; u.b = KT + ((size_t)(J * 8 + h) * 256 * 256) * 2; return true; }
    __device__ __forceinline__ void a_ready(const pg8::Unit&) const {}
    __device__ __forceinline__ void done(const pg8::Unit&) const {}
};
struct EpiRetKV {
    static constexpr int BMODE = 1;
    pg8::bf16_t* VS; pg8::bf16_t* KVX;
    __device__ __forceinline__ void operator()(const pg8::f32x4 (&acc)[2][2][4][2], const pg8::Unit& u, int wr, int wc, int fr, int fq) const {
        { const int l_ = lane_now(); fr = l_ & 15; fq = l_ >> 4; }
        const int J = u.pm, h = u.pn >> 1, half = u.pn & 1;
        pg8::bf16_t* base; int pitch;
        if (J < 63) { base = VS + ((size_t)((J + 1) * 8 + h) * 512 + half * 256) * 512 + 256; pitch = 512; }
        else { base = KVX + ((size_t)((J - 63) * 8 + h) * 512 + half * 256) * 256; pitch = 256; }
#pragma unroll
        for (int ai = 0; ai < 2; ++ai)
#pragma unroll
            for (int m = 0; m < 4; ++m) { pg8::bf16_t* rowp = base + (size_t)(ai * 128 + wr * 64 + m * 16 + fr) * pitch + wc * 32 + 8 * fq;
#pragma unroll
                for (int bj = 0; bj < 2; ++bj) { const pg8::f32x4 v0 = acc[ai][bj][m][0], v1 = acc[ai][bj][m][1];
                    v4u w; w.x = pk2(v0[0], v0[1]); w.y = pk2(v0[2], v0[3]); w.z = pk2(v1[0], v1[1]); w.w = pk2(v1[2], v1[3]);
                    *(v4u*)(rowp + bj * 128) = w; } }
    }
};
__device__ __forceinline__ void ret_scan(Frame& F, bf16* VS, const bf16* KVX, const float* state_in, float* osp, float* oss) {
    const int gt = F.bid * NTHR + F.tid;
    for (int c = gt; c < 8 * 512 * 32; c += F.G * NTHR) {
        const int h = c >> 14, dv = (c >> 5) & 511, dk0 = (c & 31) * 8; const float lg = ret_lg2(h), g256 = exp2f(256.f * lg), g64 = exp2f(64.f * lg);
        float S[8];
#pragma unroll
        for (int k = 0; k < 8; ++k) S[k] = 0.f;
        bf16* slot = VS + ((size_t)h * 512 + dv) * 512 + 256 + dk0;
        *(v4u*)slot = (v4u){0u, 0u, 0u, 0u};
        v4u nx = *(const v4u*)(slot + (size_t)8 * 512 * 512);
        for (int J = 1; J < 64; ++J) {
            const v4u kv = nx; bf16* sj = slot + (size_t)J * 8 * 512 * 512;
            if (J < 63) nx = *(const v4u*)(sj + (size_t)8 * 512 * 512);
            const float x[8] = {bflo(kv.x), bfhi(kv.x), bflo(kv.y), bfhi(kv.y), bflo(kv.z), bfhi(kv.z), bflo(kv.w), bfhi(kv.w)};
#pragma unroll
            for (int k = 0; k < 8; ++k) S[k] = (S[k] + x[k]) * g256;
            v4u w; w.x = pk2(S[0], S[1]); w.y = pk2(S[2], S[3]); w.z = pk2(S[4], S[5]); w.w = pk2(S[6], S[7]);
            *(v4u*)sj = w;
        }
        { const v4u kv = *(const v4u*)(KVX + ((size_t)h * 512 + dv) * 256 + dk0);
          const float x[8] = {bflo(kv.x), bfhi(kv.x), bflo(kv.y), bfhi(kv.y), bflo(kv.z), bfhi(kv.z), bflo(kv.w), bfhi(kv.w)};
#pragma unroll
          for (int k = 0; k < 8; ++k) osp[((size_t)h * 256 + dk0 + k) * 512 + dv] = (S[k] + x[k]) * g256; }
    }
    for (int c = gt; c < NB * 8 * 512 * 32; c += F.G * NTHR) {
        const int dv = c & 511, dk0 = ((c >> 9) & 31) * 8, h = (c >> 14) & 7, b = c >> 17; const float g64 = exp2f(64.f * ret_lg2(h));
        const float* si = state_in + (((size_t)b * 8 + h) * 256 + dk0) * 512 + dv; float* so = oss + (((size_t)b * 8 + h) * 256 + dk0) * 512 + dv;
        const v4u kv = *(const v4u*)(KVX + ((size_t)((1 + b) * 8 + h) * 512 + dv) * 256 + dk0);
        const float x[8] = {bflo(kv.x), bfhi(kv.x), bflo(kv.y), bfhi(kv.y), bflo(kv.z), bfhi(kv.z), bflo(kv.w), bfhi(kv.w)}; float s0[8];
#pragma unroll
        for (int k = 0; k < 8; ++k) s0[k] = si[(size_t)k * 512];
        v4u w; w.x = pk2(s0[0], s0[1]); w.y = pk2(s0[2], s0[3]); w.z = pk2(s0[4], s0[5]); w.w = pk2(s0[6], s0[7]);
        *(v4u*)(VS + ((size_t)((64 + b) * 8 + h) * 512 + dv) * 512 + 256 + dk0) = w;
#pragma unroll
        for (int k = 0; k < 8; ++k) so[(size_t)k * 512] = (s0[k] + x[k]) * g64;
    }
}
__device__ __forceinline__ void ret_zero_pad(Frame& F, bf16* VS, bf16* KT) {
    const size_t gt = (size_t)F.bid * NTHR + F.tid, NG = (size_t)F.G * NTHR, n = (size_t)NB * 8 * 512 * 24, n2 = (size_t)NB * 8 * 256 * 24;
    for (size_t i = gt; i < n; i += NG) { const size_t rowi = i / 24, c = i % 24; *(v4u*)(VS + ((size_t)64 * 8 * 512 + rowi) * 512 + 64 + c * 8) = (v4u){0u, 0u, 0u, 0u}; }
    for (size_t i = gt; i < n2; i += NG) { const size_t rowi = i / 24, c = i % 24; *(v4u*)(KT + ((size_t)64 * 8 * 256 + rowi) * 256 + 64 + c * 8) = (v4u){0u, 0u, 0u, 0u}; }
}
__device__ __forceinline__ void ret_table(Frame& F, float* tab) {
    const size_t gt = (size_t)F.bid * NTHR + F.tid, NG = (size_t)F.G * NTHR;
    for (size_t e = gt; e < (size_t)MP * 128; e += NG) { float c, s; rope_cs((int)(e >> 7), (int)(e & 127), 128, c, s); tab[2 * e] = c; tab[2 * e + 1] = s; }
}
__device__ __forceinline__ void r_out(Frame& F, bf16* O, const bf16* RG) {
    const int gw = F.bid * NWAVES + F.wave, NGW = F.G * NWAVES, lane = F.lane;
    for (int it = gw; it < MT * 8; it += NGW) {
        const int row = it >> 3, h = it & 7; const size_t off = (size_t)row * 4096 + h * 512 + lane * 8;
        const v4u o4 = *(const v4u*)(O + off), g4 = *(const v4u*)(RG + off);
        float o[8] = {bflo(o4.x), bfhi(o4.x), bflo(o4.y), bfhi(o4.y), bflo(o4.z), bfhi(o4.z), bflo(o4.w), bfhi(o4.w)};
        const float g[8] = {bflo(g4.x), bfhi(g4.x), bflo(g4.y), bfhi(g4.y), bflo(g4.z), bfhi(g4.z), bflo(g4.w), bfhi(g4.w)};
        float ss = 0.f;
#pragma unroll
        for (int k = 0; k < 8; ++k) ss += o[k] * o[k];
        const float rstd = 1.f / sqrtf(wave_sum(ss) * (1.f / 512.f) + EPS);
#pragma unroll
        for (int k = 0; k < 8; ++k) o[k] = o[k] * rstd * silu_f(g[k]);
        v4u w; w.x = pk2(o[0], o[1]); w.y = pk2(o[2], o[3]); w.z = pk2(o[4], o[5]); w.w = pk2(o[6], o[7]);
        *(v4u*)(O + off) = w;
    }
}
struct EpiCIn {
    static constexpr int BMODE = 0;
    pg8::bf16_t* GU; pg8::bf16_t* GVT; pg8::bf16_t* SG; pg8::bf16_t* GVS; float* SSQ; const float* ssq;
    __device__ __forceinline__ void operator()(const pg8::f32x4 (&acc)[2][2][4][2], const pg8::Unit& u, int wr, int wc, int fr, int fq) const {
        { const int l_ = lane_now(); fr = l_ & 15; fq = l_ >> 4; }
        const int pn = u.pn, pm = u.pm, typ = pn >> 4, pt = pn & 15; float rs[2][4]; row_rstd(ssq, pm, wr, fr, fq, rs);
#pragma unroll
        for (int ai = 0; ai < 2; ++ai)
#pragma unroll
            for (int m = 0; m < 4; ++m) {
                const int i = ai * 128 + wr * 64 + m * 16 + fr; const size_t row = (size_t)pm * 256 + i; float ss = 0.f;
#pragma unroll
                for (int bj = 0; bj < 2; ++bj)
#pragma unroll
                    for (int n = 0; n < 2; ++n) { const int c = pt * 256 + bj * 128 + wc * 32 + n * 16 + 4 * fq; const pg8::f32x4 x = acc[ai][bj][m][n] * rs[ai][m]; float y[4];
                        if (typ == 2) {
#pragma unroll
                            for (int e = 0; e < 4; ++e) y[e] = silu_f(x[e]);
                            v2u w; w.x = pk2(y[0], y[1]); w.y = pk2(y[2], y[3]); *(v2u*)(SG + row * 4096 + c) = w;
                        } else {
#pragma unroll
                            for (int e = 0; e < 4; ++e) y[e] = gelu_tanh_f(x[e]);
                            v2u w; w.x = pk2(y[0], y[1]); w.y = pk2(y[2], y[3]);
                            if (typ == 0) *(v2u*)(GU + row * 4096 + c) = w;
                            else { ss += (y[0] * y[0] + y[1] * y[1]) + (y[2] * y[2] + y[3] * y[3]);
                                pg8::bf16_t* t = GVT + ((size_t)pm * 4096 + c) * 256 + i;
                                t[0] = (pg8::bf16_t)(w.x & 0xffffu); t[256] = (pg8::bf16_t)(w.x >> 16); t[512] = (pg8::bf16_t)(w.y & 0xffffu); t[768] = (pg8::bf16_t)(w.y >> 16);
                                if (pm >= 64) *(v2u*)(GVS + (row - MP) * 4096 + c) = w; } } }
                if (typ == 1) { ss += __shfl_xor(ss, 16); ss += __shfl_xor(ss, 32); if (fq == 0) SSQ[row * 64 + pt * 4 + wc] = ss; }
                if (m & 1) asm volatile("" ::: "memory");
            }
    }
};
__device__ __forceinline__ void c_prep(Frame& F, const float* SSQ, const float* wsin, const float* vgain, const bf16* GVS, bf16* Wm, float* ovm) {
    LAS float* rs = (LAS float*)(F.lds + RING_OFF);
    const int tid = F.tid;
    for (int it = F.bid; it < 66 * 8; it += F.G) {
        const int J = it >> 3, g = it & 7;
        __syncthreads();
        if (tid < 256) { const float* p = SSQ + ((size_t)J * 256 + tid) * 64; float s = 0.f;
#pragma unroll
            for (int k = 0; k < 16; ++k) { const f32x4 x = *(const f32x4*)(p + 4 * k); s += (x.x + x.y) + (x.z + x.w); }
            rs[tid] = 1.f / sqrtf(s * (1.f / 4096.f) + EPS); }
        __syncthreads();
        bf16* wm = Wm + (size_t)(J * 8 + g) * 65536; const int sh = J < 64 ? 7 : 6, cm = (1 << sh) - 1;
        for (int e8 = tid; e8 < 8192; e8 += NTHR) { const int i = e8 >> 5, j0 = (e8 & 31) * 8, il = i & cm, jl0 = j0 & cm; float y[8];
            if ((i >> sh) == (j0 >> sh) && jl0 <= il) { const float* wr_ = wsin + ((size_t)g * 128 + il) * 128 + jl0; const f32x4 a = *(const f32x4*)wr_, b = *(const f32x4*)(wr_ + 4);
                const float wv[8] = {a.x, a.y, a.z, a.w, b.x, b.y, b.z, b.w};
#pragma unroll
                for (int k = 0; k < 8; ++k) y[k] = (jl0 + k <= il) ? wv[k] * rs[j0 + k] : 0.f;
            } else {
#pragma unroll
                for (int k = 0; k < 8; ++k) y[k] = 0.f; }
            v4u w; w.x = pk2(y[0], y[1]); w.y = pk2(y[2], y[3]); w.z = pk2(y[4], y[5]); w.w = pk2(y[6], y[7]);
            *(v4u*)(wm + i * 256 + j0) = w; }
    }
    const int gw = F.bid * NWAVES + F.wave, NGW = F.G * NWAVES, lane = F.lane;
    for (int r = gw; r < MS; r += NGW) {
        const float rstd = 1.f / sqrtf(wave_sum(SSQ[((size_t)MP + r) * 64 + lane]) * (1.f / 4096.f) + EPS);
#pragma unroll
        for (int k = 0; k < 8; ++k) { const int col = k * 512 + lane * 8; const v4u v4 = *(const v4u*)(GVS + (size_t)r * 4096 + col);
            const f32x4 ga = *(const f32x4*)(vgain + col), gb = *(const f32x4*)(vgain + col + 4);
            float* o = ovm + (size_t)r * 4096 + col;
            *(f32x4*)o = (f32x4){bflo(v4.x) * rstd * ga.x, bfhi(v4.x) * rstd * ga.y, bflo(v4.y) * rstd * ga.z, bfhi(v4.y) * rstd * ga.w};
            *(f32x4*)(o + 4) = (f32x4){bflo(v4.z) * rstd * gb.x, bfhi(v4.z) * rstd * gb.y, bflo(v4.w) * rstd * gb.z, bfhi(v4.w) * rstd * gb.w}; }
    }
}
struct CMixOrder {
    int G, c; const char* Wm; const char* GVT;
    __device__ __forceinline__ bool next(int i, pg8::Unit& u) const { const int L = i * G + c; if (L >= 66 * 16) return false; const int J = L >> 4, nt = L & 15;
        u.pm = J; u.pn = nt; u.a = Wm + ((size_t)(J * 8 + (nt >> 1)) * 65536) * 2; u.b = GVT + (((size_t)J * 4096 + nt * 256) * 256) * 2; return true; }
    __device__ __forceinline__ void a_ready(const pg8::Unit&) const {}
    __device__ __forceinline__ void done(const pg8::Unit&) const {}
};
struct EpiCMix {
    static constexpr int BMODE = 1;
    pg8::bf16_t* GU; const pg8::bf16_t* SG; const float* vgain; const float* bs;
    __device__ __forceinline__ void operator()(const pg8::f32x4 (&acc)[2][2][4][2], const pg8::Unit& u, int wr, int wc, int fr, int fq) const {
        { const int l_ = lane_now(); fr = l_ & 15; fq = l_ >> 4; }
        const int J = u.pm, nt = u.pn, g = nt >> 1, cm = J < 64 ? 127 : 63;
#pragma unroll
        for (int bj = 0; bj < 2; ++bj) { const int c0 = nt * 256 + bj * 128 + wc * 32 + 8 * fq; const f32x4 ga = *(const f32x4*)(vgain + c0), gb = *(const f32x4*)(vgain + c0 + 4);
            const float gn[8] = {ga.x, ga.y, ga.z, ga.w, gb.x, gb.y, gb.z, gb.w};
#pragma unroll
            for (int ai = 0; ai < 2; ++ai)
#pragma unroll
                for (int m = 0; m < 4; ++m) { const int i = ai * 128 + wr * 64 + m * 16 + fr; const size_t off = ((size_t)J * 256 + i) * 4096 + c0; const float b = bs[g * 128 + (i & cm)];
                    const v4u u4 = *(const v4u*)(GU + off), s4 = *(const v4u*)(SG + off); const pg8::f32x4 v0 = acc[ai][bj][m][0], v1 = acc[ai][bj][m][1];
                    const float mx[8] = {v0[0], v0[1], v0[2], v0[3], v1[0], v1[1], v1[2], v1[3]};
                    const float uu[8] = {bflo(u4.x), bfhi(u4.x), bflo(u4.y), bfhi(u4.y), bflo(u4.z), bfhi(u4.z), bflo(u4.w), bfhi(u4.w)};
                    const float sg[8] = {bflo(s4.x), bfhi(s4.x), bflo(s4.y), bfhi(s4.y), bflo(s4.z), bfhi(s4.z), bflo(s4.w), bfhi(s4.w)}; float y[8];
#pragma unroll
                    for (int k = 0; k < 8; ++k) y[k] = uu[k] * (mx[k] * gn[k] + b) * sg[k];
                    v4u w; w.x = pk2(y[0], y[1]); w.y = pk2(y[2], y[3]); w.z = pk2(y[4], y[5]); w.w = pk2(y[6], y[7]);
                    *(v4u*)(GU + off) = w; } }
    }
};
__device__ __forceinline__ float diff_lambda(const float* q1, const float* k1, const float* q2, const float* k2, float lam_init) {
    float a = 0.f, b = 0.f;
    for (int i = 0; i < 64; ++i) { a += q1[i] * k1[i]; b += q2[i] * k2[i]; }
    return expf(a) - expf(b) + lam_init;
}

constexpr int N_PHASES = 21;
__global__ void __launch_bounds__(NTHR, 2) mega(Args args) {
    extern __shared__ __attribute__((aligned(16))) unsigned char lds[];
    Frame F;
    F.lds = (LAS unsigned char*)lds; F.tid = threadIdx.x; F.lane = F.tid & 63; F.wave = __builtin_amdgcn_readfirstlane(F.tid >> 6); F.G = gridDim.x; F.bid = blockIdx.x;
    F.in = args.in; F.out = args.out; F.ws = args.ws;
    unsigned char* ws = args.ws; float* out = args.out;
    bf16* W_AIN[2] = {(bf16*)(ws + WS_WAIN0), (bf16*)(ws + WS_WAIN1)}; bf16* W_AOUT[2] = {(bf16*)(ws + WS_WAOUT0), (bf16*)(ws + WS_WAOUT1)};
    bf16* W_RIN = (bf16*)(ws + WS_WRIN); bf16* W_ROUT = (bf16*)(ws + WS_WROUT); bf16* W_CIN = (bf16*)(ws + WS_WCIN); bf16* W_COUT = (bf16*)(ws + WS_WCOUT);
    bf16* XN0 = (bf16*)(ws + WS_XN0); bf16* HB = (bf16*)(ws + WS_HB); float* SSQ2 = (float*)(ws + WS_SSQ2);
    bf16* Qs = (bf16*)(ws + WS_QS); bf16* KP = (bf16*)(ws + WS_KP); bf16* VP = (bf16*)(ws + WS_VP); bf16* KC = (bf16*)(ws + WS_KC); bf16* VC = (bf16*)(ws + WS_VC); bf16* AO_A = (bf16*)(ws + WS_AOA);
    bf16* KT = (bf16*)(ws + WS_KT); bf16* RG = (bf16*)(ws + WS_RG); bf16* QP = (bf16*)(ws + WS_QP); bf16* KN = (bf16*)(ws + WS_KN); bf16* VS = (bf16*)(ws + WS_VS); bf16* ORET = (bf16*)(ws + WS_ORET);
    bf16* GU = (bf16*)(ws + WS_GU); bf16* SG = (bf16*)(ws + WS_SG); bf16* GVT = (bf16*)(ws + WS_GVT); bf16* WM = (bf16*)(ws + WS_WM); float* SSQ = (float*)(ws + WS_SSQ); bf16* GVS = (bf16*)(ws + WS_GVS); float* TABR = (float*)(ws + WS_TABR); bf16* KVX = (bf16*)(ws + WS_KVX); float* TABA = (float*)(ws + WS_TABA); bf16* GA = (bf16*)(ws + WS_GA);
    const int lo = args.ph_lo, hi = args.ph_hi;
    volatile LAS unsigned* MISC = (volatile LAS unsigned*)(F.lds + MISC_OFF);
    for (int u = F.tid; u < (LDS_BYTES - MISC_OFF) / 4; u += NTHR) ((LAS unsigned*)(F.lds + MISC_OFF))[u] = 0u;
    __syncthreads();
    XcdBarrier bar = xcd_barrier_post((unsigned*)(ws + WS_CTL) + 4096, MISC + 8);
#define IN(k) (lo <= (k) && (k) < hi)
#define PH_ENTER() do { int t_ = F.wave * 64 + lane_now(); F.tid = t_; F.lane = t_ & 63; } while (0)
    volatile LAS int* DRW = (volatile LAS int*)(F.lds + MISC_OFF + 64);
    unsigned* DCTR = (unsigned*)(ws + WS_CTL) + 8192;
#define DRAIN(ph, total, BODY) do { PH_ENTER(); for (;;) { __syncthreads(); if (F.tid == 0) DRW[0] = (int)atomicAdd(DCTR + 64 * (ph), 1u); __syncthreads(); const int c_ = DRW[0]; if (c_ >= (total)) break; BODY } } while (0)
#define SEAM(k) do { if (IN(k) && IN((k) + 1)) xcd_barrier(bar, F.wave == 0 && lane_now() == 0); } while (0)

#define GEMM_STORE(Aptr, Wptr, NN, KK, Optr) do { pg8::GemmP g{KK, KK, (KK) / 64}; pg8::StaticOrder S; S.init(MT / 256, (NN) / 256, F.G, F.bid, Aptr, Wptr, KK, KK); pg8::EpiStoreBf16 E{(pg8::bf16_t*)(Optr), NN}; \
        pg8::gemm_phase<pg8::EpiStoreBf16, pg8::StaticOrder>(F.lds + RING_OFF, g, S, E, F.tid); } while (0)
#define GEMM_RESIDB(MODE_, Aptr, Wptr, KK) do { pg8::GemmP g{KK, KK, (KK) / 64}; pg8::StaticOrder S; S.init(MT / 256, DM / 256, F.G, F.bid, Aptr, Wptr, KK, KK); \
        pg8::EpiResidB<MODE_> E{args.in[I_XP], args.in[I_XS], (pg8::bf16_t*)HB, out, SSQ2}; pg8::gemm_phase<pg8::EpiResidB<MODE_>, pg8::StaticOrder>(F.lds + RING_OFF, g, S, E, F.tid); } while (0)

    PH_ENTER(); if (IN(0)) {
        transpose_weight(F, args.in[I_AWIN], 2048, 8192, W_AIN[0]); attn_table(F, TABA);
        norm_rows(F, args.in[I_XP], args.in[I_XS], args.in[I_NW], XN0);
    }
    SEAM(0);
#define GEMM_AIN(Aptr, Wptr, J_, SSQP) do { pg8::GemmP g{2048, 2048, 32}; pg8::StaticOrder S; S.init(MT / 256, 32, F.G, F.bid, Aptr, Wptr, 2048, 2048); \
        EpiAIn E{Qs, KP, VP, KC, VC, GA, out + O_KP + (size_t)(J_) * MP * DM, out + O_VP + (size_t)(J_) * MP * DM, out + O_KS + (size_t)(J_) * MS * DM, out + O_VS + (size_t)(J_) * MS * DM, TABA, args.in[I_AQG] + 64 * (J_), args.in[I_AKG] + 64 * (J_), SSQP}; \
        pg8::gemm_phase<EpiAIn, pg8::StaticOrder>(F.lds + RING_OFF, g, S, E, F.tid); } while (0)
    PH_ENTER(); if (IN(1)) { GEMM_AIN(XN0, W_AIN[0], 0, (const float*)nullptr);
        const int n0 = CC_CHUNKS, n1 = n0 + tw_chunks(2048, 2048), n2 = n1 + TR_CHUNKS;
        DRAIN(1, n2, if (c_ < n0) cc_run(F, args.in[I_CK], args.in[I_CV], KC, VC, c_); else if (c_ < n1) tw_run(F, args.in[I_AWOUT], 2048, 2048, W_AOUT[0], c_ - n0); else tr_run(F, TABR, c_ - n1);); }
    SEAM(1);
    PH_ENTER(); if (IN(3)) { const float li = 0.8f - 0.6f * expf(-0.3f * 0.f); const float lam = diff_lambda(args.in[I_LQ1], args.in[I_LK1], args.in[I_LQ2], args.in[I_LK2], li);
        attn_fast(F, Qs, KP, VP, KC, VC, GA, AO_A, lam, 1.f - li, args.in[I_ASG]); }
    SEAM(3);
    PH_ENTER(); if (IN(4)) { GEMM_RESIDB(0, AO_A, W_AOUT[0], 2048);
        const int n0 = tw_chunks(2048, 12288), n1 = n0 + tw_chunks(4096, 2048);
        DRAIN(4, n1, if (c_ < n0) tw_run(F, args.in[I_RWIN], 2048, 12288, W_RIN, c_, args.in[I_NW] + DM); else tw_run(F, args.in[I_RWOUT], 4096, 2048, W_ROUT, c_ - n0);); }
    if (IN(4) && IN(6)) xcd_barrier(bar, F.wave == 0 && lane_now() == 0);
    PH_ENTER(); if (IN(6)) { ret_zero_pad(F, VS, KT);
        PH_ENTER(); pg8::GemmP g{2048, 2048, 32}; pg8::StaticOrder S; S.init(MT / 256, 48, F.G, F.bid, HB, W_RIN, 2048, 2048); EpiRet E{QP, KN, KT, VS, RG, TABR, SSQ2};
        pg8::gemm_phase<EpiRet, pg8::StaticOrder>(F.lds + RING_OFF, g, S, E, F.tid); }
    SEAM(6);
    PH_ENTER(); if (IN(7)) { { pg8::GemmP g{4096, 2048, 4}; RetQKOrder S{F.G, F.bid, (const char*)QP, (const char*)KN}; EpiRetQK E{QP}; pg8::gemm_phase<EpiRetQK, RetQKOrder>(F.lds + RING_OFF, g, S, E, F.tid); }
        PH_ENTER(); { pg8::GemmP g{512, 256, 4}; RetKVOrder S{F.G, F.bid, (const char*)VS, (const char*)KT}; EpiRetKV E{VS, KVX}; pg8::gemm_phase<EpiRetKV, RetKVOrder>(F.lds + RING_OFF, g, S, E, F.tid); }
        xcd_barrier(bar, F.wave == 0 && lane_now() == 0);
        PH_ENTER(); ret_scan(F, VS, KVX, args.in[I_SR], out + O_SP, out + O_SS); }
    SEAM(7);
    PH_ENTER(); if (IN(8)) { pg8::GemmP g{4096, 512, 8}; RetOOrder S{F.G, F.bid, (const char*)QP, (const char*)VS}; EpiRetO E{ORET}; pg8::gemm_phase<EpiRetO, RetOOrder>(F.lds + RING_OFF, g, S, E, F.tid); }
    SEAM(8);
    PH_ENTER(); if (IN(9)) r_out(F, ORET, RG);
    SEAM(9);
    PH_ENTER(); if (IN(10)) { GEMM_RESIDB(1, ORET, W_ROUT, 4096);
        const int n0 = tw_chunks(2048, 12288), n1 = n0 + tw_chunks(4096, 2048), n2 = n1 + tw_chunks(2048, 8192), n3 = n2 + tw_chunks(2048, 2048);
        DRAIN(10, n3, if (c_ < n0) tw_run(F, args.in[I_CWIN], 2048, 12288, W_CIN, c_, args.in[I_NW] + 2 * DM); else if (c_ < n1) tw_run(F, args.in[I_CWOUT], 4096, 2048, W_COUT, c_ - n0);
                      else if (c_ < n2) tw_run(F, args.in[I_AWIN] + (size_t)2048 * 8192, 2048, 8192, W_AIN[1], c_ - n1, args.in[I_NW] + 3 * DM); else tw_run(F, args.in[I_AWOUT] + (size_t)2048 * 2048, 2048, 2048, W_AOUT[1], c_ - n2);); }
    if (IN(10) && IN(12)) xcd_barrier(bar, F.wave == 0 && lane_now() == 0);
    PH_ENTER(); if (IN(12)) { pg8::GemmP g{2048, 2048, 32}; pg8::StaticOrder S; S.init(MT / 256, 48, F.G, F.bid, HB, W_CIN, 2048, 2048); EpiCIn E{GU, GVT, SG, GVS, SSQ, SSQ2};
        pg8::gemm_phase<EpiCIn, pg8::StaticOrder>(F.lds + RING_OFF, g, S, E, F.tid); }
    SEAM(12);
    PH_ENTER(); if (IN(13)) c_prep(F, SSQ, args.in[I_CWS], args.in[I_CVG], GVS, WM, out + O_VM);
    SEAM(13);
    PH_ENTER(); if (IN(14)) { pg8::GemmP g{256, 256, 4}; CMixOrder S{F.G, F.bid, (const char*)WM, (const char*)GVT}; EpiCMix E{GU, SG, args.in[I_CVG], args.in[I_CBS]}; pg8::gemm_phase<EpiCMix, CMixOrder>(F.lds + RING_OFF, g, S, E, F.tid); }
    SEAM(14);
    PH_ENTER(); if (IN(15)) { GEMM_RESIDB(1, GU, W_COUT, 4096);
        DRAIN(15, CC_CHUNKS, cc_run(F, args.in[I_CK] + (size_t)NB * PAST * DM, args.in[I_CV] + (size_t)NB * PAST * DM, KC, VC, c_);); }
    if (IN(15) && IN(17)) xcd_barrier(bar, F.wave == 0 && lane_now() == 0);
    PH_ENTER(); if (IN(17)) GEMM_AIN(HB, W_AIN[1], 1, (const float*)SSQ2);
    SEAM(17);
    PH_ENTER(); if (IN(19)) { const float li = 0.8f - 0.6f * expf(-0.3f * 3.f); const float lam = diff_lambda(args.in[I_LQ1] + 64, args.in[I_LK1] + 64, args.in[I_LQ2] + 64, args.in[I_LK2] + 64, li);
        attn_fast(F, Qs, KP, VP, KC, VC, GA, AO_A, lam, 1.f - li, args.in[I_ASG] + 128); }
    SEAM(19);
    PH_ENTER(); if (IN(20)) GEMM_RESIDB(2, AO_A, W_AOUT[1], 2048);
#undef IN
#undef SEAM
}

extern "C" void kernel_launch(void* const* d_in, const int* in_sizes, int n_in, void* d_out, int out_size, void* d_ws, size_t ws_size, hipStream_t stream) {
    static int grid = 0;
    if (grid == 0) {
        if (n_in != N_IN || (size_t)out_size != O_END || ws_size < WS_END) { fprintf(stderr, "kernel_launch: unexpected shapes: n_in %d out %d ws %zu (need %zu)\n", n_in, out_size, ws_size, (size_t)WS_END); grid = -1; return; }
        int dev = 0, cus = 0;
        if (hipGetDevice(&dev) != hipSuccess || hipDeviceGetAttribute(&cus, hipDeviceAttributeMultiprocessorCount, dev) != hipSuccess) { grid = -1; return; }
        if (hipFuncSetAttribute((const void*)mega, hipFuncAttributeMaxDynamicSharedMemorySize, LDS_BYTES) != hipSuccess) { fprintf(stderr, "kernel_launch: hipFuncSetAttribute failed\n"); grid = -1; return; }
        (void)hipGetLastError();
        grid = cus;
    }
    if (grid < 0) return;
    Args a{};
    for (int i = 0; i < N_IN; ++i) a.in[i] = (const float*)d_in[i];
    a.out = (float*)d_out; a.ws = (unsigned char*)d_ws;
    (void)hipMemsetAsync((char*)d_ws + WS_CTL, 0, CTL_ZERO_BYTES, stream);
    a.ph_lo = 0; a.ph_hi = N_PHASES;
    hipLaunchKernelGGL(mega, dim3(grid), dim3(NTHR), LDS_BYTES, stream, a);
}
```

```cpp
#include <hip/hip_runtime.h>
#include <cstdio>
#include <cstdint>

__device__ __forceinline__ int lane_now() { int l; asm volatile("v_mbcnt_lo_u32_b32 %0, -1, 0\n\tv_mbcnt_hi_u32_b32 %0, -1, %0" : "=v"(l)); return l; }
namespace pg8 {
#define PG8_LAS __attribute__((address_space(3)))
typedef unsigned short bf16_t;
typedef short bf16x8 __attribute__((ext_vector_type(8)));
typedef float f32x4 __attribute__((ext_vector_type(4)));
typedef unsigned u32x4 __attribute__((ext_vector_type(4)));
constexpr int BM = 256, BK = 64, HALF = 128, HTB = HALF * BK * 2, STAGE_BYTES = 8 * HTB, NXCD = 8, WGM = 4;

__host__ __device__ __forceinline__ int lds_byte(int r, int c) { const int st = (r >> 4) * 2 + (c >> 5), rr = r & 15, cc = c & 31, ob = rr * 64 + cc * 2; return st * 1024 + (ob ^ (((ob >> 9) & 1) << 5)); }
__host__ __device__ __forceinline__ void stage_rc(int b, int& R, int& C) { const int st = b / 1024, sb = b % 1024, swz = sb ^ (((sb >> 9) & 1) << 5); R = (st >> 1) * 16 + swz / 64; C = (st & 1) * 32 + (swz % 64) / 2; }
__host__ __device__ __forceinline__ int perm32(int rho) { const int n = rho >> 4, i = rho & 15; return 8 * (i >> 2) + 4 * n + (i & 3); }

struct Unit { int pm, pn; const char* a; const char* b; };
struct GemmP { int lda, ldb, nt; };

struct StaticOrder {
    int nM, nN, nwg, G, c; const char* A; const char* B; size_t ta, tb;
    __host__ __device__ void init(int nM_, int nN_, int G_, int c_, const void* A_, const void* B_, int lda, int ldb) { nM = nM_; nN = nN_; nwg = nM * nN; G = G_; c = c_; A = (const char*)A_; B = (const char*)B_; ta = (size_t)BM * lda * 2; tb = (size_t)BM * ldb * 2; }
    __host__ __device__ bool next(int i, Unit& u) const {
        const long L = (long)i * G + c; if (L >= nwg) return false;
        int wgid = (int)L; { const int q = nwg / NXCD, r = nwg % NXCD, xcd = wgid % NXCD, off = wgid / NXCD; wgid = (xcd < r ? xcd * (q + 1) : r * (q + 1) + (xcd - r) * q) + off; }
        const int nig = WGM * nN, gid = wgid / nig, fm = gid * WGM, gsz = (nM - fm) < WGM ? (nM - fm) : WGM;
        u.pm = fm + ((wgid % nig) % gsz); u.pn = (wgid % nig) / gsz; u.a = A + (size_t)u.pm * ta; u.b = B + (size_t)u.pn * tb; return true;
    }
    __device__ __forceinline__ void a_ready(const Unit&) const {}
    __device__ __forceinline__ void done(const Unit&) const {}
};

__device__ __forceinline__ unsigned cvt_pk_bf16(float lo, float hi) { unsigned r; asm volatile("v_cvt_pk_bf16_f32 %0, %1, %2" : "=v"(r) : "v"(lo), "v"(hi)); return r; }

struct EpiStoreBf16 {
    static constexpr int BMODE = 1;
    bf16_t* O; int ldc;
    __device__ __forceinline__ void operator()(const f32x4 (&acc)[2][2][4][2], const Unit& u, int wr, int wc, int fr, int fq) const {
        const int row0 = u.pm * BM + wr * 64 + fr; const int col0 = u.pn * BM + wc * 32 + 8 * fq;
#pragma unroll
        for (int ai = 0; ai < 2; ++ai)
#pragma unroll
            for (int m = 0; m < 4; ++m) { bf16_t* rowp = O + (size_t)(row0 + ai * HALF + m * 16) * ldc + col0;
#pragma unroll
                for (int bj = 0; bj < 2; ++bj) { const f32x4 v0 = acc[ai][bj][m][0], v1 = acc[ai][bj][m][1];
                    u32x4 w; w.x = cvt_pk_bf16(v0[0], v0[1]); w.y = cvt_pk_bf16(v0[2], v0[3]); w.z = cvt_pk_bf16(v1[0], v1[1]); w.w = cvt_pk_bf16(v1[2], v1[3]);
                    *(u32x4*)(rowp + bj * HALF) = w; } }
    }
};
struct EpiResid {
    static constexpr int BMODE = 0;
    const float* base_p; const float* base_s; float* out; int split;
    __device__ __forceinline__ void operator()(const f32x4 (&acc)[2][2][4][2], const Unit& u, int wr, int wc, int fr, int fq) const {
        { const int l_ = lane_now(); fr = l_ & 15; fq = l_ >> 4; }
        const int col0 = u.pn * BM + wc * 32 + 4 * fq;
#pragma unroll
        for (int ai = 0; ai < 2; ++ai) {
            f32x4 bs[4][2][2];
#pragma unroll
            for (int m = 0; m < 4; ++m) { const int r = u.pm * BM + ai * HALF + wr * 64 + m * 16 + fr; const float* bp = (r < split) ? base_p + (size_t)r * 2048 : base_s + (size_t)(r - split) * 2048;
#pragma unroll
                for (int bj = 0; bj < 2; ++bj)
#pragma unroll
                    for (int n = 0; n < 2; ++n) bs[m][bj][n] = *(const f32x4*)(bp + col0 + bj * HALF + n * 16); }
#pragma unroll
            for (int m = 0; m < 4; ++m) { const int r = u.pm * BM + ai * HALF + wr * 64 + m * 16 + fr; float* op = out + (size_t)r * 2048;
#pragma unroll
                for (int bj = 0; bj < 2; ++bj)
#pragma unroll
                    for (int n = 0; n < 2; ++n) *(f32x4*)(op + col0 + bj * HALF + n * 16) = bs[m][bj][n] + acc[ai][bj][m][n]; }
            asm volatile("" ::: "memory");
        }
    }
};

template <int MODE> struct EpiResidB {
    static constexpr int BMODE = 1;
    const float* base_p; const float* base_s; bf16_t* HB; float* out; float* SSQ2;
    __device__ __forceinline__ void operator()(const f32x4 (&acc)[2][2][4][2], const Unit& u, int wr, int wc, int fr, int fq) const {
        { const int l_ = lane_now(); fr = l_ & 15; fq = l_ >> 4; }
        const int col0 = u.pn * BM + wc * 32 + 8 * fq;
#pragma unroll
        for (int ai = 0; ai < 2; ++ai) {
            f32x4 b0[4][2], b1[4][2]; u32x4 hb[4][2];
#pragma unroll
            for (int m = 0; m < 4; ++m) { const int r = u.pm * BM + ai * HALF + wr * 64 + m * 16 + fr;
#pragma unroll
                for (int bj = 0; bj < 2; ++bj) {
                    if (MODE == 0) { const float* bp = ((r < 16384) ? base_p + (size_t)r * 2048 : base_s + (size_t)(r - 16384) * 2048) + col0 + bj * HALF; b0[m][bj] = __builtin_nontemporal_load((const f32x4*)bp); b1[m][bj] = __builtin_nontemporal_load((const f32x4*)(bp + 4)); }
                    else hb[m][bj] = *(const u32x4*)(HB + (size_t)r * 2048 + col0 + bj * HALF); } }
#pragma unroll
            for (int m = 0; m < 4; ++m) { const int r = u.pm * BM + ai * HALF + wr * 64 + m * 16 + fr; float ss = 0.f;
#pragma unroll
                for (int bj = 0; bj < 2; ++bj) { f32x4 h0, h1;
                    if (MODE == 0) { h0 = b0[m][bj] + acc[ai][bj][m][0]; h1 = b1[m][bj] + acc[ai][bj][m][1]; }
                    else { const u32x4 w = hb[m][bj];
                        h0 = (f32x4){__builtin_bit_cast(float, w.x << 16), __builtin_bit_cast(float, w.x & 0xffff0000u), __builtin_bit_cast(float, w.y << 16), __builtin_bit_cast(float, w.y & 0xffff0000u)} + acc[ai][bj][m][0];
                        h1 = (f32x4){__builtin_bit_cast(float, w.z << 16), __builtin_bit_cast(float, w.z & 0xffff0000u), __builtin_bit_cast(float, w.w << 16), __builtin_bit_cast(float, w.w & 0xffff0000u)} + acc[ai][bj][m][1]; }
                    if (MODE == 2) { float* op = out + (size_t)r * 2048 + col0 + bj * HALF; __builtin_nontemporal_store(h0, (f32x4*)op); __builtin_nontemporal_store(h1, (f32x4*)(op + 4)); }
                    else { u32x4 w; w.x = cvt_pk_bf16(h0[0], h0[1]); w.y = cvt_pk_bf16(h0[2], h0[3]); w.z = cvt_pk_bf16(h1[0], h1[1]); w.w = cvt_pk_bf16(h1[2], h1[3]);
                        *(u32x4*)(HB + (size_t)r * 2048 + col0 + bj * HALF) = w;
                        ss += (h0[0] * h0[0] + h0[1] * h0[1]) + (h0[2] * h0[2] + h0[3] * h0[3]) + (h1[0] * h1[0] + h1[1] * h1[1]) + (h1[2] * h1[2] + h1[3] * h1[3]); } }
                if (MODE != 2) { ss += __shfl_xor(ss, 16); ss += __shfl_xor(ss, 32); if (fq == 0) SSQ2[(size_t)r * 32 + u.pn * 4 + wc] = ss; } }
            asm volatile("" ::: "memory");
        }
    }
};

template <class Epi, class Sched, bool ALIGN_EPI = true>
__device__ __forceinline__ void gemm_phase(PG8_LAS unsigned char* lds, const GemmP g, const Sched& S, const Epi& E, int tid) {
    asm volatile("" : "+v"(tid));
    const int wid = __builtin_amdgcn_readfirstlane(tid >> 6), lane = tid & 63, wr = wid >> 2, wc = wid & 3, fr = lane & 15, fq = lane >> 4;
    int nt = g.nt; asm volatile("" : "+s"(nt));
    unsigned voffA[2], voffB[2];
#pragma unroll
    for (int i = 0; i < 2; ++i) { int R, C; stage_rc(tid * 16 + i * 8192, R, C); const int Rb = Epi::BMODE == 2 ? (64 * (R >> 5) + perm32(R & 31)) : Epi::BMODE == 1 ? ((R & ~31) + perm32(R & 31)) : R;
        voffA[i] = (unsigned)(R * g.lda + C) * 2u; voffB[i] = (unsigned)(Rb * g.ldb + C) * 2u; }
    const size_t kstep = (size_t)(BK * 2);
    const size_t hstepA = (size_t)HALF * g.lda * 2, hstepB = (size_t)(Epi::BMODE == 2 ? 32 : HALF) * g.ldb * 2;
    const unsigned ldsw = (unsigned)wid * 1024u;
    const int aoff = lds_byte(wr * 64 + fr, fq * 8), boff = lds_byte(wc * 32 + fr, fq * 8);
#define PG8_SA(b, h) (((b) * 2 + (h)) * HTB)
#define PG8_SB(b, h) ((4 + (b) * 2 + (h)) * HTB)
#define PG8_STAGE(bufoff, gbase, voff) do { _Pragma("unroll") for (int _i = 0; _i < 2; ++_i) \
        __builtin_amdgcn_global_load_lds((const unsigned*)((const char*)(gbase) + (voff)[_i]), (PG8_LAS unsigned*)(lds + (bufoff) + ldsw + _i * 8192), 16, 0, 0); } while (0)
#define PG8_LDA(dst, b, h) do { _Pragma("unroll") for (int m = 0; m < 4; ++m) _Pragma("unroll") for (int k = 0; k < 2; ++k) dst[m][k] = *(const PG8_LAS bf16x8*)(lds + PG8_SA(b, h) + aoff + m * 2048 + k * 1024); } while (0)
#define PG8_LDB(dst, b, h) do { _Pragma("unroll") for (int n = 0; n < 2; ++n) _Pragma("unroll") for (int k = 0; k < 2; ++k) dst[n][k] = *(const PG8_LAS bf16x8*)(lds + PG8_SB(b, h) + boff + n * 2048 + k * 1024); } while (0)
#define PG8_MMA(ai, bj, At, Bt) do { __builtin_amdgcn_s_setprio(1); _Pragma("unroll") for (int m = 0; m < 4; ++m) _Pragma("unroll") for (int n = 0; n < 2; ++n) _Pragma("unroll") for (int k = 0; k < 2; ++k) \
        acc[ai][bj][m][n] = __builtin_amdgcn_mfma_f32_16x16x32_bf16(Bt[n][k], At[m][k], acc[ai][bj][m][n], 0, 0, 0); __builtin_amdgcn_s_setprio(0); } while (0)
#define PG8_WAIT_V(n) asm volatile("s_waitcnt vmcnt(" #n ")" ::: "memory")
#define PG8_WAIT_L(n) asm volatile("s_waitcnt lgkmcnt(" #n ")" ::: "memory")
#define PG8_BAR __builtin_amdgcn_s_barrier()
#define PG8_SCHED __builtin_amdgcn_sched_barrier(0)
    Unit cur, nxt; int ui = 0;
    if (!S.next(0, cur)) return;
    f32x4 acc[2][2][4][2];
#pragma unroll
    for (int a = 0; a < 2; ++a)
#pragma unroll
        for (int b = 0; b < 2; ++b)
#pragma unroll
            for (int m = 0; m < 4; ++m)
#pragma unroll
                for (int n = 0; n < 2; ++n) acc[a][b][m][n] = (f32x4){0.f, 0.f, 0.f, 0.f};
    bf16x8 At[4][2], B0[2][2], B1[2][2];
    const char* cA = cur.a; const char* cB = cur.b;
    S.a_ready(cur);
    PG8_STAGE(PG8_SB(0, 0), cB, voffB); PG8_STAGE(PG8_SB(0, 1), cB + hstepB, voffB); PG8_STAGE(PG8_SA(0, 0), cA, voffA); PG8_STAGE(PG8_SA(0, 1), cA + hstepA, voffA);
    if (wr == 1) PG8_BAR;
    PG8_WAIT_V(2); PG8_BAR;
    PG8_STAGE(PG8_SB(1, 0), cB + kstep, voffB); PG8_STAGE(PG8_SA(1, 0), cA + kstep, voffA); PG8_STAGE(PG8_SB(1, 1), cB + hstepB + kstep, voffB);
    PG8_WAIT_V(6); PG8_BAR;
    for (;;) {
        const bool has_next = S.next(ui + 1, nxt);
        const char* nA = has_next ? nxt.a : cA; const char* nB = has_next ? nxt.b : cB;
        for (int t = 0; t < nt; t += 2) {
            const bool last = (t == nt - 2);
            const char* a1 = cA + (size_t)(t + 1) * kstep;
            const char* a2 = last ? nA : cA + (size_t)(t + 2) * kstep; const char* b2 = last ? nB : cB + (size_t)(t + 2) * kstep;
            const char* a3 = a2 + kstep; const char* b3 = b2 + kstep;
            if (last && has_next) S.a_ready(nxt);
            PG8_LDB(B0, 0, 0); PG8_LDB(B1, 0, 1); PG8_SCHED; PG8_LDA(At, 0, 0); PG8_STAGE(PG8_SA(1, 1), a1 + hstepA, voffA);
            PG8_WAIT_V(8); PG8_WAIT_L(0); PG8_BAR; PG8_MMA(0, 0, At, B0); PG8_MMA(0, 1, At, B1); PG8_BAR; PG8_SCHED;
            PG8_LDA(At, 0, 1); PG8_STAGE(PG8_SB(0, 0), b2, voffB); PG8_STAGE(PG8_SB(0, 1), b2 + hstepB, voffB); PG8_STAGE(PG8_SA(0, 0), a2, voffA);
            PG8_WAIT_V(8); PG8_WAIT_L(0); PG8_BAR; PG8_MMA(1, 0, At, B0); PG8_MMA(1, 1, At, B1); PG8_BAR; PG8_SCHED;
            PG8_LDB(B0, 1, 0); PG8_LDB(B1, 1, 1); PG8_SCHED; PG8_LDA(At, 1, 0); PG8_STAGE(PG8_SA(0, 1), a2 + hstepA, voffA);
            PG8_WAIT_V(8); PG8_WAIT_L(0); PG8_BAR; PG8_MMA(0, 0, At, B0); PG8_MMA(0, 1, At, B1); PG8_BAR; PG8_SCHED;
            PG8_LDA(At, 1, 1); PG8_STAGE(PG8_SB(1, 0), b3, voffB); PG8_STAGE(PG8_SB(1, 1), b3 + hstepB, voffB); PG8_STAGE(PG8_SA(1, 0), a3, voffA);
            PG8_WAIT_V(8); PG8_WAIT_L(0); PG8_BAR; PG8_MMA(1, 0, At, B0); PG8_MMA(1, 1, At, B1); PG8_BAR; PG8_SCHED;
        }
        if constexpr (ALIGN_EPI) { if (wr == 0) PG8_BAR; }
        E(acc, cur, wr, wc, fr, fq); S.done(cur);
        if (!has_next) break;
#pragma unroll
        for (int a = 0; a < 2; ++a)
#pragma unroll
            for (int b = 0; b < 2; ++b)
#pragma unroll
                for (int m = 0; m < 4; ++m)
#pragma unroll
                    for (int n = 0; n < 2; ++n) acc[a][b][m][n] = (f32x4){0.f, 0.f, 0.f, 0.f};
        cur = nxt; cA = nA; cB = nB; ++ui;
        if constexpr (ALIGN_EPI) { if (wr == 1) PG8_BAR; }
    }
    PG8_WAIT_V(0);
    if constexpr (!ALIGN_EPI) { if (wr == 0) PG8_BAR; }
    PG8_BAR;
#undef PG8_SA
#undef PG8_SB
#undef PG8_STAGE
#undef PG8_LDA
#undef PG8_LDB
#undef PG8_MMA
#undef PG8_WAIT_V
#undef PG8_WAIT_L
#undef PG8_BAR
#undef PG8_SCHED
}
}

constexpr int NWAVES = 8, NTHR = 512;
constexpr int DM = 2048, MP = 16384, MS = 512, MT = MP + MS, PAST = 2048, DECL = 64, NB = 8;
constexpr int KCROWS = PAST + DECL;
constexpr float EPS = 1e-6f;
constexpr float LOG2E = 1.4426950408889634f;
constexpr float C2 = 0.125f * LOG2E;

enum { I_XP = 0, I_XS, I_CK, I_CV, I_SR, I_NW, I_AWIN, I_AWOUT, I_AQG, I_AKG, I_LQ1, I_LK1, I_LQ2, I_LK2, I_ASG, I_RWIN, I_RWOUT, I_CWIN, I_CWOUT, I_CVG, I_CWS, I_CBS, N_IN };
constexpr size_t O_YP = 0, O_YS = O_YP + (size_t)MP * DM, O_KP = O_YS + (size_t)MS * DM, O_VP = O_KP + 2 * (size_t)MP * DM, O_KS = O_VP + 2 * (size_t)MP * DM, O_VS = O_KS + 2 * (size_t)MS * DM,
                 O_SP = O_VS + 2 * (size_t)MS * DM, O_SS = O_SP + (size_t)8 * 256 * 512, O_VM = O_SS + (size_t)NB * 8 * 256 * 512, O_END = O_VM + (size_t)MS * 4096;

constexpr size_t MiB = 1u << 20;
constexpr size_t WS_CTL = 0, CTL_ZERO_BYTES = 1 * MiB;
constexpr size_t WS_WAIN0 = 8 * MiB, WS_WAOUT0 = 40 * MiB, WS_WRIN = 48 * MiB, WS_WROUT = 96 * MiB, WS_WCIN = 112 * MiB, WS_WCOUT = 160 * MiB, WS_WAIN1 = 176 * MiB, WS_WAOUT1 = 208 * MiB;
constexpr size_t WS_SSQ2 = 2 * MiB;
constexpr size_t WS_HB = 216 * MiB, WS_Z = 282 * MiB;
constexpr size_t WS_XN0 = 348 * MiB;
constexpr size_t WS_QS = 546 * MiB, WS_KP = 612 * MiB, WS_VP = 676 * MiB, WS_KC = 740 * MiB, WS_VC = 806 * MiB, WS_AOA = 872 * MiB;
constexpr size_t WS_KT = 112 * MiB, WS_RG = 282 * MiB, WS_QP = 414 * MiB, WS_KN = 546 * MiB, WS_VS = 612 * MiB, WS_ORET = 900 * MiB;
constexpr size_t WS_GU = 282 * MiB, WS_SG = 414 * MiB, WS_GVT = 546 * MiB, WS_WM = 678 * MiB, WS_SSQ = 744 * MiB, WS_GVS = 752 * MiB;
constexpr size_t WS_GA = 282 * MiB;
constexpr size_t WS_KVX = 184 * MiB;
constexpr size_t WS_TABR = 1040 * MiB, WS_TABA = 1056 * MiB, WS_END = 1060 * MiB;

#define GAS __attribute__((address_space(1)))
#define LAS __attribute__((address_space(3)))
typedef unsigned short bf16;
typedef unsigned v4u __attribute__((ext_vector_type(4)));
typedef unsigned v2u __attribute__((ext_vector_type(2)));
typedef float f32x4 __attribute__((ext_vector_type(4)));
typedef GAS unsigned gu32;
#define RLX_AGENT __ATOMIC_RELAXED, __HIP_MEMORY_SCOPE_AGENT
#define LDS_WAIT() asm volatile("s_waitcnt lgkmcnt(0)" ::: "memory")
#define VM_WAIT() asm volatile("s_waitcnt vmcnt(0)" ::: "memory")
typedef float g_f32x2 __attribute__((ext_vector_type(2))); typedef __bf16 g_bf16x2 __attribute__((ext_vector_type(2)));
__device__ __forceinline__ unsigned pk2(float lo, float hi) { const g_f32x2 v = {lo, hi}; const g_bf16x2 b = __builtin_convertvector(v, g_bf16x2); return __builtin_bit_cast(unsigned, b); }
__device__ __forceinline__ unsigned f2bf(float f) { return pk2(f, 0.f) & 0xffffu; }
__device__ __forceinline__ float bf2f(unsigned short b) { return __builtin_bit_cast(float, (unsigned)b << 16); }
__device__ __forceinline__ float bflo(unsigned w) { return __builtin_bit_cast(float, w << 16); }
__device__ __forceinline__ float bfhi(unsigned w) { return __builtin_bit_cast(float, w & 0xffff0000u); }
__device__ __forceinline__ float silu_f(float x) { return x * __builtin_amdgcn_rcpf(1.f + __builtin_amdgcn_exp2f(-LOG2E * x)); }
__device__ __forceinline__ float gelu_tanh_f(float x) { const float u = (0.7978845608028654f * 2.f * LOG2E) * (x + 0.044715f * x * x * x); return x * __builtin_amdgcn_rcpf(1.f + __builtin_amdgcn_exp2f(-u)); }
__device__ __forceinline__ float wave_sum(float v) {
#pragma unroll
    for (int o = 1; o < 64; o <<= 1) v += __shfl_xor(v, o);
    return v;
}
__device__ __forceinline__ void row_rstd(const float* ssq, int pm, int wr, int fr, int fq, float (&rs)[2][4]) {
#pragma unroll
    for (int ai = 0; ai < 2; ++ai)
#pragma unroll
        for (int m = 0; m < 4; ++m) {
            if (ssq) { const float* p = ssq + ((size_t)pm * 256 + ai * 128 + wr * 64 + m * 16 + fr) * 32 + 8 * fq; const f32x4 a = *(const f32x4*)p, b = *(const f32x4*)(p + 4);
                float t = ((a.x + a.y) + (a.z + a.w)) + ((b.x + b.y) + (b.z + b.w)); t += __shfl_xor(t, 16); t += __shfl_xor(t, 32); rs[ai][m] = 1.f / sqrtf(t * (1.f / 2048.f) + EPS); }
            else rs[ai][m] = 1.f; }
}
#define NT_LOAD(p) __builtin_nontemporal_load(p)
#define NT_STORE(v, p) __builtin_nontemporal_store((v), (p))
__device__ __forceinline__ void rope_cs(int pos, int i, int nf, float& c, float& s) {
    const float inv = exp2f(-(float)i / (float)nf * 13.287712379549449f);
    const double a = (double)pos * (double)inv * 0.15915494309189535;
    const float r = (float)(a - floor(a));
    c = __builtin_amdgcn_cosf(r); s = __builtin_amdgcn_sinf(r);
}

#define XB_TMO      128
#define XB_XCNT(j)  (256  + 64 * (j))
#define XB_XSUB(j)  (1280 + 64 * (j))
#define XB_XGEN(j)  (2304 + 64 * (j))
#define XB_TOP      3328
#define XB_TOPGEN   3392
#define XCD_BAR_WORDS 3456
#define XB_SPIN_CAP (1u << 22)
__device__ __forceinline__ unsigned xb_ld(unsigned* p)              { return __hip_atomic_load(p, __ATOMIC_RELAXED, __HIP_MEMORY_SCOPE_AGENT); }
__device__ __forceinline__ unsigned xb_add(unsigned* p, unsigned v) { return __hip_atomic_fetch_add(p, v, __ATOMIC_RELAXED, __HIP_MEMORY_SCOPE_AGENT); }
__device__ __forceinline__ unsigned xb_xcc_id() { return (unsigned)__builtin_amdgcn_s_getreg((3 << 11) | 20) & 0xFu; }
#define XB_SPIN(cond, bar) do { unsigned _sp = 0; while (cond) { __builtin_amdgcn_s_sleep(1); \
    if ((++_sp & 255u) == 0u) { if (xb_ld(&(bar)[XB_TMO])) break; if (_sp > XB_SPIN_CAP) { atomicAdd(&(bar)[XB_TMO], 1u); break; } } } } while (0)
struct XcdBarrier { unsigned* bar; unsigned x; volatile LAS unsigned* st; };
__device__ __forceinline__ XcdBarrier xcd_barrier_post(unsigned* bar, volatile LAS unsigned* st) {
    XcdBarrier b; b.bar = bar; b.x = xb_xcc_id(); b.st = st;
    if (threadIdx.x == 0) (void)xb_add(&bar[XB_XCNT(b.x)], 1u);
    return b;
}
__device__ __forceinline__ void xcd_barrier_complete(unsigned* bar, unsigned x, unsigned& nloc, unsigned& nx) {
    const unsigned G = gridDim.x * gridDim.y * gridDim.z;
    unsigned sum, cnt, mine, sp = 0u;
    for (;;) {
        sum = 0u; cnt = 0u; mine = 0u;
#pragma unroll
        for (unsigned j = 0; j < 16; ++j) { const unsigned c = xb_ld(&bar[XB_XCNT(j)]); sum += c; cnt += (c > 0u) ? 1u : 0u; mine = (j == x) ? c : mine; }
        if (sum == G) break;
        __builtin_amdgcn_s_sleep(1);
        if ((++sp & 255u) == 0u) { if (xb_ld(&bar[XB_TMO])) break; if (sp > XB_SPIN_CAP) { atomicAdd(&bar[XB_TMO], 1u); break; } }
    }
    nloc = mine > 0u ? mine : 1u; nx = cnt > 0u ? cnt : 1u;
}
__device__ __forceinline__ void xcd_barrier(const XcdBarrier& b, bool leader) {
    asm volatile("s_waitcnt vmcnt(0)" ::: "memory");
    __syncthreads();
    if (leader) {
        unsigned* bar = b.bar;
        __builtin_amdgcn_s_waitcnt(0);
        unsigned nloc = b.st[0], nx = b.st[1];
        if (nloc == 0u) { xcd_barrier_complete(bar, b.x, nloc, nx); b.st[0] = nloc; b.st[1] = nx; }
        const unsigned old = xb_add(&bar[XB_XSUB(b.x)], 1u);
        const unsigned gen = old / nloc;
        if (old + 1u == (gen + 1u) * nloc) {
            __builtin_amdgcn_fence(__ATOMIC_RELEASE, "agent");
            asm volatile("s_waitcnt vmcnt(0)" ::: "memory");
            const unsigned og = xb_add(&bar[XB_TOP], 1u);
            const unsigned tg = og / nx;
            if (og + 1u == (tg + 1u) * nx) xb_add(&bar[XB_TOPGEN], 1u);
            else XB_SPIN(xb_ld(&bar[XB_TOPGEN]) == tg, bar);
            __builtin_amdgcn_fence(__ATOMIC_ACQUIRE, "agent");
            xb_add(&bar[XB_XGEN(b.x)], 1u);
            asm volatile("s_waitcnt vmcnt(0)" ::: "memory");
        } else {
            XB_SPIN(xb_ld(&bar[XB_XGEN(b.x)]) == gen, bar);
            __builtin_amdgcn_fence(__ATOMIC_ACQUIRE, "agent");
            asm volatile("s_waitcnt vmcnt(0)" ::: "memory");
        }
    }
    __syncthreads();
}

constexpr int RING_OFF = 0, RING_BYTES = 139264;
constexpr int MISC_OFF = RING_BYTES;
constexpr int LDS_BYTES = 147456;
struct Args { const float* in[N_IN]; float* out; unsigned char* ws; int ph_lo, ph_hi; };
struct Frame {
    LAS unsigned char* lds; int tid, lane, wave, G, bid;
    const float* const* in; float* out; unsigned char* ws;
};

__device__ __forceinline__ void p0_transpose_item(const float* W, int K, int N, bf16* WT, LAS float* scr, int item, int lane, const float* ksc = nullptr) {
    const int nblk = N / 32, kb = item / nblk, nb = item % nblk, k0 = 64 * kb, n0 = 32 * nb;
#pragma unroll 8
    for (int i = 0; i < 32; ++i) { const int kk = 2 * i + (lane >> 5); const float w_ = NT_LOAD(W + (size_t)(k0 + kk) * N + n0 + (lane & 31)); scr[kk * 33 + (lane & 31)] = ksc ? w_ * ksc[k0 + kk] : w_; }
    LDS_WAIT(); asm volatile("" ::: "memory");
    const int c = lane & 7;
#pragma unroll
    for (int j = 0; j < 4; ++j) { const int n = (lane >> 3) + 8 * j; const LAS float* s = scr + (8 * c) * 33 + n;
        v4u o; o.x = pk2(s[0 * 33], s[1 * 33]); o.y = pk2(s[2 * 33], s[3 * 33]); o.z = pk2(s[4 * 33], s[5 * 33]); o.w = pk2(s[6 * 33], s[7 * 33]);
        *(GAS v4u*)(WT + (size_t)(n0 + n) * K + k0 + 8 * c) = o; }
    LDS_WAIT(); asm volatile("" ::: "memory");
}
__device__ __forceinline__ void transpose_weight(Frame& F, const float* W, int K, int N, bf16* WT) {
    LAS float* scr = (LAS float*)(F.lds + RING_OFF + F.wave * 16384);
    const int gw = F.bid * NWAVES + F.wave, NGW = F.G * NWAVES, nitems = (K / 64) * (N / 32);
    for (int it = gw; it < nitems; it += NGW) p0_transpose_item(W, K, N, WT, scr, it, F.lane);
}
__device__ __forceinline__ void norm_rows(Frame& F, const float* src_p, const float* src_s, const float* w, bf16* XN) {
    const int gw = F.bid * NWAVES + F.wave, NGW = F.G * NWAVES;
    for (int m = gw; m < MT; m += NGW) {
        const float* xrow = (m < MP) ? src_p + (size_t)m * DM : src_s + (size_t)(m - MP) * DM;
        const GAS f32x4* xr = (const GAS f32x4*)xrow + F.lane; const GAS f32x4* wr = (const GAS f32x4*)w + F.lane;
        f32x4 v[8]; float s = 0.f;
#pragma unroll
        for (int j = 0; j < 8; ++j) { v[j] = __builtin_nontemporal_load((const f32x4*)(xrow) + F.lane + 64 * j); s += (v[j].x * v[j].x + v[j].y * v[j].y) + (v[j].z * v[j].z + v[j].w * v[j].w); }
        const float rstd = 1.f / sqrtf(wave_sum(s) * (1.f / DM) + EPS);
        GAS v2u* o8 = (GAS v2u*)(XN + (size_t)m * DM) + F.lane;
#pragma unroll
        for (int j = 0; j < 8; ++j) { const f32x4 g = wr[64 * j]; v2u o; o.x = pk2(v[j].x * rstd * g.x, v[j].y * rstd * g.y); o.y = pk2(v[j].z * rstd * g.z, v[j].w * rstd * g.w); o8[64 * j] = o; }
    }
}
__device__ __forceinline__ void cache_cvt(Frame& F, const float* ck, const float* cv, bf16* KC, bf16* VC) {
    const size_t nvec = (size_t)NB * PAST * DM / 4;
    const size_t gt = (size_t)F.bid * NTHR + F.tid, NG = (size_t)F.G * NTHR;
    for (size_t i = gt; i < 2 * nvec; i += NG) {
        const bool isv = i >= nvec; const size_t e = (isv ? i - nvec : i) * 4;
        const size_t brow = e / DM, col = e % DM, b = brow / PAST, t = brow % PAST;
        const f32x4 x = *(const GAS f32x4*)((isv ? cv : ck) + e);
        v2u o; o.x = pk2(x.x, x.y); o.y = pk2(x.z, x.w);
        *(GAS v2u*)((isv ? VC : KC) + ((b * KCROWS + t) * DM + col)) = o;
    }
}
__device__ __forceinline__ int tw_chunks(int K, int N) { return (K / 64) * (N / 32) / 64; }
__device__ __forceinline__ void tw_run(Frame& F, const float* W, int K, int N, bf16* WT, int c, const float* ksc = nullptr) {
    LAS float* scr = (LAS float*)(F.lds + RING_OFF + F.wave * 16384);
#pragma unroll 1
    for (int i = 0; i < 8; ++i) p0_transpose_item(W, K, N, WT, scr, c * 64 + F.wave * 8 + i, F.lane, ksc);
}
constexpr int CC_CHUNKS = 2 * (NB * PAST * DM / 4) / 8192;
__device__ __forceinline__ void cc_run(Frame& F, const float* ck, const float* cv, bf16* KC, bf16* VC, int c) {
    const size_t nvec = (size_t)NB * PAST * DM / 4;
#pragma unroll 4
    for (int k = 0; k < 16; ++k) { const size_t i = (size_t)c * 8192 + k * NTHR + F.tid;
        const bool isv = i >= nvec; const size_t e = (isv ? i - nvec : i) * 4; const size_t brow = e / DM, col = e % DM, b = brow / PAST, t = brow % PAST;
        const f32x4 x = NT_LOAD((const f32x4*)((isv ? cv : ck) + e)); v2u o; o.x = pk2(x.x, x.y); o.y = pk2(x.z, x.w);
        *(GAS v2u*)((isv ? VC : KC) + ((b * KCROWS + t) * DM + col)) = o; }
}
constexpr int TR_CHUNKS = MP * 128 / 8192;
__device__ __forceinline__ void tr_run(Frame& F, float* tab, int c) {
#pragma unroll 1
    for (int k = 0; k < 16; ++k) { const size_t e = (size_t)c * 8192 + k * NTHR + F.tid; float cs, sn; rope_cs((int)(e >> 7), (int)(e & 127), 128, cs, sn); tab[2 * e] = cs; tab[2 * e + 1] = sn; }
}
__device__ __forceinline__ int row_pos(int row) { return row < MP ? row : PAST + ((row - MP) & 63); }

struct EpiAIn {
    static constexpr int BMODE = 2;
    pg8::bf16_t *Qs, *KP, *VP, *KC, *VC, *GA; float *okp, *ovp, *oks, *ovs; const float* tab; const float* qg; const float* kg; const float* ssq;
    __device__ __forceinline__ void operator()(const pg8::f32x4 (&acc)[2][2][4][2], const pg8::Unit& u, int wr, int wc, int fr, int fq) const {
        { const int l_ = lane_now(); fr = l_ & 15; fq = l_ >> 4; }
        const int pn = u.pn, pm = u.pm, typ = pn >> 3, cl = ((pn & 7) * 4 + wc) * 64 + 8 * fq; float rs[2][4]; row_rstd(ssq, pm, wr, fr, fq, rs);
        float g1[8], g2[8];
        if (typ < 2) { const float* gp = (typ == 0 ? qg : kg) + 8 * fq; const pg8::f32x4 a = *(const pg8::f32x4*)gp, b = *(const pg8::f32x4*)(gp + 4), c = *(const pg8::f32x4*)(gp + 32), d = *(const pg8::f32x4*)(gp + 36);
#pragma unroll
            for (int e = 0; e < 4; ++e) { g1[e] = a[e]; g1[4 + e] = b[e]; g2[e] = c[e]; g2[4 + e] = d[e]; } }
#pragma unroll
        for (int ai = 0; ai < 2; ++ai)
#pragma unroll
          for (int mp = 0; mp < 2; ++mp) {
            pg8::f32x4 tq[4][4];
            if (typ < 2) {
#pragma unroll
                for (int m = 2 * mp; m < 2 * mp + 2; ++m) { const int i_ = ai * 128 + wr * 64 + m * 16 + fr; const int pos_ = pm < 64 ? pm * 256 + i_ : PAST + (i_ & 63); const float* tp_ = tab + ((size_t)pos_ * 32 + 8 * fq) * 2;
#pragma unroll
                    for (int q4 = 0; q4 < 4; ++q4) tq[m][q4] = *(const pg8::f32x4*)(tp_ + 4 * q4); } }
#pragma unroll
            for (int m = 2 * mp; m < 2 * mp + 2; ++m) {
                const int i = ai * 128 + wr * 64 + m * 16 + fr; const size_t row = (size_t)pm * 256 + i;
                float x1[8], x2[8];
#pragma unroll
                for (int e = 0; e < 4; ++e) { x1[e] = acc[ai][0][m][0][e] * rs[ai][m]; x1[4 + e] = acc[ai][0][m][1][e] * rs[ai][m]; x2[e] = acc[ai][1][m][0][e] * rs[ai][m]; x2[4 + e] = acc[ai][1][m][1][e] * rs[ai][m]; }
                size_t drow; pg8::bf16_t* dk; pg8::bf16_t* dv; float* fk; float* fv;
                if (pm < 64) { drow = row; dk = KP; dv = VP; fk = okp + row * DM; fv = ovp + row * DM; }
                else { const int s_ = (int)(row - MP); drow = (size_t)(s_ >> 6) * KCROWS + PAST + (s_ & 63); dk = KC; dv = VC; fk = oks + (size_t)s_ * DM; fv = ovs + (size_t)s_ * DM; }
                if (typ < 2) {
                    float ss = 0.f;
#pragma unroll
                    for (int k = 0; k < 8; ++k) ss += x1[k] * x1[k] + x2[k] * x2[k];
                    ss += __shfl_xor(ss, 16); ss += __shfl_xor(ss, 32);
                    const float rstd = 1.f / sqrtf(ss * (1.f / 64.f) + EPS);
                    float o1[8], o2[8];
#pragma unroll
                    for (int q4 = 0; q4 < 4; ++q4) { const pg8::f32x4 t = tq[m][q4];
#pragma unroll
                        for (int z = 0; z < 2; ++z) { const int k = 2 * q4 + z; const float c = t[2 * z], s = t[2 * z + 1], y1 = x1[k] * rstd * g1[k], y2 = x2[k] * rstd * g2[k]; o1[k] = y1 * c - y2 * s; o2[k] = y2 * c + y1 * s; } }
                    if (typ == 0) { v4u w1, w2;
                        w1.x = pk2(o1[0] * C2, o1[1] * C2); w1.y = pk2(o1[2] * C2, o1[3] * C2); w1.z = pk2(o1[4] * C2, o1[5] * C2); w1.w = pk2(o1[6] * C2, o1[7] * C2);
                        w2.x = pk2(o2[0] * C2, o2[1] * C2); w2.y = pk2(o2[2] * C2, o2[3] * C2); w2.z = pk2(o2[4] * C2, o2[5] * C2); w2.w = pk2(o2[6] * C2, o2[7] * C2);
                        *(v4u*)(Qs + row * DM + cl) = w1; *(v4u*)(Qs + row * DM + cl + 32) = w2;
                    } else { v4u w1, w2;
                        w1.x = pk2(o1[0], o1[1]); w1.y = pk2(o1[2], o1[3]); w1.z = pk2(o1[4], o1[5]); w1.w = pk2(o1[6], o1[7]);
                        w2.x = pk2(o2[0], o2[1]); w2.y = pk2(o2[2], o2[3]); w2.z = pk2(o2[4], o2[5]); w2.w = pk2(o2[6], o2[7]);
                        *(v4u*)(dk + drow * DM + cl) = w1; *(v4u*)(dk + drow * DM + cl + 32) = w2;
                        NT_STORE(((pg8::f32x4){o1[0], o1[1], o1[2], o1[3]}), (pg8::f32x4*)(fk + cl)); NT_STORE(((pg8::f32x4){o1[4], o1[5], o1[6], o1[7]}), (pg8::f32x4*)(fk + cl + 4));
                        NT_STORE(((pg8::f32x4){o2[0], o2[1], o2[2], o2[3]}), (pg8::f32x4*)(fk + cl + 32)); NT_STORE(((pg8::f32x4){o2[4], o2[5], o2[6], o2[7]}), (pg8::f32x4*)(fk + cl + 36)); }
                } else { v4u w1, w2;
                    w1.x = pk2(x1[0], x1[1]); w1.y = pk2(x1[2], x1[3]); w1.z = pk2(x1[4], x1[5]); w1.w = pk2(x1[6], x1[7]);
                    w2.x = pk2(x2[0], x2[1]); w2.y = pk2(x2[2], x2[3]); w2.z = pk2(x2[4], x2[5]); w2.w = pk2(x2[6], x2[7]);
                    if (typ == 2) { *(v4u*)(dv + drow * DM + cl) = w1; *(v4u*)(dv + drow * DM + cl + 32) = w2;
                        NT_STORE(((pg8::f32x4){x1[0], x1[1], x1[2], x1[3]}), (pg8::f32x4*)(fv + cl)); NT_STORE(((pg8::f32x4){x1[4], x1[5], x1[6], x1[7]}), (pg8::f32x4*)(fv + cl + 4));
                        NT_STORE(((pg8::f32x4){x2[0], x2[1], x2[2], x2[3]}), (pg8::f32x4*)(fv + cl + 32)); NT_STORE(((pg8::f32x4){x2[4], x2[5], x2[6], x2[7]}), (pg8::f32x4*)(fv + cl + 36)); }
                    else { *(v4u*)(GA + row * DM + cl) = w1; *(v4u*)(GA + row * DM + cl + 32) = w2; }
                }
                if (m & 1) asm volatile("" ::: "memory");
            }
        }
    }
};
__device__ __forceinline__ void attn_table(Frame& F, float* tab) {
    const size_t gt = (size_t)F.bid * NTHR + F.tid, NG = (size_t)F.G * NTHR;
    for (size_t e = gt; e < (size_t)MP * 32; e += NG) { float c, s; rope_cs((int)(e >> 5), (int)(e & 31), 32, c, s); tab[2 * e] = c; tab[2 * e + 1] = s; }
}
namespace dattn {
typedef short bf16x8 __attribute__((ext_vector_type(8)));
typedef short s16x4 __attribute__((ext_vector_type(4)));
typedef short v4i16_t __attribute__((ext_vector_type(4)));
typedef float f32x16 __attribute__((ext_vector_type(16)));
typedef unsigned u32x4 __attribute__((ext_vector_type(4)));
typedef __attribute__((address_space(3))) const char* lds_cptr;
constexpr int RINGB = 98304, WSF_OFF = RINGB, XCHB = 18432, STP = 144;
__device__ __forceinline__ int crow(int r, int hi) { return (r & 3) + 8 * (r >> 2) + 4 * hi; }
__device__ __forceinline__ void glds16(const void* gsrc, unsigned lds_dst) { unsigned keep;
    asm volatile("s_mov_b32 %0, m0\n\ts_mov_b32 m0, %2\n\ts_nop 0\n\tglobal_load_lds_dwordx4 %1, off\n\ts_mov_b32 m0, %0" : "=&s"(keep) : "v"(gsrc), "s"(lds_dst) : "memory"); }
typedef float f32x2_t __attribute__((ext_vector_type(2))); typedef __bf16 bf16x2_t __attribute__((ext_vector_type(2)));
__device__ __forceinline__ unsigned cvtpk_s(float lo, float hi) { f32x2_t v = {lo, hi}; bf16x2_t b = __builtin_convertvector(v, bf16x2_t); return __builtin_bit_cast(unsigned, b); }
#define DA_WAIT_BAR(N) asm volatile("s_waitcnt vmcnt(" #N ") lgkmcnt(0)\n\ts_barrier" ::: "memory")
__device__ __forceinline__ s16x4 vtr(lds_cptr p) { return __builtin_bit_cast(s16x4, __builtin_amdgcn_ds_read_tr16_b64_v4i16((__attribute__((address_space(3))) v4i16_t*)p)); }
struct Unit { const bf16* Q; const bf16* K; const bf16* V; const bf16* G; bf16* AO; int NT; int full; int dma0; };

constexpr int KSLOT = 16384, VSLOT = 16384, VRING = 3 * KSLOT;
#define DA_SBAR() __builtin_amdgcn_sched_barrier(0)
#define DA_PIN(x) asm volatile("" : "+v"(x))
#define DA_MFMA(a, b, c) __builtin_amdgcn_mfma_f32_32x32x16_bf16(a, b, c, 0, 0, 0)
struct DmaJob { const bf16* kp; const bf16* vp; unsigned kd0, kd1, vd0, vd1; };
__device__ __forceinline__ void dma_piece(const DmaJob& j, int i) { if (i == 0) glds16(j.kp, j.kd0); else if (i == 1) glds16(j.kp + 64, j.kd1); else if (i == 2) glds16(j.vp, j.vd0); else glds16(j.vp + 64, j.vd1); }
template <bool QK, bool PV, int VAR>
__device__ __forceinline__ void step(lds_cptr kpn, lds_cptr vp, const bf16x8 (&qr)[4], bf16x8 (&kf)[8], f32x16 (&o)[4], u32x4 (&pw)[4], float& l_reg, const DmaJob& dj) {
    f32x16 C0 = f32x16{}, C1 = f32x16{};
    s16x4 vlo[4], vhi[4];
    if constexpr (!QK) { dma_piece(dj, 0); dma_piece(dj, 1); dma_piece(dj, 2); dma_piece(dj, 3); }
#define DA_FOFF(f) ((((f) & 3) * 4096) + (((f) >> 2) * 1024))
#pragma unroll
    for (int a = 0; a < 8; ++a) {
        if constexpr (PV) { if (a >= 4) { if (VAR != 4) { vlo[a - 4] = vtr(vp + DA_FOFF(a - 4)); vhi[a - 4] = vtr(vp + DA_FOFF(a - 4) + 512); } else { vlo[a - 4] = s16x4{1, 2, 3, 4}; vhi[a - 4] = s16x4{5, 6, 7, 8}; } DA_SBAR(); } }
        if constexpr (QK) {
            if (a & 1) C1 = (a < 2) ? DA_MFMA(kf[a], qr[a >> 1], f32x16{}) : DA_MFMA(kf[a], qr[a >> 1], C1);
            else       C0 = (a < 2) ? DA_MFMA(kf[a], qr[a >> 1], f32x16{}) : DA_MFMA(kf[a], qr[a >> 1], C0);
            if (a < 4) dma_piece(dj, a);
            DA_SBAR();
        }
    }
    u32x4 pwn[4]; pwn[0] = u32x4{}; pwn[1] = u32x4{}; pwn[2] = u32x4{}; pwn[3] = u32x4{};
    float s0 = 0.f, s1 = 0.f;
#pragma unroll
    for (int p = 0; p < 16; ++p) {
        if constexpr (PV) {
            const bf16x8 vf = (bf16x8){vlo[p & 3][0], vlo[p & 3][1], vlo[p & 3][2], vlo[p & 3][3], vhi[p & 3][0], vhi[p & 3][1], vhi[p & 3][2], vhi[p & 3][3]};
            if (VAR != 3) o[p & 3] = DA_MFMA(__builtin_bit_cast(bf16x8, pw[p >> 2]), vf, o[p & 3]); else { o[p & 3][0] += __builtin_bit_cast(float, (int)vf[0] | ((int)vf[4] << 16)); }
            if (p < 12 && VAR != 4) { vlo[p & 3] = vtr(vp + DA_FOFF(p + 4)); vhi[p & 3] = vtr(vp + DA_FOFF(p + 4) + 512); }
        }
        if constexpr (QK) {
            float e0, e1;
            if (VAR == 2) { if (p < 8) { e0 = C0[2 * p]; e1 = C0[2 * p + 1]; } else { e0 = C1[2 * p - 16]; e1 = C1[2 * p - 15]; } }
            else if (p < 8) { e0 = __builtin_amdgcn_exp2f(C0[2 * p]); e1 = __builtin_amdgcn_exp2f(C0[2 * p + 1]); }
            else       { e0 = __builtin_amdgcn_exp2f(C1[2 * p - 16]); e1 = __builtin_amdgcn_exp2f(C1[2 * p - 15]); }
            s0 += e0; s1 += e1; pwn[p >> 2][p & 3] = cvtpk_s(e0, e1);
            DA_PIN(s0); DA_PIN(s1); DA_PIN(pwn[p >> 2]);
            if (p >= 8 && VAR != 6) { const int j = p - 8; kf[j] = *(const __attribute__((address_space(3))) bf16x8*)(kpn + (j >> 1) * 2048 + (j & 1) * 512); }
        }
        DA_SBAR();
    }
    if constexpr (QK) { l_reg += s0 + s1; pw[0] = pwn[0]; pw[1] = pwn[1]; pw[2] = pwn[2]; pw[3] = pwn[3]; }
#undef DA_FOFF
}

template <bool QK, bool PV>
__device__ __forceinline__ void step2(lds_cptr kpn, lds_cptr vp, const bf16x8 (&qr)[4], bf16x8 (&kf)[8], f32x16 (&o)[4], u32x4 (&pw)[4], float& l_reg, const DmaJob& dj,
                                      f32x16& Cn0, f32x16& Cn1, const f32x16& Pp0, const f32x16& Pp1) {
    s16x4 vlo[4], vhi[4];
#define DA_FOFF(f) ((((f) & 3) * 4096) + (((f) >> 2) * 1024))
    if constexpr (!QK) { dma_piece(dj, 0); dma_piece(dj, 1); dma_piece(dj, 2); dma_piece(dj, 3); }
    float s0 = 0.f, s1 = 0.f;
#pragma unroll
    for (int a = 0; a < 8; ++a) {
        if constexpr (PV) { if (a >= 4) { vlo[a - 4] = vtr(vp + DA_FOFF(a - 4)); vhi[a - 4] = vtr(vp + DA_FOFF(a - 4) + 512); DA_SBAR(); } }
        if constexpr (QK) {
            if (a & 1) Cn1 = (a < 2) ? DA_MFMA(kf[a], qr[a >> 1], f32x16{}) : DA_MFMA(kf[a], qr[a >> 1], Cn1);
            else       Cn0 = (a < 2) ? DA_MFMA(kf[a], qr[a >> 1], f32x16{}) : DA_MFMA(kf[a], qr[a >> 1], Cn0);
            if (a < 4) dma_piece(dj, a);
        }
        if constexpr (PV) {
            float x0, x1, x2, x3;
            if (a < 4) { x0 = Pp0[4 * a]; x1 = Pp0[4 * a + 1]; x2 = Pp0[4 * a + 2]; x3 = Pp0[4 * a + 3]; }
            else       { x0 = Pp1[4 * a - 16]; x1 = Pp1[4 * a - 15]; x2 = Pp1[4 * a - 14]; x3 = Pp1[4 * a - 13]; }
            s0 += x0; s1 += x1; s0 += x2; s1 += x3;
            pw[(2 * a) >> 2][(2 * a) & 3] = cvtpk_s(x0, x1); pw[(2 * a + 1) >> 2][(2 * a + 1) & 3] = cvtpk_s(x2, x3);
            DA_PIN(s0); DA_PIN(s1); DA_PIN(pw[(2 * a) >> 2]);
        }
        if constexpr (QK || PV) DA_SBAR();
    }
    if constexpr (PV) l_reg += s0 + s1;
#pragma unroll
    for (int p = 0; p < 16; ++p) {
        if constexpr (PV) {
            const bf16x8 vf = (bf16x8){vlo[p & 3][0], vlo[p & 3][1], vlo[p & 3][2], vlo[p & 3][3], vhi[p & 3][0], vhi[p & 3][1], vhi[p & 3][2], vhi[p & 3][3]};
            o[p & 3] = DA_MFMA(__builtin_bit_cast(bf16x8, pw[p >> 2]), vf, o[p & 3]);
            if (p < 12) { vlo[p & 3] = vtr(vp + DA_FOFF(p + 4)); vhi[p & 3] = vtr(vp + DA_FOFF(p + 4) + 512); }
        }
        if constexpr (QK) {
            if (p < 8) { Cn0[2 * p] = __builtin_amdgcn_exp2f(Cn0[2 * p]); Cn0[2 * p + 1] = __builtin_amdgcn_exp2f(Cn0[2 * p + 1]); DA_PIN(Cn0); }
            else       { Cn1[2 * p - 16] = __builtin_amdgcn_exp2f(Cn1[2 * p - 16]); Cn1[2 * p - 15] = __builtin_amdgcn_exp2f(Cn1[2 * p - 15]); DA_PIN(Cn1); }
            if (p >= 8) { const int j = p - 8; kf[j] = *(const __attribute__((address_space(3))) bf16x8*)(kpn + (j >> 1) * 2048 + (j & 1) * 512); }
        }
        if constexpr (QK || PV) DA_SBAR();
    }
#undef DA_FOFF
}

__device__ __forceinline__ void unit_prologue(const Unit& u, unsigned lds0, int lane, int wid, bf16x8 (&qr)[4]) {
    const int r32 = lane & 31, hi = lane >> 5, s = wid >> 2, g = wid & 3; const int NT = u.NT; const int wt = u.full ? (g < 2 ? NT - 1 : NT) : (g < 2 ? NT : 0);
    const bf16* ksrc = u.K + (long)lane * DM + wid * 8;
    const bf16* vsrc = u.V + (long)(16 * (wid & 3) + (lane >> 2)) * DM + (wid >> 2) * 32 + (lane & 3) * 8;
    const unsigned kdst = lds0 + wid * 1024, vdst = lds0 + VRING + wid * 1024;
#pragma unroll
    for (int t = 0; t < 3; ++t) { const int tt_ = t < NT ? t : NT - 1; const bf16* kp_ = ksrc + (long)tt_ * 64 * DM;
        glds16(kp_, (unsigned)__builtin_amdgcn_readfirstlane(kdst + t * KSLOT)); glds16(kp_ + 64, (unsigned)__builtin_amdgcn_readfirstlane(kdst + 8192 + t * KSLOT)); }
    glds16(vsrc, (unsigned)__builtin_amdgcn_readfirstlane(vdst)); glds16(vsrc + 64, (unsigned)__builtin_amdgcn_readfirstlane(vdst + 8192));
    const bf16* Qw = u.Q + (long)(32 * g + r32) * DM + s * 64;
#pragma unroll
    for (int d0 = 0; d0 < 4; ++d0) qr[d0] = (wt > 0) ? *reinterpret_cast<const bf16x8*>(Qw + d0 * 16 + hi * 8) : (bf16x8){0, 0, 0, 0, 0, 0, 0, 0};
}
template <int VAR>
__device__ __forceinline__ void attn_unit(const Unit& u, bool has_next, const Unit& nxt, bool prefetched, bf16x8 (&qr)[4], char* shm, float* wsf_base, float lam, float one_m_li, const float* sub_gain, int tid) {
    asm volatile("" : "+v"(tid));
    const int lane = tid & 63, r32 = lane & 31, hi = lane >> 5; const int wid = __builtin_amdgcn_readfirstlane(tid >> 6), s = wid >> 2, g = wid & 3;
    const int NT = u.NT; const int wt = u.full ? (g < 2 ? NT - 1 : NT) : (g < 2 ? NT : 0);
    const unsigned lds0 = (unsigned)(uintptr_t)shm;
    float* wsf = wsf_base + wid * 64;
    const bf16* ksrc = u.K + (long)lane * DM + wid * 8;
    const bf16* vsrc = u.V + (long)(16 * (wid & 3) + (lane >> 2)) * DM + (wid >> 2) * 32 + (lane & 3) * 8;
    const unsigned kdst = lds0 + wid * 1024, vdst = lds0 + VRING + wid * 1024;
#define DA_DMA_K(t, slot) do { const int tt_ = u.dma0 ? 0 : (t) < NT ? (t) : NT - 1; const bf16* kp_ = ksrc + (long)tt_ * 64 * DM; \
        glds16(kp_, (unsigned)__builtin_amdgcn_readfirstlane(kdst + (slot) * KSLOT)); glds16(kp_ + 64, (unsigned)__builtin_amdgcn_readfirstlane(kdst + 8192 + (slot) * KSLOT)); } while (0)
#define DA_DMA_V(t, slot) do { const int tt_ = u.dma0 ? 0 : (t) < NT ? (t) : NT - 1; const bf16* vp_ = vsrc + (long)tt_ * 64 * DM; \
        glds16(vp_, (unsigned)__builtin_amdgcn_readfirstlane(vdst + (slot) * VSLOT)); glds16(vp_ + 64, (unsigned)__builtin_amdgcn_readfirstlane(vdst + 8192 + (slot) * VSLOT)); } while (0)
    const lds_cptr shm3 = (lds_cptr)shm;
    const lds_cptr kp0 = shm3 + s * 8192 + hi * 1024 + r32 * 16;
    const lds_cptr vp0 = shm3 + VRING + ((lane >> 4) & 1) * 32 + (lane & 3) * 8 + (4 * hi + ((lane & 15) >> 2)) * 64;
    if (!prefetched) unit_prologue(u, lds0, lane, wid, qr);
    asm volatile("" : "+v"(qr[0]), "+v"(qr[1]), "+v"(qr[2]), "+v"(qr[3]));
    f32x16 o[4]; o[0] = f32x16{}; o[1] = f32x16{}; o[2] = f32x16{}; o[3] = f32x16{};
    float l_reg = 0.f;
    u32x4 pw[4]; pw[0] = u32x4{}; pw[1] = u32x4{}; pw[2] = u32x4{}; pw[3] = u32x4{};
    DA_WAIT_BAR(0);
    bf16x8 kf[8];
#pragma unroll
    for (int j = 0; j < 8; ++j) kf[j] = *(const __attribute__((address_space(3))) bf16x8*)(kp0 + (j >> 1) * 2048 + (j & 1) * 512);
    int ks_cur = 0  , vs_prev = 2  ;
#define DA_TOP(t) \
        DA_WAIT_BAR(4);                                          \
        const int ks_next = (ks_cur == 2) ? 0 : ks_cur + 1, vs_cur = (vs_prev == 2) ? 0 : vs_prev + 1, vs_next = (vs_cur == 2) ? 0 : vs_cur + 1; \
        DmaJob dj; { const int tk_ = ((t) + 3) < NT ? ((t) + 3) : NT - 1, tv_ = ((t) + 1) < NT ? ((t) + 1) : NT - 1; dj.kp = ksrc + (long)tk_ * 64 * DM; dj.vp = vsrc + (long)tv_ * 64 * DM; \
          dj.kd0 = (unsigned)__builtin_amdgcn_readfirstlane(kdst + ks_cur * KSLOT); dj.kd1 = dj.kd0 + 8192u; dj.vd0 = (unsigned)__builtin_amdgcn_readfirstlane(vdst + vs_next * VSLOT); dj.vd1 = dj.vd0 + 8192u; }     \
        const lds_cptr kpn = kp0 + ks_next * KSLOT; const lds_cptr vp = vp0 + vs_prev * VSLOT; (void)kpn; (void)vp
#define DA_ROT() do { ks_cur = ks_next; vs_prev = vs_cur; } while (0)
    f32x16 pA0 = f32x16{}, pA1 = f32x16{}, pB0 = f32x16{}, pB1 = f32x16{};
#define DA_IDLE() do { dma_piece(dj, 0); dma_piece(dj, 1); dma_piece(dj, 2); dma_piece(dj, 3); } while (0)
    if (wid >= 4) __builtin_amdgcn_s_setprio(1);
    int t = 0;
    const bool odd = ((wt - 1) & 1) != 0;
    { DA_TOP(0); if (wt > 0) { if (odd) step2<true, false>(kpn, vp, qr, kf, o, pw, l_reg, dj, pB0, pB1, pA0, pA1); else step2<true, false>(kpn, vp, qr, kf, o, pw, l_reg, dj, pA0, pA1, pB0, pB1); } else DA_IDLE(); DA_ROT(); }
    t = 1;
    if (wt > 0 && odd) { DA_TOP(t); step2<true, true>(kpn, vp, qr, kf, o, pw, l_reg, dj, pA0, pA1, pB0, pB1); DA_ROT(); ++t; }
    for (; t + 1 < wt; t += 2) {
        { DA_TOP(t);     step2<true, true>(kpn, vp, qr, kf, o, pw, l_reg, dj, pB0, pB1, pA0, pA1); DA_ROT(); }
        { DA_TOP(t + 1); step2<true, true>(kpn, vp, qr, kf, o, pw, l_reg, dj, pA0, pA1, pB0, pB1); DA_ROT(); }
    }
    if (wt > 0) { DA_TOP(t); step2<false, true>(kpn, vp, qr, kf, o, pw, l_reg, dj, pB0, pB1, pA0, pA1); DA_ROT(); ++t; }
    for (; t <= NT; ++t) { DA_TOP(t); DA_IDLE(); DA_ROT(); }
#undef DA_IDLE
#undef DA_TOP
#undef DA_ROT
    __builtin_amdgcn_s_setprio(0);
    { auto rr = __builtin_amdgcn_permlane32_swap(__float_as_uint(l_reg), __float_as_uint(l_reg), false, false); l_reg = __uint_as_float(rr[0]) + __uint_as_float(rr[1]); }
    if (hi == 0) wsf[r32] = l_reg;
    DA_WAIT_BAR(0);
    if (has_next) unit_prologue(nxt, lds0, lane, wid, qr);
    float rli[16];
#pragma unroll
    for (int r = 0; r < 16; ++r) { const float lq = wsf[crow(r, hi)]; rli[r] = (s == 0 ? 1.f : -lam) / lq; }
    int le = lane; asm volatile("" : "+v"(le));
    const int r32e = le & 31, hie = le >> 5;
    float* xch = (float*)(shm + 65536 + g * XCHB);
    if (s == 1 && wt > 0) {
#pragma unroll
        for (int db = 0; db < 4; ++db)
#pragma unroll
            for (int r = 0; r < 16; ++r) xch[(db * 16 + r) * 64 + le] = o[db][r] * rli[r];
    }
    asm volatile("s_waitcnt lgkmcnt(0)\n\ts_barrier" ::: "memory");
    if (s == 0 && wt > 0) {
#pragma unroll
        for (int db = 0; db < 4; ++db)
#pragma unroll
            for (int r = 0; r < 16; ++r) o[db][r] = o[db][r] * rli[r] + xch[(db * 16 + r) * 64 + le];
        asm volatile("s_waitcnt lgkmcnt(0)" ::: "memory");
#pragma unroll
        for (int db = 0; db < 4; ++db)
#pragma unroll
            for (int r = 0; r < 16; ++r) xch[crow(r, hie) * STP + 32 * db + r32e] = o[db][r];
        asm volatile("s_waitcnt lgkmcnt(0)" ::: "memory");
        const int row = le >> 1, half = le & 1;
        float v[64]; float ss = 0.f;
#pragma unroll
        for (int k = 0; k < 16; ++k) { const f32x4 x = *(const f32x4*)(xch + row * STP + half * 64 + 4 * k); v[4 * k] = x.x; v[4 * k + 1] = x.y; v[4 * k + 2] = x.z; v[4 * k + 3] = x.w; ss += (x.x * x.x + x.y * x.y) + (x.z * x.z + x.w * x.w); }
        ss += __shfl_xor(ss, 1);
        const float sc = one_m_li / sqrtf(ss * (1.f / 128.f) + EPS);
        const bf16* gp = u.G + (long)(32 * g + row) * DM + half * 64; bf16* op = u.AO + (long)(32 * g + row) * DM + half * 64; const float* sg = sub_gain + half * 64;
#pragma unroll
        for (int k = 0; k < 8; ++k) { const v4u g4 = *(const v4u*)(gp + 8 * k); const f32x4 ga = *(const f32x4*)(sg + 8 * k), gb = *(const f32x4*)(sg + 8 * k + 4);
            const float gg[8] = {bflo(g4.x), bfhi(g4.x), bflo(g4.y), bfhi(g4.y), bflo(g4.z), bfhi(g4.z), bflo(g4.w), bfhi(g4.w)};
            const float gn[8] = {ga.x, ga.y, ga.z, ga.w, gb.x, gb.y, gb.z, gb.w}; float y[8];
#pragma unroll
            for (int e = 0; e < 8; ++e) y[e] = v[8 * k + e] * sc * gn[e] * silu_f(gg[e]);
            v4u w; w.x = pk2(y[0], y[1]); w.y = pk2(y[2], y[3]); w.z = pk2(y[4], y[5]); w.w = pk2(y[6], y[7]);
            *(v4u*)(op + 8 * k) = w; }
    }
#undef DA_DMA_K
#undef DA_DMA_V
}
}
template <int VAR = 0>
__device__ __forceinline__ void attn_fast(Frame& F, const bf16* Qs, const bf16* KP, const bf16* VP, const bf16* KC, const bf16* VC, const bf16* GA  , bf16* AO,
                                          float lam, float one_m_li, const float* sub_gain, int dma0 = 0) {
    const int NU = 2048 + 16 * NB;
    const bool xcd = (F.G == 256);
#define ATTN_GET(i_, u_, ok_) do { int qb = 0, h = 0, b = -1; ok_ = true; \
        if (xcd) { const int x = F.bid & 7, r = F.bid >> 3; \
            if ((i_) < 8) { h = x + 8 * ((i_) >> 2); const int rr = ((i_) == 0) ? (r ^ 8) : r; qb = 127 - (((i_) & 3) * 32 + (((i_) & 1) ? 31 - rr : rr)); } \
            else if ((i_) == 8 && (r & 8) == 0) { const int sb = (r & 7) + ((r >> 4) << 3); h = x + 8 * (sb >> 3); b = sb & 7; } \
            else ok_ = false; \
        } else { const int idx = (i_) * F.G + (((i_) & 1) ? F.G - 1 - F.bid : F.bid); if (idx >= NU) ok_ = false; \
            else if (idx < 2048) { qb = 127 - (idx >> 4); h = idx & 15; } else { const int j = idx - 2048; b = j >> 4; h = j & 15; } } \
        u_.dma0 = 0; \
        if (ok_) { if (b < 0) { const long row0 = 128L * qb; \
            u_.Q = Qs + row0 * DM + h * 128; u_.K = KP + h * 128; u_.V = VP + h * 128; u_.G = GA + row0 * DM + h * 128; u_.AO = AO + row0 * DM + h * 128; u_.NT = 2 * qb + 2; u_.full = 1; } \
          else { const long row0 = MP + 64L * b; \
            u_.Q = Qs + row0 * DM + h * 128; u_.K = KC + (long)b * KCROWS * DM + h * 128; u_.V = VC + (long)b * KCROWS * DM + h * 128; u_.G = GA + row0 * DM + h * 128; u_.AO = AO + row0 * DM + h * 128; u_.NT = KCROWS / 64; u_.full = 0; } } } while (0)
    dattn::Unit u, nx; bool have; ATTN_GET(0, u, have);
    dattn::bf16x8 qr[4]; bool pre = false;
    float* wsf_base = (float*)((char*)F.lds + MISC_OFF + 1024);
    for (int i = 0; have; ++i) {
        bool hn; ATTN_GET(i + 1, nx, hn);
        dattn::attn_unit<VAR>(u, hn, nx, pre, qr, (char*)F.lds + RING_OFF, wsf_base, lam, one_m_li, sub_gain, F.tid);
        u = nx; have = hn; pre = true;
    }
    __syncthreads();
#undef ATTN_GET
}
constexpr int RBLK = 72;
__device__ __forceinline__ float ret_lg2(int h) { return log2f(1.f - exp2f(-5.f - (float)h)); }
struct EpiRet {
    static constexpr int BMODE = 0;
    pg8::bf16_t* QP; pg8::bf16_t* KN; pg8::bf16_t* KT; pg8::bf16_t* VS; pg8::bf16_t* RG; const float* tab; const float* ssq;
    __device__ __forceinline__ void operator()(const pg8::f32x4 (&acc)[2][2][4][2], const pg8::Unit& u, int wr, int wc, int fr, int fq) const {
        { const int l_ = lane_now(); fr = l_ & 15; fq = l_ >> 4; }
        const int pn = u.pn, pm = u.pm; float rs[2][4]; row_rstd(ssq, pm, wr, fr, fq, rs);
#pragma unroll
        for (int ai = 0; ai < 2; ++ai)
#pragma unroll
            for (int m = 0; m < 4; ++m) {
                const int i = ai * 128 + wr * 64 + m * 16 + fr; const size_t row = (size_t)pm * 256 + i;
                const int J = pm < 64 ? pm : 64 + 4 * (pm - 64) + (i >> 6), jj = pm < 64 ? i : (i & 63), pos = pm < 64 ? (int)row : PAST + (i & 63);
                if (pn < 16) {
                    const int h = pn & 7; const bool isk = pn >= 8; const float sc = isk ? 0.0625f : 1.f;
#pragma unroll
                    for (int n = 0; n < 2; ++n) { const int c1 = wc * 32 + n * 16 + 4 * fq;
                        const pg8::f32x4 t0 = *(const pg8::f32x4*)(tab + ((size_t)pos * 128 + c1) * 2), t1 = *(const pg8::f32x4*)(tab + ((size_t)pos * 128 + c1) * 2 + 4);
                        const pg8::f32x4 x1 = acc[ai][0][m][n] * rs[ai][m], x2 = acc[ai][1][m][n] * rs[ai][m];
                        const float cs[4] = {t0[0], t0[2], t1[0], t1[2]}, sn[4] = {t0[1], t0[3], t1[1], t1[3]}; float o1[4], o2[4];
#pragma unroll
                        for (int e = 0; e < 4; ++e) { o1[e] = (x1[e] * cs[e] - x2[e] * sn[e]) * sc; o2[e] = (x2[e] * cs[e] + x1[e] * sn[e]) * sc; }
                        v2u w1, w2; w1.x = pk2(o1[0], o1[1]); w1.y = pk2(o1[2], o1[3]); w2.x = pk2(o2[0], o2[1]); w2.y = pk2(o2[2], o2[3]);
                        if (!isk) { pg8::bf16_t* p = QP + row * 4096 + h * 512 + 256 + c1; *(v2u*)p = w1; *(v2u*)(p + 128) = w2; }
                        else { pg8::bf16_t* p = KN + row * 2048 + h * 256 + c1; *(v2u*)p = w1; *(v2u*)(p + 128) = w2;
                            pg8::bf16_t* t = KT + ((size_t)(J * 8 + h) * 256 + c1) * 256 + jj;
#pragma unroll
                            for (int e = 0; e < 4; ++e) { t[(size_t)e * 256] = (pg8::bf16_t)f2bf(o1[e]); t[(size_t)(128 + e) * 256] = (pg8::bf16_t)f2bf(o2[e]); } } }
                } else if (pn < 32) {
                    const int h = (pn - 16) >> 1, half = (pn - 16) & 1; const float f = exp2f(-(float)(1 + jj) * ret_lg2(h)) * rs[ai][m];
#pragma unroll
                    for (int bj = 0; bj < 2; ++bj)
#pragma unroll
                        for (int n = 0; n < 2; ++n) { const int dv = half * 256 + bj * 128 + wc * 32 + n * 16 + 4 * fq; pg8::bf16_t* t = VS + ((size_t)(J * 8 + h) * 512 + dv) * 512 + jj;
#pragma unroll
                            for (int e = 0; e < 4; ++e) t[(size_t)e * 512] = (pg8::bf16_t)f2bf(acc[ai][bj][m][n][e] * f); }
                } else {
#pragma unroll
                    for (int bj = 0; bj < 2; ++bj)
#pragma unroll
                        for (int n = 0; n < 2; ++n) { const int c = (pn - 32) * 256 + bj * 128 + wc * 32 + n * 16 + 4 * fq; const pg8::f32x4 x = acc[ai][bj][m][n] * rs[ai][m];
                            v2u w; w.x = pk2(x[0], x[1]); w.y = pk2(x[2], x[3]); *(v2u*)(RG + row * 4096 + c) = w; }
                }
            }
    }
};
__device__ __forceinline__ size_t ret_row0(int J) { return J < 64 ? (size_t)256 * J : (size_t)MP + 64 * (J - 64); }
struct RetQKOrder {
    int G, c; const char* QP; const char* KN;
    __device__ __forceinline__ bool next(int i, pg8::Unit& u) const { const int L = i * G + c; if (L >= RBLK * 8) return false; const int J = L >> 3, h = L & 7; const size_t r0 = ret_row0(J);
        u.pm = J; u.pn = h; u.a = QP + (r0 * 4096 + h * 512 + 256) * 2; u.b = KN + (r0 * 2048 + h * 256) * 2; return true; }
    __device__ __forceinline__ void a_ready(const pg8::Unit&) const {}
    __device__ __forceinline__ void done(const pg8::Unit&) const {}
};
struct EpiRetQK {
    static constexpr int BMODE = 1;
    pg8::bf16_t* QP;
    __device__ __forceinline__ void operator()(const pg8::f32x4 (&acc)[2][2][4][2], const pg8::Unit& u, int wr, int wc, int fr, int fq) const {
        { const int l_ = lane_now(); fr = l_ & 15; fq = l_ >> 4; }
        const int J = u.pm, h = u.pn, nv = J < 64 ? 256 : 64; const size_t r0 = ret_row0(J);
#pragma unroll
        for (int ai = 0; ai < 2; ++ai)
#pragma unroll
            for (int m = 0; m < 4; ++m) { const int i = ai * 128 + wr * 64 + m * 16 + fr;
                if (i < nv) {
#pragma unroll
                    for (int bj = 0; bj < 2; ++bj) { const int j0 = bj * 128 + wc * 32 + 8 * fq; const pg8::f32x4 v0 = acc[ai][bj][m][0], v1 = acc[ai][bj][m][1]; float x[8] = {v0[0], v0[1], v0[2], v0[3], v1[0], v1[1], v1[2], v1[3]};
#pragma unroll
                        for (int k = 0; k < 8; ++k) x[k] = (j0 + k <= i) ? x[k] : 0.f;
                        v4u w; w.x = pk2(x[0], x[1]); w.y = pk2(x[2], x[3]); w.z = pk2(x[4], x[5]); w.w = pk2(x[6], x[7]);
                        *(v4u*)(QP + (r0 + i) * 4096 + h * 512 + j0) = w; } } }
    }
};
struct RetOOrder {
    int G, c; const char* QP; const char* VS;
    __device__ __forceinline__ bool next(int i, pg8::Unit& u) const { const int L = i * G + c; if (L >= RBLK * 16) return false; const int J = L >> 4, r = L & 15, h = r >> 1, half = r & 1; const size_t r0 = ret_row0(J);
        u.pm = J; u.pn = r; u.a = QP + (r0 * 4096 + h * 512) * 2; u.b = VS + (((size_t)(J * 8 + h) * 512 + half * 256) * 512) * 2; return true; }
    __device__ __forceinline__ void a_ready(const pg8::Unit&) const {}
    __device__ __forceinline__ void done(const pg8::Unit&) const {}
};
struct EpiRetO {
    static constexpr int BMODE = 1;
    pg8::bf16_t* O;
    __device__ __forceinline__ void operator()(const pg8::f32x4 (&acc)[2][2][4][2], const pg8::Unit& u, int wr, int wc, int fr, int fq) const {
        { const int l_ = lane_now(); fr = l_ & 15; fq = l_ >> 4; }
        const int J = u.pm, h = u.pn >> 1, half = u.pn & 1, nv = J < 64 ? 256 : 64; const size_t r0 = ret_row0(J); const float lg = ret_lg2(h);
#pragma unroll
        for (int ai = 0; ai < 2; ++ai)
#pragma unroll
            for (int m = 0; m < 4; ++m) { const int i = ai * 128 + wr * 64 + m * 16 + fr;
                if (i < nv) { const float f = exp2f((float)(i + 1) * lg);
#pragma unroll
                    for (int bj = 0; bj < 2; ++bj) { const int j0 = bj * 128 + wc * 32 + 8 * fq; const pg8::f32x4 v0 = acc[ai][bj][m][0] * f, v1 = acc[ai][bj][m][1] * f;
                        v4u w; w.x = pk2(v0[0], v0[1]); w.y = pk2(v0[2], v0[3]); w.z = pk2(v1[0], v1[1]); w.w = pk2(v1[2], v1[3]);
                        *(v4u*)(O + (r0 + i) * 4096 + h * 512 + half * 256 + j0) = w; } } }
    }
};
struct RetKVOrder {
    int G, c; const char* VS; const char* KT;
    __device__ __forceinline__ bool next(int i, pg8::Unit& u) const { const int L = i * G + c; if (L >= RBLK * 16) return false; const int J = L >> 4, r = L & 15, h = r >> 1, half = r & 1;
        u.pm = J; u.pn = r; u.a = VS + (((size_t)(J * 8 + h) * 512 + half * 256) * 512) * 2; u.b = KT + ((size_t)(J * 8 + h) * 256 * 256) * 2; return true; }
    __device__ __forceinline__ void a_ready(const pg8::Unit&) const {}
    __device__ __forceinline__ void done(const pg8::Unit&) const {}
};
struct EpiRetKV {
    static constexpr int BMODE = 1;
    pg8::bf16_t* VS; pg8::bf16_t* KVX;
    __device__ __forceinline__ void operator()(const pg8::f32x4 (&acc)[2][2][4][2], const pg8::Unit& u, int wr, int wc, int fr, int fq) const {
        { const int l_ = lane_now(); fr = l_ & 15; fq = l_ >> 4; }
        const int J = u.pm, h = u.pn >> 1, half = u.pn & 1;
        pg8::bf16_t* base; int pitch;
        if (J < 63) { base = VS + ((size_t)((J + 1) * 8 + h) * 512 + half * 256) * 512 + 256; pitch = 512; }
        else { base = KVX + ((size_t)((J - 63) * 8 + h) * 512 + half * 256) * 256; pitch = 256; }
#pragma unroll
        for (int ai = 0; ai < 2; ++ai)
#pragma unroll
            for (int m = 0; m < 4; ++m) { pg8::bf16_t* rowp = base + (size_t)(ai * 128 + wr * 64 + m * 16 + fr) * pitch + wc * 32 + 8 * fq;
#pragma unroll
                for (int bj = 0; bj < 2; ++bj) { const pg8::f32x4 v0 = acc[ai][bj][m][0], v1 = acc[ai][bj][m][1];
                    v4u w; w.x = pk2(v0[0], v0[1]); w.y = pk2(v0[2], v0[3]); w.z = pk2(v1[0], v1[1]); w.w = pk2(v1[2], v1[3]);
                    *(v4u*)(rowp + bj * 128) = w; } }
    }
};
__device__ __forceinline__ void ret_scan(Frame& F, bf16* VS, const bf16* KVX, const float* state_in, float* osp, float* oss) {
    const int gt = F.bid * NTHR + F.tid;
    for (int c = gt; c < 8 * 512 * 32; c += F.G * NTHR) {
        const int h = c >> 14, dv = (c >> 5) & 511, dk0 = (c & 31) * 8; const float lg = ret_lg2(h), g256 = exp2f(256.f * lg), g64 = exp2f(64.f * lg);
        float S[8];
#pragma unroll
        for (int k = 0; k < 8; ++k) S[k] = 0.f;
        bf16* slot = VS + ((size_t)h * 512 + dv) * 512 + 256 + dk0;
        *(v4u*)slot = (v4u){0u, 0u, 0u, 0u};
        v4u nx = *(const v4u*)(slot + (size_t)8 * 512 * 512);
        for (int J = 1; J < 64; ++J) {
            const v4u kv = nx; bf16* sj = slot + (size_t)J * 8 * 512 * 512;
            if (J < 63) nx = *(const v4u*)(sj + (size_t)8 * 512 * 512);
            const float x[8] = {bflo(kv.x), bfhi(kv.x), bflo(kv.y), bfhi(kv.y), bflo(kv.z), bfhi(kv.z), bflo(kv.w), bfhi(kv.w)};
#pragma unroll
            for (int k = 0; k < 8; ++k) S[k] = (S[k] + x[k]) * g256;
            v4u w; w.x = pk2(S[0], S[1]); w.y = pk2(S[2], S[3]); w.z = pk2(S[4], S[5]); w.w = pk2(S[6], S[7]);
            *(v4u*)sj = w;
        }
        { const v4u kv = *(const v4u*)(KVX + ((size_t)h * 512 + dv) * 256 + dk0);
          const float x[8] = {bflo(kv.x), bfhi(kv.x), bflo(kv.y), bfhi(kv.y), bflo(kv.z), bfhi(kv.z), bflo(kv.w), bfhi(kv.w)};
#pragma unroll
          for (int k = 0; k < 8; ++k) NT_STORE((S[k] + x[k]) * g256, osp + ((size_t)h * 256 + dk0 + k) * 512 + dv); }
    }
    for (int c = gt; c < NB * 8 * 512 * 32; c += F.G * NTHR) {
        const int dv = c & 511, dk0 = ((c >> 9) & 31) * 8, h = (c >> 14) & 7, b = c >> 17; const float g64 = exp2f(64.f * ret_lg2(h));
        const float* si = state_in + (((size_t)b * 8 + h) * 256 + dk0) * 512 + dv; float* so = oss + (((size_t)b * 8 + h) * 256 + dk0) * 512 + dv;
        const v4u kv = *(const v4u*)(KVX + ((size_t)((1 + b) * 8 + h) * 512 + dv) * 256 + dk0);
        const float x[8] = {bflo(kv.x), bfhi(kv.x), bflo(kv.y), bfhi(kv.y), bflo(kv.z), bfhi(kv.z), bflo(kv.w), bfhi(kv.w)}; float s0[8];
#pragma unroll
        for (int k = 0; k < 8; ++k) s0[k] = NT_LOAD(si + (size_t)k * 512);
        v4u w; w.x = pk2(s0[0], s0[1]); w.y = pk2(s0[2], s0[3]); w.z = pk2(s0[4], s0[5]); w.w = pk2(s0[6], s0[7]);
        *(v4u*)(VS + ((size_t)((64 + b) * 8 + h) * 512 + dv) * 512 + 256 + dk0) = w;
#pragma unroll
        for (int k = 0; k < 8; ++k) NT_STORE((s0[k] + x[k]) * g64, so + (size_t)k * 512);
    }
}
__device__ __forceinline__ void ret_zero_pad(Frame& F, bf16* VS, bf16* KT) {
    const size_t gt = (size_t)F.bid * NTHR + F.tid, NG = (size_t)F.G * NTHR, n = (size_t)NB * 8 * 512 * 24, n2 = (size_t)NB * 8 * 256 * 24;
    for (size_t i = gt; i < n; i += NG) { const size_t rowi = i / 24, c = i % 24; *(v4u*)(VS + ((size_t)64 * 8 * 512 + rowi) * 512 + 64 + c * 8) = (v4u){0u, 0u, 0u, 0u}; }
    for (size_t i = gt; i < n2; i += NG) { const size_t rowi = i / 24, c = i % 24; *(v4u*)(KT + ((size_t)64 * 8 * 256 + rowi) * 256 + 64 + c * 8) = (v4u){0u, 0u, 0u, 0u}; }
}
__device__ __forceinline__ void ret_table(Frame& F, float* tab) {
    const size_t gt = (size_t)F.bid * NTHR + F.tid, NG = (size_t)F.G * NTHR;
    for (size_t e = gt; e < (size_t)MP * 128; e += NG) { float c, s; rope_cs((int)(e >> 7), (int)(e & 127), 128, c, s); tab[2 * e] = c; tab[2 * e + 1] = s; }
}
__device__ __forceinline__ void r_out(Frame& F, bf16* O, const bf16* RG) {
    const int gw = F.bid * NWAVES + F.wave, NGW = F.G * NWAVES, lane = F.lane;
    for (int it = gw; it < MT * 8; it += NGW) {
        const int row = it >> 3, h = it & 7; const size_t off = (size_t)row * 4096 + h * 512 + lane * 8;
        const v4u o4 = *(const v4u*)(O + off), g4 = NT_LOAD((const v4u*)(RG + off));
        float o[8] = {bflo(o4.x), bfhi(o4.x), bflo(o4.y), bfhi(o4.y), bflo(o4.z), bfhi(o4.z), bflo(o4.w), bfhi(o4.w)};
        const float g[8] = {bflo(g4.x), bfhi(g4.x), bflo(g4.y), bfhi(g4.y), bflo(g4.z), bfhi(g4.z), bflo(g4.w), bfhi(g4.w)};
        float ss = 0.f;
#pragma unroll
        for (int k = 0; k < 8; ++k) ss += o[k] * o[k];
        const float rstd = 1.f / sqrtf(wave_sum(ss) * (1.f / 512.f) + EPS);
#pragma unroll
        for (int k = 0; k < 8; ++k) o[k] = o[k] * rstd * silu_f(g[k]);
        v4u w; w.x = pk2(o[0], o[1]); w.y = pk2(o[2], o[3]); w.z = pk2(o[4], o[5]); w.w = pk2(o[6], o[7]);
        *(v4u*)(O + off) = w;
    }
}
struct EpiCIn {
    static constexpr int BMODE = 0;
    pg8::bf16_t* GU; pg8::bf16_t* GVT; pg8::bf16_t* SG; pg8::bf16_t* GVS; float* SSQ; const float* ssq;
    __device__ __forceinline__ void operator()(const pg8::f32x4 (&acc)[2][2][4][2], const pg8::Unit& u, int wr, int wc, int fr, int fq) const {
        { const int l_ = lane_now(); fr = l_ & 15; fq = l_ >> 4; }
        const int pn = u.pn, pm = u.pm, typ = pn >> 4, pt = pn & 15; float rs[2][4]; row_rstd(ssq, pm, wr, fr, fq, rs);
#pragma unroll
        for (int ai = 0; ai < 2; ++ai)
#pragma unroll
            for (int m = 0; m < 4; ++m) {
                const int i = ai * 128 + wr * 64 + m * 16 + fr; const size_t row = (size_t)pm * 256 + i; float ss = 0.f;
#pragma unroll
                for (int bj = 0; bj < 2; ++bj)
#pragma unroll
                    for (int n = 0; n < 2; ++n) { const int c = pt * 256 + bj * 128 + wc * 32 + n * 16 + 4 * fq; const pg8::f32x4 x = acc[ai][bj][m][n] * rs[ai][m]; float y[4];
                        if (typ == 2) {
#pragma unroll
                            for (int e = 0; e < 4; ++e) y[e] = silu_f(x[e]);
                            v2u w; w.x = pk2(y[0], y[1]); w.y = pk2(y[2], y[3]); *(v2u*)(SG + row * 4096 + c) = w;
                        } else {
#pragma unroll
                            for (int e = 0; e < 4; ++e) y[e] = gelu_tanh_f(x[e]);
                            v2u w; w.x = pk2(y[0], y[1]); w.y = pk2(y[2], y[3]);
                            if (typ == 0) *(v2u*)(GU + row * 4096 + c) = w;
                            else { ss += (y[0] * y[0] + y[1] * y[1]) + (y[2] * y[2] + y[3] * y[3]);
                                pg8::bf16_t* t = GVT + ((size_t)pm * 4096 + c) * 256 + i;
                                t[0] = (pg8::bf16_t)(w.x & 0xffffu); t[256] = (pg8::bf16_t)(w.x >> 16); t[512] = (pg8::bf16_t)(w.y & 0xffffu); t[768] = (pg8::bf16_t)(w.y >> 16);
                                if (pm >= 64) *(v2u*)(GVS + (row - MP) * 4096 + c) = w; } } }
                if (typ == 1) { ss += __shfl_xor(ss, 16); ss += __shfl_xor(ss, 32); if (fq == 0) SSQ[row * 64 + pt * 4 + wc] = ss; }
                if (m & 1) asm volatile("" ::: "memory");
            }
    }
};
__device__ __forceinline__ void c_prep(Frame& F, const float* SSQ, const float* wsin, const float* vgain, const bf16* GVS, bf16* Wm, float* ovm) {
    LAS float* rs = (LAS float*)(F.lds + RING_OFF);
    const int tid = F.tid;
    for (int it = F.bid; it < 66 * 8; it += F.G) {
        const int J = it >> 3, g = it & 7;
        __syncthreads();
        if (tid < 256) { const float* p = SSQ + ((size_t)J * 256 + tid) * 64; float s = 0.f;
#pragma unroll
            for (int k = 0; k < 16; ++k) { const f32x4 x = *(const f32x4*)(p + 4 * k); s += (x.x + x.y) + (x.z + x.w); }
            rs[tid] = 1.f / sqrtf(s * (1.f / 4096.f) + EPS); }
        __syncthreads();
        bf16* wm = Wm + (size_t)(J * 8 + g) * 65536; const int sh = J < 64 ? 7 : 6, cm = (1 << sh) - 1;
        for (int e8 = tid; e8 < 8192; e8 += NTHR) { const int i = e8 >> 5, j0 = (e8 & 31) * 8, il = i & cm, jl0 = j0 & cm; float y[8];
            if ((i >> sh) == (j0 >> sh) && jl0 <= il) { const float* wr_ = wsin + ((size_t)g * 128 + il) * 128 + jl0; const f32x4 a = *(const f32x4*)wr_, b = *(const f32x4*)(wr_ + 4);
                const float wv[8] = {a.x, a.y, a.z, a.w, b.x, b.y, b.z, b.w};
#pragma unroll
                for (int k = 0; k < 8; ++k) y[k] = (jl0 + k <= il) ? wv[k] * rs[j0 + k] : 0.f;
            } else {
#pragma unroll
                for (int k = 0; k < 8; ++k) y[k] = 0.f; }
            v4u w; w.x = pk2(y[0], y[1]); w.y = pk2(y[2], y[3]); w.z = pk2(y[4], y[5]); w.w = pk2(y[6], y[7]);
            *(v4u*)(wm + i * 256 + j0) = w; }
    }
    const int gw = F.bid * NWAVES + F.wave, NGW = F.G * NWAVES, lane = F.lane;
    for (int r = gw; r < MS; r += NGW) {
        const float rstd = 1.f / sqrtf(wave_sum(SSQ[((size_t)MP + r) * 64 + lane]) * (1.f / 4096.f) + EPS);
#pragma unroll
        for (int k = 0; k < 8; ++k) { const int col = k * 512 + lane * 8; const v4u v4 = *(const v4u*)(GVS + (size_t)r * 4096 + col);
            const f32x4 ga = *(const f32x4*)(vgain + col), gb = *(const f32x4*)(vgain + col + 4);
            float* o = ovm + (size_t)r * 4096 + col;
            *(f32x4*)o = (f32x4){bflo(v4.x) * rstd * ga.x, bfhi(v4.x) * rstd * ga.y, bflo(v4.y) * rstd * ga.z, bfhi(v4.y) * rstd * ga.w};
            *(f32x4*)(o + 4) = (f32x4){bflo(v4.z) * rstd * gb.x, bfhi(v4.z) * rstd * gb.y, bflo(v4.w) * rstd * gb.z, bfhi(v4.w) * rstd * gb.w}; }
    }
}
struct CMixOrder {
    int G, c; const char* Wm; const char* GVT;
    __device__ __forceinline__ bool next(int i, pg8::Unit& u) const { const int L = i * G + c; if (L >= 66 * 16) return false; const int J = L >> 4, nt = L & 15;
        u.pm = J; u.pn = nt; u.a = Wm + ((size_t)(J * 8 + (nt >> 1)) * 65536) * 2; u.b = GVT + (((size_t)J * 4096 + nt * 256) * 256) * 2; return true; }
    __device__ __forceinline__ void a_ready(const pg8::Unit&) const {}
    __device__ __forceinline__ void done(const pg8::Unit&) const {}
};
struct EpiCMix {
    static constexpr int BMODE = 1;
    pg8::bf16_t* GU; const pg8::bf16_t* SG; const float* vgain; const float* bs;
    __device__ __forceinline__ void operator()(const pg8::f32x4 (&acc)[2][2][4][2], const pg8::Unit& u, int wr, int wc, int fr, int fq) const {
        { const int l_ = lane_now(); fr = l_ & 15; fq = l_ >> 4; }
        const int J = u.pm, nt = u.pn, g = nt >> 1, cm = J < 64 ? 127 : 63;
#pragma unroll
        for (int bj = 0; bj < 2; ++bj) { const int c0 = nt * 256 + bj * 128 + wc * 32 + 8 * fq; const f32x4 ga = *(const f32x4*)(vgain + c0), gb = *(const f32x4*)(vgain + c0 + 4);
            const float gn[8] = {ga.x, ga.y, ga.z, ga.w, gb.x, gb.y, gb.z, gb.w};
#pragma unroll
            for (int ai = 0; ai < 2; ++ai)
#pragma unroll
                for (int m = 0; m < 4; ++m) { const int i = ai * 128 + wr * 64 + m * 16 + fr; const size_t off = ((size_t)J * 256 + i) * 4096 + c0; const float b = bs[g * 128 + (i & cm)];
                    const v4u u4 = *(const v4u*)(GU + off), s4 = NT_LOAD((const v4u*)(SG + off)); const pg8::f32x4 v0 = acc[ai][bj][m][0], v1 = acc[ai][bj][m][1];
                    const float mx[8] = {v0[0], v0[1], v0[2], v0[3], v1[0], v1[1], v1[2], v1[3]};
                    const float uu[8] = {bflo(u4.x), bfhi(u4.x), bflo(u4.y), bfhi(u4.y), bflo(u4.z), bfhi(u4.z), bflo(u4.w), bfhi(u4.w)};
                    const float sg[8] = {bflo(s4.x), bfhi(s4.x), bflo(s4.y), bfhi(s4.y), bflo(s4.z), bfhi(s4.z), bflo(s4.w), bfhi(s4.w)}; float y[8];
#pragma unroll
                    for (int k = 0; k < 8; ++k) y[k] = uu[k] * (mx[k] * gn[k] + b) * sg[k];
                    v4u w; w.x = pk2(y[0], y[1]); w.y = pk2(y[2], y[3]); w.z = pk2(y[4], y[5]); w.w = pk2(y[6], y[7]);
                    *(v4u*)(GU + off) = w; } }
    }
};
__device__ __forceinline__ float diff_lambda(const float* q1, const float* k1, const float* q2, const float* k2, float lam_init) {
    float a = 0.f, b = 0.f;
    for (int i = 0; i < 64; ++i) { a += q1[i] * k1[i]; b += q2[i] * k2[i]; }
    return expf(a) - expf(b) + lam_init;
}

constexpr int N_PHASES = 21;
__global__ void __launch_bounds__(NTHR, 2) mega(Args args) {
    extern __shared__ __attribute__((aligned(16))) unsigned char lds[];
    Frame F;
    F.lds = (LAS unsigned char*)lds; F.tid = threadIdx.x; F.lane = F.tid & 63; F.wave = __builtin_amdgcn_readfirstlane(F.tid >> 6); F.G = gridDim.x; F.bid = blockIdx.x;
    F.in = args.in; F.out = args.out; F.ws = args.ws;
    unsigned char* ws = args.ws; float* out = args.out;
    bf16* W_AIN[2] = {(bf16*)(ws + WS_WAIN0), (bf16*)(ws + WS_WAIN1)}; bf16* W_AOUT[2] = {(bf16*)(ws + WS_WAOUT0), (bf16*)(ws + WS_WAOUT1)};
    bf16* W_RIN = (bf16*)(ws + WS_WRIN); bf16* W_ROUT = (bf16*)(ws + WS_WROUT); bf16* W_CIN = (bf16*)(ws + WS_WCIN); bf16* W_COUT = (bf16*)(ws + WS_WCOUT);
    bf16* XN0 = (bf16*)(ws + WS_XN0); bf16* HB = (bf16*)(ws + WS_HB); float* SSQ2 = (float*)(ws + WS_SSQ2);
    bf16* Qs = (bf16*)(ws + WS_QS); bf16* KP = (bf16*)(ws + WS_KP); bf16* VP = (bf16*)(ws + WS_VP); bf16* KC = (bf16*)(ws + WS_KC); bf16* VC = (bf16*)(ws + WS_VC); bf16* AO_A = (bf16*)(ws + WS_AOA);
    bf16* KT = (bf16*)(ws + WS_KT); bf16* RG = (bf16*)(ws + WS_RG); bf16* QP = (bf16*)(ws + WS_QP); bf16* KN = (bf16*)(ws + WS_KN); bf16* VS = (bf16*)(ws + WS_VS); bf16* ORET = (bf16*)(ws + WS_ORET);
    bf16* GU = (bf16*)(ws + WS_GU); bf16* SG = (bf16*)(ws + WS_SG); bf16* GVT = (bf16*)(ws + WS_GVT); bf16* WM = (bf16*)(ws + WS_WM); float* SSQ = (float*)(ws + WS_SSQ); bf16* GVS = (bf16*)(ws + WS_GVS); float* TABR = (float*)(ws + WS_TABR); bf16* KVX = (bf16*)(ws + WS_KVX); float* TABA = (float*)(ws + WS_TABA); bf16* GA = (bf16*)(ws + WS_GA);
    const int lo = args.ph_lo, hi = args.ph_hi;
    volatile LAS unsigned* MISC = (volatile LAS unsigned*)(F.lds + MISC_OFF);
    for (int u = F.tid; u < (LDS_BYTES - MISC_OFF) / 4; u += NTHR) ((LAS unsigned*)(F.lds + MISC_OFF))[u] = 0u;
    __syncthreads();
    XcdBarrier bar = xcd_barrier_post((unsigned*)(ws + WS_CTL) + 4096, MISC + 8);
#define IN(k) (lo <= (k) && (k) < hi)
#define PH_ENTER() do { int t_ = F.wave * 64 + lane_now(); F.tid = t_; F.lane = t_ & 63; } while (0)
    volatile LAS int* DRW = (volatile LAS int*)(F.lds + MISC_OFF + 64);
    unsigned* DCTR = (unsigned*)(ws + WS_CTL) + 8192;
#define DRAIN(ph, total, BODY) do { PH_ENTER(); for (;;) { __syncthreads(); if (F.tid == 0) DRW[0] = (int)atomicAdd(DCTR + 64 * (ph), 1u); __syncthreads(); const int c_ = DRW[0]; if (c_ >= (total)) break; BODY } } while (0)
#define SEAM(k) do { if (IN(k) && IN((k) + 1)) xcd_barrier(bar, F.wave == 0 && lane_now() == 0); } while (0)

#define GEMM_STORE(Aptr, Wptr, NN, KK, Optr) do { pg8::GemmP g{KK, KK, (KK) / 64}; pg8::StaticOrder S; S.init(MT / 256, (NN) / 256, F.G, F.bid, Aptr, Wptr, KK, KK); pg8::EpiStoreBf16 E{(pg8::bf16_t*)(Optr), NN}; \
        pg8::gemm_phase<pg8::EpiStoreBf16, pg8::StaticOrder>(F.lds + RING_OFF, g, S, E, F.tid); } while (0)
#define GEMM_RESIDB(MODE_, Aptr, Wptr, KK) do { pg8::GemmP g{KK, KK, (KK) / 64}; pg8::StaticOrder S; S.init(MT / 256, DM / 256, F.G, F.bid, Aptr, Wptr, KK, KK); \
        pg8::EpiResidB<MODE_> E{args.in[I_XP], args.in[I_XS], (pg8::bf16_t*)HB, out, SSQ2}; pg8::gemm_phase<pg8::EpiResidB<MODE_>, pg8::StaticOrder>(F.lds + RING_OFF, g, S, E, F.tid); } while (0)

    PH_ENTER(); if (IN(0)) {
        transpose_weight(F, args.in[I_AWIN], 2048, 8192, W_AIN[0]); attn_table(F, TABA);
        norm_rows(F, args.in[I_XP], args.in[I_XS], args.in[I_NW], XN0);
    }
    SEAM(0);
#define GEMM_AIN(Aptr, Wptr, J_, SSQP) do { pg8::GemmP g{2048, 2048, 32}; pg8::StaticOrder S; S.init(MT / 256, 32, F.G, F.bid, Aptr, Wptr, 2048, 2048); \
        EpiAIn E{Qs, KP, VP, KC, VC, GA, out + O_KP + (size_t)(J_) * MP * DM, out + O_VP + (size_t)(J_) * MP * DM, out + O_KS + (size_t)(J_) * MS * DM, out + O_VS + (size_t)(J_) * MS * DM, TABA, args.in[I_AQG] + 64 * (J_), args.in[I_AKG] + 64 * (J_), SSQP}; \
        pg8::gemm_phase<EpiAIn, pg8::StaticOrder>(F.lds + RING_OFF, g, S, E, F.tid); } while (0)
    PH_ENTER(); if (IN(1)) { GEMM_AIN(XN0, W_AIN[0], 0, (const float*)nullptr);
        const int n0 = CC_CHUNKS, n1 = n0 + tw_chunks(2048, 2048), n2 = n1 + TR_CHUNKS;
        DRAIN(1, n2, if (c_ < n0) cc_run(F, args.in[I_CK], args.in[I_CV], KC, VC, c_); else if (c_ < n1) tw_run(F, args.in[I_AWOUT], 2048, 2048, W_AOUT[0], c_ - n0); else tr_run(F, TABR, c_ - n1);); }
    SEAM(1);
    PH_ENTER(); if (IN(3)) { const float li = 0.8f - 0.6f * expf(-0.3f * 0.f); const float lam = diff_lambda(args.in[I_LQ1], args.in[I_LK1], args.in[I_LQ2], args.in[I_LK2], li);
        attn_fast(F, Qs, KP, VP, KC, VC, GA, AO_A, lam, 1.f - li, args.in[I_ASG]); }
    SEAM(3);
    PH_ENTER(); if (IN(4)) { GEMM_RESIDB(0, AO_A, W_AOUT[0], 2048);
        const int n0 = tw_chunks(2048, 12288), n1 = n0 + tw_chunks(4096, 2048);
        DRAIN(4, n1, if (c_ < n0) tw_run(F, args.in[I_RWIN], 2048, 12288, W_RIN, c_, args.in[I_NW] + DM); else tw_run(F, args.in[I_RWOUT], 4096, 2048, W_ROUT, c_ - n0);); }
    if (IN(4) && IN(6)) xcd_barrier(bar, F.wave == 0 && lane_now() == 0);
    PH_ENTER(); if (IN(6)) { ret_zero_pad(F, VS, KT);
        PH_ENTER(); pg8::GemmP g{2048, 2048, 32}; pg8::StaticOrder S; S.init(MT / 256, 48, F.G, F.bid, HB, W_RIN, 2048, 2048); EpiRet E{QP, KN, KT, VS, RG, TABR, SSQ2};
        pg8::gemm_phase<EpiRet, pg8::StaticOrder>(F.lds + RING_OFF, g, S, E, F.tid); }
    SEAM(6);
    PH_ENTER(); if (IN(7)) { { pg8::GemmP g{4096, 2048, 4}; RetQKOrder S{F.G, F.bid, (const char*)QP, (const char*)KN}; EpiRetQK E{QP}; pg8::gemm_phase<EpiRetQK, RetQKOrder>(F.lds + RING_OFF, g, S, E, F.tid); }
        PH_ENTER(); { pg8::GemmP g{512, 256, 4}; RetKVOrder S{F.G, F.bid, (const char*)VS, (const char*)KT}; EpiRetKV E{VS, KVX}; pg8::gemm_phase<EpiRetKV, RetKVOrder>(F.lds + RING_OFF, g, S, E, F.tid); }
        xcd_barrier(bar, F.wave == 0 && lane_now() == 0);
        PH_ENTER(); ret_scan(F, VS, KVX, args.in[I_SR], out + O_SP, out + O_SS); }
    SEAM(7);
    PH_ENTER(); if (IN(8)) { pg8::GemmP g{4096, 512, 8}; RetOOrder S{F.G, F.bid, (const char*)QP, (const char*)VS}; EpiRetO E{ORET}; pg8::gemm_phase<EpiRetO, RetOOrder>(F.lds + RING_OFF, g, S, E, F.tid); }
    SEAM(8);
    PH_ENTER(); if (IN(9)) r_out(F, ORET, RG);
    SEAM(9);
    PH_ENTER(); if (IN(10)) { GEMM_RESIDB(1, ORET, W_ROUT, 4096);
        const int n0 = tw_chunks(2048, 12288), n1 = n0 + tw_chunks(4096, 2048), n2 = n1 + tw_chunks(2048, 8192), n3 = n2 + tw_chunks(2048, 2048);
        DRAIN(10, n3, if (c_ < n0) tw_run(F, args.in[I_CWIN], 2048, 12288, W_CIN, c_, args.in[I_NW] + 2 * DM); else if (c_ < n1) tw_run(F, args.in[I_CWOUT], 4096, 2048, W_COUT, c_ - n0);
                      else if (c_ < n2) tw_run(F, args.in[I_AWIN] + (size_t)2048 * 8192, 2048, 8192, W_AIN[1], c_ - n1, args.in[I_NW] + 3 * DM); else tw_run(F, args.in[I_AWOUT] + (size_t)2048 * 2048, 2048, 2048, W_AOUT[1], c_ - n2);); }
    if (IN(10) && IN(12)) xcd_barrier(bar, F.wave == 0 && lane_now() == 0);
    PH_ENTER(); if (IN(12)) { pg8::GemmP g{2048, 2048, 32}; pg8::StaticOrder S; S.init(MT / 256, 48, F.G, F.bid, HB, W_CIN, 2048, 2048); EpiCIn E{GU, GVT, SG, GVS, SSQ, SSQ2};
        pg8::gemm_phase<EpiCIn, pg8::StaticOrder>(F.lds + RING_OFF, g, S, E, F.tid); }
    SEAM(12);
    PH_ENTER(); if (IN(13)) c_prep(F, SSQ, args.in[I_CWS], args.in[I_CVG], GVS, WM, out + O_VM);
    SEAM(13);
    PH_ENTER(); if (IN(14)) { pg8::GemmP g{256, 256, 4}; CMixOrder S{F.G, F.bid, (const char*)WM, (const char*)GVT}; EpiCMix E{GU, SG, args.in[I_CVG], args.in[I_CBS]}; pg8::gemm_phase<EpiCMix, CMixOrder>(F.lds + RING_OFF, g, S, E, F.tid); }
    SEAM(14);
    PH_ENTER(); if (IN(15)) { GEMM_RESIDB(1, GU, W_COUT, 4096);
        DRAIN(15, CC_CHUNKS, cc_run(F, args.in[I_CK] + (size_t)NB * PAST * DM, args.in[I_CV] + (size_t)NB * PAST * DM, KC, VC, c_);); }
    if (IN(15) && IN(17)) xcd_barrier(bar, F.wave == 0 && lane_now() == 0);
    PH_ENTER(); if (IN(17)) GEMM_AIN(HB, W_AIN[1], 1, (const float*)SSQ2);
    SEAM(17);
    PH_ENTER(); if (IN(19)) { const float li = 0.8f - 0.6f * expf(-0.3f * 3.f); const float lam = diff_lambda(args.in[I_LQ1] + 64, args.in[I_LK1] + 64, args.in[I_LQ2] + 64, args.in[I_LK2] + 64, li);
        attn_fast(F, Qs, KP, VP, KC, VC, GA, AO_A, lam, 1.f - li, args.in[I_ASG] + 128); }
    SEAM(19);
    PH_ENTER(); if (IN(20)) GEMM_RESIDB(2, AO_A, W_AOUT[1], 2048);
#undef IN
#undef SEAM
}

extern "C" void kernel_launch(void* const* d_in, const int* in_sizes, int n_in, void* d_out, int out_size, void* d_ws, size_t ws_size, hipStream_t stream) {
    static int grid = 0;
    if (grid == 0) {
        if (n_in != N_IN || (size_t)out_size != O_END || ws_size < WS_END) { fprintf(stderr, "kernel_launch: unexpected shapes: n_in %d out %d ws %zu (need %zu)\n", n_in, out_size, ws_size, (size_t)WS_END); grid = -1; return; }
        int dev = 0, cus = 0;
        if (hipGetDevice(&dev) != hipSuccess || hipDeviceGetAttribute(&cus, hipDeviceAttributeMultiprocessorCount, dev) != hipSuccess) { grid = -1; return; }
        if (hipFuncSetAttribute((const void*)mega, hipFuncAttributeMaxDynamicSharedMemorySize, LDS_BYTES) != hipSuccess) { fprintf(stderr, "kernel_launch: hipFuncSetAttribute failed\n"); grid = -1; return; }
        (void)hipGetLastError();
        grid = cus;
    }
    if (grid < 0) return;
    Args a{};
    for (int i = 0; i < N_IN; ++i) a.in[i] = (const float*)d_in[i];
    a.out = (float*)d_out; a.ws = (unsigned char*)d_ws;
    (void)hipMemsetAsync((char*)d_ws + WS_CTL, 0, CTL_ZERO_BYTES, stream);
    a.ph_lo = 0; a.ph_hi = N_PHASES;
    hipLaunchKernelGGL(mega, dim3(grid), dim3(NTHR), LDS_BYTES, stream, a);
}
```

```cpp
#include <hip/hip_runtime.h>
#include <cstdio>
#include <cstdint>

__device__ __forceinline__ int lane_now() { int l; asm volatile("v_mbcnt_lo_u32_b32 %0, -1, 0\n\tv_mbcnt_hi_u32_b32 %0, -1, %0" : "=v"(l)); return l; }
namespace pg8 {
#define PG8_LAS __attribute__((address_space(3)))
typedef unsigned short bf16_t;
typedef short bf16x8 __attribute__((ext_vector_type(8)));
typedef float f32x4 __attribute__((ext_vector_type(4)));
typedef unsigned u32x4 __attribute__((ext_vector_type(4)));
constexpr int BM = 256, BK = 64, HALF = 128, HTB = HALF * BK * 2, STAGE_BYTES = 8 * HTB, NXCD = 8, WGM = 4;

__host__ __device__ __forceinline__ int lds_byte(int r, int c) { const int st = (r >> 4) * 2 + (c >> 5), rr = r & 15, cc = c & 31, ob = rr * 64 + cc * 2; return st * 1024 + (ob ^ (((ob >> 9) & 1) << 5)); }
__host__ __device__ __forceinline__ void stage_rc(int b, int& R, int& C) { const int st = b / 1024, sb = b % 1024, swz = sb ^ (((sb >> 9) & 1) << 5); R = (st >> 1) * 16 + swz / 64; C = (st & 1) * 32 + (swz % 64) / 2; }
__host__ __device__ __forceinline__ int perm32(int rho) { const int n = rho >> 4, i = rho & 15; return 8 * (i >> 2) + 4 * n + (i & 3); }

struct Unit { int pm, pn; const char* a; const char* b; };
struct GemmP { int lda, ldb, nt; };

struct StaticOrder {
    int nM, nN, nwg, G, c; const char* A; const char* B; size_t ta, tb;
    __host__ __device__ void init(int nM_, int nN_, int G_, int c_, const void* A_, const void* B_, int lda, int ldb) { nM = nM_; nN = nN_; nwg = nM * nN; G = G_; c = c_; A = (const char*)A_; B = (const char*)B_; ta = (size_t)BM * lda * 2; tb = (size_t)BM * ldb * 2; }
    __host__ __device__ bool next(int i, Unit& u) const {
        const long L = (long)i * G + c; if (L >= nwg) return false;
        int wgid = (int)L; { const int q = nwg / NXCD, r = nwg % NXCD, xcd = wgid % NXCD, off = wgid / NXCD; wgid = (xcd < r ? xcd * (q + 1) : r * (q + 1) + (xcd - r) * q) + off; }
        const int nig = WGM * nN, gid = wgid / nig, fm = gid * WGM, gsz = (nM - fm) < WGM ? (nM - fm) : WGM;
        u.pm = fm + ((wgid % nig) % gsz); u.pn = (wgid % nig) / gsz; u.a = A + (size_t)u.pm * ta; u.b = B + (size_t)u.pn * tb; return true;
    }
    __device__ __forceinline__ void a_ready(const Unit&) const {}
    __device__ __forceinline__ void done(const Unit&) const {}
};

__device__ __forceinline__ unsigned cvt_pk_bf16(float lo, float hi) { unsigned r; asm volatile("v_cvt_pk_bf16_f32 %0, %1, %2" : "=v"(r) : "v"(lo), "v"(hi)); return r; }

struct EpiStoreBf16 {
    static constexpr int BMODE = 1;
    bf16_t* O; int ldc;
    __device__ __forceinline__ void operator()(const f32x4 (&acc)[2][2][4][2], const Unit& u, int wr, int wc, int fr, int fq) const {
        const int row0 = u.pm * BM + wr * 64 + fr; const int col0 = u.pn * BM + wc * 32 + 8 * fq;
#pragma unroll
        for (int ai = 0; ai < 2; ++ai)
#pragma unroll
            for (int m = 0; m < 4; ++m) { bf16_t* rowp = O + (size_t)(row0 + ai * HALF + m * 16) * ldc + col0;
#pragma unroll
                for (int bj = 0; bj < 2; ++bj) { const f32x4 v0 = acc[ai][bj][m][0], v1 = acc[ai][bj][m][1];
                    u32x4 w; w.x = cvt_pk_bf16(v0[0], v0[1]); w.y = cvt_pk_bf16(v0[2], v0[3]); w.z = cvt_pk_bf16(v1[0], v1[1]); w.w = cvt_pk_bf16(v1[2], v1[3]);
                    *(u32x4*)(rowp + bj * HALF) = w; } }
    }
};
struct EpiResid {
    static constexpr int BMODE = 0;
    const float* base_p; const float* base_s; float* out; int split;
    __device__ __forceinline__ void operator()(const f32x4 (&acc)[2][2][4][2], const Unit& u, int wr, int wc, int fr, int fq) const {
        { const int l_ = lane_now(); fr = l_ & 15; fq = l_ >> 4; }
        const int col0 = u.pn * BM + wc * 32 + 4 * fq;
#pragma unroll
        for (int ai = 0; ai < 2; ++ai) {
            f32x4 bs[4][2][2];
#pragma unroll
            for (int m = 0; m < 4; ++m) { const int r = u.pm * BM + ai * HALF + wr * 64 + m * 16 + fr; const float* bp = (r < split) ? base_p + (size_t)r * 2048 : base_s + (size_t)(r - split) * 2048;
#pragma unroll
                for (int bj = 0; bj < 2; ++bj)
#pragma unroll
                    for (int n = 0; n < 2; ++n) bs[m][bj][n] = *(const f32x4*)(bp + col0 + bj * HALF + n * 16); }
#pragma unroll
            for (int m = 0; m < 4; ++m) { const int r = u.pm * BM + ai * HALF + wr * 64 + m * 16 + fr; float* op = out + (size_t)r * 2048;
#pragma unroll
                for (int bj = 0; bj < 2; ++bj)
#pragma unroll
                    for (int n = 0; n < 2; ++n) *(f32x4*)(op + col0 + bj * HALF + n * 16) = bs[m][bj][n] + acc[ai][bj][m][n]; }
            asm volatile("" ::: "memory");
        }
    }
};

template <int MODE> struct EpiResidB {
    static constexpr int BMODE = 1;
    const float* base_p; const float* base_s; bf16_t* HB; float* out; float* SSQ2;
    __device__ __forceinline__ void operator()(const f32x4 (&acc)[2][2][4][2], const Unit& u, int wr, int wc, int fr, int fq) const {
        { const int l_ = lane_now(); fr = l_ & 15; fq = l_ >> 4; }
        const int col0 = u.pn * BM + wc * 32 + 8 * fq;
#pragma unroll
        for (int ai = 0; ai < 2; ++ai) {
            f32x4 b0[4][2], b1[4][2]; u32x4 hb[4][2];
#pragma unroll
            for (int m = 0; m < 4; ++m) { const int r = u.pm * BM + ai * HALF + wr * 64 + m * 16 + fr;
#pragma unroll
                for (int bj = 0; bj < 2; ++bj) {
                    if (MODE == 0) { const float* bp = ((r < 16384) ? base_p + (size_t)r * 2048 : base_s + (size_t)(r - 16384) * 2048) + col0 + bj * HALF; b0[m][bj] = __builtin_nontemporal_load((const f32x4*)bp); b1[m][bj] = __builtin_nontemporal_load((const f32x4*)(bp + 4)); }
                    else hb[m][bj] = *(const u32x4*)(HB + (size_t)r * 2048 + col0 + bj * HALF); } }
#pragma unroll
            for (int m = 0; m < 4; ++m) { const int r = u.pm * BM + ai * HALF + wr * 64 + m * 16 + fr; float ss = 0.f;
#pragma unroll
                for (int bj = 0; bj < 2; ++bj) { f32x4 h0, h1;
                    if (MODE == 0) { h0 = b0[m][bj] + acc[ai][bj][m][0]; h1 = b1[m][bj] + acc[ai][bj][m][1]; }
                    else { const u32x4 w = hb[m][bj];
                        h0 = (f32x4){__builtin_bit_cast(float, w.x << 16), __builtin_bit_cast(float, w.x & 0xffff0000u), __builtin_bit_cast(float, w.y << 16), __builtin_bit_cast(float, w.y & 0xffff0000u)} + acc[ai][bj][m][0];
                        h1 = (f32x4){__builtin_bit_cast(float, w.z << 16), __builtin_bit_cast(float, w.z & 0xffff0000u), __builtin_bit_cast(float, w.w << 16), __builtin_bit_cast(float, w.w & 0xffff0000u)} + acc[ai][bj][m][1]; }
                    if (MODE == 2) { float* op = out + (size_t)r * 2048 + col0 + bj * HALF; __builtin_nontemporal_store(h0, (f32x4*)op); __builtin_nontemporal_store(h1, (f32x4*)(op + 4)); }
                    else { u32x4 w; w.x = cvt_pk_bf16(h0[0], h0[1]); w.y = cvt_pk_bf16(h0[2], h0[3]); w.z = cvt_pk_bf16(h1[0], h1[1]); w.w = cvt_pk_bf16(h1[2], h1[3]);
                        *(u32x4*)(HB + (size_t)r * 2048 + col0 + bj * HALF) = w;
                        ss += (h0[0] * h0[0] + h0[1] * h0[1]) + (h0[2] * h0[2] + h0[3] * h0[3]) + (h1[0] * h1[0] + h1[1] * h1[1]) + (h1[2] * h1[2] + h1[3] * h1[3]); } }
                if (MODE != 2) { ss += __shfl_xor(ss, 16); ss += __shfl_xor(ss, 32); if (fq == 0) SSQ2[(size_t)r * 32 + u.pn * 4 + wc] = ss; } }
            asm volatile("" ::: "memory");
        }
    }
};

template <class Epi, class Sched, bool ALIGN_EPI = true>
__device__ __forceinline__ void gemm_phase(PG8_LAS unsigned char* lds, const GemmP g, const Sched& S, const Epi& E, int tid) {
    asm volatile("" : "+v"(tid));
    const int wid = __builtin_amdgcn_readfirstlane(tid >> 6), lane = tid & 63, wr = wid >> 2, wc = wid & 3, fr = lane & 15, fq = lane >> 4;
    int nt = g.nt; asm volatile("" : "+s"(nt));
    unsigned voffA[2], voffB[2];
#pragma unroll
    for (int i = 0; i < 2; ++i) { int R, C; stage_rc(tid * 16 + i * 8192, R, C); const int Rb = Epi::BMODE == 2 ? (64 * (R >> 5) + perm32(R & 31)) : Epi::BMODE == 1 ? ((R & ~31) + perm32(R & 31)) : R;
        voffA[i] = (unsigned)(R * g.lda + C) * 2u; voffB[i] = (unsigned)(Rb * g.ldb + C) * 2u; }
    const size_t kstep = (size_t)(BK * 2);
    const size_t hstepA = (size_t)HALF * g.lda * 2, hstepB = (size_t)(Epi::BMODE == 2 ? 32 : HALF) * g.ldb * 2;
    const unsigned ldsw = (unsigned)wid * 1024u;
    const int aoff = lds_byte(wr * 64 + fr, fq * 8), boff = lds_byte(wc * 32 + fr, fq * 8);
#define PG8_SA(b, h) (((b) * 2 + (h)) * HTB)
#define PG8_SB(b, h) ((4 + (b) * 2 + (h)) * HTB)
#define PG8_STAGE(bufoff, gbase, voff) do { _Pragma("unroll") for (int _i = 0; _i < 2; ++_i) \
        __builtin_amdgcn_global_load_lds((const unsigned*)((const char*)(gbase) + (voff)[_i]), (PG8_LAS unsigned*)(lds + (bufoff) + ldsw + _i * 8192), 16, 0, 0); } while (0)
#define PG8_LDA(dst, b, h) do { _Pragma("unroll") for (int m = 0; m < 4; ++m) _Pragma("unroll") for (int k = 0; k < 2; ++k) dst[m][k] = *(const PG8_LAS bf16x8*)(lds + PG8_SA(b, h) + aoff + m * 2048 + k * 1024); } while (0)
#define PG8_LDB(dst, b, h) do { _Pragma("unroll") for (int n = 0; n < 2; ++n) _Pragma("unroll") for (int k = 0; k < 2; ++k) dst[n][k] = *(const PG8_LAS bf16x8*)(lds + PG8_SB(b, h) + boff + n * 2048 + k * 1024); } while (0)
#define PG8_MMA(ai, bj, At, Bt) do { __builtin_amdgcn_s_setprio(1); _Pragma("unroll") for (int m = 0; m < 4; ++m) _Pragma("unroll") for (int n = 0; n < 2; ++n) _Pragma("unroll") for (int k = 0; k < 2; ++k) \
        acc[ai][bj][m][n] = __builtin_amdgcn_mfma_f32_16x16x32_bf16(Bt[n][k], At[m][k], acc[ai][bj][m][n], 0, 0, 0); __builtin_amdgcn_s_setprio(0); } while (0)
#define PG8_WAIT_V(n) asm volatile("s_waitcnt vmcnt(" #n ")" ::: "memory")
#define PG8_WAIT_L(n) asm volatile("s_waitcnt lgkmcnt(" #n ")" ::: "memory")
#define PG8_BAR __builtin_amdgcn_s_barrier()
#define PG8_SCHED __builtin_amdgcn_sched_barrier(0)
    Unit cur, nxt; int ui = 0;
    if (!S.next(0, cur)) return;
    f32x4 acc[2][2][4][2];
#pragma unroll
    for (int a = 0; a < 2; ++a)
#pragma unroll
        for (int b = 0; b < 2; ++b)
#pragma unroll
            for (int m = 0; m < 4; ++m)
#pragma unroll
                for (int n = 0; n < 2; ++n) acc[a][b][m][n] = (f32x4){0.f, 0.f, 0.f, 0.f};
    bf16x8 At[4][2], B0[2][2], B1[2][2];
    const char* cA = cur.a; const char* cB = cur.b;
    S.a_ready(cur);
    PG8_STAGE(PG8_SB(0, 0), cB, voffB); PG8_STAGE(PG8_SB(0, 1), cB + hstepB, voffB); PG8_STAGE(PG8_SA(0, 0), cA, voffA); PG8_STAGE(PG8_SA(0, 1), cA + hstepA, voffA);
    if (wr == 1) PG8_BAR;
    PG8_WAIT_V(2); PG8_BAR;
    PG8_STAGE(PG8_SB(1, 0), cB + kstep, voffB); PG8_STAGE(PG8_SA(1, 0), cA + kstep, voffA); PG8_STAGE(PG8_SB(1, 1), cB + hstepB + kstep, voffB);
    PG8_WAIT_V(6); PG8_BAR;
    for (;;) {
        const bool has_next = S.next(ui + 1, nxt);
        const char* nA = has_next ? nxt.a : cA; const char* nB = has_next ? nxt.b : cB;
        for (int t = 0; t < nt; t += 2) {
            const bool last = (t == nt - 2);
            const char* a1 = cA + (size_t)(t + 1) * kstep;
            const char* a2 = last ? nA : cA + (size_t)(t + 2) * kstep; const char* b2 = last ? nB : cB + (size_t)(t + 2) * kstep;
            const char* a3 = a2 + kstep; const char* b3 = b2 + kstep;
            if (last && has_next) S.a_ready(nxt);
            PG8_LDB(B0, 0, 0); PG8_LDB(B1, 0, 1); PG8_SCHED; PG8_LDA(At, 0, 0); PG8_STAGE(PG8_SA(1, 1), a1 + hstepA, voffA);
            PG8_WAIT_V(8); PG8_WAIT_L(0); PG8_BAR; PG8_MMA(0, 0, At, B0); PG8_MMA(0, 1, At, B1); PG8_BAR; PG8_SCHED;
            PG8_LDA(At, 0, 1); PG8_STAGE(PG8_SB(0, 0), b2, voffB); PG8_STAGE(PG8_SB(0, 1), b2 + hstepB, voffB); PG8_STAGE(PG8_SA(0, 0), a2, voffA);
            PG8_WAIT_V(8); PG8_WAIT_L(0); PG8_BAR; PG8_MMA(1, 0, At, B0); PG8_MMA(1, 1, At, B1); PG8_BAR; PG8_SCHED;
            PG8_LDB(B0, 1, 0); PG8_LDB(B1, 1, 1); PG8_SCHED; PG8_LDA(At, 1, 0); PG8_STAGE(PG8_SA(0, 1), a2 + hstepA, voffA);
            PG8_WAIT_V(8); PG8_WAIT_L(0); PG8_BAR; PG8_MMA(0, 0, At, B0); PG8_MMA(0, 1, At, B1); PG8_BAR; PG8_SCHED;
            PG8_LDA(At, 1, 1); PG8_STAGE(PG8_SB(1, 0), b3, voffB); PG8_STAGE(PG8_SB(1, 1), b3 + hstepB, voffB); PG8_STAGE(PG8_SA(1, 0), a3, voffA);
            PG8_WAIT_V(8); PG8_WAIT_L(0); PG8_BAR; PG8_MMA(1, 0, At, B0); PG8_MMA(1, 1, At, B1); PG8_BAR; PG8_SCHED;
        }
        if constexpr (ALIGN_EPI) { if (wr == 0) PG8_BAR; }
        E(acc, cur, wr, wc, fr, fq); S.done(cur);
        if (!has_next) break;
#pragma unroll
        for (int a = 0; a < 2; ++a)
#pragma unroll
            for (int b = 0; b < 2; ++b)
#pragma unroll
                for (int m = 0; m < 4; ++m)
#pragma unroll
                    for (int n = 0; n < 2; ++n) acc[a][b][m][n] = (f32x4){0.f, 0.f, 0.f, 0.f};
        cur = nxt; cA = nA; cB = nB; ++ui;
        if constexpr (ALIGN_EPI) { if (wr == 1) PG8_BAR; }
    }
    PG8_WAIT_V(0);
    if constexpr (!ALIGN_EPI) { if (wr == 0) PG8_BAR; }
    PG8_BAR;
#undef PG8_SA
#undef PG8_SB
#undef PG8_STAGE
#undef PG8_LDA
#undef PG8_LDB
#undef PG8_MMA
#undef PG8_WAIT_V
#undef PG8_WAIT_L
#undef PG8_BAR
#undef PG8_SCHED
}
}

constexpr int NWAVES = 8, NTHR = 512;
constexpr int DM = 2048, MP = 16384, MS = 512, MT = MP + MS, PAST = 2048, DECL = 64, NB = 8;
constexpr int KCROWS = PAST + DECL;
constexpr float EPS = 1e-6f;
constexpr float LOG2E = 1.4426950408889634f;
constexpr float C2 = 0.125f * LOG2E;

enum { I_XP = 0, I_XS, I_CK, I_CV, I_SR, I_NW, I_AWIN, I_AWOUT, I_AQG, I_AKG, I_LQ1, I_LK1, I_LQ2, I_LK2, I_ASG, I_RWIN, I_RWOUT, I_CWIN, I_CWOUT, I_CVG, I_CWS, I_CBS, N_IN };
constexpr size_t O_YP = 0, O_YS = O_YP + (size_t)MP * DM, O_KP = O_YS + (size_t)MS * DM, O_VP = O_KP + 2 * (size_t)MP * DM, O_KS = O_VP + 2 * (size_t)MP * DM, O_VS = O_KS + 2 * (size_t)MS * DM,
                 O_SP = O_VS + 2 * (size_t)MS * DM, O_SS = O_SP + (size_t)8 * 256 * 512, O_VM = O_SS + (size_t)NB * 8 * 256 * 512, O_END = O_VM + (size_t)MS * 4096;

constexpr size_t MiB = 1u << 20;
constexpr size_t WS_CTL = 0, CTL_ZERO_BYTES = 1 * MiB;
constexpr size_t WS_WAIN0 = 8 * MiB, WS_WAOUT0 = 40 * MiB, WS_WRIN = 48 * MiB, WS_WROUT = 96 * MiB, WS_WCIN = 112 * MiB, WS_WCOUT = 160 * MiB, WS_WAIN1 = 176 * MiB, WS_WAOUT1 = 208 * MiB;
constexpr size_t WS_SSQ2 = 2 * MiB;
constexpr size_t WS_HB = 216 * MiB, WS_Z = 282 * MiB;
constexpr size_t WS_XN0 = 348 * MiB;
constexpr size_t WS_QS = 546 * MiB, WS_KP = 612 * MiB, WS_VP = 676 * MiB, WS_KC = 740 * MiB, WS_VC = 806 * MiB, WS_AOA = 872 * MiB;
constexpr size_t WS_KT = 112 * MiB, WS_RG = 282 * MiB, WS_QP = 414 * MiB, WS_KN = 546 * MiB, WS_VS = 612 * MiB, WS_ORET = 900 * MiB;
constexpr size_t WS_GU = 282 * MiB, WS_SG = 414 * MiB, WS_GVT = 546 * MiB, WS_WM = 678 * MiB, WS_SSQ = 744 * MiB, WS_GVS = 752 * MiB;
constexpr size_t WS_GA = 282 * MiB;
constexpr size_t WS_KVX = 184 * MiB;
constexpr size_t WS_TABR = 1040 * MiB, WS_TABA = 1056 * MiB, WS_END = 1060 * MiB;

#define GAS __attribute__((address_space(1)))
#define LAS __attribute__((address_space(3)))
typedef unsigned short bf16;
typedef unsigned v4u __attribute__((ext_vector_type(4)));
typedef unsigned v2u __attribute__((ext_vector_type(2)));
typedef float f32x4 __attribute__((ext_vector_type(4)));
typedef GAS unsigned gu32;
#define RLX_AGENT __ATOMIC_RELAXED, __HIP_MEMORY_SCOPE_AGENT
#define LDS_WAIT() asm volatile("s_waitcnt lgkmcnt(0)" ::: "memory")
#define VM_WAIT() asm volatile("s_waitcnt vmcnt(0)" ::: "memory")
typedef float g_f32x2 __attribute__((ext_vector_type(2))); typedef __bf16 g_bf16x2 __attribute__((ext_vector_type(2)));
__device__ __forceinline__ unsigned pk2(float lo, float hi) { const g_f32x2 v = {lo, hi}; const g_bf16x2 b = __builtin_convertvector(v, g_bf16x2); return __builtin_bit_cast(unsigned, b); }
__device__ __forceinline__ unsigned f2bf(float f) { return pk2(f, 0.f) & 0xffffu; }
__device__ __forceinline__ float bf2f(unsigned short b) { return __builtin_bit_cast(float, (unsigned)b << 16); }
__device__ __forceinline__ float bflo(unsigned w) { return __builtin_bit_cast(float, w << 16); }
__device__ __forceinline__ float bfhi(unsigned w) { return __builtin_bit_cast(float, w & 0xffff0000u); }
__device__ __forceinline__ float silu_f(float x) { return x * __builtin_amdgcn_rcpf(1.f + __builtin_amdgcn_exp2f(-LOG2E * x)); }
__device__ __forceinline__ float gelu_tanh_f(float x) { const float u = (0.7978845608028654f * 2.f * LOG2E) * (x + 0.044715f * x * x * x); return x * __builtin_amdgcn_rcpf(1.f + __builtin_amdgcn_exp2f(-u)); }
__device__ __forceinline__ float wave_sum(float v) {
#pragma unroll
    for (int o = 1; o < 64; o <<= 1) v += __shfl_xor(v, o);
    return v;
}
__device__ __forceinline__ void row_rstd(const float* ssq, int pm, int wr, int fr, int fq, float (&rs)[2][4]) {
#pragma unroll
    for (int ai = 0; ai < 2; ++ai)
#pragma unroll
        for (int m = 0; m < 4; ++m) {
            if (ssq) { const float* p = ssq + ((size_t)pm * 256 + ai * 128 + wr * 64 + m * 16 + fr) * 32 + 8 * fq; const f32x4 a = *(const f32x4*)p, b = *(const f32x4*)(p + 4);
                float t = ((a.x + a.y) + (a.z + a.w)) + ((b.x + b.y) + (b.z + b.w)); t += __shfl_xor(t, 16); t += __shfl_xor(t, 32); rs[ai][m] = 1.f / sqrtf(t * (1.f / 2048.f) + EPS); }
            else rs[ai][m] = 1.f; }
}
#define NT_LOAD(p) __builtin_nontemporal_load(p)
#define NT_STORE(v, p) __builtin_nontemporal_store((v), (p))
__device__ __forceinline__ void rope_cs(int pos, int i, int nf, float& c, float& s) {
    const float inv = exp2f(-(float)i / (float)nf * 13.287712379549449f);
    const double a = (double)pos * (double)inv * 0.15915494309189535;
    const float r = (float)(a - floor(a));
    c = __builtin_amdgcn_cosf(r); s = __builtin_amdgcn_sinf(r);
}

#define XB_TMO      128
#define XB_XCNT(j)  (256  + 64 * (j))
#define XB_XSUB(j)  (1280 + 64 * (j))
#define XB_XGEN(j)  (2304 + 64 * (j))
#define XB_TOP      3328
#define XB_TOPGEN   3392
#define XCD_BAR_WORDS 3456
#define XB_SPIN_CAP (1u << 22)
__device__ __forceinline__ unsigned xb_ld(unsigned* p)              { return __hip_atomic_load(p, __ATOMIC_RELAXED, __HIP_MEMORY_SCOPE_AGENT); }
__device__ __forceinline__ unsigned xb_add(unsigned* p, unsigned v) { return __hip_atomic_fetch_add(p, v, __ATOMIC_RELAXED, __HIP_MEMORY_SCOPE_AGENT); }
__device__ __forceinline__ unsigned xb_xcc_id() { return (unsigned)__builtin_amdgcn_s_getreg((3 << 11) | 20) & 0xFu; }
#define XB_SPIN(cond, bar) do { unsigned _sp = 0; while (cond) { __builtin_amdgcn_s_sleep(1); \
    if ((++_sp & 255u) == 0u) { if (xb_ld(&(bar)[XB_TMO])) break; if (_sp > XB_SPIN_CAP) { atomicAdd(&(bar)[XB_TMO], 1u); break; } } } } while (0)
struct XcdBarrier { unsigned* bar; unsigned x; volatile LAS unsigned* st; };
__device__ __forceinline__ XcdBarrier xcd_barrier_post(unsigned* bar, volatile LAS unsigned* st) {
    XcdBarrier b; b.bar = bar; b.x = xb_xcc_id(); b.st = st;
    if (threadIdx.x == 0) (void)xb_add(&bar[XB_XCNT(b.x)], 1u);
    return b;
}
__device__ __forceinline__ void xcd_barrier_complete(unsigned* bar, unsigned x, unsigned& nloc, unsigned& nx) {
    const unsigned G = gridDim.x * gridDim.y * gridDim.z;
    unsigned sum, cnt, mine, sp = 0u;
    for (;;) {
        sum = 0u; cnt = 0u; mine = 0u;
#pragma unroll
        for (unsigned j = 0; j < 16; ++j) { const unsigned c = xb_ld(&bar[XB_XCNT(j)]); sum += c; cnt += (c > 0u) ? 1u : 0u; mine = (j == x) ? c : mine; }
        if (sum == G) break;
        __builtin_amdgcn_s_sleep(1);
        if ((++sp & 255u) == 0u) { if (xb_ld(&bar[XB_TMO])) break; if (sp > XB_SPIN_CAP) { atomicAdd(&bar[XB_TMO], 1u); break; } }
    }
    nloc = mine > 0u ? mine : 1u; nx = cnt > 0u ? cnt : 1u;
}
__device__ __forceinline__ void xcd_barrier(const XcdBarrier& b, bool leader) {
    asm volatile("s_waitcnt vmcnt(0)" ::: "memory");
    __syncthreads();
    if (leader) {
        unsigned* bar = b.bar;
        __builtin_amdgcn_s_waitcnt(0);
        unsigned nloc = b.st[0], nx = b.st[1];
        if (nloc == 0u) { xcd_barrier_complete(bar, b.x, nloc, nx); b.st[0] = nloc; b.st[1] = nx; }
        const unsigned old = xb_add(&bar[XB_XSUB(b.x)], 1u);
        const unsigned gen = old / nloc;
        if (old + 1u == (gen + 1u) * nloc) {
            __builtin_amdgcn_fence(__ATOMIC_RELEASE, "agent");
            asm volatile("s_waitcnt vmcnt(0)" ::: "memory");
            const unsigned og = xb_add(&bar[XB_TOP], 1u);
            const unsigned tg = og / nx;
            if (og + 1u == (tg + 1u) * nx) xb_add(&bar[XB_TOPGEN], 1u);
            else XB_SPIN(xb_ld(&bar[XB_TOPGEN]) == tg, bar);
            __builtin_amdgcn_fence(__ATOMIC_ACQUIRE, "agent");
            xb_add(&bar[XB_XGEN(b.x)], 1u);
            asm volatile("s_waitcnt vmcnt(0)" ::: "memory");
        } else {
            XB_SPIN(xb_ld(&bar[XB_XGEN(b.x)]) == gen, bar);
            __builtin_amdgcn_fence(__ATOMIC_ACQUIRE, "agent");
            asm volatile("s_waitcnt vmcnt(0)" ::: "memory");
        }
    }
    __syncthreads();
}

constexpr int RING_OFF = 0, RING_BYTES = 139264;
constexpr int MISC_OFF = RING_BYTES;
constexpr int LDS_BYTES = 147456;
struct Args { const float* in[N_IN]; float* out; unsigned char* ws; int ph_lo, ph_hi; };
struct Frame {
    LAS unsigned char* lds; int tid, lane, wave, G, bid;
    const float* const* in; float* out; unsigned char* ws;
};

__device__ __forceinline__ void p0_transpose_item(const float* W, int K, int N, bf16* WT, LAS float* scr, int item, int lane, const float* ksc = nullptr) {
    const int nblk = N / 32, kb = item / nblk, nb = item % nblk, k0 = 64 * kb, n0 = 32 * nb;
#pragma unroll 8
    for (int i = 0; i < 32; ++i) { const int kk = 2 * i + (lane >> 5); const float w_ = NT_LOAD(W + (size_t)(k0 + kk) * N + n0 + (lane & 31)); scr[kk * 33 + (lane & 31)] = ksc ? w_ * ksc[k0 + kk] : w_; }
    LDS_WAIT(); asm volatile("" ::: "memory");
    const int c = lane & 7;
#pragma unroll
    for (int j = 0; j < 4; ++j) { const int n = (lane >> 3) + 8 * j; const LAS float* s = scr + (8 * c) * 33 + n;
        v4u o; o.x = pk2(s[0 * 33], s[1 * 33]); o.y = pk2(s[2 * 33], s[3 * 33]); o.z = pk2(s[4 * 33], s[5 * 33]); o.w = pk2(s[6 * 33], s[7 * 33]);
        *(GAS v4u*)(WT + (size_t)(n0 + n) * K + k0 + 8 * c) = o; }
    LDS_WAIT(); asm volatile("" ::: "memory");
}
__device__ __forceinline__ void transpose_weight(Frame& F, const float* W, int K, int N, bf16* WT) {
    LAS float* scr = (LAS float*)(F.lds + RING_OFF + F.wave * 16384);
    const int gw = F.bid * NWAVES + F.wave, NGW = F.G * NWAVES, nitems = (K / 64) * (N / 32);
    for (int it = gw; it < nitems; it += NGW) p0_transpose_item(W, K, N, WT, scr, it, F.lane);
}
__device__ __forceinline__ void norm_rows(Frame& F, const float* src_p, const float* src_s, const float* w, bf16* XN) {
    const int gw = F.bid * NWAVES + F.wave, NGW = F.G * NWAVES;
    for (int m = gw; m < MT; m += NGW) {
        const float* xrow = (m < MP) ? src_p + (size_t)m * DM : src_s + (size_t)(m - MP) * DM;
        const GAS f32x4* xr = (const GAS f32x4*)xrow + F.lane; const GAS f32x4* wr = (const GAS f32x4*)w + F.lane;
        f32x4 v[8]; float s = 0.f;
#pragma unroll
        for (int j = 0; j < 8; ++j) { v[j] = __builtin_nontemporal_load((const f32x4*)(xrow) + F.lane + 64 * j); s += (v[j].x * v[j].x + v[j].y * v[j].y) + (v[j].z * v[j].z + v[j].w * v[j].w); }
        const float rstd = 1.f / sqrtf(wave_sum(s) * (1.f / DM) + EPS);
        GAS v2u* o8 = (GAS v2u*)(XN + (size_t)m * DM) + F.lane;
#pragma unroll
        for (int j = 0; j < 8; ++j) { const f32x4 g = wr[64 * j]; v2u o; o.x = pk2(v[j].x * rstd * g.x, v[j].y * rstd * g.y); o.y = pk2(v[j].z * rstd * g.z, v[j].w * rstd * g.w); o8[64 * j] = o; }
    }
}
__device__ __forceinline__ void cache_cvt(Frame& F, const float* ck, const float* cv, bf16* KC, bf16* VC) {
    const size_t nvec = (size_t)NB * PAST * DM / 4;
    const size_t gt = (size_t)F.bid * NTHR + F.tid, NG = (size_t)F.G * NTHR;
    for (size_t i = gt; i < 2 * nvec; i += NG) {
        const bool isv = i >= nvec; const size_t e = (isv ? i - nvec : i) * 4;
        const size_t brow = e / DM, col = e % DM, b = brow / PAST, t = brow % PAST;
        const f32x4 x = *(const GAS f32x4*)((isv ? cv : ck) + e);
        v2u o; o.x = pk2(x.x, x.y); o.y = pk2(x.z, x.w);
        *(GAS v2u*)((isv ? VC : KC) + ((b * KCROWS + t) * DM + col)) = o;
    }
}
__device__ __forceinline__ int tw_chunks(int K, int N) { return (K / 64) * (N / 32) / 64; }
__device__ __forceinline__ void tw_run(Frame& F, const float* W, int K, int N, bf16* WT, int c, const float* ksc = nullptr) {
    LAS float* scr = (LAS float*)(F.lds + RING_OFF + F.wave * 16384);
#pragma unroll 1
    for (int i = 0; i < 8; ++i) p0_transpose_item(W, K, N, WT, scr, c * 64 + F.wave * 8 + i, F.lane, ksc);
}
constexpr int CC_CHUNKS = 2 * (NB * PAST * DM / 4) / 8192;
__device__ __forceinline__ void cc_run(Frame& F, const float* ck, const float* cv, bf16* KC, bf16* VC, int c) {
    const size_t nvec = (size_t)NB * PAST * DM / 4;
#pragma unroll 4
    for (int k = 0; k < 16; ++k) { const size_t i = (size_t)c * 8192 + k * NTHR + F.tid;
        const bool isv = i >= nvec; const size_t e = (isv ? i - nvec : i) * 4; const size_t brow = e / DM, col = e % DM, b = brow / PAST, t = brow % PAST;
        const f32x4 x = NT_LOAD((const f32x4*)((isv ? cv : ck) + e)); v2u o; o.x = pk2(x.x, x.y); o.y = pk2(x.z, x.w);
        *(GAS v2u*)((isv ? VC : KC) + ((b * KCROWS + t) * DM + col)) = o; }
}
constexpr int TR_CHUNKS = MP * 128 / 8192;
__device__ __forceinline__ void tr_run(Frame& F, float* tab, int c) {
#pragma unroll 1
    for (int k = 0; k < 16; ++k) { const size_t e = (size_t)c * 8192 + k * NTHR + F.tid; float cs, sn; rope_cs((int)(e >> 7), (int)(e & 127), 128, cs, sn); tab[2 * e] = cs; tab[2 * e + 1] = sn; }
}
__device__ __forceinline__ int row_pos(int row) { return row < MP ? row : PAST + ((row - MP) & 63); }

struct EpiAIn {
    static constexpr int BMODE = 2;
    pg8::bf16_t *Qs, *KP, *VP, *KC, *VC, *GA; float *okp, *ovp, *oks, *ovs; const float* tab; const float* qg; const float* kg; const float* ssq;
    __device__ __forceinline__ void operator()(const pg8::f32x4 (&acc)[2][2][4][2], const pg8::Unit& u, int wr, int wc, int fr, int fq) const {
        { const int l_ = lane_now(); fr = l_ & 15; fq = l_ >> 4; }
        const int pn = u.pn, pm = u.pm, typ = pn >> 3, cl = ((pn & 7) * 4 + wc) * 64 + 8 * fq; float rs[2][4]; row_rstd(ssq, pm, wr, fr, fq, rs);
        float g1[8], g2[8];
        if (typ < 2) { const float* gp = (typ == 0 ? qg : kg) + 8 * fq; const pg8::f32x4 a = *(const pg8::f32x4*)gp, b = *(const pg8::f32x4*)(gp + 4), c = *(const pg8::f32x4*)(gp + 32), d = *(const pg8::f32x4*)(gp + 36);
#pragma unroll
            for (int e = 0; e < 4; ++e) { g1[e] = a[e]; g1[4 + e] = b[e]; g2[e] = c[e]; g2[4 + e] = d[e]; } }
#pragma unroll
        for (int ai = 0; ai < 2; ++ai)
#pragma unroll
          for (int mp = 0; mp < 2; ++mp) {
            pg8::f32x4 tq[4][4];
            if (typ < 2) {
#pragma unroll
                for (int m = 2 * mp; m < 2 * mp + 2; ++m) { const int i_ = ai * 128 + wr * 64 + m * 16 + fr; const int pos_ = pm < 64 ? pm * 256 + i_ : PAST + (i_ & 63); const float* tp_ = tab + ((size_t)pos_ * 32 + 8 * fq) * 2;
#pragma unroll
                    for (int q4 = 0; q4 < 4; ++q4) tq[m][q4] = *(const pg8::f32x4*)(tp_ + 4 * q4); } }
#pragma unroll
            for (int m = 2 * mp; m < 2 * mp + 2; ++m) {
                const int i = ai * 128 + wr * 64 + m * 16 + fr; const size_t row = (size_t)pm * 256 + i;
                float x1[8], x2[8];
#pragma unroll
                for (int e = 0; e < 4; ++e) { x1[e] = acc[ai][0][m][0][e] * rs[ai][m]; x1[4 + e] = acc[ai][0][m][1][e] * rs[ai][m]; x2[e] = acc[ai][1][m][0][e] * rs[ai][m]; x2[4 + e] = acc[ai][1][m][1][e] * rs[ai][m]; }
                size_t drow; pg8::bf16_t* dk; pg8::bf16_t* dv; float* fk; float* fv;
                if (pm < 64) { drow = row; dk = KP; dv = VP; fk = okp + row * DM; fv = ovp + row * DM; }
                else { const int s_ = (int)(row - MP); drow = (size_t)(s_ >> 6) * KCROWS + PAST + (s_ & 63); dk = KC; dv = VC; fk = oks + (size_t)s_ * DM; fv = ovs + (size_t)s_ * DM; }
                if (typ < 2) {
                    float ss = 0.f;
#pragma unroll
                    for (int k = 0; k < 8; ++k) ss += x1[k] * x1[k] + x2[k] * x2[k];
                    ss += __shfl_xor(ss, 16); ss += __shfl_xor(ss, 32);
                    const float rstd = 1.f / sqrtf(ss * (1.f / 64.f) + EPS);
                    float o1[8], o2[8];
#pragma unroll
                    for (int q4 = 0; q4 < 4; ++q4) { const pg8::f32x4 t = tq[m][q4];
#pragma unroll
                        for (int z = 0; z < 2; ++z) { const int k = 2 * q4 + z; const float c = t[2 * z], s = t[2 * z + 1], y1 = x1[k] * rstd * g1[k], y2 = x2[k] * rstd * g2[k]; o1[k] = y1 * c - y2 * s; o2[k] = y2 * c + y1 * s; } }
                    if (typ == 0) { v4u w1, w2;
                        w1.x = pk2(o1[0] * C2, o1[1] * C2); w1.y = pk2(o1[2] * C2, o1[3] * C2); w1.z = pk2(o1[4] * C2, o1[5] * C2); w1.w = pk2(o1[6] * C2, o1[7] * C2);
                        w2.x = pk2(o2[0] * C2, o2[1] * C2); w2.y = pk2(o2[2] * C2, o2[3] * C2); w2.z = pk2(o2[4] * C2, o2[5] * C2); w2.w = pk2(o2[6] * C2, o2[7] * C2);
                        *(v4u*)(Qs + row * DM + cl) = w1; *(v4u*)(Qs + row * DM + cl + 32) = w2;
                    } else { v4u w1, w2;
                        w1.x = pk2(o1[0], o1[1]); w1.y = pk2(o1[2], o1[3]); w1.z = pk2(o1[4], o1[5]); w1.w = pk2(o1[6], o1[7]);
                        w2.x = pk2(o2[0], o2[1]); w2.y = pk2(o2[2], o2[3]); w2.z = pk2(o2[4], o2[5]); w2.w = pk2(o2[6], o2[7]);
                        *(v4u*)(dk + drow * DM + cl) = w1; *(v4u*)(dk + drow * DM + cl + 32) = w2;
                        NT_STORE(((pg8::f32x4){o1[0], o1[1], o1[2], o1[3]}), (pg8::f32x4*)(fk + cl)); NT_STORE(((pg8::f32x4){o1[4], o1[5], o1[6], o1[7]}), (pg8::f32x4*)(fk + cl + 4));
                        NT_STORE(((pg8::f32x4){o2[0], o2[1], o2[2], o2[3]}), (pg8::f32x4*)(fk + cl + 32)); NT_STORE(((pg8::f32x4){o2[4], o2[5], o2[6], o2[7]}), (pg8::f32x4*)(fk + cl + 36)); }
                } else { v4u w1, w2;
                    w1.x = pk2(x1[0], x1[1]); w1.y = pk2(x1[2], x1[3]); w1.z = pk2(x1[4], x1[5]); w1.w = pk2(x1[6], x1[7]);
                    w2.x = pk2(x2[0], x2[1]); w2.y = pk2(x2[2], x2[3]); w2.z = pk2(x2[4], x2[5]); w2.w = pk2(x2[6], x2[7]);
                    if (typ == 2) { *(v4u*)(dv + drow * DM + cl) = w1; *(v4u*)(dv + drow * DM + cl + 32) = w2;
                        NT_STORE(((pg8::f32x4){x1[0], x1[1], x1[2], x1[3]}), (pg8::f32x4*)(fv + cl)); NT_STORE(((pg8::f32x4){x1[4], x1[5], x1[6], x1[7]}), (pg8::f32x4*)(fv + cl + 4));
                        NT_STORE(((pg8::f32x4){x2[0], x2[1], x2[2], x2[3]}), (pg8::f32x4*)(fv + cl + 32)); NT_STORE(((pg8::f32x4){x2[4], x2[5], x2[6], x2[7]}), (pg8::f32x4*)(fv + cl + 36)); }
                    else { *(v4u*)(GA + row * DM + cl) = w1; *(v4u*)(GA + row * DM + cl + 32) = w2; }
                }
                if (m & 1) asm volatile("" ::: "memory");
            }
        }
    }
};
__device__ __forceinline__ void attn_table(Frame& F, float* tab) {
    const size_t gt = (size_t)F.bid * NTHR + F.tid, NG = (size_t)F.G * NTHR;
    for (size_t e = gt; e < (size_t)MP * 32; e += NG) { float c, s; rope_cs((int)(e >> 5), (int)(e & 31), 32, c, s); tab[2 * e] = c; tab[2 * e + 1] = s; }
}
namespace dattn {
typedef short bf16x8 __attribute__((ext_vector_type(8)));
typedef short s16x4 __attribute__((ext_vector_type(4)));
typedef short v4i16_t __attribute__((ext_vector_type(4)));
typedef float f32x16 __attribute__((ext_vector_type(16)));
typedef unsigned u32x4 __attribute__((ext_vector_type(4)));
typedef __attribute__((address_space(3))) const char* lds_cptr;
constexpr int RINGB = 98304, WSF_OFF = RINGB, XCHB = 18432, STP = 144;
__device__ __forceinline__ int crow(int r, int hi) { return (r & 3) + 8 * (r >> 2) + 4 * hi; }
__device__ __forceinline__ void glds16(const void* gsrc, unsigned lds_dst) { unsigned keep;
    asm volatile("s_mov_b32 %0, m0\n\ts_mov_b32 m0, %2\n\ts_nop 0\n\tglobal_load_lds_dwordx4 %1, off\n\ts_mov_b32 m0, %0" : "=&s"(keep) : "v"(gsrc), "s"(lds_dst) : "memory"); }
typedef float f32x2_t __attribute__((ext_vector_type(2))); typedef __bf16 bf16x2_t __attribute__((ext_vector_type(2)));
__device__ __forceinline__ unsigned cvtpk_s(float lo, float hi) { f32x2_t v = {lo, hi}; bf16x2_t b = __builtin_convertvector(v, bf16x2_t); return __builtin_bit_cast(unsigned, b); }
#define DA_WAIT_BAR(N) asm volatile("s_waitcnt vmcnt(" #N ") lgkmcnt(0)\n\ts_barrier" ::: "memory")
__device__ __forceinline__ s16x4 vtr(lds_cptr p) { return __builtin_bit_cast(s16x4, __builtin_amdgcn_ds_read_tr16_b64_v4i16((__attribute__((address_space(3))) v4i16_t*)p)); }
struct Unit { const bf16* Q; const bf16* K; const bf16* V; const bf16* G; bf16* AO; int NT; int full; int dma0; };

constexpr int KSLOT = 16384, VSLOT = 16384, VRING = 3 * KSLOT;
#define DA_SBAR() __builtin_amdgcn_sched_barrier(0)
#define DA_PIN(x) asm volatile("" : "+v"(x))
#define DA_MFMA(a, b, c) __builtin_amdgcn_mfma_f32_32x32x16_bf16(a, b, c, 0, 0, 0)
struct DmaJob { const bf16* kp; const bf16* vp; unsigned kd0, kd1, vd0, vd1; };
__device__ __forceinline__ void dma_piece(const DmaJob& j, int i) { if (i == 0) glds16(j.kp, j.kd0); else if (i == 1) glds16(j.kp + 64, j.kd1); else if (i == 2) glds16(j.vp, j.vd0); else glds16(j.vp + 64, j.vd1); }
template <bool QK, bool PV, int VAR>
__device__ __forceinline__ void step(lds_cptr kpn, lds_cptr vp, const bf16x8 (&qr)[4], bf16x8 (&kf)[8], f32x16 (&o)[4], u32x4 (&pw)[4], float& l_reg, const DmaJob& dj) {
    f32x16 C0 = f32x16{}, C1 = f32x16{};
    s16x4 vlo[4], vhi[4];
    if constexpr (!QK) { dma_piece(dj, 0); dma_piece(dj, 1); dma_piece(dj, 2); dma_piece(dj, 3); }
#define DA_FOFF(f) ((((f) & 3) * 4096) + (((f) >> 2) * 1024))
#pragma unroll
    for (int a = 0; a < 8; ++a) {
        if constexpr (PV) { if (a >= 4) { if (VAR != 4) { vlo[a - 4] = vtr(vp + DA_FOFF(a - 4)); vhi[a - 4] = vtr(vp + DA_FOFF(a - 4) + 512); } else { vlo[a - 4] = s16x4{1, 2, 3, 4}; vhi[a - 4] = s16x4{5, 6, 7, 8}; } DA_SBAR(); } }
        if constexpr (QK) {
            if (a & 1) C1 = (a < 2) ? DA_MFMA(kf[a], qr[a >> 1], f32x16{}) : DA_MFMA(kf[a], qr[a >> 1], C1);
            else       C0 = (a < 2) ? DA_MFMA(kf[a], qr[a >> 1], f32x16{}) : DA_MFMA(kf[a], qr[a >> 1], C0);
            if (a < 4) dma_piece(dj, a);
            DA_SBAR();
        }
    }
    u32x4 pwn[4]; pwn[0] = u32x4{}; pwn[1] = u32x4{}; pwn[2] = u32x4{}; pwn[3] = u32x4{};
    float s0 = 0.f, s1 = 0.f;
#pragma unroll
    for (int p = 0; p < 16; ++p) {
        if constexpr (PV) {
            const bf16x8 vf = (bf16x8){vlo[p & 3][0], vlo[p & 3][1], vlo[p & 3][2], vlo[p & 3][3], vhi[p & 3][0], vhi[p & 3][1], vhi[p & 3][2], vhi[p & 3][3]};
            if (VAR != 3) o[p & 3] = DA_MFMA(__builtin_bit_cast(bf16x8, pw[p >> 2]), vf, o[p & 3]); else { o[p & 3][0] += __builtin_bit_cast(float, (int)vf[0] | ((int)vf[4] << 16)); }
            if (p < 12 && VAR != 4) { vlo[p & 3] = vtr(vp + DA_FOFF(p + 4)); vhi[p & 3] = vtr(vp + DA_FOFF(p + 4) + 512); }
        }
        if constexpr (QK) {
            float e0, e1;
            if (VAR == 2) { if (p < 8) { e0 = C0[2 * p]; e1 = C0[2 * p + 1]; } else { e0 = C1[2 * p - 16]; e1 = C1[2 * p - 15]; } }
            else if (p < 8) { e0 = __builtin_amdgcn_exp2f(C0[2 * p]); e1 = __builtin_amdgcn_exp2f(C0[2 * p + 1]); }
            else       { e0 = __builtin_amdgcn_exp2f(C1[2 * p - 16]); e1 = __builtin_amdgcn_exp2f(C1[2 * p - 15]); }
            s0 += e0; s1 += e1; pwn[p >> 2][p & 3] = cvtpk_s(e0, e1);
            DA_PIN(s0); DA_PIN(s1); DA_PIN(pwn[p >> 2]);
            if (p >= 8 && VAR != 6) { const int j = p - 8; kf[j] = *(const __attribute__((address_space(3))) bf16x8*)(kpn + (j >> 1) * 2048 + (j & 1) * 512); }
        }
        DA_SBAR();
    }
    if constexpr (QK) { l_reg += s0 + s1; pw[0] = pwn[0]; pw[1] = pwn[1]; pw[2] = pwn[2]; pw[3] = pwn[3]; }
#undef DA_FOFF
}

template <bool QK, bool PV>
__device__ __forceinline__ void step2(lds_cptr kpn, lds_cptr vp, const bf16x8 (&qr)[4], bf16x8 (&kf)[8], f32x16 (&o)[4], u32x4 (&pw)[4], float& l_reg, const DmaJob& dj,
                                      f32x16& Cn0, f32x16& Cn1, const f32x16& Pp0, const f32x16& Pp1) {
    s16x4 vlo[4], vhi[4];
#define DA_FOFF(f) ((((f) & 3) * 4096) + (((f) >> 2) * 1024))
    if constexpr (!QK) { dma_piece(dj, 0); dma_piece(dj, 1); dma_piece(dj, 2); dma_piece(dj, 3); }
    float s0 = 0.f, s1 = 0.f;
#pragma unroll
    for (int a = 0; a < 8; ++a) {
        if constexpr (PV) { if (a >= 4) { vlo[a - 4] = vtr(vp + DA_FOFF(a - 4)); vhi[a - 4] = vtr(vp + DA_FOFF(a - 4) + 512); DA_SBAR(); } }
        if constexpr (QK) {
            if (a & 1) Cn1 = (a < 2) ? DA_MFMA(kf[a], qr[a >> 1], f32x16{}) : DA_MFMA(kf[a], qr[a >> 1], Cn1);
            else       Cn0 = (a < 2) ? DA_MFMA(kf[a], qr[a >> 1], f32x16{}) : DA_MFMA(kf[a], qr[a >> 1], Cn0);
            if (a < 4) dma_piece(dj, a);
        }
        if constexpr (PV) {
            float x0, x1, x2, x3;
            if (a < 4) { x0 = Pp0[4 * a]; x1 = Pp0[4 * a + 1]; x2 = Pp0[4 * a + 2]; x3 = Pp0[4 * a + 3]; }
            else       { x0 = Pp1[4 * a - 16]; x1 = Pp1[4 * a - 15]; x2 = Pp1[4 * a - 14]; x3 = Pp1[4 * a - 13]; }
            s0 += x0; s1 += x1; s0 += x2; s1 += x3;
            pw[(2 * a) >> 2][(2 * a) & 3] = cvtpk_s(x0, x1); pw[(2 * a + 1) >> 2][(2 * a + 1) & 3] = cvtpk_s(x2, x3);
            DA_PIN(s0); DA_PIN(s1); DA_PIN(pw[(2 * a) >> 2]);
        }
        if constexpr (QK || PV) DA_SBAR();
    }
    if constexpr (PV) l_reg += s0 + s1;
#pragma unroll
    for (int p = 0; p < 16; ++p) {
        if constexpr (PV) {
            const bf16x8 vf = (bf16x8){vlo[p & 3][0], vlo[p & 3][1], vlo[p & 3][2], vlo[p & 3][3], vhi[p & 3][0], vhi[p & 3][1], vhi[p & 3][2], vhi[p & 3][3]};
            o[p & 3] = DA_MFMA(__builtin_bit_cast(bf16x8, pw[p >> 2]), vf, o[p & 3]);
            if (p < 12) { vlo[p & 3] = vtr(vp + DA_FOFF(p + 4)); vhi[p & 3] = vtr(vp + DA_FOFF(p + 4) + 512); }
        }
        if constexpr (QK) {
            if (p < 8) { Cn0[2 * p] = __builtin_amdgcn_exp2f(Cn0[2 * p]); Cn0[2 * p + 1] = __builtin_amdgcn_exp2f(Cn0[2 * p + 1]); DA_PIN(Cn0); }
            else       { Cn1[2 * p - 16] = __builtin_amdgcn_exp2f(Cn1[2 * p - 16]); Cn1[2 * p - 15] = __builtin_amdgcn_exp2f(Cn1[2 * p - 15]); DA_PIN(Cn1); }
            if (p >= 8) { const int j = p - 8; kf[j] = *(const __attribute__((address_space(3))) bf16x8*)(kpn + (j >> 1) * 2048 + (j & 1) * 512); }
        }
        if constexpr (QK || PV) DA_SBAR();
    }
#undef DA_FOFF
}

__device__ __forceinline__ void unit_prologue(const Unit& u, unsigned lds0, int lane, int wid, bf16x8 (&qr)[4]) {
    const int r32 = lane & 31, hi = lane >> 5, s = wid >> 2, g = wid & 3; const int NT = u.NT; const int wt = u.full ? (g < 2 ? NT - 1 : NT) : (g < 2 ? NT : 0);
    const bf16* ksrc = u.K + (long)lane * DM + wid * 8;
    const bf16* vsrc = u.V + (long)(16 * (wid & 3) + (lane >> 2)) * DM + (wid >> 2) * 32 + (lane & 3) * 8;
    const unsigned kdst = lds0 + wid * 1024, vdst = lds0 + VRING + wid * 1024;
#pragma unroll
    for (int t = 0; t < 3; ++t) { const int tt_ = t < NT ? t : NT - 1; const bf16* kp_ = ksrc + (long)tt_ * 64 * DM;
        glds16(kp_, (unsigned)__builtin_amdgcn_readfirstlane(kdst + t * KSLOT)); glds16(kp_ + 64, (unsigned)__builtin_amdgcn_readfirstlane(kdst + 8192 + t * KSLOT)); }
    glds16(vsrc, (unsigned)__builtin_amdgcn_readfirstlane(vdst)); glds16(vsrc + 64, (unsigned)__builtin_amdgcn_readfirstlane(vdst + 8192));
    const bf16* Qw = u.Q + (long)(32 * g + r32) * DM + s * 64;
#pragma unroll
    for (int d0 = 0; d0 < 4; ++d0) qr[d0] = (wt > 0) ? *reinterpret_cast<const bf16x8*>(Qw + d0 * 16 + hi * 8) : (bf16x8){0, 0, 0, 0, 0, 0, 0, 0};
}
template <int VAR>
__device__ __forceinline__ void attn_unit(const Unit& u, bool has_next, const Unit& nxt, bool prefetched, bf16x8 (&qr)[4], char* shm, float* wsf_base, float lam, float one_m_li, const float* sub_gain, int tid) {
    asm volatile("" : "+v"(tid));
    const int lane = tid & 63, r32 = lane & 31, hi = lane >> 5; const int wid = __builtin_amdgcn_readfirstlane(tid >> 6), s = wid >> 2, g = wid & 3;
    const int NT = u.NT; const int wt = u.full ? (g < 2 ? NT - 1 : NT) : (g < 2 ? NT : 0);
    const unsigned lds0 = (unsigned)(uintptr_t)shm;
    float* wsf = wsf_base + wid * 64;
    const bf16* ksrc = u.K + (long)lane * DM + wid * 8;
    const bf16* vsrc = u.V + (long)(16 * (wid & 3) + (lane >> 2)) * DM + (wid >> 2) * 32 + (lane & 3) * 8;
    const unsigned kdst = lds0 + wid * 1024, vdst = lds0 + VRING + wid * 1024;
#define DA_DMA_K(t, slot) do { const int tt_ = u.dma0 ? 0 : (t) < NT ? (t) : NT - 1; const bf16* kp_ = ksrc + (long)tt_ * 64 * DM; \
        glds16(kp_, (unsigned)__builtin_amdgcn_readfirstlane(kdst + (slot) * KSLOT)); glds16(kp_ + 64, (unsigned)__builtin_amdgcn_readfirstlane(kdst + 8192 + (slot) * KSLOT)); } while (0)
#define DA_DMA_V(t, slot) do { const int tt_ = u.dma0 ? 0 : (t) < NT ? (t) : NT - 1; const bf16* vp_ = vsrc + (long)tt_ * 64 * DM; \
        glds16(vp_, (unsigned)__builtin_amdgcn_readfirstlane(vdst + (slot) * VSLOT)); glds16(vp_ + 64, (unsigned)__builtin_amdgcn_readfirstlane(vdst + 8192 + (slot) * VSLOT)); } while (0)
    const lds_cptr shm3 = (lds_cptr)shm;
    const lds_cptr kp0 = shm3 + s * 8192 + hi * 1024 + r32 * 16;
    const lds_cptr vp0 = shm3 + VRING + ((lane >> 4) & 1) * 32 + (lane & 3) * 8 + (4 * hi + ((lane & 15) >> 2)) * 64;
    if (!prefetched) unit_prologue(u, lds0, lane, wid, qr);
    asm volatile("" : "+v"(qr[0]), "+v"(qr[1]), "+v"(qr[2]), "+v"(qr[3]));
    f32x16 o[4]; o[0] = f32x16{}; o[1] = f32x16{}; o[2] = f32x16{}; o[3] = f32x16{};
    float l_reg = 0.f;
    u32x4 pw[4]; pw[0] = u32x4{}; pw[1] = u32x4{}; pw[2] = u32x4{}; pw[3] = u32x4{};
    DA_WAIT_BAR(0);
    bf16x8 kf[8];
#pragma unroll
    for (int j = 0; j < 8; ++j) kf[j] = *(const __attribute__((address_space(3))) bf16x8*)(kp0 + (j >> 1) * 2048 + (j & 1) * 512);
    int ks_cur = 0  , vs_prev = 2  ;
#define DA_TOP(t) \
        DA_WAIT_BAR(4);                                          \
        const int ks_next = (ks_cur == 2) ? 0 : ks_cur + 1, vs_cur = (vs_prev == 2) ? 0 : vs_prev + 1, vs_next = (vs_cur == 2) ? 0 : vs_cur + 1; \
        DmaJob dj; { const int tk_ = ((t) + 3) < NT ? ((t) + 3) : NT - 1, tv_ = ((t) + 1) < NT ? ((t) + 1) : NT - 1; dj.kp = ksrc + (long)tk_ * 64 * DM; dj.vp = vsrc + (long)tv_ * 64 * DM; \
          dj.kd0 = (unsigned)__builtin_amdgcn_readfirstlane(kdst + ks_cur * KSLOT); dj.kd1 = dj.kd0 + 8192u; dj.vd0 = (unsigned)__builtin_amdgcn_readfirstlane(vdst + vs_next * VSLOT); dj.vd1 = dj.vd0 + 8192u; }     \
        const lds_cptr kpn = kp0 + ks_next * KSLOT; const lds_cptr vp = vp0 + vs_prev * VSLOT; (void)kpn; (void)vp
#define DA_ROT() do { ks_cur = ks_next; vs_prev = vs_cur; } while (0)
    f32x16 pA0 = f32x16{}, pA1 = f32x16{}, pB0 = f32x16{}, pB1 = f32x16{};
#define DA_IDLE() do { dma_piece(dj, 0); dma_piece(dj, 1); dma_piece(dj, 2); dma_piece(dj, 3); } while (0)
    if (wid >= 4) __builtin_amdgcn_s_setprio(1);
    int t = 0;
    const bool odd = ((wt - 1) & 1) != 0;
    { DA_TOP(0); if (wt > 0) { if (odd) step2<true, false>(kpn, vp, qr, kf, o, pw, l_reg, dj, pB0, pB1, pA0, pA1); else step2<true, false>(kpn, vp, qr, kf, o, pw, l_reg, dj, pA0, pA1, pB0, pB1); } else DA_IDLE(); DA_ROT(); }
    t = 1;
    if (wt > 0 && odd) { DA_TOP(t); step2<true, true>(kpn, vp, qr, kf, o, pw, l_reg, dj, pA0, pA1, pB0, pB1); DA_ROT(); ++t; }
    for (; t + 1 < wt; t += 2) {
        { DA_TOP(t);     step2<true, true>(kpn, vp, qr, kf, o, pw, l_reg, dj, pB0, pB1, pA0, pA1); DA_ROT(); }
        { DA_TOP(t + 1); step2<true, true>(kpn, vp, qr, kf, o, pw, l_reg, dj, pA0, pA1, pB0, pB1); DA_ROT(); }
    }
    if (wt > 0) { DA_TOP(t); step2<false, true>(kpn, vp, qr, kf, o, pw, l_reg, dj, pB0, pB1, pA0, pA1); DA_ROT(); ++t; }
    for (; t <= NT; ++t) { DA_TOP(t); DA_IDLE(); DA_ROT(); }
#undef DA_IDLE
#undef DA_TOP
#undef DA_ROT
    __builtin_amdgcn_s_setprio(0);
    { auto rr = __builtin_amdgcn_permlane32_swap(__float_as_uint(l_reg), __float_as_uint(l_reg), false, false); l_reg = __uint_as_float(rr[0]) + __uint_as_float(rr[1]); }
    if (hi == 0) wsf[r32] = l_reg;
    DA_WAIT_BAR(0);
    if (has_next) unit_prologue(nxt, lds0, lane, wid, qr);
    float rli[16];
#pragma unroll
    for (int r = 0; r < 16; ++r) { const float lq = wsf[crow(r, hi)]; rli[r] = (s == 0 ? 1.f : -lam) / lq; }
    int le = lane; asm volatile("" : "+v"(le));
    const int r32e = le & 31, hie = le >> 5;
    float* xch = (float*)(shm + 65536 + g * XCHB);
    if (s == 1 && wt > 0) {
#pragma unroll
        for (int db = 0; db < 4; ++db)
#pragma unroll
            for (int r = 0; r < 16; ++r) xch[(db * 16 + r) * 64 + le] = o[db][r] * rli[r];
    }
    asm volatile("s_waitcnt lgkmcnt(0)\n\ts_barrier" ::: "memory");
    if (s == 0 && wt > 0) {
#pragma unroll
        for (int db = 0; db < 4; ++db)
#pragma unroll
            for (int r = 0; r < 16; ++r) o[db][r] = o[db][r] * rli[r] + xch[(db * 16 + r) * 64 + le];
        asm volatile("s_waitcnt lgkmcnt(0)" ::: "memory");
#pragma unroll
        for (int db = 0; db < 4; ++db)
#pragma unroll
            for (int r = 0; r < 16; ++r) xch[crow(r, hie) * STP + 32 * db + r32e] = o[db][r];
        asm volatile("s_waitcnt lgkmcnt(0)" ::: "memory");
        const int row = le >> 1, half = le & 1;
        float v[64]; float ss = 0.f;
#pragma unroll
        for (int k = 0; k < 16; ++k) { const f32x4 x = *(const f32x4*)(xch + row * STP + half * 64 + 4 * k); v[4 * k] = x.x; v[4 * k + 1] = x.y; v[4 * k + 2] = x.z; v[4 * k + 3] = x.w; ss += (x.x * x.x + x.y * x.y) + (x.z * x.z + x.w * x.w); }
        ss += __shfl_xor(ss, 1);
        const float sc = one_m_li / sqrtf(ss * (1.f / 128.f) + EPS);
        const bf16* gp = u.G + (long)(32 * g + row) * DM + half * 64; bf16* op = u.AO + (long)(32 * g + row) * DM + half * 64; const float* sg = sub_gain + half * 64;
#pragma unroll
        for (int k = 0; k < 8; ++k) { const v4u g4 = *(const v4u*)(gp + 8 * k); const f32x4 ga = *(const f32x4*)(sg + 8 * k), gb = *(const f32x4*)(sg + 8 * k + 4);
            const float gg[8] = {bflo(g4.x), bfhi(g4.x), bflo(g4.y), bfhi(g4.y), bflo(g4.z), bfhi(g4.z), bflo(g4.w), bfhi(g4.w)};
            const float gn[8] = {ga.x, ga.y, ga.z, ga.w, gb.x, gb.y, gb.z, gb.w}; float y[8];
#pragma unroll
            for (int e = 0; e < 8; ++e) y[e] = v[8 * k + e] * sc * gn[e] * silu_f(gg[e]);
            v4u w; w.x = pk2(y[0], y[1]); w.y = pk2(y[2], y[3]); w.z = pk2(y[4], y[5]); w.w = pk2(y[6], y[7]);
            *(v4u*)(op + 8 * k) = w; }
    }
#undef DA_DMA_K
#undef DA_DMA_V
}
}
template <int VAR = 0>
__device__ __forceinline__ void attn_fast(Frame& F, const bf16* Qs, const bf16* KP, const bf16* VP, const bf16* KC, const bf16* VC, const bf16* GA  , bf16* AO,
                                          float lam, float one_m_li, const float* sub_gain, int dma0 = 0) {
    const int NU = 2048 + 16 * NB;
    const bool xcd = (F.G == 256);
#define ATTN_GET(i_, u_, ok_) do { int qb = 0, h = 0, b = -1; ok_ = true; \
        if (xcd) { const int x = F.bid & 7, r = F.bid >> 3; \
            if ((i_) < 8) { h = x + 8 * ((i_) >> 2); const int rr = ((i_) == 0) ? (r ^ 8) : r; qb = 127 - (((i_) & 3) * 32 + (((i_) & 1) ? 31 - rr : rr)); } \
            else if ((i_) == 8 && (r & 8) == 0) { const int sb = (r & 7) + ((r >> 4) << 3); h = x + 8 * (sb >> 3); b = sb & 7; } \
            else ok_ = false; \
        } else { const int idx = (i_) * F.G + (((i_) & 1) ? F.G - 1 - F.bid : F.bid); if (idx >= NU) ok_ = false; \
            else if (idx < 2048) { qb = 127 - (idx >> 4); h = idx & 15; } else { const int j = idx - 2048; b = j >> 4; h = j & 15; } } \
        u_.dma0 = 0; \
        if (ok_) { if (b < 0) { const long row0 = 128L * qb; \
            u_.Q = Qs + row0 * DM + h * 128; u_.K = KP + h * 128; u_.V = VP + h * 128; u_.G = GA + row0 * DM + h * 128; u_.AO = AO + row0 * DM + h * 128; u_.NT = 2 * qb + 2; u_.full = 1; } \
          else { const long row0 = MP + 64L * b; \
            u_.Q = Qs + row0 * DM + h * 128; u_.K = KC + (long)b * KCROWS * DM + h * 128; u_.V = VC + (long)b * KCROWS * DM + h * 128; u_.G = GA + row0 * DM + h * 128; u_.AO = AO + row0 * DM + h * 128; u_.NT = KCROWS / 64; u_.full = 0; } } } while (0)
    dattn::Unit u, nx; bool have; ATTN_GET(0, u, have);
    dattn::bf16x8 qr[4]; bool pre = false;
    float* wsf_base = (float*)((char*)F.lds + MISC_OFF + 1024);
    for (int i = 0; have; ++i) {
        bool hn; ATTN_GET(i + 1, nx, hn);
        dattn::attn_unit<VAR>(u, hn, nx, pre, qr, (char*)F.lds + RING_OFF, wsf_base, lam, one_m_li, sub_gain, F.tid);
        u = nx; have = hn; pre = true;
    }
    __syncthreads();
#undef ATTN_GET
}
constexpr int RBLK = 72;
__device__ __forceinline__ float ret_lg2(int h) { return log2f(1.f - exp2f(-5.f - (float)h)); }
struct EpiRet {
    static constexpr int BMODE = 0;
    pg8::bf16_t* QP; pg8::bf16_t* KN; pg8::bf16_t* KT; pg8::bf16_t* VS; pg8::bf16_t* RG; const float* tab; const float* ssq;
    __device__ __forceinline__ void operator()(const pg8::f32x4 (&acc)[2][2][4][2], const pg8::Unit& u, int wr, int wc, int fr, int fq) const {
        { const int l_ = lane_now(); fr = l_ & 15; fq = l_ >> 4; }
        const int pn = u.pn, pm = u.pm; float rs[2][4]; row_rstd(ssq, pm, wr, fr, fq, rs);
#pragma unroll
        for (int ai = 0; ai < 2; ++ai)
#pragma unroll
            for (int m = 0; m < 4; ++m) {
                const int i = ai * 128 + wr * 64 + m * 16 + fr; const size_t row = (size_t)pm * 256 + i;
                const int J = pm < 64 ? pm : 64 + 4 * (pm - 64) + (i >> 6), jj = pm < 64 ? i : (i & 63), pos = pm < 64 ? (int)row : PAST + (i & 63);
                if (pn < 16) {
                    const int h = pn & 7; const bool isk = pn >= 8; const float sc = isk ? 0.0625f : 1.f;
#pragma unroll
                    for (int n = 0; n < 2; ++n) { const int c1 = wc * 32 + n * 16 + 4 * fq;
                        const pg8::f32x4 t0 = *(const pg8::f32x4*)(tab + ((size_t)pos * 128 + c1) * 2), t1 = *(const pg8::f32x4*)(tab + ((size_t)pos * 128 + c1) * 2 + 4);
                        const pg8::f32x4 x1 = acc[ai][0][m][n] * rs[ai][m], x2 = acc[ai][1][m][n] * rs[ai][m];
                        const float cs[4] = {t0[0], t0[2], t1[0], t1[2]}, sn[4] = {t0[1], t0[3], t1[1], t1[3]}; float o1[4], o2[4];
#pragma unroll
                        for (int e = 0; e < 4; ++e) { o1[e] = (x1[e] * cs[e] - x2[e] * sn[e]) * sc; o2[e] = (x2[e] * cs[e] + x1[e] * sn[e]) * sc; }
                        v2u w1, w2; w1.x = pk2(o1[0], o1[1]); w1.y = pk2(o1[2], o1[3]); w2.x = pk2(o2[0], o2[1]); w2.y = pk2(o2[2], o2[3]);
                        if (!isk) { pg8::bf16_t* p = QP + row * 4096 + h * 512 + 256 + c1; *(v2u*)p = w1; *(v2u*)(p + 128) = w2; }
                        else { pg8::bf16_t* p = KN + row * 2048 + h * 256 + c1; *(v2u*)p = w1; *(v2u*)(p + 128) = w2;
                            pg8::bf16_t* t = KT + ((size_t)(J * 8 + h) * 256 + c1) * 256 + jj;
#pragma unroll
                            for (int e = 0; e < 4; ++e) { t[(size_t)e * 256] = (pg8::bf16_t)f2bf(o1[e]); t[(size_t)(128 + e) * 256] = (pg8::bf16_t)f2bf(o2[e]); } } }
                } else if (pn < 32) {
                    const int h = (pn - 16) >> 1, half = (pn - 16) & 1; const float f = exp2f(-(float)(1 + jj) * ret_lg2(h)) * rs[ai][m];
#pragma unroll
                    for (int bj = 0; bj < 2; ++bj)
#pragma unroll
                        for (int n = 0; n < 2; ++n) { const int dv = half * 256 + bj * 128 + wc * 32 + n * 16 + 4 * fq; pg8::bf16_t* t = VS + ((size_t)(J * 8 + h) * 512 + dv) * 512 + jj;
#pragma unroll
                            for (int e = 0; e < 4; ++e) t[(size_t)e * 512] = (pg8::bf16_t)f2bf(acc[ai][bj][m][n][e] * f); }
                } else {
#pragma unroll
                    for (int bj = 0; bj < 2; ++bj)
#pragma unroll
                        for (int n = 0; n < 2; ++n) { const int c = (pn - 32) * 256 + bj * 128 + wc * 32 + n * 16 + 4 * fq; const pg8::f32x4 x = acc[ai][bj][m][n] * rs[ai][m];
                            v2u w; w.x = pk2(x[0], x[1]); w.y = pk2(x[2], x[3]); *(v2u*)(RG + row * 4096 + c) = w; }
                }
            }
    }
};
__device__ __forceinline__ size_t ret_row0(int J) { return J < 64 ? (size_t)256 * J : (size_t)MP + 64 * (J - 64); }
struct RetQKOrder {
    int G, c; const char* QP; const char* KN;
    __device__ __forceinline__ bool next(int i, pg8::Unit& u) const { const int L = i * G + c; if (L >= RBLK * 8) return false; const int J = L >> 3, h = L & 7; const size_t r0 = ret_row0(J);
        u.pm = J; u.pn = h; u.a = QP + (r0 * 4096 + h * 512 + 256) * 2; u.b = KN + (r0 * 2048 + h * 256) * 2; return true; }
    __device__ __forceinline__ void a_ready(const pg8::Unit&) const {}
    __device__ __forceinline__ void done(const pg8::Unit&) const {}
};
struct EpiRetQK {
    static constexpr int BMODE = 1;
    pg8::bf16_t* QP;
    __device__ __forceinline__ void operator()(const pg8::f32x4 (&acc)[2][2][4][2], const pg8::Unit& u, int wr, int wc, int fr, int fq) const {
        { const int l_ = lane_now(); fr = l_ & 15; fq = l_ >> 4; }
        const int J = u.pm, h = u.pn, nv = J < 64 ? 256 : 64; const size_t r0 = ret_row0(J);
#pragma unroll
        for (int ai = 0; ai < 2; ++ai)
#pragma unroll
            for (int m = 0; m < 4; ++m) { const int i = ai * 128 + wr * 64 + m * 16 + fr;
                if (i < nv) {
#pragma unroll
                    for (int bj = 0; bj < 2; ++bj) { const int j0 = bj * 128 + wc * 32 + 8 * fq; const pg8::f32x4 v0 = acc[ai][bj][m][0], v1 = acc[ai][bj][m][1]; float x[8] = {v0[0], v0[1], v0[2], v0[3], v1[0], v1[1], v1[2], v1[3]};
#pragma unroll
                        for (int k = 0; k < 8; ++k) x[k] = (j0 + k <= i) ? x[k] : 0.f;
                        v4u w; w.x = pk2(x[0], x[1]); w.y = pk2(x[2], x[3]); w.z = pk2(x[4], x[5]); w.w = pk2(x[6], x[7]);
                        *(v4u*)(QP + (r0 + i) * 4096 + h * 512 + j0) = w; } } }
    }
};
struct RetOOrder {
    int G, c; const char* QP; const char* VS;
    __device__ __forceinline__ bool next(int i, pg8::Unit& u) const { const int L = i * G + c; if (L >= RBLK * 16) return false; const int J = L >> 4, r = L & 15, h = r >> 1, half = r & 1; const size_t r0 = ret_row0(J);
        u.pm = J; u.pn = r; u.a = QP + (r0 * 4096 + h * 512) * 2; u.b = VS + (((size_t)(J * 8 + h) * 512 + half * 256) * 512) * 2; return true; }
    __device__ __forceinline__ void a_ready(const pg8::Unit&) const {}
    __device__ __forceinline__ void done(const pg8::Unit&) const {}
};
struct EpiRetO {
    static constexpr int BMODE = 1;
    pg8::bf16_t* O;
    __device__ __forceinline__ void operator()(const pg8::f32x4 (&acc)[2][2][4][2], const pg8::Unit& u, int wr, int wc, int fr, int fq) const {
        { const int l_ = lane_now(); fr = l_ & 15; fq = l_ >> 4; }
        const int J = u.pm, h = u.pn >> 1, half = u.pn & 1, nv = J < 64 ? 256 : 64; const size_t r0 = ret_row0(J); const float lg = ret_lg2(h);
#pragma unroll
        for (int ai = 0; ai < 2; ++ai)
#pragma unroll
            for (int m = 0; m < 4; ++m) { const int i = ai * 128 + wr * 64 + m * 16 + fr;
                if (i < nv) { const float f = exp2f((float)(i + 1) * lg);
#pragma unroll
                    for (int bj = 0; bj < 2; ++bj) { const int j0 = bj * 128 + wc * 32 + 8 * fq; const pg8::f32x4 v0 = acc[ai][bj][m][0] * f, v1 = acc[ai][bj][m][1] * f;
                        v4u w; w.x = pk2(v0[0], v0[1]); w.y = pk2(v0[2], v0[3]); w.z = pk2(v1[0], v1[1]); w.w = pk2(v1[2], v1[3]);
                        *(v4u*)(O + (r0 + i) * 4096 + h * 512 + half * 256 + j0) = w; } } }
    }
};
struct RetKVOrder {
    int G, c; const char* VS; const char* KT;
    __device__ __forceinline__ bool next(int i, pg8::Unit& u) const { const int L = i * G + c; if (L >= RBLK * 16) return false; const int J = L >> 4, r = L & 15, h = r >> 1, half = r & 1;
        u.pm = J; u.pn = r; u.a = VS + (((size_t)(J * 8 + h) * 512 + half * 256) * 512) * 2; u.b = KT + ((size_t)(J * 8 + h) * 256 * 256) * 2; return true; }
    __device__ __forceinline__ void a_ready(const pg8::Unit&) const {}
    __device__ __forceinline__ void done(const pg8::Unit&) const {}
};
struct EpiRetKV {
    static constexpr int BMODE = 1;
    pg8::bf16_t* VS; pg8::bf16_t* KVX;
    __device__ __forceinline__ void operator()(const pg8::f32x4 (&acc)[2][2][4][2], const pg8::Unit& u, int wr, int wc, int fr, int fq) const {
        { const int l_ = lane_now(); fr = l_ & 15; fq = l_ >> 4; }
        const int J = u.pm, h = u.pn >> 1, half = u.pn & 1;
        pg8::bf16_t* base; int pitch;
        if (J < 63) { base = VS + ((size_t)((J + 1) * 8 + h) * 512 + half * 256) * 512 + 256; pitch = 512; }
        else { base = KVX + ((size_t)((J - 63) * 8 + h) * 512 + half * 256) * 256; pitch = 256; }
#pragma unroll
        for (int ai = 0; ai < 2; ++ai)
#pragma unroll
            for (int m = 0; m < 4; ++m) { pg8::bf16_t* rowp = base + (size_t)(ai * 128 + wr * 64 + m * 16 + fr) * pitch + wc * 32 + 8 * fq;
#pragma unroll
                for (int bj = 0; bj < 2; ++bj) { const pg8::f32x4 v0 = acc[ai][bj][m][0], v1 = acc[ai][bj][m][1];
                    v4u w; w.x = pk2(v0[0], v0[1]); w.y = pk2(v0[2], v0[3]); w.z = pk2(v1[0], v1[1]); w.w = pk2(v1[2], v1[3]);
                    *(v4u*)(rowp + bj * 128) = w; } }
    }
};
__device__ __forceinline__ void ret_scan(Frame& F, bf16* VS, const bf16* KVX, const float* state_in, float* osp, float* oss) {
    const int gt = F.bid * NTHR + F.tid;
    for (int c = gt; c < 8 * 512 * 32; c += F.G * NTHR) {
        const int h = c >> 14, dv = (c >> 5) & 511, dk0 = (c & 31) * 8; const float lg = ret_lg2(h), g256 = exp2f(256.f * lg), g64 = exp2f(64.f * lg);
        float S[8];
#pragma unroll
        for (int k = 0; k < 8; ++k) S[k] = 0.f;
        bf16* slot = VS + ((size_t)h * 512 + dv) * 512 + 256 + dk0;
        *(v4u*)slot = (v4u){0u, 0u, 0u, 0u};
        v4u nx = *(const v4u*)(slot + (size_t)8 * 512 * 512);
        for (int J = 1; J < 64; ++J) {
            const v4u kv = nx; bf16* sj = slot + (size_t)J * 8 * 512 * 512;
            if (J < 63) nx = *(const v4u*)(sj + (size_t)8 * 512 * 512);
            const float x[8] = {bflo(kv.x), bfhi(kv.x), bflo(kv.y), bfhi(kv.y), bflo(kv.z), bfhi(kv.z), bflo(kv.w), bfhi(kv.w)};
#pragma unroll
            for (int k = 0; k < 8; ++k) S[k] = (S[k] + x[k]) * g256;
            v4u w; w.x = pk2(S[0], S[1]); w.y = pk2(S[2], S[3]); w.z = pk2(S[4], S[5]); w.w = pk2(S[6], S[7]);
            *(v4u*)sj = w;
        }
        { const v4u kv = *(const v4u*)(KVX + ((size_t)h * 512 + dv) * 256 + dk0);
          const float x[8] = {bflo(kv.x), bfhi(kv.x), bflo(kv.y), bfhi(kv.y), bflo(kv.z), bfhi(kv.z), bflo(kv.w), bfhi(kv.w)};
#pragma unroll
          for (int k = 0; k < 8; ++k) NT_STORE((S[k] + x[k]) * g256, osp + ((size_t)h * 256 + dk0 + k) * 512 + dv); }
    }
    for (int c = gt; c < NB * 8 * 512 * 32; c += F.G * NTHR) {
        const int dv = c & 511, dk0 = ((c >> 9) & 31) * 8, h = (c >> 14) & 7, b = c >> 17; const float g64 = exp2f(64.f * ret_lg2(h));
        const float* si = state_in + (((size_t)b * 8 + h) * 256 + dk0) * 512 + dv; float* so = oss + (((size_t)b * 8 + h) * 256 + dk0) * 512 + dv;
        const v4u kv = *(const v4u*)(KVX + ((size_t)((1 + b) * 8 + h) * 512 + dv) * 256 + dk0);
        const float x[8] = {bflo(kv.x), bfhi(kv.x), bflo(kv.y), bfhi(kv.y), bflo(kv.z), bfhi(kv.z), bflo(kv.w), bfhi(kv.w)}; float s0[8];
#pragma unroll
        for (int k = 0; k < 8; ++k) s0[k] = NT_LOAD(si + (size_t)k * 512);
        v4u w; w.x = pk2(s0[0], s0[1]); w.y = pk2(s0[2], s0[3]); w.z = pk2(s0[4], s0[5]); w.w = pk2(s0[6], s0[7]);
        *(v4u*)(VS + ((size_t)((64 + b) * 8 + h) * 512 + dv) * 512 + 256 + dk0) = w;
#pragma unroll
        for (int k = 0; k < 8; ++k) NT_STORE((s0[k] + x[k]) * g64, so + (size_t)k * 512);
    }
}
__device__ __forceinline__ void ret_zero_pad(Frame& F, bf16* VS, bf16* KT) {
    const size_t gt = (size_t)F.bid * NTHR + F.tid, NG = (size_t)F.G * NTHR, n = (size_t)NB * 8 * 512 * 24, n2 = (size_t)NB * 8 * 256 * 24;
    for (size_t i = gt; i < n; i += NG) { const size_t rowi = i / 24, c = i % 24; *(v4u*)(VS + ((size_t)64 * 8 * 512 + rowi) * 512 + 64 + c * 8) = (v4u){0u, 0u, 0u, 0u}; }
    for (size_t i = gt; i < n2; i += NG) { const size_t rowi = i / 24, c = i % 24; *(v4u*)(KT + ((size_t)64 * 8 * 256 + rowi) * 256 + 64 + c * 8) = (v4u){0u, 0u, 0u, 0u}; }
}
__device__ __forceinline__ void ret_table(Frame& F, float* tab) {
    const size_t gt = (size_t)F.bid * NTHR + F.tid, NG = (size_t)F.G * NTHR;
    for (size_t e = gt; e < (size_t)MP * 128; e += NG) { float c, s; rope_cs((int)(e >> 7), (int)(e & 127), 128, c, s); tab[2 * e] = c; tab[2 * e + 1] = s; }
}
__device__ __forceinline__ void r_out(Frame& F, bf16* O, const bf16* RG) {
    const int gw = F.bid * NWAVES + F.wave, NGW = F.G * NWAVES, lane = F.lane;
    for (int it = gw; it < MT * 8; it += NGW) {
        const int row = it >> 3, h = it & 7; const size_t off = (size_t)row * 4096 + h * 512 + lane * 8;
        const v4u o4 = *(const v4u*)(O + off), g4 = NT_LOAD((const v4u*)(RG + off));
        float o[8] = {bflo(o4.x), bfhi(o4.x), bflo(o4.y), bfhi(o4.y), bflo(o4.z), bfhi(o4.z), bflo(o4.w), bfhi(o4.w)};
        const float g[8] = {bflo(g4.x), bfhi(g4.x), bflo(g4.y), bfhi(g4.y), bflo(g4.z), bfhi(g4.z), bflo(g4.w), bfhi(g4.w)};
        float ss = 0.f;
#pragma unroll
        for (int k = 0; k < 8; ++k) ss += o[k] * o[k];
        const float rstd = 1.f / sqrtf(wave_sum(ss) * (1.f / 512.f) + EPS);
#pragma unroll
        for (int k = 0; k < 8; ++k) o[k] = o[k] * rstd * silu_f(g[k]);
        v4u w; w.x = pk2(o[0], o[1]); w.y = pk2(o[2], o[3]); w.z = pk2(o[4], o[5]); w.w = pk2(o[6], o[7]);
        *(v4u*)(O + off) = w;
    }
}
struct EpiCIn {
    static constexpr int BMODE = 0;
    pg8::bf16_t* GU; pg8::bf16_t* GVT; pg8::bf16_t* SG; pg8::bf16_t* GVS; float* SSQ; const float* ssq;
    __device__ __forceinline__ void operator()(const pg8::f32x4 (&acc)[2][2][4][2], const pg8::Unit& u, int wr, int wc, int fr, int fq) const {
        { const int l_ = lane_now(); fr = l_ & 15; fq = l_ >> 4; }
        const int pn = u.pn, pm = u.pm, typ = pn >> 4, pt = pn & 15; float rs[2][4]; row_rstd(ssq, pm, wr, fr, fq, rs);
#pragma unroll
        for (int ai = 0; ai < 2; ++ai)
#pragma unroll
            for (int m = 0; m < 4; ++m) {
                const int i = ai * 128 + wr * 64 + m * 16 + fr; const size_t row = (size_t)pm * 256 + i; float ss = 0.f;
#pragma unroll
                for (int bj = 0; bj < 2; ++bj)
#pragma unroll
                    for (int n = 0; n < 2; ++n) { const int c = pt * 256 + bj * 128 + wc * 32 + n * 16 + 4 * fq; const pg8::f32x4 x = acc[ai][bj][m][n] * rs[ai][m]; float y[4];
                        if (typ == 2) {
#pragma unroll
                            for (int e = 0; e < 4; ++e) y[e] = silu_f(x[e]);
                            v2u w; w.x = pk2(y[0], y[1]); w.y = pk2(y[2], y[3]); *(v2u*)(SG + row * 4096 + c) = w;
                        } else {
#pragma unroll
                            for (int e = 0; e < 4; ++e) y[e] = gelu_tanh_f(x[e]);
                            v2u w; w.x = pk2(y[0], y[1]); w.y = pk2(y[2], y[3]);
                            if (typ == 0) *(v2u*)(GU + row * 4096 + c) = w;
                            else { ss += (y[0] * y[0] + y[1] * y[1]) + (y[2] * y[2] + y[3] * y[3]);
                                pg8::bf16_t* t = GVT + ((size_t)pm * 4096 + c) * 256 + i;
                                t[0] = (pg8::bf16_t)(w.x & 0xffffu); t[256] = (pg8::bf16_t)(w.x >> 16); t[512] = (pg8::bf16_t)(w.y & 0xffffu); t[768] = (pg8::bf16_t)(w.y >> 16);
                                if (pm >= 64) *(v2u*)(GVS + (row - MP) * 4096 + c) = w; } } }
                if (typ == 1) { ss += __shfl_xor(ss, 16); ss += __shfl_xor(ss, 32); if (fq == 0) SSQ[row * 64 + pt * 4 + wc] = ss; }
                if (m & 1) asm volatile("" ::: "memory");
            }
    }
};
__device__ __forceinline__ void c_prep(Frame& F, const float* SSQ, const float* wsin, const float* vgain, const bf16* GVS, bf16* Wm, float* ovm) {
    LAS float* rs = (LAS float*)(F.lds + RING_OFF);
    const int tid = F.tid;
    for (int it = F.bid; it < 66 * 8; it += F.G) {
        const int J = it >> 3, g = it & 7;
        __syncthreads();
        if (tid < 256) { const float* p = SSQ + ((size_t)J * 256 + tid) * 64; float s = 0.f;
#pragma unroll
            for (int k = 0; k < 16; ++k) { const f32x4 x = *(const f32x4*)(p + 4 * k); s += (x.x + x.y) + (x.z + x.w); }
            rs[tid] = 1.f / sqrtf(s * (1.f / 4096.f) + EPS); }
        __syncthreads();
        bf16* wm = Wm + (size_t)(J * 8 + g) * 65536; const int sh = J < 64 ? 7 : 6, cm = (1 << sh) - 1;
        for (int e8 = tid; e8 < 8192; e8 += NTHR) { const int i = e8 >> 5, j0 = (e8 & 31) * 8, il = i & cm, jl0 = j0 & cm; float y[8];
            if ((i >> sh) == (j0 >> sh) && jl0 <= il) { const float* wr_ = wsin + ((size_t)g * 128 + il) * 128 + jl0; const f32x4 a = *(const f32x4*)wr_, b = *(const f32x4*)(wr_ + 4);
                const float wv[8] = {a.x, a.y, a.z, a.w, b.x, b.y, b.z, b.w};
#pragma unroll
                for (int k = 0; k < 8; ++k) y[k] = (jl0 + k <= il) ? wv[k] * rs[j0 + k] : 0.f;
            } else {
#pragma unroll
                for (int k = 0; k < 8; ++k) y[k] = 0.f; }
            v4u w; w.x = pk2(y[0], y[1]); w.y = pk2(y[2], y[3]); w.z = pk2(y[4], y[5]); w.w = pk2(y[6], y[7]);
            *(v4u*)(wm + i * 256 + j0) = w; }
    }
    const int gw = F.bid * NWAVES + F.wave, NGW = F.G * NWAVES, lane = F.lane;
    for (int r = gw; r < MS; r += NGW) {
        const float rstd = 1.f / sqrtf(wave_sum(SSQ[((size_t)MP + r) * 64 + lane]) * (1.f / 4096.f) + EPS);
#pragma unroll
        for (int k = 0; k < 8; ++k) { const int col = k * 512 + lane * 8; const v4u v4 = *(const v4u*)(GVS + (size_t)r * 4096 + col);
            const f32x4 ga = *(const f32x4*)(vgain + col), gb = *(const f32x4*)(vgain + col + 4);
            float* o = ovm + (size_t)r * 4096 + col;
            *(f32x4*)o = (f32x4){bflo(v4.x) * rstd * ga.x, bfhi(v4.x) * rstd * ga.y, bflo(v4.y) * rstd * ga.z, bfhi(v4.y) * rstd * ga.w};
            *(f32x4*)(o + 4) = (f32x4){bflo(v4.z) * rstd * gb.x, bfhi(v4.z) * rstd * gb.y, bflo(v4.w) * rstd * gb.z, bfhi(v4.w) * rstd * gb.w}; }
    }
}
struct CMixOrder {
    int G, c; const char* Wm; const char* GVT;
    __device__ __forceinline__ bool next(int i, pg8::Unit& u) const { const int L = i * G + c; if (L >= 66 * 16) return false; const int J = L >> 4, nt = L & 15;
        u.pm = J; u.pn = nt; u.a = Wm + ((size_t)(J * 8 + (nt >> 1)) * 65536) * 2; u.b = GVT + (((size_t)J * 4096 + nt * 256) * 256) * 2; return true; }
    __device__ __forceinline__ void a_ready(const pg8::Unit&) const {}
    __device__ __forceinline__ void done(const pg8::Unit&) const {}
};
struct EpiCMix {
    static constexpr int BMODE = 1;
    pg8::bf16_t* GU; const pg8::bf16_t* SG; const float* vgain; const float* bs;
    __device__ __forceinline__ void operator()(const pg8::f32x4 (&acc)[2][2][4][2], const pg8::Unit& u, int wr, int wc, int fr, int fq) const {
        { const int l_ = lane_now(); fr = l_ & 15; fq = l_ >> 4; }
        const int J = u.pm, nt = u.pn, g = nt >> 1, cm = J < 64 ? 127 : 63;
#pragma unroll
        for (int bj = 0; bj < 2; ++bj) { const int c0 = nt * 256 + bj * 128 + wc * 32 + 8 * fq; const f32x4 ga = *(const f32x4*)(vgain + c0), gb = *(const f32x4*)(vgain + c0 + 4);
            const float gn[8] = {ga.x, ga.y, ga.z, ga.w, gb.x, gb.y, gb.z, gb.w};
#pragma unroll
            for (int ai = 0; ai < 2; ++ai)
#pragma unroll
                for (int m = 0; m < 4; ++m) { const int i = ai * 128 + wr * 64 + m * 16 + fr; const size_t off = ((size_t)J * 256 + i) * 4096 + c0; const float b = bs[g * 128 + (i & cm)];
                    const v4u u4 = *(const v4u*)(GU + off), s4 = NT_LOAD((const v4u*)(SG + off)); const pg8::f32x4 v0 = acc[ai][bj][m][0], v1 = acc[ai][bj][m][1];
                    const float mx[8] = {v0[0], v0[1], v0[2], v0[3], v1[0], v1[1], v1[2], v1[3]};
                    const float uu[8] = {bflo(u4.x), bfhi(u4.x), bflo(u4.y), bfhi(u4.y), bflo(u4.z), bfhi(u4.z), bflo(u4.w), bfhi(u4.w)};
                    const float sg[8] = {bflo(s4.x), bfhi(s4.x), bflo(s4.y), bfhi(s4.y), bflo(s4.z), bfhi(s4.z), bflo(s4.w), bfhi(s4.w)}; float y[8];
#pragma unroll
                    for (int k = 0; k < 8; ++k) y[k] = uu[k] * (mx[k] * gn[k] + b) * sg[k];
                    v4u w; w.x = pk2(y[0], y[1]); w.y = pk2(y[2], y[3]); w.z = pk2(y[4], y[5]); w.w = pk2(y[6], y[7]);
                    *(v4u*)(GU + off) = w; } }
    }
};
__device__ __forceinline__ float diff_lambda(const float* q1, const float* k1, const float* q2, const float* k2, float lam_init) {
    float a = 0.f, b = 0.f;
    for (int i = 0; i < 64; ++i) { a += q1[i] * k1[i]; b += q2[i] * k2[i]; }
    return expf(a) - expf(b) + lam_init;
}

constexpr int N_PHASES = 21;
__global__ void __launch_bounds__(NTHR, 2) mega(Args args) {
    extern __shared__ __attribute__((aligned(16))) unsigned char lds[];
    Frame F;
    F.lds = (LAS unsigned char*)lds; F.tid = threadIdx.x; F.lane = F.tid & 63; F.wave = __builtin_amdgcn_readfirstlane(F.tid >> 6); F.G = gridDim.x; F.bid = blockIdx.x;
    F.in = args.in; F.out = args.out; F.ws = args.ws;
    unsigned char* ws = args.ws; float* out = args.out;
    bf16* W_AIN[2] = {(bf16*)(ws + WS_WAIN0), (bf16*)(ws + WS_WAIN1)}; bf16* W_AOUT[2] = {(bf16*)(ws + WS_WAOUT0), (bf16*)(ws + WS_WAOUT1)};
    bf16* W_RIN = (bf16*)(ws + WS_WRIN); bf16* W_ROUT = (bf16*)(ws + WS_WROUT); bf16* W_CIN = (bf16*)(ws + WS_WCIN); bf16* W_COUT = (bf16*)(ws + WS_WCOUT);
    bf16* XN0 = (bf16*)(ws + WS_XN0); bf16* HB = (bf16*)(ws + WS_HB); float* SSQ2 = (float*)(ws + WS_SSQ2);
    bf16* Qs = (bf16*)(ws + WS_QS); bf16* KP = (bf16*)(ws + WS_KP); bf16* VP = (bf16*)(ws + WS_VP); bf16* KC = (bf16*)(ws + WS_KC); bf16* VC = (bf16*)(ws + WS_VC); bf16* AO_A = (bf16*)(ws + WS_AOA);
    bf16* KT = (bf16*)(ws + WS_KT); bf16* RG = (bf16*)(ws + WS_RG); bf16* QP = (bf16*)(ws + WS_QP); bf16* KN = (bf16*)(ws + WS_KN); bf16* VS = (bf16*)(ws + WS_VS); bf16* ORET = (bf16*)(ws + WS_ORET);
    bf16* GU = (bf16*)(ws + WS_GU); bf16* SG = (bf16*)(ws + WS_SG); bf16* GVT = (bf16*)(ws + WS_GVT); bf16* WM = (bf16*)(ws + WS_WM); float* SSQ = (float*)(ws + WS_SSQ); bf16* GVS = (bf16*)(ws + WS_GVS); float* TABR = (float*)(ws + WS_TABR); bf16* KVX = (bf16*)(ws + WS_KVX); float* TABA = (float*)(ws + WS_TABA); bf16* GA = (bf16*)(ws + WS_GA);
    const int lo = args.ph_lo, hi = args.ph_hi;
    volatile LAS unsigned* MISC = (volatile LAS unsigned*)(F.lds + MISC_OFF);
    for (int u = F.tid; u < (LDS_BYTES - MISC_OFF) / 4; u += NTHR) ((LAS unsigned*)(F.lds + MISC_OFF))[u] = 0u;
    __syncthreads();
    XcdBarrier bar = xcd_barrier_post((unsigned*)(ws + WS_CTL) + 4096, MISC + 8);
#define IN(k) (lo <= (k) && (k) < hi)
#define PH_ENTER() do { int t_ = F.wave * 64 + lane_now(); F.tid = t_; F.lane = t_ & 63; } while (0)
    volatile LAS int* DRW = (volatile LAS int*)(F.lds + MISC_OFF + 64);
    unsigned* DCTR = (unsigned*)(ws + WS_CTL) + 8192;
#define DRAIN(ph, total, BODY) do { PH_ENTER(); for (;;) { __syncthreads(); if (F.tid == 0) DRW[0] = (int)atomicAdd(DCTR + 64 * (ph), 1u); __syncthreads(); const int c_ = DRW[0]; if (c_ >= (total)) break; BODY } } while (0)
#define SEAM(k) do { if (IN(k) && IN((k) + 1)) xcd_barrier(bar, F.wave == 0 && lane_now() == 0); } while (0)

#define GEMM_STORE(Aptr, Wptr, NN, KK, Optr) do { pg8::GemmP g{KK, KK, (KK) / 64}; pg8::StaticOrder S; S.init(MT / 256, (NN) / 256, F.G, F.bid, Aptr, Wptr, KK, KK); pg8::EpiStoreBf16 E{(pg8::bf16_t*)(Optr), NN}; \
        pg8::gemm_phase<pg8::EpiStoreBf16, pg8::StaticOrder>(F.lds + RING_OFF, g, S, E, F.tid); } while (0)
#define GEMM_RESIDB(MODE_, Aptr, Wptr, KK) do { pg8::GemmP g{KK, KK, (KK) / 64}; pg8::StaticOrder S; S.init(MT / 256, DM / 256, F.G, F.bid, Aptr, Wptr, KK, KK); \
        pg8::EpiResidB<MODE_> E{args.in[I_XP], args.in[I_XS], (pg8::bf16_t*)HB, out, SSQ2}; pg8::gemm_phase<pg8::EpiResidB<MODE_>, pg8::StaticOrder>(F.lds + RING_OFF, g, S, E, F.tid); } while (0)

    PH_ENTER(); if (IN(0)) {
        transpose_weight(F, args.in[I_AWIN], 2048, 8192, W_AIN[0]); attn_table(F, TABA);
        norm_rows(F, args.in[I_XP], args.in[I_XS], args.in[I_NW], XN0);
    }
    SEAM(0);
#define GEMM_AIN(Aptr, Wptr, J_, SSQP) do { pg8::GemmP g{2048, 2048, 32}; pg8::StaticOrder S; S.init(MT / 256, 32, F.G, F.bid, Aptr, Wptr, 2048, 2048); \
        EpiAIn E{Qs, KP, VP, KC, VC, GA, out + O_KP + (size_t)(J_) * MP * DM, out + O_VP + (size_t)(J_) * MP * DM, out + O_KS + (size_t)(J_) * MS * DM, out + O_VS + (size_t)(J_) * MS * DM, TABA, args.in[I_AQG] + 64 * (J_), args.in[I_AKG] + 64 * (J_), SSQP}; \
        pg8::gemm_phase<EpiAIn, pg8::StaticOrder>(F.lds + RING_OFF, g, S, E, F.tid); } while (0)
    PH_ENTER(); if (IN(1)) { GEMM_AIN(XN0, W_AIN[0], 0, (const float*)nullptr);
        const int n0 = CC_CHUNKS, n1 = n0 + tw_chunks(2048, 2048), n2 = n1 + TR_CHUNKS;
        DRAIN(1, n2, if (c_ < n0) cc_run(F, args.in[I_CK], args.in[I_CV], KC, VC, c_); else if (c_ < n1) tw_run(F, args.in[I_AWOUT], 2048, 2048, W_AOUT[0], c_ - n0); else tr_run(F, TABR, c_ - n1);); }
    SEAM(1);
    PH_ENTER(); if (IN(3)) { const float li = 0.8f - 0.6f * expf(-0.3f * 0.f); const float lam = diff_lambda(args.in[I_LQ1], args.in[I_LK1], args.in[I_LQ2], args.in[I_LK2], li);
        attn_fast(F, Qs, KP, VP, KC, VC, GA, AO_A, lam, 1.f - li, args.in[I_ASG]); }
    SEAM(3);
    PH_ENTER(); if (IN(4)) { GEMM_RESIDB(0, AO_A, W_AOUT[0], 2048);
        const int n0 = tw_chunks(2048, 12288), n1 = n0 + tw_chunks(4096, 2048);
        DRAIN(4, n1, if (c_ < n0) tw_run(F, args.in[I_RWIN], 2048, 12288, W_RIN, c_, args.in[I_NW] + DM); else tw_run(F, args.in[I_RWOUT], 4096, 2048, W_ROUT, c_ - n0);); }
    if (IN(4) && IN(6)) xcd_barrier(bar, F.wave == 0 && lane_now() == 0);
    PH_ENTER(); if (IN(6)) { ret_zero_pad(F, VS, KT);
        PH_ENTER(); pg8::GemmP g{2048, 2048, 32}; pg8::StaticOrder S; S.init(MT / 256, 48, F.G, F.bid, HB, W_RIN, 2048, 2048); EpiRet E{QP, KN, KT, VS, RG, TABR, SSQ2};
        pg8::gemm_phase<EpiRet, pg8::StaticOrder>(F.lds + RING_OFF, g, S, E, F.tid); }
    SEAM(6);
    PH_ENTER(); if (IN(7)) { { pg8::GemmP g{4096, 2048, 4}; RetQKOrder S{F.G, F.bid, (const char*)QP, (const char*)KN}; EpiRetQK E{QP}; pg8::gemm_phase<EpiRetQK, RetQKOrder>(F.lds + RING_OFF, g, S, E, F.tid); }
        PH_ENTER(); { pg8::GemmP g{512, 256, 4}; RetKVOrder S{F.G, F.bid, (const char*)VS, (const char*)KT}; EpiRetKV E{VS, KVX}; pg8::gemm_phase<EpiRetKV, RetKVOrder>(F.lds + RING_OFF, g, S, E, F.tid); }
        xcd_barrier(bar, F.wave == 0 && lane_now() == 0);
        PH_ENTER(); ret_scan(F, VS, KVX, args.in[I_SR], out + O_SP, out + O_SS); }
    SEAM(7);
    PH_ENTER(); if (IN(8)) { pg8::GemmP g{4096, 512, 8}; RetOOrder S{F.G, F.bid, (const char*)QP, (const char*)VS}; EpiRetO E{ORET}; pg8::gemm_phase<EpiRetO, RetOOrder>(F.lds + RING_OFF, g, S, E, F.tid); }
    SEAM(8);
    PH_ENTER(); if (IN(9)) r_out(F, ORET, RG);
    SEAM(9);
    PH_ENTER(); if (IN(10)) { GEMM_RESIDB(1, ORET, W_ROUT, 4096);
        const int n0 = tw_chunks(2048, 12288), n1 = n0 + tw_chunks(4096, 2048), n2 = n1 + tw_chunks(2048, 8192), n3 = n2 + tw_chunks(2048, 2048);
        DRAIN(10, n3, if (c_ < n0) tw_run(F, args.in[I_CWIN], 2048, 12288, W_CIN, c_, args.in[I_NW] + 2 * DM); else if (c_ < n1) tw_run(F, args.in[I_CWOUT], 4096, 2048, W_COUT, c_ - n0);
                      else if (c_ < n2) tw_run(F, args.in[I_AWIN] + (size_t)2048 * 8192, 2048, 8192, W_AIN[1], c_ - n1, args.in[I_NW] + 3 * DM); else tw_run(F, args.in[I_AWOUT] + (size_t)2048 * 2048, 2048, 2048, W_AOUT[1], c_ - n2);); }
    if (IN(10) && IN(12)) xcd_barrier(bar, F.wave == 0 && lane_now() == 0);
    PH_ENTER(); if (IN(12)) { pg8::GemmP g{2048, 2048, 32}; pg8::StaticOrder S; S.init(MT / 256, 48, F.G, F.bid, HB, W_CIN, 2048, 2048); EpiCIn E{GU, GVT, SG, GVS, SSQ, SSQ2};
        pg8::gemm_phase<EpiCIn, pg8::StaticOrder>(F.lds + RING_OFF, g, S, E, F.tid); }
    SEAM(12);
    PH_ENTER(); if (IN(13)) c_prep(F, SSQ, args.in[I_CWS], args.in[I_CVG], GVS, WM, out + O_VM);
    SEAM(13);
    PH_ENTER(); if (IN(14)) { pg8::GemmP g{256, 256, 4}; CMixOrder S{F.G, F.bid, (const char*)WM, (const char*)GVT}; EpiCMix E{GU, SG, args.in[I_CVG], args.in[I_CBS]}; pg8::gemm_phase<EpiCMix, CMixOrder>(F.lds + RING_OFF, g, S, E, F.tid); }
    SEAM(14);
    PH_ENTER(); if (IN(15)) { GEMM_RESIDB(1, GU, W_COUT, 4096);
        DRAIN(15, CC_CHUNKS, cc_run(F, args.in[I_CK] + (size_t)NB * PAST * DM, args.in[I_CV] + (size_t)NB * PAST * DM, KC, VC, c_);); }
    if (IN(15) && IN(17)) xcd_barrier(bar, F.wave == 0 && lane_now() == 0);
    PH_ENTER(); if (IN(17)) GEMM_AIN(HB, W_AIN[1], 1, (const float*)SSQ2);
    SEAM(17);
    PH_ENTER(); if (IN(19)) { const float li = 0.8f - 0.6f * expf(-0.3f * 3.f); const float lam = diff_lambda(args.in[I_LQ1] + 64, args.in[I_LK1] + 64, args.in[I_LQ2] + 64, args.in[I_LK2] + 64, li);
        attn_fast(F, Qs, KP, VP, KC, VC, GA, AO_A, lam, 1.f - li, args.in[I_ASG] + 128); }
    SEAM(19);
    PH_ENTER(); if (IN(20)) GEMM_RESIDB(2, AO_A, W_AOUT[1], 2048);
#undef IN
#undef SEAM
}

extern "C" void kernel_launch(void* const* d_in, const int* in_sizes, int n_in, void* d_out, int out_size, void* d_ws, size_t ws_size, hipStream_t stream) {
    static int grid = 0;
    if (grid == 0) {
        if (n_in != N_IN || (size_t)out_size != O_END || ws_size < WS_END) { fprintf(stderr, "kernel_launch: unexpected shapes: n_in %d out %d ws %zu (need %zu)\n", n_in, out_size, ws_size, (size_t)WS_END); grid = -1; return; }
        int dev = 0, cus = 0;
        if (hipGetDevice(&dev) != hipSuccess || hipDeviceGetAttribute(&cus, hipDeviceAttributeMultiprocessorCount, dev) != hipSuccess) { grid = -1; return; }
        if (hipFuncSetAttribute((const void*)mega, hipFuncAttributeMaxDynamicSharedMemorySize, LDS_BYTES) != hipSuccess) { fprintf(stderr, "kernel_launch: hipFuncSetAttribute failed\n"); grid = -1; return; }
        int per_cu = 0;
        if (hipOccupancyMaxActiveBlocksPerMultiprocessor(&per_cu, (const void*)mega, NTHR, LDS_BYTES) != hipSuccess || per_cu < 1) { fprintf(stderr, "kernel_launch: occupancy query: %d workgroups per CU\n", per_cu); grid = -1; return; }
        (void)hipGetLastError();
        grid = cus;
    }
    if (grid < 0) return;
    Args a{};
    for (int i = 0; i < N_IN; ++i) a.in[i] = (const float*)d_in[i];
    a.out = (float*)d_out; a.ws = (unsigned char*)d_ws;
    (void)hipMemsetAsync((char*)d_ws + WS_CTL, 0, CTL_ZERO_BYTES, stream);
    a.ph_lo = 0; a.ph_hi = N_PHASES;
    hipLaunchKernelGGL(mega, dim3(grid), dim3(NTHR), LDS_BYTES, stream, a);
}
```

```cpp
#include <hip/hip_runtime.h>
#include <cstdio>
#include <cstdint>

__device__ __forceinline__ int lane_now() { int l; asm volatile("v_mbcnt_lo_u32_b32 %0, -1, 0\n\tv_mbcnt_hi_u32_b32 %0, -1, %0" : "=v"(l)); return l; }
namespace pg8 {
#define PG8_LAS __attribute__((address_space(3)))
typedef unsigned short bf16_t;
typedef short bf16x8 __attribute__((ext_vector_type(8)));
typedef float f32x4 __attribute__((ext_vector_type(4)));
typedef unsigned u32x4 __attribute__((ext_vector_type(4)));
constexpr int BM = 256, BK = 64, HALF = 128, HTB = HALF * BK * 2, STAGE_BYTES = 8 * HTB, NXCD = 8, WGM = 4;

__host__ __device__ __forceinline__ int lds_byte(int r, int c) { const int st = (r >> 4) * 2 + (c >> 5), rr = r & 15, cc = c & 31, ob = rr * 64 + cc * 2; return st * 1024 + (ob ^ (((ob >> 9) & 1) << 5)); }
__host__ __device__ __forceinline__ void stage_rc(int b, int& R, int& C) { const int st = b / 1024, sb = b % 1024, swz = sb ^ (((sb >> 9) & 1) << 5); R = (st >> 1) * 16 + swz / 64; C = (st & 1) * 32 + (swz % 64) / 2; }
__host__ __device__ __forceinline__ int perm32(int rho) { const int n = rho >> 4, i = rho & 15; return 8 * (i >> 2) + 4 * n + (i & 3); }

struct Unit { int pm, pn; const char* a; const char* b; };
struct GemmP { int lda, ldb, nt; };

struct StaticOrder {
    int nM, nN, nwg, G, c; const char* A; const char* B; size_t ta, tb;
    __host__ __device__ void init(int nM_, int nN_, int G_, int c_, const void* A_, const void* B_, int lda, int ldb) { nM = nM_; nN = nN_; nwg = nM * nN; G = G_; c = c_; A = (const char*)A_; B = (const char*)B_; ta = (size_t)BM * lda * 2; tb = (size_t)BM * ldb * 2; }
    __host__ __device__ bool next(int i, Unit& u) const {
        const long L = (long)i * G + c; if (L >= nwg) return false;
        int wgid = (int)L; { const int q = nwg / NXCD, r = nwg % NXCD, xcd = wgid % NXCD, off = wgid / NXCD; wgid = (xcd < r ? xcd * (q + 1) : r * (q + 1) + (xcd - r) * q) + off; }
        const int nig = WGM * nN, gid = wgid / nig, fm = gid * WGM, gsz = (nM - fm) < WGM ? (nM - fm) : WGM;
        u.pm = fm + ((wgid % nig) % gsz); u.pn = (wgid % nig) / gsz; u.a = A + (size_t)u.pm * ta; u.b = B + (size_t)u.pn * tb; return true;
    }
    __device__ __forceinline__ void a_ready(const Unit&) const {}
    __device__ __forceinline__ void done(const Unit&) const {}
};

__device__ __forceinline__ unsigned cvt_pk_bf16(float lo, float hi) { unsigned r; asm volatile("v_cvt_pk_bf16_f32 %0, %1, %2" : "=v"(r) : "v"(lo), "v"(hi)); return r; }

struct EpiStoreBf16 {
    static constexpr int BMODE = 1;
    bf16_t* O; int ldc;
    __device__ __forceinline__ void operator()(const f32x4 (&acc)[2][2][4][2], const Unit& u, int wr, int wc, int fr, int fq) const {
        const int row0 = u.pm * BM + wr * 64 + fr; const int col0 = u.pn * BM + wc * 32 + 8 * fq;
#pragma unroll
        for (int ai = 0; ai < 2; ++ai)
#pragma unroll
            for (int m = 0; m < 4; ++m) { bf16_t* rowp = O + (size_t)(row0 + ai * HALF + m * 16) * ldc + col0;
#pragma unroll
                for (int bj = 0; bj < 2; ++bj) { const f32x4 v0 = acc[ai][bj][m][0], v1 = acc[ai][bj][m][1];
                    u32x4 w; w.x = cvt_pk_bf16(v0[0], v0[1]); w.y = cvt_pk_bf16(v0[2], v0[3]); w.z = cvt_pk_bf16(v1[0], v1[1]); w.w = cvt_pk_bf16(v1[2], v1[3]);
                    *(u32x4*)(rowp + bj * HALF) = w; } }
    }
};
struct EpiResid {
    static constexpr int BMODE = 0;
    const float* base_p; const float* base_s; float* out; int split;
    __device__ __forceinline__ void operator()(const f32x4 (&acc)[2][2][4][2], const Unit& u, int wr, int wc, int fr, int fq) const {
        { const int l_ = lane_now(); fr = l_ & 15; fq = l_ >> 4; }
        const int col0 = u.pn * BM + wc * 32 + 4 * fq;
#pragma unroll
        for (int ai = 0; ai < 2; ++ai) {
            f32x4 bs[4][2][2];
#pragma unroll
            for (int m = 0; m < 4; ++m) { const int r = u.pm * BM + ai * HALF + wr * 64 + m * 16 + fr; const float* bp = (r < split) ? base_p + (size_t)r * 2048 : base_s + (size_t)(r - split) * 2048;
#pragma unroll
                for (int bj = 0; bj < 2; ++bj)
#pragma unroll
                    for (int n = 0; n < 2; ++n) bs[m][bj][n] = *(const f32x4*)(bp + col0 + bj * HALF + n * 16); }
#pragma unroll
            for (int m = 0; m < 4; ++m) { const int r = u.pm * BM + ai * HALF + wr * 64 + m * 16 + fr; float* op = out + (size_t)r * 2048;
#pragma unroll
                for (int bj = 0; bj < 2; ++bj)
#pragma unroll
                    for (int n = 0; n < 2; ++n) *(f32x4*)(op + col0 + bj * HALF + n * 16) = bs[m][bj][n] + acc[ai][bj][m][n]; }
            asm volatile("" ::: "memory");
        }
    }
};

template <int MODE> struct EpiResidB {
    static constexpr int BMODE = 1;
    const float* base_p; const float* base_s; bf16_t* HB; float* out; float* SSQ2;
    __device__ __forceinline__ void operator()(const f32x4 (&acc)[2][2][4][2], const Unit& u, int wr, int wc, int fr, int fq) const {
        { const int l_ = lane_now(); fr = l_ & 15; fq = l_ >> 4; }
        const int col0 = u.pn * BM + wc * 32 + 8 * fq;
#pragma unroll
        for (int ai = 0; ai < 2; ++ai) {
            f32x4 b0[4][2], b1[4][2]; u32x4 hb[4][2];
#pragma unroll
            for (int m = 0; m < 4; ++m) { const int r = u.pm * BM + ai * HALF + wr * 64 + m * 16 + fr;
#pragma unroll
                for (int bj = 0; bj < 2; ++bj) {
                    if (MODE == 0) { const float* bp = ((r < 16384) ? base_p + (size_t)r * 2048 : base_s + (size_t)(r - 16384) * 2048) + col0 + bj * HALF; b0[m][bj] = __builtin_nontemporal_load((const f32x4*)bp); b1[m][bj] = __builtin_nontemporal_load((const f32x4*)(bp + 4)); }
                    else hb[m][bj] = *(const u32x4*)(HB + (size_t)r * 2048 + col0 + bj * HALF); } }
#pragma unroll
            for (int m = 0; m < 4; ++m) { const int r = u.pm * BM + ai * HALF + wr * 64 + m * 16 + fr; float ss = 0.f;
#pragma unroll
                for (int bj = 0; bj < 2; ++bj) { f32x4 h0, h1;
                    if (MODE == 0) { h0 = b0[m][bj] + acc[ai][bj][m][0]; h1 = b1[m][bj] + acc[ai][bj][m][1]; }
                    else { const u32x4 w = hb[m][bj];
                        h0 = (f32x4){__builtin_bit_cast(float, w.x << 16), __builtin_bit_cast(float, w.x & 0xffff0000u), __builtin_bit_cast(float, w.y << 16), __builtin_bit_cast(float, w.y & 0xffff0000u)} + acc[ai][bj][m][0];
                        h1 = (f32x4){__builtin_bit_cast(float, w.z << 16), __builtin_bit_cast(float, w.z & 0xffff0000u), __builtin_bit_cast(float, w.w << 16), __builtin_bit_cast(float, w.w & 0xffff0000u)} + acc[ai][bj][m][1]; }
                    if (MODE == 2) { float* op = out + (size_t)r * 2048 + col0 + bj * HALF; __builtin_nontemporal_store(h0, (f32x4*)op); __builtin_nontemporal_store(h1, (f32x4*)(op + 4)); }
                    else { u32x4 w; w.x = cvt_pk_bf16(h0[0], h0[1]); w.y = cvt_pk_bf16(h0[2], h0[3]); w.z = cvt_pk_bf16(h1[0], h1[1]); w.w = cvt_pk_bf16(h1[2], h1[3]);
                        *(u32x4*)(HB + (size_t)r * 2048 + col0 + bj * HALF) = w;
                        ss += (h0[0] * h0[0] + h0[1] * h0[1]) + (h0[2] * h0[2] + h0[3] * h0[3]) + (h1[0] * h1[0] + h1[1] * h1[1]) + (h1[2] * h1[2] + h1[3] * h1[3]); } }
                if (MODE != 2) { ss += __shfl_xor(ss, 16); ss += __shfl_xor(ss, 32); if (fq == 0) SSQ2[(size_t)r * 32 + u.pn * 4 + wc] = ss; } }
            asm volatile("" ::: "memory");
        }
    }
};

template <class Epi, class Sched, bool ALIGN_EPI = true>
__device__ __forceinline__ void gemm_phase(PG8_LAS unsigned char* lds, const GemmP g, const Sched& S, const Epi& E, int tid) {
    asm volatile("" : "+v"(tid));
    const int wid = __builtin_amdgcn_readfirstlane(tid >> 6), lane = tid & 63, wr = wid >> 2, wc = wid & 3, fr = lane & 15, fq = lane >> 4;
    int nt = g.nt; asm volatile("" : "+s"(nt));
    unsigned voffA[2], voffB[2];
#pragma unroll
    for (int i = 0; i < 2; ++i) { int R, C; stage_rc(tid * 16 + i * 8192, R, C); const int Rb = Epi::BMODE == 2 ? (64 * (R >> 5) + perm32(R & 31)) : Epi::BMODE == 1 ? ((R & ~31) + perm32(R & 31)) : R;
        voffA[i] = (unsigned)(R * g.lda + C) * 2u; voffB[i] = (unsigned)(Rb * g.ldb + C) * 2u; }
    const size_t kstep = (size_t)(BK * 2);
    const size_t hstepA = (size_t)HALF * g.lda * 2, hstepB = (size_t)(Epi::BMODE == 2 ? 32 : HALF) * g.ldb * 2;
    const unsigned ldsw = (unsigned)wid * 1024u;
    const int aoff = lds_byte(wr * 64 + fr, fq * 8), boff = lds_byte(wc * 32 + fr, fq * 8);
#define PG8_SA(b, h) (((b) * 2 + (h)) * HTB)
#define PG8_SB(b, h) ((4 + (b) * 2 + (h)) * HTB)
#define PG8_STAGE(bufoff, gbase, voff) do { _Pragma("unroll") for (int _i = 0; _i < 2; ++_i) \
        __builtin_amdgcn_global_load_lds((const unsigned*)((const char*)(gbase) + (voff)[_i]), (PG8_LAS unsigned*)(lds + (bufoff) + ldsw + _i * 8192), 16, 0, 0); } while (0)
#define PG8_LDA(dst, b, h) do { _Pragma("unroll") for (int m = 0; m < 4; ++m) _Pragma("unroll") for (int k = 0; k < 2; ++k) dst[m][k] = *(const PG8_LAS bf16x8*)(lds + PG8_SA(b, h) + aoff + m * 2048 + k * 1024); } while (0)
#define PG8_LDB(dst, b, h) do { _Pragma("unroll") for (int n = 0; n < 2; ++n) _Pragma("unroll") for (int k = 0; k < 2; ++k) dst[n][k] = *(const PG8_LAS bf16x8*)(lds + PG8_SB(b, h) + boff + n * 2048 + k * 1024); } while (0)
#define PG8_MMA(ai, bj, At, Bt) do { __builtin_amdgcn_s_setprio(1); _Pragma("unroll") for (int m = 0; m < 4; ++m) _Pragma("unroll") for (int n = 0; n < 2; ++n) _Pragma("unroll") for (int k = 0; k < 2; ++k) \
        acc[ai][bj][m][n] = __builtin_amdgcn_mfma_f32_16x16x32_bf16(Bt[n][k], At[m][k], acc[ai][bj][m][n], 0, 0, 0); __builtin_amdgcn_s_setprio(0); } while (0)
#define PG8_WAIT_V(n) asm volatile("s_waitcnt vmcnt(" #n ")" ::: "memory")
#define PG8_WAIT_L(n) asm volatile("s_waitcnt lgkmcnt(" #n ")" ::: "memory")
#define PG8_BAR __builtin_amdgcn_s_barrier()
#define PG8_SCHED __builtin_amdgcn_sched_barrier(0)
    Unit cur, nxt; int ui = 0;
    if (!S.next(0, cur)) return;
    f32x4 acc[2][2][4][2];
#pragma unroll
    for (int a = 0; a < 2; ++a)
#pragma unroll
        for (int b = 0; b < 2; ++b)
#pragma unroll
            for (int m = 0; m < 4; ++m)
#pragma unroll
                for (int n = 0; n < 2; ++n) acc[a][b][m][n] = (f32x4){0.f, 0.f, 0.f, 0.f};
    bf16x8 At[4][2], B0[2][2], B1[2][2];
    const char* cA = cur.a; const char* cB = cur.b;
    S.a_ready(cur);
    PG8_STAGE(PG8_SB(0, 0), cB, voffB); PG8_STAGE(PG8_SB(0, 1), cB + hstepB, voffB); PG8_STAGE(PG8_SA(0, 0), cA, voffA); PG8_STAGE(PG8_SA(0, 1), cA + hstepA, voffA);
    if (wr == 1) PG8_BAR;
    PG8_WAIT_V(2); PG8_BAR;
    PG8_STAGE(PG8_SB(1, 0), cB + kstep, voffB); PG8_STAGE(PG8_SA(1, 0), cA + kstep, voffA); PG8_STAGE(PG8_SB(1, 1), cB + hstepB + kstep, voffB);
    PG8_WAIT_V(6); PG8_BAR;
    for (;;) {
        const bool has_next = S.next(ui + 1, nxt);
        const char* nA = has_next ? nxt.a : cA; const char* nB = has_next ? nxt.b : cB;
        for (int t = 0; t < nt; t += 2) {
            const bool last = (t == nt - 2);
            const char* a1 = cA + (size_t)(t + 1) * kstep;
            const char* a2 = last ? nA : cA + (size_t)(t + 2) * kstep; const char* b2 = last ? nB : cB + (size_t)(t + 2) * kstep;
            const char* a3 = a2 + kstep; const char* b3 = b2 + kstep;
            if (last && has_next) S.a_ready(nxt);
            PG8_LDB(B0, 0, 0); PG8_LDB(B1, 0, 1); PG8_SCHED; PG8_LDA(At, 0, 0); PG8_STAGE(PG8_SA(1, 1), a1 + hstepA, voffA);
            PG8_WAIT_V(8); PG8_WAIT_L(0); PG8_BAR; PG8_MMA(0, 0, At, B0); PG8_MMA(0, 1, At, B1); PG8_BAR; PG8_SCHED;
            PG8_LDA(At, 0, 1); PG8_STAGE(PG8_SB(0, 0), b2, voffB); PG8_STAGE(PG8_SB(0, 1), b2 + hstepB, voffB); PG8_STAGE(PG8_SA(0, 0), a2, voffA);
            PG8_WAIT_V(8); PG8_WAIT_L(0); PG8_BAR; PG8_MMA(1, 0, At, B0); PG8_MMA(1, 1, At, B1); PG8_BAR; PG8_SCHED;
            PG8_LDB(B0, 1, 0); PG8_LDB(B1, 1, 1); PG8_SCHED; PG8_LDA(At, 1, 0); PG8_STAGE(PG8_SA(0, 1), a2 + hstepA, voffA);
            PG8_WAIT_V(8); PG8_WAIT_L(0); PG8_BAR; PG8_MMA(0, 0, At, B0); PG8_MMA(0, 1, At, B1); PG8_BAR; PG8_SCHED;
            PG8_LDA(At, 1, 1); PG8_STAGE(PG8_SB(1, 0), b3, voffB); PG8_STAGE(PG8_SB(1, 1), b3 + hstepB, voffB); PG8_STAGE(PG8_SA(1, 0), a3, voffA);
            PG8_WAIT_V(8); PG8_WAIT_L(0); PG8_BAR; PG8_MMA(1, 0, At, B0); PG8_MMA(1, 1, At, B1); PG8_BAR; PG8_SCHED;
        }
        if constexpr (ALIGN_EPI) { if (wr == 0) PG8_BAR; }
        E(acc, cur, wr, wc, fr, fq); S.done(cur);
        if (!has_next) break;
#pragma unroll
        for (int a = 0; a < 2; ++a)
#pragma unroll
            for (int b = 0; b < 2; ++b)
#pragma unroll
                for (int m = 0; m < 4; ++m)
#pragma unroll
                    for (int n = 0; n < 2; ++n) acc[a][b][m][n] = (f32x4){0.f, 0.f, 0.f, 0.f};
        cur = nxt; cA = nA; cB = nB; ++ui;
        if constexpr (ALIGN_EPI) { if (wr == 1) PG8_BAR; }
    }
    PG8_WAIT_V(0);
    if constexpr (!ALIGN_EPI) { if (wr == 0) PG8_BAR; }
    PG8_BAR;
#undef PG8_SA
#undef PG8_SB
#undef PG8_STAGE
#undef PG8_LDA
#undef PG8_LDB
#undef PG8_MMA
#undef PG8_WAIT_V
#undef PG8_WAIT_L
#undef PG8_BAR
#undef PG8_SCHED
}
}

constexpr int NWAVES = 8, NTHR = 512;
constexpr int DM = 2048, MP = 16384, MS = 512, MT = MP + MS, PAST = 2048, DECL = 64, NB = 8;
constexpr int KCROWS = PAST + DECL;
constexpr float EPS = 1e-6f;
constexpr float LOG2E = 1.4426950408889634f;
constexpr float C2 = 0.125f * LOG2E;

enum { I_XP = 0, I_XS, I_CK, I_CV, I_SR, I_NW, I_AWIN, I_AWOUT, I_AQG, I_AKG, I_LQ1, I_LK1, I_LQ2, I_LK2, I_ASG, I_RWIN, I_RWOUT, I_CWIN, I_CWOUT, I_CVG, I_CWS, I_CBS, N_IN };
constexpr size_t O_YP = 0, O_YS = O_YP + (size_t)MP * DM, O_KP = O_YS + (size_t)MS * DM, O_VP = O_KP + 2 * (size_t)MP * DM, O_KS = O_VP + 2 * (size_t)MP * DM, O_VS = O_KS + 2 * (size_t)MS * DM,
                 O_SP = O_VS + 2 * (size_t)MS * DM, O_SS = O_SP + (size_t)8 * 256 * 512, O_VM = O_SS + (size_t)NB * 8 * 256 * 512, O_END = O_VM + (size_t)MS * 4096;

constexpr size_t MiB = 1u << 20;
constexpr size_t WS_CTL = 0, CTL_ZERO_BYTES = 1 * MiB;
constexpr size_t WS_WAIN0 = 8 * MiB, WS_WAOUT0 = 40 * MiB, WS_WRIN = 48 * MiB, WS_WROUT = 96 * MiB, WS_WCIN = 112 * MiB, WS_WCOUT = 160 * MiB, WS_WAIN1 = 176 * MiB, WS_WAOUT1 = 208 * MiB;
constexpr size_t WS_SSQ2 = 2 * MiB;
constexpr size_t WS_HB = 216 * MiB, WS_Z = 282 * MiB;
constexpr size_t WS_XN0 = 348 * MiB;
constexpr size_t WS_QS = 546 * MiB, WS_KP = 612 * MiB, WS_VP = 676 * MiB, WS_KC = 740 * MiB, WS_VC = 806 * MiB, WS_AOA = 872 * MiB;
constexpr size_t WS_KT = 112 * MiB, WS_RG = 282 * MiB, WS_QP = 414 * MiB, WS_KN = 546 * MiB, WS_VS = 612 * MiB, WS_ORET = 900 * MiB;
constexpr size_t WS_GU = 282 * MiB, WS_SG = 414 * MiB, WS_GVT = 546 * MiB, WS_WM = 678 * MiB, WS_SSQ = 744 * MiB, WS_GVS = 752 * MiB;
constexpr size_t WS_GA = 282 * MiB;
constexpr size_t WS_KVX = 184 * MiB;
constexpr size_t WS_TABR = 1040 * MiB, WS_TABA = 1056 * MiB, WS_END = 1060 * MiB;

#define GAS __attribute__((address_space(1)))
#define LAS __attribute__((address_space(3)))
typedef unsigned short bf16;
typedef unsigned v4u __attribute__((ext_vector_type(4)));
typedef unsigned v2u __attribute__((ext_vector_type(2)));
typedef float f32x4 __attribute__((ext_vector_type(4)));
typedef GAS unsigned gu32;
#define RLX_AGENT __ATOMIC_RELAXED, __HIP_MEMORY_SCOPE_AGENT
#define LDS_WAIT() asm volatile("s_waitcnt lgkmcnt(0)" ::: "memory")
#define VM_WAIT() asm volatile("s_waitcnt vmcnt(0)" ::: "memory")
typedef float g_f32x2 __attribute__((ext_vector_type(2))); typedef __bf16 g_bf16x2 __attribute__((ext_vector_type(2)));
__device__ __forceinline__ unsigned pk2(float lo, float hi) { const g_f32x2 v = {lo, hi}; const g_bf16x2 b = __builtin_convertvector(v, g_bf16x2); return __builtin_bit_cast(unsigned, b); }
__device__ __forceinline__ unsigned f2bf(float f) { return pk2(f, 0.f) & 0xffffu; }
__device__ __forceinline__ float bf2f(unsigned short b) { return __builtin_bit_cast(float, (unsigned)b << 16); }
__device__ __forceinline__ float bflo(unsigned w) { return __builtin_bit_cast(float, w << 16); }
__device__ __forceinline__ float bfhi(unsigned w) { return __builtin_bit_cast(float, w & 0xffff0000u); }
__device__ __forceinline__ float silu_f(float x) { return x * __builtin_amdgcn_rcpf(1.f + __builtin_amdgcn_exp2f(-LOG2E * x)); }
__device__ __forceinline__ float gelu_tanh_f(float x) { const float u = (0.7978845608028654f * 2.f * LOG2E) * (x + 0.044715f * x * x * x); return x * __builtin_amdgcn_rcpf(1.f + __builtin_amdgcn_exp2f(-u)); }
__device__ __forceinline__ float wave_sum(float v) {
#pragma unroll
    for (int o = 1; o < 64; o <<= 1) v += __shfl_xor(v, o);
    return v;
}
__device__ __forceinline__ void row_rstd(const float* ssq, int pm, int wr, int fr, int fq, float (&rs)[2][4]) {
#pragma unroll
    for (int ai = 0; ai < 2; ++ai)
#pragma unroll
        for (int m = 0; m < 4; ++m) {
            if (ssq) { const float* p = ssq + ((size_t)pm * 256 + ai * 128 + wr * 64 + m * 16 + fr) * 32 + 8 * fq; const f32x4 a = *(const f32x4*)p, b = *(const f32x4*)(p + 4);
                float t = ((a.x + a.y) + (a.z + a.w)) + ((b.x + b.y) + (b.z + b.w)); t += __shfl_xor(t, 16); t += __shfl_xor(t, 32); rs[ai][m] = 1.f / sqrtf(t * (1.f / 2048.f) + EPS); }
            else rs[ai][m] = 1.f; }
}
#define NT_LOAD(p) __builtin_nontemporal_load(p)
#define NT_STORE(v, p) __builtin_nontemporal_store((v), (p))
__device__ __forceinline__ void rope_cs(int pos, int i, int nf, float& c, float& s) {
    const float inv = exp2f(-(float)i / (float)nf * 13.287712379549449f);
    const double a = (double)pos * (double)inv * 0.15915494309189535;
    const float r = (float)(a - floor(a));
    c = __builtin_amdgcn_cosf(r); s = __builtin_amdgcn_sinf(r);
}

#define XB_TMO      128
#define XB_XCNT(j)  (256  + 64 * (j))
#define XB_XSUB(j)  (1280 + 64 * (j))
#define XB_XGEN(j)  (2304 + 64 * (j))
#define XB_TOP      3328
#define XB_TOPGEN   3392
#define XCD_BAR_WORDS 3456
#define XB_SPIN_CAP (1u << 22)
__device__ __forceinline__ unsigned xb_ld(unsigned* p)              { return __hip_atomic_load(p, __ATOMIC_RELAXED, __HIP_MEMORY_SCOPE_AGENT); }
__device__ __forceinline__ unsigned xb_add(unsigned* p, unsigned v) { return __hip_atomic_fetch_add(p, v, __ATOMIC_RELAXED, __HIP_MEMORY_SCOPE_AGENT); }
__device__ __forceinline__ unsigned xb_xcc_id() { return (unsigned)__builtin_amdgcn_s_getreg((3 << 11) | 20) & 0xFu; }
#define XB_SPIN(cond, bar) do { unsigned _sp = 0; while (cond) { __builtin_amdgcn_s_sleep(1); \
    if ((++_sp & 255u) == 0u) { if (xb_ld(&(bar)[XB_TMO])) break; if (_sp > XB_SPIN_CAP) { atomicAdd(&(bar)[XB_TMO], 1u); break; } } } } while (0)
struct XcdBarrier { unsigned* bar; unsigned x; volatile LAS unsigned* st; };
__device__ __forceinline__ XcdBarrier xcd_barrier_post(unsigned* bar, volatile LAS unsigned* st) {
    XcdBarrier b; b.bar = bar; b.x = xb_xcc_id(); b.st = st;
    if (threadIdx.x == 0) (void)xb_add(&bar[XB_XCNT(b.x)], 1u);
    return b;
}
__device__ __forceinline__ void xcd_barrier_complete(unsigned* bar, unsigned x, unsigned& nloc, unsigned& nx) {
    const unsigned G = gridDim.x * gridDim.y * gridDim.z;
    unsigned sum, cnt, mine, sp = 0u;
    for (;;) {
        sum = 0u; cnt = 0u; mine = 0u;
#pragma unroll
        for (unsigned j = 0; j < 16; ++j) { const unsigned c = xb_ld(&bar[XB_XCNT(j)]); sum += c; cnt += (c > 0u) ? 1u : 0u; mine = (j == x) ? c : mine; }
        if (sum == G) break;
        __builtin_amdgcn_s_sleep(1);
        if ((++sp & 255u) == 0u) { if (xb_ld(&bar[XB_TMO])) break; if (sp > XB_SPIN_CAP) { atomicAdd(&bar[XB_TMO], 1u); break; } }
    }
    nloc = mine > 0u ? mine : 1u; nx = cnt > 0u ? cnt : 1u;
}
__device__ __forceinline__ void xcd_barrier(const XcdBarrier& b, bool leader) {
    asm volatile("s_waitcnt vmcnt(0)" ::: "memory");
    __syncthreads();
    if (leader) {
        unsigned* bar = b.bar;
        __builtin_amdgcn_s_waitcnt(0);
        unsigned nloc = b.st[0], nx = b.st[1];
        if (nloc == 0u) { xcd_barrier_complete(bar, b.x, nloc, nx); b.st[0] = nloc; b.st[1] = nx; }
        const unsigned old = xb_add(&bar[XB_XSUB(b.x)], 1u);
        const unsigned gen = old / nloc;
        if (old + 1u == (gen + 1u) * nloc) {
            __builtin_amdgcn_fence(__ATOMIC_RELEASE, "agent");
            asm volatile("s_waitcnt vmcnt(0)" ::: "memory");
            const unsigned og = xb_add(&bar[XB_TOP], 1u);
            const unsigned tg = og / nx;
            if (og + 1u == (tg + 1u) * nx) xb_add(&bar[XB_TOPGEN], 1u);
            else XB_SPIN(xb_ld(&bar[XB_TOPGEN]) == tg, bar);
            __builtin_amdgcn_fence(__ATOMIC_ACQUIRE, "agent");
            xb_add(&bar[XB_XGEN(b.x)], 1u);
            asm volatile("s_waitcnt vmcnt(0)" ::: "memory");
        } else {
            XB_SPIN(xb_ld(&bar[XB_XGEN(b.x)]) == gen, bar);
            __builtin_amdgcn_fence(__ATOMIC_ACQUIRE, "agent");
            asm volatile("s_waitcnt vmcnt(0)" ::: "memory");
        }
    }
    __syncthreads();
}

constexpr int RING_OFF = 0, RING_BYTES = 139264;
constexpr int MISC_OFF = RING_BYTES;
constexpr int LDS_BYTES = 147456;
struct Args { const float* in[N_IN]; float* out; unsigned char* ws; int ph_lo, ph_hi; };
struct Frame {
    LAS unsigned char* lds; int tid, lane, wave, G, bid;
    const float* const* in; float* out; unsigned char* ws;
};

__device__ __forceinline__ void p0_transpose_item(const float* W, int K, int N, bf16* WT, LAS float* scr, int item, int lane, const float* ksc = nullptr) {
    const int nblk = N / 32, kb = item / nblk, nb = item % nblk, k0 = 64 * kb, n0 = 32 * nb;
    float w_[32];
#pragma unroll
    for (int i = 0; i < 32; ++i) w_[i] = NT_LOAD(W + (size_t)(k0 + 2 * i + (lane >> 5)) * N + n0 + (lane & 31));
#pragma unroll
    for (int i = 0; i < 32; ++i) { const int kk = 2 * i + (lane >> 5); scr[kk * 33 + (lane & 31)] = ksc ? w_[i] * ksc[k0 + kk] : w_[i]; }
    LDS_WAIT(); asm volatile("" ::: "memory");
    const int c = lane & 7;
#pragma unroll
    for (int j = 0; j < 4; ++j) { const int n = (lane >> 3) + 8 * j; const LAS float* s = scr + (8 * c) * 33 + n;
        v4u o; o.x = pk2(s[0 * 33], s[1 * 33]); o.y = pk2(s[2 * 33], s[3 * 33]); o.z = pk2(s[4 * 33], s[5 * 33]); o.w = pk2(s[6 * 33], s[7 * 33]);
        *(GAS v4u*)(WT + (size_t)(n0 + n) * K + k0 + 8 * c) = o; }
    LDS_WAIT(); asm volatile("" ::: "memory");
}
__device__ __forceinline__ void transpose_weight(Frame& F, const float* W, int K, int N, bf16* WT) {
    LAS float* scr = (LAS float*)(F.lds + RING_OFF + F.wave * 16384);
    const int gw = F.bid * NWAVES + F.wave, NGW = F.G * NWAVES, nitems = (K / 64) * (N / 32);
    for (int it = gw; it < nitems; it += NGW) p0_transpose_item(W, K, N, WT, scr, it, F.lane);
}
__device__ __forceinline__ void norm_rows(Frame& F, const float* src_p, const float* src_s, const float* w, bf16* XN) {
    const int gw = F.bid * NWAVES + F.wave, NGW = F.G * NWAVES;
    for (int m = gw; m < MT; m += NGW) {
        const float* xrow = (m < MP) ? src_p + (size_t)m * DM : src_s + (size_t)(m - MP) * DM;
        const GAS f32x4* xr = (const GAS f32x4*)xrow + F.lane; const GAS f32x4* wr = (const GAS f32x4*)w + F.lane;
        f32x4 v[8]; float s = 0.f;
#pragma unroll
        for (int j = 0; j < 8; ++j) { v[j] = __builtin_nontemporal_load((const f32x4*)(xrow) + F.lane + 64 * j); s += (v[j].x * v[j].x + v[j].y * v[j].y) + (v[j].z * v[j].z + v[j].w * v[j].w); }
        const float rstd = 1.f / sqrtf(wave_sum(s) * (1.f / DM) + EPS);
        GAS v2u* o8 = (GAS v2u*)(XN + (size_t)m * DM) + F.lane;
#pragma unroll
        for (int j = 0; j < 8; ++j) { const f32x4 g = wr[64 * j]; v2u o; o.x = pk2(v[j].x * rstd * g.x, v[j].y * rstd * g.y); o.y = pk2(v[j].z * rstd * g.z, v[j].w * rstd * g.w); o8[64 * j] = o; }
    }
}
__device__ __forceinline__ void cache_cvt(Frame& F, const float* ck, const float* cv, bf16* KC, bf16* VC) {
    const size_t nvec = (size_t)NB * PAST * DM / 4;
    const size_t gt = (size_t)F.bid * NTHR + F.tid, NG = (size_t)F.G * NTHR;
    for (size_t i = gt; i < 2 * nvec; i += NG) {
        const bool isv = i >= nvec; const size_t e = (isv ? i - nvec : i) * 4;
        const size_t brow = e / DM, col = e % DM, b = brow / PAST, t = brow % PAST;
        const f32x4 x = *(const GAS f32x4*)((isv ? cv : ck) + e);
        v2u o; o.x = pk2(x.x, x.y); o.y = pk2(x.z, x.w);
        *(GAS v2u*)((isv ? VC : KC) + ((b * KCROWS + t) * DM + col)) = o;
    }
}
__device__ __forceinline__ int tw_chunks(int K, int N) { return (K / 64) * (N / 32) / 64; }
__device__ __forceinline__ void tw_run(Frame& F, const float* W, int K, int N, bf16* WT, int c, const float* ksc = nullptr) {
    LAS float* scr = (LAS float*)(F.lds + RING_OFF + F.wave * 16384);
#pragma unroll 1
    for (int i = 0; i < 8; ++i) p0_transpose_item(W, K, N, WT, scr, c * 64 + F.wave * 8 + i, F.lane, ksc);
}
constexpr int CC_CHUNKS = 2 * (NB * PAST * DM / 4) / 8192;
__device__ __forceinline__ void cc_run(Frame& F, const float* ck, const float* cv, bf16* KC, bf16* VC, int c) {
    const bool isv = c >= CC_CHUNKS / 2; const int brow0 = (isv ? c - CC_CHUNKS / 2 : c) * 16, b = brow0 / PAST, t0 = brow0 % PAST;
    const float* src = (isv ? cv : ck) + (size_t)brow0 * DM + F.tid * 4;
    bf16* dst = (isv ? VC : KC) + ((size_t)b * KCROWS + t0) * DM + F.tid * 4;
    f32x4 x[16];
#pragma unroll
    for (int k = 0; k < 16; ++k) x[k] = NT_LOAD((const f32x4*)(src + (size_t)k * DM));
#pragma unroll
    for (int k = 0; k < 16; ++k) { v2u o; o.x = pk2(x[k].x, x[k].y); o.y = pk2(x[k].z, x[k].w); *(GAS v2u*)(dst + (size_t)k * DM) = o; }
}
constexpr int TR_CHUNKS = MP * 128 / 8192;
__device__ __forceinline__ void tr_run(Frame& F, float* tab, int c) {
#pragma unroll 1
    for (int k = 0; k < 16; ++k) { const size_t e = (size_t)c * 8192 + k * NTHR + F.tid; float cs, sn; rope_cs((int)(e >> 7), (int)(e & 127), 128, cs, sn); tab[2 * e] = cs; tab[2 * e + 1] = sn; }
}
__device__ __forceinline__ int row_pos(int row) { return row < MP ? row : PAST + ((row - MP) & 63); }

struct EpiAIn {
    static constexpr int BMODE = 2;
    pg8::bf16_t *Qs, *KP, *VP, *KC, *VC, *GA; float *okp, *ovp, *oks, *ovs; const float* tab; const float* qg; const float* kg; const float* ssq;
    __device__ __forceinline__ void operator()(const pg8::f32x4 (&acc)[2][2][4][2], const pg8::Unit& u, int wr, int wc, int fr, int fq) const {
        { const int l_ = lane_now(); fr = l_ & 15; fq = l_ >> 4; }
        const int pn = u.pn, pm = u.pm, typ = pn >> 3, cl = ((pn & 7) * 4 + wc) * 64 + 8 * fq; float rs[2][4]; row_rstd(ssq, pm, wr, fr, fq, rs);
        float g1[8], g2[8];
        if (typ < 2) { const float* gp = (typ == 0 ? qg : kg) + 8 * fq; const pg8::f32x4 a = *(const pg8::f32x4*)gp, b = *(const pg8::f32x4*)(gp + 4), c = *(const pg8::f32x4*)(gp + 32), d = *(const pg8::f32x4*)(gp + 36);
#pragma unroll
            for (int e = 0; e < 4; ++e) { g1[e] = a[e]; g1[4 + e] = b[e]; g2[e] = c[e]; g2[4 + e] = d[e]; } }
#pragma unroll
        for (int ai = 0; ai < 2; ++ai)
#pragma unroll
          for (int mp = 0; mp < 2; ++mp) {
            pg8::f32x4 tq[4][4];
            if (typ < 2) {
#pragma unroll
                for (int m = 2 * mp; m < 2 * mp + 2; ++m) { const int i_ = ai * 128 + wr * 64 + m * 16 + fr; const int pos_ = pm < 64 ? pm * 256 + i_ : PAST + (i_ & 63); const float* tp_ = tab + ((size_t)pos_ * 32 + 8 * fq) * 2;
#pragma unroll
                    for (int q4 = 0; q4 < 4; ++q4) tq[m][q4] = *(const pg8::f32x4*)(tp_ + 4 * q4); } }
#pragma unroll
            for (int m = 2 * mp; m < 2 * mp + 2; ++m) {
                const int i = ai * 128 + wr * 64 + m * 16 + fr; const size_t row = (size_t)pm * 256 + i;
                float x1[8], x2[8];
#pragma unroll
                for (int e = 0; e < 4; ++e) { x1[e] = acc[ai][0][m][0][e] * rs[ai][m]; x1[4 + e] = acc[ai][0][m][1][e] * rs[ai][m]; x2[e] = acc[ai][1][m][0][e] * rs[ai][m]; x2[4 + e] = acc[ai][1][m][1][e] * rs[ai][m]; }
                size_t drow; pg8::bf16_t* dk; pg8::bf16_t* dv; float* fk; float* fv;
                if (pm < 64) { drow = row; dk = KP; dv = VP; fk = okp + row * DM; fv = ovp + row * DM; }
                else { const int s_ = (int)(row - MP); drow = (size_t)(s_ >> 6) * KCROWS + PAST + (s_ & 63); dk = KC; dv = VC; fk = oks + (size_t)s_ * DM; fv = ovs + (size_t)s_ * DM; }
                if (typ < 2) {
                    float ss = 0.f;
#pragma unroll
                    for (int k = 0; k < 8; ++k) ss += x1[k] * x1[k] + x2[k] * x2[k];
                    ss += __shfl_xor(ss, 16); ss += __shfl_xor(ss, 32);
                    const float rstd = 1.f / sqrtf(ss * (1.f / 64.f) + EPS);
                    float o1[8], o2[8];
#pragma unroll
                    for (int q4 = 0; q4 < 4; ++q4) { const pg8::f32x4 t = tq[m][q4];
#pragma unroll
                        for (int z = 0; z < 2; ++z) { const int k = 2 * q4 + z; const float c = t[2 * z], s = t[2 * z + 1], y1 = x1[k] * rstd * g1[k], y2 = x2[k] * rstd * g2[k]; o1[k] = y1 * c - y2 * s; o2[k] = y2 * c + y1 * s; } }
                    if (typ == 0) { v4u w1, w2;
                        w1.x = pk2(o1[0] * C2, o1[1] * C2); w1.y = pk2(o1[2] * C2, o1[3] * C2); w1.z = pk2(o1[4] * C2, o1[5] * C2); w1.w = pk2(o1[6] * C2, o1[7] * C2);
                        w2.x = pk2(o2[0] * C2, o2[1] * C2); w2.y = pk2(o2[2] * C2, o2[3] * C2); w2.z = pk2(o2[4] * C2, o2[5] * C2); w2.w = pk2(o2[6] * C2, o2[7] * C2);
                        *(v4u*)(Qs + row * DM + cl) = w1; *(v4u*)(Qs + row * DM + cl + 32) = w2;
                    } else { v4u w1, w2;
                        w1.x = pk2(o1[0], o1[1]); w1.y = pk2(o1[2], o1[3]); w1.z = pk2(o1[4], o1[5]); w1.w = pk2(o1[6], o1[7]);
                        w2.x = pk2(o2[0], o2[1]); w2.y = pk2(o2[2], o2[3]); w2.z = pk2(o2[4], o2[5]); w2.w = pk2(o2[6], o2[7]);
                        *(v4u*)(dk + drow * DM + cl) = w1; *(v4u*)(dk + drow * DM + cl + 32) = w2;
                        NT_STORE(((pg8::f32x4){o1[0], o1[1], o1[2], o1[3]}), (pg8::f32x4*)(fk + cl)); NT_STORE(((pg8::f32x4){o1[4], o1[5], o1[6], o1[7]}), (pg8::f32x4*)(fk + cl + 4));
                        NT_STORE(((pg8::f32x4){o2[0], o2[1], o2[2], o2[3]}), (pg8::f32x4*)(fk + cl + 32)); NT_STORE(((pg8::f32x4){o2[4], o2[5], o2[6], o2[7]}), (pg8::f32x4*)(fk + cl + 36)); }
                } else { v4u w1, w2;
                    w1.x = pk2(x1[0], x1[1]); w1.y = pk2(x1[2], x1[3]); w1.z = pk2(x1[4], x1[5]); w1.w = pk2(x1[6], x1[7]);
                    w2.x = pk2(x2[0], x2[1]); w2.y = pk2(x2[2], x2[3]); w2.z = pk2(x2[4], x2[5]); w2.w = pk2(x2[6], x2[7]);
                    if (typ == 2) { *(v4u*)(dv + drow * DM + cl) = w1; *(v4u*)(dv + drow * DM + cl + 32) = w2;
                        NT_STORE(((pg8::f32x4){x1[0], x1[1], x1[2], x1[3]}), (pg8::f32x4*)(fv + cl)); NT_STORE(((pg8::f32x4){x1[4], x1[5], x1[6], x1[7]}), (pg8::f32x4*)(fv + cl + 4));
                        NT_STORE(((pg8::f32x4){x2[0], x2[1], x2[2], x2[3]}), (pg8::f32x4*)(fv + cl + 32)); NT_STORE(((pg8::f32x4){x2[4], x2[5], x2[6], x2[7]}), (pg8::f32x4*)(fv + cl + 36)); }
                    else { *(v4u*)(GA + row * DM + cl) = w1; *(v4u*)(GA + row * DM + cl + 32) = w2; }
                }
                if (m & 1) asm volatile("" ::: "memory");
            }
        }
    }
};
__device__ __forceinline__ void attn_table(Frame& F, float* tab) {
    const size_t gt = (size_t)F.bid * NTHR + F.tid, NG = (size_t)F.G * NTHR;
    for (size_t e = gt; e < (size_t)MP * 32; e += NG) { float c, s; rope_cs((int)(e >> 5), (int)(e & 31), 32, c, s); tab[2 * e] = c; tab[2 * e + 1] = s; }
}
namespace dattn {
typedef short bf16x8 __attribute__((ext_vector_type(8)));
typedef short s16x4 __attribute__((ext_vector_type(4)));
typedef short v4i16_t __attribute__((ext_vector_type(4)));
typedef float f32x16 __attribute__((ext_vector_type(16)));
typedef unsigned u32x4 __attribute__((ext_vector_type(4)));
typedef __attribute__((address_space(3))) const char* lds_cptr;
constexpr int RINGB = 98304, WSF_OFF = RINGB, XCHB = 18432, STP = 144;
__device__ __forceinline__ int crow(int r, int hi) { return (r & 3) + 8 * (r >> 2) + 4 * hi; }
__device__ __forceinline__ void glds16(const void* gsrc, unsigned lds_dst) { unsigned keep;
    asm volatile("s_mov_b32 %0, m0\n\ts_mov_b32 m0, %2\n\ts_nop 0\n\tglobal_load_lds_dwordx4 %1, off\n\ts_mov_b32 m0, %0" : "=&s"(keep) : "v"(gsrc), "s"(lds_dst) : "memory"); }
typedef float f32x2_t __attribute__((ext_vector_type(2))); typedef __bf16 bf16x2_t __attribute__((ext_vector_type(2)));
__device__ __forceinline__ unsigned cvtpk_s(float lo, float hi) { f32x2_t v = {lo, hi}; bf16x2_t b = __builtin_convertvector(v, bf16x2_t); return __builtin_bit_cast(unsigned, b); }
#define DA_WAIT_BAR(N) asm volatile("s_waitcnt vmcnt(" #N ") lgkmcnt(0)\n\ts_barrier" ::: "memory")
__device__ __forceinline__ s16x4 vtr(lds_cptr p) { return __builtin_bit_cast(s16x4, __builtin_amdgcn_ds_read_tr16_b64_v4i16((__attribute__((address_space(3))) v4i16_t*)p)); }
struct Unit { const bf16* Q; const bf16* K; const bf16* V; const bf16* G; bf16* AO; int NT; int full; int dma0; };

constexpr int KSLOT = 16384, VSLOT = 16384, VRING = 3 * KSLOT;
#define DA_SBAR() __builtin_amdgcn_sched_barrier(0)
#define DA_PIN(x) asm volatile("" : "+v"(x))
#define DA_MFMA(a, b, c) __builtin_amdgcn_mfma_f32_32x32x16_bf16(a, b, c, 0, 0, 0)
struct DmaJob { const bf16* kp; const bf16* vp; unsigned kd0, kd1, vd0, vd1; };
__device__ __forceinline__ void dma_piece(const DmaJob& j, int i) { if (i == 0) glds16(j.kp, j.kd0); else if (i == 1) glds16(j.kp + 64, j.kd1); else if (i == 2) glds16(j.vp, j.vd0); else glds16(j.vp + 64, j.vd1); }
template <bool QK, bool PV, int VAR>
__device__ __forceinline__ void step(lds_cptr kpn, lds_cptr vp, const bf16x8 (&qr)[4], bf16x8 (&kf)[8], f32x16 (&o)[4], u32x4 (&pw)[4], float& l_reg, const DmaJob& dj) {
    f32x16 C0 = f32x16{}, C1 = f32x16{};
    s16x4 vlo[4], vhi[4];
    if constexpr (!QK) { dma_piece(dj, 0); dma_piece(dj, 1); dma_piece(dj, 2); dma_piece(dj, 3); }
#define DA_FOFF(f) ((((f) & 3) * 4096) + (((f) >> 2) * 1024))
#pragma unroll
    for (int a = 0; a < 8; ++a) {
        if constexpr (PV) { if (a >= 4) { if (VAR != 4) { vlo[a - 4] = vtr(vp + DA_FOFF(a - 4)); vhi[a - 4] = vtr(vp + DA_FOFF(a - 4) + 512); } else { vlo[a - 4] = s16x4{1, 2, 3, 4}; vhi[a - 4] = s16x4{5, 6, 7, 8}; } DA_SBAR(); } }
        if constexpr (QK) {
            if (a & 1) C1 = (a < 2) ? DA_MFMA(kf[a], qr[a >> 1], f32x16{}) : DA_MFMA(kf[a], qr[a >> 1], C1);
            else       C0 = (a < 2) ? DA_MFMA(kf[a], qr[a >> 1], f32x16{}) : DA_MFMA(kf[a], qr[a >> 1], C0);
            if (a < 4) dma_piece(dj, a);
            DA_SBAR();
        }
    }
    u32x4 pwn[4]; pwn[0] = u32x4{}; pwn[1] = u32x4{}; pwn[2] = u32x4{}; pwn[3] = u32x4{};
    float s0 = 0.f, s1 = 0.f;
#pragma unroll
    for (int p = 0; p < 16; ++p) {
        if constexpr (PV) {
            const bf16x8 vf = (bf16x8){vlo[p & 3][0], vlo[p & 3][1], vlo[p & 3][2], vlo[p & 3][3], vhi[p & 3][0], vhi[p & 3][1], vhi[p & 3][2], vhi[p & 3][3]};
            if (VAR != 3) o[p & 3] = DA_MFMA(__builtin_bit_cast(bf16x8, pw[p >> 2]), vf, o[p & 3]); else { o[p & 3][0] += __builtin_bit_cast(float, (int)vf[0] | ((int)vf[4] << 16)); }
            if (p < 12 && VAR != 4) { vlo[p & 3] = vtr(vp + DA_FOFF(p + 4)); vhi[p & 3] = vtr(vp + DA_FOFF(p + 4) + 512); }
        }
        if constexpr (QK) {
            float e0, e1;
            if (VAR == 2) { if (p < 8) { e0 = C0[2 * p]; e1 = C0[2 * p + 1]; } else { e0 = C1[2 * p - 16]; e1 = C1[2 * p - 15]; } }
            else if (p < 8) { e0 = __builtin_amdgcn_exp2f(C0[2 * p]); e1 = __builtin_amdgcn_exp2f(C0[2 * p + 1]); }
            else       { e0 = __builtin_amdgcn_exp2f(C1[2 * p - 16]); e1 = __builtin_amdgcn_exp2f(C1[2 * p - 15]); }
            s0 += e0; s1 += e1; pwn[p >> 2][p & 3] = cvtpk_s(e0, e1);
            DA_PIN(s0); DA_PIN(s1); DA_PIN(pwn[p >> 2]);
            if (p >= 8 && VAR != 6) { const int j = p - 8; kf[j] = *(const __attribute__((address_space(3))) bf16x8*)(kpn + (j >> 1) * 2048 + (j & 1) * 512); }
        }
        DA_SBAR();
    }
    if constexpr (QK) { l_reg += s0 + s1; pw[0] = pwn[0]; pw[1] = pwn[1]; pw[2] = pwn[2]; pw[3] = pwn[3]; }
#undef DA_FOFF
}

template <bool QK, bool PV>
__device__ __forceinline__ void step2(lds_cptr kpn, lds_cptr vp, const bf16x8 (&qr)[4], bf16x8 (&kf)[8], f32x16 (&o)[4], u32x4 (&pw)[4], float& l_reg, const DmaJob& dj,
                                      f32x16& Cn0, f32x16& Cn1, const f32x16& Pp0, const f32x16& Pp1) {
    s16x4 vlo[4], vhi[4];
#define DA_FOFF(f) ((((f) & 3) * 4096) + (((f) >> 2) * 1024))
    if constexpr (!QK) { dma_piece(dj, 0); dma_piece(dj, 1); dma_piece(dj, 2); dma_piece(dj, 3); }
    float s0 = 0.f, s1 = 0.f;
#pragma unroll
    for (int a = 0; a < 8; ++a) {
        if constexpr (PV) { if (a >= 4) { vlo[a - 4] = vtr(vp + DA_FOFF(a - 4)); vhi[a - 4] = vtr(vp + DA_FOFF(a - 4) + 512); DA_SBAR(); } }
        if constexpr (QK) {
            if (a & 1) Cn1 = (a < 2) ? DA_MFMA(kf[a], qr[a >> 1], f32x16{}) : DA_MFMA(kf[a], qr[a >> 1], Cn1);
            else       Cn0 = (a < 2) ? DA_MFMA(kf[a], qr[a >> 1], f32x16{}) : DA_MFMA(kf[a], qr[a >> 1], Cn0);
            if (a < 4) dma_piece(dj, a);
        }
        if constexpr (PV) {
            float x0, x1, x2, x3;
            if (a < 4) { x0 = Pp0[4 * a]; x1 = Pp0[4 * a + 1]; x2 = Pp0[4 * a + 2]; x3 = Pp0[4 * a + 3]; }
            else       { x0 = Pp1[4 * a - 16]; x1 = Pp1[4 * a - 15]; x2 = Pp1[4 * a - 14]; x3 = Pp1[4 * a - 13]; }
            s0 += x0; s1 += x1; s0 += x2; s1 += x3;
            pw[(2 * a) >> 2][(2 * a) & 3] = cvtpk_s(x0, x1); pw[(2 * a + 1) >> 2][(2 * a + 1) & 3] = cvtpk_s(x2, x3);
            DA_PIN(s0); DA_PIN(s1); DA_PIN(pw[(2 * a) >> 2]);
        }
        if constexpr (QK || PV) DA_SBAR();
    }
    if constexpr (PV) l_reg += s0 + s1;
#pragma unroll
    for (int p = 0; p < 16; ++p) {
        if constexpr (PV) {
            const bf16x8 vf = (bf16x8){vlo[p & 3][0], vlo[p & 3][1], vlo[p & 3][2], vlo[p & 3][3], vhi[p & 3][0], vhi[p & 3][1], vhi[p & 3][2], vhi[p & 3][3]};
            o[p & 3] = DA_MFMA(__builtin_bit_cast(bf16x8, pw[p >> 2]), vf, o[p & 3]);
            if (p < 12) { vlo[p & 3] = vtr(vp + DA_FOFF(p + 4)); vhi[p & 3] = vtr(vp + DA_FOFF(p + 4) + 512); }
        }
        if constexpr (QK) {
            if (p < 8) { Cn0[2 * p] = __builtin_amdgcn_exp2f(Cn0[2 * p]); Cn0[2 * p + 1] = __builtin_amdgcn_exp2f(Cn0[2 * p + 1]); DA_PIN(Cn0); }
            else       { Cn1[2 * p - 16] = __builtin_amdgcn_exp2f(Cn1[2 * p - 16]); Cn1[2 * p - 15] = __builtin_amdgcn_exp2f(Cn1[2 * p - 15]); DA_PIN(Cn1); }
            if (p >= 8) { const int j = p - 8; kf[j] = *(const __attribute__((address_space(3))) bf16x8*)(kpn + (j >> 1) * 2048 + (j & 1) * 512); }
        }
        if constexpr (QK || PV) DA_SBAR();
    }
#undef DA_FOFF
}

__device__ __forceinline__ void unit_prologue(const Unit& u, unsigned lds0, int lane, int wid, bf16x8 (&qr)[4]) {
    const int r32 = lane & 31, hi = lane >> 5, s = wid >> 2, g = wid & 3; const int NT = u.NT; const int wt = u.full ? (g < 2 ? NT - 1 : NT) : (g < 2 ? NT : 0);
    const bf16* ksrc = u.K + (long)lane * DM + wid * 8;
    const bf16* vsrc = u.V + (long)(16 * (wid & 3) + (lane >> 2)) * DM + (wid >> 2) * 32 + (lane & 3) * 8;
    const unsigned kdst = lds0 + wid * 1024, vdst = lds0 + VRING + wid * 1024;
#pragma unroll
    for (int t = 0; t < 3; ++t) { const int tt_ = t < NT ? t : NT - 1; const bf16* kp_ = ksrc + (long)tt_ * 64 * DM;
        glds16(kp_, (unsigned)__builtin_amdgcn_readfirstlane(kdst + t * KSLOT)); glds16(kp_ + 64, (unsigned)__builtin_amdgcn_readfirstlane(kdst + 8192 + t * KSLOT)); }
    glds16(vsrc, (unsigned)__builtin_amdgcn_readfirstlane(vdst)); glds16(vsrc + 64, (unsigned)__builtin_amdgcn_readfirstlane(vdst + 8192));
    const bf16* Qw = u.Q + (long)(32 * g + r32) * DM + s * 64;
#pragma unroll
    for (int d0 = 0; d0 < 4; ++d0) qr[d0] = (wt > 0) ? *reinterpret_cast<const bf16x8*>(Qw + d0 * 16 + hi * 8) : (bf16x8){0, 0, 0, 0, 0, 0, 0, 0};
}
template <int VAR>
__device__ __forceinline__ void attn_unit(const Unit& u, bool has_next, const Unit& nxt, bool prefetched, bf16x8 (&qr)[4], char* shm, float* wsf_base, float lam, float one_m_li, const float* sub_gain, int tid) {
    asm volatile("" : "+v"(tid));
    const int lane = tid & 63, r32 = lane & 31, hi = lane >> 5; const int wid = __builtin_amdgcn_readfirstlane(tid >> 6), s = wid >> 2, g = wid & 3;
    const int NT = u.NT; const int wt = u.full ? (g < 2 ? NT - 1 : NT) : (g < 2 ? NT : 0);
    const unsigned lds0 = (unsigned)(uintptr_t)shm;
    float* wsf = wsf_base + wid * 64;
    const bf16* ksrc = u.K + (long)lane * DM + wid * 8;
    const bf16* vsrc = u.V + (long)(16 * (wid & 3) + (lane >> 2)) * DM + (wid >> 2) * 32 + (lane & 3) * 8;
    const unsigned kdst = lds0 + wid * 1024, vdst = lds0 + VRING + wid * 1024;
#define DA_DMA_K(t, slot) do { const int tt_ = u.dma0 ? 0 : (t) < NT ? (t) : NT - 1; const bf16* kp_ = ksrc + (long)tt_ * 64 * DM; \
        glds16(kp_, (unsigned)__builtin_amdgcn_readfirstlane(kdst + (slot) * KSLOT)); glds16(kp_ + 64, (unsigned)__builtin_amdgcn_readfirstlane(kdst + 8192 + (slot) * KSLOT)); } while (0)
#define DA_DMA_V(t, slot) do { const int tt_ = u.dma0 ? 0 : (t) < NT ? (t) : NT - 1; const bf16* vp_ = vsrc + (long)tt_ * 64 * DM; \
        glds16(vp_, (unsigned)__builtin_amdgcn_readfirstlane(vdst + (slot) * VSLOT)); glds16(vp_ + 64, (unsigned)__builtin_amdgcn_readfirstlane(vdst + 8192 + (slot) * VSLOT)); } while (0)
    const lds_cptr shm3 = (lds_cptr)shm;
    const lds_cptr kp0 = shm3 + s * 8192 + hi * 1024 + r32 * 16;
    const lds_cptr vp0 = shm3 + VRING + ((lane >> 4) & 1) * 32 + (lane & 3) * 8 + (4 * hi + ((lane & 15) >> 2)) * 64;
    if (!prefetched) unit_prologue(u, lds0, lane, wid, qr);
    asm volatile("" : "+v"(qr[0]), "+v"(qr[1]), "+v"(qr[2]), "+v"(qr[3]));
    f32x16 o[4]; o[0] = f32x16{}; o[1] = f32x16{}; o[2] = f32x16{}; o[3] = f32x16{};
    float l_reg = 0.f;
    u32x4 pw[4]; pw[0] = u32x4{}; pw[1] = u32x4{}; pw[2] = u32x4{}; pw[3] = u32x4{};
    DA_WAIT_BAR(0);
    bf16x8 kf[8];
#pragma unroll
    for (int j = 0; j < 8; ++j) kf[j] = *(const __attribute__((address_space(3))) bf16x8*)(kp0 + (j >> 1) * 2048 + (j & 1) * 512);
    int ks_cur = 0  , vs_prev = 2  ;
#define DA_TOP(t) \
        DA_WAIT_BAR(4);                                          \
        const int ks_next = (ks_cur == 2) ? 0 : ks_cur + 1, vs_cur = (vs_prev == 2) ? 0 : vs_prev + 1, vs_next = (vs_cur == 2) ? 0 : vs_cur + 1; \
        DmaJob dj; { const int tk_ = ((t) + 3) < NT ? ((t) + 3) : NT - 1, tv_ = ((t) + 1) < NT ? ((t) + 1) : NT - 1; dj.kp = ksrc + (long)tk_ * 64 * DM; dj.vp = vsrc + (long)tv_ * 64 * DM; \
          dj.kd0 = (unsigned)__builtin_amdgcn_readfirstlane(kdst + ks_cur * KSLOT); dj.kd1 = dj.kd0 + 8192u; dj.vd0 = (unsigned)__builtin_amdgcn_readfirstlane(vdst + vs_next * VSLOT); dj.vd1 = dj.vd0 + 8192u; }     \
        const lds_cptr kpn = kp0 + ks_next * KSLOT; const lds_cptr vp = vp0 + vs_prev * VSLOT; (void)kpn; (void)vp
#define DA_ROT() do { ks_cur = ks_next; vs_prev = vs_cur; } while (0)
    f32x16 pA0 = f32x16{}, pA1 = f32x16{}, pB0 = f32x16{}, pB1 = f32x16{};
#define DA_IDLE() do { dma_piece(dj, 0); dma_piece(dj, 1); dma_piece(dj, 2); dma_piece(dj, 3); } while (0)
    if (wid >= 4) __builtin_amdgcn_s_setprio(1);
    int t = 0;
    const bool odd = ((wt - 1) & 1) != 0;
    { DA_TOP(0); if (wt > 0) { if (odd) step2<true, false>(kpn, vp, qr, kf, o, pw, l_reg, dj, pB0, pB1, pA0, pA1); else step2<true, false>(kpn, vp, qr, kf, o, pw, l_reg, dj, pA0, pA1, pB0, pB1); } else DA_IDLE(); DA_ROT(); }
    t = 1;
    if (wt > 0 && odd) { DA_TOP(t); step2<true, true>(kpn, vp, qr, kf, o, pw, l_reg, dj, pA0, pA1, pB0, pB1); DA_ROT(); ++t; }
    for (; t + 1 < wt; t += 2) {
        { DA_TOP(t);     step2<true, true>(kpn, vp, qr, kf, o, pw, l_reg, dj, pB0, pB1, pA0, pA1); DA_ROT(); }
        { DA_TOP(t + 1); step2<true, true>(kpn, vp, qr, kf, o, pw, l_reg, dj, pA0, pA1, pB0, pB1); DA_ROT(); }
    }
    if (wt > 0) { DA_TOP(t); step2<false, true>(kpn, vp, qr, kf, o, pw, l_reg, dj, pB0, pB1, pA0, pA1); DA_ROT(); ++t; }
    for (; t <= NT; ++t) { DA_TOP(t); DA_IDLE(); DA_ROT(); }
#undef DA_IDLE
#undef DA_TOP
#undef DA_ROT
    __builtin_amdgcn_s_setprio(0);
    { auto rr = __builtin_amdgcn_permlane32_swap(__float_as_uint(l_reg), __float_as_uint(l_reg), false, false); l_reg = __uint_as_float(rr[0]) + __uint_as_float(rr[1]); }
    if (hi == 0) wsf[r32] = l_reg;
    DA_WAIT_BAR(0);
    if (has_next) unit_prologue(nxt, lds0, lane, wid, qr);
    float rli[16];
#pragma unroll
    for (int r = 0; r < 16; ++r) { const float lq = wsf[crow(r, hi)]; rli[r] = (s == 0 ? 1.f : -lam) / lq; }
    int le = lane; asm volatile("" : "+v"(le));
    const int r32e = le & 31, hie = le >> 5;
    float* xch = (float*)(shm + 65536 + g * XCHB);
    if (s == 1 && wt > 0) {
#pragma unroll
        for (int db = 0; db < 4; ++db)
#pragma unroll
            for (int r = 0; r < 16; ++r) xch[(db * 16 + r) * 64 + le] = o[db][r] * rli[r];
    }
    asm volatile("s_waitcnt lgkmcnt(0)\n\ts_barrier" ::: "memory");
    if (s == 0 && wt > 0) {
#pragma unroll
        for (int db = 0; db < 4; ++db)
#pragma unroll
            for (int r = 0; r < 16; ++r) o[db][r] = o[db][r] * rli[r] + xch[(db * 16 + r) * 64 + le];
        asm volatile("s_waitcnt lgkmcnt(0)" ::: "memory");
#pragma unroll
        for (int db = 0; db < 4; ++db)
#pragma unroll
            for (int r = 0; r < 16; ++r) xch[crow(r, hie) * STP + 32 * db + r32e] = o[db][r];
        asm volatile("s_waitcnt lgkmcnt(0)" ::: "memory");
        const int row = le >> 1, half = le & 1;
        float v[64]; float ss = 0.f;
#pragma unroll
        for (int k = 0; k < 16; ++k) { const f32x4 x = *(const f32x4*)(xch + row * STP + half * 64 + 4 * k); v[4 * k] = x.x; v[4 * k + 1] = x.y; v[4 * k + 2] = x.z; v[4 * k + 3] = x.w; ss += (x.x * x.x + x.y * x.y) + (x.z * x.z + x.w * x.w); }
        ss += __shfl_xor(ss, 1);
        const float sc = one_m_li / sqrtf(ss * (1.f / 128.f) + EPS);
        const bf16* gp = u.G + (long)(32 * g + row) * DM + half * 64; bf16* op = u.AO + (long)(32 * g + row) * DM + half * 64; const float* sg = sub_gain + half * 64;
#pragma unroll
        for (int k = 0; k < 8; ++k) { const v4u g4 = *(const v4u*)(gp + 8 * k); const f32x4 ga = *(const f32x4*)(sg + 8 * k), gb = *(const f32x4*)(sg + 8 * k + 4);
            const float gg[8] = {bflo(g4.x), bfhi(g4.x), bflo(g4.y), bfhi(g4.y), bflo(g4.z), bfhi(g4.z), bflo(g4.w), bfhi(g4.w)};
            const float gn[8] = {ga.x, ga.y, ga.z, ga.w, gb.x, gb.y, gb.z, gb.w}; float y[8];
#pragma unroll
            for (int e = 0; e < 8; ++e) y[e] = v[8 * k + e] * sc * gn[e] * silu_f(gg[e]);
            v4u w; w.x = pk2(y[0], y[1]); w.y = pk2(y[2], y[3]); w.z = pk2(y[4], y[5]); w.w = pk2(y[6], y[7]);
            *(v4u*)(op + 8 * k) = w; }
    }
#undef DA_DMA_K
#undef DA_DMA_V
}
}
template <int VAR = 0>
__device__ __forceinline__ void attn_fast(Frame& F, const bf16* Qs, const bf16* KP, const bf16* VP, const bf16* KC, const bf16* VC, const bf16* GA  , bf16* AO,
                                          float lam, float one_m_li, const float* sub_gain, int dma0 = 0) {
    const int NU = 2048 + 16 * NB;
    const bool xcd = (F.G == 256);
#define ATTN_GET(i_, u_, ok_) do { int qb = 0, h = 0, b = -1; ok_ = true; \
        if (xcd) { const int x = F.bid & 7, r = F.bid >> 3; \
            if ((i_) < 8) { h = x + 8 * ((i_) >> 2); const int rr = ((i_) == 0) ? (r ^ 8) : r; qb = 127 - (((i_) & 3) * 32 + (((i_) & 1) ? 31 - rr : rr)); } \
            else if ((i_) == 8 && (r & 8) == 0) { const int sb = (r & 7) + ((r >> 4) << 3); h = x + 8 * (sb >> 3); b = sb & 7; } \
            else ok_ = false; \
        } else { const int idx = (i_) * F.G + (((i_) & 1) ? F.G - 1 - F.bid : F.bid); if (idx >= NU) ok_ = false; \
            else if (idx < 2048) { qb = 127 - (idx >> 4); h = idx & 15; } else { const int j = idx - 2048; b = j >> 4; h = j & 15; } } \
        u_.dma0 = 0; \
        if (ok_) { if (b < 0) { const long row0 = 128L * qb; \
            u_.Q = Qs + row0 * DM + h * 128; u_.K = KP + h * 128; u_.V = VP + h * 128; u_.G = GA + row0 * DM + h * 128; u_.AO = AO + row0 * DM + h * 128; u_.NT = 2 * qb + 2; u_.full = 1; } \
          else { const long row0 = MP + 64L * b; \
            u_.Q = Qs + row0 * DM + h * 128; u_.K = KC + (long)b * KCROWS * DM + h * 128; u_.V = VC + (long)b * KCROWS * DM + h * 128; u_.G = GA + row0 * DM + h * 128; u_.AO = AO + row0 * DM + h * 128; u_.NT = KCROWS / 64; u_.full = 0; } } } while (0)
    dattn::Unit u, nx; bool have; ATTN_GET(0, u, have);
    dattn::bf16x8 qr[4]; bool pre = false;
    float* wsf_base = (float*)((char*)F.lds + MISC_OFF + 1024);
    for (int i = 0; have; ++i) {
        bool hn; ATTN_GET(i + 1, nx, hn);
        dattn::attn_unit<VAR>(u, hn, nx, pre, qr, (char*)F.lds + RING_OFF, wsf_base, lam, one_m_li, sub_gain, F.tid);
        u = nx; have = hn; pre = true;
    }
    __syncthreads();
#undef ATTN_GET
}
constexpr int RBLK = 72;
__device__ __forceinline__ float ret_lg2(int h) { return log2f(1.f - exp2f(-5.f - (float)h)); }
struct EpiRet {
    static constexpr int BMODE = 0;
    pg8::bf16_t* QP; pg8::bf16_t* KN; pg8::bf16_t* KT; pg8::bf16_t* VS; pg8::bf16_t* RG; const float* tab; const float* ssq;
    __device__ __forceinline__ void operator()(const pg8::f32x4 (&acc)[2][2][4][2], const pg8::Unit& u, int wr, int wc, int fr, int fq) const {
        { const int l_ = lane_now(); fr = l_ & 15; fq = l_ >> 4; }
        const int pn = u.pn, pm = u.pm; float rs[2][4]; row_rstd(ssq, pm, wr, fr, fq, rs);
#pragma unroll
        for (int ai = 0; ai < 2; ++ai)
#pragma unroll
            for (int m = 0; m < 4; ++m) {
                const int i = ai * 128 + wr * 64 + m * 16 + fr; const size_t row = (size_t)pm * 256 + i;
                const int J = pm < 64 ? pm : 64 + 4 * (pm - 64) + (i >> 6), jj = pm < 64 ? i : (i & 63), pos = pm < 64 ? (int)row : PAST + (i & 63);
                if (pn < 16) {
                    const int h = pn & 7; const bool isk = pn >= 8; const float sc = isk ? 0.0625f : 1.f;
#pragma unroll
                    for (int n = 0; n < 2; ++n) { const int c1 = wc * 32 + n * 16 + 4 * fq;
                        const pg8::f32x4 t0 = *(const pg8::f32x4*)(tab + ((size_t)pos * 128 + c1) * 2), t1 = *(const pg8::f32x4*)(tab + ((size_t)pos * 128 + c1) * 2 + 4);
                        const pg8::f32x4 x1 = acc[ai][0][m][n] * rs[ai][m], x2 = acc[ai][1][m][n] * rs[ai][m];
                        const float cs[4] = {t0[0], t0[2], t1[0], t1[2]}, sn[4] = {t0[1], t0[3], t1[1], t1[3]}; float o1[4], o2[4];
#pragma unroll
                        for (int e = 0; e < 4; ++e) { o1[e] = (x1[e] * cs[e] - x2[e] * sn[e]) * sc; o2[e] = (x2[e] * cs[e] + x1[e] * sn[e]) * sc; }
                        v2u w1, w2; w1.x = pk2(o1[0], o1[1]); w1.y = pk2(o1[2], o1[3]); w2.x = pk2(o2[0], o2[1]); w2.y = pk2(o2[2], o2[3]);
                        if (!isk) { pg8::bf16_t* p = QP + row * 4096 + h * 512 + 256 + c1; *(v2u*)p = w1; *(v2u*)(p + 128) = w2; }
                        else { pg8::bf16_t* p = KN + row * 2048 + h * 256 + c1; *(v2u*)p = w1; *(v2u*)(p + 128) = w2;
                            pg8::bf16_t* t = KT + ((size_t)(J * 8 + h) * 256 + c1) * 256 + jj;
#pragma unroll
                            for (int e = 0; e < 4; ++e) { t[(size_t)e * 256] = (pg8::bf16_t)f2bf(o1[e]); t[(size_t)(128 + e) * 256] = (pg8::bf16_t)f2bf(o2[e]); } } }
                } else if (pn < 32) {
                    const int h = (pn - 16) >> 1, half = (pn - 16) & 1; const float f = exp2f(-(float)(1 + jj) * ret_lg2(h)) * rs[ai][m];
#pragma unroll
                    for (int bj = 0; bj < 2; ++bj)
#pragma unroll
                        for (int n = 0; n < 2; ++n) { const int dv = half * 256 + bj * 128 + wc * 32 + n * 16 + 4 * fq; pg8::bf16_t* t = VS + ((size_t)(J * 8 + h) * 512 + dv) * 512 + jj;
#pragma unroll
                            for (int e = 0; e < 4; ++e) t[(size_t)e * 512] = (pg8::bf16_t)f2bf(acc[ai][bj][m][n][e] * f); }
                } else {
#pragma unroll
                    for (int bj = 0; bj < 2; ++bj)
#pragma unroll
                        for (int n = 0; n < 2; ++n) { const int c = (pn - 32) * 256 + bj * 128 + wc * 32 + n * 16 + 4 * fq; const pg8::f32x4 x = acc[ai][bj][m][n] * rs[ai][m];
                            v2u w; w.x = pk2(x[0], x[1]); w.y = pk2(x[2], x[3]); *(v2u*)(RG + row * 4096 + c) = w; }
                }
            }
    }
};
__device__ __forceinline__ size_t ret_row0(int J) { return J < 64 ? (size_t)256 * J : (size_t)MP + 64 * (J - 64); }
struct RetQKOrder {
    int G, c; const char* QP; const char* KN;
    __device__ __forceinline__ bool next(int i, pg8::Unit& u) const { const int L = i * G + c; if (L >= RBLK * 8) return false; const int J = L >> 3, h = L & 7; const size_t r0 = ret_row0(J);
        u.pm = J; u.pn = h; u.a = QP + (r0 * 4096 + h * 512 + 256) * 2; u.b = KN + (r0 * 2048 + h * 256) * 2; return true; }
    __device__ __forceinline__ void a_ready(const pg8::Unit&) const {}
    __device__ __forceinline__ void done(const pg8::Unit&) const {}
};
struct EpiRetQK {
    static constexpr int BMODE = 1;
    pg8::bf16_t* QP;
    __device__ __forceinline__ void operator()(const pg8::f32x4 (&acc)[2][2][4][2], const pg8::Unit& u, int wr, int wc, int fr, int fq) const {
        { const int l_ = lane_now(); fr = l_ & 15; fq = l_ >> 4; }
        const int J = u.pm, h = u.pn, nv = J < 64 ? 256 : 64; const size_t r0 = ret_row0(J);
#pragma unroll
        for (int ai = 0; ai < 2; ++ai)
#pragma unroll
            for (int m = 0; m < 4; ++m) { const int i = ai * 128 + wr * 64 + m * 16 + fr;
                if (i < nv) {
#pragma unroll
                    for (int bj = 0; bj < 2; ++bj) { const int j0 = bj * 128 + wc * 32 + 8 * fq; const pg8::f32x4 v0 = acc[ai][bj][m][0], v1 = acc[ai][bj][m][1]; float x[8] = {v0[0], v0[1], v0[2], v0[3], v1[0], v1[1], v1[2], v1[3]};
#pragma unroll
                        for (int k = 0; k < 8; ++k) x[k] = (j0 + k <= i) ? x[k] : 0.f;
                        v4u w; w.x = pk2(x[0], x[1]); w.y = pk2(x[2], x[3]); w.z = pk2(x[4], x[5]); w.w = pk2(x[6], x[7]);
                        *(v4u*)(QP + (r0 + i) * 4096 + h * 512 + j0) = w; } } }
    }
};
struct RetOOrder {
    int G, c; const char* QP; const char* VS;
    __device__ __forceinline__ bool next(int i, pg8::Unit& u) const { const int L = i * G + c; if (L >= RBLK * 16) return false; const int J = L >> 4, r = L & 15, h = r >> 1, half = r & 1; const size_t r0 = ret_row0(J);
        u.pm = J; u.pn = r; u.a = QP + (r0 * 4096 + h * 512) * 2; u.b = VS + (((size_t)(J * 8 + h) * 512 + half * 256) * 512) * 2; return true; }
    __device__ __forceinline__ void a_ready(const pg8::Unit&) const {}
    __device__ __forceinline__ void done(const pg8::Unit&) const {}
};
struct EpiRetO {
    static constexpr int BMODE = 1;
    pg8::bf16_t* O;
    __device__ __forceinline__ void operator()(const pg8::f32x4 (&acc)[2][2][4][2], const pg8::Unit& u, int wr, int wc, int fr, int fq) const {
        { const int l_ = lane_now(); fr = l_ & 15; fq = l_ >> 4; }
        const int J = u.pm, h = u.pn >> 1, half = u.pn & 1, nv = J < 64 ? 256 : 64; const size_t r0 = ret_row0(J); const float lg = ret_lg2(h);
#pragma unroll
        for (int ai = 0; ai < 2; ++ai)
#pragma unroll
            for (int m = 0; m < 4; ++m) { const int i = ai * 128 + wr * 64 + m * 16 + fr;
                if (i < nv) { const float f = exp2f((float)(i + 1) * lg);
#pragma unroll
                    for (int bj = 0; bj < 2; ++bj) { const int j0 = bj * 128 + wc * 32 + 8 * fq; const pg8::f32x4 v0 = acc[ai][bj][m][0] * f, v1 = acc[ai][bj][m][1] * f;
                        v4u w; w.x = pk2(v0[0], v0[1]); w.y = pk2(v0[2], v0[3]); w.z = pk2(v1[0], v1[1]); w.w = pk2(v1[2], v1[3]);
                        *(v4u*)(O + (r0 + i) * 4096 + h * 512 + half * 256 + j0) = w; } } }
    }
};
struct RetKVOrder {
    int G, c; const char* VS; const char* KT;
    __device__ __forceinline__ bool next(int i, pg8::Unit& u) const { const int L = i * G + c; if (L >= RBLK * 16) return false; const int J = L >> 4, r = L & 15, h = r >> 1, half = r & 1;
        u.pm = J; u.pn = r; u.a = VS + (((size_t)(J * 8 + h) * 512 + half * 256) * 512) * 2; u.b = KT + ((size_t)(J * 8 + h) * 256 * 256) * 2; return true; }
    __device__ __forceinline__ void a_ready(const pg8::Unit&) const {}
    __device__ __forceinline__ void done(const pg8::Unit&) const {}
};
struct EpiRetKV {
    static constexpr int BMODE = 1;
    pg8::bf16_t* VS; pg8::bf16_t* KVX;
    __device__ __forceinline__ void operator()(const pg8::f32x4 (&acc)[2][2][4][2], const pg8::Unit& u, int wr, int wc, int fr, int fq) const {
        { const int l_ = lane_now(); fr = l_ & 15; fq = l_ >> 4; }
        const int J = u.pm, h = u.pn >> 1, half = u.pn & 1;
        pg8::bf16_t* base; int pitch;
        if (J < 63) { base = VS + ((size_t)((J + 1) * 8 + h) * 512 + half * 256) * 512 + 256; pitch = 512; }
        else { base = KVX + ((size_t)((J - 63) * 8 + h) * 512 + half * 256) * 256; pitch = 256; }
#pragma unroll
        for (int ai = 0; ai < 2; ++ai)
#pragma unroll
            for (int m = 0; m < 4; ++m) { pg8::bf16_t* rowp = base + (size_t)(ai * 128 + wr * 64 + m * 16 + fr) * pitch + wc * 32 + 8 * fq;
#pragma unroll
                for (int bj = 0; bj < 2; ++bj) { const pg8::f32x4 v0 = acc[ai][bj][m][0], v1 = acc[ai][bj][m][1];
                    v4u w; w.x = pk2(v0[0], v0[1]); w.y = pk2(v0[2], v0[3]); w.z = pk2(v1[0], v1[1]); w.w = pk2(v1[2], v1[3]);
                    *(v4u*)(rowp + bj * 128) = w; } }
    }
};
__device__ __forceinline__ void ret_scan(Frame& F, bf16* VS, const bf16* KVX, const float* state_in, float* osp, float* oss) {
    const int gt = F.bid * NTHR + F.tid;
    for (int c = gt; c < 8 * 512 * 32; c += F.G * NTHR) {
        const int h = c >> 14, dv = (c >> 5) & 511, dk0 = (c & 31) * 8; const float lg = ret_lg2(h), g256 = exp2f(256.f * lg), g64 = exp2f(64.f * lg);
        float S[8];
#pragma unroll
        for (int k = 0; k < 8; ++k) S[k] = 0.f;
        bf16* slot = VS + ((size_t)h * 512 + dv) * 512 + 256 + dk0;
        *(v4u*)slot = (v4u){0u, 0u, 0u, 0u};
        v4u nx = *(const v4u*)(slot + (size_t)8 * 512 * 512);
        for (int J = 1; J < 64; ++J) {
            const v4u kv = nx; bf16* sj = slot + (size_t)J * 8 * 512 * 512;
            if (J < 63) nx = *(const v4u*)(sj + (size_t)8 * 512 * 512);
            const float x[8] = {bflo(kv.x), bfhi(kv.x), bflo(kv.y), bfhi(kv.y), bflo(kv.z), bfhi(kv.z), bflo(kv.w), bfhi(kv.w)};
#pragma unroll
            for (int k = 0; k < 8; ++k) S[k] = (S[k] + x[k]) * g256;
            v4u w; w.x = pk2(S[0], S[1]); w.y = pk2(S[2], S[3]); w.z = pk2(S[4], S[5]); w.w = pk2(S[6], S[7]);
            *(v4u*)sj = w;
        }
        { const v4u kv = *(const v4u*)(KVX + ((size_t)h * 512 + dv) * 256 + dk0);
          const float x[8] = {bflo(kv.x), bfhi(kv.x), bflo(kv.y), bfhi(kv.y), bflo(kv.z), bfhi(kv.z), bflo(kv.w), bfhi(kv.w)};
#pragma unroll
          for (int k = 0; k < 8; ++k) NT_STORE((S[k] + x[k]) * g256, osp + ((size_t)h * 256 + dk0 + k) * 512 + dv); }
    }
    for (int c = gt; c < NB * 8 * 512 * 32; c += F.G * NTHR) {
        const int dv = c & 511, dk0 = ((c >> 9) & 31) * 8, h = (c >> 14) & 7, b = c >> 17; const float g64 = exp2f(64.f * ret_lg2(h));
        const float* si = state_in + (((size_t)b * 8 + h) * 256 + dk0) * 512 + dv; float* so = oss + (((size_t)b * 8 + h) * 256 + dk0) * 512 + dv;
        const v4u kv = *(const v4u*)(KVX + ((size_t)((1 + b) * 8 + h) * 512 + dv) * 256 + dk0);
        const float x[8] = {bflo(kv.x), bfhi(kv.x), bflo(kv.y), bfhi(kv.y), bflo(kv.z), bfhi(kv.z), bflo(kv.w), bfhi(kv.w)}; float s0[8];
#pragma unroll
        for (int k = 0; k < 8; ++k) s0[k] = NT_LOAD(si + (size_t)k * 512);
        v4u w; w.x = pk2(s0[0], s0[1]); w.y = pk2(s0[2], s0[3]); w.z = pk2(s0[4], s0[5]); w.w = pk2(s0[6], s0[7]);
        *(v4u*)(VS + ((size_t)((64 + b) * 8 + h) * 512 + dv) * 512 + 256 + dk0) = w;
#pragma unroll
        for (int k = 0; k < 8; ++k) NT_STORE((s0[k] + x[k]) * g64, so + (size_t)k * 512);
    }
}
__device__ __forceinline__ void ret_zero_pad(Frame& F, bf16* VS, bf16* KT) {
    const size_t gt = (size_t)F.bid * NTHR + F.tid, NG = (size_t)F.G * NTHR, n = (size_t)NB * 8 * 512 * 24, n2 = (size_t)NB * 8 * 256 * 24;
    for (size_t i = gt; i < n; i += NG) { const size_t rowi = i / 24, c = i % 24; *(v4u*)(VS + ((size_t)64 * 8 * 512 + rowi) * 512 + 64 + c * 8) = (v4u){0u, 0u, 0u, 0u}; }
    for (size_t i = gt; i < n2; i += NG) { const size_t rowi = i / 24, c = i % 24; *(v4u*)(KT + ((size_t)64 * 8 * 256 + rowi) * 256 + 64 + c * 8) = (v4u){0u, 0u, 0u, 0u}; }
}
__device__ __forceinline__ void ret_table(Frame& F, float* tab) {
    const size_t gt = (size_t)F.bid * NTHR + F.tid, NG = (size_t)F.G * NTHR;
    for (size_t e = gt; e < (size_t)MP * 128; e += NG) { float c, s; rope_cs((int)(e >> 7), (int)(e & 127), 128, c, s); tab[2 * e] = c; tab[2 * e + 1] = s; }
}
__device__ __forceinline__ void r_out(Frame& F, bf16* O, const bf16* RG) {
    const int gw = F.bid * NWAVES + F.wave, NGW = F.G * NWAVES, lane = F.lane;
    for (int it = gw; it < MT * 8; it += NGW) {
        const int row = it >> 3, h = it & 7; const size_t off = (size_t)row * 4096 + h * 512 + lane * 8;
        const v4u o4 = *(const v4u*)(O + off), g4 = NT_LOAD((const v4u*)(RG + off));
        float o[8] = {bflo(o4.x), bfhi(o4.x), bflo(o4.y), bfhi(o4.y), bflo(o4.z), bfhi(o4.z), bflo(o4.w), bfhi(o4.w)};
        const float g[8] = {bflo(g4.x), bfhi(g4.x), bflo(g4.y), bfhi(g4.y), bflo(g4.z), bfhi(g4.z), bflo(g4.w), bfhi(g4.w)};
        float ss = 0.f;
#pragma unroll
        for (int k = 0; k < 8; ++k) ss += o[k] * o[k];
        const float rstd = 1.f / sqrtf(wave_sum(ss) * (1.f / 512.f) + EPS);
#pragma unroll
        for (int k = 0; k < 8; ++k) o[k] = o[k] * rstd * silu_f(g[k]);
        v4u w; w.x = pk2(o[0], o[1]); w.y = pk2(o[2], o[3]); w.z = pk2(o[4], o[5]); w.w = pk2(o[6], o[7]);
        *(v4u*)(O + off) = w;
    }
}
struct EpiCIn {
    static constexpr int BMODE = 0;
    pg8::bf16_t* GU; pg8::bf16_t* GVT; pg8::bf16_t* SG; pg8::bf16_t* GVS; float* SSQ; const float* ssq;
    __device__ __forceinline__ void operator()(const pg8::f32x4 (&acc)[2][2][4][2], const pg8::Unit& u, int wr, int wc, int fr, int fq) const {
        { const int l_ = lane_now(); fr = l_ & 15; fq = l_ >> 4; }
        const int pn = u.pn, pm = u.pm, typ = pn >> 4, pt = pn & 15; float rs[2][4]; row_rstd(ssq, pm, wr, fr, fq, rs);
#pragma unroll
        for (int ai = 0; ai < 2; ++ai)
#pragma unroll
            for (int m = 0; m < 4; ++m) {
                const int i = ai * 128 + wr * 64 + m * 16 + fr; const size_t row = (size_t)pm * 256 + i; float ss = 0.f;
#pragma unroll
                for (int bj = 0; bj < 2; ++bj)
#pragma unroll
                    for (int n = 0; n < 2; ++n) { const int c = pt * 256 + bj * 128 + wc * 32 + n * 16 + 4 * fq; const pg8::f32x4 x = acc[ai][bj][m][n] * rs[ai][m]; float y[4];
                        if (typ == 2) {
#pragma unroll
                            for (int e = 0; e < 4; ++e) y[e] = silu_f(x[e]);
                            v2u w; w.x = pk2(y[0], y[1]); w.y = pk2(y[2], y[3]); *(v2u*)(SG + row * 4096 + c) = w;
                        } else {
#pragma unroll
                            for (int e = 0; e < 4; ++e) y[e] = gelu_tanh_f(x[e]);
                            v2u w; w.x = pk2(y[0], y[1]); w.y = pk2(y[2], y[3]);
                            if (typ == 0) *(v2u*)(GU + row * 4096 + c) = w;
                            else { ss += (y[0] * y[0] + y[1] * y[1]) + (y[2] * y[2] + y[3] * y[3]);
                                pg8::bf16_t* t = GVT + ((size_t)pm * 4096 + c) * 256 + i;
                                t[0] = (pg8::bf16_t)(w.x & 0xffffu); t[256] = (pg8::bf16_t)(w.x >> 16); t[512] = (pg8::bf16_t)(w.y & 0xffffu); t[768] = (pg8::bf16_t)(w.y >> 16);
                                if (pm >= 64) *(v2u*)(GVS + (row - MP) * 4096 + c) = w; } } }
                if (typ == 1) { ss += __shfl_xor(ss, 16); ss += __shfl_xor(ss, 32); if (fq == 0) SSQ[row * 64 + pt * 4 + wc] = ss; }
                if (m & 1) asm volatile("" ::: "memory");
            }
    }
};
__device__ __forceinline__ void c_prep(Frame& F, const float* SSQ, const float* wsin, const float* vgain, const bf16* GVS, bf16* Wm, float* ovm) {
    LAS float* rs = (LAS float*)(F.lds + RING_OFF);
    const int tid = F.tid;
    for (int it = F.bid; it < 66 * 8; it += F.G) {
        const int J = it >> 3, g = it & 7;
        __syncthreads();
        if (tid < 256) { const float* p = SSQ + ((size_t)J * 256 + tid) * 64; float s = 0.f;
#pragma unroll
            for (int k = 0; k < 16; ++k) { const f32x4 x = *(const f32x4*)(p + 4 * k); s += (x.x + x.y) + (x.z + x.w); }
            rs[tid] = 1.f / sqrtf(s * (1.f / 4096.f) + EPS); }
        __syncthreads();
        bf16* wm = Wm + (size_t)(J * 8 + g) * 65536; const int sh = J < 64 ? 7 : 6, cm = (1 << sh) - 1;
        for (int e8 = tid; e8 < 8192; e8 += NTHR) { const int i = e8 >> 5, j0 = (e8 & 31) * 8, il = i & cm, jl0 = j0 & cm; float y[8];
            if ((i >> sh) == (j0 >> sh) && jl0 <= il) { const float* wr_ = wsin + ((size_t)g * 128 + il) * 128 + jl0; const f32x4 a = *(const f32x4*)wr_, b = *(const f32x4*)(wr_ + 4);
                const float wv[8] = {a.x, a.y, a.z, a.w, b.x, b.y, b.z, b.w};
#pragma unroll
                for (int k = 0; k < 8; ++k) y[k] = (jl0 + k <= il) ? wv[k] * rs[j0 + k] : 0.f;
            } else {
#pragma unroll
                for (int k = 0; k < 8; ++k) y[k] = 0.f; }
            v4u w; w.x = pk2(y[0], y[1]); w.y = pk2(y[2], y[3]); w.z = pk2(y[4], y[5]); w.w = pk2(y[6], y[7]);
            *(v4u*)(wm + i * 256 + j0) = w; }
    }
    const int gw = F.bid * NWAVES + F.wave, NGW = F.G * NWAVES, lane = F.lane;
    for (int r = gw; r < MS; r += NGW) {
        const float rstd = 1.f / sqrtf(wave_sum(SSQ[((size_t)MP + r) * 64 + lane]) * (1.f / 4096.f) + EPS);
#pragma unroll
        for (int k = 0; k < 8; ++k) { const int col = k * 512 + lane * 8; const v4u v4 = *(const v4u*)(GVS + (size_t)r * 4096 + col);
            const f32x4 ga = *(const f32x4*)(vgain + col), gb = *(const f32x4*)(vgain + col + 4);
            float* o = ovm + (size_t)r * 4096 + col;
            *(f32x4*)o = (f32x4){bflo(v4.x) * rstd * ga.x, bfhi(v4.x) * rstd * ga.y, bflo(v4.y) * rstd * ga.z, bfhi(v4.y) * rstd * ga.w};
            *(f32x4*)(o + 4) = (f32x4){bflo(v4.z) * rstd * gb.x, bfhi(v4.z) * rstd * gb.y, bflo(v4.w) * rstd * gb.z, bfhi(v4.w) * rstd * gb.w}; }
    }
}
struct CMixOrder {
    int G, c; const char* Wm; const char* GVT;
    __device__ __forceinline__ bool next(int i, pg8::Unit& u) const { const int L = i * G + c; if (L >= 66 * 16) return false; const int J = L >> 4, nt = L & 15;
        u.pm = J; u.pn = nt; u.a = Wm + ((size_t)(J * 8 + (nt >> 1)) * 65536) * 2; u.b = GVT + (((size_t)J * 4096 + nt * 256) * 256) * 2; return true; }
    __device__ __forceinline__ void a_ready(const pg8::Unit&) const {}
    __device__ __forceinline__ void done(const pg8::Unit&) const {}
};
struct EpiCMix {
    static constexpr int BMODE = 1;
    pg8::bf16_t* GU; const pg8::bf16_t* SG; const float* vgain; const float* bs;
    __device__ __forceinline__ void operator()(const pg8::f32x4 (&acc)[2][2][4][2], const pg8::Unit& u, int wr, int wc, int fr, int fq) const {
        { const int l_ = lane_now(); fr = l_ & 15; fq = l_ >> 4; }
        const int J = u.pm, nt = u.pn, g = nt >> 1, cm = J < 64 ? 127 : 63;
#pragma unroll
        for (int bj = 0; bj < 2; ++bj) { const int c0 = nt * 256 + bj * 128 + wc * 32 + 8 * fq; const f32x4 ga = *(const f32x4*)(vgain + c0), gb = *(const f32x4*)(vgain + c0 + 4);
            const float gn[8] = {ga.x, ga.y, ga.z, ga.w, gb.x, gb.y, gb.z, gb.w};
#pragma unroll
            for (int ai = 0; ai < 2; ++ai)
#pragma unroll
                for (int m = 0; m < 4; ++m) { const int i = ai * 128 + wr * 64 + m * 16 + fr; const size_t off = ((size_t)J * 256 + i) * 4096 + c0; const float b = bs[g * 128 + (i & cm)];
                    const v4u u4 = *(const v4u*)(GU + off), s4 = NT_LOAD((const v4u*)(SG + off)); const pg8::f32x4 v0 = acc[ai][bj][m][0], v1 = acc[ai][bj][m][1];
                    const float mx[8] = {v0[0], v0[1], v0[2], v0[3], v1[0], v1[1], v1[2], v1[3]};
                    const float uu[8] = {bflo(u4.x), bfhi(u4.x), bflo(u4.y), bfhi(u4.y), bflo(u4.z), bfhi(u4.z), bflo(u4.w), bfhi(u4.w)};
                    const float sg[8] = {bflo(s4.x), bfhi(s4.x), bflo(s4.y), bfhi(s4.y), bflo(s4.z), bfhi(s4.z), bflo(s4.w), bfhi(s4.w)}; float y[8];
#pragma unroll
                    for (int k = 0; k < 8; ++k) y[k] = uu[k] * (mx[k] * gn[k] + b) * sg[k];
                    v4u w; w.x = pk2(y[0], y[1]); w.y = pk2(y[2], y[3]); w.z = pk2(y[4], y[5]); w.w = pk2(y[6], y[7]);
                    *(v4u*)(GU + off) = w; } }
    }
};
__device__ __forceinline__ float diff_lambda(const float* q1, const float* k1, const float* q2, const float* k2, float lam_init) {
    float a = 0.f, b = 0.f;
    for (int i = 0; i < 64; ++i) { a += q1[i] * k1[i]; b += q2[i] * k2[i]; }
    return expf(a) - expf(b) + lam_init;
}

constexpr int N_PHASES = 21;
__global__ void __launch_bounds__(NTHR, 2) mega(Args args) {
    extern __shared__ __attribute__((aligned(16))) unsigned char lds[];
    Frame F;
    F.lds = (LAS unsigned char*)lds; F.tid = threadIdx.x; F.lane = F.tid & 63; F.wave = __builtin_amdgcn_readfirstlane(F.tid >> 6); F.G = gridDim.x; F.bid = blockIdx.x;
    F.in = args.in; F.out = args.out; F.ws = args.ws;
    unsigned char* ws = args.ws; float* out = args.out;
    bf16* W_AIN[2] = {(bf16*)(ws + WS_WAIN0), (bf16*)(ws + WS_WAIN1)}; bf16* W_AOUT[2] = {(bf16*)(ws + WS_WAOUT0), (bf16*)(ws + WS_WAOUT1)};
    bf16* W_RIN = (bf16*)(ws + WS_WRIN); bf16* W_ROUT = (bf16*)(ws + WS_WROUT); bf16* W_CIN = (bf16*)(ws + WS_WCIN); bf16* W_COUT = (bf16*)(ws + WS_WCOUT);
    bf16* XN0 = (bf16*)(ws + WS_XN0); bf16* HB = (bf16*)(ws + WS_HB); float* SSQ2 = (float*)(ws + WS_SSQ2);
    bf16* Qs = (bf16*)(ws + WS_QS); bf16* KP = (bf16*)(ws + WS_KP); bf16* VP = (bf16*)(ws + WS_VP); bf16* KC = (bf16*)(ws + WS_KC); bf16* VC = (bf16*)(ws + WS_VC); bf16* AO_A = (bf16*)(ws + WS_AOA);
    bf16* KT = (bf16*)(ws + WS_KT); bf16* RG = (bf16*)(ws + WS_RG); bf16* QP = (bf16*)(ws + WS_QP); bf16* KN = (bf16*)(ws + WS_KN); bf16* VS = (bf16*)(ws + WS_VS); bf16* ORET = (bf16*)(ws + WS_ORET);
    bf16* GU = (bf16*)(ws + WS_GU); bf16* SG = (bf16*)(ws + WS_SG); bf16* GVT = (bf16*)(ws + WS_GVT); bf16* WM = (bf16*)(ws + WS_WM); float* SSQ = (float*)(ws + WS_SSQ); bf16* GVS = (bf16*)(ws + WS_GVS); float* TABR = (float*)(ws + WS_TABR); bf16* KVX = (bf16*)(ws + WS_KVX); float* TABA = (float*)(ws + WS_TABA); bf16* GA = (bf16*)(ws + WS_GA);
    const int lo = args.ph_lo, hi = args.ph_hi;
    volatile LAS unsigned* MISC = (volatile LAS unsigned*)(F.lds + MISC_OFF);
    for (int u = F.tid; u < (LDS_BYTES - MISC_OFF) / 4; u += NTHR) ((LAS unsigned*)(F.lds + MISC_OFF))[u] = 0u;
    __syncthreads();
    XcdBarrier bar = xcd_barrier_post((unsigned*)(ws + WS_CTL) + 4096, MISC + 8);
#define IN(k) (lo <= (k) && (k) < hi)
#define PH_ENTER() do { int t_ = F.wave * 64 + lane_now(); F.tid = t_; F.lane = t_ & 63; } while (0)
    volatile LAS int* DRW = (volatile LAS int*)(F.lds + MISC_OFF + 64);
    unsigned* DCTR = (unsigned*)(ws + WS_CTL) + 8192;
#define DRAIN(ph, total, BODY) do { PH_ENTER(); for (;;) { __syncthreads(); if (F.tid == 0) DRW[0] = (int)atomicAdd(DCTR + 64 * (ph), 1u); __syncthreads(); const int c_ = DRW[0]; if (c_ >= (total)) break; BODY } } while (0)
#define SEAM(k) do { if (IN(k) && IN((k) + 1)) xcd_barrier(bar, F.wave == 0 && lane_now() == 0); } while (0)

#define GEMM_STORE(Aptr, Wptr, NN, KK, Optr) do { pg8::GemmP g{KK, KK, (KK) / 64}; pg8::StaticOrder S; S.init(MT / 256, (NN) / 256, F.G, F.bid, Aptr, Wptr, KK, KK); pg8::EpiStoreBf16 E{(pg8::bf16_t*)(Optr), NN}; \
        pg8::gemm_phase<pg8::EpiStoreBf16, pg8::StaticOrder>(F.lds + RING_OFF, g, S, E, F.tid); } while (0)
#define GEMM_RESIDB(MODE_, Aptr, Wptr, KK) do { pg8::GemmP g{KK, KK, (KK) / 64}; pg8::StaticOrder S; S.init(MT / 256, DM / 256, F.G, F.bid, Aptr, Wptr, KK, KK); \
        pg8::EpiResidB<MODE_> E{args.in[I_XP], args.in[I_XS], (pg8::bf16_t*)HB, out, SSQ2}; pg8::gemm_phase<pg8::EpiResidB<MODE_>, pg8::StaticOrder>(F.lds + RING_OFF, g, S, E, F.tid); } while (0)

    PH_ENTER(); if (IN(0)) {
        transpose_weight(F, args.in[I_AWIN], 2048, 8192, W_AIN[0]); attn_table(F, TABA);
        norm_rows(F, args.in[I_XP], args.in[I_XS], args.in[I_NW], XN0);
    }
    SEAM(0);
#define GEMM_AIN(Aptr, Wptr, J_, SSQP) do { pg8::GemmP g{2048, 2048, 32}; pg8::StaticOrder S; S.init(MT / 256, 32, F.G, F.bid, Aptr, Wptr, 2048, 2048); \
        EpiAIn E{Qs, KP, VP, KC, VC, GA, out + O_KP + (size_t)(J_) * MP * DM, out + O_VP + (size_t)(J_) * MP * DM, out + O_KS + (size_t)(J_) * MS * DM, out + O_VS + (size_t)(J_) * MS * DM, TABA, args.in[I_AQG] + 64 * (J_), args.in[I_AKG] + 64 * (J_), SSQP}; \
        pg8::gemm_phase<EpiAIn, pg8::StaticOrder>(F.lds + RING_OFF, g, S, E, F.tid); } while (0)
    PH_ENTER(); if (IN(1)) { GEMM_AIN(XN0, W_AIN[0], 0, (const float*)nullptr);
        const int n0 = CC_CHUNKS, n1 = n0 + tw_chunks(2048, 2048), n2 = n1 + TR_CHUNKS;
        DRAIN(1, n2, if (c_ < n0) cc_run(F, args.in[I_CK], args.in[I_CV], KC, VC, c_); else if (c_ < n1) tw_run(F, args.in[I_AWOUT], 2048, 2048, W_AOUT[0], c_ - n0); else tr_run(F, TABR, c_ - n1);); }
    SEAM(1);
    PH_ENTER(); if (IN(3)) { const float li = 0.8f - 0.6f * expf(-0.3f * 0.f); const float lam = diff_lambda(args.in[I_LQ1], args.in[I_LK1], args.in[I_LQ2], args.in[I_LK2], li);
        attn_fast(F, Qs, KP, VP, KC, VC, GA, AO_A, lam, 1.f - li, args.in[I_ASG]); }
    SEAM(3);
    PH_ENTER(); if (IN(4)) { GEMM_RESIDB(0, AO_A, W_AOUT[0], 2048);
        const int n0 = tw_chunks(2048, 12288), n1 = n0 + tw_chunks(4096, 2048);
        DRAIN(4, n1, if (c_ < n0) tw_run(F, args.in[I_RWIN], 2048, 12288, W_RIN, c_, args.in[I_NW] + DM); else tw_run(F, args.in[I_RWOUT], 4096, 2048, W_ROUT, c_ - n0);); }
    if (IN(4) && IN(6)) xcd_barrier(bar, F.wave == 0 && lane_now() == 0);
    PH_ENTER(); if (IN(6)) { ret_zero_pad(F, VS, KT);
        PH_ENTER(); pg8::GemmP g{2048, 2048, 32}; pg8::StaticOrder S; S.init(MT / 256, 48, F.G, F.bid, HB, W_RIN, 2048, 2048); EpiRet E{QP, KN, KT, VS, RG, TABR, SSQ2};
        pg8::gemm_phase<EpiRet, pg8::StaticOrder>(F.lds + RING_OFF, g, S, E, F.tid); }
    SEAM(6);
    PH_ENTER(); if (IN(7)) { { pg8::GemmP g{4096, 2048, 4}; RetQKOrder S{F.G, F.bid, (const char*)QP, (const char*)KN}; EpiRetQK E{QP}; pg8::gemm_phase<EpiRetQK, RetQKOrder>(F.lds + RING_OFF, g, S, E, F.tid); }
        PH_ENTER(); { pg8::GemmP g{512, 256, 4}; RetKVOrder S{F.G, F.bid, (const char*)VS, (const char*)KT}; EpiRetKV E{VS, KVX}; pg8::gemm_phase<EpiRetKV, RetKVOrder>(F.lds + RING_OFF, g, S, E, F.tid); }
        xcd_barrier(bar, F.wave == 0 && lane_now() == 0);
        PH_ENTER(); ret_scan(F, VS, KVX, args.in[I_SR], out + O_SP, out + O_SS); }
    SEAM(7);
    PH_ENTER(); if (IN(8)) { pg8::GemmP g{4096, 512, 8}; RetOOrder S{F.G, F.bid, (const char*)QP, (const char*)VS}; EpiRetO E{ORET}; pg8::gemm_phase<EpiRetO, RetOOrder>(F.lds + RING_OFF, g, S, E, F.tid); }
    SEAM(8);
    PH_ENTER(); if (IN(9)) r_out(F, ORET, RG);
    SEAM(9);
    PH_ENTER(); if (IN(10)) { GEMM_RESIDB(1, ORET, W_ROUT, 4096);
        const int n0 = tw_chunks(2048, 12288), n1 = n0 + tw_chunks(4096, 2048), n2 = n1 + tw_chunks(2048, 8192), n3 = n2 + tw_chunks(2048, 2048);
        DRAIN(10, n3, if (c_ < n0) tw_run(F, args.in[I_CWIN], 2048, 12288, W_CIN, c_, args.in[I_NW] + 2 * DM); else if (c_ < n1) tw_run(F, args.in[I_CWOUT], 4096, 2048, W_COUT, c_ - n0);
                      else if (c_ < n2) tw_run(F, args.in[I_AWIN] + (size_t)2048 * 8192, 2048, 8192, W_AIN[1], c_ - n1, args.in[I_NW] + 3 * DM); else tw_run(F, args.in[I_AWOUT] + (size_t)2048 * 2048, 2048, 2048, W_AOUT[1], c_ - n2);); }
    if (IN(10) && IN(12)) xcd_barrier(bar, F.wave == 0 && lane_now() == 0);
    PH_ENTER(); if (IN(12)) { pg8::GemmP g{2048, 2048, 32}; pg8::StaticOrder S; S.init(MT / 256, 48, F.G, F.bid, HB, W_CIN, 2048, 2048); EpiCIn E{GU, GVT, SG, GVS, SSQ, SSQ2};
        pg8::gemm_phase<EpiCIn, pg8::StaticOrder>(F.lds + RING_OFF, g, S, E, F.tid); }
    SEAM(12);
    PH_ENTER(); if (IN(13)) c_prep(F, SSQ, args.in[I_CWS], args.in[I_CVG], GVS, WM, out + O_VM);
    SEAM(13);
    PH_ENTER(); if (IN(14)) { pg8::GemmP g{256, 256, 4}; CMixOrder S{F.G, F.bid, (const char*)WM, (const char*)GVT}; EpiCMix E{GU, SG, args.in[I_CVG], args.in[I_CBS]}; pg8::gemm_phase<EpiCMix, CMixOrder>(F.lds + RING_OFF, g, S, E, F.tid); }
    SEAM(14);
    PH_ENTER(); if (IN(15)) { GEMM_RESIDB(1, GU, W_COUT, 4096);
        DRAIN(15, CC_CHUNKS, cc_run(F, args.in[I_CK] + (size_t)NB * PAST * DM, args.in[I_CV] + (size_t)NB * PAST * DM, KC, VC, c_);); }
    if (IN(15) && IN(17)) xcd_barrier(bar, F.wave == 0 && lane_now() == 0);
    PH_ENTER(); if (IN(17)) GEMM_AIN(HB, W_AIN[1], 1, (const float*)SSQ2);
    SEAM(17);
    PH_ENTER(); if (IN(19)) { const float li = 0.8f - 0.6f * expf(-0.3f * 3.f); const float lam = diff_lambda(args.in[I_LQ1] + 64, args.in[I_LK1] + 64, args.in[I_LQ2] + 64, args.in[I_LK2] + 64, li);
        attn_fast(F, Qs, KP, VP, KC, VC, GA, AO_A, lam, 1.f - li, args.in[I_ASG] + 128); }
    SEAM(19);
    PH_ENTER(); if (IN(20)) GEMM_RESIDB(2, AO_A, W_AOUT[1], 2048);
#undef IN
#undef SEAM
}

extern "C" void kernel_launch(void* const* d_in, const int* in_sizes, int n_in, void* d_out, int out_size, void* d_ws, size_t ws_size, hipStream_t stream) {
    static int grid = 0;
    if (grid == 0) {
        if (n_in != N_IN || (size_t)out_size != O_END || ws_size < WS_END) { fprintf(stderr, "kernel_launch: unexpected shapes: n_in %d out %d ws %zu (need %zu)\n", n_in, out_size, ws_size, (size_t)WS_END); grid = -1; return; }
        int dev = 0, cus = 0;
        if (hipGetDevice(&dev) != hipSuccess || hipDeviceGetAttribute(&cus, hipDeviceAttributeMultiprocessorCount, dev) != hipSuccess) { grid = -1; return; }
        if (hipFuncSetAttribute((const void*)mega, hipFuncAttributeMaxDynamicSharedMemorySize, LDS_BYTES) != hipSuccess) { fprintf(stderr, "kernel_launch: hipFuncSetAttribute failed\n"); grid = -1; return; }
        int per_cu = 0;
        if (hipOccupancyMaxActiveBlocksPerMultiprocessor(&per_cu, (const void*)mega, NTHR, LDS_BYTES) != hipSuccess || per_cu < 1) { fprintf(stderr, "kernel_launch: occupancy query: %d workgroups per CU\n", per_cu); grid = -1; return; }
        (void)hipGetLastError();
        grid = cus;
    }
    if (grid < 0) return;
    Args a{};
    for (int i = 0; i < N_IN; ++i) a.in[i] = (const float*)d_in[i];
    a.out = (float*)d_out; a.ws = (unsigned char*)d_ws;
    (void)hipMemsetAsync((char*)d_ws + WS_CTL, 0, CTL_ZERO_BYTES, stream);
    a.ph_lo = 0; a.ph_hi = N_PHASES;
    hipLaunchKernelGGL(mega, dim3(grid), dim3(NTHR), LDS_BYTES, stream, a);
}
```

```cpp
#include <hip/hip_runtime.h>
#include <cstdio>
#include <cstdint>

__device__ __forceinline__ int lane_now() { int l; asm volatile("v_mbcnt_lo_u32_b32 %0, -1, 0\n\tv_mbcnt_hi_u32_b32 %0, -1, %0" : "=v"(l)); return l; }
namespace pg8 {
#define PG8_LAS __attribute__((address_space(3)))
typedef unsigned short bf16_t;
typedef short bf16x8 __attribute__((ext_vector_type(8)));
typedef float f32x4 __attribute__((ext_vector_type(4)));
typedef unsigned u32x4 __attribute__((ext_vector_type(4)));
constexpr int BM = 256, BK = 64, HALF = 128, HTB = HALF * BK * 2, STAGE_BYTES = 8 * HTB, NXCD = 8, WGM = 4;

__host__ __device__ __forceinline__ int lds_byte(int r, int c) { const int st = (r >> 4) * 2 + (c >> 5), rr = r & 15, cc = c & 31, ob = rr * 64 + cc * 2; return st * 1024 + (ob ^ (((ob >> 9) & 1) << 5)); }
__host__ __device__ __forceinline__ void stage_rc(int b, int& R, int& C) { const int st = b / 1024, sb = b % 1024, swz = sb ^ (((sb >> 9) & 1) << 5); R = (st >> 1) * 16 + swz / 64; C = (st & 1) * 32 + (swz % 64) / 2; }
__host__ __device__ __forceinline__ int perm32(int rho) { const int n = rho >> 4, i = rho & 15; return 8 * (i >> 2) + 4 * n + (i & 3); }

struct Unit { int pm, pn; const char* a; const char* b; };
struct GemmP { int lda, ldb, nt; };

struct StaticOrder {
    int nM, nN, nwg, G, c; const char* A; const char* B; size_t ta, tb;
    __host__ __device__ void init(int nM_, int nN_, int G_, int c_, const void* A_, const void* B_, int lda, int ldb) { nM = nM_; nN = nN_; nwg = nM * nN; G = G_; c = c_; A = (const char*)A_; B = (const char*)B_; ta = (size_t)BM * lda * 2; tb = (size_t)BM * ldb * 2; }
    __host__ __device__ bool next(int i, Unit& u) const {
        const long L = (long)i * G + c; if (L >= nwg) return false;
        int wgid = (int)L; { const int q = nwg / NXCD, r = nwg % NXCD, xcd = wgid % NXCD, off = wgid / NXCD; wgid = (xcd < r ? xcd * (q + 1) : r * (q + 1) + (xcd - r) * q) + off; }
        const int nig = WGM * nN, gid = wgid / nig, fm = gid * WGM, gsz = (nM - fm) < WGM ? (nM - fm) : WGM;
        u.pm = fm + ((wgid % nig) % gsz); u.pn = (wgid % nig) / gsz; u.a = A + (size_t)u.pm * ta; u.b = B + (size_t)u.pn * tb; return true;
    }
    __device__ __forceinline__ void a_ready(const Unit&) const {}
    __device__ __forceinline__ void done(const Unit&) const {}
};

__device__ __forceinline__ unsigned cvt_pk_bf16(float lo, float hi) { unsigned r; asm volatile("v_cvt_pk_bf16_f32 %0, %1, %2" : "=v"(r) : "v"(lo), "v"(hi)); return r; }

struct EpiStoreBf16 {
    static constexpr int BMODE = 1;
    bf16_t* O; int ldc;
    __device__ __forceinline__ void operator()(const f32x4 (&acc)[2][2][4][2], const Unit& u, int wr, int wc, int fr, int fq) const {
        const int row0 = u.pm * BM + wr * 64 + fr; const int col0 = u.pn * BM + wc * 32 + 8 * fq;
#pragma unroll
        for (int ai = 0; ai < 2; ++ai)
#pragma unroll
            for (int m = 0; m < 4; ++m) { bf16_t* rowp = O + (size_t)(row0 + ai * HALF + m * 16) * ldc + col0;
#pragma unroll
                for (int bj = 0; bj < 2; ++bj) { const f32x4 v0 = acc[ai][bj][m][0], v1 = acc[ai][bj][m][1];
                    u32x4 w; w.x = cvt_pk_bf16(v0[0], v0[1]); w.y = cvt_pk_bf16(v0[2], v0[3]); w.z = cvt_pk_bf16(v1[0], v1[1]); w.w = cvt_pk_bf16(v1[2], v1[3]);
                    *(u32x4*)(rowp + bj * HALF) = w; } }
    }
};
struct EpiResid {
    static constexpr int BMODE = 0;
    const float* base_p; const float* base_s; float* out; int split;
    __device__ __forceinline__ void operator()(const f32x4 (&acc)[2][2][4][2], const Unit& u, int wr, int wc, int fr, int fq) const {
        { const int l_ = lane_now(); fr = l_ & 15; fq = l_ >> 4; }
        const int col0 = u.pn * BM + wc * 32 + 4 * fq;
#pragma unroll
        for (int ai = 0; ai < 2; ++ai) {
            f32x4 bs[4][2][2];
#pragma unroll
            for (int m = 0; m < 4; ++m) { const int r = u.pm * BM + ai * HALF + wr * 64 + m * 16 + fr; const float* bp = (r < split) ? base_p + (size_t)r * 2048 : base_s + (size_t)(r - split) * 2048;
#pragma unroll
                for (int bj = 0; bj < 2; ++bj)
#pragma unroll
                    for (int n = 0; n < 2; ++n) bs[m][bj][n] = *(const f32x4*)(bp + col0 + bj * HALF + n * 16); }
#pragma unroll
            for (int m = 0; m < 4; ++m) { const int r = u.pm * BM + ai * HALF + wr * 64 + m * 16 + fr; float* op = out + (size_t)r * 2048;
#pragma unroll
                for (int bj = 0; bj < 2; ++bj)
#pragma unroll
                    for (int n = 0; n < 2; ++n) *(f32x4*)(op + col0 + bj * HALF + n * 16) = bs[m][bj][n] + acc[ai][bj][m][n]; }
            asm volatile("" ::: "memory");
        }
    }
};

template <int MODE> struct EpiResidB {
    static constexpr int BMODE = 1;
    const float* base_p; const float* base_s; bf16_t* HB; float* out; float* SSQ2;
    __device__ __forceinline__ void operator()(const f32x4 (&acc)[2][2][4][2], const Unit& u, int wr, int wc, int fr, int fq) const {
        { const int l_ = lane_now(); fr = l_ & 15; fq = l_ >> 4; }
        const int col0 = u.pn * BM + wc * 32 + 8 * fq;
#pragma unroll
        for (int ai = 0; ai < 2; ++ai) {
            f32x4 b0[4][2], b1[4][2]; u32x4 hb[4][2];
#pragma unroll
            for (int m = 0; m < 4; ++m) { const int r = u.pm * BM + ai * HALF + wr * 64 + m * 16 + fr;
#pragma unroll
                for (int bj = 0; bj < 2; ++bj) {
                    if (MODE == 0) { const float* bp = ((r < 16384) ? base_p + (size_t)r * 2048 : base_s + (size_t)(r - 16384) * 2048) + col0 + bj * HALF; b0[m][bj] = __builtin_nontemporal_load((const f32x4*)bp); b1[m][bj] = __builtin_nontemporal_load((const f32x4*)(bp + 4)); }
                    else hb[m][bj] = *(const u32x4*)(HB + (size_t)r * 2048 + col0 + bj * HALF); } }
#pragma unroll
            for (int m = 0; m < 4; ++m) { const int r = u.pm * BM + ai * HALF + wr * 64 + m * 16 + fr; float ss = 0.f;
#pragma unroll
                for (int bj = 0; bj < 2; ++bj) { f32x4 h0, h1;
                    if (MODE == 0) { h0 = b0[m][bj] + acc[ai][bj][m][0]; h1 = b1[m][bj] + acc[ai][bj][m][1]; }
                    else { const u32x4 w = hb[m][bj];
                        h0 = (f32x4){__builtin_bit_cast(float, w.x << 16), __builtin_bit_cast(float, w.x & 0xffff0000u), __builtin_bit_cast(float, w.y << 16), __builtin_bit_cast(float, w.y & 0xffff0000u)} + acc[ai][bj][m][0];
                        h1 = (f32x4){__builtin_bit_cast(float, w.z << 16), __builtin_bit_cast(float, w.z & 0xffff0000u), __builtin_bit_cast(float, w.w << 16), __builtin_bit_cast(float, w.w & 0xffff0000u)} + acc[ai][bj][m][1]; }
                    if (MODE == 2) { float* op = out + (size_t)r * 2048 + col0 + bj * HALF; __builtin_nontemporal_store(h0, (f32x4*)op); __builtin_nontemporal_store(h1, (f32x4*)(op + 4)); }
                    else { u32x4 w; w.x = cvt_pk_bf16(h0[0], h0[1]); w.y = cvt_pk_bf16(h0[2], h0[3]); w.z = cvt_pk_bf16(h1[0], h1[1]); w.w = cvt_pk_bf16(h1[2], h1[3]);
                        *(u32x4*)(HB + (size_t)r * 2048 + col0 + bj * HALF) = w;
                        ss += (h0[0] * h0[0] + h0[1] * h0[1]) + (h0[2] * h0[2] + h0[3] * h0[3]) + (h1[0] * h1[0] + h1[1] * h1[1]) + (h1[2] * h1[2] + h1[3] * h1[3]); } }
                if (MODE != 2) { ss += __shfl_xor(ss, 16); ss += __shfl_xor(ss, 32); if (fq == 0) SSQ2[(size_t)r * 32 + u.pn * 4 + wc] = ss; } }
            asm volatile("" ::: "memory");
        }
    }
};

template <class Epi, class Sched, bool ALIGN_EPI = true>
__device__ __forceinline__ void gemm_phase(PG8_LAS unsigned char* lds, const GemmP g, const Sched& S, const Epi& E, int tid) {
    asm volatile("" : "+v"(tid));
    const int wid = __builtin_amdgcn_readfirstlane(tid >> 6), lane = tid & 63, wr = wid >> 2, wc = wid & 3, fr = lane & 15, fq = lane >> 4;
    int nt = g.nt; asm volatile("" : "+s"(nt));
    unsigned voffA[2], voffB[2];
#pragma unroll
    for (int i = 0; i < 2; ++i) { int R, C; stage_rc(tid * 16 + i * 8192, R, C); const int Rb = Epi::BMODE == 2 ? (64 * (R >> 5) + perm32(R & 31)) : Epi::BMODE == 1 ? ((R & ~31) + perm32(R & 31)) : R;
        voffA[i] = (unsigned)(R * g.lda + C) * 2u; voffB[i] = (unsigned)(Rb * g.ldb + C) * 2u; }
    const size_t kstep = (size_t)(BK * 2);
    const size_t hstepA = (size_t)HALF * g.lda * 2, hstepB = (size_t)(Epi::BMODE == 2 ? 32 : HALF) * g.ldb * 2;
    const unsigned ldsw = (unsigned)wid * 1024u;
    const int aoff = lds_byte(wr * 64 + fr, fq * 8), boff = lds_byte(wc * 32 + fr, fq * 8);
#define PG8_SA(b, h) (((b) * 2 + (h)) * HTB)
#define PG8_SB(b, h) ((4 + (b) * 2 + (h)) * HTB)
#define PG8_STAGE(bufoff, gbase, voff) do { _Pragma("unroll") for (int _i = 0; _i < 2; ++_i) \
        __builtin_amdgcn_global_load_lds((const unsigned*)((const char*)(gbase) + (voff)[_i]), (PG8_LAS unsigned*)(lds + (bufoff) + ldsw + _i * 8192), 16, 0, 0); } while (0)
#define PG8_LDA(dst, b, h) do { _Pragma("unroll") for (int m = 0; m < 4; ++m) _Pragma("unroll") for (int k = 0; k < 2; ++k) dst[m][k] = *(const PG8_LAS bf16x8*)(lds + PG8_SA(b, h) + aoff + m * 2048 + k * 1024); } while (0)
#define PG8_LDB(dst, b, h) do { _Pragma("unroll") for (int n = 0; n < 2; ++n) _Pragma("unroll") for (int k = 0; k < 2; ++k) dst[n][k] = *(const PG8_LAS bf16x8*)(lds + PG8_SB(b, h) + boff + n * 2048 + k * 1024); } while (0)
#define PG8_MMA(ai, bj, At, Bt) do { __builtin_amdgcn_s_setprio(1); _Pragma("unroll") for (int m = 0; m < 4; ++m) _Pragma("unroll") for (int n = 0; n < 2; ++n) _Pragma("unroll") for (int k = 0; k < 2; ++k) \
        acc[ai][bj][m][n] = __builtin_amdgcn_mfma_f32_16x16x32_bf16(Bt[n][k], At[m][k], acc[ai][bj][m][n], 0, 0, 0); __builtin_amdgcn_s_setprio(0); } while (0)
#define PG8_WAIT_V(n) asm volatile("s_waitcnt vmcnt(" #n ")" ::: "memory")
#define PG8_WAIT_L(n) asm volatile("s_waitcnt lgkmcnt(" #n ")" ::: "memory")
#define PG8_BAR __builtin_amdgcn_s_barrier()
#define PG8_SCHED __builtin_amdgcn_sched_barrier(0)
    Unit cur, nxt; int ui = 0;
    if (!S.next(0, cur)) return;
    f32x4 acc[2][2][4][2];
#pragma unroll
    for (int a = 0; a < 2; ++a)
#pragma unroll
        for (int b = 0; b < 2; ++b)
#pragma unroll
            for (int m = 0; m < 4; ++m)
#pragma unroll
                for (int n = 0; n < 2; ++n) acc[a][b][m][n] = (f32x4){0.f, 0.f, 0.f, 0.f};
    bf16x8 At[4][2], B0[2][2], B1[2][2];
    const char* cA = cur.a; const char* cB = cur.b;
    S.a_ready(cur);
    PG8_STAGE(PG8_SB(0, 0), cB, voffB); PG8_STAGE(PG8_SB(0, 1), cB + hstepB, voffB); PG8_STAGE(PG8_SA(0, 0), cA, voffA); PG8_STAGE(PG8_SA(0, 1), cA + hstepA, voffA);
    if (wr == 1) PG8_BAR;
    PG8_WAIT_V(2); PG8_BAR;
    PG8_STAGE(PG8_SB(1, 0), cB + kstep, voffB); PG8_STAGE(PG8_SA(1, 0), cA + kstep, voffA); PG8_STAGE(PG8_SB(1, 1), cB + hstepB + kstep, voffB);
    PG8_WAIT_V(6); PG8_BAR;
    for (;;) {
        const bool has_next = S.next(ui + 1, nxt);
        const char* nA = has_next ? nxt.a : cA; const char* nB = has_next ? nxt.b : cB;
        for (int t = 0; t < nt; t += 2) {
            const bool last = (t == nt - 2);
            const char* a1 = cA + (size_t)(t + 1) * kstep;
            const char* a2 = last ? nA : cA + (size_t)(t + 2) * kstep; const char* b2 = last ? nB : cB + (size_t)(t + 2) * kstep;
            const char* a3 = a2 + kstep; const char* b3 = b2 + kstep;
            if (last && has_next) S.a_ready(nxt);
            PG8_LDB(B0, 0, 0); PG8_LDB(B1, 0, 1); PG8_SCHED; PG8_LDA(At, 0, 0); PG8_STAGE(PG8_SA(1, 1), a1 + hstepA, voffA);
            PG8_WAIT_V(8); PG8_WAIT_L(0); PG8_BAR; PG8_MMA(0, 0, At, B0); PG8_MMA(0, 1, At, B1); PG8_BAR; PG8_SCHED;
            PG8_LDA(At, 0, 1); PG8_STAGE(PG8_SB(0, 0), b2, voffB); PG8_STAGE(PG8_SB(0, 1), b2 + hstepB, voffB); PG8_STAGE(PG8_SA(0, 0), a2, voffA);
            PG8_WAIT_V(8); PG8_WAIT_L(0); PG8_BAR; PG8_MMA(1, 0, At, B0); PG8_MMA(1, 1, At, B1); PG8_BAR; PG8_SCHED;
            PG8_LDB(B0, 1, 0); PG8_LDB(B1, 1, 1); PG8_SCHED; PG8_LDA(At, 1, 0); PG8_STAGE(PG8_SA(0, 1), a2 + hstepA, voffA);
            PG8_WAIT_V(8); PG8_WAIT_L(0); PG8_BAR; PG8_MMA(0, 0, At, B0); PG8_MMA(0, 1, At, B1); PG8_BAR; PG8_SCHED;
            PG8_LDA(At, 1, 1); PG8_STAGE(PG8_SB(1, 0), b3, voffB); PG8_STAGE(PG8_SB(1, 1), b3 + hstepB, voffB); PG8_STAGE(PG8_SA(1, 0), a3, voffA);
            PG8_WAIT_V(8); PG8_WAIT_L(0); PG8_BAR; PG8_MMA(1, 0, At, B0); PG8_MMA(1, 1, At, B1); PG8_BAR; PG8_SCHED;
        }
        if constexpr (ALIGN_EPI) { if (wr == 0) PG8_BAR; }
        E(acc, cur, wr, wc, fr, fq); S.done(cur);
        if (!has_next) break;
#pragma unroll
        for (int a = 0; a < 2; ++a)
#pragma unroll
            for (int b = 0; b < 2; ++b)
#pragma unroll
                for (int m = 0; m < 4; ++m)
#pragma unroll
                    for (int n = 0; n < 2; ++n) acc[a][b][m][n] = (f32x4){0.f, 0.f, 0.f, 0.f};
        cur = nxt; cA = nA; cB = nB; ++ui;
        if constexpr (ALIGN_EPI) { if (wr == 1) PG8_BAR; }
    }
    PG8_WAIT_V(0);
    if constexpr (!ALIGN_EPI) { if (wr == 0) PG8_BAR; }
    PG8_BAR;
#undef PG8_SA
#undef PG8_SB
#undef PG8_STAGE
#undef PG8_LDA
#undef PG8_LDB
#undef PG8_MMA
#undef PG8_WAIT_V
#undef PG8_WAIT_L
#undef PG8_BAR
#undef PG8_SCHED
}
}

constexpr int NWAVES = 8, NTHR = 512;
constexpr int DM = 2048, MP = 16384, MS = 512, MT = MP + MS, PAST = 2048, DECL = 64, NB = 8;
constexpr int KCROWS = PAST + DECL;
constexpr float EPS = 1e-6f;
constexpr float LOG2E = 1.4426950408889634f;
constexpr float C2 = 0.125f * LOG2E;

enum { I_XP = 0, I_XS, I_CK, I_CV, I_SR, I_NW, I_AWIN, I_AWOUT, I_AQG, I_AKG, I_LQ1, I_LK1, I_LQ2, I_LK2, I_ASG, I_RWIN, I_RWOUT, I_CWIN, I_CWOUT, I_CVG, I_CWS, I_CBS, N_IN };
constexpr size_t O_YP = 0, O_YS = O_YP + (size_t)MP * DM, O_KP = O_YS + (size_t)MS * DM, O_VP = O_KP + 2 * (size_t)MP * DM, O_KS = O_VP + 2 * (size_t)MP * DM, O_VS = O_KS + 2 * (size_t)MS * DM,
                 O_SP = O_VS + 2 * (size_t)MS * DM, O_SS = O_SP + (size_t)8 * 256 * 512, O_VM = O_SS + (size_t)NB * 8 * 256 * 512, O_END = O_VM + (size_t)MS * 4096;

constexpr size_t MiB = 1u << 20;
constexpr size_t WS_CTL = 0, CTL_ZERO_BYTES = 1 * MiB;
constexpr size_t WS_WAIN0 = 8 * MiB, WS_WAOUT0 = 40 * MiB, WS_WRIN = 48 * MiB, WS_WROUT = 96 * MiB, WS_WCIN = 112 * MiB, WS_WCOUT = 160 * MiB, WS_WAIN1 = 176 * MiB, WS_WAOUT1 = 208 * MiB;
constexpr size_t WS_SSQ2 = 2 * MiB;
constexpr size_t WS_HB = 216 * MiB, WS_Z = 282 * MiB;
constexpr size_t WS_XN0 = 348 * MiB;
constexpr size_t WS_QS = 546 * MiB, WS_KP = 612 * MiB, WS_VP = 676 * MiB, WS_KC = 740 * MiB, WS_VC = 806 * MiB, WS_AOA = 872 * MiB;
constexpr size_t WS_KT = 112 * MiB, WS_RG = 282 * MiB, WS_QP = 414 * MiB, WS_KN = 546 * MiB, WS_VS = 612 * MiB, WS_ORET = 900 * MiB;
constexpr size_t WS_GU = 282 * MiB, WS_SG = 414 * MiB, WS_GVT = 546 * MiB, WS_WM = 678 * MiB, WS_SSQ = 744 * MiB, WS_GVS = 752 * MiB;
constexpr size_t WS_GA = 282 * MiB;
constexpr size_t WS_KVX = 184 * MiB;
constexpr size_t WS_TABR = 1040 * MiB, WS_TABA = 1056 * MiB, WS_END = 1060 * MiB;

#define GAS __attribute__((address_space(1)))
#define LAS __attribute__((address_space(3)))
typedef unsigned short bf16;
typedef unsigned v4u __attribute__((ext_vector_type(4)));
typedef unsigned v2u __attribute__((ext_vector_type(2)));
typedef float f32x4 __attribute__((ext_vector_type(4)));
typedef GAS unsigned gu32;
#define RLX_AGENT __ATOMIC_RELAXED, __HIP_MEMORY_SCOPE_AGENT
#define LDS_WAIT() asm volatile("s_waitcnt lgkmcnt(0)" ::: "memory")
#define VM_WAIT() asm volatile("s_waitcnt vmcnt(0)" ::: "memory")
typedef float g_f32x2 __attribute__((ext_vector_type(2))); typedef __bf16 g_bf16x2 __attribute__((ext_vector_type(2)));
__device__ __forceinline__ unsigned pk2(float lo, float hi) { const g_f32x2 v = {lo, hi}; const g_bf16x2 b = __builtin_convertvector(v, g_bf16x2); return __builtin_bit_cast(unsigned, b); }
__device__ __forceinline__ unsigned f2bf(float f) { return pk2(f, 0.f) & 0xffffu; }
__device__ __forceinline__ float bf2f(unsigned short b) { return __builtin_bit_cast(float, (unsigned)b << 16); }
__device__ __forceinline__ float bflo(unsigned w) { return __builtin_bit_cast(float, w << 16); }
__device__ __forceinline__ float bfhi(unsigned w) { return __builtin_bit_cast(float, w & 0xffff0000u); }
__device__ __forceinline__ float silu_f(float x) { return x * __builtin_amdgcn_rcpf(1.f + __builtin_amdgcn_exp2f(-LOG2E * x)); }
__device__ __forceinline__ float gelu_tanh_f(float x) { const float u = (0.7978845608028654f * 2.f * LOG2E) * (x + 0.044715f * x * x * x); return x * __builtin_amdgcn_rcpf(1.f + __builtin_amdgcn_exp2f(-u)); }
__device__ __forceinline__ float wave_sum(float v) {
#pragma unroll
    for (int o = 1; o < 64; o <<= 1) v += __shfl_xor(v, o);
    return v;
}
__device__ __forceinline__ void row_rstd(const float* ssq, int pm, int wr, int fr, int fq, float (&rs)[2][4]) {
#pragma unroll
    for (int ai = 0; ai < 2; ++ai)
#pragma unroll
        for (int m = 0; m < 4; ++m) {
            if (ssq) { const float* p = ssq + ((size_t)pm * 256 + ai * 128 + wr * 64 + m * 16 + fr) * 32 + 8 * fq; const f32x4 a = *(const f32x4*)p, b = *(const f32x4*)(p + 4);
                float t = ((a.x + a.y) + (a.z + a.w)) + ((b.x + b.y) + (b.z + b.w)); t += __shfl_xor(t, 16); t += __shfl_xor(t, 32); rs[ai][m] = 1.f / sqrtf(t * (1.f / 2048.f) + EPS); }
            else rs[ai][m] = 1.f; }
}
#define NT_LOAD(p) __builtin_nontemporal_load(p)
#define NT_STORE(v, p) __builtin_nontemporal_store((v), (p))
__device__ __forceinline__ void rope_cs(int pos, int i, int nf, float& c, float& s) {
    const float inv = exp2f(-(float)i / (float)nf * 13.287712379549449f);
    const double a = (double)pos * (double)inv * 0.15915494309189535;
    const float r = (float)(a - floor(a));
    c = __builtin_amdgcn_cosf(r); s = __builtin_amdgcn_sinf(r);
}

#define XB_TMO      128
#define XB_XCNT(j)  (256  + 64 * (j))
#define XB_XSUB(j)  (1280 + 64 * (j))
#define XB_XGEN(j)  (2304 + 64 * (j))
#define XB_TOP      3328
#define XB_TOPGEN   3392
#define XCD_BAR_WORDS 3456
#define XB_SPIN_CAP (1u << 22)
__device__ __forceinline__ unsigned xb_ld(unsigned* p)              { return __hip_atomic_load(p, __ATOMIC_RELAXED, __HIP_MEMORY_SCOPE_AGENT); }
__device__ __forceinline__ unsigned xb_add(unsigned* p, unsigned v) { return __hip_atomic_fetch_add(p, v, __ATOMIC_RELAXED, __HIP_MEMORY_SCOPE_AGENT); }
__device__ __forceinline__ unsigned xb_xcc_id() { return (unsigned)__builtin_amdgcn_s_getreg((3 << 11) | 20) & 0xFu; }
#define XB_SPIN(cond, bar) do { unsigned _sp = 0; while (cond) { __builtin_amdgcn_s_sleep(1); \
    if ((++_sp & 255u) == 0u) { if (xb_ld(&(bar)[XB_TMO])) break; if (_sp > XB_SPIN_CAP) { atomicAdd(&(bar)[XB_TMO], 1u); break; } } } } while (0)
struct XcdBarrier { unsigned* bar; unsigned x; volatile LAS unsigned* st; };
__device__ __forceinline__ XcdBarrier xcd_barrier_post(unsigned* bar, volatile LAS unsigned* st) {
    XcdBarrier b; b.bar = bar; b.x = xb_xcc_id(); b.st = st;
    if (threadIdx.x == 0) (void)xb_add(&bar[XB_XCNT(b.x)], 1u);
    return b;
}
__device__ __forceinline__ void xcd_barrier_complete(unsigned* bar, unsigned x, unsigned& nloc, unsigned& nx) {
    const unsigned G = gridDim.x * gridDim.y * gridDim.z;
    unsigned sum, cnt, mine, sp = 0u;
    for (;;) {
        sum = 0u; cnt = 0u; mine = 0u;
#pragma unroll
        for (unsigned j = 0; j < 16; ++j) { const unsigned c = xb_ld(&bar[XB_XCNT(j)]); sum += c; cnt += (c > 0u) ? 1u : 0u; mine = (j == x) ? c : mine; }
        if (sum == G) break;
        __builtin_amdgcn_s_sleep(1);
        if ((++sp & 255u) == 0u) { if (xb_ld(&bar[XB_TMO])) break; if (sp > XB_SPIN_CAP) { atomicAdd(&bar[XB_TMO], 1u); break; } }
    }
    nloc = mine > 0u ? mine : 1u; nx = cnt > 0u ? cnt : 1u;
}
__device__ __forceinline__ void xcd_barrier(const XcdBarrier& b, bool leader) {
    asm volatile("s_waitcnt vmcnt(0)" ::: "memory");
    __syncthreads();
    if (leader) {
        unsigned* bar = b.bar;
        __builtin_amdgcn_s_waitcnt(0);
        unsigned nloc = b.st[0], nx = b.st[1];
        if (nloc == 0u) { xcd_barrier_complete(bar, b.x, nloc, nx); b.st[0] = nloc; b.st[1] = nx; }
        const unsigned old = xb_add(&bar[XB_XSUB(b.x)], 1u);
        const unsigned gen = old / nloc;
        if (old + 1u == (gen + 1u) * nloc) {
            __builtin_amdgcn_fence(__ATOMIC_RELEASE, "agent");
            asm volatile("s_waitcnt vmcnt(0)" ::: "memory");
            const unsigned og = xb_add(&bar[XB_TOP], 1u);
            const unsigned tg = og / nx;
            if (og + 1u == (tg + 1u) * nx) xb_add(&bar[XB_TOPGEN], 1u);
            else XB_SPIN(xb_ld(&bar[XB_TOPGEN]) == tg, bar);
            __builtin_amdgcn_fence(__ATOMIC_ACQUIRE, "agent");
            xb_add(&bar[XB_XGEN(b.x)], 1u);
            asm volatile("s_waitcnt vmcnt(0)" ::: "memory");
        } else {
            XB_SPIN(xb_ld(&bar[XB_XGEN(b.x)]) == gen, bar);
            __builtin_amdgcn_fence(__ATOMIC_ACQUIRE, "agent");
            asm volatile("s_waitcnt vmcnt(0)" ::: "memory");
        }
    }
    __syncthreads();
}

constexpr int RING_OFF = 0, RING_BYTES = 139264;
constexpr int MISC_OFF = RING_BYTES;
constexpr int LDS_BYTES = 147456;
struct Args { const float* in[N_IN]; float* out; unsigned char* ws; int ph_lo, ph_hi; };
struct Frame {
    LAS unsigned char* lds; int tid, lane, wave, G, bid;
    const float* const* in; float* out; unsigned char* ws;
};

__device__ __forceinline__ void p0_transpose_item(const float* W, int K, int N, bf16* WT, LAS float* scr, int item, int lane, const float* ksc = nullptr) {
    const int nblk = N / 32, kb = item / nblk, nb = item % nblk, k0 = 64 * kb, n0 = 32 * nb;
    float w_[32];
#pragma unroll
    for (int i = 0; i < 32; ++i) w_[i] = NT_LOAD(W + (size_t)(k0 + 2 * i + (lane >> 5)) * N + n0 + (lane & 31));
#pragma unroll
    for (int i = 0; i < 32; ++i) { const int kk = 2 * i + (lane >> 5); scr[kk * 33 + (lane & 31)] = ksc ? w_[i] * ksc[k0 + kk] : w_[i]; }
    LDS_WAIT(); asm volatile("" ::: "memory");
    const int c = lane & 7;
#pragma unroll
    for (int j = 0; j < 4; ++j) { const int n = (lane >> 3) + 8 * j; const LAS float* s = scr + (8 * c) * 33 + n;
        v4u o; o.x = pk2(s[0 * 33], s[1 * 33]); o.y = pk2(s[2 * 33], s[3 * 33]); o.z = pk2(s[4 * 33], s[5 * 33]); o.w = pk2(s[6 * 33], s[7 * 33]);
        *(GAS v4u*)(WT + (size_t)(n0 + n) * K + k0 + 8 * c) = o; }
    LDS_WAIT(); asm volatile("" ::: "memory");
}
__device__ __forceinline__ void transpose_weight(Frame& F, const float* W, int K, int N, bf16* WT) {
    LAS float* scr = (LAS float*)(F.lds + RING_OFF + F.wave * 16384);
    const int gw = F.bid * NWAVES + F.wave, NGW = F.G * NWAVES, nitems = (K / 64) * (N / 32);
    for (int it = gw; it < nitems; it += NGW) p0_transpose_item(W, K, N, WT, scr, it, F.lane);
}
__device__ __forceinline__ void norm_rows(Frame& F, const float* src_p, const float* src_s, const float* w, bf16* XN) {
    const int gw = F.bid * NWAVES + F.wave, NGW = F.G * NWAVES;
    const GAS f32x4* wr = (const GAS f32x4*)w + F.lane;
    f32x4 nx[8];
    if (gw < MT) { const float* xrow = (gw < MP) ? src_p + (size_t)gw * DM : src_s + (size_t)(gw - MP) * DM;
#pragma unroll
        for (int j = 0; j < 8; ++j) nx[j] = __builtin_nontemporal_load((const f32x4*)(xrow) + F.lane + 64 * j); }
    for (int m = gw; m < MT; m += NGW) {
        f32x4 v[8]; float s = 0.f;
#pragma unroll
        for (int j = 0; j < 8; ++j) v[j] = nx[j];
        const int m2 = m + NGW;
        if (m2 < MT) { const float* xrow = (m2 < MP) ? src_p + (size_t)m2 * DM : src_s + (size_t)(m2 - MP) * DM;
#pragma unroll
            for (int j = 0; j < 8; ++j) nx[j] = __builtin_nontemporal_load((const f32x4*)(xrow) + F.lane + 64 * j); }
#pragma unroll
        for (int j = 0; j < 8; ++j) s += (v[j].x * v[j].x + v[j].y * v[j].y) + (v[j].z * v[j].z + v[j].w * v[j].w);
        const float rstd = 1.f / sqrtf(wave_sum(s) * (1.f / DM) + EPS);
        GAS v2u* o8 = (GAS v2u*)(XN + (size_t)m * DM) + F.lane;
#pragma unroll
        for (int j = 0; j < 8; ++j) { const f32x4 g = wr[64 * j]; v2u o; o.x = pk2(v[j].x * rstd * g.x, v[j].y * rstd * g.y); o.y = pk2(v[j].z * rstd * g.z, v[j].w * rstd * g.w); o8[64 * j] = o; }
    }
}
__device__ __forceinline__ void cache_cvt(Frame& F, const float* ck, const float* cv, bf16* KC, bf16* VC) {
    const size_t nvec = (size_t)NB * PAST * DM / 4;
    const size_t gt = (size_t)F.bid * NTHR + F.tid, NG = (size_t)F.G * NTHR;
    for (size_t i = gt; i < 2 * nvec; i += NG) {
        const bool isv = i >= nvec; const size_t e = (isv ? i - nvec : i) * 4;
        const size_t brow = e / DM, col = e % DM, b = brow / PAST, t = brow % PAST;
        const f32x4 x = *(const GAS f32x4*)((isv ? cv : ck) + e);
        v2u o; o.x = pk2(x.x, x.y); o.y = pk2(x.z, x.w);
        *(GAS v2u*)((isv ? VC : KC) + ((b * KCROWS + t) * DM + col)) = o;
    }
}
__device__ __forceinline__ int tw_chunks(int K, int N) { return (K / 64) * (N / 32) / 64; }
__device__ __forceinline__ void tw_run(Frame& F, const float* W, int K, int N, bf16* WT, int c, const float* ksc = nullptr) {
    LAS float* scr = (LAS float*)(F.lds + RING_OFF + F.wave * 16384);
#pragma unroll 1
    for (int i = 0; i < 8; ++i) p0_transpose_item(W, K, N, WT, scr, c * 64 + F.wave * 8 + i, F.lane, ksc);
}
constexpr int CC_CHUNKS = 2 * (NB * PAST * DM / 4) / 8192;
__device__ __forceinline__ void cc_run(Frame& F, const float* ck, const float* cv, bf16* KC, bf16* VC, int c) {
    const bool isv = c >= CC_CHUNKS / 2; const int brow0 = (isv ? c - CC_CHUNKS / 2 : c) * 16, b = brow0 / PAST, t0 = brow0 % PAST;
    const float* src = (isv ? cv : ck) + (size_t)brow0 * DM + F.tid * 4;
    bf16* dst = (isv ? VC : KC) + ((size_t)b * KCROWS + t0) * DM + F.tid * 4;
    f32x4 x[16];
#pragma unroll
    for (int k = 0; k < 16; ++k) x[k] = NT_LOAD((const f32x4*)(src + (size_t)k * DM));
#pragma unroll
    for (int k = 0; k < 16; ++k) { v2u o; o.x = pk2(x[k].x, x[k].y); o.y = pk2(x[k].z, x[k].w); *(GAS v2u*)(dst + (size_t)k * DM) = o; }
}
constexpr int TR_CHUNKS = MP * 128 / 8192;
__device__ __forceinline__ void tr_run(Frame& F, float* tab, int c) {
#pragma unroll 1
    for (int k = 0; k < 16; ++k) { const size_t e = (size_t)c * 8192 + k * NTHR + F.tid; float cs, sn; rope_cs((int)(e >> 7), (int)(e & 127), 128, cs, sn); tab[2 * e] = cs; tab[2 * e + 1] = sn; }
}
__device__ __forceinline__ int row_pos(int row) { return row < MP ? row : PAST + ((row - MP) & 63); }

struct EpiAIn {
    static constexpr int BMODE = 2;
    pg8::bf16_t *Qs, *KP, *VP, *KC, *VC, *GA; float *okp, *ovp, *oks, *ovs; const float* tab; const float* qg; const float* kg; const float* ssq;
    __device__ __forceinline__ void operator()(const pg8::f32x4 (&acc)[2][2][4][2], const pg8::Unit& u, int wr, int wc, int fr, int fq) const {
        { const int l_ = lane_now(); fr = l_ & 15; fq = l_ >> 4; }
        const int pn = u.pn, pm = u.pm, typ = pn >> 3, cl = ((pn & 7) * 4 + wc) * 64 + 8 * fq; float rs[2][4]; row_rstd(ssq, pm, wr, fr, fq, rs);
        float g1[8], g2[8];
        if (typ < 2) { const float* gp = (typ == 0 ? qg : kg) + 8 * fq; const pg8::f32x4 a = *(const pg8::f32x4*)gp, b = *(const pg8::f32x4*)(gp + 4), c = *(const pg8::f32x4*)(gp + 32), d = *(const pg8::f32x4*)(gp + 36);
#pragma unroll
            for (int e = 0; e < 4; ++e) { g1[e] = a[e]; g1[4 + e] = b[e]; g2[e] = c[e]; g2[4 + e] = d[e]; } }
#pragma unroll
        for (int ai = 0; ai < 2; ++ai)
#pragma unroll
          for (int mp = 0; mp < 2; ++mp) {
            pg8::f32x4 tq[4][4];
            if (typ < 2) {
#pragma unroll
                for (int m = 2 * mp; m < 2 * mp + 2; ++m) { const int i_ = ai * 128 + wr * 64 + m * 16 + fr; const int pos_ = pm < 64 ? pm * 256 + i_ : PAST + (i_ & 63); const float* tp_ = tab + ((size_t)pos_ * 32 + 8 * fq) * 2;
#pragma unroll
                    for (int q4 = 0; q4 < 4; ++q4) tq[m][q4] = *(const pg8::f32x4*)(tp_ + 4 * q4); } }
#pragma unroll
            for (int m = 2 * mp; m < 2 * mp + 2; ++m) {
                const int i = ai * 128 + wr * 64 + m * 16 + fr; const size_t row = (size_t)pm * 256 + i;
                float x1[8], x2[8];
#pragma unroll
                for (int e = 0; e < 4; ++e) { x1[e] = acc[ai][0][m][0][e] * rs[ai][m]; x1[4 + e] = acc[ai][0][m][1][e] * rs[ai][m]; x2[e] = acc[ai][1][m][0][e] * rs[ai][m]; x2[4 + e] = acc[ai][1][m][1][e] * rs[ai][m]; }
                size_t drow; pg8::bf16_t* dk; pg8::bf16_t* dv; float* fk; float* fv;
                if (pm < 64) { drow = row; dk = KP; dv = VP; fk = okp + row * DM; fv = ovp + row * DM; }
                else { const int s_ = (int)(row - MP); drow = (size_t)(s_ >> 6) * KCROWS + PAST + (s_ & 63); dk = KC; dv = VC; fk = oks + (size_t)s_ * DM; fv = ovs + (size_t)s_ * DM; }
                if (typ < 2) {
                    float ss = 0.f;
#pragma unroll
                    for (int k = 0; k < 8; ++k) ss += x1[k] * x1[k] + x2[k] * x2[k];
                    ss += __shfl_xor(ss, 16); ss += __shfl_xor(ss, 32);
                    const float rstd = 1.f / sqrtf(ss * (1.f / 64.f) + EPS);
                    float o1[8], o2[8];
#pragma unroll
                    for (int q4 = 0; q4 < 4; ++q4) { const pg8::f32x4 t = tq[m][q4];
#pragma unroll
                        for (int z = 0; z < 2; ++z) { const int k = 2 * q4 + z; const float c = t[2 * z], s = t[2 * z + 1], y1 = x1[k] * rstd * g1[k], y2 = x2[k] * rstd * g2[k]; o1[k] = y1 * c - y2 * s; o2[k] = y2 * c + y1 * s; } }
                    if (typ == 0) { v4u w1, w2;
                        w1.x = pk2(o1[0] * C2, o1[1] * C2); w1.y = pk2(o1[2] * C2, o1[3] * C2); w1.z = pk2(o1[4] * C2, o1[5] * C2); w1.w = pk2(o1[6] * C2, o1[7] * C2);
                        w2.x = pk2(o2[0] * C2, o2[1] * C2); w2.y = pk2(o2[2] * C2, o2[3] * C2); w2.z = pk2(o2[4] * C2, o2[5] * C2); w2.w = pk2(o2[6] * C2, o2[7] * C2);
                        *(v4u*)(Qs + row * DM + cl) = w1; *(v4u*)(Qs + row * DM + cl + 32) = w2;
                    } else { v4u w1, w2;
                        w1.x = pk2(o1[0], o1[1]); w1.y = pk2(o1[2], o1[3]); w1.z = pk2(o1[4], o1[5]); w1.w = pk2(o1[6], o1[7]);
                        w2.x = pk2(o2[0], o2[1]); w2.y = pk2(o2[2], o2[3]); w2.z = pk2(o2[4], o2[5]); w2.w = pk2(o2[6], o2[7]);
                        *(v4u*)(dk + drow * DM + cl) = w1; *(v4u*)(dk + drow * DM + cl + 32) = w2;
                        NT_STORE(((pg8::f32x4){o1[0], o1[1], o1[2], o1[3]}), (pg8::f32x4*)(fk + cl)); NT_STORE(((pg8::f32x4){o1[4], o1[5], o1[6], o1[7]}), (pg8::f32x4*)(fk + cl + 4));
                        NT_STORE(((pg8::f32x4){o2[0], o2[1], o2[2], o2[3]}), (pg8::f32x4*)(fk + cl + 32)); NT_STORE(((pg8::f32x4){o2[4], o2[5], o2[6], o2[7]}), (pg8::f32x4*)(fk + cl + 36)); }
                } else { v4u w1, w2;
                    w1.x = pk2(x1[0], x1[1]); w1.y = pk2(x1[2], x1[3]); w1.z = pk2(x1[4], x1[5]); w1.w = pk2(x1[6], x1[7]);
                    w2.x = pk2(x2[0], x2[1]); w2.y = pk2(x2[2], x2[3]); w2.z = pk2(x2[4], x2[5]); w2.w = pk2(x2[6], x2[7]);
                    if (typ == 2) { *(v4u*)(dv + drow * DM + cl) = w1; *(v4u*)(dv + drow * DM + cl + 32) = w2;
                        NT_STORE(((pg8::f32x4){x1[0], x1[1], x1[2], x1[3]}), (pg8::f32x4*)(fv + cl)); NT_STORE(((pg8::f32x4){x1[4], x1[5], x1[6], x1[7]}), (pg8::f32x4*)(fv + cl + 4));
                        NT_STORE(((pg8::f32x4){x2[0], x2[1], x2[2], x2[3]}), (pg8::f32x4*)(fv + cl + 32)); NT_STORE(((pg8::f32x4){x2[4], x2[5], x2[6], x2[7]}), (pg8::f32x4*)(fv + cl + 36)); }
                    else { *(v4u*)(GA + row * DM + cl) = w1; *(v4u*)(GA + row * DM + cl + 32) = w2; }
                }
                if (m & 1) asm volatile("" ::: "memory");
            }
        }
    }
};
__device__ __forceinline__ void attn_table(Frame& F, float* tab) {
    const size_t gt = (size_t)F.bid * NTHR + F.tid, NG = (size_t)F.G * NTHR;
    for (size_t e = gt; e < (size_t)MP * 32; e += NG) { float c, s; rope_cs((int)(e >> 5), (int)(e & 31), 32, c, s); tab[2 * e] = c; tab[2 * e + 1] = s; }
}
namespace dattn {
typedef short bf16x8 __attribute__((ext_vector_type(8)));
typedef short s16x4 __attribute__((ext_vector_type(4)));
typedef short v4i16_t __attribute__((ext_vector_type(4)));
typedef float f32x16 __attribute__((ext_vector_type(16)));
typedef unsigned u32x4 __attribute__((ext_vector_type(4)));
typedef __attribute__((address_space(3))) const char* lds_cptr;
constexpr int RINGB = 98304, WSF_OFF = RINGB, XCHB = 18432, STP = 144;
__device__ __forceinline__ int crow(int r, int hi) { return (r & 3) + 8 * (r >> 2) + 4 * hi; }
__device__ __forceinline__ void glds16(const void* gsrc, unsigned lds_dst) { unsigned keep;
    asm volatile("s_mov_b32 %0, m0\n\ts_mov_b32 m0, %2\n\ts_nop 0\n\tglobal_load_lds_dwordx4 %1, off\n\ts_mov_b32 m0, %0" : "=&s"(keep) : "v"(gsrc), "s"(lds_dst) : "memory"); }
typedef float f32x2_t __attribute__((ext_vector_type(2))); typedef __bf16 bf16x2_t __attribute__((ext_vector_type(2)));
__device__ __forceinline__ unsigned cvtpk_s(float lo, float hi) { f32x2_t v = {lo, hi}; bf16x2_t b = __builtin_convertvector(v, bf16x2_t); return __builtin_bit_cast(unsigned, b); }
#define DA_WAIT_BAR(N) asm volatile("s_waitcnt vmcnt(" #N ") lgkmcnt(0)\n\ts_barrier" ::: "memory")
__device__ __forceinline__ s16x4 vtr(lds_cptr p) { return __builtin_bit_cast(s16x4, __builtin_amdgcn_ds_read_tr16_b64_v4i16((__attribute__((address_space(3))) v4i16_t*)p)); }
struct Unit { const bf16* Q; const bf16* K; const bf16* V; const bf16* G; bf16* AO; int NT; int full; int dma0; };

constexpr int KSLOT = 16384, VSLOT = 16384, VRING = 3 * KSLOT;
#define DA_SBAR() __builtin_amdgcn_sched_barrier(0)
#define DA_PIN(x) asm volatile("" : "+v"(x))
#define DA_MFMA(a, b, c) __builtin_amdgcn_mfma_f32_32x32x16_bf16(a, b, c, 0, 0, 0)
struct DmaJob { const bf16* kp; const bf16* vp; unsigned kd0, kd1, vd0, vd1; };
__device__ __forceinline__ void dma_piece(const DmaJob& j, int i) { if (i == 0) glds16(j.kp, j.kd0); else if (i == 1) glds16(j.kp + 64, j.kd1); else if (i == 2) glds16(j.vp, j.vd0); else glds16(j.vp + 64, j.vd1); }
template <bool QK, bool PV, int VAR>
__device__ __forceinline__ void step(lds_cptr kpn, lds_cptr vp, const bf16x8 (&qr)[4], bf16x8 (&kf)[8], f32x16 (&o)[4], u32x4 (&pw)[4], float& l_reg, const DmaJob& dj) {
    f32x16 C0 = f32x16{}, C1 = f32x16{};
    s16x4 vlo[4], vhi[4];
    if constexpr (!QK) { dma_piece(dj, 0); dma_piece(dj, 1); dma_piece(dj, 2); dma_piece(dj, 3); }
#define DA_FOFF(f) ((((f) & 3) * 4096) + (((f) >> 2) * 1024))
#pragma unroll
    for (int a = 0; a < 8; ++a) {
        if constexpr (PV) { if (a >= 4) { if (VAR != 4) { vlo[a - 4] = vtr(vp + DA_FOFF(a - 4)); vhi[a - 4] = vtr(vp + DA_FOFF(a - 4) + 512); } else { vlo[a - 4] = s16x4{1, 2, 3, 4}; vhi[a - 4] = s16x4{5, 6, 7, 8}; } DA_SBAR(); } }
        if constexpr (QK) {
            if (a & 1) C1 = (a < 2) ? DA_MFMA(kf[a], qr[a >> 1], f32x16{}) : DA_MFMA(kf[a], qr[a >> 1], C1);
            else       C0 = (a < 2) ? DA_MFMA(kf[a], qr[a >> 1], f32x16{}) : DA_MFMA(kf[a], qr[a >> 1], C0);
            if (a < 4) dma_piece(dj, a);
            DA_SBAR();
        }
    }
    u32x4 pwn[4]; pwn[0] = u32x4{}; pwn[1] = u32x4{}; pwn[2] = u32x4{}; pwn[3] = u32x4{};
    float s0 = 0.f, s1 = 0.f;
#pragma unroll
    for (int p = 0; p < 16; ++p) {
        if constexpr (PV) {
            const bf16x8 vf = (bf16x8){vlo[p & 3][0], vlo[p & 3][1], vlo[p & 3][2], vlo[p & 3][3], vhi[p & 3][0], vhi[p & 3][1], vhi[p & 3][2], vhi[p & 3][3]};
            if (VAR != 3) o[p & 3] = DA_MFMA(__builtin_bit_cast(bf16x8, pw[p >> 2]), vf, o[p & 3]); else { o[p & 3][0] += __builtin_bit_cast(float, (int)vf[0] | ((int)vf[4] << 16)); }
            if (p < 12 && VAR != 4) { vlo[p & 3] = vtr(vp + DA_FOFF(p + 4)); vhi[p & 3] = vtr(vp + DA_FOFF(p + 4) + 512); }
        }
        if constexpr (QK) {
            float e0, e1;
            if (VAR == 2) { if (p < 8) { e0 = C0[2 * p]; e1 = C0[2 * p + 1]; } else { e0 = C1[2 * p - 16]; e1 = C1[2 * p - 15]; } }
            else if (p < 8) { e0 = __builtin_amdgcn_exp2f(C0[2 * p]); e1 = __builtin_amdgcn_exp2f(C0[2 * p + 1]); }
            else       { e0 = __builtin_amdgcn_exp2f(C1[2 * p - 16]); e1 = __builtin_amdgcn_exp2f(C1[2 * p - 15]); }
            s0 += e0; s1 += e1; pwn[p >> 2][p & 3] = cvtpk_s(e0, e1);
            DA_PIN(s0); DA_PIN(s1); DA_PIN(pwn[p >> 2]);
            if (p >= 8 && VAR != 6) { const int j = p - 8; kf[j] = *(const __attribute__((address_space(3))) bf16x8*)(kpn + (j >> 1) * 2048 + (j & 1) * 512); }
        }
        DA_SBAR();
    }
    if constexpr (QK) { l_reg += s0 + s1; pw[0] = pwn[0]; pw[1] = pwn[1]; pw[2] = pwn[2]; pw[3] = pwn[3]; }
#undef DA_FOFF
}

template <bool QK, bool PV>
__device__ __forceinline__ void step2(lds_cptr kpn, lds_cptr vp, const bf16x8 (&qr)[4], bf16x8 (&kf)[8], f32x16 (&o)[4], u32x4 (&pw)[4], float& l_reg, const DmaJob& dj,
                                      f32x16& Cn0, f32x16& Cn1, const f32x16& Pp0, const f32x16& Pp1) {
    s16x4 vlo[4], vhi[4];
#define DA_FOFF(f) ((((f) & 3) * 4096) + (((f) >> 2) * 1024))
    if constexpr (!QK) { dma_piece(dj, 0); dma_piece(dj, 1); dma_piece(dj, 2); dma_piece(dj, 3); }
    float s0 = 0.f, s1 = 0.f;
#pragma unroll
    for (int a = 0; a < 8; ++a) {
        if constexpr (PV) { if (a >= 4) { vlo[a - 4] = vtr(vp + DA_FOFF(a - 4)); vhi[a - 4] = vtr(vp + DA_FOFF(a - 4) + 512); DA_SBAR(); } }
        if constexpr (QK) {
            if (a & 1) Cn1 = (a < 2) ? DA_MFMA(kf[a], qr[a >> 1], f32x16{}) : DA_MFMA(kf[a], qr[a >> 1], Cn1);
            else       Cn0 = (a < 2) ? DA_MFMA(kf[a], qr[a >> 1], f32x16{}) : DA_MFMA(kf[a], qr[a >> 1], Cn0);
            if (a < 4) dma_piece(dj, a);
        }
        if constexpr (PV) {
            float x0, x1, x2, x3;
            if (a < 4) { x0 = Pp0[4 * a]; x1 = Pp0[4 * a + 1]; x2 = Pp0[4 * a + 2]; x3 = Pp0[4 * a + 3]; }
            else       { x0 = Pp1[4 * a - 16]; x1 = Pp1[4 * a - 15]; x2 = Pp1[4 * a - 14]; x3 = Pp1[4 * a - 13]; }
            s0 += x0; s1 += x1; s0 += x2; s1 += x3;
            pw[(2 * a) >> 2][(2 * a) & 3] = cvtpk_s(x0, x1); pw[(2 * a + 1) >> 2][(2 * a + 1) & 3] = cvtpk_s(x2, x3);
            DA_PIN(s0); DA_PIN(s1); DA_PIN(pw[(2 * a) >> 2]);
        }
        if constexpr (QK || PV) DA_SBAR();
    }
    if constexpr (PV) l_reg += s0 + s1;
#pragma unroll
    for (int p = 0; p < 16; ++p) {
        if constexpr (PV) {
            const bf16x8 vf = (bf16x8){vlo[p & 3][0], vlo[p & 3][1], vlo[p & 3][2], vlo[p & 3][3], vhi[p & 3][0], vhi[p & 3][1], vhi[p & 3][2], vhi[p & 3][3]};
            o[p & 3] = DA_MFMA(__builtin_bit_cast(bf16x8, pw[p >> 2]), vf, o[p & 3]);
            if (p < 12) { vlo[p & 3] = vtr(vp + DA_FOFF(p + 4)); vhi[p & 3] = vtr(vp + DA_FOFF(p + 4) + 512); }
        }
        if constexpr (QK) {
            if (p < 8) { Cn0[2 * p] = __builtin_amdgcn_exp2f(Cn0[2 * p]); Cn0[2 * p + 1] = __builtin_amdgcn_exp2f(Cn0[2 * p + 1]); DA_PIN(Cn0); }
            else       { Cn1[2 * p - 16] = __builtin_amdgcn_exp2f(Cn1[2 * p - 16]); Cn1[2 * p - 15] = __builtin_amdgcn_exp2f(Cn1[2 * p - 15]); DA_PIN(Cn1); }
            if (p >= 8) { const int j = p - 8; kf[j] = *(const __attribute__((address_space(3))) bf16x8*)(kpn + (j >> 1) * 2048 + (j & 1) * 512); }
        }
        if constexpr (QK || PV) DA_SBAR();
    }
#undef DA_FOFF
}

__device__ __forceinline__ void unit_prologue(const Unit& u, unsigned lds0, int lane, int wid, bf16x8 (&qr)[4]) {
    const int r32 = lane & 31, hi = lane >> 5, s = wid >> 2, g = wid & 3; const int NT = u.NT; const int wt = u.full ? (g < 2 ? NT - 1 : NT) : (g < 2 ? NT : 0);
    const bf16* ksrc = u.K + (long)lane * DM + wid * 8;
    const bf16* vsrc = u.V + (long)(16 * (wid & 3) + (lane >> 2)) * DM + (wid >> 2) * 32 + (lane & 3) * 8;
    const unsigned kdst = lds0 + wid * 1024, vdst = lds0 + VRING + wid * 1024;
#pragma unroll
    for (int t = 0; t < 3; ++t) { const int tt_ = t < NT ? t : NT - 1; const bf16* kp_ = ksrc + (long)tt_ * 64 * DM;
        glds16(kp_, (unsigned)__builtin_amdgcn_readfirstlane(kdst + t * KSLOT)); glds16(kp_ + 64, (unsigned)__builtin_amdgcn_readfirstlane(kdst + 8192 + t * KSLOT)); }
    glds16(vsrc, (unsigned)__builtin_amdgcn_readfirstlane(vdst)); glds16(vsrc + 64, (unsigned)__builtin_amdgcn_readfirstlane(vdst + 8192));
    const bf16* Qw = u.Q + (long)(32 * g + r32) * DM + s * 64;
#pragma unroll
    for (int d0 = 0; d0 < 4; ++d0) qr[d0] = (wt > 0) ? *reinterpret_cast<const bf16x8*>(Qw + d0 * 16 + hi * 8) : (bf16x8){0, 0, 0, 0, 0, 0, 0, 0};
}
template <int VAR>
__device__ __forceinline__ void attn_unit(const Unit& u, bool has_next, const Unit& nxt, bool prefetched, bf16x8 (&qr)[4], char* shm, float* wsf_base, float lam, float one_m_li, const float* sub_gain, int tid) {
    asm volatile("" : "+v"(tid));
    const int lane = tid & 63, r32 = lane & 31, hi = lane >> 5; const int wid = __builtin_amdgcn_readfirstlane(tid >> 6), s = wid >> 2, g = wid & 3;
    const int NT = u.NT; const int wt = u.full ? (g < 2 ? NT - 1 : NT) : (g < 2 ? NT : 0);
    const unsigned lds0 = (unsigned)(uintptr_t)shm;
    float* wsf = wsf_base + wid * 64;
    const bf16* ksrc = u.K + (long)lane * DM + wid * 8;
    const bf16* vsrc = u.V + (long)(16 * (wid & 3) + (lane >> 2)) * DM + (wid >> 2) * 32 + (lane & 3) * 8;
    const unsigned kdst = lds0 + wid * 1024, vdst = lds0 + VRING + wid * 1024;
#define DA_DMA_K(t, slot) do { const int tt_ = u.dma0 ? 0 : (t) < NT ? (t) : NT - 1; const bf16* kp_ = ksrc + (long)tt_ * 64 * DM; \
        glds16(kp_, (unsigned)__builtin_amdgcn_readfirstlane(kdst + (slot) * KSLOT)); glds16(kp_ + 64, (unsigned)__builtin_amdgcn_readfirstlane(kdst + 8192 + (slot) * KSLOT)); } while (0)
#define DA_DMA_V(t, slot) do { const int tt_ = u.dma0 ? 0 : (t) < NT ? (t) : NT - 1; const bf16* vp_ = vsrc + (long)tt_ * 64 * DM; \
        glds16(vp_, (unsigned)__builtin_amdgcn_readfirstlane(vdst + (slot) * VSLOT)); glds16(vp_ + 64, (unsigned)__builtin_amdgcn_readfirstlane(vdst + 8192 + (slot) * VSLOT)); } while (0)
    const lds_cptr shm3 = (lds_cptr)shm;
    const lds_cptr kp0 = shm3 + s * 8192 + hi * 1024 + r32 * 16;
    const lds_cptr vp0 = shm3 + VRING + ((lane >> 4) & 1) * 32 + (lane & 3) * 8 + (4 * hi + ((lane & 15) >> 2)) * 64;
    if (!prefetched) unit_prologue(u, lds0, lane, wid, qr);
    asm volatile("" : "+v"(qr[0]), "+v"(qr[1]), "+v"(qr[2]), "+v"(qr[3]));
    f32x16 o[4]; o[0] = f32x16{}; o[1] = f32x16{}; o[2] = f32x16{}; o[3] = f32x16{};
    float l_reg = 0.f;
    u32x4 pw[4]; pw[0] = u32x4{}; pw[1] = u32x4{}; pw[2] = u32x4{}; pw[3] = u32x4{};
    DA_WAIT_BAR(0);
    bf16x8 kf[8];
#pragma unroll
    for (int j = 0; j < 8; ++j) kf[j] = *(const __attribute__((address_space(3))) bf16x8*)(kp0 + (j >> 1) * 2048 + (j & 1) * 512);
    int ks_cur = 0  , vs_prev = 2  ;
#define DA_TOP(t) \
        DA_WAIT_BAR(4);                                          \
        const int ks_next = (ks_cur == 2) ? 0 : ks_cur + 1, vs_cur = (vs_prev == 2) ? 0 : vs_prev + 1, vs_next = (vs_cur == 2) ? 0 : vs_cur + 1; \
        DmaJob dj; { const int tk_ = ((t) + 3) < NT ? ((t) + 3) : NT - 1, tv_ = ((t) + 1) < NT ? ((t) + 1) : NT - 1; dj.kp = ksrc + (long)tk_ * 64 * DM; dj.vp = vsrc + (long)tv_ * 64 * DM; \
          dj.kd0 = (unsigned)__builtin_amdgcn_readfirstlane(kdst + ks_cur * KSLOT); dj.kd1 = dj.kd0 + 8192u; dj.vd0 = (unsigned)__builtin_amdgcn_readfirstlane(vdst + vs_next * VSLOT); dj.vd1 = dj.vd0 + 8192u; }     \
        const lds_cptr kpn = kp0 + ks_next * KSLOT; const lds_cptr vp = vp0 + vs_prev * VSLOT; (void)kpn; (void)vp
#define DA_ROT() do { ks_cur = ks_next; vs_prev = vs_cur; } while (0)
    f32x16 pA0 = f32x16{}, pA1 = f32x16{}, pB0 = f32x16{}, pB1 = f32x16{};
#define DA_IDLE() do { dma_piece(dj, 0); dma_piece(dj, 1); dma_piece(dj, 2); dma_piece(dj, 3); } while (0)
    if (wid >= 4) __builtin_amdgcn_s_setprio(1);
    int t = 0;
    const bool odd = ((wt - 1) & 1) != 0;
    { DA_TOP(0); if (wt > 0) { if (odd) step2<true, false>(kpn, vp, qr, kf, o, pw, l_reg, dj, pB0, pB1, pA0, pA1); else step2<true, false>(kpn, vp, qr, kf, o, pw, l_reg, dj, pA0, pA1, pB0, pB1); } else DA_IDLE(); DA_ROT(); }
    t = 1;
    if (wt > 0 && odd) { DA_TOP(t); step2<true, true>(kpn, vp, qr, kf, o, pw, l_reg, dj, pA0, pA1, pB0, pB1); DA_ROT(); ++t; }
    for (; t + 1 < wt; t += 2) {
        { DA_TOP(t);     step2<true, true>(kpn, vp, qr, kf, o, pw, l_reg, dj, pB0, pB1, pA0, pA1); DA_ROT(); }
        { DA_TOP(t + 1); step2<true, true>(kpn, vp, qr, kf, o, pw, l_reg, dj, pA0, pA1, pB0, pB1); DA_ROT(); }
    }
    if (wt > 0) { DA_TOP(t); step2<false, true>(kpn, vp, qr, kf, o, pw, l_reg, dj, pB0, pB1, pA0, pA1); DA_ROT(); ++t; }
    for (; t <= NT; ++t) { DA_TOP(t); DA_IDLE(); DA_ROT(); }
#undef DA_IDLE
#undef DA_TOP
#undef DA_ROT
    __builtin_amdgcn_s_setprio(0);
    { auto rr = __builtin_amdgcn_permlane32_swap(__float_as_uint(l_reg), __float_as_uint(l_reg), false, false); l_reg = __uint_as_float(rr[0]) + __uint_as_float(rr[1]); }
    if (hi == 0) wsf[r32] = l_reg;
    DA_WAIT_BAR(0);
    if (has_next) unit_prologue(nxt, lds0, lane, wid, qr);
    int le = lane; asm volatile("" : "+v"(le));
    const int r32e = le & 31, hie = le >> 5;
    v4u g4r[8]; f32x4 sga[8], sgb[8];
    if (s == 0 && wt > 0) { const bf16* gp_ = u.G + (long)(32 * g + (le >> 1)) * DM + (le & 1) * 64; const float* sg_ = sub_gain + (le & 1) * 64;
#pragma unroll
        for (int k = 0; k < 8; ++k) { g4r[k] = *(const v4u*)(gp_ + 8 * k); sga[k] = *(const f32x4*)(sg_ + 8 * k); sgb[k] = *(const f32x4*)(sg_ + 8 * k + 4); } }
    float rli[16];
#pragma unroll
    for (int r = 0; r < 16; ++r) { const float lq = wsf[crow(r, hi)]; rli[r] = (s == 0 ? 1.f : -lam) / lq; }
    float* xch = (float*)(shm + 65536 + g * XCHB);
    if (s == 1 && wt > 0) {
#pragma unroll
        for (int db = 0; db < 4; ++db)
#pragma unroll
            for (int r = 0; r < 16; ++r) xch[(db * 16 + r) * 64 + le] = o[db][r] * rli[r];
    }
    asm volatile("s_waitcnt lgkmcnt(0)\n\ts_barrier" ::: "memory");
    if (s == 0 && wt > 0) {
#pragma unroll
        for (int db = 0; db < 4; ++db)
#pragma unroll
            for (int r = 0; r < 16; ++r) o[db][r] = o[db][r] * rli[r] + xch[(db * 16 + r) * 64 + le];
        asm volatile("s_waitcnt lgkmcnt(0)" ::: "memory");
#pragma unroll
        for (int db = 0; db < 4; ++db)
#pragma unroll
            for (int r = 0; r < 16; ++r) xch[crow(r, hie) * STP + 32 * db + r32e] = o[db][r];
        asm volatile("s_waitcnt lgkmcnt(0)" ::: "memory");
        const int row = le >> 1, half = le & 1;
        float v[64]; float ss = 0.f;
#pragma unroll
        for (int k = 0; k < 16; ++k) { const f32x4 x = *(const f32x4*)(xch + row * STP + half * 64 + 4 * k); v[4 * k] = x.x; v[4 * k + 1] = x.y; v[4 * k + 2] = x.z; v[4 * k + 3] = x.w; ss += (x.x * x.x + x.y * x.y) + (x.z * x.z + x.w * x.w); }
        ss += __shfl_xor(ss, 1);
        const float sc = one_m_li / sqrtf(ss * (1.f / 128.f) + EPS);
        bf16* op = u.AO + (long)(32 * g + row) * DM + half * 64;
#pragma unroll
        for (int k = 0; k < 8; ++k) { const v4u g4 = g4r[k]; const f32x4 ga = sga[k], gb = sgb[k];
            const float gg[8] = {bflo(g4.x), bfhi(g4.x), bflo(g4.y), bfhi(g4.y), bflo(g4.z), bfhi(g4.z), bflo(g4.w), bfhi(g4.w)};
            const float gn[8] = {ga.x, ga.y, ga.z, ga.w, gb.x, gb.y, gb.z, gb.w}; float y[8];
#pragma unroll
            for (int e = 0; e < 8; ++e) y[e] = v[8 * k + e] * sc * gn[e] * silu_f(gg[e]);
            v4u w; w.x = pk2(y[0], y[1]); w.y = pk2(y[2], y[3]); w.z = pk2(y[4], y[5]); w.w = pk2(y[6], y[7]);
            *(v4u*)(op + 8 * k) = w; }
    }
#undef DA_DMA_K
#undef DA_DMA_V
}
}
template <int VAR = 0>
__device__ __forceinline__ void attn_fast(Frame& F, const bf16* Qs, const bf16* KP, const bf16* VP, const bf16* KC, const bf16* VC, const bf16* GA  , bf16* AO,
                                          float lam, float one_m_li, const float* sub_gain, int dma0 = 0) {
    const int NU = 2048 + 16 * NB;
    const bool xcd = (F.G == 256);
#define ATTN_GET(i_, u_, ok_) do { int qb = 0, h = 0, b = -1; ok_ = true; \
        if (xcd) { const int x = F.bid & 7, r = F.bid >> 3; \
            if ((i_) < 8) { h = x + 8 * ((i_) >> 2); const int rr = ((i_) == 0) ? (r ^ 8) : r; qb = 127 - (((i_) & 3) * 32 + (((i_) & 1) ? 31 - rr : rr)); } \
            else if ((i_) == 8 && (r & 8) == 0) { const int sb = (r & 7) + ((r >> 4) << 3); h = x + 8 * (sb >> 3); b = sb & 7; } \
            else ok_ = false; \
        } else { const int idx = (i_) * F.G + (((i_) & 1) ? F.G - 1 - F.bid : F.bid); if (idx >= NU) ok_ = false; \
            else if (idx < 2048) { qb = 127 - (idx >> 4); h = idx & 15; } else { const int j = idx - 2048; b = j >> 4; h = j & 15; } } \
        u_.dma0 = 0; \
        if (ok_) { if (b < 0) { const long row0 = 128L * qb; \
            u_.Q = Qs + row0 * DM + h * 128; u_.K = KP + h * 128; u_.V = VP + h * 128; u_.G = GA + row0 * DM + h * 128; u_.AO = AO + row0 * DM + h * 128; u_.NT = 2 * qb + 2; u_.full = 1; } \
          else { const long row0 = MP + 64L * b; \
            u_.Q = Qs + row0 * DM + h * 128; u_.K = KC + (long)b * KCROWS * DM + h * 128; u_.V = VC + (long)b * KCROWS * DM + h * 128; u_.G = GA + row0 * DM + h * 128; u_.AO = AO + row0 * DM + h * 128; u_.NT = KCROWS / 64; u_.full = 0; } } } while (0)
    dattn::Unit u, nx; bool have; ATTN_GET(0, u, have);
    dattn::bf16x8 qr[4]; bool pre = false;
    float* wsf_base = (float*)((char*)F.lds + MISC_OFF + 1024);
    for (int i = 0; have; ++i) {
        bool hn; ATTN_GET(i + 1, nx, hn);
        dattn::attn_unit<VAR>(u, hn, nx, pre, qr, (char*)F.lds + RING_OFF, wsf_base, lam, one_m_li, sub_gain, F.tid);
        u = nx; have = hn; pre = true;
    }
    __syncthreads();
#undef ATTN_GET
}
constexpr int RBLK = 72;
__device__ __forceinline__ float ret_lg2(int h) { return log2f(1.f - exp2f(-5.f - (float)h)); }
struct EpiRet {
    static constexpr int BMODE = 0;
    pg8::bf16_t* QP; pg8::bf16_t* KN; pg8::bf16_t* KT; pg8::bf16_t* VS; pg8::bf16_t* RG; const float* tab; const float* ssq;
    __device__ __forceinline__ void operator()(const pg8::f32x4 (&acc)[2][2][4][2], const pg8::Unit& u, int wr, int wc, int fr, int fq) const {
        { const int l_ = lane_now(); fr = l_ & 15; fq = l_ >> 4; }
        const int pn = u.pn, pm = u.pm; float rs[2][4]; row_rstd(ssq, pm, wr, fr, fq, rs);
#pragma unroll
        for (int ai = 0; ai < 2; ++ai)
#pragma unroll
            for (int m = 0; m < 4; ++m) {
                const int i = ai * 128 + wr * 64 + m * 16 + fr; const size_t row = (size_t)pm * 256 + i;
                const int J = pm < 64 ? pm : 64 + 4 * (pm - 64) + (i >> 6), jj = pm < 64 ? i : (i & 63), pos = pm < 64 ? (int)row : PAST + (i & 63);
                if (pn < 16) {
                    const int h = pn & 7; const bool isk = pn >= 8; const float sc = isk ? 0.0625f : 1.f;
#pragma unroll
                    for (int n = 0; n < 2; ++n) { const int c1 = wc * 32 + n * 16 + 4 * fq;
                        const pg8::f32x4 t0 = *(const pg8::f32x4*)(tab + ((size_t)pos * 128 + c1) * 2), t1 = *(const pg8::f32x4*)(tab + ((size_t)pos * 128 + c1) * 2 + 4);
                        const pg8::f32x4 x1 = acc[ai][0][m][n] * rs[ai][m], x2 = acc[ai][1][m][n] * rs[ai][m];
                        const float cs[4] = {t0[0], t0[2], t1[0], t1[2]}, sn[4] = {t0[1], t0[3], t1[1], t1[3]}; float o1[4], o2[4];
#pragma unroll
                        for (int e = 0; e < 4; ++e) { o1[e] = (x1[e] * cs[e] - x2[e] * sn[e]) * sc; o2[e] = (x2[e] * cs[e] + x1[e] * sn[e]) * sc; }
                        v2u w1, w2; w1.x = pk2(o1[0], o1[1]); w1.y = pk2(o1[2], o1[3]); w2.x = pk2(o2[0], o2[1]); w2.y = pk2(o2[2], o2[3]);
                        if (!isk) { pg8::bf16_t* p = QP + row * 4096 + h * 512 + 256 + c1; *(v2u*)p = w1; *(v2u*)(p + 128) = w2; }
                        else { pg8::bf16_t* p = KN + row * 2048 + h * 256 + c1; *(v2u*)p = w1; *(v2u*)(p + 128) = w2;
                            pg8::bf16_t* t = KT + ((size_t)(J * 8 + h) * 256 + c1) * 256 + jj;
#pragma unroll
                            for (int e = 0; e < 4; ++e) { t[(size_t)e * 256] = (pg8::bf16_t)f2bf(o1[e]); t[(size_t)(128 + e) * 256] = (pg8::bf16_t)f2bf(o2[e]); } } }
                } else if (pn < 32) {
                    const int h = (pn - 16) >> 1, half = (pn - 16) & 1; const float f = exp2f(-(float)(1 + jj) * ret_lg2(h)) * rs[ai][m];
#pragma unroll
                    for (int bj = 0; bj < 2; ++bj)
#pragma unroll
                        for (int n = 0; n < 2; ++n) { const int dv = half * 256 + bj * 128 + wc * 32 + n * 16 + 4 * fq; pg8::bf16_t* t = VS + ((size_t)(J * 8 + h) * 512 + dv) * 512 + jj;
#pragma unroll
                            for (int e = 0; e < 4; ++e) t[(size_t)e * 512] = (pg8::bf16_t)f2bf(acc[ai][bj][m][n][e] * f); }
                } else {
#pragma unroll
                    for (int bj = 0; bj < 2; ++bj)
#pragma unroll
                        for (int n = 0; n < 2; ++n) { const int c = (pn - 32) * 256 + bj * 128 + wc * 32 + n * 16 + 4 * fq; const pg8::f32x4 x = acc[ai][bj][m][n] * rs[ai][m];
                            v2u w; w.x = pk2(x[0], x[1]); w.y = pk2(x[2], x[3]); *(v2u*)(RG + row * 4096 + c) = w; }
                }
            }
    }
};
__device__ __forceinline__ size_t ret_row0(int J) { return J < 64 ? (size_t)256 * J : (size_t)MP + 64 * (J - 64); }
struct RetQKOrder {
    int G, c; const char* QP; const char* KN;
    __device__ __forceinline__ bool next(int i, pg8::Unit& u) const { const int L = i * G + c; if (L >= RBLK * 8) return false; const int J = L >> 3, h = L & 7; const size_t r0 = ret_row0(J);
        u.pm = J; u.pn = h; u.a = QP + (r0 * 4096 + h * 512 + 256) * 2; u.b = KN + (r0 * 2048 + h * 256) * 2; return true; }
    __device__ __forceinline__ void a_ready(const pg8::Unit&) const {}
    __device__ __forceinline__ void done(const pg8::Unit&) const {}
};
struct EpiRetQK {
    static constexpr int BMODE = 1;
    pg8::bf16_t* QP;
    __device__ __forceinline__ void operator()(const pg8::f32x4 (&acc)[2][2][4][2], const pg8::Unit& u, int wr, int wc, int fr, int fq) const {
        { const int l_ = lane_now(); fr = l_ & 15; fq = l_ >> 4; }
        const int J = u.pm, h = u.pn, nv = J < 64 ? 256 : 64; const size_t r0 = ret_row0(J);
#pragma unroll
        for (int ai = 0; ai < 2; ++ai)
#pragma unroll
            for (int m = 0; m < 4; ++m) { const int i = ai * 128 + wr * 64 + m * 16 + fr;
                if (i < nv) {
#pragma unroll
                    for (int bj = 0; bj < 2; ++bj) { const int j0 = bj * 128 + wc * 32 + 8 * fq; const pg8::f32x4 v0 = acc[ai][bj][m][0], v1 = acc[ai][bj][m][1]; float x[8] = {v0[0], v0[1], v0[2], v0[3], v1[0], v1[1], v1[2], v1[3]};
#pragma unroll
                        for (int k = 0; k < 8; ++k) x[k] = (j0 + k <= i) ? x[k] : 0.f;
                        v4u w; w.x = pk2(x[0], x[1]); w.y = pk2(x[2], x[3]); w.z = pk2(x[4], x[5]); w.w = pk2(x[6], x[7]);
                        *(v4u*)(QP + (r0 + i) * 4096 + h * 512 + j0) = w; } } }
    }
};
struct RetOOrder {
    int G, c; const char* QP; const char* VS;
    __device__ __forceinline__ bool next(int i, pg8::Unit& u) const { const int L = i * G + c; if (L >= RBLK * 16) return false; const int J = L >> 4, r = L & 15, h = r >> 1, half = r & 1; const size_t r0 = ret_row0(J);
        u.pm = J; u.pn = r; u.a = QP + (r0 * 4096 + h * 512) * 2; u.b = VS + (((size_t)(J * 8 + h) * 512 + half * 256) * 512) * 2; return true; }
    __device__ __forceinline__ void a_ready(const pg8::Unit&) const {}
    __device__ __forceinline__ void done(const pg8::Unit&) const {}
};
struct EpiRetO {
    static constexpr int BMODE = 1;
    pg8::bf16_t* O;
    __device__ __forceinline__ void operator()(const pg8::f32x4 (&acc)[2][2][4][2], const pg8::Unit& u, int wr, int wc, int fr, int fq) const {
        { const int l_ = lane_now(); fr = l_ & 15; fq = l_ >> 4; }
        const int J = u.pm, h = u.pn >> 1, half = u.pn & 1, nv = J < 64 ? 256 : 64; const size_t r0 = ret_row0(J); const float lg = ret_lg2(h);
#pragma unroll
        for (int ai = 0; ai < 2; ++ai)
#pragma unroll
            for (int m = 0; m < 4; ++m) { const int i = ai * 128 + wr * 64 + m * 16 + fr;
                if (i < nv) { const float f = exp2f((float)(i + 1) * lg);
#pragma unroll
                    for (int bj = 0; bj < 2; ++bj) { const int j0 = bj * 128 + wc * 32 + 8 * fq; const pg8::f32x4 v0 = acc[ai][bj][m][0] * f, v1 = acc[ai][bj][m][1] * f;
                        v4u w; w.x = pk2(v0[0], v0[1]); w.y = pk2(v0[2], v0[3]); w.z = pk2(v1[0], v1[1]); w.w = pk2(v1[2], v1[3]);
                        *(v4u*)(O + (r0 + i) * 4096 + h * 512 + half * 256 + j0) = w; } } }
    }
};
struct RetKVOrder {
    int G, c; const char* VS; const char* KT;
    __device__ __forceinline__ bool next(int i, pg8::Unit& u) const { const int L = i * G + c; if (L >= RBLK * 16) return false; const int J = L >> 4, r = L & 15, h = r >> 1, half = r & 1;
        u.pm = J; u.pn = r; u.a = VS + (((size_t)(J * 8 + h) * 512 + half * 256) * 512) * 2; u.b = KT + ((size_t)(J * 8 + h) * 256 * 256) * 2; return true; }
    __device__ __forceinline__ void a_ready(const pg8::Unit&) const {}
    __device__ __forceinline__ void done(const pg8::Unit&) const {}
};
struct EpiRetKV {
    static constexpr int BMODE = 1;
    pg8::bf16_t* VS; pg8::bf16_t* KVX;
    __device__ __forceinline__ void operator()(const pg8::f32x4 (&acc)[2][2][4][2], const pg8::Unit& u, int wr, int wc, int fr, int fq) const {
        { const int l_ = lane_now(); fr = l_ & 15; fq = l_ >> 4; }
        const int J = u.pm, h = u.pn >> 1, half = u.pn & 1;
        pg8::bf16_t* base; int pitch;
        if (J < 63) { base = VS + ((size_t)((J + 1) * 8 + h) * 512 + half * 256) * 512 + 256; pitch = 512; }
        else { base = KVX + ((size_t)((J - 63) * 8 + h) * 512 + half * 256) * 256; pitch = 256; }
#pragma unroll
        for (int ai = 0; ai < 2; ++ai)
#pragma unroll
            for (int m = 0; m < 4; ++m) { pg8::bf16_t* rowp = base + (size_t)(ai * 128 + wr * 64 + m * 16 + fr) * pitch + wc * 32 + 8 * fq;
#pragma unroll
                for (int bj = 0; bj < 2; ++bj) { const pg8::f32x4 v0 = acc[ai][bj][m][0], v1 = acc[ai][bj][m][1];
                    v4u w; w.x = pk2(v0[0], v0[1]); w.y = pk2(v0[2], v0[3]); w.z = pk2(v1[0], v1[1]); w.w = pk2(v1[2], v1[3]);
                    *(v4u*)(rowp + bj * 128) = w; } }
    }
};
__device__ __forceinline__ void ret_scan(Frame& F, bf16* VS, const bf16* KVX, const float* state_in, float* osp, float* oss) {
    const int gt = F.bid * NTHR + F.tid;
    for (int c = gt; c < 8 * 512 * 32; c += F.G * NTHR) {
        const int h = c >> 14, dv = (c >> 5) & 511, dk0 = (c & 31) * 8; const float lg = ret_lg2(h), g256 = exp2f(256.f * lg), g64 = exp2f(64.f * lg);
        float S[8];
#pragma unroll
        for (int k = 0; k < 8; ++k) S[k] = 0.f;
        bf16* slot = VS + ((size_t)h * 512 + dv) * 512 + 256 + dk0;
        *(v4u*)slot = (v4u){0u, 0u, 0u, 0u};
        v4u nx = *(const v4u*)(slot + (size_t)8 * 512 * 512);
        for (int J = 1; J < 64; ++J) {
            const v4u kv = nx; bf16* sj = slot + (size_t)J * 8 * 512 * 512;
            if (J < 63) nx = *(const v4u*)(sj + (size_t)8 * 512 * 512);
            const float x[8] = {bflo(kv.x), bfhi(kv.x), bflo(kv.y), bfhi(kv.y), bflo(kv.z), bfhi(kv.z), bflo(kv.w), bfhi(kv.w)};
#pragma unroll
            for (int k = 0; k < 8; ++k) S[k] = (S[k] + x[k]) * g256;
            v4u w; w.x = pk2(S[0], S[1]); w.y = pk2(S[2], S[3]); w.z = pk2(S[4], S[5]); w.w = pk2(S[6], S[7]);
            *(v4u*)sj = w;
        }
        { const v4u kv = *(const v4u*)(KVX + ((size_t)h * 512 + dv) * 256 + dk0);
          const float x[8] = {bflo(kv.x), bfhi(kv.x), bflo(kv.y), bfhi(kv.y), bflo(kv.z), bfhi(kv.z), bflo(kv.w), bfhi(kv.w)};
#pragma unroll
          for (int k = 0; k < 8; ++k) NT_STORE((S[k] + x[k]) * g256, osp + ((size_t)h * 256 + dk0 + k) * 512 + dv); }
    }
    for (int c = gt; c < NB * 8 * 512 * 32; c += F.G * NTHR) {
        const int dv = c & 511, dk0 = ((c >> 9) & 31) * 8, h = (c >> 14) & 7, b = c >> 17; const float g64 = exp2f(64.f * ret_lg2(h));
        const float* si = state_in + (((size_t)b * 8 + h) * 256 + dk0) * 512 + dv; float* so = oss + (((size_t)b * 8 + h) * 256 + dk0) * 512 + dv;
        const v4u kv = *(const v4u*)(KVX + ((size_t)((1 + b) * 8 + h) * 512 + dv) * 256 + dk0);
        const float x[8] = {bflo(kv.x), bfhi(kv.x), bflo(kv.y), bfhi(kv.y), bflo(kv.z), bfhi(kv.z), bflo(kv.w), bfhi(kv.w)}; float s0[8];
#pragma unroll
        for (int k = 0; k < 8; ++k) s0[k] = NT_LOAD(si + (size_t)k * 512);
        v4u w; w.x = pk2(s0[0], s0[1]); w.y = pk2(s0[2], s0[3]); w.z = pk2(s0[4], s0[5]); w.w = pk2(s0[6], s0[7]);
        *(v4u*)(VS + ((size_t)((64 + b) * 8 + h) * 512 + dv) * 512 + 256 + dk0) = w;
#pragma unroll
        for (int k = 0; k < 8; ++k) NT_STORE((s0[k] + x[k]) * g64, so + (size_t)k * 512);
    }
}
__device__ __forceinline__ void ret_zero_pad(Frame& F, bf16* VS, bf16* KT) {
    const size_t gt = (size_t)F.bid * NTHR + F.tid, NG = (size_t)F.G * NTHR, n = (size_t)NB * 8 * 512 * 24, n2 = (size_t)NB * 8 * 256 * 24;
    for (size_t i = gt; i < n; i += NG) { const size_t rowi = i / 24, c = i % 24; *(v4u*)(VS + ((size_t)64 * 8 * 512 + rowi) * 512 + 64 + c * 8) = (v4u){0u, 0u, 0u, 0u}; }
    for (size_t i = gt; i < n2; i += NG) { const size_t rowi = i / 24, c = i % 24; *(v4u*)(KT + ((size_t)64 * 8 * 256 + rowi) * 256 + 64 + c * 8) = (v4u){0u, 0u, 0u, 0u}; }
}
__device__ __forceinline__ void ret_table(Frame& F, float* tab) {
    const size_t gt = (size_t)F.bid * NTHR + F.tid, NG = (size_t)F.G * NTHR;
    for (size_t e = gt; e < (size_t)MP * 128; e += NG) { float c, s; rope_cs((int)(e >> 7), (int)(e & 127), 128, c, s); tab[2 * e] = c; tab[2 * e + 1] = s; }
}
__device__ __forceinline__ void r_out(Frame& F, bf16* O, const bf16* RG) {
    const int gw = F.bid * NWAVES + F.wave, NGW = F.G * NWAVES, lane = F.lane;
    constexpr int U = 3;
    for (int it0 = gw; it0 < MT * 8; it0 += U * NGW) {
        v4u o4[U], g4[U]; size_t off[U]; bool ok[U];
#pragma unroll
        for (int j = 0; j < U; ++j) { const int it = it0 + j * NGW; ok[j] = it < MT * 8; const int itc = ok[j] ? it : gw; off[j] = (size_t)(itc >> 3) * 4096 + (itc & 7) * 512 + lane * 8;
            o4[j] = *(const v4u*)(O + off[j]); g4[j] = NT_LOAD((const v4u*)(RG + off[j])); }
#pragma unroll
        for (int j = 0; j < U; ++j) {
            float o[8] = {bflo(o4[j].x), bfhi(o4[j].x), bflo(o4[j].y), bfhi(o4[j].y), bflo(o4[j].z), bfhi(o4[j].z), bflo(o4[j].w), bfhi(o4[j].w)};
            const float g[8] = {bflo(g4[j].x), bfhi(g4[j].x), bflo(g4[j].y), bfhi(g4[j].y), bflo(g4[j].z), bfhi(g4[j].z), bflo(g4[j].w), bfhi(g4[j].w)};
            float ss = 0.f;
#pragma unroll
            for (int k = 0; k < 8; ++k) ss += o[k] * o[k];
            const float rstd = 1.f / sqrtf(wave_sum(ss) * (1.f / 512.f) + EPS);
#pragma unroll
            for (int k = 0; k < 8; ++k) o[k] = o[k] * rstd * silu_f(g[k]);
            v4u w; w.x = pk2(o[0], o[1]); w.y = pk2(o[2], o[3]); w.z = pk2(o[4], o[5]); w.w = pk2(o[6], o[7]);
            if (ok[j]) *(v4u*)(O + off[j]) = w;
        }
    }
}
struct EpiCIn {
    static constexpr int BMODE = 0;
    pg8::bf16_t* GU; pg8::bf16_t* GVT; pg8::bf16_t* SG; pg8::bf16_t* GVS; float* SSQ; const float* ssq;
    __device__ __forceinline__ void operator()(const pg8::f32x4 (&acc)[2][2][4][2], const pg8::Unit& u, int wr, int wc, int fr, int fq) const {
        { const int l_ = lane_now(); fr = l_ & 15; fq = l_ >> 4; }
        const int pn = u.pn, pm = u.pm, typ = pn >> 4, pt = pn & 15; float rs[2][4]; row_rstd(ssq, pm, wr, fr, fq, rs);
#pragma unroll
        for (int ai = 0; ai < 2; ++ai)
#pragma unroll
            for (int m = 0; m < 4; ++m) {
                const int i = ai * 128 + wr * 64 + m * 16 + fr; const size_t row = (size_t)pm * 256 + i; float ss = 0.f;
#pragma unroll
                for (int bj = 0; bj < 2; ++bj)
#pragma unroll
                    for (int n = 0; n < 2; ++n) { const int c = pt * 256 + bj * 128 + wc * 32 + n * 16 + 4 * fq; const pg8::f32x4 x = acc[ai][bj][m][n] * rs[ai][m]; float y[4];
                        if (typ == 2) {
#pragma unroll
                            for (int e = 0; e < 4; ++e) y[e] = silu_f(x[e]);
                            v2u w; w.x = pk2(y[0], y[1]); w.y = pk2(y[2], y[3]); *(v2u*)(SG + row * 4096 + c) = w;
                        } else {
#pragma unroll
                            for (int e = 0; e < 4; ++e) y[e] = gelu_tanh_f(x[e]);
                            v2u w; w.x = pk2(y[0], y[1]); w.y = pk2(y[2], y[3]);
                            if (typ == 0) *(v2u*)(GU + row * 4096 + c) = w;
                            else { ss += (y[0] * y[0] + y[1] * y[1]) + (y[2] * y[2] + y[3] * y[3]);
                                pg8::bf16_t* t = GVT + ((size_t)pm * 4096 + c) * 256 + i;
                                t[0] = (pg8::bf16_t)(w.x & 0xffffu); t[256] = (pg8::bf16_t)(w.x >> 16); t[512] = (pg8::bf16_t)(w.y & 0xffffu); t[768] = (pg8::bf16_t)(w.y >> 16);
                                if (pm >= 64) *(v2u*)(GVS + (row - MP) * 4096 + c) = w; } } }
                if (typ == 1) { ss += __shfl_xor(ss, 16); ss += __shfl_xor(ss, 32); if (fq == 0) SSQ[row * 64 + pt * 4 + wc] = ss; }
                if (m & 1) asm volatile("" ::: "memory");
            }
    }
};
__device__ __forceinline__ void c_prep(Frame& F, const float* SSQ, const float* wsin, const float* vgain, const bf16* GVS, bf16* Wm, float* ovm) {
    LAS float* rs = (LAS float*)(F.lds + RING_OFF);
    const int tid = F.tid;
    for (int it = F.bid; it < 66 * 8; it += F.G) {
        const int J = it >> 3, g = it & 7;
        __syncthreads();
        if (tid < 256) { const float* p = SSQ + ((size_t)J * 256 + tid) * 64; float s = 0.f;
#pragma unroll
            for (int k = 0; k < 16; ++k) { const f32x4 x = *(const f32x4*)(p + 4 * k); s += (x.x + x.y) + (x.z + x.w); }
            rs[tid] = 1.f / sqrtf(s * (1.f / 4096.f) + EPS); }
        __syncthreads();
        bf16* wm = Wm + (size_t)(J * 8 + g) * 65536; const int sh = J < 64 ? 7 : 6, cm = (1 << sh) - 1;
        for (int eb = tid; eb < 8192; eb += 4 * NTHR) {
            f32x4 wa[4], wb[4];
#pragma unroll
            for (int q = 0; q < 4; ++q) { const int e8 = eb + q * NTHR, i = e8 >> 5, j0 = (e8 & 31) * 8, il = i & cm, jl0 = j0 & cm; const bool on = (i >> sh) == (j0 >> sh) && jl0 <= il;
                const float* wr_ = wsin + ((size_t)g * 128 + (on ? il : 0)) * 128 + (on ? jl0 : 0); wa[q] = *(const f32x4*)wr_; wb[q] = *(const f32x4*)(wr_ + 4); }
#pragma unroll
            for (int q = 0; q < 4; ++q) { const int e8 = eb + q * NTHR, i = e8 >> 5, j0 = (e8 & 31) * 8, il = i & cm, jl0 = j0 & cm; const bool on = (i >> sh) == (j0 >> sh) && jl0 <= il; float y[8];
                const float wv[8] = {wa[q].x, wa[q].y, wa[q].z, wa[q].w, wb[q].x, wb[q].y, wb[q].z, wb[q].w};
#pragma unroll
                for (int k = 0; k < 8; ++k) y[k] = (on && jl0 + k <= il) ? wv[k] * rs[j0 + k] : 0.f;
                v4u w; w.x = pk2(y[0], y[1]); w.y = pk2(y[2], y[3]); w.z = pk2(y[4], y[5]); w.w = pk2(y[6], y[7]);
                *(v4u*)(wm + i * 256 + j0) = w; } }
    }
    const int gw = F.bid * NWAVES + F.wave, NGW = F.G * NWAVES, lane = F.lane;
    for (int r = gw; r < MS; r += NGW) {
        const float rstd = 1.f / sqrtf(wave_sum(SSQ[((size_t)MP + r) * 64 + lane]) * (1.f / 4096.f) + EPS);
#pragma unroll
        for (int k = 0; k < 8; ++k) { const int col = k * 512 + lane * 8; const v4u v4 = *(const v4u*)(GVS + (size_t)r * 4096 + col);
            const f32x4 ga = *(const f32x4*)(vgain + col), gb = *(const f32x4*)(vgain + col + 4);
            float* o = ovm + (size_t)r * 4096 + col;
            *(f32x4*)o = (f32x4){bflo(v4.x) * rstd * ga.x, bfhi(v4.x) * rstd * ga.y, bflo(v4.y) * rstd * ga.z, bfhi(v4.y) * rstd * ga.w};
            *(f32x4*)(o + 4) = (f32x4){bflo(v4.z) * rstd * gb.x, bfhi(v4.z) * rstd * gb.y, bflo(v4.w) * rstd * gb.z, bfhi(v4.w) * rstd * gb.w}; }
    }
}
struct CMixOrder {
    int G, c; const char* Wm; const char* GVT;
    __device__ __forceinline__ bool next(int i, pg8::Unit& u) const { const int L = i * G + c; if (L >= 66 * 16) return false; const int J = L >> 4, nt = L & 15;
        u.pm = J; u.pn = nt; u.a = Wm + ((size_t)(J * 8 + (nt >> 1)) * 65536) * 2; u.b = GVT + (((size_t)J * 4096 + nt * 256) * 256) * 2; return true; }
    __device__ __forceinline__ void a_ready(const pg8::Unit&) const {}
    __device__ __forceinline__ void done(const pg8::Unit&) const {}
};
struct EpiCMix {
    static constexpr int BMODE = 1;
    pg8::bf16_t* GU; const pg8::bf16_t* SG; const float* vgain; const float* bs;
    __device__ __forceinline__ void operator()(const pg8::f32x4 (&acc)[2][2][4][2], const pg8::Unit& u, int wr, int wc, int fr, int fq) const {
        { const int l_ = lane_now(); fr = l_ & 15; fq = l_ >> 4; }
        const int J = u.pm, nt = u.pn, g = nt >> 1, cm = J < 64 ? 127 : 63;
#pragma unroll
        for (int bj = 0; bj < 2; ++bj) { const int c0 = nt * 256 + bj * 128 + wc * 32 + 8 * fq; const f32x4 ga = *(const f32x4*)(vgain + c0), gb = *(const f32x4*)(vgain + c0 + 4);
            const float gn[8] = {ga.x, ga.y, ga.z, ga.w, gb.x, gb.y, gb.z, gb.w};
#pragma unroll
            for (int ai = 0; ai < 2; ++ai)
#pragma unroll
                for (int m = 0; m < 4; ++m) { const int i = ai * 128 + wr * 64 + m * 16 + fr; const size_t off = ((size_t)J * 256 + i) * 4096 + c0; const float b = bs[g * 128 + (i & cm)];
                    const v4u u4 = *(const v4u*)(GU + off), s4 = NT_LOAD((const v4u*)(SG + off)); const pg8::f32x4 v0 = acc[ai][bj][m][0], v1 = acc[ai][bj][m][1];
                    const float mx[8] = {v0[0], v0[1], v0[2], v0[3], v1[0], v1[1], v1[2], v1[3]};
                    const float uu[8] = {bflo(u4.x), bfhi(u4.x), bflo(u4.y), bfhi(u4.y), bflo(u4.z), bfhi(u4.z), bflo(u4.w), bfhi(u4.w)};
                    const float sg[8] = {bflo(s4.x), bfhi(s4.x), bflo(s4.y), bfhi(s4.y), bflo(s4.z), bfhi(s4.z), bflo(s4.w), bfhi(s4.w)}; float y[8];
#pragma unroll
                    for (int k = 0; k < 8; ++k) y[k] = uu[k] * (mx[k] * gn[k] + b) * sg[k];
                    v4u w; w.x = pk2(y[0], y[1]); w.y = pk2(y[2], y[3]); w.z = pk2(y[4], y[5]); w.w = pk2(y[6], y[7]);
                    *(v4u*)(GU + off) = w; } }
    }
};
__device__ __forceinline__ float diff_lambda(const float* q1, const float* k1, const float* q2, const float* k2, float lam_init) {
    float a = 0.f, b = 0.f;
    for (int i = 0; i < 64; ++i) { a += q1[i] * k1[i]; b += q2[i] * k2[i]; }
    return expf(a) - expf(b) + lam_init;
}

constexpr int N_PHASES = 21;
__global__ void __launch_bounds__(NTHR, 2) mega(Args args) {
    extern __shared__ __attribute__((aligned(16))) unsigned char lds[];
    Frame F;
    F.lds = (LAS unsigned char*)lds; F.tid = threadIdx.x; F.lane = F.tid & 63; F.wave = __builtin_amdgcn_readfirstlane(F.tid >> 6); F.G = gridDim.x; F.bid = blockIdx.x;
    F.in = args.in; F.out = args.out; F.ws = args.ws;
    unsigned char* ws = args.ws; float* out = args.out;
    bf16* W_AIN[2] = {(bf16*)(ws + WS_WAIN0), (bf16*)(ws + WS_WAIN1)}; bf16* W_AOUT[2] = {(bf16*)(ws + WS_WAOUT0), (bf16*)(ws + WS_WAOUT1)};
    bf16* W_RIN = (bf16*)(ws + WS_WRIN); bf16* W_ROUT = (bf16*)(ws + WS_WROUT); bf16* W_CIN = (bf16*)(ws + WS_WCIN); bf16* W_COUT = (bf16*)(ws + WS_WCOUT);
    bf16* XN0 = (bf16*)(ws + WS_XN0); bf16* HB = (bf16*)(ws + WS_HB); float* SSQ2 = (float*)(ws + WS_SSQ2);
    bf16* Qs = (bf16*)(ws + WS_QS); bf16* KP = (bf16*)(ws + WS_KP); bf16* VP = (bf16*)(ws + WS_VP); bf16* KC = (bf16*)(ws + WS_KC); bf16* VC = (bf16*)(ws + WS_VC); bf16* AO_A = (bf16*)(ws + WS_AOA);
    bf16* KT = (bf16*)(ws + WS_KT); bf16* RG = (bf16*)(ws + WS_RG); bf16* QP = (bf16*)(ws + WS_QP); bf16* KN = (bf16*)(ws + WS_KN); bf16* VS = (bf16*)(ws + WS_VS); bf16* ORET = (bf16*)(ws + WS_ORET);
    bf16* GU = (bf16*)(ws + WS_GU); bf16* SG = (bf16*)(ws + WS_SG); bf16* GVT = (bf16*)(ws + WS_GVT); bf16* WM = (bf16*)(ws + WS_WM); float* SSQ = (float*)(ws + WS_SSQ); bf16* GVS = (bf16*)(ws + WS_GVS); float* TABR = (float*)(ws + WS_TABR); bf16* KVX = (bf16*)(ws + WS_KVX); float* TABA = (float*)(ws + WS_TABA); bf16* GA = (bf16*)(ws + WS_GA);
    const int lo = args.ph_lo, hi = args.ph_hi;
    volatile LAS unsigned* MISC = (volatile LAS unsigned*)(F.lds + MISC_OFF);
    for (int u = F.tid; u < (LDS_BYTES - MISC_OFF) / 4; u += NTHR) ((LAS unsigned*)(F.lds + MISC_OFF))[u] = 0u;
    __syncthreads();
    XcdBarrier bar = xcd_barrier_post((unsigned*)(ws + WS_CTL) + 4096, MISC + 8);
#define IN(k) (lo <= (k) && (k) < hi)
#define PH_ENTER() do { int t_ = F.wave * 64 + lane_now(); F.tid = t_; F.lane = t_ & 63; } while (0)
    volatile LAS int* DRW = (volatile LAS int*)(F.lds + MISC_OFF + 64);
    unsigned* DCTR = (unsigned*)(ws + WS_CTL) + 8192;
#define DRAIN(ph, total, BODY) do { PH_ENTER(); unsigned tk_ = 0u; if (F.tid == 0) tk_ = atomicAdd(DCTR + 64 * (ph), 1u); for (;;) { __syncthreads(); if (F.tid == 0) DRW[0] = (int)tk_; __syncthreads(); const int c_ = DRW[0]; if (c_ >= (total)) break; \
        if (F.tid == 0) tk_ = atomicAdd(DCTR + 64 * (ph), 1u);     \
        BODY } } while (0)
#define SEAM(k) do { if (IN(k) && IN((k) + 1)) xcd_barrier(bar, F.wave == 0 && lane_now() == 0); } while (0)

#define GEMM_STORE(Aptr, Wptr, NN, KK, Optr) do { pg8::GemmP g{KK, KK, (KK) / 64}; pg8::StaticOrder S; S.init(MT / 256, (NN) / 256, F.G, F.bid, Aptr, Wptr, KK, KK); pg8::EpiStoreBf16 E{(pg8::bf16_t*)(Optr), NN}; \
        pg8::gemm_phase<pg8::EpiStoreBf16, pg8::StaticOrder>(F.lds + RING_OFF, g, S, E, F.tid); } while (0)
#define GEMM_RESIDB(MODE_, Aptr, Wptr, KK) do { pg8::GemmP g{KK, KK, (KK) / 64}; pg8::StaticOrder S; S.init(MT / 256, DM / 256, F.G, F.bid, Aptr, Wptr, KK, KK); \
        pg8::EpiResidB<MODE_> E{args.in[I_XP], args.in[I_XS], (pg8::bf16_t*)HB, out, SSQ2}; pg8::gemm_phase<pg8::EpiResidB<MODE_>, pg8::StaticOrder>(F.lds + RING_OFF, g, S, E, F.tid); } while (0)

    PH_ENTER(); if (IN(0)) {
        transpose_weight(F, args.in[I_AWIN], 2048, 8192, W_AIN[0]); attn_table(F, TABA);
        norm_rows(F, args.in[I_XP], args.in[I_XS], args.in[I_NW], XN0);
    }
    SEAM(0);
#define GEMM_AIN(Aptr, Wptr, J_, SSQP) do { pg8::GemmP g{2048, 2048, 32}; pg8::StaticOrder S; S.init(MT / 256, 32, F.G, F.bid, Aptr, Wptr, 2048, 2048); \
        EpiAIn E{Qs, KP, VP, KC, VC, GA, out + O_KP + (size_t)(J_) * MP * DM, out + O_VP + (size_t)(J_) * MP * DM, out + O_KS + (size_t)(J_) * MS * DM, out + O_VS + (size_t)(J_) * MS * DM, TABA, args.in[I_AQG] + 64 * (J_), args.in[I_AKG] + 64 * (J_), SSQP}; \
        pg8::gemm_phase<EpiAIn, pg8::StaticOrder>(F.lds + RING_OFF, g, S, E, F.tid); } while (0)
    PH_ENTER(); if (IN(1)) { GEMM_AIN(XN0, W_AIN[0], 0, (const float*)nullptr);
        const int n0 = CC_CHUNKS, n1 = n0 + tw_chunks(2048, 2048), n2 = n1 + TR_CHUNKS;
        DRAIN(1, n2, if (c_ < n0) cc_run(F, args.in[I_CK], args.in[I_CV], KC, VC, c_); else if (c_ < n1) tw_run(F, args.in[I_AWOUT], 2048, 2048, W_AOUT[0], c_ - n0); else tr_run(F, TABR, c_ - n1);); }
    SEAM(1);
    PH_ENTER(); if (IN(3)) { const float li = 0.8f - 0.6f * expf(-0.3f * 0.f); const float lam = diff_lambda(args.in[I_LQ1], args.in[I_LK1], args.in[I_LQ2], args.in[I_LK2], li);
        attn_fast(F, Qs, KP, VP, KC, VC, GA, AO_A, lam, 1.f - li, args.in[I_ASG]); }
    SEAM(3);
    PH_ENTER(); if (IN(4)) { GEMM_RESIDB(0, AO_A, W_AOUT[0], 2048);
        const int n0 = tw_chunks(2048, 12288), n1 = n0 + tw_chunks(4096, 2048);
        DRAIN(4, n1, if (c_ < n0) tw_run(F, args.in[I_RWIN], 2048, 12288, W_RIN, c_, args.in[I_NW] + DM); else tw_run(F, args.in[I_RWOUT], 4096, 2048, W_ROUT, c_ - n0);); }
    if (IN(4) && IN(6)) xcd_barrier(bar, F.wave == 0 && lane_now() == 0);
    PH_ENTER(); if (IN(6)) { ret_zero_pad(F, VS, KT);
        PH_ENTER(); pg8::GemmP g{2048, 2048, 32}; pg8::StaticOrder S; S.init(MT / 256, 48, F.G, F.bid, HB, W_RIN, 2048, 2048); EpiRet E{QP, KN, KT, VS, RG, TABR, SSQ2};
        pg8::gemm_phase<EpiRet, pg8::StaticOrder>(F.lds + RING_OFF, g, S, E, F.tid); }
    SEAM(6);
    PH_ENTER(); if (IN(7)) { { pg8::GemmP g{4096, 2048, 4}; RetQKOrder S{F.G, F.bid, (const char*)QP, (const char*)KN}; EpiRetQK E{QP}; pg8::gemm_phase<EpiRetQK, RetQKOrder>(F.lds + RING_OFF, g, S, E, F.tid); }
        PH_ENTER(); { pg8::GemmP g{512, 256, 4}; RetKVOrder S{F.G, F.bid, (const char*)VS, (const char*)KT}; EpiRetKV E{VS, KVX}; pg8::gemm_phase<EpiRetKV, RetKVOrder>(F.lds + RING_OFF, g, S, E, F.tid); }
        xcd_barrier(bar, F.wave == 0 && lane_now() == 0);
        PH_ENTER(); ret_scan(F, VS, KVX, args.in[I_SR], out + O_SP, out + O_SS); }
    SEAM(7);
    PH_ENTER(); if (IN(8)) { pg8::GemmP g{4096, 512, 8}; RetOOrder S{F.G, F.bid, (const char*)QP, (const char*)VS}; EpiRetO E{ORET}; pg8::gemm_phase<EpiRetO, RetOOrder>(F.lds + RING_OFF, g, S, E, F.tid); }
    SEAM(8);
    PH_ENTER(); if (IN(9)) r_out(F, ORET, RG);
    SEAM(9);
    PH_ENTER(); if (IN(10)) { GEMM_RESIDB(1, ORET, W_ROUT, 4096);
        const int n0 = tw_chunks(2048, 12288), n1 = n0 + tw_chunks(4096, 2048), n2 = n1 + tw_chunks(2048, 8192), n3 = n2 + tw_chunks(2048, 2048);
        DRAIN(10, n3, if (c_ < n0) tw_run(F, args.in[I_CWIN], 2048, 12288, W_CIN, c_, args.in[I_NW] + 2 * DM); else if (c_ < n1) tw_run(F, args.in[I_CWOUT], 4096, 2048, W_COUT, c_ - n0);
                      else if (c_ < n2) tw_run(F, args.in[I_AWIN] + (size_t)2048 * 8192, 2048, 8192, W_AIN[1], c_ - n1, args.in[I_NW] + 3 * DM); else tw_run(F, args.in[I_AWOUT] + (size_t)2048 * 2048, 2048, 2048, W_AOUT[1], c_ - n2);); }
    if (IN(10) && IN(12)) xcd_barrier(bar, F.wave == 0 && lane_now() == 0);
    PH_ENTER(); if (IN(12)) { pg8::GemmP g{2048, 2048, 32}; pg8::StaticOrder S; S.init(MT / 256, 48, F.G, F.bid, HB, W_CIN, 2048, 2048); EpiCIn E{GU, GVT, SG, GVS, SSQ, SSQ2};
        pg8::gemm_phase<EpiCIn, pg8::StaticOrder>(F.lds + RING_OFF, g, S, E, F.tid); }
    SEAM(12);
    PH_ENTER(); if (IN(13)) c_prep(F, SSQ, args.in[I_CWS], args.in[I_CVG], GVS, WM, out + O_VM);
    SEAM(13);
    PH_ENTER(); if (IN(14)) { pg8::GemmP g{256, 256, 4}; CMixOrder S{F.G, F.bid, (const char*)WM, (const char*)GVT}; EpiCMix E{GU, SG, args.in[I_CVG], args.in[I_CBS]}; pg8::gemm_phase<EpiCMix, CMixOrder>(F.lds + RING_OFF, g, S, E, F.tid); }
    SEAM(14);
    PH_ENTER(); if (IN(15)) { GEMM_RESIDB(1, GU, W_COUT, 4096);
        DRAIN(15, CC_CHUNKS, cc_run(F, args.in[I_CK] + (size_t)NB * PAST * DM, args.in[I_CV] + (size_t)NB * PAST * DM, KC, VC, c_);); }
    if (IN(15) && IN(17)) xcd_barrier(bar, F.wave == 0 && lane_now() == 0);
    PH_ENTER(); if (IN(17)) GEMM_AIN(HB, W_AIN[1], 1, (const float*)SSQ2);
    SEAM(17);
    PH_ENTER(); if (IN(19)) { const float li = 0.8f - 0.6f * expf(-0.3f * 3.f); const float lam = diff_lambda(args.in[I_LQ1] + 64, args.in[I_LK1] + 64, args.in[I_LQ2] + 64, args.in[I_LK2] + 64, li);
        attn_fast(F, Qs, KP, VP, KC, VC, GA, AO_A, lam, 1.f - li, args.in[I_ASG] + 128); }
    SEAM(19);
    PH_ENTER(); if (IN(20)) GEMM_RESIDB(2, AO_A, W_AOUT[1], 2048);
#undef IN
#undef SEAM
}

extern "C" void kernel_launch(void* const* d_in, const int* in_sizes, int n_in, void* d_out, int out_size, void* d_ws, size_t ws_size, hipStream_t stream) {
    static int grid = 0;
    if (grid == 0) {
        if (n_in != N_IN || (size_t)out_size != O_END || ws_size < WS_END) { fprintf(stderr, "kernel_launch: unexpected shapes: n_in %d out %d ws %zu (need %zu)\n", n_in, out_size, ws_size, (size_t)WS_END); grid = -1; return; }
        int dev = 0, cus = 0;
        if (hipGetDevice(&dev) != hipSuccess || hipDeviceGetAttribute(&cus, hipDeviceAttributeMultiprocessorCount, dev) != hipSuccess) { grid = -1; return; }
        if (hipFuncSetAttribute((const void*)mega, hipFuncAttributeMaxDynamicSharedMemorySize, LDS_BYTES) != hipSuccess) { fprintf(stderr, "kernel_launch: hipFuncSetAttribute failed\n"); grid = -1; return; }
        int per_cu = 0;
        if (hipOccupancyMaxActiveBlocksPerMultiprocessor(&per_cu, (const void*)mega, NTHR, LDS_BYTES) != hipSuccess || per_cu < 1) { fprintf(stderr, "kernel_launch: occupancy query: %d workgroups per CU\n", per_cu); grid = -1; return; }
        (void)hipGetLastError();
        grid = cus;
    }
    if (grid < 0) return;
    Args a{};
    for (int i = 0; i < N_IN; ++i) a.in[i] = (const float*)d_in[i];
    a.out = (float*)d_out; a.ws = (unsigned char*)d_ws;
    (void)hipMemsetAsync((char*)d_ws + WS_CTL, 0, CTL_ZERO_BYTES, stream);
    a.ph_lo = 0; a.ph_hi = N_PHASES;
    hipLaunchKernelGGL(mega, dim3(grid), dim3(NTHR), LDS_BYTES, stream, a);
}
```

```cpp
#include <hip/hip_runtime.h>
#include <cstdio>
#include <cstdint>

__device__ __forceinline__ int lane_now() { int l; asm volatile("v_mbcnt_lo_u32_b32 %0, -1, 0\n\tv_mbcnt_hi_u32_b32 %0, -1, %0" : "=v"(l)); return l; }
namespace pg8 {
#define PG8_LAS __attribute__((address_space(3)))
typedef unsigned short bf16_t;
typedef short bf16x8 __attribute__((ext_vector_type(8)));
typedef float f32x4 __attribute__((ext_vector_type(4)));
typedef unsigned u32x4 __attribute__((ext_vector_type(4)));
constexpr int BM = 256, BK = 64, HALF = 128, HTB = HALF * BK * 2, STAGE_BYTES = 8 * HTB, NXCD = 8, WGM = 4;

__host__ __device__ __forceinline__ int lds_byte(int r, int c) { const int st = (r >> 4) * 2 + (c >> 5), rr = r & 15, cc = c & 31, ob = rr * 64 + cc * 2; return st * 1024 + (ob ^ (((ob >> 9) & 1) << 5)); }
__host__ __device__ __forceinline__ void stage_rc(int b, int& R, int& C) { const int st = b / 1024, sb = b % 1024, swz = sb ^ (((sb >> 9) & 1) << 5); R = (st >> 1) * 16 + swz / 64; C = (st & 1) * 32 + (swz % 64) / 2; }
__host__ __device__ __forceinline__ int perm32(int rho) { const int n = rho >> 4, i = rho & 15; return 8 * (i >> 2) + 4 * n + (i & 3); }

struct Unit { int pm, pn; const char* a; const char* b; };
struct GemmP { int lda, ldb, nt; };

struct StaticOrder {
    int nM, nN, nwg, G, c; const char* A; const char* B; size_t ta, tb;
    __host__ __device__ void init(int nM_, int nN_, int G_, int c_, const void* A_, const void* B_, int lda, int ldb) { nM = nM_; nN = nN_; nwg = nM * nN; G = G_; c = c_; A = (const char*)A_; B = (const char*)B_; ta = (size_t)BM * lda * 2; tb = (size_t)BM * ldb * 2; }
    __host__ __device__ bool next(int i, Unit& u) const {
        const long L = (long)i * G + c; if (L >= nwg) return false;
        int wgid = (int)L; { const int q = nwg / NXCD, r = nwg % NXCD, xcd = wgid % NXCD, off = wgid / NXCD; wgid = (xcd < r ? xcd * (q + 1) : r * (q + 1) + (xcd - r) * q) + off; }
        const int nig = WGM * nN, gid = wgid / nig, fm = gid * WGM, gsz = (nM - fm) < WGM ? (nM - fm) : WGM;
        u.pm = fm + ((wgid % nig) % gsz); u.pn = (wgid % nig) / gsz; u.a = A + (size_t)u.pm * ta; u.b = B + (size_t)u.pn * tb; return true;
    }
    __device__ __forceinline__ void a_ready(const Unit&) const {}
    __device__ __forceinline__ void done(const Unit&) const {}
};

__device__ __forceinline__ unsigned cvt_pk_bf16(float lo, float hi) { unsigned r; asm volatile("v_cvt_pk_bf16_f32 %0, %1, %2" : "=v"(r) : "v"(lo), "v"(hi)); return r; }

struct EpiStoreBf16 {
    static constexpr int BMODE = 1;
    bf16_t* O; int ldc;
    __device__ __forceinline__ void operator()(const f32x4 (&acc)[2][2][4][2], const Unit& u, int wr, int wc, int fr, int fq) const {
        const int row0 = u.pm * BM + wr * 64 + fr; const int col0 = u.pn * BM + wc * 32 + 8 * fq;
#pragma unroll
        for (int ai = 0; ai < 2; ++ai)
#pragma unroll
            for (int m = 0; m < 4; ++m) { bf16_t* rowp = O + (size_t)(row0 + ai * HALF + m * 16) * ldc + col0;
#pragma unroll
                for (int bj = 0; bj < 2; ++bj) { const f32x4 v0 = acc[ai][bj][m][0], v1 = acc[ai][bj][m][1];
                    u32x4 w; w.x = cvt_pk_bf16(v0[0], v0[1]); w.y = cvt_pk_bf16(v0[2], v0[3]); w.z = cvt_pk_bf16(v1[0], v1[1]); w.w = cvt_pk_bf16(v1[2], v1[3]);
                    *(u32x4*)(rowp + bj * HALF) = w; } }
    }
};
struct EpiResid {
    static constexpr int BMODE = 0;
    const float* base_p; const float* base_s; float* out; int split;
    __device__ __forceinline__ void operator()(const f32x4 (&acc)[2][2][4][2], const Unit& u, int wr, int wc, int fr, int fq) const {
        { const int l_ = lane_now(); fr = l_ & 15; fq = l_ >> 4; }
        const int col0 = u.pn * BM + wc * 32 + 4 * fq;
#pragma unroll
        for (int ai = 0; ai < 2; ++ai) {
            f32x4 bs[4][2][2];
#pragma unroll
            for (int m = 0; m < 4; ++m) { const int r = u.pm * BM + ai * HALF + wr * 64 + m * 16 + fr; const float* bp = (r < split) ? base_p + (size_t)r * 2048 : base_s + (size_t)(r - split) * 2048;
#pragma unroll
                for (int bj = 0; bj < 2; ++bj)
#pragma unroll
                    for (int n = 0; n < 2; ++n) bs[m][bj][n] = *(const f32x4*)(bp + col0 + bj * HALF + n * 16); }
#pragma unroll
            for (int m = 0; m < 4; ++m) { const int r = u.pm * BM + ai * HALF + wr * 64 + m * 16 + fr; float* op = out + (size_t)r * 2048;
#pragma unroll
                for (int bj = 0; bj < 2; ++bj)
#pragma unroll
                    for (int n = 0; n < 2; ++n) *(f32x4*)(op + col0 + bj * HALF + n * 16) = bs[m][bj][n] + acc[ai][bj][m][n]; }
            asm volatile("" ::: "memory");
        }
    }
};

template <int MODE> struct EpiResidB {
    static constexpr int BMODE = 1;
    const float* base_p; const float* base_s; bf16_t* HB; float* out; float* SSQ2;
    __device__ __forceinline__ void operator()(const f32x4 (&acc)[2][2][4][2], const Unit& u, int wr, int wc, int fr, int fq) const {
        { const int l_ = lane_now(); fr = l_ & 15; fq = l_ >> 4; }
        const int col0 = u.pn * BM + wc * 32 + 8 * fq;
#pragma unroll
        for (int ai = 0; ai < 2; ++ai) {
            f32x4 b0[4][2], b1[4][2]; u32x4 hb[4][2];
#pragma unroll
            for (int m = 0; m < 4; ++m) { const int r = u.pm * BM + ai * HALF + wr * 64 + m * 16 + fr;
#pragma unroll
                for (int bj = 0; bj < 2; ++bj) {
                    if (MODE == 0) { const float* bp = ((r < 16384) ? base_p + (size_t)r * 2048 : base_s + (size_t)(r - 16384) * 2048) + col0 + bj * HALF; b0[m][bj] = __builtin_nontemporal_load((const f32x4*)bp); b1[m][bj] = __builtin_nontemporal_load((const f32x4*)(bp + 4)); }
                    else hb[m][bj] = *(const u32x4*)(HB + (size_t)r * 2048 + col0 + bj * HALF); } }
#pragma unroll
            for (int m = 0; m < 4; ++m) { const int r = u.pm * BM + ai * HALF + wr * 64 + m * 16 + fr; float ss = 0.f;
#pragma unroll
                for (int bj = 0; bj < 2; ++bj) { f32x4 h0, h1;
                    if (MODE == 0) { h0 = b0[m][bj] + acc[ai][bj][m][0]; h1 = b1[m][bj] + acc[ai][bj][m][1]; }
                    else { const u32x4 w = hb[m][bj];
                        h0 = (f32x4){__builtin_bit_cast(float, w.x << 16), __builtin_bit_cast(float, w.x & 0xffff0000u), __builtin_bit_cast(float, w.y << 16), __builtin_bit_cast(float, w.y & 0xffff0000u)} + acc[ai][bj][m][0];
                        h1 = (f32x4){__builtin_bit_cast(float, w.z << 16), __builtin_bit_cast(float, w.z & 0xffff0000u), __builtin_bit_cast(float, w.w << 16), __builtin_bit_cast(float, w.w & 0xffff0000u)} + acc[ai][bj][m][1]; }
                    if (MODE == 2) { float* op = out + (size_t)r * 2048 + col0 + bj * HALF; __builtin_nontemporal_store(h0, (f32x4*)op); __builtin_nontemporal_store(h1, (f32x4*)(op + 4)); }
                    else { u32x4 w; w.x = cvt_pk_bf16(h0[0], h0[1]); w.y = cvt_pk_bf16(h0[2], h0[3]); w.z = cvt_pk_bf16(h1[0], h1[1]); w.w = cvt_pk_bf16(h1[2], h1[3]);
                        *(u32x4*)(HB + (size_t)r * 2048 + col0 + bj * HALF) = w;
                        ss += (h0[0] * h0[0] + h0[1] * h0[1]) + (h0[2] * h0[2] + h0[3] * h0[3]) + (h1[0] * h1[0] + h1[1] * h1[1]) + (h1[2] * h1[2] + h1[3] * h1[3]); } }
                if (MODE != 2) { ss += __shfl_xor(ss, 16); ss += __shfl_xor(ss, 32); if (fq == 0) SSQ2[(size_t)r * 32 + u.pn * 4 + wc] = ss; } }
            asm volatile("" ::: "memory");
        }
    }
};

template <class Epi, class Sched, bool ALIGN_EPI = true>
__device__ __forceinline__ void gemm_phase(PG8_LAS unsigned char* lds, const GemmP g, const Sched& S, const Epi& E, int tid) {
    asm volatile("" : "+v"(tid));
    const int wid = __builtin_amdgcn_readfirstlane(tid >> 6), lane = tid & 63, wr = wid >> 2, wc = wid & 3, fr = lane & 15, fq = lane >> 4;
    int nt = g.nt; asm volatile("" : "+s"(nt));
    unsigned voffA[2], voffB[2];
#pragma unroll
    for (int i = 0; i < 2; ++i) { int R, C; stage_rc(tid * 16 + i * 8192, R, C); const int Rb = Epi::BMODE == 2 ? (64 * (R >> 5) + perm32(R & 31)) : Epi::BMODE == 1 ? ((R & ~31) + perm32(R & 31)) : R;
        voffA[i] = (unsigned)(R * g.lda + C) * 2u; voffB[i] = (unsigned)(Rb * g.ldb + C) * 2u; }
    const size_t kstep = (size_t)(BK * 2);
    const size_t hstepA = (size_t)HALF * g.lda * 2, hstepB = (size_t)(Epi::BMODE == 2 ? 32 : HALF) * g.ldb * 2;
    const unsigned ldsw = (unsigned)wid * 1024u;
    const int aoff = lds_byte(wr * 64 + fr, fq * 8), boff = lds_byte(wc * 32 + fr, fq * 8);
#define PG8_SA(b, h) (((b) * 2 + (h)) * HTB)
#define PG8_SB(b, h) ((4 + (b) * 2 + (h)) * HTB)
#define PG8_STAGE(bufoff, gbase, voff) do { _Pragma("unroll") for (int _i = 0; _i < 2; ++_i) \
        __builtin_amdgcn_global_load_lds((const unsigned*)((const char*)(gbase) + (voff)[_i]), (PG8_LAS unsigned*)(lds + (bufoff) + ldsw + _i * 8192), 16, 0, 0); } while (0)
#define PG8_LDA(dst, b, h) do { _Pragma("unroll") for (int m = 0; m < 4; ++m) _Pragma("unroll") for (int k = 0; k < 2; ++k) dst[m][k] = *(const PG8_LAS bf16x8*)(lds + PG8_SA(b, h) + aoff + m * 2048 + k * 1024); } while (0)
#define PG8_LDB(dst, b, h) do { _Pragma("unroll") for (int n = 0; n < 2; ++n) _Pragma("unroll") for (int k = 0; k < 2; ++k) dst[n][k] = *(const PG8_LAS bf16x8*)(lds + PG8_SB(b, h) + boff + n * 2048 + k * 1024); } while (0)
#define PG8_MMA(ai, bj, At, Bt) do { __builtin_amdgcn_s_setprio(1); _Pragma("unroll") for (int m = 0; m < 4; ++m) _Pragma("unroll") for (int n = 0; n < 2; ++n) _Pragma("unroll") for (int k = 0; k < 2; ++k) \
        acc[ai][bj][m][n] = __builtin_amdgcn_mfma_f32_16x16x32_bf16(Bt[n][k], At[m][k], acc[ai][bj][m][n], 0, 0, 0); __builtin_amdgcn_s_setprio(0); } while (0)
#define PG8_WAIT_V(n) asm volatile("s_waitcnt vmcnt(" #n ")" ::: "memory")
#define PG8_WAIT_L(n) asm volatile("s_waitcnt lgkmcnt(" #n ")" ::: "memory")
#define PG8_BAR __builtin_amdgcn_s_barrier()
#define PG8_SCHED __builtin_amdgcn_sched_barrier(0)
    Unit cur, nxt; int ui = 0;
    if (!S.next(0, cur)) return;
    f32x4 acc[2][2][4][2];
#pragma unroll
    for (int a = 0; a < 2; ++a)
#pragma unroll
        for (int b = 0; b < 2; ++b)
#pragma unroll
            for (int m = 0; m < 4; ++m)
#pragma unroll
                for (int n = 0; n < 2; ++n) acc[a][b][m][n] = (f32x4){0.f, 0.f, 0.f, 0.f};
    bf16x8 At[4][2], B0[2][2], B1[2][2];
    const char* cA = cur.a; const char* cB = cur.b;
    S.a_ready(cur);
    PG8_STAGE(PG8_SB(0, 0), cB, voffB); PG8_STAGE(PG8_SB(0, 1), cB + hstepB, voffB); PG8_STAGE(PG8_SA(0, 0), cA, voffA); PG8_STAGE(PG8_SA(0, 1), cA + hstepA, voffA);
    if (wr == 1) PG8_BAR;
    PG8_WAIT_V(2); PG8_BAR;
    PG8_STAGE(PG8_SB(1, 0), cB + kstep, voffB); PG8_STAGE(PG8_SA(1, 0), cA + kstep, voffA); PG8_STAGE(PG8_SB(1, 1), cB + hstepB + kstep, voffB);
    PG8_WAIT_V(6); PG8_BAR;
    for (;;) {
        const bool has_next = S.next(ui + 1, nxt);
        const char* nA = has_next ? nxt.a : cA; const char* nB = has_next ? nxt.b : cB;
        for (int t = 0; t < nt; t += 2) {
            const bool last = (t == nt - 2);
            const char* a1 = cA + (size_t)(t + 1) * kstep;
            const char* a2 = last ? nA : cA + (size_t)(t + 2) * kstep; const char* b2 = last ? nB : cB + (size_t)(t + 2) * kstep;
            const char* a3 = a2 + kstep; const char* b3 = b2 + kstep;
            if (last && has_next) S.a_ready(nxt);
            PG8_LDB(B0, 0, 0); PG8_LDB(B1, 0, 1); PG8_SCHED; PG8_LDA(At, 0, 0); PG8_STAGE(PG8_SA(1, 1), a1 + hstepA, voffA);
            PG8_WAIT_V(8); PG8_WAIT_L(0); PG8_BAR; PG8_MMA(0, 0, At, B0); PG8_MMA(0, 1, At, B1); PG8_BAR; PG8_SCHED;
            PG8_LDA(At, 0, 1); PG8_STAGE(PG8_SB(0, 0), b2, voffB); PG8_STAGE(PG8_SB(0, 1), b2 + hstepB, voffB); PG8_STAGE(PG8_SA(0, 0), a2, voffA);
            PG8_WAIT_V(8); PG8_WAIT_L(0); PG8_BAR; PG8_MMA(1, 0, At, B0); PG8_MMA(1, 1, At, B1); PG8_BAR; PG8_SCHED;
            PG8_LDB(B0, 1, 0); PG8_LDB(B1, 1, 1); PG8_SCHED; PG8_LDA(At, 1, 0); PG8_STAGE(PG8_SA(0, 1), a2 + hstepA, voffA);
            PG8_WAIT_V(8); PG8_WAIT_L(0); PG8_BAR; PG8_MMA(0, 0, At, B0); PG8_MMA(0, 1, At, B1); PG8_BAR; PG8_SCHED;
            PG8_LDA(At, 1, 1); PG8_STAGE(PG8_SB(1, 0), b3, voffB); PG8_STAGE(PG8_SB(1, 1), b3 + hstepB, voffB); PG8_STAGE(PG8_SA(1, 0), a3, voffA);
            PG8_WAIT_V(8); PG8_WAIT_L(0); PG8_BAR; PG8_MMA(1, 0, At, B0); PG8_MMA(1, 1, At, B1); PG8_BAR; PG8_SCHED;
        }
        if constexpr (ALIGN_EPI) { if (wr == 0) PG8_BAR; }
        E(acc, cur, wr, wc, fr, fq); S.done(cur);
        if (!has_next) break;
#pragma unroll
        for (int a = 0; a < 2; ++a)
#pragma unroll
            for (int b = 0; b < 2; ++b)
#pragma unroll
                for (int m = 0; m < 4; ++m)
#pragma unroll
                    for (int n = 0; n < 2; ++n) acc[a][b][m][n] = (f32x4){0.f, 0.f, 0.f, 0.f};
        cur = nxt; cA = nA; cB = nB; ++ui;
        if constexpr (ALIGN_EPI) { if (wr == 1) PG8_BAR; }
    }
    PG8_WAIT_V(0);
    if constexpr (!ALIGN_EPI) { if (wr == 0) PG8_BAR; }
    PG8_BAR;
#undef PG8_SA
#undef PG8_SB
#undef PG8_STAGE
#undef PG8_LDA
#undef PG8_LDB
#undef PG8_MMA
#undef PG8_WAIT_V
#undef PG8_WAIT_L
#undef PG8_BAR
#undef PG8_SCHED
}
}

constexpr int NWAVES = 8, NTHR = 512;
constexpr int DM = 2048, MP = 16384, MS = 512, MT = MP + MS, PAST = 2048, DECL = 64, NB = 8;
constexpr int KCROWS = PAST + DECL;
constexpr float EPS = 1e-6f;
constexpr float LOG2E = 1.4426950408889634f;
constexpr float C2 = 0.125f * LOG2E;

enum { I_XP = 0, I_XS, I_CK, I_CV, I_SR, I_NW, I_AWIN, I_AWOUT, I_AQG, I_AKG, I_LQ1, I_LK1, I_LQ2, I_LK2, I_ASG, I_RWIN, I_RWOUT, I_CWIN, I_CWOUT, I_CVG, I_CWS, I_CBS, N_IN };
constexpr size_t O_YP = 0, O_YS = O_YP + (size_t)MP * DM, O_KP = O_YS + (size_t)MS * DM, O_VP = O_KP + 2 * (size_t)MP * DM, O_KS = O_VP + 2 * (size_t)MP * DM, O_VS = O_KS + 2 * (size_t)MS * DM,
                 O_SP = O_VS + 2 * (size_t)MS * DM, O_SS = O_SP + (size_t)8 * 256 * 512, O_VM = O_SS + (size_t)NB * 8 * 256 * 512, O_END = O_VM + (size_t)MS * 4096;

constexpr size_t MiB = 1u << 20;
constexpr size_t WS_CTL = 0, CTL_ZERO_BYTES = 1 * MiB;
constexpr size_t WS_WAIN0 = 8 * MiB, WS_WAOUT0 = 40 * MiB, WS_WRIN = 48 * MiB, WS_WROUT = 96 * MiB, WS_WCIN = 112 * MiB, WS_WCOUT = 160 * MiB, WS_WAIN1 = 176 * MiB, WS_WAOUT1 = 208 * MiB;
constexpr size_t WS_SSQ2 = 2 * MiB;
constexpr size_t WS_HB = 216 * MiB, WS_Z = 282 * MiB;
constexpr size_t WS_XN0 = 348 * MiB;
constexpr size_t WS_QS = 546 * MiB, WS_KP = 612 * MiB, WS_VP = 676 * MiB, WS_KC = 740 * MiB, WS_VC = 806 * MiB, WS_AOA = 872 * MiB;
constexpr size_t WS_KT = 112 * MiB, WS_RG = 282 * MiB, WS_QP = 414 * MiB, WS_KN = 546 * MiB, WS_VS = 612 * MiB, WS_ORET = 900 * MiB;
constexpr size_t WS_GU = 282 * MiB, WS_SG = 414 * MiB, WS_GVT = 546 * MiB, WS_WM = 678 * MiB, WS_SSQ = 744 * MiB, WS_GVS = 752 * MiB;
constexpr size_t WS_GA = 282 * MiB;
constexpr size_t WS_KVX = 184 * MiB;
constexpr size_t WS_TABR = 1040 * MiB, WS_TABA = 1056 * MiB, WS_END = 1060 * MiB;

#define GAS __attribute__((address_space(1)))
#define LAS __attribute__((address_space(3)))
typedef unsigned short bf16;
typedef unsigned v4u __attribute__((ext_vector_type(4)));
typedef unsigned v2u __attribute__((ext_vector_type(2)));
typedef float f32x4 __attribute__((ext_vector_type(4)));
typedef GAS unsigned gu32;
#define RLX_AGENT __ATOMIC_RELAXED, __HIP_MEMORY_SCOPE_AGENT
#define LDS_WAIT() asm volatile("s_waitcnt lgkmcnt(0)" ::: "memory")
#define VM_WAIT() asm volatile("s_waitcnt vmcnt(0)" ::: "memory")
typedef float g_f32x2 __attribute__((ext_vector_type(2))); typedef __bf16 g_bf16x2 __attribute__((ext_vector_type(2)));
__device__ __forceinline__ unsigned pk2(float lo, float hi) { const g_f32x2 v = {lo, hi}; const g_bf16x2 b = __builtin_convertvector(v, g_bf16x2); return __builtin_bit_cast(unsigned, b); }
__device__ __forceinline__ unsigned f2bf(float f) { return pk2(f, 0.f) & 0xffffu; }
__device__ __forceinline__ float bf2f(unsigned short b) { return __builtin_bit_cast(float, (unsigned)b << 16); }
__device__ __forceinline__ float bflo(unsigned w) { return __builtin_bit_cast(float, w << 16); }
__device__ __forceinline__ float bfhi(unsigned w) { return __builtin_bit_cast(float, w & 0xffff0000u); }
__device__ __forceinline__ float silu_f(float x) { return x * __builtin_amdgcn_rcpf(1.f + __builtin_amdgcn_exp2f(-LOG2E * x)); }
__device__ __forceinline__ float gelu_tanh_f(float x) { const float u = (0.7978845608028654f * 2.f * LOG2E) * (x + 0.044715f * x * x * x); return x * __builtin_amdgcn_rcpf(1.f + __builtin_amdgcn_exp2f(-u)); }
__device__ __forceinline__ float wave_sum(float v) {
#pragma unroll
    for (int o = 1; o < 64; o <<= 1) v += __shfl_xor(v, o);
    return v;
}
__device__ __forceinline__ void row_rstd(const float* ssq, int pm, int wr, int fr, int fq, float (&rs)[2][4]) {
#pragma unroll
    for (int ai = 0; ai < 2; ++ai)
#pragma unroll
        for (int m = 0; m < 4; ++m) {
            if (ssq) { const float* p = ssq + ((size_t)pm * 256 + ai * 128 + wr * 64 + m * 16 + fr) * 32 + 8 * fq; const f32x4 a = *(const f32x4*)p, b = *(const f32x4*)(p + 4);
                float t = ((a.x + a.y) + (a.z + a.w)) + ((b.x + b.y) + (b.z + b.w)); t += __shfl_xor(t, 16); t += __shfl_xor(t, 32); rs[ai][m] = 1.f / sqrtf(t * (1.f / 2048.f) + EPS); }
            else rs[ai][m] = 1.f; }
}
#define NT_LOAD(p) __builtin_nontemporal_load(p)
#define NT_STORE(v, p) __builtin_nontemporal_store((v), (p))
__device__ __forceinline__ void rope_cs(int pos, int i, int nf, float& c, float& s) {
    const float inv = exp2f(-(float)i / (float)nf * 13.287712379549449f);
    const double a = (double)pos * (double)inv * 0.15915494309189535;
    const float r = (float)(a - floor(a));
    c = __builtin_amdgcn_cosf(r); s = __builtin_amdgcn_sinf(r);
}

#define XB_TMO      128
#define XB_XCNT(j)  (256  + 64 * (j))
#define XB_XSUB(j)  (1280 + 64 * (j))
#define XB_XGEN(j)  (2304 + 64 * (j))
#define XB_TOP      3328
#define XB_TOPGEN   3392
#define XCD_BAR_WORDS 3456
#define XB_SPIN_CAP (1u << 22)
__device__ __forceinline__ unsigned xb_ld(unsigned* p)              { return __hip_atomic_load(p, __ATOMIC_RELAXED, __HIP_MEMORY_SCOPE_AGENT); }
__device__ __forceinline__ unsigned xb_add(unsigned* p, unsigned v) { return __hip_atomic_fetch_add(p, v, __ATOMIC_RELAXED, __HIP_MEMORY_SCOPE_AGENT); }
__device__ __forceinline__ unsigned xb_xcc_id() { return (unsigned)__builtin_amdgcn_s_getreg((3 << 11) | 20) & 0xFu; }
#define XB_SPIN(cond, bar) do { unsigned _sp = 0; while (cond) { __builtin_amdgcn_s_sleep(1); \
    if ((++_sp & 255u) == 0u) { if (xb_ld(&(bar)[XB_TMO])) break; if (_sp > XB_SPIN_CAP) { atomicAdd(&(bar)[XB_TMO], 1u); break; } } } } while (0)
struct XcdBarrier { unsigned* bar; unsigned x; volatile LAS unsigned* st; };
__device__ __forceinline__ XcdBarrier xcd_barrier_post(unsigned* bar, volatile LAS unsigned* st) {
    XcdBarrier b; b.bar = bar; b.x = xb_xcc_id(); b.st = st;
    if (threadIdx.x == 0) (void)xb_add(&bar[XB_XCNT(b.x)], 1u);
    return b;
}
__device__ __forceinline__ void xcd_barrier_complete(unsigned* bar, unsigned x, unsigned& nloc, unsigned& nx) {
    const unsigned G = gridDim.x * gridDim.y * gridDim.z;
    unsigned sum, cnt, mine, sp = 0u;
    for (;;) {
        sum = 0u; cnt = 0u; mine = 0u;
#pragma unroll
        for (unsigned j = 0; j < 16; ++j) { const unsigned c = xb_ld(&bar[XB_XCNT(j)]); sum += c; cnt += (c > 0u) ? 1u : 0u; mine = (j == x) ? c : mine; }
        if (sum == G) break;
        __builtin_amdgcn_s_sleep(1);
        if ((++sp & 255u) == 0u) { if (xb_ld(&bar[XB_TMO])) break; if (sp > XB_SPIN_CAP) { atomicAdd(&bar[XB_TMO], 1u); break; } }
    }
    nloc = mine > 0u ? mine : 1u; nx = cnt > 0u ? cnt : 1u;
}
__device__ __forceinline__ void xcd_barrier(const XcdBarrier& b, bool leader) {
    asm volatile("s_waitcnt vmcnt(0)" ::: "memory");
    __syncthreads();
    if (leader) {
        unsigned* bar = b.bar;
        __builtin_amdgcn_s_waitcnt(0);
        unsigned nloc = b.st[0], nx = b.st[1];
        if (nloc == 0u) { xcd_barrier_complete(bar, b.x, nloc, nx); b.st[0] = nloc; b.st[1] = nx; }
        const unsigned old = xb_add(&bar[XB_XSUB(b.x)], 1u);
        const unsigned gen = old / nloc;
        if (old + 1u == (gen + 1u) * nloc) {
            __builtin_amdgcn_fence(__ATOMIC_RELEASE, "agent");
            asm volatile("s_waitcnt vmcnt(0)" ::: "memory");
            const unsigned og = xb_add(&bar[XB_TOP], 1u);
            const unsigned tg = og / nx;
            if (og + 1u == (tg + 1u) * nx) xb_add(&bar[XB_TOPGEN], 1u);
            else XB_SPIN(xb_ld(&bar[XB_TOPGEN]) == tg, bar);
            __builtin_amdgcn_fence(__ATOMIC_ACQUIRE, "agent");
            xb_add(&bar[XB_XGEN(b.x)], 1u);
            asm volatile("s_waitcnt vmcnt(0)" ::: "memory");
        } else {
            XB_SPIN(xb_ld(&bar[XB_XGEN(b.x)]) == gen, bar);
            __builtin_amdgcn_fence(__ATOMIC_ACQUIRE, "agent");
            asm volatile("s_waitcnt vmcnt(0)" ::: "memory");
        }
    }
    __syncthreads();
}

constexpr int RING_OFF = 0, RING_BYTES = 139264;
constexpr int MISC_OFF = RING_BYTES;
constexpr int LDS_BYTES = 147456;
struct Args { const float* in[N_IN]; float* out; unsigned char* ws; int ph_lo, ph_hi; };
struct Frame {
    LAS unsigned char* lds; int tid, lane, wave, G, bid;
    const float* const* in; float* out; unsigned char* ws;
};

__device__ __forceinline__ void p0_transpose_item(const float* W, int K, int N, bf16* WT, LAS float* scr, int item, int lane, const float* ksc = nullptr) {
    const int nblk = N / 32, kb = item / nblk, nb = item % nblk, k0 = 64 * kb, n0 = 32 * nb;
    float w_[32];
#pragma unroll
    for (int i = 0; i < 32; ++i) w_[i] = NT_LOAD(W + (size_t)(k0 + 2 * i + (lane >> 5)) * N + n0 + (lane & 31));
#pragma unroll
    for (int i = 0; i < 32; ++i) { const int kk = 2 * i + (lane >> 5); scr[kk * 33 + (lane & 31)] = ksc ? w_[i] * ksc[k0 + kk] : w_[i]; }
    LDS_WAIT(); asm volatile("" ::: "memory");
    const int c = lane & 7;
#pragma unroll
    for (int j = 0; j < 4; ++j) { const int n = (lane >> 3) + 8 * j; const LAS float* s = scr + (8 * c) * 33 + n;
        v4u o; o.x = pk2(s[0 * 33], s[1 * 33]); o.y = pk2(s[2 * 33], s[3 * 33]); o.z = pk2(s[4 * 33], s[5 * 33]); o.w = pk2(s[6 * 33], s[7 * 33]);
        *(GAS v4u*)(WT + (size_t)(n0 + n) * K + k0 + 8 * c) = o; }
    LDS_WAIT(); asm volatile("" ::: "memory");
}
__device__ __forceinline__ void transpose_weight(Frame& F, const float* W, int K, int N, bf16* WT) {
    LAS float* scr = (LAS float*)(F.lds + RING_OFF + F.wave * 16384);
    const int gw = F.bid * NWAVES + F.wave, NGW = F.G * NWAVES, nitems = (K / 64) * (N / 32);
    for (int it = gw; it < nitems; it += NGW) p0_transpose_item(W, K, N, WT, scr, it, F.lane);
}
__device__ __forceinline__ void norm_rows(Frame& F, const float* src_p, const float* src_s, const float* w, bf16* XN) {
    const int gw = F.bid * NWAVES + F.wave, NGW = F.G * NWAVES;
    const GAS f32x4* wr = (const GAS f32x4*)w + F.lane;
    f32x4 nx[8];
    if (gw < MT) { const float* xrow = (gw < MP) ? src_p + (size_t)gw * DM : src_s + (size_t)(gw - MP) * DM;
#pragma unroll
        for (int j = 0; j < 8; ++j) nx[j] = __builtin_nontemporal_load((const f32x4*)(xrow) + F.lane + 64 * j); }
    for (int m = gw; m < MT; m += NGW) {
        f32x4 v[8]; float s = 0.f;
#pragma unroll
        for (int j = 0; j < 8; ++j) v[j] = nx[j];
        const int m2 = m + NGW;
        if (m2 < MT) { const float* xrow = (m2 < MP) ? src_p + (size_t)m2 * DM : src_s + (size_t)(m2 - MP) * DM;
#pragma unroll
            for (int j = 0; j < 8; ++j) nx[j] = __builtin_nontemporal_load((const f32x4*)(xrow) + F.lane + 64 * j); }
#pragma unroll
        for (int j = 0; j < 8; ++j) s += (v[j].x * v[j].x + v[j].y * v[j].y) + (v[j].z * v[j].z + v[j].w * v[j].w);
        const float rstd = 1.f / sqrtf(wave_sum(s) * (1.f / DM) + EPS);
        GAS v2u* o8 = (GAS v2u*)(XN + (size_t)m * DM) + F.lane;
#pragma unroll
        for (int j = 0; j < 8; ++j) { const f32x4 g = wr[64 * j]; v2u o; o.x = pk2(v[j].x * rstd * g.x, v[j].y * rstd * g.y); o.y = pk2(v[j].z * rstd * g.z, v[j].w * rstd * g.w); o8[64 * j] = o; }
    }
}
__device__ __forceinline__ void cache_cvt(Frame& F, const float* ck, const float* cv, bf16* KC, bf16* VC) {
    const size_t nvec = (size_t)NB * PAST * DM / 4;
    const size_t gt = (size_t)F.bid * NTHR + F.tid, NG = (size_t)F.G * NTHR;
    for (size_t i = gt; i < 2 * nvec; i += NG) {
        const bool isv = i >= nvec; const size_t e = (isv ? i - nvec : i) * 4;
        const size_t brow = e / DM, col = e % DM, b = brow / PAST, t = brow % PAST;
        const f32x4 x = *(const GAS f32x4*)((isv ? cv : ck) + e);
        v2u o; o.x = pk2(x.x, x.y); o.y = pk2(x.z, x.w);
        *(GAS v2u*)((isv ? VC : KC) + ((b * KCROWS + t) * DM + col)) = o;
    }
}
__device__ __forceinline__ int tw_chunks(int K, int N) { return (K / 64) * (N / 32) / 64; }
__device__ __forceinline__ void tw_run(Frame& F, const float* W, int K, int N, bf16* WT, int c, const float* ksc = nullptr) {
    LAS float* scr = (LAS float*)(F.lds + RING_OFF + F.wave * 16384);
#pragma unroll 1
    for (int i = 0; i < 8; ++i) p0_transpose_item(W, K, N, WT, scr, c * 64 + F.wave * 8 + i, F.lane, ksc);
}
constexpr int CC_CHUNKS = 2 * (NB * PAST * DM / 4) / 8192;
__device__ __forceinline__ void cc_run(Frame& F, const float* ck, const float* cv, bf16* KC, bf16* VC, int c) {
    const bool isv = c >= CC_CHUNKS / 2; const int brow0 = (isv ? c - CC_CHUNKS / 2 : c) * 16, b = brow0 / PAST, t0 = brow0 % PAST;
    const float* src = (isv ? cv : ck) + (size_t)brow0 * DM + F.tid * 4;
    bf16* dst = (isv ? VC : KC) + ((size_t)b * KCROWS + t0) * DM + F.tid * 4;
    f32x4 x[16];
#pragma unroll
    for (int k = 0; k < 16; ++k) x[k] = NT_LOAD((const f32x4*)(src + (size_t)k * DM));
#pragma unroll
    for (int k = 0; k < 16; ++k) { v2u o; o.x = pk2(x[k].x, x[k].y); o.y = pk2(x[k].z, x[k].w); *(GAS v2u*)(dst + (size_t)k * DM) = o; }
}
constexpr int TR_CHUNKS = MP * 128 / 8192;
__device__ __forceinline__ void tr_run(Frame& F, float* tab, int c) {
#pragma unroll 1
    for (int k = 0; k < 16; ++k) { const size_t e = (size_t)c * 8192 + k * NTHR + F.tid; float cs, sn; rope_cs((int)(e >> 7), (int)(e & 127), 128, cs, sn); tab[2 * e] = cs; tab[2 * e + 1] = sn; }
}
__device__ __forceinline__ int row_pos(int row) { return row < MP ? row : PAST + ((row - MP) & 63); }

struct EpiAIn {
    static constexpr int BMODE = 2;
    pg8::bf16_t *Qs, *KP, *VP, *KC, *VC, *GA; float *okp, *ovp, *oks, *ovs; const float* tab; const float* qg; const float* kg; const float* ssq;
    __device__ __forceinline__ void operator()(const pg8::f32x4 (&acc)[2][2][4][2], const pg8::Unit& u, int wr, int wc, int fr, int fq) const {
        { const int l_ = lane_now(); fr = l_ & 15; fq = l_ >> 4; }
        const int pn = u.pn, pm = u.pm, typ = pn >> 3, cl = ((pn & 7) * 4 + wc) * 64 + 8 * fq; float rs[2][4]; row_rstd(ssq, pm, wr, fr, fq, rs);
        float g1[8], g2[8];
        if (typ < 2) { const float* gp = (typ == 0 ? qg : kg) + 8 * fq; const pg8::f32x4 a = *(const pg8::f32x4*)gp, b = *(const pg8::f32x4*)(gp + 4), c = *(const pg8::f32x4*)(gp + 32), d = *(const pg8::f32x4*)(gp + 36);
#pragma unroll
            for (int e = 0; e < 4; ++e) { g1[e] = a[e]; g1[4 + e] = b[e]; g2[e] = c[e]; g2[4 + e] = d[e]; } }
#pragma unroll
        for (int ai = 0; ai < 2; ++ai)
#pragma unroll
          for (int mp = 0; mp < 2; ++mp) {
            pg8::f32x4 tq[4][4];
            if (typ < 2) {
#pragma unroll
                for (int m = 2 * mp; m < 2 * mp + 2; ++m) { const int i_ = ai * 128 + wr * 64 + m * 16 + fr; const int pos_ = pm < 64 ? pm * 256 + i_ : PAST + (i_ & 63); const float* tp_ = tab + ((size_t)pos_ * 32 + 8 * fq) * 2;
#pragma unroll
                    for (int q4 = 0; q4 < 4; ++q4) tq[m][q4] = *(const pg8::f32x4*)(tp_ + 4 * q4); } }
#pragma unroll
            for (int m = 2 * mp; m < 2 * mp + 2; ++m) {
                const int i = ai * 128 + wr * 64 + m * 16 + fr; const size_t row = (size_t)pm * 256 + i;
                float x1[8], x2[8];
#pragma unroll
                for (int e = 0; e < 4; ++e) { x1[e] = acc[ai][0][m][0][e] * rs[ai][m]; x1[4 + e] = acc[ai][0][m][1][e] * rs[ai][m]; x2[e] = acc[ai][1][m][0][e] * rs[ai][m]; x2[4 + e] = acc[ai][1][m][1][e] * rs[ai][m]; }
                size_t drow; pg8::bf16_t* dk; pg8::bf16_t* dv; float* fk; float* fv;
                if (pm < 64) { drow = row; dk = KP; dv = VP; fk = okp + row * DM; fv = ovp + row * DM; }
                else { const int s_ = (int)(row - MP); drow = (size_t)(s_ >> 6) * KCROWS + PAST + (s_ & 63); dk = KC; dv = VC; fk = oks + (size_t)s_ * DM; fv = ovs + (size_t)s_ * DM; }
                if (typ < 2) {
                    float ss = 0.f;
#pragma unroll
                    for (int k = 0; k < 8; ++k) ss += x1[k] * x1[k] + x2[k] * x2[k];
                    ss += __shfl_xor(ss, 16); ss += __shfl_xor(ss, 32);
                    const float rstd = 1.f / sqrtf(ss * (1.f / 64.f) + EPS);
                    float o1[8], o2[8];
#pragma unroll
                    for (int q4 = 0; q4 < 4; ++q4) { const pg8::f32x4 t = tq[m][q4];
#pragma unroll
                        for (int z = 0; z < 2; ++z) { const int k = 2 * q4 + z; const float c = t[2 * z], s = t[2 * z + 1], y1 = x1[k] * rstd * g1[k], y2 = x2[k] * rstd * g2[k]; o1[k] = y1 * c - y2 * s; o2[k] = y2 * c + y1 * s; } }
                    if (typ == 0) { v4u w1, w2;
                        w1.x = pk2(o1[0] * C2, o1[1] * C2); w1.y = pk2(o1[2] * C2, o1[3] * C2); w1.z = pk2(o1[4] * C2, o1[5] * C2); w1.w = pk2(o1[6] * C2, o1[7] * C2);
                        w2.x = pk2(o2[0] * C2, o2[1] * C2); w2.y = pk2(o2[2] * C2, o2[3] * C2); w2.z = pk2(o2[4] * C2, o2[5] * C2); w2.w = pk2(o2[6] * C2, o2[7] * C2);
                        *(v4u*)(Qs + row * DM + cl) = w1; *(v4u*)(Qs + row * DM + cl + 32) = w2;
                    } else { v4u w1, w2;
                        w1.x = pk2(o1[0], o1[1]); w1.y = pk2(o1[2], o1[3]); w1.z = pk2(o1[4], o1[5]); w1.w = pk2(o1[6], o1[7]);
                        w2.x = pk2(o2[0], o2[1]); w2.y = pk2(o2[2], o2[3]); w2.z = pk2(o2[4], o2[5]); w2.w = pk2(o2[6], o2[7]);
                        *(v4u*)(dk + drow * DM + cl) = w1; *(v4u*)(dk + drow * DM + cl + 32) = w2;
                        NT_STORE(((pg8::f32x4){o1[0], o1[1], o1[2], o1[3]}), (pg8::f32x4*)(fk + cl)); NT_STORE(((pg8::f32x4){o1[4], o1[5], o1[6], o1[7]}), (pg8::f32x4*)(fk + cl + 4));
                        NT_STORE(((pg8::f32x4){o2[0], o2[1], o2[2], o2[3]}), (pg8::f32x4*)(fk + cl + 32)); NT_STORE(((pg8::f32x4){o2[4], o2[5], o2[6], o2[7]}), (pg8::f32x4*)(fk + cl + 36)); }
                } else { v4u w1, w2;
                    w1.x = pk2(x1[0], x1[1]); w1.y = pk2(x1[2], x1[3]); w1.z = pk2(x1[4], x1[5]); w1.w = pk2(x1[6], x1[7]);
                    w2.x = pk2(x2[0], x2[1]); w2.y = pk2(x2[2], x2[3]); w2.z = pk2(x2[4], x2[5]); w2.w = pk2(x2[6], x2[7]);
                    if (typ == 2) { *(v4u*)(dv + drow * DM + cl) = w1; *(v4u*)(dv + drow * DM + cl + 32) = w2;
                        NT_STORE(((pg8::f32x4){x1[0], x1[1], x1[2], x1[3]}), (pg8::f32x4*)(fv + cl)); NT_STORE(((pg8::f32x4){x1[4], x1[5], x1[6], x1[7]}), (pg8::f32x4*)(fv + cl + 4));
                        NT_STORE(((pg8::f32x4){x2[0], x2[1], x2[2], x2[3]}), (pg8::f32x4*)(fv + cl + 32)); NT_STORE(((pg8::f32x4){x2[4], x2[5], x2[6], x2[7]}), (pg8::f32x4*)(fv + cl + 36)); }
                    else { *(v4u*)(GA + row * DM + cl) = w1; *(v4u*)(GA + row * DM + cl + 32) = w2; }
                }
                if (m & 1) asm volatile("" ::: "memory");
            }
        }
    }
};
__device__ __forceinline__ void attn_table(Frame& F, float* tab) {
    const size_t gt = (size_t)F.bid * NTHR + F.tid, NG = (size_t)F.G * NTHR;
    for (size_t e = gt; e < (size_t)MP * 32; e += NG) { float c, s; rope_cs((int)(e >> 5), (int)(e & 31), 32, c, s); tab[2 * e] = c; tab[2 * e + 1] = s; }
}
namespace dattn {
typedef short bf16x8 __attribute__((ext_vector_type(8)));
typedef short s16x4 __attribute__((ext_vector_type(4)));
typedef short v4i16_t __attribute__((ext_vector_type(4)));
typedef float f32x16 __attribute__((ext_vector_type(16)));
typedef unsigned u32x4 __attribute__((ext_vector_type(4)));
typedef __attribute__((address_space(3))) const char* lds_cptr;
constexpr int RINGB = 98304, WSF_OFF = RINGB, XCHB = 18432, STP = 144;
__device__ __forceinline__ int crow(int r, int hi) { return (r & 3) + 8 * (r >> 2) + 4 * hi; }
__device__ __forceinline__ void glds16(const void* gsrc, unsigned lds_dst) { unsigned keep;
    asm volatile("s_mov_b32 %0, m0\n\ts_mov_b32 m0, %2\n\ts_nop 0\n\tglobal_load_lds_dwordx4 %1, off\n\ts_mov_b32 m0, %0" : "=&s"(keep) : "v"(gsrc), "s"(lds_dst) : "memory"); }
typedef float f32x2_t __attribute__((ext_vector_type(2))); typedef __bf16 bf16x2_t __attribute__((ext_vector_type(2)));
__device__ __forceinline__ unsigned cvtpk_s(float lo, float hi) { f32x2_t v = {lo, hi}; bf16x2_t b = __builtin_convertvector(v, bf16x2_t); return __builtin_bit_cast(unsigned, b); }
#define DA_WAIT_BAR(N) asm volatile("s_waitcnt vmcnt(" #N ") lgkmcnt(0)\n\ts_barrier" ::: "memory")
__device__ __forceinline__ s16x4 vtr(lds_cptr p) { return __builtin_bit_cast(s16x4, __builtin_amdgcn_ds_read_tr16_b64_v4i16((__attribute__((address_space(3))) v4i16_t*)p)); }
struct Unit { const bf16* Q; const bf16* K; const bf16* V; const bf16* G; bf16* AO; int NT; int full; int dma0; };

constexpr int KSLOT = 16384, VSLOT = 16384, VRING = 3 * KSLOT;
#define DA_SBAR() __builtin_amdgcn_sched_barrier(0)
#define DA_PIN(x) asm volatile("" : "+v"(x))
#define DA_MFMA(a, b, c) __builtin_amdgcn_mfma_f32_32x32x16_bf16(a, b, c, 0, 0, 0)
struct DmaJob { const bf16* kp; const bf16* vp; unsigned kd0, kd1, vd0, vd1; };
__device__ __forceinline__ void dma_piece(const DmaJob& j, int i) { if (i == 0) glds16(j.kp, j.kd0); else if (i == 1) glds16(j.kp + 64, j.kd1); else if (i == 2) glds16(j.vp, j.vd0); else glds16(j.vp + 64, j.vd1); }
template <bool QK, bool PV, int VAR>
__device__ __forceinline__ void step(lds_cptr kpn, lds_cptr vp, const bf16x8 (&qr)[4], bf16x8 (&kf)[8], f32x16 (&o)[4], u32x4 (&pw)[4], float& l_reg, const DmaJob& dj) {
    f32x16 C0 = f32x16{}, C1 = f32x16{};
    s16x4 vlo[4], vhi[4];
    if constexpr (!QK) { dma_piece(dj, 0); dma_piece(dj, 1); dma_piece(dj, 2); dma_piece(dj, 3); }
#define DA_FOFF(f) ((((f) & 3) * 4096) + (((f) >> 2) * 1024))
#pragma unroll
    for (int a = 0; a < 8; ++a) {
        if constexpr (PV) { if (a >= 4) { if (VAR != 4) { vlo[a - 4] = vtr(vp + DA_FOFF(a - 4)); vhi[a - 4] = vtr(vp + DA_FOFF(a - 4) + 512); } else { vlo[a - 4] = s16x4{1, 2, 3, 4}; vhi[a - 4] = s16x4{5, 6, 7, 8}; } DA_SBAR(); } }
        if constexpr (QK) {
            if (a & 1) C1 = (a < 2) ? DA_MFMA(kf[a], qr[a >> 1], f32x16{}) : DA_MFMA(kf[a], qr[a >> 1], C1);
            else       C0 = (a < 2) ? DA_MFMA(kf[a], qr[a >> 1], f32x16{}) : DA_MFMA(kf[a], qr[a >> 1], C0);
            if (a < 4) dma_piece(dj, a);
            DA_SBAR();
        }
    }
    u32x4 pwn[4]; pwn[0] = u32x4{}; pwn[1] = u32x4{}; pwn[2] = u32x4{}; pwn[3] = u32x4{};
    float s0 = 0.f, s1 = 0.f;
#pragma unroll
    for (int p = 0; p < 16; ++p) {
        if constexpr (PV) {
            const bf16x8 vf = (bf16x8){vlo[p & 3][0], vlo[p & 3][1], vlo[p & 3][2], vlo[p & 3][3], vhi[p & 3][0], vhi[p & 3][1], vhi[p & 3][2], vhi[p & 3][3]};
            if (VAR != 3) o[p & 3] = DA_MFMA(__builtin_bit_cast(bf16x8, pw[p >> 2]), vf, o[p & 3]); else { o[p & 3][0] += __builtin_bit_cast(float, (int)vf[0] | ((int)vf[4] << 16)); }
            if (p < 12 && VAR != 4) { vlo[p & 3] = vtr(vp + DA_FOFF(p + 4)); vhi[p & 3] = vtr(vp + DA_FOFF(p + 4) + 512); }
        }
        if constexpr (QK) {
            float e0, e1;
            if (VAR == 2) { if (p < 8) { e0 = C0[2 * p]; e1 = C0[2 * p + 1]; } else { e0 = C1[2 * p - 16]; e1 = C1[2 * p - 15]; } }
            else if (p < 8) { e0 = __builtin_amdgcn_exp2f(C0[2 * p]); e1 = __builtin_amdgcn_exp2f(C0[2 * p + 1]); }
            else       { e0 = __builtin_amdgcn_exp2f(C1[2 * p - 16]); e1 = __builtin_amdgcn_exp2f(C1[2 * p - 15]); }
            s0 += e0; s1 += e1; pwn[p >> 2][p & 3] = cvtpk_s(e0, e1);
            DA_PIN(s0); DA_PIN(s1); DA_PIN(pwn[p >> 2]);
            if (p >= 8 && VAR != 6) { const int j = p - 8; kf[j] = *(const __attribute__((address_space(3))) bf16x8*)(kpn + (j >> 1) * 2048 + (j & 1) * 512); }
        }
        DA_SBAR();
    }
    if constexpr (QK) { l_reg += s0 + s1; pw[0] = pwn[0]; pw[1] = pwn[1]; pw[2] = pwn[2]; pw[3] = pwn[3]; }
#undef DA_FOFF
}

template <bool QK, bool PV>
__device__ __forceinline__ void step2(lds_cptr kpn, lds_cptr vp, const bf16x8 (&qr)[4], bf16x8 (&kf)[8], f32x16 (&o)[4], u32x4 (&pw)[4], float& l_reg, const DmaJob& dj,
                                      f32x16& Cn0, f32x16& Cn1, const f32x16& Pp0, const f32x16& Pp1) {
    s16x4 vlo[4], vhi[4];
#define DA_FOFF(f) ((((f) & 3) * 4096) + (((f) >> 2) * 1024))
    if constexpr (!QK) { dma_piece(dj, 0); dma_piece(dj, 1); dma_piece(dj, 2); dma_piece(dj, 3); }
    float s0 = 0.f, s1 = 0.f;
#pragma unroll
    for (int a = 0; a < 8; ++a) {
        if constexpr (PV) { if (a >= 4) { vlo[a - 4] = vtr(vp + DA_FOFF(a - 4)); vhi[a - 4] = vtr(vp + DA_FOFF(a - 4) + 512); DA_SBAR(); } }
        if constexpr (QK) {
            if (a & 1) Cn1 = (a < 2) ? DA_MFMA(kf[a], qr[a >> 1], f32x16{}) : DA_MFMA(kf[a], qr[a >> 1], Cn1);
            else       Cn0 = (a < 2) ? DA_MFMA(kf[a], qr[a >> 1], f32x16{}) : DA_MFMA(kf[a], qr[a >> 1], Cn0);
            if (a < 4) dma_piece(dj, a);
        }
        if constexpr (PV) {
            float x0, x1, x2, x3;
            if (a < 4) { x0 = Pp0[4 * a]; x1 = Pp0[4 * a + 1]; x2 = Pp0[4 * a + 2]; x3 = Pp0[4 * a + 3]; }
            else       { x0 = Pp1[4 * a - 16]; x1 = Pp1[4 * a - 15]; x2 = Pp1[4 * a - 14]; x3 = Pp1[4 * a - 13]; }
            s0 += x0; s1 += x1; s0 += x2; s1 += x3;
            pw[(2 * a) >> 2][(2 * a) & 3] = cvtpk_s(x0, x1); pw[(2 * a + 1) >> 2][(2 * a + 1) & 3] = cvtpk_s(x2, x3);
            DA_PIN(s0); DA_PIN(s1); DA_PIN(pw[(2 * a) >> 2]);
        }
        if constexpr (QK || PV) DA_SBAR();
    }
    if constexpr (PV) l_reg += s0 + s1;
#pragma unroll
    for (int p = 0; p < 16; ++p) {
        if constexpr (PV) {
            const bf16x8 vf = (bf16x8){vlo[p & 3][0], vlo[p & 3][1], vlo[p & 3][2], vlo[p & 3][3], vhi[p & 3][0], vhi[p & 3][1], vhi[p & 3][2], vhi[p & 3][3]};
            o[p & 3] = DA_MFMA(__builtin_bit_cast(bf16x8, pw[p >> 2]), vf, o[p & 3]);
            if (p < 12) { vlo[p & 3] = vtr(vp + DA_FOFF(p + 4)); vhi[p & 3] = vtr(vp + DA_FOFF(p + 4) + 512); }
        }
        if constexpr (QK) {
            if (p < 8) { Cn0[2 * p] = __builtin_amdgcn_exp2f(Cn0[2 * p]); Cn0[2 * p + 1] = __builtin_amdgcn_exp2f(Cn0[2 * p + 1]); DA_PIN(Cn0); }
            else       { Cn1[2 * p - 16] = __builtin_amdgcn_exp2f(Cn1[2 * p - 16]); Cn1[2 * p - 15] = __builtin_amdgcn_exp2f(Cn1[2 * p - 15]); DA_PIN(Cn1); }
            if (p >= 8) { const int j = p - 8; kf[j] = *(const __attribute__((address_space(3))) bf16x8*)(kpn + (j >> 1) * 2048 + (j & 1) * 512); }
        }
        if constexpr (QK || PV) DA_SBAR();
    }
#undef DA_FOFF
}

__device__ __forceinline__ void unit_prologue(const Unit& u, unsigned lds0, int lane, int wid, bf16x8 (&qr)[4]) {
    const int r32 = lane & 31, hi = lane >> 5, s = wid >> 2, g = wid & 3; const int NT = u.NT; const int wt = u.full ? (g < 2 ? NT - 1 : NT) : (g < 2 ? NT : 0);
    const bf16* ksrc = u.K + (long)lane * DM + wid * 8;
    const bf16* vsrc = u.V + (long)(16 * (wid & 3) + (lane >> 2)) * DM + (wid >> 2) * 32 + (lane & 3) * 8;
    const unsigned kdst = lds0 + wid * 1024, vdst = lds0 + VRING + wid * 1024;
#pragma unroll
    for (int t = 0; t < 3; ++t) { const int tt_ = t < NT ? t : NT - 1; const bf16* kp_ = ksrc + (long)tt_ * 64 * DM;
        glds16(kp_, (unsigned)__builtin_amdgcn_readfirstlane(kdst + t * KSLOT)); glds16(kp_ + 64, (unsigned)__builtin_amdgcn_readfirstlane(kdst + 8192 + t * KSLOT)); }
    glds16(vsrc, (unsigned)__builtin_amdgcn_readfirstlane(vdst)); glds16(vsrc + 64, (unsigned)__builtin_amdgcn_readfirstlane(vdst + 8192));
    const bf16* Qw = u.Q + (long)(32 * g + r32) * DM + s * 64;
#pragma unroll
    for (int d0 = 0; d0 < 4; ++d0) qr[d0] = (wt > 0) ? *reinterpret_cast<const bf16x8*>(Qw + d0 * 16 + hi * 8) : (bf16x8){0, 0, 0, 0, 0, 0, 0, 0};
}
template <int VAR>
__device__ __forceinline__ void attn_unit(const Unit& u, bool has_next, const Unit& nxt, bool prefetched, bf16x8 (&qr)[4], char* shm, float* wsf_base, float lam, float one_m_li, const float* sub_gain, int tid) {
    asm volatile("" : "+v"(tid));
    const int lane = tid & 63, r32 = lane & 31, hi = lane >> 5; const int wid = __builtin_amdgcn_readfirstlane(tid >> 6), s = wid >> 2, g = wid & 3;
    const int NT = u.NT; const int wt = u.full ? (g < 2 ? NT - 1 : NT) : (g < 2 ? NT : 0);
    const unsigned lds0 = (unsigned)(uintptr_t)shm;
    float* wsf = wsf_base + wid * 64;
    const bf16* ksrc = u.K + (long)lane * DM + wid * 8;
    const bf16* vsrc = u.V + (long)(16 * (wid & 3) + (lane >> 2)) * DM + (wid >> 2) * 32 + (lane & 3) * 8;
    const unsigned kdst = lds0 + wid * 1024, vdst = lds0 + VRING + wid * 1024;
#define DA_DMA_K(t, slot) do { const int tt_ = u.dma0 ? 0 : (t) < NT ? (t) : NT - 1; const bf16* kp_ = ksrc + (long)tt_ * 64 * DM; \
        glds16(kp_, (unsigned)__builtin_amdgcn_readfirstlane(kdst + (slot) * KSLOT)); glds16(kp_ + 64, (unsigned)__builtin_amdgcn_readfirstlane(kdst + 8192 + (slot) * KSLOT)); } while (0)
#define DA_DMA_V(t, slot) do { const int tt_ = u.dma0 ? 0 : (t) < NT ? (t) : NT - 1; const bf16* vp_ = vsrc + (long)tt_ * 64 * DM; \
        glds16(vp_, (unsigned)__builtin_amdgcn_readfirstlane(vdst + (slot) * VSLOT)); glds16(vp_ + 64, (unsigned)__builtin_amdgcn_readfirstlane(vdst + 8192 + (slot) * VSLOT)); } while (0)
    const lds_cptr shm3 = (lds_cptr)shm;
    const lds_cptr kp0 = shm3 + s * 8192 + hi * 1024 + r32 * 16;
    const lds_cptr vp0 = shm3 + VRING + ((lane >> 4) & 1) * 32 + (lane & 3) * 8 + (4 * hi + ((lane & 15) >> 2)) * 64;
    if (!prefetched) unit_prologue(u, lds0, lane, wid, qr);
    asm volatile("" : "+v"(qr[0]), "+v"(qr[1]), "+v"(qr[2]), "+v"(qr[3]));
    f32x16 o[4]; o[0] = f32x16{}; o[1] = f32x16{}; o[2] = f32x16{}; o[3] = f32x16{};
    float l_reg = 0.f;
    u32x4 pw[4]; pw[0] = u32x4{}; pw[1] = u32x4{}; pw[2] = u32x4{}; pw[3] = u32x4{};
    DA_WAIT_BAR(0);
    bf16x8 kf[8];
#pragma unroll
    for (int j = 0; j < 8; ++j) kf[j] = *(const __attribute__((address_space(3))) bf16x8*)(kp0 + (j >> 1) * 2048 + (j & 1) * 512);
    int ks_cur = 0  , vs_prev = 2  ;
#define DA_TOP(t) \
        DA_WAIT_BAR(4);                                          \
        const int ks_next = (ks_cur == 2) ? 0 : ks_cur + 1, vs_cur = (vs_prev == 2) ? 0 : vs_prev + 1, vs_next = (vs_cur == 2) ? 0 : vs_cur + 1; \
        DmaJob dj; { const int tk_ = ((t) + 3) < NT ? ((t) + 3) : NT - 1, tv_ = ((t) + 1) < NT ? ((t) + 1) : NT - 1; dj.kp = ksrc + (long)tk_ * 64 * DM; dj.vp = vsrc + (long)tv_ * 64 * DM; \
          dj.kd0 = (unsigned)__builtin_amdgcn_readfirstlane(kdst + ks_cur * KSLOT); dj.kd1 = dj.kd0 + 8192u; dj.vd0 = (unsigned)__builtin_amdgcn_readfirstlane(vdst + vs_next * VSLOT); dj.vd1 = dj.vd0 + 8192u; }     \
        const lds_cptr kpn = kp0 + ks_next * KSLOT; const lds_cptr vp = vp0 + vs_prev * VSLOT; (void)kpn; (void)vp
#define DA_ROT() do { ks_cur = ks_next; vs_prev = vs_cur; } while (0)
    f32x16 pA0 = f32x16{}, pA1 = f32x16{}, pB0 = f32x16{}, pB1 = f32x16{};
#define DA_IDLE() do { dma_piece(dj, 0); dma_piece(dj, 1); dma_piece(dj, 2); dma_piece(dj, 3); } while (0)
    if (wid >= 4) __builtin_amdgcn_s_setprio(1);
    int t = 0;
    const bool odd = ((wt - 1) & 1) != 0;
    { DA_TOP(0); if (wt > 0) { if (odd) step2<true, false>(kpn, vp, qr, kf, o, pw, l_reg, dj, pB0, pB1, pA0, pA1); else step2<true, false>(kpn, vp, qr, kf, o, pw, l_reg, dj, pA0, pA1, pB0, pB1); } else DA_IDLE(); DA_ROT(); }
    t = 1;
    if (wt > 0 && odd) { DA_TOP(t); step2<true, true>(kpn, vp, qr, kf, o, pw, l_reg, dj, pA0, pA1, pB0, pB1); DA_ROT(); ++t; }
    for (; t + 1 < wt; t += 2) {
        { DA_TOP(t);     step2<true, true>(kpn, vp, qr, kf, o, pw, l_reg, dj, pB0, pB1, pA0, pA1); DA_ROT(); }
        { DA_TOP(t + 1); step2<true, true>(kpn, vp, qr, kf, o, pw, l_reg, dj, pA0, pA1, pB0, pB1); DA_ROT(); }
    }
    if (wt > 0) { DA_TOP(t); step2<false, true>(kpn, vp, qr, kf, o, pw, l_reg, dj, pB0, pB1, pA0, pA1); DA_ROT(); ++t; }
    for (; t <= NT; ++t) { DA_TOP(t); DA_IDLE(); DA_ROT(); }
#undef DA_IDLE
#undef DA_TOP
#undef DA_ROT
    __builtin_amdgcn_s_setprio(0);
    { auto rr = __builtin_amdgcn_permlane32_swap(__float_as_uint(l_reg), __float_as_uint(l_reg), false, false); l_reg = __uint_as_float(rr[0]) + __uint_as_float(rr[1]); }
    if (hi == 0) wsf[r32] = l_reg;
    DA_WAIT_BAR(0);
    if (has_next) unit_prologue(nxt, lds0, lane, wid, qr);
    int le = lane; asm volatile("" : "+v"(le));
    const int r32e = le & 31, hie = le >> 5;
    v4u g4r[8]; f32x4 sga[8], sgb[8];
    if (s == 0 && wt > 0) { const bf16* gp_ = u.G + (long)(32 * g + (le >> 1)) * DM + (le & 1) * 64; const float* sg_ = sub_gain + (le & 1) * 64;
#pragma unroll
        for (int k = 0; k < 8; ++k) { g4r[k] = *(const v4u*)(gp_ + 8 * k); sga[k] = *(const f32x4*)(sg_ + 8 * k); sgb[k] = *(const f32x4*)(sg_ + 8 * k + 4); } }
    float rli[16];
#pragma unroll
    for (int r = 0; r < 16; ++r) { const float lq = wsf[crow(r, hi)]; rli[r] = (s == 0 ? 1.f : -lam) / lq; }
    float* xch = (float*)(shm + 65536 + g * XCHB);
    if (s == 1 && wt > 0) {
#pragma unroll
        for (int db = 0; db < 4; ++db)
#pragma unroll
            for (int r = 0; r < 16; ++r) xch[(db * 16 + r) * 64 + le] = o[db][r] * rli[r];
    }
    asm volatile("s_waitcnt lgkmcnt(0)\n\ts_barrier" ::: "memory");
    if (s == 0 && wt > 0) {
#pragma unroll
        for (int db = 0; db < 4; ++db)
#pragma unroll
            for (int r = 0; r < 16; ++r) o[db][r] = o[db][r] * rli[r] + xch[(db * 16 + r) * 64 + le];
        asm volatile("s_waitcnt lgkmcnt(0)" ::: "memory");
#pragma unroll
        for (int db = 0; db < 4; ++db)
#pragma unroll
            for (int r = 0; r < 16; ++r) xch[crow(r, hie) * STP + 32 * db + r32e] = o[db][r];
        asm volatile("s_waitcnt lgkmcnt(0)" ::: "memory");
        const int row = le >> 1, half = le & 1;
        float v[64]; float ss = 0.f;
#pragma unroll
        for (int k = 0; k < 16; ++k) { const f32x4 x = *(const f32x4*)(xch + row * STP + half * 64 + 4 * k); v[4 * k] = x.x; v[4 * k + 1] = x.y; v[4 * k + 2] = x.z; v[4 * k + 3] = x.w; ss += (x.x * x.x + x.y * x.y) + (x.z * x.z + x.w * x.w); }
        ss += __shfl_xor(ss, 1);
        const float sc = one_m_li / sqrtf(ss * (1.f / 128.f) + EPS);
        bf16* op = u.AO + (long)(32 * g + row) * DM + half * 64;
#pragma unroll
        for (int k = 0; k < 8; ++k) { const v4u g4 = g4r[k]; const f32x4 ga = sga[k], gb = sgb[k];
            const float gg[8] = {bflo(g4.x), bfhi(g4.x), bflo(g4.y), bfhi(g4.y), bflo(g4.z), bfhi(g4.z), bflo(g4.w), bfhi(g4.w)};
            const float gn[8] = {ga.x, ga.y, ga.z, ga.w, gb.x, gb.y, gb.z, gb.w}; float y[8];
#pragma unroll
            for (int e = 0; e < 8; ++e) y[e] = v[8 * k + e] * sc * gn[e] * silu_f(gg[e]);
            v4u w; w.x = pk2(y[0], y[1]); w.y = pk2(y[2], y[3]); w.z = pk2(y[4], y[5]); w.w = pk2(y[6], y[7]);
            *(v4u*)(op + 8 * k) = w; }
    }
#undef DA_DMA_K
#undef DA_DMA_V
}
}
template <int VAR = 0>
__device__ __forceinline__ void attn_fast(Frame& F, const bf16* Qs, const bf16* KP, const bf16* VP, const bf16* KC, const bf16* VC, const bf16* GA  , bf16* AO,
                                          float lam, float one_m_li, const float* sub_gain, int dma0 = 0) {
    const int NU = 2048 + 16 * NB;
    const bool xcd = (F.G == 256);
#define ATTN_GET(i_, u_, ok_) do { int qb = 0, h = 0, b = -1; ok_ = true; \
        if (xcd) { const int x = F.bid & 7, r = F.bid >> 3; \
            if ((i_) < 8) { h = x + 8 * ((i_) >> 2); const int rr = ((i_) == 0) ? (r ^ 8) : r; qb = 127 - (((i_) & 3) * 32 + (((i_) & 1) ? 31 - rr : rr)); } \
            else if ((i_) == 8 && (r & 8) == 0) { const int sb = (r & 7) + ((r >> 4) << 3); h = x + 8 * (sb >> 3); b = sb & 7; } \
            else ok_ = false; \
        } else { const int idx = (i_) * F.G + (((i_) & 1) ? F.G - 1 - F.bid : F.bid); if (idx >= NU) ok_ = false; \
            else if (idx < 2048) { qb = 127 - (idx >> 4); h = idx & 15; } else { const int j = idx - 2048; b = j >> 4; h = j & 15; } } \
        u_.dma0 = 0; \
        if (ok_) { if (b < 0) { const long row0 = 128L * qb; \
            u_.Q = Qs + row0 * DM + h * 128; u_.K = KP + h * 128; u_.V = VP + h * 128; u_.G = GA + row0 * DM + h * 128; u_.AO = AO + row0 * DM + h * 128; u_.NT = 2 * qb + 2; u_.full = 1; } \
          else { const long row0 = MP + 64L * b; \
            u_.Q = Qs + row0 * DM + h * 128; u_.K = KC + (long)b * KCROWS * DM + h * 128; u_.V = VC + (long)b * KCROWS * DM + h * 128; u_.G = GA + row0 * DM + h * 128; u_.AO = AO + row0 * DM + h * 128; u_.NT = KCROWS / 64; u_.full = 0; } } } while (0)
    dattn::Unit u, nx; bool have; ATTN_GET(0, u, have);
    dattn::bf16x8 qr[4]; bool pre = false;
    float* wsf_base = (float*)((char*)F.lds + MISC_OFF + 1024);
    for (int i = 0; have; ++i) {
        bool hn; ATTN_GET(i + 1, nx, hn);
        dattn::attn_unit<VAR>(u, hn, nx, pre, qr, (char*)F.lds + RING_OFF, wsf_base, lam, one_m_li, sub_gain, F.tid);
        u = nx; have = hn; pre = true;
    }
    __syncthreads();
#undef ATTN_GET
}
constexpr int RBLK = 72;
__device__ __forceinline__ float ret_lg2(int h) { return log2f(1.f - exp2f(-5.f - (float)h)); }
struct EpiRet {
    static constexpr int BMODE = 0;
    pg8::bf16_t* QP; pg8::bf16_t* KN; pg8::bf16_t* KT; pg8::bf16_t* VS; pg8::bf16_t* RG; const float* tab; const float* ssq;
    __device__ __forceinline__ void operator()(const pg8::f32x4 (&acc)[2][2][4][2], const pg8::Unit& u, int wr, int wc, int fr, int fq) const {
        { const int l_ = lane_now(); fr = l_ & 15; fq = l_ >> 4; }
        const int pn = u.pn, pm = u.pm; float rs[2][4]; row_rstd(ssq, pm, wr, fr, fq, rs);
#pragma unroll
        for (int ai = 0; ai < 2; ++ai)
#pragma unroll
            for (int m = 0; m < 4; ++m) {
                const int i = ai * 128 + wr * 64 + m * 16 + fr; const size_t row = (size_t)pm * 256 + i;
                const int J = pm < 64 ? pm : 64 + 4 * (pm - 64) + (i >> 6), jj = pm < 64 ? i : (i & 63), pos = pm < 64 ? (int)row : PAST + (i & 63);
                if (pn < 16) {
                    const int h = pn & 7; const bool isk = pn >= 8; const float sc = isk ? 0.0625f : 1.f;
#pragma unroll
                    for (int n = 0; n < 2; ++n) { const int c1 = wc * 32 + n * 16 + 4 * fq;
                        const pg8::f32x4 t0 = *(const pg8::f32x4*)(tab + ((size_t)pos * 128 + c1) * 2), t1 = *(const pg8::f32x4*)(tab + ((size_t)pos * 128 + c1) * 2 + 4);
                        const pg8::f32x4 x1 = acc[ai][0][m][n] * rs[ai][m], x2 = acc[ai][1][m][n] * rs[ai][m];
                        const float cs[4] = {t0[0], t0[2], t1[0], t1[2]}, sn[4] = {t0[1], t0[3], t1[1], t1[3]}; float o1[4], o2[4];
#pragma unroll
                        for (int e = 0; e < 4; ++e) { o1[e] = (x1[e] * cs[e] - x2[e] * sn[e]) * sc; o2[e] = (x2[e] * cs[e] + x1[e] * sn[e]) * sc; }
                        v2u w1, w2; w1.x = pk2(o1[0], o1[1]); w1.y = pk2(o1[2], o1[3]); w2.x = pk2(o2[0], o2[1]); w2.y = pk2(o2[2], o2[3]);
                        if (!isk) { pg8::bf16_t* p = QP + row * 4096 + h * 512 + 256 + c1; *(v2u*)p = w1; *(v2u*)(p + 128) = w2; }
                        else { pg8::bf16_t* p = KN + row * 2048 + h * 256 + c1; *(v2u*)p = w1; *(v2u*)(p + 128) = w2;
                            pg8::bf16_t* t = KT + ((size_t)(J * 8 + h) * 256 + c1) * 256 + jj;
#pragma unroll
                            for (int e = 0; e < 4; ++e) { t[(size_t)e * 256] = (pg8::bf16_t)f2bf(o1[e]); t[(size_t)(128 + e) * 256] = (pg8::bf16_t)f2bf(o2[e]); } } }
                } else if (pn < 32) {
                    const int h = (pn - 16) >> 1, half = (pn - 16) & 1; const float f = exp2f(-(float)(1 + jj) * ret_lg2(h)) * rs[ai][m];
#pragma unroll
                    for (int bj = 0; bj < 2; ++bj)
#pragma unroll
                        for (int n = 0; n < 2; ++n) { const int dv = half * 256 + bj * 128 + wc * 32 + n * 16 + 4 * fq; pg8::bf16_t* t = VS + ((size_t)(J * 8 + h) * 512 + dv) * 512 + jj;
#pragma unroll
                            for (int e = 0; e < 4; ++e) t[(size_t)e * 512] = (pg8::bf16_t)f2bf(acc[ai][bj][m][n][e] * f); }
                } else {
#pragma unroll
                    for (int bj = 0; bj < 2; ++bj)
#pragma unroll
                        for (int n = 0; n < 2; ++n) { const int c = (pn - 32) * 256 + bj * 128 + wc * 32 + n * 16 + 4 * fq; const pg8::f32x4 x = acc[ai][bj][m][n] * rs[ai][m];
                            v2u w; w.x = pk2(x[0], x[1]); w.y = pk2(x[2], x[3]); *(v2u*)(RG + row * 4096 + c) = w; }
                }
            }
    }
};
__device__ __forceinline__ size_t ret_row0(int J) { return J < 64 ? (size_t)256 * J : (size_t)MP + 64 * (J - 64); }
struct RetQKOrder {
    int G, c; const char* QP; const char* KN;
    __device__ __forceinline__ bool next(int i, pg8::Unit& u) const { const int L = i * G + c; if (L >= RBLK * 8) return false; const int J = L >> 3, h = L & 7; const size_t r0 = ret_row0(J);
        u.pm = J; u.pn = h; u.a = QP + (r0 * 4096 + h * 512 + 256) * 2; u.b = KN + (r0 * 2048 + h * 256) * 2; return true; }
    __device__ __forceinline__ void a_ready(const pg8::Unit&) const {}
    __device__ __forceinline__ void done(const pg8::Unit&) const {}
};
struct EpiRetQK {
    static constexpr int BMODE = 1;
    pg8::bf16_t* QP;
    __device__ __forceinline__ void operator()(const pg8::f32x4 (&acc)[2][2][4][2], const pg8::Unit& u, int wr, int wc, int fr, int fq) const {
        { const int l_ = lane_now(); fr = l_ & 15; fq = l_ >> 4; }
        const int J = u.pm, h = u.pn, nv = J < 64 ? 256 : 64; const size_t r0 = ret_row0(J);
#pragma unroll
        for (int ai = 0; ai < 2; ++ai)
#pragma unroll
            for (int m = 0; m < 4; ++m) { const int i = ai * 128 + wr * 64 + m * 16 + fr;
                if (i < nv) {
#pragma unroll
                    for (int bj = 0; bj < 2; ++bj) { const int j0 = bj * 128 + wc * 32 + 8 * fq; const pg8::f32x4 v0 = acc[ai][bj][m][0], v1 = acc[ai][bj][m][1]; float x[8] = {v0[0], v0[1], v0[2], v0[3], v1[0], v1[1], v1[2], v1[3]};
#pragma unroll
                        for (int k = 0; k < 8; ++k) x[k] = (j0 + k <= i) ? x[k] : 0.f;
                        v4u w; w.x = pk2(x[0], x[1]); w.y = pk2(x[2], x[3]); w.z = pk2(x[4], x[5]); w.w = pk2(x[6], x[7]);
                        *(v4u*)(QP + (r0 + i) * 4096 + h * 512 + j0) = w; } } }
    }
};
struct RetOOrder {
    int G, c; const char* QP; const char* VS;
    __device__ __forceinline__ bool next(int i, pg8::Unit& u) const { const int L = i * G + c; if (L >= RBLK * 16) return false; const int J = L >> 4, r = L & 15, h = r >> 1, half = r & 1; const size_t r0 = ret_row0(J);
        u.pm = J; u.pn = r; u.a = QP + (r0 * 4096 + h * 512) * 2; u.b = VS + (((size_t)(J * 8 + h) * 512 + half * 256) * 512) * 2; return true; }
    __device__ __forceinline__ void a_ready(const pg8::Unit&) const {}
    __device__ __forceinline__ void done(const pg8::Unit&) const {}
};
struct EpiRetO {
    static constexpr int BMODE = 1;
    pg8::bf16_t* O;
    __device__ __forceinline__ void operator()(const pg8::f32x4 (&acc)[2][2][4][2], const pg8::Unit& u, int wr, int wc, int fr, int fq) const {
        { const int l_ = lane_now(); fr = l_ & 15; fq = l_ >> 4; }
        const int J = u.pm, h = u.pn >> 1, half = u.pn & 1, nv = J < 64 ? 256 : 64; const size_t r0 = ret_row0(J); const float lg = ret_lg2(h);
#pragma unroll
        for (int ai = 0; ai < 2; ++ai)
#pragma unroll
            for (int m = 0; m < 4; ++m) { const int i = ai * 128 + wr * 64 + m * 16 + fr;
                if (i < nv) { const float f = exp2f((float)(i + 1) * lg);
#pragma unroll
                    for (int bj = 0; bj < 2; ++bj) { const int j0 = bj * 128 + wc * 32 + 8 * fq; const pg8::f32x4 v0 = acc[ai][bj][m][0] * f, v1 = acc[ai][bj][m][1] * f;
                        v4u w; w.x = pk2(v0[0], v0[1]); w.y = pk2(v0[2], v0[3]); w.z = pk2(v1[0], v1[1]); w.w = pk2(v1[2], v1[3]);
                        *(v4u*)(O + (r0 + i) * 4096 + h * 512 + half * 256 + j0) = w; } } }
    }
};
struct RetKVOrder {
    int G, c; const char* VS; const char* KT;
    __device__ __forceinline__ bool next(int i, pg8::Unit& u) const { const int L = i * G + c; if (L >= RBLK * 16) return false; const int J = L >> 4, r = L & 15, h = r >> 1, half = r & 1;
        u.pm = J; u.pn = r; u.a = VS + (((size_t)(J * 8 + h) * 512 + half * 256) * 512) * 2; u.b = KT + ((size_t)(J * 8 + h) * 256 * 256) * 2; return true; }
    __device__ __forceinline__ void a_ready(const pg8::Unit&) const {}
    __device__ __forceinline__ void done(const pg8::Unit&) const {}
};
struct EpiRetKV {
    static constexpr int BMODE = 1;
    pg8::bf16_t* VS; pg8::bf16_t* KVX;
    __device__ __forceinline__ void operator()(const pg8::f32x4 (&acc)[2][2][4][2], const pg8::Unit& u, int wr, int wc, int fr, int fq) const {
        { const int l_ = lane_now(); fr = l_ & 15; fq = l_ >> 4; }
        const int J = u.pm, h = u.pn >> 1, half = u.pn & 1;
        pg8::bf16_t* base; int pitch;
        if (J < 63) { base = VS + ((size_t)((J + 1) * 8 + h) * 512 + half * 256) * 512 + 256; pitch = 512; }
        else { base = KVX + ((size_t)((J - 63) * 8 + h) * 512 + half * 256) * 256; pitch = 256; }
#pragma unroll
        for (int ai = 0; ai < 2; ++ai)
#pragma unroll
            for (int m = 0; m < 4; ++m) { pg8::bf16_t* rowp = base + (size_t)(ai * 128 + wr * 64 + m * 16 + fr) * pitch + wc * 32 + 8 * fq;
#pragma unroll
                for (int bj = 0; bj < 2; ++bj) { const pg8::f32x4 v0 = acc[ai][bj][m][0], v1 = acc[ai][bj][m][1];
                    v4u w; w.x = pk2(v0[0], v0[1]); w.y = pk2(v0[2], v0[3]); w.z = pk2(v1[0], v1[1]); w.w = pk2(v1[2], v1[3]);
                    *(v4u*)(rowp + bj * 128) = w; } }
    }
};
__device__ __forceinline__ void ret_scan(Frame& F, bf16* VS, const bf16* KVX, const float* state_in, float* osp, float* oss) {
    const int gt = F.bid * NTHR + F.tid;
    for (int c = gt; c < 8 * 512 * 32; c += F.G * NTHR) {
        const int h = c >> 14, dv = (c >> 5) & 511, dk0 = (c & 31) * 8; const float lg = ret_lg2(h), g256 = exp2f(256.f * lg), g64 = exp2f(64.f * lg);
        float S[8];
#pragma unroll
        for (int k = 0; k < 8; ++k) S[k] = 0.f;
        bf16* slot = VS + ((size_t)h * 512 + dv) * 512 + 256 + dk0;
        *(v4u*)slot = (v4u){0u, 0u, 0u, 0u};
        constexpr size_t SJ = (size_t)8 * 512 * 512;
        v4u nx[4];
#pragma unroll
        for (int q = 0; q < 4; ++q) nx[q] = *(const v4u*)(slot + (size_t)(1 + q) * SJ);
        for (int J0 = 1; J0 < 64; J0 += 4) {
            v4u cur[4];
#pragma unroll
            for (int q = 0; q < 4; ++q) cur[q] = nx[q];
            if (J0 + 4 < 64) {
#pragma unroll
                for (int q = 0; q < 4; ++q) { const int Jn = J0 + 4 + q; nx[q] = *(const v4u*)(slot + (size_t)(Jn < 64 ? Jn : 63) * SJ); } }
#pragma unroll
            for (int q = 0; q < 4; ++q) { const int J = J0 + q;
                if (J < 64) { const v4u kv = cur[q]; bf16* sj = slot + (size_t)J * SJ;
                    const float x[8] = {bflo(kv.x), bfhi(kv.x), bflo(kv.y), bfhi(kv.y), bflo(kv.z), bfhi(kv.z), bflo(kv.w), bfhi(kv.w)};
#pragma unroll
                    for (int k = 0; k < 8; ++k) S[k] = (S[k] + x[k]) * g256;
                    v4u w; w.x = pk2(S[0], S[1]); w.y = pk2(S[2], S[3]); w.z = pk2(S[4], S[5]); w.w = pk2(S[6], S[7]);
                    *(v4u*)sj = w; } }
        }
        { const v4u kv = *(const v4u*)(KVX + ((size_t)h * 512 + dv) * 256 + dk0);
          const float x[8] = {bflo(kv.x), bfhi(kv.x), bflo(kv.y), bfhi(kv.y), bflo(kv.z), bfhi(kv.z), bflo(kv.w), bfhi(kv.w)};
#pragma unroll
          for (int k = 0; k < 8; ++k) NT_STORE((S[k] + x[k]) * g256, osp + ((size_t)h * 256 + dk0 + k) * 512 + dv); }
    }
    for (int c = gt; c < NB * 8 * 512 * 32; c += F.G * NTHR) {
        const int dv = c & 511, dk0 = ((c >> 9) & 31) * 8, h = (c >> 14) & 7, b = c >> 17; const float g64 = exp2f(64.f * ret_lg2(h));
        const float* si = state_in + (((size_t)b * 8 + h) * 256 + dk0) * 512 + dv; float* so = oss + (((size_t)b * 8 + h) * 256 + dk0) * 512 + dv;
        const v4u kv = *(const v4u*)(KVX + ((size_t)((1 + b) * 8 + h) * 512 + dv) * 256 + dk0);
        const float x[8] = {bflo(kv.x), bfhi(kv.x), bflo(kv.y), bfhi(kv.y), bflo(kv.z), bfhi(kv.z), bflo(kv.w), bfhi(kv.w)}; float s0[8];
#pragma unroll
        for (int k = 0; k < 8; ++k) s0[k] = NT_LOAD(si + (size_t)k * 512);
        v4u w; w.x = pk2(s0[0], s0[1]); w.y = pk2(s0[2], s0[3]); w.z = pk2(s0[4], s0[5]); w.w = pk2(s0[6], s0[7]);
        *(v4u*)(VS + ((size_t)((64 + b) * 8 + h) * 512 + dv) * 512 + 256 + dk0) = w;
#pragma unroll
        for (int k = 0; k < 8; ++k) NT_STORE((s0[k] + x[k]) * g64, so + (size_t)k * 512);
    }
}
__device__ __forceinline__ void ret_zero_pad(Frame& F, bf16* VS, bf16* KT) {
    const size_t gt = (size_t)F.bid * NTHR + F.tid, NG = (size_t)F.G * NTHR, n = (size_t)NB * 8 * 512 * 24, n2 = (size_t)NB * 8 * 256 * 24;
    for (size_t i = gt; i < n; i += NG) { const size_t rowi = i / 24, c = i % 24; *(v4u*)(VS + ((size_t)64 * 8 * 512 + rowi) * 512 + 64 + c * 8) = (v4u){0u, 0u, 0u, 0u}; }
    for (size_t i = gt; i < n2; i += NG) { const size_t rowi = i / 24, c = i % 24; *(v4u*)(KT + ((size_t)64 * 8 * 256 + rowi) * 256 + 64 + c * 8) = (v4u){0u, 0u, 0u, 0u}; }
}
__device__ __forceinline__ void ret_table(Frame& F, float* tab) {
    const size_t gt = (size_t)F.bid * NTHR + F.tid, NG = (size_t)F.G * NTHR;
    for (size_t e = gt; e < (size_t)MP * 128; e += NG) { float c, s; rope_cs((int)(e >> 7), (int)(e & 127), 128, c, s); tab[2 * e] = c; tab[2 * e + 1] = s; }
}
__device__ __forceinline__ void r_out(Frame& F, bf16* O, const bf16* RG) {
    const int gw = F.bid * NWAVES + F.wave, NGW = F.G * NWAVES, lane = F.lane;
    constexpr int U = 6;
    for (int it0 = gw; it0 < MT * 8; it0 += U * NGW) {
        v4u o4[U], g4[U]; size_t off[U]; bool ok[U];
#pragma unroll
        for (int j = 0; j < U; ++j) { const int it = it0 + j * NGW; ok[j] = it < MT * 8; const int itc = ok[j] ? it : gw; off[j] = (size_t)(itc >> 3) * 4096 + (itc & 7) * 512 + lane * 8;
            o4[j] = *(const v4u*)(O + off[j]); g4[j] = NT_LOAD((const v4u*)(RG + off[j])); }
#pragma unroll
        for (int j = 0; j < U; ++j) {
            float o[8] = {bflo(o4[j].x), bfhi(o4[j].x), bflo(o4[j].y), bfhi(o4[j].y), bflo(o4[j].z), bfhi(o4[j].z), bflo(o4[j].w), bfhi(o4[j].w)};
            const float g[8] = {bflo(g4[j].x), bfhi(g4[j].x), bflo(g4[j].y), bfhi(g4[j].y), bflo(g4[j].z), bfhi(g4[j].z), bflo(g4[j].w), bfhi(g4[j].w)};
            float ss = 0.f;
#pragma unroll
            for (int k = 0; k < 8; ++k) ss += o[k] * o[k];
            const float rstd = 1.f / sqrtf(wave_sum(ss) * (1.f / 512.f) + EPS);
#pragma unroll
            for (int k = 0; k < 8; ++k) o[k] = o[k] * rstd * silu_f(g[k]);
            v4u w; w.x = pk2(o[0], o[1]); w.y = pk2(o[2], o[3]); w.z = pk2(o[4], o[5]); w.w = pk2(o[6], o[7]);
            if (ok[j]) *(v4u*)(O + off[j]) = w;
        }
    }
}
struct EpiCIn {
    static constexpr int BMODE = 0;
    pg8::bf16_t* GU; pg8::bf16_t* GVT; pg8::bf16_t* SG; pg8::bf16_t* GVS; float* SSQ; const float* ssq;
    __device__ __forceinline__ void operator()(const pg8::f32x4 (&acc)[2][2][4][2], const pg8::Unit& u, int wr, int wc, int fr, int fq) const {
        { const int l_ = lane_now(); fr = l_ & 15; fq = l_ >> 4; }
        const int pn = u.pn, pm = u.pm, typ = pn >> 4, pt = pn & 15; float rs[2][4]; row_rstd(ssq, pm, wr, fr, fq, rs);
#pragma unroll
        for (int ai = 0; ai < 2; ++ai)
#pragma unroll
            for (int m = 0; m < 4; ++m) {
                const int i = ai * 128 + wr * 64 + m * 16 + fr; const size_t row = (size_t)pm * 256 + i; float ss = 0.f;
#pragma unroll
                for (int bj = 0; bj < 2; ++bj)
#pragma unroll
                    for (int n = 0; n < 2; ++n) { const int c = pt * 256 + bj * 128 + wc * 32 + n * 16 + 4 * fq; const pg8::f32x4 x = acc[ai][bj][m][n] * rs[ai][m]; float y[4];
                        if (typ == 2) {
#pragma unroll
                            for (int e = 0; e < 4; ++e) y[e] = silu_f(x[e]);
                            v2u w; w.x = pk2(y[0], y[1]); w.y = pk2(y[2], y[3]); *(v2u*)(SG + row * 4096 + c) = w;
                        } else {
#pragma unroll
                            for (int e = 0; e < 4; ++e) y[e] = gelu_tanh_f(x[e]);
                            v2u w; w.x = pk2(y[0], y[1]); w.y = pk2(y[2], y[3]);
                            if (typ == 0) *(v2u*)(GU + row * 4096 + c) = w;
                            else { ss += (y[0] * y[0] + y[1] * y[1]) + (y[2] * y[2] + y[3] * y[3]);
                                pg8::bf16_t* t = GVT + ((size_t)pm * 4096 + c) * 256 + i;
                                t[0] = (pg8::bf16_t)(w.x & 0xffffu); t[256] = (pg8::bf16_t)(w.x >> 16); t[512] = (pg8::bf16_t)(w.y & 0xffffu); t[768] = (pg8::bf16_t)(w.y >> 16);
                                if (pm >= 64) *(v2u*)(GVS + (row - MP) * 4096 + c) = w; } } }
                if (typ == 1) { ss += __shfl_xor(ss, 16); ss += __shfl_xor(ss, 32); if (fq == 0) SSQ[row * 64 + pt * 4 + wc] = ss; }
                if (m & 1) asm volatile("" ::: "memory");
            }
    }
};
__device__ __forceinline__ void c_prep(Frame& F, const float* SSQ, const float* wsin, const float* vgain, const bf16* GVS, bf16* Wm, float* ovm) {
    LAS float* rs = (LAS float*)(F.lds + RING_OFF);
    const int tid = F.tid;
    for (int it = F.bid; it < 66 * 8; it += F.G) {
        const int J = it >> 3, g = it & 7;
        __syncthreads();
        if (tid < 256) { const float* p = SSQ + ((size_t)J * 256 + tid) * 64; float s = 0.f;
#pragma unroll
            for (int k = 0; k < 16; ++k) { const f32x4 x = *(const f32x4*)(p + 4 * k); s += (x.x + x.y) + (x.z + x.w); }
            rs[tid] = 1.f / sqrtf(s * (1.f / 4096.f) + EPS); }
        __syncthreads();
        bf16* wm = Wm + (size_t)(J * 8 + g) * 65536; const int sh = J < 64 ? 7 : 6, cm = (1 << sh) - 1;
        for (int eb = tid; eb < 8192; eb += 4 * NTHR) {
            f32x4 wa[4], wb[4];
#pragma unroll
            for (int q = 0; q < 4; ++q) { const int e8 = eb + q * NTHR, i = e8 >> 5, j0 = (e8 & 31) * 8, il = i & cm, jl0 = j0 & cm; const bool on = (i >> sh) == (j0 >> sh) && jl0 <= il;
                const float* wr_ = wsin + ((size_t)g * 128 + (on ? il : 0)) * 128 + (on ? jl0 : 0); wa[q] = *(const f32x4*)wr_; wb[q] = *(const f32x4*)(wr_ + 4); }
#pragma unroll
            for (int q = 0; q < 4; ++q) { const int e8 = eb + q * NTHR, i = e8 >> 5, j0 = (e8 & 31) * 8, il = i & cm, jl0 = j0 & cm; const bool on = (i >> sh) == (j0 >> sh) && jl0 <= il; float y[8];
                const float wv[8] = {wa[q].x, wa[q].y, wa[q].z, wa[q].w, wb[q].x, wb[q].y, wb[q].z, wb[q].w};
#pragma unroll
                for (int k = 0; k < 8; ++k) y[k] = (on && jl0 + k <= il) ? wv[k] * rs[j0 + k] : 0.f;
                v4u w; w.x = pk2(y[0], y[1]); w.y = pk2(y[2], y[3]); w.z = pk2(y[4], y[5]); w.w = pk2(y[6], y[7]);
                *(v4u*)(wm + i * 256 + j0) = w; } }
    }
    const int gw = F.bid * NWAVES + F.wave, NGW = F.G * NWAVES, lane = F.lane;
    for (int r = gw; r < MS; r += NGW) {
        const float rstd = 1.f / sqrtf(wave_sum(SSQ[((size_t)MP + r) * 64 + lane]) * (1.f / 4096.f) + EPS);
        v4u vr[8]; f32x4 gar[8], gbr[8];
#pragma unroll
        for (int k = 0; k < 8; ++k) { const int col = k * 512 + lane * 8; vr[k] = *(const v4u*)(GVS + (size_t)r * 4096 + col); gar[k] = *(const f32x4*)(vgain + col); gbr[k] = *(const f32x4*)(vgain + col + 4); }
#pragma unroll
        for (int k = 0; k < 8; ++k) { const int col = k * 512 + lane * 8; const v4u v4 = vr[k];
            const f32x4 ga = gar[k], gb = gbr[k];
            float* o = ovm + (size_t)r * 4096 + col;
            *(f32x4*)o = (f32x4){bflo(v4.x) * rstd * ga.x, bfhi(v4.x) * rstd * ga.y, bflo(v4.y) * rstd * ga.z, bfhi(v4.y) * rstd * ga.w};
            *(f32x4*)(o + 4) = (f32x4){bflo(v4.z) * rstd * gb.x, bfhi(v4.z) * rstd * gb.y, bflo(v4.w) * rstd * gb.z, bfhi(v4.w) * rstd * gb.w}; }
    }
}
struct CMixOrder {
    int G, c; const char* Wm; const char* GVT;
    __device__ __forceinline__ bool next(int i, pg8::Unit& u) const { const int L = i * G + c; if (L >= 66 * 16) return false; const int J = L >> 4, nt = L & 15;
        u.pm = J; u.pn = nt; u.a = Wm + ((size_t)(J * 8 + (nt >> 1)) * 65536) * 2; u.b = GVT + (((size_t)J * 4096 + nt * 256) * 256) * 2; return true; }
    __device__ __forceinline__ void a_ready(const pg8::Unit&) const {}
    __device__ __forceinline__ void done(const pg8::Unit&) const {}
};
struct EpiCMix {
    static constexpr int BMODE = 1;
    pg8::bf16_t* GU; const pg8::bf16_t* SG; const float* vgain; const float* bs;
    __device__ __forceinline__ void operator()(const pg8::f32x4 (&acc)[2][2][4][2], const pg8::Unit& u, int wr, int wc, int fr, int fq) const {
        { const int l_ = lane_now(); fr = l_ & 15; fq = l_ >> 4; }
        const int J = u.pm, nt = u.pn, g = nt >> 1, cm = J < 64 ? 127 : 63;
#pragma unroll
        for (int bj = 0; bj < 2; ++bj) { const int c0 = nt * 256 + bj * 128 + wc * 32 + 8 * fq; const f32x4 ga = *(const f32x4*)(vgain + c0), gb = *(const f32x4*)(vgain + c0 + 4);
            const float gn[8] = {ga.x, ga.y, ga.z, ga.w, gb.x, gb.y, gb.z, gb.w};
#pragma unroll
            for (int ai = 0; ai < 2; ++ai)
#pragma unroll
                for (int m = 0; m < 4; ++m) { const int i = ai * 128 + wr * 64 + m * 16 + fr; const size_t off = ((size_t)J * 256 + i) * 4096 + c0; const float b = bs[g * 128 + (i & cm)];
                    const v4u u4 = *(const v4u*)(GU + off), s4 = NT_LOAD((const v4u*)(SG + off)); const pg8::f32x4 v0 = acc[ai][bj][m][0], v1 = acc[ai][bj][m][1];
                    const float mx[8] = {v0[0], v0[1], v0[2], v0[3], v1[0], v1[1], v1[2], v1[3]};
                    const float uu[8] = {bflo(u4.x), bfhi(u4.x), bflo(u4.y), bfhi(u4.y), bflo(u4.z), bfhi(u4.z), bflo(u4.w), bfhi(u4.w)};
                    const float sg[8] = {bflo(s4.x), bfhi(s4.x), bflo(s4.y), bfhi(s4.y), bflo(s4.z), bfhi(s4.z), bflo(s4.w), bfhi(s4.w)}; float y[8];
#pragma unroll
                    for (int k = 0; k < 8; ++k) y[k] = uu[k] * (mx[k] * gn[k] + b) * sg[k];
                    v4u w; w.x = pk2(y[0], y[1]); w.y = pk2(y[2], y[3]); w.z = pk2(y[4], y[5]); w.w = pk2(y[6], y[7]);
                    *(v4u*)(GU + off) = w; } }
    }
};
__device__ __forceinline__ float diff_lambda(const float* q1, const float* k1, const float* q2, const float* k2, float lam_init) {
    float a = 0.f, b = 0.f;
    for (int i = 0; i < 64; ++i) { a += q1[i] * k1[i]; b += q2[i] * k2[i]; }
    return expf(a) - expf(b) + lam_init;
}

constexpr int N_PHASES = 21;
__global__ void __launch_bounds__(NTHR, 2) mega(Args args) {
    extern __shared__ __attribute__((aligned(16))) unsigned char lds[];
    Frame F;
    F.lds = (LAS unsigned char*)lds; F.tid = threadIdx.x; F.lane = F.tid & 63; F.wave = __builtin_amdgcn_readfirstlane(F.tid >> 6); F.G = gridDim.x; F.bid = blockIdx.x;
    F.in = args.in; F.out = args.out; F.ws = args.ws;
    unsigned char* ws = args.ws; float* out = args.out;
    bf16* W_AIN[2] = {(bf16*)(ws + WS_WAIN0), (bf16*)(ws + WS_WAIN1)}; bf16* W_AOUT[2] = {(bf16*)(ws + WS_WAOUT0), (bf16*)(ws + WS_WAOUT1)};
    bf16* W_RIN = (bf16*)(ws + WS_WRIN); bf16* W_ROUT = (bf16*)(ws + WS_WROUT); bf16* W_CIN = (bf16*)(ws + WS_WCIN); bf16* W_COUT = (bf16*)(ws + WS_WCOUT);
    bf16* XN0 = (bf16*)(ws + WS_XN0); bf16* HB = (bf16*)(ws + WS_HB); float* SSQ2 = (float*)(ws + WS_SSQ2);
    bf16* Qs = (bf16*)(ws + WS_QS); bf16* KP = (bf16*)(ws + WS_KP); bf16* VP = (bf16*)(ws + WS_VP); bf16* KC = (bf16*)(ws + WS_KC); bf16* VC = (bf16*)(ws + WS_VC); bf16* AO_A = (bf16*)(ws + WS_AOA);
    bf16* KT = (bf16*)(ws + WS_KT); bf16* RG = (bf16*)(ws + WS_RG); bf16* QP = (bf16*)(ws + WS_QP); bf16* KN = (bf16*)(ws + WS_KN); bf16* VS = (bf16*)(ws + WS_VS); bf16* ORET = (bf16*)(ws + WS_ORET);
    bf16* GU = (bf16*)(ws + WS_GU); bf16* SG = (bf16*)(ws + WS_SG); bf16* GVT = (bf16*)(ws + WS_GVT); bf16* WM = (bf16*)(ws + WS_WM); float* SSQ = (float*)(ws + WS_SSQ); bf16* GVS = (bf16*)(ws + WS_GVS); float* TABR = (float*)(ws + WS_TABR); bf16* KVX = (bf16*)(ws + WS_KVX); float* TABA = (float*)(ws + WS_TABA); bf16* GA = (bf16*)(ws + WS_GA);
    const int lo = args.ph_lo, hi = args.ph_hi;
    volatile LAS unsigned* MISC = (volatile LAS unsigned*)(F.lds + MISC_OFF);
    for (int u = F.tid; u < (LDS_BYTES - MISC_OFF) / 4; u += NTHR) ((LAS unsigned*)(F.lds + MISC_OFF))[u] = 0u;
    __syncthreads();
    XcdBarrier bar = xcd_barrier_post((unsigned*)(ws + WS_CTL) + 4096, MISC + 8);
#define IN(k) (lo <= (k) && (k) < hi)
#define PH_ENTER() do { int t_ = F.wave * 64 + lane_now(); F.tid = t_; F.lane = t_ & 63; } while (0)
    volatile LAS int* DRW = (volatile LAS int*)(F.lds + MISC_OFF + 64);
    unsigned* DCTR = (unsigned*)(ws + WS_CTL) + 8192;
#define DRAIN(ph, total, BODY) do { PH_ENTER(); unsigned tk_ = 0u; if (F.tid == 0) tk_ = atomicAdd(DCTR + 64 * (ph), 1u); for (;;) { __syncthreads(); if (F.tid == 0) DRW[0] = (int)tk_; __syncthreads(); const int c_ = DRW[0]; if (c_ >= (total)) break; \
        if (F.tid == 0) tk_ = atomicAdd(DCTR + 64 * (ph), 1u);     \
        BODY } } while (0)
#define SEAM(k) do { if (IN(k) && IN((k) + 1)) xcd_barrier(bar, F.wave == 0 && lane_now() == 0); } while (0)

#define GEMM_STORE(Aptr, Wptr, NN, KK, Optr) do { pg8::GemmP g{KK, KK, (KK) / 64}; pg8::StaticOrder S; S.init(MT / 256, (NN) / 256, F.G, F.bid, Aptr, Wptr, KK, KK); pg8::EpiStoreBf16 E{(pg8::bf16_t*)(Optr), NN}; \
        pg8::gemm_phase<pg8::EpiStoreBf16, pg8::StaticOrder>(F.lds + RING_OFF, g, S, E, F.tid); } while (0)
#define GEMM_RESIDB(MODE_, Aptr, Wptr, KK) do { pg8::GemmP g{KK, KK, (KK) / 64}; pg8::StaticOrder S; S.init(MT / 256, DM / 256, F.G, F.bid, Aptr, Wptr, KK, KK); \
        pg8::EpiResidB<MODE_> E{args.in[I_XP], args.in[I_XS], (pg8::bf16_t*)HB, out, SSQ2}; pg8::gemm_phase<pg8::EpiResidB<MODE_>, pg8::StaticOrder>(F.lds + RING_OFF, g, S, E, F.tid); } while (0)

    PH_ENTER(); if (IN(0)) {
        transpose_weight(F, args.in[I_AWIN], 2048, 8192, W_AIN[0]); attn_table(F, TABA);
        norm_rows(F, args.in[I_XP], args.in[I_XS], args.in[I_NW], XN0);
    }
    SEAM(0);
#define GEMM_AIN(Aptr, Wptr, J_, SSQP) do { pg8::GemmP g{2048, 2048, 32}; pg8::StaticOrder S; S.init(MT / 256, 32, F.G, F.bid, Aptr, Wptr, 2048, 2048); \
        EpiAIn E{Qs, KP, VP, KC, VC, GA, out + O_KP + (size_t)(J_) * MP * DM, out + O_VP + (size_t)(J_) * MP * DM, out + O_KS + (size_t)(J_) * MS * DM, out + O_VS + (size_t)(J_) * MS * DM, TABA, args.in[I_AQG] + 64 * (J_), args.in[I_AKG] + 64 * (J_), SSQP}; \
        pg8::gemm_phase<EpiAIn, pg8::StaticOrder>(F.lds + RING_OFF, g, S, E, F.tid); } while (0)
    PH_ENTER(); if (IN(1)) { GEMM_AIN(XN0, W_AIN[0], 0, (const float*)nullptr);
        const int n0 = CC_CHUNKS, n1 = n0 + tw_chunks(2048, 2048), n2 = n1 + TR_CHUNKS;
        DRAIN(1, n2, if (c_ < n0) cc_run(F, args.in[I_CK], args.in[I_CV], KC, VC, c_); else if (c_ < n1) tw_run(F, args.in[I_AWOUT], 2048, 2048, W_AOUT[0], c_ - n0); else tr_run(F, TABR, c_ - n1);); }
    SEAM(1);
    PH_ENTER(); if (IN(3)) { const float li = 0.8f - 0.6f * expf(-0.3f * 0.f); const float lam = diff_lambda(args.in[I_LQ1], args.in[I_LK1], args.in[I_LQ2], args.in[I_LK2], li);
        attn_fast(F, Qs, KP, VP, KC, VC, GA, AO_A, lam, 1.f - li, args.in[I_ASG]); }
    SEAM(3);
    PH_ENTER(); if (IN(4)) { GEMM_RESIDB(0, AO_A, W_AOUT[0], 2048);
        const int n0 = tw_chunks(2048, 12288), n1 = n0 + tw_chunks(4096, 2048);
        DRAIN(4, n1, if (c_ < n0) tw_run(F, args.in[I_RWIN], 2048, 12288, W_RIN, c_, args.in[I_NW] + DM); else tw_run(F, args.in[I_RWOUT], 4096, 2048, W_ROUT, c_ - n0);); }
    if (IN(4) && IN(6)) xcd_barrier(bar, F.wave == 0 && lane_now() == 0);
    PH_ENTER(); if (IN(6)) { ret_zero_pad(F, VS, KT);
        PH_ENTER(); pg8::GemmP g{2048, 2048, 32}; pg8::StaticOrder S; S.init(MT / 256, 48, F.G, F.bid, HB, W_RIN, 2048, 2048); EpiRet E{QP, KN, KT, VS, RG, TABR, SSQ2};
        pg8::gemm_phase<EpiRet, pg8::StaticOrder>(F.lds + RING_OFF, g, S, E, F.tid); }
    SEAM(6);
    PH_ENTER(); if (IN(7)) { { pg8::GemmP g{4096, 2048, 4}; RetQKOrder S{F.G, F.bid, (const char*)QP, (const char*)KN}; EpiRetQK E{QP}; pg8::gemm_phase<EpiRetQK, RetQKOrder>(F.lds + RING_OFF, g, S, E, F.tid); }
        PH_ENTER(); { pg8::GemmP g{512, 256, 4}; RetKVOrder S{F.G, F.bid, (const char*)VS, (const char*)KT}; EpiRetKV E{VS, KVX}; pg8::gemm_phase<EpiRetKV, RetKVOrder>(F.lds + RING_OFF, g, S, E, F.tid); }
        xcd_barrier(bar, F.wave == 0 && lane_now() == 0);
        PH_ENTER(); ret_scan(F, VS, KVX, args.in[I_SR], out + O_SP, out + O_SS); }
    SEAM(7);
    PH_ENTER(); if (IN(8)) { pg8::GemmP g{4096, 512, 8}; RetOOrder S{F.G, F.bid, (const char*)QP, (const char*)VS}; EpiRetO E{ORET}; pg8::gemm_phase<EpiRetO, RetOOrder>(F.lds + RING_OFF, g, S, E, F.tid); }
    SEAM(8);
    PH_ENTER(); if (IN(9)) r_out(F, ORET, RG);
    SEAM(9);
    PH_ENTER(); if (IN(10)) { GEMM_RESIDB(1, ORET, W_ROUT, 4096);
        const int n0 = tw_chunks(2048, 12288), n1 = n0 + tw_chunks(4096, 2048), n2 = n1 + tw_chunks(2048, 8192), n3 = n2 + tw_chunks(2048, 2048);
        DRAIN(10, n3, if (c_ < n0) tw_run(F, args.in[I_CWIN], 2048, 12288, W_CIN, c_, args.in[I_NW] + 2 * DM); else if (c_ < n1) tw_run(F, args.in[I_CWOUT], 4096, 2048, W_COUT, c_ - n0);
                      else if (c_ < n2) tw_run(F, args.in[I_AWIN] + (size_t)2048 * 8192, 2048, 8192, W_AIN[1], c_ - n1, args.in[I_NW] + 3 * DM); else tw_run(F, args.in[I_AWOUT] + (size_t)2048 * 2048, 2048, 2048, W_AOUT[1], c_ - n2);); }
    if (IN(10) && IN(12)) xcd_barrier(bar, F.wave == 0 && lane_now() == 0);
    PH_ENTER(); if (IN(12)) { pg8::GemmP g{2048, 2048, 32}; pg8::StaticOrder S; S.init(MT / 256, 48, F.G, F.bid, HB, W_CIN, 2048, 2048); EpiCIn E{GU, GVT, SG, GVS, SSQ, SSQ2};
        pg8::gemm_phase<EpiCIn, pg8::StaticOrder>(F.lds + RING_OFF, g, S, E, F.tid); }
    SEAM(12);
    PH_ENTER(); if (IN(13)) c_prep(F, SSQ, args.in[I_CWS], args.in[I_CVG], GVS, WM, out + O_VM);
    SEAM(13);
    PH_ENTER(); if (IN(14)) { pg8::GemmP g{256, 256, 4}; CMixOrder S{F.G, F.bid, (const char*)WM, (const char*)GVT}; EpiCMix E{GU, SG, args.in[I_CVG], args.in[I_CBS]}; pg8::gemm_phase<EpiCMix, CMixOrder>(F.lds + RING_OFF, g, S, E, F.tid); }
    SEAM(14);
    PH_ENTER(); if (IN(15)) { GEMM_RESIDB(1, GU, W_COUT, 4096);
        DRAIN(15, CC_CHUNKS, cc_run(F, args.in[I_CK] + (size_t)NB * PAST * DM, args.in[I_CV] + (size_t)NB * PAST * DM, KC, VC, c_);); }
    if (IN(15) && IN(17)) xcd_barrier(bar, F.wave == 0 && lane_now() == 0);
    PH_ENTER(); if (IN(17)) GEMM_AIN(HB, W_AIN[1], 1, (const float*)SSQ2);
    SEAM(17);
    PH_ENTER(); if (IN(19)) { const float li = 0.8f - 0.6f * expf(-0.3f * 3.f); const float lam = diff_lambda(args.in[I_LQ1] + 64, args.in[I_LK1] + 64, args.in[I_LQ2] + 64, args.in[I_LK2] + 64, li);
        attn_fast(F, Qs, KP, VP, KC, VC, GA, AO_A, lam, 1.f - li, args.in[I_ASG] + 128); }
    SEAM(19);
    PH_ENTER(); if (IN(20)) GEMM_RESIDB(2, AO_A, W_AOUT[1], 2048);
#undef IN
#undef SEAM
}

extern "C" void kernel_launch(void* const* d_in, const int* in_sizes, int n_in, void* d_out, int out_size, void* d_ws, size_t ws_size, hipStream_t stream) {
    static int grid = 0;
    if (grid == 0) {
        if (n_in != N_IN || (size_t)out_size != O_END || ws_size < WS_END) { fprintf(stderr, "kernel_launch: unexpected shapes: n_in %d out %d ws %zu (need %zu)\n", n_in, out_size, ws_size, (size_t)WS_END); grid = -1; return; }
        int dev = 0, cus = 0;
        if (hipGetDevice(&dev) != hipSuccess || hipDeviceGetAttribute(&cus, hipDeviceAttributeMultiprocessorCount, dev) != hipSuccess) { grid = -1; return; }
        if (hipFuncSetAttribute((const void*)mega, hipFuncAttributeMaxDynamicSharedMemorySize, LDS_BYTES) != hipSuccess) { fprintf(stderr, "kernel_launch: hipFuncSetAttribute failed\n"); grid = -1; return; }
        int per_cu = 0;
        if (hipOccupancyMaxActiveBlocksPerMultiprocessor(&per_cu, (const void*)mega, NTHR, LDS_BYTES) != hipSuccess || per_cu < 1) { fprintf(stderr, "kernel_launch: occupancy query: %d workgroups per CU\n", per_cu); grid = -1; return; }
        (void)hipGetLastError();
        grid = cus;
    }
    if (grid < 0) return;
    Args a{};
    for (int i = 0; i < N_IN; ++i) a.in[i] = (const float*)d_in[i];
    a.out = (float*)d_out; a.ws = (unsigned char*)d_ws;
    (void)hipMemsetAsync((char*)d_ws + WS_CTL, 0, CTL_ZERO_BYTES, stream);
    a.ph_lo = 0; a.ph_hi = N_PHASES;
    hipLaunchKernelGGL(mega, dim3(grid), dim3(NTHR), LDS_BYTES, stream, a);
}
```

```cpp
#include <hip/hip_runtime.h>
#include <cstdio>
#include <cstdint>

__device__ __forceinline__ int lane_now() { int l; asm volatile("v_mbcnt_lo_u32_b32 %0, -1, 0\n\tv_mbcnt_hi_u32_b32 %0, -1, %0" : "=v"(l)); return l; }
namespace pg8 {
#define PG8_LAS __attribute__((address_space(3)))
typedef unsigned short bf16_t;
typedef short bf16x8 __attribute__((ext_vector_type(8)));
typedef float f32x4 __attribute__((ext_vector_type(4)));
typedef unsigned u32x4 __attribute__((ext_vector_type(4)));
constexpr int BM = 256, BK = 64, HALF = 128, HTB = HALF * BK * 2, STAGE_BYTES = 8 * HTB, NXCD = 8, WGM = 4;

__host__ __device__ __forceinline__ int lds_byte(int r, int c) { const int st = (r >> 4) * 2 + (c >> 5), rr = r & 15, cc = c & 31, ob = rr * 64 + cc * 2; return st * 1024 + (ob ^ (((ob >> 9) & 1) << 5)); }
__host__ __device__ __forceinline__ void stage_rc(int b, int& R, int& C) { const int st = b / 1024, sb = b % 1024, swz = sb ^ (((sb >> 9) & 1) << 5); R = (st >> 1) * 16 + swz / 64; C = (st & 1) * 32 + (swz % 64) / 2; }
__host__ __device__ __forceinline__ int perm32(int rho) { const int n = rho >> 4, i = rho & 15; return 8 * (i >> 2) + 4 * n + (i & 3); }

struct Unit { int pm, pn; const char* a; const char* b; };
struct GemmP { int lda, ldb, nt; };

struct StaticOrder {
    int nM, nN, nwg, G, c; const char* A; const char* B; size_t ta, tb;
    __host__ __device__ void init(int nM_, int nN_, int G_, int c_, const void* A_, const void* B_, int lda, int ldb) { nM = nM_; nN = nN_; nwg = nM * nN; G = G_; c = c_; A = (const char*)A_; B = (const char*)B_; ta = (size_t)BM * lda * 2; tb = (size_t)BM * ldb * 2; }
    __host__ __device__ bool next(int i, Unit& u) const {
        const long L = (long)i * G + c; if (L >= nwg) return false;
        int wgid = (int)L; { const int q = nwg / NXCD, r = nwg % NXCD, xcd = wgid % NXCD, off = wgid / NXCD; wgid = (xcd < r ? xcd * (q + 1) : r * (q + 1) + (xcd - r) * q) + off; }
        const int nig = WGM * nN, gid = wgid / nig, fm = gid * WGM, gsz = (nM - fm) < WGM ? (nM - fm) : WGM;
        u.pm = fm + ((wgid % nig) % gsz); u.pn = (wgid % nig) / gsz; u.a = A + (size_t)u.pm * ta; u.b = B + (size_t)u.pn * tb; return true;
    }
    __device__ __forceinline__ void a_ready(const Unit&) const {}
    __device__ __forceinline__ void done(const Unit&) const {}
};

__device__ __forceinline__ unsigned cvt_pk_bf16(float lo, float hi) { unsigned r; asm volatile("v_cvt_pk_bf16_f32 %0, %1, %2" : "=v"(r) : "v"(lo), "v"(hi)); return r; }

struct EpiStoreBf16 {
    static constexpr int BMODE = 1;
    bf16_t* O; int ldc;
    __device__ __forceinline__ void operator()(const f32x4 (&acc)[2][2][4][2], const Unit& u, int wr, int wc, int fr, int fq) const {
        const int row0 = u.pm * BM + wr * 64 + fr; const int col0 = u.pn * BM + wc * 32 + 8 * fq;
#pragma unroll
        for (int ai = 0; ai < 2; ++ai)
#pragma unroll
            for (int m = 0; m < 4; ++m) { bf16_t* rowp = O + (size_t)(row0 + ai * HALF + m * 16) * ldc + col0;
#pragma unroll
                for (int bj = 0; bj < 2; ++bj) { const f32x4 v0 = acc[ai][bj][m][0], v1 = acc[ai][bj][m][1];
                    u32x4 w; w.x = cvt_pk_bf16(v0[0], v0[1]); w.y = cvt_pk_bf16(v0[2], v0[3]); w.z = cvt_pk_bf16(v1[0], v1[1]); w.w = cvt_pk_bf16(v1[2], v1[3]);
                    *(u32x4*)(rowp + bj * HALF) = w; } }
    }
};
struct EpiResid {
    static constexpr int BMODE = 0;
    const float* base_p; const float* base_s; float* out; int split;
    __device__ __forceinline__ void operator()(const f32x4 (&acc)[2][2][4][2], const Unit& u, int wr, int wc, int fr, int fq) const {
        { const int l_ = lane_now(); fr = l_ & 15; fq = l_ >> 4; }
        const int col0 = u.pn * BM + wc * 32 + 4 * fq;
#pragma unroll
        for (int ai = 0; ai < 2; ++ai) {
            f32x4 bs[4][2][2];
#pragma unroll
            for (int m = 0; m < 4; ++m) { const int r = u.pm * BM + ai * HALF + wr * 64 + m * 16 + fr; const float* bp = (r < split) ? base_p + (size_t)r * 2048 : base_s + (size_t)(r - split) * 2048;
#pragma unroll
                for (int bj = 0; bj < 2; ++bj)
#pragma unroll
                    for (int n = 0; n < 2; ++n) bs[m][bj][n] = *(const f32x4*)(bp + col0 + bj * HALF + n * 16); }
#pragma unroll
            for (int m = 0; m < 4; ++m) { const int r = u.pm * BM + ai * HALF + wr * 64 + m * 16 + fr; float* op = out + (size_t)r * 2048;
#pragma unroll
                for (int bj = 0; bj < 2; ++bj)
#pragma unroll
                    for (int n = 0; n < 2; ++n) *(f32x4*)(op + col0 + bj * HALF + n * 16) = bs[m][bj][n] + acc[ai][bj][m][n]; }
            asm volatile("" ::: "memory");
        }
    }
};

template <int MODE> struct EpiResidB {
    static constexpr int BMODE = 1;
    const float* base_p; const float* base_s; bf16_t* HB; float* out; float* SSQ2;
    __device__ __forceinline__ void operator()(const f32x4 (&acc)[2][2][4][2], const Unit& u, int wr, int wc, int fr, int fq) const {
        { const int l_ = lane_now(); fr = l_ & 15; fq = l_ >> 4; }
        const int col0 = u.pn * BM + wc * 32 + 8 * fq;
#pragma unroll
        for (int ai = 0; ai < 2; ++ai) {
            f32x4 b0[4][2], b1[4][2]; u32x4 hb[4][2];
#pragma unroll
            for (int m = 0; m < 4; ++m) { const int r = u.pm * BM + ai * HALF + wr * 64 + m * 16 + fr;
#pragma unroll
                for (int bj = 0; bj < 2; ++bj) {
                    if (MODE == 0) { const float* bp = ((r < 16384) ? base_p + (size_t)r * 2048 : base_s + (size_t)(r - 16384) * 2048) + col0 + bj * HALF; b0[m][bj] = __builtin_nontemporal_load((const f32x4*)bp); b1[m][bj] = __builtin_nontemporal_load((const f32x4*)(bp + 4)); }
                    else hb[m][bj] = *(const u32x4*)(HB + (size_t)r * 2048 + col0 + bj * HALF); } }
#pragma unroll
            for (int m = 0; m < 4; ++m) { const int r = u.pm * BM + ai * HALF + wr * 64 + m * 16 + fr; float ss = 0.f;
#pragma unroll
                for (int bj = 0; bj < 2; ++bj) { f32x4 h0, h1;
                    if (MODE == 0) { h0 = b0[m][bj] + acc[ai][bj][m][0]; h1 = b1[m][bj] + acc[ai][bj][m][1]; }
                    else { const u32x4 w = hb[m][bj];
                        h0 = (f32x4){__builtin_bit_cast(float, w.x << 16), __builtin_bit_cast(float, w.x & 0xffff0000u), __builtin_bit_cast(float, w.y << 16), __builtin_bit_cast(float, w.y & 0xffff0000u)} + acc[ai][bj][m][0];
                        h1 = (f32x4){__builtin_bit_cast(float, w.z << 16), __builtin_bit_cast(float, w.z & 0xffff0000u), __builtin_bit_cast(float, w.w << 16), __builtin_bit_cast(float, w.w & 0xffff0000u)} + acc[ai][bj][m][1]; }
                    if (MODE == 2) { float* op = out + (size_t)r * 2048 + col0 + bj * HALF; __builtin_nontemporal_store(h0, (f32x4*)op); __builtin_nontemporal_store(h1, (f32x4*)(op + 4)); }
                    else { u32x4 w; w.x = cvt_pk_bf16(h0[0], h0[1]); w.y = cvt_pk_bf16(h0[2], h0[3]); w.z = cvt_pk_bf16(h1[0], h1[1]); w.w = cvt_pk_bf16(h1[2], h1[3]);
                        *(u32x4*)(HB + (size_t)r * 2048 + col0 + bj * HALF) = w;
                        ss += (h0[0] * h0[0] + h0[1] * h0[1]) + (h0[2] * h0[2] + h0[3] * h0[3]) + (h1[0] * h1[0] + h1[1] * h1[1]) + (h1[2] * h1[2] + h1[3] * h1[3]); } }
                if (MODE != 2) { ss += __shfl_xor(ss, 16); ss += __shfl_xor(ss, 32); if (fq == 0) SSQ2[(size_t)r * 32 + u.pn * 4 + wc] = ss; } }
            asm volatile("" ::: "memory");
        }
    }
};

template <class Epi, class Sched, bool ALIGN_EPI = true>
__device__ __forceinline__ void gemm_phase(PG8_LAS unsigned char* lds, const GemmP g, const Sched& S, const Epi& E, int tid) {
    asm volatile("" : "+v"(tid));
    const int wid = __builtin_amdgcn_readfirstlane(tid >> 6), lane = tid & 63, wr = wid >> 2, wc = wid & 3, fr = lane & 15, fq = lane >> 4;
    int nt = g.nt; asm volatile("" : "+s"(nt));
    unsigned voffA[2], voffB[2];
#pragma unroll
    for (int i = 0; i < 2; ++i) { int R, C; stage_rc(tid * 16 + i * 8192, R, C); const int Rb = Epi::BMODE == 2 ? (64 * (R >> 5) + perm32(R & 31)) : Epi::BMODE == 1 ? ((R & ~31) + perm32(R & 31)) : R;
        voffA[i] = (unsigned)(R * g.lda + C) * 2u; voffB[i] = (unsigned)(Rb * g.ldb + C) * 2u; }
    const size_t kstep = (size_t)(BK * 2);
    const size_t hstepA = (size_t)HALF * g.lda * 2, hstepB = (size_t)(Epi::BMODE == 2 ? 32 : HALF) * g.ldb * 2;
    const unsigned ldsw = (unsigned)wid * 1024u;
    const int aoff = lds_byte(wr * 64 + fr, fq * 8), boff = lds_byte(wc * 32 + fr, fq * 8);
#define PG8_SA(b, h) (((b) * 2 + (h)) * HTB)
#define PG8_SB(b, h) ((4 + (b) * 2 + (h)) * HTB)
#define PG8_STAGE(bufoff, gbase, voff) do { _Pragma("unroll") for (int _i = 0; _i < 2; ++_i) \
        __builtin_amdgcn_global_load_lds((const unsigned*)((const char*)(gbase) + (voff)[_i]), (PG8_LAS unsigned*)(lds + (bufoff) + ldsw + _i * 8192), 16, 0, 0); } while (0)
#define PG8_LDA(dst, b, h) do { _Pragma("unroll") for (int m = 0; m < 4; ++m) _Pragma("unroll") for (int k = 0; k < 2; ++k) dst[m][k] = *(const PG8_LAS bf16x8*)(lds + PG8_SA(b, h) + aoff + m * 2048 + k * 1024); } while (0)
#define PG8_LDB(dst, b, h) do { _Pragma("unroll") for (int n = 0; n < 2; ++n) _Pragma("unroll") for (int k = 0; k < 2; ++k) dst[n][k] = *(const PG8_LAS bf16x8*)(lds + PG8_SB(b, h) + boff + n * 2048 + k * 1024); } while (0)
#define PG8_MMA(ai, bj, At, Bt) do { __builtin_amdgcn_s_setprio(1); _Pragma("unroll") for (int m = 0; m < 4; ++m) _Pragma("unroll") for (int n = 0; n < 2; ++n) _Pragma("unroll") for (int k = 0; k < 2; ++k) \
        acc[ai][bj][m][n] = __builtin_amdgcn_mfma_f32_16x16x32_bf16(Bt[n][k], At[m][k], acc[ai][bj][m][n], 0, 0, 0); __builtin_amdgcn_s_setprio(0); } while (0)
#define PG8_WAIT_V(n) asm volatile("s_waitcnt vmcnt(" #n ")" ::: "memory")
#define PG8_WAIT_L(n) asm volatile("s_waitcnt lgkmcnt(" #n ")" ::: "memory")
#define PG8_BAR __builtin_amdgcn_s_barrier()
#define PG8_SCHED __builtin_amdgcn_sched_barrier(0)
    Unit cur, nxt; int ui = 0;
    if (!S.next(0, cur)) return;
    f32x4 acc[2][2][4][2];
#pragma unroll
    for (int a = 0; a < 2; ++a)
#pragma unroll
        for (int b = 0; b < 2; ++b)
#pragma unroll
            for (int m = 0; m < 4; ++m)
#pragma unroll
                for (int n = 0; n < 2; ++n) acc[a][b][m][n] = (f32x4){0.f, 0.f, 0.f, 0.f};
    bf16x8 At[4][2], B0[2][2], B1[2][2];
    const char* cA = cur.a; const char* cB = cur.b;
    S.a_ready(cur);
    PG8_STAGE(PG8_SB(0, 0), cB, voffB); PG8_STAGE(PG8_SB(0, 1), cB + hstepB, voffB); PG8_STAGE(PG8_SA(0, 0), cA, voffA); PG8_STAGE(PG8_SA(0, 1), cA + hstepA, voffA);
    if (wr == 1) PG8_BAR;
    PG8_WAIT_V(2); PG8_BAR;
    PG8_STAGE(PG8_SB(1, 0), cB + kstep, voffB); PG8_STAGE(PG8_SA(1, 0), cA + kstep, voffA); PG8_STAGE(PG8_SB(1, 1), cB + hstepB + kstep, voffB);
    PG8_WAIT_V(6); PG8_BAR;
    for (;;) {
        const bool has_next = S.next(ui + 1, nxt);
        const char* nA = has_next ? nxt.a : cA; const char* nB = has_next ? nxt.b : cB;
        for (int t = 0; t < nt; t += 2) {
            const bool last = (t == nt - 2);
            const char* a1 = cA + (size_t)(t + 1) * kstep;
            const char* a2 = last ? nA : cA + (size_t)(t + 2) * kstep; const char* b2 = last ? nB : cB + (size_t)(t + 2) * kstep;
            const char* a3 = a2 + kstep; const char* b3 = b2 + kstep;
            if (last && has_next) S.a_ready(nxt);
            PG8_LDB(B0, 0, 0); PG8_LDB(B1, 0, 1); PG8_SCHED; PG8_LDA(At, 0, 0); PG8_STAGE(PG8_SA(1, 1), a1 + hstepA, voffA);
            PG8_WAIT_V(8); PG8_WAIT_L(0); PG8_BAR; PG8_MMA(0, 0, At, B0); PG8_MMA(0, 1, At, B1); PG8_BAR; PG8_SCHED;
            PG8_LDA(At, 0, 1); PG8_STAGE(PG8_SB(0, 0), b2, voffB); PG8_STAGE(PG8_SB(0, 1), b2 + hstepB, voffB); PG8_STAGE(PG8_SA(0, 0), a2, voffA);
            PG8_WAIT_V(8); PG8_WAIT_L(0); PG8_BAR; PG8_MMA(1, 0, At, B0); PG8_MMA(1, 1, At, B1); PG8_BAR; PG8_SCHED;
            PG8_LDB(B0, 1, 0); PG8_LDB(B1, 1, 1); PG8_SCHED; PG8_LDA(At, 1, 0); PG8_STAGE(PG8_SA(0, 1), a2 + hstepA, voffA);
            PG8_WAIT_V(8); PG8_WAIT_L(0); PG8_BAR; PG8_MMA(0, 0, At, B0); PG8_MMA(0, 1, At, B1); PG8_BAR; PG8_SCHED;
            PG8_LDA(At, 1, 1); PG8_STAGE(PG8_SB(1, 0), b3, voffB); PG8_STAGE(PG8_SB(1, 1), b3 + hstepB, voffB); PG8_STAGE(PG8_SA(1, 0), a3, voffA);
            PG8_WAIT_V(8); PG8_WAIT_L(0); PG8_BAR; PG8_MMA(1, 0, At, B0); PG8_MMA(1, 1, At, B1); PG8_BAR; PG8_SCHED;
        }
        if constexpr (ALIGN_EPI) { if (wr == 0) PG8_BAR; }
        E(acc, cur, wr, wc, fr, fq); S.done(cur);
        if (!has_next) break;
#pragma unroll
        for (int a = 0; a < 2; ++a)
#pragma unroll
            for (int b = 0; b < 2; ++b)
#pragma unroll
                for (int m = 0; m < 4; ++m)
#pragma unroll
                    for (int n = 0; n < 2; ++n) acc[a][b][m][n] = (f32x4){0.f, 0.f, 0.f, 0.f};
        cur = nxt; cA = nA; cB = nB; ++ui;
        if constexpr (ALIGN_EPI) { if (wr == 1) PG8_BAR; }
    }
    PG8_WAIT_V(0);
    if constexpr (!ALIGN_EPI) { if (wr == 0) PG8_BAR; }
    PG8_BAR;
#undef PG8_SA
#undef PG8_SB
#undef PG8_STAGE
#undef PG8_LDA
#undef PG8_LDB
#undef PG8_MMA
#undef PG8_WAIT_V
#undef PG8_WAIT_L
#undef PG8_BAR
#undef PG8_SCHED
}
}

constexpr int NWAVES = 8, NTHR = 512;
constexpr int DM = 2048, MP = 16384, MS = 512, MT = MP + MS, PAST = 2048, DECL = 64, NB = 8;
constexpr int KCROWS = PAST + DECL;
constexpr float EPS = 1e-6f;
constexpr float LOG2E = 1.4426950408889634f;
constexpr float C2 = 0.125f * LOG2E;

enum { I_XP = 0, I_XS, I_CK, I_CV, I_SR, I_NW, I_AWIN, I_AWOUT, I_AQG, I_AKG, I_LQ1, I_LK1, I_LQ2, I_LK2, I_ASG, I_RWIN, I_RWOUT, I_CWIN, I_CWOUT, I_CVG, I_CWS, I_CBS, N_IN };
constexpr size_t O_YP = 0, O_YS = O_YP + (size_t)MP * DM, O_KP = O_YS + (size_t)MS * DM, O_VP = O_KP + 2 * (size_t)MP * DM, O_KS = O_VP + 2 * (size_t)MP * DM, O_VS = O_KS + 2 * (size_t)MS * DM,
                 O_SP = O_VS + 2 * (size_t)MS * DM, O_SS = O_SP + (size_t)8 * 256 * 512, O_VM = O_SS + (size_t)NB * 8 * 256 * 512, O_END = O_VM + (size_t)MS * 4096;

constexpr size_t MiB = 1u << 20;
constexpr size_t WS_CTL = 0, CTL_ZERO_BYTES = 1 * MiB;
constexpr size_t WS_WAIN0 = 8 * MiB, WS_WAOUT0 = 40 * MiB, WS_WRIN = 48 * MiB, WS_WROUT = 96 * MiB, WS_WCIN = 112 * MiB, WS_WCOUT = 160 * MiB, WS_WAIN1 = 176 * MiB, WS_WAOUT1 = 208 * MiB;
constexpr size_t WS_SSQ2 = 2 * MiB;
constexpr size_t WS_HB = 216 * MiB, WS_Z = 282 * MiB;
constexpr size_t WS_XN0 = 348 * MiB;
constexpr size_t WS_QS = 546 * MiB, WS_KP = 612 * MiB, WS_VP = 676 * MiB, WS_KC = 740 * MiB, WS_VC = 806 * MiB, WS_AOA = 872 * MiB;
constexpr size_t WS_KT = 112 * MiB, WS_RG = 282 * MiB, WS_QP = 414 * MiB, WS_KN = 546 * MiB, WS_VS = 612 * MiB, WS_ORET = 900 * MiB;
constexpr size_t WS_GU = 282 * MiB, WS_SG = 414 * MiB, WS_GVT = 546 * MiB, WS_WM = 678 * MiB, WS_SSQ = 744 * MiB, WS_GVS = 752 * MiB;
constexpr size_t WS_GA = 282 * MiB;
constexpr size_t WS_KVX = 184 * MiB;
constexpr size_t WS_TABR = 1040 * MiB, WS_TABA = 1056 * MiB, WS_END = 1060 * MiB;

#define GAS __attribute__((address_space(1)))
#define LAS __attribute__((address_space(3)))
typedef unsigned short bf16;
typedef unsigned v4u __attribute__((ext_vector_type(4)));
typedef unsigned v2u __attribute__((ext_vector_type(2)));
typedef float f32x4 __attribute__((ext_vector_type(4)));
typedef GAS unsigned gu32;
#define RLX_AGENT __ATOMIC_RELAXED, __HIP_MEMORY_SCOPE_AGENT
#define LDS_WAIT() asm volatile("s_waitcnt lgkmcnt(0)" ::: "memory")
#define VM_WAIT() asm volatile("s_waitcnt vmcnt(0)" ::: "memory")
typedef float g_f32x2 __attribute__((ext_vector_type(2))); typedef __bf16 g_bf16x2 __attribute__((ext_vector_type(2)));
__device__ __forceinline__ unsigned pk2(float lo, float hi) { const g_f32x2 v = {lo, hi}; const g_bf16x2 b = __builtin_convertvector(v, g_bf16x2); return __builtin_bit_cast(unsigned, b); }
__device__ __forceinline__ unsigned f2bf(float f) { return pk2(f, 0.f) & 0xffffu; }
__device__ __forceinline__ float bf2f(unsigned short b) { return __builtin_bit_cast(float, (unsigned)b << 16); }
__device__ __forceinline__ float bflo(unsigned w) { return __builtin_bit_cast(float, w << 16); }
__device__ __forceinline__ float bfhi(unsigned w) { return __builtin_bit_cast(float, w & 0xffff0000u); }
__device__ __forceinline__ float silu_f(float x) { return x * __builtin_amdgcn_rcpf(1.f + __builtin_amdgcn_exp2f(-LOG2E * x)); }
__device__ __forceinline__ float gelu_tanh_f(float x) { const float u = (0.7978845608028654f * 2.f * LOG2E) * (x + 0.044715f * x * x * x); return x * __builtin_amdgcn_rcpf(1.f + __builtin_amdgcn_exp2f(-u)); }
__device__ __forceinline__ float wave_sum(float v) {
#pragma unroll
    for (int o = 1; o < 64; o <<= 1) v += __shfl_xor(v, o);
    return v;
}
__device__ __forceinline__ void row_rstd(const float* ssq, int pm, int wr, int fr, int fq, float (&rs)[2][4]) {
#pragma unroll
    for (int ai = 0; ai < 2; ++ai)
#pragma unroll
        for (int m = 0; m < 4; ++m) {
            if (ssq) { const float* p = ssq + ((size_t)pm * 256 + ai * 128 + wr * 64 + m * 16 + fr) * 32 + 8 * fq; const f32x4 a = *(const f32x4*)p, b = *(const f32x4*)(p + 4);
                float t = ((a.x + a.y) + (a.z + a.w)) + ((b.x + b.y) + (b.z + b.w)); t += __shfl_xor(t, 16); t += __shfl_xor(t, 32); rs[ai][m] = 1.f / sqrtf(t * (1.f / 2048.f) + EPS); }
            else rs[ai][m] = 1.f; }
}
#define NT_LOAD(p) __builtin_nontemporal_load(p)
#define NT_STORE(v, p) __builtin_nontemporal_store((v), (p))
__device__ __forceinline__ void rope_cs(int pos, int i, int nf, float& c, float& s) {
    const float inv = exp2f(-(float)i / (float)nf * 13.287712379549449f);
    const double a = (double)pos * (double)inv * 0.15915494309189535;
    const float r = (float)(a - floor(a));
    c = __builtin_amdgcn_cosf(r); s = __builtin_amdgcn_sinf(r);
}

#define XB_TMO      128
#define XB_XCNT(j)  (256  + 64 * (j))
#define XB_XSUB(j)  (1280 + 64 * (j))
#define XB_XGEN(j)  (2304 + 64 * (j))
#define XB_TOP      3328
#define XB_TOPGEN   3392
#define XCD_BAR_WORDS 3456
#define XB_SPIN_CAP (1u << 22)
__device__ __forceinline__ unsigned xb_ld(unsigned* p)              { return __hip_atomic_load(p, __ATOMIC_RELAXED, __HIP_MEMORY_SCOPE_AGENT); }
__device__ __forceinline__ unsigned xb_add(unsigned* p, unsigned v) { return __hip_atomic_fetch_add(p, v, __ATOMIC_RELAXED, __HIP_MEMORY_SCOPE_AGENT); }
__device__ __forceinline__ unsigned xb_xcc_id() { return (unsigned)__builtin_amdgcn_s_getreg((3 << 11) | 20) & 0xFu; }
#define XB_SPIN(cond, bar) do { unsigned _sp = 0; while (cond) { __builtin_amdgcn_s_sleep(1); \
    if ((++_sp & 255u) == 0u) { if (xb_ld(&(bar)[XB_TMO])) break; if (_sp > XB_SPIN_CAP) { atomicAdd(&(bar)[XB_TMO], 1u); break; } } } } while (0)
struct XcdBarrier { unsigned* bar; unsigned x; volatile LAS unsigned* st; };
__device__ __forceinline__ XcdBarrier xcd_barrier_post(unsigned* bar, volatile LAS unsigned* st) {
    XcdBarrier b; b.bar = bar; b.x = xb_xcc_id(); b.st = st;
    if (threadIdx.x == 0) (void)xb_add(&bar[XB_XCNT(b.x)], 1u);
    return b;
}
__device__ __forceinline__ void xcd_barrier_complete(unsigned* bar, unsigned x, unsigned& nloc, unsigned& nx) {
    const unsigned G = gridDim.x * gridDim.y * gridDim.z;
    unsigned sum, cnt, mine, sp = 0u;
    for (;;) {
        sum = 0u; cnt = 0u; mine = 0u;
#pragma unroll
        for (unsigned j = 0; j < 16; ++j) { const unsigned c = xb_ld(&bar[XB_XCNT(j)]); sum += c; cnt += (c > 0u) ? 1u : 0u; mine = (j == x) ? c : mine; }
        if (sum == G) break;
        __builtin_amdgcn_s_sleep(1);
        if ((++sp & 255u) == 0u) { if (xb_ld(&bar[XB_TMO])) break; if (sp > XB_SPIN_CAP) { atomicAdd(&bar[XB_TMO], 1u); break; } }
    }
    nloc = mine > 0u ? mine : 1u; nx = cnt > 0u ? cnt : 1u;
}
__device__ __forceinline__ void xcd_barrier(const XcdBarrier& b, bool leader) {
    asm volatile("s_waitcnt vmcnt(0)" ::: "memory");
    __syncthreads();
    if (leader) {
        unsigned* bar = b.bar;
        __builtin_amdgcn_s_waitcnt(0);
        unsigned nloc = b.st[0], nx = b.st[1];
        if (nloc == 0u) { xcd_barrier_complete(bar, b.x, nloc, nx); b.st[0] = nloc; b.st[1] = nx; }
        const unsigned old = xb_add(&bar[XB_XSUB(b.x)], 1u);
        const unsigned gen = old / nloc;
        if (old + 1u == (gen + 1u) * nloc) {
            __builtin_amdgcn_fence(__ATOMIC_RELEASE, "agent");
            asm volatile("s_waitcnt vmcnt(0)" ::: "memory");
            const unsigned og = xb_add(&bar[XB_TOP], 1u);
            const unsigned tg = og / nx;
            if (og + 1u == (tg + 1u) * nx) xb_add(&bar[XB_TOPGEN], 1u);
            else XB_SPIN(xb_ld(&bar[XB_TOPGEN]) == tg, bar);
            __builtin_amdgcn_fence(__ATOMIC_ACQUIRE, "agent");
            xb_add(&bar[XB_XGEN(b.x)], 1u);
            asm volatile("s_waitcnt vmcnt(0)" ::: "memory");
        } else {
            XB_SPIN(xb_ld(&bar[XB_XGEN(b.x)]) == gen, bar);
            __builtin_amdgcn_fence(__ATOMIC_ACQUIRE, "agent");
            asm volatile("s_waitcnt vmcnt(0)" ::: "memory");
        }
    }
    __syncthreads();
}

constexpr int RING_OFF = 0, RING_BYTES = 139264;
constexpr int MISC_OFF = RING_BYTES;
constexpr int LDS_BYTES = 147456;
struct Args { const float* in[N_IN]; float* out; unsigned char* ws; int ph_lo, ph_hi; };
struct Frame {
    LAS unsigned char* lds; int tid, lane, wave, G, bid;
    const float* const* in; float* out; unsigned char* ws;
};

__device__ __forceinline__ int cmlp_col(int n) { return n < 4096 ? (n >> 7) * 256 + (n & 127) : n < 8192 ? n + 4096 : ((n - 8192) >> 7) * 256 + 128 + (n & 127); }
__device__ __forceinline__ void p0_transpose_item(const float* W, int K, int N, bf16* WT, LAS float* scr, int item, int lane, const float* ksc = nullptr, bool cperm = false) {
    const int nblk = N / 32, kb = item / nblk, nb = item % nblk, k0 = 64 * kb, n0 = 32 * nb;
    float w_[32];
#pragma unroll
    for (int i = 0; i < 32; ++i) w_[i] = NT_LOAD(W + (size_t)(k0 + 2 * i + (lane >> 5)) * N + n0 + (lane & 31));
#pragma unroll
    for (int i = 0; i < 32; ++i) { const int kk = 2 * i + (lane >> 5); scr[kk * 33 + (lane & 31)] = ksc ? w_[i] * ksc[k0 + kk] : w_[i]; }
    LDS_WAIT(); asm volatile("" ::: "memory");
    const int c = lane & 7;
#pragma unroll
    for (int j = 0; j < 4; ++j) { const int n = (lane >> 3) + 8 * j; const LAS float* s = scr + (8 * c) * 33 + n;
        v4u o; o.x = pk2(s[0 * 33], s[1 * 33]); o.y = pk2(s[2 * 33], s[3 * 33]); o.z = pk2(s[4 * 33], s[5 * 33]); o.w = pk2(s[6 * 33], s[7 * 33]);
        *(GAS v4u*)(WT + (size_t)((cperm ? cmlp_col(n0) : n0) + n) * K + k0 + 8 * c) = o; }
    LDS_WAIT(); asm volatile("" ::: "memory");
}
__device__ __forceinline__ void transpose_weight(Frame& F, const float* W, int K, int N, bf16* WT) {
    LAS float* scr = (LAS float*)(F.lds + RING_OFF + F.wave * 16384);
    const int gw = F.bid * NWAVES + F.wave, NGW = F.G * NWAVES, nitems = (K / 64) * (N / 32);
    for (int it = gw; it < nitems; it += NGW) p0_transpose_item(W, K, N, WT, scr, it, F.lane);
}
__device__ __forceinline__ void norm_rows(Frame& F, const float* src_p, const float* src_s, const float* w, bf16* XN) {
    const int gw = F.bid * NWAVES + F.wave, NGW = F.G * NWAVES;
    const GAS f32x4* wr = (const GAS f32x4*)w + F.lane;
    f32x4 nx[8];
    if (gw < MT) { const float* xrow = (gw < MP) ? src_p + (size_t)gw * DM : src_s + (size_t)(gw - MP) * DM;
#pragma unroll
        for (int j = 0; j < 8; ++j) nx[j] = __builtin_nontemporal_load((const f32x4*)(xrow) + F.lane + 64 * j); }
    for (int m = gw; m < MT; m += NGW) {
        f32x4 v[8]; float s = 0.f;
#pragma unroll
        for (int j = 0; j < 8; ++j) v[j] = nx[j];
        const int m2 = m + NGW;
        if (m2 < MT) { const float* xrow = (m2 < MP) ? src_p + (size_t)m2 * DM : src_s + (size_t)(m2 - MP) * DM;
#pragma unroll
            for (int j = 0; j < 8; ++j) nx[j] = __builtin_nontemporal_load((const f32x4*)(xrow) + F.lane + 64 * j); }
#pragma unroll
        for (int j = 0; j < 8; ++j) s += (v[j].x * v[j].x + v[j].y * v[j].y) + (v[j].z * v[j].z + v[j].w * v[j].w);
        const float rstd = 1.f / sqrtf(wave_sum(s) * (1.f / DM) + EPS);
        GAS v2u* o8 = (GAS v2u*)(XN + (size_t)m * DM) + F.lane;
#pragma unroll
        for (int j = 0; j < 8; ++j) { const f32x4 g = wr[64 * j]; v2u o; o.x = pk2(v[j].x * rstd * g.x, v[j].y * rstd * g.y); o.y = pk2(v[j].z * rstd * g.z, v[j].w * rstd * g.w); o8[64 * j] = o; }
    }
}
__device__ __forceinline__ void cache_cvt(Frame& F, const float* ck, const float* cv, bf16* KC, bf16* VC) {
    const size_t nvec = (size_t)NB * PAST * DM / 4;
    const size_t gt = (size_t)F.bid * NTHR + F.tid, NG = (size_t)F.G * NTHR;
    for (size_t i = gt; i < 2 * nvec; i += NG) {
        const bool isv = i >= nvec; const size_t e = (isv ? i - nvec : i) * 4;
        const size_t brow = e / DM, col = e % DM, b = brow / PAST, t = brow % PAST;
        const f32x4 x = *(const GAS f32x4*)((isv ? cv : ck) + e);
        v2u o; o.x = pk2(x.x, x.y); o.y = pk2(x.z, x.w);
        *(GAS v2u*)((isv ? VC : KC) + ((b * KCROWS + t) * DM + col)) = o;
    }
}
__device__ __forceinline__ int tw_chunks(int K, int N) { return (K / 64) * (N / 32) / 64; }
__device__ __forceinline__ void tw_run(Frame& F, const float* W, int K, int N, bf16* WT, int c, const float* ksc = nullptr, bool cperm = false) {
    LAS float* scr = (LAS float*)(F.lds + RING_OFF + F.wave * 16384);
#pragma unroll 1
    for (int i = 0; i < 8; ++i) p0_transpose_item(W, K, N, WT, scr, c * 64 + F.wave * 8 + i, F.lane, ksc, cperm);
}
constexpr int CC_CHUNKS = 2 * (NB * PAST * DM / 4) / 8192;
__device__ __forceinline__ void cc_run(Frame& F, const float* ck, const float* cv, bf16* KC, bf16* VC, int c) {
    const bool isv = c >= CC_CHUNKS / 2; const int brow0 = (isv ? c - CC_CHUNKS / 2 : c) * 16, b = brow0 / PAST, t0 = brow0 % PAST;
    const float* src = (isv ? cv : ck) + (size_t)brow0 * DM + F.tid * 4;
    bf16* dst = (isv ? VC : KC) + ((size_t)b * KCROWS + t0) * DM + F.tid * 4;
    f32x4 x[16];
#pragma unroll
    for (int k = 0; k < 16; ++k) x[k] = NT_LOAD((const f32x4*)(src + (size_t)k * DM));
#pragma unroll
    for (int k = 0; k < 16; ++k) { v2u o; o.x = pk2(x[k].x, x[k].y); o.y = pk2(x[k].z, x[k].w); *(GAS v2u*)(dst + (size_t)k * DM) = o; }
}
constexpr int TR_CHUNKS = MP * 128 / 8192;
__device__ __forceinline__ void tr_run(Frame& F, float* tab, int c) {
#pragma unroll 1
    for (int k = 0; k < 16; ++k) { const size_t e = (size_t)c * 8192 + k * NTHR + F.tid; float cs, sn; rope_cs((int)(e >> 7), (int)(e & 127), 128, cs, sn); tab[2 * e] = cs; tab[2 * e + 1] = sn; }
}
__device__ __forceinline__ int row_pos(int row) { return row < MP ? row : PAST + ((row - MP) & 63); }

struct EpiAIn {
    static constexpr int BMODE = 2;
    pg8::bf16_t *Qs, *KP, *VP, *KC, *VC, *GA; float *okp, *ovp, *oks, *ovs; const float* tab; const float* qg; const float* kg; const float* ssq;
    __device__ __forceinline__ void operator()(const pg8::f32x4 (&acc)[2][2][4][2], const pg8::Unit& u, int wr, int wc, int fr, int fq) const {
        { const int l_ = lane_now(); fr = l_ & 15; fq = l_ >> 4; }
        const int pn = u.pn, pm = u.pm, typ = pn >> 3, cl = ((pn & 7) * 4 + wc) * 64 + 8 * fq; float rs[2][4]; row_rstd(ssq, pm, wr, fr, fq, rs);
        float g1[8], g2[8];
        if (typ < 2) { const float* gp = (typ == 0 ? qg : kg) + 8 * fq; const pg8::f32x4 a = *(const pg8::f32x4*)gp, b = *(const pg8::f32x4*)(gp + 4), c = *(const pg8::f32x4*)(gp + 32), d = *(const pg8::f32x4*)(gp + 36);
#pragma unroll
            for (int e = 0; e < 4; ++e) { g1[e] = a[e]; g1[4 + e] = b[e]; g2[e] = c[e]; g2[4 + e] = d[e]; } }
#pragma unroll
        for (int ai = 0; ai < 2; ++ai)
#pragma unroll
          for (int mp = 0; mp < 2; ++mp) {
            pg8::f32x4 tq[4][4];
            if (typ < 2) {
#pragma unroll
                for (int m = 2 * mp; m < 2 * mp + 2; ++m) { const int i_ = ai * 128 + wr * 64 + m * 16 + fr; const int pos_ = pm < 64 ? pm * 256 + i_ : PAST + (i_ & 63); const float* tp_ = tab + ((size_t)pos_ * 32 + 8 * fq) * 2;
#pragma unroll
                    for (int q4 = 0; q4 < 4; ++q4) tq[m][q4] = *(const pg8::f32x4*)(tp_ + 4 * q4); } }
#pragma unroll
            for (int m = 2 * mp; m < 2 * mp + 2; ++m) {
                const int i = ai * 128 + wr * 64 + m * 16 + fr; const size_t row = (size_t)pm * 256 + i;
                float x1[8], x2[8];
#pragma unroll
                for (int e = 0; e < 4; ++e) { x1[e] = acc[ai][0][m][0][e] * rs[ai][m]; x1[4 + e] = acc[ai][0][m][1][e] * rs[ai][m]; x2[e] = acc[ai][1][m][0][e] * rs[ai][m]; x2[4 + e] = acc[ai][1][m][1][e] * rs[ai][m]; }
                size_t drow; pg8::bf16_t* dk; pg8::bf16_t* dv; float* fk; float* fv;
                if (pm < 64) { drow = row; dk = KP; dv = VP; fk = okp + row * DM; fv = ovp + row * DM; }
                else { const int s_ = (int)(row - MP); drow = (size_t)(s_ >> 6) * KCROWS + PAST + (s_ & 63); dk = KC; dv = VC; fk = oks + (size_t)s_ * DM; fv = ovs + (size_t)s_ * DM; }
                if (typ < 2) {
                    float ss = 0.f;
#pragma unroll
                    for (int k = 0; k < 8; ++k) ss += x1[k] * x1[k] + x2[k] * x2[k];
                    ss += __shfl_xor(ss, 16); ss += __shfl_xor(ss, 32);
                    const float rstd = 1.f / sqrtf(ss * (1.f / 64.f) + EPS);
                    float o1[8], o2[8];
#pragma unroll
                    for (int q4 = 0; q4 < 4; ++q4) { const pg8::f32x4 t = tq[m][q4];
#pragma unroll
                        for (int z = 0; z < 2; ++z) { const int k = 2 * q4 + z; const float c = t[2 * z], s = t[2 * z + 1], y1 = x1[k] * rstd * g1[k], y2 = x2[k] * rstd * g2[k]; o1[k] = y1 * c - y2 * s; o2[k] = y2 * c + y1 * s; } }
                    if (typ == 0) { v4u w1, w2;
                        w1.x = pk2(o1[0] * C2, o1[1] * C2); w1.y = pk2(o1[2] * C2, o1[3] * C2); w1.z = pk2(o1[4] * C2, o1[5] * C2); w1.w = pk2(o1[6] * C2, o1[7] * C2);
                        w2.x = pk2(o2[0] * C2, o2[1] * C2); w2.y = pk2(o2[2] * C2, o2[3] * C2); w2.z = pk2(o2[4] * C2, o2[5] * C2); w2.w = pk2(o2[6] * C2, o2[7] * C2);
                        *(v4u*)(Qs + row * DM + cl) = w1; *(v4u*)(Qs + row * DM + cl + 32) = w2;
                    } else { v4u w1, w2;
                        w1.x = pk2(o1[0], o1[1]); w1.y = pk2(o1[2], o1[3]); w1.z = pk2(o1[4], o1[5]); w1.w = pk2(o1[6], o1[7]);
                        w2.x = pk2(o2[0], o2[1]); w2.y = pk2(o2[2], o2[3]); w2.z = pk2(o2[4], o2[5]); w2.w = pk2(o2[6], o2[7]);
                        *(v4u*)(dk + drow * DM + cl) = w1; *(v4u*)(dk + drow * DM + cl + 32) = w2;
                        NT_STORE(((pg8::f32x4){o1[0], o1[1], o1[2], o1[3]}), (pg8::f32x4*)(fk + cl)); NT_STORE(((pg8::f32x4){o1[4], o1[5], o1[6], o1[7]}), (pg8::f32x4*)(fk + cl + 4));
                        NT_STORE(((pg8::f32x4){o2[0], o2[1], o2[2], o2[3]}), (pg8::f32x4*)(fk + cl + 32)); NT_STORE(((pg8::f32x4){o2[4], o2[5], o2[6], o2[7]}), (pg8::f32x4*)(fk + cl + 36)); }
                } else { v4u w1, w2;
                    w1.x = pk2(x1[0], x1[1]); w1.y = pk2(x1[2], x1[3]); w1.z = pk2(x1[4], x1[5]); w1.w = pk2(x1[6], x1[7]);
                    w2.x = pk2(x2[0], x2[1]); w2.y = pk2(x2[2], x2[3]); w2.z = pk2(x2[4], x2[5]); w2.w = pk2(x2[6], x2[7]);
                    if (typ == 2) { *(v4u*)(dv + drow * DM + cl) = w1; *(v4u*)(dv + drow * DM + cl + 32) = w2;
                        NT_STORE(((pg8::f32x4){x1[0], x1[1], x1[2], x1[3]}), (pg8::f32x4*)(fv + cl)); NT_STORE(((pg8::f32x4){x1[4], x1[5], x1[6], x1[7]}), (pg8::f32x4*)(fv + cl + 4));
                        NT_STORE(((pg8::f32x4){x2[0], x2[1], x2[2], x2[3]}), (pg8::f32x4*)(fv + cl + 32)); NT_STORE(((pg8::f32x4){x2[4], x2[5], x2[6], x2[7]}), (pg8::f32x4*)(fv + cl + 36)); }
                    else { *(v4u*)(GA + row * DM + cl) = w1; *(v4u*)(GA + row * DM + cl + 32) = w2; }
                }
                if (m & 1) asm volatile("" ::: "memory");
            }
        }
    }
};
__device__ __forceinline__ void attn_table(Frame& F, float* tab) {
    const size_t gt = (size_t)F.bid * NTHR + F.tid, NG = (size_t)F.G * NTHR;
    for (size_t e = gt; e < (size_t)MP * 32; e += NG) { float c, s; rope_cs((int)(e >> 5), (int)(e & 31), 32, c, s); tab[2 * e] = c; tab[2 * e + 1] = s; }
}
namespace dattn {
typedef short bf16x8 __attribute__((ext_vector_type(8)));
typedef short s16x4 __attribute__((ext_vector_type(4)));
typedef short v4i16_t __attribute__((ext_vector_type(4)));
typedef float f32x16 __attribute__((ext_vector_type(16)));
typedef unsigned u32x4 __attribute__((ext_vector_type(4)));
typedef __attribute__((address_space(3))) const char* lds_cptr;
constexpr int RINGB = 98304, WSF_OFF = RINGB, XCHB = 18432, STP = 144;
__device__ __forceinline__ int crow(int r, int hi) { return (r & 3) + 8 * (r >> 2) + 4 * hi; }
__device__ __forceinline__ void glds16(const void* gsrc, unsigned lds_dst) { unsigned keep;
    asm volatile("s_mov_b32 %0, m0\n\ts_mov_b32 m0, %2\n\ts_nop 0\n\tglobal_load_lds_dwordx4 %1, off\n\ts_mov_b32 m0, %0" : "=&s"(keep) : "v"(gsrc), "s"(lds_dst) : "memory"); }
typedef float f32x2_t __attribute__((ext_vector_type(2))); typedef __bf16 bf16x2_t __attribute__((ext_vector_type(2)));
__device__ __forceinline__ unsigned cvtpk_s(float lo, float hi) { f32x2_t v = {lo, hi}; bf16x2_t b = __builtin_convertvector(v, bf16x2_t); return __builtin_bit_cast(unsigned, b); }
#define DA_WAIT_BAR(N) asm volatile("s_waitcnt vmcnt(" #N ") lgkmcnt(0)\n\ts_barrier" ::: "memory")
__device__ __forceinline__ s16x4 vtr(lds_cptr p) { return __builtin_bit_cast(s16x4, __builtin_amdgcn_ds_read_tr16_b64_v4i16((__attribute__((address_space(3))) v4i16_t*)p)); }
struct Unit { const bf16* Q; const bf16* K; const bf16* V; const bf16* G; bf16* AO; int NT; int full; int dma0; };

constexpr int KSLOT = 16384, VSLOT = 16384, VRING = 3 * KSLOT;
#define DA_SBAR() __builtin_amdgcn_sched_barrier(0)
#define DA_PIN(x) asm volatile("" : "+v"(x))
#define DA_MFMA(a, b, c) __builtin_amdgcn_mfma_f32_32x32x16_bf16(a, b, c, 0, 0, 0)
struct DmaJob { const bf16* kp; const bf16* vp; unsigned kd0, kd1, vd0, vd1; };
__device__ __forceinline__ void dma_piece(const DmaJob& j, int i) { if (i == 0) glds16(j.kp, j.kd0); else if (i == 1) glds16(j.kp + 64, j.kd1); else if (i == 2) glds16(j.vp, j.vd0); else glds16(j.vp + 64, j.vd1); }
template <bool QK, bool PV, int VAR>
__device__ __forceinline__ void step(lds_cptr kpn, lds_cptr vp, const bf16x8 (&qr)[4], bf16x8 (&kf)[8], f32x16 (&o)[4], u32x4 (&pw)[4], float& l_reg, const DmaJob& dj) {
    f32x16 C0 = f32x16{}, C1 = f32x16{};
    s16x4 vlo[4], vhi[4];
    if constexpr (!QK) { dma_piece(dj, 0); dma_piece(dj, 1); dma_piece(dj, 2); dma_piece(dj, 3); }
#define DA_FOFF(f) ((((f) & 3) * 4096) + (((f) >> 2) * 1024))
#pragma unroll
    for (int a = 0; a < 8; ++a) {
        if constexpr (PV) { if (a >= 4) { if (VAR != 4) { vlo[a - 4] = vtr(vp + DA_FOFF(a - 4)); vhi[a - 4] = vtr(vp + DA_FOFF(a - 4) + 512); } else { vlo[a - 4] = s16x4{1, 2, 3, 4}; vhi[a - 4] = s16x4{5, 6, 7, 8}; } DA_SBAR(); } }
        if constexpr (QK) {
            if (a & 1) C1 = (a < 2) ? DA_MFMA(kf[a], qr[a >> 1], f32x16{}) : DA_MFMA(kf[a], qr[a >> 1], C1);
            else       C0 = (a < 2) ? DA_MFMA(kf[a], qr[a >> 1], f32x16{}) : DA_MFMA(kf[a], qr[a >> 1], C0);
            if (a < 4) dma_piece(dj, a);
            DA_SBAR();
        }
    }
    u32x4 pwn[4]; pwn[0] = u32x4{}; pwn[1] = u32x4{}; pwn[2] = u32x4{}; pwn[3] = u32x4{};
    float s0 = 0.f, s1 = 0.f;
#pragma unroll
    for (int p = 0; p < 16; ++p) {
        if constexpr (PV) {
            const bf16x8 vf = (bf16x8){vlo[p & 3][0], vlo[p & 3][1], vlo[p & 3][2], vlo[p & 3][3], vhi[p & 3][0], vhi[p & 3][1], vhi[p & 3][2], vhi[p & 3][3]};
            if (VAR != 3) o[p & 3] = DA_MFMA(__builtin_bit_cast(bf16x8, pw[p >> 2]), vf, o[p & 3]); else { o[p & 3][0] += __builtin_bit_cast(float, (int)vf[0] | ((int)vf[4] << 16)); }
            if (p < 12 && VAR != 4) { vlo[p & 3] = vtr(vp + DA_FOFF(p + 4)); vhi[p & 3] = vtr(vp + DA_FOFF(p + 4) + 512); }
        }
        if constexpr (QK) {
            float e0, e1;
            if (VAR == 2) { if (p < 8) { e0 = C0[2 * p]; e1 = C0[2 * p + 1]; } else { e0 = C1[2 * p - 16]; e1 = C1[2 * p - 15]; } }
            else if (p < 8) { e0 = __builtin_amdgcn_exp2f(C0[2 * p]); e1 = __builtin_amdgcn_exp2f(C0[2 * p + 1]); }
            else       { e0 = __builtin_amdgcn_exp2f(C1[2 * p - 16]); e1 = __builtin_amdgcn_exp2f(C1[2 * p - 15]); }
            s0 += e0; s1 += e1; pwn[p >> 2][p & 3] = cvtpk_s(e0, e1);
            DA_PIN(s0); DA_PIN(s1); DA_PIN(pwn[p >> 2]);
            if (p >= 8 && VAR != 6) { const int j = p - 8; kf[j] = *(const __attribute__((address_space(3))) bf16x8*)(kpn + (j >> 1) * 2048 + (j & 1) * 512); }
        }
        DA_SBAR();
    }
    if constexpr (QK) { l_reg += s0 + s1; pw[0] = pwn[0]; pw[1] = pwn[1]; pw[2] = pwn[2]; pw[3] = pwn[3]; }
#undef DA_FOFF
}

template <bool QK, bool PV>
__device__ __forceinline__ void step2(lds_cptr kpn, lds_cptr vp, const bf16x8 (&qr)[4], bf16x8 (&kf)[8], f32x16 (&o)[4], u32x4 (&pw)[4], float& l_reg, const DmaJob& dj,
                                      f32x16& Cn0, f32x16& Cn1, const f32x16& Pp0, const f32x16& Pp1) {
    s16x4 vlo[4], vhi[4];
#define DA_FOFF(f) ((((f) & 3) * 4096) + (((f) >> 2) * 1024))
    if constexpr (!QK) { dma_piece(dj, 0); dma_piece(dj, 1); dma_piece(dj, 2); dma_piece(dj, 3); }
    float s0 = 0.f, s1 = 0.f;
#pragma unroll
    for (int a = 0; a < 8; ++a) {
        if constexpr (PV) { if (a >= 4) { vlo[a - 4] = vtr(vp + DA_FOFF(a - 4)); vhi[a - 4] = vtr(vp + DA_FOFF(a - 4) + 512); DA_SBAR(); } }
        if constexpr (QK) {
            if (a & 1) Cn1 = (a < 2) ? DA_MFMA(kf[a], qr[a >> 1], f32x16{}) : DA_MFMA(kf[a], qr[a >> 1], Cn1);
            else       Cn0 = (a < 2) ? DA_MFMA(kf[a], qr[a >> 1], f32x16{}) : DA_MFMA(kf[a], qr[a >> 1], Cn0);
            if (a < 4) dma_piece(dj, a);
        }
        if constexpr (PV) {
            float x0, x1, x2, x3;
            if (a < 4) { x0 = Pp0[4 * a]; x1 = Pp0[4 * a + 1]; x2 = Pp0[4 * a + 2]; x3 = Pp0[4 * a + 3]; }
            else       { x0 = Pp1[4 * a - 16]; x1 = Pp1[4 * a - 15]; x2 = Pp1[4 * a - 14]; x3 = Pp1[4 * a - 13]; }
            s0 += x0; s1 += x1; s0 += x2; s1 += x3;
            pw[(2 * a) >> 2][(2 * a) & 3] = cvtpk_s(x0, x1); pw[(2 * a + 1) >> 2][(2 * a + 1) & 3] = cvtpk_s(x2, x3);
            DA_PIN(s0); DA_PIN(s1); DA_PIN(pw[(2 * a) >> 2]);
        }
        if constexpr (QK || PV) DA_SBAR();
    }
    if constexpr (PV) l_reg += s0 + s1;
#pragma unroll
    for (int p = 0; p < 16; ++p) {
        if constexpr (PV) {
            const bf16x8 vf = (bf16x8){vlo[p & 3][0], vlo[p & 3][1], vlo[p & 3][2], vlo[p & 3][3], vhi[p & 3][0], vhi[p & 3][1], vhi[p & 3][2], vhi[p & 3][3]};
            o[p & 3] = DA_MFMA(__builtin_bit_cast(bf16x8, pw[p >> 2]), vf, o[p & 3]);
            if (p < 12) { vlo[p & 3] = vtr(vp + DA_FOFF(p + 4)); vhi[p & 3] = vtr(vp + DA_FOFF(p + 4) + 512); }
        }
        if constexpr (QK) {
            if (p < 8) { Cn0[2 * p] = __builtin_amdgcn_exp2f(Cn0[2 * p]); Cn0[2 * p + 1] = __builtin_amdgcn_exp2f(Cn0[2 * p + 1]); DA_PIN(Cn0); }
            else       { Cn1[2 * p - 16] = __builtin_amdgcn_exp2f(Cn1[2 * p - 16]); Cn1[2 * p - 15] = __builtin_amdgcn_exp2f(Cn1[2 * p - 15]); DA_PIN(Cn1); }
            if (p >= 8) { const int j = p - 8; kf[j] = *(const __attribute__((address_space(3))) bf16x8*)(kpn + (j >> 1) * 2048 + (j & 1) * 512); }
        }
        if constexpr (QK || PV) DA_SBAR();
    }
#undef DA_FOFF
}

__device__ __forceinline__ void unit_prologue(const Unit& u, unsigned lds0, int lane, int wid, bf16x8 (&qr)[4]) {
    const int r32 = lane & 31, hi = lane >> 5, s = wid >> 2, g = wid & 3; const int NT = u.NT; const int wt = u.full ? (g < 2 ? NT - 1 : NT) : (g < 2 ? NT : 0);
    const bf16* ksrc = u.K + (long)lane * DM + wid * 8;
    const bf16* vsrc = u.V + (long)(16 * (wid & 3) + (lane >> 2)) * DM + (wid >> 2) * 32 + (lane & 3) * 8;
    const unsigned kdst = lds0 + wid * 1024, vdst = lds0 + VRING + wid * 1024;
#pragma unroll
    for (int t = 0; t < 3; ++t) { const int tt_ = t < NT ? t : NT - 1; const bf16* kp_ = ksrc + (long)tt_ * 64 * DM;
        glds16(kp_, (unsigned)__builtin_amdgcn_readfirstlane(kdst + t * KSLOT)); glds16(kp_ + 64, (unsigned)__builtin_amdgcn_readfirstlane(kdst + 8192 + t * KSLOT)); }
    glds16(vsrc, (unsigned)__builtin_amdgcn_readfirstlane(vdst)); glds16(vsrc + 64, (unsigned)__builtin_amdgcn_readfirstlane(vdst + 8192));
    const bf16* Qw = u.Q + (long)(32 * g + r32) * DM + s * 64;
#pragma unroll
    for (int d0 = 0; d0 < 4; ++d0) qr[d0] = (wt > 0) ? *reinterpret_cast<const bf16x8*>(Qw + d0 * 16 + hi * 8) : (bf16x8){0, 0, 0, 0, 0, 0, 0, 0};
}
template <int VAR>
__device__ __forceinline__ void attn_unit(const Unit& u, bool has_next, const Unit& nxt, bool prefetched, bf16x8 (&qr)[4], char* shm, float* wsf_base, float lam, float one_m_li, const float* sub_gain, int tid) {
    asm volatile("" : "+v"(tid));
    const int lane = tid & 63, r32 = lane & 31, hi = lane >> 5; const int wid = __builtin_amdgcn_readfirstlane(tid >> 6), s = wid >> 2, g = wid & 3;
    const int NT = u.NT; const int wt = u.full ? (g < 2 ? NT - 1 : NT) : (g < 2 ? NT : 0);
    const unsigned lds0 = (unsigned)(uintptr_t)shm;
    float* wsf = wsf_base + wid * 64;
    const bf16* ksrc = u.K + (long)lane * DM + wid * 8;
    const bf16* vsrc = u.V + (long)(16 * (wid & 3) + (lane >> 2)) * DM + (wid >> 2) * 32 + (lane & 3) * 8;
    const unsigned kdst = lds0 + wid * 1024, vdst = lds0 + VRING + wid * 1024;
#define DA_DMA_K(t, slot) do { const int tt_ = u.dma0 ? 0 : (t) < NT ? (t) : NT - 1; const bf16* kp_ = ksrc + (long)tt_ * 64 * DM; \
        glds16(kp_, (unsigned)__builtin_amdgcn_readfirstlane(kdst + (slot) * KSLOT)); glds16(kp_ + 64, (unsigned)__builtin_amdgcn_readfirstlane(kdst + 8192 + (slot) * KSLOT)); } while (0)
#define DA_DMA_V(t, slot) do { const int tt_ = u.dma0 ? 0 : (t) < NT ? (t) : NT - 1; const bf16* vp_ = vsrc + (long)tt_ * 64 * DM; \
        glds16(vp_, (unsigned)__builtin_amdgcn_readfirstlane(vdst + (slot) * VSLOT)); glds16(vp_ + 64, (unsigned)__builtin_amdgcn_readfirstlane(vdst + 8192 + (slot) * VSLOT)); } while (0)
    const lds_cptr shm3 = (lds_cptr)shm;
    const lds_cptr kp0 = shm3 + s * 8192 + hi * 1024 + r32 * 16;
    const lds_cptr vp0 = shm3 + VRING + ((lane >> 4) & 1) * 32 + (lane & 3) * 8 + (4 * hi + ((lane & 15) >> 2)) * 64;
    if (!prefetched) unit_prologue(u, lds0, lane, wid, qr);
    asm volatile("" : "+v"(qr[0]), "+v"(qr[1]), "+v"(qr[2]), "+v"(qr[3]));
    f32x16 o[4]; o[0] = f32x16{}; o[1] = f32x16{}; o[2] = f32x16{}; o[3] = f32x16{};
    float l_reg = 0.f;
    u32x4 pw[4]; pw[0] = u32x4{}; pw[1] = u32x4{}; pw[2] = u32x4{}; pw[3] = u32x4{};
    DA_WAIT_BAR(0);
    bf16x8 kf[8];
#pragma unroll
    for (int j = 0; j < 8; ++j) kf[j] = *(const __attribute__((address_space(3))) bf16x8*)(kp0 + (j >> 1) * 2048 + (j & 1) * 512);
    int ks_cur = 0  , vs_prev = 2  ;
#define DA_TOP(t) \
        DA_WAIT_BAR(4);                                          \
        const int ks_next = (ks_cur == 2) ? 0 : ks_cur + 1, vs_cur = (vs_prev == 2) ? 0 : vs_prev + 1, vs_next = (vs_cur == 2) ? 0 : vs_cur + 1; \
        DmaJob dj; { const int tk_ = ((t) + 3) < NT ? ((t) + 3) : NT - 1, tv_ = ((t) + 1) < NT ? ((t) + 1) : NT - 1; dj.kp = ksrc + (long)tk_ * 64 * DM; dj.vp = vsrc + (long)tv_ * 64 * DM; \
          dj.kd0 = (unsigned)__builtin_amdgcn_readfirstlane(kdst + ks_cur * KSLOT); dj.kd1 = dj.kd0 + 8192u; dj.vd0 = (unsigned)__builtin_amdgcn_readfirstlane(vdst + vs_next * VSLOT); dj.vd1 = dj.vd0 + 8192u; }     \
        const lds_cptr kpn = kp0 + ks_next * KSLOT; const lds_cptr vp = vp0 + vs_prev * VSLOT; (void)kpn; (void)vp
#define DA_ROT() do { ks_cur = ks_next; vs_prev = vs_cur; } while (0)
    f32x16 pA0 = f32x16{}, pA1 = f32x16{}, pB0 = f32x16{}, pB1 = f32x16{};
#define DA_IDLE() do { dma_piece(dj, 0); dma_piece(dj, 1); dma_piece(dj, 2); dma_piece(dj, 3); } while (0)
    if (wid >= 4) __builtin_amdgcn_s_setprio(1);
    int t = 0;
    const bool odd = ((wt - 1) & 1) != 0;
    { DA_TOP(0); if (wt > 0) { if (odd) step2<true, false>(kpn, vp, qr, kf, o, pw, l_reg, dj, pB0, pB1, pA0, pA1); else step2<true, false>(kpn, vp, qr, kf, o, pw, l_reg, dj, pA0, pA1, pB0, pB1); } else DA_IDLE(); DA_ROT(); }
    t = 1;
    if (wt > 0 && odd) { DA_TOP(t); step2<true, true>(kpn, vp, qr, kf, o, pw, l_reg, dj, pA0, pA1, pB0, pB1); DA_ROT(); ++t; }
    for (; t + 1 < wt; t += 2) {
        { DA_TOP(t);     step2<true, true>(kpn, vp, qr, kf, o, pw, l_reg, dj, pB0, pB1, pA0, pA1); DA_ROT(); }
        { DA_TOP(t + 1); step2<true, true>(kpn, vp, qr, kf, o, pw, l_reg, dj, pA0, pA1, pB0, pB1); DA_ROT(); }
    }
    if (wt > 0) { DA_TOP(t); step2<false, true>(kpn, vp, qr, kf, o, pw, l_reg, dj, pB0, pB1, pA0, pA1); DA_ROT(); ++t; }
    for (; t <= NT; ++t) { DA_TOP(t); DA_IDLE(); DA_ROT(); }
#undef DA_IDLE
#undef DA_TOP
#undef DA_ROT
    __builtin_amdgcn_s_setprio(0);
    { auto rr = __builtin_amdgcn_permlane32_swap(__float_as_uint(l_reg), __float_as_uint(l_reg), false, false); l_reg = __uint_as_float(rr[0]) + __uint_as_float(rr[1]); }
    if (hi == 0) wsf[r32] = l_reg;
    DA_WAIT_BAR(0);
    if (has_next) unit_prologue(nxt, lds0, lane, wid, qr);
    int le = lane; asm volatile("" : "+v"(le));
    const int r32e = le & 31, hie = le >> 5;
    v4u g4r[8]; f32x4 sga[8], sgb[8];
    if (s == 0 && wt > 0) { const bf16* gp_ = u.G + (long)(32 * g + (le >> 1)) * DM + (le & 1) * 64; const float* sg_ = sub_gain + (le & 1) * 64;
#pragma unroll
        for (int k = 0; k < 8; ++k) { g4r[k] = *(const v4u*)(gp_ + 8 * k); sga[k] = *(const f32x4*)(sg_ + 8 * k); sgb[k] = *(const f32x4*)(sg_ + 8 * k + 4); } }
    float rli[16];
#pragma unroll
    for (int r = 0; r < 16; ++r) { const float lq = wsf[crow(r, hi)]; rli[r] = (s == 0 ? 1.f : -lam) / lq; }
    float* xch = (float*)(shm + 65536 + g * XCHB);
    if (s == 1 && wt > 0) {
#pragma unroll
        for (int db = 0; db < 4; ++db)
#pragma unroll
            for (int r = 0; r < 16; ++r) xch[(db * 16 + r) * 64 + le] = o[db][r] * rli[r];
    }
    asm volatile("s_waitcnt lgkmcnt(0)\n\ts_barrier" ::: "memory");
    if (s == 0 && wt > 0) {
#pragma unroll
        for (int db = 0; db < 4; ++db)
#pragma unroll
            for (int r = 0; r < 16; ++r) o[db][r] = o[db][r] * rli[r] + xch[(db * 16 + r) * 64 + le];
        asm volatile("s_waitcnt lgkmcnt(0)" ::: "memory");
#pragma unroll
        for (int db = 0; db < 4; ++db)
#pragma unroll
            for (int r = 0; r < 16; ++r) xch[crow(r, hie) * STP + 32 * db + r32e] = o[db][r];
        asm volatile("s_waitcnt lgkmcnt(0)" ::: "memory");
        const int row = le >> 1, half = le & 1;
        float v[64]; float ss = 0.f;
#pragma unroll
        for (int k = 0; k < 16; ++k) { const f32x4 x = *(const f32x4*)(xch + row * STP + half * 64 + 4 * k); v[4 * k] = x.x; v[4 * k + 1] = x.y; v[4 * k + 2] = x.z; v[4 * k + 3] = x.w; ss += (x.x * x.x + x.y * x.y) + (x.z * x.z + x.w * x.w); }
        ss += __shfl_xor(ss, 1);
        const float sc = one_m_li / sqrtf(ss * (1.f / 128.f) + EPS);
        bf16* op = u.AO + (long)(32 * g + row) * DM + half * 64;
#pragma unroll
        for (int k = 0; k < 8; ++k) { const v4u g4 = g4r[k]; const f32x4 ga = sga[k], gb = sgb[k];
            const float gg[8] = {bflo(g4.x), bfhi(g4.x), bflo(g4.y), bfhi(g4.y), bflo(g4.z), bfhi(g4.z), bflo(g4.w), bfhi(g4.w)};
            const float gn[8] = {ga.x, ga.y, ga.z, ga.w, gb.x, gb.y, gb.z, gb.w}; float y[8];
#pragma unroll
            for (int e = 0; e < 8; ++e) y[e] = v[8 * k + e] * sc * gn[e] * silu_f(gg[e]);
            v4u w; w.x = pk2(y[0], y[1]); w.y = pk2(y[2], y[3]); w.z = pk2(y[4], y[5]); w.w = pk2(y[6], y[7]);
            *(v4u*)(op + 8 * k) = w; }
    }
#undef DA_DMA_K
#undef DA_DMA_V
}
}
template <int VAR = 0>
__device__ __forceinline__ void attn_fast(Frame& F, const bf16* Qs, const bf16* KP, const bf16* VP, const bf16* KC, const bf16* VC, const bf16* GA  , bf16* AO,
                                          float lam, float one_m_li, const float* sub_gain, int dma0 = 0) {
    const int NU = 2048 + 16 * NB;
    const bool xcd = (F.G == 256);
#define ATTN_GET(i_, u_, ok_) do { int qb = 0, h = 0, b = -1; ok_ = true; \
        if (xcd) { const int x = F.bid & 7, r = F.bid >> 3; \
            if ((i_) < 8) { h = x + 8 * ((i_) >> 2); const int rr = ((i_) == 0) ? (r ^ 8) : r; qb = 127 - (((i_) & 3) * 32 + (((i_) & 1) ? 31 - rr : rr)); } \
            else if ((i_) == 8 && (r & 8) == 0) { const int sb = (r & 7) + ((r >> 4) << 3); h = x + 8 * (sb >> 3); b = sb & 7; } \
            else ok_ = false; \
        } else { const int idx = (i_) * F.G + (((i_) & 1) ? F.G - 1 - F.bid : F.bid); if (idx >= NU) ok_ = false; \
            else if (idx < 2048) { qb = 127 - (idx >> 4); h = idx & 15; } else { const int j = idx - 2048; b = j >> 4; h = j & 15; } } \
        u_.dma0 = 0; \
        if (ok_) { if (b < 0) { const long row0 = 128L * qb; \
            u_.Q = Qs + row0 * DM + h * 128; u_.K = KP + h * 128; u_.V = VP + h * 128; u_.G = GA + row0 * DM + h * 128; u_.AO = AO + row0 * DM + h * 128; u_.NT = 2 * qb + 2; u_.full = 1; } \
          else { const long row0 = MP + 64L * b; \
            u_.Q = Qs + row0 * DM + h * 128; u_.K = KC + (long)b * KCROWS * DM + h * 128; u_.V = VC + (long)b * KCROWS * DM + h * 128; u_.G = GA + row0 * DM + h * 128; u_.AO = AO + row0 * DM + h * 128; u_.NT = KCROWS / 64; u_.full = 0; } } } while (0)
    dattn::Unit u, nx; bool have; ATTN_GET(0, u, have);
    dattn::bf16x8 qr[4]; bool pre = false;
    float* wsf_base = (float*)((char*)F.lds + MISC_OFF + 1024);
    for (int i = 0; have; ++i) {
        bool hn; ATTN_GET(i + 1, nx, hn);
        dattn::attn_unit<VAR>(u, hn, nx, pre, qr, (char*)F.lds + RING_OFF, wsf_base, lam, one_m_li, sub_gain, F.tid);
        u = nx; have = hn; pre = true;
    }
    __syncthreads();
#undef ATTN_GET
}
constexpr int RBLK = 72;
__device__ __forceinline__ float ret_lg2(int h) { return log2f(1.f - exp2f(-5.f - (float)h)); }
struct EpiRet {
    static constexpr int BMODE = 0;
    pg8::bf16_t* QP; pg8::bf16_t* KN; pg8::bf16_t* KT; pg8::bf16_t* VS; pg8::bf16_t* RG; const float* tab; const float* ssq;
    __device__ __forceinline__ void operator()(const pg8::f32x4 (&acc)[2][2][4][2], const pg8::Unit& u, int wr, int wc, int fr, int fq) const {
        { const int l_ = lane_now(); fr = l_ & 15; fq = l_ >> 4; }
        const int pn = u.pn, pm = u.pm; float rs[2][4]; row_rstd(ssq, pm, wr, fr, fq, rs);
#pragma unroll
        for (int ai = 0; ai < 2; ++ai)
#pragma unroll
            for (int m = 0; m < 4; ++m) {
                const int i = ai * 128 + wr * 64 + m * 16 + fr; const size_t row = (size_t)pm * 256 + i;
                const int J = pm < 64 ? pm : 64 + 4 * (pm - 64) + (i >> 6), jj = pm < 64 ? i : (i & 63), pos = pm < 64 ? (int)row : PAST + (i & 63);
                if (pn < 16) {
                    const int h = pn & 7; const bool isk = pn >= 8; const float sc = isk ? 0.0625f : 1.f;
#pragma unroll
                    for (int n = 0; n < 2; ++n) { const int c1 = wc * 32 + n * 16 + 4 * fq;
                        const pg8::f32x4 t0 = *(const pg8::f32x4*)(tab + ((size_t)pos * 128 + c1) * 2), t1 = *(const pg8::f32x4*)(tab + ((size_t)pos * 128 + c1) * 2 + 4);
                        const pg8::f32x4 x1 = acc[ai][0][m][n] * rs[ai][m], x2 = acc[ai][1][m][n] * rs[ai][m];
                        const float cs[4] = {t0[0], t0[2], t1[0], t1[2]}, sn[4] = {t0[1], t0[3], t1[1], t1[3]}; float o1[4], o2[4];
#pragma unroll
                        for (int e = 0; e < 4; ++e) { o1[e] = (x1[e] * cs[e] - x2[e] * sn[e]) * sc; o2[e] = (x2[e] * cs[e] + x1[e] * sn[e]) * sc; }
                        v2u w1, w2; w1.x = pk2(o1[0], o1[1]); w1.y = pk2(o1[2], o1[3]); w2.x = pk2(o2[0], o2[1]); w2.y = pk2(o2[2], o2[3]);
                        if (!isk) { pg8::bf16_t* p = QP + row * 4096 + h * 512 + 256 + c1; *(v2u*)p = w1; *(v2u*)(p + 128) = w2; }
                        else { pg8::bf16_t* p = KN + row * 2048 + h * 256 + c1; *(v2u*)p = w1; *(v2u*)(p + 128) = w2;
                            pg8::bf16_t* t = KT + ((size_t)(J * 8 + h) * 256 + c1) * 256 + jj;
#pragma unroll
                            for (int e = 0; e < 4; ++e) { t[(size_t)e * 256] = (pg8::bf16_t)f2bf(o1[e]); t[(size_t)(128 + e) * 256] = (pg8::bf16_t)f2bf(o2[e]); } } }
                } else if (pn < 32) {
                    const int h = (pn - 16) >> 1, half = (pn - 16) & 1; const float f = exp2f(-(float)(1 + jj) * ret_lg2(h)) * rs[ai][m];
#pragma unroll
                    for (int bj = 0; bj < 2; ++bj)
#pragma unroll
                        for (int n = 0; n < 2; ++n) { const int dv = half * 256 + bj * 128 + wc * 32 + n * 16 + 4 * fq; pg8::bf16_t* t = VS + ((size_t)(J * 8 + h) * 512 + dv) * 512 + jj;
#pragma unroll
                            for (int e = 0; e < 4; ++e) t[(size_t)e * 512] = (pg8::bf16_t)f2bf(acc[ai][bj][m][n][e] * f); }
                } else {
#pragma unroll
                    for (int bj = 0; bj < 2; ++bj)
#pragma unroll
                        for (int n = 0; n < 2; ++n) { const int c = (pn - 32) * 256 + bj * 128 + wc * 32 + n * 16 + 4 * fq; const pg8::f32x4 x = acc[ai][bj][m][n] * rs[ai][m];
                            v2u w; w.x = pk2(x[0], x[1]); w.y = pk2(x[2], x[3]); *(v2u*)(RG + row * 4096 + c) = w; }
                }
            }
    }
};
__device__ __forceinline__ size_t ret_row0(int J) { return J < 64 ? (size_t)256 * J : (size_t)MP + 64 * (J - 64); }
struct RetQKOrder {
    int G, c; const char* QP; const char* KN;
    __device__ __forceinline__ bool next(int i, pg8::Unit& u) const { const int L = i * G + c; if (L >= RBLK * 8) return false; const int J = L >> 3, h = L & 7; const size_t r0 = ret_row0(J);
        u.pm = J; u.pn = h; u.a = QP + (r0 * 4096 + h * 512 + 256) * 2; u.b = KN + (r0 * 2048 + h * 256) * 2; return true; }
    __device__ __forceinline__ void a_ready(const pg8::Unit&) const {}
    __device__ __forceinline__ void done(const pg8::Unit&) const {}
};
struct EpiRetQK {
    static constexpr int BMODE = 1;
    pg8::bf16_t* QP;
    __device__ __forceinline__ void operator()(const pg8::f32x4 (&acc)[2][2][4][2], const pg8::Unit& u, int wr, int wc, int fr, int fq) const {
        { const int l_ = lane_now(); fr = l_ & 15; fq = l_ >> 4; }
        const int J = u.pm, h = u.pn, nv = J < 64 ? 256 : 64; const size_t r0 = ret_row0(J);
#pragma unroll
        for (int ai = 0; ai < 2; ++ai)
#pragma unroll
            for (int m = 0; m < 4; ++m) { const int i = ai * 128 + wr * 64 + m * 16 + fr;
                if (i < nv) {
#pragma unroll
                    for (int bj = 0; bj < 2; ++bj) { const int j0 = bj * 128 + wc * 32 + 8 * fq; const pg8::f32x4 v0 = acc[ai][bj][m][0], v1 = acc[ai][bj][m][1]; float x[8] = {v0[0], v0[1], v0[2], v0[3], v1[0], v1[1], v1[2], v1[3]};
#pragma unroll
                        for (int k = 0; k < 8; ++k) x[k] = (j0 + k <= i) ? x[k] : 0.f;
                        v4u w; w.x = pk2(x[0], x[1]); w.y = pk2(x[2], x[3]); w.z = pk2(x[4], x[5]); w.w = pk2(x[6], x[7]);
                        *(v4u*)(QP + (r0 + i) * 4096 + h * 512 + j0) = w; } } }
    }
};
struct RetOOrder {
    int G, c; const char* QP; const char* VS;
    __device__ __forceinline__ bool next(int i, pg8::Unit& u) const { const int L = i * G + c; if (L >= RBLK * 16) return false; const int J = L >> 4, r = L & 15, h = r >> 1, half = r & 1; const size_t r0 = ret_row0(J);
        u.pm = J; u.pn = r; u.a = QP + (r0 * 4096 + h * 512) * 2; u.b = VS + (((size_t)(J * 8 + h) * 512 + half * 256) * 512) * 2; return true; }
    __device__ __forceinline__ void a_ready(const pg8::Unit&) const {}
    __device__ __forceinline__ void done(const pg8::Unit&) const {}
};
struct EpiRetO {
    static constexpr int BMODE = 1;
    pg8::bf16_t* O;
    __device__ __forceinline__ void operator()(const pg8::f32x4 (&acc)[2][2][4][2], const pg8::Unit& u, int wr, int wc, int fr, int fq) const {
        { const int l_ = lane_now(); fr = l_ & 15; fq = l_ >> 4; }
        const int J = u.pm, h = u.pn >> 1, half = u.pn & 1, nv = J < 64 ? 256 : 64; const size_t r0 = ret_row0(J); const float lg = ret_lg2(h);
#pragma unroll
        for (int ai = 0; ai < 2; ++ai)
#pragma unroll
            for (int m = 0; m < 4; ++m) { const int i = ai * 128 + wr * 64 + m * 16 + fr;
                if (i < nv) { const float f = exp2f((float)(i + 1) * lg);
#pragma unroll
                    for (int bj = 0; bj < 2; ++bj) { const int j0 = bj * 128 + wc * 32 + 8 * fq; const pg8::f32x4 v0 = acc[ai][bj][m][0] * f, v1 = acc[ai][bj][m][1] * f;
                        v4u w; w.x = pk2(v0[0], v0[1]); w.y = pk2(v0[2], v0[3]); w.z = pk2(v1[0], v1[1]); w.w = pk2(v1[2], v1[3]);
                        *(v4u*)(O + (r0 + i) * 4096 + h * 512 + half * 256 + j0) = w; } } }
    }
};
struct RetKVOrder {
    int G, c; const char* VS; const char* KT;
    __device__ __forceinline__ bool next(int i, pg8::Unit& u) const { const int L = i * G + c; if (L >= RBLK * 16) return false; const int J = L >> 4, r = L & 15, h = r >> 1, half = r & 1;
        u.pm = J; u.pn = r; u.a = VS + (((size_t)(J * 8 + h) * 512 + half * 256) * 512) * 2; u.b = KT + ((size_t)(J * 8 + h) * 256 * 256) * 2; return true; }
    __device__ __forceinline__ void a_ready(const pg8::Unit&) const {}
    __device__ __forceinline__ void done(const pg8::Unit&) const {}
};
struct EpiRetKV {
    static constexpr int BMODE = 1;
    pg8::bf16_t* VS; pg8::bf16_t* KVX;
    __device__ __forceinline__ void operator()(const pg8::f32x4 (&acc)[2][2][4][2], const pg8::Unit& u, int wr, int wc, int fr, int fq) const {
        { const int l_ = lane_now(); fr = l_ & 15; fq = l_ >> 4; }
        const int J = u.pm, h = u.pn >> 1, half = u.pn & 1;
        pg8::bf16_t* base; int pitch;
        if (J < 63) { base = VS + ((size_t)((J + 1) * 8 + h) * 512 + half * 256) * 512 + 256; pitch = 512; }
        else { base = KVX + ((size_t)((J - 63) * 8 + h) * 512 + half * 256) * 256; pitch = 256; }
#pragma unroll
        for (int ai = 0; ai < 2; ++ai)
#pragma unroll
            for (int m = 0; m < 4; ++m) { pg8::bf16_t* rowp = base + (size_t)(ai * 128 + wr * 64 + m * 16 + fr) * pitch + wc * 32 + 8 * fq;
#pragma unroll
                for (int bj = 0; bj < 2; ++bj) { const pg8::f32x4 v0 = acc[ai][bj][m][0], v1 = acc[ai][bj][m][1];
                    v4u w; w.x = pk2(v0[0], v0[1]); w.y = pk2(v0[2], v0[3]); w.z = pk2(v1[0], v1[1]); w.w = pk2(v1[2], v1[3]);
                    *(v4u*)(rowp + bj * 128) = w; } }
    }
};
__device__ __forceinline__ void ret_scan(Frame& F, bf16* VS, const bf16* KVX, const float* state_in, float* osp, float* oss) {
    const int gt = F.bid * NTHR + F.tid;
    for (int c = gt; c < 8 * 512 * 32; c += F.G * NTHR) {
        const int h = c >> 14, dv = (c >> 5) & 511, dk0 = (c & 31) * 8; const float lg = ret_lg2(h), g256 = exp2f(256.f * lg), g64 = exp2f(64.f * lg);
        float S[8];
#pragma unroll
        for (int k = 0; k < 8; ++k) S[k] = 0.f;
        bf16* slot = VS + ((size_t)h * 512 + dv) * 512 + 256 + dk0;
        *(v4u*)slot = (v4u){0u, 0u, 0u, 0u};
        constexpr size_t SJ = (size_t)8 * 512 * 512;
        v4u nx[4];
#pragma unroll
        for (int q = 0; q < 4; ++q) nx[q] = *(const v4u*)(slot + (size_t)(1 + q) * SJ);
        for (int J0 = 1; J0 < 64; J0 += 4) {
            v4u cur[4];
#pragma unroll
            for (int q = 0; q < 4; ++q) cur[q] = nx[q];
            if (J0 + 4 < 64) {
#pragma unroll
                for (int q = 0; q < 4; ++q) { const int Jn = J0 + 4 + q; nx[q] = *(const v4u*)(slot + (size_t)(Jn < 64 ? Jn : 63) * SJ); } }
#pragma unroll
            for (int q = 0; q < 4; ++q) { const int J = J0 + q;
                if (J < 64) { const v4u kv = cur[q]; bf16* sj = slot + (size_t)J * SJ;
                    const float x[8] = {bflo(kv.x), bfhi(kv.x), bflo(kv.y), bfhi(kv.y), bflo(kv.z), bfhi(kv.z), bflo(kv.w), bfhi(kv.w)};
#pragma unroll
                    for (int k = 0; k < 8; ++k) S[k] = (S[k] + x[k]) * g256;
                    v4u w; w.x = pk2(S[0], S[1]); w.y = pk2(S[2], S[3]); w.z = pk2(S[4], S[5]); w.w = pk2(S[6], S[7]);
                    *(v4u*)sj = w; } }
        }
        { const v4u kv = *(const v4u*)(KVX + ((size_t)h * 512 + dv) * 256 + dk0);
          const float x[8] = {bflo(kv.x), bfhi(kv.x), bflo(kv.y), bfhi(kv.y), bflo(kv.z), bfhi(kv.z), bflo(kv.w), bfhi(kv.w)};
#pragma unroll
          for (int k = 0; k < 8; ++k) NT_STORE((S[k] + x[k]) * g256, osp + ((size_t)h * 256 + dk0 + k) * 512 + dv); }
    }
    for (int c = gt; c < NB * 8 * 512 * 32; c += F.G * NTHR) {
        const int dv = c & 511, dk0 = ((c >> 9) & 31) * 8, h = (c >> 14) & 7, b = c >> 17; const float g64 = exp2f(64.f * ret_lg2(h));
        const float* si = state_in + (((size_t)b * 8 + h) * 256 + dk0) * 512 + dv; float* so = oss + (((size_t)b * 8 + h) * 256 + dk0) * 512 + dv;
        const v4u kv = *(const v4u*)(KVX + ((size_t)((1 + b) * 8 + h) * 512 + dv) * 256 + dk0);
        const float x[8] = {bflo(kv.x), bfhi(kv.x), bflo(kv.y), bfhi(kv.y), bflo(kv.z), bfhi(kv.z), bflo(kv.w), bfhi(kv.w)}; float s0[8];
#pragma unroll
        for (int k = 0; k < 8; ++k) s0[k] = NT_LOAD(si + (size_t)k * 512);
        v4u w; w.x = pk2(s0[0], s0[1]); w.y = pk2(s0[2], s0[3]); w.z = pk2(s0[4], s0[5]); w.w = pk2(s0[6], s0[7]);
        *(v4u*)(VS + ((size_t)((64 + b) * 8 + h) * 512 + dv) * 512 + 256 + dk0) = w;
#pragma unroll
        for (int k = 0; k < 8; ++k) NT_STORE((s0[k] + x[k]) * g64, so + (size_t)k * 512);
    }
}
__device__ __forceinline__ void ret_zero_pad(Frame& F, bf16* VS, bf16* KT) {
    const size_t gt = (size_t)F.bid * NTHR + F.tid, NG = (size_t)F.G * NTHR, n = (size_t)NB * 8 * 512 * 24, n2 = (size_t)NB * 8 * 256 * 24;
    for (size_t i = gt; i < n; i += NG) { const size_t rowi = i / 24, c = i % 24; *(v4u*)(VS + ((size_t)64 * 8 * 512 + rowi) * 512 + 64 + c * 8) = (v4u){0u, 0u, 0u, 0u}; }
    for (size_t i = gt; i < n2; i += NG) { const size_t rowi = i / 24, c = i % 24; *(v4u*)(KT + ((size_t)64 * 8 * 256 + rowi) * 256 + 64 + c * 8) = (v4u){0u, 0u, 0u, 0u}; }
}
__device__ __forceinline__ void ret_table(Frame& F, float* tab) {
    const size_t gt = (size_t)F.bid * NTHR + F.tid, NG = (size_t)F.G * NTHR;
    for (size_t e = gt; e < (size_t)MP * 128; e += NG) { float c, s; rope_cs((int)(e >> 7), (int)(e & 127), 128, c, s); tab[2 * e] = c; tab[2 * e + 1] = s; }
}
__device__ __forceinline__ void r_out(Frame& F, bf16* O, const bf16* RG) {
    const int gw = F.bid * NWAVES + F.wave, NGW = F.G * NWAVES, lane = F.lane;
    constexpr int U = 6;
    for (int it0 = gw; it0 < MT * 8; it0 += U * NGW) {
        v4u o4[U], g4[U]; size_t off[U]; bool ok[U];
#pragma unroll
        for (int j = 0; j < U; ++j) { const int it = it0 + j * NGW; ok[j] = it < MT * 8; const int itc = ok[j] ? it : gw; off[j] = (size_t)(itc >> 3) * 4096 + (itc & 7) * 512 + lane * 8;
            o4[j] = *(const v4u*)(O + off[j]); g4[j] = NT_LOAD((const v4u*)(RG + off[j])); }
#pragma unroll
        for (int j = 0; j < U; ++j) {
            float o[8] = {bflo(o4[j].x), bfhi(o4[j].x), bflo(o4[j].y), bfhi(o4[j].y), bflo(o4[j].z), bfhi(o4[j].z), bflo(o4[j].w), bfhi(o4[j].w)};
            const float g[8] = {bflo(g4[j].x), bfhi(g4[j].x), bflo(g4[j].y), bfhi(g4[j].y), bflo(g4[j].z), bfhi(g4[j].z), bflo(g4[j].w), bfhi(g4[j].w)};
            float ss = 0.f;
#pragma unroll
            for (int k = 0; k < 8; ++k) ss += o[k] * o[k];
            const float rstd = 1.f / sqrtf(wave_sum(ss) * (1.f / 512.f) + EPS);
#pragma unroll
            for (int k = 0; k < 8; ++k) o[k] = o[k] * rstd * silu_f(g[k]);
            v4u w; w.x = pk2(o[0], o[1]); w.y = pk2(o[2], o[3]); w.z = pk2(o[4], o[5]); w.w = pk2(o[6], o[7]);
            if (ok[j]) *(v4u*)(O + off[j]) = w;
        }
    }
}
struct EpiCIn {
    static constexpr int BMODE = 0;
    pg8::bf16_t* GU; pg8::bf16_t* GVT; pg8::bf16_t* GVS; float* SSQ; const float* ssq;
    __device__ __forceinline__ void operator()(const pg8::f32x4 (&acc)[2][2][4][2], const pg8::Unit& u, int wr, int wc, int fr, int fq) const {
        { const int l_ = lane_now(); fr = l_ & 15; fq = l_ >> 4; }
        const int pn = u.pn, pm = u.pm; const bool isv = pn >= 32; const int pt = isv ? pn - 32 : pn; float rs[2][4]; row_rstd(ssq, pm, wr, fr, fq, rs);
#pragma unroll
        for (int ai = 0; ai < 2; ++ai)
#pragma unroll
            for (int m = 0; m < 4; ++m) {
                const int i = ai * 128 + wr * 64 + m * 16 + fr; const size_t row = (size_t)pm * 256 + i; float ss = 0.f;
                if (!isv) {
#pragma unroll
                    for (int n = 0; n < 2; ++n) { const int c = pt * 128 + wc * 32 + n * 16 + 4 * fq; const pg8::f32x4 xu = acc[ai][0][m][n] * rs[ai][m], xg = acc[ai][1][m][n] * rs[ai][m]; float y[4];
#pragma unroll
                        for (int e = 0; e < 4; ++e) y[e] = gelu_tanh_f(xu[e]) * silu_f(xg[e]);
                        v2u w; w.x = pk2(y[0], y[1]); w.y = pk2(y[2], y[3]); *(v2u*)(GU + row * 4096 + c) = w; }
                } else {
#pragma unroll
                    for (int bj = 0; bj < 2; ++bj)
#pragma unroll
                        for (int n = 0; n < 2; ++n) { const int c = pt * 256 + bj * 128 + wc * 32 + n * 16 + 4 * fq; const pg8::f32x4 x = acc[ai][bj][m][n] * rs[ai][m]; float y[4];
#pragma unroll
                            for (int e = 0; e < 4; ++e) y[e] = gelu_tanh_f(x[e]);
                            v2u w; w.x = pk2(y[0], y[1]); w.y = pk2(y[2], y[3]);
                            ss += (y[0] * y[0] + y[1] * y[1]) + (y[2] * y[2] + y[3] * y[3]);
                            pg8::bf16_t* t = GVT + ((size_t)pm * 4096 + c) * 256 + i;
                            t[0] = (pg8::bf16_t)(w.x & 0xffffu); t[256] = (pg8::bf16_t)(w.x >> 16); t[512] = (pg8::bf16_t)(w.y & 0xffffu); t[768] = (pg8::bf16_t)(w.y >> 16);
                            if (pm >= 64) *(v2u*)(GVS + (row - MP) * 4096 + c) = w; }
                    ss += __shfl_xor(ss, 16); ss += __shfl_xor(ss, 32); if (fq == 0) SSQ[row * 64 + pt * 4 + wc] = ss;
                }
                if (m & 1) asm volatile("" ::: "memory");
            }
    }
};
__device__ __forceinline__ void c_prep(Frame& F, const float* SSQ, const float* wsin, const float* vgain, const bf16* GVS, bf16* Wm, float* ovm) {
    LAS float* rs = (LAS float*)(F.lds + RING_OFF);
    const int tid = F.tid;
    for (int it = F.bid; it < 66 * 8; it += F.G) {
        const int J = it >> 3, g = it & 7;
        __syncthreads();
        if (tid < 256) { const float* p = SSQ + ((size_t)J * 256 + tid) * 64; float s = 0.f;
#pragma unroll
            for (int k = 0; k < 16; ++k) { const f32x4 x = *(const f32x4*)(p + 4 * k); s += (x.x + x.y) + (x.z + x.w); }
            rs[tid] = 1.f / sqrtf(s * (1.f / 4096.f) + EPS); }
        __syncthreads();
        bf16* wm = Wm + (size_t)(J * 8 + g) * 65536; const int sh = J < 64 ? 7 : 6, cm = (1 << sh) - 1;
        for (int eb = tid; eb < 8192; eb += 4 * NTHR) {
            f32x4 wa[4], wb[4];
#pragma unroll
            for (int q = 0; q < 4; ++q) { const int e8 = eb + q * NTHR, i = e8 >> 5, j0 = (e8 & 31) * 8, il = i & cm, jl0 = j0 & cm; const bool on = (i >> sh) == (j0 >> sh) && jl0 <= il;
                const float* wr_ = wsin + ((size_t)g * 128 + (on ? il : 0)) * 128 + (on ? jl0 : 0); wa[q] = *(const f32x4*)wr_; wb[q] = *(const f32x4*)(wr_ + 4); }
#pragma unroll
            for (int q = 0; q < 4; ++q) { const int e8 = eb + q * NTHR, i = e8 >> 5, j0 = (e8 & 31) * 8, il = i & cm, jl0 = j0 & cm; const bool on = (i >> sh) == (j0 >> sh) && jl0 <= il; float y[8];
                const float wv[8] = {wa[q].x, wa[q].y, wa[q].z, wa[q].w, wb[q].x, wb[q].y, wb[q].z, wb[q].w};
#pragma unroll
                for (int k = 0; k < 8; ++k) y[k] = (on && jl0 + k <= il) ? wv[k] * rs[j0 + k] : 0.f;
                v4u w; w.x = pk2(y[0], y[1]); w.y = pk2(y[2], y[3]); w.z = pk2(y[4], y[5]); w.w = pk2(y[6], y[7]);
                *(v4u*)(wm + i * 256 + j0) = w; } }
    }
    const int gw = F.bid * NWAVES + F.wave, NGW = F.G * NWAVES, lane = F.lane;
    for (int r = gw; r < MS; r += NGW) {
        const float rstd = 1.f / sqrtf(wave_sum(SSQ[((size_t)MP + r) * 64 + lane]) * (1.f / 4096.f) + EPS);
        v4u vr[8]; f32x4 gar[8], gbr[8];
#pragma unroll
        for (int k = 0; k < 8; ++k) { const int col = k * 512 + lane * 8; vr[k] = *(const v4u*)(GVS + (size_t)r * 4096 + col); gar[k] = *(const f32x4*)(vgain + col); gbr[k] = *(const f32x4*)(vgain + col + 4); }
#pragma unroll
        for (int k = 0; k < 8; ++k) { const int col = k * 512 + lane * 8; const v4u v4 = vr[k];
            const f32x4 ga = gar[k], gb = gbr[k];
            float* o = ovm + (size_t)r * 4096 + col;
            *(f32x4*)o = (f32x4){bflo(v4.x) * rstd * ga.x, bfhi(v4.x) * rstd * ga.y, bflo(v4.y) * rstd * ga.z, bfhi(v4.y) * rstd * ga.w};
            *(f32x4*)(o + 4) = (f32x4){bflo(v4.z) * rstd * gb.x, bfhi(v4.z) * rstd * gb.y, bflo(v4.w) * rstd * gb.z, bfhi(v4.w) * rstd * gb.w}; }
    }
}
struct CMixOrder {
    int G, c; const char* Wm; const char* GVT;
    __device__ __forceinline__ bool next(int i, pg8::Unit& u) const { const int L = i * G + c; if (L >= 66 * 16) return false; const int J = L >> 4, nt = L & 15;
        u.pm = J; u.pn = nt; u.a = Wm + ((size_t)(J * 8 + (nt >> 1)) * 65536) * 2; u.b = GVT + (((size_t)J * 4096 + nt * 256) * 256) * 2; return true; }
    __device__ __forceinline__ void a_ready(const pg8::Unit&) const {}
    __device__ __forceinline__ void done(const pg8::Unit&) const {}
};
struct EpiCMix {
    static constexpr int BMODE = 1;
    pg8::bf16_t* GU; const float* vgain; const float* bs;
    __device__ __forceinline__ void operator()(const pg8::f32x4 (&acc)[2][2][4][2], const pg8::Unit& u, int wr, int wc, int fr, int fq) const {
        { const int l_ = lane_now(); fr = l_ & 15; fq = l_ >> 4; }
        const int J = u.pm, nt = u.pn, g = nt >> 1, cm = J < 64 ? 127 : 63;
#pragma unroll
        for (int bj = 0; bj < 2; ++bj) { const int c0 = nt * 256 + bj * 128 + wc * 32 + 8 * fq; const f32x4 ga = *(const f32x4*)(vgain + c0), gb = *(const f32x4*)(vgain + c0 + 4);
            const float gn[8] = {ga.x, ga.y, ga.z, ga.w, gb.x, gb.y, gb.z, gb.w};
#pragma unroll
            for (int ai = 0; ai < 2; ++ai)
#pragma unroll
                for (int m = 0; m < 4; ++m) { const int i = ai * 128 + wr * 64 + m * 16 + fr; const size_t off = ((size_t)J * 256 + i) * 4096 + c0; const float b = bs[g * 128 + (i & cm)];
                    const v4u u4 = *(const v4u*)(GU + off); const pg8::f32x4 v0 = acc[ai][bj][m][0], v1 = acc[ai][bj][m][1];
                    const float mx[8] = {v0[0], v0[1], v0[2], v0[3], v1[0], v1[1], v1[2], v1[3]};
                    const float uu[8] = {bflo(u4.x), bfhi(u4.x), bflo(u4.y), bfhi(u4.y), bflo(u4.z), bfhi(u4.z), bflo(u4.w), bfhi(u4.w)};
                    float y[8];
#pragma unroll
                    for (int k = 0; k < 8; ++k) y[k] = uu[k] * (mx[k] * gn[k] + b);
                    v4u w; w.x = pk2(y[0], y[1]); w.y = pk2(y[2], y[3]); w.z = pk2(y[4], y[5]); w.w = pk2(y[6], y[7]);
                    *(v4u*)(GU + off) = w; } }
    }
};
__device__ __forceinline__ float diff_lambda(const float* q1, const float* k1, const float* q2, const float* k2, float lam_init) {
    float a = 0.f, b = 0.f;
    for (int i = 0; i < 64; ++i) { a += q1[i] * k1[i]; b += q2[i] * k2[i]; }
    return expf(a) - expf(b) + lam_init;
}

constexpr int N_PHASES = 21;
__global__ void __launch_bounds__(NTHR, 2) mega(Args args) {
    extern __shared__ __attribute__((aligned(16))) unsigned char lds[];
    Frame F;
    F.lds = (LAS unsigned char*)lds; F.tid = threadIdx.x; F.lane = F.tid & 63; F.wave = __builtin_amdgcn_readfirstlane(F.tid >> 6); F.G = gridDim.x; F.bid = blockIdx.x;
    F.in = args.in; F.out = args.out; F.ws = args.ws;
    unsigned char* ws = args.ws; float* out = args.out;
    bf16* W_AIN[2] = {(bf16*)(ws + WS_WAIN0), (bf16*)(ws + WS_WAIN1)}; bf16* W_AOUT[2] = {(bf16*)(ws + WS_WAOUT0), (bf16*)(ws + WS_WAOUT1)};
    bf16* W_RIN = (bf16*)(ws + WS_WRIN); bf16* W_ROUT = (bf16*)(ws + WS_WROUT); bf16* W_CIN = (bf16*)(ws + WS_WCIN); bf16* W_COUT = (bf16*)(ws + WS_WCOUT);
    bf16* XN0 = (bf16*)(ws + WS_XN0); bf16* HB = (bf16*)(ws + WS_HB); float* SSQ2 = (float*)(ws + WS_SSQ2);
    bf16* Qs = (bf16*)(ws + WS_QS); bf16* KP = (bf16*)(ws + WS_KP); bf16* VP = (bf16*)(ws + WS_VP); bf16* KC = (bf16*)(ws + WS_KC); bf16* VC = (bf16*)(ws + WS_VC); bf16* AO_A = (bf16*)(ws + WS_AOA);
    bf16* KT = (bf16*)(ws + WS_KT); bf16* RG = (bf16*)(ws + WS_RG); bf16* QP = (bf16*)(ws + WS_QP); bf16* KN = (bf16*)(ws + WS_KN); bf16* VS = (bf16*)(ws + WS_VS); bf16* ORET = (bf16*)(ws + WS_ORET);
    bf16* GU = (bf16*)(ws + WS_GU); bf16* SG = (bf16*)(ws + WS_SG); bf16* GVT = (bf16*)(ws + WS_GVT); bf16* WM = (bf16*)(ws + WS_WM); float* SSQ = (float*)(ws + WS_SSQ); bf16* GVS = (bf16*)(ws + WS_GVS); float* TABR = (float*)(ws + WS_TABR); bf16* KVX = (bf16*)(ws + WS_KVX); float* TABA = (float*)(ws + WS_TABA); bf16* GA = (bf16*)(ws + WS_GA);
    const int lo = args.ph_lo, hi = args.ph_hi;
    volatile LAS unsigned* MISC = (volatile LAS unsigned*)(F.lds + MISC_OFF);
    for (int u = F.tid; u < (LDS_BYTES - MISC_OFF) / 4; u += NTHR) ((LAS unsigned*)(F.lds + MISC_OFF))[u] = 0u;
    __syncthreads();
    XcdBarrier bar = xcd_barrier_post((unsigned*)(ws + WS_CTL) + 4096, MISC + 8);
#define IN(k) (lo <= (k) && (k) < hi)
#define PH_ENTER() do { int t_ = F.wave * 64 + lane_now(); F.tid = t_; F.lane = t_ & 63; } while (0)
    volatile LAS int* DRW = (volatile LAS int*)(F.lds + MISC_OFF + 64);
    unsigned* DCTR = (unsigned*)(ws + WS_CTL) + 8192;
#define DRAIN(ph, total, BODY) do { PH_ENTER(); unsigned tk_ = 0u; if (F.tid == 0) tk_ = atomicAdd(DCTR + 64 * (ph), 1u); for (;;) { __syncthreads(); if (F.tid == 0) DRW[0] = (int)tk_; __syncthreads(); const int c_ = DRW[0]; if (c_ >= (total)) break; \
        if (F.tid == 0) tk_ = atomicAdd(DCTR + 64 * (ph), 1u);     \
        BODY } } while (0)
#define SEAM(k) do { if (IN(k) && IN((k) + 1)) xcd_barrier(bar, F.wave == 0 && lane_now() == 0); } while (0)

#define GEMM_STORE(Aptr, Wptr, NN, KK, Optr) do { pg8::GemmP g{KK, KK, (KK) / 64}; pg8::StaticOrder S; S.init(MT / 256, (NN) / 256, F.G, F.bid, Aptr, Wptr, KK, KK); pg8::EpiStoreBf16 E{(pg8::bf16_t*)(Optr), NN}; \
        pg8::gemm_phase<pg8::EpiStoreBf16, pg8::StaticOrder>(F.lds + RING_OFF, g, S, E, F.tid); } while (0)
#define GEMM_RESIDB(MODE_, Aptr, Wptr, KK) do { pg8::GemmP g{KK, KK, (KK) / 64}; pg8::StaticOrder S; S.init(MT / 256, DM / 256, F.G, F.bid, Aptr, Wptr, KK, KK); \
        pg8::EpiResidB<MODE_> E{args.in[I_XP], args.in[I_XS], (pg8::bf16_t*)HB, out, SSQ2}; pg8::gemm_phase<pg8::EpiResidB<MODE_>, pg8::StaticOrder>(F.lds + RING_OFF, g, S, E, F.tid); } while (0)

    PH_ENTER(); if (IN(0)) {
        transpose_weight(F, args.in[I_AWIN], 2048, 8192, W_AIN[0]); attn_table(F, TABA);
        norm_rows(F, args.in[I_XP], args.in[I_XS], args.in[I_NW], XN0);
    }
    SEAM(0);
#define GEMM_AIN(Aptr, Wptr, J_, SSQP) do { pg8::GemmP g{2048, 2048, 32}; pg8::StaticOrder S; S.init(MT / 256, 32, F.G, F.bid, Aptr, Wptr, 2048, 2048); \
        EpiAIn E{Qs, KP, VP, KC, VC, GA, out + O_KP + (size_t)(J_) * MP * DM, out + O_VP + (size_t)(J_) * MP * DM, out + O_KS + (size_t)(J_) * MS * DM, out + O_VS + (size_t)(J_) * MS * DM, TABA, args.in[I_AQG] + 64 * (J_), args.in[I_AKG] + 64 * (J_), SSQP}; \
        pg8::gemm_phase<EpiAIn, pg8::StaticOrder>(F.lds + RING_OFF, g, S, E, F.tid); } while (0)
    PH_ENTER(); if (IN(1)) { GEMM_AIN(XN0, W_AIN[0], 0, (const float*)nullptr);
        const int n0 = CC_CHUNKS, n1 = n0 + tw_chunks(2048, 2048), n2 = n1 + TR_CHUNKS;
        DRAIN(1, n2, if (c_ < n0) cc_run(F, args.in[I_CK], args.in[I_CV], KC, VC, c_); else if (c_ < n1) tw_run(F, args.in[I_AWOUT], 2048, 2048, W_AOUT[0], c_ - n0); else tr_run(F, TABR, c_ - n1);); }
    SEAM(1);
    PH_ENTER(); if (IN(3)) { const float li = 0.8f - 0.6f * expf(-0.3f * 0.f); const float lam = diff_lambda(args.in[I_LQ1], args.in[I_LK1], args.in[I_LQ2], args.in[I_LK2], li);
        attn_fast(F, Qs, KP, VP, KC, VC, GA, AO_A, lam, 1.f - li, args.in[I_ASG]); }
    SEAM(3);
    PH_ENTER(); if (IN(4)) { GEMM_RESIDB(0, AO_A, W_AOUT[0], 2048);
        const int n0 = tw_chunks(2048, 12288), n1 = n0 + tw_chunks(4096, 2048);
        DRAIN(4, n1, if (c_ < n0) tw_run(F, args.in[I_RWIN], 2048, 12288, W_RIN, c_, args.in[I_NW] + DM); else tw_run(F, args.in[I_RWOUT], 4096, 2048, W_ROUT, c_ - n0);); }
    if (IN(4) && IN(6)) xcd_barrier(bar, F.wave == 0 && lane_now() == 0);
    PH_ENTER(); if (IN(6)) { ret_zero_pad(F, VS, KT);
        PH_ENTER(); pg8::GemmP g{2048, 2048, 32}; pg8::StaticOrder S; S.init(MT / 256, 48, F.G, F.bid, HB, W_RIN, 2048, 2048); EpiRet E{QP, KN, KT, VS, RG, TABR, SSQ2};
        pg8::gemm_phase<EpiRet, pg8::StaticOrder>(F.lds + RING_OFF, g, S, E, F.tid); }
    SEAM(6);
    PH_ENTER(); if (IN(7)) { { pg8::GemmP g{4096, 2048, 4}; RetQKOrder S{F.G, F.bid, (const char*)QP, (const char*)KN}; EpiRetQK E{QP}; pg8::gemm_phase<EpiRetQK, RetQKOrder>(F.lds + RING_OFF, g, S, E, F.tid); }
        PH_ENTER(); { pg8::GemmP g{512, 256, 4}; RetKVOrder S{F.G, F.bid, (const char*)VS, (const char*)KT}; EpiRetKV E{VS, KVX}; pg8::gemm_phase<EpiRetKV, RetKVOrder>(F.lds + RING_OFF, g, S, E, F.tid); }
        xcd_barrier(bar, F.wave == 0 && lane_now() == 0);
        PH_ENTER(); ret_scan(F, VS, KVX, args.in[I_SR], out + O_SP, out + O_SS); }
    SEAM(7);
    PH_ENTER(); if (IN(8)) { pg8::GemmP g{4096, 512, 8}; RetOOrder S{F.G, F.bid, (const char*)QP, (const char*)VS}; EpiRetO E{ORET}; pg8::gemm_phase<EpiRetO, RetOOrder>(F.lds + RING_OFF, g, S, E, F.tid); }
    SEAM(8);
    PH_ENTER(); if (IN(9)) r_out(F, ORET, RG);
    SEAM(9);
    PH_ENTER(); if (IN(10)) { GEMM_RESIDB(1, ORET, W_ROUT, 4096);
        const int n0 = tw_chunks(2048, 12288), n1 = n0 + tw_chunks(4096, 2048), n2 = n1 + tw_chunks(2048, 8192), n3 = n2 + tw_chunks(2048, 2048);
        DRAIN(10, n3, if (c_ < n0) tw_run(F, args.in[I_CWIN], 2048, 12288, W_CIN, c_, args.in[I_NW] + 2 * DM, true); else if (c_ < n1) tw_run(F, args.in[I_CWOUT], 4096, 2048, W_COUT, c_ - n0);
                      else if (c_ < n2) tw_run(F, args.in[I_AWIN] + (size_t)2048 * 8192, 2048, 8192, W_AIN[1], c_ - n1, args.in[I_NW] + 3 * DM); else tw_run(F, args.in[I_AWOUT] + (size_t)2048 * 2048, 2048, 2048, W_AOUT[1], c_ - n2);); }
    if (IN(10) && IN(12)) xcd_barrier(bar, F.wave == 0 && lane_now() == 0);
    PH_ENTER(); if (IN(12)) { pg8::GemmP g{2048, 2048, 32}; pg8::StaticOrder S; S.init(MT / 256, 48, F.G, F.bid, HB, W_CIN, 2048, 2048); EpiCIn E{GU, GVT, GVS, SSQ, SSQ2};
        pg8::gemm_phase<EpiCIn, pg8::StaticOrder>(F.lds + RING_OFF, g, S, E, F.tid); }
    SEAM(12);
    PH_ENTER(); if (IN(13)) c_prep(F, SSQ, args.in[I_CWS], args.in[I_CVG], GVS, WM, out + O_VM);
    SEAM(13);
    PH_ENTER(); if (IN(14)) { pg8::GemmP g{256, 256, 4}; CMixOrder S{F.G, F.bid, (const char*)WM, (const char*)GVT}; EpiCMix E{GU, args.in[I_CVG], args.in[I_CBS]}; pg8::gemm_phase<EpiCMix, CMixOrder>(F.lds + RING_OFF, g, S, E, F.tid); }
    SEAM(14);
    PH_ENTER(); if (IN(15)) { GEMM_RESIDB(1, GU, W_COUT, 4096);
        DRAIN(15, CC_CHUNKS, cc_run(F, args.in[I_CK] + (size_t)NB * PAST * DM, args.in[I_CV] + (size_t)NB * PAST * DM, KC, VC, c_);); }
    if (IN(15) && IN(17)) xcd_barrier(bar, F.wave == 0 && lane_now() == 0);
    PH_ENTER(); if (IN(17)) GEMM_AIN(HB, W_AIN[1], 1, (const float*)SSQ2);
    SEAM(17);
    PH_ENTER(); if (IN(19)) { const float li = 0.8f - 0.6f * expf(-0.3f * 3.f); const float lam = diff_lambda(args.in[I_LQ1] + 64, args.in[I_LK1] + 64, args.in[I_LQ2] + 64, args.in[I_LK2] + 64, li);
        attn_fast(F, Qs, KP, VP, KC, VC, GA, AO_A, lam, 1.f - li, args.in[I_ASG] + 128); }
    SEAM(19);
    PH_ENTER(); if (IN(20)) GEMM_RESIDB(2, AO_A, W_AOUT[1], 2048);
#undef IN
#undef SEAM
}

extern "C" void kernel_launch(void* const* d_in, const int* in_sizes, int n_in, void* d_out, int out_size, void* d_ws, size_t ws_size, hipStream_t stream) {
    static int grid = 0;
    if (grid == 0) {
        if (n_in != N_IN || (size_t)out_size != O_END || ws_size < WS_END) { fprintf(stderr, "kernel_launch: unexpected shapes: n_in %d out %d ws %zu (need %zu)\n", n_in, out_size, ws_size, (size_t)WS_END); grid = -1; return; }
        int dev = 0, cus = 0;
        if (hipGetDevice(&dev) != hipSuccess || hipDeviceGetAttribute(&cus, hipDeviceAttributeMultiprocessorCount, dev) != hipSuccess) { grid = -1; return; }
        if (hipFuncSetAttribute((const void*)mega, hipFuncAttributeMaxDynamicSharedMemorySize, LDS_BYTES) != hipSuccess) { fprintf(stderr, "kernel_launch: hipFuncSetAttribute failed\n"); grid = -1; return; }
        int per_cu = 0;
        if (hipOccupancyMaxActiveBlocksPerMultiprocessor(&per_cu, (const void*)mega, NTHR, LDS_BYTES) != hipSuccess || per_cu < 1) { fprintf(stderr, "kernel_launch: occupancy query: %d workgroups per CU\n", per_cu); grid = -1; return; }
        (void)hipGetLastError();
        grid = cus;
    }
    if (grid < 0) return;
    Args a{};
    for (int i = 0; i < N_IN; ++i) a.in[i] = (const float*)d_in[i];
    a.out = (float*)d_out; a.ws = (unsigned char*)d_ws;
    (void)hipMemsetAsync((char*)d_ws + WS_CTL, 0, CTL_ZERO_BYTES, stream);
    a.ph_lo = 0; a.ph_hi = N_PHASES;
    hipLaunchKernelGGL(mega, dim3(grid), dim3(NTHR), LDS_BYTES, stream, a);
}
```

```cpp
#include <hip/hip_runtime.h>
#include <cstdio>
#include <cstdint>

__device__ __forceinline__ int lane_now() { int l; asm volatile("v_mbcnt_lo_u32_b32 %0, -1, 0\n\tv_mbcnt_hi_u32_b32 %0, -1, %0" : "=v"(l)); return l; }
namespace pg8 {
#define PG8_LAS __attribute__((address_space(3)))
typedef unsigned short bf16_t;
typedef short bf16x8 __attribute__((ext_vector_type(8)));
typedef float f32x4 __attribute__((ext_vector_type(4)));
typedef unsigned u32x4 __attribute__((ext_vector_type(4)));
constexpr int BM = 256, BK = 64, HALF = 128, HTB = HALF * BK * 2, STAGE_BYTES = 8 * HTB, NXCD = 8, WGM = 4;

__host__ __device__ __forceinline__ int lds_byte(int r, int c) { const int st = (r >> 4) * 2 + (c >> 5), rr = r & 15, cc = c & 31, ob = rr * 64 + cc * 2; return st * 1024 + (ob ^ (((ob >> 9) & 1) << 5)); }
__host__ __device__ __forceinline__ void stage_rc(int b, int& R, int& C) { const int st = b / 1024, sb = b % 1024, swz = sb ^ (((sb >> 9) & 1) << 5); R = (st >> 1) * 16 + swz / 64; C = (st & 1) * 32 + (swz % 64) / 2; }
__host__ __device__ __forceinline__ int perm32(int rho) { const int n = rho >> 4, i = rho & 15; return 8 * (i >> 2) + 4 * n + (i & 3); }

struct Unit { int pm, pn; const char* a; const char* b; };
struct GemmP { int lda, ldb, nt; };

struct StaticOrder {
    int nM, nN, nwg, G, c; const char* A; const char* B; size_t ta, tb;
    __host__ __device__ void init(int nM_, int nN_, int G_, int c_, const void* A_, const void* B_, int lda, int ldb) { nM = nM_; nN = nN_; nwg = nM * nN; G = G_; c = c_; A = (const char*)A_; B = (const char*)B_; ta = (size_t)BM * lda * 2; tb = (size_t)BM * ldb * 2; }
    __host__ __device__ bool next(int i, Unit& u) const {
        const long L = (long)i * G + c; if (L >= nwg) return false;
        int wgid = (int)L; { const int q = nwg / NXCD, r = nwg % NXCD, xcd = wgid % NXCD, off = wgid / NXCD; wgid = (xcd < r ? xcd * (q + 1) : r * (q + 1) + (xcd - r) * q) + off; }
        const int nig = WGM * nN, gid = wgid / nig, fm = gid * WGM, gsz = (nM - fm) < WGM ? (nM - fm) : WGM;
        u.pm = fm + ((wgid % nig) % gsz); u.pn = (wgid % nig) / gsz; u.a = A + (size_t)u.pm * ta; u.b = B + (size_t)u.pn * tb; return true;
    }
    __device__ __forceinline__ void a_ready(const Unit&) const {}
    __device__ __forceinline__ void done(const Unit&) const {}
};

__device__ __forceinline__ unsigned cvt_pk_bf16(float lo, float hi) { unsigned r; asm volatile("v_cvt_pk_bf16_f32 %0, %1, %2" : "=v"(r) : "v"(lo), "v"(hi)); return r; }

struct EpiStoreBf16 {
    static constexpr int BMODE = 1;
    bf16_t* O; int ldc;
    __device__ __forceinline__ void operator()(const f32x4 (&acc)[2][2][4][2], const Unit& u, int wr, int wc, int fr, int fq) const {
        const int row0 = u.pm * BM + wr * 64 + fr; const int col0 = u.pn * BM + wc * 32 + 8 * fq;
#pragma unroll
        for (int ai = 0; ai < 2; ++ai)
#pragma unroll
            for (int m = 0; m < 4; ++m) { bf16_t* rowp = O + (size_t)(row0 + ai * HALF + m * 16) * ldc + col0;
#pragma unroll
                for (int bj = 0; bj < 2; ++bj) { const f32x4 v0 = acc[ai][bj][m][0], v1 = acc[ai][bj][m][1];
                    u32x4 w; w.x = cvt_pk_bf16(v0[0], v0[1]); w.y = cvt_pk_bf16(v0[2], v0[3]); w.z = cvt_pk_bf16(v1[0], v1[1]); w.w = cvt_pk_bf16(v1[2], v1[3]);
                    *(u32x4*)(rowp + bj * HALF) = w; } }
    }
};
struct EpiResid {
    static constexpr int BMODE = 0;
    const float* base_p; const float* base_s; float* out; int split;
    __device__ __forceinline__ void operator()(const f32x4 (&acc)[2][2][4][2], const Unit& u, int wr, int wc, int fr, int fq) const {
        { const int l_ = lane_now(); fr = l_ & 15; fq = l_ >> 4; }
        const int col0 = u.pn * BM + wc * 32 + 4 * fq;
#pragma unroll
        for (int ai = 0; ai < 2; ++ai) {
            f32x4 bs[4][2][2];
#pragma unroll
            for (int m = 0; m < 4; ++m) { const int r = u.pm * BM + ai * HALF + wr * 64 + m * 16 + fr; const float* bp = (r < split) ? base_p + (size_t)r * 2048 : base_s + (size_t)(r - split) * 2048;
#pragma unroll
                for (int bj = 0; bj < 2; ++bj)
#pragma unroll
                    for (int n = 0; n < 2; ++n) bs[m][bj][n] = *(const f32x4*)(bp + col0 + bj * HALF + n * 16); }
#pragma unroll
            for (int m = 0; m < 4; ++m) { const int r = u.pm * BM + ai * HALF + wr * 64 + m * 16 + fr; float* op = out + (size_t)r * 2048;
#pragma unroll
                for (int bj = 0; bj < 2; ++bj)
#pragma unroll
                    for (int n = 0; n < 2; ++n) *(f32x4*)(op + col0 + bj * HALF + n * 16) = bs[m][bj][n] + acc[ai][bj][m][n]; }
            asm volatile("" ::: "memory");
        }
    }
};

template <int MODE> struct EpiResidB {
    static constexpr int BMODE = 1;
    const float* base_p; const float* base_s; bf16_t* HB; float* out; float* SSQ2;
    __device__ __forceinline__ void operator()(const f32x4 (&acc)[2][2][4][2], const Unit& u, int wr, int wc, int fr, int fq) const {
        { const int l_ = lane_now(); fr = l_ & 15; fq = l_ >> 4; }
        const int col0 = u.pn * BM + wc * 32 + 8 * fq;
#pragma unroll
        for (int ai = 0; ai < 2; ++ai) {
            f32x4 b0[4][2], b1[4][2]; u32x4 hb[4][2];
#pragma unroll
            for (int m = 0; m < 4; ++m) { const int r = u.pm * BM + ai * HALF + wr * 64 + m * 16 + fr;
#pragma unroll
                for (int bj = 0; bj < 2; ++bj) {
                    if (MODE == 0) { const float* bp = ((r < 16384) ? base_p + (size_t)r * 2048 : base_s + (size_t)(r - 16384) * 2048) + col0 + bj * HALF; b0[m][bj] = __builtin_nontemporal_load((const f32x4*)bp); b1[m][bj] = __builtin_nontemporal_load((const f32x4*)(bp + 4)); }
                    else hb[m][bj] = *(const u32x4*)(HB + (size_t)r * 2048 + col0 + bj * HALF); } }
#pragma unroll
            for (int m = 0; m < 4; ++m) { const int r = u.pm * BM + ai * HALF + wr * 64 + m * 16 + fr; float ss = 0.f;
#pragma unroll
                for (int bj = 0; bj < 2; ++bj) { f32x4 h0, h1;
                    if (MODE == 0) { h0 = b0[m][bj] + acc[ai][bj][m][0]; h1 = b1[m][bj] + acc[ai][bj][m][1]; }
                    else { const u32x4 w = hb[m][bj];
                        h0 = (f32x4){__builtin_bit_cast(float, w.x << 16), __builtin_bit_cast(float, w.x & 0xffff0000u), __builtin_bit_cast(float, w.y << 16), __builtin_bit_cast(float, w.y & 0xffff0000u)} + acc[ai][bj][m][0];
                        h1 = (f32x4){__builtin_bit_cast(float, w.z << 16), __builtin_bit_cast(float, w.z & 0xffff0000u), __builtin_bit_cast(float, w.w << 16), __builtin_bit_cast(float, w.w & 0xffff0000u)} + acc[ai][bj][m][1]; }
                    if (MODE == 2) { float* op = out + (size_t)r * 2048 + col0 + bj * HALF; __builtin_nontemporal_store(h0, (f32x4*)op); __builtin_nontemporal_store(h1, (f32x4*)(op + 4)); }
                    else { u32x4 w; w.x = cvt_pk_bf16(h0[0], h0[1]); w.y = cvt_pk_bf16(h0[2], h0[3]); w.z = cvt_pk_bf16(h1[0], h1[1]); w.w = cvt_pk_bf16(h1[2], h1[3]);
                        *(u32x4*)(HB + (size_t)r * 2048 + col0 + bj * HALF) = w;
                        ss += (h0[0] * h0[0] + h0[1] * h0[1]) + (h0[2] * h0[2] + h0[3] * h0[3]) + (h1[0] * h1[0] + h1[1] * h1[1]) + (h1[2] * h1[2] + h1[3] * h1[3]); } }
                if (MODE != 2) { ss += __shfl_xor(ss, 16); ss += __shfl_xor(ss, 32); if (fq == 0) SSQ2[(size_t)r * 32 + u.pn * 4 + wc] = ss; } }
            asm volatile("" ::: "memory");
        }
    }
};

template <class Epi, class Sched, bool ALIGN_EPI = true>
__device__ __forceinline__ void gemm_phase(PG8_LAS unsigned char* lds, const GemmP g, const Sched& S, const Epi& E, int tid) {
    asm volatile("" : "+v"(tid));
    const int wid = __builtin_amdgcn_readfirstlane(tid >> 6), lane = tid & 63, wr = wid >> 2, wc = wid & 3, fr = lane & 15, fq = lane >> 4;
    int nt = g.nt; asm volatile("" : "+s"(nt));
    unsigned voffA[2], voffB[2];
#pragma unroll
    for (int i = 0; i < 2; ++i) { int R, C; stage_rc(tid * 16 + i * 8192, R, C); const int Rb = Epi::BMODE == 2 ? (64 * (R >> 5) + perm32(R & 31)) : Epi::BMODE == 1 ? ((R & ~31) + perm32(R & 31)) : R;
        voffA[i] = (unsigned)(R * g.lda + C) * 2u; voffB[i] = (unsigned)(Rb * g.ldb + C) * 2u; }
    const size_t kstep = (size_t)(BK * 2);
    const size_t hstepA = (size_t)HALF * g.lda * 2, hstepB = (size_t)(Epi::BMODE == 2 ? 32 : HALF) * g.ldb * 2;
    const unsigned ldsw = (unsigned)wid * 1024u;
    const int aoff = lds_byte(wr * 64 + fr, fq * 8), boff = lds_byte(wc * 32 + fr, fq * 8);
#define PG8_SA(b, h) (((b) * 2 + (h)) * HTB)
#define PG8_SB(b, h) ((4 + (b) * 2 + (h)) * HTB)
#define PG8_STAGE(bufoff, gbase, voff) do { _Pragma("unroll") for (int _i = 0; _i < 2; ++_i) \
        __builtin_amdgcn_global_load_lds((const unsigned*)((const char*)(gbase) + (voff)[_i]), (PG8_LAS unsigned*)(lds + (bufoff) + ldsw + _i * 8192), 16, 0, 0); } while (0)
#define PG8_LDA(dst, b, h) do { _Pragma("unroll") for (int m = 0; m < 4; ++m) _Pragma("unroll") for (int k = 0; k < 2; ++k) dst[m][k] = *(const PG8_LAS bf16x8*)(lds + PG8_SA(b, h) + aoff + m * 2048 + k * 1024); } while (0)
#define PG8_LDB(dst, b, h) do { _Pragma("unroll") for (int n = 0; n < 2; ++n) _Pragma("unroll") for (int k = 0; k < 2; ++k) dst[n][k] = *(const PG8_LAS bf16x8*)(lds + PG8_SB(b, h) + boff + n * 2048 + k * 1024); } while (0)
#define PG8_MMA(ai, bj, At, Bt) do { __builtin_amdgcn_s_setprio(1); _Pragma("unroll") for (int m = 0; m < 4; ++m) _Pragma("unroll") for (int n = 0; n < 2; ++n) _Pragma("unroll") for (int k = 0; k < 2; ++k) \
        acc[ai][bj][m][n] = __builtin_amdgcn_mfma_f32_16x16x32_bf16(Bt[n][k], At[m][k], acc[ai][bj][m][n], 0, 0, 0); __builtin_amdgcn_s_setprio(0); } while (0)
#define PG8_WAIT_V(n) asm volatile("s_waitcnt vmcnt(" #n ")" ::: "memory")
#define PG8_WAIT_L(n) asm volatile("s_waitcnt lgkmcnt(" #n ")" ::: "memory")
#define PG8_BAR __builtin_amdgcn_s_barrier()
#define PG8_SCHED __builtin_amdgcn_sched_barrier(0)
    Unit cur, nxt; int ui = 0;
    if (!S.next(0, cur)) return;
    f32x4 acc[2][2][4][2];
#pragma unroll
    for (int a = 0; a < 2; ++a)
#pragma unroll
        for (int b = 0; b < 2; ++b)
#pragma unroll
            for (int m = 0; m < 4; ++m)
#pragma unroll
                for (int n = 0; n < 2; ++n) acc[a][b][m][n] = (f32x4){0.f, 0.f, 0.f, 0.f};
    bf16x8 At[4][2], B0[2][2], B1[2][2];
    const char* cA = cur.a; const char* cB = cur.b;
    S.a_ready(cur);
    PG8_STAGE(PG8_SB(0, 0), cB, voffB); PG8_STAGE(PG8_SB(0, 1), cB + hstepB, voffB); PG8_STAGE(PG8_SA(0, 0), cA, voffA); PG8_STAGE(PG8_SA(0, 1), cA + hstepA, voffA);
    if (wr == 1) PG8_BAR;
    PG8_WAIT_V(2); PG8_BAR;
    PG8_STAGE(PG8_SB(1, 0), cB + kstep, voffB); PG8_STAGE(PG8_SA(1, 0), cA + kstep, voffA); PG8_STAGE(PG8_SB(1, 1), cB + hstepB + kstep, voffB);
    PG8_WAIT_V(6); PG8_BAR;
    for (;;) {
        const bool has_next = S.next(ui + 1, nxt);
        const char* nA = has_next ? nxt.a : cA; const char* nB = has_next ? nxt.b : cB;
        for (int t = 0; t < nt; t += 2) {
            const bool last = (t == nt - 2);
            const char* a1 = cA + (size_t)(t + 1) * kstep;
            const char* a2 = last ? nA : cA + (size_t)(t + 2) * kstep; const char* b2 = last ? nB : cB + (size_t)(t + 2) * kstep;
            const char* a3 = a2 + kstep; const char* b3 = b2 + kstep;
            if (last && has_next) S.a_ready(nxt);
            PG8_LDB(B0, 0, 0); PG8_LDB(B1, 0, 1); PG8_SCHED; PG8_LDA(At, 0, 0); PG8_STAGE(PG8_SA(1, 1), a1 + hstepA, voffA);
            PG8_WAIT_V(8); PG8_WAIT_L(0); PG8_BAR; PG8_MMA(0, 0, At, B0); PG8_MMA(0, 1, At, B1); PG8_BAR; PG8_SCHED;
            PG8_LDA(At, 0, 1); PG8_STAGE(PG8_SB(0, 0), b2, voffB); PG8_STAGE(PG8_SB(0, 1), b2 + hstepB, voffB); PG8_STAGE(PG8_SA(0, 0), a2, voffA);
            PG8_WAIT_V(8); PG8_WAIT_L(0); PG8_BAR; PG8_MMA(1, 0, At, B0); PG8_MMA(1, 1, At, B1); PG8_BAR; PG8_SCHED;
            PG8_LDB(B0, 1, 0); PG8_LDB(B1, 1, 1); PG8_SCHED; PG8_LDA(At, 1, 0); PG8_STAGE(PG8_SA(0, 1), a2 + hstepA, voffA);
            PG8_WAIT_V(8); PG8_WAIT_L(0); PG8_BAR; PG8_MMA(0, 0, At, B0); PG8_MMA(0, 1, At, B1); PG8_BAR; PG8_SCHED;
            PG8_LDA(At, 1, 1); PG8_STAGE(PG8_SB(1, 0), b3, voffB); PG8_STAGE(PG8_SB(1, 1), b3 + hstepB, voffB); PG8_STAGE(PG8_SA(1, 0), a3, voffA);
            PG8_WAIT_V(8); PG8_WAIT_L(0); PG8_BAR; PG8_MMA(1, 0, At, B0); PG8_MMA(1, 1, At, B1); PG8_BAR; PG8_SCHED;
        }
        if constexpr (ALIGN_EPI) { if (wr == 0) PG8_BAR; }
        E(acc, cur, wr, wc, fr, fq); S.done(cur);
        if (!has_next) break;
#pragma unroll
        for (int a = 0; a < 2; ++a)
#pragma unroll
            for (int b = 0; b < 2; ++b)
#pragma unroll
                for (int m = 0; m < 4; ++m)
#pragma unroll
                    for (int n = 0; n < 2; ++n) acc[a][b][m][n] = (f32x4){0.f, 0.f, 0.f, 0.f};
        cur = nxt; cA = nA; cB = nB; ++ui;
        if constexpr (ALIGN_EPI) { if (wr == 1) PG8_BAR; }
    }
    PG8_WAIT_V(0);
    if constexpr (!ALIGN_EPI) { if (wr == 0) PG8_BAR; }
    PG8_BAR;
#undef PG8_SA
#undef PG8_SB
#undef PG8_STAGE
#undef PG8_LDA
#undef PG8_LDB
#undef PG8_MMA
#undef PG8_WAIT_V
#undef PG8_WAIT_L
#undef PG8_BAR
#undef PG8_SCHED
}
}

constexpr int NWAVES = 8, NTHR = 512;
constexpr int DM = 2048, MP = 16384, MS = 512, MT = MP + MS, PAST = 2048, DECL = 64, NB = 8;
constexpr int KCROWS = PAST + DECL;
constexpr float EPS = 1e-6f;
constexpr float LOG2E = 1.4426950408889634f;
constexpr float C2 = 0.125f * LOG2E;

enum { I_XP = 0, I_XS, I_CK, I_CV, I_SR, I_NW, I_AWIN, I_AWOUT, I_AQG, I_AKG, I_LQ1, I_LK1, I_LQ2, I_LK2, I_ASG, I_RWIN, I_RWOUT, I_CWIN, I_CWOUT, I_CVG, I_CWS, I_CBS, N_IN };
constexpr size_t O_YP = 0, O_YS = O_YP + (size_t)MP * DM, O_KP = O_YS + (size_t)MS * DM, O_VP = O_KP + 2 * (size_t)MP * DM, O_KS = O_VP + 2 * (size_t)MP * DM, O_VS = O_KS + 2 * (size_t)MS * DM,
                 O_SP = O_VS + 2 * (size_t)MS * DM, O_SS = O_SP + (size_t)8 * 256 * 512, O_VM = O_SS + (size_t)NB * 8 * 256 * 512, O_END = O_VM + (size_t)MS * 4096;

constexpr size_t MiB = 1u << 20;
constexpr size_t WS_CTL = 0, CTL_ZERO_BYTES = 1 * MiB;
constexpr size_t WS_WAIN0 = 8 * MiB, WS_WAOUT0 = 40 * MiB, WS_WRIN = 48 * MiB, WS_WROUT = 96 * MiB, WS_WCIN = 112 * MiB, WS_WCOUT = 160 * MiB, WS_WAIN1 = 176 * MiB, WS_WAOUT1 = 208 * MiB;
constexpr size_t WS_SSQ2 = 2 * MiB;
constexpr size_t WS_HB = 216 * MiB, WS_Z = 282 * MiB;
constexpr size_t WS_XN0 = 348 * MiB;
constexpr size_t WS_QS = 546 * MiB, WS_KP = 612 * MiB, WS_VP = 676 * MiB, WS_KC = 740 * MiB, WS_VC = 806 * MiB, WS_AOA = 872 * MiB;
constexpr size_t WS_KT = 112 * MiB, WS_RG = 282 * MiB, WS_QP = 414 * MiB, WS_KN = 546 * MiB, WS_VS = 612 * MiB, WS_ORET = 900 * MiB;
constexpr size_t WS_GU = 282 * MiB, WS_SG = 414 * MiB, WS_GVT = 546 * MiB, WS_WM = 678 * MiB, WS_SSQ = 744 * MiB, WS_GVS = 752 * MiB;
constexpr size_t WS_GA = 282 * MiB;
constexpr size_t WS_KVX = 184 * MiB;
constexpr size_t WS_TABR = 1040 * MiB, WS_TABA = 1056 * MiB, WS_END = 1060 * MiB;

#define GAS __attribute__((address_space(1)))
#define LAS __attribute__((address_space(3)))
typedef unsigned short bf16;
typedef unsigned v4u __attribute__((ext_vector_type(4)));
typedef unsigned v2u __attribute__((ext_vector_type(2)));
typedef float f32x4 __attribute__((ext_vector_type(4)));
typedef GAS unsigned gu32;
#define RLX_AGENT __ATOMIC_RELAXED, __HIP_MEMORY_SCOPE_AGENT
#define LDS_WAIT() asm volatile("s_waitcnt lgkmcnt(0)" ::: "memory")
#define VM_WAIT() asm volatile("s_waitcnt vmcnt(0)" ::: "memory")
typedef float g_f32x2 __attribute__((ext_vector_type(2))); typedef __bf16 g_bf16x2 __attribute__((ext_vector_type(2)));
__device__ __forceinline__ unsigned pk2(float lo, float hi) { const g_f32x2 v = {lo, hi}; const g_bf16x2 b = __builtin_convertvector(v, g_bf16x2); return __builtin_bit_cast(unsigned, b); }
__device__ __forceinline__ unsigned f2bf(float f) { return pk2(f, 0.f) & 0xffffu; }
__device__ __forceinline__ float bf2f(unsigned short b) { return __builtin_bit_cast(float, (unsigned)b << 16); }
__device__ __forceinline__ float bflo(unsigned w) { return __builtin_bit_cast(float, w << 16); }
__device__ __forceinline__ float bfhi(unsigned w) { return __builtin_bit_cast(float, w & 0xffff0000u); }
__device__ __forceinline__ float silu_f(float x) { return x * __builtin_amdgcn_rcpf(1.f + __builtin_amdgcn_exp2f(-LOG2E * x)); }
__device__ __forceinline__ float gelu_tanh_f(float x) { const float u = (0.7978845608028654f * 2.f * LOG2E) * (x + 0.044715f * x * x * x); return x * __builtin_amdgcn_rcpf(1.f + __builtin_amdgcn_exp2f(-u)); }
__device__ __forceinline__ float wave_sum(float v) {
#pragma unroll
    for (int o = 1; o < 64; o <<= 1) v += __shfl_xor(v, o);
    return v;
}
__device__ __forceinline__ void row_rstd(const float* ssq, int pm, int wr, int fr, int fq, float (&rs)[2][4]) {
#pragma unroll
    for (int ai = 0; ai < 2; ++ai)
#pragma unroll
        for (int m = 0; m < 4; ++m) {
            if (ssq) { const float* p = ssq + ((size_t)pm * 256 + ai * 128 + wr * 64 + m * 16 + fr) * 32 + 8 * fq; const f32x4 a = *(const f32x4*)p, b = *(const f32x4*)(p + 4);
                float t = ((a.x + a.y) + (a.z + a.w)) + ((b.x + b.y) + (b.z + b.w)); t += __shfl_xor(t, 16); t += __shfl_xor(t, 32); rs[ai][m] = 1.f / sqrtf(t * (1.f / 2048.f) + EPS); }
            else rs[ai][m] = 1.f; }
}
#define NT_LOAD(p) __builtin_nontemporal_load(p)
#define NT_STORE(v, p) __builtin_nontemporal_store((v), (p))
__device__ __forceinline__ void rope_cs(int pos, int i, int nf, float& c, float& s) {
    const float inv = exp2f(-(float)i / (float)nf * 13.287712379549449f);
    const double a = (double)pos * (double)inv * 0.15915494309189535;
    const float r = (float)(a - floor(a));
    c = __builtin_amdgcn_cosf(r); s = __builtin_amdgcn_sinf(r);
}

#define XB_TMO      128
#define XB_XCNT(j)  (256  + 64 * (j))
#define XB_XSUB(j)  (1280 + 64 * (j))
#define XB_XGEN(j)  (2304 + 64 * (j))
#define XB_TOP      3328
#define XB_TOPGEN   3392
#define XCD_BAR_WORDS 3456
#define XB_SPIN_CAP (1u << 22)
__device__ __forceinline__ unsigned xb_ld(unsigned* p)              { return __hip_atomic_load(p, __ATOMIC_RELAXED, __HIP_MEMORY_SCOPE_AGENT); }
__device__ __forceinline__ unsigned xb_add(unsigned* p, unsigned v) { return __hip_atomic_fetch_add(p, v, __ATOMIC_RELAXED, __HIP_MEMORY_SCOPE_AGENT); }
__device__ __forceinline__ unsigned xb_xcc_id() { return (unsigned)__builtin_amdgcn_s_getreg((3 << 11) | 20) & 0xFu; }
#define XB_SPIN(cond, bar) do { unsigned _sp = 0; while (cond) { __builtin_amdgcn_s_sleep(1); \
    if ((++_sp & 255u) == 0u) { if (xb_ld(&(bar)[XB_TMO])) break; if (_sp > XB_SPIN_CAP) { atomicAdd(&(bar)[XB_TMO], 1u); break; } } } } while (0)
struct XcdBarrier { unsigned* bar; unsigned x; volatile LAS unsigned* st; };
__device__ __forceinline__ XcdBarrier xcd_barrier_post(unsigned* bar, volatile LAS unsigned* st) {
    XcdBarrier b; b.bar = bar; b.x = xb_xcc_id(); b.st = st;
    if (threadIdx.x == 0) (void)xb_add(&bar[XB_XCNT(b.x)], 1u);
    return b;
}
__device__ __forceinline__ void xcd_barrier_complete(unsigned* bar, unsigned x, unsigned& nloc, unsigned& nx) {
    const unsigned G = gridDim.x * gridDim.y * gridDim.z;
    unsigned sum, cnt, mine, sp = 0u;
    for (;;) {
        sum = 0u; cnt = 0u; mine = 0u;
#pragma unroll
        for (unsigned j = 0; j < 16; ++j) { const unsigned c = xb_ld(&bar[XB_XCNT(j)]); sum += c; cnt += (c > 0u) ? 1u : 0u; mine = (j == x) ? c : mine; }
        if (sum == G) break;
        __builtin_amdgcn_s_sleep(1);
        if ((++sp & 255u) == 0u) { if (xb_ld(&bar[XB_TMO])) break; if (sp > XB_SPIN_CAP) { atomicAdd(&bar[XB_TMO], 1u); break; } }
    }
    nloc = mine > 0u ? mine : 1u; nx = cnt > 0u ? cnt : 1u;
}
__device__ __forceinline__ void xcd_barrier(const XcdBarrier& b, bool leader) {
    asm volatile("s_waitcnt vmcnt(0)" ::: "memory");
    __syncthreads();
    if (leader) {
        unsigned* bar = b.bar;
        __builtin_amdgcn_s_waitcnt(0);
        unsigned nloc = b.st[0], nx = b.st[1];
        if (nloc == 0u) { xcd_barrier_complete(bar, b.x, nloc, nx); b.st[0] = nloc; b.st[1] = nx; }
        const unsigned old = xb_add(&bar[XB_XSUB(b.x)], 1u);
        const unsigned gen = old / nloc;
        if (old + 1u == (gen + 1u) * nloc) {
            __builtin_amdgcn_fence(__ATOMIC_RELEASE, "agent");
            asm volatile("s_waitcnt vmcnt(0)" ::: "memory");
            const unsigned og = xb_add(&bar[XB_TOP], 1u);
            const unsigned tg = og / nx;
            if (og + 1u == (tg + 1u) * nx) xb_add(&bar[XB_TOPGEN], 1u);
            else XB_SPIN(xb_ld(&bar[XB_TOPGEN]) == tg, bar);
            __builtin_amdgcn_fence(__ATOMIC_ACQUIRE, "agent");
            xb_add(&bar[XB_XGEN(b.x)], 1u);
            asm volatile("s_waitcnt vmcnt(0)" ::: "memory");
        } else {
            XB_SPIN(xb_ld(&bar[XB_XGEN(b.x)]) == gen, bar);
            __builtin_amdgcn_fence(__ATOMIC_ACQUIRE, "agent");
            asm volatile("s_waitcnt vmcnt(0)" ::: "memory");
        }
    }
    __syncthreads();
}

constexpr int RING_OFF = 0, RING_BYTES = 139264;
constexpr int MISC_OFF = RING_BYTES;
constexpr int LDS_BYTES = 147456;
struct Args { const float* in[N_IN]; float* out; unsigned char* ws; int ph_lo, ph_hi; };
struct Frame {
    LAS unsigned char* lds; int tid, lane, wave, G, bid;
    const float* const* in; float* out; unsigned char* ws;
};

__device__ __forceinline__ int cmlp_col(int n) { return n < 4096 ? (n >> 7) * 256 + (n & 127) : n < 8192 ? n + 4096 : ((n - 8192) >> 7) * 256 + 128 + (n & 127); }
__device__ __forceinline__ void p0_transpose_item(const float* W, int K, int N, bf16* WT, LAS float* scr, int item, int lane, const float* ksc = nullptr, bool cperm = false) {
    const int nblk = N / 32, kb = item / nblk, nb = item % nblk, k0 = 64 * kb, n0 = 32 * nb;
    float w_[32];
#pragma unroll
    for (int i = 0; i < 32; ++i) w_[i] = NT_LOAD(W + (size_t)(k0 + 2 * i + (lane >> 5)) * N + n0 + (lane & 31));
#pragma unroll
    for (int i = 0; i < 32; ++i) { const int kk = 2 * i + (lane >> 5); scr[kk * 33 + (lane & 31)] = ksc ? w_[i] * ksc[k0 + kk] : w_[i]; }
    LDS_WAIT(); asm volatile("" ::: "memory");
    const int c = lane & 7;
#pragma unroll
    for (int j = 0; j < 4; ++j) { const int n = (lane >> 3) + 8 * j; const LAS float* s = scr + (8 * c) * 33 + n;
        v4u o; o.x = pk2(s[0 * 33], s[1 * 33]); o.y = pk2(s[2 * 33], s[3 * 33]); o.z = pk2(s[4 * 33], s[5 * 33]); o.w = pk2(s[6 * 33], s[7 * 33]);
        *(GAS v4u*)(WT + (size_t)((cperm ? cmlp_col(n0) : n0) + n) * K + k0 + 8 * c) = o; }
    LDS_WAIT(); asm volatile("" ::: "memory");
}
__device__ __forceinline__ void transpose_weight(Frame& F, const float* W, int K, int N, bf16* WT) {
    LAS float* scr = (LAS float*)(F.lds + RING_OFF + F.wave * 16384);
    const int gw = F.bid * NWAVES + F.wave, NGW = F.G * NWAVES, nitems = (K / 64) * (N / 32);
    for (int it = gw; it < nitems; it += NGW) p0_transpose_item(W, K, N, WT, scr, it, F.lane);
}
__device__ __forceinline__ void norm_rows(Frame& F, const float* src_p, const float* src_s, const float* w, bf16* XN) {
    const int gw = F.bid * NWAVES + F.wave, NGW = F.G * NWAVES;
    const GAS f32x4* wr = (const GAS f32x4*)w + F.lane;
    f32x4 nx[8];
    if (gw < MT) { const float* xrow = (gw < MP) ? src_p + (size_t)gw * DM : src_s + (size_t)(gw - MP) * DM;
#pragma unroll
        for (int j = 0; j < 8; ++j) nx[j] = __builtin_nontemporal_load((const f32x4*)(xrow) + F.lane + 64 * j); }
    for (int m = gw; m < MT; m += NGW) {
        f32x4 v[8]; float s = 0.f;
#pragma unroll
        for (int j = 0; j < 8; ++j) v[j] = nx[j];
        const int m2 = m + NGW;
        if (m2 < MT) { const float* xrow = (m2 < MP) ? src_p + (size_t)m2 * DM : src_s + (size_t)(m2 - MP) * DM;
#pragma unroll
            for (int j = 0; j < 8; ++j) nx[j] = __builtin_nontemporal_load((const f32x4*)(xrow) + F.lane + 64 * j); }
#pragma unroll
        for (int j = 0; j < 8; ++j) s += (v[j].x * v[j].x + v[j].y * v[j].y) + (v[j].z * v[j].z + v[j].w * v[j].w);
        const float rstd = 1.f / sqrtf(wave_sum(s) * (1.f / DM) + EPS);
        GAS v2u* o8 = (GAS v2u*)(XN + (size_t)m * DM) + F.lane;
#pragma unroll
        for (int j = 0; j < 8; ++j) { const f32x4 g = wr[64 * j]; v2u o; o.x = pk2(v[j].x * rstd * g.x, v[j].y * rstd * g.y); o.y = pk2(v[j].z * rstd * g.z, v[j].w * rstd * g.w); o8[64 * j] = o; }
    }
}
__device__ __forceinline__ void cache_cvt(Frame& F, const float* ck, const float* cv, bf16* KC, bf16* VC) {
    const size_t nvec = (size_t)NB * PAST * DM / 4;
    const size_t gt = (size_t)F.bid * NTHR + F.tid, NG = (size_t)F.G * NTHR;
    for (size_t i = gt; i < 2 * nvec; i += NG) {
        const bool isv = i >= nvec; const size_t e = (isv ? i - nvec : i) * 4;
        const size_t brow = e / DM, col = e % DM, b = brow / PAST, t = brow % PAST;
        const f32x4 x = *(const GAS f32x4*)((isv ? cv : ck) + e);
        v2u o; o.x = pk2(x.x, x.y); o.y = pk2(x.z, x.w);
        *(GAS v2u*)((isv ? VC : KC) + ((b * KCROWS + t) * DM + col)) = o;
    }
}
__device__ __forceinline__ int tw_chunks(int K, int N) { return (K / 64) * (N / 32) / 64; }
__device__ __forceinline__ void tw_run(Frame& F, const float* W, int K, int N, bf16* WT, int c, const float* ksc = nullptr, bool cperm = false) {
    LAS float* scr = (LAS float*)(F.lds + RING_OFF + F.wave * 16384);
#pragma unroll 1
    for (int i = 0; i < 8; ++i) p0_transpose_item(W, K, N, WT, scr, c * 64 + F.wave * 8 + i, F.lane, ksc, cperm);
}
constexpr int CC_CHUNKS = 2 * (NB * PAST * DM / 4) / 8192;
__device__ __forceinline__ void cc_run(Frame& F, const float* ck, const float* cv, bf16* KC, bf16* VC, int c) {
    const bool isv = c >= CC_CHUNKS / 2; const int brow0 = (isv ? c - CC_CHUNKS / 2 : c) * 16, b = brow0 / PAST, t0 = brow0 % PAST;
    const float* src = (isv ? cv : ck) + (size_t)brow0 * DM + F.tid * 4;
    bf16* dst = (isv ? VC : KC) + ((size_t)b * KCROWS + t0) * DM + F.tid * 4;
    f32x4 x[16];
#pragma unroll
    for (int k = 0; k < 16; ++k) x[k] = NT_LOAD((const f32x4*)(src + (size_t)k * DM));
#pragma unroll
    for (int k = 0; k < 16; ++k) { v2u o; o.x = pk2(x[k].x, x[k].y); o.y = pk2(x[k].z, x[k].w); *(GAS v2u*)(dst + (size_t)k * DM) = o; }
}
constexpr int TR_CHUNKS = MP * 128 / 8192;
__device__ __forceinline__ void tr_run(Frame& F, float* tab, int c) {
#pragma unroll 1
    for (int k = 0; k < 16; ++k) { const size_t e = (size_t)c * 8192 + k * NTHR + F.tid; float cs, sn; rope_cs((int)(e >> 7), (int)(e & 127), 128, cs, sn); tab[2 * e] = cs; tab[2 * e + 1] = sn; }
}
__device__ __forceinline__ int row_pos(int row) { return row < MP ? row : PAST + ((row - MP) & 63); }

struct EpiAIn {
    static constexpr int BMODE = 2;
    pg8::bf16_t *Qs, *KP, *VP, *KC, *VC, *GA; float *okp, *ovp, *oks, *ovs; const float* tab; const float* qg; const float* kg; const float* ssq;
    __device__ __forceinline__ void operator()(const pg8::f32x4 (&acc)[2][2][4][2], const pg8::Unit& u, int wr, int wc, int fr, int fq) const {
        { const int l_ = lane_now(); fr = l_ & 15; fq = l_ >> 4; }
        const int pn = u.pn, pm = u.pm, typ = pn >> 3, cl = ((pn & 7) * 4 + wc) * 64 + 8 * fq; float rs[2][4]; row_rstd(ssq, pm, wr, fr, fq, rs);
        float g1[8], g2[8];
        if (typ < 2) { const float* gp = (typ == 0 ? qg : kg) + 8 * fq; const pg8::f32x4 a = *(const pg8::f32x4*)gp, b = *(const pg8::f32x4*)(gp + 4), c = *(const pg8::f32x4*)(gp + 32), d = *(const pg8::f32x4*)(gp + 36);
#pragma unroll
            for (int e = 0; e < 4; ++e) { g1[e] = a[e]; g1[4 + e] = b[e]; g2[e] = c[e]; g2[4 + e] = d[e]; } }
#pragma unroll
        for (int ai = 0; ai < 2; ++ai)
#pragma unroll
          for (int mp = 0; mp < 2; ++mp) {
            pg8::f32x4 tq[4][4];
            if (typ < 2) {
#pragma unroll
                for (int m = 2 * mp; m < 2 * mp + 2; ++m) { const int i_ = ai * 128 + wr * 64 + m * 16 + fr; const int pos_ = pm < 64 ? pm * 256 + i_ : PAST + (i_ & 63); const float* tp_ = tab + ((size_t)pos_ * 32 + 8 * fq) * 2;
#pragma unroll
                    for (int q4 = 0; q4 < 4; ++q4) tq[m][q4] = *(const pg8::f32x4*)(tp_ + 4 * q4); } }
#pragma unroll
            for (int m = 2 * mp; m < 2 * mp + 2; ++m) {
                const int i = ai * 128 + wr * 64 + m * 16 + fr; const size_t row = (size_t)pm * 256 + i;
                float x1[8], x2[8];
#pragma unroll
                for (int e = 0; e < 4; ++e) { x1[e] = acc[ai][0][m][0][e] * rs[ai][m]; x1[4 + e] = acc[ai][0][m][1][e] * rs[ai][m]; x2[e] = acc[ai][1][m][0][e] * rs[ai][m]; x2[4 + e] = acc[ai][1][m][1][e] * rs[ai][m]; }
                size_t drow; pg8::bf16_t* dk; pg8::bf16_t* dv; float* fk; float* fv;
                if (pm < 64) { drow = row; dk = KP; dv = VP; fk = okp + row * DM; fv = ovp + row * DM; }
                else { const int s_ = (int)(row - MP); drow = (size_t)(s_ >> 6) * KCROWS + PAST + (s_ & 63); dk = KC; dv = VC; fk = oks + (size_t)s_ * DM; fv = ovs + (size_t)s_ * DM; }
                if (typ < 2) {
                    float ss = 0.f;
#pragma unroll
                    for (int k = 0; k < 8; ++k) ss += x1[k] * x1[k] + x2[k] * x2[k];
                    ss += __shfl_xor(ss, 16); ss += __shfl_xor(ss, 32);
                    const float rstd = 1.f / sqrtf(ss * (1.f / 64.f) + EPS);
                    float o1[8], o2[8];
#pragma unroll
                    for (int q4 = 0; q4 < 4; ++q4) { const pg8::f32x4 t = tq[m][q4];
#pragma unroll
                        for (int z = 0; z < 2; ++z) { const int k = 2 * q4 + z; const float c = t[2 * z], s = t[2 * z + 1], y1 = x1[k] * rstd * g1[k], y2 = x2[k] * rstd * g2[k]; o1[k] = y1 * c - y2 * s; o2[k] = y2 * c + y1 * s; } }
                    if (typ == 0) { v4u w1, w2;
                        w1.x = pk2(o1[0] * C2, o1[1] * C2); w1.y = pk2(o1[2] * C2, o1[3] * C2); w1.z = pk2(o1[4] * C2, o1[5] * C2); w1.w = pk2(o1[6] * C2, o1[7] * C2);
                        w2.x = pk2(o2[0] * C2, o2[1] * C2); w2.y = pk2(o2[2] * C2, o2[3] * C2); w2.z = pk2(o2[4] * C2, o2[5] * C2); w2.w = pk2(o2[6] * C2, o2[7] * C2);
                        *(v4u*)(Qs + row * DM + cl) = w1; *(v4u*)(Qs + row * DM + cl + 32) = w2;
                    } else { v4u w1, w2;
                        w1.x = pk2(o1[0], o1[1]); w1.y = pk2(o1[2], o1[3]); w1.z = pk2(o1[4], o1[5]); w1.w = pk2(o1[6], o1[7]);
                        w2.x = pk2(o2[0], o2[1]); w2.y = pk2(o2[2], o2[3]); w2.z = pk2(o2[4], o2[5]); w2.w = pk2(o2[6], o2[7]);
                        *(v4u*)(dk + drow * DM + cl) = w1; *(v4u*)(dk + drow * DM + cl + 32) = w2;
                        NT_STORE(((pg8::f32x4){o1[0], o1[1], o1[2], o1[3]}), (pg8::f32x4*)(fk + cl)); NT_STORE(((pg8::f32x4){o1[4], o1[5], o1[6], o1[7]}), (pg8::f32x4*)(fk + cl + 4));
                        NT_STORE(((pg8::f32x4){o2[0], o2[1], o2[2], o2[3]}), (pg8::f32x4*)(fk + cl + 32)); NT_STORE(((pg8::f32x4){o2[4], o2[5], o2[6], o2[7]}), (pg8::f32x4*)(fk + cl + 36)); }
                } else { v4u w1, w2;
                    w1.x = pk2(x1[0], x1[1]); w1.y = pk2(x1[2], x1[3]); w1.z = pk2(x1[4], x1[5]); w1.w = pk2(x1[6], x1[7]);
                    w2.x = pk2(x2[0], x2[1]); w2.y = pk2(x2[2], x2[3]); w2.z = pk2(x2[4], x2[5]); w2.w = pk2(x2[6], x2[7]);
                    if (typ == 2) { *(v4u*)(dv + drow * DM + cl) = w1; *(v4u*)(dv + drow * DM + cl + 32) = w2;
                        NT_STORE(((pg8::f32x4){x1[0], x1[1], x1[2], x1[3]}), (pg8::f32x4*)(fv + cl)); NT_STORE(((pg8::f32x4){x1[4], x1[5], x1[6], x1[7]}), (pg8::f32x4*)(fv + cl + 4));
                        NT_STORE(((pg8::f32x4){x2[0], x2[1], x2[2], x2[3]}), (pg8::f32x4*)(fv + cl + 32)); NT_STORE(((pg8::f32x4){x2[4], x2[5], x2[6], x2[7]}), (pg8::f32x4*)(fv + cl + 36)); }
                    else { *(v4u*)(GA + row * DM + cl) = w1; *(v4u*)(GA + row * DM + cl + 32) = w2; }
                }
                if (m & 1) asm volatile("" ::: "memory");
            }
        }
    }
};
__device__ __forceinline__ void attn_table(Frame& F, float* tab) {
    const size_t gt = (size_t)F.bid * NTHR + F.tid, NG = (size_t)F.G * NTHR;
    for (size_t e = gt; e < (size_t)MP * 32; e += NG) { float c, s; rope_cs((int)(e >> 5), (int)(e & 31), 32, c, s); tab[2 * e] = c; tab[2 * e + 1] = s; }
}
namespace dattn {
typedef short bf16x8 __attribute__((ext_vector_type(8)));
typedef short s16x4 __attribute__((ext_vector_type(4)));
typedef short v4i16_t __attribute__((ext_vector_type(4)));
typedef float f32x16 __attribute__((ext_vector_type(16)));
typedef unsigned u32x4 __attribute__((ext_vector_type(4)));
typedef __attribute__((address_space(3))) const char* lds_cptr;
constexpr int RINGB = 98304, WSF_OFF = RINGB, XCHB = 18432, STP = 144;
__device__ __forceinline__ int crow(int r, int hi) { return (r & 3) + 8 * (r >> 2) + 4 * hi; }
__device__ __forceinline__ void glds16(const void* gsrc, unsigned lds_dst) { unsigned keep;
    asm volatile("s_mov_b32 %0, m0\n\ts_mov_b32 m0, %2\n\ts_nop 0\n\tglobal_load_lds_dwordx4 %1, off\n\ts_mov_b32 m0, %0" : "=&s"(keep) : "v"(gsrc), "s"(lds_dst) : "memory"); }
typedef float f32x2_t __attribute__((ext_vector_type(2))); typedef __bf16 bf16x2_t __attribute__((ext_vector_type(2)));
__device__ __forceinline__ unsigned cvtpk_s(float lo, float hi) { f32x2_t v = {lo, hi}; bf16x2_t b = __builtin_convertvector(v, bf16x2_t); return __builtin_bit_cast(unsigned, b); }
#define DA_WAIT_BAR(N) asm volatile("s_waitcnt vmcnt(" #N ") lgkmcnt(0)\n\ts_barrier" ::: "memory")
__device__ __forceinline__ s16x4 vtr(lds_cptr p) { return __builtin_bit_cast(s16x4, __builtin_amdgcn_ds_read_tr16_b64_v4i16((__attribute__((address_space(3))) v4i16_t*)p)); }
struct Unit { const bf16* Q; const bf16* K; const bf16* V; const bf16* G; bf16* AO; int NT; int full; int dma0; };

constexpr int KSLOT = 16384, VSLOT = 16384, VRING = 3 * KSLOT;
#define DA_SBAR() __builtin_amdgcn_sched_barrier(0)
#define DA_PIN(x) asm volatile("" : "+v"(x))
#define DA_MFMA(a, b, c) __builtin_amdgcn_mfma_f32_32x32x16_bf16(a, b, c, 0, 0, 0)
struct DmaJob { const bf16* kp; const bf16* vp; unsigned kd0, kd1, vd0, vd1; };
__device__ __forceinline__ void dma_piece(const DmaJob& j, int i) { if (i == 0) glds16(j.kp, j.kd0); else if (i == 1) glds16(j.kp + 64, j.kd1); else if (i == 2) glds16(j.vp, j.vd0); else glds16(j.vp + 64, j.vd1); }
template <bool QK, bool PV, int VAR>
__device__ __forceinline__ void step(lds_cptr kpn, lds_cptr vp, const bf16x8 (&qr)[4], bf16x8 (&kf)[8], f32x16 (&o)[4], u32x4 (&pw)[4], float& l_reg, const DmaJob& dj) {
    f32x16 C0 = f32x16{}, C1 = f32x16{};
    s16x4 vlo[4], vhi[4];
    if constexpr (!QK) { dma_piece(dj, 0); dma_piece(dj, 1); dma_piece(dj, 2); dma_piece(dj, 3); }
#define DA_FOFF(f) ((((f) & 3) * 4096) + (((f) >> 2) * 1024))
#pragma unroll
    for (int a = 0; a < 8; ++a) {
        if constexpr (PV) { if (a >= 4) { if (VAR != 4) { vlo[a - 4] = vtr(vp + DA_FOFF(a - 4)); vhi[a - 4] = vtr(vp + DA_FOFF(a - 4) + 512); } else { vlo[a - 4] = s16x4{1, 2, 3, 4}; vhi[a - 4] = s16x4{5, 6, 7, 8}; } DA_SBAR(); } }
        if constexpr (QK) {
            if (a & 1) C1 = (a < 2) ? DA_MFMA(kf[a], qr[a >> 1], f32x16{}) : DA_MFMA(kf[a], qr[a >> 1], C1);
            else       C0 = (a < 2) ? DA_MFMA(kf[a], qr[a >> 1], f32x16{}) : DA_MFMA(kf[a], qr[a >> 1], C0);
            if (a < 4) dma_piece(dj, a);
            DA_SBAR();
        }
    }
    u32x4 pwn[4]; pwn[0] = u32x4{}; pwn[1] = u32x4{}; pwn[2] = u32x4{}; pwn[3] = u32x4{};
    float s0 = 0.f, s1 = 0.f;
#pragma unroll
    for (int p = 0; p < 16; ++p) {
        if constexpr (PV) {
            const bf16x8 vf = (bf16x8){vlo[p & 3][0], vlo[p & 3][1], vlo[p & 3][2], vlo[p & 3][3], vhi[p & 3][0], vhi[p & 3][1], vhi[p & 3][2], vhi[p & 3][3]};
            if (VAR != 3) o[p & 3] = DA_MFMA(__builtin_bit_cast(bf16x8, pw[p >> 2]), vf, o[p & 3]); else { o[p & 3][0] += __builtin_bit_cast(float, (int)vf[0] | ((int)vf[4] << 16)); }
            if (p < 12 && VAR != 4) { vlo[p & 3] = vtr(vp + DA_FOFF(p + 4)); vhi[p & 3] = vtr(vp + DA_FOFF(p + 4) + 512); }
        }
        if constexpr (QK) {
            float e0, e1;
            if (VAR == 2) { if (p < 8) { e0 = C0[2 * p]; e1 = C0[2 * p + 1]; } else { e0 = C1[2 * p - 16]; e1 = C1[2 * p - 15]; } }
            else if (p < 8) { e0 = __builtin_amdgcn_exp2f(C0[2 * p]); e1 = __builtin_amdgcn_exp2f(C0[2 * p + 1]); }
            else       { e0 = __builtin_amdgcn_exp2f(C1[2 * p - 16]); e1 = __builtin_amdgcn_exp2f(C1[2 * p - 15]); }
            s0 += e0; s1 += e1; pwn[p >> 2][p & 3] = cvtpk_s(e0, e1);
            DA_PIN(s0); DA_PIN(s1); DA_PIN(pwn[p >> 2]);
            if (p >= 8 && VAR != 6) { const int j = p - 8; kf[j] = *(const __attribute__((address_space(3))) bf16x8*)(kpn + (j >> 1) * 2048 + (j & 1) * 512); }
        }
        DA_SBAR();
    }
    if constexpr (QK) { l_reg += s0 + s1; pw[0] = pwn[0]; pw[1] = pwn[1]; pw[2] = pwn[2]; pw[3] = pwn[3]; }
#undef DA_FOFF
}

template <bool QK, bool PV>
__device__ __forceinline__ void step2(lds_cptr kpn, lds_cptr vp, const bf16x8 (&qr)[4], bf16x8 (&kf)[8], f32x16 (&o)[4], u32x4 (&pw)[4], float& l_reg, const DmaJob& dj,
                                      f32x16& Cn0, f32x16& Cn1, const f32x16& Pp0, const f32x16& Pp1) {
    s16x4 vlo[4], vhi[4];
#define DA_FOFF(f) ((((f) & 3) * 4096) + (((f) >> 2) * 1024))
    if constexpr (!QK) { dma_piece(dj, 0); dma_piece(dj, 1); dma_piece(dj, 2); dma_piece(dj, 3); }
    float s0 = 0.f, s1 = 0.f;
#pragma unroll
    for (int a = 0; a < 8; ++a) {
        if constexpr (PV) { if (a >= 4) { vlo[a - 4] = vtr(vp + DA_FOFF(a - 4)); vhi[a - 4] = vtr(vp + DA_FOFF(a - 4) + 512); DA_SBAR(); } }
        if constexpr (QK) {
            if (a & 1) Cn1 = (a < 2) ? DA_MFMA(kf[a], qr[a >> 1], f32x16{}) : DA_MFMA(kf[a], qr[a >> 1], Cn1);
            else       Cn0 = (a < 2) ? DA_MFMA(kf[a], qr[a >> 1], f32x16{}) : DA_MFMA(kf[a], qr[a >> 1], Cn0);
            if (a < 4) dma_piece(dj, a);
        }
        if constexpr (PV) {
            float x0, x1, x2, x3;
            if (a < 4) { x0 = Pp0[4 * a]; x1 = Pp0[4 * a + 1]; x2 = Pp0[4 * a + 2]; x3 = Pp0[4 * a + 3]; }
            else       { x0 = Pp1[4 * a - 16]; x1 = Pp1[4 * a - 15]; x2 = Pp1[4 * a - 14]; x3 = Pp1[4 * a - 13]; }
            s0 += x0; s1 += x1; s0 += x2; s1 += x3;
            pw[(2 * a) >> 2][(2 * a) & 3] = cvtpk_s(x0, x1); pw[(2 * a + 1) >> 2][(2 * a + 1) & 3] = cvtpk_s(x2, x3);
            DA_PIN(s0); DA_PIN(s1); DA_PIN(pw[(2 * a) >> 2]);
        }
        if constexpr (QK || PV) DA_SBAR();
    }
    if constexpr (PV) l_reg += s0 + s1;
#pragma unroll
    for (int p = 0; p < 16; ++p) {
        if constexpr (PV) {
            const bf16x8 vf = (bf16x8){vlo[p & 3][0], vlo[p & 3][1], vlo[p & 3][2], vlo[p & 3][3], vhi[p & 3][0], vhi[p & 3][1], vhi[p & 3][2], vhi[p & 3][3]};
            o[p & 3] = DA_MFMA(__builtin_bit_cast(bf16x8, pw[p >> 2]), vf, o[p & 3]);
            if (p < 12) { vlo[p & 3] = vtr(vp + DA_FOFF(p + 4)); vhi[p & 3] = vtr(vp + DA_FOFF(p + 4) + 512); }
        }
        if constexpr (QK) {
            if (p < 8) { Cn0[2 * p] = __builtin_amdgcn_exp2f(Cn0[2 * p]); Cn0[2 * p + 1] = __builtin_amdgcn_exp2f(Cn0[2 * p + 1]); DA_PIN(Cn0); }
            else       { Cn1[2 * p - 16] = __builtin_amdgcn_exp2f(Cn1[2 * p - 16]); Cn1[2 * p - 15] = __builtin_amdgcn_exp2f(Cn1[2 * p - 15]); DA_PIN(Cn1); }
            if (p >= 8) { const int j = p - 8; kf[j] = *(const __attribute__((address_space(3))) bf16x8*)(kpn + (j >> 1) * 2048 + (j & 1) * 512); }
        }
        if constexpr (QK || PV) DA_SBAR();
    }
#undef DA_FOFF
}

__device__ __forceinline__ void unit_prologue(const Unit& u, unsigned lds0, int lane, int wid, bf16x8 (&qr)[4]) {
    const int r32 = lane & 31, hi = lane >> 5, s = wid >> 2, g = wid & 3; const int NT = u.NT; const int wt = u.full ? (g < 2 ? NT - 1 : NT) : (g < 2 ? NT : 0);
    const bf16* ksrc = u.K + (long)lane * DM + wid * 8;
    const bf16* vsrc = u.V + (long)(16 * (wid & 3) + (lane >> 2)) * DM + (wid >> 2) * 32 + (lane & 3) * 8;
    const unsigned kdst = lds0 + wid * 1024, vdst = lds0 + VRING + wid * 1024;
#pragma unroll
    for (int t = 0; t < 3; ++t) { const int tt_ = t < NT ? t : NT - 1; const bf16* kp_ = ksrc + (long)tt_ * 64 * DM;
        glds16(kp_, (unsigned)__builtin_amdgcn_readfirstlane(kdst + t * KSLOT)); glds16(kp_ + 64, (unsigned)__builtin_amdgcn_readfirstlane(kdst + 8192 + t * KSLOT)); }
    glds16(vsrc, (unsigned)__builtin_amdgcn_readfirstlane(vdst)); glds16(vsrc + 64, (unsigned)__builtin_amdgcn_readfirstlane(vdst + 8192));
    const bf16* Qw = u.Q + (long)(32 * g + r32) * DM + s * 64;
#pragma unroll
    for (int d0 = 0; d0 < 4; ++d0) qr[d0] = (wt > 0) ? *reinterpret_cast<const bf16x8*>(Qw + d0 * 16 + hi * 8) : (bf16x8){0, 0, 0, 0, 0, 0, 0, 0};
}
template <int VAR>
__device__ __forceinline__ void attn_unit(const Unit& u, bool has_next, const Unit& nxt, bool prefetched, bf16x8 (&qr)[4], char* shm, float* wsf_base, float lam, float one_m_li, const float* sub_gain, int tid) {
    asm volatile("" : "+v"(tid));
    const int lane = tid & 63, r32 = lane & 31, hi = lane >> 5; const int wid = __builtin_amdgcn_readfirstlane(tid >> 6), s = wid >> 2, g = wid & 3;
    const int NT = u.NT; const int wt = u.full ? (g < 2 ? NT - 1 : NT) : (g < 2 ? NT : 0);
    const unsigned lds0 = (unsigned)(uintptr_t)shm;
    float* wsf = wsf_base + wid * 64;
    const bf16* ksrc = u.K + (long)lane * DM + wid * 8;
    const bf16* vsrc = u.V + (long)(16 * (wid & 3) + (lane >> 2)) * DM + (wid >> 2) * 32 + (lane & 3) * 8;
    const unsigned kdst = lds0 + wid * 1024, vdst = lds0 + VRING + wid * 1024;
#define DA_DMA_K(t, slot) do { const int tt_ = u.dma0 ? 0 : (t) < NT ? (t) : NT - 1; const bf16* kp_ = ksrc + (long)tt_ * 64 * DM; \
        glds16(kp_, (unsigned)__builtin_amdgcn_readfirstlane(kdst + (slot) * KSLOT)); glds16(kp_ + 64, (unsigned)__builtin_amdgcn_readfirstlane(kdst + 8192 + (slot) * KSLOT)); } while (0)
#define DA_DMA_V(t, slot) do { const int tt_ = u.dma0 ? 0 : (t) < NT ? (t) : NT - 1; const bf16* vp_ = vsrc + (long)tt_ * 64 * DM; \
        glds16(vp_, (unsigned)__builtin_amdgcn_readfirstlane(vdst + (slot) * VSLOT)); glds16(vp_ + 64, (unsigned)__builtin_amdgcn_readfirstlane(vdst + 8192 + (slot) * VSLOT)); } while (0)
    const lds_cptr shm3 = (lds_cptr)shm;
    const lds_cptr kp0 = shm3 + s * 8192 + hi * 1024 + r32 * 16;
    const lds_cptr vp0 = shm3 + VRING + ((lane >> 4) & 1) * 32 + (lane & 3) * 8 + (4 * hi + ((lane & 15) >> 2)) * 64;
    if (!prefetched) unit_prologue(u, lds0, lane, wid, qr);
    asm volatile("" : "+v"(qr[0]), "+v"(qr[1]), "+v"(qr[2]), "+v"(qr[3]));
    f32x16 o[4]; o[0] = f32x16{}; o[1] = f32x16{}; o[2] = f32x16{}; o[3] = f32x16{};
    float l_reg = 0.f;
    u32x4 pw[4]; pw[0] = u32x4{}; pw[1] = u32x4{}; pw[2] = u32x4{}; pw[3] = u32x4{};
    DA_WAIT_BAR(0);
    bf16x8 kf[8];
#pragma unroll
    for (int j = 0; j < 8; ++j) kf[j] = *(const __attribute__((address_space(3))) bf16x8*)(kp0 + (j >> 1) * 2048 + (j & 1) * 512);
    int ks_cur = 0  , vs_prev = 2  ;
#define DA_TOP(t) \
        DA_WAIT_BAR(4);                                          \
        const int ks_next = (ks_cur == 2) ? 0 : ks_cur + 1, vs_cur = (vs_prev == 2) ? 0 : vs_prev + 1, vs_next = (vs_cur == 2) ? 0 : vs_cur + 1; \
        DmaJob dj; { const int tk_ = ((t) + 3) < NT ? ((t) + 3) : NT - 1, tv_ = ((t) + 1) < NT ? ((t) + 1) : NT - 1; dj.kp = ksrc + (long)tk_ * 64 * DM; dj.vp = vsrc + (long)tv_ * 64 * DM; \
          dj.kd0 = (unsigned)__builtin_amdgcn_readfirstlane(kdst + ks_cur * KSLOT); dj.kd1 = dj.kd0 + 8192u; dj.vd0 = (unsigned)__builtin_amdgcn_readfirstlane(vdst + vs_next * VSLOT); dj.vd1 = dj.vd0 + 8192u; }     \
        const lds_cptr kpn = kp0 + ks_next * KSLOT; const lds_cptr vp = vp0 + vs_prev * VSLOT; (void)kpn; (void)vp
#define DA_ROT() do { ks_cur = ks_next; vs_prev = vs_cur; } while (0)
    f32x16 pA0 = f32x16{}, pA1 = f32x16{}, pB0 = f32x16{}, pB1 = f32x16{};
#define DA_IDLE() do { dma_piece(dj, 0); dma_piece(dj, 1); dma_piece(dj, 2); dma_piece(dj, 3); } while (0)
    if (wid >= 4) __builtin_amdgcn_s_setprio(1);
    int t = 0;
    const bool odd = ((wt - 1) & 1) != 0;
    { DA_TOP(0); if (wt > 0) { if (odd) step2<true, false>(kpn, vp, qr, kf, o, pw, l_reg, dj, pB0, pB1, pA0, pA1); else step2<true, false>(kpn, vp, qr, kf, o, pw, l_reg, dj, pA0, pA1, pB0, pB1); } else DA_IDLE(); DA_ROT(); }
    t = 1;
    if (wt > 0 && odd) { DA_TOP(t); step2<true, true>(kpn, vp, qr, kf, o, pw, l_reg, dj, pA0, pA1, pB0, pB1); DA_ROT(); ++t; }
    for (; t + 1 < wt; t += 2) {
        { DA_TOP(t);     step2<true, true>(kpn, vp, qr, kf, o, pw, l_reg, dj, pB0, pB1, pA0, pA1); DA_ROT(); }
        { DA_TOP(t + 1); step2<true, true>(kpn, vp, qr, kf, o, pw, l_reg, dj, pA0, pA1, pB0, pB1); DA_ROT(); }
    }
    if (wt > 0) { DA_TOP(t); step2<false, true>(kpn, vp, qr, kf, o, pw, l_reg, dj, pB0, pB1, pA0, pA1); DA_ROT(); ++t; }
    for (; t <= NT; ++t) { DA_TOP(t); DA_IDLE(); DA_ROT(); }
#undef DA_IDLE
#undef DA_TOP
#undef DA_ROT
    __builtin_amdgcn_s_setprio(0);
    { auto rr = __builtin_amdgcn_permlane32_swap(__float_as_uint(l_reg), __float_as_uint(l_reg), false, false); l_reg = __uint_as_float(rr[0]) + __uint_as_float(rr[1]); }
    if (hi == 0) wsf[r32] = l_reg;
    DA_WAIT_BAR(0);
    if (has_next) unit_prologue(nxt, lds0, lane, wid, qr);
    int le = lane; asm volatile("" : "+v"(le));
    const int r32e = le & 31, hie = le >> 5;
    v4u g4r[8]; f32x4 sga[8], sgb[8];
    if (s == 0 && wt > 0) { const bf16* gp_ = u.G + (long)(32 * g + (le >> 1)) * DM + (le & 1) * 64; const float* sg_ = sub_gain + (le & 1) * 64;
#pragma unroll
        for (int k = 0; k < 8; ++k) { g4r[k] = *(const v4u*)(gp_ + 8 * k); sga[k] = *(const f32x4*)(sg_ + 8 * k); sgb[k] = *(const f32x4*)(sg_ + 8 * k + 4); } }
    float rli[16];
#pragma unroll
    for (int r = 0; r < 16; ++r) { const float lq = wsf[crow(r, hi)]; rli[r] = (s == 0 ? 1.f : -lam) / lq; }
    float* xch = (float*)(shm + 65536 + g * XCHB);
    if (s == 1 && wt > 0) {
#pragma unroll
        for (int db = 0; db < 4; ++db)
#pragma unroll
            for (int r = 0; r < 16; ++r) xch[(db * 16 + r) * 64 + le] = o[db][r] * rli[r];
    }
    asm volatile("s_waitcnt lgkmcnt(0)\n\ts_barrier" ::: "memory");
    if (s == 0 && wt > 0) {
#pragma unroll
        for (int db = 0; db < 4; ++db)
#pragma unroll
            for (int r = 0; r < 16; ++r) o[db][r] = o[db][r] * rli[r] + xch[(db * 16 + r) * 64 + le];
        asm volatile("s_waitcnt lgkmcnt(0)" ::: "memory");
#pragma unroll
        for (int db = 0; db < 4; ++db)
#pragma unroll
            for (int r = 0; r < 16; ++r) xch[crow(r, hie) * STP + 32 * db + r32e] = o[db][r];
        asm volatile("s_waitcnt lgkmcnt(0)" ::: "memory");
        const int row = le >> 1, half = le & 1;
        float v[64]; float ss = 0.f;
#pragma unroll
        for (int k = 0; k < 16; ++k) { const f32x4 x = *(const f32x4*)(xch + row * STP + half * 64 + 4 * k); v[4 * k] = x.x; v[4 * k + 1] = x.y; v[4 * k + 2] = x.z; v[4 * k + 3] = x.w; ss += (x.x * x.x + x.y * x.y) + (x.z * x.z + x.w * x.w); }
        ss += __shfl_xor(ss, 1);
        const float sc = one_m_li / sqrtf(ss * (1.f / 128.f) + EPS);
        bf16* op = u.AO + (long)(32 * g + row) * DM + half * 64;
#pragma unroll
        for (int k = 0; k < 8; ++k) { const v4u g4 = g4r[k]; const f32x4 ga = sga[k], gb = sgb[k];
            const float gg[8] = {bflo(g4.x), bfhi(g4.x), bflo(g4.y), bfhi(g4.y), bflo(g4.z), bfhi(g4.z), bflo(g4.w), bfhi(g4.w)};
            const float gn[8] = {ga.x, ga.y, ga.z, ga.w, gb.x, gb.y, gb.z, gb.w}; float y[8];
#pragma unroll
            for (int e = 0; e < 8; ++e) y[e] = v[8 * k + e] * sc * gn[e] * silu_f(gg[e]);
            v4u w; w.x = pk2(y[0], y[1]); w.y = pk2(y[2], y[3]); w.z = pk2(y[4], y[5]); w.w = pk2(y[6], y[7]);
            *(v4u*)(op + 8 * k) = w; }
    }
#undef DA_DMA_K
#undef DA_DMA_V
}
}
template <int VAR = 0>
__device__ __forceinline__ void attn_fast(Frame& F, const bf16* Qs, const bf16* KP, const bf16* VP, const bf16* KC, const bf16* VC, const bf16* GA  , bf16* AO,
                                          float lam, float one_m_li, const float* sub_gain, int dma0 = 0) {
    const int NU = 2048 + 16 * NB;
    const bool xcd = (F.G == 256);
#define ATTN_GET(i_, u_, ok_) do { int qb = 0, h = 0, b = -1; ok_ = true; \
        if (xcd) { const int x = F.bid & 7, r = F.bid >> 3; \
            if ((i_) < 8) { h = x + 8 * ((i_) >> 2); const int rr = ((i_) == 0) ? (r ^ 8) : r; qb = 127 - (((i_) & 3) * 32 + (((i_) & 1) ? 31 - rr : rr)); } \
            else if ((i_) == 8 && (r & 8) == 0) { const int sb = (r & 7) + ((r >> 4) << 3); h = x + 8 * (sb >> 3); b = sb & 7; } \
            else ok_ = false; \
        } else { const int idx = (i_) * F.G + (((i_) & 1) ? F.G - 1 - F.bid : F.bid); if (idx >= NU) ok_ = false; \
            else if (idx < 2048) { qb = 127 - (idx >> 4); h = idx & 15; } else { const int j = idx - 2048; b = j >> 4; h = j & 15; } } \
        u_.dma0 = 0; \
        if (ok_) { if (b < 0) { const long row0 = 128L * qb; \
            u_.Q = Qs + row0 * DM + h * 128; u_.K = KP + h * 128; u_.V = VP + h * 128; u_.G = GA + row0 * DM + h * 128; u_.AO = AO + row0 * DM + h * 128; u_.NT = 2 * qb + 2; u_.full = 1; } \
          else { const long row0 = MP + 64L * b; \
            u_.Q = Qs + row0 * DM + h * 128; u_.K = KC + (long)b * KCROWS * DM + h * 128; u_.V = VC + (long)b * KCROWS * DM + h * 128; u_.G = GA + row0 * DM + h * 128; u_.AO = AO + row0 * DM + h * 128; u_.NT = KCROWS / 64; u_.full = 0; } } } while (0)
    dattn::Unit u, nx; bool have; ATTN_GET(0, u, have);
    dattn::bf16x8 qr[4]; bool pre = false;
    float* wsf_base = (float*)((char*)F.lds + MISC_OFF + 1024);
    for (int i = 0; have; ++i) {
        bool hn; ATTN_GET(i + 1, nx, hn);
        dattn::attn_unit<VAR>(u, hn, nx, pre, qr, (char*)F.lds + RING_OFF, wsf_base, lam, one_m_li, sub_gain, F.tid);
        u = nx; have = hn; pre = true;
    }
    __syncthreads();
#undef ATTN_GET
}
constexpr int RBLK = 72;
__device__ __forceinline__ float ret_lg2(int h) { return log2f(1.f - exp2f(-5.f - (float)h)); }
struct EpiRet {
    static constexpr int BMODE = 0;
    pg8::bf16_t* QP; pg8::bf16_t* KN; pg8::bf16_t* KT; pg8::bf16_t* VS; pg8::bf16_t* RG; const float* tab; const float* ssq;
    __device__ __forceinline__ void operator()(const pg8::f32x4 (&acc)[2][2][4][2], const pg8::Unit& u, int wr, int wc, int fr, int fq) const {
        { const int l_ = lane_now(); fr = l_ & 15; fq = l_ >> 4; }
        const int pn = u.pn, pm = u.pm; float rs[2][4]; row_rstd(ssq, pm, wr, fr, fq, rs);
#pragma unroll
        for (int ai = 0; ai < 2; ++ai)
#pragma unroll
            for (int m = 0; m < 4; ++m) {
                const int i = ai * 128 + wr * 64 + m * 16 + fr; const size_t row = (size_t)pm * 256 + i;
                const int J = pm < 64 ? pm : 64 + 4 * (pm - 64) + (i >> 6), jj = pm < 64 ? i : (i & 63), pos = pm < 64 ? (int)row : PAST + (i & 63);
                if (pn < 16) {
                    const int h = pn & 7; const bool isk = pn >= 8; const float sc = isk ? 0.0625f : 1.f;
#pragma unroll
                    for (int n = 0; n < 2; ++n) { const int c1 = wc * 32 + n * 16 + 4 * fq;
                        const pg8::f32x4 t0 = *(const pg8::f32x4*)(tab + ((size_t)pos * 128 + c1) * 2), t1 = *(const pg8::f32x4*)(tab + ((size_t)pos * 128 + c1) * 2 + 4);
                        const pg8::f32x4 x1 = acc[ai][0][m][n] * rs[ai][m], x2 = acc[ai][1][m][n] * rs[ai][m];
                        const float cs[4] = {t0[0], t0[2], t1[0], t1[2]}, sn[4] = {t0[1], t0[3], t1[1], t1[3]}; float o1[4], o2[4];
#pragma unroll
                        for (int e = 0; e < 4; ++e) { o1[e] = (x1[e] * cs[e] - x2[e] * sn[e]) * sc; o2[e] = (x2[e] * cs[e] + x1[e] * sn[e]) * sc; }
                        v2u w1, w2; w1.x = pk2(o1[0], o1[1]); w1.y = pk2(o1[2], o1[3]); w2.x = pk2(o2[0], o2[1]); w2.y = pk2(o2[2], o2[3]);
                        if (!isk) { pg8::bf16_t* p = QP + row * 4096 + h * 512 + 256 + c1; *(v2u*)p = w1; *(v2u*)(p + 128) = w2; }
                        else { pg8::bf16_t* p = KN + row * 2048 + h * 256 + c1; *(v2u*)p = w1; *(v2u*)(p + 128) = w2;
                            pg8::bf16_t* t = KT + ((size_t)(J * 8 + h) * 256 + c1) * 256 + jj;
#pragma unroll
                            for (int e = 0; e < 4; ++e) { t[(size_t)e * 256] = (pg8::bf16_t)f2bf(o1[e]); t[(size_t)(128 + e) * 256] = (pg8::bf16_t)f2bf(o2[e]); } } }
                } else if (pn < 32) {
                    const int h = (pn - 16) >> 1, half = (pn - 16) & 1; const float f = exp2f(-(float)(1 + jj) * ret_lg2(h)) * rs[ai][m];
#pragma unroll
                    for (int bj = 0; bj < 2; ++bj)
#pragma unroll
                        for (int n = 0; n < 2; ++n) { const int dv = half * 256 + bj * 128 + wc * 32 + n * 16 + 4 * fq; pg8::bf16_t* t = VS + ((size_t)(J * 8 + h) * 512 + dv) * 512 + jj;
#pragma unroll
                            for (int e = 0; e < 4; ++e) t[(size_t)e * 512] = (pg8::bf16_t)f2bf(acc[ai][bj][m][n][e] * f); }
                } else {
#pragma unroll
                    for (int bj = 0; bj < 2; ++bj)
#pragma unroll
                        for (int n = 0; n < 2; ++n) { const int c = (pn - 32) * 256 + bj * 128 + wc * 32 + n * 16 + 4 * fq; const pg8::f32x4 x = acc[ai][bj][m][n] * rs[ai][m];
                            v2u w; w.x = pk2(x[0], x[1]); w.y = pk2(x[2], x[3]); *(v2u*)(RG + row * 4096 + c) = w; }
                }
            }
    }
};
__device__ __forceinline__ size_t ret_row0(int J) { return J < 64 ? (size_t)256 * J : (size_t)MP + 64 * (J - 64); }
struct RetQKOrder {
    int G, c; const char* QP; const char* KN;
    __device__ __forceinline__ bool next(int i, pg8::Unit& u) const { const int L = i * G + c; if (L >= RBLK * 8) return false; const int J = L >> 3, h = L & 7; const size_t r0 = ret_row0(J);
        u.pm = J; u.pn = h; u.a = QP + (r0 * 4096 + h * 512 + 256) * 2; u.b = KN + (r0 * 2048 + h * 256) * 2; return true; }
    __device__ __forceinline__ void a_ready(const pg8::Unit&) const {}
    __device__ __forceinline__ void done(const pg8::Unit&) const {}
};
struct EpiRetQK {
    static constexpr int BMODE = 1;
    pg8::bf16_t* QP;
    __device__ __forceinline__ void operator()(const pg8::f32x4 (&acc)[2][2][4][2], const pg8::Unit& u, int wr, int wc, int fr, int fq) const {
        { const int l_ = lane_now(); fr = l_ & 15; fq = l_ >> 4; }
        const int J = u.pm, h = u.pn, nv = J < 64 ? 256 : 64; const size_t r0 = ret_row0(J);
#pragma unroll
        for (int ai = 0; ai < 2; ++ai)
#pragma unroll
            for (int m = 0; m < 4; ++m) { const int i = ai * 128 + wr * 64 + m * 16 + fr;
                if (i < nv) {
#pragma unroll
                    for (int bj = 0; bj < 2; ++bj) { const int j0 = bj * 128 + wc * 32 + 8 * fq; const pg8::f32x4 v0 = acc[ai][bj][m][0], v1 = acc[ai][bj][m][1]; float x[8] = {v0[0], v0[1], v0[2], v0[3], v1[0], v1[1], v1[2], v1[3]};
#pragma unroll
                        for (int k = 0; k < 8; ++k) x[k] = (j0 + k <= i) ? x[k] : 0.f;
                        v4u w; w.x = pk2(x[0], x[1]); w.y = pk2(x[2], x[3]); w.z = pk2(x[4], x[5]); w.w = pk2(x[6], x[7]);
                        *(v4u*)(QP + (r0 + i) * 4096 + h * 512 + j0) = w; } } }
    }
};
__device__ __forceinline__ int xcd_lin(int i, int G, int c) { return (G & 7) ? i * G + c : i * G + (c & 7) * (G >> 3) + (c >> 3); }
struct RetOOrder {
    int G, c; const char* QP; const char* VS;
    __device__ __forceinline__ bool next(int i, pg8::Unit& u) const { const int L = xcd_lin(i, G, c); if (L >= RBLK * 16) return false; const int J = L >> 4, r = L & 15, h = r >> 1, half = r & 1; const size_t r0 = ret_row0(J);
        u.pm = J; u.pn = r; u.a = QP + (r0 * 4096 + h * 512) * 2; u.b = VS + (((size_t)(J * 8 + h) * 512 + half * 256) * 512) * 2; return true; }
    __device__ __forceinline__ void a_ready(const pg8::Unit&) const {}
    __device__ __forceinline__ void done(const pg8::Unit&) const {}
};
struct EpiRetO {
    static constexpr int BMODE = 1;
    pg8::bf16_t* O;
    __device__ __forceinline__ void operator()(const pg8::f32x4 (&acc)[2][2][4][2], const pg8::Unit& u, int wr, int wc, int fr, int fq) const {
        { const int l_ = lane_now(); fr = l_ & 15; fq = l_ >> 4; }
        const int J = u.pm, h = u.pn >> 1, half = u.pn & 1, nv = J < 64 ? 256 : 64; const size_t r0 = ret_row0(J); const float lg = ret_lg2(h);
#pragma unroll
        for (int ai = 0; ai < 2; ++ai)
#pragma unroll
            for (int m = 0; m < 4; ++m) { const int i = ai * 128 + wr * 64 + m * 16 + fr;
                if (i < nv) { const float f = exp2f((float)(i + 1) * lg);
#pragma unroll
                    for (int bj = 0; bj < 2; ++bj) { const int j0 = bj * 128 + wc * 32 + 8 * fq; const pg8::f32x4 v0 = acc[ai][bj][m][0] * f, v1 = acc[ai][bj][m][1] * f;
                        v4u w; w.x = pk2(v0[0], v0[1]); w.y = pk2(v0[2], v0[3]); w.z = pk2(v1[0], v1[1]); w.w = pk2(v1[2], v1[3]);
                        *(v4u*)(O + (r0 + i) * 4096 + h * 512 + half * 256 + j0) = w; } } }
    }
};
struct RetKVOrder {
    int G, c; const char* VS; const char* KT;
    __device__ __forceinline__ bool next(int i, pg8::Unit& u) const { const int L = xcd_lin(i, G, c); if (L >= RBLK * 16) return false; const int J = L >> 4, r = L & 15, h = r >> 1, half = r & 1;
        u.pm = J; u.pn = r; u.a = VS + (((size_t)(J * 8 + h) * 512 + half * 256) * 512) * 2; u.b = KT + ((size_t)(J * 8 + h) * 256 * 256) * 2; return true; }
    __device__ __forceinline__ void a_ready(const pg8::Unit&) const {}
    __device__ __forceinline__ void done(const pg8::Unit&) const {}
};
struct EpiRetKV {
    static constexpr int BMODE = 1;
    pg8::bf16_t* VS; pg8::bf16_t* KVX;
    __device__ __forceinline__ void operator()(const pg8::f32x4 (&acc)[2][2][4][2], const pg8::Unit& u, int wr, int wc, int fr, int fq) const {
        { const int l_ = lane_now(); fr = l_ & 15; fq = l_ >> 4; }
        const int J = u.pm, h = u.pn >> 1, half = u.pn & 1;
        pg8::bf16_t* base; int pitch;
        if (J < 63) { base = VS + ((size_t)((J + 1) * 8 + h) * 512 + half * 256) * 512 + 256; pitch = 512; }
        else { base = KVX + ((size_t)((J - 63) * 8 + h) * 512 + half * 256) * 256; pitch = 256; }
#pragma unroll
        for (int ai = 0; ai < 2; ++ai)
#pragma unroll
            for (int m = 0; m < 4; ++m) { pg8::bf16_t* rowp = base + (size_t)(ai * 128 + wr * 64 + m * 16 + fr) * pitch + wc * 32 + 8 * fq;
#pragma unroll
                for (int bj = 0; bj < 2; ++bj) { const pg8::f32x4 v0 = acc[ai][bj][m][0], v1 = acc[ai][bj][m][1];
                    v4u w; w.x = pk2(v0[0], v0[1]); w.y = pk2(v0[2], v0[3]); w.z = pk2(v1[0], v1[1]); w.w = pk2(v1[2], v1[3]);
                    *(v4u*)(rowp + bj * 128) = w; } }
    }
};
__device__ __forceinline__ void ret_scan(Frame& F, bf16* VS, const bf16* KVX, const float* state_in, float* osp, float* oss) {
    const int gt = F.bid * NTHR + F.tid;
    for (int c = gt; c < 8 * 512 * 32; c += F.G * NTHR) {
        const int h = c >> 14, dv = (c >> 5) & 511, dk0 = (c & 31) * 8; const float lg = ret_lg2(h), g256 = exp2f(256.f * lg), g64 = exp2f(64.f * lg);
        float S[8];
#pragma unroll
        for (int k = 0; k < 8; ++k) S[k] = 0.f;
        bf16* slot = VS + ((size_t)h * 512 + dv) * 512 + 256 + dk0;
        *(v4u*)slot = (v4u){0u, 0u, 0u, 0u};
        constexpr size_t SJ = (size_t)8 * 512 * 512;
        v4u nx[4];
#pragma unroll
        for (int q = 0; q < 4; ++q) nx[q] = *(const v4u*)(slot + (size_t)(1 + q) * SJ);
        for (int J0 = 1; J0 < 64; J0 += 4) {
            v4u cur[4];
#pragma unroll
            for (int q = 0; q < 4; ++q) cur[q] = nx[q];
            if (J0 + 4 < 64) {
#pragma unroll
                for (int q = 0; q < 4; ++q) { const int Jn = J0 + 4 + q; nx[q] = *(const v4u*)(slot + (size_t)(Jn < 64 ? Jn : 63) * SJ); } }
#pragma unroll
            for (int q = 0; q < 4; ++q) { const int J = J0 + q;
                if (J < 64) { const v4u kv = cur[q]; bf16* sj = slot + (size_t)J * SJ;
                    const float x[8] = {bflo(kv.x), bfhi(kv.x), bflo(kv.y), bfhi(kv.y), bflo(kv.z), bfhi(kv.z), bflo(kv.w), bfhi(kv.w)};
#pragma unroll
                    for (int k = 0; k < 8; ++k) S[k] = (S[k] + x[k]) * g256;
                    v4u w; w.x = pk2(S[0], S[1]); w.y = pk2(S[2], S[3]); w.z = pk2(S[4], S[5]); w.w = pk2(S[6], S[7]);
                    *(v4u*)sj = w; } }
        }
        { const v4u kv = *(const v4u*)(KVX + ((size_t)h * 512 + dv) * 256 + dk0);
          const float x[8] = {bflo(kv.x), bfhi(kv.x), bflo(kv.y), bfhi(kv.y), bflo(kv.z), bfhi(kv.z), bflo(kv.w), bfhi(kv.w)};
#pragma unroll
          for (int k = 0; k < 8; ++k) NT_STORE((S[k] + x[k]) * g256, osp + ((size_t)h * 256 + dk0 + k) * 512 + dv); }
    }
    for (int c = gt; c < NB * 8 * 512 * 32; c += F.G * NTHR) {
        const int dv = c & 511, dk0 = ((c >> 9) & 31) * 8, h = (c >> 14) & 7, b = c >> 17; const float g64 = exp2f(64.f * ret_lg2(h));
        const float* si = state_in + (((size_t)b * 8 + h) * 256 + dk0) * 512 + dv; float* so = oss + (((size_t)b * 8 + h) * 256 + dk0) * 512 + dv;
        const v4u kv = *(const v4u*)(KVX + ((size_t)((1 + b) * 8 + h) * 512 + dv) * 256 + dk0);
        const float x[8] = {bflo(kv.x), bfhi(kv.x), bflo(kv.y), bfhi(kv.y), bflo(kv.z), bfhi(kv.z), bflo(kv.w), bfhi(kv.w)}; float s0[8];
#pragma unroll
        for (int k = 0; k < 8; ++k) s0[k] = NT_LOAD(si + (size_t)k * 512);
        v4u w; w.x = pk2(s0[0], s0[1]); w.y = pk2(s0[2], s0[3]); w.z = pk2(s0[4], s0[5]); w.w = pk2(s0[6], s0[7]);
        *(v4u*)(VS + ((size_t)((64 + b) * 8 + h) * 512 + dv) * 512 + 256 + dk0) = w;
#pragma unroll
        for (int k = 0; k < 8; ++k) NT_STORE((s0[k] + x[k]) * g64, so + (size_t)k * 512);
    }
}
__device__ __forceinline__ void ret_zero_pad(Frame& F, bf16* VS, bf16* KT) {
    const size_t gt = (size_t)F.bid * NTHR + F.tid, NG = (size_t)F.G * NTHR, n = (size_t)NB * 8 * 512 * 24, n2 = (size_t)NB * 8 * 256 * 24;
    for (size_t i = gt; i < n; i += NG) { const size_t rowi = i / 24, c = i % 24; *(v4u*)(VS + ((size_t)64 * 8 * 512 + rowi) * 512 + 64 + c * 8) = (v4u){0u, 0u, 0u, 0u}; }
    for (size_t i = gt; i < n2; i += NG) { const size_t rowi = i / 24, c = i % 24; *(v4u*)(KT + ((size_t)64 * 8 * 256 + rowi) * 256 + 64 + c * 8) = (v4u){0u, 0u, 0u, 0u}; }
}
__device__ __forceinline__ void ret_table(Frame& F, float* tab) {
    const size_t gt = (size_t)F.bid * NTHR + F.tid, NG = (size_t)F.G * NTHR;
    for (size_t e = gt; e < (size_t)MP * 128; e += NG) { float c, s; rope_cs((int)(e >> 7), (int)(e & 127), 128, c, s); tab[2 * e] = c; tab[2 * e + 1] = s; }
}
__device__ __forceinline__ void r_out(Frame& F, bf16* O, const bf16* RG) {
    const int gw = F.bid * NWAVES + F.wave, NGW = F.G * NWAVES, lane = F.lane;
    constexpr int U = 6;
    for (int it0 = gw; it0 < MT * 8; it0 += U * NGW) {
        v4u o4[U], g4[U]; size_t off[U]; bool ok[U];
#pragma unroll
        for (int j = 0; j < U; ++j) { const int it = it0 + j * NGW; ok[j] = it < MT * 8; const int itc = ok[j] ? it : gw; off[j] = (size_t)(itc >> 3) * 4096 + (itc & 7) * 512 + lane * 8;
            o4[j] = *(const v4u*)(O + off[j]); g4[j] = NT_LOAD((const v4u*)(RG + off[j])); }
#pragma unroll
        for (int j = 0; j < U; ++j) {
            float o[8] = {bflo(o4[j].x), bfhi(o4[j].x), bflo(o4[j].y), bfhi(o4[j].y), bflo(o4[j].z), bfhi(o4[j].z), bflo(o4[j].w), bfhi(o4[j].w)};
            const float g[8] = {bflo(g4[j].x), bfhi(g4[j].x), bflo(g4[j].y), bfhi(g4[j].y), bflo(g4[j].z), bfhi(g4[j].z), bflo(g4[j].w), bfhi(g4[j].w)};
            float ss = 0.f;
#pragma unroll
            for (int k = 0; k < 8; ++k) ss += o[k] * o[k];
            const float rstd = 1.f / sqrtf(wave_sum(ss) * (1.f / 512.f) + EPS);
#pragma unroll
            for (int k = 0; k < 8; ++k) o[k] = o[k] * rstd * silu_f(g[k]);
            v4u w; w.x = pk2(o[0], o[1]); w.y = pk2(o[2], o[3]); w.z = pk2(o[4], o[5]); w.w = pk2(o[6], o[7]);
            if (ok[j]) *(v4u*)(O + off[j]) = w;
        }
    }
}
struct EpiCIn {
    static constexpr int BMODE = 0;
    pg8::bf16_t* GU; pg8::bf16_t* GVT; pg8::bf16_t* GVS; float* SSQ; const float* ssq;
    __device__ __forceinline__ void operator()(const pg8::f32x4 (&acc)[2][2][4][2], const pg8::Unit& u, int wr, int wc, int fr, int fq) const {
        { const int l_ = lane_now(); fr = l_ & 15; fq = l_ >> 4; }
        const int pn = u.pn, pm = u.pm; const bool isv = pn >= 32; const int pt = isv ? pn - 32 : pn; float rs[2][4]; row_rstd(ssq, pm, wr, fr, fq, rs);
#pragma unroll
        for (int ai = 0; ai < 2; ++ai)
#pragma unroll
            for (int m = 0; m < 4; ++m) {
                const int i = ai * 128 + wr * 64 + m * 16 + fr; const size_t row = (size_t)pm * 256 + i; float ss = 0.f;
                if (!isv) {
#pragma unroll
                    for (int n = 0; n < 2; ++n) { const int c = pt * 128 + wc * 32 + n * 16 + 4 * fq; const pg8::f32x4 xu = acc[ai][0][m][n] * rs[ai][m], xg = acc[ai][1][m][n] * rs[ai][m]; float y[4];
#pragma unroll
                        for (int e = 0; e < 4; ++e) y[e] = gelu_tanh_f(xu[e]) * silu_f(xg[e]);
                        v2u w; w.x = pk2(y[0], y[1]); w.y = pk2(y[2], y[3]); *(v2u*)(GU + row * 4096 + c) = w; }
                } else {
#pragma unroll
                    for (int bj = 0; bj < 2; ++bj)
#pragma unroll
                        for (int n = 0; n < 2; ++n) { const int c = pt * 256 + bj * 128 + wc * 32 + n * 16 + 4 * fq; const pg8::f32x4 x = acc[ai][bj][m][n] * rs[ai][m]; float y[4];
#pragma unroll
                            for (int e = 0; e < 4; ++e) y[e] = gelu_tanh_f(x[e]);
                            v2u w; w.x = pk2(y[0], y[1]); w.y = pk2(y[2], y[3]);
                            ss += (y[0] * y[0] + y[1] * y[1]) + (y[2] * y[2] + y[3] * y[3]);
                            pg8::bf16_t* t = GVT + ((size_t)pm * 4096 + c) * 256 + i;
                            t[0] = (pg8::bf16_t)(w.x & 0xffffu); t[256] = (pg8::bf16_t)(w.x >> 16); t[512] = (pg8::bf16_t)(w.y & 0xffffu); t[768] = (pg8::bf16_t)(w.y >> 16);
                            if (pm >= 64) *(v2u*)(GVS + (row - MP) * 4096 + c) = w; }
                    ss += __shfl_xor(ss, 16); ss += __shfl_xor(ss, 32); if (fq == 0) SSQ[row * 64 + pt * 4 + wc] = ss;
                }
                if (m & 1) asm volatile("" ::: "memory");
            }
    }
};
__device__ __forceinline__ void c_prep(Frame& F, const float* SSQ, const float* wsin, const float* vgain, const bf16* GVS, bf16* Wm, float* ovm) {
    LAS float* rs = (LAS float*)(F.lds + RING_OFF);
    const int tid = F.tid;
    for (int it = F.bid; it < 66 * 8; it += F.G) {
        const int J = it >> 3, g = it & 7;
        __syncthreads();
        if (tid < 256) { const float* p = SSQ + ((size_t)J * 256 + tid) * 64; float s = 0.f;
#pragma unroll
            for (int k = 0; k < 16; ++k) { const f32x4 x = *(const f32x4*)(p + 4 * k); s += (x.x + x.y) + (x.z + x.w); }
            rs[tid] = 1.f / sqrtf(s * (1.f / 4096.f) + EPS); }
        __syncthreads();
        bf16* wm = Wm + (size_t)(J * 8 + g) * 65536; const int sh = J < 64 ? 7 : 6, cm = (1 << sh) - 1;
        for (int eb = tid; eb < 8192; eb += 4 * NTHR) {
            f32x4 wa[4], wb[4];
#pragma unroll
            for (int q = 0; q < 4; ++q) { const int e8 = eb + q * NTHR, i = e8 >> 5, j0 = (e8 & 31) * 8, il = i & cm, jl0 = j0 & cm; const bool on = (i >> sh) == (j0 >> sh) && jl0 <= il;
                const float* wr_ = wsin + ((size_t)g * 128 + (on ? il : 0)) * 128 + (on ? jl0 : 0); wa[q] = *(const f32x4*)wr_; wb[q] = *(const f32x4*)(wr_ + 4); }
#pragma unroll
            for (int q = 0; q < 4; ++q) { const int e8 = eb + q * NTHR, i = e8 >> 5, j0 = (e8 & 31) * 8, il = i & cm, jl0 = j0 & cm; const bool on = (i >> sh) == (j0 >> sh) && jl0 <= il; float y[8];
                const float wv[8] = {wa[q].x, wa[q].y, wa[q].z, wa[q].w, wb[q].x, wb[q].y, wb[q].z, wb[q].w};
#pragma unroll
                for (int k = 0; k < 8; ++k) y[k] = (on && jl0 + k <= il) ? wv[k] * rs[j0 + k] : 0.f;
                v4u w; w.x = pk2(y[0], y[1]); w.y = pk2(y[2], y[3]); w.z = pk2(y[4], y[5]); w.w = pk2(y[6], y[7]);
                *(v4u*)(wm + i * 256 + j0) = w; } }
    }
    const int gw = F.bid * NWAVES + F.wave, NGW = F.G * NWAVES, lane = F.lane;
    for (int r = gw; r < MS; r += NGW) {
        const float rstd = 1.f / sqrtf(wave_sum(SSQ[((size_t)MP + r) * 64 + lane]) * (1.f / 4096.f) + EPS);
        v4u vr[8]; f32x4 gar[8], gbr[8];
#pragma unroll
        for (int k = 0; k < 8; ++k) { const int col = k * 512 + lane * 8; vr[k] = *(const v4u*)(GVS + (size_t)r * 4096 + col); gar[k] = *(const f32x4*)(vgain + col); gbr[k] = *(const f32x4*)(vgain + col + 4); }
#pragma unroll
        for (int k = 0; k < 8; ++k) { const int col = k * 512 + lane * 8; const v4u v4 = vr[k];
            const f32x4 ga = gar[k], gb = gbr[k];
            float* o = ovm + (size_t)r * 4096 + col;
            *(f32x4*)o = (f32x4){bflo(v4.x) * rstd * ga.x, bfhi(v4.x) * rstd * ga.y, bflo(v4.y) * rstd * ga.z, bfhi(v4.y) * rstd * ga.w};
            *(f32x4*)(o + 4) = (f32x4){bflo(v4.z) * rstd * gb.x, bfhi(v4.z) * rstd * gb.y, bflo(v4.w) * rstd * gb.z, bfhi(v4.w) * rstd * gb.w}; }
    }
}
struct CMixOrder {
    int G, c; const char* Wm; const char* GVT;
    __device__ __forceinline__ bool next(int i, pg8::Unit& u) const { const int L = xcd_lin(i, G, c); if (L >= 66 * 16) return false; const int J = L >> 4, nt = L & 15;
        u.pm = J; u.pn = nt; u.a = Wm + ((size_t)(J * 8 + (nt >> 1)) * 65536) * 2; u.b = GVT + (((size_t)J * 4096 + nt * 256) * 256) * 2; return true; }
    __device__ __forceinline__ void a_ready(const pg8::Unit&) const {}
    __device__ __forceinline__ void done(const pg8::Unit&) const {}
};
struct EpiCMix {
    static constexpr int BMODE = 1;
    pg8::bf16_t* GU; const float* vgain; const float* bs;
    __device__ __forceinline__ void operator()(const pg8::f32x4 (&acc)[2][2][4][2], const pg8::Unit& u, int wr, int wc, int fr, int fq) const {
        { const int l_ = lane_now(); fr = l_ & 15; fq = l_ >> 4; }
        const int J = u.pm, nt = u.pn, g = nt >> 1, cm = J < 64 ? 127 : 63;
#pragma unroll
        for (int bj = 0; bj < 2; ++bj) { const int c0 = nt * 256 + bj * 128 + wc * 32 + 8 * fq; const f32x4 ga = *(const f32x4*)(vgain + c0), gb = *(const f32x4*)(vgain + c0 + 4);
            const float gn[8] = {ga.x, ga.y, ga.z, ga.w, gb.x, gb.y, gb.z, gb.w};
#pragma unroll
            for (int ai = 0; ai < 2; ++ai)
#pragma unroll
                for (int m = 0; m < 4; ++m) { const int i = ai * 128 + wr * 64 + m * 16 + fr; const size_t off = ((size_t)J * 256 + i) * 4096 + c0; const float b = bs[g * 128 + (i & cm)];
                    const v4u u4 = *(const v4u*)(GU + off); const pg8::f32x4 v0 = acc[ai][bj][m][0], v1 = acc[ai][bj][m][1];
                    const float mx[8] = {v0[0], v0[1], v0[2], v0[3], v1[0], v1[1], v1[2], v1[3]};
                    const float uu[8] = {bflo(u4.x), bfhi(u4.x), bflo(u4.y), bfhi(u4.y), bflo(u4.z), bfhi(u4.z), bflo(u4.w), bfhi(u4.w)};
                    float y[8];
#pragma unroll
                    for (int k = 0; k < 8; ++k) y[k] = uu[k] * (mx[k] * gn[k] + b);
                    v4u w; w.x = pk2(y[0], y[1]); w.y = pk2(y[2], y[3]); w.z = pk2(y[4], y[5]); w.w = pk2(y[6], y[7]);
                    *(v4u*)(GU + off) = w; } }
    }
};
__device__ __forceinline__ float diff_lambda(const float* q1, const float* k1, const float* q2, const float* k2, float lam_init) {
    float a = 0.f, b = 0.f;
    for (int i = 0; i < 64; ++i) { a += q1[i] * k1[i]; b += q2[i] * k2[i]; }
    return expf(a) - expf(b) + lam_init;
}

constexpr int N_PHASES = 21;
__global__ void __launch_bounds__(NTHR, 2) mega(Args args) {
    extern __shared__ __attribute__((aligned(16))) unsigned char lds[];
    Frame F;
    F.lds = (LAS unsigned char*)lds; F.tid = threadIdx.x; F.lane = F.tid & 63; F.wave = __builtin_amdgcn_readfirstlane(F.tid >> 6); F.G = gridDim.x; F.bid = blockIdx.x;
    F.in = args.in; F.out = args.out; F.ws = args.ws;
    unsigned char* ws = args.ws; float* out = args.out;
    bf16* W_AIN[2] = {(bf16*)(ws + WS_WAIN0), (bf16*)(ws + WS_WAIN1)}; bf16* W_AOUT[2] = {(bf16*)(ws + WS_WAOUT0), (bf16*)(ws + WS_WAOUT1)};
    bf16* W_RIN = (bf16*)(ws + WS_WRIN); bf16* W_ROUT = (bf16*)(ws + WS_WROUT); bf16* W_CIN = (bf16*)(ws + WS_WCIN); bf16* W_COUT = (bf16*)(ws + WS_WCOUT);
    bf16* XN0 = (bf16*)(ws + WS_XN0); bf16* HB = (bf16*)(ws + WS_HB); float* SSQ2 = (float*)(ws + WS_SSQ2);
    bf16* Qs = (bf16*)(ws + WS_QS); bf16* KP = (bf16*)(ws + WS_KP); bf16* VP = (bf16*)(ws + WS_VP); bf16* KC = (bf16*)(ws + WS_KC); bf16* VC = (bf16*)(ws + WS_VC); bf16* AO_A = (bf16*)(ws + WS_AOA);
    bf16* KT = (bf16*)(ws + WS_KT); bf16* RG = (bf16*)(ws + WS_RG); bf16* QP = (bf16*)(ws + WS_QP); bf16* KN = (bf16*)(ws + WS_KN); bf16* VS = (bf16*)(ws + WS_VS); bf16* ORET = (bf16*)(ws + WS_ORET);
    bf16* GU = (bf16*)(ws + WS_GU); bf16* SG = (bf16*)(ws + WS_SG); bf16* GVT = (bf16*)(ws + WS_GVT); bf16* WM = (bf16*)(ws + WS_WM); float* SSQ = (float*)(ws + WS_SSQ); bf16* GVS = (bf16*)(ws + WS_GVS); float* TABR = (float*)(ws + WS_TABR); bf16* KVX = (bf16*)(ws + WS_KVX); float* TABA = (float*)(ws + WS_TABA); bf16* GA = (bf16*)(ws + WS_GA);
    const int lo = args.ph_lo, hi = args.ph_hi;
    volatile LAS unsigned* MISC = (volatile LAS unsigned*)(F.lds + MISC_OFF);
    for (int u = F.tid; u < (LDS_BYTES - MISC_OFF) / 4; u += NTHR) ((LAS unsigned*)(F.lds + MISC_OFF))[u] = 0u;
    __syncthreads();
    XcdBarrier bar = xcd_barrier_post((unsigned*)(ws + WS_CTL) + 4096, MISC + 8);
#define IN(k) (lo <= (k) && (k) < hi)
#define PH_ENTER() do { int t_ = F.wave * 64 + lane_now(); F.tid = t_; F.lane = t_ & 63; } while (0)
    volatile LAS int* DRW = (volatile LAS int*)(F.lds + MISC_OFF + 64);
    unsigned* DCTR = (unsigned*)(ws + WS_CTL) + 8192;
#define DRAIN(ph, total, BODY) do { PH_ENTER(); unsigned tk_ = 0u; if (F.tid == 0) tk_ = atomicAdd(DCTR + 64 * (ph), 1u); for (;;) { __syncthreads(); if (F.tid == 0) DRW[0] = (int)tk_; __syncthreads(); const int c_ = DRW[0]; if (c_ >= (total)) break; \
        if (F.tid == 0) tk_ = atomicAdd(DCTR + 64 * (ph), 1u);     \
        BODY } } while (0)
#define SEAM(k) do { if (IN(k) && IN((k) + 1)) xcd_barrier(bar, F.wave == 0 && lane_now() == 0); } while (0)

#define GEMM_STORE(Aptr, Wptr, NN, KK, Optr) do { pg8::GemmP g{KK, KK, (KK) / 64}; pg8::StaticOrder S; S.init(MT / 256, (NN) / 256, F.G, F.bid, Aptr, Wptr, KK, KK); pg8::EpiStoreBf16 E{(pg8::bf16_t*)(Optr), NN}; \
        pg8::gemm_phase<pg8::EpiStoreBf16, pg8::StaticOrder>(F.lds + RING_OFF, g, S, E, F.tid); } while (0)
#define GEMM_RESIDB(MODE_, Aptr, Wptr, KK) do { pg8::GemmP g{KK, KK, (KK) / 64}; pg8::StaticOrder S; S.init(MT / 256, DM / 256, F.G, F.bid, Aptr, Wptr, KK, KK); \
        pg8::EpiResidB<MODE_> E{args.in[I_XP], args.in[I_XS], (pg8::bf16_t*)HB, out, SSQ2}; pg8::gemm_phase<pg8::EpiResidB<MODE_>, pg8::StaticOrder>(F.lds + RING_OFF, g, S, E, F.tid); } while (0)

    PH_ENTER(); if (IN(0)) {
        transpose_weight(F, args.in[I_AWIN], 2048, 8192, W_AIN[0]); attn_table(F, TABA);
        norm_rows(F, args.in[I_XP], args.in[I_XS], args.in[I_NW], XN0);
    }
    SEAM(0);
#define GEMM_AIN(Aptr, Wptr, J_, SSQP) do { pg8::GemmP g{2048, 2048, 32}; pg8::StaticOrder S; S.init(MT / 256, 32, F.G, F.bid, Aptr, Wptr, 2048, 2048); \
        EpiAIn E{Qs, KP, VP, KC, VC, GA, out + O_KP + (size_t)(J_) * MP * DM, out + O_VP + (size_t)(J_) * MP * DM, out + O_KS + (size_t)(J_) * MS * DM, out + O_VS + (size_t)(J_) * MS * DM, TABA, args.in[I_AQG] + 64 * (J_), args.in[I_AKG] + 64 * (J_), SSQP}; \
        pg8::gemm_phase<EpiAIn, pg8::StaticOrder>(F.lds + RING_OFF, g, S, E, F.tid); } while (0)
    PH_ENTER(); if (IN(1)) { GEMM_AIN(XN0, W_AIN[0], 0, (const float*)nullptr);
        const int n0 = CC_CHUNKS, n1 = n0 + tw_chunks(2048, 2048), n2 = n1 + TR_CHUNKS;
        DRAIN(1, n2, if (c_ < n0) cc_run(F, args.in[I_CK], args.in[I_CV], KC, VC, c_); else if (c_ < n1) tw_run(F, args.in[I_AWOUT], 2048, 2048, W_AOUT[0], c_ - n0); else tr_run(F, TABR, c_ - n1);); }
    SEAM(1);
    PH_ENTER(); if (IN(3)) { const float li = 0.8f - 0.6f * expf(-0.3f * 0.f); const float lam = diff_lambda(args.in[I_LQ1], args.in[I_LK1], args.in[I_LQ2], args.in[I_LK2], li);
        attn_fast(F, Qs, KP, VP, KC, VC, GA, AO_A, lam, 1.f - li, args.in[I_ASG]); }
    SEAM(3);
    PH_ENTER(); if (IN(4)) { GEMM_RESIDB(0, AO_A, W_AOUT[0], 2048);
        const int n0 = tw_chunks(2048, 12288), n1 = n0 + tw_chunks(4096, 2048);
        DRAIN(4, n1, if (c_ < n0) tw_run(F, args.in[I_RWIN], 2048, 12288, W_RIN, c_, args.in[I_NW] + DM); else tw_run(F, args.in[I_RWOUT], 4096, 2048, W_ROUT, c_ - n0);); }
    if (IN(4) && IN(6)) xcd_barrier(bar, F.wave == 0 && lane_now() == 0);
    PH_ENTER(); if (IN(6)) { ret_zero_pad(F, VS, KT);
        PH_ENTER(); pg8::GemmP g{2048, 2048, 32}; pg8::StaticOrder S; S.init(MT / 256, 48, F.G, F.bid, HB, W_RIN, 2048, 2048); EpiRet E{QP, KN, KT, VS, RG, TABR, SSQ2};
        pg8::gemm_phase<EpiRet, pg8::StaticOrder>(F.lds + RING_OFF, g, S, E, F.tid); }
    SEAM(6);
    PH_ENTER(); if (IN(7)) { { pg8::GemmP g{4096, 2048, 4}; RetQKOrder S{F.G, F.bid, (const char*)QP, (const char*)KN}; EpiRetQK E{QP}; pg8::gemm_phase<EpiRetQK, RetQKOrder>(F.lds + RING_OFF, g, S, E, F.tid); }
        PH_ENTER(); { pg8::GemmP g{512, 256, 4}; RetKVOrder S{F.G, F.bid, (const char*)VS, (const char*)KT}; EpiRetKV E{VS, KVX}; pg8::gemm_phase<EpiRetKV, RetKVOrder>(F.lds + RING_OFF, g, S, E, F.tid); }
        xcd_barrier(bar, F.wave == 0 && lane_now() == 0);
        PH_ENTER(); ret_scan(F, VS, KVX, args.in[I_SR], out + O_SP, out + O_SS); }
    SEAM(7);
    PH_ENTER(); if (IN(8)) { pg8::GemmP g{4096, 512, 8}; RetOOrder S{F.G, F.bid, (const char*)QP, (const char*)VS}; EpiRetO E{ORET}; pg8::gemm_phase<EpiRetO, RetOOrder>(F.lds + RING_OFF, g, S, E, F.tid); }
    SEAM(8);
    PH_ENTER(); if (IN(9)) r_out(F, ORET, RG);
    SEAM(9);
    PH_ENTER(); if (IN(10)) { GEMM_RESIDB(1, ORET, W_ROUT, 4096);
        const int n0 = tw_chunks(2048, 12288), n1 = n0 + tw_chunks(4096, 2048), n2 = n1 + tw_chunks(2048, 8192), n3 = n2 + tw_chunks(2048, 2048);
        DRAIN(10, n3, if (c_ < n0) tw_run(F, args.in[I_CWIN], 2048, 12288, W_CIN, c_, args.in[I_NW] + 2 * DM, true); else if (c_ < n1) tw_run(F, args.in[I_CWOUT], 4096, 2048, W_COUT, c_ - n0);
                      else if (c_ < n2) tw_run(F, args.in[I_AWIN] + (size_t)2048 * 8192, 2048, 8192, W_AIN[1], c_ - n1, args.in[I_NW] + 3 * DM); else tw_run(F, args.in[I_AWOUT] + (size_t)2048 * 2048, 2048, 2048, W_AOUT[1], c_ - n2);); }
    if (IN(10) && IN(12)) xcd_barrier(bar, F.wave == 0 && lane_now() == 0);
    PH_ENTER(); if (IN(12)) { pg8::GemmP g{2048, 2048, 32}; pg8::StaticOrder S; S.init(MT / 256, 48, F.G, F.bid, HB, W_CIN, 2048, 2048); EpiCIn E{GU, GVT, GVS, SSQ, SSQ2};
        pg8::gemm_phase<EpiCIn, pg8::StaticOrder>(F.lds + RING_OFF, g, S, E, F.tid); }
    SEAM(12);
    PH_ENTER(); if (IN(13)) c_prep(F, SSQ, args.in[I_CWS], args.in[I_CVG], GVS, WM, out + O_VM);
    SEAM(13);
    PH_ENTER(); if (IN(14)) { pg8::GemmP g{256, 256, 4}; CMixOrder S{F.G, F.bid, (const char*)WM, (const char*)GVT}; EpiCMix E{GU, args.in[I_CVG], args.in[I_CBS]}; pg8::gemm_phase<EpiCMix, CMixOrder>(F.lds + RING_OFF, g, S, E, F.tid); }
    SEAM(14);
    PH_ENTER(); if (IN(15)) { GEMM_RESIDB(1, GU, W_COUT, 4096);
        DRAIN(15, CC_CHUNKS, cc_run(F, args.in[I_CK] + (size_t)NB * PAST * DM, args.in[I_CV] + (size_t)NB * PAST * DM, KC, VC, c_);); }
    if (IN(15) && IN(17)) xcd_barrier(bar, F.wave == 0 && lane_now() == 0);
    PH_ENTER(); if (IN(17)) GEMM_AIN(HB, W_AIN[1], 1, (const float*)SSQ2);
    SEAM(17);
    PH_ENTER(); if (IN(19)) { const float li = 0.8f - 0.6f * expf(-0.3f * 3.f); const float lam = diff_lambda(args.in[I_LQ1] + 64, args.in[I_LK1] + 64, args.in[I_LQ2] + 64, args.in[I_LK2] + 64, li);
        attn_fast(F, Qs, KP, VP, KC, VC, GA, AO_A, lam, 1.f - li, args.in[I_ASG] + 128); }
    SEAM(19);
    PH_ENTER(); if (IN(20)) GEMM_RESIDB(2, AO_A, W_AOUT[1], 2048);
#undef IN
#undef SEAM
}

extern "C" void kernel_launch(void* const* d_in, const int* in_sizes, int n_in, void* d_out, int out_size, void* d_ws, size_t ws_size, hipStream_t stream) {
    static int grid = 0;
    if (grid == 0) {
        if (n_in != N_IN || (size_t)out_size != O_END || ws_size < WS_END) { fprintf(stderr, "kernel_launch: unexpected shapes: n_in %d out %d ws %zu (need %zu)\n", n_in, out_size, ws_size, (size_t)WS_END); grid = -1; return; }
        int dev = 0, cus = 0;
        if (hipGetDevice(&dev) != hipSuccess || hipDeviceGetAttribute(&cus, hipDeviceAttributeMultiprocessorCount, dev) != hipSuccess) { grid = -1; return; }
        if (hipFuncSetAttribute((const void*)mega, hipFuncAttributeMaxDynamicSharedMemorySize, LDS_BYTES) != hipSuccess) { fprintf(stderr, "kernel_launch: hipFuncSetAttribute failed\n"); grid = -1; return; }
        int per_cu = 0;
        if (hipOccupancyMaxActiveBlocksPerMultiprocessor(&per_cu, (const void*)mega, NTHR, LDS_BYTES) != hipSuccess || per_cu < 1) { fprintf(stderr, "kernel_launch: occupancy query: %d workgroups per CU\n", per_cu); grid = -1; return; }
        (void)hipGetLastError();
        grid = cus;
    }
    if (grid < 0) return;
    Args a{};
    for (int i = 0; i < N_IN; ++i) a.in[i] = (const float*)d_in[i];
    a.out = (float*)d_out; a.ws = (unsigned char*)d_ws;
    (void)hipMemsetAsync((char*)d_ws + WS_CTL, 0, CTL_ZERO_BYTES, stream);
    a.ph_lo = 0; a.ph_hi = N_PHASES;
    hipLaunchKernelGGL(mega, dim3(grid), dim3(NTHR), LDS_BYTES, stream, a);
}
```

```cpp
#include <hip/hip_runtime.h>
#include <cstdio>
#include <cstdint>

__device__ __forceinline__ int lane_now() { int l; asm volatile("v_mbcnt_lo_u32_b32 %0, -1, 0\n\tv_mbcnt_hi_u32_b32 %0, -1, %0" : "=v"(l)); return l; }
namespace pg8 {
#define PG8_LAS __attribute__((address_space(3)))
typedef unsigned short bf16_t;
typedef short bf16x8 __attribute__((ext_vector_type(8)));
typedef float f32x4 __attribute__((ext_vector_type(4)));
typedef unsigned u32x4 __attribute__((ext_vector_type(4)));
constexpr int BM = 256, BK = 64, HALF = 128, HTB = HALF * BK * 2, STAGE_BYTES = 8 * HTB, NXCD = 8, WGM = 4;

__host__ __device__ __forceinline__ int lds_byte(int r, int c) { const int st = (r >> 4) * 2 + (c >> 5), rr = r & 15, cc = c & 31, ob = rr * 64 + cc * 2; return st * 1024 + (ob ^ (((ob >> 9) & 1) << 5)); }
__host__ __device__ __forceinline__ void stage_rc(int b, int& R, int& C) { const int st = b / 1024, sb = b % 1024, swz = sb ^ (((sb >> 9) & 1) << 5); R = (st >> 1) * 16 + swz / 64; C = (st & 1) * 32 + (swz % 64) / 2; }
__host__ __device__ __forceinline__ int perm32(int rho) { const int n = rho >> 4, i = rho & 15; return 8 * (i >> 2) + 4 * n + (i & 3); }

struct Unit { int pm, pn; const char* a; const char* b; };
struct GemmP { int lda, ldb, nt; };

struct StaticOrder {
    int nM, nN, nwg, G, c; const char* A; const char* B; size_t ta, tb;
    __host__ __device__ void init(int nM_, int nN_, int G_, int c_, const void* A_, const void* B_, int lda, int ldb) { nM = nM_; nN = nN_; nwg = nM * nN; G = G_; c = c_; A = (const char*)A_; B = (const char*)B_; ta = (size_t)BM * lda * 2; tb = (size_t)BM * ldb * 2; }
    __host__ __device__ bool next(int i, Unit& u) const {
        const long L = (long)i * G + c; if (L >= nwg) return false;
        int wgid = (int)L; { const int q = nwg / NXCD, r = nwg % NXCD, xcd = wgid % NXCD, off = wgid / NXCD; wgid = (xcd < r ? xcd * (q + 1) : r * (q + 1) + (xcd - r) * q) + off; }
        const int nig = WGM * nN, gid = wgid / nig, fm = gid * WGM, gsz = (nM - fm) < WGM ? (nM - fm) : WGM;
        u.pm = fm + ((wgid % nig) % gsz); u.pn = (wgid % nig) / gsz; u.a = A + (size_t)u.pm * ta; u.b = B + (size_t)u.pn * tb; return true;
    }
    __device__ __forceinline__ void a_ready(const Unit&) const {}
    __device__ __forceinline__ void done(const Unit&) const {}
};

__device__ __forceinline__ unsigned cvt_pk_bf16(float lo, float hi) { unsigned r; asm volatile("v_cvt_pk_bf16_f32 %0, %1, %2" : "=v"(r) : "v"(lo), "v"(hi)); return r; }

struct EpiStoreBf16 {
    static constexpr int BMODE = 1;
    bf16_t* O; int ldc;
    __device__ __forceinline__ void operator()(const f32x4 (&acc)[2][2][4][2], const Unit& u, int wr, int wc, int fr, int fq) const {
        const int row0 = u.pm * BM + wr * 64 + fr; const int col0 = u.pn * BM + wc * 32 + 8 * fq;
#pragma unroll
        for (int ai = 0; ai < 2; ++ai)
#pragma unroll
            for (int m = 0; m < 4; ++m) { bf16_t* rowp = O + (size_t)(row0 + ai * HALF + m * 16) * ldc + col0;
#pragma unroll
                for (int bj = 0; bj < 2; ++bj) { const f32x4 v0 = acc[ai][bj][m][0], v1 = acc[ai][bj][m][1];
                    u32x4 w; w.x = cvt_pk_bf16(v0[0], v0[1]); w.y = cvt_pk_bf16(v0[2], v0[3]); w.z = cvt_pk_bf16(v1[0], v1[1]); w.w = cvt_pk_bf16(v1[2], v1[3]);
                    *(u32x4*)(rowp + bj * HALF) = w; } }
    }
};
struct EpiResid {
    static constexpr int BMODE = 0;
    const float* base_p; const float* base_s; float* out; int split;
    __device__ __forceinline__ void operator()(const f32x4 (&acc)[2][2][4][2], const Unit& u, int wr, int wc, int fr, int fq) const {
        { const int l_ = lane_now(); fr = l_ & 15; fq = l_ >> 4; }
        const int col0 = u.pn * BM + wc * 32 + 4 * fq;
#pragma unroll
        for (int ai = 0; ai < 2; ++ai) {
            f32x4 bs[4][2][2];
#pragma unroll
            for (int m = 0; m < 4; ++m) { const int r = u.pm * BM + ai * HALF + wr * 64 + m * 16 + fr; const float* bp = (r < split) ? base_p + (size_t)r * 2048 : base_s + (size_t)(r - split) * 2048;
#pragma unroll
                for (int bj = 0; bj < 2; ++bj)
#pragma unroll
                    for (int n = 0; n < 2; ++n) bs[m][bj][n] = *(const f32x4*)(bp + col0 + bj * HALF + n * 16); }
#pragma unroll
            for (int m = 0; m < 4; ++m) { const int r = u.pm * BM + ai * HALF + wr * 64 + m * 16 + fr; float* op = out + (size_t)r * 2048;
#pragma unroll
                for (int bj = 0; bj < 2; ++bj)
#pragma unroll
                    for (int n = 0; n < 2; ++n) *(f32x4*)(op + col0 + bj * HALF + n * 16) = bs[m][bj][n] + acc[ai][bj][m][n]; }
            asm volatile("" ::: "memory");
        }
    }
};

template <int MODE> struct EpiResidB {
    static constexpr int BMODE = 1;
    const float* base_p; const float* base_s; bf16_t* HB; float* out; float* SSQ2;
    __device__ __forceinline__ void operator()(const f32x4 (&acc)[2][2][4][2], const Unit& u, int wr, int wc, int fr, int fq) const {
        { const int l_ = lane_now(); fr = l_ & 15; fq = l_ >> 4; }
        const int col0 = u.pn * BM + wc * 32 + 8 * fq;
#pragma unroll
        for (int ai = 0; ai < 2; ++ai) {
            f32x4 b0[4][2], b1[4][2]; u32x4 hb[4][2];
#pragma unroll
            for (int m = 0; m < 4; ++m) { const int r = u.pm * BM + ai * HALF + wr * 64 + m * 16 + fr;
#pragma unroll
                for (int bj = 0; bj < 2; ++bj) {
                    if (MODE == 0) { const float* bp = ((r < 16384) ? base_p + (size_t)r * 2048 : base_s + (size_t)(r - 16384) * 2048) + col0 + bj * HALF; b0[m][bj] = __builtin_nontemporal_load((const f32x4*)bp); b1[m][bj] = __builtin_nontemporal_load((const f32x4*)(bp + 4)); }
                    else hb[m][bj] = *(const u32x4*)(HB + (size_t)r * 2048 + col0 + bj * HALF); } }
#pragma unroll
            for (int m = 0; m < 4; ++m) { const int r = u.pm * BM + ai * HALF + wr * 64 + m * 16 + fr; float ss = 0.f;
#pragma unroll
                for (int bj = 0; bj < 2; ++bj) { f32x4 h0, h1;
                    if (MODE == 0) { h0 = b0[m][bj] + acc[ai][bj][m][0]; h1 = b1[m][bj] + acc[ai][bj][m][1]; }
                    else { const u32x4 w = hb[m][bj];
                        h0 = (f32x4){__builtin_bit_cast(float, w.x << 16), __builtin_bit_cast(float, w.x & 0xffff0000u), __builtin_bit_cast(float, w.y << 16), __builtin_bit_cast(float, w.y & 0xffff0000u)} + acc[ai][bj][m][0];
                        h1 = (f32x4){__builtin_bit_cast(float, w.z << 16), __builtin_bit_cast(float, w.z & 0xffff0000u), __builtin_bit_cast(float, w.w << 16), __builtin_bit_cast(float, w.w & 0xffff0000u)} + acc[ai][bj][m][1]; }
                    if (MODE == 2) { float* op = out + (size_t)r * 2048 + col0 + bj * HALF; __builtin_nontemporal_store(h0, (f32x4*)op); __builtin_nontemporal_store(h1, (f32x4*)(op + 4)); }
                    else { u32x4 w; w.x = cvt_pk_bf16(h0[0], h0[1]); w.y = cvt_pk_bf16(h0[2], h0[3]); w.z = cvt_pk_bf16(h1[0], h1[1]); w.w = cvt_pk_bf16(h1[2], h1[3]);
                        *(u32x4*)(HB + (size_t)r * 2048 + col0 + bj * HALF) = w;
                        ss += (h0[0] * h0[0] + h0[1] * h0[1]) + (h0[2] * h0[2] + h0[3] * h0[3]) + (h1[0] * h1[0] + h1[1] * h1[1]) + (h1[2] * h1[2] + h1[3] * h1[3]); } }
                if (MODE != 2) { ss += __shfl_xor(ss, 16); ss += __shfl_xor(ss, 32); if (fq == 0) SSQ2[(size_t)r * 32 + u.pn * 4 + wc] = ss; } }
            asm volatile("" ::: "memory");
        }
    }
};

template <class Epi, class Sched, bool ALIGN_EPI = true>
__device__ __forceinline__ void gemm_phase(PG8_LAS unsigned char* lds, const GemmP g, const Sched& S, const Epi& E, int tid) {
    asm volatile("" : "+v"(tid));
    const int wid = __builtin_amdgcn_readfirstlane(tid >> 6), lane = tid & 63, wr = wid >> 2, wc = wid & 3, fr = lane & 15, fq = lane >> 4;
    int nt = g.nt; asm volatile("" : "+s"(nt));
    unsigned voffA[2], voffB[2];
#pragma unroll
    for (int i = 0; i < 2; ++i) { int R, C; stage_rc(tid * 16 + i * 8192, R, C); const int Rb = Epi::BMODE == 2 ? (64 * (R >> 5) + perm32(R & 31)) : Epi::BMODE == 1 ? ((R & ~31) + perm32(R & 31)) : R;
        voffA[i] = (unsigned)(R * g.lda + C) * 2u; voffB[i] = (unsigned)(Rb * g.ldb + C) * 2u; }
    const size_t kstep = (size_t)(BK * 2);
    const size_t hstepA = (size_t)HALF * g.lda * 2, hstepB = (size_t)(Epi::BMODE == 2 ? 32 : HALF) * g.ldb * 2;
    const unsigned ldsw = (unsigned)wid * 1024u;
    const int aoff = lds_byte(wr * 64 + fr, fq * 8), boff = lds_byte(wc * 32 + fr, fq * 8);
#define PG8_SA(b, h) (((b) * 2 + (h)) * HTB)
#define PG8_SB(b, h) ((4 + (b) * 2 + (h)) * HTB)
#define PG8_STAGE(bufoff, gbase, voff) do { _Pragma("unroll") for (int _i = 0; _i < 2; ++_i) \
        __builtin_amdgcn_global_load_lds((const unsigned*)((const char*)(gbase) + (voff)[_i]), (PG8_LAS unsigned*)(lds + (bufoff) + ldsw + _i * 8192), 16, 0, 0); } while (0)
#define PG8_LDA(dst, b, h) do { _Pragma("unroll") for (int m = 0; m < 4; ++m) _Pragma("unroll") for (int k = 0; k < 2; ++k) dst[m][k] = *(const PG8_LAS bf16x8*)(lds + PG8_SA(b, h) + aoff + m * 2048 + k * 1024); } while (0)
#define PG8_LDB(dst, b, h) do { _Pragma("unroll") for (int n = 0; n < 2; ++n) _Pragma("unroll") for (int k = 0; k < 2; ++k) dst[n][k] = *(const PG8_LAS bf16x8*)(lds + PG8_SB(b, h) + boff + n * 2048 + k * 1024); } while (0)
#define PG8_MMA(ai, bj, At, Bt) do { __builtin_amdgcn_s_setprio(1); _Pragma("unroll") for (int m = 0; m < 4; ++m) _Pragma("unroll") for (int n = 0; n < 2; ++n) _Pragma("unroll") for (int k = 0; k < 2; ++k) \
        acc[ai][bj][m][n] = __builtin_amdgcn_mfma_f32_16x16x32_bf16(Bt[n][k], At[m][k], acc[ai][bj][m][n], 0, 0, 0); __builtin_amdgcn_s_setprio(0); } while (0)
#define PG8_WAIT_V(n) asm volatile("s_waitcnt vmcnt(" #n ")" ::: "memory")
#define PG8_WAIT_L(n) asm volatile("s_waitcnt lgkmcnt(" #n ")" ::: "memory")
#define PG8_BAR __builtin_amdgcn_s_barrier()
#define PG8_SCHED __builtin_amdgcn_sched_barrier(0)
    Unit cur, nxt; int ui = 0;
    if (!S.next(0, cur)) return;
    f32x4 acc[2][2][4][2];
#pragma unroll
    for (int a = 0; a < 2; ++a)
#pragma unroll
        for (int b = 0; b < 2; ++b)
#pragma unroll
            for (int m = 0; m < 4; ++m)
#pragma unroll
                for (int n = 0; n < 2; ++n) acc[a][b][m][n] = (f32x4){0.f, 0.f, 0.f, 0.f};
    bf16x8 At[4][2], B0[2][2], B1[2][2];
    const char* cA = cur.a; const char* cB = cur.b;
    S.a_ready(cur);
    PG8_STAGE(PG8_SB(0, 0), cB, voffB); PG8_STAGE(PG8_SB(0, 1), cB + hstepB, voffB); PG8_STAGE(PG8_SA(0, 0), cA, voffA); PG8_STAGE(PG8_SA(0, 1), cA + hstepA, voffA);
    if (wr == 1) PG8_BAR;
    PG8_WAIT_V(2); PG8_BAR;
    PG8_STAGE(PG8_SB(1, 0), cB + kstep, voffB); PG8_STAGE(PG8_SA(1, 0), cA + kstep, voffA); PG8_STAGE(PG8_SB(1, 1), cB + hstepB + kstep, voffB);
    PG8_WAIT_V(6); PG8_BAR;
    for (;;) {
        const bool has_next = S.next(ui + 1, nxt);
        const char* nA = has_next ? nxt.a : cA; const char* nB = has_next ? nxt.b : cB;
        for (int t = 0; t < nt; t += 2) {
            const bool last = (t == nt - 2);
            const char* a1 = cA + (size_t)(t + 1) * kstep;
            const char* a2 = last ? nA : cA + (size_t)(t + 2) * kstep; const char* b2 = last ? nB : cB + (size_t)(t + 2) * kstep;
            const char* a3 = a2 + kstep; const char* b3 = b2 + kstep;
            if (last && has_next) S.a_ready(nxt);
            PG8_LDB(B0, 0, 0); PG8_LDB(B1, 0, 1); PG8_SCHED; PG8_LDA(At, 0, 0); PG8_STAGE(PG8_SA(1, 1), a1 + hstepA, voffA);
            PG8_WAIT_V(8); PG8_WAIT_L(0); PG8_BAR; PG8_MMA(0, 0, At, B0); PG8_MMA(0, 1, At, B1); PG8_BAR; PG8_SCHED;
            PG8_LDA(At, 0, 1); PG8_STAGE(PG8_SB(0, 0), b2, voffB); PG8_STAGE(PG8_SB(0, 1), b2 + hstepB, voffB); PG8_STAGE(PG8_SA(0, 0), a2, voffA);
            PG8_WAIT_V(8); PG8_WAIT_L(0); PG8_BAR; PG8_MMA(1, 0, At, B0); PG8_MMA(1, 1, At, B1); PG8_BAR; PG8_SCHED;
            PG8_LDB(B0, 1, 0); PG8_LDB(B1, 1, 1); PG8_SCHED; PG8_LDA(At, 1, 0); PG8_STAGE(PG8_SA(0, 1), a2 + hstepA, voffA);
            PG8_WAIT_V(8); PG8_WAIT_L(0); PG8_BAR; PG8_MMA(0, 0, At, B0); PG8_MMA(0, 1, At, B1); PG8_BAR; PG8_SCHED;
            PG8_LDA(At, 1, 1); PG8_STAGE(PG8_SB(1, 0), b3, voffB); PG8_STAGE(PG8_SB(1, 1), b3 + hstepB, voffB); PG8_STAGE(PG8_SA(1, 0), a3, voffA);
            PG8_WAIT_V(8); PG8_WAIT_L(0); PG8_BAR; PG8_MMA(1, 0, At, B0); PG8_MMA(1, 1, At, B1); PG8_BAR; PG8_SCHED;
        }
        if constexpr (ALIGN_EPI) { if (wr == 0) PG8_BAR; }
        E(acc, cur, wr, wc, fr, fq); S.done(cur);
        if (!has_next) break;
#pragma unroll
        for (int a = 0; a < 2; ++a)
#pragma unroll
            for (int b = 0; b < 2; ++b)
#pragma unroll
                for (int m = 0; m < 4; ++m)
#pragma unroll
                    for (int n = 0; n < 2; ++n) acc[a][b][m][n] = (f32x4){0.f, 0.f, 0.f, 0.f};
        cur = nxt; cA = nA; cB = nB; ++ui;
        if constexpr (ALIGN_EPI) { if (wr == 1) PG8_BAR; }
    }
    PG8_WAIT_V(0);
    if constexpr (!ALIGN_EPI) { if (wr == 0) PG8_BAR; }
    PG8_BAR;
#undef PG8_SA
#undef PG8_SB
#undef PG8_STAGE
#undef PG8_LDA
#undef PG8_LDB
#undef PG8_MMA
#undef PG8_WAIT_V
#undef PG8_WAIT_L
#undef PG8_BAR
#undef PG8_SCHED
}
}

constexpr int NWAVES = 8, NTHR = 512;
constexpr int DM = 2048, MP = 16384, MS = 512, MT = MP + MS, PAST = 2048, DECL = 64, NB = 8;
constexpr int KCROWS = PAST + DECL;
constexpr float EPS = 1e-6f;
constexpr float LOG2E = 1.4426950408889634f;
constexpr float C2 = 0.125f * LOG2E;

enum { I_XP = 0, I_XS, I_CK, I_CV, I_SR, I_NW, I_AWIN, I_AWOUT, I_AQG, I_AKG, I_LQ1, I_LK1, I_LQ2, I_LK2, I_ASG, I_RWIN, I_RWOUT, I_CWIN, I_CWOUT, I_CVG, I_CWS, I_CBS, N_IN };
constexpr size_t O_YP = 0, O_YS = O_YP + (size_t)MP * DM, O_KP = O_YS + (size_t)MS * DM, O_VP = O_KP + 2 * (size_t)MP * DM, O_KS = O_VP + 2 * (size_t)MP * DM, O_VS = O_KS + 2 * (size_t)MS * DM,
                 O_SP = O_VS + 2 * (size_t)MS * DM, O_SS = O_SP + (size_t)8 * 256 * 512, O_VM = O_SS + (size_t)NB * 8 * 256 * 512, O_END = O_VM + (size_t)MS * 4096;

constexpr size_t MiB = 1u << 20;
constexpr size_t WS_CTL = 0, CTL_ZERO_BYTES = 1 * MiB;
constexpr size_t WS_WAIN0 = 8 * MiB, WS_WAOUT0 = 40 * MiB, WS_WRIN = 48 * MiB, WS_WROUT = 96 * MiB, WS_WCIN = 112 * MiB, WS_WCOUT = 160 * MiB, WS_WAIN1 = 176 * MiB, WS_WAOUT1 = 208 * MiB;
constexpr size_t WS_SSQ2 = 2 * MiB;
constexpr size_t WS_HB = 216 * MiB, WS_Z = 282 * MiB;
constexpr size_t WS_XN0 = 348 * MiB;
constexpr size_t WS_QS = 546 * MiB, WS_KP = 612 * MiB, WS_VP = 676 * MiB, WS_KC = 740 * MiB, WS_VC = 806 * MiB, WS_AOA = 872 * MiB;
constexpr size_t WS_KT = 112 * MiB, WS_RG = 282 * MiB, WS_QP = 414 * MiB, WS_KN = 546 * MiB, WS_VS = 612 * MiB, WS_ORET = 900 * MiB;
constexpr size_t WS_GU = 282 * MiB, WS_SG = 414 * MiB, WS_GVT = 546 * MiB, WS_WM = 678 * MiB, WS_SSQ = 744 * MiB, WS_GVS = 752 * MiB;
constexpr size_t WS_GA = 282 * MiB;
constexpr size_t WS_KVX = 184 * MiB;
constexpr size_t WS_TABR = 1040 * MiB, WS_TABA = 1056 * MiB, WS_END = 1060 * MiB;

#define GAS __attribute__((address_space(1)))
#define LAS __attribute__((address_space(3)))
typedef unsigned short bf16;
typedef unsigned v4u __attribute__((ext_vector_type(4)));
typedef unsigned v2u __attribute__((ext_vector_type(2)));
typedef float f32x4 __attribute__((ext_vector_type(4)));
typedef GAS unsigned gu32;
#define RLX_AGENT __ATOMIC_RELAXED, __HIP_MEMORY_SCOPE_AGENT
#define LDS_WAIT() asm volatile("s_waitcnt lgkmcnt(0)" ::: "memory")
#define VM_WAIT() asm volatile("s_waitcnt vmcnt(0)" ::: "memory")
typedef float g_f32x2 __attribute__((ext_vector_type(2))); typedef __bf16 g_bf16x2 __attribute__((ext_vector_type(2)));
__device__ __forceinline__ unsigned pk2(float lo, float hi) { const g_f32x2 v = {lo, hi}; const g_bf16x2 b = __builtin_convertvector(v, g_bf16x2); return __builtin_bit_cast(unsigned, b); }
__device__ __forceinline__ unsigned f2bf(float f) { return pk2(f, 0.f) & 0xffffu; }
__device__ __forceinline__ float bf2f(unsigned short b) { return __builtin_bit_cast(float, (unsigned)b << 16); }
__device__ __forceinline__ float bflo(unsigned w) { return __builtin_bit_cast(float, w << 16); }
__device__ __forceinline__ float bfhi(unsigned w) { return __builtin_bit_cast(float, w & 0xffff0000u); }
__device__ __forceinline__ float silu_f(float x) { return x * __builtin_amdgcn_rcpf(1.f + __builtin_amdgcn_exp2f(-LOG2E * x)); }
__device__ __forceinline__ float gelu_tanh_f(float x) { const float u = (0.7978845608028654f * 2.f * LOG2E) * (x + 0.044715f * x * x * x); return x * __builtin_amdgcn_rcpf(1.f + __builtin_amdgcn_exp2f(-u)); }
__device__ __forceinline__ float wave_sum(float v) {
#pragma unroll
    for (int o = 1; o < 64; o <<= 1) v += __shfl_xor(v, o);
    return v;
}
__device__ __forceinline__ void row_rstd(const float* ssq, int pm, int wr, int fr, int fq, float (&rs)[2][4]) {
#pragma unroll
    for (int ai = 0; ai < 2; ++ai)
#pragma unroll
        for (int m = 0; m < 4; ++m) {
            if (ssq) { const float* p = ssq + ((size_t)pm * 256 + ai * 128 + wr * 64 + m * 16 + fr) * 32 + 8 * fq; const f32x4 a = *(const f32x4*)p, b = *(const f32x4*)(p + 4);
                float t = ((a.x + a.y) + (a.z + a.w)) + ((b.x + b.y) + (b.z + b.w)); t += __shfl_xor(t, 16); t += __shfl_xor(t, 32); rs[ai][m] = 1.f / sqrtf(t * (1.f / 2048.f) + EPS); }
            else rs[ai][m] = 1.f; }
}
__device__ __forceinline__ void row_rstd_c(const float* ssq, LAS float* rc, int pm, int wr, int wc, int fr, int fq, float (&rs)[2][4]) {
    if (!ssq) {
#pragma unroll
        for (int ai = 0; ai < 2; ++ai)
#pragma unroll
            for (int m = 0; m < 4; ++m) rs[ai][m] = 1.f;
        return; }
    volatile LAS int* tagp = (volatile LAS int*)rc;
    if (tagp[0] != pm + 1) {
        const int t = (wr * 4 + wc) * 64 + fq * 16 + fr, row = t >> 1, half = t & 1;
        const float* p = ssq + ((size_t)pm * 256 + row) * 32 + half * 16;
        const f32x4 a = *(const f32x4*)p, b = *(const f32x4*)(p + 4), c = *(const f32x4*)(p + 8), d = *(const f32x4*)(p + 12);
        float s = (((a.x + a.y) + (a.z + a.w)) + ((b.x + b.y) + (b.z + b.w))) + (((c.x + c.y) + (c.z + c.w)) + ((d.x + d.y) + (d.z + d.w)));
        s += __shfl_xor(s, 1);
        if (half == 0) rc[64 + row] = 1.f / sqrtf(s * (1.f / 2048.f) + EPS);
        asm volatile("s_waitcnt lgkmcnt(0)\n\ts_barrier" ::: "memory");
        if (t == 0) tagp[0] = pm + 1;
    }
#pragma unroll
    for (int ai = 0; ai < 2; ++ai)
#pragma unroll
        for (int m = 0; m < 4; ++m) rs[ai][m] = rc[64 + ai * 128 + wr * 64 + m * 16 + fr];
}
#define NT_LOAD(p) __builtin_nontemporal_load(p)
#define NT_STORE(v, p) __builtin_nontemporal_store((v), (p))
__device__ __forceinline__ void rope_cs(int pos, int i, int nf, float& c, float& s) {
    const float inv = exp2f(-(float)i / (float)nf * 13.287712379549449f);
    const double a = (double)pos * (double)inv * 0.15915494309189535;
    const float r = (float)(a - floor(a));
    c = __builtin_amdgcn_cosf(r); s = __builtin_amdgcn_sinf(r);
}

#define XB_TMO      128
#define XB_XCNT(j)  (256  + 64 * (j))
#define XB_XSUB(j)  (1280 + 64 * (j))
#define XB_XGEN(j)  (2304 + 64 * (j))
#define XB_TOP      3328
#define XB_TOPGEN   3392
#define XCD_BAR_WORDS 3456
#define XB_SPIN_CAP (1u << 22)
__device__ __forceinline__ unsigned xb_ld(unsigned* p)              { return __hip_atomic_load(p, __ATOMIC_RELAXED, __HIP_MEMORY_SCOPE_AGENT); }
__device__ __forceinline__ unsigned xb_add(unsigned* p, unsigned v) { return __hip_atomic_fetch_add(p, v, __ATOMIC_RELAXED, __HIP_MEMORY_SCOPE_AGENT); }
__device__ __forceinline__ unsigned xb_xcc_id() { return (unsigned)__builtin_amdgcn_s_getreg((3 << 11) | 20) & 0xFu; }
#define XB_SPIN(cond, bar) do { unsigned _sp = 0; while (cond) { __builtin_amdgcn_s_sleep(1); \
    if ((++_sp & 255u) == 0u) { if (xb_ld(&(bar)[XB_TMO])) break; if (_sp > XB_SPIN_CAP) { atomicAdd(&(bar)[XB_TMO], 1u); break; } } } } while (0)
struct XcdBarrier { unsigned* bar; unsigned x; volatile LAS unsigned* st; };
__device__ __forceinline__ XcdBarrier xcd_barrier_post(unsigned* bar, volatile LAS unsigned* st) {
    XcdBarrier b; b.bar = bar; b.x = xb_xcc_id(); b.st = st;
    if (threadIdx.x == 0) (void)xb_add(&bar[XB_XCNT(b.x)], 1u);
    return b;
}
__device__ __forceinline__ void xcd_barrier_complete(unsigned* bar, unsigned x, unsigned& nloc, unsigned& nx) {
    const unsigned G = gridDim.x * gridDim.y * gridDim.z;
    unsigned sum, cnt, mine, sp = 0u;
    for (;;) {
        sum = 0u; cnt = 0u; mine = 0u;
#pragma unroll
        for (unsigned j = 0; j < 16; ++j) { const unsigned c = xb_ld(&bar[XB_XCNT(j)]); sum += c; cnt += (c > 0u) ? 1u : 0u; mine = (j == x) ? c : mine; }
        if (sum == G) break;
        __builtin_amdgcn_s_sleep(1);
        if ((++sp & 255u) == 0u) { if (xb_ld(&bar[XB_TMO])) break; if (sp > XB_SPIN_CAP) { atomicAdd(&bar[XB_TMO], 1u); break; } }
    }
    nloc = mine > 0u ? mine : 1u; nx = cnt > 0u ? cnt : 1u;
}
__device__ __forceinline__ void xcd_barrier(const XcdBarrier& b, bool leader) {
    asm volatile("s_waitcnt vmcnt(0)" ::: "memory");
    __syncthreads();
    if (leader) {
        unsigned* bar = b.bar;
        __builtin_amdgcn_s_waitcnt(0);
        unsigned nloc = b.st[0], nx = b.st[1];
        if (nloc == 0u) { xcd_barrier_complete(bar, b.x, nloc, nx); b.st[0] = nloc; b.st[1] = nx; }
        const unsigned old = xb_add(&bar[XB_XSUB(b.x)], 1u);
        const unsigned gen = old / nloc;
        if (old + 1u == (gen + 1u) * nloc) {
            __builtin_amdgcn_fence(__ATOMIC_RELEASE, "agent");
            asm volatile("s_waitcnt vmcnt(0)" ::: "memory");
            const unsigned og = xb_add(&bar[XB_TOP], 1u);
            const unsigned tg = og / nx;
            if (og + 1u == (tg + 1u) * nx) xb_add(&bar[XB_TOPGEN], 1u);
            else XB_SPIN(xb_ld(&bar[XB_TOPGEN]) == tg, bar);
            __builtin_amdgcn_fence(__ATOMIC_ACQUIRE, "agent");
            xb_add(&bar[XB_XGEN(b.x)], 1u);
            asm volatile("s_waitcnt vmcnt(0)" ::: "memory");
        } else {
            XB_SPIN(xb_ld(&bar[XB_XGEN(b.x)]) == gen, bar);
            __builtin_amdgcn_fence(__ATOMIC_ACQUIRE, "agent");
            asm volatile("s_waitcnt vmcnt(0)" ::: "memory");
        }
    }
    __syncthreads();
}

constexpr int RING_OFF = 0, RING_BYTES = 139264;
constexpr int MISC_OFF = RING_BYTES;
constexpr int LDS_BYTES = 147456;
struct Args { const float* in[N_IN]; float* out; unsigned char* ws; int ph_lo, ph_hi; };
struct Frame {
    LAS unsigned char* lds; int tid, lane, wave, G, bid;
    const float* const* in; float* out; unsigned char* ws;
};

__device__ __forceinline__ int cmlp_col(int n) { return n < 4096 ? (n >> 7) * 256 + (n & 127) : n < 8192 ? n + 4096 : ((n - 8192) >> 7) * 256 + 128 + (n & 127); }
__device__ __forceinline__ void p0_transpose_item(const float* W, int K, int N, bf16* WT, LAS float* scr, int item, int lane, const float* ksc = nullptr, bool cperm = false) {
    const int nblk = N / 32, kb = item / nblk, nb = item % nblk, k0 = 64 * kb, n0 = 32 * nb;
    float w_[32];
#pragma unroll
    for (int i = 0; i < 32; ++i) w_[i] = NT_LOAD(W + (size_t)(k0 + 2 * i + (lane >> 5)) * N + n0 + (lane & 31));
#pragma unroll
    for (int i = 0; i < 32; ++i) { const int kk = 2 * i + (lane >> 5); scr[kk * 33 + (lane & 31)] = ksc ? w_[i] * ksc[k0 + kk] : w_[i]; }
    LDS_WAIT(); asm volatile("" ::: "memory");
    const int c = lane & 7;
#pragma unroll
    for (int j = 0; j < 4; ++j) { const int n = (lane >> 3) + 8 * j; const LAS float* s = scr + (8 * c) * 33 + n;
        v4u o; o.x = pk2(s[0 * 33], s[1 * 33]); o.y = pk2(s[2 * 33], s[3 * 33]); o.z = pk2(s[4 * 33], s[5 * 33]); o.w = pk2(s[6 * 33], s[7 * 33]);
        *(GAS v4u*)(WT + (size_t)((cperm ? cmlp_col(n0) : n0) + n) * K + k0 + 8 * c) = o; }
    LDS_WAIT(); asm volatile("" ::: "memory");
}
__device__ __forceinline__ void transpose_weight(Frame& F, const float* W, int K, int N, bf16* WT) {
    LAS float* scr = (LAS float*)(F.lds + RING_OFF + F.wave * 16384);
    const int gw = F.bid * NWAVES + F.wave, NGW = F.G * NWAVES, nitems = (K / 64) * (N / 32);
    for (int it = gw; it < nitems; it += NGW) p0_transpose_item(W, K, N, WT, scr, it, F.lane);
}
__device__ __forceinline__ void norm_rows(Frame& F, const float* src_p, const float* src_s, const float* w, bf16* XN) {
    const int gw = F.bid * NWAVES + F.wave, NGW = F.G * NWAVES;
    const GAS f32x4* wr = (const GAS f32x4*)w + F.lane;
    f32x4 nx[8];
    if (gw < MT) { const float* xrow = (gw < MP) ? src_p + (size_t)gw * DM : src_s + (size_t)(gw - MP) * DM;
#pragma unroll
        for (int j = 0; j < 8; ++j) nx[j] = __builtin_nontemporal_load((const f32x4*)(xrow) + F.lane + 64 * j); }
    for (int m = gw; m < MT; m += NGW) {
        f32x4 v[8]; float s = 0.f;
#pragma unroll
        for (int j = 0; j < 8; ++j) v[j] = nx[j];
        const int m2 = m + NGW;
        if (m2 < MT) { const float* xrow = (m2 < MP) ? src_p + (size_t)m2 * DM : src_s + (size_t)(m2 - MP) * DM;
#pragma unroll
            for (int j = 0; j < 8; ++j) nx[j] = __builtin_nontemporal_load((const f32x4*)(xrow) + F.lane + 64 * j); }
#pragma unroll
        for (int j = 0; j < 8; ++j) s += (v[j].x * v[j].x + v[j].y * v[j].y) + (v[j].z * v[j].z + v[j].w * v[j].w);
        const float rstd = 1.f / sqrtf(wave_sum(s) * (1.f / DM) + EPS);
        GAS v2u* o8 = (GAS v2u*)(XN + (size_t)m * DM) + F.lane;
#pragma unroll
        for (int j = 0; j < 8; ++j) { const f32x4 g = wr[64 * j]; v2u o; o.x = pk2(v[j].x * rstd * g.x, v[j].y * rstd * g.y); o.y = pk2(v[j].z * rstd * g.z, v[j].w * rstd * g.w); o8[64 * j] = o; }
    }
}
__device__ __forceinline__ void cache_cvt(Frame& F, const float* ck, const float* cv, bf16* KC, bf16* VC) {
    const size_t nvec = (size_t)NB * PAST * DM / 4;
    const size_t gt = (size_t)F.bid * NTHR + F.tid, NG = (size_t)F.G * NTHR;
    for (size_t i = gt; i < 2 * nvec; i += NG) {
        const bool isv = i >= nvec; const size_t e = (isv ? i - nvec : i) * 4;
        const size_t brow = e / DM, col = e % DM, b = brow / PAST, t = brow % PAST;
        const f32x4 x = *(const GAS f32x4*)((isv ? cv : ck) + e);
        v2u o; o.x = pk2(x.x, x.y); o.y = pk2(x.z, x.w);
        *(GAS v2u*)((isv ? VC : KC) + ((b * KCROWS + t) * DM + col)) = o;
    }
}
__device__ __forceinline__ int tw_chunks(int K, int N) { return (K / 64) * (N / 32) / 64; }
__device__ __forceinline__ void tw_run(Frame& F, const float* W, int K, int N, bf16* WT, int c, const float* ksc = nullptr, bool cperm = false) {
    LAS float* scr = (LAS float*)(F.lds + RING_OFF + F.wave * 16384);
#pragma unroll 1
    for (int i = 0; i < 8; ++i) p0_transpose_item(W, K, N, WT, scr, c * 64 + F.wave * 8 + i, F.lane, ksc, cperm);
}
constexpr int CC_CHUNKS = 2 * (NB * PAST * DM / 4) / 8192;
__device__ __forceinline__ void cc_run(Frame& F, const float* ck, const float* cv, bf16* KC, bf16* VC, int c) {
    const bool isv = c >= CC_CHUNKS / 2; const int brow0 = (isv ? c - CC_CHUNKS / 2 : c) * 16, b = brow0 / PAST, t0 = brow0 % PAST;
    const float* src = (isv ? cv : ck) + (size_t)brow0 * DM + F.tid * 4;
    bf16* dst = (isv ? VC : KC) + ((size_t)b * KCROWS + t0) * DM + F.tid * 4;
    f32x4 x[16];
#pragma unroll
    for (int k = 0; k < 16; ++k) x[k] = NT_LOAD((const f32x4*)(src + (size_t)k * DM));
#pragma unroll
    for (int k = 0; k < 16; ++k) { v2u o; o.x = pk2(x[k].x, x[k].y); o.y = pk2(x[k].z, x[k].w); *(GAS v2u*)(dst + (size_t)k * DM) = o; }
}
constexpr int TR_CHUNKS = MP * 128 / 8192;
__device__ __forceinline__ void tr_run(Frame& F, float* tab, int c) {
#pragma unroll 1
    for (int k = 0; k < 16; ++k) { const size_t e = (size_t)c * 8192 + k * NTHR + F.tid; float cs, sn; rope_cs((int)(e >> 7), (int)(e & 127), 128, cs, sn); tab[2 * e] = cs; tab[2 * e + 1] = sn; }
}
__device__ __forceinline__ int row_pos(int row) { return row < MP ? row : PAST + ((row - MP) & 63); }

struct EpiAIn {
    static constexpr int BMODE = 2;
    pg8::bf16_t *Qs, *KP, *VP, *KC, *VC, *GA; float *okp, *ovp, *oks, *ovs; const float* tab; const float* qg; const float* kg; const float* ssq; LAS float* rc;
    __device__ __forceinline__ void operator()(const pg8::f32x4 (&acc)[2][2][4][2], const pg8::Unit& u, int wr, int wc, int fr, int fq) const {
        { const int l_ = lane_now(); fr = l_ & 15; fq = l_ >> 4; }
        const int pn = u.pn, pm = u.pm, typ = pn >> 3, cl = ((pn & 7) * 4 + wc) * 64 + 8 * fq; float rs[2][4]; row_rstd_c(ssq, rc, pm, wr, wc, fr, fq, rs);
        float g1[8], g2[8];
        if (typ < 2) { const float* gp = (typ == 0 ? qg : kg) + 8 * fq; const pg8::f32x4 a = *(const pg8::f32x4*)gp, b = *(const pg8::f32x4*)(gp + 4), c = *(const pg8::f32x4*)(gp + 32), d = *(const pg8::f32x4*)(gp + 36);
#pragma unroll
            for (int e = 0; e < 4; ++e) { g1[e] = a[e]; g1[4 + e] = b[e]; g2[e] = c[e]; g2[4 + e] = d[e]; } }
#pragma unroll
        for (int ai = 0; ai < 2; ++ai)
#pragma unroll
          for (int mp = 0; mp < 2; ++mp) {
            pg8::f32x4 tq[4][4];
            if (typ < 2) {
#pragma unroll
                for (int m = 2 * mp; m < 2 * mp + 2; ++m) { const int i_ = ai * 128 + wr * 64 + m * 16 + fr; const int pos_ = pm < 64 ? pm * 256 + i_ : PAST + (i_ & 63); const float* tp_ = tab + ((size_t)pos_ * 32 + 8 * fq) * 2;
#pragma unroll
                    for (int q4 = 0; q4 < 4; ++q4) tq[m][q4] = *(const pg8::f32x4*)(tp_ + 4 * q4); } }
#pragma unroll
            for (int m = 2 * mp; m < 2 * mp + 2; ++m) {
                const int i = ai * 128 + wr * 64 + m * 16 + fr; const size_t row = (size_t)pm * 256 + i;
                float x1[8], x2[8];
#pragma unroll
                for (int e = 0; e < 4; ++e) { x1[e] = acc[ai][0][m][0][e] * rs[ai][m]; x1[4 + e] = acc[ai][0][m][1][e] * rs[ai][m]; x2[e] = acc[ai][1][m][0][e] * rs[ai][m]; x2[4 + e] = acc[ai][1][m][1][e] * rs[ai][m]; }
                size_t drow; pg8::bf16_t* dk; pg8::bf16_t* dv; float* fk; float* fv;
                if (pm < 64) { drow = row; dk = KP; dv = VP; fk = okp + row * DM; fv = ovp + row * DM; }
                else { const int s_ = (int)(row - MP); drow = (size_t)(s_ >> 6) * KCROWS + PAST + (s_ & 63); dk = KC; dv = VC; fk = oks + (size_t)s_ * DM; fv = ovs + (size_t)s_ * DM; }
                if (typ < 2) {
                    float ss = 0.f;
#pragma unroll
                    for (int k = 0; k < 8; ++k) ss += x1[k] * x1[k] + x2[k] * x2[k];
                    ss += __shfl_xor(ss, 16); ss += __shfl_xor(ss, 32);
                    const float rstd = 1.f / sqrtf(ss * (1.f / 64.f) + EPS);
                    float o1[8], o2[8];
#pragma unroll
                    for (int q4 = 0; q4 < 4; ++q4) { const pg8::f32x4 t = tq[m][q4];
#pragma unroll
                        for (int z = 0; z < 2; ++z) { const int k = 2 * q4 + z; const float c = t[2 * z], s = t[2 * z + 1], y1 = x1[k] * rstd * g1[k], y2 = x2[k] * rstd * g2[k]; o1[k] = y1 * c - y2 * s; o2[k] = y2 * c + y1 * s; } }
                    if (typ == 0) { v4u w1, w2;
                        w1.x = pk2(o1[0] * C2, o1[1] * C2); w1.y = pk2(o1[2] * C2, o1[3] * C2); w1.z = pk2(o1[4] * C2, o1[5] * C2); w1.w = pk2(o1[6] * C2, o1[7] * C2);
                        w2.x = pk2(o2[0] * C2, o2[1] * C2); w2.y = pk2(o2[2] * C2, o2[3] * C2); w2.z = pk2(o2[4] * C2, o2[5] * C2); w2.w = pk2(o2[6] * C2, o2[7] * C2);
                        *(v4u*)(Qs + row * DM + cl) = w1; *(v4u*)(Qs + row * DM + cl + 32) = w2;
                    } else { v4u w1, w2;
                        w1.x = pk2(o1[0], o1[1]); w1.y = pk2(o1[2], o1[3]); w1.z = pk2(o1[4], o1[5]); w1.w = pk2(o1[6], o1[7]);
                        w2.x = pk2(o2[0], o2[1]); w2.y = pk2(o2[2], o2[3]); w2.z = pk2(o2[4], o2[5]); w2.w = pk2(o2[6], o2[7]);
                        *(v4u*)(dk + drow * DM + cl) = w1; *(v4u*)(dk + drow * DM + cl + 32) = w2;
                        NT_STORE(((pg8::f32x4){o1[0], o1[1], o1[2], o1[3]}), (pg8::f32x4*)(fk + cl)); NT_STORE(((pg8::f32x4){o1[4], o1[5], o1[6], o1[7]}), (pg8::f32x4*)(fk + cl + 4));
                        NT_STORE(((pg8::f32x4){o2[0], o2[1], o2[2], o2[3]}), (pg8::f32x4*)(fk + cl + 32)); NT_STORE(((pg8::f32x4){o2[4], o2[5], o2[6], o2[7]}), (pg8::f32x4*)(fk + cl + 36)); }
                } else { v4u w1, w2;
                    w1.x = pk2(x1[0], x1[1]); w1.y = pk2(x1[2], x1[3]); w1.z = pk2(x1[4], x1[5]); w1.w = pk2(x1[6], x1[7]);
                    w2.x = pk2(x2[0], x2[1]); w2.y = pk2(x2[2], x2[3]); w2.z = pk2(x2[4], x2[5]); w2.w = pk2(x2[6], x2[7]);
                    if (typ == 2) { *(v4u*)(dv + drow * DM + cl) = w1; *(v4u*)(dv + drow * DM + cl + 32) = w2;
                        NT_STORE(((pg8::f32x4){x1[0], x1[1], x1[2], x1[3]}), (pg8::f32x4*)(fv + cl)); NT_STORE(((pg8::f32x4){x1[4], x1[5], x1[6], x1[7]}), (pg8::f32x4*)(fv + cl + 4));
                        NT_STORE(((pg8::f32x4){x2[0], x2[1], x2[2], x2[3]}), (pg8::f32x4*)(fv + cl + 32)); NT_STORE(((pg8::f32x4){x2[4], x2[5], x2[6], x2[7]}), (pg8::f32x4*)(fv + cl + 36)); }
                    else { *(v4u*)(GA + row * DM + cl) = w1; *(v4u*)(GA + row * DM + cl + 32) = w2; }
                }
                if (m & 1) asm volatile("" ::: "memory");
            }
        }
    }
};
__device__ __forceinline__ void attn_table(Frame& F, float* tab) {
    const size_t gt = (size_t)F.bid * NTHR + F.tid, NG = (size_t)F.G * NTHR;
    for (size_t e = gt; e < (size_t)MP * 32; e += NG) { float c, s; rope_cs((int)(e >> 5), (int)(e & 31), 32, c, s); tab[2 * e] = c; tab[2 * e + 1] = s; }
}
namespace dattn {
typedef short bf16x8 __attribute__((ext_vector_type(8)));
typedef short s16x4 __attribute__((ext_vector_type(4)));
typedef short v4i16_t __attribute__((ext_vector_type(4)));
typedef float f32x16 __attribute__((ext_vector_type(16)));
typedef unsigned u32x4 __attribute__((ext_vector_type(4)));
typedef __attribute__((address_space(3))) const char* lds_cptr;
constexpr int RINGB = 98304, WSF_OFF = RINGB, XCHB = 18432, STP = 144;
__device__ __forceinline__ int crow(int r, int hi) { return (r & 3) + 8 * (r >> 2) + 4 * hi; }
__device__ __forceinline__ void glds16(const void* gsrc, unsigned lds_dst) { unsigned keep;
    asm volatile("s_mov_b32 %0, m0\n\ts_mov_b32 m0, %2\n\ts_nop 0\n\tglobal_load_lds_dwordx4 %1, off\n\ts_mov_b32 m0, %0" : "=&s"(keep) : "v"(gsrc), "s"(lds_dst) : "memory"); }
typedef float f32x2_t __attribute__((ext_vector_type(2))); typedef __bf16 bf16x2_t __attribute__((ext_vector_type(2)));
__device__ __forceinline__ unsigned cvtpk_s(float lo, float hi) { f32x2_t v = {lo, hi}; bf16x2_t b = __builtin_convertvector(v, bf16x2_t); return __builtin_bit_cast(unsigned, b); }
#define DA_WAIT_BAR(N) asm volatile("s_waitcnt vmcnt(" #N ") lgkmcnt(0)\n\ts_barrier" ::: "memory")
__device__ __forceinline__ s16x4 vtr(lds_cptr p) { return __builtin_bit_cast(s16x4, __builtin_amdgcn_ds_read_tr16_b64_v4i16((__attribute__((address_space(3))) v4i16_t*)p)); }
struct Unit { const bf16* Q; const bf16* K; const bf16* V; const bf16* G; bf16* AO; int NT; int full; int dma0; };

constexpr int KSLOT = 16384, VSLOT = 16384, VRING = 3 * KSLOT;
#define DA_SBAR() __builtin_amdgcn_sched_barrier(0)
#define DA_PIN(x) asm volatile("" : "+v"(x))
#define DA_MFMA(a, b, c) __builtin_amdgcn_mfma_f32_32x32x16_bf16(a, b, c, 0, 0, 0)
struct DmaJob { const bf16* kp; const bf16* vp; unsigned kd0, kd1, vd0, vd1; };
__device__ __forceinline__ void dma_piece(const DmaJob& j, int i) { if (i == 0) glds16(j.kp, j.kd0); else if (i == 1) glds16(j.kp + 64, j.kd1); else if (i == 2) glds16(j.vp, j.vd0); else glds16(j.vp + 64, j.vd1); }
template <bool QK, bool PV, int VAR>
__device__ __forceinline__ void step(lds_cptr kpn, lds_cptr vp, const bf16x8 (&qr)[4], bf16x8 (&kf)[8], f32x16 (&o)[4], u32x4 (&pw)[4], float& l_reg, const DmaJob& dj) {
    f32x16 C0 = f32x16{}, C1 = f32x16{};
    s16x4 vlo[4], vhi[4];
    if constexpr (!QK) { dma_piece(dj, 0); dma_piece(dj, 1); dma_piece(dj, 2); dma_piece(dj, 3); }
#define DA_FOFF(f) ((((f) & 3) * 4096) + (((f) >> 2) * 1024))
#pragma unroll
    for (int a = 0; a < 8; ++a) {
        if constexpr (PV) { if (a >= 4) { if (VAR != 4) { vlo[a - 4] = vtr(vp + DA_FOFF(a - 4)); vhi[a - 4] = vtr(vp + DA_FOFF(a - 4) + 512); } else { vlo[a - 4] = s16x4{1, 2, 3, 4}; vhi[a - 4] = s16x4{5, 6, 7, 8}; } DA_SBAR(); } }
        if constexpr (QK) {
            if (a & 1) C1 = (a < 2) ? DA_MFMA(kf[a], qr[a >> 1], f32x16{}) : DA_MFMA(kf[a], qr[a >> 1], C1);
            else       C0 = (a < 2) ? DA_MFMA(kf[a], qr[a >> 1], f32x16{}) : DA_MFMA(kf[a], qr[a >> 1], C0);
            if (a < 4) dma_piece(dj, a);
            DA_SBAR();
        }
    }
    u32x4 pwn[4]; pwn[0] = u32x4{}; pwn[1] = u32x4{}; pwn[2] = u32x4{}; pwn[3] = u32x4{};
    float s0 = 0.f, s1 = 0.f;
#pragma unroll
    for (int p = 0; p < 16; ++p) {
        if constexpr (PV) {
            const bf16x8 vf = (bf16x8){vlo[p & 3][0], vlo[p & 3][1], vlo[p & 3][2], vlo[p & 3][3], vhi[p & 3][0], vhi[p & 3][1], vhi[p & 3][2], vhi[p & 3][3]};
            if (VAR != 3) o[p & 3] = DA_MFMA(__builtin_bit_cast(bf16x8, pw[p >> 2]), vf, o[p & 3]); else { o[p & 3][0] += __builtin_bit_cast(float, (int)vf[0] | ((int)vf[4] << 16)); }
            if (p < 12 && VAR != 4) { vlo[p & 3] = vtr(vp + DA_FOFF(p + 4)); vhi[p & 3] = vtr(vp + DA_FOFF(p + 4) + 512); }
        }
        if constexpr (QK) {
            float e0, e1;
            if (VAR == 2) { if (p < 8) { e0 = C0[2 * p]; e1 = C0[2 * p + 1]; } else { e0 = C1[2 * p - 16]; e1 = C1[2 * p - 15]; } }
            else if (p < 8) { e0 = __builtin_amdgcn_exp2f(C0[2 * p]); e1 = __builtin_amdgcn_exp2f(C0[2 * p + 1]); }
            else       { e0 = __builtin_amdgcn_exp2f(C1[2 * p - 16]); e1 = __builtin_amdgcn_exp2f(C1[2 * p - 15]); }
            s0 += e0; s1 += e1; pwn[p >> 2][p & 3] = cvtpk_s(e0, e1);
            DA_PIN(s0); DA_PIN(s1); DA_PIN(pwn[p >> 2]);
            if (p >= 8 && VAR != 6) { const int j = p - 8; kf[j] = *(const __attribute__((address_space(3))) bf16x8*)(kpn + (j >> 1) * 2048 + (j & 1) * 512); }
        }
        DA_SBAR();
    }
    if constexpr (QK) { l_reg += s0 + s1; pw[0] = pwn[0]; pw[1] = pwn[1]; pw[2] = pwn[2]; pw[3] = pwn[3]; }
#undef DA_FOFF
}

template <bool QK, bool PV>
__device__ __forceinline__ void step2(lds_cptr kpn, lds_cptr vp, const bf16x8 (&qr)[4], bf16x8 (&kf)[8], f32x16 (&o)[4], u32x4 (&pw)[4], float& l_reg, const DmaJob& dj,
                                      f32x16& Cn0, f32x16& Cn1, const f32x16& Pp0, const f32x16& Pp1) {
    s16x4 vlo[4], vhi[4];
#define DA_FOFF(f) ((((f) & 3) * 4096) + (((f) >> 2) * 1024))
    if constexpr (!QK) { dma_piece(dj, 0); dma_piece(dj, 1); dma_piece(dj, 2); dma_piece(dj, 3); }
    float s0 = 0.f, s1 = 0.f;
#pragma unroll
    for (int a = 0; a < 8; ++a) {
        if constexpr (PV) { if (a >= 4) { vlo[a - 4] = vtr(vp + DA_FOFF(a - 4)); vhi[a - 4] = vtr(vp + DA_FOFF(a - 4) + 512); DA_SBAR(); } }
        if constexpr (QK) {
            if (a & 1) Cn1 = (a < 2) ? DA_MFMA(kf[a], qr[a >> 1], f32x16{}) : DA_MFMA(kf[a], qr[a >> 1], Cn1);
            else       Cn0 = (a < 2) ? DA_MFMA(kf[a], qr[a >> 1], f32x16{}) : DA_MFMA(kf[a], qr[a >> 1], Cn0);
            if (a < 4) dma_piece(dj, a);
        }
        if constexpr (PV) {
            float x0, x1, x2, x3;
            if (a < 4) { x0 = Pp0[4 * a]; x1 = Pp0[4 * a + 1]; x2 = Pp0[4 * a + 2]; x3 = Pp0[4 * a + 3]; }
            else       { x0 = Pp1[4 * a - 16]; x1 = Pp1[4 * a - 15]; x2 = Pp1[4 * a - 14]; x3 = Pp1[4 * a - 13]; }
            s0 += x0; s1 += x1; s0 += x2; s1 += x3;
            pw[(2 * a) >> 2][(2 * a) & 3] = cvtpk_s(x0, x1); pw[(2 * a + 1) >> 2][(2 * a + 1) & 3] = cvtpk_s(x2, x3);
            DA_PIN(s0); DA_PIN(s1); DA_PIN(pw[(2 * a) >> 2]);
        }
        if constexpr (QK || PV) DA_SBAR();
    }
    if constexpr (PV) l_reg += s0 + s1;
#pragma unroll
    for (int p = 0; p < 16; ++p) {
        if constexpr (PV) {
            const bf16x8 vf = (bf16x8){vlo[p & 3][0], vlo[p & 3][1], vlo[p & 3][2], vlo[p & 3][3], vhi[p & 3][0], vhi[p & 3][1], vhi[p & 3][2], vhi[p & 3][3]};
            o[p & 3] = DA_MFMA(__builtin_bit_cast(bf16x8, pw[p >> 2]), vf, o[p & 3]);
            if (p < 12) { vlo[p & 3] = vtr(vp + DA_FOFF(p + 4)); vhi[p & 3] = vtr(vp + DA_FOFF(p + 4) + 512); }
        }
        if constexpr (QK) {
            if (p < 8) { Cn0[2 * p] = __builtin_amdgcn_exp2f(Cn0[2 * p]); Cn0[2 * p + 1] = __builtin_amdgcn_exp2f(Cn0[2 * p + 1]); DA_PIN(Cn0); }
            else       { Cn1[2 * p - 16] = __builtin_amdgcn_exp2f(Cn1[2 * p - 16]); Cn1[2 * p - 15] = __builtin_amdgcn_exp2f(Cn1[2 * p - 15]); DA_PIN(Cn1); }
            if (p >= 8) { const int j = p - 8; kf[j] = *(const __attribute__((address_space(3))) bf16x8*)(kpn + (j >> 1) * 2048 + (j & 1) * 512); }
        }
        if constexpr (QK || PV) DA_SBAR();
    }
#undef DA_FOFF
}

__device__ __forceinline__ void unit_prologue(const Unit& u, unsigned lds0, int lane, int wid, bf16x8 (&qr)[4]) {
    const int r32 = lane & 31, hi = lane >> 5, s = wid >> 2, g = wid & 3; const int NT = u.NT; const int wt = u.full ? (g < 2 ? NT - 1 : NT) : (g < 2 ? NT : 0);
    const bf16* ksrc = u.K + (long)lane * DM + wid * 8;
    const bf16* vsrc = u.V + (long)(16 * (wid & 3) + (lane >> 2)) * DM + (wid >> 2) * 32 + (lane & 3) * 8;
    const unsigned kdst = lds0 + wid * 1024, vdst = lds0 + VRING + wid * 1024;
#pragma unroll
    for (int t = 0; t < 3; ++t) { const int tt_ = t < NT ? t : NT - 1; const bf16* kp_ = ksrc + (long)tt_ * 64 * DM;
        glds16(kp_, (unsigned)__builtin_amdgcn_readfirstlane(kdst + t * KSLOT)); glds16(kp_ + 64, (unsigned)__builtin_amdgcn_readfirstlane(kdst + 8192 + t * KSLOT)); }
    glds16(vsrc, (unsigned)__builtin_amdgcn_readfirstlane(vdst)); glds16(vsrc + 64, (unsigned)__builtin_amdgcn_readfirstlane(vdst + 8192));
    const bf16* Qw = u.Q + (long)(32 * g + r32) * DM + s * 64;
#pragma unroll
    for (int d0 = 0; d0 < 4; ++d0) qr[d0] = (wt > 0) ? *reinterpret_cast<const bf16x8*>(Qw + d0 * 16 + hi * 8) : (bf16x8){0, 0, 0, 0, 0, 0, 0, 0};
}
template <int VAR>
__device__ __forceinline__ void attn_unit(const Unit& u, bool has_next, const Unit& nxt, bool prefetched, bf16x8 (&qr)[4], char* shm, float* wsf_base, float lam, float one_m_li, const float* sub_gain, int tid) {
    asm volatile("" : "+v"(tid));
    const int lane = tid & 63, r32 = lane & 31, hi = lane >> 5; const int wid = __builtin_amdgcn_readfirstlane(tid >> 6), s = wid >> 2, g = wid & 3;
    const int NT = u.NT; const int wt = u.full ? (g < 2 ? NT - 1 : NT) : (g < 2 ? NT : 0);
    const unsigned lds0 = (unsigned)(uintptr_t)shm;
    float* wsf = wsf_base + wid * 64;
    const bf16* ksrc = u.K + (long)lane * DM + wid * 8;
    const bf16* vsrc = u.V + (long)(16 * (wid & 3) + (lane >> 2)) * DM + (wid >> 2) * 32 + (lane & 3) * 8;
    const unsigned kdst = lds0 + wid * 1024, vdst = lds0 + VRING + wid * 1024;
#define DA_DMA_K(t, slot) do { const int tt_ = u.dma0 ? 0 : (t) < NT ? (t) : NT - 1; const bf16* kp_ = ksrc + (long)tt_ * 64 * DM; \
        glds16(kp_, (unsigned)__builtin_amdgcn_readfirstlane(kdst + (slot) * KSLOT)); glds16(kp_ + 64, (unsigned)__builtin_amdgcn_readfirstlane(kdst + 8192 + (slot) * KSLOT)); } while (0)
#define DA_DMA_V(t, slot) do { const int tt_ = u.dma0 ? 0 : (t) < NT ? (t) : NT - 1; const bf16* vp_ = vsrc + (long)tt_ * 64 * DM; \
        glds16(vp_, (unsigned)__builtin_amdgcn_readfirstlane(vdst + (slot) * VSLOT)); glds16(vp_ + 64, (unsigned)__builtin_amdgcn_readfirstlane(vdst + 8192 + (slot) * VSLOT)); } while (0)
    const lds_cptr shm3 = (lds_cptr)shm;
    const lds_cptr kp0 = shm3 + s * 8192 + hi * 1024 + r32 * 16;
    const lds_cptr vp0 = shm3 + VRING + ((lane >> 4) & 1) * 32 + (lane & 3) * 8 + (4 * hi + ((lane & 15) >> 2)) * 64;
    if (!prefetched) unit_prologue(u, lds0, lane, wid, qr);
    asm volatile("" : "+v"(qr[0]), "+v"(qr[1]), "+v"(qr[2]), "+v"(qr[3]));
    f32x16 o[4]; o[0] = f32x16{}; o[1] = f32x16{}; o[2] = f32x16{}; o[3] = f32x16{};
    float l_reg = 0.f;
    u32x4 pw[4]; pw[0] = u32x4{}; pw[1] = u32x4{}; pw[2] = u32x4{}; pw[3] = u32x4{};
    DA_WAIT_BAR(0);
    bf16x8 kf[8];
#pragma unroll
    for (int j = 0; j < 8; ++j) kf[j] = *(const __attribute__((address_space(3))) bf16x8*)(kp0 + (j >> 1) * 2048 + (j & 1) * 512);
    int ks_cur = 0  , vs_prev = 2  ;
#define DA_TOP(t) \
        DA_WAIT_BAR(4);                                          \
        const int ks_next = (ks_cur == 2) ? 0 : ks_cur + 1, vs_cur = (vs_prev == 2) ? 0 : vs_prev + 1, vs_next = (vs_cur == 2) ? 0 : vs_cur + 1; \
        DmaJob dj; { const int tk_ = ((t) + 3) < NT ? ((t) + 3) : NT - 1, tv_ = ((t) + 1) < NT ? ((t) + 1) : NT - 1; dj.kp = ksrc + (long)tk_ * 64 * DM; dj.vp = vsrc + (long)tv_ * 64 * DM; \
          dj.kd0 = (unsigned)__builtin_amdgcn_readfirstlane(kdst + ks_cur * KSLOT); dj.kd1 = dj.kd0 + 8192u; dj.vd0 = (unsigned)__builtin_amdgcn_readfirstlane(vdst + vs_next * VSLOT); dj.vd1 = dj.vd0 + 8192u; }     \
        const lds_cptr kpn = kp0 + ks_next * KSLOT; const lds_cptr vp = vp0 + vs_prev * VSLOT; (void)kpn; (void)vp
#define DA_ROT() do { ks_cur = ks_next; vs_prev = vs_cur; } while (0)
    f32x16 pA0 = f32x16{}, pA1 = f32x16{}, pB0 = f32x16{}, pB1 = f32x16{};
#define DA_IDLE() do { dma_piece(dj, 0); dma_piece(dj, 1); dma_piece(dj, 2); dma_piece(dj, 3); } while (0)
    if (wid >= 4) __builtin_amdgcn_s_setprio(1);
    int t = 0;
    const bool odd = ((wt - 1) & 1) != 0;
    { DA_TOP(0); if (wt > 0) { if (odd) step2<true, false>(kpn, vp, qr, kf, o, pw, l_reg, dj, pB0, pB1, pA0, pA1); else step2<true, false>(kpn, vp, qr, kf, o, pw, l_reg, dj, pA0, pA1, pB0, pB1); } else DA_IDLE(); DA_ROT(); }
    t = 1;
    if (wt > 0 && odd) { DA_TOP(t); step2<true, true>(kpn, vp, qr, kf, o, pw, l_reg, dj, pA0, pA1, pB0, pB1); DA_ROT(); ++t; }
    for (; t + 1 < wt; t += 2) {
        { DA_TOP(t);     step2<true, true>(kpn, vp, qr, kf, o, pw, l_reg, dj, pB0, pB1, pA0, pA1); DA_ROT(); }
        { DA_TOP(t + 1); step2<true, true>(kpn, vp, qr, kf, o, pw, l_reg, dj, pA0, pA1, pB0, pB1); DA_ROT(); }
    }
    if (wt > 0) { DA_TOP(t); step2<false, true>(kpn, vp, qr, kf, o, pw, l_reg, dj, pB0, pB1, pA0, pA1); DA_ROT(); ++t; }
    for (; t <= NT; ++t) { DA_TOP(t); DA_IDLE(); DA_ROT(); }
#undef DA_IDLE
#undef DA_TOP
#undef DA_ROT
    __builtin_amdgcn_s_setprio(0);
    { auto rr = __builtin_amdgcn_permlane32_swap(__float_as_uint(l_reg), __float_as_uint(l_reg), false, false); l_reg = __uint_as_float(rr[0]) + __uint_as_float(rr[1]); }
    if (hi == 0) wsf[r32] = l_reg;
    DA_WAIT_BAR(0);
    if (has_next) unit_prologue(nxt, lds0, lane, wid, qr);
    int le = lane; asm volatile("" : "+v"(le));
    const int r32e = le & 31, hie = le >> 5;
    v4u g4r[8]; f32x4 sga[8], sgb[8];
    if (s == 0 && wt > 0) { const bf16* gp_ = u.G + (long)(32 * g + (le >> 1)) * DM + (le & 1) * 64; const float* sg_ = sub_gain + (le & 1) * 64;
#pragma unroll
        for (int k = 0; k < 8; ++k) { g4r[k] = *(const v4u*)(gp_ + 8 * k); sga[k] = *(const f32x4*)(sg_ + 8 * k); sgb[k] = *(const f32x4*)(sg_ + 8 * k + 4); } }
    float rli[16];
#pragma unroll
    for (int r = 0; r < 16; ++r) { const float lq = wsf[crow(r, hi)]; rli[r] = (s == 0 ? 1.f : -lam) / lq; }
    float* xch = (float*)(shm + 65536 + g * XCHB);
    if (s == 1 && wt > 0) {
#pragma unroll
        for (int db = 0; db < 4; ++db)
#pragma unroll
            for (int r = 0; r < 16; ++r) xch[(db * 16 + r) * 64 + le] = o[db][r] * rli[r];
    }
    asm volatile("s_waitcnt lgkmcnt(0)\n\ts_barrier" ::: "memory");
    if (s == 0 && wt > 0) {
#pragma unroll
        for (int db = 0; db < 4; ++db)
#pragma unroll
            for (int r = 0; r < 16; ++r) o[db][r] = o[db][r] * rli[r] + xch[(db * 16 + r) * 64 + le];
        asm volatile("s_waitcnt lgkmcnt(0)" ::: "memory");
#pragma unroll
        for (int db = 0; db < 4; ++db)
#pragma unroll
            for (int r = 0; r < 16; ++r) xch[crow(r, hie) * STP + 32 * db + r32e] = o[db][r];
        asm volatile("s_waitcnt lgkmcnt(0)" ::: "memory");
        const int row = le >> 1, half = le & 1;
        float v[64]; float ss = 0.f;
#pragma unroll
        for (int k = 0; k < 16; ++k) { const f32x4 x = *(const f32x4*)(xch + row * STP + half * 64 + 4 * k); v[4 * k] = x.x; v[4 * k + 1] = x.y; v[4 * k + 2] = x.z; v[4 * k + 3] = x.w; ss += (x.x * x.x + x.y * x.y) + (x.z * x.z + x.w * x.w); }
        ss += __shfl_xor(ss, 1);
        const float sc = one_m_li / sqrtf(ss * (1.f / 128.f) + EPS);
        bf16* op = u.AO + (long)(32 * g + row) * DM + half * 64;
#pragma unroll
        for (int k = 0; k < 8; ++k) { const v4u g4 = g4r[k]; const f32x4 ga = sga[k], gb = sgb[k];
            const float gg[8] = {bflo(g4.x), bfhi(g4.x), bflo(g4.y), bfhi(g4.y), bflo(g4.z), bfhi(g4.z), bflo(g4.w), bfhi(g4.w)};
            const float gn[8] = {ga.x, ga.y, ga.z, ga.w, gb.x, gb.y, gb.z, gb.w}; float y[8];
#pragma unroll
            for (int e = 0; e < 8; ++e) y[e] = v[8 * k + e] * sc * gn[e] * silu_f(gg[e]);
            v4u w; w.x = pk2(y[0], y[1]); w.y = pk2(y[2], y[3]); w.z = pk2(y[4], y[5]); w.w = pk2(y[6], y[7]);
            *(v4u*)(op + 8 * k) = w; }
    }
#undef DA_DMA_K
#undef DA_DMA_V
}
}
template <int VAR = 0>
__device__ __forceinline__ void attn_fast(Frame& F, const bf16* Qs, const bf16* KP, const bf16* VP, const bf16* KC, const bf16* VC, const bf16* GA  , bf16* AO,
                                          float lam, float one_m_li, const float* sub_gain, int dma0 = 0) {
    const int NU = 2048 + 16 * NB;
    const bool xcd = (F.G == 256);
#define ATTN_GET(i_, u_, ok_) do { int qb = 0, h = 0, b = -1; ok_ = true; \
        if (xcd) { const int x = F.bid & 7, r = F.bid >> 3; \
            if ((i_) < 8) { h = x + 8 * ((i_) >> 2); const int rr = ((i_) == 0) ? (r ^ 8) : r; qb = 127 - (((i_) & 3) * 32 + (((i_) & 1) ? 31 - rr : rr)); } \
            else if ((i_) == 8 && (r & 8) == 0) { const int sb = (r & 7) + ((r >> 4) << 3); h = x + 8 * (sb >> 3); b = sb & 7; } \
            else ok_ = false; \
        } else { const int idx = (i_) * F.G + (((i_) & 1) ? F.G - 1 - F.bid : F.bid); if (idx >= NU) ok_ = false; \
            else if (idx < 2048) { qb = 127 - (idx >> 4); h = idx & 15; } else { const int j = idx - 2048; b = j >> 4; h = j & 15; } } \
        u_.dma0 = 0; \
        if (ok_) { if (b < 0) { const long row0 = 128L * qb; \
            u_.Q = Qs + row0 * DM + h * 128; u_.K = KP + h * 128; u_.V = VP + h * 128; u_.G = GA + row0 * DM + h * 128; u_.AO = AO + row0 * DM + h * 128; u_.NT = 2 * qb + 2; u_.full = 1; } \
          else { const long row0 = MP + 64L * b; \
            u_.Q = Qs + row0 * DM + h * 128; u_.K = KC + (long)b * KCROWS * DM + h * 128; u_.V = VC + (long)b * KCROWS * DM + h * 128; u_.G = GA + row0 * DM + h * 128; u_.AO = AO + row0 * DM + h * 128; u_.NT = KCROWS / 64; u_.full = 0; } } } while (0)
    dattn::Unit u, nx; bool have; ATTN_GET(0, u, have);
    dattn::bf16x8 qr[4]; bool pre = false;
    float* wsf_base = (float*)((char*)F.lds + MISC_OFF + 1024);
    for (int i = 0; have; ++i) {
        bool hn; ATTN_GET(i + 1, nx, hn);
        dattn::attn_unit<VAR>(u, hn, nx, pre, qr, (char*)F.lds + RING_OFF, wsf_base, lam, one_m_li, sub_gain, F.tid);
        u = nx; have = hn; pre = true;
    }
    __syncthreads();
#undef ATTN_GET
}
constexpr int RBLK = 72;
__device__ __forceinline__ float ret_lg2(int h) { return log2f(1.f - exp2f(-5.f - (float)h)); }
struct EpiRet {
    static constexpr int BMODE = 0;
    pg8::bf16_t* QP; pg8::bf16_t* KN; pg8::bf16_t* KT; pg8::bf16_t* VS; pg8::bf16_t* RG; const float* tab; const float* ssq; LAS float* rc;
    __device__ __forceinline__ void operator()(const pg8::f32x4 (&acc)[2][2][4][2], const pg8::Unit& u, int wr, int wc, int fr, int fq) const {
        { const int l_ = lane_now(); fr = l_ & 15; fq = l_ >> 4; }
        const int pn = u.pn, pm = u.pm; float rs[2][4]; row_rstd_c(ssq, rc, pm, wr, wc, fr, fq, rs);
#pragma unroll
        for (int ai = 0; ai < 2; ++ai)
#pragma unroll
            for (int m = 0; m < 4; ++m) {
                const int i = ai * 128 + wr * 64 + m * 16 + fr; const size_t row = (size_t)pm * 256 + i;
                const int J = pm < 64 ? pm : 64 + 4 * (pm - 64) + (i >> 6), jj = pm < 64 ? i : (i & 63), pos = pm < 64 ? (int)row : PAST + (i & 63);
                if (pn < 16) {
                    const int h = pn & 7; const bool isk = pn >= 8; const float sc = isk ? 0.0625f : 1.f;
#pragma unroll
                    for (int n = 0; n < 2; ++n) { const int c1 = wc * 32 + n * 16 + 4 * fq;
                        const pg8::f32x4 t0 = *(const pg8::f32x4*)(tab + ((size_t)pos * 128 + c1) * 2), t1 = *(const pg8::f32x4*)(tab + ((size_t)pos * 128 + c1) * 2 + 4);
                        const pg8::f32x4 x1 = acc[ai][0][m][n] * rs[ai][m], x2 = acc[ai][1][m][n] * rs[ai][m];
                        const float cs[4] = {t0[0], t0[2], t1[0], t1[2]}, sn[4] = {t0[1], t0[3], t1[1], t1[3]}; float o1[4], o2[4];
#pragma unroll
                        for (int e = 0; e < 4; ++e) { o1[e] = (x1[e] * cs[e] - x2[e] * sn[e]) * sc; o2[e] = (x2[e] * cs[e] + x1[e] * sn[e]) * sc; }
                        v2u w1, w2; w1.x = pk2(o1[0], o1[1]); w1.y = pk2(o1[2], o1[3]); w2.x = pk2(o2[0], o2[1]); w2.y = pk2(o2[2], o2[3]);
                        if (!isk) { pg8::bf16_t* p = QP + row * 4096 + h * 512 + 256 + c1; *(v2u*)p = w1; *(v2u*)(p + 128) = w2; }
                        else { pg8::bf16_t* p = KN + row * 2048 + h * 256 + c1; *(v2u*)p = w1; *(v2u*)(p + 128) = w2;
                            pg8::bf16_t* t = KT + ((size_t)(J * 8 + h) * 256 + c1) * 256 + jj;
#pragma unroll
                            for (int e = 0; e < 4; ++e) { t[(size_t)e * 256] = (pg8::bf16_t)f2bf(o1[e]); t[(size_t)(128 + e) * 256] = (pg8::bf16_t)f2bf(o2[e]); } } }
                } else if (pn < 32) {
                    const int h = (pn - 16) >> 1, half = (pn - 16) & 1; const float f = exp2f(-(float)(1 + jj) * ret_lg2(h)) * rs[ai][m];
#pragma unroll
                    for (int bj = 0; bj < 2; ++bj)
#pragma unroll
                        for (int n = 0; n < 2; ++n) { const int dv = half * 256 + bj * 128 + wc * 32 + n * 16 + 4 * fq; pg8::bf16_t* t = VS + ((size_t)(J * 8 + h) * 512 + dv) * 512 + jj;
#pragma unroll
                            for (int e = 0; e < 4; ++e) t[(size_t)e * 512] = (pg8::bf16_t)f2bf(acc[ai][bj][m][n][e] * f); }
                } else {
#pragma unroll
                    for (int bj = 0; bj < 2; ++bj)
#pragma unroll
                        for (int n = 0; n < 2; ++n) { const int c = (pn - 32) * 256 + bj * 128 + wc * 32 + n * 16 + 4 * fq; const pg8::f32x4 x = acc[ai][bj][m][n] * rs[ai][m];
                            v2u w; w.x = pk2(x[0], x[1]); w.y = pk2(x[2], x[3]); *(v2u*)(RG + row * 4096 + c) = w; }
                }
            }
    }
};
__device__ __forceinline__ size_t ret_row0(int J) { return J < 64 ? (size_t)256 * J : (size_t)MP + 64 * (J - 64); }
struct RetQKOrder {
    int G, c; const char* QP; const char* KN;
    __device__ __forceinline__ bool next(int i, pg8::Unit& u) const { const int L = i * G + c; if (L >= RBLK * 8) return false; const int J = L >> 3, h = L & 7; const size_t r0 = ret_row0(J);
        u.pm = J; u.pn = h; u.a = QP + (r0 * 4096 + h * 512 + 256) * 2; u.b = KN + (r0 * 2048 + h * 256) * 2; return true; }
    __device__ __forceinline__ void a_ready(const pg8::Unit&) const {}
    __device__ __forceinline__ void done(const pg8::Unit&) const {}
};
struct EpiRetQK {
    static constexpr int BMODE = 1;
    pg8::bf16_t* QP;
    __device__ __forceinline__ void operator()(const pg8::f32x4 (&acc)[2][2][4][2], const pg8::Unit& u, int wr, int wc, int fr, int fq) const {
        { const int l_ = lane_now(); fr = l_ & 15; fq = l_ >> 4; }
        const int J = u.pm, h = u.pn, nv = J < 64 ? 256 : 64; const size_t r0 = ret_row0(J);
#pragma unroll
        for (int ai = 0; ai < 2; ++ai)
#pragma unroll
            for (int m = 0; m < 4; ++m) { const int i = ai * 128 + wr * 64 + m * 16 + fr;
                if (i < nv) {
#pragma unroll
                    for (int bj = 0; bj < 2; ++bj) { const int j0 = bj * 128 + wc * 32 + 8 * fq; const pg8::f32x4 v0 = acc[ai][bj][m][0], v1 = acc[ai][bj][m][1]; float x[8] = {v0[0], v0[1], v0[2], v0[3], v1[0], v1[1], v1[2], v1[3]};
#pragma unroll
                        for (int k = 0; k < 8; ++k) x[k] = (j0 + k <= i) ? x[k] : 0.f;
                        v4u w; w.x = pk2(x[0], x[1]); w.y = pk2(x[2], x[3]); w.z = pk2(x[4], x[5]); w.w = pk2(x[6], x[7]);
                        *(v4u*)(QP + (r0 + i) * 4096 + h * 512 + j0) = w; } } }
    }
};
__device__ __forceinline__ int xcd_lin(int i, int G, int c) { return (G & 7) ? i * G + c : i * G + (c & 7) * (G >> 3) + (c >> 3); }
struct RetOOrder {
    int G, c; const char* QP; const char* VS;
    __device__ __forceinline__ bool next(int i, pg8::Unit& u) const { const int L = xcd_lin(i, G, c); if (L >= RBLK * 16) return false; const int J = L >> 4, r = L & 15, h = r >> 1, half = r & 1; const size_t r0 = ret_row0(J);
        u.pm = J; u.pn = r; u.a = QP + (r0 * 4096 + h * 512) * 2; u.b = VS + (((size_t)(J * 8 + h) * 512 + half * 256) * 512) * 2; return true; }
    __device__ __forceinline__ void a_ready(const pg8::Unit&) const {}
    __device__ __forceinline__ void done(const pg8::Unit&) const {}
};
struct EpiRetO {
    static constexpr int BMODE = 1;
    pg8::bf16_t* O;
    __device__ __forceinline__ void operator()(const pg8::f32x4 (&acc)[2][2][4][2], const pg8::Unit& u, int wr, int wc, int fr, int fq) const {
        { const int l_ = lane_now(); fr = l_ & 15; fq = l_ >> 4; }
        const int J = u.pm, h = u.pn >> 1, half = u.pn & 1, nv = J < 64 ? 256 : 64; const size_t r0 = ret_row0(J); const float lg = ret_lg2(h);
#pragma unroll
        for (int ai = 0; ai < 2; ++ai)
#pragma unroll
            for (int m = 0; m < 4; ++m) { const int i = ai * 128 + wr * 64 + m * 16 + fr;
                if (i < nv) { const float f = exp2f((float)(i + 1) * lg);
#pragma unroll
                    for (int bj = 0; bj < 2; ++bj) { const int j0 = bj * 128 + wc * 32 + 8 * fq; const pg8::f32x4 v0 = acc[ai][bj][m][0] * f, v1 = acc[ai][bj][m][1] * f;
                        v4u w; w.x = pk2(v0[0], v0[1]); w.y = pk2(v0[2], v0[3]); w.z = pk2(v1[0], v1[1]); w.w = pk2(v1[2], v1[3]);
                        *(v4u*)(O + (r0 + i) * 4096 + h * 512 + half * 256 + j0) = w; } } }
    }
};
struct RetKVOrder {
    int G, c; const char* VS; const char* KT;
    __device__ __forceinline__ bool next(int i, pg8::Unit& u) const { const int L = xcd_lin(i, G, c); if (L >= RBLK * 16) return false; const int J = L >> 4, r = L & 15, h = r >> 1, half = r & 1;
        u.pm = J; u.pn = r; u.a = VS + (((size_t)(J * 8 + h) * 512 + half * 256) * 512) * 2; u.b = KT + ((size_t)(J * 8 + h) * 256 * 256) * 2; return true; }
    __device__ __forceinline__ void a_ready(const pg8::Unit&) const {}
    __device__ __forceinline__ void done(const pg8::Unit&) const {}
};
struct EpiRetKV {
    static constexpr int BMODE = 1;
    pg8::bf16_t* VS; pg8::bf16_t* KVX;
    __device__ __forceinline__ void operator()(const pg8::f32x4 (&acc)[2][2][4][2], const pg8::Unit& u, int wr, int wc, int fr, int fq) const {
        { const int l_ = lane_now(); fr = l_ & 15; fq = l_ >> 4; }
        const int J = u.pm, h = u.pn >> 1, half = u.pn & 1;
        pg8::bf16_t* base; int pitch;
        if (J < 63) { base = VS + ((size_t)((J + 1) * 8 + h) * 512 + half * 256) * 512 + 256; pitch = 512; }
        else { base = KVX + ((size_t)((J - 63) * 8 + h) * 512 + half * 256) * 256; pitch = 256; }
#pragma unroll
        for (int ai = 0; ai < 2; ++ai)
#pragma unroll
            for (int m = 0; m < 4; ++m) { pg8::bf16_t* rowp = base + (size_t)(ai * 128 + wr * 64 + m * 16 + fr) * pitch + wc * 32 + 8 * fq;
#pragma unroll
                for (int bj = 0; bj < 2; ++bj) { const pg8::f32x4 v0 = acc[ai][bj][m][0], v1 = acc[ai][bj][m][1];
                    v4u w; w.x = pk2(v0[0], v0[1]); w.y = pk2(v0[2], v0[3]); w.z = pk2(v1[0], v1[1]); w.w = pk2(v1[2], v1[3]);
                    *(v4u*)(rowp + bj * 128) = w; } }
    }
};
__device__ __forceinline__ void ret_scan(Frame& F, bf16* VS, const bf16* KVX, const float* state_in, float* osp, float* oss) {
    const int gt = F.bid * NTHR + F.tid;
    for (int c = gt; c < 8 * 512 * 32; c += F.G * NTHR) {
        const int h = c >> 14, dv = (c >> 5) & 511, dk0 = (c & 31) * 8; const float lg = ret_lg2(h), g256 = exp2f(256.f * lg), g64 = exp2f(64.f * lg);
        float S[8];
#pragma unroll
        for (int k = 0; k < 8; ++k) S[k] = 0.f;
        bf16* slot = VS + ((size_t)h * 512 + dv) * 512 + 256 + dk0;
        *(v4u*)slot = (v4u){0u, 0u, 0u, 0u};
        constexpr size_t SJ = (size_t)8 * 512 * 512;
        v4u nx[4];
#pragma unroll
        for (int q = 0; q < 4; ++q) nx[q] = *(const v4u*)(slot + (size_t)(1 + q) * SJ);
        for (int J0 = 1; J0 < 64; J0 += 4) {
            v4u cur[4];
#pragma unroll
            for (int q = 0; q < 4; ++q) cur[q] = nx[q];
            if (J0 + 4 < 64) {
#pragma unroll
                for (int q = 0; q < 4; ++q) { const int Jn = J0 + 4 + q; nx[q] = *(const v4u*)(slot + (size_t)(Jn < 64 ? Jn : 63) * SJ); } }
#pragma unroll
            for (int q = 0; q < 4; ++q) { const int J = J0 + q;
                if (J < 64) { const v4u kv = cur[q]; bf16* sj = slot + (size_t)J * SJ;
                    const float x[8] = {bflo(kv.x), bfhi(kv.x), bflo(kv.y), bfhi(kv.y), bflo(kv.z), bfhi(kv.z), bflo(kv.w), bfhi(kv.w)};
#pragma unroll
                    for (int k = 0; k < 8; ++k) S[k] = (S[k] + x[k]) * g256;
                    v4u w; w.x = pk2(S[0], S[1]); w.y = pk2(S[2], S[3]); w.z = pk2(S[4], S[5]); w.w = pk2(S[6], S[7]);
                    *(v4u*)sj = w; } }
        }
        { const v4u kv = *(const v4u*)(KVX + ((size_t)h * 512 + dv) * 256 + dk0);
          const float x[8] = {bflo(kv.x), bfhi(kv.x), bflo(kv.y), bfhi(kv.y), bflo(kv.z), bfhi(kv.z), bflo(kv.w), bfhi(kv.w)};
#pragma unroll
          for (int k = 0; k < 8; ++k) NT_STORE((S[k] + x[k]) * g256, osp + ((size_t)h * 256 + dk0 + k) * 512 + dv); }
    }
    for (int c = gt; c < NB * 8 * 512 * 32; c += F.G * NTHR) {
        const int dv = c & 511, dk0 = ((c >> 9) & 31) * 8, h = (c >> 14) & 7, b = c >> 17; const float g64 = exp2f(64.f * ret_lg2(h));
        const float* si = state_in + (((size_t)b * 8 + h) * 256 + dk0) * 512 + dv; float* so = oss + (((size_t)b * 8 + h) * 256 + dk0) * 512 + dv;
        const v4u kv = *(const v4u*)(KVX + ((size_t)((1 + b) * 8 + h) * 512 + dv) * 256 + dk0);
        const float x[8] = {bflo(kv.x), bfhi(kv.x), bflo(kv.y), bfhi(kv.y), bflo(kv.z), bfhi(kv.z), bflo(kv.w), bfhi(kv.w)}; float s0[8];
#pragma unroll
        for (int k = 0; k < 8; ++k) s0[k] = NT_LOAD(si + (size_t)k * 512);
        v4u w; w.x = pk2(s0[0], s0[1]); w.y = pk2(s0[2], s0[3]); w.z = pk2(s0[4], s0[5]); w.w = pk2(s0[6], s0[7]);
        *(v4u*)(VS + ((size_t)((64 + b) * 8 + h) * 512 + dv) * 512 + 256 + dk0) = w;
#pragma unroll
        for (int k = 0; k < 8; ++k) NT_STORE((s0[k] + x[k]) * g64, so + (size_t)k * 512);
    }
}
__device__ __forceinline__ void ret_zero_pad(Frame& F, bf16* VS, bf16* KT) {
    const size_t gt = (size_t)F.bid * NTHR + F.tid, NG = (size_t)F.G * NTHR, n = (size_t)NB * 8 * 512 * 24, n2 = (size_t)NB * 8 * 256 * 24;
    for (size_t i = gt; i < n; i += NG) { const size_t rowi = i / 24, c = i % 24; *(v4u*)(VS + ((size_t)64 * 8 * 512 + rowi) * 512 + 64 + c * 8) = (v4u){0u, 0u, 0u, 0u}; }
    for (size_t i = gt; i < n2; i += NG) { const size_t rowi = i / 24, c = i % 24; *(v4u*)(KT + ((size_t)64 * 8 * 256 + rowi) * 256 + 64 + c * 8) = (v4u){0u, 0u, 0u, 0u}; }
}
__device__ __forceinline__ void ret_table(Frame& F, float* tab) {
    const size_t gt = (size_t)F.bid * NTHR + F.tid, NG = (size_t)F.G * NTHR;
    for (size_t e = gt; e < (size_t)MP * 128; e += NG) { float c, s; rope_cs((int)(e >> 7), (int)(e & 127), 128, c, s); tab[2 * e] = c; tab[2 * e + 1] = s; }
}
__device__ __forceinline__ void r_out(Frame& F, bf16* O, const bf16* RG) {
    const int gw = F.bid * NWAVES + F.wave, NGW = F.G * NWAVES, lane = F.lane;
    constexpr int U = 6;
    for (int it0 = gw; it0 < MT * 8; it0 += U * NGW) {
        v4u o4[U], g4[U]; size_t off[U]; bool ok[U];
#pragma unroll
        for (int j = 0; j < U; ++j) { const int it = it0 + j * NGW; ok[j] = it < MT * 8; const int itc = ok[j] ? it : gw; off[j] = (size_t)(itc >> 3) * 4096 + (itc & 7) * 512 + lane * 8;
            o4[j] = *(const v4u*)(O + off[j]); g4[j] = NT_LOAD((const v4u*)(RG + off[j])); }
#pragma unroll
        for (int j = 0; j < U; ++j) {
            float o[8] = {bflo(o4[j].x), bfhi(o4[j].x), bflo(o4[j].y), bfhi(o4[j].y), bflo(o4[j].z), bfhi(o4[j].z), bflo(o4[j].w), bfhi(o4[j].w)};
            const float g[8] = {bflo(g4[j].x), bfhi(g4[j].x), bflo(g4[j].y), bfhi(g4[j].y), bflo(g4[j].z), bfhi(g4[j].z), bflo(g4[j].w), bfhi(g4[j].w)};
            float ss = 0.f;
#pragma unroll
            for (int k = 0; k < 8; ++k) ss += o[k] * o[k];
            const float rstd = 1.f / sqrtf(wave_sum(ss) * (1.f / 512.f) + EPS);
#pragma unroll
            for (int k = 0; k < 8; ++k) o[k] = o[k] * rstd * silu_f(g[k]);
            v4u w; w.x = pk2(o[0], o[1]); w.y = pk2(o[2], o[3]); w.z = pk2(o[4], o[5]); w.w = pk2(o[6], o[7]);
            if (ok[j]) *(v4u*)(O + off[j]) = w;
        }
    }
}
struct EpiCIn {
    static constexpr int BMODE = 0;
    pg8::bf16_t* GU; pg8::bf16_t* GVT; pg8::bf16_t* GVS; float* SSQ; const float* ssq; LAS float* rc;
    __device__ __forceinline__ void operator()(const pg8::f32x4 (&acc)[2][2][4][2], const pg8::Unit& u, int wr, int wc, int fr, int fq) const {
        { const int l_ = lane_now(); fr = l_ & 15; fq = l_ >> 4; }
        const int pn = u.pn, pm = u.pm; const bool isv = pn >= 32; const int pt = isv ? pn - 32 : pn; float rs[2][4]; row_rstd_c(ssq, rc, pm, wr, wc, fr, fq, rs);
#pragma unroll
        for (int ai = 0; ai < 2; ++ai)
#pragma unroll
            for (int m = 0; m < 4; ++m) {
                const int i = ai * 128 + wr * 64 + m * 16 + fr; const size_t row = (size_t)pm * 256 + i; float ss = 0.f;
                if (!isv) {
#pragma unroll
                    for (int n = 0; n < 2; ++n) { const int c = pt * 128 + wc * 32 + n * 16 + 4 * fq; const pg8::f32x4 xu = acc[ai][0][m][n] * rs[ai][m], xg = acc[ai][1][m][n] * rs[ai][m]; float y[4];
#pragma unroll
                        for (int e = 0; e < 4; ++e) y[e] = gelu_tanh_f(xu[e]) * silu_f(xg[e]);
                        v2u w; w.x = pk2(y[0], y[1]); w.y = pk2(y[2], y[3]); *(v2u*)(GU + row * 4096 + c) = w; }
                } else {
#pragma unroll
                    for (int bj = 0; bj < 2; ++bj)
#pragma unroll
                        for (int n = 0; n < 2; ++n) { const int c = pt * 256 + bj * 128 + wc * 32 + n * 16 + 4 * fq; const pg8::f32x4 x = acc[ai][bj][m][n] * rs[ai][m]; float y[4];
#pragma unroll
                            for (int e = 0; e < 4; ++e) y[e] = gelu_tanh_f(x[e]);
                            v2u w; w.x = pk2(y[0], y[1]); w.y = pk2(y[2], y[3]);
                            ss += (y[0] * y[0] + y[1] * y[1]) + (y[2] * y[2] + y[3] * y[3]);
                            pg8::bf16_t* t = GVT + ((size_t)pm * 4096 + c) * 256 + i;
                            t[0] = (pg8::bf16_t)(w.x & 0xffffu); t[256] = (pg8::bf16_t)(w.x >> 16); t[512] = (pg8::bf16_t)(w.y & 0xffffu); t[768] = (pg8::bf16_t)(w.y >> 16);
                            if (pm >= 64) *(v2u*)(GVS + (row - MP) * 4096 + c) = w; }
                    ss += __shfl_xor(ss, 16); ss += __shfl_xor(ss, 32); if (fq == 0) SSQ[row * 64 + pt * 4 + wc] = ss;
                }
                if (m & 1) asm volatile("" ::: "memory");
            }
    }
};
__device__ __forceinline__ void c_prep(Frame& F, const float* SSQ, const float* wsin, const float* vgain, const bf16* GVS, bf16* Wm, float* ovm) {
    LAS float* rs = (LAS float*)(F.lds + RING_OFF);
    const int tid = F.tid;
    for (int it = F.bid; it < 66 * 8; it += F.G) {
        const int J = it >> 3, g = it & 7;
        __syncthreads();
        if (tid < 256) { const float* p = SSQ + ((size_t)J * 256 + tid) * 64; float s = 0.f;
#pragma unroll
            for (int k = 0; k < 16; ++k) { const f32x4 x = *(const f32x4*)(p + 4 * k); s += (x.x + x.y) + (x.z + x.w); }
            rs[tid] = 1.f / sqrtf(s * (1.f / 4096.f) + EPS); }
        __syncthreads();
        bf16* wm = Wm + (size_t)(J * 8 + g) * 65536; const int sh = J < 64 ? 7 : 6, cm = (1 << sh) - 1;
        for (int eb = tid; eb < 8192; eb += 4 * NTHR) {
            f32x4 wa[4], wb[4];
#pragma unroll
            for (int q = 0; q < 4; ++q) { const int e8 = eb + q * NTHR, i = e8 >> 5, j0 = (e8 & 31) * 8, il = i & cm, jl0 = j0 & cm; const bool on = (i >> sh) == (j0 >> sh) && jl0 <= il;
                const float* wr_ = wsin + ((size_t)g * 128 + (on ? il : 0)) * 128 + (on ? jl0 : 0); wa[q] = *(const f32x4*)wr_; wb[q] = *(const f32x4*)(wr_ + 4); }
#pragma unroll
            for (int q = 0; q < 4; ++q) { const int e8 = eb + q * NTHR, i = e8 >> 5, j0 = (e8 & 31) * 8, il = i & cm, jl0 = j0 & cm; const bool on = (i >> sh) == (j0 >> sh) && jl0 <= il; float y[8];
                const float wv[8] = {wa[q].x, wa[q].y, wa[q].z, wa[q].w, wb[q].x, wb[q].y, wb[q].z, wb[q].w};
#pragma unroll
                for (int k = 0; k < 8; ++k) y[k] = (on && jl0 + k <= il) ? wv[k] * rs[j0 + k] : 0.f;
                v4u w; w.x = pk2(y[0], y[1]); w.y = pk2(y[2], y[3]); w.z = pk2(y[4], y[5]); w.w = pk2(y[6], y[7]);
                *(v4u*)(wm + i * 256 + j0) = w; } }
    }
    const int gw = F.bid * NWAVES + F.wave, NGW = F.G * NWAVES, lane = F.lane;
    for (int r = gw; r < MS; r += NGW) {
        const float rstd = 1.f / sqrtf(wave_sum(SSQ[((size_t)MP + r) * 64 + lane]) * (1.f / 4096.f) + EPS);
        v4u vr[8]; f32x4 gar[8], gbr[8];
#pragma unroll
        for (int k = 0; k < 8; ++k) { const int col = k * 512 + lane * 8; vr[k] = *(const v4u*)(GVS + (size_t)r * 4096 + col); gar[k] = *(const f32x4*)(vgain + col); gbr[k] = *(const f32x4*)(vgain + col + 4); }
#pragma unroll
        for (int k = 0; k < 8; ++k) { const int col = k * 512 + lane * 8; const v4u v4 = vr[k];
            const f32x4 ga = gar[k], gb = gbr[k];
            float* o = ovm + (size_t)r * 4096 + col;
            *(f32x4*)o = (f32x4){bflo(v4.x) * rstd * ga.x, bfhi(v4.x) * rstd * ga.y, bflo(v4.y) * rstd * ga.z, bfhi(v4.y) * rstd * ga.w};
            *(f32x4*)(o + 4) = (f32x4){bflo(v4.z) * rstd * gb.x, bfhi(v4.z) * rstd * gb.y, bflo(v4.w) * rstd * gb.z, bfhi(v4.w) * rstd * gb.w}; }
    }
}
struct CMixOrder {
    int G, c; const char* Wm; const char* GVT;
    __device__ __forceinline__ bool next(int i, pg8::Unit& u) const { const int L = xcd_lin(i, G, c); if (L >= 66 * 16) return false; const int J = L >> 4, nt = L & 15;
        u.pm = J; u.pn = nt; u.a = Wm + ((size_t)(J * 8 + (nt >> 1)) * 65536) * 2; u.b = GVT + (((size_t)J * 4096 + nt * 256) * 256) * 2; return true; }
    __device__ __forceinline__ void a_ready(const pg8::Unit&) const {}
    __device__ __forceinline__ void done(const pg8::Unit&) const {}
};
struct EpiCMix {
    static constexpr int BMODE = 1;
    pg8::bf16_t* GU; const float* vgain; const float* bs;
    __device__ __forceinline__ void operator()(const pg8::f32x4 (&acc)[2][2][4][2], const pg8::Unit& u, int wr, int wc, int fr, int fq) const {
        { const int l_ = lane_now(); fr = l_ & 15; fq = l_ >> 4; }
        const int J = u.pm, nt = u.pn, g = nt >> 1, cm = J < 64 ? 127 : 63;
#pragma unroll
        for (int bj = 0; bj < 2; ++bj) { const int c0 = nt * 256 + bj * 128 + wc * 32 + 8 * fq; const f32x4 ga = *(const f32x4*)(vgain + c0), gb = *(const f32x4*)(vgain + c0 + 4);
            const float gn[8] = {ga.x, ga.y, ga.z, ga.w, gb.x, gb.y, gb.z, gb.w};
#pragma unroll
            for (int ai = 0; ai < 2; ++ai)
#pragma unroll
                for (int m = 0; m < 4; ++m) { const int i = ai * 128 + wr * 64 + m * 16 + fr; const size_t off = ((size_t)J * 256 + i) * 4096 + c0; const float b = bs[g * 128 + (i & cm)];
                    const v4u u4 = *(const v4u*)(GU + off); const pg8::f32x4 v0 = acc[ai][bj][m][0], v1 = acc[ai][bj][m][1];
                    const float mx[8] = {v0[0], v0[1], v0[2], v0[3], v1[0], v1[1], v1[2], v1[3]};
                    const float uu[8] = {bflo(u4.x), bfhi(u4.x), bflo(u4.y), bfhi(u4.y), bflo(u4.z), bfhi(u4.z), bflo(u4.w), bfhi(u4.w)};
                    float y[8];
#pragma unroll
                    for (int k = 0; k < 8; ++k) y[k] = uu[k] * (mx[k] * gn[k] + b);
                    v4u w; w.x = pk2(y[0], y[1]); w.y = pk2(y[2], y[3]); w.z = pk2(y[4], y[5]); w.w = pk2(y[6], y[7]);
                    *(v4u*)(GU + off) = w; } }
    }
};
__device__ __forceinline__ float diff_lambda(const float* q1, const float* k1, const float* q2, const float* k2, float lam_init) {
    float a = 0.f, b = 0.f;
    for (int i = 0; i < 64; ++i) { a += q1[i] * k1[i]; b += q2[i] * k2[i]; }
    return expf(a) - expf(b) + lam_init;
}

constexpr int N_PHASES = 21;
__global__ void __launch_bounds__(NTHR, 2) mega(Args args) {
    extern __shared__ __attribute__((aligned(16))) unsigned char lds[];
    Frame F;
    F.lds = (LAS unsigned char*)lds; F.tid = threadIdx.x; F.lane = F.tid & 63; F.wave = __builtin_amdgcn_readfirstlane(F.tid >> 6); F.G = gridDim.x; F.bid = blockIdx.x;
    F.in = args.in; F.out = args.out; F.ws = args.ws;
    unsigned char* ws = args.ws; float* out = args.out;
    bf16* W_AIN[2] = {(bf16*)(ws + WS_WAIN0), (bf16*)(ws + WS_WAIN1)}; bf16* W_AOUT[2] = {(bf16*)(ws + WS_WAOUT0), (bf16*)(ws + WS_WAOUT1)};
    bf16* W_RIN = (bf16*)(ws + WS_WRIN); bf16* W_ROUT = (bf16*)(ws + WS_WROUT); bf16* W_CIN = (bf16*)(ws + WS_WCIN); bf16* W_COUT = (bf16*)(ws + WS_WCOUT);
    bf16* XN0 = (bf16*)(ws + WS_XN0); bf16* HB = (bf16*)(ws + WS_HB); float* SSQ2 = (float*)(ws + WS_SSQ2);
    bf16* Qs = (bf16*)(ws + WS_QS); bf16* KP = (bf16*)(ws + WS_KP); bf16* VP = (bf16*)(ws + WS_VP); bf16* KC = (bf16*)(ws + WS_KC); bf16* VC = (bf16*)(ws + WS_VC); bf16* AO_A = (bf16*)(ws + WS_AOA);
    bf16* KT = (bf16*)(ws + WS_KT); bf16* RG = (bf16*)(ws + WS_RG); bf16* QP = (bf16*)(ws + WS_QP); bf16* KN = (bf16*)(ws + WS_KN); bf16* VS = (bf16*)(ws + WS_VS); bf16* ORET = (bf16*)(ws + WS_ORET);
    bf16* GU = (bf16*)(ws + WS_GU); bf16* SG = (bf16*)(ws + WS_SG); bf16* GVT = (bf16*)(ws + WS_GVT); bf16* WM = (bf16*)(ws + WS_WM); float* SSQ = (float*)(ws + WS_SSQ); bf16* GVS = (bf16*)(ws + WS_GVS); float* TABR = (float*)(ws + WS_TABR); bf16* KVX = (bf16*)(ws + WS_KVX); float* TABA = (float*)(ws + WS_TABA); bf16* GA = (bf16*)(ws + WS_GA);
    const int lo = args.ph_lo, hi = args.ph_hi;
    volatile LAS unsigned* MISC = (volatile LAS unsigned*)(F.lds + MISC_OFF);
    for (int u = F.tid; u < (LDS_BYTES - MISC_OFF) / 4; u += NTHR) ((LAS unsigned*)(F.lds + MISC_OFF))[u] = 0u;
    __syncthreads();
    XcdBarrier bar = xcd_barrier_post((unsigned*)(ws + WS_CTL) + 4096, MISC + 8);
    LAS float* RSC = (LAS float*)(F.lds + MISC_OFF + 4096);
#define RSC_RESET() do { if (F.wave == 0 && lane_now() == 0) ((volatile LAS int*)RSC)[0] = 0; } while (0)
#define IN(k) (lo <= (k) && (k) < hi)
#define PH_ENTER() do { int t_ = F.wave * 64 + lane_now(); F.tid = t_; F.lane = t_ & 63; } while (0)
    volatile LAS int* DRW = (volatile LAS int*)(F.lds + MISC_OFF + 64);
    unsigned* DCTR = (unsigned*)(ws + WS_CTL) + 8192;
#define DRAIN(ph, total, BODY) do { PH_ENTER(); unsigned tk_ = 0u; if (F.tid == 0) tk_ = atomicAdd(DCTR + 64 * (ph), 1u); for (;;) { __syncthreads(); if (F.tid == 0) DRW[0] = (int)tk_; __syncthreads(); const int c_ = DRW[0]; if (c_ >= (total)) break; \
        if (F.tid == 0) tk_ = atomicAdd(DCTR + 64 * (ph), 1u);     \
        BODY } } while (0)
#define SEAM(k) do { if (IN(k) && IN((k) + 1)) xcd_barrier(bar, F.wave == 0 && lane_now() == 0); } while (0)

#define GEMM_STORE(Aptr, Wptr, NN, KK, Optr) do { pg8::GemmP g{KK, KK, (KK) / 64}; pg8::StaticOrder S; S.init(MT / 256, (NN) / 256, F.G, F.bid, Aptr, Wptr, KK, KK); pg8::EpiStoreBf16 E{(pg8::bf16_t*)(Optr), NN}; \
        pg8::gemm_phase<pg8::EpiStoreBf16, pg8::StaticOrder>(F.lds + RING_OFF, g, S, E, F.tid); } while (0)
#define GEMM_RESIDB(MODE_, Aptr, Wptr, KK) do { pg8::GemmP g{KK, KK, (KK) / 64}; pg8::StaticOrder S; S.init(MT / 256, DM / 256, F.G, F.bid, Aptr, Wptr, KK, KK); \
        pg8::EpiResidB<MODE_> E{args.in[I_XP], args.in[I_XS], (pg8::bf16_t*)HB, out, SSQ2}; pg8::gemm_phase<pg8::EpiResidB<MODE_>, pg8::StaticOrder>(F.lds + RING_OFF, g, S, E, F.tid); } while (0)

    PH_ENTER(); if (IN(0)) {
        transpose_weight(F, args.in[I_AWIN], 2048, 8192, W_AIN[0]); attn_table(F, TABA);
        norm_rows(F, args.in[I_XP], args.in[I_XS], args.in[I_NW], XN0);
    }
    SEAM(0);
#define GEMM_AIN(Aptr, Wptr, J_, SSQP) do { pg8::GemmP g{2048, 2048, 32}; pg8::StaticOrder S; S.init(MT / 256, 32, F.G, F.bid, Aptr, Wptr, 2048, 2048); \
        EpiAIn E{Qs, KP, VP, KC, VC, GA, out + O_KP + (size_t)(J_) * MP * DM, out + O_VP + (size_t)(J_) * MP * DM, out + O_KS + (size_t)(J_) * MS * DM, out + O_VS + (size_t)(J_) * MS * DM, TABA, args.in[I_AQG] + 64 * (J_), args.in[I_AKG] + 64 * (J_), SSQP, RSC}; RSC_RESET(); \
        pg8::gemm_phase<EpiAIn, pg8::StaticOrder>(F.lds + RING_OFF, g, S, E, F.tid); } while (0)
    PH_ENTER(); if (IN(1)) { GEMM_AIN(XN0, W_AIN[0], 0, (const float*)nullptr);
        const int n0 = CC_CHUNKS, n1 = n0 + tw_chunks(2048, 2048), n2 = n1 + TR_CHUNKS;
        DRAIN(1, n2, if (c_ < n0) cc_run(F, args.in[I_CK], args.in[I_CV], KC, VC, c_); else if (c_ < n1) tw_run(F, args.in[I_AWOUT], 2048, 2048, W_AOUT[0], c_ - n0); else tr_run(F, TABR, c_ - n1);); }
    SEAM(1);
    PH_ENTER(); if (IN(3)) { const float li = 0.8f - 0.6f * expf(-0.3f * 0.f); const float lam = diff_lambda(args.in[I_LQ1], args.in[I_LK1], args.in[I_LQ2], args.in[I_LK2], li);
        attn_fast(F, Qs, KP, VP, KC, VC, GA, AO_A, lam, 1.f - li, args.in[I_ASG]); }
    SEAM(3);
    PH_ENTER(); if (IN(4)) { GEMM_RESIDB(0, AO_A, W_AOUT[0], 2048);
        const int n0 = tw_chunks(2048, 12288), n1 = n0 + tw_chunks(4096, 2048);
        DRAIN(4, n1, if (c_ < n0) tw_run(F, args.in[I_RWIN], 2048, 12288, W_RIN, c_, args.in[I_NW] + DM); else tw_run(F, args.in[I_RWOUT], 4096, 2048, W_ROUT, c_ - n0);); }
    if (IN(4) && IN(6)) xcd_barrier(bar, F.wave == 0 && lane_now() == 0);
    PH_ENTER(); if (IN(6)) { ret_zero_pad(F, VS, KT);
        PH_ENTER(); pg8::GemmP g{2048, 2048, 32}; pg8::StaticOrder S; S.init(MT / 256, 48, F.G, F.bid, HB, W_RIN, 2048, 2048); EpiRet E{QP, KN, KT, VS, RG, TABR, SSQ2, RSC}; RSC_RESET();
        pg8::gemm_phase<EpiRet, pg8::StaticOrder>(F.lds + RING_OFF, g, S, E, F.tid); }
    SEAM(6);
    PH_ENTER(); if (IN(7)) { { pg8::GemmP g{4096, 2048, 4}; RetQKOrder S{F.G, F.bid, (const char*)QP, (const char*)KN}; EpiRetQK E{QP}; pg8::gemm_phase<EpiRetQK, RetQKOrder>(F.lds + RING_OFF, g, S, E, F.tid); }
        PH_ENTER(); { pg8::GemmP g{512, 256, 4}; RetKVOrder S{F.G, F.bid, (const char*)VS, (const char*)KT}; EpiRetKV E{VS, KVX}; pg8::gemm_phase<EpiRetKV, RetKVOrder>(F.lds + RING_OFF, g, S, E, F.tid); }
        xcd_barrier(bar, F.wave == 0 && lane_now() == 0);
        PH_ENTER(); ret_scan(F, VS, KVX, args.in[I_SR], out + O_SP, out + O_SS); }
    SEAM(7);
    PH_ENTER(); if (IN(8)) { pg8::GemmP g{4096, 512, 8}; RetOOrder S{F.G, F.bid, (const char*)QP, (const char*)VS}; EpiRetO E{ORET}; pg8::gemm_phase<EpiRetO, RetOOrder>(F.lds + RING_OFF, g, S, E, F.tid); }
    SEAM(8);
    PH_ENTER(); if (IN(9)) r_out(F, ORET, RG);
    SEAM(9);
    PH_ENTER(); if (IN(10)) { GEMM_RESIDB(1, ORET, W_ROUT, 4096);
        const int n0 = tw_chunks(2048, 12288), n1 = n0 + tw_chunks(4096, 2048), n2 = n1 + tw_chunks(2048, 8192), n3 = n2 + tw_chunks(2048, 2048);
        DRAIN(10, n3, if (c_ < n0) tw_run(F, args.in[I_CWIN], 2048, 12288, W_CIN, c_, args.in[I_NW] + 2 * DM, true); else if (c_ < n1) tw_run(F, args.in[I_CWOUT], 4096, 2048, W_COUT, c_ - n0);
                      else if (c_ < n2) tw_run(F, args.in[I_AWIN] + (size_t)2048 * 8192, 2048, 8192, W_AIN[1], c_ - n1, args.in[I_NW] + 3 * DM); else tw_run(F, args.in[I_AWOUT] + (size_t)2048 * 2048, 2048, 2048, W_AOUT[1], c_ - n2);); }
    if (IN(10) && IN(12)) xcd_barrier(bar, F.wave == 0 && lane_now() == 0);
    PH_ENTER(); if (IN(12)) { pg8::GemmP g{2048, 2048, 32}; pg8::StaticOrder S; S.init(MT / 256, 48, F.G, F.bid, HB, W_CIN, 2048, 2048); EpiCIn E{GU, GVT, GVS, SSQ, SSQ2, RSC}; RSC_RESET();
        pg8::gemm_phase<EpiCIn, pg8::StaticOrder>(F.lds + RING_OFF, g, S, E, F.tid); }
    SEAM(12);
    PH_ENTER(); if (IN(13)) c_prep(F, SSQ, args.in[I_CWS], args.in[I_CVG], GVS, WM, out + O_VM);
    SEAM(13);
    PH_ENTER(); if (IN(14)) { pg8::GemmP g{256, 256, 4}; CMixOrder S{F.G, F.bid, (const char*)WM, (const char*)GVT}; EpiCMix E{GU, args.in[I_CVG], args.in[I_CBS]}; pg8::gemm_phase<EpiCMix, CMixOrder>(F.lds + RING_OFF, g, S, E, F.tid); }
    SEAM(14);
    PH_ENTER(); if (IN(15)) { GEMM_RESIDB(1, GU, W_COUT, 4096);
        DRAIN(15, CC_CHUNKS, cc_run(F, args.in[I_CK] + (size_t)NB * PAST * DM, args.in[I_CV] + (size_t)NB * PAST * DM, KC, VC, c_);); }
    if (IN(15) && IN(17)) xcd_barrier(bar, F.wave == 0 && lane_now() == 0);
    PH_ENTER(); if (IN(17)) GEMM_AIN(HB, W_AIN[1], 1, (const float*)SSQ2);
    SEAM(17);
    PH_ENTER(); if (IN(19)) { const float li = 0.8f - 0.6f * expf(-0.3f * 3.f); const float lam = diff_lambda(args.in[I_LQ1] + 64, args.in[I_LK1] + 64, args.in[I_LQ2] + 64, args.in[I_LK2] + 64, li);
        attn_fast(F, Qs, KP, VP, KC, VC, GA, AO_A, lam, 1.f - li, args.in[I_ASG] + 128); }
    SEAM(19);
    PH_ENTER(); if (IN(20)) GEMM_RESIDB(2, AO_A, W_AOUT[1], 2048);
#undef IN
#undef SEAM
}

extern "C" void kernel_launch(void* const* d_in, const int* in_sizes, int n_in, void* d_out, int out_size, void* d_ws, size_t ws_size, hipStream_t stream) {
    static int grid = 0;
    if (grid == 0) {
        if (n_in != N_IN || (size_t)out_size != O_END || ws_size < WS_END) { fprintf(stderr, "kernel_launch: unexpected shapes: n_in %d out %d ws %zu (need %zu)\n", n_in, out_size, ws_size, (size_t)WS_END); grid = -1; return; }
        int dev = 0, cus = 0;
        if (hipGetDevice(&dev) != hipSuccess || hipDeviceGetAttribute(&cus, hipDeviceAttributeMultiprocessorCount, dev) != hipSuccess) { grid = -1; return; }
        if (hipFuncSetAttribute((const void*)mega, hipFuncAttributeMaxDynamicSharedMemorySize, LDS_BYTES) != hipSuccess) { fprintf(stderr, "kernel_launch: hipFuncSetAttribute failed\n"); grid = -1; return; }
        int per_cu = 0;
        if (hipOccupancyMaxActiveBlocksPerMultiprocessor(&per_cu, (const void*)mega, NTHR, LDS_BYTES) != hipSuccess || per_cu < 1) { fprintf(stderr, "kernel_launch: occupancy query: %d workgroups per CU\n", per_cu); grid = -1; return; }
        (void)hipGetLastError();
        grid = cus;
    }
    if (grid < 0) return;
    Args a{};
    for (int i = 0; i < N_IN; ++i) a.in[i] = (const float*)d_in[i];
    a.out = (float*)d_out; a.ws = (unsigned char*)d_ws;
    (void)hipMemsetAsync((char*)d_ws + WS_CTL, 0, CTL_ZERO_BYTES, stream);
    a.ph_lo = 0; a.ph_hi = N_PHASES;
    hipLaunchKernelGGL(mega, dim3(grid), dim3(NTHR), LDS_BYTES, stream, a);
}
```
